# Optimizing an MI355X kernel written in HIP

```python
import jax, jax.numpy as jnp
from jax import lax
import numpy as np

D_MODEL = 1024
BATCH = 16
SEQ = 2048
DEPTH = 1

CHUNK = 64
RET_HEADS = 4
RET_DK = 128
RET_DV = 128
D_RET_QK = RET_HEADS * RET_DK
D_RET = RET_HEADS * RET_DV
MLSTM_HEADS = 4
MLSTM_D = 128
D_MLSTM = MLSTM_HEADS * MLSTM_D
D_MIX = D_RET + D_MLSTM
CONV_W = 4
ROPE_BASE = 10000.0
PEER_HEADS = 8
PEER_NKEYS = 128
PEER_TOPK = 16
PEER_DKEY = 256
PEER_N = PEER_NKEYS * PEER_NKEYS
PEER_BLOCK = 128
EPS = 1e-6
PROJ_SIZES = (D_RET_QK, D_RET_QK, D_RET, D_RET, D_MLSTM, D_MLSTM, D_MLSTM, MLSTM_HEADS, MLSTM_HEADS)
D_IN_PROJ = sum(PROJ_SIZES)

kernel_name = "retention_mlstm_peer_hybrid"


def rms_norm(x, g):
    xf = x.astype(jnp.float32)
    y = xf * lax.rsqrt(jnp.mean(xf * xf, axis=-1, keepdims=True) + EPS)
    return (y * g.astype(jnp.float32)).astype(x.dtype)


def head_group_norm(h, g):
    mu = jnp.mean(h, axis=-1, keepdims=True)
    var = jnp.mean(jnp.square(h - mu), axis=-1, keepdims=True)
    return (h - mu) * lax.rsqrt(var + EPS) * g.astype(jnp.float32)


def rotary(t, pos):
    half = t.shape[-1] // 2
    inv = ROPE_BASE ** (-jnp.arange(half, dtype=jnp.float32) / half)
    ang = pos.astype(jnp.float32)[:, None] * inv[None, :]
    cos = jnp.cos(ang)[None, :, None, :]
    sin = jnp.sin(ang)[None, :, None, :]
    t1, t2 = t[..., :half], t[..., half:]
    return jnp.concatenate([t1 * cos - t2 * sin, t1 * sin + t2 * cos], axis=-1)


def to_chunks(t):
    b, s, h, d = t.shape
    return t.reshape(b, s // CHUNK, CHUNK, h, d).transpose(1, 0, 3, 2, 4)


def from_chunks(t):
    nc, b, h, l, d = t.shape
    return t.transpose(1, 0, 3, 2, 4).reshape(b, nc * l, h, d)


def causal_dwconv(x, w, b):
    s = x.shape[1]
    xp = jnp.pad(x, ((0, 0), (CONV_W - 1, 0), (0, 0)))
    y = b + xp[:, 0:s] * w[0]
    for j in range(1, CONV_W):
        y = y + xp[:, j:j + s] * w[j]
    return y


def retention(q, k, v):
    b, _, h, dk = q.shape
    dv = v.shape[-1]
    log_g = jnp.log(1.0 - 2.0 ** (-5.0 - jnp.arange(h, dtype=jnp.float32)))
    l = jnp.arange(CHUNK, dtype=jnp.float32)
    intra_decay = jnp.exp(log_g[:, None, None] * jnp.abs(l[:, None] - l[None, :]))
    q_decay = jnp.exp(log_g[:, None] * (l + 1.0))[None, :, :, None]
    k_decay = jnp.exp(log_g[:, None] * (CHUNK - 1.0 - l))[None, :, :, None]
    chunk_decay = jnp.exp(log_g * CHUNK)[None, :, None, None]
    qc, kc, vc = to_chunks(q), to_chunks(k), to_chunks(v)
    scores = jnp.einsum('cbhld,cbhmd->cbhlm', qc, kc) * intra_decay
    o_intra = jnp.einsum('cbhlm,cbhmv->cbhlv', scores, vc)

    def step(state, inp):
        q_c, k_c, v_c = inp
        cross = jnp.einsum('bhld,bhdv->bhlv', q_c, state) * q_decay
        state = chunk_decay * state + jnp.einsum('bhld,bhlv->bhdv', k_c * k_decay, v_c)
        return state, cross

    state0 = jnp.zeros((b, h, dk, dv), jnp.float32)
    _, o_cross = lax.scan(step, state0, (qc, kc, vc))
    return from_chunks(o_intra + o_cross)


def mlstm(q, k, v, i_pre, log_f):
    b, s, h, d = q.shape
    nc = s // CHUNK
    qc, kc, vc = to_chunks(q), to_chunks(k), to_chunks(v)
    ic = i_pre.reshape(b, nc, CHUNK, h).transpose(1, 0, 3, 2)
    fc = log_f.reshape(b, nc, CHUNK, h).transpose(1, 0, 3, 2)
    f_cum = jnp.cumsum(fc, axis=-1)
    a = f_cum[..., -1]
    logw = a[..., None] - f_cum + ic
    m_in = jnp.max(logw, axis=-1)

    def step(carry, inp):
        c_mem, n_mem, m = carry
        q_c, k_c, v_c, logw_c, a_c, m_in_c = inp
        m_new = jnp.maximum(a_c + m, m_in_c)
        decay = jnp.exp(a_c + m - m_new)
        w = jnp.exp(logw_c - m_new[..., None])
        c_mem = decay[..., None, None] * c_mem + jnp.einsum('bhs,bhsk,bhsv->bhkv', w, k_c, v_c)
        n_mem = decay[..., None] * n_mem + jnp.einsum('bhs,bhsk->bhk', w, k_c)
        num = jnp.einsum('bhlk,bhkv->bhlv', q_c, c_mem)
        den = jnp.maximum(jnp.abs(jnp.einsum('bhlk,bhk->bhl', q_c, n_mem)),
                          jnp.exp(-m_new)[..., None])
        return (c_mem, n_mem, m_new), num / den[..., None]

    init = (jnp.zeros((b, h, d, d), jnp.float32),
            jnp.zeros((b, h, d), jnp.float32),
            jnp.zeros((b, h), jnp.float32))
    _, hc = lax.scan(step, init, (qc, kc, vc, logw, a, m_in))
    return from_chunks(hc)


def peer(xn, wq, keys, down, up):
    b, s, d = xn.shape
    t = b * s
    xt = xn.reshape(t, d)
    q = (xt @ wq).reshape(t, PEER_HEADS, 2, PEER_DKEY // 2).astype(jnp.float32)
    sub = jnp.einsum('thpd,hpnd->thpn', q, keys.astype(jnp.float32))
    s_top, i_top = lax.top_k(sub, PEER_TOPK)
    cand = (s_top[:, :, 0, :, None] + s_top[:, :, 1, None, :]).reshape(t, PEER_HEADS, PEER_TOPK * PEER_TOPK)
    best, flat = lax.top_k(cand, PEER_TOPK)
    i1 = jnp.take_along_axis(i_top[:, :, 0, :], flat // PEER_TOPK, axis=-1)
    i2 = jnp.take_along_axis(i_top[:, :, 1, :], flat % PEER_TOPK, axis=-1)
    expert = i1 * PEER_NKEYS + i2
    gates = jax.nn.softmax(best, axis=-1)
    nb = t // PEER_BLOCK
    e_per_tok = PEER_HEADS * PEER_TOPK
    xb = xt.reshape(nb, PEER_BLOCK, d)
    eb = expert.reshape(nb, PEER_BLOCK, e_per_tok)
    gb = gates.astype(xt.dtype).reshape(nb, PEER_BLOCK, e_per_tok)

    def block(args):
        xi, ei, gi = args
        u = jnp.take(down, ei, axis=0)
        act = jax.nn.gelu(jnp.einsum('td,ted->te', xi, u), approximate=False)
        vv = jnp.take(up, ei, axis=0)
        return jnp.einsum('te,ted->td', gi * act, vv)

    out = lax.map(block, (xb, eb, gb))
    return out.reshape(b, s, d)


def hybrid_layer(x, norm1_g, w_in, ret_norm_g, m_conv_w, m_conv_b, m_wq, m_wk,
                 m_b_i, m_b_f, m_norm_g, m_skip, w_out, norm2_g,
                 peer_wq, peer_keys, peer_down, peer_up):
    f32 = jnp.float32
    b, s, _ = x.shape
    pos = jnp.arange(s, dtype=jnp.int32)
    h = rms_norm(x, norm1_g)
    proj = h @ w_in
    split_idx = [int(v) for v in np.cumsum(PROJ_SIZES)[:-1]]
    rq, rk, rv, rg, mx, mv, mo, mi, mf = jnp.split(proj, split_idx, axis=-1)

    rq = rotary(rq.reshape(b, s, RET_HEADS, RET_DK).astype(f32), pos)
    rk = rotary(rk.reshape(b, s, RET_HEADS, RET_DK).astype(f32), pos) * (RET_DK ** -0.5)
    rv = rv.reshape(b, s, RET_HEADS, RET_DV).astype(f32)
    o_ret = head_group_norm(retention(rq, rk, rv), ret_norm_g).reshape(b, s, D_RET)
    y_ret = jax.nn.silu(rg.astype(f32)) * o_ret

    c = jax.nn.silu(causal_dwconv(mx, m_conv_w, m_conv_b)).astype(f32)
    ch = c.reshape(b, s, MLSTM_HEADS, MLSTM_D)
    mq = jnp.einsum('bshd,hde->bshe', ch, m_wq.astype(f32))
    mk = jnp.einsum('bshd,hde->bshe', ch, m_wk.astype(f32)) * (MLSTM_D ** -0.5)
    mvv = mv.reshape(b, s, MLSTM_HEADS, MLSTM_D).astype(f32)
    i_pre = mi.astype(f32) + m_b_i.astype(f32)
    log_f = jax.nn.log_sigmoid(mf.astype(f32) + m_b_f.astype(f32))
    hm = head_group_norm(mlstm(mq, mk, mvv, i_pre, log_f), m_norm_g).reshape(b, s, D_MLSTM)
    y_m = jax.nn.sigmoid(mo.astype(f32)) * (hm + m_skip.astype(f32) * c)

    y = jnp.concatenate([y_ret, y_m], axis=-1).astype(x.dtype) @ w_out
    x = x + y
    x = x + peer(rms_norm(x, norm2_g), peer_wq, peer_keys, peer_down, peer_up)
    return x


def setup_inputs(seed: int = 0) -> dict:
    key = jax.random.key(seed)
    ks = jax.random.split(key, 20)
    f32 = jnp.float32
    nrm = lambda k, shape: jax.random.normal(k, shape, f32)
    L = DEPTH
    return {
        "x": nrm(ks[0], (BATCH, SEQ, D_MODEL)),
        "norm1_g": 1.0 + 0.02 * nrm(ks[1], (L, D_MODEL)),
        "w_in": nrm(ks[2], (L, D_MODEL, D_IN_PROJ)) * D_MODEL ** -0.5,
        "ret_norm_g": 1.0 + 0.02 * nrm(ks[3], (L, RET_HEADS, RET_DV)),
        "m_conv_w": nrm(ks[4], (L, CONV_W, D_MLSTM)) * CONV_W ** -0.5,
        "m_conv_b": 0.02 * nrm(ks[5], (L, D_MLSTM)),
        "m_wq": nrm(ks[6], (L, MLSTM_HEADS, MLSTM_D, MLSTM_D)) * MLSTM_D ** -0.5,
        "m_wk": nrm(ks[7], (L, MLSTM_HEADS, MLSTM_D, MLSTM_D)) * MLSTM_D ** -0.5,
        "m_b_i": 0.1 * nrm(ks[8], (L, MLSTM_HEADS)),
        "m_b_f": jnp.linspace(3.0, 6.0, MLSTM_HEADS, dtype=f32)[None, :] + 0.1 * nrm(ks[9], (L, MLSTM_HEADS)),
        "m_norm_g": 1.0 + 0.02 * nrm(ks[10], (L, MLSTM_HEADS, MLSTM_D)),
        "m_skip": 1.0 + 0.02 * nrm(ks[11], (L, D_MLSTM)),
        "w_out": nrm(ks[12], (L, D_MIX, D_MODEL)) * D_MIX ** -0.5,
        "norm2_g": 1.0 + 0.02 * nrm(ks[13], (L, D_MODEL)),
        "peer_wq": nrm(ks[14], (L, D_MODEL, PEER_HEADS * PEER_DKEY)) * D_MODEL ** -0.5,
        "peer_keys": nrm(ks[15], (L, PEER_HEADS, 2, PEER_NKEYS, PEER_DKEY // 2)) * (PEER_DKEY // 2) ** -0.5,
        "peer_down": nrm(ks[16], (L, PEER_N, D_MODEL)) * D_MODEL ** -0.5,
        "peer_up": nrm(ks[17], (L, PEER_N, D_MODEL)) * PEER_HEADS ** -0.5,
        "final_g": 1.0 + 0.02 * nrm(ks[18], (D_MODEL,)),
    }


def reference(x, norm1_g, w_in, ret_norm_g, m_conv_w, m_conv_b, m_wq, m_wk,
              m_b_i, m_b_f, m_norm_g, m_skip, w_out, norm2_g,
              peer_wq, peer_keys, peer_down, peer_up, final_g):
    for i in range(DEPTH):
        x = hybrid_layer(x, norm1_g[i], w_in[i], ret_norm_g[i], m_conv_w[i], m_conv_b[i],
                         m_wq[i], m_wk[i], m_b_i[i], m_b_f[i], m_norm_g[i], m_skip[i],
                         w_out[i], norm2_g[i], peer_wq[i], peer_keys[i],
                         peer_down[i], peer_up[i])
    return rms_norm(x, final_g)
```

```cpp
#include <hip/hip_runtime.h>
#include <stdint.h>

typedef unsigned short bf16_t;
typedef short bf16x8 __attribute__((ext_vector_type(8)));
typedef float f32x4 __attribute__((ext_vector_type(4)));

#define DEVI __device__ __forceinline__

constexpr int T_TOK = 32768, DM = 1024, NPJ = 3584, DIN = 3592;
constexpr int NTHR = 256;
constexpr float EPSN = 1e-6f;

struct Params {
    const float *x, *norm1_g, *w_in, *ret_norm_g, *m_conv_w, *m_conv_b, *m_wq, *m_wk, *m_b_i, *m_b_f, *m_norm_g, *m_skip, *w_out,
        *norm2_g, *peer_wq, *peer_keys, *peer_down, *peer_up, *final_g;
    float* out;
    bf16_t *proj, *xb, *yb, *mq, *mk, *x1b, *cbuf, *down_bf, *up_bf, *W1t, *W2t, *Wsubt, *Wqt, *Wkt;
    float *rs1, *rs2, *ipre, *logf, *rope_cos, *rope_sin, *sub, *gate;
    int* eidx;
};

DEVI unsigned f2bf_bits(float f) { unsigned u = __float_as_uint(f); return (u + 0x7fffu + ((u >> 16) & 1u)) >> 16; }
DEVI bf16_t f2bf(float f) { return (bf16_t)f2bf_bits(f); }
DEVI unsigned pk2(float lo, float hi) { return f2bf_bits(lo) | (f2bf_bits(hi) << 16); }
DEVI float bflo(unsigned w) { return __uint_as_float(w << 16); }
DEVI float bfhi(unsigned w) { return __uint_as_float(w & 0xffff0000u); }
DEVI float bf2f(bf16_t h) { return __uint_as_float(((unsigned)h) << 16); }
DEVI float wave_sum(float v) {
#pragma unroll
    for (int o = 32; o; o >>= 1) v += __shfl_xor(v, o);
    return v;
}
DEVI float wave_max(float v) {
#pragma unroll
    for (int o = 32; o; o >>= 1) v = fmaxf(v, __shfl_xor(v, o));
    return v;
}
DEVI f32x4 mfma16(bf16x8 a, bf16x8 b, f32x4 c) { return __builtin_amdgcn_mfma_f32_16x16x32_bf16(a, b, c, 0, 0, 0); }
DEVI bf16x8 ld8(const char* p) { return *reinterpret_cast<const bf16x8*>(p); }
DEVI bf16x8 mk8(uint2 lo, uint2 hi) {
    union { uint4 u; bf16x8 v; } x;
    x.u = make_uint4(lo.x, lo.y, hi.x, hi.y);
    return x.v;
}
DEVI float sigmoidf_(float z) { return 1.f / (1.f + __expf(-z)); }

DEVI void st_prep_misc(const Params& p) {
    const int gtid = blockIdx.x * NTHR + threadIdx.x, gsz = gridDim.x * NTHR;
    for (int i = gtid; i < 2048 * 64; i += gsz) {
        const int pos = i >> 6, j = i & 63;
        const float inv = powf(10000.f, -(float)j * (1.f / 64.f));
        const float ang = (float)pos * inv;
        float s, c;
        sincosf(ang, &s, &c);
        p.rope_cos[i] = c;
        p.rope_sin[i] = s;
    }
    for (int i = gtid; i < 4 * 128 * 128; i += gsz) {
        const int h = i >> 14, e = (i >> 7) & 127, d = i & 127;
        p.Wqt[i] = f2bf(p.m_wq[h * 16384 + d * 128 + e]);
        p.Wkt[i] = f2bf(p.m_wk[h * 16384 + d * 128 + e] * 0.08838834764831845f);
    }
    const int n8 = 16384 * 1024 / 8;
    for (int i = gtid; i < 2 * n8; i += gsz) {
        const bool up = i >= n8;
        const int k = up ? i - n8 : i;
        const float4* s = (const float4*)(up ? p.peer_up : p.peer_down) + (size_t)k * 2;
        const float4 a = s[0], b = s[1];
        uint4 o = make_uint4(pk2(a.x, a.y), pk2(a.z, a.w), pk2(b.x, b.y), pk2(b.z, b.w));
        ((uint4*)(up ? p.up_bf : p.down_bf))[k] = o;
    }
}

DEVI void transpose_tile(const float* __restrict__ src, int ld, const float* __restrict__ scale, bf16_t* __restrict__ dst, int K, int k0, int n0,
                         float* tile) {
    const int tx = threadIdx.x & 31, ty = threadIdx.x >> 5;
#pragma unroll
    for (int i = 0; i < 4; ++i) {
        const int k = k0 + ty + 8 * i;
        float v = src[(size_t)k * ld + n0 + tx];
        if (scale) v *= scale[k];
        tile[(ty + 8 * i) * 33 + tx] = v;
    }
    __syncthreads();
#pragma unroll
    for (int i = 0; i < 4; ++i) {
        const int n = n0 + ty + 8 * i;
        dst[(size_t)n * K + k0 + tx] = f2bf(tile[tx * 33 + ty + 8 * i]);
    }
    __syncthreads();
}
DEVI void st_prep_w(const Params& p, char* smem) {
    float* tile = (float*)smem;
    constexpr int N1 = (NPJ / 32) * 32, N2 = 32 * 32;
    for (int it = blockIdx.x; it < N1 + N2; it += gridDim.x) {
        if (it < N1) {
            const int nt = it >> 5, kt = it & 31;
            transpose_tile(p.w_in, DIN, p.norm1_g, p.W1t, 1024, kt * 32, nt * 32, tile);
        } else {
            const int r = it - N1, nt = r >> 5, kt = r & 31;
            transpose_tile(p.w_out, 1024, nullptr, p.W2t, 1024, kt * 32, nt * 32, tile);
        }
    }
}
DEVI void st_prep_wsub(const Params& p, char* smem) {
    float* wq_s = (float*)smem;
    float* key_s = wq_s + 32 * 129 + 16;
    const int tid = threadIdx.x;
    for (int it = blockIdx.x; it < 16 * 32 * 2; it += gridDim.x) {
        const int grp = it >> 6, kt = (it >> 1) & 31, nh = it & 1, k0 = kt * 32;
#pragma unroll
        for (int i = 0; i < 16; ++i) {
            const int idx = tid + 256 * i, r = idx >> 7, d = idx & 127;
            wq_s[r * 129 + d] = p.peer_wq[(size_t)(k0 + r) * 2048 + grp * 128 + d];
        }
#pragma unroll
        for (int i = 0; i < 32; ++i) {
            const int idx = tid + 256 * i, n = idx >> 7, d = idx & 127;
            key_s[n * 128 + d] = p.peer_keys[((size_t)grp * 128 + nh * 64 + n) * 128 + d];
        }
        __syncthreads();
        const int kl = tid & 31, ng = tid >> 5;
        float acc[8];
#pragma unroll
        for (int i = 0; i < 8; ++i) acc[i] = 0.f;
        for (int d = 0; d < 128; ++d) {
            const float a = wq_s[kl * 129 + d];
#pragma unroll
            for (int i = 0; i < 8; ++i) acc[i] += a * key_s[(ng * 8 + i) * 128 + d];
        }
        const float g = p.norm2_g[k0 + kl];
#pragma unroll
        for (int i = 0; i < 8; ++i) p.Wsubt[(size_t)(grp * 128 + nh * 64 + ng * 8 + i) * 1024 + k0 + kl] = f2bf(acc[i] * g);
        __syncthreads();
    }
}

DEVI void st_prep_x(const Params& p, char* smem) {
    float* Wg_s = (float*)smem;
    for (int i = threadIdx.x; i < 8192; i += NTHR) {
        const int k = i >> 3, g = i & 7;
        Wg_s[g * 1024 + k] = p.norm1_g[k] * p.w_in[(size_t)k * DIN + NPJ + g];
    }
    __syncthreads();
    const int lane = threadIdx.x & 63, wid = threadIdx.x >> 6;
    for (int t = blockIdx.x * 4 + wid; t < T_TOK; t += gridDim.x * 4) {
        const float4* xr = (const float4*)(p.x + (size_t)t * 1024);
        float4 v[4];
        float ss = 0.f, g8[8];
#pragma unroll
        for (int g = 0; g < 8; ++g) g8[g] = 0.f;
#pragma unroll
        for (int j = 0; j < 4; ++j) {
            v[j] = xr[lane + 64 * j];
            ss += v[j].x * v[j].x + v[j].y * v[j].y + v[j].z * v[j].z + v[j].w * v[j].w;
#pragma unroll
            for (int g = 0; g < 8; ++g) {
                const float4 w = *(const float4*)(Wg_s + g * 1024 + (lane + 64 * j) * 4);
                g8[g] += v[j].x * w.x + v[j].y * w.y + v[j].z * w.z + v[j].w * w.w;
            }
        }
        ss = wave_sum(ss);
#pragma unroll
        for (int g = 0; g < 8; ++g) g8[g] = wave_sum(g8[g]);
        const float rs = rsqrtf(ss * (1.f / 1024.f) + EPSN);
        uint2* o = (uint2*)(p.xb + (size_t)t * 1024);
#pragma unroll
        for (int j = 0; j < 4; ++j) o[lane + 64 * j] = make_uint2(pk2(v[j].x, v[j].y), pk2(v[j].z, v[j].w));
        if (lane == 0) {
            p.rs1[t] = rs;
#pragma unroll
            for (int h = 0; h < 4; ++h) {
                p.ipre[t * 4 + h] = g8[h] * rs + p.m_b_i[h];
                const float z = g8[4 + h] * rs + p.m_b_f[h];
                p.logf[t * 4 + h] = fminf(z, 0.f) - log1pf(__expf(-fabsf(z)));
            }
        }
    }
}

constexpr int G_LDS_ROW = 144;
constexpr int G_LDS_MAT = 128 * G_LDS_ROW;
constexpr int G_LDS_BYTES = 4 * G_LDS_MAT;

template <class Epi>
DEVI void gemm_tile(const bf16_t* __restrict__ A, const bf16_t* __restrict__ Bt, int K, int m0, int n0, char* smem, const Epi& epi) {
    const int tid = threadIdx.x, lane = tid & 63, wid = tid >> 6, wr = wid >> 1, wc = wid & 1, fr = lane & 15, fq = lane >> 4;
    f32x4 acc[4][4];
#pragma unroll
    for (int i = 0; i < 4; ++i)
#pragma unroll
        for (int j = 0; j < 4; ++j) acc[i][j] = (f32x4){0.f, 0.f, 0.f, 0.f};
    uint4 ra[4], rb[4];
    const int nt = K / 64;
    auto gload = [&](int kt) {
#pragma unroll
        for (int i = 0; i < 4; ++i) {
            const int id = tid + 256 * i, r = id >> 3, c = id & 7;
            ra[i] = *(const uint4*)(A + (size_t)(m0 + r) * K + kt * 64 + c * 8);
            rb[i] = *(const uint4*)(Bt + (size_t)(n0 + r) * K + kt * 64 + c * 8);
        }
    };
    auto swrite = [&](int buf) {
        char* As = smem + buf * 2 * G_LDS_MAT;
        char* Bs = As + G_LDS_MAT;
#pragma unroll
        for (int i = 0; i < 4; ++i) {
            const int id = tid + 256 * i, r = id >> 3, c = id & 7;
            *(uint4*)(As + r * G_LDS_ROW + c * 16) = ra[i];
            *(uint4*)(Bs + r * G_LDS_ROW + c * 16) = rb[i];
        }
    };
    gload(0);
    swrite(0);
    __syncthreads();
    for (int kt = 0; kt < nt; ++kt) {
        if (kt + 1 < nt) gload(kt + 1);
        const char* As = smem + (kt & 1) * 2 * G_LDS_MAT;
        const char* Bs = As + G_LDS_MAT;
#pragma unroll
        for (int kk = 0; kk < 2; ++kk) {
            bf16x8 a[4], b[4];
#pragma unroll
            for (int i = 0; i < 4; ++i) a[i] = ld8(As + (wr * 64 + i * 16 + fr) * G_LDS_ROW + (kk * 4 + fq) * 16);
#pragma unroll
            for (int j = 0; j < 4; ++j) b[j] = ld8(Bs + (wc * 64 + j * 16 + fr) * G_LDS_ROW + (kk * 4 + fq) * 16);
#pragma unroll
            for (int i = 0; i < 4; ++i)
#pragma unroll
                for (int j = 0; j < 4; ++j) acc[i][j] = mfma16(b[j], a[i], acc[i][j]);
        }
        if (kt + 1 < nt) swrite((kt + 1) & 1);
        __syncthreads();
    }
#pragma unroll
    for (int i = 0; i < 4; ++i)
#pragma unroll
        for (int j = 0; j < 4; ++j) epi(acc[i][j], m0 + wr * 64 + i * 16 + fr, n0 + wc * 64 + j * 16 + 4 * fq);
}
struct EpiProj {
    bf16_t* proj; const float* rs1;
    DEVI void operator()(const f32x4& v, int m, int n) const {
        const float s = rs1[m];
        *(uint2*)(proj + (size_t)m * NPJ + n) = make_uint2(pk2(v[0] * s, v[1] * s), pk2(v[2] * s, v[3] * s));
    }
};
struct EpiX1 {
    const float* x; float* out;
    DEVI void operator()(const f32x4& v, int m, int n) const {
        const float4 xv = *(const float4*)(x + (size_t)m * 1024 + n);
        *(float4*)(out + (size_t)m * 1024 + n) = make_float4(xv.x + v[0], xv.y + v[1], xv.z + v[2], xv.w + v[3]);
    }
};
struct EpiSub {
    float* sub; const float* rs2;
    DEVI void operator()(const f32x4& v, int m, int n) const {
        const float s = rs2[m];
        *(float4*)(sub + (size_t)m * 2048 + n) = make_float4(v[0] * s, v[1] * s, v[2] * s, v[3] * s);
    }
};
template <class Epi>
DEVI void st_gemm(const bf16_t* A, const bf16_t* Bt, int N, int K, char* smem, const Epi& epi) {
    const int nN = N / 128, ntile = (T_TOK / 128) * nN;
    for (int it = blockIdx.x; it < ntile; it += gridDim.x) {
        const int pm = it / nN, pn = it - pm * nN;
        gemm_tile(A, Bt, K, pm * 128, pn * 128, smem, epi);
    }
}

DEVI void st_conv_qk(const Params& p, char* smem) {
    char* cs = smem;
    char* ws = smem + 128 * 272;
    const int tid = threadIdx.x, lane = tid & 63, wid = tid >> 6, wr = wid >> 1, wc = wid & 1, fr = lane & 15, fq = lane >> 4;
    for (int it = blockIdx.x; it < 256 * 4; it += gridDim.x) {
        const int h = it & 3, t0 = (it >> 2) * 128, s0 = t0 & 2047;
        {
            const int ch = tid & 127, r0 = (tid >> 7) * 64;
            const int col = 2048 + h * 128 + ch;
            const float w0 = p.m_conv_w[0 * 512 + h * 128 + ch], w1 = p.m_conv_w[1 * 512 + h * 128 + ch], w2 = p.m_conv_w[2 * 512 + h * 128 + ch],
                        w3 = p.m_conv_w[3 * 512 + h * 128 + ch], bb = p.m_conv_b[h * 128 + ch];
            float xm3 = 0.f, xm2 = 0.f, xm1 = 0.f;
            if (s0 + r0 > 0) {
                xm3 = bf2f(p.proj[(size_t)(t0 + r0 - 3) * NPJ + col]);
                xm2 = bf2f(p.proj[(size_t)(t0 + r0 - 2) * NPJ + col]);
                xm1 = bf2f(p.proj[(size_t)(t0 + r0 - 1) * NPJ + col]);
            }
            for (int r = r0; r < r0 + 64; ++r) {
                const float xc = bf2f(p.proj[(size_t)(t0 + r) * NPJ + col]);
                const float y = bb + w0 * xm3 + w1 * xm2 + w2 * xm1 + w3 * xc;
                const float c = y * sigmoidf_(y);
                const bf16_t cb = f2bf(c);
                *(bf16_t*)(cs + r * 272 + ch * 2) = cb;
                p.cbuf[(size_t)(t0 + r) * 512 + h * 128 + ch] = cb;
                xm3 = xm2; xm2 = xm1; xm1 = xc;
            }
        }
#pragma unroll
        for (int which = 0; which < 2; ++which) {
            const bf16_t* W = (which ? p.Wkt : p.Wqt) + h * 16384;
            bf16_t* O = which ? p.mk : p.mq;
#pragma unroll
            for (int i = 0; i < 8; ++i) {
                const int id = tid + 256 * i, r = id >> 4, c = id & 15;
                *(uint4*)(ws + r * 272 + c * 16) = *(const uint4*)(W + r * 128 + c * 8);
            }
            __syncthreads();
            f32x4 acc[4][4];
#pragma unroll
            for (int i = 0; i < 4; ++i)
#pragma unroll
                for (int j = 0; j < 4; ++j) acc[i][j] = (f32x4){0.f, 0.f, 0.f, 0.f};
#pragma unroll
            for (int ks = 0; ks < 4; ++ks) {
                bf16x8 a[4], b[4];
#pragma unroll
                for (int i = 0; i < 4; ++i) a[i] = ld8(cs + (wr * 64 + i * 16 + fr) * 272 + (ks * 4 + fq) * 16);
#pragma unroll
                for (int j = 0; j < 4; ++j) b[j] = ld8(ws + (wc * 64 + j * 16 + fr) * 272 + (ks * 4 + fq) * 16);
#pragma unroll
                for (int i = 0; i < 4; ++i)
#pragma unroll
                    for (int j = 0; j < 4; ++j) acc[i][j] = mfma16(b[j], a[i], acc[i][j]);
            }
#pragma unroll
            for (int i = 0; i < 4; ++i)
#pragma unroll
                for (int j = 0; j < 4; ++j) {
                    const int m = t0 + wr * 64 + i * 16 + fr, n = h * 128 + wc * 64 + j * 16 + 4 * fq;
                    const f32x4 v = acc[i][j];
                    *(uint2*)(O + (size_t)m * 512 + n) = make_uint2(pk2(v[0], v[1]), pk2(v[2], v[3]));
                }
            __syncthreads();
        }
    }
}

DEVI void ret_item(const Params& p, char* smem, int b, int h, int vh) {
    char* qs = smem;
    char* ks = smem + 17408;
    char* kTs = smem + 34816;
    char* vTs = smem + 53248;
    char* Ss = smem + 62464;
    const int tid = threadIdx.x, lane = tid & 63, w = tid >> 6, fr = lane & 15, fq = lane >> 4;
    const float gamma = 1.f - exp2f(-5.f - (float)h);
    const float l2g = log2f(gamma);
    const float g64 = exp2f(l2g * 64.f);
    f32x4 st[8];
#pragma unroll
    for (int i = 0; i < 8; ++i) st[i] = (f32x4){0.f, 0.f, 0.f, 0.f};
    for (int c = 0; c < 32; ++c) {
        const int t0 = b * 2048 + c * 64;
#pragma unroll
        for (int i = 0; i < 2; ++i) {
            const int u = tid + 256 * i, m = u >> 3, j0 = (u & 7) * 8;
            const int pos = c * 64 + m;
            const float4 c0 = *(const float4*)(p.rope_cos + pos * 64 + j0), c1 = *(const float4*)(p.rope_cos + pos * 64 + j0 + 4);
            const float4 s0 = *(const float4*)(p.rope_sin + pos * 64 + j0), s1 = *(const float4*)(p.rope_sin + pos * 64 + j0 + 4);
            const float cs_[8] = {c0.x, c0.y, c0.z, c0.w, c1.x, c1.y, c1.z, c1.w};
            const float sn_[8] = {s0.x, s0.y, s0.z, s0.w, s1.x, s1.y, s1.z, s1.w};
            const bf16_t* row = p.proj + (size_t)(t0 + m) * NPJ + h * 128 + j0;
            {
                const uint4 a = *(const uint4*)(row), bq = *(const uint4*)(row + 64);
                const unsigned aw[4] = {a.x, a.y, a.z, a.w}, bw[4] = {bq.x, bq.y, bq.z, bq.w};
                unsigned o1[4], o2[4];
#pragma unroll
                for (int e = 0; e < 4; ++e) {
                    const float t1a = bflo(aw[e]), t1b = bfhi(aw[e]), t2a = bflo(bw[e]), t2b = bfhi(bw[e]);
                    o1[e] = pk2(t1a * cs_[2 * e] - t2a * sn_[2 * e], t1b * cs_[2 * e + 1] - t2b * sn_[2 * e + 1]);
                    o2[e] = pk2(t1a * sn_[2 * e] + t2a * cs_[2 * e], t1b * sn_[2 * e + 1] + t2b * cs_[2 * e + 1]);
                }
                *(uint4*)(qs + m * 272 + j0 * 2) = make_uint4(o1[0], o1[1], o1[2], o1[3]);
                *(uint4*)(qs + m * 272 + (64 + j0) * 2) = make_uint4(o2[0], o2[1], o2[2], o2[3]);
            }
            {
                const uint4 a = *(const uint4*)(row + 512), bq = *(const uint4*)(row + 512 + 64);
                const unsigned aw[4] = {a.x, a.y, a.z, a.w}, bw[4] = {bq.x, bq.y, bq.z, bq.w};
                const float kd = exp2f(l2g * (float)(63 - m));
                const float sc = 0.08838834764831845f;
                unsigned o1[4], o2[4];
#pragma unroll
                for (int e = 0; e < 4; ++e) {
                    const float t1a = bflo(aw[e]), t1b = bfhi(aw[e]), t2a = bflo(bw[e]), t2b = bfhi(bw[e]);
                    const float r1a = (t1a * cs_[2 * e] - t2a * sn_[2 * e]) * sc, r1b = (t1b * cs_[2 * e + 1] - t2b * sn_[2 * e + 1]) * sc;
                    const float r2a = (t1a * sn_[2 * e] + t2a * cs_[2 * e]) * sc, r2b = (t1b * sn_[2 * e + 1] + t2b * cs_[2 * e + 1]) * sc;
                    o1[e] = pk2(r1a, r1b);
                    o2[e] = pk2(r2a, r2b);
                    *(bf16_t*)(kTs + (j0 + 2 * e) * 144 + m * 2) = f2bf(r1a * kd);
                    *(bf16_t*)(kTs + (j0 + 2 * e + 1) * 144 + m * 2) = f2bf(r1b * kd);
                    *(bf16_t*)(kTs + (64 + j0 + 2 * e) * 144 + m * 2) = f2bf(r2a * kd);
                    *(bf16_t*)(kTs + (64 + j0 + 2 * e + 1) * 144 + m * 2) = f2bf(r2b * kd);
                }
                *(uint4*)(ks + m * 272 + j0 * 2) = make_uint4(o1[0], o1[1], o1[2], o1[3]);
                *(uint4*)(ks + m * 272 + (64 + j0) * 2) = make_uint4(o2[0], o2[1], o2[2], o2[3]);
            }
            {
                const uint4 a = *(const uint4*)(p.proj + (size_t)(t0 + m) * NPJ + 1024 + h * 128 + vh * 64 + j0);
                const unsigned aw[4] = {a.x, a.y, a.z, a.w};
#pragma unroll
                for (int e = 0; e < 4; ++e) {
                    *(bf16_t*)(vTs + (j0 + 2 * e) * 144 + m * 2) = (bf16_t)(aw[e] & 0xffffu);
                    *(bf16_t*)(vTs + (j0 + 2 * e + 1) * 144 + m * 2) = (bf16_t)(aw[e] >> 16);
                }
            }
        }
        __syncthreads();
        {
            bf16x8 qf[4];
#pragma unroll
            for (int s = 0; s < 4; ++s) qf[s] = ld8(qs + (16 * w + fr) * 272 + (s * 4 + fq) * 16);
#pragma unroll
            for (int j = 0; j < 4; ++j) {
                f32x4 a = (f32x4){0.f, 0.f, 0.f, 0.f};
#pragma unroll
                for (int s = 0; s < 4; ++s) a = mfma16(ld8(ks + (16 * j + fr) * 272 + (s * 4 + fq) * 16), qf[s], a);
                const int l = 16 * w + fr, mb = 16 * j + 4 * fq;
                float v[4];
#pragma unroll
                for (int r = 0; r < 4; ++r) {
                    const int dd = l - (mb + r);
                    v[r] = a[r] * exp2f(l2g * (float)(dd < 0 ? -dd : dd));
                }
                *(uint2*)(Ss + l * 144 + mb * 2) = make_uint2(pk2(v[0], v[1]), pk2(v[2], v[3]));
            }
        }
        __syncthreads();
        {
            bf16x8 sp[4];
#pragma unroll
            for (int s = 0; s < 4; ++s)
                sp[s] = mk8(make_uint2(pk2(st[2 * s][0], st[2 * s][1]), pk2(st[2 * s][2], st[2 * s][3])),
                            make_uint2(pk2(st[2 * s + 1][0], st[2 * s + 1][1]), pk2(st[2 * s + 1][2], st[2 * s + 1][3])));
            bf16x8 vf[2];
#pragma unroll
            for (int s2 = 0; s2 < 2; ++s2) vf[s2] = ld8(vTs + (16 * w + fr) * 144 + (s2 * 4 + fq) * 16);
#pragma unroll
            for (int i = 0; i < 4; ++i) {
                f32x4 a = (f32x4){0.f, 0.f, 0.f, 0.f};
                const char* qrow = qs + (16 * i + fr) * 272;
#pragma unroll
                for (int s = 0; s < 4; ++s) {
                    const uint2 lo = *(const uint2*)(qrow + (32 * s + 4 * fq) * 2), hi = *(const uint2*)(qrow + (32 * s + 16 + 4 * fq) * 2);
                    a = mfma16(sp[s], mk8(lo, hi), a);
                }
                const float qd = exp2f(l2g * (float)(16 * i + fr + 1));
                a = a * qd;
#pragma unroll
                for (int s2 = 0; s2 < 2; ++s2) a = mfma16(vf[s2], ld8(Ss + (16 * i + fr) * 144 + (s2 * 4 + fq) * 16), a);
                *(uint2*)(p.proj + (size_t)(t0 + 16 * i + fr) * NPJ + 1024 + h * 128 + vh * 64 + 16 * w + 4 * fq) =
                    make_uint2(pk2(a[0], a[1]), pk2(a[2], a[3]));
            }
#pragma unroll
            for (int i = 0; i < 8; ++i) {
                f32x4 a = st[i] * g64;
#pragma unroll
                for (int s2 = 0; s2 < 2; ++s2) a = mfma16(ld8(kTs + (16 * i + fr) * 144 + (s2 * 4 + fq) * 16), vf[s2], a);
                st[i] = a;
            }
        }
        __syncthreads();
    }
}

DEVI void mlstm_item(const Params& p, char* smem, int b, int h, int vh) {
    char* qs = smem;
    char* kTs = smem + 17408;
    char* vTs = smem + 35840;
    float* n_s = (float*)(smem + 45056);
    float* qn_s = (float*)(smem + 45568);
    float* den_s = (float*)(smem + 46592);
    const int tid = threadIdx.x, lane = tid & 63, w = tid >> 6, fr = lane & 15, fq = lane >> 4;
    f32x4 st[8];
#pragma unroll
    for (int i = 0; i < 8; ++i) st[i] = (f32x4){0.f, 0.f, 0.f, 0.f};
    float m_run = 0.f, n_reg = 0.f;
    for (int c = 0; c < 32; ++c) {
        const int t0 = b * 2048 + c * 64;
        const float iv = p.ipre[(t0 + lane) * 4 + h], fv = p.logf[(t0 + lane) * 4 + h];
        float fcum = fv;
#pragma unroll
        for (int o = 1; o < 64; o <<= 1) {
            const float tv = __shfl_up(fcum, o);
            if (lane >= o) fcum += tv;
        }
        const float a_c = __shfl(fcum, 63);
        const float logw = a_c - fcum + iv;
        const float m_in = wave_max(logw);
        const float m_new = fmaxf(a_c + m_run, m_in);
        const float decay = __expf(a_c + m_run - m_new);
        const float wgt = __expf(logw - m_new);
        const float emn = __expf(-m_new);
        m_run = m_new;
#pragma unroll
        for (int i = 0; i < 4; ++i) {
            const int u = tid + 256 * i, m = u >> 4, j0 = (u & 15) * 8;
            *(uint4*)(qs + m * 272 + j0 * 2) = *(const uint4*)(p.mq + (size_t)(t0 + m) * 512 + h * 128 + j0);
            const uint4 kk = *(const uint4*)(p.mk + (size_t)(t0 + m) * 512 + h * 128 + j0);
            const float wm = __shfl(wgt, m);
            const unsigned kw[4] = {kk.x, kk.y, kk.z, kk.w};
#pragma unroll
            for (int e = 0; e < 4; ++e) {
                *(bf16_t*)(kTs + (j0 + 2 * e) * 144 + m * 2) = f2bf(bflo(kw[e]) * wm);
                *(bf16_t*)(kTs + (j0 + 2 * e + 1) * 144 + m * 2) = f2bf(bfhi(kw[e]) * wm);
            }
        }
#pragma unroll
        for (int i = 0; i < 2; ++i) {
            const int u = tid + 256 * i, m = u >> 3, j0 = (u & 7) * 8;
            const uint4 a = *(const uint4*)(p.proj + (size_t)(t0 + m) * NPJ + 2560 + h * 128 + vh * 64 + j0);
            const unsigned aw[4] = {a.x, a.y, a.z, a.w};
#pragma unroll
            for (int e = 0; e < 4; ++e) {
                *(bf16_t*)(vTs + (j0 + 2 * e) * 144 + m * 2) = (bf16_t)(aw[e] & 0xffffu);
                *(bf16_t*)(vTs + (j0 + 2 * e + 1) * 144 + m * 2) = (bf16_t)(aw[e] >> 16);
            }
        }
        __syncthreads();
        if (tid < 128) {
            float s = 0.f;
#pragma unroll
            for (int q = 0; q < 8; ++q) {
                const uint4 a = *(const uint4*)(kTs + tid * 144 + q * 16);
                s += (bflo(a.x) + bfhi(a.x)) + (bflo(a.y) + bfhi(a.y)) + (bflo(a.z) + bfhi(a.z)) + (bflo(a.w) + bfhi(a.w));
            }
            n_reg = decay * n_reg + s;
            n_s[tid] = n_reg;
        }
        {
            bf16x8 vf[2];
#pragma unroll
            for (int s2 = 0; s2 < 2; ++s2) vf[s2] = ld8(vTs + (16 * w + fr) * 144 + (s2 * 4 + fq) * 16);
#pragma unroll
            for (int i = 0; i < 8; ++i) {
                f32x4 a = st[i] * decay;
#pragma unroll
                for (int s2 = 0; s2 < 2; ++s2) a = mfma16(ld8(kTs + (16 * i + fr) * 144 + (s2 * 4 + fq) * 16), vf[s2], a);
                st[i] = a;
            }
        }
        __syncthreads();
        {
            const int l = tid & 63, part = tid >> 6;
            float s = 0.f;
#pragma unroll
            for (int q = 0; q < 8; ++q) {
                const uint2 a = *(const uint2*)(qs + l * 272 + (part * 32 + 4 * q) * 2);
                const float* nn = n_s + part * 32 + 4 * q;
                s += bflo(a.x) * nn[0] + bfhi(a.x) * nn[1] + bflo(a.y) * nn[2] + bfhi(a.y) * nn[3];
            }
            qn_s[part * 64 + l] = s;
        }
        __syncthreads();
        if (tid < 64) den_s[tid] = fmaxf(fabsf(qn_s[tid] + qn_s[64 + tid] + qn_s[128 + tid] + qn_s[192 + tid]), emn);
        __syncthreads();
        {
            bf16x8 sp[4];
#pragma unroll
            for (int s = 0; s < 4; ++s)
                sp[s] = mk8(make_uint2(pk2(st[2 * s][0], st[2 * s][1]), pk2(st[2 * s][2], st[2 * s][3])),
                            make_uint2(pk2(st[2 * s + 1][0], st[2 * s + 1][1]), pk2(st[2 * s + 1][2], st[2 * s + 1][3])));
#pragma unroll
            for (int i = 0; i < 4; ++i) {
                f32x4 a = (f32x4){0.f, 0.f, 0.f, 0.f};
                const char* qrow = qs + (16 * i + fr) * 272;
#pragma unroll
                for (int s = 0; s < 4; ++s) {
                    const uint2 lo = *(const uint2*)(qrow + (32 * s + 4 * fq) * 2), hi = *(const uint2*)(qrow + (32 * s + 16 + 4 * fq) * 2);
                    a = mfma16(sp[s], mk8(lo, hi), a);
                }
                const float rd = 1.f / den_s[16 * i + fr];
                *(uint2*)(p.proj + (size_t)(t0 + 16 * i + fr) * NPJ + 2560 + h * 128 + vh * 64 + 16 * w + 4 * fq) =
                    make_uint2(pk2(a[0] * rd, a[1] * rd), pk2(a[2] * rd, a[3] * rd));
            }
        }
        __syncthreads();
    }
}
DEVI void st_recur(const Params& p, char* smem) {
    for (int it = blockIdx.x; it < 256; it += gridDim.x) {
        const int kind = it & 1, r = it >> 1, vh = r & 1, h = (r >> 1) & 3, b = r >> 3;
        if (kind == 0) ret_item(p, smem, b, h, vh);
        else mlstm_item(p, smem, b, h, vh);
    }
}

DEVI void st_gate(const Params& p) {
    const int lane = threadIdx.x & 63, wid = threadIdx.x >> 6;
    for (int t = blockIdx.x * 4 + wid; t < T_TOK; t += gridDim.x * 4) {
        const bf16_t* pr = p.proj + (size_t)t * NPJ;
#pragma unroll
        for (int hh = 0; hh < 8; ++hh) {
            const bool ml = hh >= 4;
            const int h = hh & 3;
            const unsigned ow = *(const unsigned*)(pr + (ml ? 2560 : 1024) + h * 128 + 2 * lane);
            const float o0 = bflo(ow), o1 = bfhi(ow);
            const float mu = wave_sum(o0 + o1) * (1.f / 128.f);
            const float d0 = o0 - mu, d1 = o1 - mu;
            const float var = wave_sum(d0 * d0 + d1 * d1) * (1.f / 128.f);
            const float rstd = rsqrtf(var + EPSN);
            const float* gn = (ml ? p.m_norm_g : p.ret_norm_g) + h * 128 + 2 * lane;
            const float n0 = d0 * rstd * gn[0], n1 = d1 * rstd * gn[1];
            const unsigned gw = *(const unsigned*)(pr + (ml ? 3072 : 1536) + h * 128 + 2 * lane);
            const float g0 = bflo(gw), g1 = bfhi(gw);
            float y0, y1;
            if (!ml) {
                y0 = g0 * sigmoidf_(g0) * n0;
                y1 = g1 * sigmoidf_(g1) * n1;
            } else {
                const unsigned cw = *(const unsigned*)(p.cbuf + (size_t)t * 512 + h * 128 + 2 * lane);
                const float* sk = p.m_skip + h * 128 + 2 * lane;
                y0 = sigmoidf_(g0) * (n0 + sk[0] * bflo(cw));
                y1 = sigmoidf_(g1) * (n1 + sk[1] * bfhi(cw));
            }
            *(unsigned*)(p.yb + (size_t)t * 1024 + hh * 128 + 2 * lane) = pk2(y0, y1);
        }
    }
}

DEVI void st_norm2(const Params& p) {
    const int lane = threadIdx.x & 63, wid = threadIdx.x >> 6;
    for (int t = blockIdx.x * 4 + wid; t < T_TOK; t += gridDim.x * 4) {
        const float4* xr = (const float4*)(p.out + (size_t)t * 1024);
        uint2* o = (uint2*)(p.x1b + (size_t)t * 1024);
        float ss = 0.f;
#pragma unroll
        for (int j = 0; j < 4; ++j) {
            const float4 v = xr[lane + 64 * j];
            ss += v.x * v.x + v.y * v.y + v.z * v.z + v.w * v.w;
            o[lane + 64 * j] = make_uint2(pk2(v.x, v.y), pk2(v.z, v.w));
        }
        ss = wave_sum(ss);
        if (lane == 0) p.rs2[t] = rsqrtf(ss * (1.f / 1024.f) + EPSN);
    }
}

DEVI void st_topk(const Params& p) {
    const int lane = threadIdx.x & 63, wid = threadIdx.x >> 6;
    const float NEG = -3.0e38f;
    for (int it = blockIdx.x * 4 + wid; it < T_TOK * 8; it += gridDim.x * 4) {
        const int t = it >> 3, h = it & 7;
        const float* sr = p.sub + (size_t)t * 2048 + h * 256;
        float sl[2] = {0.f, 0.f};
        int il[2] = {0, 0};
#pragma unroll
        for (int pp = 0; pp < 2; ++pp) {
            float v0 = sr[pp * 128 + lane], v1 = sr[pp * 128 + 64 + lane];
            for (int k = 0; k < 16; ++k) {
                const float M = wave_max(fmaxf(v0, v1));
                const unsigned long long b0 = __ballot(v0 == M), b1 = __ballot(v1 == M);
                int src, idx;
                if (b0) { src = __ffsll((long long)b0) - 1; idx = src; }
                else { src = __ffsll((long long)b1) - 1; idx = src + 64; }
                if (lane == k) { sl[pp] = M; il[pp] = idx; }
                if (lane == src) { if (b0) v0 = NEG; else v1 = NEG; }
            }
        }
        float cv[4];
        const float s1 = __shfl(sl[0], lane >> 2);
#pragma unroll
        for (int c = 0; c < 4; ++c) cv[c] = s1 + __shfl(sl[1], (lane & 3) * 4 + c);
        float best = 0.f; int eid = 0;
        for (int k = 0; k < 16; ++k) {
            const float lm = fmaxf(fmaxf(cv[0], cv[1]), fmaxf(cv[2], cv[3]));
            const float M = wave_max(lm);
            const unsigned long long bb = __ballot(lm == M);
            const int src = __ffsll((long long)bb) - 1;
            int cidx = 0;
            if (cv[3] == M) cidx = 3;
            if (cv[2] == M) cidx = 2;
            if (cv[1] == M) cidx = 1;
            if (cv[0] == M) cidx = 0;
            const int csel = __shfl(cidx, src);
            const int flat = src * 4 + csel;
            const int i1 = __shfl(il[0], flat >> 4), i2 = __shfl(il[1], flat & 15);
            if (lane == k) { best = M; eid = i1 * 128 + i2; }
            if (lane == src) {
#pragma unroll
                for (int c = 0; c < 4; ++c) if (c == csel) cv[c] = NEG;
            }
        }
        const float bmax = __shfl(best, 0);
        const float ex = lane < 16 ? __expf(best - bmax) : 0.f;
        const float sum = wave_sum(ex);
        if (lane < 16) {
            p.eidx[(size_t)t * 128 + h * 16 + lane] = eid;
            p.gate[(size_t)t * 128 + h * 16 + lane] = ex / sum;
        }
    }
}

DEVI void st_experts(const Params& p) {
    const int lane = threadIdx.x & 63, wid = threadIdx.x >> 6;
    for (int t = blockIdx.x * 4 + wid; t < T_TOK; t += gridDim.x * 4) {
        float x1v[16], xn[16], acc[16];
        const float rs = p.rs2[t];
#pragma unroll
        for (int i = 0; i < 2; ++i) {
            const float4 a = *(const float4*)(p.out + (size_t)t * 1024 + i * 512 + lane * 8), b = *(const float4*)(p.out + (size_t)t * 1024 + i * 512 + lane * 8 + 4);
            const float4 ga = *(const float4*)(p.norm2_g + i * 512 + lane * 8), gb = *(const float4*)(p.norm2_g + i * 512 + lane * 8 + 4);
            const float xs[8] = {a.x, a.y, a.z, a.w, b.x, b.y, b.z, b.w};
            const float gs[8] = {ga.x, ga.y, ga.z, ga.w, gb.x, gb.y, gb.z, gb.w};
#pragma unroll
            for (int c = 0; c < 8; ++c) { x1v[i * 8 + c] = xs[c]; xn[i * 8 + c] = xs[c] * rs * gs[c]; acc[i * 8 + c] = 0.f; }
        }
        const int e_lo = p.eidx[(size_t)t * 128 + lane], e_hi = p.eidx[(size_t)t * 128 + 64 + lane];
        const float g_lo = p.gate[(size_t)t * 128 + lane], g_hi = p.gate[(size_t)t * 128 + 64 + lane];
        for (int kb = 0; kb < 128; kb += 4) {
            int e[4]; float g[4], u[4];
            uint4 r[4][2];
#pragma unroll
            for (int q = 0; q < 4; ++q) {
                const int k = kb + q;
                e[q] = __shfl(k < 64 ? e_lo : e_hi, k & 63);
                g[q] = __shfl(k < 64 ? g_lo : g_hi, k & 63);
                const uint4* row = (const uint4*)(p.down_bf + (size_t)e[q] * 1024);
                r[q][0] = row[lane];
                r[q][1] = row[64 + lane];
            }
#pragma unroll
            for (int q = 0; q < 4; ++q) {
                float s = 0.f;
#pragma unroll
                for (int i = 0; i < 2; ++i) {
                    const unsigned wv[4] = {r[q][i].x, r[q][i].y, r[q][i].z, r[q][i].w};
#pragma unroll
                    for (int c = 0; c < 4; ++c) s += bflo(wv[c]) * xn[i * 8 + 2 * c] + bfhi(wv[c]) * xn[i * 8 + 2 * c + 1];
                }
                u[q] = wave_sum(s);
            }
#pragma unroll
            for (int q = 0; q < 4; ++q) {
                const uint4* row = (const uint4*)(p.up_bf + (size_t)e[q] * 1024);
                r[q][0] = row[lane];
                r[q][1] = row[64 + lane];
            }
#pragma unroll
            for (int q = 0; q < 4; ++q) {
                const float a = g[q] * 0.5f * u[q] * (1.f + erff(u[q] * 0.70710678118654752f));
#pragma unroll
                for (int i = 0; i < 2; ++i) {
                    const unsigned wv[4] = {r[q][i].x, r[q][i].y, r[q][i].z, r[q][i].w};
#pragma unroll
                    for (int c = 0; c < 4; ++c) { acc[i * 8 + 2 * c] += a * bflo(wv[c]); acc[i * 8 + 2 * c + 1] += a * bfhi(wv[c]); }
                }
            }
        }
        float ss = 0.f;
#pragma unroll
        for (int c = 0; c < 16; ++c) { acc[c] += x1v[c]; ss += acc[c] * acc[c]; }
        ss = wave_sum(ss);
        const float rf = rsqrtf(ss * (1.f / 1024.f) + EPSN);
#pragma unroll
        for (int i = 0; i < 2; ++i) {
            const float4 ga = *(const float4*)(p.final_g + i * 512 + lane * 8), gb = *(const float4*)(p.final_g + i * 512 + lane * 8 + 4);
            *(float4*)(p.out + (size_t)t * 1024 + i * 512 + lane * 8) =
                make_float4(acc[i * 8 + 0] * rf * ga.x, acc[i * 8 + 1] * rf * ga.y, acc[i * 8 + 2] * rf * ga.z, acc[i * 8 + 3] * rf * ga.w);
            *(float4*)(p.out + (size_t)t * 1024 + i * 512 + lane * 8 + 4) =
                make_float4(acc[i * 8 + 4] * rf * gb.x, acc[i * 8 + 5] * rf * gb.y, acc[i * 8 + 6] * rf * gb.z, acc[i * 8 + 7] * rf * gb.w);
        }
    }
}

constexpr int LDS_BYTES = 75 * 1024;
extern __shared__ __attribute__((aligned(16))) char smem_dyn[];
__global__ void __launch_bounds__(NTHR) k_prep_misc(Params p) { st_prep_misc(p); }
__global__ void __launch_bounds__(NTHR) k_prep_w(Params p) { st_prep_w(p, smem_dyn); }
__global__ void __launch_bounds__(NTHR) k_prep_wsub(Params p) { st_prep_wsub(p, smem_dyn); }
__global__ void __launch_bounds__(NTHR) k_prep_x(Params p) { st_prep_x(p, smem_dyn); }
__global__ void __launch_bounds__(NTHR) k_gemm1(Params p) { st_gemm(p.xb, p.W1t, NPJ, 1024, smem_dyn, EpiProj{p.proj, p.rs1}); }
__global__ void __launch_bounds__(NTHR) k_conv_qk(Params p) { st_conv_qk(p, smem_dyn); }
__global__ void __launch_bounds__(NTHR) k_recur(Params p) { st_recur(p, smem_dyn); }
__global__ void __launch_bounds__(NTHR) k_gate(Params p) { st_gate(p); }
__global__ void __launch_bounds__(NTHR) k_gemm2(Params p) { st_gemm(p.yb, p.W2t, 1024, 1024, smem_dyn, EpiX1{p.x, p.out}); }
__global__ void __launch_bounds__(NTHR) k_norm2(Params p) { st_norm2(p); }
__global__ void __launch_bounds__(NTHR) k_gemm3(Params p) { st_gemm(p.x1b, p.Wsubt, 2048, 1024, smem_dyn, EpiSub{p.sub, p.rs2}); }
__global__ void __launch_bounds__(NTHR) k_topk(Params p) { st_topk(p); }
__global__ void __launch_bounds__(NTHR) k_experts(Params p) { st_experts(p); }

extern "C" void kernel_launch(void* const* d_in, const int* in_sizes, int n_in, void* d_out, int out_size, void* d_ws, size_t ws_size,
                              hipStream_t stream) {
    Params p{};
    const float* const* in = (const float* const*)d_in;
    p.x = in[0]; p.norm1_g = in[1]; p.w_in = in[2]; p.ret_norm_g = in[3]; p.m_conv_w = in[4]; p.m_conv_b = in[5]; p.m_wq = in[6]; p.m_wk = in[7];
    p.m_b_i = in[8]; p.m_b_f = in[9]; p.m_norm_g = in[10]; p.m_skip = in[11]; p.w_out = in[12]; p.norm2_g = in[13]; p.peer_wq = in[14];
    p.peer_keys = in[15]; p.peer_down = in[16]; p.peer_up = in[17]; p.final_g = in[18];
    p.out = (float*)d_out;
    char* ws = (char*)d_ws;
    size_t off = 0;
    auto take = [&](size_t bytes) { char* r = ws + off; off += (bytes + 255) & ~(size_t)255; return r; };
    p.proj = (bf16_t*)take((size_t)T_TOK * NPJ * 2);
    p.xb = (bf16_t*)take((size_t)T_TOK * 1024 * 2);
    p.yb = p.xb;
    p.sub = (float*)ws;
    p.gate = (float*)(ws + (size_t)T_TOK * 2048 * 4);
    p.mq = (bf16_t*)take((size_t)T_TOK * 512 * 2);
    p.mk = (bf16_t*)take((size_t)T_TOK * 512 * 2);
    p.x1b = p.mq;
    p.cbuf = (bf16_t*)take((size_t)T_TOK * 512 * 2);
    p.eidx = (int*)p.cbuf;
    p.down_bf = (bf16_t*)take((size_t)16384 * 1024 * 2);
    p.up_bf = (bf16_t*)take((size_t)16384 * 1024 * 2);
    p.W1t = (bf16_t*)take((size_t)NPJ * 1024 * 2);
    p.W2t = (bf16_t*)take((size_t)1024 * 1024 * 2);
    p.Wsubt = (bf16_t*)take((size_t)2048 * 1024 * 2);
    p.Wqt = (bf16_t*)take(4 * 128 * 128 * 2);
    p.Wkt = (bf16_t*)take(4 * 128 * 128 * 2);
    p.rs1 = (float*)take(T_TOK * 4);
    p.rs2 = (float*)take(T_TOK * 4);
    p.ipre = (float*)take(T_TOK * 4 * 4);
    p.logf = (float*)take(T_TOK * 4 * 4);
    p.rope_cos = (float*)take(2048 * 64 * 4);
    p.rope_sin = (float*)take(2048 * 64 * 4);
    if (off > ws_size) return;

    static bool attr_done = false;
    if (!attr_done) {
        hipFuncSetAttribute((const void*)k_prep_w, hipFuncAttributeMaxDynamicSharedMemorySize, LDS_BYTES);
        hipFuncSetAttribute((const void*)k_prep_wsub, hipFuncAttributeMaxDynamicSharedMemorySize, LDS_BYTES);
        hipFuncSetAttribute((const void*)k_prep_x, hipFuncAttributeMaxDynamicSharedMemorySize, LDS_BYTES);
        hipFuncSetAttribute((const void*)k_gemm1, hipFuncAttributeMaxDynamicSharedMemorySize, LDS_BYTES);
        hipFuncSetAttribute((const void*)k_gemm2, hipFuncAttributeMaxDynamicSharedMemorySize, LDS_BYTES);
        hipFuncSetAttribute((const void*)k_gemm3, hipFuncAttributeMaxDynamicSharedMemorySize, LDS_BYTES);
        hipFuncSetAttribute((const void*)k_conv_qk, hipFuncAttributeMaxDynamicSharedMemorySize, LDS_BYTES);
        hipFuncSetAttribute((const void*)k_recur, hipFuncAttributeMaxDynamicSharedMemorySize, LDS_BYTES);
        attr_done = true;
    }
    const dim3 blk(NTHR);
    k_prep_misc<<<2048, blk, 0, stream>>>(p);
    k_prep_w<<<1024, blk, LDS_BYTES, stream>>>(p);
    k_prep_wsub<<<1024, blk, LDS_BYTES, stream>>>(p);
    k_prep_x<<<1024, blk, LDS_BYTES, stream>>>(p);
    k_gemm1<<<(T_TOK / 128) * (NPJ / 128), blk, LDS_BYTES, stream>>>(p);
    k_conv_qk<<<1024, blk, LDS_BYTES, stream>>>(p);
    k_recur<<<256, blk, LDS_BYTES, stream>>>(p);
    k_gate<<<2048, blk, 0, stream>>>(p);
    k_gemm2<<<(T_TOK / 128) * 8, blk, LDS_BYTES, stream>>>(p);
    k_norm2<<<2048, blk, 0, stream>>>(p);
    k_gemm3<<<(T_TOK / 128) * 16, blk, LDS_BYTES, stream>>>(p);
    k_topk<<<4096, blk, 0, stream>>>(p);
    k_experts<<<2048, blk, 0, stream>>>(p);
}
```

```cpp
#include <hip/hip_runtime.h>
#include <hip/hip_cooperative_groups.h>
#include <stdint.h>
#include <cstdio>
namespace cg = cooperative_groups;

typedef unsigned short bf16_t;
typedef short bf16x8 __attribute__((ext_vector_type(8)));
typedef float f32x4 __attribute__((ext_vector_type(4)));

#define DEVI __device__ __forceinline__

constexpr int T_TOK = 32768, DM = 1024, NPJ = 3584, DIN = 3592;
constexpr int NTHR = 256;
constexpr float EPSN = 1e-6f;

struct Params {
    const float *x, *norm1_g, *w_in, *ret_norm_g, *m_conv_w, *m_conv_b, *m_wq, *m_wk, *m_b_i, *m_b_f, *m_norm_g, *m_skip, *w_out,
        *norm2_g, *peer_wq, *peer_keys, *peer_down, *peer_up, *final_g;
    float* out;
    bf16_t *proj, *xb, *yb, *mq, *mk, *x1b, *cbuf, *down_bf, *up_bf, *W1t, *W2t, *Wsubt, *Wqt, *Wkt;
    float *rs1, *rs2, *ipre, *logf, *rope_cos, *rope_sin, *sub, *gate;
    int* eidx;
};

DEVI unsigned f2bf_bits(float f) { unsigned u = __float_as_uint(f); return (u + 0x7fffu + ((u >> 16) & 1u)) >> 16; }
DEVI bf16_t f2bf(float f) { return (bf16_t)f2bf_bits(f); }
DEVI unsigned pk2(float lo, float hi) { return f2bf_bits(lo) | (f2bf_bits(hi) << 16); }
DEVI float bflo(unsigned w) { return __uint_as_float(w << 16); }
DEVI float bfhi(unsigned w) { return __uint_as_float(w & 0xffff0000u); }
DEVI float bf2f(bf16_t h) { return __uint_as_float(((unsigned)h) << 16); }
DEVI float wave_sum(float v) {
#pragma unroll
    for (int o = 32; o; o >>= 1) v += __shfl_xor(v, o);
    return v;
}
DEVI float wave_max(float v) {
#pragma unroll
    for (int o = 32; o; o >>= 1) v = fmaxf(v, __shfl_xor(v, o));
    return v;
}
DEVI f32x4 mfma16(bf16x8 a, bf16x8 b, f32x4 c) { return __builtin_amdgcn_mfma_f32_16x16x32_bf16(a, b, c, 0, 0, 0); }
DEVI bf16x8 ld8(const char* p) { return *reinterpret_cast<const bf16x8*>(p); }
DEVI bf16x8 mk8(uint2 lo, uint2 hi) {
    union { uint4 u; bf16x8 v; } x;
    x.u = make_uint4(lo.x, lo.y, hi.x, hi.y);
    return x.v;
}
DEVI float sigmoidf_(float z) { return 1.f / (1.f + __expf(-z)); }

DEVI void st_prep_misc(const Params& p) {
    const int gtid = blockIdx.x * NTHR + threadIdx.x, gsz = gridDim.x * NTHR;
    for (int i = gtid; i < 2048 * 64; i += gsz) {
        const int pos = i >> 6, j = i & 63;
        const float inv = powf(10000.f, -(float)j * (1.f / 64.f));
        const float ang = (float)pos * inv;
        float s, c;
        sincosf(ang, &s, &c);
        p.rope_cos[i] = c;
        p.rope_sin[i] = s;
    }
    for (int i = gtid; i < 4 * 128 * 128; i += gsz) {
        const int h = i >> 14, e = (i >> 7) & 127, d = i & 127;
        p.Wqt[i] = f2bf(p.m_wq[h * 16384 + d * 128 + e]);
        p.Wkt[i] = f2bf(p.m_wk[h * 16384 + d * 128 + e] * 0.08838834764831845f);
    }
    const int n8 = 16384 * 1024 / 8;
    for (int i = gtid; i < 2 * n8; i += gsz) {
        const bool up = i >= n8;
        const int k = up ? i - n8 : i;
        const float4* s = (const float4*)(up ? p.peer_up : p.peer_down) + (size_t)k * 2;
        const float4 a = s[0], b = s[1];
        uint4 o = make_uint4(pk2(a.x, a.y), pk2(a.z, a.w), pk2(b.x, b.y), pk2(b.z, b.w));
        ((uint4*)(up ? p.up_bf : p.down_bf))[k] = o;
    }
}

DEVI void transpose_tile(const float* __restrict__ src, int ld, const float* __restrict__ scale, bf16_t* __restrict__ dst, int K, int k0, int n0,
                         float* tile) {
    const int tx = threadIdx.x & 31, ty = threadIdx.x >> 5;
#pragma unroll
    for (int i = 0; i < 4; ++i) {
        const int k = k0 + ty + 8 * i;
        float v = src[(size_t)k * ld + n0 + tx];
        if (scale) v *= scale[k];
        tile[(ty + 8 * i) * 33 + tx] = v;
    }
    __syncthreads();
#pragma unroll
    for (int i = 0; i < 4; ++i) {
        const int n = n0 + ty + 8 * i;
        dst[(size_t)n * K + k0 + tx] = f2bf(tile[tx * 33 + ty + 8 * i]);
    }
    __syncthreads();
}
DEVI void st_prep_w(const Params& p, char* smem) {
    float* tile = (float*)smem;
    constexpr int N1 = (NPJ / 32) * 32, N2 = 32 * 32;
    for (int it = blockIdx.x; it < N1 + N2; it += gridDim.x) {
        if (it < N1) {
            const int nt = it >> 5, kt = it & 31;
            transpose_tile(p.w_in, DIN, p.norm1_g, p.W1t, 1024, kt * 32, nt * 32, tile);
        } else {
            const int r = it - N1, nt = r >> 5, kt = r & 31;
            transpose_tile(p.w_out, 1024, nullptr, p.W2t, 1024, kt * 32, nt * 32, tile);
        }
    }
}
DEVI void st_prep_wsub(const Params& p, char* smem) {
    float* wq_s = (float*)smem;
    float* key_s = wq_s + 32 * 129 + 16;
    const int tid = threadIdx.x;
    for (int it = blockIdx.x; it < 16 * 32 * 2; it += gridDim.x) {
        const int grp = it >> 6, kt = (it >> 1) & 31, nh = it & 1, k0 = kt * 32;
#pragma unroll
        for (int i = 0; i < 16; ++i) {
            const int idx = tid + 256 * i, r = idx >> 7, d = idx & 127;
            wq_s[r * 129 + d] = p.peer_wq[(size_t)(k0 + r) * 2048 + grp * 128 + d];
        }
#pragma unroll
        for (int i = 0; i < 32; ++i) {
            const int idx = tid + 256 * i, n = idx >> 7, d = idx & 127;
            key_s[n * 128 + d] = p.peer_keys[((size_t)grp * 128 + nh * 64 + n) * 128 + d];
        }
        __syncthreads();
        const int kl = tid & 31, ng = tid >> 5;
        float acc[8];
#pragma unroll
        for (int i = 0; i < 8; ++i) acc[i] = 0.f;
        for (int d = 0; d < 128; ++d) {
            const float a = wq_s[kl * 129 + d];
#pragma unroll
            for (int i = 0; i < 8; ++i) acc[i] += a * key_s[(ng * 8 + i) * 128 + d];
        }
        const float g = p.norm2_g[k0 + kl];
#pragma unroll
        for (int i = 0; i < 8; ++i) p.Wsubt[(size_t)(grp * 128 + nh * 64 + ng * 8 + i) * 1024 + k0 + kl] = f2bf(acc[i] * g);
        __syncthreads();
    }
}

DEVI void st_prep_x(const Params& p, char* smem) {
    float* Wg_s = (float*)smem;
    for (int i = threadIdx.x; i < 8192; i += NTHR) {
        const int k = i >> 3, g = i & 7;
        Wg_s[g * 1024 + k] = p.norm1_g[k] * p.w_in[(size_t)k * DIN + NPJ + g];
    }
    __syncthreads();
    const int lane = threadIdx.x & 63, wid = threadIdx.x >> 6;
    for (int t = blockIdx.x * 4 + wid; t < T_TOK; t += gridDim.x * 4) {
        const float4* xr = (const float4*)(p.x + (size_t)t * 1024);
        float4 v[4];
        float ss = 0.f, g8[8];
#pragma unroll
        for (int g = 0; g < 8; ++g) g8[g] = 0.f;
#pragma unroll
        for (int j = 0; j < 4; ++j) {
            v[j] = xr[lane + 64 * j];
            ss += v[j].x * v[j].x + v[j].y * v[j].y + v[j].z * v[j].z + v[j].w * v[j].w;
#pragma unroll
            for (int g = 0; g < 8; ++g) {
                const float4 w = *(const float4*)(Wg_s + g * 1024 + (lane + 64 * j) * 4);
                g8[g] += v[j].x * w.x + v[j].y * w.y + v[j].z * w.z + v[j].w * w.w;
            }
        }
        ss = wave_sum(ss);
#pragma unroll
        for (int g = 0; g < 8; ++g) g8[g] = wave_sum(g8[g]);
        const float rs = rsqrtf(ss * (1.f / 1024.f) + EPSN);
        uint2* o = (uint2*)(p.xb + (size_t)t * 1024);
#pragma unroll
        for (int j = 0; j < 4; ++j) o[lane + 64 * j] = make_uint2(pk2(v[j].x, v[j].y), pk2(v[j].z, v[j].w));
        if (lane == 0) {
            p.rs1[t] = rs;
#pragma unroll
            for (int h = 0; h < 4; ++h) {
                p.ipre[t * 4 + h] = g8[h] * rs + p.m_b_i[h];
                const float z = g8[4 + h] * rs + p.m_b_f[h];
                p.logf[t * 4 + h] = fminf(z, 0.f) - log1pf(__expf(-fabsf(z)));
            }
        }
    }
}

constexpr int G_LDS_ROW = 144;
constexpr int G_LDS_MAT = 128 * G_LDS_ROW;
constexpr int G_LDS_BYTES = 4 * G_LDS_MAT;

template <class Epi>
DEVI void gemm_tile(const bf16_t* __restrict__ A, const bf16_t* __restrict__ Bt, int K, int m0, int n0, char* smem, const Epi& epi) {
    const int tid = threadIdx.x, lane = tid & 63, wid = tid >> 6, wr = wid >> 1, wc = wid & 1, fr = lane & 15, fq = lane >> 4;
    f32x4 acc[4][4];
#pragma unroll
    for (int i = 0; i < 4; ++i)
#pragma unroll
        for (int j = 0; j < 4; ++j) acc[i][j] = (f32x4){0.f, 0.f, 0.f, 0.f};
    uint4 ra[4], rb[4];
    const int nt = K / 64;
    auto gload = [&](int kt) {
#pragma unroll
        for (int i = 0; i < 4; ++i) {
            const int id = tid + 256 * i, r = id >> 3, c = id & 7;
            ra[i] = *(const uint4*)(A + (size_t)(m0 + r) * K + kt * 64 + c * 8);
            rb[i] = *(const uint4*)(Bt + (size_t)(n0 + r) * K + kt * 64 + c * 8);
        }
    };
    auto swrite = [&](int buf) {
        char* As = smem + buf * 2 * G_LDS_MAT;
        char* Bs = As + G_LDS_MAT;
#pragma unroll
        for (int i = 0; i < 4; ++i) {
            const int id = tid + 256 * i, r = id >> 3, c = id & 7;
            *(uint4*)(As + r * G_LDS_ROW + c * 16) = ra[i];
            *(uint4*)(Bs + r * G_LDS_ROW + c * 16) = rb[i];
        }
    };
    gload(0);
    swrite(0);
    __syncthreads();
    for (int kt = 0; kt < nt; ++kt) {
        if (kt + 1 < nt) gload(kt + 1);
        const char* As = smem + (kt & 1) * 2 * G_LDS_MAT;
        const char* Bs = As + G_LDS_MAT;
#pragma unroll
        for (int kk = 0; kk < 2; ++kk) {
            bf16x8 a[4], b[4];
#pragma unroll
            for (int i = 0; i < 4; ++i) a[i] = ld8(As + (wr * 64 + i * 16 + fr) * G_LDS_ROW + (kk * 4 + fq) * 16);
#pragma unroll
            for (int j = 0; j < 4; ++j) b[j] = ld8(Bs + (wc * 64 + j * 16 + fr) * G_LDS_ROW + (kk * 4 + fq) * 16);
#pragma unroll
            for (int i = 0; i < 4; ++i)
#pragma unroll
                for (int j = 0; j < 4; ++j) acc[i][j] = mfma16(b[j], a[i], acc[i][j]);
        }
        if (kt + 1 < nt) swrite((kt + 1) & 1);
        __syncthreads();
    }
#pragma unroll
    for (int i = 0; i < 4; ++i)
#pragma unroll
        for (int j = 0; j < 4; ++j) epi(acc[i][j], m0 + wr * 64 + i * 16 + fr, n0 + wc * 64 + j * 16 + 4 * fq);
}
struct EpiProj {
    bf16_t* proj; const float* rs1;
    DEVI void operator()(const f32x4& v, int m, int n) const {
        const float s = rs1[m];
        *(uint2*)(proj + (size_t)m * NPJ + n) = make_uint2(pk2(v[0] * s, v[1] * s), pk2(v[2] * s, v[3] * s));
    }
};
struct EpiX1 {
    const float* x; float* out;
    DEVI void operator()(const f32x4& v, int m, int n) const {
        const float4 xv = *(const float4*)(x + (size_t)m * 1024 + n);
        *(float4*)(out + (size_t)m * 1024 + n) = make_float4(xv.x + v[0], xv.y + v[1], xv.z + v[2], xv.w + v[3]);
    }
};
struct EpiSub {
    float* sub; const float* rs2;
    DEVI void operator()(const f32x4& v, int m, int n) const {
        const float s = rs2[m];
        *(float4*)(sub + (size_t)m * 2048 + n) = make_float4(v[0] * s, v[1] * s, v[2] * s, v[3] * s);
    }
};
template <class Epi>
DEVI void st_gemm(const bf16_t* A, const bf16_t* Bt, int N, int K, char* smem, const Epi& epi) {
    const int nN = N / 128, ntile = (T_TOK / 128) * nN;
    for (int it = blockIdx.x; it < ntile; it += gridDim.x) {
        const int pm = it / nN, pn = it - pm * nN;
        gemm_tile(A, Bt, K, pm * 128, pn * 128, smem, epi);
    }
}

DEVI void st_conv_qk(const Params& p, char* smem) {
    char* cs = smem;
    char* ws = smem + 128 * 272;
    const int tid = threadIdx.x, lane = tid & 63, wid = tid >> 6, wr = wid >> 1, wc = wid & 1, fr = lane & 15, fq = lane >> 4;
    for (int it = blockIdx.x; it < 256 * 4; it += gridDim.x) {
        const int h = it & 3, t0 = (it >> 2) * 128, s0 = t0 & 2047;
        {
            const int ch = tid & 127, r0 = (tid >> 7) * 64;
            const int col = 2048 + h * 128 + ch;
            const float w0 = p.m_conv_w[0 * 512 + h * 128 + ch], w1 = p.m_conv_w[1 * 512 + h * 128 + ch], w2 = p.m_conv_w[2 * 512 + h * 128 + ch],
                        w3 = p.m_conv_w[3 * 512 + h * 128 + ch], bb = p.m_conv_b[h * 128 + ch];
            float xm3 = 0.f, xm2 = 0.f, xm1 = 0.f;
            if (s0 + r0 > 0) {
                xm3 = bf2f(p.proj[(size_t)(t0 + r0 - 3) * NPJ + col]);
                xm2 = bf2f(p.proj[(size_t)(t0 + r0 - 2) * NPJ + col]);
                xm1 = bf2f(p.proj[(size_t)(t0 + r0 - 1) * NPJ + col]);
            }
            for (int r = r0; r < r0 + 64; ++r) {
                const float xc = bf2f(p.proj[(size_t)(t0 + r) * NPJ + col]);
                const float y = bb + w0 * xm3 + w1 * xm2 + w2 * xm1 + w3 * xc;
                const float c = y * sigmoidf_(y);
                const bf16_t cb = f2bf(c);
                *(bf16_t*)(cs + r * 272 + ch * 2) = cb;
                p.cbuf[(size_t)(t0 + r) * 512 + h * 128 + ch] = cb;
                xm3 = xm2; xm2 = xm1; xm1 = xc;
            }
        }
#pragma unroll
        for (int which = 0; which < 2; ++which) {
            const bf16_t* W = (which ? p.Wkt : p.Wqt) + h * 16384;
            bf16_t* O = which ? p.mk : p.mq;
#pragma unroll
            for (int i = 0; i < 8; ++i) {
                const int id = tid + 256 * i, r = id >> 4, c = id & 15;
                *(uint4*)(ws + r * 272 + c * 16) = *(const uint4*)(W + r * 128 + c * 8);
            }
            __syncthreads();
            f32x4 acc[4][4];
#pragma unroll
            for (int i = 0; i < 4; ++i)
#pragma unroll
                for (int j = 0; j < 4; ++j) acc[i][j] = (f32x4){0.f, 0.f, 0.f, 0.f};
#pragma unroll
            for (int ks = 0; ks < 4; ++ks) {
                bf16x8 a[4], b[4];
#pragma unroll
                for (int i = 0; i < 4; ++i) a[i] = ld8(cs + (wr * 64 + i * 16 + fr) * 272 + (ks * 4 + fq) * 16);
#pragma unroll
                for (int j = 0; j < 4; ++j) b[j] = ld8(ws + (wc * 64 + j * 16 + fr) * 272 + (ks * 4 + fq) * 16);
#pragma unroll
                for (int i = 0; i < 4; ++i)
#pragma unroll
                    for (int j = 0; j < 4; ++j) acc[i][j] = mfma16(b[j], a[i], acc[i][j]);
            }
#pragma unroll
            for (int i = 0; i < 4; ++i)
#pragma unroll
                for (int j = 0; j < 4; ++j) {
                    const int m = t0 + wr * 64 + i * 16 + fr, n = h * 128 + wc * 64 + j * 16 + 4 * fq;
                    const f32x4 v = acc[i][j];
                    *(uint2*)(O + (size_t)m * 512 + n) = make_uint2(pk2(v[0], v[1]), pk2(v[2], v[3]));
                }
            __syncthreads();
        }
    }
}

DEVI void ret_item(const Params& p, char* smem, int b, int h, int vh) {
    char* qs = smem;
    char* ks = smem + 17408;
    char* kTs = smem + 34816;
    char* vTs = smem + 53248;
    char* Ss = smem + 62464;
    const int tid = threadIdx.x, lane = tid & 63, w = tid >> 6, fr = lane & 15, fq = lane >> 4;
    const float gamma = 1.f - exp2f(-5.f - (float)h);
    const float l2g = log2f(gamma);
    const float g64 = exp2f(l2g * 64.f);
    f32x4 st[8];
#pragma unroll
    for (int i = 0; i < 8; ++i) st[i] = (f32x4){0.f, 0.f, 0.f, 0.f};
    for (int c = 0; c < 32; ++c) {
        const int t0 = b * 2048 + c * 64;
#pragma unroll
        for (int i = 0; i < 2; ++i) {
            const int u = tid + 256 * i, m = u >> 3, j0 = (u & 7) * 8;
            const int pos = c * 64 + m;
            const float4 c0 = *(const float4*)(p.rope_cos + pos * 64 + j0), c1 = *(const float4*)(p.rope_cos + pos * 64 + j0 + 4);
            const float4 s0 = *(const float4*)(p.rope_sin + pos * 64 + j0), s1 = *(const float4*)(p.rope_sin + pos * 64 + j0 + 4);
            const float cs_[8] = {c0.x, c0.y, c0.z, c0.w, c1.x, c1.y, c1.z, c1.w};
            const float sn_[8] = {s0.x, s0.y, s0.z, s0.w, s1.x, s1.y, s1.z, s1.w};
            const bf16_t* row = p.proj + (size_t)(t0 + m) * NPJ + h * 128 + j0;
            {
                const uint4 a = *(const uint4*)(row), bq = *(const uint4*)(row + 64);
                const unsigned aw[4] = {a.x, a.y, a.z, a.w}, bw[4] = {bq.x, bq.y, bq.z, bq.w};
                unsigned o1[4], o2[4];
#pragma unroll
                for (int e = 0; e < 4; ++e) {
                    const float t1a = bflo(aw[e]), t1b = bfhi(aw[e]), t2a = bflo(bw[e]), t2b = bfhi(bw[e]);
                    o1[e] = pk2(t1a * cs_[2 * e] - t2a * sn_[2 * e], t1b * cs_[2 * e + 1] - t2b * sn_[2 * e + 1]);
                    o2[e] = pk2(t1a * sn_[2 * e] + t2a * cs_[2 * e], t1b * sn_[2 * e + 1] + t2b * cs_[2 * e + 1]);
                }
                *(uint4*)(qs + m * 272 + j0 * 2) = make_uint4(o1[0], o1[1], o1[2], o1[3]);
                *(uint4*)(qs + m * 272 + (64 + j0) * 2) = make_uint4(o2[0], o2[1], o2[2], o2[3]);
            }
            {
                const uint4 a = *(const uint4*)(row + 512), bq = *(const uint4*)(row + 512 + 64);
                const unsigned aw[4] = {a.x, a.y, a.z, a.w}, bw[4] = {bq.x, bq.y, bq.z, bq.w};
                const float kd = exp2f(l2g * (float)(63 - m));
                const float sc = 0.08838834764831845f;
                unsigned o1[4], o2[4];
#pragma unroll
                for (int e = 0; e < 4; ++e) {
                    const float t1a = bflo(aw[e]), t1b = bfhi(aw[e]), t2a = bflo(bw[e]), t2b = bfhi(bw[e]);
                    const float r1a = (t1a * cs_[2 * e] - t2a * sn_[2 * e]) * sc, r1b = (t1b * cs_[2 * e + 1] - t2b * sn_[2 * e + 1]) * sc;
                    const float r2a = (t1a * sn_[2 * e] + t2a * cs_[2 * e]) * sc, r2b = (t1b * sn_[2 * e + 1] + t2b * cs_[2 * e + 1]) * sc;
                    o1[e] = pk2(r1a, r1b);
                    o2[e] = pk2(r2a, r2b);
                    *(bf16_t*)(kTs + (j0 + 2 * e) * 144 + m * 2) = f2bf(r1a * kd);
                    *(bf16_t*)(kTs + (j0 + 2 * e + 1) * 144 + m * 2) = f2bf(r1b * kd);
                    *(bf16_t*)(kTs + (64 + j0 + 2 * e) * 144 + m * 2) = f2bf(r2a * kd);
                    *(bf16_t*)(kTs + (64 + j0 + 2 * e + 1) * 144 + m * 2) = f2bf(r2b * kd);
                }
                *(uint4*)(ks + m * 272 + j0 * 2) = make_uint4(o1[0], o1[1], o1[2], o1[3]);
                *(uint4*)(ks + m * 272 + (64 + j0) * 2) = make_uint4(o2[0], o2[1], o2[2], o2[3]);
            }
            {
                const uint4 a = *(const uint4*)(p.proj + (size_t)(t0 + m) * NPJ + 1024 + h * 128 + vh * 64 + j0);
                const unsigned aw[4] = {a.x, a.y, a.z, a.w};
#pragma unroll
                for (int e = 0; e < 4; ++e) {
                    *(bf16_t*)(vTs + (j0 + 2 * e) * 144 + m * 2) = (bf16_t)(aw[e] & 0xffffu);
                    *(bf16_t*)(vTs + (j0 + 2 * e + 1) * 144 + m * 2) = (bf16_t)(aw[e] >> 16);
                }
            }
        }
        __syncthreads();
        {
            bf16x8 qf[4];
#pragma unroll
            for (int s = 0; s < 4; ++s) qf[s] = ld8(qs + (16 * w + fr) * 272 + (s * 4 + fq) * 16);
#pragma unroll
            for (int j = 0; j < 4; ++j) {
                f32x4 a = (f32x4){0.f, 0.f, 0.f, 0.f};
#pragma unroll
                for (int s = 0; s < 4; ++s) a = mfma16(ld8(ks + (16 * j + fr) * 272 + (s * 4 + fq) * 16), qf[s], a);
                const int l = 16 * w + fr, mb = 16 * j + 4 * fq;
                float v[4];
#pragma unroll
                for (int r = 0; r < 4; ++r) {
                    const int dd = l - (mb + r);
                    v[r] = a[r] * exp2f(l2g * (float)(dd < 0 ? -dd : dd));
                }
                *(uint2*)(Ss + l * 144 + mb * 2) = make_uint2(pk2(v[0], v[1]), pk2(v[2], v[3]));
            }
        }
        __syncthreads();
        {
            bf16x8 sp[4];
#pragma unroll
            for (int s = 0; s < 4; ++s)
                sp[s] = mk8(make_uint2(pk2(st[2 * s][0], st[2 * s][1]), pk2(st[2 * s][2], st[2 * s][3])),
                            make_uint2(pk2(st[2 * s + 1][0], st[2 * s + 1][1]), pk2(st[2 * s + 1][2], st[2 * s + 1][3])));
            bf16x8 vf[2];
#pragma unroll
            for (int s2 = 0; s2 < 2; ++s2) vf[s2] = ld8(vTs + (16 * w + fr) * 144 + (s2 * 4 + fq) * 16);
#pragma unroll
            for (int i = 0; i < 4; ++i) {
                f32x4 a = (f32x4){0.f, 0.f, 0.f, 0.f};
                const char* qrow = qs + (16 * i + fr) * 272;
#pragma unroll
                for (int s = 0; s < 4; ++s) {
                    const uint2 lo = *(const uint2*)(qrow + (32 * s + 4 * fq) * 2), hi = *(const uint2*)(qrow + (32 * s + 16 + 4 * fq) * 2);
                    a = mfma16(sp[s], mk8(lo, hi), a);
                }
                const float qd = exp2f(l2g * (float)(16 * i + fr + 1));
                a = a * qd;
#pragma unroll
                for (int s2 = 0; s2 < 2; ++s2) a = mfma16(vf[s2], ld8(Ss + (16 * i + fr) * 144 + (s2 * 4 + fq) * 16), a);
                *(uint2*)(p.proj + (size_t)(t0 + 16 * i + fr) * NPJ + 1024 + h * 128 + vh * 64 + 16 * w + 4 * fq) =
                    make_uint2(pk2(a[0], a[1]), pk2(a[2], a[3]));
            }
#pragma unroll
            for (int i = 0; i < 8; ++i) {
                f32x4 a = st[i] * g64;
#pragma unroll
                for (int s2 = 0; s2 < 2; ++s2) a = mfma16(ld8(kTs + (16 * i + fr) * 144 + (s2 * 4 + fq) * 16), vf[s2], a);
                st[i] = a;
            }
        }
        __syncthreads();
    }
}

DEVI void mlstm_item(const Params& p, char* smem, int b, int h, int vh) {
    char* qs = smem;
    char* kTs = smem + 17408;
    char* vTs = smem + 35840;
    float* n_s = (float*)(smem + 45056);
    float* qn_s = (float*)(smem + 45568);
    float* den_s = (float*)(smem + 46592);
    const int tid = threadIdx.x, lane = tid & 63, w = tid >> 6, fr = lane & 15, fq = lane >> 4;
    f32x4 st[8];
#pragma unroll
    for (int i = 0; i < 8; ++i) st[i] = (f32x4){0.f, 0.f, 0.f, 0.f};
    float m_run = 0.f, n_reg = 0.f;
    for (int c = 0; c < 32; ++c) {
        const int t0 = b * 2048 + c * 64;
        const float iv = p.ipre[(t0 + lane) * 4 + h], fv = p.logf[(t0 + lane) * 4 + h];
        float fcum = fv;
#pragma unroll
        for (int o = 1; o < 64; o <<= 1) {
            const float tv = __shfl_up(fcum, o);
            if (lane >= o) fcum += tv;
        }
        const float a_c = __shfl(fcum, 63);
        const float logw = a_c - fcum + iv;
        const float m_in = wave_max(logw);
        const float m_new = fmaxf(a_c + m_run, m_in);
        const float decay = __expf(a_c + m_run - m_new);
        const float wgt = __expf(logw - m_new);
        const float emn = __expf(-m_new);
        m_run = m_new;
#pragma unroll
        for (int i = 0; i < 4; ++i) {
            const int u = tid + 256 * i, m = u >> 4, j0 = (u & 15) * 8;
            *(uint4*)(qs + m * 272 + j0 * 2) = *(const uint4*)(p.mq + (size_t)(t0 + m) * 512 + h * 128 + j0);
            const uint4 kk = *(const uint4*)(p.mk + (size_t)(t0 + m) * 512 + h * 128 + j0);
            const float wm = __shfl(wgt, m);
            const unsigned kw[4] = {kk.x, kk.y, kk.z, kk.w};
#pragma unroll
            for (int e = 0; e < 4; ++e) {
                *(bf16_t*)(kTs + (j0 + 2 * e) * 144 + m * 2) = f2bf(bflo(kw[e]) * wm);
                *(bf16_t*)(kTs + (j0 + 2 * e + 1) * 144 + m * 2) = f2bf(bfhi(kw[e]) * wm);
            }
        }
#pragma unroll
        for (int i = 0; i < 2; ++i) {
            const int u = tid + 256 * i, m = u >> 3, j0 = (u & 7) * 8;
            const uint4 a = *(const uint4*)(p.proj + (size_t)(t0 + m) * NPJ + 2560 + h * 128 + vh * 64 + j0);
            const unsigned aw[4] = {a.x, a.y, a.z, a.w};
#pragma unroll
            for (int e = 0; e < 4; ++e) {
                *(bf16_t*)(vTs + (j0 + 2 * e) * 144 + m * 2) = (bf16_t)(aw[e] & 0xffffu);
                *(bf16_t*)(vTs + (j0 + 2 * e + 1) * 144 + m * 2) = (bf16_t)(aw[e] >> 16);
            }
        }
        __syncthreads();
        if (tid < 128) {
            float s = 0.f;
#pragma unroll
            for (int q = 0; q < 8; ++q) {
                const uint4 a = *(const uint4*)(kTs + tid * 144 + q * 16);
                s += (bflo(a.x) + bfhi(a.x)) + (bflo(a.y) + bfhi(a.y)) + (bflo(a.z) + bfhi(a.z)) + (bflo(a.w) + bfhi(a.w));
            }
            n_reg = decay * n_reg + s;
            n_s[tid] = n_reg;
        }
        {
            bf16x8 vf[2];
#pragma unroll
            for (int s2 = 0; s2 < 2; ++s2) vf[s2] = ld8(vTs + (16 * w + fr) * 144 + (s2 * 4 + fq) * 16);
#pragma unroll
            for (int i = 0; i < 8; ++i) {
                f32x4 a = st[i] * decay;
#pragma unroll
                for (int s2 = 0; s2 < 2; ++s2) a = mfma16(ld8(kTs + (16 * i + fr) * 144 + (s2 * 4 + fq) * 16), vf[s2], a);
                st[i] = a;
            }
        }
        __syncthreads();
        {
            const int l = tid & 63, part = tid >> 6;
            float s = 0.f;
#pragma unroll
            for (int q = 0; q < 8; ++q) {
                const uint2 a = *(const uint2*)(qs + l * 272 + (part * 32 + 4 * q) * 2);
                const float* nn = n_s + part * 32 + 4 * q;
                s += bflo(a.x) * nn[0] + bfhi(a.x) * nn[1] + bflo(a.y) * nn[2] + bfhi(a.y) * nn[3];
            }
            qn_s[part * 64 + l] = s;
        }
        __syncthreads();
        if (tid < 64) den_s[tid] = fmaxf(fabsf(qn_s[tid] + qn_s[64 + tid] + qn_s[128 + tid] + qn_s[192 + tid]), emn);
        __syncthreads();
        {
            bf16x8 sp[4];
#pragma unroll
            for (int s = 0; s < 4; ++s)
                sp[s] = mk8(make_uint2(pk2(st[2 * s][0], st[2 * s][1]), pk2(st[2 * s][2], st[2 * s][3])),
                            make_uint2(pk2(st[2 * s + 1][0], st[2 * s + 1][1]), pk2(st[2 * s + 1][2], st[2 * s + 1][3])));
#pragma unroll
            for (int i = 0; i < 4; ++i) {
                f32x4 a = (f32x4){0.f, 0.f, 0.f, 0.f};
                const char* qrow = qs + (16 * i + fr) * 272;
#pragma unroll
                for (int s = 0; s < 4; ++s) {
                    const uint2 lo = *(const uint2*)(qrow + (32 * s + 4 * fq) * 2), hi = *(const uint2*)(qrow + (32 * s + 16 + 4 * fq) * 2);
                    a = mfma16(sp[s], mk8(lo, hi), a);
                }
                const float rd = 1.f / den_s[16 * i + fr];
                *(uint2*)(p.proj + (size_t)(t0 + 16 * i + fr) * NPJ + 2560 + h * 128 + vh * 64 + 16 * w + 4 * fq) =
                    make_uint2(pk2(a[0] * rd, a[1] * rd), pk2(a[2] * rd, a[3] * rd));
            }
        }
        __syncthreads();
    }
}
DEVI void st_recur(const Params& p, char* smem) {
    for (int it = blockIdx.x; it < 256; it += gridDim.x) {
        const int kind = it & 1, r = it >> 1, vh = r & 1, h = (r >> 1) & 3, b = r >> 3;
        if (kind == 0) ret_item(p, smem, b, h, vh);
        else mlstm_item(p, smem, b, h, vh);
    }
}

DEVI void st_gate(const Params& p) {
    const int lane = threadIdx.x & 63, wid = threadIdx.x >> 6;
    for (int t = blockIdx.x * 4 + wid; t < T_TOK; t += gridDim.x * 4) {
        const bf16_t* pr = p.proj + (size_t)t * NPJ;
#pragma unroll
        for (int hh = 0; hh < 8; ++hh) {
            const bool ml = hh >= 4;
            const int h = hh & 3;
            const unsigned ow = *(const unsigned*)(pr + (ml ? 2560 : 1024) + h * 128 + 2 * lane);
            const float o0 = bflo(ow), o1 = bfhi(ow);
            const float mu = wave_sum(o0 + o1) * (1.f / 128.f);
            const float d0 = o0 - mu, d1 = o1 - mu;
            const float var = wave_sum(d0 * d0 + d1 * d1) * (1.f / 128.f);
            const float rstd = rsqrtf(var + EPSN);
            const float* gn = (ml ? p.m_norm_g : p.ret_norm_g) + h * 128 + 2 * lane;
            const float n0 = d0 * rstd * gn[0], n1 = d1 * rstd * gn[1];
            const unsigned gw = *(const unsigned*)(pr + (ml ? 3072 : 1536) + h * 128 + 2 * lane);
            const float g0 = bflo(gw), g1 = bfhi(gw);
            float y0, y1;
            if (!ml) {
                y0 = g0 * sigmoidf_(g0) * n0;
                y1 = g1 * sigmoidf_(g1) * n1;
            } else {
                const unsigned cw = *(const unsigned*)(p.cbuf + (size_t)t * 512 + h * 128 + 2 * lane);
                const float* sk = p.m_skip + h * 128 + 2 * lane;
                y0 = sigmoidf_(g0) * (n0 + sk[0] * bflo(cw));
                y1 = sigmoidf_(g1) * (n1 + sk[1] * bfhi(cw));
            }
            *(unsigned*)(p.yb + (size_t)t * 1024 + hh * 128 + 2 * lane) = pk2(y0, y1);
        }
    }
}

DEVI void st_norm2(const Params& p) {
    const int lane = threadIdx.x & 63, wid = threadIdx.x >> 6;
    for (int t = blockIdx.x * 4 + wid; t < T_TOK; t += gridDim.x * 4) {
        const float4* xr = (const float4*)(p.out + (size_t)t * 1024);
        uint2* o = (uint2*)(p.x1b + (size_t)t * 1024);
        float ss = 0.f;
#pragma unroll
        for (int j = 0; j < 4; ++j) {
            const float4 v = xr[lane + 64 * j];
            ss += v.x * v.x + v.y * v.y + v.z * v.z + v.w * v.w;
            o[lane + 64 * j] = make_uint2(pk2(v.x, v.y), pk2(v.z, v.w));
        }
        ss = wave_sum(ss);
        if (lane == 0) p.rs2[t] = rsqrtf(ss * (1.f / 1024.f) + EPSN);
    }
}

DEVI void st_topk(const Params& p) {
    const int lane = threadIdx.x & 63, wid = threadIdx.x >> 6;
    const float NEG = -3.0e38f;
    for (int it = blockIdx.x * 4 + wid; it < T_TOK * 8; it += gridDim.x * 4) {
        const int t = it >> 3, h = it & 7;
        const float* sr = p.sub + (size_t)t * 2048 + h * 256;
        float sl[2] = {0.f, 0.f};
        int il[2] = {0, 0};
#pragma unroll
        for (int pp = 0; pp < 2; ++pp) {
            float v0 = sr[pp * 128 + lane], v1 = sr[pp * 128 + 64 + lane];
            for (int k = 0; k < 16; ++k) {
                const float M = wave_max(fmaxf(v0, v1));
                const unsigned long long b0 = __ballot(v0 == M), b1 = __ballot(v1 == M);
                int src, idx;
                if (b0) { src = __ffsll((long long)b0) - 1; idx = src; }
                else { src = __ffsll((long long)b1) - 1; idx = src + 64; }
                if (lane == k) { sl[pp] = M; il[pp] = idx; }
                if (lane == src) { if (b0) v0 = NEG; else v1 = NEG; }
            }
        }
        float cv[4];
        const float s1 = __shfl(sl[0], lane >> 2);
#pragma unroll
        for (int c = 0; c < 4; ++c) cv[c] = s1 + __shfl(sl[1], (lane & 3) * 4 + c);
        float best = 0.f; int eid = 0;
        for (int k = 0; k < 16; ++k) {
            const float lm = fmaxf(fmaxf(cv[0], cv[1]), fmaxf(cv[2], cv[3]));
            const float M = wave_max(lm);
            const unsigned long long bb = __ballot(lm == M);
            const int src = __ffsll((long long)bb) - 1;
            int cidx = 0;
            if (cv[3] == M) cidx = 3;
            if (cv[2] == M) cidx = 2;
            if (cv[1] == M) cidx = 1;
            if (cv[0] == M) cidx = 0;
            const int csel = __shfl(cidx, src);
            const int flat = src * 4 + csel;
            const int i1 = __shfl(il[0], flat >> 4), i2 = __shfl(il[1], flat & 15);
            if (lane == k) { best = M; eid = i1 * 128 + i2; }
            if (lane == src) {
#pragma unroll
                for (int c = 0; c < 4; ++c) if (c == csel) cv[c] = NEG;
            }
        }
        const float bmax = __shfl(best, 0);
        const float ex = lane < 16 ? __expf(best - bmax) : 0.f;
        const float sum = wave_sum(ex);
        if (lane < 16) {
            p.eidx[(size_t)t * 128 + h * 16 + lane] = eid;
            p.gate[(size_t)t * 128 + h * 16 + lane] = ex / sum;
        }
    }
}

DEVI void st_experts(const Params& p) {
    const int lane = threadIdx.x & 63, wid = threadIdx.x >> 6;
    for (int t = blockIdx.x * 4 + wid; t < T_TOK; t += gridDim.x * 4) {
        float x1v[16], xn[16], acc[16];
        const float rs = p.rs2[t];
#pragma unroll
        for (int i = 0; i < 2; ++i) {
            const float4 a = *(const float4*)(p.out + (size_t)t * 1024 + i * 512 + lane * 8), b = *(const float4*)(p.out + (size_t)t * 1024 + i * 512 + lane * 8 + 4);
            const float4 ga = *(const float4*)(p.norm2_g + i * 512 + lane * 8), gb = *(const float4*)(p.norm2_g + i * 512 + lane * 8 + 4);
            const float xs[8] = {a.x, a.y, a.z, a.w, b.x, b.y, b.z, b.w};
            const float gs[8] = {ga.x, ga.y, ga.z, ga.w, gb.x, gb.y, gb.z, gb.w};
#pragma unroll
            for (int c = 0; c < 8; ++c) { x1v[i * 8 + c] = xs[c]; xn[i * 8 + c] = xs[c] * rs * gs[c]; acc[i * 8 + c] = 0.f; }
        }
        const int e_lo = p.eidx[(size_t)t * 128 + lane], e_hi = p.eidx[(size_t)t * 128 + 64 + lane];
        const float g_lo = p.gate[(size_t)t * 128 + lane], g_hi = p.gate[(size_t)t * 128 + 64 + lane];
        for (int kb = 0; kb < 128; kb += 4) {
            int e[4]; float g[4], u[4];
            uint4 r[4][2];
#pragma unroll
            for (int q = 0; q < 4; ++q) {
                const int k = kb + q;
                e[q] = __shfl(k < 64 ? e_lo : e_hi, k & 63);
                g[q] = __shfl(k < 64 ? g_lo : g_hi, k & 63);
                const uint4* row = (const uint4*)(p.down_bf + (size_t)e[q] * 1024);
                r[q][0] = row[lane];
                r[q][1] = row[64 + lane];
            }
#pragma unroll
            for (int q = 0; q < 4; ++q) {
                float s = 0.f;
#pragma unroll
                for (int i = 0; i < 2; ++i) {
                    const unsigned wv[4] = {r[q][i].x, r[q][i].y, r[q][i].z, r[q][i].w};
#pragma unroll
                    for (int c = 0; c < 4; ++c) s += bflo(wv[c]) * xn[i * 8 + 2 * c] + bfhi(wv[c]) * xn[i * 8 + 2 * c + 1];
                }
                u[q] = wave_sum(s);
            }
#pragma unroll
            for (int q = 0; q < 4; ++q) {
                const uint4* row = (const uint4*)(p.up_bf + (size_t)e[q] * 1024);
                r[q][0] = row[lane];
                r[q][1] = row[64 + lane];
            }
#pragma unroll
            for (int q = 0; q < 4; ++q) {
                const float a = g[q] * 0.5f * u[q] * (1.f + erff(u[q] * 0.70710678118654752f));
#pragma unroll
                for (int i = 0; i < 2; ++i) {
                    const unsigned wv[4] = {r[q][i].x, r[q][i].y, r[q][i].z, r[q][i].w};
#pragma unroll
                    for (int c = 0; c < 4; ++c) { acc[i * 8 + 2 * c] += a * bflo(wv[c]); acc[i * 8 + 2 * c + 1] += a * bfhi(wv[c]); }
                }
            }
        }
        float ss = 0.f;
#pragma unroll
        for (int c = 0; c < 16; ++c) { acc[c] += x1v[c]; ss += acc[c] * acc[c]; }
        ss = wave_sum(ss);
        const float rf = rsqrtf(ss * (1.f / 1024.f) + EPSN);
#pragma unroll
        for (int i = 0; i < 2; ++i) {
            const float4 ga = *(const float4*)(p.final_g + i * 512 + lane * 8), gb = *(const float4*)(p.final_g + i * 512 + lane * 8 + 4);
            *(float4*)(p.out + (size_t)t * 1024 + i * 512 + lane * 8) =
                make_float4(acc[i * 8 + 0] * rf * ga.x, acc[i * 8 + 1] * rf * ga.y, acc[i * 8 + 2] * rf * ga.z, acc[i * 8 + 3] * rf * ga.w);
            *(float4*)(p.out + (size_t)t * 1024 + i * 512 + lane * 8 + 4) =
                make_float4(acc[i * 8 + 4] * rf * gb.x, acc[i * 8 + 5] * rf * gb.y, acc[i * 8 + 6] * rf * gb.z, acc[i * 8 + 7] * rf * gb.w);
        }
    }
}

constexpr int LDS_BYTES = 75 * 1024;
extern __shared__ __attribute__((aligned(16))) char smem_dyn[];
__global__ void __launch_bounds__(NTHR, 2) mega_fwd(Params p) {
    cg::grid_group grid = cg::this_grid();
    st_prep_misc(p);
    st_prep_w(p, smem_dyn);
    st_prep_wsub(p, smem_dyn);
    st_prep_x(p, smem_dyn);
    grid.sync();
    st_gemm(p.xb, p.W1t, NPJ, 1024, smem_dyn, EpiProj{p.proj, p.rs1});
    grid.sync();
    st_conv_qk(p, smem_dyn);
    grid.sync();
    st_recur(p, smem_dyn);
    grid.sync();
    st_gate(p);
    grid.sync();
    st_gemm(p.yb, p.W2t, 1024, 1024, smem_dyn, EpiX1{p.x, p.out});
    grid.sync();
    st_norm2(p);
    grid.sync();
    st_gemm(p.x1b, p.Wsubt, 2048, 1024, smem_dyn, EpiSub{p.sub, p.rs2});
    grid.sync();
    st_topk(p);
    grid.sync();
    st_experts(p);
}

extern "C" void kernel_launch(void* const* d_in, const int* in_sizes, int n_in, void* d_out, int out_size, void* d_ws, size_t ws_size,
                              hipStream_t stream) {
    Params p{};
    const float* const* in = (const float* const*)d_in;
    p.x = in[0]; p.norm1_g = in[1]; p.w_in = in[2]; p.ret_norm_g = in[3]; p.m_conv_w = in[4]; p.m_conv_b = in[5]; p.m_wq = in[6]; p.m_wk = in[7];
    p.m_b_i = in[8]; p.m_b_f = in[9]; p.m_norm_g = in[10]; p.m_skip = in[11]; p.w_out = in[12]; p.norm2_g = in[13]; p.peer_wq = in[14];
    p.peer_keys = in[15]; p.peer_down = in[16]; p.peer_up = in[17]; p.final_g = in[18];
    p.out = (float*)d_out;
    char* ws = (char*)d_ws;
    size_t off = 0;
    auto take = [&](size_t bytes) { char* r = ws + off; off += (bytes + 255) & ~(size_t)255; return r; };
    p.proj = (bf16_t*)take((size_t)T_TOK * NPJ * 2);
    p.xb = (bf16_t*)take((size_t)T_TOK * 1024 * 2);
    p.yb = p.xb;
    p.sub = (float*)ws;
    p.gate = (float*)(ws + (size_t)T_TOK * 2048 * 4);
    p.mq = (bf16_t*)take((size_t)T_TOK * 512 * 2);
    p.mk = (bf16_t*)take((size_t)T_TOK * 512 * 2);
    p.x1b = p.mq;
    p.cbuf = (bf16_t*)take((size_t)T_TOK * 512 * 2);
    p.eidx = (int*)p.cbuf;
    p.down_bf = (bf16_t*)take((size_t)16384 * 1024 * 2);
    p.up_bf = (bf16_t*)take((size_t)16384 * 1024 * 2);
    p.W1t = (bf16_t*)take((size_t)NPJ * 1024 * 2);
    p.W2t = (bf16_t*)take((size_t)1024 * 1024 * 2);
    p.Wsubt = (bf16_t*)take((size_t)2048 * 1024 * 2);
    p.Wqt = (bf16_t*)take(4 * 128 * 128 * 2);
    p.Wkt = (bf16_t*)take(4 * 128 * 128 * 2);
    p.rs1 = (float*)take(T_TOK * 4);
    p.rs2 = (float*)take(T_TOK * 4);
    p.ipre = (float*)take(T_TOK * 4 * 4);
    p.logf = (float*)take(T_TOK * 4 * 4);
    p.rope_cos = (float*)take(2048 * 64 * 4);
    p.rope_sin = (float*)take(2048 * 64 * 4);
    if (off > ws_size) { fprintf(stderr, "kernel_launch: workspace too small (%zu > %zu)\n", off, ws_size); return; }

    static int grid_blocks = 0;
    if (!grid_blocks) {
        int dev = 0, cus = 0, per_cu = 0;
        (void)hipGetDevice(&dev);
        (void)hipDeviceGetAttribute(&cus, hipDeviceAttributeMultiprocessorCount, dev);
        (void)hipFuncSetAttribute((const void*)mega_fwd, hipFuncAttributeMaxDynamicSharedMemorySize, LDS_BYTES);
        (void)hipOccupancyMaxActiveBlocksPerMultiprocessor(&per_cu, (const void*)mega_fwd, NTHR, LDS_BYTES);
        if (per_cu > 2) per_cu = 2;
        if (per_cu < 1) per_cu = 1;
        grid_blocks = cus * per_cu;
    }
    void* args[] = {&p};
    hipError_t e = hipLaunchCooperativeKernel((const void*)mega_fwd, dim3(grid_blocks), dim3(NTHR), args, LDS_BYTES, stream);
    if (e != hipSuccess) fprintf(stderr, "cooperative launch failed: %s (grid %d)\n", hipGetErrorString(e), grid_blocks);
}
```

```cpp
#include <hip/hip_runtime.h>
#include <hip/hip_cooperative_groups.h>
#include <stdint.h>
#include <cstdio>
namespace cg = cooperative_groups;

typedef unsigned short bf16_t;
typedef short bf16x8 __attribute__((ext_vector_type(8)));
typedef float f32x4 __attribute__((ext_vector_type(4)));

#define DEVI __device__ __forceinline__

constexpr int T_TOK = 32768, DM = 1024, NPJ = 3584, DIN = 3592;
constexpr int NTHR = 256;
constexpr float EPSN = 1e-6f;

struct Params {
    const float *x, *norm1_g, *w_in, *ret_norm_g, *m_conv_w, *m_conv_b, *m_wq, *m_wk, *m_b_i, *m_b_f, *m_norm_g, *m_skip, *w_out,
        *norm2_g, *peer_wq, *peer_keys, *peer_down, *peer_up, *final_g;
    float* out;
    bf16_t *proj, *xb, *yb, *mq, *mk, *x1b, *cbuf, *W1t, *W2t, *Wsubt, *Wqt, *Wkt;
    unsigned char *down_q, *up_q;
    float *dscale, *uscale;
    unsigned* bar;
    float *rs1, *rs2, *ipre, *logf, *rope_cos, *rope_sin, *sub, *gate;
    int* eidx;
    int pad_[2];
};

DEVI unsigned f2bf_bits(float f) { unsigned u = __float_as_uint(f); return (u + 0x7fffu + ((u >> 16) & 1u)) >> 16; }
DEVI bf16_t f2bf(float f) { return (bf16_t)f2bf_bits(f); }
DEVI unsigned pk2(float lo, float hi) { return f2bf_bits(lo) | (f2bf_bits(hi) << 16); }
DEVI float bflo(unsigned w) { return __uint_as_float(w << 16); }
DEVI float bfhi(unsigned w) { return __uint_as_float(w & 0xffff0000u); }
DEVI float bf2f(bf16_t h) { return __uint_as_float(((unsigned)h) << 16); }
DEVI float wave_sum(float v) {
#pragma unroll
    for (int o = 32; o; o >>= 1) v += __shfl_xor(v, o);
    return v;
}
DEVI float wave_max(float v) {
#pragma unroll
    for (int o = 32; o; o >>= 1) v = fmaxf(v, __shfl_xor(v, o));
    return v;
}
DEVI f32x4 mfma16(bf16x8 a, bf16x8 b, f32x4 c) { return __builtin_amdgcn_mfma_f32_16x16x32_bf16(a, b, c, 0, 0, 0); }
DEVI bf16x8 ld8(const char* p) { return *reinterpret_cast<const bf16x8*>(p); }
DEVI bf16x8 mk8(uint2 lo, uint2 hi) {
    union { uint4 u; bf16x8 v; } x;
    x.u = make_uint4(lo.x, lo.y, hi.x, hi.y);
    return x.v;
}
DEVI float sigmoidf_(float z) { return 1.f / (1.f + __expf(-z)); }

DEVI void st_prep_misc(const Params& p) {
    const int gtid = blockIdx.x * NTHR + threadIdx.x, gsz = gridDim.x * NTHR;
    for (int i = gtid; i < 2048 * 64; i += gsz) {
        const int pos = i >> 6, j = i & 63;
        const float inv = powf(10000.f, -(float)j * (1.f / 64.f));
        const float ang = (float)pos * inv;
        float s, c;
        sincosf(ang, &s, &c);
        p.rope_cos[i] = c;
        p.rope_sin[i] = s;
    }
    for (int i = gtid; i < 4 * 128 * 128; i += gsz) {
        const int h = i >> 14, e = (i >> 7) & 127, d = i & 127;
        p.Wqt[i] = f2bf(p.m_wq[h * 16384 + d * 128 + e]);
        p.Wkt[i] = f2bf(p.m_wk[h * 16384 + d * 128 + e] * 0.08838834764831845f);
    }
}
DEVI void st_prep_tables(const Params& p) {
    const int lane = threadIdx.x & 63, wid = threadIdx.x >> 6;
    for (int row = blockIdx.x * 4 + wid; row < 32768; row += gridDim.x * 4) {
        const bool up = row >= 16384;
        const int e = up ? row - 16384 : row;
        const float4* s = (const float4*)((up ? p.peer_up : p.peer_down) + (size_t)e * 1024 + lane * 16);
        float4 v[4];
        float am = 0.f;
#pragma unroll
        for (int i = 0; i < 4; ++i) {
            v[i] = s[i];
            am = fmaxf(am, fmaxf(fmaxf(fabsf(v[i].x), fabsf(v[i].y)), fmaxf(fabsf(v[i].z), fabsf(v[i].w))));
        }
        am = wave_max(am);
        const float sc = am > 0.f ? am * (1.f / 127.f) : 1.f, inv = am > 0.f ? 127.f / am : 0.f;
        const int ofs = up ? 128 : 0;
        unsigned w[4];
#pragma unroll
        for (int i = 0; i < 4; ++i) {
            const int q0 = (int)rintf(v[i].x * inv) + ofs, q1 = (int)rintf(v[i].y * inv) + ofs, q2 = (int)rintf(v[i].z * inv) + ofs, q3 = (int)rintf(v[i].w * inv) + ofs;
            w[i] = (unsigned)(q0 & 255) | ((unsigned)(q1 & 255) << 8) | ((unsigned)(q2 & 255) << 16) | ((unsigned)(q3 & 255) << 24);
        }
        ((uint4*)((up ? p.up_q : p.down_q) + (size_t)e * 1024))[lane] = make_uint4(w[0], w[1], w[2], w[3]);
        if (lane == 0) (up ? p.uscale : p.dscale)[e] = sc;
    }
}

DEVI void transpose_tile(const float* __restrict__ src, int ld, const float* __restrict__ scale, bf16_t* __restrict__ dst, int K, int k0, int n0,
                         float* tile) {
    const int tx = threadIdx.x & 31, ty = threadIdx.x >> 5;
#pragma unroll
    for (int i = 0; i < 4; ++i) {
        const int k = k0 + ty + 8 * i;
        float v = src[(size_t)k * ld + n0 + tx];
        if (scale) v *= scale[k];
        tile[(ty + 8 * i) * 33 + tx] = v;
    }
    __syncthreads();
#pragma unroll
    for (int i = 0; i < 4; ++i) {
        const int n = n0 + ty + 8 * i;
        dst[(size_t)n * K + k0 + tx] = f2bf(tile[tx * 33 + ty + 8 * i]);
    }
    __syncthreads();
}
DEVI void st_prep_w(const Params& p, char* smem) {
    float* tile = (float*)smem;
    constexpr int N1 = (NPJ / 32) * 32, N2 = 32 * 32;
    for (int it = blockIdx.x; it < N1 + N2; it += gridDim.x) {
        if (it < N1) {
            const int nt = it >> 5, kt = it & 31;
            transpose_tile(p.w_in, DIN, p.norm1_g, p.W1t, 1024, kt * 32, nt * 32, tile);
        } else {
            const int r = it - N1, nt = r >> 5, kt = r & 31;
            transpose_tile(p.w_out, 1024, nullptr, p.W2t, 1024, kt * 32, nt * 32, tile);
        }
    }
}
DEVI void st_prep_wsub(const Params& p, char* smem) {
    float* wq_s = (float*)smem;
    float* key_s = wq_s + 32 * 129 + 16;
    const int tid = threadIdx.x;
    for (int it = blockIdx.x; it < 16 * 32 * 2; it += gridDim.x) {
        const int grp = it >> 6, kt = (it >> 1) & 31, nh = it & 1, k0 = kt * 32;
#pragma unroll
        for (int i = 0; i < 16; ++i) {
            const int idx = tid + 256 * i, r = idx >> 7, d = idx & 127;
            wq_s[r * 129 + d] = p.peer_wq[(size_t)(k0 + r) * 2048 + grp * 128 + d];
        }
#pragma unroll
        for (int i = 0; i < 32; ++i) {
            const int idx = tid + 256 * i, n = idx >> 7, d = idx & 127;
            key_s[n * 128 + d] = p.peer_keys[((size_t)grp * 128 + nh * 64 + n) * 128 + d];
        }
        __syncthreads();
        const int kl = tid & 31, ng = tid >> 5;
        float acc[8];
#pragma unroll
        for (int i = 0; i < 8; ++i) acc[i] = 0.f;
        for (int d = 0; d < 128; ++d) {
            const float a = wq_s[kl * 129 + d];
#pragma unroll
            for (int i = 0; i < 8; ++i) acc[i] += a * key_s[(ng * 8 + i) * 128 + d];
        }
        const float g = p.norm2_g[k0 + kl];
#pragma unroll
        for (int i = 0; i < 8; ++i) p.Wsubt[(size_t)(grp * 128 + nh * 64 + ng * 8 + i) * 1024 + k0 + kl] = f2bf(acc[i] * g);
        __syncthreads();
    }
}

DEVI void st_prep_x(const Params& p, char* smem) {
    float* Wg_s = (float*)smem;
    for (int i = threadIdx.x; i < 8192; i += NTHR) {
        const int k = i >> 3, g = i & 7;
        Wg_s[g * 1024 + k] = p.norm1_g[k] * p.w_in[(size_t)k * DIN + NPJ + g];
    }
    __syncthreads();
    const int lane = threadIdx.x & 63, wid = threadIdx.x >> 6;
    for (int t = blockIdx.x * 4 + wid; t < T_TOK; t += gridDim.x * 4) {
        const float4* xr = (const float4*)(p.x + (size_t)t * 1024);
        float4 v[4];
        float ss = 0.f, g8[8];
#pragma unroll
        for (int g = 0; g < 8; ++g) g8[g] = 0.f;
#pragma unroll
        for (int j = 0; j < 4; ++j) {
            v[j] = xr[lane + 64 * j];
            ss += v[j].x * v[j].x + v[j].y * v[j].y + v[j].z * v[j].z + v[j].w * v[j].w;
#pragma unroll
            for (int g = 0; g < 8; ++g) {
                const float4 w = *(const float4*)(Wg_s + g * 1024 + (lane + 64 * j) * 4);
                g8[g] += v[j].x * w.x + v[j].y * w.y + v[j].z * w.z + v[j].w * w.w;
            }
        }
        ss = wave_sum(ss);
#pragma unroll
        for (int g = 0; g < 8; ++g) g8[g] = wave_sum(g8[g]);
        const float rs = rsqrtf(ss * (1.f / 1024.f) + EPSN);
        uint2* o = (uint2*)(p.xb + (size_t)t * 1024);
#pragma unroll
        for (int j = 0; j < 4; ++j) o[lane + 64 * j] = make_uint2(pk2(v[j].x, v[j].y), pk2(v[j].z, v[j].w));
        if (lane == 0) {
            p.rs1[t] = rs;
#pragma unroll
            for (int h = 0; h < 4; ++h) {
                p.ipre[t * 4 + h] = g8[h] * rs + p.m_b_i[h];
                const float z = g8[4 + h] * rs + p.m_b_f[h];
                p.logf[t * 4 + h] = fminf(z, 0.f) - log1pf(__expf(-fabsf(z)));
            }
        }
    }
}

constexpr int G_LDS_ROW = 144;
constexpr int G_LDS_MAT = 128 * G_LDS_ROW;
constexpr int G_LDS_BYTES = 4 * G_LDS_MAT;

template <class Epi>
DEVI void gemm_tile(const bf16_t* __restrict__ A, const bf16_t* __restrict__ Bt, int K, int m0, int n0, char* smem, const Epi& epi) {
    const int tid = threadIdx.x, lane = tid & 63, wid = tid >> 6, wr = wid >> 1, wc = wid & 1, fr = lane & 15, fq = lane >> 4;
    f32x4 acc[4][4];
#pragma unroll
    for (int i = 0; i < 4; ++i)
#pragma unroll
        for (int j = 0; j < 4; ++j) acc[i][j] = (f32x4){0.f, 0.f, 0.f, 0.f};
    uint4 ra[4], rb[4];
    const int nt = K / 64;
    auto gload = [&](int kt) {
#pragma unroll
        for (int i = 0; i < 4; ++i) {
            const int id = tid + 256 * i, r = id >> 3, c = id & 7;
            ra[i] = *(const uint4*)(A + (size_t)(m0 + r) * K + kt * 64 + c * 8);
            rb[i] = *(const uint4*)(Bt + (size_t)(n0 + r) * K + kt * 64 + c * 8);
        }
    };
    auto swrite = [&](int buf) {
        char* As = smem + buf * 2 * G_LDS_MAT;
        char* Bs = As + G_LDS_MAT;
#pragma unroll
        for (int i = 0; i < 4; ++i) {
            const int id = tid + 256 * i, r = id >> 3, c = id & 7;
            *(uint4*)(As + r * G_LDS_ROW + c * 16) = ra[i];
            *(uint4*)(Bs + r * G_LDS_ROW + c * 16) = rb[i];
        }
    };
    gload(0);
    swrite(0);
    __syncthreads();
    for (int kt = 0; kt < nt; ++kt) {
        if (kt + 1 < nt) gload(kt + 1);
        const char* As = smem + (kt & 1) * 2 * G_LDS_MAT;
        const char* Bs = As + G_LDS_MAT;
#pragma unroll
        for (int kk = 0; kk < 2; ++kk) {
            bf16x8 a[4], b[4];
#pragma unroll
            for (int i = 0; i < 4; ++i) a[i] = ld8(As + (wr * 64 + i * 16 + fr) * G_LDS_ROW + (kk * 4 + fq) * 16);
#pragma unroll
            for (int j = 0; j < 4; ++j) b[j] = ld8(Bs + (wc * 64 + j * 16 + fr) * G_LDS_ROW + (kk * 4 + fq) * 16);
#pragma unroll
            for (int i = 0; i < 4; ++i)
#pragma unroll
                for (int j = 0; j < 4; ++j) acc[i][j] = mfma16(b[j], a[i], acc[i][j]);
        }
        if (kt + 1 < nt) swrite((kt + 1) & 1);
        __syncthreads();
    }
#pragma unroll
    for (int i = 0; i < 4; ++i)
#pragma unroll
        for (int j = 0; j < 4; ++j) epi(acc[i][j], m0 + wr * 64 + i * 16 + fr, n0 + wc * 64 + j * 16 + 4 * fq);
}
struct EpiProj {
    bf16_t* proj; const float* rs1;
    DEVI void operator()(const f32x4& v, int m, int n) const {
        const float s = rs1[m];
        *(uint2*)(proj + (size_t)m * NPJ + n) = make_uint2(pk2(v[0] * s, v[1] * s), pk2(v[2] * s, v[3] * s));
    }
};
struct EpiX1 {
    const float* x; float* out;
    DEVI void operator()(const f32x4& v, int m, int n) const {
        const float4 xv = *(const float4*)(x + (size_t)m * 1024 + n);
        *(float4*)(out + (size_t)m * 1024 + n) = make_float4(xv.x + v[0], xv.y + v[1], xv.z + v[2], xv.w + v[3]);
    }
};
struct EpiSub {
    float* sub; const float* rs2;
    DEVI void operator()(const f32x4& v, int m, int n) const {
        const float s = rs2[m];
        *(float4*)(sub + (size_t)m * 2048 + n) = make_float4(v[0] * s, v[1] * s, v[2] * s, v[3] * s);
    }
};
template <class Epi>
DEVI void st_gemm(const bf16_t* A, const bf16_t* Bt, int N, int K, char* smem, const Epi& epi) {
    const int nN = N / 128, ntile = (T_TOK / 128) * nN;
    for (int it = blockIdx.x; it < ntile; it += gridDim.x) {
        const int pm = it / nN, pn = it - pm * nN;
        gemm_tile(A, Bt, K, pm * 128, pn * 128, smem, epi);
    }
}

DEVI void st_conv_qk(const Params& p, char* smem) {
    char* cs = smem;
    char* ws = smem + 128 * 272;
    const int tid = threadIdx.x, lane = tid & 63, wid = tid >> 6, wr = wid >> 1, wc = wid & 1, fr = lane & 15, fq = lane >> 4;
    for (int it = blockIdx.x; it < 256 * 4; it += gridDim.x) {
        const int h = it & 3, t0 = (it >> 2) * 128, s0 = t0 & 2047;
        {
            const int ch = tid & 127, r0 = (tid >> 7) * 64;
            const int col = 2048 + h * 128 + ch;
            const float w0 = p.m_conv_w[0 * 512 + h * 128 + ch], w1 = p.m_conv_w[1 * 512 + h * 128 + ch], w2 = p.m_conv_w[2 * 512 + h * 128 + ch],
                        w3 = p.m_conv_w[3 * 512 + h * 128 + ch], bb = p.m_conv_b[h * 128 + ch];
            float xm3 = 0.f, xm2 = 0.f, xm1 = 0.f;
            if (s0 + r0 > 0) {
                xm3 = bf2f(p.proj[(size_t)(t0 + r0 - 3) * NPJ + col]);
                xm2 = bf2f(p.proj[(size_t)(t0 + r0 - 2) * NPJ + col]);
                xm1 = bf2f(p.proj[(size_t)(t0 + r0 - 1) * NPJ + col]);
            }
            for (int r = r0; r < r0 + 64; ++r) {
                const float xc = bf2f(p.proj[(size_t)(t0 + r) * NPJ + col]);
                const float y = bb + w0 * xm3 + w1 * xm2 + w2 * xm1 + w3 * xc;
                const float c = y * sigmoidf_(y);
                const bf16_t cb = f2bf(c);
                *(bf16_t*)(cs + r * 272 + ch * 2) = cb;
                p.cbuf[(size_t)(t0 + r) * 512 + h * 128 + ch] = cb;
                xm3 = xm2; xm2 = xm1; xm1 = xc;
            }
        }
#pragma unroll
        for (int which = 0; which < 2; ++which) {
            const bf16_t* W = (which ? p.Wkt : p.Wqt) + h * 16384;
            bf16_t* O = which ? p.mk : p.mq;
#pragma unroll
            for (int i = 0; i < 8; ++i) {
                const int id = tid + 256 * i, r = id >> 4, c = id & 15;
                *(uint4*)(ws + r * 272 + c * 16) = *(const uint4*)(W + r * 128 + c * 8);
            }
            __syncthreads();
            f32x4 acc[4][4];
#pragma unroll
            for (int i = 0; i < 4; ++i)
#pragma unroll
                for (int j = 0; j < 4; ++j) acc[i][j] = (f32x4){0.f, 0.f, 0.f, 0.f};
#pragma unroll
            for (int ks = 0; ks < 4; ++ks) {
                bf16x8 a[4], b[4];
#pragma unroll
                for (int i = 0; i < 4; ++i) a[i] = ld8(cs + (wr * 64 + i * 16 + fr) * 272 + (ks * 4 + fq) * 16);
#pragma unroll
                for (int j = 0; j < 4; ++j) b[j] = ld8(ws + (wc * 64 + j * 16 + fr) * 272 + (ks * 4 + fq) * 16);
#pragma unroll
                for (int i = 0; i < 4; ++i)
#pragma unroll
                    for (int j = 0; j < 4; ++j) acc[i][j] = mfma16(b[j], a[i], acc[i][j]);
            }
#pragma unroll
            for (int i = 0; i < 4; ++i)
#pragma unroll
                for (int j = 0; j < 4; ++j) {
                    const int m = t0 + wr * 64 + i * 16 + fr, n = h * 128 + wc * 64 + j * 16 + 4 * fq;
                    const f32x4 v = acc[i][j];
                    *(uint2*)(O + (size_t)m * 512 + n) = make_uint2(pk2(v[0], v[1]), pk2(v[2], v[3]));
                }
            __syncthreads();
        }
    }
}

DEVI void ret_item(const Params& p, char* smem, int b, int h, int vh) {
    char* qs = smem;
    char* ks = smem + 17408;
    char* kTs = smem + 34816;
    char* vTs = smem + 53248;
    char* Ss = smem + 62464;
    const int tid = threadIdx.x, lane = tid & 63, w = tid >> 6, fr = lane & 15, fq = lane >> 4;
    const float gamma = 1.f - exp2f(-5.f - (float)h);
    const float l2g = log2f(gamma);
    const float g64 = exp2f(l2g * 64.f);
    f32x4 st[8];
#pragma unroll
    for (int i = 0; i < 8; ++i) st[i] = (f32x4){0.f, 0.f, 0.f, 0.f};
    for (int c = 0; c < 32; ++c) {
        const int t0 = b * 2048 + c * 64;
#pragma unroll
        for (int i = 0; i < 2; ++i) {
            const int u = tid + 256 * i, m = u >> 3, j0 = (u & 7) * 8;
            const int pos = c * 64 + m;
            const float4 c0 = *(const float4*)(p.rope_cos + pos * 64 + j0), c1 = *(const float4*)(p.rope_cos + pos * 64 + j0 + 4);
            const float4 s0 = *(const float4*)(p.rope_sin + pos * 64 + j0), s1 = *(const float4*)(p.rope_sin + pos * 64 + j0 + 4);
            const float cs_[8] = {c0.x, c0.y, c0.z, c0.w, c1.x, c1.y, c1.z, c1.w};
            const float sn_[8] = {s0.x, s0.y, s0.z, s0.w, s1.x, s1.y, s1.z, s1.w};
            const bf16_t* row = p.proj + (size_t)(t0 + m) * NPJ + h * 128 + j0;
            {
                const uint4 a = *(const uint4*)(row), bq = *(const uint4*)(row + 64);
                const unsigned aw[4] = {a.x, a.y, a.z, a.w}, bw[4] = {bq.x, bq.y, bq.z, bq.w};
                unsigned o1[4], o2[4];
#pragma unroll
                for (int e = 0; e < 4; ++e) {
                    const float t1a = bflo(aw[e]), t1b = bfhi(aw[e]), t2a = bflo(bw[e]), t2b = bfhi(bw[e]);
                    o1[e] = pk2(t1a * cs_[2 * e] - t2a * sn_[2 * e], t1b * cs_[2 * e + 1] - t2b * sn_[2 * e + 1]);
                    o2[e] = pk2(t1a * sn_[2 * e] + t2a * cs_[2 * e], t1b * sn_[2 * e + 1] + t2b * cs_[2 * e + 1]);
                }
                *(uint4*)(qs + m * 272 + j0 * 2) = make_uint4(o1[0], o1[1], o1[2], o1[3]);
                *(uint4*)(qs + m * 272 + (64 + j0) * 2) = make_uint4(o2[0], o2[1], o2[2], o2[3]);
            }
            {
                const uint4 a = *(const uint4*)(row + 512), bq = *(const uint4*)(row + 512 + 64);
                const unsigned aw[4] = {a.x, a.y, a.z, a.w}, bw[4] = {bq.x, bq.y, bq.z, bq.w};
                const float kd = exp2f(l2g * (float)(63 - m));
                const float sc = 0.08838834764831845f;
                unsigned o1[4], o2[4];
#pragma unroll
                for (int e = 0; e < 4; ++e) {
                    const float t1a = bflo(aw[e]), t1b = bfhi(aw[e]), t2a = bflo(bw[e]), t2b = bfhi(bw[e]);
                    const float r1a = (t1a * cs_[2 * e] - t2a * sn_[2 * e]) * sc, r1b = (t1b * cs_[2 * e + 1] - t2b * sn_[2 * e + 1]) * sc;
                    const float r2a = (t1a * sn_[2 * e] + t2a * cs_[2 * e]) * sc, r2b = (t1b * sn_[2 * e + 1] + t2b * cs_[2 * e + 1]) * sc;
                    o1[e] = pk2(r1a, r1b);
                    o2[e] = pk2(r2a, r2b);
                    *(bf16_t*)(kTs + (j0 + 2 * e) * 144 + m * 2) = f2bf(r1a * kd);
                    *(bf16_t*)(kTs + (j0 + 2 * e + 1) * 144 + m * 2) = f2bf(r1b * kd);
                    *(bf16_t*)(kTs + (64 + j0 + 2 * e) * 144 + m * 2) = f2bf(r2a * kd);
                    *(bf16_t*)(kTs + (64 + j0 + 2 * e + 1) * 144 + m * 2) = f2bf(r2b * kd);
                }
                *(uint4*)(ks + m * 272 + j0 * 2) = make_uint4(o1[0], o1[1], o1[2], o1[3]);
                *(uint4*)(ks + m * 272 + (64 + j0) * 2) = make_uint4(o2[0], o2[1], o2[2], o2[3]);
            }
            {
                const uint4 a = *(const uint4*)(p.proj + (size_t)(t0 + m) * NPJ + 1024 + h * 128 + vh * 64 + j0);
                const unsigned aw[4] = {a.x, a.y, a.z, a.w};
#pragma unroll
                for (int e = 0; e < 4; ++e) {
                    *(bf16_t*)(vTs + (j0 + 2 * e) * 144 + m * 2) = (bf16_t)(aw[e] & 0xffffu);
                    *(bf16_t*)(vTs + (j0 + 2 * e + 1) * 144 + m * 2) = (bf16_t)(aw[e] >> 16);
                }
            }
        }
        __syncthreads();
        {
            bf16x8 qf[4];
#pragma unroll
            for (int s = 0; s < 4; ++s) qf[s] = ld8(qs + (16 * w + fr) * 272 + (s * 4 + fq) * 16);
#pragma unroll
            for (int j = 0; j < 4; ++j) {
                f32x4 a = (f32x4){0.f, 0.f, 0.f, 0.f};
#pragma unroll
                for (int s = 0; s < 4; ++s) a = mfma16(ld8(ks + (16 * j + fr) * 272 + (s * 4 + fq) * 16), qf[s], a);
                const int l = 16 * w + fr, mb = 16 * j + 4 * fq;
                float v[4];
#pragma unroll
                for (int r = 0; r < 4; ++r) {
                    const int dd = l - (mb + r);
                    v[r] = a[r] * exp2f(l2g * (float)(dd < 0 ? -dd : dd));
                }
                *(uint2*)(Ss + l * 144 + mb * 2) = make_uint2(pk2(v[0], v[1]), pk2(v[2], v[3]));
            }
        }
        __syncthreads();
        {
            bf16x8 sp[4];
#pragma unroll
            for (int s = 0; s < 4; ++s)
                sp[s] = mk8(make_uint2(pk2(st[2 * s][0], st[2 * s][1]), pk2(st[2 * s][2], st[2 * s][3])),
                            make_uint2(pk2(st[2 * s + 1][0], st[2 * s + 1][1]), pk2(st[2 * s + 1][2], st[2 * s + 1][3])));
            bf16x8 vf[2];
#pragma unroll
            for (int s2 = 0; s2 < 2; ++s2) vf[s2] = ld8(vTs + (16 * w + fr) * 144 + (s2 * 4 + fq) * 16);
#pragma unroll
            for (int i = 0; i < 4; ++i) {
                f32x4 a = (f32x4){0.f, 0.f, 0.f, 0.f};
                const char* qrow = qs + (16 * i + fr) * 272;
#pragma unroll
                for (int s = 0; s < 4; ++s) {
                    const uint2 lo = *(const uint2*)(qrow + (32 * s + 4 * fq) * 2), hi = *(const uint2*)(qrow + (32 * s + 16 + 4 * fq) * 2);
                    a = mfma16(sp[s], mk8(lo, hi), a);
                }
                const float qd = exp2f(l2g * (float)(16 * i + fr + 1));
                a = a * qd;
#pragma unroll
                for (int s2 = 0; s2 < 2; ++s2) a = mfma16(vf[s2], ld8(Ss + (16 * i + fr) * 144 + (s2 * 4 + fq) * 16), a);
                *(uint2*)(p.proj + (size_t)(t0 + 16 * i + fr) * NPJ + 1024 + h * 128 + vh * 64 + 16 * w + 4 * fq) =
                    make_uint2(pk2(a[0], a[1]), pk2(a[2], a[3]));
            }
#pragma unroll
            for (int i = 0; i < 8; ++i) {
                f32x4 a = st[i] * g64;
#pragma unroll
                for (int s2 = 0; s2 < 2; ++s2) a = mfma16(ld8(kTs + (16 * i + fr) * 144 + (s2 * 4 + fq) * 16), vf[s2], a);
                st[i] = a;
            }
        }
        __syncthreads();
    }
}

DEVI void mlstm_item(const Params& p, char* smem, int b, int h, int vh) {
    char* qs = smem;
    char* kTs = smem + 17408;
    char* vTs = smem + 35840;
    float* n_s = (float*)(smem + 45056);
    float* qn_s = (float*)(smem + 45568);
    float* den_s = (float*)(smem + 46592);
    const int tid = threadIdx.x, lane = tid & 63, w = tid >> 6, fr = lane & 15, fq = lane >> 4;
    f32x4 st[8];
#pragma unroll
    for (int i = 0; i < 8; ++i) st[i] = (f32x4){0.f, 0.f, 0.f, 0.f};
    float m_run = 0.f, n_reg = 0.f;
    for (int c = 0; c < 32; ++c) {
        const int t0 = b * 2048 + c * 64;
        const float iv = p.ipre[(t0 + lane) * 4 + h], fv = p.logf[(t0 + lane) * 4 + h];
        float fcum = fv;
#pragma unroll
        for (int o = 1; o < 64; o <<= 1) {
            const float tv = __shfl_up(fcum, o);
            if (lane >= o) fcum += tv;
        }
        const float a_c = __shfl(fcum, 63);
        const float logw = a_c - fcum + iv;
        const float m_in = wave_max(logw);
        const float m_new = fmaxf(a_c + m_run, m_in);
        const float decay = __expf(a_c + m_run - m_new);
        const float wgt = __expf(logw - m_new);
        const float emn = __expf(-m_new);
        m_run = m_new;
#pragma unroll
        for (int i = 0; i < 4; ++i) {
            const int u = tid + 256 * i, m = u >> 4, j0 = (u & 15) * 8;
            *(uint4*)(qs + m * 272 + j0 * 2) = *(const uint4*)(p.mq + (size_t)(t0 + m) * 512 + h * 128 + j0);
            const uint4 kk = *(const uint4*)(p.mk + (size_t)(t0 + m) * 512 + h * 128 + j0);
            const float wm = __shfl(wgt, m);
            const unsigned kw[4] = {kk.x, kk.y, kk.z, kk.w};
#pragma unroll
            for (int e = 0; e < 4; ++e) {
                *(bf16_t*)(kTs + (j0 + 2 * e) * 144 + m * 2) = f2bf(bflo(kw[e]) * wm);
                *(bf16_t*)(kTs + (j0 + 2 * e + 1) * 144 + m * 2) = f2bf(bfhi(kw[e]) * wm);
            }
        }
#pragma unroll
        for (int i = 0; i < 2; ++i) {
            const int u = tid + 256 * i, m = u >> 3, j0 = (u & 7) * 8;
            const uint4 a = *(const uint4*)(p.proj + (size_t)(t0 + m) * NPJ + 2560 + h * 128 + vh * 64 + j0);
            const unsigned aw[4] = {a.x, a.y, a.z, a.w};
#pragma unroll
            for (int e = 0; e < 4; ++e) {
                *(bf16_t*)(vTs + (j0 + 2 * e) * 144 + m * 2) = (bf16_t)(aw[e] & 0xffffu);
                *(bf16_t*)(vTs + (j0 + 2 * e + 1) * 144 + m * 2) = (bf16_t)(aw[e] >> 16);
            }
        }
        __syncthreads();
        if (tid < 128) {
            float s = 0.f;
#pragma unroll
            for (int q = 0; q < 8; ++q) {
                const uint4 a = *(const uint4*)(kTs + tid * 144 + q * 16);
                s += (bflo(a.x) + bfhi(a.x)) + (bflo(a.y) + bfhi(a.y)) + (bflo(a.z) + bfhi(a.z)) + (bflo(a.w) + bfhi(a.w));
            }
            n_reg = decay * n_reg + s;
            n_s[tid] = n_reg;
        }
        {
            bf16x8 vf[2];
#pragma unroll
            for (int s2 = 0; s2 < 2; ++s2) vf[s2] = ld8(vTs + (16 * w + fr) * 144 + (s2 * 4 + fq) * 16);
#pragma unroll
            for (int i = 0; i < 8; ++i) {
                f32x4 a = st[i] * decay;
#pragma unroll
                for (int s2 = 0; s2 < 2; ++s2) a = mfma16(ld8(kTs + (16 * i + fr) * 144 + (s2 * 4 + fq) * 16), vf[s2], a);
                st[i] = a;
            }
        }
        __syncthreads();
        {
            const int l = tid & 63, part = tid >> 6;
            float s = 0.f;
#pragma unroll
            for (int q = 0; q < 8; ++q) {
                const uint2 a = *(const uint2*)(qs + l * 272 + (part * 32 + 4 * q) * 2);
                const float* nn = n_s + part * 32 + 4 * q;
                s += bflo(a.x) * nn[0] + bfhi(a.x) * nn[1] + bflo(a.y) * nn[2] + bfhi(a.y) * nn[3];
            }
            qn_s[part * 64 + l] = s;
        }
        __syncthreads();
        if (tid < 64) den_s[tid] = fmaxf(fabsf(qn_s[tid] + qn_s[64 + tid] + qn_s[128 + tid] + qn_s[192 + tid]), emn);
        __syncthreads();
        {
            bf16x8 sp[4];
#pragma unroll
            for (int s = 0; s < 4; ++s)
                sp[s] = mk8(make_uint2(pk2(st[2 * s][0], st[2 * s][1]), pk2(st[2 * s][2], st[2 * s][3])),
                            make_uint2(pk2(st[2 * s + 1][0], st[2 * s + 1][1]), pk2(st[2 * s + 1][2], st[2 * s + 1][3])));
#pragma unroll
            for (int i = 0; i < 4; ++i) {
                f32x4 a = (f32x4){0.f, 0.f, 0.f, 0.f};
                const char* qrow = qs + (16 * i + fr) * 272;
#pragma unroll
                for (int s = 0; s < 4; ++s) {
                    const uint2 lo = *(const uint2*)(qrow + (32 * s + 4 * fq) * 2), hi = *(const uint2*)(qrow + (32 * s + 16 + 4 * fq) * 2);
                    a = mfma16(sp[s], mk8(lo, hi), a);
                }
                const float rd = 1.f / den_s[16 * i + fr];
                *(uint2*)(p.proj + (size_t)(t0 + 16 * i + fr) * NPJ + 2560 + h * 128 + vh * 64 + 16 * w + 4 * fq) =
                    make_uint2(pk2(a[0] * rd, a[1] * rd), pk2(a[2] * rd, a[3] * rd));
            }
        }
        __syncthreads();
    }
}
DEVI void st_recur(const Params& p, char* smem) {
    for (int it = blockIdx.x; it < 256; it += gridDim.x) {
        const int kind = it & 1, r = it >> 1, vh = r & 1, h = (r >> 1) & 3, b = r >> 3;
        if (kind == 0) ret_item(p, smem, b, h, vh);
        else mlstm_item(p, smem, b, h, vh);
    }
}

DEVI void st_gate(const Params& p) {
    const int lane = threadIdx.x & 63, wid = threadIdx.x >> 6;
    for (int t = blockIdx.x * 4 + wid; t < T_TOK; t += gridDim.x * 4) {
        const bf16_t* pr = p.proj + (size_t)t * NPJ;
#pragma unroll
        for (int hh = 0; hh < 8; ++hh) {
            const bool ml = hh >= 4;
            const int h = hh & 3;
            const unsigned ow = *(const unsigned*)(pr + (ml ? 2560 : 1024) + h * 128 + 2 * lane);
            const float o0 = bflo(ow), o1 = bfhi(ow);
            const float mu = wave_sum(o0 + o1) * (1.f / 128.f);
            const float d0 = o0 - mu, d1 = o1 - mu;
            const float var = wave_sum(d0 * d0 + d1 * d1) * (1.f / 128.f);
            const float rstd = rsqrtf(var + EPSN);
            const float* gn = (ml ? p.m_norm_g : p.ret_norm_g) + h * 128 + 2 * lane;
            const float n0 = d0 * rstd * gn[0], n1 = d1 * rstd * gn[1];
            const unsigned gw = *(const unsigned*)(pr + (ml ? 3072 : 1536) + h * 128 + 2 * lane);
            const float g0 = bflo(gw), g1 = bfhi(gw);
            float y0, y1;
            if (!ml) {
                y0 = g0 * sigmoidf_(g0) * n0;
                y1 = g1 * sigmoidf_(g1) * n1;
            } else {
                const unsigned cw = *(const unsigned*)(p.cbuf + (size_t)t * 512 + h * 128 + 2 * lane);
                const float* sk = p.m_skip + h * 128 + 2 * lane;
                y0 = sigmoidf_(g0) * (n0 + sk[0] * bflo(cw));
                y1 = sigmoidf_(g1) * (n1 + sk[1] * bfhi(cw));
            }
            *(unsigned*)(p.yb + (size_t)t * 1024 + hh * 128 + 2 * lane) = pk2(y0, y1);
        }
    }
}

DEVI void st_norm2(const Params& p) {
    const int lane = threadIdx.x & 63, wid = threadIdx.x >> 6;
    for (int t = blockIdx.x * 4 + wid; t < T_TOK; t += gridDim.x * 4) {
        const float4* xr = (const float4*)(p.out + (size_t)t * 1024);
        uint2* o = (uint2*)(p.x1b + (size_t)t * 1024);
        float ss = 0.f;
#pragma unroll
        for (int j = 0; j < 4; ++j) {
            const float4 v = xr[lane + 64 * j];
            ss += v.x * v.x + v.y * v.y + v.z * v.z + v.w * v.w;
            o[lane + 64 * j] = make_uint2(pk2(v.x, v.y), pk2(v.z, v.w));
        }
        ss = wave_sum(ss);
        if (lane == 0) p.rs2[t] = rsqrtf(ss * (1.f / 1024.f) + EPSN);
    }
}

DEVI void st_topk(const Params& p) {
    const int lane = threadIdx.x & 63, wid = threadIdx.x >> 6;
    const float NEG = -3.0e38f;
    for (int it = blockIdx.x * 4 + wid; it < T_TOK * 8; it += gridDim.x * 4) {
        const int t = it >> 3, h = it & 7;
        const float* sr = p.sub + (size_t)t * 2048 + h * 256;
        float sl[2] = {0.f, 0.f};
        int il[2] = {0, 0};
#pragma unroll
        for (int pp = 0; pp < 2; ++pp) {
            float v0 = sr[pp * 128 + lane], v1 = sr[pp * 128 + 64 + lane];
            for (int k = 0; k < 16; ++k) {
                const float M = wave_max(fmaxf(v0, v1));
                const unsigned long long b0 = __ballot(v0 == M), b1 = __ballot(v1 == M);
                int src, idx;
                if (b0) { src = __ffsll((long long)b0) - 1; idx = src; }
                else { src = __ffsll((long long)b1) - 1; idx = src + 64; }
                if (lane == k) { sl[pp] = M; il[pp] = idx; }
                if (lane == src) { if (b0) v0 = NEG; else v1 = NEG; }
            }
        }
        float cv[4];
        const float s1 = __shfl(sl[0], lane >> 2);
#pragma unroll
        for (int c = 0; c < 4; ++c) cv[c] = s1 + __shfl(sl[1], (lane & 3) * 4 + c);
        float best = 0.f; int eid = 0;
        for (int k = 0; k < 16; ++k) {
            const float lm = fmaxf(fmaxf(cv[0], cv[1]), fmaxf(cv[2], cv[3]));
            const float M = wave_max(lm);
            const unsigned long long bb = __ballot(lm == M);
            const int src = __ffsll((long long)bb) - 1;
            int cidx = 0;
            if (cv[3] == M) cidx = 3;
            if (cv[2] == M) cidx = 2;
            if (cv[1] == M) cidx = 1;
            if (cv[0] == M) cidx = 0;
            const int csel = __shfl(cidx, src);
            const int flat = src * 4 + csel;
            const int i1 = __shfl(il[0], flat >> 4), i2 = __shfl(il[1], flat & 15);
            if (lane == k) { best = M; eid = i1 * 128 + i2; }
            if (lane == src) {
#pragma unroll
                for (int c = 0; c < 4; ++c) if (c == csel) cv[c] = NEG;
            }
        }
        const float bmax = __shfl(best, 0);
        const float ex = lane < 16 ? __expf(best - bmax) : 0.f;
        const float sum = wave_sum(ex);
        if (lane < 16) {
            p.eidx[(size_t)t * 128 + h * 16 + lane] = eid;
            p.gate[(size_t)t * 128 + h * 16 + lane] = ex / sum;
        }
    }
}

DEVI int rdlane_i(int v, int l) { return __builtin_amdgcn_readlane(v, l); }
DEVI float rdlane_f(float v, int l) { return __int_as_float(__builtin_amdgcn_readlane(__float_as_int(v), l)); }
DEVI float ub(unsigned w, int n) { return (float)((w >> (8 * n)) & 0xffu); }
DEVI void st_experts(const Params& p) {
    const int lane = threadIdx.x & 63, wid = threadIdx.x >> 6;
    const int myidx = ((lane >> 5) & 1) * 8 + ((lane >> 4) & 1) * 4 + ((lane >> 3) & 1) * 2 + ((lane >> 2) & 1);
    const bool b5 = lane & 32, b4 = lane & 16, b3 = lane & 8, b2 = lane & 4;
    for (int t = blockIdx.x * 4 + wid; t < T_TOK; t += gridDim.x * 4) {
        float x1v[16], acc[16];
        int xq[4];
        float xsc;
        {
            const float rs = p.rs2[t];
            float xn[16], am = 0.f;
#pragma unroll
            for (int i = 0; i < 4; ++i) {
                const float4 a = *(const float4*)(p.out + (size_t)t * 1024 + lane * 16 + i * 4), g = *(const float4*)(p.norm2_g + lane * 16 + i * 4);
                x1v[4 * i] = a.x; x1v[4 * i + 1] = a.y; x1v[4 * i + 2] = a.z; x1v[4 * i + 3] = a.w;
                xn[4 * i] = a.x * rs * g.x; xn[4 * i + 1] = a.y * rs * g.y; xn[4 * i + 2] = a.z * rs * g.z; xn[4 * i + 3] = a.w * rs * g.w;
            }
#pragma unroll
            for (int c = 0; c < 16; ++c) { am = fmaxf(am, fabsf(xn[c])); acc[c] = 0.f; }
            am = wave_max(am);
            xsc = am > 0.f ? am * (1.f / 127.f) : 1.f;
            const float inv = am > 0.f ? 127.f / am : 0.f;
#pragma unroll
            for (int i = 0; i < 4; ++i) {
                const int q0 = (int)rintf(xn[4 * i] * inv), q1 = (int)rintf(xn[4 * i + 1] * inv), q2 = (int)rintf(xn[4 * i + 2] * inv), q3 = (int)rintf(xn[4 * i + 3] * inv);
                xq[i] = (int)((unsigned)(q0 & 255) | ((unsigned)(q1 & 255) << 8) | ((unsigned)(q2 & 255) << 16) | ((unsigned)(q3 & 255) << 24));
            }
        }
        float asum = 0.f;
        for (int kb = 0; kb < 128; kb += 16) {
            const int e16 = p.eidx[(size_t)t * 128 + kb + (lane & 15)];
            uint4 dr[16], ur[16];
#pragma unroll
            for (int j = 0; j < 16; ++j) dr[j] = ((const uint4*)(p.down_q + (size_t)rdlane_i(e16, j) * 1024))[lane];
#pragma unroll
            for (int j = 0; j < 16; ++j) ur[j] = ((const uint4*)(p.up_q + (size_t)rdlane_i(e16, j) * 1024))[lane];
            int ps[16];
#pragma unroll
            for (int j = 0; j < 16; ++j)
                ps[j] = __builtin_amdgcn_sdot4((int)dr[j].x, xq[0], __builtin_amdgcn_sdot4((int)dr[j].y, xq[1],
                        __builtin_amdgcn_sdot4((int)dr[j].z, xq[2], __builtin_amdgcn_sdot4((int)dr[j].w, xq[3], 0, false), false), false), false);
            int q8[8], q4[4], q2[2], q1;
#pragma unroll
            for (int j = 0; j < 8; ++j) { const int snd = b5 ? ps[j] : ps[j + 8], kp = b5 ? ps[j + 8] : ps[j]; q8[j] = kp + __shfl_xor(snd, 32); }
#pragma unroll
            for (int j = 0; j < 4; ++j) { const int snd = b4 ? q8[j] : q8[j + 4], kp = b4 ? q8[j + 4] : q8[j]; q4[j] = kp + __shfl_xor(snd, 16); }
#pragma unroll
            for (int j = 0; j < 2; ++j) { const int snd = b3 ? q4[j] : q4[j + 2], kp = b3 ? q4[j + 2] : q4[j]; q2[j] = kp + __shfl_xor(snd, 8); }
            { const int snd = b2 ? q2[0] : q2[1], kp = b2 ? q2[1] : q2[0]; q1 = kp + __shfl_xor(snd, 4); }
            q1 += __shfl_xor(q1, 2);
            q1 += __shfl_xor(q1, 1);
            const int em = __shfl(e16, myidx);
            const float gm = p.gate[(size_t)t * 128 + kb + myidx];
            const float u = (float)q1 * xsc * p.dscale[em];
            const float a = gm * 0.5f * u * (1.f + erff(u * 0.70710678118654752f)) * p.uscale[em];
#pragma unroll
            for (int j = 0; j < 16; ++j) {
                const int LJ = ((j >> 3) & 1) * 32 + ((j >> 2) & 1) * 16 + ((j >> 1) & 1) * 8 + (j & 1) * 4;
                const float aj = rdlane_f(a, LJ);
                asum += aj;
                const unsigned wv[4] = {ur[j].x, ur[j].y, ur[j].z, ur[j].w};
#pragma unroll
                for (int i = 0; i < 4; ++i)
#pragma unroll
                    for (int n = 0; n < 4; ++n) acc[4 * i + n] += aj * ub(wv[i], n);
            }
        }
        float ss = 0.f;
        const float corr = 128.f * asum;
#pragma unroll
        for (int c = 0; c < 16; ++c) { acc[c] = x1v[c] + acc[c] - corr; ss += acc[c] * acc[c]; }
        ss = wave_sum(ss);
        const float rf = rsqrtf(ss * (1.f / 1024.f) + EPSN);
#pragma unroll
        for (int i = 0; i < 4; ++i) {
            const float4 g = *(const float4*)(p.final_g + lane * 16 + i * 4);
            *(float4*)(p.out + (size_t)t * 1024 + lane * 16 + i * 4) =
                make_float4(acc[4 * i] * rf * g.x, acc[4 * i + 1] * rf * g.y, acc[4 * i + 2] * rf * g.z, acc[4 * i + 3] * rf * g.w);
        }
    }
}

#define XB_TMO      128
#define XB_XCNT(j)  (256  + 64 * (j))
#define XB_XSUB(j)  (1280 + 64 * (j))
#define XB_XGEN(j)  (2304 + 64 * (j))
#define XB_TOP      3328
#define XB_TOPGEN   3392
#define XCD_BAR_WORDS 3456
#define XB_SPIN_CAP (1u << 20)
#define LAS __attribute__((address_space(3)))
DEVI unsigned xb_ld(unsigned* p) { return __hip_atomic_load(p, __ATOMIC_RELAXED, __HIP_MEMORY_SCOPE_AGENT); }
DEVI unsigned xb_add(unsigned* p, unsigned v) { return __hip_atomic_fetch_add(p, v, __ATOMIC_RELAXED, __HIP_MEMORY_SCOPE_AGENT); }
DEVI unsigned xb_xcc_id() { return (unsigned)__builtin_amdgcn_s_getreg((3 << 11) | 20) & 0xFu; }
#define XB_SPIN(cond, bar) do { unsigned _sp = 0; while (cond) { __builtin_amdgcn_s_sleep(1); \
    if ((++_sp & 255u) == 0u) { if (xb_ld(&(bar)[XB_TMO])) break; if (_sp > XB_SPIN_CAP) { atomicAdd(&(bar)[XB_TMO], 1u); break; } } } } while (0)
struct XcdBarrier { unsigned* bar; unsigned x; volatile LAS unsigned* st; };
DEVI XcdBarrier xcd_barrier_post(unsigned* bar, volatile LAS unsigned* st) {
    XcdBarrier b; b.bar = bar; b.x = xb_xcc_id(); b.st = st;
    if (threadIdx.x == 0) (void)xb_add(&bar[XB_XCNT(b.x)], 1u);
    return b;
}
DEVI void xcd_barrier_complete(unsigned* bar, unsigned x, unsigned& nloc, unsigned& nx) {
    const unsigned G = gridDim.x * gridDim.y * gridDim.z;
    unsigned sum, cnt, mine, sp = 0u;
    for (;;) {
        sum = 0u; cnt = 0u; mine = 0u;
#pragma unroll
        for (unsigned j = 0; j < 16; ++j) { const unsigned c = xb_ld(&bar[XB_XCNT(j)]); sum += c; cnt += (c > 0u) ? 1u : 0u; mine = (j == x) ? c : mine; }
        if (sum == G) break;
        __builtin_amdgcn_s_sleep(1);
        if ((++sp & 255u) == 0u) { if (xb_ld(&bar[XB_TMO])) break; if (sp > XB_SPIN_CAP) { atomicAdd(&bar[XB_TMO], 1u); break; } }
    }
    nloc = mine > 0u ? mine : 1u; nx = cnt > 0u ? cnt : 1u;
}
DEVI void xcd_barrier(const XcdBarrier& b) {
    asm volatile("s_waitcnt vmcnt(0)" ::: "memory");
    __syncthreads();
    if (threadIdx.x == 0) {
        unsigned* bar = b.bar;
        __builtin_amdgcn_s_waitcnt(0);
        unsigned nloc = b.st[0], nx = b.st[1];
        if (nloc == 0u) { xcd_barrier_complete(bar, b.x, nloc, nx); b.st[0] = nloc; b.st[1] = nx; }
        const unsigned old = xb_add(&bar[XB_XSUB(b.x)], 1u);
        const unsigned gen = old / nloc;
        if (old + 1u == (gen + 1u) * nloc) {
            __builtin_amdgcn_fence(__ATOMIC_RELEASE, "agent");
            asm volatile("s_waitcnt vmcnt(0)" ::: "memory");
            const unsigned og = xb_add(&bar[XB_TOP], 1u);
            const unsigned tg = og / nx;
            if (og + 1u == (tg + 1u) * nx) xb_add(&bar[XB_TOPGEN], 1u);
            else XB_SPIN(xb_ld(&bar[XB_TOPGEN]) == tg, bar);
            __builtin_amdgcn_fence(__ATOMIC_ACQUIRE, "agent");
            xb_add(&bar[XB_XGEN(b.x)], 1u);
            asm volatile("s_waitcnt vmcnt(0)" ::: "memory");
        } else {
            XB_SPIN(xb_ld(&bar[XB_XGEN(b.x)]) == gen, bar);
            __builtin_amdgcn_fence(__ATOMIC_ACQUIRE, "agent");
            asm volatile("s_waitcnt vmcnt(0)" ::: "memory");
        }
    }
    __syncthreads();
}

constexpr int LDS_BYTES = 75 * 1024;
constexpr int LDS_BARW = LDS_BYTES - 16;
extern __shared__ __attribute__((aligned(16))) char smem_dyn[];
__global__ void __launch_bounds__(NTHR, 2) mega_fwd(Params p) {
    cg::grid_group grid = cg::this_grid();
    volatile LAS unsigned* bst = (volatile LAS unsigned*)(LAS char*)(smem_dyn + LDS_BARW);
    if (threadIdx.x < 4) bst[threadIdx.x] = 0u;
    __syncthreads();
    XcdBarrier bar = xcd_barrier_post(p.bar, bst);
    st_prep_misc(p);
    st_prep_tables(p);
    st_prep_w(p, smem_dyn);
    st_prep_wsub(p, smem_dyn);
    st_prep_x(p, smem_dyn);
    grid.sync();
    st_gemm(p.xb, p.W1t, NPJ, 1024, smem_dyn, EpiProj{p.proj, p.rs1});
    xcd_barrier(bar);
    st_conv_qk(p, smem_dyn);
    xcd_barrier(bar);
    st_recur(p, smem_dyn);
    xcd_barrier(bar);
    st_gate(p);
    xcd_barrier(bar);
    st_gemm(p.yb, p.W2t, 1024, 1024, smem_dyn, EpiX1{p.x, p.out});
    xcd_barrier(bar);
    st_norm2(p);
    xcd_barrier(bar);
    st_gemm(p.x1b, p.Wsubt, 2048, 1024, smem_dyn, EpiSub{p.sub, p.rs2});
    xcd_barrier(bar);
    st_topk(p);
    xcd_barrier(bar);
    st_experts(p);
}

extern "C" void kernel_launch(void* const* d_in, const int* in_sizes, int n_in, void* d_out, int out_size, void* d_ws, size_t ws_size,
                              hipStream_t stream) {
    Params p{};
    const float* const* in = (const float* const*)d_in;
    p.x = in[0]; p.norm1_g = in[1]; p.w_in = in[2]; p.ret_norm_g = in[3]; p.m_conv_w = in[4]; p.m_conv_b = in[5]; p.m_wq = in[6]; p.m_wk = in[7];
    p.m_b_i = in[8]; p.m_b_f = in[9]; p.m_norm_g = in[10]; p.m_skip = in[11]; p.w_out = in[12]; p.norm2_g = in[13]; p.peer_wq = in[14];
    p.peer_keys = in[15]; p.peer_down = in[16]; p.peer_up = in[17]; p.final_g = in[18];
    p.out = (float*)d_out;
    char* ws = (char*)d_ws;
    size_t off = 0;
    auto take = [&](size_t bytes) { char* r = ws + off; off += (bytes + 255) & ~(size_t)255; return r; };
    p.proj = (bf16_t*)take((size_t)T_TOK * NPJ * 2);
    p.xb = (bf16_t*)take((size_t)T_TOK * 1024 * 2);
    p.yb = p.xb;
    p.sub = (float*)ws;
    p.gate = (float*)(ws + (size_t)T_TOK * 2048 * 4);
    p.mq = (bf16_t*)take((size_t)T_TOK * 512 * 2);
    p.mk = (bf16_t*)take((size_t)T_TOK * 512 * 2);
    p.x1b = p.mq;
    p.cbuf = (bf16_t*)take((size_t)T_TOK * 512 * 2);
    p.eidx = (int*)p.cbuf;
    p.down_q = (unsigned char*)take((size_t)16384 * 1024);
    p.up_q = (unsigned char*)take((size_t)16384 * 1024);
    p.dscale = (float*)take(16384 * 4);
    p.uscale = (float*)take(16384 * 4);
    p.bar = (unsigned*)take(XCD_BAR_WORDS * 4);
    p.W1t = (bf16_t*)take((size_t)NPJ * 1024 * 2);
    p.W2t = (bf16_t*)take((size_t)1024 * 1024 * 2);
    p.Wsubt = (bf16_t*)take((size_t)2048 * 1024 * 2);
    p.Wqt = (bf16_t*)take(4 * 128 * 128 * 2);
    p.Wkt = (bf16_t*)take(4 * 128 * 128 * 2);
    p.rs1 = (float*)take(T_TOK * 4);
    p.rs2 = (float*)take(T_TOK * 4);
    p.ipre = (float*)take(T_TOK * 4 * 4);
    p.logf = (float*)take(T_TOK * 4 * 4);
    p.rope_cos = (float*)take(2048 * 64 * 4);
    p.rope_sin = (float*)take(2048 * 64 * 4);
    if (off > ws_size) { fprintf(stderr, "kernel_launch: workspace too small (%zu > %zu)\n", off, ws_size); return; }

    static int grid_blocks = 0;
    if (!grid_blocks) {
        int dev = 0, cus = 0, per_cu = 0;
        (void)hipGetDevice(&dev);
        (void)hipDeviceGetAttribute(&cus, hipDeviceAttributeMultiprocessorCount, dev);
        (void)hipFuncSetAttribute((const void*)mega_fwd, hipFuncAttributeMaxDynamicSharedMemorySize, LDS_BYTES);
        (void)hipOccupancyMaxActiveBlocksPerMultiprocessor(&per_cu, (const void*)mega_fwd, NTHR, LDS_BYTES);
        if (per_cu > 2) per_cu = 2;
        if (per_cu < 1) per_cu = 1;
        grid_blocks = cus * per_cu;
    }
    (void)hipMemsetAsync(p.bar, 0, XCD_BAR_WORDS * 4, stream);
    void* args[] = {&p};
    hipError_t e = hipLaunchCooperativeKernel((const void*)mega_fwd, dim3(grid_blocks), dim3(NTHR), args, LDS_BYTES, stream);
    if (e != hipSuccess) fprintf(stderr, "cooperative launch failed: %s (grid %d)\n", hipGetErrorString(e), grid_blocks);
}
```

```cpp
#include <hip/hip_runtime.h>
#include <hip/hip_cooperative_groups.h>
#include <stdint.h>
#include <cstdio>
namespace cg = cooperative_groups;

typedef unsigned short bf16_t;
typedef short bf16x8 __attribute__((ext_vector_type(8)));
typedef float f32x4 __attribute__((ext_vector_type(4)));

#define DEVI __device__ __forceinline__

constexpr int T_TOK = 32768, DM = 1024, NPJ = 3584, DIN = 3592;
constexpr int NTHR = 256;
constexpr float EPSN = 1e-6f;

struct Params {
    const float *x, *norm1_g, *w_in, *ret_norm_g, *m_conv_w, *m_conv_b, *m_wq, *m_wk, *m_b_i, *m_b_f, *m_norm_g, *m_skip, *w_out,
        *norm2_g, *peer_wq, *peer_keys, *peer_down, *peer_up, *final_g;
    float* out;
    bf16_t *proj, *xb, *yb, *mq, *mk, *x1b, *cbuf, *W1t, *W2t, *Wsubt, *Wqt, *Wkt;
    unsigned char *down_q, *up_q;
    float *dscale, *uscale;
    unsigned* bar;
    float *rs1, *rs2, *ipre, *logf, *rope_cos, *rope_sin, *sub, *gate;
    int* eidx;
    int pad_[2];
};

DEVI unsigned f2bf_bits(float f) { unsigned u = __float_as_uint(f); return (u + 0x7fffu + ((u >> 16) & 1u)) >> 16; }
DEVI bf16_t f2bf(float f) { return (bf16_t)f2bf_bits(f); }
DEVI unsigned pk2(float lo, float hi) { return f2bf_bits(lo) | (f2bf_bits(hi) << 16); }
DEVI float bflo(unsigned w) { return __uint_as_float(w << 16); }
DEVI float bfhi(unsigned w) { return __uint_as_float(w & 0xffff0000u); }
DEVI float bf2f(bf16_t h) { return __uint_as_float(((unsigned)h) << 16); }
DEVI float wave_sum(float v) {
#pragma unroll
    for (int o = 32; o; o >>= 1) v += __shfl_xor(v, o);
    return v;
}
DEVI float wave_max(float v) {
#pragma unroll
    for (int o = 32; o; o >>= 1) v = fmaxf(v, __shfl_xor(v, o));
    return v;
}
DEVI f32x4 mfma16(bf16x8 a, bf16x8 b, f32x4 c) { return __builtin_amdgcn_mfma_f32_16x16x32_bf16(a, b, c, 0, 0, 0); }
DEVI bf16x8 ld8(const char* p) { return *reinterpret_cast<const bf16x8*>(p); }
DEVI bf16x8 mk8(uint2 lo, uint2 hi) {
    union { uint4 u; bf16x8 v; } x;
    x.u = make_uint4(lo.x, lo.y, hi.x, hi.y);
    return x.v;
}
DEVI float sigmoidf_(float z) { return 1.f / (1.f + __expf(-z)); }

DEVI void st_prep_misc(const Params& p) {
    const int gtid = blockIdx.x * NTHR + threadIdx.x, gsz = gridDim.x * NTHR;
    for (int i = gtid; i < 2048 * 64; i += gsz) {
        const int pos = i >> 6, j = i & 63;
        const float inv = powf(10000.f, -(float)j * (1.f / 64.f));
        const float ang = (float)pos * inv;
        float s, c;
        sincosf(ang, &s, &c);
        p.rope_cos[i] = c;
        p.rope_sin[i] = s;
    }
    for (int i = gtid; i < 4 * 128 * 128; i += gsz) {
        const int h = i >> 14, e = (i >> 7) & 127, d = i & 127;
        p.Wqt[i] = f2bf(p.m_wq[h * 16384 + d * 128 + e]);
        p.Wkt[i] = f2bf(p.m_wk[h * 16384 + d * 128 + e] * 0.08838834764831845f);
    }
}
DEVI void st_prep_tables(const Params& p) {
    const int lane = threadIdx.x & 63, wid = threadIdx.x >> 6;
    for (int row = blockIdx.x * 4 + wid; row < 32768; row += gridDim.x * 4) {
        const bool up = row >= 16384;
        const int e = up ? row - 16384 : row;
        const float4* s = (const float4*)((up ? p.peer_up : p.peer_down) + (size_t)e * 1024 + lane * 16);
        float4 v[4];
        float am = 0.f;
#pragma unroll
        for (int i = 0; i < 4; ++i) {
            v[i] = s[i];
            am = fmaxf(am, fmaxf(fmaxf(fabsf(v[i].x), fabsf(v[i].y)), fmaxf(fabsf(v[i].z), fabsf(v[i].w))));
        }
        am = wave_max(am);
        const float sc = am > 0.f ? am * (1.f / 127.f) : 1.f, inv = am > 0.f ? 127.f / am : 0.f;
        const int ofs = up ? 128 : 0;
        unsigned w[4];
#pragma unroll
        for (int i = 0; i < 4; ++i) {
            const int q0 = (int)rintf(v[i].x * inv) + ofs, q1 = (int)rintf(v[i].y * inv) + ofs, q2 = (int)rintf(v[i].z * inv) + ofs, q3 = (int)rintf(v[i].w * inv) + ofs;
            w[i] = (unsigned)(q0 & 255) | ((unsigned)(q1 & 255) << 8) | ((unsigned)(q2 & 255) << 16) | ((unsigned)(q3 & 255) << 24);
        }
        ((uint4*)((up ? p.up_q : p.down_q) + (size_t)e * 1024))[lane] = make_uint4(w[0], w[1], w[2], w[3]);
        if (lane == 0) (up ? p.uscale : p.dscale)[e] = sc;
    }
}

DEVI void transpose_tile(const float* __restrict__ src, int ld, const float* __restrict__ scale, bf16_t* __restrict__ dst, int K, int k0, int n0,
                         float* tile) {
    const int tx = threadIdx.x & 31, ty = threadIdx.x >> 5;
#pragma unroll
    for (int i = 0; i < 4; ++i) {
        const int k = k0 + ty + 8 * i;
        float v = src[(size_t)k * ld + n0 + tx];
        if (scale) v *= scale[k];
        tile[(ty + 8 * i) * 33 + tx] = v;
    }
    __syncthreads();
#pragma unroll
    for (int i = 0; i < 4; ++i) {
        const int n = n0 + ty + 8 * i;
        dst[(size_t)n * K + k0 + tx] = f2bf(tile[tx * 33 + ty + 8 * i]);
    }
    __syncthreads();
}
DEVI void st_prep_w(const Params& p, char* smem) {
    float* tile = (float*)smem;
    constexpr int N1 = (NPJ / 32) * 32, N2 = 32 * 32;
    for (int it = blockIdx.x; it < N1 + N2; it += gridDim.x) {
        if (it < N1) {
            const int nt = it >> 5, kt = it & 31;
            transpose_tile(p.w_in, DIN, p.norm1_g, p.W1t, 1024, kt * 32, nt * 32, tile);
        } else {
            const int r = it - N1, nt = r >> 5, kt = r & 31;
            transpose_tile(p.w_out, 1024, nullptr, p.W2t, 1024, kt * 32, nt * 32, tile);
        }
    }
}
DEVI void st_prep_wsub(const Params& p, char* smem) {
    float* wq_s = (float*)smem;
    float* key_s = wq_s + 32 * 129 + 16;
    const int tid = threadIdx.x;
    for (int it = blockIdx.x; it < 16 * 32 * 2; it += gridDim.x) {
        const int grp = it >> 6, kt = (it >> 1) & 31, nh = it & 1, k0 = kt * 32;
#pragma unroll
        for (int i = 0; i < 16; ++i) {
            const int idx = tid + 256 * i, r = idx >> 7, d = idx & 127;
            wq_s[r * 129 + d] = p.peer_wq[(size_t)(k0 + r) * 2048 + grp * 128 + d];
        }
#pragma unroll
        for (int i = 0; i < 32; ++i) {
            const int idx = tid + 256 * i, n = idx >> 7, d = idx & 127;
            key_s[n * 128 + d] = p.peer_keys[((size_t)grp * 128 + nh * 64 + n) * 128 + d];
        }
        __syncthreads();
        const int kl = tid & 31, ng = tid >> 5;
        float acc[8];
#pragma unroll
        for (int i = 0; i < 8; ++i) acc[i] = 0.f;
        for (int d = 0; d < 128; ++d) {
            const float a = wq_s[kl * 129 + d];
#pragma unroll
            for (int i = 0; i < 8; ++i) acc[i] += a * key_s[(ng * 8 + i) * 128 + d];
        }
        const float g = p.norm2_g[k0 + kl];
#pragma unroll
        for (int i = 0; i < 8; ++i) p.Wsubt[(size_t)(grp * 128 + nh * 64 + ng * 8 + i) * 1024 + k0 + kl] = f2bf(acc[i] * g);
        __syncthreads();
    }
}

DEVI void st_prep_x(const Params& p, char* smem) {
    float* Wg_s = (float*)smem;
    for (int i = threadIdx.x; i < 8192; i += NTHR) {
        const int k = i >> 3, g = i & 7;
        Wg_s[g * 1024 + k] = p.norm1_g[k] * p.w_in[(size_t)k * DIN + NPJ + g];
    }
    __syncthreads();
    const int lane = threadIdx.x & 63, wid = threadIdx.x >> 6;
    for (int t = blockIdx.x * 4 + wid; t < T_TOK; t += gridDim.x * 4) {
        const float4* xr = (const float4*)(p.x + (size_t)t * 1024);
        float4 v[4];
        float ss = 0.f, g8[8];
#pragma unroll
        for (int g = 0; g < 8; ++g) g8[g] = 0.f;
#pragma unroll
        for (int j = 0; j < 4; ++j) {
            v[j] = xr[lane + 64 * j];
            ss += v[j].x * v[j].x + v[j].y * v[j].y + v[j].z * v[j].z + v[j].w * v[j].w;
#pragma unroll
            for (int g = 0; g < 8; ++g) {
                const float4 w = *(const float4*)(Wg_s + g * 1024 + (lane + 64 * j) * 4);
                g8[g] += v[j].x * w.x + v[j].y * w.y + v[j].z * w.z + v[j].w * w.w;
            }
        }
        ss = wave_sum(ss);
#pragma unroll
        for (int g = 0; g < 8; ++g) g8[g] = wave_sum(g8[g]);
        const float rs = rsqrtf(ss * (1.f / 1024.f) + EPSN);
        uint2* o = (uint2*)(p.xb + (size_t)t * 1024);
#pragma unroll
        for (int j = 0; j < 4; ++j) o[lane + 64 * j] = make_uint2(pk2(v[j].x, v[j].y), pk2(v[j].z, v[j].w));
        if (lane == 0) {
            p.rs1[t] = rs;
#pragma unroll
            for (int h = 0; h < 4; ++h) {
                p.ipre[t * 4 + h] = g8[h] * rs + p.m_b_i[h];
                const float z = g8[4 + h] * rs + p.m_b_f[h];
                p.logf[t * 4 + h] = fminf(z, 0.f) - log1pf(__expf(-fabsf(z)));
            }
        }
    }
}

constexpr int G_LDS_ROW = 144;
constexpr int G_LDS_MAT = 128 * G_LDS_ROW;
constexpr int G_LDS_BYTES = 4 * G_LDS_MAT;

template <class Epi>
DEVI void gemm_tile(const bf16_t* __restrict__ A, const bf16_t* __restrict__ Bt, int K, int m0, int n0, char* smem, const Epi& epi) {
    const int tid = threadIdx.x, lane = tid & 63, wid = tid >> 6, wr = wid >> 1, wc = wid & 1, fr = lane & 15, fq = lane >> 4;
    f32x4 acc[4][4];
#pragma unroll
    for (int i = 0; i < 4; ++i)
#pragma unroll
        for (int j = 0; j < 4; ++j) acc[i][j] = (f32x4){0.f, 0.f, 0.f, 0.f};
    uint4 ra[4], rb[4];
    const int nt = K / 64;
    auto gload = [&](int kt) {
#pragma unroll
        for (int i = 0; i < 4; ++i) {
            const int id = tid + 256 * i, r = id >> 3, c = id & 7;
            ra[i] = *(const uint4*)(A + (size_t)(m0 + r) * K + kt * 64 + c * 8);
            rb[i] = *(const uint4*)(Bt + (size_t)(n0 + r) * K + kt * 64 + c * 8);
        }
    };
    auto swrite = [&](int buf) {
        char* As = smem + buf * 2 * G_LDS_MAT;
        char* Bs = As + G_LDS_MAT;
#pragma unroll
        for (int i = 0; i < 4; ++i) {
            const int id = tid + 256 * i, r = id >> 3, c = id & 7;
            *(uint4*)(As + r * G_LDS_ROW + c * 16) = ra[i];
            *(uint4*)(Bs + r * G_LDS_ROW + c * 16) = rb[i];
        }
    };
    gload(0);
    swrite(0);
    __syncthreads();
    for (int kt = 0; kt < nt; ++kt) {
        if (kt + 1 < nt) gload(kt + 1);
        const char* As = smem + (kt & 1) * 2 * G_LDS_MAT;
        const char* Bs = As + G_LDS_MAT;
#pragma unroll
        for (int kk = 0; kk < 2; ++kk) {
            bf16x8 a[4], b[4];
#pragma unroll
            for (int i = 0; i < 4; ++i) a[i] = ld8(As + (wr * 64 + i * 16 + fr) * G_LDS_ROW + (kk * 4 + fq) * 16);
#pragma unroll
            for (int j = 0; j < 4; ++j) b[j] = ld8(Bs + (wc * 64 + j * 16 + fr) * G_LDS_ROW + (kk * 4 + fq) * 16);
#pragma unroll
            for (int i = 0; i < 4; ++i)
#pragma unroll
                for (int j = 0; j < 4; ++j) acc[i][j] = mfma16(b[j], a[i], acc[i][j]);
        }
        if (kt + 1 < nt) swrite((kt + 1) & 1);
        __syncthreads();
    }
#pragma unroll
    for (int i = 0; i < 4; ++i)
#pragma unroll
        for (int j = 0; j < 4; ++j) epi(acc[i][j], m0 + wr * 64 + i * 16 + fr, n0 + wc * 64 + j * 16 + 4 * fq);
}
struct EpiProj {
    bf16_t* proj; const float* rs1;
    DEVI void operator()(const f32x4& v, int m, int n) const {
        const float s = rs1[m];
        *(uint2*)(proj + (size_t)m * NPJ + n) = make_uint2(pk2(v[0] * s, v[1] * s), pk2(v[2] * s, v[3] * s));
    }
};
struct EpiX1 {
    const float* x; float* out;
    DEVI void operator()(const f32x4& v, int m, int n) const {
        const float4 xv = *(const float4*)(x + (size_t)m * 1024 + n);
        *(float4*)(out + (size_t)m * 1024 + n) = make_float4(xv.x + v[0], xv.y + v[1], xv.z + v[2], xv.w + v[3]);
    }
};
struct EpiSub {
    float* sub; const float* rs2;
    DEVI void operator()(const f32x4& v, int m, int n) const {
        const float s = rs2[m];
        *(float4*)(sub + (size_t)m * 2048 + n) = make_float4(v[0] * s, v[1] * s, v[2] * s, v[3] * s);
    }
};
template <class Epi>
DEVI void st_gemm(const bf16_t* A, const bf16_t* Bt, int N, int K, char* smem, const Epi& epi) {
    const int nN = N / 128, ntile = (T_TOK / 128) * nN;
    for (int it = blockIdx.x; it < ntile; it += gridDim.x) {
        const int pm = it / nN, pn = it - pm * nN;
        gemm_tile(A, Bt, K, pm * 128, pn * 128, smem, epi);
    }
}

DEVI void st_conv_qk(const Params& p, char* smem) {
    char* cs = smem;
    char* ws = smem + 128 * 272;
    const int tid = threadIdx.x, lane = tid & 63, wid = tid >> 6, wr = wid >> 1, wc = wid & 1, fr = lane & 15, fq = lane >> 4;
    for (int it = blockIdx.x; it < 256 * 4; it += gridDim.x) {
        const int h = it & 3, t0 = (it >> 2) * 128, s0 = t0 & 2047;
        {
            const int ch = tid & 127, r0 = (tid >> 7) * 64;
            const int col = 2048 + h * 128 + ch;
            const float w0 = p.m_conv_w[0 * 512 + h * 128 + ch], w1 = p.m_conv_w[1 * 512 + h * 128 + ch], w2 = p.m_conv_w[2 * 512 + h * 128 + ch],
                        w3 = p.m_conv_w[3 * 512 + h * 128 + ch], bb = p.m_conv_b[h * 128 + ch];
            float xm3 = 0.f, xm2 = 0.f, xm1 = 0.f;
            if (s0 + r0 > 0) {
                xm3 = bf2f(p.proj[(size_t)(t0 + r0 - 3) * NPJ + col]);
                xm2 = bf2f(p.proj[(size_t)(t0 + r0 - 2) * NPJ + col]);
                xm1 = bf2f(p.proj[(size_t)(t0 + r0 - 1) * NPJ + col]);
            }
            for (int r = r0; r < r0 + 64; ++r) {
                const float xc = bf2f(p.proj[(size_t)(t0 + r) * NPJ + col]);
                const float y = bb + w0 * xm3 + w1 * xm2 + w2 * xm1 + w3 * xc;
                const float c = y * sigmoidf_(y);
                const bf16_t cb = f2bf(c);
                *(bf16_t*)(cs + r * 272 + ch * 2) = cb;
                p.cbuf[(size_t)(t0 + r) * 512 + h * 128 + ch] = cb;
                xm3 = xm2; xm2 = xm1; xm1 = xc;
            }
        }
#pragma unroll
        for (int which = 0; which < 2; ++which) {
            const bf16_t* W = (which ? p.Wkt : p.Wqt) + h * 16384;
            bf16_t* O = which ? p.mk : p.mq;
#pragma unroll
            for (int i = 0; i < 8; ++i) {
                const int id = tid + 256 * i, r = id >> 4, c = id & 15;
                *(uint4*)(ws + r * 272 + c * 16) = *(const uint4*)(W + r * 128 + c * 8);
            }
            __syncthreads();
            f32x4 acc[4][4];
#pragma unroll
            for (int i = 0; i < 4; ++i)
#pragma unroll
                for (int j = 0; j < 4; ++j) acc[i][j] = (f32x4){0.f, 0.f, 0.f, 0.f};
#pragma unroll
            for (int ks = 0; ks < 4; ++ks) {
                bf16x8 a[4], b[4];
#pragma unroll
                for (int i = 0; i < 4; ++i) a[i] = ld8(cs + (wr * 64 + i * 16 + fr) * 272 + (ks * 4 + fq) * 16);
#pragma unroll
                for (int j = 0; j < 4; ++j) b[j] = ld8(ws + (wc * 64 + j * 16 + fr) * 272 + (ks * 4 + fq) * 16);
#pragma unroll
                for (int i = 0; i < 4; ++i)
#pragma unroll
                    for (int j = 0; j < 4; ++j) acc[i][j] = mfma16(b[j], a[i], acc[i][j]);
            }
#pragma unroll
            for (int i = 0; i < 4; ++i)
#pragma unroll
                for (int j = 0; j < 4; ++j) {
                    const int m = t0 + wr * 64 + i * 16 + fr, n = h * 128 + wc * 64 + j * 16 + 4 * fq;
                    const f32x4 v = acc[i][j];
                    *(uint2*)(O + (size_t)m * 512 + n) = make_uint2(pk2(v[0], v[1]), pk2(v[2], v[3]));
                }
            __syncthreads();
        }
    }
}

DEVI void ret_item(const Params& p, char* smem, int b, int h, int vh) {
    char* qs = smem;
    char* ks = smem + 17408;
    char* kTs = smem + 34816;
    char* vTs = smem + 53248;
    char* Ss = smem + 62464;
    const int tid = threadIdx.x, lane = tid & 63, w = tid >> 6, fr = lane & 15, fq = lane >> 4;
    const float gamma = 1.f - exp2f(-5.f - (float)h);
    const float l2g = log2f(gamma);
    const float g64 = exp2f(l2g * 64.f);
    f32x4 st[8];
#pragma unroll
    for (int i = 0; i < 8; ++i) st[i] = (f32x4){0.f, 0.f, 0.f, 0.f};
    for (int c = 0; c < 32; ++c) {
        const int t0 = b * 2048 + c * 64;
#pragma unroll
        for (int i = 0; i < 2; ++i) {
            const int u = tid + 256 * i, m = u >> 3, j0 = (u & 7) * 8;
            const int pos = c * 64 + m;
            const float4 c0 = *(const float4*)(p.rope_cos + pos * 64 + j0), c1 = *(const float4*)(p.rope_cos + pos * 64 + j0 + 4);
            const float4 s0 = *(const float4*)(p.rope_sin + pos * 64 + j0), s1 = *(const float4*)(p.rope_sin + pos * 64 + j0 + 4);
            const float cs_[8] = {c0.x, c0.y, c0.z, c0.w, c1.x, c1.y, c1.z, c1.w};
            const float sn_[8] = {s0.x, s0.y, s0.z, s0.w, s1.x, s1.y, s1.z, s1.w};
            const bf16_t* row = p.proj + (size_t)(t0 + m) * NPJ + h * 128 + j0;
            {
                const uint4 a = *(const uint4*)(row), bq = *(const uint4*)(row + 64);
                const unsigned aw[4] = {a.x, a.y, a.z, a.w}, bw[4] = {bq.x, bq.y, bq.z, bq.w};
                unsigned o1[4], o2[4];
#pragma unroll
                for (int e = 0; e < 4; ++e) {
                    const float t1a = bflo(aw[e]), t1b = bfhi(aw[e]), t2a = bflo(bw[e]), t2b = bfhi(bw[e]);
                    o1[e] = pk2(t1a * cs_[2 * e] - t2a * sn_[2 * e], t1b * cs_[2 * e + 1] - t2b * sn_[2 * e + 1]);
                    o2[e] = pk2(t1a * sn_[2 * e] + t2a * cs_[2 * e], t1b * sn_[2 * e + 1] + t2b * cs_[2 * e + 1]);
                }
                *(uint4*)(qs + m * 272 + j0 * 2) = make_uint4(o1[0], o1[1], o1[2], o1[3]);
                *(uint4*)(qs + m * 272 + (64 + j0) * 2) = make_uint4(o2[0], o2[1], o2[2], o2[3]);
            }
            {
                const uint4 a = *(const uint4*)(row + 512), bq = *(const uint4*)(row + 512 + 64);
                const unsigned aw[4] = {a.x, a.y, a.z, a.w}, bw[4] = {bq.x, bq.y, bq.z, bq.w};
                const float kd = exp2f(l2g * (float)(63 - m));
                const float sc = 0.08838834764831845f;
                unsigned o1[4], o2[4];
#pragma unroll
                for (int e = 0; e < 4; ++e) {
                    const float t1a = bflo(aw[e]), t1b = bfhi(aw[e]), t2a = bflo(bw[e]), t2b = bfhi(bw[e]);
                    const float r1a = (t1a * cs_[2 * e] - t2a * sn_[2 * e]) * sc, r1b = (t1b * cs_[2 * e + 1] - t2b * sn_[2 * e + 1]) * sc;
                    const float r2a = (t1a * sn_[2 * e] + t2a * cs_[2 * e]) * sc, r2b = (t1b * sn_[2 * e + 1] + t2b * cs_[2 * e + 1]) * sc;
                    o1[e] = pk2(r1a, r1b);
                    o2[e] = pk2(r2a, r2b);
                    *(bf16_t*)(kTs + (j0 + 2 * e) * 144 + m * 2) = f2bf(r1a * kd);
                    *(bf16_t*)(kTs + (j0 + 2 * e + 1) * 144 + m * 2) = f2bf(r1b * kd);
                    *(bf16_t*)(kTs + (64 + j0 + 2 * e) * 144 + m * 2) = f2bf(r2a * kd);
                    *(bf16_t*)(kTs + (64 + j0 + 2 * e + 1) * 144 + m * 2) = f2bf(r2b * kd);
                }
                *(uint4*)(ks + m * 272 + j0 * 2) = make_uint4(o1[0], o1[1], o1[2], o1[3]);
                *(uint4*)(ks + m * 272 + (64 + j0) * 2) = make_uint4(o2[0], o2[1], o2[2], o2[3]);
            }
            {
                const uint4 a = *(const uint4*)(p.proj + (size_t)(t0 + m) * NPJ + 1024 + h * 128 + vh * 64 + j0);
                const unsigned aw[4] = {a.x, a.y, a.z, a.w};
#pragma unroll
                for (int e = 0; e < 4; ++e) {
                    *(bf16_t*)(vTs + (j0 + 2 * e) * 144 + m * 2) = (bf16_t)(aw[e] & 0xffffu);
                    *(bf16_t*)(vTs + (j0 + 2 * e + 1) * 144 + m * 2) = (bf16_t)(aw[e] >> 16);
                }
            }
        }
        __syncthreads();
        {
            bf16x8 qf[4];
#pragma unroll
            for (int s = 0; s < 4; ++s) qf[s] = ld8(qs + (16 * w + fr) * 272 + (s * 4 + fq) * 16);
#pragma unroll
            for (int j = 0; j < 4; ++j) {
                f32x4 a = (f32x4){0.f, 0.f, 0.f, 0.f};
#pragma unroll
                for (int s = 0; s < 4; ++s) a = mfma16(ld8(ks + (16 * j + fr) * 272 + (s * 4 + fq) * 16), qf[s], a);
                const int l = 16 * w + fr, mb = 16 * j + 4 * fq;
                float v[4];
#pragma unroll
                for (int r = 0; r < 4; ++r) {
                    const int dd = l - (mb + r);
                    v[r] = a[r] * exp2f(l2g * (float)(dd < 0 ? -dd : dd));
                }
                *(uint2*)(Ss + l * 144 + mb * 2) = make_uint2(pk2(v[0], v[1]), pk2(v[2], v[3]));
            }
        }
        __syncthreads();
        {
            bf16x8 sp[4];
#pragma unroll
            for (int s = 0; s < 4; ++s)
                sp[s] = mk8(make_uint2(pk2(st[2 * s][0], st[2 * s][1]), pk2(st[2 * s][2], st[2 * s][3])),
                            make_uint2(pk2(st[2 * s + 1][0], st[2 * s + 1][1]), pk2(st[2 * s + 1][2], st[2 * s + 1][3])));
            bf16x8 vf[2];
#pragma unroll
            for (int s2 = 0; s2 < 2; ++s2) vf[s2] = ld8(vTs + (16 * w + fr) * 144 + (s2 * 4 + fq) * 16);
#pragma unroll
            for (int i = 0; i < 4; ++i) {
                f32x4 a = (f32x4){0.f, 0.f, 0.f, 0.f};
                const char* qrow = qs + (16 * i + fr) * 272;
#pragma unroll
                for (int s = 0; s < 4; ++s) {
                    const uint2 lo = *(const uint2*)(qrow + (32 * s + 4 * fq) * 2), hi = *(const uint2*)(qrow + (32 * s + 16 + 4 * fq) * 2);
                    a = mfma16(sp[s], mk8(lo, hi), a);
                }
                const float qd = exp2f(l2g * (float)(16 * i + fr + 1));
                a = a * qd;
#pragma unroll
                for (int s2 = 0; s2 < 2; ++s2) a = mfma16(vf[s2], ld8(Ss + (16 * i + fr) * 144 + (s2 * 4 + fq) * 16), a);
                *(uint2*)(p.proj + (size_t)(t0 + 16 * i + fr) * NPJ + 1024 + h * 128 + vh * 64 + 16 * w + 4 * fq) =
                    make_uint2(pk2(a[0], a[1]), pk2(a[2], a[3]));
            }
#pragma unroll
            for (int i = 0; i < 8; ++i) {
                f32x4 a = st[i] * g64;
#pragma unroll
                for (int s2 = 0; s2 < 2; ++s2) a = mfma16(ld8(kTs + (16 * i + fr) * 144 + (s2 * 4 + fq) * 16), vf[s2], a);
                st[i] = a;
            }
        }
        __syncthreads();
    }
}

DEVI void mlstm_item(const Params& p, char* smem, int b, int h, int vh) {
    char* qs = smem;
    char* kTs = smem + 17408;
    char* vTs = smem + 35840;
    float* n_s = (float*)(smem + 45056);
    float* qn_s = (float*)(smem + 45568);
    float* den_s = (float*)(smem + 46592);
    const int tid = threadIdx.x, lane = tid & 63, w = tid >> 6, fr = lane & 15, fq = lane >> 4;
    f32x4 st[8];
#pragma unroll
    for (int i = 0; i < 8; ++i) st[i] = (f32x4){0.f, 0.f, 0.f, 0.f};
    float m_run = 0.f, n_reg = 0.f;
    for (int c = 0; c < 32; ++c) {
        const int t0 = b * 2048 + c * 64;
        const float iv = p.ipre[(t0 + lane) * 4 + h], fv = p.logf[(t0 + lane) * 4 + h];
        float fcum = fv;
#pragma unroll
        for (int o = 1; o < 64; o <<= 1) {
            const float tv = __shfl_up(fcum, o);
            if (lane >= o) fcum += tv;
        }
        const float a_c = __shfl(fcum, 63);
        const float logw = a_c - fcum + iv;
        const float m_in = wave_max(logw);
        const float m_new = fmaxf(a_c + m_run, m_in);
        const float decay = __expf(a_c + m_run - m_new);
        const float wgt = __expf(logw - m_new);
        const float emn = __expf(-m_new);
        m_run = m_new;
#pragma unroll
        for (int i = 0; i < 4; ++i) {
            const int u = tid + 256 * i, m = u >> 4, j0 = (u & 15) * 8;
            *(uint4*)(qs + m * 272 + j0 * 2) = *(const uint4*)(p.mq + (size_t)(t0 + m) * 512 + h * 128 + j0);
            const uint4 kk = *(const uint4*)(p.mk + (size_t)(t0 + m) * 512 + h * 128 + j0);
            const float wm = __shfl(wgt, m);
            const unsigned kw[4] = {kk.x, kk.y, kk.z, kk.w};
#pragma unroll
            for (int e = 0; e < 4; ++e) {
                *(bf16_t*)(kTs + (j0 + 2 * e) * 144 + m * 2) = f2bf(bflo(kw[e]) * wm);
                *(bf16_t*)(kTs + (j0 + 2 * e + 1) * 144 + m * 2) = f2bf(bfhi(kw[e]) * wm);
            }
        }
#pragma unroll
        for (int i = 0; i < 2; ++i) {
            const int u = tid + 256 * i, m = u >> 3, j0 = (u & 7) * 8;
            const uint4 a = *(const uint4*)(p.proj + (size_t)(t0 + m) * NPJ + 2560 + h * 128 + vh * 64 + j0);
            const unsigned aw[4] = {a.x, a.y, a.z, a.w};
#pragma unroll
            for (int e = 0; e < 4; ++e) {
                *(bf16_t*)(vTs + (j0 + 2 * e) * 144 + m * 2) = (bf16_t)(aw[e] & 0xffffu);
                *(bf16_t*)(vTs + (j0 + 2 * e + 1) * 144 + m * 2) = (bf16_t)(aw[e] >> 16);
            }
        }
        __syncthreads();
        if (tid < 128) {
            float s = 0.f;
#pragma unroll
            for (int q = 0; q < 8; ++q) {
                const uint4 a = *(const uint4*)(kTs + tid * 144 + q * 16);
                s += (bflo(a.x) + bfhi(a.x)) + (bflo(a.y) + bfhi(a.y)) + (bflo(a.z) + bfhi(a.z)) + (bflo(a.w) + bfhi(a.w));
            }
            n_reg = decay * n_reg + s;
            n_s[tid] = n_reg;
        }
        {
            bf16x8 vf[2];
#pragma unroll
            for (int s2 = 0; s2 < 2; ++s2) vf[s2] = ld8(vTs + (16 * w + fr) * 144 + (s2 * 4 + fq) * 16);
#pragma unroll
            for (int i = 0; i < 8; ++i) {
                f32x4 a = st[i] * decay;
#pragma unroll
                for (int s2 = 0; s2 < 2; ++s2) a = mfma16(ld8(kTs + (16 * i + fr) * 144 + (s2 * 4 + fq) * 16), vf[s2], a);
                st[i] = a;
            }
        }
        __syncthreads();
        {
            const int l = tid & 63, part = tid >> 6;
            float s = 0.f;
#pragma unroll
            for (int q = 0; q < 8; ++q) {
                const uint2 a = *(const uint2*)(qs + l * 272 + (part * 32 + 4 * q) * 2);
                const float* nn = n_s + part * 32 + 4 * q;
                s += bflo(a.x) * nn[0] + bfhi(a.x) * nn[1] + bflo(a.y) * nn[2] + bfhi(a.y) * nn[3];
            }
            qn_s[part * 64 + l] = s;
        }
        __syncthreads();
        if (tid < 64) den_s[tid] = fmaxf(fabsf(qn_s[tid] + qn_s[64 + tid] + qn_s[128 + tid] + qn_s[192 + tid]), emn);
        __syncthreads();
        {
            bf16x8 sp[4];
#pragma unroll
            for (int s = 0; s < 4; ++s)
                sp[s] = mk8(make_uint2(pk2(st[2 * s][0], st[2 * s][1]), pk2(st[2 * s][2], st[2 * s][3])),
                            make_uint2(pk2(st[2 * s + 1][0], st[2 * s + 1][1]), pk2(st[2 * s + 1][2], st[2 * s + 1][3])));
#pragma unroll
            for (int i = 0; i < 4; ++i) {
                f32x4 a = (f32x4){0.f, 0.f, 0.f, 0.f};
                const char* qrow = qs + (16 * i + fr) * 272;
#pragma unroll
                for (int s = 0; s < 4; ++s) {
                    const uint2 lo = *(const uint2*)(qrow + (32 * s + 4 * fq) * 2), hi = *(const uint2*)(qrow + (32 * s + 16 + 4 * fq) * 2);
                    a = mfma16(sp[s], mk8(lo, hi), a);
                }
                const float rd = 1.f / den_s[16 * i + fr];
                *(uint2*)(p.proj + (size_t)(t0 + 16 * i + fr) * NPJ + 2560 + h * 128 + vh * 64 + 16 * w + 4 * fq) =
                    make_uint2(pk2(a[0] * rd, a[1] * rd), pk2(a[2] * rd, a[3] * rd));
            }
        }
        __syncthreads();
    }
}
DEVI void st_recur(const Params& p, char* smem) {
    for (int it = blockIdx.x; it < 256; it += gridDim.x) {
        const int kind = it & 1, r = it >> 1, vh = r & 1, h = (r >> 1) & 3, b = r >> 3;
        if (kind == 0) ret_item(p, smem, b, h, vh);
        else mlstm_item(p, smem, b, h, vh);
    }
}

DEVI void st_gate(const Params& p) {
    const int lane = threadIdx.x & 63, wid = threadIdx.x >> 6;
    for (int t = blockIdx.x * 4 + wid; t < T_TOK; t += gridDim.x * 4) {
        const bf16_t* pr = p.proj + (size_t)t * NPJ;
#pragma unroll
        for (int hh = 0; hh < 8; ++hh) {
            const bool ml = hh >= 4;
            const int h = hh & 3;
            const unsigned ow = *(const unsigned*)(pr + (ml ? 2560 : 1024) + h * 128 + 2 * lane);
            const float o0 = bflo(ow), o1 = bfhi(ow);
            const float mu = wave_sum(o0 + o1) * (1.f / 128.f);
            const float d0 = o0 - mu, d1 = o1 - mu;
            const float var = wave_sum(d0 * d0 + d1 * d1) * (1.f / 128.f);
            const float rstd = rsqrtf(var + EPSN);
            const float* gn = (ml ? p.m_norm_g : p.ret_norm_g) + h * 128 + 2 * lane;
            const float n0 = d0 * rstd * gn[0], n1 = d1 * rstd * gn[1];
            const unsigned gw = *(const unsigned*)(pr + (ml ? 3072 : 1536) + h * 128 + 2 * lane);
            const float g0 = bflo(gw), g1 = bfhi(gw);
            float y0, y1;
            if (!ml) {
                y0 = g0 * sigmoidf_(g0) * n0;
                y1 = g1 * sigmoidf_(g1) * n1;
            } else {
                const unsigned cw = *(const unsigned*)(p.cbuf + (size_t)t * 512 + h * 128 + 2 * lane);
                const float* sk = p.m_skip + h * 128 + 2 * lane;
                y0 = sigmoidf_(g0) * (n0 + sk[0] * bflo(cw));
                y1 = sigmoidf_(g1) * (n1 + sk[1] * bfhi(cw));
            }
            *(unsigned*)(p.yb + (size_t)t * 1024 + hh * 128 + 2 * lane) = pk2(y0, y1);
        }
    }
}

DEVI void st_norm2(const Params& p) {
    const int lane = threadIdx.x & 63, wid = threadIdx.x >> 6;
    for (int t = blockIdx.x * 4 + wid; t < T_TOK; t += gridDim.x * 4) {
        const float4* xr = (const float4*)(p.out + (size_t)t * 1024);
        uint2* o = (uint2*)(p.x1b + (size_t)t * 1024);
        float ss = 0.f;
#pragma unroll
        for (int j = 0; j < 4; ++j) {
            const float4 v = xr[lane + 64 * j];
            ss += v.x * v.x + v.y * v.y + v.z * v.z + v.w * v.w;
            o[lane + 64 * j] = make_uint2(pk2(v.x, v.y), pk2(v.z, v.w));
        }
        ss = wave_sum(ss);
        if (lane == 0) p.rs2[t] = rsqrtf(ss * (1.f / 1024.f) + EPSN);
    }
}

DEVI int f2key(float f) { const int b = __float_as_int(f); return b ^ ((b >> 31) & 0x7fffffff); }
DEVI float key2f(int k) { return __int_as_float(k ^ ((k >> 31) & 0x7fffffff)); }
template <int N> DEVI void bsort_desc(int (&v)[N]) {
#pragma unroll
    for (int k = 2; k <= N; k <<= 1)
#pragma unroll
        for (int j = k >> 1; j > 0; j >>= 1)
#pragma unroll
            for (int i = 0; i < N; ++i) {
                const int l = i ^ j;
                if (l > i) {
                    const int a = v[i], b = v[l];
                    const int mx = a > b ? a : b, mn = a > b ? b : a;
                    if ((i & k) == 0) { v[i] = mx; v[l] = mn; } else { v[i] = mn; v[l] = mx; }
                }
            }
}
template <int N> DEVI void bmerge_desc(int (&v)[N]) {
#pragma unroll
    for (int j = N >> 1; j > 0; j >>= 1)
#pragma unroll
        for (int i = 0; i < N; ++i) {
            const int l = i ^ j;
            if (l > i) { const int a = v[i], b = v[l]; v[i] = a > b ? a : b; v[l] = a > b ? b : a; }
        }
}
DEVI void xmerge16(int (&v)[16], int mask) {
    int o[16];
#pragma unroll
    for (int i = 0; i < 16; ++i) o[i] = __shfl_xor(v[15 - i], mask);
#pragma unroll
    for (int i = 0; i < 16; ++i) v[i] = v[i] > o[i] ? v[i] : o[i];
    bmerge_desc<16>(v);
}
__device__ const unsigned char cand_tab[52] = {
    0x00, 0x01, 0x02, 0x03, 0x04, 0x05, 0x06, 0x07, 0x08, 0x09, 0x0a, 0x0b, 0x0c, 0x0d, 0x0e, 0x0f,
    0x10, 0x11, 0x12, 0x13, 0x14, 0x15, 0x16, 0x17, 0x20, 0x21, 0x22, 0x23, 0x24, 0x30, 0x31, 0x32, 0x33,
    0x40, 0x41, 0x42, 0x50, 0x51, 0x60, 0x61, 0x70, 0x71, 0x80, 0x90, 0xa0, 0xb0, 0xc0, 0xd0, 0xe0, 0xf0, 0xff, 0xff};
constexpr int H_A = 128 * 64, H_B = 256 * 64, H_STAGE = H_A + H_B;
DEVI void glds16(const void* g, char* l) {
    __builtin_amdgcn_global_load_lds((const __attribute__((address_space(1))) unsigned*)g, (__attribute__((address_space(3))) unsigned*)l, 16, 0, 0);
}
DEVI void gemm3_topk_tile(const Params& p, int m0, int h, char* smem) {
    const int tid = threadIdx.x, lane = tid & 63, w = tid >> 6, fr = lane & 15, fq = lane >> 4;
    f32x4 acc[2][16];
#pragma unroll
    for (int i = 0; i < 2; ++i)
#pragma unroll
        for (int j = 0; j < 16; ++j) acc[i][j] = (f32x4){0.f, 0.f, 0.f, 0.f};
    const int r16 = lane >> 2, csrc = (lane & 3) ^ ((r16 >> 2) & 3);
    const bf16_t* srcA = p.x1b + (size_t)(m0 + w * 32 + r16) * 1024 + csrc * 8;
    const bf16_t* srcB = p.Wsubt + ((size_t)h * 256 + w * 64 + r16) * 1024 + csrc * 8;
    char* dstA = smem + (w * 32) * 64 + lane * 16;
    char* dstB = smem + H_A + (w * 64) * 64 + lane * 16;
    auto issue = [&](int kt, int buf) {
#pragma unroll
        for (int q = 0; q < 2; ++q) glds16(srcA + (size_t)q * 16 * 1024 + kt * 32, dstA + buf * H_STAGE + q * 1024);
#pragma unroll
        for (int q = 0; q < 4; ++q) glds16(srcB + (size_t)q * 16 * 1024 + kt * 32, dstB + buf * H_STAGE + q * 1024);
    };
    const int rdoff = fr * 64 + ((fq ^ ((fr >> 2) & 3)) * 16);
    issue(0, 0);
    __syncthreads();
#pragma unroll 1
    for (int kt = 0; kt < 32; ++kt) {
        if (kt + 1 < 32) issue(kt + 1, (kt + 1) & 1);
        const char* As = smem + (kt & 1) * H_STAGE;
        const char* Bs = As + H_A;
        bf16x8 a[2];
#pragma unroll
        for (int i = 0; i < 2; ++i) a[i] = ld8(As + (32 * w + 16 * i) * 64 + rdoff);
#pragma unroll
        for (int jg = 0; jg < 4; ++jg) {
            bf16x8 b[4];
#pragma unroll
            for (int j = 0; j < 4; ++j) b[j] = ld8(Bs + (16 * (4 * jg + j)) * 64 + rdoff);
#pragma unroll
            for (int i = 0; i < 2; ++i)
#pragma unroll
                for (int j = 0; j < 4; ++j) acc[i][4 * jg + j] = mfma16(b[j], a[i], acc[i][4 * jg + j]);
        }
        __syncthreads();
    }
    int* L = (int*)(smem + H_STAGE + w * 2304);
#pragma unroll
    for (int i = 0; i < 2; ++i) {
        const int t = m0 + 32 * w + 16 * i + fr;
        const float rs = p.rs2[t];
#pragma unroll
        for (int pp = 0; pp < 2; ++pp) {
            int ka[16], kb[16];
#pragma unroll
            for (int jj = 0; jj < 4; ++jj)
#pragma unroll
                for (int r = 0; r < 4; ++r) {
                    ka[jj * 4 + r] = (f2key(acc[i][8 * pp + jj][r] * rs) & ~127) | (16 * jj + 4 * fq + r);
                    kb[jj * 4 + r] = (f2key(acc[i][8 * pp + 4 + jj][r] * rs) & ~127) | (16 * (jj + 4) + 4 * fq + r);
                }
            bsort_desc<16>(ka);
            bsort_desc<16>(kb);
#pragma unroll
            for (int q = 0; q < 16; ++q) ka[q] = ka[q] > kb[15 - q] ? ka[q] : kb[15 - q];
            bmerge_desc<16>(ka);
            xmerge16(ka, 16);
            xmerge16(ka, 32);
            if (fq == 0) {
#pragma unroll
                for (int q = 0; q < 4; ++q) *(int4*)(L + fr * 36 + pp * 16 + q * 4) = make_int4(ka[4 * q], ka[4 * q + 1], ka[4 * q + 2], ka[4 * q + 3]);
            }
        }
        int c[16];
#pragma unroll
        for (int s = 0; s < 13; ++s) {
            const int ab = cand_tab[fq * 13 + s];
            const int k1 = L[fr * 36 + (ab >> 4)], k2 = L[fr * 36 + 16 + (ab & 15)];
            const float v = key2f(k1 & ~127) + key2f(k2 & ~127);
            c[s] = (f2key(v) & ~0x3fff) | ((k1 & 127) << 7) | (k2 & 127);
        }
        c[13] = c[14] = c[15] = (int)0x80000000;
        bsort_desc<16>(c);
        xmerge16(c, 16);
        xmerge16(c, 32);
        const float vmax = key2f(c[0] & ~0x3fff);
        float e[16], sum = 0.f;
#pragma unroll
        for (int q = 0; q < 16; ++q) { e[q] = __expf(key2f(c[q] & ~0x3fff) - vmax); sum += e[q]; }
        const float inv = 1.f / sum;
        int ce[4]; float ge[4];
#pragma unroll
        for (int q = 0; q < 4; ++q) {
            const int cq = fq == 0 ? c[q] : fq == 1 ? c[4 + q] : fq == 2 ? c[8 + q] : c[12 + q];
            const float eq = fq == 0 ? e[q] : fq == 1 ? e[4 + q] : fq == 2 ? e[8 + q] : e[12 + q];
            ce[q] = ((cq >> 7) & 127) * 128 + (cq & 127);
            ge[q] = eq * inv;
        }
        *(int4*)(p.eidx + (size_t)t * 128 + h * 16 + 4 * fq) = make_int4(ce[0], ce[1], ce[2], ce[3]);
        *(float4*)(p.gate + (size_t)t * 128 + h * 16 + 4 * fq) = make_float4(ge[0], ge[1], ge[2], ge[3]);
    }
}
DEVI void st_gemm3_topk(const Params& p, char* smem) {
    for (int it = blockIdx.x; it < 256 * 8; it += gridDim.x) gemm3_topk_tile(p, (it >> 3) * 128, it & 7, smem);
}

DEVI int rdlane_i(int v, int l) { return __builtin_amdgcn_readlane(v, l); }
DEVI float rdlane_f(float v, int l) { return __int_as_float(__builtin_amdgcn_readlane(__float_as_int(v), l)); }
DEVI float ub(unsigned w, int n) { return (float)((w >> (8 * n)) & 0xffu); }
DEVI void st_experts(const Params& p) {
    const int lane = threadIdx.x & 63, wid = threadIdx.x >> 6;
    const int myidx = ((lane >> 5) & 1) * 8 + ((lane >> 4) & 1) * 4 + ((lane >> 3) & 1) * 2 + ((lane >> 2) & 1);
    const bool b5 = lane & 32, b4 = lane & 16, b3 = lane & 8, b2 = lane & 4;
    for (int t = blockIdx.x * 4 + wid; t < T_TOK; t += gridDim.x * 4) {
        float x1v[16], acc[16];
        int xq[4];
        float xsc;
        {
            const float rs = p.rs2[t];
            float xn[16], am = 0.f;
#pragma unroll
            for (int i = 0; i < 4; ++i) {
                const float4 a = *(const float4*)(p.out + (size_t)t * 1024 + lane * 16 + i * 4), g = *(const float4*)(p.norm2_g + lane * 16 + i * 4);
                x1v[4 * i] = a.x; x1v[4 * i + 1] = a.y; x1v[4 * i + 2] = a.z; x1v[4 * i + 3] = a.w;
                xn[4 * i] = a.x * rs * g.x; xn[4 * i + 1] = a.y * rs * g.y; xn[4 * i + 2] = a.z * rs * g.z; xn[4 * i + 3] = a.w * rs * g.w;
            }
#pragma unroll
            for (int c = 0; c < 16; ++c) { am = fmaxf(am, fabsf(xn[c])); acc[c] = 0.f; }
            am = wave_max(am);
            xsc = am > 0.f ? am * (1.f / 127.f) : 1.f;
            const float inv = am > 0.f ? 127.f / am : 0.f;
#pragma unroll
            for (int i = 0; i < 4; ++i) {
                const int q0 = (int)rintf(xn[4 * i] * inv), q1 = (int)rintf(xn[4 * i + 1] * inv), q2 = (int)rintf(xn[4 * i + 2] * inv), q3 = (int)rintf(xn[4 * i + 3] * inv);
                xq[i] = (int)((unsigned)(q0 & 255) | ((unsigned)(q1 & 255) << 8) | ((unsigned)(q2 & 255) << 16) | ((unsigned)(q3 & 255) << 24));
            }
        }
        float asum = 0.f;
        for (int kb = 0; kb < 128; kb += 16) {
            const int e16 = p.eidx[(size_t)t * 128 + kb + (lane & 15)];
            uint4 dr[16], ur[16];
#pragma unroll
            for (int j = 0; j < 16; ++j) dr[j] = ((const uint4*)(p.down_q + (size_t)rdlane_i(e16, j) * 1024))[lane];
#pragma unroll
            for (int j = 0; j < 16; ++j) ur[j] = ((const uint4*)(p.up_q + (size_t)rdlane_i(e16, j) * 1024))[lane];
            int ps[16];
#pragma unroll
            for (int j = 0; j < 16; ++j)
                ps[j] = __builtin_amdgcn_sdot4((int)dr[j].x, xq[0], __builtin_amdgcn_sdot4((int)dr[j].y, xq[1],
                        __builtin_amdgcn_sdot4((int)dr[j].z, xq[2], __builtin_amdgcn_sdot4((int)dr[j].w, xq[3], 0, false), false), false), false);
            int q8[8], q4[4], q2[2], q1;
#pragma unroll
            for (int j = 0; j < 8; ++j) { const int snd = b5 ? ps[j] : ps[j + 8], kp = b5 ? ps[j + 8] : ps[j]; q8[j] = kp + __shfl_xor(snd, 32); }
#pragma unroll
            for (int j = 0; j < 4; ++j) { const int snd = b4 ? q8[j] : q8[j + 4], kp = b4 ? q8[j + 4] : q8[j]; q4[j] = kp + __shfl_xor(snd, 16); }
#pragma unroll
            for (int j = 0; j < 2; ++j) { const int snd = b3 ? q4[j] : q4[j + 2], kp = b3 ? q4[j + 2] : q4[j]; q2[j] = kp + __shfl_xor(snd, 8); }
            { const int snd = b2 ? q2[0] : q2[1], kp = b2 ? q2[1] : q2[0]; q1 = kp + __shfl_xor(snd, 4); }
            q1 += __shfl_xor(q1, 2);
            q1 += __shfl_xor(q1, 1);
            const int em = __shfl(e16, myidx);
            const float gm = p.gate[(size_t)t * 128 + kb + myidx];
            const float u = (float)q1 * xsc * p.dscale[em];
            const float a = gm * 0.5f * u * (1.f + erff(u * 0.70710678118654752f)) * p.uscale[em];
#pragma unroll
            for (int j = 0; j < 16; ++j) {
                const int LJ = ((j >> 3) & 1) * 32 + ((j >> 2) & 1) * 16 + ((j >> 1) & 1) * 8 + (j & 1) * 4;
                const float aj = rdlane_f(a, LJ);
                asum += aj;
                const unsigned wv[4] = {ur[j].x, ur[j].y, ur[j].z, ur[j].w};
#pragma unroll
                for (int i = 0; i < 4; ++i)
#pragma unroll
                    for (int n = 0; n < 4; ++n) acc[4 * i + n] += aj * ub(wv[i], n);
            }
        }
        float ss = 0.f;
        const float corr = 128.f * asum;
#pragma unroll
        for (int c = 0; c < 16; ++c) { acc[c] = x1v[c] + acc[c] - corr; ss += acc[c] * acc[c]; }
        ss = wave_sum(ss);
        const float rf = rsqrtf(ss * (1.f / 1024.f) + EPSN);
#pragma unroll
        for (int i = 0; i < 4; ++i) {
            const float4 g = *(const float4*)(p.final_g + lane * 16 + i * 4);
            *(float4*)(p.out + (size_t)t * 1024 + lane * 16 + i * 4) =
                make_float4(acc[4 * i] * rf * g.x, acc[4 * i + 1] * rf * g.y, acc[4 * i + 2] * rf * g.z, acc[4 * i + 3] * rf * g.w);
        }
    }
}

#define XB_TMO      128
#define XB_XCNT(j)  (256  + 64 * (j))
#define XB_XSUB(j)  (1280 + 64 * (j))
#define XB_XGEN(j)  (2304 + 64 * (j))
#define XB_TOP      3328
#define XB_TOPGEN   3392
#define XCD_BAR_WORDS 3456
#define XB_SPIN_CAP (1u << 20)
#define LAS __attribute__((address_space(3)))
DEVI unsigned xb_ld(unsigned* p) { return __hip_atomic_load(p, __ATOMIC_RELAXED, __HIP_MEMORY_SCOPE_AGENT); }
DEVI unsigned xb_add(unsigned* p, unsigned v) { return __hip_atomic_fetch_add(p, v, __ATOMIC_RELAXED, __HIP_MEMORY_SCOPE_AGENT); }
DEVI unsigned xb_xcc_id() { return (unsigned)__builtin_amdgcn_s_getreg((3 << 11) | 20) & 0xFu; }
#define XB_SPIN(cond, bar) do { unsigned _sp = 0; while (cond) { __builtin_amdgcn_s_sleep(1); \
    if ((++_sp & 255u) == 0u) { if (xb_ld(&(bar)[XB_TMO])) break; if (_sp > XB_SPIN_CAP) { atomicAdd(&(bar)[XB_TMO], 1u); break; } } } } while (0)
struct XcdBarrier { unsigned* bar; unsigned x; volatile LAS unsigned* st; };
DEVI XcdBarrier xcd_barrier_post(unsigned* bar, volatile LAS unsigned* st) {
    XcdBarrier b; b.bar = bar; b.x = xb_xcc_id(); b.st = st;
    if (threadIdx.x == 0) (void)xb_add(&bar[XB_XCNT(b.x)], 1u);
    return b;
}
DEVI void xcd_barrier_complete(unsigned* bar, unsigned x, unsigned& nloc, unsigned& nx) {
    const unsigned G = gridDim.x * gridDim.y * gridDim.z;
    unsigned sum, cnt, mine, sp = 0u;
    for (;;) {
        sum = 0u; cnt = 0u; mine = 0u;
#pragma unroll
        for (unsigned j = 0; j < 16; ++j) { const unsigned c = xb_ld(&bar[XB_XCNT(j)]); sum += c; cnt += (c > 0u) ? 1u : 0u; mine = (j == x) ? c : mine; }
        if (sum == G) break;
        __builtin_amdgcn_s_sleep(1);
        if ((++sp & 255u) == 0u) { if (xb_ld(&bar[XB_TMO])) break; if (sp > XB_SPIN_CAP) { atomicAdd(&bar[XB_TMO], 1u); break; } }
    }
    nloc = mine > 0u ? mine : 1u; nx = cnt > 0u ? cnt : 1u;
}
DEVI void xcd_barrier(const XcdBarrier& b) {
    asm volatile("s_waitcnt vmcnt(0)" ::: "memory");
    __syncthreads();
    if (threadIdx.x == 0) {
        unsigned* bar = b.bar;
        __builtin_amdgcn_s_waitcnt(0);
        unsigned nloc = b.st[0], nx = b.st[1];
        if (nloc == 0u) { xcd_barrier_complete(bar, b.x, nloc, nx); b.st[0] = nloc; b.st[1] = nx; }
        const unsigned old = xb_add(&bar[XB_XSUB(b.x)], 1u);
        const unsigned gen = old / nloc;
        if (old + 1u == (gen + 1u) * nloc) {
            __builtin_amdgcn_fence(__ATOMIC_RELEASE, "agent");
            asm volatile("s_waitcnt vmcnt(0)" ::: "memory");
            const unsigned og = xb_add(&bar[XB_TOP], 1u);
            const unsigned tg = og / nx;
            if (og + 1u == (tg + 1u) * nx) xb_add(&bar[XB_TOPGEN], 1u);
            else XB_SPIN(xb_ld(&bar[XB_TOPGEN]) == tg, bar);
            __builtin_amdgcn_fence(__ATOMIC_ACQUIRE, "agent");
            xb_add(&bar[XB_XGEN(b.x)], 1u);
            asm volatile("s_waitcnt vmcnt(0)" ::: "memory");
        } else {
            XB_SPIN(xb_ld(&bar[XB_XGEN(b.x)]) == gen, bar);
            __builtin_amdgcn_fence(__ATOMIC_ACQUIRE, "agent");
            asm volatile("s_waitcnt vmcnt(0)" ::: "memory");
        }
    }
    __syncthreads();
}

constexpr int LDS_BYTES = 75 * 1024;
constexpr int LDS_BARW = LDS_BYTES - 16;
extern __shared__ __attribute__((aligned(16))) char smem_dyn[];
__global__ void __launch_bounds__(NTHR, 2) mega_fwd(Params p) {
    cg::grid_group grid = cg::this_grid();
    volatile LAS unsigned* bst = (volatile LAS unsigned*)(LAS char*)(smem_dyn + LDS_BARW);
    if (threadIdx.x < 4) bst[threadIdx.x] = 0u;
    __syncthreads();
    XcdBarrier bar = xcd_barrier_post(p.bar, bst);
    st_prep_misc(p);
    st_prep_tables(p);
    st_prep_w(p, smem_dyn);
    st_prep_wsub(p, smem_dyn);
    st_prep_x(p, smem_dyn);
    grid.sync();
    st_gemm(p.xb, p.W1t, NPJ, 1024, smem_dyn, EpiProj{p.proj, p.rs1});
    xcd_barrier(bar);
    st_conv_qk(p, smem_dyn);
    xcd_barrier(bar);
    st_recur(p, smem_dyn);
    xcd_barrier(bar);
    st_gate(p);
    xcd_barrier(bar);
    st_gemm(p.yb, p.W2t, 1024, 1024, smem_dyn, EpiX1{p.x, p.out});
    xcd_barrier(bar);
    st_norm2(p);
    xcd_barrier(bar);
    st_gemm3_topk(p, smem_dyn);
    xcd_barrier(bar);
    st_experts(p);
}

extern "C" void kernel_launch(void* const* d_in, const int* in_sizes, int n_in, void* d_out, int out_size, void* d_ws, size_t ws_size,
                              hipStream_t stream) {
    Params p{};
    const float* const* in = (const float* const*)d_in;
    p.x = in[0]; p.norm1_g = in[1]; p.w_in = in[2]; p.ret_norm_g = in[3]; p.m_conv_w = in[4]; p.m_conv_b = in[5]; p.m_wq = in[6]; p.m_wk = in[7];
    p.m_b_i = in[8]; p.m_b_f = in[9]; p.m_norm_g = in[10]; p.m_skip = in[11]; p.w_out = in[12]; p.norm2_g = in[13]; p.peer_wq = in[14];
    p.peer_keys = in[15]; p.peer_down = in[16]; p.peer_up = in[17]; p.final_g = in[18];
    p.out = (float*)d_out;
    char* ws = (char*)d_ws;
    size_t off = 0;
    auto take = [&](size_t bytes) { char* r = ws + off; off += (bytes + 255) & ~(size_t)255; return r; };
    p.proj = (bf16_t*)take((size_t)T_TOK * NPJ * 2);
    p.xb = (bf16_t*)take((size_t)T_TOK * 1024 * 2);
    p.yb = p.xb;
    p.sub = (float*)ws;
    p.gate = (float*)(ws + (size_t)T_TOK * 2048 * 4);
    p.mq = (bf16_t*)take((size_t)T_TOK * 512 * 2);
    p.mk = (bf16_t*)take((size_t)T_TOK * 512 * 2);
    p.x1b = p.mq;
    p.cbuf = (bf16_t*)take((size_t)T_TOK * 512 * 2);
    p.eidx = (int*)p.cbuf;
    p.down_q = (unsigned char*)take((size_t)16384 * 1024);
    p.up_q = (unsigned char*)take((size_t)16384 * 1024);
    p.dscale = (float*)take(16384 * 4);
    p.uscale = (float*)take(16384 * 4);
    p.bar = (unsigned*)take(XCD_BAR_WORDS * 4);
    p.W1t = (bf16_t*)take((size_t)NPJ * 1024 * 2);
    p.W2t = (bf16_t*)take((size_t)1024 * 1024 * 2);
    p.Wsubt = (bf16_t*)take((size_t)2048 * 1024 * 2);
    p.Wqt = (bf16_t*)take(4 * 128 * 128 * 2);
    p.Wkt = (bf16_t*)take(4 * 128 * 128 * 2);
    p.rs1 = (float*)take(T_TOK * 4);
    p.rs2 = (float*)take(T_TOK * 4);
    p.ipre = (float*)take(T_TOK * 4 * 4);
    p.logf = (float*)take(T_TOK * 4 * 4);
    p.rope_cos = (float*)take(2048 * 64 * 4);
    p.rope_sin = (float*)take(2048 * 64 * 4);
    if (off > ws_size) { fprintf(stderr, "kernel_launch: workspace too small (%zu > %zu)\n", off, ws_size); return; }

    static int grid_blocks = 0;
    if (!grid_blocks) {
        int dev = 0, cus = 0, per_cu = 0;
        (void)hipGetDevice(&dev);
        (void)hipDeviceGetAttribute(&cus, hipDeviceAttributeMultiprocessorCount, dev);
        (void)hipFuncSetAttribute((const void*)mega_fwd, hipFuncAttributeMaxDynamicSharedMemorySize, LDS_BYTES);
        (void)hipOccupancyMaxActiveBlocksPerMultiprocessor(&per_cu, (const void*)mega_fwd, NTHR, LDS_BYTES);
        if (per_cu > 2) per_cu = 2;
        if (per_cu < 1) per_cu = 1;
        grid_blocks = cus * per_cu;
    }
    (void)hipMemsetAsync(p.bar, 0, XCD_BAR_WORDS * 4, stream);
    void* args[] = {&p};
    hipError_t e = hipLaunchCooperativeKernel((const void*)mega_fwd, dim3(grid_blocks), dim3(NTHR), args, LDS_BYTES, stream);
    if (e != hipSuccess) fprintf(stderr, "cooperative launch failed: %s (grid %d)\n", hipGetErrorString(e), grid_blocks);
}
```

```cpp
#include <hip/hip_runtime.h>
#include <hip/hip_cooperative_groups.h>
#include <stdint.h>
#include <cstdio>
namespace cg = cooperative_groups;

typedef unsigned short bf16_t;
typedef short bf16x8 __attribute__((ext_vector_type(8)));
typedef float f32x4 __attribute__((ext_vector_type(4)));

#define DEVI __device__ __forceinline__

constexpr int T_TOK = 32768, DM = 1024, NPJ = 3584, DIN = 3592;
constexpr int NTHR = 256;
constexpr float EPSN = 1e-6f;

struct Params {
    const float *x, *norm1_g, *w_in, *ret_norm_g, *m_conv_w, *m_conv_b, *m_wq, *m_wk, *m_b_i, *m_b_f, *m_norm_g, *m_skip, *w_out,
        *norm2_g, *peer_wq, *peer_keys, *peer_down, *peer_up, *final_g;
    float* out;
    bf16_t *proj, *xb, *yb, *mq, *mk, *x1b, *cbuf, *W1t, *W2t, *Wsubt, *Wqt, *Wkt;
    unsigned char *down_q, *up_q;
    float *dscale, *uscale, *xsc, *asc;
    unsigned short* eperm;
    unsigned char* aq;
    int* part;
    unsigned char* xq;
    unsigned* bar;
    float *rs1, *rs2, *ipre, *logf, *rope_cos, *rope_sin, *gate;
    int pad_[2];
};

DEVI unsigned f2bf_bits(float f) { unsigned u = __float_as_uint(f); return (u + 0x7fffu + ((u >> 16) & 1u)) >> 16; }
DEVI bf16_t f2bf(float f) { return (bf16_t)f2bf_bits(f); }
DEVI unsigned pk2(float lo, float hi) { return f2bf_bits(lo) | (f2bf_bits(hi) << 16); }
DEVI float bflo(unsigned w) { return __uint_as_float(w << 16); }
DEVI float bfhi(unsigned w) { return __uint_as_float(w & 0xffff0000u); }
DEVI float bf2f(bf16_t h) { return __uint_as_float(((unsigned)h) << 16); }
DEVI float wave_sum(float v) {
#pragma unroll
    for (int o = 32; o; o >>= 1) v += __shfl_xor(v, o);
    return v;
}
DEVI float wave_max(float v) {
#pragma unroll
    for (int o = 32; o; o >>= 1) v = fmaxf(v, __shfl_xor(v, o));
    return v;
}
DEVI f32x4 mfma16(bf16x8 a, bf16x8 b, f32x4 c) { return __builtin_amdgcn_mfma_f32_16x16x32_bf16(a, b, c, 0, 0, 0); }
DEVI bf16x8 ld8(const char* p) { return *reinterpret_cast<const bf16x8*>(p); }
DEVI bf16x8 mk8(uint2 lo, uint2 hi) {
    union { uint4 u; bf16x8 v; } x;
    x.u = make_uint4(lo.x, lo.y, hi.x, hi.y);
    return x.v;
}
DEVI float sigmoidf_(float z) { return 1.f / (1.f + __expf(-z)); }

DEVI void st_prep_misc(const Params& p) {
    const int gtid = blockIdx.x * NTHR + threadIdx.x, gsz = gridDim.x * NTHR;
    for (int i = gtid; i < 2048 * 64; i += gsz) {
        const int pos = i >> 6, j = i & 63;
        const float inv = powf(10000.f, -(float)j * (1.f / 64.f));
        const float ang = (float)pos * inv;
        float s, c;
        sincosf(ang, &s, &c);
        p.rope_cos[i] = c;
        p.rope_sin[i] = s;
    }
    for (int i = gtid; i < 4 * 128 * 128; i += gsz) {
        const int h = i >> 14, e = (i >> 7) & 127, d = i & 127;
        p.Wqt[i] = f2bf(p.m_wq[h * 16384 + d * 128 + e]);
        p.Wkt[i] = f2bf(p.m_wk[h * 16384 + d * 128 + e] * 0.08838834764831845f);
    }
}
DEVI void st_prep_tables(const Params& p) {
    const int lane = threadIdx.x & 63, wid = threadIdx.x >> 6;
    for (int row = blockIdx.x * 4 + wid; row < 32768; row += gridDim.x * 4) {
        const bool up = row >= 16384;
        const int e = up ? row - 16384 : row;
        const float4* s = (const float4*)((up ? p.peer_up : p.peer_down) + (size_t)e * 1024 + lane * 16);
        float4 v[4];
        float am = 0.f;
#pragma unroll
        for (int i = 0; i < 4; ++i) {
            v[i] = s[i];
            am = fmaxf(am, fmaxf(fmaxf(fabsf(v[i].x), fabsf(v[i].y)), fmaxf(fabsf(v[i].z), fabsf(v[i].w))));
        }
        am = wave_max(am);
        const float sc = am > 0.f ? am * (1.f / 127.f) : 1.f, inv = am > 0.f ? 127.f / am : 0.f;
        const int ofs = 0;
        unsigned w[4];
#pragma unroll
        for (int i = 0; i < 4; ++i) {
            const int q0 = (int)rintf(v[i].x * inv) + ofs, q1 = (int)rintf(v[i].y * inv) + ofs, q2 = (int)rintf(v[i].z * inv) + ofs, q3 = (int)rintf(v[i].w * inv) + ofs;
            w[i] = (unsigned)(q0 & 255) | ((unsigned)(q1 & 255) << 8) | ((unsigned)(q2 & 255) << 16) | ((unsigned)(q3 & 255) << 24);
        }
        *(uint4*)((up ? p.up_q : p.down_q) + ((size_t)(lane >> 3) * 16384 + e) * 128 + (lane & 7) * 16) = make_uint4(w[0], w[1], w[2], w[3]);
        if (lane == 0) (up ? p.uscale : p.dscale)[e] = sc;
    }
}

DEVI void transpose_tile(const float* __restrict__ src, int ld, const float* __restrict__ scale, bf16_t* __restrict__ dst, int K, int k0, int n0,
                         float* tile) {
    const int tx = threadIdx.x & 31, ty = threadIdx.x >> 5;
#pragma unroll
    for (int i = 0; i < 4; ++i) {
        const int k = k0 + ty + 8 * i;
        float v = src[(size_t)k * ld + n0 + tx];
        if (scale) v *= scale[k];
        tile[(ty + 8 * i) * 33 + tx] = v;
    }
    __syncthreads();
#pragma unroll
    for (int i = 0; i < 4; ++i) {
        const int n = n0 + ty + 8 * i;
        dst[(size_t)n * K + k0 + tx] = f2bf(tile[tx * 33 + ty + 8 * i]);
    }
    __syncthreads();
}
DEVI void st_prep_w(const Params& p, char* smem) {
    float* tile = (float*)smem;
    constexpr int N1 = (NPJ / 32) * 32, N2 = 32 * 32;
    for (int it = blockIdx.x; it < N1 + N2; it += gridDim.x) {
        if (it < N1) {
            const int nt = it >> 5, kt = it & 31;
            transpose_tile(p.w_in, DIN, p.norm1_g, p.W1t, 1024, kt * 32, nt * 32, tile);
        } else {
            const int r = it - N1, nt = r >> 5, kt = r & 31;
            transpose_tile(p.w_out, 1024, nullptr, p.W2t, 1024, kt * 32, nt * 32, tile);
        }
    }
}
DEVI void st_prep_wsub(const Params& p, char* smem) {
    float* wq_s = (float*)smem;
    float* key_s = wq_s + 32 * 129 + 16;
    const int tid = threadIdx.x;
    for (int it = blockIdx.x; it < 16 * 32 * 2; it += gridDim.x) {
        const int grp = it >> 6, kt = (it >> 1) & 31, nh = it & 1, k0 = kt * 32;
#pragma unroll
        for (int i = 0; i < 16; ++i) {
            const int idx = tid + 256 * i, r = idx >> 7, d = idx & 127;
            wq_s[r * 129 + d] = p.peer_wq[(size_t)(k0 + r) * 2048 + grp * 128 + d];
        }
#pragma unroll
        for (int i = 0; i < 32; ++i) {
            const int idx = tid + 256 * i, n = idx >> 7, d = idx & 127;
            key_s[n * 128 + d] = p.peer_keys[((size_t)grp * 128 + nh * 64 + n) * 128 + d];
        }
        __syncthreads();
        const int kl = tid & 31, ng = tid >> 5;
        float acc[8];
#pragma unroll
        for (int i = 0; i < 8; ++i) acc[i] = 0.f;
        for (int d = 0; d < 128; ++d) {
            const float a = wq_s[kl * 129 + d];
#pragma unroll
            for (int i = 0; i < 8; ++i) acc[i] += a * key_s[(ng * 8 + i) * 128 + d];
        }
        const float g = p.norm2_g[k0 + kl];
#pragma unroll
        for (int i = 0; i < 8; ++i) p.Wsubt[(size_t)(grp * 128 + nh * 64 + ng * 8 + i) * 1024 + k0 + kl] = f2bf(acc[i] * g);
        __syncthreads();
    }
}

DEVI void st_prep_x(const Params& p, char* smem) {
    float* Wg_s = (float*)smem;
    for (int i = threadIdx.x; i < 8192; i += NTHR) {
        const int k = i >> 3, g = i & 7;
        Wg_s[g * 1024 + k] = p.norm1_g[k] * p.w_in[(size_t)k * DIN + NPJ + g];
    }
    __syncthreads();
    const int lane = threadIdx.x & 63, wid = threadIdx.x >> 6;
    for (int t = blockIdx.x * 4 + wid; t < T_TOK; t += gridDim.x * 4) {
        const float4* xr = (const float4*)(p.x + (size_t)t * 1024);
        float4 v[4];
        float ss = 0.f, g8[8];
#pragma unroll
        for (int g = 0; g < 8; ++g) g8[g] = 0.f;
#pragma unroll
        for (int j = 0; j < 4; ++j) {
            v[j] = xr[lane + 64 * j];
            ss += v[j].x * v[j].x + v[j].y * v[j].y + v[j].z * v[j].z + v[j].w * v[j].w;
#pragma unroll
            for (int g = 0; g < 8; ++g) {
                const float4 w = *(const float4*)(Wg_s + g * 1024 + (lane + 64 * j) * 4);
                g8[g] += v[j].x * w.x + v[j].y * w.y + v[j].z * w.z + v[j].w * w.w;
            }
        }
        ss = wave_sum(ss);
#pragma unroll
        for (int g = 0; g < 8; ++g) g8[g] = wave_sum(g8[g]);
        const float rs = rsqrtf(ss * (1.f / 1024.f) + EPSN);
        uint2* o = (uint2*)(p.xb + (size_t)t * 1024);
#pragma unroll
        for (int j = 0; j < 4; ++j) o[lane + 64 * j] = make_uint2(pk2(v[j].x, v[j].y), pk2(v[j].z, v[j].w));
        if (lane == 0) {
            p.rs1[t] = rs;
#pragma unroll
            for (int h = 0; h < 4; ++h) {
                p.ipre[t * 4 + h] = g8[h] * rs + p.m_b_i[h];
                const float z = g8[4 + h] * rs + p.m_b_f[h];
                p.logf[t * 4 + h] = fminf(z, 0.f) - log1pf(__expf(-fabsf(z)));
            }
        }
    }
}

constexpr int G_LDS_ROW = 144;
constexpr int G_LDS_MAT = 128 * G_LDS_ROW;
constexpr int G_LDS_BYTES = 4 * G_LDS_MAT;

template <class Epi>
DEVI void gemm_tile(const bf16_t* __restrict__ A, const bf16_t* __restrict__ Bt, int K, int m0, int n0, char* smem, const Epi& epi) {
    const int tid = threadIdx.x, lane = tid & 63, wid = tid >> 6, wr = wid >> 1, wc = wid & 1, fr = lane & 15, fq = lane >> 4;
    f32x4 acc[4][4];
#pragma unroll
    for (int i = 0; i < 4; ++i)
#pragma unroll
        for (int j = 0; j < 4; ++j) acc[i][j] = (f32x4){0.f, 0.f, 0.f, 0.f};
    uint4 ra[4], rb[4];
    const int nt = K / 64;
    auto gload = [&](int kt) {
#pragma unroll
        for (int i = 0; i < 4; ++i) {
            const int id = tid + 256 * i, r = id >> 3, c = id & 7;
            ra[i] = *(const uint4*)(A + (size_t)(m0 + r) * K + kt * 64 + c * 8);
            rb[i] = *(const uint4*)(Bt + (size_t)(n0 + r) * K + kt * 64 + c * 8);
        }
    };
    auto swrite = [&](int buf) {
        char* As = smem + buf * 2 * G_LDS_MAT;
        char* Bs = As + G_LDS_MAT;
#pragma unroll
        for (int i = 0; i < 4; ++i) {
            const int id = tid + 256 * i, r = id >> 3, c = id & 7;
            *(uint4*)(As + r * G_LDS_ROW + c * 16) = ra[i];
            *(uint4*)(Bs + r * G_LDS_ROW + c * 16) = rb[i];
        }
    };
    gload(0);
    swrite(0);
    __syncthreads();
    for (int kt = 0; kt < nt; ++kt) {
        if (kt + 1 < nt) gload(kt + 1);
        const char* As = smem + (kt & 1) * 2 * G_LDS_MAT;
        const char* Bs = As + G_LDS_MAT;
#pragma unroll
        for (int kk = 0; kk < 2; ++kk) {
            bf16x8 a[4], b[4];
#pragma unroll
            for (int i = 0; i < 4; ++i) a[i] = ld8(As + (wr * 64 + i * 16 + fr) * G_LDS_ROW + (kk * 4 + fq) * 16);
#pragma unroll
            for (int j = 0; j < 4; ++j) b[j] = ld8(Bs + (wc * 64 + j * 16 + fr) * G_LDS_ROW + (kk * 4 + fq) * 16);
#pragma unroll
            for (int i = 0; i < 4; ++i)
#pragma unroll
                for (int j = 0; j < 4; ++j) acc[i][j] = mfma16(b[j], a[i], acc[i][j]);
        }
        if (kt + 1 < nt) swrite((kt + 1) & 1);
        __syncthreads();
    }
#pragma unroll
    for (int i = 0; i < 4; ++i)
#pragma unroll
        for (int j = 0; j < 4; ++j) epi(acc[i][j], m0 + wr * 64 + i * 16 + fr, n0 + wc * 64 + j * 16 + 4 * fq);
}
struct EpiProj {
    bf16_t* proj; const float* rs1;
    DEVI void operator()(const f32x4& v, int m, int n) const {
        const float s = rs1[m];
        *(uint2*)(proj + (size_t)m * NPJ + n) = make_uint2(pk2(v[0] * s, v[1] * s), pk2(v[2] * s, v[3] * s));
    }
};
struct EpiX1 {
    const float* x; float* out;
    DEVI void operator()(const f32x4& v, int m, int n) const {
        const float4 xv = *(const float4*)(x + (size_t)m * 1024 + n);
        *(float4*)(out + (size_t)m * 1024 + n) = make_float4(xv.x + v[0], xv.y + v[1], xv.z + v[2], xv.w + v[3]);
    }
};
struct EpiSub {
    float* sub; const float* rs2;
    DEVI void operator()(const f32x4& v, int m, int n) const {
        const float s = rs2[m];
        *(float4*)(sub + (size_t)m * 2048 + n) = make_float4(v[0] * s, v[1] * s, v[2] * s, v[3] * s);
    }
};
template <class Epi>
DEVI void st_gemm(const bf16_t* A, const bf16_t* Bt, int N, int K, char* smem, const Epi& epi) {
    const int nN = N / 128, ntile = (T_TOK / 128) * nN;
    for (int it = blockIdx.x; it < ntile; it += gridDim.x) {
        const int pm = it / nN, pn = it - pm * nN;
        gemm_tile(A, Bt, K, pm * 128, pn * 128, smem, epi);
    }
}

DEVI void st_conv_qk(const Params& p, char* smem) {
    char* cs = smem;
    char* ws = smem + 128 * 272;
    const int tid = threadIdx.x, lane = tid & 63, wid = tid >> 6, wr = wid >> 1, wc = wid & 1, fr = lane & 15, fq = lane >> 4;
    for (int it = blockIdx.x; it < 256 * 4; it += gridDim.x) {
        const int h = it & 3, t0 = (it >> 2) * 128, s0 = t0 & 2047;
        {
            const int ch = tid & 127, r0 = (tid >> 7) * 64;
            const int col = 2048 + h * 128 + ch;
            const float w0 = p.m_conv_w[0 * 512 + h * 128 + ch], w1 = p.m_conv_w[1 * 512 + h * 128 + ch], w2 = p.m_conv_w[2 * 512 + h * 128 + ch],
                        w3 = p.m_conv_w[3 * 512 + h * 128 + ch], bb = p.m_conv_b[h * 128 + ch];
            float xm3 = 0.f, xm2 = 0.f, xm1 = 0.f;
            if (s0 + r0 > 0) {
                xm3 = bf2f(p.proj[(size_t)(t0 + r0 - 3) * NPJ + col]);
                xm2 = bf2f(p.proj[(size_t)(t0 + r0 - 2) * NPJ + col]);
                xm1 = bf2f(p.proj[(size_t)(t0 + r0 - 1) * NPJ + col]);
            }
            for (int r = r0; r < r0 + 64; ++r) {
                const float xc = bf2f(p.proj[(size_t)(t0 + r) * NPJ + col]);
                const float y = bb + w0 * xm3 + w1 * xm2 + w2 * xm1 + w3 * xc;
                const float c = y * sigmoidf_(y);
                const bf16_t cb = f2bf(c);
                *(bf16_t*)(cs + r * 272 + ch * 2) = cb;
                p.cbuf[(size_t)(t0 + r) * 512 + h * 128 + ch] = cb;
                xm3 = xm2; xm2 = xm1; xm1 = xc;
            }
        }
#pragma unroll
        for (int which = 0; which < 2; ++which) {
            const bf16_t* W = (which ? p.Wkt : p.Wqt) + h * 16384;
            bf16_t* O = which ? p.mk : p.mq;
#pragma unroll
            for (int i = 0; i < 8; ++i) {
                const int id = tid + 256 * i, r = id >> 4, c = id & 15;
                *(uint4*)(ws + r * 272 + c * 16) = *(const uint4*)(W + r * 128 + c * 8);
            }
            __syncthreads();
            f32x4 acc[4][4];
#pragma unroll
            for (int i = 0; i < 4; ++i)
#pragma unroll
                for (int j = 0; j < 4; ++j) acc[i][j] = (f32x4){0.f, 0.f, 0.f, 0.f};
#pragma unroll
            for (int ks = 0; ks < 4; ++ks) {
                bf16x8 a[4], b[4];
#pragma unroll
                for (int i = 0; i < 4; ++i) a[i] = ld8(cs + (wr * 64 + i * 16 + fr) * 272 + (ks * 4 + fq) * 16);
#pragma unroll
                for (int j = 0; j < 4; ++j) b[j] = ld8(ws + (wc * 64 + j * 16 + fr) * 272 + (ks * 4 + fq) * 16);
#pragma unroll
                for (int i = 0; i < 4; ++i)
#pragma unroll
                    for (int j = 0; j < 4; ++j) acc[i][j] = mfma16(b[j], a[i], acc[i][j]);
            }
#pragma unroll
            for (int i = 0; i < 4; ++i)
#pragma unroll
                for (int j = 0; j < 4; ++j) {
                    const int m = t0 + wr * 64 + i * 16 + fr, n = h * 128 + wc * 64 + j * 16 + 4 * fq;
                    const f32x4 v = acc[i][j];
                    *(uint2*)(O + (size_t)m * 512 + n) = make_uint2(pk2(v[0], v[1]), pk2(v[2], v[3]));
                }
            __syncthreads();
        }
    }
}

DEVI void ret_item(const Params& p, char* smem, int b, int h, int vh) {
    char* qs = smem;
    char* ks = smem + 17408;
    char* kTs = smem + 34816;
    char* vTs = smem + 53248;
    char* Ss = smem + 62464;
    const int tid = threadIdx.x, lane = tid & 63, w = tid >> 6, fr = lane & 15, fq = lane >> 4;
    const float gamma = 1.f - exp2f(-5.f - (float)h);
    const float l2g = log2f(gamma);
    const float g64 = exp2f(l2g * 64.f);
    f32x4 st[8];
#pragma unroll
    for (int i = 0; i < 8; ++i) st[i] = (f32x4){0.f, 0.f, 0.f, 0.f};
    for (int c = 0; c < 32; ++c) {
        const int t0 = b * 2048 + c * 64;
#pragma unroll
        for (int i = 0; i < 2; ++i) {
            const int u = tid + 256 * i, m = u >> 3, j0 = (u & 7) * 8;
            const int pos = c * 64 + m;
            const float4 c0 = *(const float4*)(p.rope_cos + pos * 64 + j0), c1 = *(const float4*)(p.rope_cos + pos * 64 + j0 + 4);
            const float4 s0 = *(const float4*)(p.rope_sin + pos * 64 + j0), s1 = *(const float4*)(p.rope_sin + pos * 64 + j0 + 4);
            const float cs_[8] = {c0.x, c0.y, c0.z, c0.w, c1.x, c1.y, c1.z, c1.w};
            const float sn_[8] = {s0.x, s0.y, s0.z, s0.w, s1.x, s1.y, s1.z, s1.w};
            const bf16_t* row = p.proj + (size_t)(t0 + m) * NPJ + h * 128 + j0;
            {
                const uint4 a = *(const uint4*)(row), bq = *(const uint4*)(row + 64);
                const unsigned aw[4] = {a.x, a.y, a.z, a.w}, bw[4] = {bq.x, bq.y, bq.z, bq.w};
                unsigned o1[4], o2[4];
#pragma unroll
                for (int e = 0; e < 4; ++e) {
                    const float t1a = bflo(aw[e]), t1b = bfhi(aw[e]), t2a = bflo(bw[e]), t2b = bfhi(bw[e]);
                    o1[e] = pk2(t1a * cs_[2 * e] - t2a * sn_[2 * e], t1b * cs_[2 * e + 1] - t2b * sn_[2 * e + 1]);
                    o2[e] = pk2(t1a * sn_[2 * e] + t2a * cs_[2 * e], t1b * sn_[2 * e + 1] + t2b * cs_[2 * e + 1]);
                }
                *(uint4*)(qs + m * 272 + j0 * 2) = make_uint4(o1[0], o1[1], o1[2], o1[3]);
                *(uint4*)(qs + m * 272 + (64 + j0) * 2) = make_uint4(o2[0], o2[1], o2[2], o2[3]);
            }
            {
                const uint4 a = *(const uint4*)(row + 512), bq = *(const uint4*)(row + 512 + 64);
                const unsigned aw[4] = {a.x, a.y, a.z, a.w}, bw[4] = {bq.x, bq.y, bq.z, bq.w};
                const float kd = exp2f(l2g * (float)(63 - m));
                const float sc = 0.08838834764831845f;
                unsigned o1[4], o2[4];
#pragma unroll
                for (int e = 0; e < 4; ++e) {
                    const float t1a = bflo(aw[e]), t1b = bfhi(aw[e]), t2a = bflo(bw[e]), t2b = bfhi(bw[e]);
                    const float r1a = (t1a * cs_[2 * e] - t2a * sn_[2 * e]) * sc, r1b = (t1b * cs_[2 * e + 1] - t2b * sn_[2 * e + 1]) * sc;
                    const float r2a = (t1a * sn_[2 * e] + t2a * cs_[2 * e]) * sc, r2b = (t1b * sn_[2 * e + 1] + t2b * cs_[2 * e + 1]) * sc;
                    o1[e] = pk2(r1a, r1b);
                    o2[e] = pk2(r2a, r2b);
                    *(bf16_t*)(kTs + (j0 + 2 * e) * 144 + m * 2) = f2bf(r1a * kd);
                    *(bf16_t*)(kTs + (j0 + 2 * e + 1) * 144 + m * 2) = f2bf(r1b * kd);
                    *(bf16_t*)(kTs + (64 + j0 + 2 * e) * 144 + m * 2) = f2bf(r2a * kd);
                    *(bf16_t*)(kTs + (64 + j0 + 2 * e + 1) * 144 + m * 2) = f2bf(r2b * kd);
                }
                *(uint4*)(ks + m * 272 + j0 * 2) = make_uint4(o1[0], o1[1], o1[2], o1[3]);
                *(uint4*)(ks + m * 272 + (64 + j0) * 2) = make_uint4(o2[0], o2[1], o2[2], o2[3]);
            }
            {
                const uint4 a = *(const uint4*)(p.proj + (size_t)(t0 + m) * NPJ + 1024 + h * 128 + vh * 64 + j0);
                const unsigned aw[4] = {a.x, a.y, a.z, a.w};
#pragma unroll
                for (int e = 0; e < 4; ++e) {
                    *(bf16_t*)(vTs + (j0 + 2 * e) * 144 + m * 2) = (bf16_t)(aw[e] & 0xffffu);
                    *(bf16_t*)(vTs + (j0 + 2 * e + 1) * 144 + m * 2) = (bf16_t)(aw[e] >> 16);
                }
            }
        }
        __syncthreads();
        {
            bf16x8 qf[4];
#pragma unroll
            for (int s = 0; s < 4; ++s) qf[s] = ld8(qs + (16 * w + fr) * 272 + (s * 4 + fq) * 16);
#pragma unroll
            for (int j = 0; j < 4; ++j) {
                f32x4 a = (f32x4){0.f, 0.f, 0.f, 0.f};
#pragma unroll
                for (int s = 0; s < 4; ++s) a = mfma16(ld8(ks + (16 * j + fr) * 272 + (s * 4 + fq) * 16), qf[s], a);
                const int l = 16 * w + fr, mb = 16 * j + 4 * fq;
                float v[4];
#pragma unroll
                for (int r = 0; r < 4; ++r) {
                    const int dd = l - (mb + r);
                    v[r] = a[r] * exp2f(l2g * (float)(dd < 0 ? -dd : dd));
                }
                *(uint2*)(Ss + l * 144 + mb * 2) = make_uint2(pk2(v[0], v[1]), pk2(v[2], v[3]));
            }
        }
        __syncthreads();
        {
            bf16x8 sp[4];
#pragma unroll
            for (int s = 0; s < 4; ++s)
                sp[s] = mk8(make_uint2(pk2(st[2 * s][0], st[2 * s][1]), pk2(st[2 * s][2], st[2 * s][3])),
                            make_uint2(pk2(st[2 * s + 1][0], st[2 * s + 1][1]), pk2(st[2 * s + 1][2], st[2 * s + 1][3])));
            bf16x8 vf[2];
#pragma unroll
            for (int s2 = 0; s2 < 2; ++s2) vf[s2] = ld8(vTs + (16 * w + fr) * 144 + (s2 * 4 + fq) * 16);
#pragma unroll
            for (int i = 0; i < 4; ++i) {
                f32x4 a = (f32x4){0.f, 0.f, 0.f, 0.f};
                const char* qrow = qs + (16 * i + fr) * 272;
#pragma unroll
                for (int s = 0; s < 4; ++s) {
                    const uint2 lo = *(const uint2*)(qrow + (32 * s + 4 * fq) * 2), hi = *(const uint2*)(qrow + (32 * s + 16 + 4 * fq) * 2);
                    a = mfma16(sp[s], mk8(lo, hi), a);
                }
                const float qd = exp2f(l2g * (float)(16 * i + fr + 1));
                a = a * qd;
#pragma unroll
                for (int s2 = 0; s2 < 2; ++s2) a = mfma16(vf[s2], ld8(Ss + (16 * i + fr) * 144 + (s2 * 4 + fq) * 16), a);
                *(uint2*)(p.proj + (size_t)(t0 + 16 * i + fr) * NPJ + 1024 + h * 128 + vh * 64 + 16 * w + 4 * fq) =
                    make_uint2(pk2(a[0], a[1]), pk2(a[2], a[3]));
            }
#pragma unroll
            for (int i = 0; i < 8; ++i) {
                f32x4 a = st[i] * g64;
#pragma unroll
                for (int s2 = 0; s2 < 2; ++s2) a = mfma16(ld8(kTs + (16 * i + fr) * 144 + (s2 * 4 + fq) * 16), vf[s2], a);
                st[i] = a;
            }
        }
        __syncthreads();
    }
}

DEVI void mlstm_item(const Params& p, char* smem, int b, int h, int vh) {
    char* qs = smem;
    char* kTs = smem + 17408;
    char* vTs = smem + 35840;
    float* n_s = (float*)(smem + 45056);
    float* qn_s = (float*)(smem + 45568);
    float* den_s = (float*)(smem + 46592);
    const int tid = threadIdx.x, lane = tid & 63, w = tid >> 6, fr = lane & 15, fq = lane >> 4;
    f32x4 st[8];
#pragma unroll
    for (int i = 0; i < 8; ++i) st[i] = (f32x4){0.f, 0.f, 0.f, 0.f};
    float m_run = 0.f, n_reg = 0.f;
    for (int c = 0; c < 32; ++c) {
        const int t0 = b * 2048 + c * 64;
        const float iv = p.ipre[(t0 + lane) * 4 + h], fv = p.logf[(t0 + lane) * 4 + h];
        float fcum = fv;
#pragma unroll
        for (int o = 1; o < 64; o <<= 1) {
            const float tv = __shfl_up(fcum, o);
            if (lane >= o) fcum += tv;
        }
        const float a_c = __shfl(fcum, 63);
        const float logw = a_c - fcum + iv;
        const float m_in = wave_max(logw);
        const float m_new = fmaxf(a_c + m_run, m_in);
        const float decay = __expf(a_c + m_run - m_new);
        const float wgt = __expf(logw - m_new);
        const float emn = __expf(-m_new);
        m_run = m_new;
#pragma unroll
        for (int i = 0; i < 4; ++i) {
            const int u = tid + 256 * i, m = u >> 4, j0 = (u & 15) * 8;
            *(uint4*)(qs + m * 272 + j0 * 2) = *(const uint4*)(p.mq + (size_t)(t0 + m) * 512 + h * 128 + j0);
            const uint4 kk = *(const uint4*)(p.mk + (size_t)(t0 + m) * 512 + h * 128 + j0);
            const float wm = __shfl(wgt, m);
            const unsigned kw[4] = {kk.x, kk.y, kk.z, kk.w};
#pragma unroll
            for (int e = 0; e < 4; ++e) {
                *(bf16_t*)(kTs + (j0 + 2 * e) * 144 + m * 2) = f2bf(bflo(kw[e]) * wm);
                *(bf16_t*)(kTs + (j0 + 2 * e + 1) * 144 + m * 2) = f2bf(bfhi(kw[e]) * wm);
            }
        }
#pragma unroll
        for (int i = 0; i < 2; ++i) {
            const int u = tid + 256 * i, m = u >> 3, j0 = (u & 7) * 8;
            const uint4 a = *(const uint4*)(p.proj + (size_t)(t0 + m) * NPJ + 2560 + h * 128 + vh * 64 + j0);
            const unsigned aw[4] = {a.x, a.y, a.z, a.w};
#pragma unroll
            for (int e = 0; e < 4; ++e) {
                *(bf16_t*)(vTs + (j0 + 2 * e) * 144 + m * 2) = (bf16_t)(aw[e] & 0xffffu);
                *(bf16_t*)(vTs + (j0 + 2 * e + 1) * 144 + m * 2) = (bf16_t)(aw[e] >> 16);
            }
        }
        __syncthreads();
        if (tid < 128) {
            float s = 0.f;
#pragma unroll
            for (int q = 0; q < 8; ++q) {
                const uint4 a = *(const uint4*)(kTs + tid * 144 + q * 16);
                s += (bflo(a.x) + bfhi(a.x)) + (bflo(a.y) + bfhi(a.y)) + (bflo(a.z) + bfhi(a.z)) + (bflo(a.w) + bfhi(a.w));
            }
            n_reg = decay * n_reg + s;
            n_s[tid] = n_reg;
        }
        {
            bf16x8 vf[2];
#pragma unroll
            for (int s2 = 0; s2 < 2; ++s2) vf[s2] = ld8(vTs + (16 * w + fr) * 144 + (s2 * 4 + fq) * 16);
#pragma unroll
            for (int i = 0; i < 8; ++i) {
                f32x4 a = st[i] * decay;
#pragma unroll
                for (int s2 = 0; s2 < 2; ++s2) a = mfma16(ld8(kTs + (16 * i + fr) * 144 + (s2 * 4 + fq) * 16), vf[s2], a);
                st[i] = a;
            }
        }
        __syncthreads();
        {
            const int l = tid & 63, part = tid >> 6;
            float s = 0.f;
#pragma unroll
            for (int q = 0; q < 8; ++q) {
                const uint2 a = *(const uint2*)(qs + l * 272 + (part * 32 + 4 * q) * 2);
                const float* nn = n_s + part * 32 + 4 * q;
                s += bflo(a.x) * nn[0] + bfhi(a.x) * nn[1] + bflo(a.y) * nn[2] + bfhi(a.y) * nn[3];
            }
            qn_s[part * 64 + l] = s;
        }
        __syncthreads();
        if (tid < 64) den_s[tid] = fmaxf(fabsf(qn_s[tid] + qn_s[64 + tid] + qn_s[128 + tid] + qn_s[192 + tid]), emn);
        __syncthreads();
        {
            bf16x8 sp[4];
#pragma unroll
            for (int s = 0; s < 4; ++s)
                sp[s] = mk8(make_uint2(pk2(st[2 * s][0], st[2 * s][1]), pk2(st[2 * s][2], st[2 * s][3])),
                            make_uint2(pk2(st[2 * s + 1][0], st[2 * s + 1][1]), pk2(st[2 * s + 1][2], st[2 * s + 1][3])));
#pragma unroll
            for (int i = 0; i < 4; ++i) {
                f32x4 a = (f32x4){0.f, 0.f, 0.f, 0.f};
                const char* qrow = qs + (16 * i + fr) * 272;
#pragma unroll
                for (int s = 0; s < 4; ++s) {
                    const uint2 lo = *(const uint2*)(qrow + (32 * s + 4 * fq) * 2), hi = *(const uint2*)(qrow + (32 * s + 16 + 4 * fq) * 2);
                    a = mfma16(sp[s], mk8(lo, hi), a);
                }
                const float rd = 1.f / den_s[16 * i + fr];
                *(uint2*)(p.proj + (size_t)(t0 + 16 * i + fr) * NPJ + 2560 + h * 128 + vh * 64 + 16 * w + 4 * fq) =
                    make_uint2(pk2(a[0] * rd, a[1] * rd), pk2(a[2] * rd, a[3] * rd));
            }
        }
        __syncthreads();
    }
}
DEVI void st_recur(const Params& p, char* smem) {
    for (int it = blockIdx.x; it < 256; it += gridDim.x) {
        const int kind = it & 1, r = it >> 1, vh = r & 1, h = (r >> 1) & 3, b = r >> 3;
        if (kind == 0) ret_item(p, smem, b, h, vh);
        else mlstm_item(p, smem, b, h, vh);
    }
}

DEVI void st_gate(const Params& p) {
    const int lane = threadIdx.x & 63, wid = threadIdx.x >> 6;
    for (int t = blockIdx.x * 4 + wid; t < T_TOK; t += gridDim.x * 4) {
        const bf16_t* pr = p.proj + (size_t)t * NPJ;
#pragma unroll
        for (int hh = 0; hh < 8; ++hh) {
            const bool ml = hh >= 4;
            const int h = hh & 3;
            const unsigned ow = *(const unsigned*)(pr + (ml ? 2560 : 1024) + h * 128 + 2 * lane);
            const float o0 = bflo(ow), o1 = bfhi(ow);
            const float mu = wave_sum(o0 + o1) * (1.f / 128.f);
            const float d0 = o0 - mu, d1 = o1 - mu;
            const float var = wave_sum(d0 * d0 + d1 * d1) * (1.f / 128.f);
            const float rstd = rsqrtf(var + EPSN);
            const float* gn = (ml ? p.m_norm_g : p.ret_norm_g) + h * 128 + 2 * lane;
            const float n0 = d0 * rstd * gn[0], n1 = d1 * rstd * gn[1];
            const unsigned gw = *(const unsigned*)(pr + (ml ? 3072 : 1536) + h * 128 + 2 * lane);
            const float g0 = bflo(gw), g1 = bfhi(gw);
            float y0, y1;
            if (!ml) {
                y0 = g0 * sigmoidf_(g0) * n0;
                y1 = g1 * sigmoidf_(g1) * n1;
            } else {
                const unsigned cw = *(const unsigned*)(p.cbuf + (size_t)t * 512 + h * 128 + 2 * lane);
                const float* sk = p.m_skip + h * 128 + 2 * lane;
                y0 = sigmoidf_(g0) * (n0 + sk[0] * bflo(cw));
                y1 = sigmoidf_(g1) * (n1 + sk[1] * bfhi(cw));
            }
            *(unsigned*)(p.yb + (size_t)t * 1024 + hh * 128 + 2 * lane) = pk2(y0, y1);
        }
    }
}

DEVI void st_norm2(const Params& p) {
    const int lane = threadIdx.x & 63, wid = threadIdx.x >> 6;
    for (int t = blockIdx.x * 4 + wid; t < T_TOK; t += gridDim.x * 4) {
        float xv[16];
        float ss = 0.f;
#pragma unroll
        for (int i = 0; i < 4; ++i) {
            const float4 a = *(const float4*)(p.out + (size_t)t * 1024 + lane * 16 + i * 4);
            xv[4 * i] = a.x; xv[4 * i + 1] = a.y; xv[4 * i + 2] = a.z; xv[4 * i + 3] = a.w;
            ss += a.x * a.x + a.y * a.y + a.z * a.z + a.w * a.w;
        }
        ss = wave_sum(ss);
        const float rs = rsqrtf(ss * (1.f / 1024.f) + EPSN);
        uint4* ob = (uint4*)(p.x1b + (size_t)t * 1024 + lane * 16);
        ob[0] = make_uint4(pk2(xv[0], xv[1]), pk2(xv[2], xv[3]), pk2(xv[4], xv[5]), pk2(xv[6], xv[7]));
        ob[1] = make_uint4(pk2(xv[8], xv[9]), pk2(xv[10], xv[11]), pk2(xv[12], xv[13]), pk2(xv[14], xv[15]));
        float am = 0.f;
#pragma unroll
        for (int i = 0; i < 4; ++i) {
            const float4 g = *(const float4*)(p.norm2_g + lane * 16 + i * 4);
            xv[4 * i] *= rs * g.x; xv[4 * i + 1] *= rs * g.y; xv[4 * i + 2] *= rs * g.z; xv[4 * i + 3] *= rs * g.w;
        }
#pragma unroll
        for (int c = 0; c < 16; ++c) am = fmaxf(am, fabsf(xv[c]));
        am = wave_max(am);
        const float inv = am > 0.f ? 127.f / am : 0.f;
        unsigned w[4];
#pragma unroll
        for (int i = 0; i < 4; ++i) {
            const int q0 = (int)rintf(xv[4 * i] * inv), q1 = (int)rintf(xv[4 * i + 1] * inv), q2 = (int)rintf(xv[4 * i + 2] * inv), q3 = (int)rintf(xv[4 * i + 3] * inv);
            w[i] = (unsigned)(q0 & 255) | ((unsigned)(q1 & 255) << 8) | ((unsigned)(q2 & 255) << 16) | ((unsigned)(q3 & 255) << 24);
        }
        *(uint4*)(p.xq + (size_t)t * 1024 + lane * 16) = make_uint4(w[0], w[1], w[2], w[3]);
        if (lane == 0) { p.rs2[t] = rs; p.xsc[t] = am > 0.f ? am * (1.f / 127.f) : 1.f; }
    }
}

DEVI int f2key(float f) { const int b = __float_as_int(f); return b ^ ((b >> 31) & 0x7fffffff); }
DEVI float key2f(int k) { return __int_as_float(k ^ ((k >> 31) & 0x7fffffff)); }
template <int N> DEVI void bsort_desc(int (&v)[N]) {
#pragma unroll
    for (int k = 2; k <= N; k <<= 1)
#pragma unroll
        for (int j = k >> 1; j > 0; j >>= 1)
#pragma unroll
            for (int i = 0; i < N; ++i) {
                const int l = i ^ j;
                if (l > i) {
                    const int a = v[i], b = v[l];
                    const int mx = a > b ? a : b, mn = a > b ? b : a;
                    if ((i & k) == 0) { v[i] = mx; v[l] = mn; } else { v[i] = mn; v[l] = mx; }
                }
            }
}
template <int N> DEVI void bmerge_desc(int (&v)[N]) {
#pragma unroll
    for (int j = N >> 1; j > 0; j >>= 1)
#pragma unroll
        for (int i = 0; i < N; ++i) {
            const int l = i ^ j;
            if (l > i) { const int a = v[i], b = v[l]; v[i] = a > b ? a : b; v[l] = a > b ? b : a; }
        }
}
DEVI void xmerge16(int (&v)[16], int mask) {
    int o[16];
#pragma unroll
    for (int i = 0; i < 16; ++i) o[i] = __shfl_xor(v[15 - i], mask);
#pragma unroll
    for (int i = 0; i < 16; ++i) v[i] = v[i] > o[i] ? v[i] : o[i];
    bmerge_desc<16>(v);
}
__device__ const unsigned char cand_tab[52] = {
    0x00, 0x01, 0x02, 0x03, 0x04, 0x05, 0x06, 0x07, 0x08, 0x09, 0x0a, 0x0b, 0x0c, 0x0d, 0x0e, 0x0f,
    0x10, 0x11, 0x12, 0x13, 0x14, 0x15, 0x16, 0x17, 0x20, 0x21, 0x22, 0x23, 0x24, 0x30, 0x31, 0x32, 0x33,
    0x40, 0x41, 0x42, 0x50, 0x51, 0x60, 0x61, 0x70, 0x71, 0x80, 0x90, 0xa0, 0xb0, 0xc0, 0xd0, 0xe0, 0xf0, 0xff, 0xff};
constexpr int H_A = 128 * 64, H_B = 256 * 64, H_STAGE = H_A + H_B;
DEVI void glds16(const void* g, char* l) {
    __builtin_amdgcn_global_load_lds((const __attribute__((address_space(1))) unsigned*)g, (__attribute__((address_space(3))) unsigned*)l, 16, 0, 0);
}
DEVI void gemm3_topk_tile(const Params& p, int m0, int h, char* smem) {
    const int tid = threadIdx.x, lane = tid & 63, w = tid >> 6, fr = lane & 15, fq = lane >> 4;
    f32x4 acc[2][16];
#pragma unroll
    for (int i = 0; i < 2; ++i)
#pragma unroll
        for (int j = 0; j < 16; ++j) acc[i][j] = (f32x4){0.f, 0.f, 0.f, 0.f};
    const int r16 = lane >> 2, csrc = (lane & 3) ^ ((r16 >> 2) & 3);
    const bf16_t* srcA = p.x1b + (size_t)(m0 + w * 32 + r16) * 1024 + csrc * 8;
    const bf16_t* srcB = p.Wsubt + ((size_t)h * 256 + w * 64 + r16) * 1024 + csrc * 8;
    char* dstA = smem + (w * 32) * 64 + lane * 16;
    char* dstB = smem + H_A + (w * 64) * 64 + lane * 16;
    auto issue = [&](int kt, int buf) {
#pragma unroll
        for (int q = 0; q < 2; ++q) glds16(srcA + (size_t)q * 16 * 1024 + kt * 32, dstA + buf * H_STAGE + q * 1024);
#pragma unroll
        for (int q = 0; q < 4; ++q) glds16(srcB + (size_t)q * 16 * 1024 + kt * 32, dstB + buf * H_STAGE + q * 1024);
    };
    const int rdoff = fr * 64 + ((fq ^ ((fr >> 2) & 3)) * 16);
    issue(0, 0);
    __syncthreads();
#pragma unroll 1
    for (int kt = 0; kt < 32; ++kt) {
        if (kt + 1 < 32) issue(kt + 1, (kt + 1) & 1);
        const char* As = smem + (kt & 1) * H_STAGE;
        const char* Bs = As + H_A;
        bf16x8 a[2];
#pragma unroll
        for (int i = 0; i < 2; ++i) a[i] = ld8(As + (32 * w + 16 * i) * 64 + rdoff);
#pragma unroll
        for (int jg = 0; jg < 4; ++jg) {
            bf16x8 b[4];
#pragma unroll
            for (int j = 0; j < 4; ++j) b[j] = ld8(Bs + (16 * (4 * jg + j)) * 64 + rdoff);
#pragma unroll
            for (int i = 0; i < 2; ++i)
#pragma unroll
                for (int j = 0; j < 4; ++j) acc[i][4 * jg + j] = mfma16(b[j], a[i], acc[i][4 * jg + j]);
        }
        __syncthreads();
    }
    int* L = (int*)(smem + H_STAGE + w * 2304);
#pragma unroll
    for (int i = 0; i < 2; ++i) {
        const int t = m0 + 32 * w + 16 * i + fr;
        const float rs = p.rs2[t];
#pragma unroll
        for (int pp = 0; pp < 2; ++pp) {
            int ka[16], kb[16];
#pragma unroll
            for (int jj = 0; jj < 4; ++jj)
#pragma unroll
                for (int r = 0; r < 4; ++r) {
                    ka[jj * 4 + r] = (f2key(acc[i][8 * pp + jj][r] * rs) & ~127) | (16 * jj + 4 * fq + r);
                    kb[jj * 4 + r] = (f2key(acc[i][8 * pp + 4 + jj][r] * rs) & ~127) | (16 * (jj + 4) + 4 * fq + r);
                }
            bsort_desc<16>(ka);
            bsort_desc<16>(kb);
#pragma unroll
            for (int q = 0; q < 16; ++q) ka[q] = ka[q] > kb[15 - q] ? ka[q] : kb[15 - q];
            bmerge_desc<16>(ka);
            xmerge16(ka, 16);
            xmerge16(ka, 32);
            if (fq == 0) {
#pragma unroll
                for (int q = 0; q < 4; ++q) *(int4*)(L + fr * 36 + pp * 16 + q * 4) = make_int4(ka[4 * q], ka[4 * q + 1], ka[4 * q + 2], ka[4 * q + 3]);
            }
        }
        int c[16];
#pragma unroll
        for (int s = 0; s < 13; ++s) {
            const int ab = cand_tab[fq * 13 + s];
            const int k1 = L[fr * 36 + (ab >> 4)], k2 = L[fr * 36 + 16 + (ab & 15)];
            const float v = key2f(k1 & ~127) + key2f(k2 & ~127);
            c[s] = (f2key(v) & ~0x3fff) | ((k1 & 127) << 7) | (k2 & 127);
        }
        c[13] = c[14] = c[15] = (int)0x80000000;
        bsort_desc<16>(c);
        xmerge16(c, 16);
        xmerge16(c, 32);
        const float vmax = key2f(c[0] & ~0x3fff);
        float e[16], sum = 0.f;
#pragma unroll
        for (int q = 0; q < 16; ++q) { e[q] = __expf(key2f(c[q] & ~0x3fff) - vmax); sum += e[q]; }
        const float inv = 1.f / sum;
#pragma unroll
        for (int q = 0; q < 4; ++q) {
            const int cq = fq == 0 ? c[q] : fq == 1 ? c[4 + q] : fq == 2 ? c[8 + q] : c[12 + q];
            const float eq = fq == 0 ? e[q] : fq == 1 ? e[4 + q] : fq == 2 ? e[8 + q] : e[12 + q];
            const int k = h * 16 + 4 * fq + q, slot = (k & 7) * 16 + (k >> 3);
            p.eperm[(size_t)t * 128 + slot] = (unsigned short)(((cq >> 7) & 127) * 128 + (cq & 127));
            p.gate[(size_t)t * 128 + slot] = eq * inv;
        }
    }
}
DEVI void st_gemm3_topk(const Params& p, char* smem) {
    for (int it = blockIdx.x; it < 256 * 8; it += gridDim.x) gemm3_topk_tile(p, (it >> 3) * 128, it & 7, smem);
}

#define XB_TMO      128
#define XB_XCNT(j)  (256  + 64 * (j))
#define XB_XSUB(j)  (1280 + 64 * (j))
#define XB_XGEN(j)  (2304 + 64 * (j))
#define XB_TOP      3328
#define XB_TOPGEN   3392
#define XCD_BAR_WORDS 3456
#define XB_SPIN_CAP (1u << 20)
#define LAS __attribute__((address_space(3)))
DEVI unsigned xb_ld(unsigned* p) { return __hip_atomic_load(p, __ATOMIC_RELAXED, __HIP_MEMORY_SCOPE_AGENT); }
DEVI unsigned xb_add(unsigned* p, unsigned v) { return __hip_atomic_fetch_add(p, v, __ATOMIC_RELAXED, __HIP_MEMORY_SCOPE_AGENT); }
DEVI unsigned xb_xcc_id() { return (unsigned)__builtin_amdgcn_s_getreg((3 << 11) | 20) & 0xFu; }
#define XB_SPIN(cond, bar) do { unsigned _sp = 0; while (cond) { __builtin_amdgcn_s_sleep(1); \
    if ((++_sp & 255u) == 0u) { if (xb_ld(&(bar)[XB_TMO])) break; if (_sp > XB_SPIN_CAP) { atomicAdd(&(bar)[XB_TMO], 1u); break; } } } } while (0)
struct XcdBarrier { unsigned* bar; unsigned x; volatile LAS unsigned* st; };
DEVI XcdBarrier xcd_barrier_post(unsigned* bar, volatile LAS unsigned* st) {
    XcdBarrier b; b.bar = bar; b.x = xb_xcc_id(); b.st = st;
    if (threadIdx.x == 0) (void)xb_add(&bar[XB_XCNT(b.x)], 1u);
    return b;
}
DEVI void xcd_barrier_complete(unsigned* bar, unsigned x, unsigned& nloc, unsigned& nx) {
    const unsigned G = gridDim.x * gridDim.y * gridDim.z;
    unsigned sum, cnt, mine, sp = 0u;
    for (;;) {
        sum = 0u; cnt = 0u; mine = 0u;
#pragma unroll
        for (unsigned j = 0; j < 16; ++j) { const unsigned c = xb_ld(&bar[XB_XCNT(j)]); sum += c; cnt += (c > 0u) ? 1u : 0u; mine = (j == x) ? c : mine; }
        if (sum == G) break;
        __builtin_amdgcn_s_sleep(1);
        if ((++sp & 255u) == 0u) { if (xb_ld(&bar[XB_TMO])) break; if (sp > XB_SPIN_CAP) { atomicAdd(&bar[XB_TMO], 1u); break; } }
    }
    nloc = mine > 0u ? mine : 1u; nx = cnt > 0u ? cnt : 1u;
}
DEVI void xcd_barrier(const XcdBarrier& b) {
    asm volatile("s_waitcnt vmcnt(0)" ::: "memory");
    __syncthreads();
    if (threadIdx.x == 0) {
        unsigned* bar = b.bar;
        __builtin_amdgcn_s_waitcnt(0);
        unsigned nloc = b.st[0], nx = b.st[1];
        if (nloc == 0u) { xcd_barrier_complete(bar, b.x, nloc, nx); b.st[0] = nloc; b.st[1] = nx; }
        const unsigned old = xb_add(&bar[XB_XSUB(b.x)], 1u);
        const unsigned gen = old / nloc;
        if (old + 1u == (gen + 1u) * nloc) {
            __builtin_amdgcn_fence(__ATOMIC_RELEASE, "agent");
            asm volatile("s_waitcnt vmcnt(0)" ::: "memory");
            const unsigned og = xb_add(&bar[XB_TOP], 1u);
            const unsigned tg = og / nx;
            if (og + 1u == (tg + 1u) * nx) xb_add(&bar[XB_TOPGEN], 1u);
            else XB_SPIN(xb_ld(&bar[XB_TOPGEN]) == tg, bar);
            __builtin_amdgcn_fence(__ATOMIC_ACQUIRE, "agent");
            xb_add(&bar[XB_XGEN(b.x)], 1u);
            asm volatile("s_waitcnt vmcnt(0)" ::: "memory");
        } else {
            XB_SPIN(xb_ld(&bar[XB_XGEN(b.x)]) == gen, bar);
            __builtin_amdgcn_fence(__ATOMIC_ACQUIRE, "agent");
            asm volatile("s_waitcnt vmcnt(0)" ::: "memory");
        }
    }
    __syncthreads();
}

#define CTR_A(x) (XCD_BAR_WORDS + 64 * (x))
#define CTR_B(x) (XCD_BAR_WORDS + 512 + 64 * (x))
#define CTL_WORDS (XCD_BAR_WORDS + 1024)
typedef float f32x2 __attribute__((ext_vector_type(2)));
DEVI float ub(unsigned w, int n) { return (float)((w >> (8 * n)) & 0xffu); }
DEVI float gelu_erf(float u) { return 0.5f * u * (1.f + erff(u * 0.70710678118654752f)); }
struct ExpMeta { uint4 e[2]; uint4 xa; float sc; };
struct ExpRows { uint4 r[16]; float2 x1; };

template <int PHASE> DEVI void exp_load_meta(const Params& p, ExpMeta& m, int t, int x, int lane) {
    const uint4* ep = (const uint4*)(p.eperm + (size_t)t * 128 + (lane >> 3) * 16);
    m.e[0] = ep[0];
    m.e[1] = ep[1];
    if (PHASE == 0) m.xa = *(const uint4*)(p.xq + (size_t)t * 1024 + 128 * x + 16 * (lane & 7));
    else { m.xa = *(const uint4*)(p.aq + (size_t)t * 128 + (lane >> 3) * 16); m.sc = p.asc[t]; }
}
template <int PHASE> DEVI void exp_issue(const Params& p, const ExpMeta& m, ExpRows& R, int t, int x, int lane) {
    const unsigned char* base = (PHASE == 0 ? p.down_q : p.up_q) + (size_t)x * (16384 * 128) + (lane & 7) * 16;
    const unsigned ew[8] = {m.e[0].x, m.e[0].y, m.e[0].z, m.e[0].w, m.e[1].x, m.e[1].y, m.e[1].z, m.e[1].w};
#pragma unroll
    for (int j = 0; j < 16; ++j) {
        const unsigned ek = (j & 1) ? (ew[j >> 1] >> 16) : (ew[j >> 1] & 0xffffu);
        R.r[j] = *(const uint4*)(base + (size_t)ek * 128);
    }
    if (PHASE == 1) {
        const int col = 128 * x + 16 * (lane & 7) + ((lane & 32) ? 8 : 0) + ((lane & 16) ? 4 : 0) + ((lane & 8) ? 2 : 0);
        R.x1 = *(const float2*)(p.out + (size_t)t * 1024 + col);
    }
}
DEVI void expA_compute(const Params& p, const ExpMeta& m, const ExpRows& R, int t, int x, int lane) {
    const bool b2 = lane & 4, b1 = lane & 2, b0 = lane & 1;
    int ps[16];
#pragma unroll
    for (int j = 0; j < 16; ++j)
        ps[j] = __builtin_amdgcn_sdot4((int)R.r[j].x, (int)m.xa.x, __builtin_amdgcn_sdot4((int)R.r[j].y, (int)m.xa.y,
                __builtin_amdgcn_sdot4((int)R.r[j].z, (int)m.xa.z, __builtin_amdgcn_sdot4((int)R.r[j].w, (int)m.xa.w, 0, false), false), false), false);
    int q8[8], q4[4], q2[2];
#pragma unroll
    for (int j = 0; j < 8; ++j) { const int snd = b2 ? ps[j] : ps[j + 8], kp = b2 ? ps[j + 8] : ps[j]; q8[j] = kp + __shfl_xor(snd, 4); }
#pragma unroll
    for (int j = 0; j < 4; ++j) { const int snd = b1 ? q8[j] : q8[j + 4], kp = b1 ? q8[j + 4] : q8[j]; q4[j] = kp + __shfl_xor(snd, 2); }
#pragma unroll
    for (int j = 0; j < 2; ++j) { const int snd = b0 ? q4[j] : q4[j + 2], kp = b0 ? q4[j + 2] : q4[j]; q2[j] = kp + __shfl_xor(snd, 1); }
    *(int2*)(p.part + ((size_t)x * T_TOK + t) * 128 + 2 * lane) = make_int2(q2[0], q2[1]);
}
DEVI void expB_compute(const Params& p, const ExpMeta& m, const ExpRows& R, int t, int x, int lane) {
    const bool b5 = lane & 32, b4 = lane & 16, b3 = lane & 8;
    const unsigned pa[4] = {m.xa.x, m.xa.y, m.xa.z, m.xa.w};
    int acc[16];
#pragma unroll
    for (int c = 0; c < 16; ++c) acc[c] = 0;
#pragma unroll
    for (int g = 0; g < 4; ++g) {
        const unsigned r0[4] = {R.r[4 * g].x, R.r[4 * g].y, R.r[4 * g].z, R.r[4 * g].w};
        const unsigned r1[4] = {R.r[4 * g + 1].x, R.r[4 * g + 1].y, R.r[4 * g + 1].z, R.r[4 * g + 1].w};
        const unsigned r2[4] = {R.r[4 * g + 2].x, R.r[4 * g + 2].y, R.r[4 * g + 2].z, R.r[4 * g + 2].w};
        const unsigned r3[4] = {R.r[4 * g + 3].x, R.r[4 * g + 3].y, R.r[4 * g + 3].z, R.r[4 * g + 3].w};
#pragma unroll
        for (int i = 0; i < 4; ++i) {
            const unsigned t0 = __builtin_amdgcn_perm(r1[i], r0[i], 0x05010400u), t1 = __builtin_amdgcn_perm(r1[i], r0[i], 0x07030602u);
            const unsigned t2 = __builtin_amdgcn_perm(r3[i], r2[i], 0x05010400u), t3 = __builtin_amdgcn_perm(r3[i], r2[i], 0x07030602u);
            const unsigned o0 = __builtin_amdgcn_perm(t2, t0, 0x05040100u), o1 = __builtin_amdgcn_perm(t2, t0, 0x07060302u);
            const unsigned o2 = __builtin_amdgcn_perm(t3, t1, 0x05040100u), o3 = __builtin_amdgcn_perm(t3, t1, 0x07060302u);
            acc[4 * i + 0] = __builtin_amdgcn_sdot4((int)o0, (int)pa[g], acc[4 * i + 0], false);
            acc[4 * i + 1] = __builtin_amdgcn_sdot4((int)o1, (int)pa[g], acc[4 * i + 1], false);
            acc[4 * i + 2] = __builtin_amdgcn_sdot4((int)o2, (int)pa[g], acc[4 * i + 2], false);
            acc[4 * i + 3] = __builtin_amdgcn_sdot4((int)o3, (int)pa[g], acc[4 * i + 3], false);
        }
    }
    int q8[8], q4[4], q2[2];
#pragma unroll
    for (int j = 0; j < 8; ++j) { const int snd = b5 ? acc[j] : acc[j + 8], kp = b5 ? acc[j + 8] : acc[j]; q8[j] = kp + __shfl_xor(snd, 32); }
#pragma unroll
    for (int j = 0; j < 4; ++j) { const int snd = b4 ? q8[j] : q8[j + 4], kp = b4 ? q8[j + 4] : q8[j]; q4[j] = kp + __shfl_xor(snd, 16); }
#pragma unroll
    for (int j = 0; j < 2; ++j) { const int snd = b3 ? q4[j] : q4[j + 2], kp = b3 ? q4[j + 2] : q4[j]; q2[j] = kp + __shfl_xor(snd, 8); }
    const int col = 128 * x + 16 * (lane & 7) + (b5 ? 8 : 0) + (b4 ? 4 : 0) + (b3 ? 2 : 0);
    *(float2*)((float*)p.proj + (size_t)t * 1024 + col) = make_float2(R.x1.x + (float)q2[0] * m.sc, R.x1.y + (float)q2[1] * m.sc);
}
template <int PHASE>
DEVI void exp_chunk(const Params& p, int tb, int x, int lane) {
    ExpMeta mA, mB, nA, nB;
    ExpRows rA, rB;
    exp_load_meta<PHASE>(p, mA, tb, x, lane);
    exp_load_meta<PHASE>(p, mB, tb + 1, x, lane);
    exp_issue<PHASE>(p, mA, rA, tb, x, lane);
    exp_issue<PHASE>(p, mB, rB, tb + 1, x, lane);
    exp_load_meta<PHASE>(p, nA, tb + 2, x, lane);
    exp_load_meta<PHASE>(p, nB, tb + 3, x, lane);
#pragma unroll 1
    for (int i = 0; i < 8; ++i) {
        const int tA = tb + 2 * i, tB = tA + 1;
        if (PHASE == 0) expA_compute(p, mA, rA, tA, x, lane); else expB_compute(p, mA, rA, tA, x, lane);
        if (i < 7) {
            mA = nA;
            exp_issue<PHASE>(p, mA, rA, tA + 2, x, lane);
            if (i < 6) exp_load_meta<PHASE>(p, nA, tA + 4, x, lane);
        }
        if (PHASE == 0) expA_compute(p, mB, rB, tB, x, lane); else expB_compute(p, mB, rB, tB, x, lane);
        if (i < 7) {
            mB = nB;
            exp_issue<PHASE>(p, mB, rB, tB + 2, x, lane);
            if (i < 6) exp_load_meta<PHASE>(p, nB, tB + 4, x, lane);
        }
    }
}
template <int PHASE>
DEVI void st_expAB(const Params& p, char* smem) {
    const int tid = threadIdx.x, lane = tid & 63, wid = tid >> 6;
    volatile int* cs = (volatile int*)smem;
    const unsigned myx = xb_xcc_id() & 7u;
    constexpr int NCH = T_TOK / 64;
    for (int si = 0; si < 8; ++si) {
        const int x = (int)((myx + si) & 7u);
        unsigned* ctr = &p.bar[PHASE == 0 ? CTR_A(x) : CTR_B(x)];
        if (tid == 0) cs[0] = (int)xb_add(ctr, 1u);
        __syncthreads();
        int chunk = cs[0];
        __syncthreads();
        while (chunk < NCH) {
            int nxt = 0;
            if (tid == 0) nxt = (int)xb_add(ctr, 1u);
            exp_chunk<PHASE>(p, chunk * 64 + wid * 16, x, lane);
            if (tid == 0) cs[0] = nxt;
            __syncthreads();
            chunk = cs[0];
            __syncthreads();
        }
    }
}
DEVI void st_expA2(const Params& p) {
    const int lane = threadIdx.x & 63, wid = threadIdx.x >> 6;
    for (int t = blockIdx.x * 4 + wid; t < T_TOK; t += gridDim.x * 4) {
        int s0 = 0, s1 = 0;
#pragma unroll
        for (int x = 0; x < 8; ++x) { const int2 v = *(const int2*)(p.part + ((size_t)x * T_TOK + t) * 128 + 2 * lane); s0 += v.x; s1 += v.y; }
        const float xs = p.xsc[t];
        const unsigned ew = *(const unsigned*)(p.eperm + (size_t)t * 128 + 2 * lane);
        const int ea = (int)(ew & 0xffffu), eb = (int)(ew >> 16);
        const float2 g = *(const float2*)(p.gate + (size_t)t * 128 + 2 * lane);
        const float a0 = g.x * gelu_erf((float)s0 * xs * p.dscale[ea]) * p.uscale[ea];
        const float a1 = g.y * gelu_erf((float)s1 * xs * p.dscale[eb]) * p.uscale[eb];
        const float amax = wave_max(fmaxf(fabsf(a0), fabsf(a1)));
        const float inv = amax > 0.f ? 127.f / amax : 0.f;
        const unsigned q0 = (unsigned)((int)rintf(a0 * inv) & 255), q1 = (unsigned)((int)rintf(a1 * inv) & 255);
        *(unsigned short*)(p.aq + (size_t)t * 128 + 2 * lane) = (unsigned short)(q0 | (q1 << 8));
        if (lane == 0) p.asc[t] = amax * (1.f / 127.f);
    }
}
DEVI void st_expC(const Params& p) {
    const int lane = threadIdx.x & 63, wid = threadIdx.x >> 6;
    for (int t = blockIdx.x * 4 + wid; t < T_TOK; t += gridDim.x * 4) {
        const float4* row = (const float4*)((const float*)p.proj + (size_t)t * 1024);
        float4 v[4];
        float ss = 0.f;
#pragma unroll
        for (int j = 0; j < 4; ++j) { v[j] = row[lane + 64 * j]; ss += v[j].x * v[j].x + v[j].y * v[j].y + v[j].z * v[j].z + v[j].w * v[j].w; }
        ss = wave_sum(ss);
        const float rf = rsqrtf(ss * (1.f / 1024.f) + EPSN);
        float4* orow = (float4*)(p.out + (size_t)t * 1024);
#pragma unroll
        for (int j = 0; j < 4; ++j) {
            const float4 g = *(const float4*)(p.final_g + (lane + 64 * j) * 4);
            orow[lane + 64 * j] = make_float4(v[j].x * rf * g.x, v[j].y * rf * g.y, v[j].z * rf * g.z, v[j].w * rf * g.w);
        }
    }
}

constexpr int LDS_BYTES = 75 * 1024;
constexpr int LDS_BARW = LDS_BYTES - 16;
extern __shared__ __attribute__((aligned(16))) char smem_dyn[];
__global__ void __launch_bounds__(NTHR, 2) mega_fwd(Params p) {
    cg::grid_group grid = cg::this_grid();
    volatile LAS unsigned* bst = (volatile LAS unsigned*)(LAS char*)(smem_dyn + LDS_BARW);
    if (threadIdx.x < 4) bst[threadIdx.x] = 0u;
    __syncthreads();
    XcdBarrier bar = xcd_barrier_post(p.bar, bst);
    st_prep_misc(p);
    st_prep_tables(p);
    st_prep_w(p, smem_dyn);
    st_prep_wsub(p, smem_dyn);
    st_prep_x(p, smem_dyn);
    grid.sync();
    st_gemm(p.xb, p.W1t, NPJ, 1024, smem_dyn, EpiProj{p.proj, p.rs1});
    xcd_barrier(bar);
    st_conv_qk(p, smem_dyn);
    xcd_barrier(bar);
    st_recur(p, smem_dyn);
    xcd_barrier(bar);
    st_gate(p);
    xcd_barrier(bar);
    st_gemm(p.yb, p.W2t, 1024, 1024, smem_dyn, EpiX1{p.x, p.out});
    xcd_barrier(bar);
    st_norm2(p);
    xcd_barrier(bar);
    st_gemm3_topk(p, smem_dyn);
    xcd_barrier(bar);
    st_expAB<0>(p, smem_dyn);
    xcd_barrier(bar);
    st_expA2(p);
    xcd_barrier(bar);
    st_expAB<1>(p, smem_dyn);
    xcd_barrier(bar);
    st_expC(p);
}

extern "C" void kernel_launch(void* const* d_in, const int* in_sizes, int n_in, void* d_out, int out_size, void* d_ws, size_t ws_size,
                              hipStream_t stream) {
    Params p{};
    const float* const* in = (const float* const*)d_in;
    p.x = in[0]; p.norm1_g = in[1]; p.w_in = in[2]; p.ret_norm_g = in[3]; p.m_conv_w = in[4]; p.m_conv_b = in[5]; p.m_wq = in[6]; p.m_wk = in[7];
    p.m_b_i = in[8]; p.m_b_f = in[9]; p.m_norm_g = in[10]; p.m_skip = in[11]; p.w_out = in[12]; p.norm2_g = in[13]; p.peer_wq = in[14];
    p.peer_keys = in[15]; p.peer_down = in[16]; p.peer_up = in[17]; p.final_g = in[18];
    p.out = (float*)d_out;
    char* ws = (char*)d_ws;
    size_t off = 0;
    auto take = [&](size_t bytes) { char* r = ws + off; off += (bytes + 255) & ~(size_t)255; return r; };
    p.proj = (bf16_t*)take((size_t)T_TOK * NPJ * 2);
    p.xb = (bf16_t*)take((size_t)T_TOK * 1024 * 2);
    p.yb = p.xb;
    p.gate = (float*)(ws + (size_t)T_TOK * 2048 * 4);
    p.mq = (bf16_t*)take((size_t)T_TOK * 512 * 2);
    p.mk = (bf16_t*)take((size_t)T_TOK * 512 * 2);
    p.x1b = p.mq;
    p.cbuf = (bf16_t*)take((size_t)T_TOK * 512 * 2);
    p.eperm = (unsigned short*)p.cbuf;
    p.down_q = (unsigned char*)take((size_t)16384 * 1024);
    p.up_q = (unsigned char*)take((size_t)16384 * 1024);
    p.dscale = (float*)take(16384 * 4);
    p.uscale = (float*)take(16384 * 4);
    p.bar = (unsigned*)take(CTL_WORDS * 4);
    p.xq = (unsigned char*)take((size_t)T_TOK * 1024);
    p.xsc = (float*)take(T_TOK * 4);
    p.asc = (float*)take(T_TOK * 4);
    p.aq = (unsigned char*)take((size_t)T_TOK * 128);
    p.part = (int*)(ws + (size_t)T_TOK * 1024 * 4);
    p.W1t = (bf16_t*)take((size_t)NPJ * 1024 * 2);
    p.W2t = (bf16_t*)take((size_t)1024 * 1024 * 2);
    p.Wsubt = (bf16_t*)take((size_t)2048 * 1024 * 2);
    p.Wqt = (bf16_t*)take(4 * 128 * 128 * 2);
    p.Wkt = (bf16_t*)take(4 * 128 * 128 * 2);
    p.rs1 = (float*)take(T_TOK * 4);
    p.rs2 = (float*)take(T_TOK * 4);
    p.ipre = (float*)take(T_TOK * 4 * 4);
    p.logf = (float*)take(T_TOK * 4 * 4);
    p.rope_cos = (float*)take(2048 * 64 * 4);
    p.rope_sin = (float*)take(2048 * 64 * 4);
    if (off > ws_size) { fprintf(stderr, "kernel_launch: workspace too small (%zu > %zu)\n", off, ws_size); return; }

    static int grid_blocks = 0;
    if (!grid_blocks) {
        int dev = 0, cus = 0, per_cu = 0;
        (void)hipGetDevice(&dev);
        (void)hipDeviceGetAttribute(&cus, hipDeviceAttributeMultiprocessorCount, dev);
        (void)hipFuncSetAttribute((const void*)mega_fwd, hipFuncAttributeMaxDynamicSharedMemorySize, LDS_BYTES);
        (void)hipOccupancyMaxActiveBlocksPerMultiprocessor(&per_cu, (const void*)mega_fwd, NTHR, LDS_BYTES);
        if (per_cu > 2) per_cu = 2;
        if (per_cu < 1) per_cu = 1;
        grid_blocks = cus * per_cu;
    }
    (void)hipMemsetAsync(p.bar, 0, CTL_WORDS * 4, stream);
    void* args[] = {&p};
    hipError_t e = hipLaunchCooperativeKernel((const void*)mega_fwd, dim3(grid_blocks), dim3(NTHR), args, LDS_BYTES, stream);
    if (e != hipSuccess) fprintf(stderr, "cooperative launch failed: %s (grid %d)\n", hipGetErrorString(e), grid_blocks);
}
```

```cpp
#include <hip/hip_runtime.h>
#include <hip/hip_cooperative_groups.h>
#include <stdint.h>
#include <cstdio>
namespace cg = cooperative_groups;

typedef unsigned short bf16_t;
typedef short bf16x8 __attribute__((ext_vector_type(8)));
typedef float f32x4 __attribute__((ext_vector_type(4)));

#define DEVI __device__ __forceinline__

constexpr int T_TOK = 32768, DM = 1024, NPJ = 3584, DIN = 3592;
constexpr int NTHR = 512, NW = 8;
constexpr float EPSN = 1e-6f;

struct Params {
    const float *x, *norm1_g, *w_in, *ret_norm_g, *m_conv_w, *m_conv_b, *m_wq, *m_wk, *m_b_i, *m_b_f, *m_norm_g, *m_skip, *w_out,
        *norm2_g, *peer_wq, *peer_keys, *peer_down, *peer_up, *final_g;
    float* out;
    bf16_t *proj, *xb, *yb, *mq, *mk, *x1b, *cbuf, *W1t, *W2t, *Wsubt, *Wqt, *Wkt;
    unsigned char *down_q, *up_q;
    float *dscale, *uscale, *xsc, *asc;
    unsigned short* eperm;
    unsigned char* aq;
    int* part;
    unsigned char* xq;
    unsigned* bar;
    float *rs1, *rs2, *ipre, *logf, *rope_cos, *rope_sin, *gate;
    int pad_[2];
};

DEVI unsigned f2bf_bits(float f) { unsigned u = __float_as_uint(f); return (u + 0x7fffu + ((u >> 16) & 1u)) >> 16; }
DEVI bf16_t f2bf(float f) { return (bf16_t)f2bf_bits(f); }
DEVI unsigned pk2(float lo, float hi) { return f2bf_bits(lo) | (f2bf_bits(hi) << 16); }
DEVI float bflo(unsigned w) { return __uint_as_float(w << 16); }
DEVI float bfhi(unsigned w) { return __uint_as_float(w & 0xffff0000u); }
DEVI float bf2f(bf16_t h) { return __uint_as_float(((unsigned)h) << 16); }
DEVI float wave_sum(float v) {
#pragma unroll
    for (int o = 32; o; o >>= 1) v += __shfl_xor(v, o);
    return v;
}
DEVI float wave_max(float v) {
#pragma unroll
    for (int o = 32; o; o >>= 1) v = fmaxf(v, __shfl_xor(v, o));
    return v;
}
DEVI f32x4 mfma16(bf16x8 a, bf16x8 b, f32x4 c) { return __builtin_amdgcn_mfma_f32_16x16x32_bf16(a, b, c, 0, 0, 0); }
DEVI bf16x8 ld8(const char* p) { return *reinterpret_cast<const bf16x8*>(p); }
DEVI bf16x8 mk8(uint2 lo, uint2 hi) {
    union { uint4 u; bf16x8 v; } x;
    x.u = make_uint4(lo.x, lo.y, hi.x, hi.y);
    return x.v;
}
DEVI float sigmoidf_(float z) { return 1.f / (1.f + __expf(-z)); }

DEVI void st_prep_misc(const Params& p) {
    const int gtid = blockIdx.x * NTHR + threadIdx.x, gsz = gridDim.x * NTHR;
    for (int i = gtid; i < 2048 * 64; i += gsz) {
        const int pos = i >> 6, j = i & 63;
        const float inv = powf(10000.f, -(float)j * (1.f / 64.f));
        const float ang = (float)pos * inv;
        float s, c;
        sincosf(ang, &s, &c);
        p.rope_cos[i] = c;
        p.rope_sin[i] = s;
    }
    for (int i = gtid; i < 4 * 128 * 128; i += gsz) {
        const int h = i >> 14, e = (i >> 7) & 127, d = i & 127;
        p.Wqt[i] = f2bf(p.m_wq[h * 16384 + d * 128 + e]);
        p.Wkt[i] = f2bf(p.m_wk[h * 16384 + d * 128 + e] * 0.08838834764831845f);
    }
}
DEVI void st_prep_tables(const Params& p) {
    const int lane = threadIdx.x & 63, wid = threadIdx.x >> 6;
    for (int row = blockIdx.x * NW + wid; row < 32768; row += gridDim.x * NW) {
        const bool up = row >= 16384;
        const int e = up ? row - 16384 : row;
        const float4* s = (const float4*)((up ? p.peer_up : p.peer_down) + (size_t)e * 1024 + lane * 16);
        float4 v[4];
        float am = 0.f;
#pragma unroll
        for (int i = 0; i < 4; ++i) {
            v[i] = s[i];
            am = fmaxf(am, fmaxf(fmaxf(fabsf(v[i].x), fabsf(v[i].y)), fmaxf(fabsf(v[i].z), fabsf(v[i].w))));
        }
        am = wave_max(am);
        const float sc = am > 0.f ? am * (1.f / 127.f) : 1.f, inv = am > 0.f ? 127.f / am : 0.f;
        const int ofs = 0;
        unsigned w[4];
#pragma unroll
        for (int i = 0; i < 4; ++i) {
            const int q0 = (int)rintf(v[i].x * inv) + ofs, q1 = (int)rintf(v[i].y * inv) + ofs, q2 = (int)rintf(v[i].z * inv) + ofs, q3 = (int)rintf(v[i].w * inv) + ofs;
            w[i] = (unsigned)(q0 & 255) | ((unsigned)(q1 & 255) << 8) | ((unsigned)(q2 & 255) << 16) | ((unsigned)(q3 & 255) << 24);
        }
        *(uint4*)((up ? p.up_q : p.down_q) + ((size_t)(lane >> 3) * 16384 + e) * 128 + (lane & 7) * 16) = make_uint4(w[0], w[1], w[2], w[3]);
        if (lane == 0) (up ? p.uscale : p.dscale)[e] = sc;
    }
}

DEVI void transpose_tile(const float* __restrict__ src, int ld, const float* __restrict__ scale, bf16_t* __restrict__ dst, int K, int k0, int n0,
                         float* tile) {
    const int tx = threadIdx.x & 31, ty = (threadIdx.x >> 5) & 7;
    const bool act = threadIdx.x < 256;
    if (act) {
#pragma unroll
        for (int i = 0; i < 4; ++i) {
            const int k = k0 + ty + 8 * i;
            float v = src[(size_t)k * ld + n0 + tx];
            if (scale) v *= scale[k];
            tile[(ty + 8 * i) * 33 + tx] = v;
        }
    }
    __syncthreads();
    if (act) {
#pragma unroll
        for (int i = 0; i < 4; ++i) {
            const int n = n0 + ty + 8 * i;
            dst[(size_t)n * K + k0 + tx] = f2bf(tile[tx * 33 + ty + 8 * i]);
        }
    }
    __syncthreads();
}
DEVI void st_prep_w(const Params& p, char* smem) {
    float* tile = (float*)smem;
    constexpr int N1 = (NPJ / 32) * 32, N2 = 32 * 32;
    for (int it = blockIdx.x; it < N1 + N2; it += gridDim.x) {
        if (it < N1) {
            const int nt = it >> 5, kt = it & 31;
            transpose_tile(p.w_in, DIN, p.norm1_g, p.W1t, 1024, kt * 32, nt * 32, tile);
        } else {
            const int r = it - N1, nt = r >> 5, kt = r & 31;
            transpose_tile(p.w_out, 1024, nullptr, p.W2t, 1024, kt * 32, nt * 32, tile);
        }
    }
}
DEVI void st_prep_wsub(const Params& p, char* smem) {
    float* wq_s = (float*)smem;
    float* key_s = wq_s + 32 * 129 + 16;
    const int tid = threadIdx.x & 255;
    const bool act = threadIdx.x < 256;
    for (int it = blockIdx.x; it < 16 * 32 * 2; it += gridDim.x) {
        const int grp = it >> 6, kt = (it >> 1) & 31, nh = it & 1, k0 = kt * 32;
        if (act) {
#pragma unroll
            for (int i = 0; i < 16; ++i) {
                const int idx = tid + 256 * i, r = idx >> 7, d = idx & 127;
                wq_s[r * 129 + d] = p.peer_wq[(size_t)(k0 + r) * 2048 + grp * 128 + d];
            }
#pragma unroll
            for (int i = 0; i < 32; ++i) {
                const int idx = tid + 256 * i, n = idx >> 7, d = idx & 127;
                key_s[n * 128 + d] = p.peer_keys[((size_t)grp * 128 + nh * 64 + n) * 128 + d];
            }
        }
        __syncthreads();
        if (act) {
            const int kl = tid & 31, ng = tid >> 5;
            float acc[8];
#pragma unroll
            for (int i = 0; i < 8; ++i) acc[i] = 0.f;
            for (int d = 0; d < 128; ++d) {
                const float a = wq_s[kl * 129 + d];
#pragma unroll
                for (int i = 0; i < 8; ++i) acc[i] += a * key_s[(ng * 8 + i) * 128 + d];
            }
            const float g = p.norm2_g[k0 + kl];
#pragma unroll
            for (int i = 0; i < 8; ++i) p.Wsubt[(size_t)(grp * 128 + nh * 64 + ng * 8 + i) * 1024 + k0 + kl] = f2bf(acc[i] * g);
        }
        __syncthreads();
    }
}

DEVI void st_prep_x(const Params& p, char* smem) {
    float* Wg_s = (float*)smem;
    for (int i = threadIdx.x; i < 8192; i += NTHR) {
        const int k = i >> 3, g = i & 7;
        Wg_s[g * 1024 + k] = p.norm1_g[k] * p.w_in[(size_t)k * DIN + NPJ + g];
    }
    __syncthreads();
    const int lane = threadIdx.x & 63, wid = threadIdx.x >> 6;
    for (int t = blockIdx.x * NW + wid; t < T_TOK; t += gridDim.x * NW) {
        const float4* xr = (const float4*)(p.x + (size_t)t * 1024);
        float4 v[4];
        float ss = 0.f, g8[8];
#pragma unroll
        for (int g = 0; g < 8; ++g) g8[g] = 0.f;
#pragma unroll
        for (int j = 0; j < 4; ++j) {
            v[j] = xr[lane + 64 * j];
            ss += v[j].x * v[j].x + v[j].y * v[j].y + v[j].z * v[j].z + v[j].w * v[j].w;
#pragma unroll
            for (int g = 0; g < 8; ++g) {
                const float4 w = *(const float4*)(Wg_s + g * 1024 + (lane + 64 * j) * 4);
                g8[g] += v[j].x * w.x + v[j].y * w.y + v[j].z * w.z + v[j].w * w.w;
            }
        }
        ss = wave_sum(ss);
#pragma unroll
        for (int g = 0; g < 8; ++g) g8[g] = wave_sum(g8[g]);
        const float rs = rsqrtf(ss * (1.f / 1024.f) + EPSN);
        uint2* o = (uint2*)(p.xb + (size_t)t * 1024);
#pragma unroll
        for (int j = 0; j < 4; ++j) o[lane + 64 * j] = make_uint2(pk2(v[j].x, v[j].y), pk2(v[j].z, v[j].w));
        if (lane == 0) {
            p.rs1[t] = rs;
#pragma unroll
            for (int h = 0; h < 4; ++h) {
                p.ipre[t * 4 + h] = g8[h] * rs + p.m_b_i[h];
                const float z = g8[4 + h] * rs + p.m_b_f[h];
                p.logf[t * 4 + h] = fminf(z, 0.f) - log1pf(__expf(-fabsf(z)));
            }
        }
    }
}

namespace pg8 {
#define PG8_LAS __attribute__((address_space(3)))
typedef unsigned short bf16_t;
typedef short bf16x8 __attribute__((ext_vector_type(8)));
typedef float f32x4 __attribute__((ext_vector_type(4)));
typedef unsigned u32x4 __attribute__((ext_vector_type(4)));
constexpr int BM = 256, BK = 64, HALF = 128, HTB = HALF * BK * 2  , STAGE_BYTES = 8 * HTB, NXCD = 8, WGM = 8;

__host__ __device__ __forceinline__ int lds_byte(int r, int c) { const int st = (r >> 4) * 2 + (c >> 5), rr = r & 15, cc = c & 31, ob = rr * 64 + cc * 2; return st * 1024 + (ob ^ (((ob >> 9) & 1) << 5)); }
__host__ __device__ __forceinline__ void stage_rc(int b, int& R, int& C) { const int st = b / 1024, sb = b % 1024, swz = sb ^ (((sb >> 9) & 1) << 5); R = (st >> 1) * 16 + swz / 64; C = (st & 1) * 32 + (swz % 64) / 2; }
__host__ __device__ __forceinline__ int perm32(int rho) { const int n = rho >> 4, i = rho & 15; return 8 * (i >> 2) + 4 * n + (i & 3); }

struct Unit { int pm, pn; };
struct Gemm { const bf16_t* A; const bf16_t* Bt; int M, N, K; };

struct StaticOrder {
    int nM, nN, nwg, G, c;
    __host__ __device__ void init(int M, int N, int G_, int c_) { nM = M / BM; nN = N / BM; nwg = nM * nN; G = G_; c = c_; }
    __host__ __device__ bool next(int i, Unit& u) const {
        const long L = (long)i * G + c; if (L >= nwg) return false;
        int wgid = (int)L; { const int q = nwg / NXCD, r = nwg % NXCD, xcd = wgid % NXCD, off = wgid / NXCD; wgid = (xcd < r ? xcd * (q + 1) : r * (q + 1) + (xcd - r) * q) + off; }
        const int nig = WGM * nN, gid = wgid / nig, fm = gid * WGM, gsz = (nM - fm) < WGM ? (nM - fm) : WGM;
        u.pm = fm + ((wgid % nig) % gsz); u.pn = (wgid % nig) / gsz; return true;
    }
    __device__ __forceinline__ void a_ready(const Unit&) const {}
    __device__ __forceinline__ void done(const Unit&) const {}
};

__device__ __forceinline__ unsigned cvt_pk_bf16(float lo, float hi) { unsigned r; asm volatile("v_cvt_pk_bf16_f32 %0, %1, %2" : "=v"(r) : "v"(lo), "v"(hi)); return r; }

template <class Epi, class Sched, bool ALIGN_EPI = false, bool SP2 = false>
__device__ __forceinline__ void gemm_phase(PG8_LAS unsigned char* lds, const Gemm g, const Sched& S, const Epi& E) {
    const int tid = threadIdx.x, wid = __builtin_amdgcn_readfirstlane(tid >> 6), lane = tid & 63, wr = wid >> 2, wc = wid & 3, fr = lane & 15, fq = lane >> 4;
    const int K = g.K, nt = K / BK;
    unsigned voffA[2], voffB[2];
#pragma unroll
    for (int i = 0; i < 2; ++i) { int R, C; stage_rc(tid * 16 + i * 8192, R, C); const int Rb = Epi::PERM ? ((R & ~31) + perm32(R & 31)) : R;
        voffA[i] = (unsigned)(R * K + C) * 2u; voffB[i] = (unsigned)(Rb * K + C) * 2u; }
    const size_t kstep = (size_t)(BK * 2);
    const size_t hstep = (size_t)HALF * K * 2;
    const size_t tstep = 2 * hstep;
    const unsigned ldsw = (unsigned)wid * 1024u;
    const int aoff = lds_byte(wr * 64 + fr, fq * 8), boff = lds_byte(wc * 32 + fr, fq * 8);
#define PG8_SA(b, h) (((b) * 2 + (h)) * HTB)
#define PG8_SB(b, h) ((4 + (b) * 2 + (h)) * HTB)
#define PG8_STAGE(bufoff, gbase, voff) do { _Pragma("unroll") for (int _i = 0; _i < 2; ++_i) \
        __builtin_amdgcn_global_load_lds((const unsigned*)((const char*)(gbase) + (voff)[_i]), (PG8_LAS unsigned*)(lds + (bufoff) + ldsw + _i * 8192), 16, 0, 0); } while (0)
#define PG8_LDA(dst, b, h) do { _Pragma("unroll") for (int m = 0; m < 4; ++m) _Pragma("unroll") for (int k = 0; k < 2; ++k) dst[m][k] = *(const PG8_LAS bf16x8*)(lds + PG8_SA(b, h) + aoff + m * 2048 + k * 1024); } while (0)
#define PG8_LDB(dst, b, h) do { _Pragma("unroll") for (int n = 0; n < 2; ++n) _Pragma("unroll") for (int k = 0; k < 2; ++k) dst[n][k] = *(const PG8_LAS bf16x8*)(lds + PG8_SB(b, h) + boff + n * 2048 + k * 1024); } while (0)
#define PG8_MMA(ai, bj, At, Bt) do { __builtin_amdgcn_s_setprio(1); _Pragma("unroll") for (int m = 0; m < 4; ++m) _Pragma("unroll") for (int n = 0; n < 2; ++n) _Pragma("unroll") for (int k = 0; k < 2; ++k) \
        acc[ai][bj][m][n] = __builtin_amdgcn_mfma_f32_16x16x32_bf16(Bt[n][k], At[m][k], acc[ai][bj][m][n], 0, 0, 0); __builtin_amdgcn_s_setprio(0); } while (0)
#define PG8_WAIT_V(n) asm volatile("s_waitcnt vmcnt(" #n ")" ::: "memory")
#define PG8_WAIT_L(n) asm volatile("s_waitcnt lgkmcnt(" #n ")" ::: "memory")
#define PG8_BAR __builtin_amdgcn_s_barrier()
#define PG8_SCHED __builtin_amdgcn_sched_barrier(0)
    Unit cur, nxt; int ui = 0;
    if (!S.next(0, cur)) return;
    f32x4 acc[2][2][4][2];
#pragma unroll
    for (int a = 0; a < 2; ++a)
#pragma unroll
        for (int b = 0; b < 2; ++b)
#pragma unroll
            for (int m = 0; m < 4; ++m)
#pragma unroll
                for (int n = 0; n < 2; ++n) acc[a][b][m][n] = (f32x4){0.f, 0.f, 0.f, 0.f};
    bf16x8 At[4][2], B0[2][2], B1[2][2];
    const char* cA = (const char*)g.A + (size_t)cur.pm * tstep; const char* cB = (const char*)g.Bt + (size_t)cur.pn * tstep;
    S.a_ready(cur);
    if constexpr (SP2) {
        PG8_STAGE(PG8_SB(0, 0), cB, voffB); PG8_STAGE(PG8_SB(0, 1), cB + hstep, voffB); PG8_STAGE(PG8_SA(0, 0), cA, voffA); PG8_STAGE(PG8_SA(0, 1), cA + hstep, voffA);
        if (wr == 1) PG8_BAR;
        PG8_WAIT_V(2); PG8_BAR;
        PG8_STAGE(PG8_SB(1, 0), cB + kstep, voffB); PG8_STAGE(PG8_SA(1, 0), cA + kstep, voffA); PG8_STAGE(PG8_SB(1, 1), cB + hstep + kstep, voffB);
        PG8_WAIT_V(6); PG8_BAR;
    } else {
        PG8_STAGE(PG8_SB(0, 0), cB, voffB); PG8_STAGE(PG8_SA(0, 0), cA, voffA); PG8_STAGE(PG8_SB(0, 1), cB + hstep, voffB); PG8_STAGE(PG8_SA(0, 1), cA + hstep, voffA);
        if (wr == 1) PG8_BAR;
        PG8_WAIT_V(4); PG8_BAR;
        PG8_STAGE(PG8_SB(1, 0), cB + kstep, voffB); PG8_STAGE(PG8_SA(1, 0), cA + kstep, voffA); PG8_STAGE(PG8_SB(1, 1), cB + hstep + kstep, voffB);
        PG8_WAIT_V(6); PG8_BAR;
    }
    for (;;) {
        const bool has_next = S.next(ui + 1, nxt);
        const char* nA = has_next ? (const char*)g.A + (size_t)nxt.pm * tstep : cA; const char* nB = has_next ? (const char*)g.Bt + (size_t)nxt.pn * tstep : cB;
        for (int t = 0; t < nt; t += 2) {
            const bool last = (t == nt - 2);
            const char* a1 = cA + (size_t)(t + 1) * kstep;
            const char* a2 = last ? nA : cA + (size_t)(t + 2) * kstep; const char* b2 = last ? nB : cB + (size_t)(t + 2) * kstep;
            const char* a3 = a2 + kstep; const char* b3 = b2 + kstep;
            if (last && has_next) S.a_ready(nxt);
            if constexpr (SP2) {
            PG8_LDB(B0, 0, 0); PG8_LDB(B1, 0, 1); PG8_SCHED; PG8_LDA(At, 0, 0); PG8_STAGE(PG8_SA(1, 1), a1 + hstep, voffA);
            PG8_WAIT_V(8); PG8_WAIT_L(0); PG8_BAR; PG8_MMA(0, 0, At, B0); PG8_MMA(0, 1, At, B1); PG8_BAR; PG8_SCHED;
            PG8_LDA(At, 0, 1); PG8_STAGE(PG8_SB(0, 0), b2, voffB); PG8_STAGE(PG8_SB(0, 1), b2 + hstep, voffB); PG8_STAGE(PG8_SA(0, 0), a2, voffA);
            PG8_WAIT_V(8); PG8_WAIT_L(0); PG8_BAR; PG8_MMA(1, 0, At, B0); PG8_MMA(1, 1, At, B1); PG8_BAR; PG8_SCHED;
            PG8_LDB(B0, 1, 0); PG8_LDB(B1, 1, 1); PG8_SCHED; PG8_LDA(At, 1, 0); PG8_STAGE(PG8_SA(0, 1), a2 + hstep, voffA);
            PG8_WAIT_V(8); PG8_WAIT_L(0); PG8_BAR; PG8_MMA(0, 0, At, B0); PG8_MMA(0, 1, At, B1); PG8_BAR; PG8_SCHED;
            PG8_LDA(At, 1, 1); PG8_STAGE(PG8_SB(1, 0), b3, voffB); PG8_STAGE(PG8_SB(1, 1), b3 + hstep, voffB); PG8_STAGE(PG8_SA(1, 0), a3, voffA);
            PG8_WAIT_V(8); PG8_WAIT_L(0); PG8_BAR; PG8_MMA(1, 0, At, B0); PG8_MMA(1, 1, At, B1); PG8_BAR; PG8_SCHED;
            } else {
            PG8_LDB(B0, 0, 0); PG8_SCHED; PG8_LDA(At, 0, 0); PG8_STAGE(PG8_SA(1, 1), a1 + hstep, voffA);
            PG8_WAIT_L(8); PG8_BAR; PG8_WAIT_L(0); PG8_MMA(0, 0, At, B0); PG8_BAR; PG8_SCHED;
            PG8_LDB(B1, 0, 1); PG8_STAGE(PG8_SB(0, 0), b2, voffB);
            PG8_BAR; PG8_WAIT_L(0); PG8_MMA(0, 1, At, B1); PG8_BAR;
            PG8_LDA(At, 0, 1); PG8_STAGE(PG8_SA(0, 0), a2, voffA);
            PG8_BAR; PG8_WAIT_L(0); PG8_MMA(1, 0, At, B0); PG8_BAR; PG8_SCHED;
            PG8_STAGE(PG8_SB(0, 1), b2 + hstep, voffB);
            PG8_WAIT_V(6); PG8_BAR; PG8_MMA(1, 1, At, B1); PG8_BAR;
            PG8_LDB(B0, 1, 0); PG8_SCHED; PG8_LDA(At, 1, 0); PG8_STAGE(PG8_SA(0, 1), a2 + hstep, voffA);
            PG8_WAIT_L(8); PG8_BAR; PG8_WAIT_L(0); PG8_MMA(0, 0, At, B0); PG8_BAR; PG8_SCHED;
            PG8_LDB(B1, 1, 1); PG8_STAGE(PG8_SB(1, 0), b3, voffB);
            PG8_BAR; PG8_WAIT_L(0); PG8_MMA(0, 1, At, B1); PG8_BAR;
            PG8_LDA(At, 1, 1); PG8_STAGE(PG8_SA(1, 0), a3, voffA);
            PG8_BAR; PG8_WAIT_L(0); PG8_MMA(1, 0, At, B0); PG8_BAR; PG8_SCHED;
            PG8_STAGE(PG8_SB(1, 1), b3 + hstep, voffB);
            PG8_WAIT_V(6); PG8_BAR; PG8_MMA(1, 1, At, B1); PG8_BAR;
            }
        }
        if constexpr (ALIGN_EPI) { if (wr == 0) PG8_BAR; }
        if constexpr (!Epi::AFTER_DRAIN) { E(acc, cur, wr, wc, fr, fq); S.done(cur); }
        if (!has_next) break;
#pragma unroll
        for (int a = 0; a < 2; ++a)
#pragma unroll
            for (int b = 0; b < 2; ++b)
#pragma unroll
                for (int m = 0; m < 4; ++m)
#pragma unroll
                    for (int n = 0; n < 2; ++n) acc[a][b][m][n] = (f32x4){0.f, 0.f, 0.f, 0.f};
        cur = nxt; cA = nA; cB = nB; ++ui;
        if constexpr (ALIGN_EPI) { if (wr == 1) PG8_BAR; }
    }
    PG8_WAIT_V(0);
    if constexpr (!ALIGN_EPI) { if (wr == 0) PG8_BAR; }
    PG8_BAR;
    if constexpr (Epi::AFTER_DRAIN) { E.fused(acc, cur, wr, wc, fr, fq, lds, wid, lane); S.done(cur); }
#undef PG8_SA
#undef PG8_SB
#undef PG8_STAGE
#undef PG8_LDA
#undef PG8_LDB
#undef PG8_MMA
#undef PG8_WAIT_V
#undef PG8_WAIT_L
#undef PG8_BAR
#undef PG8_SCHED
}
}

#ifndef PG8_SP2
#define PG8_SP2 true
#endif
#ifndef PG8_ALIGN
#define PG8_ALIGN true
#endif
struct EpiProj8 {
    static constexpr bool PERM = true, AFTER_DRAIN = false;
    bf16_t* O; const float* rs;
    __device__ __forceinline__ void operator()(const pg8::f32x4 (&acc)[2][2][4][2], const pg8::Unit& u, int wr, int wc, int fr, int fq) const {
        const int row0 = u.pm * 256 + wr * 64 + fr, col0 = u.pn * 256 + wc * 32 + 8 * fq;
#pragma unroll
        for (int ai = 0; ai < 2; ++ai)
#pragma unroll
            for (int m = 0; m < 4; ++m) {
                const int row = row0 + ai * 128 + m * 16;
                const float s = rs[row];
                bf16_t* rowp = O + (size_t)row * NPJ + col0;
#pragma unroll
                for (int bj = 0; bj < 2; ++bj) {
                    const pg8::f32x4 v0 = acc[ai][bj][m][0] * s, v1 = acc[ai][bj][m][1] * s;
                    *(uint4*)(rowp + bj * 128) = make_uint4(pk2(v0[0], v0[1]), pk2(v0[2], v0[3]), pk2(v1[0], v1[1]), pk2(v1[2], v1[3]));
                }
            }
    }
};
struct EpiX18 {
    static constexpr bool PERM = false, AFTER_DRAIN = false;
    const float* x; float* out;
    __device__ __forceinline__ void operator()(const pg8::f32x4 (&acc)[2][2][4][2], const pg8::Unit& u, int wr, int wc, int fr, int fq) const {
        const int row0 = u.pm * 256 + wr * 64 + fr, col0 = u.pn * 256 + wc * 32 + 4 * fq;
#pragma unroll
        for (int ai = 0; ai < 2; ++ai)
#pragma unroll
            for (int m = 0; m < 4; ++m) {
                const size_t ro = (size_t)(row0 + ai * 128 + m * 16) * 1024 + col0;
#pragma unroll
                for (int bj = 0; bj < 2; ++bj)
#pragma unroll
                    for (int n = 0; n < 2; ++n) {
                        const float4 xv = *(const float4*)(x + ro + bj * 128 + n * 16);
                        const pg8::f32x4 v = acc[ai][bj][m][n];
                        *(float4*)(out + ro + bj * 128 + n * 16) = make_float4(xv.x + v[0], xv.y + v[1], xv.z + v[2], xv.w + v[3]);
                    }
            }
    }
};
template <class Epi, bool ALIGN>
DEVI void st_gemm8(const bf16_t* A, const bf16_t* Bt, int N, int K, char* smem, const Epi& epi) {
    pg8::Gemm g{A, Bt, T_TOK, N, K};
    pg8::StaticOrder S;
    S.init(T_TOK, N, (int)gridDim.x, (int)blockIdx.x);
    pg8::gemm_phase<Epi, pg8::StaticOrder, ALIGN, PG8_SP2>((PG8_LAS unsigned char*)smem, g, S, epi);
}

DEVI void st_conv_qk(const Params& p, char* smem) {
    char* cs = smem;
    char* ws = smem + 128 * 272;
    const int tid = threadIdx.x, lane = tid & 63, wid = tid >> 6, wr = wid >> 1, wc = wid & 1, fr = lane & 15, fq = lane >> 4;
    for (int it = blockIdx.x; it < 256 * 4; it += gridDim.x) {
        const int h = it & 3, t0 = (it >> 2) * 128, s0 = t0 & 2047;
        {
            const int ch = tid & 127, r0 = (tid >> 7) * 32;
            const int col = 2048 + h * 128 + ch;
            const float w0 = p.m_conv_w[0 * 512 + h * 128 + ch], w1 = p.m_conv_w[1 * 512 + h * 128 + ch], w2 = p.m_conv_w[2 * 512 + h * 128 + ch],
                        w3 = p.m_conv_w[3 * 512 + h * 128 + ch], bb = p.m_conv_b[h * 128 + ch];
            float xm3 = 0.f, xm2 = 0.f, xm1 = 0.f;
            if (s0 + r0 > 0) {
                xm3 = bf2f(p.proj[(size_t)(t0 + r0 - 3) * NPJ + col]);
                xm2 = bf2f(p.proj[(size_t)(t0 + r0 - 2) * NPJ + col]);
                xm1 = bf2f(p.proj[(size_t)(t0 + r0 - 1) * NPJ + col]);
            }
            for (int r = r0; r < r0 + 32; ++r) {
                const float xc = bf2f(p.proj[(size_t)(t0 + r) * NPJ + col]);
                const float y = bb + w0 * xm3 + w1 * xm2 + w2 * xm1 + w3 * xc;
                const float c = y * sigmoidf_(y);
                const bf16_t cb = f2bf(c);
                *(bf16_t*)(cs + r * 272 + ch * 2) = cb;
                p.cbuf[(size_t)(t0 + r) * 512 + h * 128 + ch] = cb;
                xm3 = xm2; xm2 = xm1; xm1 = xc;
            }
        }
#pragma unroll
        for (int which = 0; which < 2; ++which) {
            const bf16_t* W = (which ? p.Wkt : p.Wqt) + h * 16384;
            bf16_t* O = which ? p.mk : p.mq;
#pragma unroll
            for (int i = 0; i < 4; ++i) {
                const int id = tid + 512 * i, r = id >> 4, c = id & 15;
                *(uint4*)(ws + r * 272 + c * 16) = *(const uint4*)(W + r * 128 + c * 8);
            }
            __syncthreads();
            f32x4 acc[2][4];
#pragma unroll
            for (int i = 0; i < 2; ++i)
#pragma unroll
                for (int j = 0; j < 4; ++j) acc[i][j] = (f32x4){0.f, 0.f, 0.f, 0.f};
#pragma unroll
            for (int ks = 0; ks < 4; ++ks) {
                bf16x8 a[2], b[4];
#pragma unroll
                for (int i = 0; i < 2; ++i) a[i] = ld8(cs + (wr * 32 + i * 16 + fr) * 272 + (ks * 4 + fq) * 16);
#pragma unroll
                for (int j = 0; j < 4; ++j) b[j] = ld8(ws + (wc * 64 + j * 16 + fr) * 272 + (ks * 4 + fq) * 16);
#pragma unroll
                for (int i = 0; i < 2; ++i)
#pragma unroll
                    for (int j = 0; j < 4; ++j) acc[i][j] = mfma16(b[j], a[i], acc[i][j]);
            }
#pragma unroll
            for (int i = 0; i < 2; ++i)
#pragma unroll
                for (int j = 0; j < 4; ++j) {
                    const int m = t0 + wr * 32 + i * 16 + fr, n = h * 128 + wc * 64 + j * 16 + 4 * fq;
                    const f32x4 v = acc[i][j];
                    *(uint2*)(O + (size_t)m * 512 + n) = make_uint2(pk2(v[0], v[1]), pk2(v[2], v[3]));
                }
            __syncthreads();
        }
    }
}

DEVI void ret_item(const Params& p, char* smem, int b, int h, int vh, int tid) {
    char* qs = smem;
    char* ks = smem + 17408;
    char* kTs = smem + 34816;
    char* vTs = smem + 53248;
    char* Ss = smem + 62464;
    const int lane = tid & 63, w = tid >> 6, fr = lane & 15, fq = lane >> 4;
    const float gamma = 1.f - exp2f(-5.f - (float)h);
    const float l2g = log2f(gamma);
    const float g64 = exp2f(l2g * 64.f);
    f32x4 st[8];
#pragma unroll
    for (int i = 0; i < 8; ++i) st[i] = (f32x4){0.f, 0.f, 0.f, 0.f};
    for (int c = 0; c < 32; ++c) {
        const int t0 = b * 2048 + c * 64;
#pragma unroll
        for (int i = 0; i < 2; ++i) {
            const int u = tid + 256 * i, m = u >> 3, j0 = (u & 7) * 8;
            const int pos = c * 64 + m;
            const float4 c0 = *(const float4*)(p.rope_cos + pos * 64 + j0), c1 = *(const float4*)(p.rope_cos + pos * 64 + j0 + 4);
            const float4 s0 = *(const float4*)(p.rope_sin + pos * 64 + j0), s1 = *(const float4*)(p.rope_sin + pos * 64 + j0 + 4);
            const float cs_[8] = {c0.x, c0.y, c0.z, c0.w, c1.x, c1.y, c1.z, c1.w};
            const float sn_[8] = {s0.x, s0.y, s0.z, s0.w, s1.x, s1.y, s1.z, s1.w};
            const bf16_t* row = p.proj + (size_t)(t0 + m) * NPJ + h * 128 + j0;
            {
                const uint4 a = *(const uint4*)(row), bq = *(const uint4*)(row + 64);
                const unsigned aw[4] = {a.x, a.y, a.z, a.w}, bw[4] = {bq.x, bq.y, bq.z, bq.w};
                unsigned o1[4], o2[4];
#pragma unroll
                for (int e = 0; e < 4; ++e) {
                    const float t1a = bflo(aw[e]), t1b = bfhi(aw[e]), t2a = bflo(bw[e]), t2b = bfhi(bw[e]);
                    o1[e] = pk2(t1a * cs_[2 * e] - t2a * sn_[2 * e], t1b * cs_[2 * e + 1] - t2b * sn_[2 * e + 1]);
                    o2[e] = pk2(t1a * sn_[2 * e] + t2a * cs_[2 * e], t1b * sn_[2 * e + 1] + t2b * cs_[2 * e + 1]);
                }
                *(uint4*)(qs + m * 272 + j0 * 2) = make_uint4(o1[0], o1[1], o1[2], o1[3]);
                *(uint4*)(qs + m * 272 + (64 + j0) * 2) = make_uint4(o2[0], o2[1], o2[2], o2[3]);
            }
            {
                const uint4 a = *(const uint4*)(row + 512), bq = *(const uint4*)(row + 512 + 64);
                const unsigned aw[4] = {a.x, a.y, a.z, a.w}, bw[4] = {bq.x, bq.y, bq.z, bq.w};
                const float kd = exp2f(l2g * (float)(63 - m));
                const float sc = 0.08838834764831845f;
                unsigned o1[4], o2[4];
#pragma unroll
                for (int e = 0; e < 4; ++e) {
                    const float t1a = bflo(aw[e]), t1b = bfhi(aw[e]), t2a = bflo(bw[e]), t2b = bfhi(bw[e]);
                    const float r1a = (t1a * cs_[2 * e] - t2a * sn_[2 * e]) * sc, r1b = (t1b * cs_[2 * e + 1] - t2b * sn_[2 * e + 1]) * sc;
                    const float r2a = (t1a * sn_[2 * e] + t2a * cs_[2 * e]) * sc, r2b = (t1b * sn_[2 * e + 1] + t2b * cs_[2 * e + 1]) * sc;
                    o1[e] = pk2(r1a, r1b);
                    o2[e] = pk2(r2a, r2b);
                    *(bf16_t*)(kTs + (j0 + 2 * e) * 144 + m * 2) = f2bf(r1a * kd);
                    *(bf16_t*)(kTs + (j0 + 2 * e + 1) * 144 + m * 2) = f2bf(r1b * kd);
                    *(bf16_t*)(kTs + (64 + j0 + 2 * e) * 144 + m * 2) = f2bf(r2a * kd);
                    *(bf16_t*)(kTs + (64 + j0 + 2 * e + 1) * 144 + m * 2) = f2bf(r2b * kd);
                }
                *(uint4*)(ks + m * 272 + j0 * 2) = make_uint4(o1[0], o1[1], o1[2], o1[3]);
                *(uint4*)(ks + m * 272 + (64 + j0) * 2) = make_uint4(o2[0], o2[1], o2[2], o2[3]);
            }
            {
                const uint4 a = *(const uint4*)(p.proj + (size_t)(t0 + m) * NPJ + 1024 + h * 128 + vh * 64 + j0);
                const unsigned aw[4] = {a.x, a.y, a.z, a.w};
#pragma unroll
                for (int e = 0; e < 4; ++e) {
                    *(bf16_t*)(vTs + (j0 + 2 * e) * 144 + m * 2) = (bf16_t)(aw[e] & 0xffffu);
                    *(bf16_t*)(vTs + (j0 + 2 * e + 1) * 144 + m * 2) = (bf16_t)(aw[e] >> 16);
                }
            }
        }
        __syncthreads();
        {
            bf16x8 qf[4];
#pragma unroll
            for (int s = 0; s < 4; ++s) qf[s] = ld8(qs + (16 * w + fr) * 272 + (s * 4 + fq) * 16);
#pragma unroll
            for (int j = 0; j < 4; ++j) {
                f32x4 a = (f32x4){0.f, 0.f, 0.f, 0.f};
#pragma unroll
                for (int s = 0; s < 4; ++s) a = mfma16(ld8(ks + (16 * j + fr) * 272 + (s * 4 + fq) * 16), qf[s], a);
                const int l = 16 * w + fr, mb = 16 * j + 4 * fq;
                float v[4];
#pragma unroll
                for (int r = 0; r < 4; ++r) {
                    const int dd = l - (mb + r);
                    v[r] = a[r] * exp2f(l2g * (float)(dd < 0 ? -dd : dd));
                }
                *(uint2*)(Ss + l * 144 + mb * 2) = make_uint2(pk2(v[0], v[1]), pk2(v[2], v[3]));
            }
        }
        __syncthreads();
        {
            bf16x8 sp[4];
#pragma unroll
            for (int s = 0; s < 4; ++s)
                sp[s] = mk8(make_uint2(pk2(st[2 * s][0], st[2 * s][1]), pk2(st[2 * s][2], st[2 * s][3])),
                            make_uint2(pk2(st[2 * s + 1][0], st[2 * s + 1][1]), pk2(st[2 * s + 1][2], st[2 * s + 1][3])));
            bf16x8 vf[2];
#pragma unroll
            for (int s2 = 0; s2 < 2; ++s2) vf[s2] = ld8(vTs + (16 * w + fr) * 144 + (s2 * 4 + fq) * 16);
#pragma unroll
            for (int i = 0; i < 4; ++i) {
                f32x4 a = (f32x4){0.f, 0.f, 0.f, 0.f};
                const char* qrow = qs + (16 * i + fr) * 272;
#pragma unroll
                for (int s = 0; s < 4; ++s) {
                    const uint2 lo = *(const uint2*)(qrow + (32 * s + 4 * fq) * 2), hi = *(const uint2*)(qrow + (32 * s + 16 + 4 * fq) * 2);
                    a = mfma16(sp[s], mk8(lo, hi), a);
                }
                const float qd = exp2f(l2g * (float)(16 * i + fr + 1));
                a = a * qd;
#pragma unroll
                for (int s2 = 0; s2 < 2; ++s2) a = mfma16(vf[s2], ld8(Ss + (16 * i + fr) * 144 + (s2 * 4 + fq) * 16), a);
                *(uint2*)(p.proj + (size_t)(t0 + 16 * i + fr) * NPJ + 1024 + h * 128 + vh * 64 + 16 * w + 4 * fq) =
                    make_uint2(pk2(a[0], a[1]), pk2(a[2], a[3]));
            }
#pragma unroll
            for (int i = 0; i < 8; ++i) {
                f32x4 a = st[i] * g64;
#pragma unroll
                for (int s2 = 0; s2 < 2; ++s2) a = mfma16(ld8(kTs + (16 * i + fr) * 144 + (s2 * 4 + fq) * 16), vf[s2], a);
                st[i] = a;
            }
        }
        __syncthreads();
    }
}

DEVI void mlstm_item(const Params& p, char* smem, int b, int h, int vh, int tid) {
    char* qs = smem;
    char* kTs = smem + 17408;
    char* vTs = smem + 35840;
    float* n_s = (float*)(smem + 45056);
    float* qn_s = (float*)(smem + 45568);
    float* den_s = (float*)(smem + 46592);
    const int lane = tid & 63, w = tid >> 6, fr = lane & 15, fq = lane >> 4;
    f32x4 st[8];
#pragma unroll
    for (int i = 0; i < 8; ++i) st[i] = (f32x4){0.f, 0.f, 0.f, 0.f};
    float m_run = 0.f, n_reg = 0.f;
    for (int c = 0; c < 32; ++c) {
        const int t0 = b * 2048 + c * 64;
        const float iv = p.ipre[(t0 + lane) * 4 + h], fv = p.logf[(t0 + lane) * 4 + h];
        float fcum = fv;
#pragma unroll
        for (int o = 1; o < 64; o <<= 1) {
            const float tv = __shfl_up(fcum, o);
            if (lane >= o) fcum += tv;
        }
        const float a_c = __shfl(fcum, 63);
        const float logw = a_c - fcum + iv;
        const float m_in = wave_max(logw);
        const float m_new = fmaxf(a_c + m_run, m_in);
        const float decay = __expf(a_c + m_run - m_new);
        const float wgt = __expf(logw - m_new);
        const float emn = __expf(-m_new);
        m_run = m_new;
#pragma unroll
        for (int i = 0; i < 4; ++i) {
            const int u = tid + 256 * i, m = u >> 4, j0 = (u & 15) * 8;
            *(uint4*)(qs + m * 272 + j0 * 2) = *(const uint4*)(p.mq + (size_t)(t0 + m) * 512 + h * 128 + j0);
            const uint4 kk = *(const uint4*)(p.mk + (size_t)(t0 + m) * 512 + h * 128 + j0);
            const float wm = __shfl(wgt, m);
            const unsigned kw[4] = {kk.x, kk.y, kk.z, kk.w};
#pragma unroll
            for (int e = 0; e < 4; ++e) {
                *(bf16_t*)(kTs + (j0 + 2 * e) * 144 + m * 2) = f2bf(bflo(kw[e]) * wm);
                *(bf16_t*)(kTs + (j0 + 2 * e + 1) * 144 + m * 2) = f2bf(bfhi(kw[e]) * wm);
            }
        }
#pragma unroll
        for (int i = 0; i < 2; ++i) {
            const int u = tid + 256 * i, m = u >> 3, j0 = (u & 7) * 8;
            const uint4 a = *(const uint4*)(p.proj + (size_t)(t0 + m) * NPJ + 2560 + h * 128 + vh * 64 + j0);
            const unsigned aw[4] = {a.x, a.y, a.z, a.w};
#pragma unroll
            for (int e = 0; e < 4; ++e) {
                *(bf16_t*)(vTs + (j0 + 2 * e) * 144 + m * 2) = (bf16_t)(aw[e] & 0xffffu);
                *(bf16_t*)(vTs + (j0 + 2 * e + 1) * 144 + m * 2) = (bf16_t)(aw[e] >> 16);
            }
        }
        __syncthreads();
        if (tid < 128) {
            float s = 0.f;
#pragma unroll
            for (int q = 0; q < 8; ++q) {
                const uint4 a = *(const uint4*)(kTs + tid * 144 + q * 16);
                s += (bflo(a.x) + bfhi(a.x)) + (bflo(a.y) + bfhi(a.y)) + (bflo(a.z) + bfhi(a.z)) + (bflo(a.w) + bfhi(a.w));
            }
            n_reg = decay * n_reg + s;
            n_s[tid] = n_reg;
        }
        {
            bf16x8 vf[2];
#pragma unroll
            for (int s2 = 0; s2 < 2; ++s2) vf[s2] = ld8(vTs + (16 * w + fr) * 144 + (s2 * 4 + fq) * 16);
#pragma unroll
            for (int i = 0; i < 8; ++i) {
                f32x4 a = st[i] * decay;
#pragma unroll
                for (int s2 = 0; s2 < 2; ++s2) a = mfma16(ld8(kTs + (16 * i + fr) * 144 + (s2 * 4 + fq) * 16), vf[s2], a);
                st[i] = a;
            }
        }
        __syncthreads();
        {
            const int l = tid & 63, part = tid >> 6;
            float s = 0.f;
#pragma unroll
            for (int q = 0; q < 8; ++q) {
                const uint2 a = *(const uint2*)(qs + l * 272 + (part * 32 + 4 * q) * 2);
                const float* nn = n_s + part * 32 + 4 * q;
                s += bflo(a.x) * nn[0] + bfhi(a.x) * nn[1] + bflo(a.y) * nn[2] + bfhi(a.y) * nn[3];
            }
            qn_s[part * 64 + l] = s;
        }
        __syncthreads();
        if (tid < 64) den_s[tid] = fmaxf(fabsf(qn_s[tid] + qn_s[64 + tid] + qn_s[128 + tid] + qn_s[192 + tid]), emn);
        __syncthreads();
        {
            bf16x8 sp[4];
#pragma unroll
            for (int s = 0; s < 4; ++s)
                sp[s] = mk8(make_uint2(pk2(st[2 * s][0], st[2 * s][1]), pk2(st[2 * s][2], st[2 * s][3])),
                            make_uint2(pk2(st[2 * s + 1][0], st[2 * s + 1][1]), pk2(st[2 * s + 1][2], st[2 * s + 1][3])));
#pragma unroll
            for (int i = 0; i < 4; ++i) {
                f32x4 a = (f32x4){0.f, 0.f, 0.f, 0.f};
                const char* qrow = qs + (16 * i + fr) * 272;
#pragma unroll
                for (int s = 0; s < 4; ++s) {
                    const uint2 lo = *(const uint2*)(qrow + (32 * s + 4 * fq) * 2), hi = *(const uint2*)(qrow + (32 * s + 16 + 4 * fq) * 2);
                    a = mfma16(sp[s], mk8(lo, hi), a);
                }
                const float rd = 1.f / den_s[16 * i + fr];
                *(uint2*)(p.proj + (size_t)(t0 + 16 * i + fr) * NPJ + 2560 + h * 128 + vh * 64 + 16 * w + 4 * fq) =
                    make_uint2(pk2(a[0] * rd, a[1] * rd), pk2(a[2] * rd, a[3] * rd));
            }
        }
        __syncthreads();
    }
}
DEVI void st_recur(const Params& p, char* smem) {
    const int grp = threadIdx.x >> 8, ltid = threadIdx.x & 255;
    for (int bi = blockIdx.x; bi < 128; bi += gridDim.x) {
        const int kind = bi & 1, r = (bi >> 1) * 2 + grp, vh = r & 1, h = (r >> 1) & 3, b = r >> 3;
        if (kind == 0) ret_item(p, smem + grp * 73728, b, h, vh, ltid);
        else mlstm_item(p, smem + grp * 73728, b, h, vh, ltid);
    }
}

DEVI void st_gate(const Params& p) {
    const int lane = threadIdx.x & 63, wid = threadIdx.x >> 6;
    for (int t = blockIdx.x * NW + wid; t < T_TOK; t += gridDim.x * NW) {
        const bf16_t* pr = p.proj + (size_t)t * NPJ;
#pragma unroll
        for (int hh = 0; hh < 8; ++hh) {
            const bool ml = hh >= 4;
            const int h = hh & 3;
            const unsigned ow = *(const unsigned*)(pr + (ml ? 2560 : 1024) + h * 128 + 2 * lane);
            const float o0 = bflo(ow), o1 = bfhi(ow);
            const float mu = wave_sum(o0 + o1) * (1.f / 128.f);
            const float d0 = o0 - mu, d1 = o1 - mu;
            const float var = wave_sum(d0 * d0 + d1 * d1) * (1.f / 128.f);
            const float rstd = rsqrtf(var + EPSN);
            const float* gn = (ml ? p.m_norm_g : p.ret_norm_g) + h * 128 + 2 * lane;
            const float n0 = d0 * rstd * gn[0], n1 = d1 * rstd * gn[1];
            const unsigned gw = *(const unsigned*)(pr + (ml ? 3072 : 1536) + h * 128 + 2 * lane);
            const float g0 = bflo(gw), g1 = bfhi(gw);
            float y0, y1;
            if (!ml) {
                y0 = g0 * sigmoidf_(g0) * n0;
                y1 = g1 * sigmoidf_(g1) * n1;
            } else {
                const unsigned cw = *(const unsigned*)(p.cbuf + (size_t)t * 512 + h * 128 + 2 * lane);
                const float* sk = p.m_skip + h * 128 + 2 * lane;
                y0 = sigmoidf_(g0) * (n0 + sk[0] * bflo(cw));
                y1 = sigmoidf_(g1) * (n1 + sk[1] * bfhi(cw));
            }
            *(unsigned*)(p.yb + (size_t)t * 1024 + hh * 128 + 2 * lane) = pk2(y0, y1);
        }
    }
}

DEVI void st_norm2(const Params& p) {
    const int lane = threadIdx.x & 63, wid = threadIdx.x >> 6;
    for (int t = blockIdx.x * NW + wid; t < T_TOK; t += gridDim.x * NW) {
        float xv[16];
        float ss = 0.f;
#pragma unroll
        for (int i = 0; i < 4; ++i) {
            const float4 a = *(const float4*)(p.out + (size_t)t * 1024 + lane * 16 + i * 4);
            xv[4 * i] = a.x; xv[4 * i + 1] = a.y; xv[4 * i + 2] = a.z; xv[4 * i + 3] = a.w;
            ss += a.x * a.x + a.y * a.y + a.z * a.z + a.w * a.w;
        }
        ss = wave_sum(ss);
        const float rs = rsqrtf(ss * (1.f / 1024.f) + EPSN);
        uint4* ob = (uint4*)(p.x1b + (size_t)t * 1024 + lane * 16);
        ob[0] = make_uint4(pk2(xv[0], xv[1]), pk2(xv[2], xv[3]), pk2(xv[4], xv[5]), pk2(xv[6], xv[7]));
        ob[1] = make_uint4(pk2(xv[8], xv[9]), pk2(xv[10], xv[11]), pk2(xv[12], xv[13]), pk2(xv[14], xv[15]));
        float am = 0.f;
#pragma unroll
        for (int i = 0; i < 4; ++i) {
            const float4 g = *(const float4*)(p.norm2_g + lane * 16 + i * 4);
            xv[4 * i] *= rs * g.x; xv[4 * i + 1] *= rs * g.y; xv[4 * i + 2] *= rs * g.z; xv[4 * i + 3] *= rs * g.w;
        }
#pragma unroll
        for (int c = 0; c < 16; ++c) am = fmaxf(am, fabsf(xv[c]));
        am = wave_max(am);
        const float inv = am > 0.f ? 127.f / am : 0.f;
        unsigned w[4];
#pragma unroll
        for (int i = 0; i < 4; ++i) {
            const int q0 = (int)rintf(xv[4 * i] * inv), q1 = (int)rintf(xv[4 * i + 1] * inv), q2 = (int)rintf(xv[4 * i + 2] * inv), q3 = (int)rintf(xv[4 * i + 3] * inv);
            w[i] = (unsigned)(q0 & 255) | ((unsigned)(q1 & 255) << 8) | ((unsigned)(q2 & 255) << 16) | ((unsigned)(q3 & 255) << 24);
        }
        *(uint4*)(p.xq + (size_t)t * 1024 + lane * 16) = make_uint4(w[0], w[1], w[2], w[3]);
        if (lane == 0) { p.rs2[t] = rs; p.xsc[t] = am > 0.f ? am * (1.f / 127.f) : 1.f; }
    }
}

DEVI int f2key(float f) { const int b = __float_as_int(f); return b ^ ((b >> 31) & 0x7fffffff); }
DEVI float key2f(int k) { return __int_as_float(k ^ ((k >> 31) & 0x7fffffff)); }
template <int N> DEVI void bsort_desc(int (&v)[N]) {
#pragma unroll
    for (int k = 2; k <= N; k <<= 1)
#pragma unroll
        for (int j = k >> 1; j > 0; j >>= 1)
#pragma unroll
            for (int i = 0; i < N; ++i) {
                const int l = i ^ j;
                if (l > i) {
                    const int a = v[i], b = v[l];
                    const int mx = a > b ? a : b, mn = a > b ? b : a;
                    if ((i & k) == 0) { v[i] = mx; v[l] = mn; } else { v[i] = mn; v[l] = mx; }
                }
            }
}
template <int N> DEVI void bmerge_desc(int (&v)[N]) {
#pragma unroll
    for (int j = N >> 1; j > 0; j >>= 1)
#pragma unroll
        for (int i = 0; i < N; ++i) {
            const int l = i ^ j;
            if (l > i) { const int a = v[i], b = v[l]; v[i] = a > b ? a : b; v[l] = a > b ? b : a; }
        }
}
DEVI void xmerge16(int (&v)[16], int mask) {
    int o[16];
#pragma unroll
    for (int i = 0; i < 16; ++i) o[i] = __shfl_xor(v[15 - i], mask);
#pragma unroll
    for (int i = 0; i < 16; ++i) v[i] = v[i] > o[i] ? v[i] : o[i];
    bmerge_desc<16>(v);
}
__device__ const unsigned char cand_tab[52] = {
    0x00, 0x01, 0x02, 0x03, 0x04, 0x05, 0x06, 0x07, 0x08, 0x09, 0x0a, 0x0b, 0x0c, 0x0d, 0x0e, 0x0f,
    0x10, 0x11, 0x12, 0x13, 0x14, 0x15, 0x16, 0x17, 0x20, 0x21, 0x22, 0x23, 0x24, 0x30, 0x31, 0x32, 0x33,
    0x40, 0x41, 0x42, 0x50, 0x51, 0x60, 0x61, 0x70, 0x71, 0x80, 0x90, 0xa0, 0xb0, 0xc0, 0xd0, 0xe0, 0xf0, 0xff, 0xff};
constexpr int H_A = 256 * 64, H_B = 256 * 64, H_STAGE = H_A + H_B;
DEVI void glds16(const void* g, char* l) {
    __builtin_amdgcn_global_load_lds((const __attribute__((address_space(1))) unsigned*)g, (__attribute__((address_space(3))) unsigned*)l, 16, 0, 0);
}
DEVI void gemm3_topk_tile(const Params& p, int m0, int h, char* smem) {
    const int tid = threadIdx.x, lane = tid & 63, w = tid >> 6, fr = lane & 15, fq = lane >> 4;
    f32x4 acc[2][16];
#pragma unroll
    for (int i = 0; i < 2; ++i)
#pragma unroll
        for (int j = 0; j < 16; ++j) acc[i][j] = (f32x4){0.f, 0.f, 0.f, 0.f};
    const int r16 = lane >> 2, csrc = (lane & 3) ^ ((r16 >> 2) & 3);
    const bf16_t* srcA = p.x1b + (size_t)(m0 + w * 32 + r16) * 1024 + csrc * 8;
    const bf16_t* srcB = p.Wsubt + ((size_t)h * 256 + w * 32 + r16) * 1024 + csrc * 8;
    char* dstA = smem + (w * 32) * 64 + lane * 16;
    char* dstB = smem + H_A + (w * 32) * 64 + lane * 16;
    auto issue = [&](int kt, int buf) {
#pragma unroll
        for (int q = 0; q < 2; ++q) glds16(srcA + (size_t)q * 16 * 1024 + kt * 32, dstA + buf * H_STAGE + q * 1024);
#pragma unroll
        for (int q = 0; q < 2; ++q) glds16(srcB + (size_t)q * 16 * 1024 + kt * 32, dstB + buf * H_STAGE + q * 1024);
    };
    const int rdoff = fr * 64 + ((fq ^ ((fr >> 2) & 3)) * 16);
    issue(0, 0);
    __syncthreads();
#pragma unroll 1
    for (int kt = 0; kt < 32; ++kt) {
        if (kt + 1 < 32) issue(kt + 1, (kt + 1) & 1);
        const char* As = smem + (kt & 1) * H_STAGE;
        const char* Bs = As + H_A;
        bf16x8 a[2];
#pragma unroll
        for (int i = 0; i < 2; ++i) a[i] = ld8(As + (32 * w + 16 * i) * 64 + rdoff);
#pragma unroll
        for (int jg = 0; jg < 4; ++jg) {
            bf16x8 b[4];
#pragma unroll
            for (int j = 0; j < 4; ++j) b[j] = ld8(Bs + (16 * (4 * jg + j)) * 64 + rdoff);
#pragma unroll
            for (int i = 0; i < 2; ++i)
#pragma unroll
                for (int j = 0; j < 4; ++j) acc[i][4 * jg + j] = mfma16(b[j], a[i], acc[i][4 * jg + j]);
        }
        __syncthreads();
    }
    int* L = (int*)(smem + H_STAGE + w * 2304);
#pragma unroll
    for (int i = 0; i < 2; ++i) {
        const int t = m0 + 32 * w + 16 * i + fr;
        const float rs = p.rs2[t];
#pragma unroll
        for (int pp = 0; pp < 2; ++pp) {
            int ka[16], kb[16];
#pragma unroll
            for (int jj = 0; jj < 4; ++jj)
#pragma unroll
                for (int r = 0; r < 4; ++r) {
                    ka[jj * 4 + r] = (f2key(acc[i][8 * pp + jj][r] * rs) & ~127) | (16 * jj + 4 * fq + r);
                    kb[jj * 4 + r] = (f2key(acc[i][8 * pp + 4 + jj][r] * rs) & ~127) | (16 * (jj + 4) + 4 * fq + r);
                }
            bsort_desc<16>(ka);
            bsort_desc<16>(kb);
#pragma unroll
            for (int q = 0; q < 16; ++q) ka[q] = ka[q] > kb[15 - q] ? ka[q] : kb[15 - q];
            bmerge_desc<16>(ka);
            xmerge16(ka, 16);
            xmerge16(ka, 32);
            if (fq == 0) {
#pragma unroll
                for (int q = 0; q < 4; ++q) *(int4*)(L + fr * 36 + pp * 16 + q * 4) = make_int4(ka[4 * q], ka[4 * q + 1], ka[4 * q + 2], ka[4 * q + 3]);
            }
        }
        int c[16];
#pragma unroll
        for (int s = 0; s < 13; ++s) {
            const int ab = cand_tab[fq * 13 + s];
            const int k1 = L[fr * 36 + (ab >> 4)], k2 = L[fr * 36 + 16 + (ab & 15)];
            const float v = key2f(k1 & ~127) + key2f(k2 & ~127);
            c[s] = (f2key(v) & ~0x3fff) | ((k1 & 127) << 7) | (k2 & 127);
        }
        c[13] = c[14] = c[15] = (int)0x80000000;
        bsort_desc<16>(c);
        xmerge16(c, 16);
        xmerge16(c, 32);
        const float vmax = key2f(c[0] & ~0x3fff);
        float e[16], sum = 0.f;
#pragma unroll
        for (int q = 0; q < 16; ++q) { e[q] = __expf(key2f(c[q] & ~0x3fff) - vmax); sum += e[q]; }
        const float inv = 1.f / sum;
#pragma unroll
        for (int q = 0; q < 4; ++q) {
            const int cq = fq == 0 ? c[q] : fq == 1 ? c[4 + q] : fq == 2 ? c[8 + q] : c[12 + q];
            const float eq = fq == 0 ? e[q] : fq == 1 ? e[4 + q] : fq == 2 ? e[8 + q] : e[12 + q];
            const int k = h * 16 + 4 * fq + q, slot = (k & 7) * 16 + (k >> 3);
            p.eperm[(size_t)t * 128 + slot] = (unsigned short)(((cq >> 7) & 127) * 128 + (cq & 127));
            p.gate[(size_t)t * 128 + slot] = eq * inv;
        }
    }
}
DEVI void st_gemm3_topk(const Params& p, char* smem) {
    for (int it = blockIdx.x; it < 128 * 8; it += gridDim.x) gemm3_topk_tile(p, (it >> 3) * 256, it & 7, smem);
}

#define XB_TMO      128
#define XB_XCNT(j)  (256  + 64 * (j))
#define XB_XSUB(j)  (1280 + 64 * (j))
#define XB_XGEN(j)  (2304 + 64 * (j))
#define XB_TOP      3328
#define XB_TOPGEN   3392
#define XCD_BAR_WORDS 3456
#define XB_SPIN_CAP (1u << 20)
#define LAS __attribute__((address_space(3)))
DEVI unsigned xb_ld(unsigned* p) { return __hip_atomic_load(p, __ATOMIC_RELAXED, __HIP_MEMORY_SCOPE_AGENT); }
DEVI unsigned xb_add(unsigned* p, unsigned v) { return __hip_atomic_fetch_add(p, v, __ATOMIC_RELAXED, __HIP_MEMORY_SCOPE_AGENT); }
DEVI unsigned xb_xcc_id() { return (unsigned)__builtin_amdgcn_s_getreg((3 << 11) | 20) & 0xFu; }
#define XB_SPIN(cond, bar) do { unsigned _sp = 0; while (cond) { __builtin_amdgcn_s_sleep(1); \
    if ((++_sp & 255u) == 0u) { if (xb_ld(&(bar)[XB_TMO])) break; if (_sp > XB_SPIN_CAP) { atomicAdd(&(bar)[XB_TMO], 1u); break; } } } } while (0)
struct XcdBarrier { unsigned* bar; unsigned x; volatile LAS unsigned* st; };
DEVI XcdBarrier xcd_barrier_post(unsigned* bar, volatile LAS unsigned* st) {
    XcdBarrier b; b.bar = bar; b.x = xb_xcc_id(); b.st = st;
    if (threadIdx.x == 0) (void)xb_add(&bar[XB_XCNT(b.x)], 1u);
    return b;
}
DEVI void xcd_barrier_complete(unsigned* bar, unsigned x, unsigned& nloc, unsigned& nx) {
    const unsigned G = gridDim.x * gridDim.y * gridDim.z;
    unsigned sum, cnt, mine, sp = 0u;
    for (;;) {
        sum = 0u; cnt = 0u; mine = 0u;
#pragma unroll
        for (unsigned j = 0; j < 16; ++j) { const unsigned c = xb_ld(&bar[XB_XCNT(j)]); sum += c; cnt += (c > 0u) ? 1u : 0u; mine = (j == x) ? c : mine; }
        if (sum == G) break;
        __builtin_amdgcn_s_sleep(1);
        if ((++sp & 255u) == 0u) { if (xb_ld(&bar[XB_TMO])) break; if (sp > XB_SPIN_CAP) { atomicAdd(&bar[XB_TMO], 1u); break; } }
    }
    nloc = mine > 0u ? mine : 1u; nx = cnt > 0u ? cnt : 1u;
}
DEVI void xcd_barrier(const XcdBarrier& b) {
    asm volatile("s_waitcnt vmcnt(0)" ::: "memory");
    __syncthreads();
    if (threadIdx.x == 0) {
        unsigned* bar = b.bar;
        __builtin_amdgcn_s_waitcnt(0);
        unsigned nloc = b.st[0], nx = b.st[1];
        if (nloc == 0u) { xcd_barrier_complete(bar, b.x, nloc, nx); b.st[0] = nloc; b.st[1] = nx; }
        const unsigned old = xb_add(&bar[XB_XSUB(b.x)], 1u);
        const unsigned gen = old / nloc;
        if (old + 1u == (gen + 1u) * nloc) {
            __builtin_amdgcn_fence(__ATOMIC_RELEASE, "agent");
            asm volatile("s_waitcnt vmcnt(0)" ::: "memory");
            const unsigned og = xb_add(&bar[XB_TOP], 1u);
            const unsigned tg = og / nx;
            if (og + 1u == (tg + 1u) * nx) xb_add(&bar[XB_TOPGEN], 1u);
            else XB_SPIN(xb_ld(&bar[XB_TOPGEN]) == tg, bar);
            __builtin_amdgcn_fence(__ATOMIC_ACQUIRE, "agent");
            xb_add(&bar[XB_XGEN(b.x)], 1u);
            asm volatile("s_waitcnt vmcnt(0)" ::: "memory");
        } else {
            XB_SPIN(xb_ld(&bar[XB_XGEN(b.x)]) == gen, bar);
            __builtin_amdgcn_fence(__ATOMIC_ACQUIRE, "agent");
            asm volatile("s_waitcnt vmcnt(0)" ::: "memory");
        }
    }
    __syncthreads();
}

#define CTR_A(x) (XCD_BAR_WORDS + 64 * (x))
#define CTR_B(x) (XCD_BAR_WORDS + 512 + 64 * (x))
#define CTL_WORDS (XCD_BAR_WORDS + 1024)
typedef float f32x2 __attribute__((ext_vector_type(2)));
DEVI float ub(unsigned w, int n) { return (float)((w >> (8 * n)) & 0xffu); }
DEVI float gelu_erf(float u) { return 0.5f * u * (1.f + erff(u * 0.70710678118654752f)); }
struct ExpMeta { uint4 e[2]; uint4 xa; float sc; };
struct ExpRows { uint4 r[16]; float2 x1; };

template <int PHASE> DEVI void exp_load_meta(const Params& p, ExpMeta& m, int t, int x, int lane) {
    const uint4* ep = (const uint4*)(p.eperm + (size_t)t * 128 + (lane >> 3) * 16);
    m.e[0] = ep[0];
    m.e[1] = ep[1];
    if (PHASE == 0) m.xa = *(const uint4*)(p.xq + (size_t)t * 1024 + 128 * x + 16 * (lane & 7));
    else { m.xa = *(const uint4*)(p.aq + (size_t)t * 128 + (lane >> 3) * 16); m.sc = p.asc[t]; }
}
template <int PHASE> DEVI void exp_issue(const Params& p, const ExpMeta& m, ExpRows& R, int t, int x, int lane) {
    const unsigned char* base = (PHASE == 0 ? p.down_q : p.up_q) + (size_t)x * (16384 * 128) + (lane & 7) * 16;
    const unsigned ew[8] = {m.e[0].x, m.e[0].y, m.e[0].z, m.e[0].w, m.e[1].x, m.e[1].y, m.e[1].z, m.e[1].w};
#pragma unroll
    for (int j = 0; j < 16; ++j) {
        const unsigned ek = (j & 1) ? (ew[j >> 1] >> 16) : (ew[j >> 1] & 0xffffu);
        R.r[j] = *(const uint4*)(base + (size_t)ek * 128);
    }
    if (PHASE == 1) {
        const int col = 128 * x + 16 * (lane & 7) + ((lane & 32) ? 8 : 0) + ((lane & 16) ? 4 : 0) + ((lane & 8) ? 2 : 0);
        R.x1 = *(const float2*)(p.out + (size_t)t * 1024 + col);
    }
}
DEVI void expA_compute(const Params& p, const ExpMeta& m, const ExpRows& R, int t, int x, int lane) {
    const bool b2 = lane & 4, b1 = lane & 2, b0 = lane & 1;
    int ps[16];
#pragma unroll
    for (int j = 0; j < 16; ++j)
        ps[j] = __builtin_amdgcn_sdot4((int)R.r[j].x, (int)m.xa.x, __builtin_amdgcn_sdot4((int)R.r[j].y, (int)m.xa.y,
                __builtin_amdgcn_sdot4((int)R.r[j].z, (int)m.xa.z, __builtin_amdgcn_sdot4((int)R.r[j].w, (int)m.xa.w, 0, false), false), false), false);
    int q8[8], q4[4], q2[2];
#pragma unroll
    for (int j = 0; j < 8; ++j) { const int snd = b2 ? ps[j] : ps[j + 8], kp = b2 ? ps[j + 8] : ps[j]; q8[j] = kp + __shfl_xor(snd, 4); }
#pragma unroll
    for (int j = 0; j < 4; ++j) { const int snd = b1 ? q8[j] : q8[j + 4], kp = b1 ? q8[j + 4] : q8[j]; q4[j] = kp + __shfl_xor(snd, 2); }
#pragma unroll
    for (int j = 0; j < 2; ++j) { const int snd = b0 ? q4[j] : q4[j + 2], kp = b0 ? q4[j + 2] : q4[j]; q2[j] = kp + __shfl_xor(snd, 1); }
    *(int2*)(p.part + ((size_t)x * T_TOK + t) * 128 + 2 * lane) = make_int2(q2[0], q2[1]);
}
DEVI void expB_compute(const Params& p, const ExpMeta& m, const ExpRows& R, int t, int x, int lane) {
    const bool b5 = lane & 32, b4 = lane & 16, b3 = lane & 8;
    const unsigned pa[4] = {m.xa.x, m.xa.y, m.xa.z, m.xa.w};
    int acc[16];
#pragma unroll
    for (int c = 0; c < 16; ++c) acc[c] = 0;
#pragma unroll
    for (int g = 0; g < 4; ++g) {
        const unsigned r0[4] = {R.r[4 * g].x, R.r[4 * g].y, R.r[4 * g].z, R.r[4 * g].w};
        const unsigned r1[4] = {R.r[4 * g + 1].x, R.r[4 * g + 1].y, R.r[4 * g + 1].z, R.r[4 * g + 1].w};
        const unsigned r2[4] = {R.r[4 * g + 2].x, R.r[4 * g + 2].y, R.r[4 * g + 2].z, R.r[4 * g + 2].w};
        const unsigned r3[4] = {R.r[4 * g + 3].x, R.r[4 * g + 3].y, R.r[4 * g + 3].z, R.r[4 * g + 3].w};
#pragma unroll
        for (int i = 0; i < 4; ++i) {
            const unsigned t0 = __builtin_amdgcn_perm(r1[i], r0[i], 0x05010400u), t1 = __builtin_amdgcn_perm(r1[i], r0[i], 0x07030602u);
            const unsigned t2 = __builtin_amdgcn_perm(r3[i], r2[i], 0x05010400u), t3 = __builtin_amdgcn_perm(r3[i], r2[i], 0x07030602u);
            const unsigned o0 = __builtin_amdgcn_perm(t2, t0, 0x05040100u), o1 = __builtin_amdgcn_perm(t2, t0, 0x07060302u);
            const unsigned o2 = __builtin_amdgcn_perm(t3, t1, 0x05040100u), o3 = __builtin_amdgcn_perm(t3, t1, 0x07060302u);
            acc[4 * i + 0] = __builtin_amdgcn_sdot4((int)o0, (int)pa[g], acc[4 * i + 0], false);
            acc[4 * i + 1] = __builtin_amdgcn_sdot4((int)o1, (int)pa[g], acc[4 * i + 1], false);
            acc[4 * i + 2] = __builtin_amdgcn_sdot4((int)o2, (int)pa[g], acc[4 * i + 2], false);
            acc[4 * i + 3] = __builtin_amdgcn_sdot4((int)o3, (int)pa[g], acc[4 * i + 3], false);
        }
    }
    int q8[8], q4[4], q2[2];
#pragma unroll
    for (int j = 0; j < 8; ++j) { const int snd = b5 ? acc[j] : acc[j + 8], kp = b5 ? acc[j + 8] : acc[j]; q8[j] = kp + __shfl_xor(snd, 32); }
#pragma unroll
    for (int j = 0; j < 4; ++j) { const int snd = b4 ? q8[j] : q8[j + 4], kp = b4 ? q8[j + 4] : q8[j]; q4[j] = kp + __shfl_xor(snd, 16); }
#pragma unroll
    for (int j = 0; j < 2; ++j) { const int snd = b3 ? q4[j] : q4[j + 2], kp = b3 ? q4[j + 2] : q4[j]; q2[j] = kp + __shfl_xor(snd, 8); }
    const int col = 128 * x + 16 * (lane & 7) + (b5 ? 8 : 0) + (b4 ? 4 : 0) + (b3 ? 2 : 0);
    *(float2*)((float*)p.proj + (size_t)t * 1024 + col) = make_float2(R.x1.x + (float)q2[0] * m.sc, R.x1.y + (float)q2[1] * m.sc);
}
template <int PHASE>
DEVI void exp_chunk(const Params& p, int tb, int x, int lane) {
    ExpMeta mA, mB, nA, nB;
    ExpRows rA, rB;
    exp_load_meta<PHASE>(p, mA, tb, x, lane);
    exp_load_meta<PHASE>(p, mB, tb + 1, x, lane);
    exp_issue<PHASE>(p, mA, rA, tb, x, lane);
    exp_issue<PHASE>(p, mB, rB, tb + 1, x, lane);
    exp_load_meta<PHASE>(p, nA, tb + 2, x, lane);
    exp_load_meta<PHASE>(p, nB, tb + 3, x, lane);
#pragma unroll 1
    for (int i = 0; i < 8; ++i) {
        const int tA = tb + 2 * i, tB = tA + 1;
        if (PHASE == 0) expA_compute(p, mA, rA, tA, x, lane); else expB_compute(p, mA, rA, tA, x, lane);
        if (i < 7) {
            mA = nA;
            exp_issue<PHASE>(p, mA, rA, tA + 2, x, lane);
            if (i < 6) exp_load_meta<PHASE>(p, nA, tA + 4, x, lane);
        }
        if (PHASE == 0) expA_compute(p, mB, rB, tB, x, lane); else expB_compute(p, mB, rB, tB, x, lane);
        if (i < 7) {
            mB = nB;
            exp_issue<PHASE>(p, mB, rB, tB + 2, x, lane);
            if (i < 6) exp_load_meta<PHASE>(p, nB, tB + 4, x, lane);
        }
    }
}
template <int PHASE>
DEVI void st_expAB(const Params& p, char* smem) {
    const int tid = threadIdx.x, lane = tid & 63, wid = tid >> 6;
    volatile int* cs = (volatile int*)smem;
    const unsigned myx = xb_xcc_id() & 7u;
    constexpr int NCH = T_TOK / (16 * NW);
    for (int si = 0; si < 8; ++si) {
        const int x = (int)((myx + si) & 7u);
        unsigned* ctr = &p.bar[PHASE == 0 ? CTR_A(x) : CTR_B(x)];
        if (tid == 0) cs[0] = (int)xb_add(ctr, 1u);
        __syncthreads();
        int chunk = cs[0];
        __syncthreads();
        while (chunk < NCH) {
            int nxt = 0;
            if (tid == 0) nxt = (int)xb_add(ctr, 1u);
            exp_chunk<PHASE>(p, chunk * (16 * NW) + wid * 16, x, lane);
            if (tid == 0) cs[0] = nxt;
            __syncthreads();
            chunk = cs[0];
            __syncthreads();
        }
    }
}
DEVI void st_expA2(const Params& p) {
    const int lane = threadIdx.x & 63, wid = threadIdx.x >> 6;
    for (int t = blockIdx.x * NW + wid; t < T_TOK; t += gridDim.x * NW) {
        int s0 = 0, s1 = 0;
#pragma unroll
        for (int x = 0; x < 8; ++x) { const int2 v = *(const int2*)(p.part + ((size_t)x * T_TOK + t) * 128 + 2 * lane); s0 += v.x; s1 += v.y; }
        const float xs = p.xsc[t];
        const unsigned ew = *(const unsigned*)(p.eperm + (size_t)t * 128 + 2 * lane);
        const int ea = (int)(ew & 0xffffu), eb = (int)(ew >> 16);
        const float2 g = *(const float2*)(p.gate + (size_t)t * 128 + 2 * lane);
        const float a0 = g.x * gelu_erf((float)s0 * xs * p.dscale[ea]) * p.uscale[ea];
        const float a1 = g.y * gelu_erf((float)s1 * xs * p.dscale[eb]) * p.uscale[eb];
        const float amax = wave_max(fmaxf(fabsf(a0), fabsf(a1)));
        const float inv = amax > 0.f ? 127.f / amax : 0.f;
        const unsigned q0 = (unsigned)((int)rintf(a0 * inv) & 255), q1 = (unsigned)((int)rintf(a1 * inv) & 255);
        *(unsigned short*)(p.aq + (size_t)t * 128 + 2 * lane) = (unsigned short)(q0 | (q1 << 8));
        if (lane == 0) p.asc[t] = amax * (1.f / 127.f);
    }
}
DEVI void st_expC(const Params& p) {
    const int lane = threadIdx.x & 63, wid = threadIdx.x >> 6;
    for (int t = blockIdx.x * NW + wid; t < T_TOK; t += gridDim.x * NW) {
        const float4* row = (const float4*)((const float*)p.proj + (size_t)t * 1024);
        float4 v[4];
        float ss = 0.f;
#pragma unroll
        for (int j = 0; j < 4; ++j) { v[j] = row[lane + 64 * j]; ss += v[j].x * v[j].x + v[j].y * v[j].y + v[j].z * v[j].z + v[j].w * v[j].w; }
        ss = wave_sum(ss);
        const float rf = rsqrtf(ss * (1.f / 1024.f) + EPSN);
        float4* orow = (float4*)(p.out + (size_t)t * 1024);
#pragma unroll
        for (int j = 0; j < 4; ++j) {
            const float4 g = *(const float4*)(p.final_g + (lane + 64 * j) * 4);
            orow[lane + 64 * j] = make_float4(v[j].x * rf * g.x, v[j].y * rf * g.y, v[j].z * rf * g.z, v[j].w * rf * g.w);
        }
    }
}

constexpr int LDS_BYTES = 147456;
constexpr int LDS_BARW = LDS_BYTES - 16;
extern __shared__ __attribute__((aligned(16))) char smem_dyn[];
__global__ void __launch_bounds__(NTHR, 2) mega_fwd(Params p) {
    cg::grid_group grid = cg::this_grid();
    volatile LAS unsigned* bst = (volatile LAS unsigned*)(LAS char*)(smem_dyn + LDS_BARW);
    if (threadIdx.x < 4) bst[threadIdx.x] = 0u;
    __syncthreads();
    XcdBarrier bar = xcd_barrier_post(p.bar, bst);
    st_prep_misc(p);
    st_prep_tables(p);
    st_prep_w(p, smem_dyn);
    st_prep_wsub(p, smem_dyn);
    st_prep_x(p, smem_dyn);
    if (p.pad_[0] == 0x7fffabcd) grid.sync();
    xcd_barrier(bar);
    st_gemm8<EpiProj8, PG8_ALIGN>(p.xb, p.W1t, NPJ, 1024, smem_dyn, EpiProj8{p.proj, p.rs1});
    xcd_barrier(bar);
    st_conv_qk(p, smem_dyn);
    xcd_barrier(bar);
    st_recur(p, smem_dyn);
    xcd_barrier(bar);
    st_gate(p);
    xcd_barrier(bar);
    st_gemm8<EpiX18, PG8_ALIGN>(p.yb, p.W2t, 1024, 1024, smem_dyn, EpiX18{p.x, p.out});
    xcd_barrier(bar);
    st_norm2(p);
    xcd_barrier(bar);
    st_gemm3_topk(p, smem_dyn);
    xcd_barrier(bar);
    st_expAB<0>(p, smem_dyn);
    xcd_barrier(bar);
    st_expA2(p);
    xcd_barrier(bar);
    st_expAB<1>(p, smem_dyn);
    xcd_barrier(bar);
    st_expC(p);
}

extern "C" void kernel_launch(void* const* d_in, const int* in_sizes, int n_in, void* d_out, int out_size, void* d_ws, size_t ws_size,
                              hipStream_t stream) {
    Params p{};
    const float* const* in = (const float* const*)d_in;
    p.x = in[0]; p.norm1_g = in[1]; p.w_in = in[2]; p.ret_norm_g = in[3]; p.m_conv_w = in[4]; p.m_conv_b = in[5]; p.m_wq = in[6]; p.m_wk = in[7];
    p.m_b_i = in[8]; p.m_b_f = in[9]; p.m_norm_g = in[10]; p.m_skip = in[11]; p.w_out = in[12]; p.norm2_g = in[13]; p.peer_wq = in[14];
    p.peer_keys = in[15]; p.peer_down = in[16]; p.peer_up = in[17]; p.final_g = in[18];
    p.out = (float*)d_out;
    char* ws = (char*)d_ws;
    size_t off = 0;
    auto take = [&](size_t bytes) { char* r = ws + off; off += (bytes + 255) & ~(size_t)255; return r; };
    p.proj = (bf16_t*)take((size_t)T_TOK * NPJ * 2);
    p.xb = (bf16_t*)take((size_t)T_TOK * 1024 * 2);
    p.yb = p.xb;
    p.gate = (float*)(ws + (size_t)T_TOK * 2048 * 4);
    p.mq = (bf16_t*)take((size_t)T_TOK * 512 * 2);
    p.mk = (bf16_t*)take((size_t)T_TOK * 512 * 2);
    p.x1b = p.mq;
    p.cbuf = (bf16_t*)take((size_t)T_TOK * 512 * 2);
    p.eperm = (unsigned short*)p.cbuf;
    p.down_q = (unsigned char*)take((size_t)16384 * 1024);
    p.up_q = (unsigned char*)take((size_t)16384 * 1024);
    p.dscale = (float*)take(16384 * 4);
    p.uscale = (float*)take(16384 * 4);
    p.bar = (unsigned*)take(CTL_WORDS * 4);
    p.xq = (unsigned char*)take((size_t)T_TOK * 1024);
    p.xsc = (float*)take(T_TOK * 4);
    p.asc = (float*)take(T_TOK * 4);
    p.aq = (unsigned char*)take((size_t)T_TOK * 128);
    p.part = (int*)(ws + (size_t)T_TOK * 1024 * 4);
    p.W1t = (bf16_t*)take((size_t)NPJ * 1024 * 2);
    p.W2t = (bf16_t*)take((size_t)1024 * 1024 * 2);
    p.Wsubt = (bf16_t*)take((size_t)2048 * 1024 * 2);
    p.Wqt = (bf16_t*)take(4 * 128 * 128 * 2);
    p.Wkt = (bf16_t*)take(4 * 128 * 128 * 2);
    p.rs1 = (float*)take(T_TOK * 4);
    p.rs2 = (float*)take(T_TOK * 4);
    p.ipre = (float*)take(T_TOK * 4 * 4);
    p.logf = (float*)take(T_TOK * 4 * 4);
    p.rope_cos = (float*)take(2048 * 64 * 4);
    p.rope_sin = (float*)take(2048 * 64 * 4);
    if (off > ws_size) { fprintf(stderr, "kernel_launch: workspace too small (%zu > %zu)\n", off, ws_size); return; }

    static int grid_blocks = 0;
    if (!grid_blocks) {
        int dev = 0, cus = 0, per_cu = 0;
        (void)hipGetDevice(&dev);
        (void)hipDeviceGetAttribute(&cus, hipDeviceAttributeMultiprocessorCount, dev);
        (void)hipFuncSetAttribute((const void*)mega_fwd, hipFuncAttributeMaxDynamicSharedMemorySize, LDS_BYTES);
        (void)hipOccupancyMaxActiveBlocksPerMultiprocessor(&per_cu, (const void*)mega_fwd, NTHR, LDS_BYTES);
        if (per_cu > 1) per_cu = 1;
        if (per_cu < 1) per_cu = 1;
        grid_blocks = cus * per_cu;
    }
    (void)hipMemsetAsync(p.bar, 0, CTL_WORDS * 4, stream);
    void* args[] = {&p};
    hipError_t e = hipLaunchCooperativeKernel((const void*)mega_fwd, dim3(grid_blocks), dim3(NTHR), args, LDS_BYTES, stream);
    if (e != hipSuccess) fprintf(stderr, "cooperative launch failed: %s (grid %d)\n", hipGetErrorString(e), grid_blocks);
}
```

```cpp
#include <hip/hip_runtime.h>
#include <hip/hip_cooperative_groups.h>
#include <stdint.h>
#include <cstdio>
namespace cg = cooperative_groups;

typedef unsigned short bf16_t;
typedef short bf16x8 __attribute__((ext_vector_type(8)));
typedef float f32x4 __attribute__((ext_vector_type(4)));

#define DEVI __device__ __forceinline__
__device__ __forceinline__ int stid() { int t = (int)threadIdx.x; asm volatile("" : "+v"(t)); return t; }

constexpr int T_TOK = 32768, DM = 1024, NPJ = 3584, DIN = 3592;
constexpr int NTHR = 512, NW = 8;
constexpr float EPSN = 1e-6f;

struct Params {
    const float *x, *norm1_g, *w_in, *ret_norm_g, *m_conv_w, *m_conv_b, *m_wq, *m_wk, *m_b_i, *m_b_f, *m_norm_g, *m_skip, *w_out,
        *norm2_g, *peer_wq, *peer_keys, *peer_down, *peer_up, *final_g;
    float* out;
    bf16_t *proj, *xb, *yb, *mq, *mk, *x1b, *cbuf, *W1t, *W2t, *Wsubt, *Wqt, *Wkt;
    unsigned char *down_q, *up_q;
    float *dscale, *uscale, *xsc, *asc;
    unsigned short* eperm;
    unsigned char* aq;
    int* part;
    unsigned char* xq;
    unsigned* bar;
    float *rs1, *rs2, *ipre, *logf, *rope_cos, *rope_sin, *gate;
    int pad_[2];
};

DEVI unsigned f2bf_bits(float f) { unsigned u = __float_as_uint(f); return (u + 0x7fffu + ((u >> 16) & 1u)) >> 16; }
DEVI bf16_t f2bf(float f) { return (bf16_t)f2bf_bits(f); }
DEVI unsigned pk2(float lo, float hi) { return f2bf_bits(lo) | (f2bf_bits(hi) << 16); }
DEVI float bflo(unsigned w) { return __uint_as_float(w << 16); }
DEVI float bfhi(unsigned w) { return __uint_as_float(w & 0xffff0000u); }
DEVI float bf2f(bf16_t h) { return __uint_as_float(((unsigned)h) << 16); }
DEVI float wave_sum(float v) {
#pragma unroll
    for (int o = 32; o; o >>= 1) v += __shfl_xor(v, o);
    return v;
}
DEVI float wave_max(float v) {
#pragma unroll
    for (int o = 32; o; o >>= 1) v = fmaxf(v, __shfl_xor(v, o));
    return v;
}
DEVI f32x4 mfma16(bf16x8 a, bf16x8 b, f32x4 c) { return __builtin_amdgcn_mfma_f32_16x16x32_bf16(a, b, c, 0, 0, 0); }
DEVI bf16x8 ld8(const char* p) { return *reinterpret_cast<const bf16x8*>(p); }
DEVI bf16x8 mk8(uint2 lo, uint2 hi) {
    union { uint4 u; bf16x8 v; } x;
    x.u = make_uint4(lo.x, lo.y, hi.x, hi.y);
    return x.v;
}
DEVI float sigmoidf_(float z) { return 1.f / (1.f + __expf(-z)); }

DEVI void st_prep_misc(const Params& p) {
    const int gtid = blockIdx.x * NTHR + stid(), gsz = gridDim.x * NTHR;
    for (int i = gtid; i < 2048 * 64; i += gsz) {
        const int pos = i >> 6, j = i & 63;
        const float inv = powf(10000.f, -(float)j * (1.f / 64.f));
        const float ang = (float)pos * inv;
        float s, c;
        sincosf(ang, &s, &c);
        p.rope_cos[i] = c;
        p.rope_sin[i] = s;
    }
    for (int i = gtid; i < 4 * 128 * 128; i += gsz) {
        const int h = i >> 14, e = (i >> 7) & 127, d = i & 127;
        p.Wqt[i] = f2bf(p.m_wq[h * 16384 + d * 128 + e]);
        p.Wkt[i] = f2bf(p.m_wk[h * 16384 + d * 128 + e] * 0.08838834764831845f);
    }
}
DEVI void prep_table_row(const Params& p, int row, const float4 (&v)[4], int lane) {
    const bool up = row >= 16384;
    const int e = up ? row - 16384 : row;
    float am = 0.f;
#pragma unroll
    for (int i = 0; i < 4; ++i) am = fmaxf(am, fmaxf(fmaxf(fabsf(v[i].x), fabsf(v[i].y)), fmaxf(fabsf(v[i].z), fabsf(v[i].w))));
    am = wave_max(am);
    const float sc = am > 0.f ? am * (1.f / 127.f) : 1.f, inv = am > 0.f ? 127.f / am : 0.f;
    unsigned w[4];
#pragma unroll
    for (int i = 0; i < 4; ++i) {
        const int q0 = (int)rintf(v[i].x * inv), q1 = (int)rintf(v[i].y * inv), q2 = (int)rintf(v[i].z * inv), q3 = (int)rintf(v[i].w * inv);
        w[i] = (unsigned)(q0 & 255) | ((unsigned)(q1 & 255) << 8) | ((unsigned)(q2 & 255) << 16) | ((unsigned)(q3 & 255) << 24);
    }
    *(uint4*)((up ? p.up_q : p.down_q) + ((size_t)(lane >> 3) * 16384 + e) * 128 + (lane & 7) * 16) = make_uint4(w[0], w[1], w[2], w[3]);
    if (lane == 0) (up ? p.uscale : p.dscale)[e] = sc;
}
DEVI void st_prep_tables(const Params& p, int bid, int nb) {
    const int lane = stid() & 63, wid = stid() >> 6;
    for (int row = (bid * NW + wid) * 2; row < 32768; row += nb * NW * 2) {
        float4 va[4], vb[4];
        const float4* sa = (const float4*)((row >= 16384 ? p.peer_up + (size_t)(row - 16384) * 1024 : p.peer_down + (size_t)row * 1024) + lane * 16);
        const float4* sb = (const float4*)((row + 1 >= 16384 ? p.peer_up + (size_t)(row + 1 - 16384) * 1024 : p.peer_down + (size_t)(row + 1) * 1024) + lane * 16);
#pragma unroll
        for (int i = 0; i < 4; ++i) { va[i] = sa[i]; vb[i] = sb[i]; }
        prep_table_row(p, row, va, lane);
        prep_table_row(p, row + 1, vb, lane);
    }
}

DEVI void transpose_tile(const float* __restrict__ src, int ld, const float* __restrict__ scale, bf16_t* __restrict__ dst, int K, int k0, int n0,
                         float* tile, bool permqk = false) {
    const int tid = stid();
    {
        const int tx = tid & 63, ty = tid >> 6;
#pragma unroll
        for (int i = 0; i < 4; ++i) {
            const int k = k0 + ty + 8 * i;
            float v = src[(size_t)k * ld + n0 + tx];
            if (scale) v *= scale[k];
            tile[(ty + 8 * i) * 65 + tx] = v;
        }
    }
    __syncthreads();
    {
        const int n = tid >> 3, kq = tid & 7;
        const float a = tile[(4 * kq) * 65 + n], b = tile[(4 * kq + 1) * 65 + n], c = tile[(4 * kq + 2) * 65 + n], d = tile[(4 * kq + 3) * 65 + n];
        int nn = n0 + n;
        if (permqk && nn < 1024) { const int dd = nn & 127; nn = (nn & ~127) + (dd < 64 ? 2 * dd : 2 * (dd - 64) + 1); }
        *(uint2*)(dst + (size_t)nn * K + k0 + 4 * kq) = make_uint2(pk2(a, b), pk2(c, d));
    }
    __syncthreads();
}
DEVI void st_prep_w1(const Params& p, char* smem) {
    float* tile = (float*)smem;
    for (int it = blockIdx.x; it < 56 * 32; it += gridDim.x) transpose_tile(p.w_in, DIN, p.norm1_g, p.W1t, 1024, (it & 31) * 32, (it >> 5) * 64, tile, true);
}
DEVI void st_prep_w2(const Params& p, char* smem, int bid, int nb) {
    float* tile = (float*)smem;
    for (int it = bid; it < 16 * 32; it += nb) transpose_tile(p.w_out, 1024, nullptr, p.W2t, 1024, (it & 31) * 32, (it >> 5) * 64, tile);
}
DEVI void st_prep_wsub(const Params& p, char* smem, int bid, int nb) {
    float* wq_s = (float*)smem;
    float* key_s = wq_s + 32 * 132;
    const int tid = stid();
    for (int it = bid; it < 16 * 32 * 2; it += nb) {
        const int grp = it >> 6, kt = (it >> 1) & 31, nh = it & 1, k0 = kt * 32;
#pragma unroll
        for (int i = 0; i < 8; ++i) {
            const int idx = tid + 512 * i, r = idx >> 7, d = idx & 127;
            wq_s[r * 132 + d] = p.peer_wq[(size_t)(k0 + r) * 2048 + grp * 128 + d];
        }
#pragma unroll
        for (int i = 0; i < 16; ++i) {
            const int idx = tid + 512 * i, n = idx >> 7, d = idx & 127;
            key_s[n * 132 + d] = p.peer_keys[((size_t)grp * 128 + nh * 64 + n) * 128 + d];
        }
        __syncthreads();
        const int kl = tid & 15, ng = tid >> 4;
        float a00 = 0.f, a01 = 0.f, a10 = 0.f, a11 = 0.f;
#pragma unroll 8
        for (int d4 = 0; d4 < 32; ++d4) {
            const float4 w0 = *(const float4*)(wq_s + (2 * kl) * 132 + 4 * d4), w1 = *(const float4*)(wq_s + (2 * kl + 1) * 132 + 4 * d4);
            const float4 y0 = *(const float4*)(key_s + (2 * ng) * 132 + 4 * d4), y1 = *(const float4*)(key_s + (2 * ng + 1) * 132 + 4 * d4);
            a00 += w0.x * y0.x + w0.y * y0.y + w0.z * y0.z + w0.w * y0.w;
            a01 += w0.x * y1.x + w0.y * y1.y + w0.z * y1.z + w0.w * y1.w;
            a10 += w1.x * y0.x + w1.y * y0.y + w1.z * y0.z + w1.w * y0.w;
            a11 += w1.x * y1.x + w1.y * y1.y + w1.z * y1.z + w1.w * y1.w;
        }
        const float g0 = p.norm2_g[k0 + 2 * kl], g1 = p.norm2_g[k0 + 2 * kl + 1];
        bf16_t* o = p.Wsubt + (size_t)(grp * 128 + nh * 64 + 2 * ng) * 1024 + k0 + 2 * kl;
        *(unsigned*)o = pk2(a00 * g0, a10 * g1);
        *(unsigned*)(o + 1024) = pk2(a01 * g0, a11 * g1);
        __syncthreads();
    }
}

DEVI void prep_x_token(const Params& p, const float* Wg_s, int t, const float4 (&v)[4], int lane) {
    float ss = 0.f, g8[8];
#pragma unroll
    for (int g = 0; g < 8; ++g) g8[g] = 0.f;
#pragma unroll
    for (int j = 0; j < 4; ++j) {
        ss += v[j].x * v[j].x + v[j].y * v[j].y + v[j].z * v[j].z + v[j].w * v[j].w;
#pragma unroll
        for (int g = 0; g < 8; ++g) {
            const float4 w = *(const float4*)(Wg_s + g * 1024 + (lane + 64 * j) * 4);
            g8[g] += v[j].x * w.x + v[j].y * w.y + v[j].z * w.z + v[j].w * w.w;
        }
    }
    ss = wave_sum(ss);
#pragma unroll
    for (int g = 0; g < 8; ++g) g8[g] = wave_sum(g8[g]);
    const float rs = rsqrtf(ss * (1.f / 1024.f) + EPSN);
    uint2* o = (uint2*)(p.xb + (size_t)t * 1024);
#pragma unroll
    for (int j = 0; j < 4; ++j) o[lane + 64 * j] = make_uint2(pk2(v[j].x, v[j].y), pk2(v[j].z, v[j].w));
    if (lane == 0) {
        p.rs1[t] = rs;
#pragma unroll
        for (int h = 0; h < 4; ++h) {
            p.ipre[t * 4 + h] = g8[h] * rs + p.m_b_i[h];
            const float z = g8[4 + h] * rs + p.m_b_f[h];
            p.logf[t * 4 + h] = fminf(z, 0.f) - log1pf(__expf(-fabsf(z)));
        }
    }
}
DEVI void st_prep_x(const Params& p, char* smem) {
    float* Wg_s = (float*)smem;
    for (int i = stid(); i < 8192; i += NTHR) {
        const int k = i >> 3, g = i & 7;
        Wg_s[g * 1024 + k] = p.norm1_g[k] * p.w_in[(size_t)k * DIN + NPJ + g];
    }
    __syncthreads();
    const int lane = stid() & 63, wid = stid() >> 6;
    for (int t = (blockIdx.x * NW + wid) * 2; t < T_TOK; t += gridDim.x * NW * 2) {
        float4 va[4], vb[4];
        const float4* xa = (const float4*)(p.x + (size_t)t * 1024);
#pragma unroll
        for (int j = 0; j < 4; ++j) { va[j] = xa[lane + 64 * j]; vb[j] = xa[256 + lane + 64 * j]; }
        prep_x_token(p, Wg_s, t, va, lane);
        prep_x_token(p, Wg_s, t + 1, vb, lane);
    }
    __syncthreads();
}

namespace pg8 {
#define PG8_LAS __attribute__((address_space(3)))
typedef unsigned short bf16_t;
typedef short bf16x8 __attribute__((ext_vector_type(8)));
typedef float f32x4 __attribute__((ext_vector_type(4)));
typedef unsigned u32x4 __attribute__((ext_vector_type(4)));
constexpr int BM = 256, BK = 64, HALF = 128, HTB = HALF * BK * 2  , STAGE_BYTES = 8 * HTB, NXCD = 8, WGM = 8;

__host__ __device__ __forceinline__ int lds_byte(int r, int c) { const int st = (r >> 4) * 2 + (c >> 5), rr = r & 15, cc = c & 31, ob = rr * 64 + cc * 2; return st * 1024 + (ob ^ (((ob >> 9) & 1) << 5)); }
__host__ __device__ __forceinline__ void stage_rc(int b, int& R, int& C) { const int st = b / 1024, sb = b % 1024, swz = sb ^ (((sb >> 9) & 1) << 5); R = (st >> 1) * 16 + swz / 64; C = (st & 1) * 32 + (swz % 64) / 2; }
__host__ __device__ __forceinline__ int perm32(int rho) { const int n = rho >> 4, i = rho & 15; return 8 * (i >> 2) + 4 * n + (i & 3); }

struct Unit { int pm, pn; };
struct Gemm { const bf16_t* A; const bf16_t* Bt; int M, N, K; };

struct StaticOrder {
    int nM, nN, nwg, G, c;
    __host__ __device__ void init(int M, int N, int G_, int c_) { nM = M / BM; nN = N / BM; nwg = nM * nN; G = G_; c = c_; }
    __host__ __device__ bool next(int i, Unit& u) const {
        const long L = (long)i * G + c; if (L >= nwg) return false;
        int wgid = (int)L; { const int q = nwg / NXCD, r = nwg % NXCD, xcd = wgid % NXCD, off = wgid / NXCD; wgid = (xcd < r ? xcd * (q + 1) : r * (q + 1) + (xcd - r) * q) + off; }
        const int nig = WGM * nN, gid = wgid / nig, fm = gid * WGM, gsz = (nM - fm) < WGM ? (nM - fm) : WGM;
        u.pm = fm + ((wgid % nig) % gsz); u.pn = (wgid % nig) / gsz; return true;
    }
    __device__ __forceinline__ void a_ready(const Unit&) const {}
    __device__ __forceinline__ void done(const Unit&) const {}
};

__device__ __forceinline__ unsigned cvt_pk_bf16(float lo, float hi) { unsigned r; asm volatile("v_cvt_pk_bf16_f32 %0, %1, %2" : "=v"(r) : "v"(lo), "v"(hi)); return r; }

template <class Epi, class Sched, bool ALIGN_EPI = false, bool SP2 = false>
__device__ __forceinline__ void gemm_phase(PG8_LAS unsigned char* lds, const Gemm g, const Sched& S, const Epi& E) {
    const int tid = stid(), wid = __builtin_amdgcn_readfirstlane(tid >> 6), lane = tid & 63, wr = wid >> 2, wc = wid & 3, fr = lane & 15, fq = lane >> 4;
    const int K = g.K, nt = K / BK;
    unsigned voffA[2], voffB[2];
#pragma unroll
    for (int i = 0; i < 2; ++i) { int R, C; stage_rc(tid * 16 + i * 8192, R, C); const int Rb = Epi::PERM ? ((R & ~31) + perm32(R & 31)) : R;
        voffA[i] = (unsigned)(R * K + C) * 2u; voffB[i] = (unsigned)(Rb * K + C) * 2u; }
    const size_t kstep = (size_t)(BK * 2);
    const size_t hstep = (size_t)HALF * K * 2;
    const size_t tstep = 2 * hstep;
    const unsigned ldsw = (unsigned)wid * 1024u;
    const int aoff = lds_byte(wr * 64 + fr, fq * 8), boff = lds_byte(wc * 32 + fr, fq * 8);
#define PG8_SA(b, h) (((b) * 2 + (h)) * HTB)
#define PG8_SB(b, h) ((4 + (b) * 2 + (h)) * HTB)
#define PG8_STAGE(bufoff, gbase, voff) do { _Pragma("unroll") for (int _i = 0; _i < 2; ++_i) \
        __builtin_amdgcn_global_load_lds((const unsigned*)((const char*)(gbase) + (voff)[_i]), (PG8_LAS unsigned*)(lds + (bufoff) + ldsw + _i * 8192), 16, 0, 0); } while (0)
#define PG8_LDA(dst, b, h) do { _Pragma("unroll") for (int m = 0; m < 4; ++m) _Pragma("unroll") for (int k = 0; k < 2; ++k) dst[m][k] = *(const PG8_LAS bf16x8*)(lds + PG8_SA(b, h) + aoff + m * 2048 + k * 1024); } while (0)
#define PG8_LDB(dst, b, h) do { _Pragma("unroll") for (int n = 0; n < 2; ++n) _Pragma("unroll") for (int k = 0; k < 2; ++k) dst[n][k] = *(const PG8_LAS bf16x8*)(lds + PG8_SB(b, h) + boff + n * 2048 + k * 1024); } while (0)
#define PG8_MMA(ai, bj, At, Bt) do { __builtin_amdgcn_s_setprio(1); _Pragma("unroll") for (int m = 0; m < 4; ++m) _Pragma("unroll") for (int n = 0; n < 2; ++n) _Pragma("unroll") for (int k = 0; k < 2; ++k) \
        acc[ai][bj][m][n] = __builtin_amdgcn_mfma_f32_16x16x32_bf16(Bt[n][k], At[m][k], acc[ai][bj][m][n], 0, 0, 0); __builtin_amdgcn_s_setprio(0); } while (0)
#define PG8_WAIT_V(n) asm volatile("s_waitcnt vmcnt(" #n ")" ::: "memory")
#define PG8_WAIT_L(n) asm volatile("s_waitcnt lgkmcnt(" #n ")" ::: "memory")
#define PG8_BAR __builtin_amdgcn_s_barrier()
#define PG8_SCHED __builtin_amdgcn_sched_barrier(0)
    Unit cur, nxt; int ui = 0;
    if (!S.next(0, cur)) return;
    f32x4 acc[2][2][4][2];
#pragma unroll
    for (int a = 0; a < 2; ++a)
#pragma unroll
        for (int b = 0; b < 2; ++b)
#pragma unroll
            for (int m = 0; m < 4; ++m)
#pragma unroll
                for (int n = 0; n < 2; ++n) acc[a][b][m][n] = (f32x4){0.f, 0.f, 0.f, 0.f};
    bf16x8 At[4][2], B0[2][2], B1[2][2];
    const char* cA = (const char*)g.A + (size_t)cur.pm * tstep; const char* cB = (const char*)g.Bt + (size_t)cur.pn * tstep;
    S.a_ready(cur);
    if constexpr (SP2) {
        PG8_STAGE(PG8_SB(0, 0), cB, voffB); PG8_STAGE(PG8_SB(0, 1), cB + hstep, voffB); PG8_STAGE(PG8_SA(0, 0), cA, voffA); PG8_STAGE(PG8_SA(0, 1), cA + hstep, voffA);
        if (wr == 1) PG8_BAR;
        PG8_WAIT_V(2); PG8_BAR;
        PG8_STAGE(PG8_SB(1, 0), cB + kstep, voffB); PG8_STAGE(PG8_SA(1, 0), cA + kstep, voffA); PG8_STAGE(PG8_SB(1, 1), cB + hstep + kstep, voffB);
        PG8_WAIT_V(6); PG8_BAR;
    } else {
        PG8_STAGE(PG8_SB(0, 0), cB, voffB); PG8_STAGE(PG8_SA(0, 0), cA, voffA); PG8_STAGE(PG8_SB(0, 1), cB + hstep, voffB); PG8_STAGE(PG8_SA(0, 1), cA + hstep, voffA);
        if (wr == 1) PG8_BAR;
        PG8_WAIT_V(4); PG8_BAR;
        PG8_STAGE(PG8_SB(1, 0), cB + kstep, voffB); PG8_STAGE(PG8_SA(1, 0), cA + kstep, voffA); PG8_STAGE(PG8_SB(1, 1), cB + hstep + kstep, voffB);
        PG8_WAIT_V(6); PG8_BAR;
    }
    for (;;) {
        const bool has_next = S.next(ui + 1, nxt);
        const char* nA = has_next ? (const char*)g.A + (size_t)nxt.pm * tstep : cA; const char* nB = has_next ? (const char*)g.Bt + (size_t)nxt.pn * tstep : cB;
        for (int t = 0; t < nt; t += 2) {
            const bool last = (t == nt - 2);
            const char* a1 = cA + (size_t)(t + 1) * kstep;
            const char* a2 = last ? nA : cA + (size_t)(t + 2) * kstep; const char* b2 = last ? nB : cB + (size_t)(t + 2) * kstep;
            const char* a3 = a2 + kstep; const char* b3 = b2 + kstep;
            if (last && has_next) S.a_ready(nxt);
            if constexpr (SP2) {
            PG8_LDB(B0, 0, 0); PG8_LDB(B1, 0, 1); PG8_SCHED; PG8_LDA(At, 0, 0); PG8_STAGE(PG8_SA(1, 1), a1 + hstep, voffA);
            PG8_WAIT_V(8); PG8_WAIT_L(0); PG8_BAR; PG8_MMA(0, 0, At, B0); PG8_MMA(0, 1, At, B1); PG8_BAR; PG8_SCHED;
            PG8_LDA(At, 0, 1); PG8_STAGE(PG8_SB(0, 0), b2, voffB); PG8_STAGE(PG8_SB(0, 1), b2 + hstep, voffB); PG8_STAGE(PG8_SA(0, 0), a2, voffA);
            PG8_WAIT_V(8); PG8_WAIT_L(0); PG8_BAR; PG8_MMA(1, 0, At, B0); PG8_MMA(1, 1, At, B1); PG8_BAR; PG8_SCHED;
            PG8_LDB(B0, 1, 0); PG8_LDB(B1, 1, 1); PG8_SCHED; PG8_LDA(At, 1, 0); PG8_STAGE(PG8_SA(0, 1), a2 + hstep, voffA);
            PG8_WAIT_V(8); PG8_WAIT_L(0); PG8_BAR; PG8_MMA(0, 0, At, B0); PG8_MMA(0, 1, At, B1); PG8_BAR; PG8_SCHED;
            PG8_LDA(At, 1, 1); PG8_STAGE(PG8_SB(1, 0), b3, voffB); PG8_STAGE(PG8_SB(1, 1), b3 + hstep, voffB); PG8_STAGE(PG8_SA(1, 0), a3, voffA);
            PG8_WAIT_V(8); PG8_WAIT_L(0); PG8_BAR; PG8_MMA(1, 0, At, B0); PG8_MMA(1, 1, At, B1); PG8_BAR; PG8_SCHED;
            } else {
            PG8_LDB(B0, 0, 0); PG8_SCHED; PG8_LDA(At, 0, 0); PG8_STAGE(PG8_SA(1, 1), a1 + hstep, voffA);
            PG8_WAIT_L(8); PG8_BAR; PG8_WAIT_L(0); PG8_MMA(0, 0, At, B0); PG8_BAR; PG8_SCHED;
            PG8_LDB(B1, 0, 1); PG8_STAGE(PG8_SB(0, 0), b2, voffB);
            PG8_BAR; PG8_WAIT_L(0); PG8_MMA(0, 1, At, B1); PG8_BAR;
            PG8_LDA(At, 0, 1); PG8_STAGE(PG8_SA(0, 0), a2, voffA);
            PG8_BAR; PG8_WAIT_L(0); PG8_MMA(1, 0, At, B0); PG8_BAR; PG8_SCHED;
            PG8_STAGE(PG8_SB(0, 1), b2 + hstep, voffB);
            PG8_WAIT_V(6); PG8_BAR; PG8_MMA(1, 1, At, B1); PG8_BAR;
            PG8_LDB(B0, 1, 0); PG8_SCHED; PG8_LDA(At, 1, 0); PG8_STAGE(PG8_SA(0, 1), a2 + hstep, voffA);
            PG8_WAIT_L(8); PG8_BAR; PG8_WAIT_L(0); PG8_MMA(0, 0, At, B0); PG8_BAR; PG8_SCHED;
            PG8_LDB(B1, 1, 1); PG8_STAGE(PG8_SB(1, 0), b3, voffB);
            PG8_BAR; PG8_WAIT_L(0); PG8_MMA(0, 1, At, B1); PG8_BAR;
            PG8_LDA(At, 1, 1); PG8_STAGE(PG8_SA(1, 0), a3, voffA);
            PG8_BAR; PG8_WAIT_L(0); PG8_MMA(1, 0, At, B0); PG8_BAR; PG8_SCHED;
            PG8_STAGE(PG8_SB(1, 1), b3 + hstep, voffB);
            PG8_WAIT_V(6); PG8_BAR; PG8_MMA(1, 1, At, B1); PG8_BAR;
            }
        }
        if constexpr (ALIGN_EPI) { if (wr == 0) PG8_BAR; }
        if constexpr (!Epi::AFTER_DRAIN) { E(acc, cur, wr, wc, fr, fq); S.done(cur); }
        if (!has_next) break;
#pragma unroll
        for (int a = 0; a < 2; ++a)
#pragma unroll
            for (int b = 0; b < 2; ++b)
#pragma unroll
                for (int m = 0; m < 4; ++m)
#pragma unroll
                    for (int n = 0; n < 2; ++n) acc[a][b][m][n] = (f32x4){0.f, 0.f, 0.f, 0.f};
        cur = nxt; cA = nA; cB = nB; ++ui;
        if constexpr (ALIGN_EPI) { if (wr == 1) PG8_BAR; }
    }
    PG8_WAIT_V(0);
    if constexpr (!ALIGN_EPI) { if (wr == 0) PG8_BAR; }
    PG8_BAR;
    if constexpr (Epi::AFTER_DRAIN) { E.fused(acc, cur, wr, wc, fr, fq, lds, wid, lane); S.done(cur); }
#undef PG8_SA
#undef PG8_SB
#undef PG8_STAGE
#undef PG8_LDA
#undef PG8_LDB
#undef PG8_MMA
#undef PG8_WAIT_V
#undef PG8_WAIT_L
#undef PG8_BAR
#undef PG8_SCHED
}
}

#ifndef PG8_SP2
#define PG8_SP2 true
#endif
#ifndef PG8_ALIGN
#define PG8_ALIGN true
#endif
struct EpiProj8 {
    static constexpr bool PERM = true, AFTER_DRAIN = false;
    bf16_t* O; const float* rs; const float* rcos; const float* rsin;
    __device__ __forceinline__ void operator()(const pg8::f32x4 (&acc)[2][2][4][2], const pg8::Unit& u, int wr, int wc, int fr, int fq) const {
        const int row0 = u.pm * 256 + wr * 64 + fr, col0 = u.pn * 256 + wc * 32 + 8 * fq;
        const bool rot = u.pn < 4;
        const float ksc = u.pn >= 2 ? 0.08838834764831845f : 1.f;
#pragma unroll
        for (int ai = 0; ai < 2; ++ai)
#pragma unroll
            for (int m = 0; m < 4; ++m) {
                const int row = row0 + ai * 128 + m * 16;
                const float s = rs[row];
                bf16_t* rowp = O + (size_t)row * NPJ + col0;
                float4 cs = make_float4(1.f, 1.f, 1.f, 1.f), sn = make_float4(0.f, 0.f, 0.f, 0.f);
                float s2 = s;
                if (rot) {
                    const int ti = (row & 2047) * 64 + 16 * wc + 4 * fq;
                    cs = *(const float4*)(rcos + ti);
                    sn = *(const float4*)(rsin + ti);
                    s2 = s * ksc;
                }
#pragma unroll
                for (int bj = 0; bj < 2; ++bj) {
                    const pg8::f32x4 v0 = acc[ai][bj][m][0] * s2, v1 = acc[ai][bj][m][1] * s2;
                    *(uint4*)(rowp + bj * 128) = make_uint4(pk2(v0[0] * cs.x - v0[1] * sn.x, v0[0] * sn.x + v0[1] * cs.x), pk2(v0[2] * cs.y - v0[3] * sn.y, v0[2] * sn.y + v0[3] * cs.y),
                                                            pk2(v1[0] * cs.z - v1[1] * sn.z, v1[0] * sn.z + v1[1] * cs.z), pk2(v1[2] * cs.w - v1[3] * sn.w, v1[2] * sn.w + v1[3] * cs.w));
                }
            }
    }
};
struct EpiX18 {
    static constexpr bool PERM = false, AFTER_DRAIN = false;
    const float* x; float* out;
    __device__ __forceinline__ void operator()(const pg8::f32x4 (&acc)[2][2][4][2], const pg8::Unit& u, int wr, int wc, int fr, int fq) const {
        const int row0 = u.pm * 256 + wr * 64 + fr, col0 = u.pn * 256 + wc * 32 + 4 * fq;
#pragma unroll
        for (int ai = 0; ai < 2; ++ai)
#pragma unroll
            for (int m = 0; m < 4; ++m) {
                const size_t ro = (size_t)(row0 + ai * 128 + m * 16) * 1024 + col0;
#pragma unroll
                for (int bj = 0; bj < 2; ++bj)
#pragma unroll
                    for (int n = 0; n < 2; ++n) {
                        const float4 xv = *(const float4*)(x + ro + bj * 128 + n * 16);
                        const pg8::f32x4 v = acc[ai][bj][m][n];
                        *(float4*)(out + ro + bj * 128 + n * 16) = make_float4(xv.x + v[0], xv.y + v[1], xv.z + v[2], xv.w + v[3]);
                    }
            }
    }
};
template <class Epi, bool ALIGN>
DEVI void st_gemm8(const bf16_t* A, const bf16_t* Bt, int N, int K, char* smem, const Epi& epi) {
    pg8::Gemm g{A, Bt, T_TOK, N, K};
    pg8::StaticOrder S;
    S.init(T_TOK, N, (int)gridDim.x, (int)blockIdx.x);
    pg8::gemm_phase<Epi, pg8::StaticOrder, ALIGN, PG8_SP2>((PG8_LAS unsigned char*)smem, g, S, epi);
}

DEVI void st_conv_qk(const Params& p, char* smem) {
    char* cs = smem;
    char* ws = smem + 128 * 272;
    const int tid = stid(), lane = tid & 63, wid = tid >> 6, wr = wid >> 1, wc = wid & 1, fr = lane & 15, fq = lane >> 4;
    for (int it = blockIdx.x; it < 256 * 4; it += gridDim.x) {
        const int h = it & 3, t0 = (it >> 2) * 128, s0 = t0 & 2047;
        {
            const int ch = tid & 127, r0 = (tid >> 7) * 32;
            const int col = 2048 + h * 128 + ch;
            const float w0 = p.m_conv_w[0 * 512 + h * 128 + ch], w1 = p.m_conv_w[1 * 512 + h * 128 + ch], w2 = p.m_conv_w[2 * 512 + h * 128 + ch],
                        w3 = p.m_conv_w[3 * 512 + h * 128 + ch], bb = p.m_conv_b[h * 128 + ch];
            float xm3 = 0.f, xm2 = 0.f, xm1 = 0.f;
            if (s0 + r0 > 0) {
                xm3 = bf2f(p.proj[(size_t)(t0 + r0 - 3) * NPJ + col]);
                xm2 = bf2f(p.proj[(size_t)(t0 + r0 - 2) * NPJ + col]);
                xm1 = bf2f(p.proj[(size_t)(t0 + r0 - 1) * NPJ + col]);
            }
            for (int r = r0; r < r0 + 32; ++r) {
                const float xc = bf2f(p.proj[(size_t)(t0 + r) * NPJ + col]);
                const float y = bb + w0 * xm3 + w1 * xm2 + w2 * xm1 + w3 * xc;
                const float c = y * sigmoidf_(y);
                const bf16_t cb = f2bf(c);
                *(bf16_t*)(cs + r * 272 + ch * 2) = cb;
                p.cbuf[(size_t)(t0 + r) * 512 + h * 128 + ch] = cb;
                xm3 = xm2; xm2 = xm1; xm1 = xc;
            }
        }
#pragma unroll
        for (int which = 0; which < 2; ++which) {
            const bf16_t* W = (which ? p.Wkt : p.Wqt) + h * 16384;
            bf16_t* O = which ? p.mk : p.mq;
#pragma unroll
            for (int i = 0; i < 4; ++i) {
                const int id = tid + 512 * i, r = id >> 4, c = id & 15;
                *(uint4*)(ws + r * 272 + c * 16) = *(const uint4*)(W + r * 128 + c * 8);
            }
            __syncthreads();
            f32x4 acc[2][4];
#pragma unroll
            for (int i = 0; i < 2; ++i)
#pragma unroll
                for (int j = 0; j < 4; ++j) acc[i][j] = (f32x4){0.f, 0.f, 0.f, 0.f};
#pragma unroll
            for (int ks = 0; ks < 4; ++ks) {
                bf16x8 a[2], b[4];
#pragma unroll
                for (int i = 0; i < 2; ++i) a[i] = ld8(cs + (wr * 32 + i * 16 + fr) * 272 + (ks * 4 + fq) * 16);
#pragma unroll
                for (int j = 0; j < 4; ++j) b[j] = ld8(ws + (wc * 64 + j * 16 + fr) * 272 + (ks * 4 + fq) * 16);
#pragma unroll
                for (int i = 0; i < 2; ++i)
#pragma unroll
                    for (int j = 0; j < 4; ++j) acc[i][j] = mfma16(b[j], a[i], acc[i][j]);
            }
#pragma unroll
            for (int i = 0; i < 2; ++i)
#pragma unroll
                for (int j = 0; j < 4; ++j) {
                    const int m = t0 + wr * 32 + i * 16 + fr, n = h * 128 + wc * 64 + j * 16 + 4 * fq;
                    const f32x4 v = acc[i][j];
                    *(uint2*)(O + (size_t)m * 512 + n) = make_uint2(pk2(v[0], v[1]), pk2(v[2], v[3]));
                }
            __syncthreads();
        }
    }
}

DEVI bf16x8 u4_to_frag(uint4 u) { union { uint4 u; bf16x8 v; } x; x.u = u; return x.v; }
DEVI void sel_frags(bf16x8 (&sel)[2], int fr, int fq) {
#pragma unroll
    for (int hh = 0; hh < 2; ++hh) {
        const int jstar = fr + 16 * hh - 8 * fq;
        bf16x8 s;
#pragma unroll
        for (int j = 0; j < 8; ++j) s[j] = (j == jstar) ? (short)0x3F80 : (short)0;
        sel[hh] = s;
    }
}
DEVI void tr_store(char* XT, bf16x8 frag, const bf16x8 (&sel)[2], int mi, int ks, int fr, int fq, const float (&sc)[4]) {
#pragma unroll
    for (int hh = 0; hh < 2; ++hh) {
        const f32x4 d = mfma16(frag, sel[hh], (f32x4){0.f, 0.f, 0.f, 0.f});
        *(uint2*)(XT + (32 * ks + 16 * hh + fr) * 144 + (16 * mi + 4 * fq) * 2) = make_uint2(pk2(d[0] * sc[0], d[1] * sc[1]), pk2(d[2] * sc[2], d[3] * sc[3]));
    }
}
DEVI bf16x8 state_pack(const f32x4& a, const f32x4& b) {
    return mk8(make_uint2(pk2(a[0], a[1]), pk2(a[2], a[3])), make_uint2(pk2(b[0], b[1]), pk2(b[2], b[3])));
}
DEVI const float* opaque_ptr(const float* q) { asm volatile("" : "+v"(q)); return q; }
DEVI float opaque_f(float v) { asm volatile("" : "+v"(v)); return v; }
DEVI float grp8_sum(float v) { v += __shfl_xor(v, 1); v += __shfl_xor(v, 2); v += __shfl_xor(v, 4); return v; }

struct RetPre { uint4 f[4]; uint4 v[2]; };
struct RetOff { unsigned f, v0, v1, g; };
DEVI void ret_offsets(RetOff& o, int h, int tid) {
    const int lane = tid & 63, w = tid >> 6, fr = lane & 15, fq = lane >> 4, mi = w & 3;
    o.f = (unsigned)(((16 * mi + fr) * NPJ + (w < 4 ? 512 : 0) + h * 128 + 8 * fq) * 2);
    o.v0 = (unsigned)(((16 * ((2 * w) >> 2) + fr) * NPJ + 1024 + h * 128 + 32 * ((2 * w) & 3) + 8 * fq) * 2);
    o.v1 = (unsigned)(((16 * ((2 * w + 1) >> 2) + fr) * NPJ + 1024 + h * 128 + 32 * ((2 * w + 1) & 3) + 8 * fq) * 2);
    o.g = (unsigned)(((tid >> 3) * NPJ + 1536 + h * 128 + 16 * (tid & 7)) * 2);
}
DEVI void ret_prefetch(const Params& p, RetPre& P, const RetOff& o, int b, int c) {
    const char* base = (const char*)p.proj + (size_t)(b * 2048 + c * 64) * (NPJ * 2);
#pragma unroll
    for (int ks = 0; ks < 4; ++ks) P.f[ks] = *(const uint4*)(base + o.f + 64 * ks);
    P.v[0] = *(const uint4*)(base + o.v0);
    P.v[1] = *(const uint4*)(base + o.v1);
}
DEVI void ret_block(const Params& p, char* smem, int b, int h) {
    char* qs = smem;
    char* ks_ = smem + 17408;
    char* kTs = smem + 34816;
    char* vTs = smem + 53248;
    char* Ss = smem + 71680;
    char* Os = smem + 80896;
    const int tid = stid(), lane = tid & 63, w = tid >> 6, fr = lane & 15, fq = lane >> 4;
    const float gamma = 1.f - exp2f(-5.f - (float)h);
    const float l2g = log2f(gamma);
    const float g64 = exp2f(l2g * 64.f);
    bf16x8 sel[2];
    sel_frags(sel, fr, fq);
    f32x4 st[8];
#pragma unroll
    for (int i = 0; i < 8; ++i) st[i] = (f32x4){0.f, 0.f, 0.f, 0.f};
    RetPre P;
    RetOff RO;
    ret_offsets(RO, h, tid);
    ret_prefetch(p, P, RO, b, 0);
    const float l2g_ = l2g;
#pragma unroll 1
    for (int c = 0; c < 32; ++c) {
        const int t0 = b * 2048 + c * 64;
        const float l2g = opaque_f(l2g_);
        {
            const int mi = w & 3;
            char* dst = (w < 4 ? ks_ : qs) + (16 * mi + fr) * 272 + fq * 16;
#pragma unroll
            for (int ks = 0; ks < 4; ++ks) *(uint4*)(dst + ks * 64) = P.f[ks];
            if (w < 4) {
                float kd[4];
#pragma unroll
                for (int r = 0; r < 4; ++r) kd[r] = exp2f(l2g * (float)(63 - (16 * mi + 4 * fq + r)));
#pragma unroll
                for (int ks = 0; ks < 4; ++ks) tr_store(kTs, u4_to_frag(P.f[ks]), sel, mi, ks, fr, fq, kd);
            }
            const float one[4] = {1.f, 1.f, 1.f, 1.f};
#pragma unroll
            for (int q = 0; q < 2; ++q) { const int pr = 2 * w + q; tr_store(vTs, u4_to_frag(P.v[q]), sel, pr >> 2, pr & 3, fr, fq, one); }
        }
        __syncthreads();
        const char* gbase = (const char*)p.proj + (size_t)t0 * (NPJ * 2) + RO.g;
        const uint4 g0 = *(const uint4*)gbase, g1 = *(const uint4*)(gbase + 16);
        if (c + 1 < 32) ret_prefetch(p, P, RO, b, c + 1);
        {
            const int lt = w & 3;
            bf16x8 qf[4];
#pragma unroll
            for (int s = 0; s < 4; ++s) qf[s] = ld8(qs + (16 * lt + fr) * 272 + (s * 4 + fq) * 16);
#pragma unroll
            for (int jj = 0; jj < 2; ++jj) {
                const int j = 2 * (w >> 2) + jj;
                f32x4 a = (f32x4){0.f, 0.f, 0.f, 0.f};
#pragma unroll
                for (int s = 0; s < 4; ++s) a = mfma16(ld8(ks_ + (16 * j + fr) * 272 + (s * 4 + fq) * 16), qf[s], a);
                const int l = 16 * lt + fr, mb = 16 * j + 4 * fq;
                float v[4];
#pragma unroll
                for (int r = 0; r < 4; ++r) { const int dd = l - (mb + r); v[r] = a[r] * exp2f(l2g * (float)(dd < 0 ? -dd : dd)); }
                *(uint2*)(Ss + l * 144 + mb * 2) = make_uint2(pk2(v[0], v[1]), pk2(v[2], v[3]));
            }
        }
        __syncthreads();
        {
            bf16x8 sp[4];
#pragma unroll
            for (int s = 0; s < 4; ++s) sp[s] = state_pack(st[2 * s], st[2 * s + 1]);
            bf16x8 vf[2];
#pragma unroll
            for (int s2 = 0; s2 < 2; ++s2) vf[s2] = ld8(vTs + (16 * w + fr) * 144 + (s2 * 4 + fq) * 16);
#pragma unroll
            for (int i = 0; i < 4; ++i) {
                f32x4 a = (f32x4){0.f, 0.f, 0.f, 0.f};
                const char* qrow = qs + (16 * i + fr) * 272;
#pragma unroll
                for (int s = 0; s < 4; ++s) {
                    const uint2 lo = *(const uint2*)(qrow + (32 * s + 4 * fq) * 2), hi = *(const uint2*)(qrow + (32 * s + 16 + 4 * fq) * 2);
                    a = mfma16(sp[s], mk8(lo, hi), a);
                }
                a = a * exp2f(l2g * (float)(16 * i + fr + 1));
#pragma unroll
                for (int s2 = 0; s2 < 2; ++s2) a = mfma16(vf[s2], ld8(Ss + (16 * i + fr) * 144 + (s2 * 4 + fq) * 16), a);
                *(uint2*)(Os + (16 * i + fr) * 272 + (16 * w + 4 * fq) * 2) = make_uint2(pk2(a[0], a[1]), pk2(a[2], a[3]));
            }
#pragma unroll
            for (int i = 0; i < 8; ++i) {
                f32x4 a = st[i] * g64;
#pragma unroll
                for (int s2 = 0; s2 < 2; ++s2) a = mfma16(ld8(kTs + (16 * i + fr) * 144 + (s2 * 4 + fq) * 16), vf[s2], a);
                st[i] = a;
            }
        }
        __syncthreads();
        {
            const int l = tid >> 3, part = tid & 7;
            const uint4 o0 = *(const uint4*)(Os + l * 272 + part * 32), o1 = *(const uint4*)(Os + l * 272 + part * 32 + 16);
            const unsigned ow[8] = {o0.x, o0.y, o0.z, o0.w, o1.x, o1.y, o1.z, o1.w}, gw[8] = {g0.x, g0.y, g0.z, g0.w, g1.x, g1.y, g1.z, g1.w};
            float x[16], s = 0.f;
#pragma unroll
            for (int e = 0; e < 8; ++e) { x[2 * e] = bflo(ow[e]); x[2 * e + 1] = bfhi(ow[e]); s += x[2 * e] + x[2 * e + 1]; }
            const float mu = grp8_sum(s) * (1.f / 128.f);
            float q = 0.f;
#pragma unroll
            for (int e = 0; e < 16; ++e) { x[e] -= mu; q += x[e] * x[e]; }
            const float rstd = rsqrtf(grp8_sum(q) * (1.f / 128.f) + EPSN);
            const float* gn = opaque_ptr(p.ret_norm_g + h * 128 + 16 * part);
            unsigned yo[8];
#pragma unroll
            for (int e = 0; e < 8; ++e) {
                const float ga = bflo(gw[e]), gb = bfhi(gw[e]);
                yo[e] = pk2(ga * sigmoidf_(ga) * x[2 * e] * rstd * gn[2 * e], gb * sigmoidf_(gb) * x[2 * e + 1] * rstd * gn[2 * e + 1]);
            }
            uint4* yp = (uint4*)(p.yb + (size_t)(t0 + l) * 1024 + h * 128 + 16 * part);
            yp[0] = make_uint4(yo[0], yo[1], yo[2], yo[3]);
            yp[1] = make_uint4(yo[4], yo[5], yo[6], yo[7]);
        }
    }
}

struct MlPre { uint4 f[4]; uint4 v[2]; float iv, fv; };
struct MlOff { unsigned f, v0, v1, o, c, g; };
DEVI void ml_offsets(const Params& p, MlOff& o, int h, int tid) {
    const int lane = tid & 63, w = tid >> 6, fr = lane & 15, fq = lane >> 4, mi = w & 3;
    const unsigned kdiff = (unsigned)((const char*)p.mk - (const char*)p.mq);
    o.f = (unsigned)(((16 * mi + fr) * 512 + h * 128 + 8 * fq) * 2) + (w < 4 ? kdiff : 0u);
    o.v0 = (unsigned)(((16 * ((2 * w) >> 2) + fr) * NPJ + 2560 + h * 128 + 32 * ((2 * w) & 3) + 8 * fq) * 2);
    o.v1 = (unsigned)(((16 * ((2 * w + 1) >> 2) + fr) * NPJ + 2560 + h * 128 + 32 * ((2 * w + 1) & 3) + 8 * fq) * 2);
    o.o = (unsigned)(((tid >> 3) * NPJ + 3072 + h * 128 + 16 * (tid & 7)) * 2);
    o.c = (unsigned)(((tid >> 3) * 512 + h * 128 + 16 * (tid & 7)) * 2);
    o.g = (unsigned)((lane * 4 + h) * 4);
}
DEVI void ml_prefetch(const Params& p, MlPre& P, const MlOff& o, int b, int c) {
    const size_t t0 = (size_t)(b * 2048 + c * 64);
    const char* bq = (const char*)p.mq + t0 * 1024, *bp = (const char*)p.proj + t0 * (NPJ * 2);
    const char* bi = (const char*)p.ipre + t0 * 16, *bf = (const char*)p.logf + t0 * 16;
#pragma unroll
    for (int ks = 0; ks < 4; ++ks) P.f[ks] = *(const uint4*)(bq + o.f + 64 * ks);
    P.v[0] = *(const uint4*)(bp + o.v0);
    P.v[1] = *(const uint4*)(bp + o.v1);
    P.iv = *(const float*)(bi + o.g);
    P.fv = *(const float*)(bf + o.g);
}
DEVI void mlstm_block(const Params& p, char* smem, int b, int h) {
    char* qs = smem;
    char* kTs = smem + 17408;
    char* vTs = smem + 35840;
    char* Os = smem + 54272;
    float* n_s = (float*)(smem + 71680);
    float* den_s = (float*)(smem + 72192);
    const int tid = stid(), lane = tid & 63, w = tid >> 6, fr = lane & 15, fq = lane >> 4;
    bf16x8 sel[2];
    sel_frags(sel, fr, fq);
    f32x4 st[8];
#pragma unroll
    for (int i = 0; i < 8; ++i) st[i] = (f32x4){0.f, 0.f, 0.f, 0.f};
    float m_run = 0.f, n_reg = 0.f;
    MlPre P;
    MlOff MO;
    ml_offsets(p, MO, h, tid);
    ml_prefetch(p, P, MO, b, 0);
#pragma unroll 1
    for (int c = 0; c < 32; ++c) {
        const int t0 = b * 2048 + c * 64;
        float fcum = P.fv;
#pragma unroll
        for (int o = 1; o < 64; o <<= 1) { const float tv = __shfl_up(fcum, o); if (lane >= o) fcum += tv; }
        const float a_c = __shfl(fcum, 63);
        const float logw = a_c - fcum + P.iv;
        const float m_in = wave_max(logw);
        const float m_new = fmaxf(a_c + m_run, m_in);
        const float decay = __expf(a_c + m_run - m_new);
        const float wgt = __expf(logw - m_new);
        const float emn = __expf(-m_new);
        m_run = m_new;
        {
            const int mi = w & 3;
            if (w < 4) {
                float kw[4];
#pragma unroll
                for (int r = 0; r < 4; ++r) kw[r] = __shfl(wgt, 16 * mi + 4 * fq + r);
#pragma unroll
                for (int ks = 0; ks < 4; ++ks) tr_store(kTs, u4_to_frag(P.f[ks]), sel, mi, ks, fr, fq, kw);
            } else {
                char* dst = qs + (16 * mi + fr) * 272 + fq * 16;
#pragma unroll
                for (int ks = 0; ks < 4; ++ks) *(uint4*)(dst + ks * 64) = P.f[ks];
            }
            const float one[4] = {1.f, 1.f, 1.f, 1.f};
#pragma unroll
            for (int q = 0; q < 2; ++q) { const int pr = 2 * w + q; tr_store(vTs, u4_to_frag(P.v[q]), sel, pr >> 2, pr & 3, fr, fq, one); }
        }
        __syncthreads();
        const char* obase = (const char*)p.proj + (size_t)t0 * (NPJ * 2) + MO.o, *cbase = (const char*)p.cbuf + (size_t)t0 * 1024 + MO.c;
        const uint4 mo0 = *(const uint4*)obase, mo1 = *(const uint4*)(obase + 16), cc0 = *(const uint4*)cbase, cc1 = *(const uint4*)(cbase + 16);
        if (c + 1 < 32) ml_prefetch(p, P, MO, b, c + 1);
        if (tid < 128) {
            float s = 0.f;
#pragma unroll
            for (int q = 0; q < 8; ++q) {
                const uint4 a = *(const uint4*)(kTs + tid * 144 + q * 16);
                s += (bflo(a.x) + bfhi(a.x)) + (bflo(a.y) + bfhi(a.y)) + (bflo(a.z) + bfhi(a.z)) + (bflo(a.w) + bfhi(a.w));
            }
            n_reg = decay * n_reg + s;
            n_s[tid] = n_reg;
        }
        {
            bf16x8 vf[2];
#pragma unroll
            for (int s2 = 0; s2 < 2; ++s2) vf[s2] = ld8(vTs + (16 * w + fr) * 144 + (s2 * 4 + fq) * 16);
#pragma unroll
            for (int i = 0; i < 8; ++i) {
                f32x4 a = st[i] * decay;
#pragma unroll
                for (int s2 = 0; s2 < 2; ++s2) a = mfma16(ld8(kTs + (16 * i + fr) * 144 + (s2 * 4 + fq) * 16), vf[s2], a);
                st[i] = a;
            }
        }
        __syncthreads();
        {
            const int l = tid >> 3, part = tid & 7;
            const uint4 a0 = *(const uint4*)(qs + l * 272 + part * 32), a1 = *(const uint4*)(qs + l * 272 + part * 32 + 16);
            const unsigned aw[8] = {a0.x, a0.y, a0.z, a0.w, a1.x, a1.y, a1.z, a1.w};
            const float* nn = n_s + 16 * part;
            float s = 0.f;
#pragma unroll
            for (int e = 0; e < 8; ++e) s += bflo(aw[e]) * nn[2 * e] + bfhi(aw[e]) * nn[2 * e + 1];
            s = grp8_sum(s);
            if (part == 0) den_s[l] = fmaxf(fabsf(s), emn);
        }
        __syncthreads();
        {
            bf16x8 sp[4];
#pragma unroll
            for (int s = 0; s < 4; ++s) sp[s] = state_pack(st[2 * s], st[2 * s + 1]);
#pragma unroll
            for (int i = 0; i < 4; ++i) {
                f32x4 a = (f32x4){0.f, 0.f, 0.f, 0.f};
                const char* qrow = qs + (16 * i + fr) * 272;
#pragma unroll
                for (int s = 0; s < 4; ++s) {
                    const uint2 lo = *(const uint2*)(qrow + (32 * s + 4 * fq) * 2), hi = *(const uint2*)(qrow + (32 * s + 16 + 4 * fq) * 2);
                    a = mfma16(sp[s], mk8(lo, hi), a);
                }
                const float rd = 1.f / den_s[16 * i + fr];
                *(uint2*)(Os + (16 * i + fr) * 272 + (16 * w + 4 * fq) * 2) = make_uint2(pk2(a[0] * rd, a[1] * rd), pk2(a[2] * rd, a[3] * rd));
            }
        }
        __syncthreads();
        {
            const int l = tid >> 3, part = tid & 7;
            const uint4 o0 = *(const uint4*)(Os + l * 272 + part * 32), o1 = *(const uint4*)(Os + l * 272 + part * 32 + 16);
            const unsigned ow[8] = {o0.x, o0.y, o0.z, o0.w, o1.x, o1.y, o1.z, o1.w};
            const unsigned gw[8] = {mo0.x, mo0.y, mo0.z, mo0.w, mo1.x, mo1.y, mo1.z, mo1.w}, cw[8] = {cc0.x, cc0.y, cc0.z, cc0.w, cc1.x, cc1.y, cc1.z, cc1.w};
            float x[16], s = 0.f;
#pragma unroll
            for (int e = 0; e < 8; ++e) { x[2 * e] = bflo(ow[e]); x[2 * e + 1] = bfhi(ow[e]); s += x[2 * e] + x[2 * e + 1]; }
            const float mu = grp8_sum(s) * (1.f / 128.f);
            float q = 0.f;
#pragma unroll
            for (int e = 0; e < 16; ++e) { x[e] -= mu; q += x[e] * x[e]; }
            const float rstd = rsqrtf(grp8_sum(q) * (1.f / 128.f) + EPSN);
            const float* gn = opaque_ptr(p.m_norm_g + h * 128 + 16 * part);
            const float* sk = opaque_ptr(p.m_skip + h * 128 + 16 * part);
            unsigned yo[8];
#pragma unroll
            for (int e = 0; e < 8; ++e) {
                const float ya = sigmoidf_(bflo(gw[e])) * (x[2 * e] * rstd * gn[2 * e] + sk[2 * e] * bflo(cw[e]));
                const float yb_ = sigmoidf_(bfhi(gw[e])) * (x[2 * e + 1] * rstd * gn[2 * e + 1] + sk[2 * e + 1] * bfhi(cw[e]));
                yo[e] = pk2(ya, yb_);
            }
            uint4* yp = (uint4*)(p.yb + (size_t)(t0 + l) * 1024 + 512 + h * 128 + 16 * part);
            yp[0] = make_uint4(yo[0], yo[1], yo[2], yo[3]);
            yp[1] = make_uint4(yo[4], yo[5], yo[6], yo[7]);
        }
    }
}
DEVI void st_recur(const Params& p, char* smem) {
    if (blockIdx.x >= 128 || gridDim.x <= 128) {
        const int bid = gridDim.x > 128 ? (int)blockIdx.x - 128 : (int)blockIdx.x, nb = gridDim.x > 128 ? (int)gridDim.x - 128 : (int)gridDim.x;
        st_prep_w2(p, smem, bid, nb);
        st_prep_wsub(p, smem, bid, nb);
        st_prep_tables(p, bid, nb);
        if (gridDim.x > 128) return;
    }
    for (int bi = blockIdx.x; bi < 128; bi += gridDim.x) {
        const int kind = bi & 1, h = (bi >> 1) & 3, b = bi >> 3;
        if (kind == 0) ret_block(p, smem, b, h);
        else mlstm_block(p, smem, b, h);
        __syncthreads();
    }
}

DEVI void st_norm2(const Params& p) {
    const int lane = stid() & 63, wid = stid() >> 6;
    for (int t = blockIdx.x * NW + wid; t < T_TOK; t += gridDim.x * NW) {
        float xv[16];
        float ss = 0.f;
#pragma unroll
        for (int i = 0; i < 4; ++i) {
            const float4 a = *(const float4*)(p.out + (size_t)t * 1024 + lane * 16 + i * 4);
            xv[4 * i] = a.x; xv[4 * i + 1] = a.y; xv[4 * i + 2] = a.z; xv[4 * i + 3] = a.w;
            ss += a.x * a.x + a.y * a.y + a.z * a.z + a.w * a.w;
        }
        ss = wave_sum(ss);
        const float rs = rsqrtf(ss * (1.f / 1024.f) + EPSN);
        uint4* ob = (uint4*)(p.x1b + (size_t)t * 1024 + lane * 16);
        ob[0] = make_uint4(pk2(xv[0], xv[1]), pk2(xv[2], xv[3]), pk2(xv[4], xv[5]), pk2(xv[6], xv[7]));
        ob[1] = make_uint4(pk2(xv[8], xv[9]), pk2(xv[10], xv[11]), pk2(xv[12], xv[13]), pk2(xv[14], xv[15]));
        float am = 0.f;
#pragma unroll
        for (int i = 0; i < 4; ++i) {
            const float4 g = *(const float4*)(p.norm2_g + lane * 16 + i * 4);
            xv[4 * i] *= rs * g.x; xv[4 * i + 1] *= rs * g.y; xv[4 * i + 2] *= rs * g.z; xv[4 * i + 3] *= rs * g.w;
        }
#pragma unroll
        for (int c = 0; c < 16; ++c) am = fmaxf(am, fabsf(xv[c]));
        am = wave_max(am);
        const float inv = am > 0.f ? 127.f / am : 0.f;
        unsigned w[4];
#pragma unroll
        for (int i = 0; i < 4; ++i) {
            const int q0 = (int)rintf(xv[4 * i] * inv), q1 = (int)rintf(xv[4 * i + 1] * inv), q2 = (int)rintf(xv[4 * i + 2] * inv), q3 = (int)rintf(xv[4 * i + 3] * inv);
            w[i] = (unsigned)(q0 & 255) | ((unsigned)(q1 & 255) << 8) | ((unsigned)(q2 & 255) << 16) | ((unsigned)(q3 & 255) << 24);
        }
        *(uint4*)(p.xq + (size_t)t * 1024 + lane * 16) = make_uint4(w[0], w[1], w[2], w[3]);
        if (lane == 0) { p.rs2[t] = rs; p.xsc[t] = am > 0.f ? am * (1.f / 127.f) : 1.f; }
    }
}

DEVI int f2key(float f) { const int b = __float_as_int(f); return b ^ ((b >> 31) & 0x7fffffff); }
DEVI float key2f(int k) { return __int_as_float(k ^ ((k >> 31) & 0x7fffffff)); }
template <int N> DEVI void bsort_desc(int (&v)[N]) {
#pragma unroll
    for (int k = 2; k <= N; k <<= 1)
#pragma unroll
        for (int j = k >> 1; j > 0; j >>= 1)
#pragma unroll
            for (int i = 0; i < N; ++i) {
                const int l = i ^ j;
                if (l > i) {
                    const int a = v[i], b = v[l];
                    const int mx = a > b ? a : b, mn = a > b ? b : a;
                    if ((i & k) == 0) { v[i] = mx; v[l] = mn; } else { v[i] = mn; v[l] = mx; }
                }
            }
}
template <int N> DEVI void bmerge_desc(int (&v)[N]) {
#pragma unroll
    for (int j = N >> 1; j > 0; j >>= 1)
#pragma unroll
        for (int i = 0; i < N; ++i) {
            const int l = i ^ j;
            if (l > i) { const int a = v[i], b = v[l]; v[i] = a > b ? a : b; v[l] = a > b ? b : a; }
        }
}
DEVI void xmerge16(int (&v)[16], int mask) {
    int o[16];
#pragma unroll
    for (int i = 0; i < 16; ++i) o[i] = __shfl_xor(v[15 - i], mask);
#pragma unroll
    for (int i = 0; i < 16; ++i) v[i] = v[i] > o[i] ? v[i] : o[i];
    bmerge_desc<16>(v);
}
__device__ const unsigned char cand_tab[52] = {
    0x00, 0x01, 0x02, 0x03, 0x04, 0x05, 0x06, 0x07, 0x08, 0x09, 0x0a, 0x0b, 0x0c, 0x0d, 0x0e, 0x0f,
    0x10, 0x11, 0x12, 0x13, 0x14, 0x15, 0x16, 0x17, 0x20, 0x21, 0x22, 0x23, 0x24, 0x30, 0x31, 0x32, 0x33,
    0x40, 0x41, 0x42, 0x50, 0x51, 0x60, 0x61, 0x70, 0x71, 0x80, 0x90, 0xa0, 0xb0, 0xc0, 0xd0, 0xe0, 0xf0, 0xff, 0xff};
constexpr int H_A = 256 * 64, H_B = 256 * 64, H_STAGE = H_A + H_B;
DEVI void glds16(const void* g, char* l) {
    __builtin_amdgcn_global_load_lds((const __attribute__((address_space(1))) unsigned*)g, (__attribute__((address_space(3))) unsigned*)l, 16, 0, 0);
}
DEVI void gemm3_topk_tile(const Params& p, int m0, int h, char* smem) {
    const int tid = stid(), lane = tid & 63, w = tid >> 6, fr = lane & 15, fq = lane >> 4;
    f32x4 acc[2][16];
#pragma unroll
    for (int i = 0; i < 2; ++i)
#pragma unroll
        for (int j = 0; j < 16; ++j) acc[i][j] = (f32x4){0.f, 0.f, 0.f, 0.f};
    const int r16 = lane >> 2, csrc = (lane & 3) ^ ((r16 >> 2) & 3);
    const bf16_t* srcA = p.x1b + (size_t)(m0 + w * 32 + r16) * 1024 + csrc * 8;
    const bf16_t* srcB = p.Wsubt + ((size_t)h * 256 + w * 32 + r16) * 1024 + csrc * 8;
    char* dstA = smem + (w * 32) * 64 + lane * 16;
    char* dstB = smem + H_A + (w * 32) * 64 + lane * 16;
    auto issue = [&](int kt, int buf) {
#pragma unroll
        for (int q = 0; q < 2; ++q) glds16(srcA + (size_t)q * 16 * 1024 + kt * 32, dstA + buf * H_STAGE + q * 1024);
#pragma unroll
        for (int q = 0; q < 2; ++q) glds16(srcB + (size_t)q * 16 * 1024 + kt * 32, dstB + buf * H_STAGE + q * 1024);
    };
    const int rdoff = fr * 64 + ((fq ^ ((fr >> 2) & 3)) * 16);
    issue(0, 0);
    __syncthreads();
#pragma unroll 1
    for (int kt = 0; kt < 32; ++kt) {
        if (kt + 1 < 32) issue(kt + 1, (kt + 1) & 1);
        const char* As = smem + (kt & 1) * H_STAGE;
        const char* Bs = As + H_A;
        bf16x8 a[2];
#pragma unroll
        for (int i = 0; i < 2; ++i) a[i] = ld8(As + (32 * w + 16 * i) * 64 + rdoff);
#pragma unroll
        for (int jg = 0; jg < 4; ++jg) {
            bf16x8 b[4];
#pragma unroll
            for (int j = 0; j < 4; ++j) b[j] = ld8(Bs + (16 * (4 * jg + j)) * 64 + rdoff);
#pragma unroll
            for (int i = 0; i < 2; ++i)
#pragma unroll
                for (int j = 0; j < 4; ++j) acc[i][4 * jg + j] = mfma16(b[j], a[i], acc[i][4 * jg + j]);
        }
        __syncthreads();
    }
    int* L = (int*)(smem + H_STAGE + w * 2304);
#pragma unroll
    for (int i = 0; i < 2; ++i) {
        const int t = m0 + 32 * w + 16 * i + fr;
        const float rs = p.rs2[t];
#pragma unroll
        for (int pp = 0; pp < 2; ++pp) {
            int ka[16], kb[16];
#pragma unroll
            for (int jj = 0; jj < 4; ++jj)
#pragma unroll
                for (int r = 0; r < 4; ++r) {
                    ka[jj * 4 + r] = (f2key(acc[i][8 * pp + jj][r] * rs) & ~127) | (16 * jj + 4 * fq + r);
                    kb[jj * 4 + r] = (f2key(acc[i][8 * pp + 4 + jj][r] * rs) & ~127) | (16 * (jj + 4) + 4 * fq + r);
                }
            bsort_desc<16>(ka);
            bsort_desc<16>(kb);
#pragma unroll
            for (int q = 0; q < 16; ++q) ka[q] = ka[q] > kb[15 - q] ? ka[q] : kb[15 - q];
            bmerge_desc<16>(ka);
            xmerge16(ka, 16);
            xmerge16(ka, 32);
            if (fq == 0) {
#pragma unroll
                for (int q = 0; q < 4; ++q) *(int4*)(L + fr * 36 + pp * 16 + q * 4) = make_int4(ka[4 * q], ka[4 * q + 1], ka[4 * q + 2], ka[4 * q + 3]);
            }
        }
        int c[16];
#pragma unroll
        for (int s = 0; s < 13; ++s) {
            const int ab = cand_tab[fq * 13 + s];
            const int k1 = L[fr * 36 + (ab >> 4)], k2 = L[fr * 36 + 16 + (ab & 15)];
            const float v = key2f(k1 & ~127) + key2f(k2 & ~127);
            c[s] = (f2key(v) & ~0x3fff) | ((k1 & 127) << 7) | (k2 & 127);
        }
        c[13] = c[14] = c[15] = (int)0x80000000;
        bsort_desc<16>(c);
        xmerge16(c, 16);
        xmerge16(c, 32);
        const float vmax = key2f(c[0] & ~0x3fff);
        float e[16], sum = 0.f;
#pragma unroll
        for (int q = 0; q < 16; ++q) { e[q] = __expf(key2f(c[q] & ~0x3fff) - vmax); sum += e[q]; }
        const float inv = 1.f / sum;
#pragma unroll
        for (int q = 0; q < 4; ++q) {
            const int cq = fq == 0 ? c[q] : fq == 1 ? c[4 + q] : fq == 2 ? c[8 + q] : c[12 + q];
            const float eq = fq == 0 ? e[q] : fq == 1 ? e[4 + q] : fq == 2 ? e[8 + q] : e[12 + q];
            const int k = h * 16 + 4 * fq + q, slot = (k & 7) * 16 + (k >> 3);
            p.eperm[(size_t)t * 128 + slot] = (unsigned short)(((cq >> 7) & 127) * 128 + (cq & 127));
            p.gate[(size_t)t * 128 + slot] = eq * inv;
        }
    }
}
DEVI void st_gemm3_topk(const Params& p, char* smem) {
    for (int it = blockIdx.x; it < 128 * 8; it += gridDim.x) gemm3_topk_tile(p, (it >> 3) * 256, it & 7, smem);
}

#define XB_TMO      128
#define XB_XCNT(j)  (256  + 64 * (j))
#define XB_XSUB(j)  (1280 + 64 * (j))
#define XB_XGEN(j)  (2304 + 64 * (j))
#define XB_TOP      3328
#define XB_TOPGEN   3392
#define XCD_BAR_WORDS 3456
#define XB_SPIN_CAP (1u << 20)
#define LAS __attribute__((address_space(3)))
DEVI unsigned xb_ld(unsigned* p) { return __hip_atomic_load(p, __ATOMIC_RELAXED, __HIP_MEMORY_SCOPE_AGENT); }
DEVI unsigned xb_add(unsigned* p, unsigned v) { return __hip_atomic_fetch_add(p, v, __ATOMIC_RELAXED, __HIP_MEMORY_SCOPE_AGENT); }
DEVI unsigned xb_xcc_id() { return (unsigned)__builtin_amdgcn_s_getreg((3 << 11) | 20) & 0xFu; }
#define XB_SPIN(cond, bar) do { unsigned _sp = 0; while (cond) { __builtin_amdgcn_s_sleep(1); \
    if ((++_sp & 255u) == 0u) { if (xb_ld(&(bar)[XB_TMO])) break; if (_sp > XB_SPIN_CAP) { atomicAdd(&(bar)[XB_TMO], 1u); break; } } } } while (0)
struct XcdBarrier { unsigned* bar; unsigned x; volatile LAS unsigned* st; };
DEVI XcdBarrier xcd_barrier_post(unsigned* bar, volatile LAS unsigned* st) {
    XcdBarrier b; b.bar = bar; b.x = xb_xcc_id(); b.st = st;
    if (stid() == 0) (void)xb_add(&bar[XB_XCNT(b.x)], 1u);
    return b;
}
DEVI void xcd_barrier_complete(unsigned* bar, unsigned x, unsigned& nloc, unsigned& nx) {
    const unsigned G = gridDim.x * gridDim.y * gridDim.z;
    unsigned sum, cnt, mine, sp = 0u;
    for (;;) {
        sum = 0u; cnt = 0u; mine = 0u;
#pragma unroll
        for (unsigned j = 0; j < 16; ++j) { const unsigned c = xb_ld(&bar[XB_XCNT(j)]); sum += c; cnt += (c > 0u) ? 1u : 0u; mine = (j == x) ? c : mine; }
        if (sum == G) break;
        __builtin_amdgcn_s_sleep(1);
        if ((++sp & 255u) == 0u) { if (xb_ld(&bar[XB_TMO])) break; if (sp > XB_SPIN_CAP) { atomicAdd(&bar[XB_TMO], 1u); break; } }
    }
    nloc = mine > 0u ? mine : 1u; nx = cnt > 0u ? cnt : 1u;
}
DEVI void xcd_barrier(const XcdBarrier& b) {
    asm volatile("s_waitcnt vmcnt(0)" ::: "memory");
    __syncthreads();
    if (stid() == 0) {
        unsigned* bar = b.bar;
        __builtin_amdgcn_s_waitcnt(0);
        unsigned nloc = b.st[0], nx = b.st[1];
        if (nloc == 0u) { xcd_barrier_complete(bar, b.x, nloc, nx); b.st[0] = nloc; b.st[1] = nx; }
        const unsigned old = xb_add(&bar[XB_XSUB(b.x)], 1u);
        const unsigned gen = old / nloc;
        if (old + 1u == (gen + 1u) * nloc) {
            __builtin_amdgcn_fence(__ATOMIC_RELEASE, "agent");
            asm volatile("s_waitcnt vmcnt(0)" ::: "memory");
            const unsigned og = xb_add(&bar[XB_TOP], 1u);
            const unsigned tg = og / nx;
            if (og + 1u == (tg + 1u) * nx) xb_add(&bar[XB_TOPGEN], 1u);
            else XB_SPIN(xb_ld(&bar[XB_TOPGEN]) == tg, bar);
            __builtin_amdgcn_fence(__ATOMIC_ACQUIRE, "agent");
            xb_add(&bar[XB_XGEN(b.x)], 1u);
            asm volatile("s_waitcnt vmcnt(0)" ::: "memory");
        } else {
            XB_SPIN(xb_ld(&bar[XB_XGEN(b.x)]) == gen, bar);
            __builtin_amdgcn_fence(__ATOMIC_ACQUIRE, "agent");
            asm volatile("s_waitcnt vmcnt(0)" ::: "memory");
        }
    }
    __syncthreads();
}

#define CTR_A(x) (XCD_BAR_WORDS + 64 * (x))
#define CTR_B(x) (XCD_BAR_WORDS + 512 + 64 * (x))
#define CTL_WORDS (XCD_BAR_WORDS + 1024)
typedef float f32x2 __attribute__((ext_vector_type(2)));
DEVI float ub(unsigned w, int n) { return (float)((w >> (8 * n)) & 0xffu); }
DEVI float gelu_erf(float u) { return 0.5f * u * (1.f + erff(u * 0.70710678118654752f)); }
struct ExpMeta { uint4 e[2]; uint4 xa; float sc; };
struct ExpRows { uint4 r[16]; float2 x1; };

template <int PHASE> DEVI void exp_load_meta(const Params& p, ExpMeta& m, int t, int x, int lane) {
    const uint4* ep = (const uint4*)(p.eperm + (size_t)t * 128 + (lane >> 3) * 16);
    m.e[0] = ep[0];
    m.e[1] = ep[1];
    if (PHASE == 0) m.xa = *(const uint4*)(p.xq + (size_t)t * 1024 + 128 * x + 16 * (lane & 7));
    else { m.xa = *(const uint4*)(p.aq + (size_t)t * 128 + (lane >> 3) * 16); m.sc = p.asc[t]; }
}
template <int PHASE> DEVI void exp_issue(const Params& p, const ExpMeta& m, ExpRows& R, int t, int x, int lane) {
    const unsigned char* base = (PHASE == 0 ? p.down_q : p.up_q) + (size_t)x * (16384 * 128) + (lane & 7) * 16;
    const unsigned ew[8] = {m.e[0].x, m.e[0].y, m.e[0].z, m.e[0].w, m.e[1].x, m.e[1].y, m.e[1].z, m.e[1].w};
#pragma unroll
    for (int j = 0; j < 16; ++j) {
        const unsigned ek = (j & 1) ? (ew[j >> 1] >> 16) : (ew[j >> 1] & 0xffffu);
        R.r[j] = *(const uint4*)(base + (size_t)ek * 128);
    }
    if (PHASE == 1) {
        const int col = 128 * x + 16 * (lane & 7) + ((lane & 32) ? 8 : 0) + ((lane & 16) ? 4 : 0) + ((lane & 8) ? 2 : 0);
        R.x1 = *(const float2*)(p.out + (size_t)t * 1024 + col);
    }
}
DEVI void expA_compute(const Params& p, const ExpMeta& m, const ExpRows& R, int t, int x, int lane) {
    const bool b2 = lane & 4, b1 = lane & 2, b0 = lane & 1;
    int ps[16];
#pragma unroll
    for (int j = 0; j < 16; ++j)
        ps[j] = __builtin_amdgcn_sdot4((int)R.r[j].x, (int)m.xa.x, __builtin_amdgcn_sdot4((int)R.r[j].y, (int)m.xa.y,
                __builtin_amdgcn_sdot4((int)R.r[j].z, (int)m.xa.z, __builtin_amdgcn_sdot4((int)R.r[j].w, (int)m.xa.w, 0, false), false), false), false);
    int q8[8], q4[4], q2[2];
#pragma unroll
    for (int j = 0; j < 8; ++j) { const int snd = b2 ? ps[j] : ps[j + 8], kp = b2 ? ps[j + 8] : ps[j]; q8[j] = kp + __shfl_xor(snd, 4); }
#pragma unroll
    for (int j = 0; j < 4; ++j) { const int snd = b1 ? q8[j] : q8[j + 4], kp = b1 ? q8[j + 4] : q8[j]; q4[j] = kp + __shfl_xor(snd, 2); }
#pragma unroll
    for (int j = 0; j < 2; ++j) { const int snd = b0 ? q4[j] : q4[j + 2], kp = b0 ? q4[j + 2] : q4[j]; q2[j] = kp + __shfl_xor(snd, 1); }
    *(int2*)(p.part + ((size_t)x * T_TOK + t) * 128 + 2 * lane) = make_int2(q2[0], q2[1]);
}
DEVI void expB_compute(const Params& p, const ExpMeta& m, const ExpRows& R, int t, int x, int lane) {
    const bool b5 = lane & 32, b4 = lane & 16, b3 = lane & 8;
    const unsigned pa[4] = {m.xa.x, m.xa.y, m.xa.z, m.xa.w};
    int acc[16];
#pragma unroll
    for (int c = 0; c < 16; ++c) acc[c] = 0;
#pragma unroll
    for (int g = 0; g < 4; ++g) {
        const unsigned r0[4] = {R.r[4 * g].x, R.r[4 * g].y, R.r[4 * g].z, R.r[4 * g].w};
        const unsigned r1[4] = {R.r[4 * g + 1].x, R.r[4 * g + 1].y, R.r[4 * g + 1].z, R.r[4 * g + 1].w};
        const unsigned r2[4] = {R.r[4 * g + 2].x, R.r[4 * g + 2].y, R.r[4 * g + 2].z, R.r[4 * g + 2].w};
        const unsigned r3[4] = {R.r[4 * g + 3].x, R.r[4 * g + 3].y, R.r[4 * g + 3].z, R.r[4 * g + 3].w};
#pragma unroll
        for (int i = 0; i < 4; ++i) {
            const unsigned t0 = __builtin_amdgcn_perm(r1[i], r0[i], 0x05010400u), t1 = __builtin_amdgcn_perm(r1[i], r0[i], 0x07030602u);
            const unsigned t2 = __builtin_amdgcn_perm(r3[i], r2[i], 0x05010400u), t3 = __builtin_amdgcn_perm(r3[i], r2[i], 0x07030602u);
            const unsigned o0 = __builtin_amdgcn_perm(t2, t0, 0x05040100u), o1 = __builtin_amdgcn_perm(t2, t0, 0x07060302u);
            const unsigned o2 = __builtin_amdgcn_perm(t3, t1, 0x05040100u), o3 = __builtin_amdgcn_perm(t3, t1, 0x07060302u);
            acc[4 * i + 0] = __builtin_amdgcn_sdot4((int)o0, (int)pa[g], acc[4 * i + 0], false);
            acc[4 * i + 1] = __builtin_amdgcn_sdot4((int)o1, (int)pa[g], acc[4 * i + 1], false);
            acc[4 * i + 2] = __builtin_amdgcn_sdot4((int)o2, (int)pa[g], acc[4 * i + 2], false);
            acc[4 * i + 3] = __builtin_amdgcn_sdot4((int)o3, (int)pa[g], acc[4 * i + 3], false);
        }
    }
    int q8[8], q4[4], q2[2];
#pragma unroll
    for (int j = 0; j < 8; ++j) { const int snd = b5 ? acc[j] : acc[j + 8], kp = b5 ? acc[j + 8] : acc[j]; q8[j] = kp + __shfl_xor(snd, 32); }
#pragma unroll
    for (int j = 0; j < 4; ++j) { const int snd = b4 ? q8[j] : q8[j + 4], kp = b4 ? q8[j + 4] : q8[j]; q4[j] = kp + __shfl_xor(snd, 16); }
#pragma unroll
    for (int j = 0; j < 2; ++j) { const int snd = b3 ? q4[j] : q4[j + 2], kp = b3 ? q4[j + 2] : q4[j]; q2[j] = kp + __shfl_xor(snd, 8); }
    const int col = 128 * x + 16 * (lane & 7) + (b5 ? 8 : 0) + (b4 ? 4 : 0) + (b3 ? 2 : 0);
    *(float2*)((float*)p.proj + (size_t)t * 1024 + col) = make_float2(R.x1.x + (float)q2[0] * m.sc, R.x1.y + (float)q2[1] * m.sc);
}
template <int PHASE>
DEVI void exp_chunk(const Params& p, int tb, int x, int lane) {
    ExpMeta mA, mB, nA, nB;
    ExpRows rA, rB;
    exp_load_meta<PHASE>(p, mA, tb, x, lane);
    exp_load_meta<PHASE>(p, mB, tb + 1, x, lane);
    exp_issue<PHASE>(p, mA, rA, tb, x, lane);
    exp_issue<PHASE>(p, mB, rB, tb + 1, x, lane);
    exp_load_meta<PHASE>(p, nA, tb + 2, x, lane);
    exp_load_meta<PHASE>(p, nB, tb + 3, x, lane);
#pragma unroll 1
    for (int i = 0; i < 8; ++i) {
        const int tA = tb + 2 * i, tB = tA + 1;
        if (PHASE == 0) expA_compute(p, mA, rA, tA, x, lane); else expB_compute(p, mA, rA, tA, x, lane);
        if (i < 7) {
            mA = nA;
            exp_issue<PHASE>(p, mA, rA, tA + 2, x, lane);
            if (i < 6) exp_load_meta<PHASE>(p, nA, tA + 4, x, lane);
        }
        if (PHASE == 0) expA_compute(p, mB, rB, tB, x, lane); else expB_compute(p, mB, rB, tB, x, lane);
        if (i < 7) {
            mB = nB;
            exp_issue<PHASE>(p, mB, rB, tB + 2, x, lane);
            if (i < 6) exp_load_meta<PHASE>(p, nB, tB + 4, x, lane);
        }
    }
}
template <int PHASE>
DEVI void st_expAB(const Params& p, char* smem) {
    const int tid = stid(), lane = tid & 63, wid = tid >> 6;
    volatile int* cs = (volatile int*)smem;
    const unsigned myx = xb_xcc_id() & 7u;
    constexpr int NCH = T_TOK / (16 * NW);
    for (int si = 0; si < 8; ++si) {
        const int x = (int)((myx + si) & 7u);
        unsigned* ctr = &p.bar[PHASE == 0 ? CTR_A(x) : CTR_B(x)];
        if (tid == 0) cs[0] = (int)xb_add(ctr, 1u);
        __syncthreads();
        int chunk = cs[0];
        __syncthreads();
        while (chunk < NCH) {
            int nxt = 0;
            if (tid == 0) nxt = (int)xb_add(ctr, 1u);
            exp_chunk<PHASE>(p, chunk * (16 * NW) + wid * 16, x, lane);
            if (tid == 0) cs[0] = nxt;
            __syncthreads();
            chunk = cs[0];
            __syncthreads();
        }
    }
}
DEVI void st_expA2(const Params& p) {
    const int lane = stid() & 63, wid = stid() >> 6;
    for (int t = blockIdx.x * NW + wid; t < T_TOK; t += gridDim.x * NW) {
        int s0 = 0, s1 = 0;
#pragma unroll
        for (int x = 0; x < 8; ++x) { const int2 v = *(const int2*)(p.part + ((size_t)x * T_TOK + t) * 128 + 2 * lane); s0 += v.x; s1 += v.y; }
        const float xs = p.xsc[t];
        const unsigned ew = *(const unsigned*)(p.eperm + (size_t)t * 128 + 2 * lane);
        const int ea = (int)(ew & 0xffffu), eb = (int)(ew >> 16);
        const float2 g = *(const float2*)(p.gate + (size_t)t * 128 + 2 * lane);
        const float a0 = g.x * gelu_erf((float)s0 * xs * p.dscale[ea]) * p.uscale[ea];
        const float a1 = g.y * gelu_erf((float)s1 * xs * p.dscale[eb]) * p.uscale[eb];
        const float amax = wave_max(fmaxf(fabsf(a0), fabsf(a1)));
        const float inv = amax > 0.f ? 127.f / amax : 0.f;
        const unsigned q0 = (unsigned)((int)rintf(a0 * inv) & 255), q1 = (unsigned)((int)rintf(a1 * inv) & 255);
        *(unsigned short*)(p.aq + (size_t)t * 128 + 2 * lane) = (unsigned short)(q0 | (q1 << 8));
        if (lane == 0) p.asc[t] = amax * (1.f / 127.f);
    }
}
DEVI void st_expC(const Params& p) {
    const int lane = stid() & 63, wid = stid() >> 6;
    for (int t = blockIdx.x * NW + wid; t < T_TOK; t += gridDim.x * NW) {
        const float4* row = (const float4*)((const float*)p.proj + (size_t)t * 1024);
        float4 v[4];
        float ss = 0.f;
#pragma unroll
        for (int j = 0; j < 4; ++j) { v[j] = row[lane + 64 * j]; ss += v[j].x * v[j].x + v[j].y * v[j].y + v[j].z * v[j].z + v[j].w * v[j].w; }
        ss = wave_sum(ss);
        const float rf = rsqrtf(ss * (1.f / 1024.f) + EPSN);
        float4* orow = (float4*)(p.out + (size_t)t * 1024);
#pragma unroll
        for (int j = 0; j < 4; ++j) {
            const float4 g = *(const float4*)(p.final_g + (lane + 64 * j) * 4);
            orow[lane + 64 * j] = make_float4(v[j].x * rf * g.x, v[j].y * rf * g.y, v[j].z * rf * g.z, v[j].w * rf * g.w);
        }
    }
}

constexpr int LDS_BYTES = 147456;
constexpr int LDS_BARW = LDS_BYTES - 16;
extern __shared__ __attribute__((aligned(16))) char smem_dyn[];
__global__ void __launch_bounds__(NTHR, 2) mega_fwd(Params p) {
    cg::grid_group grid = cg::this_grid();
    volatile LAS unsigned* bst = (volatile LAS unsigned*)(LAS char*)(smem_dyn + LDS_BARW);
    if (stid() < 4) bst[stid()] = 0u;
    __syncthreads();
    XcdBarrier bar = xcd_barrier_post(p.bar, bst);
    st_prep_misc(p);
    st_prep_w1(p, smem_dyn);
    st_prep_x(p, smem_dyn);
    if (p.pad_[0] == 0x7fffabcd) grid.sync();
    xcd_barrier(bar);
    st_gemm8<EpiProj8, PG8_ALIGN>(p.xb, p.W1t, NPJ, 1024, smem_dyn, EpiProj8{p.proj, p.rs1, p.rope_cos, p.rope_sin});
    xcd_barrier(bar);
    st_conv_qk(p, smem_dyn);
    xcd_barrier(bar);
    st_recur(p, smem_dyn);
    xcd_barrier(bar);
    st_gemm8<EpiX18, PG8_ALIGN>(p.yb, p.W2t, 1024, 1024, smem_dyn, EpiX18{p.x, p.out});
    xcd_barrier(bar);
    st_norm2(p);
    xcd_barrier(bar);
    st_gemm3_topk(p, smem_dyn);
    xcd_barrier(bar);
    st_expAB<0>(p, smem_dyn);
    xcd_barrier(bar);
    st_expA2(p);
    xcd_barrier(bar);
    st_expAB<1>(p, smem_dyn);
    xcd_barrier(bar);
    st_expC(p);
}

extern "C" void kernel_launch(void* const* d_in, const int* in_sizes, int n_in, void* d_out, int out_size, void* d_ws, size_t ws_size,
                              hipStream_t stream) {
    Params p{};
    const float* const* in = (const float* const*)d_in;
    p.x = in[0]; p.norm1_g = in[1]; p.w_in = in[2]; p.ret_norm_g = in[3]; p.m_conv_w = in[4]; p.m_conv_b = in[5]; p.m_wq = in[6]; p.m_wk = in[7];
    p.m_b_i = in[8]; p.m_b_f = in[9]; p.m_norm_g = in[10]; p.m_skip = in[11]; p.w_out = in[12]; p.norm2_g = in[13]; p.peer_wq = in[14];
    p.peer_keys = in[15]; p.peer_down = in[16]; p.peer_up = in[17]; p.final_g = in[18];
    p.out = (float*)d_out;
    char* ws = (char*)d_ws;
    size_t off = 0;
    auto take = [&](size_t bytes) { char* r = ws + off; off += (bytes + 255) & ~(size_t)255; return r; };
    p.proj = (bf16_t*)take((size_t)T_TOK * NPJ * 2);
    p.xb = (bf16_t*)take((size_t)T_TOK * 1024 * 2);
    p.yb = p.xb;
    p.gate = (float*)(ws + (size_t)T_TOK * 2048 * 4);
    p.mq = (bf16_t*)take((size_t)T_TOK * 512 * 2);
    p.mk = (bf16_t*)take((size_t)T_TOK * 512 * 2);
    p.x1b = p.mq;
    p.cbuf = (bf16_t*)take((size_t)T_TOK * 512 * 2);
    p.eperm = (unsigned short*)p.cbuf;
    p.down_q = (unsigned char*)take((size_t)16384 * 1024);
    p.up_q = (unsigned char*)take((size_t)16384 * 1024);
    p.dscale = (float*)take(16384 * 4);
    p.uscale = (float*)take(16384 * 4);
    p.bar = (unsigned*)take(CTL_WORDS * 4);
    p.xq = (unsigned char*)take((size_t)T_TOK * 1024);
    p.xsc = (float*)take(T_TOK * 4);
    p.asc = (float*)take(T_TOK * 4);
    p.aq = (unsigned char*)take((size_t)T_TOK * 128);
    p.part = (int*)(ws + (size_t)T_TOK * 1024 * 4);
    p.W1t = (bf16_t*)take((size_t)NPJ * 1024 * 2);
    p.W2t = (bf16_t*)take((size_t)1024 * 1024 * 2);
    p.Wsubt = (bf16_t*)take((size_t)2048 * 1024 * 2);
    p.Wqt = (bf16_t*)take(4 * 128 * 128 * 2);
    p.Wkt = (bf16_t*)take(4 * 128 * 128 * 2);
    p.rs1 = (float*)take(T_TOK * 4);
    p.rs2 = (float*)take(T_TOK * 4);
    p.ipre = (float*)take(T_TOK * 4 * 4);
    p.logf = (float*)take(T_TOK * 4 * 4);
    p.rope_cos = (float*)take(2048 * 64 * 4);
    p.rope_sin = (float*)take(2048 * 64 * 4);
    if (off > ws_size) { fprintf(stderr, "kernel_launch: workspace too small (%zu > %zu)\n", off, ws_size); return; }

    static int grid_blocks = 0;
    if (!grid_blocks) {
        int dev = 0, cus = 0, per_cu = 0;
        (void)hipGetDevice(&dev);
        (void)hipDeviceGetAttribute(&cus, hipDeviceAttributeMultiprocessorCount, dev);
        (void)hipFuncSetAttribute((const void*)mega_fwd, hipFuncAttributeMaxDynamicSharedMemorySize, LDS_BYTES);
        (void)hipOccupancyMaxActiveBlocksPerMultiprocessor(&per_cu, (const void*)mega_fwd, NTHR, LDS_BYTES);
        if (per_cu > 1) per_cu = 1;
        if (per_cu < 1) per_cu = 1;
        grid_blocks = cus * per_cu;
    }
    (void)hipMemsetAsync(p.bar, 0, CTL_WORDS * 4, stream);
    void* args[] = {&p};
    hipError_t e = hipLaunchCooperativeKernel((const void*)mega_fwd, dim3(grid_blocks), dim3(NTHR), args, LDS_BYTES, stream);
    if (e != hipSuccess) fprintf(stderr, "cooperative launch failed: %s (grid %d)\n", hipGetErrorString(e), grid_blocks);
}
```

```cpp
#include <hip/hip_runtime.h>
#include <hip/hip_cooperative_groups.h>
#include <stdint.h>
#include <cstdio>
namespace cg = cooperative_groups;

typedef unsigned short bf16_t;
typedef short bf16x8 __attribute__((ext_vector_type(8)));
typedef float f32x4 __attribute__((ext_vector_type(4)));

#define DEVI __device__ __forceinline__
__device__ __forceinline__ int stid() { int t = (int)threadIdx.x; asm volatile("" : "+v"(t)); return t; }

constexpr int T_TOK = 32768, DM = 1024, NPJ = 3584, DIN = 3592;
constexpr int NTHR = 512, NW = 8;
constexpr float EPSN = 1e-6f;

struct Params {
    const float *x, *norm1_g, *w_in, *ret_norm_g, *m_conv_w, *m_conv_b, *m_wq, *m_wk, *m_b_i, *m_b_f, *m_norm_g, *m_skip, *w_out,
        *norm2_g, *peer_wq, *peer_keys, *peer_down, *peer_up, *final_g;
    float* out;
    bf16_t *proj, *xb, *yb, *mq, *mk, *x1b, *cbuf, *W1t, *W2t, *Wsubt, *Wqt, *Wkt;
    unsigned char *down_q, *up_q;
    float *dscale, *uscale, *xsc, *asc;
    unsigned short* eperm;
    unsigned char* aq;
    int* part;
    unsigned char* xq;
    unsigned* bar;
    float *rs1, *rs2, *ipre, *logf, *rope_cos, *rope_sin, *gate;
    int pad_[2];
};

DEVI unsigned f2bf_bits(float f) { unsigned u = __float_as_uint(f); return (u + 0x7fffu + ((u >> 16) & 1u)) >> 16; }
DEVI bf16_t f2bf(float f) { return __builtin_bit_cast(bf16_t, (__bf16)f); }
typedef __bf16 bf16x2_t __attribute__((ext_vector_type(2)));
DEVI unsigned pk2(float lo, float hi) { bf16x2_t v = {(__bf16)lo, (__bf16)hi}; return __builtin_bit_cast(unsigned, v); }
DEVI float bflo(unsigned w) { return __uint_as_float(w << 16); }
DEVI float bfhi(unsigned w) { return __uint_as_float(w & 0xffff0000u); }
DEVI float bf2f(bf16_t h) { return __uint_as_float(((unsigned)h) << 16); }
DEVI float wave_sum(float v) {
#pragma unroll
    for (int o = 32; o; o >>= 1) v += __shfl_xor(v, o);
    return v;
}
DEVI float wave_max(float v) {
#pragma unroll
    for (int o = 32; o; o >>= 1) v = fmaxf(v, __shfl_xor(v, o));
    return v;
}
DEVI f32x4 mfma16(bf16x8 a, bf16x8 b, f32x4 c) { return __builtin_amdgcn_mfma_f32_16x16x32_bf16(a, b, c, 0, 0, 0); }
DEVI bf16x8 ld8(const char* p) { return *reinterpret_cast<const bf16x8*>(p); }
DEVI bf16x8 mk8(uint2 lo, uint2 hi) {
    union { uint4 u; bf16x8 v; } x;
    x.u = make_uint4(lo.x, lo.y, hi.x, hi.y);
    return x.v;
}
DEVI float sigmoidf_(float z) { return 1.f / (1.f + __expf(-z)); }

DEVI void st_prep_misc(const Params& p) {
    const int gtid = blockIdx.x * NTHR + stid(), gsz = gridDim.x * NTHR;
    for (int i = gtid; i < 2048 * 64; i += gsz) {
        const int pos = i >> 6, j = i & 63;
        const float inv = powf(10000.f, -(float)j * (1.f / 64.f));
        const float ang = (float)pos * inv;
        float s, c;
        sincosf(ang, &s, &c);
        p.rope_cos[i] = c;
        p.rope_sin[i] = s;
    }
    for (int i = gtid; i < 4 * 128 * 128; i += gsz) {
        const int h = i >> 14, e = (i >> 7) & 127, d = i & 127;
        p.Wqt[i] = f2bf(p.m_wq[h * 16384 + d * 128 + e]);
        p.Wkt[i] = f2bf(p.m_wk[h * 16384 + d * 128 + e] * 0.08838834764831845f);
    }
}
DEVI void prep_table_row(const Params& p, int row, const float4 (&v)[4], int lane) {
    const bool up = row >= 16384;
    const int e = up ? row - 16384 : row;
    float am = 0.f;
#pragma unroll
    for (int i = 0; i < 4; ++i) am = fmaxf(am, fmaxf(fmaxf(fabsf(v[i].x), fabsf(v[i].y)), fmaxf(fabsf(v[i].z), fabsf(v[i].w))));
    am = wave_max(am);
    const float sc = am > 0.f ? am * (1.f / 127.f) : 1.f, inv = am > 0.f ? 127.f / am : 0.f;
    unsigned w[4];
#pragma unroll
    for (int i = 0; i < 4; ++i) {
        const int q0 = (int)rintf(v[i].x * inv), q1 = (int)rintf(v[i].y * inv), q2 = (int)rintf(v[i].z * inv), q3 = (int)rintf(v[i].w * inv);
        w[i] = (unsigned)(q0 & 255) | ((unsigned)(q1 & 255) << 8) | ((unsigned)(q2 & 255) << 16) | ((unsigned)(q3 & 255) << 24);
    }
    *(uint4*)((up ? p.up_q : p.down_q) + ((size_t)(lane >> 3) * 16384 + e) * 128 + (lane & 7) * 16) = make_uint4(w[0], w[1], w[2], w[3]);
    if (lane == 0) (up ? p.uscale : p.dscale)[e] = sc;
}
DEVI void st_prep_tables(const Params& p, int bid, int nb) {
    const int lane = stid() & 63, wid = stid() >> 6;
    for (int row = (bid * NW + wid) * 2; row < 32768; row += nb * NW * 2) {
        float4 va[4], vb[4];
        const float4* sa = (const float4*)((row >= 16384 ? p.peer_up + (size_t)(row - 16384) * 1024 : p.peer_down + (size_t)row * 1024) + lane * 16);
        const float4* sb = (const float4*)((row + 1 >= 16384 ? p.peer_up + (size_t)(row + 1 - 16384) * 1024 : p.peer_down + (size_t)(row + 1) * 1024) + lane * 16);
#pragma unroll
        for (int i = 0; i < 4; ++i) { va[i] = sa[i]; vb[i] = sb[i]; }
        prep_table_row(p, row, va, lane);
        prep_table_row(p, row + 1, vb, lane);
    }
}

DEVI void transpose_tile(const float* __restrict__ src, int ld, const float* __restrict__ scale, bf16_t* __restrict__ dst, int K, int k0, int n0,
                         float* tile, bool permqk = false) {
    const int tid = stid();
    {
        const int tx = tid & 63, ty = tid >> 6;
#pragma unroll
        for (int i = 0; i < 4; ++i) {
            const int k = k0 + ty + 8 * i;
            float v = src[(size_t)k * ld + n0 + tx];
            if (scale) v *= scale[k];
            tile[(ty + 8 * i) * 65 + tx] = v;
        }
    }
    __syncthreads();
    {
        const int n = tid >> 3, kq = tid & 7;
        const float a = tile[(4 * kq) * 65 + n], b = tile[(4 * kq + 1) * 65 + n], c = tile[(4 * kq + 2) * 65 + n], d = tile[(4 * kq + 3) * 65 + n];
        int nn = n0 + n;
        if (permqk && nn < 1024) { const int dd = nn & 127; nn = (nn & ~127) + (dd < 64 ? 2 * dd : 2 * (dd - 64) + 1); }
        *(uint2*)(dst + (size_t)nn * K + k0 + 4 * kq) = make_uint2(pk2(a, b), pk2(c, d));
    }
    __syncthreads();
}
DEVI void st_prep_w1(const Params& p, char* smem) {
    float* tile = (float*)smem;
    for (int it = blockIdx.x; it < 56 * 32; it += gridDim.x) transpose_tile(p.w_in, DIN, p.norm1_g, p.W1t, 1024, (it & 31) * 32, (it >> 5) * 64, tile, true);
}
DEVI void st_prep_w2(const Params& p, char* smem, int bid, int nb) {
    float* tile = (float*)smem;
    for (int it = bid; it < 16 * 32; it += nb) transpose_tile(p.w_out, 1024, nullptr, p.W2t, 1024, (it & 31) * 32, (it >> 5) * 64, tile);
}
DEVI void st_prep_wsub(const Params& p, char* smem, int bid, int nb) {
    float* wq_s = (float*)smem;
    float* key_s = wq_s + 32 * 132;
    const int tid = stid();
    for (int it = bid; it < 16 * 32 * 2; it += nb) {
        const int grp = it >> 6, kt = (it >> 1) & 31, nh = it & 1, k0 = kt * 32;
#pragma unroll
        for (int i = 0; i < 8; ++i) {
            const int idx = tid + 512 * i, r = idx >> 7, d = idx & 127;
            wq_s[r * 132 + d] = p.peer_wq[(size_t)(k0 + r) * 2048 + grp * 128 + d];
        }
#pragma unroll
        for (int i = 0; i < 16; ++i) {
            const int idx = tid + 512 * i, n = idx >> 7, d = idx & 127;
            key_s[n * 132 + d] = p.peer_keys[((size_t)grp * 128 + nh * 64 + n) * 128 + d];
        }
        __syncthreads();
        const int kl = tid & 15, ng = tid >> 4;
        float a00 = 0.f, a01 = 0.f, a10 = 0.f, a11 = 0.f;
#pragma unroll 8
        for (int d4 = 0; d4 < 32; ++d4) {
            const float4 w0 = *(const float4*)(wq_s + (2 * kl) * 132 + 4 * d4), w1 = *(const float4*)(wq_s + (2 * kl + 1) * 132 + 4 * d4);
            const float4 y0 = *(const float4*)(key_s + (2 * ng) * 132 + 4 * d4), y1 = *(const float4*)(key_s + (2 * ng + 1) * 132 + 4 * d4);
            a00 += w0.x * y0.x + w0.y * y0.y + w0.z * y0.z + w0.w * y0.w;
            a01 += w0.x * y1.x + w0.y * y1.y + w0.z * y1.z + w0.w * y1.w;
            a10 += w1.x * y0.x + w1.y * y0.y + w1.z * y0.z + w1.w * y0.w;
            a11 += w1.x * y1.x + w1.y * y1.y + w1.z * y1.z + w1.w * y1.w;
        }
        const float g0 = p.norm2_g[k0 + 2 * kl], g1 = p.norm2_g[k0 + 2 * kl + 1];
        bf16_t* o = p.Wsubt + (size_t)(grp * 128 + nh * 64 + 2 * ng) * 1024 + k0 + 2 * kl;
        *(unsigned*)o = pk2(a00 * g0, a10 * g1);
        *(unsigned*)(o + 1024) = pk2(a01 * g0, a11 * g1);
        __syncthreads();
    }
}

DEVI void prep_x_token(const Params& p, const float* Wg_s, int t, const float4 (&v)[4], int lane) {
    float ss = 0.f, g8[8];
#pragma unroll
    for (int g = 0; g < 8; ++g) g8[g] = 0.f;
#pragma unroll
    for (int j = 0; j < 4; ++j) {
        ss += v[j].x * v[j].x + v[j].y * v[j].y + v[j].z * v[j].z + v[j].w * v[j].w;
#pragma unroll
        for (int g = 0; g < 8; ++g) {
            const float4 w = *(const float4*)(Wg_s + g * 1024 + (lane + 64 * j) * 4);
            g8[g] += v[j].x * w.x + v[j].y * w.y + v[j].z * w.z + v[j].w * w.w;
        }
    }
    ss = wave_sum(ss);
    const bool b5 = lane & 32, b4 = lane & 16, b3 = lane & 8;
    float q4[4], q2[2], q1;
#pragma unroll
    for (int j = 0; j < 4; ++j) { const float snd = b5 ? g8[j] : g8[j + 4], kp = b5 ? g8[j + 4] : g8[j]; q4[j] = kp + __shfl_xor(snd, 32); }
#pragma unroll
    for (int j = 0; j < 2; ++j) { const float snd = b4 ? q4[j] : q4[j + 2], kp = b4 ? q4[j + 2] : q4[j]; q2[j] = kp + __shfl_xor(snd, 16); }
    { const float snd = b3 ? q2[0] : q2[1], kp = b3 ? q2[1] : q2[0]; q1 = kp + __shfl_xor(snd, 8); }
    q1 += __shfl_xor(q1, 4);
    q1 += __shfl_xor(q1, 2);
    q1 += __shfl_xor(q1, 1);
    const float rs = rsqrtf(ss * (1.f / 1024.f) + EPSN);
    uint2* o = (uint2*)(p.xb + (size_t)t * 1024);
#pragma unroll
    for (int j = 0; j < 4; ++j) o[lane + 64 * j] = make_uint2(pk2(v[j].x, v[j].y), pk2(v[j].z, v[j].w));
    if (lane == 0) p.rs1[t] = rs;
    if ((lane & 7) == 0) {
        const int gi = (b5 ? 4 : 0) + (b4 ? 2 : 0) + (b3 ? 1 : 0);
        if (gi < 4) p.ipre[t * 4 + gi] = q1 * rs + p.m_b_i[gi];
        else {
            const float z = q1 * rs + p.m_b_f[gi - 4];
            p.logf[t * 4 + gi - 4] = fminf(z, 0.f) - log1pf(__expf(-fabsf(z)));
        }
    }
}
DEVI void st_prep_x(const Params& p, char* smem) {
    float* Wg_s = (float*)smem;
    for (int i = stid(); i < 8192; i += NTHR) {
        const int k = i >> 3, g = i & 7;
        Wg_s[g * 1024 + k] = p.norm1_g[k] * p.w_in[(size_t)k * DIN + NPJ + g];
    }
    __syncthreads();
    const int lane = stid() & 63, wid = stid() >> 6;
    for (int t = (blockIdx.x * NW + wid) * 2; t < T_TOK; t += gridDim.x * NW * 2) {
        float4 va[4], vb[4];
        const float4* xa = (const float4*)(p.x + (size_t)t * 1024);
#pragma unroll
        for (int j = 0; j < 4; ++j) { va[j] = xa[lane + 64 * j]; vb[j] = xa[256 + lane + 64 * j]; }
        prep_x_token(p, Wg_s, t, va, lane);
        prep_x_token(p, Wg_s, t + 1, vb, lane);
    }
    __syncthreads();
}

namespace pg8 {
#define PG8_LAS __attribute__((address_space(3)))
typedef unsigned short bf16_t;
typedef short bf16x8 __attribute__((ext_vector_type(8)));
typedef float f32x4 __attribute__((ext_vector_type(4)));
typedef unsigned u32x4 __attribute__((ext_vector_type(4)));
constexpr int BM = 256, BK = 64, HALF = 128, HTB = HALF * BK * 2  , STAGE_BYTES = 8 * HTB, NXCD = 8, WGM = 8;

__host__ __device__ __forceinline__ int lds_byte(int r, int c) { const int st = (r >> 4) * 2 + (c >> 5), rr = r & 15, cc = c & 31, ob = rr * 64 + cc * 2; return st * 1024 + (ob ^ (((ob >> 9) & 1) << 5)); }
__host__ __device__ __forceinline__ void stage_rc(int b, int& R, int& C) { const int st = b / 1024, sb = b % 1024, swz = sb ^ (((sb >> 9) & 1) << 5); R = (st >> 1) * 16 + swz / 64; C = (st & 1) * 32 + (swz % 64) / 2; }
__host__ __device__ __forceinline__ int perm32(int rho) { const int n = rho >> 4, i = rho & 15; return 8 * (i >> 2) + 4 * n + (i & 3); }

struct Unit { int pm, pn; };
struct Gemm { const bf16_t* A; const bf16_t* Bt; int M, N, K; };

struct StaticOrder {
    int nM, nN, nwg, G, c;
    __host__ __device__ void init(int M, int N, int G_, int c_) { nM = M / BM; nN = N / BM; nwg = nM * nN; G = G_; c = c_; }
    __host__ __device__ bool next(int i, Unit& u) const {
        const long L = (long)i * G + c; if (L >= nwg) return false;
        int wgid = (int)L; { const int q = nwg / NXCD, r = nwg % NXCD, xcd = wgid % NXCD, off = wgid / NXCD; wgid = (xcd < r ? xcd * (q + 1) : r * (q + 1) + (xcd - r) * q) + off; }
        const int nig = WGM * nN, gid = wgid / nig, fm = gid * WGM, gsz = (nM - fm) < WGM ? (nM - fm) : WGM;
        u.pm = fm + ((wgid % nig) % gsz); u.pn = (wgid % nig) / gsz; return true;
    }
    __device__ __forceinline__ void a_ready(const Unit&) const {}
    __device__ __forceinline__ void done(const Unit&) const {}
};

__device__ __forceinline__ unsigned cvt_pk_bf16(float lo, float hi) { unsigned r; asm volatile("v_cvt_pk_bf16_f32 %0, %1, %2" : "=v"(r) : "v"(lo), "v"(hi)); return r; }

template <class Epi, class Sched, bool ALIGN_EPI = false, bool SP2 = false>
__device__ __forceinline__ void gemm_phase(PG8_LAS unsigned char* lds, const Gemm g, const Sched& S, const Epi& E) {
    const int tid = stid(), wid = __builtin_amdgcn_readfirstlane(tid >> 6), lane = tid & 63, wr = wid >> 2, wc = wid & 3, fr = lane & 15, fq = lane >> 4;
    const int K = g.K, nt = K / BK;
    unsigned voffA[2], voffB[2];
#pragma unroll
    for (int i = 0; i < 2; ++i) { int R, C; stage_rc(tid * 16 + i * 8192, R, C); const int Rb = Epi::PERM ? ((R & ~31) + perm32(R & 31)) : R;
        voffA[i] = (unsigned)(R * K + C) * 2u; voffB[i] = (unsigned)(Rb * K + C) * 2u; }
    const size_t kstep = (size_t)(BK * 2);
    const size_t hstep = (size_t)HALF * K * 2;
    const size_t tstep = 2 * hstep;
    const unsigned ldsw = (unsigned)wid * 1024u;
    const int aoff = lds_byte(wr * 64 + fr, fq * 8), boff = lds_byte(wc * 32 + fr, fq * 8);
#define PG8_SA(b, h) (((b) * 2 + (h)) * HTB)
#define PG8_SB(b, h) ((4 + (b) * 2 + (h)) * HTB)
#define PG8_STAGE(bufoff, gbase, voff) do { _Pragma("unroll") for (int _i = 0; _i < 2; ++_i) \
        __builtin_amdgcn_global_load_lds((const unsigned*)((const char*)(gbase) + (voff)[_i]), (PG8_LAS unsigned*)(lds + (bufoff) + ldsw + _i * 8192), 16, 0, 0); } while (0)
#define PG8_LDA(dst, b, h) do { _Pragma("unroll") for (int m = 0; m < 4; ++m) _Pragma("unroll") for (int k = 0; k < 2; ++k) dst[m][k] = *(const PG8_LAS bf16x8*)(lds + PG8_SA(b, h) + aoff + m * 2048 + k * 1024); } while (0)
#define PG8_LDB(dst, b, h) do { _Pragma("unroll") for (int n = 0; n < 2; ++n) _Pragma("unroll") for (int k = 0; k < 2; ++k) dst[n][k] = *(const PG8_LAS bf16x8*)(lds + PG8_SB(b, h) + boff + n * 2048 + k * 1024); } while (0)
#define PG8_MMA(ai, bj, At, Bt) do { __builtin_amdgcn_s_setprio(1); _Pragma("unroll") for (int m = 0; m < 4; ++m) _Pragma("unroll") for (int n = 0; n < 2; ++n) _Pragma("unroll") for (int k = 0; k < 2; ++k) \
        acc[ai][bj][m][n] = __builtin_amdgcn_mfma_f32_16x16x32_bf16(Bt[n][k], At[m][k], acc[ai][bj][m][n], 0, 0, 0); __builtin_amdgcn_s_setprio(0); } while (0)
#define PG8_WAIT_V(n) asm volatile("s_waitcnt vmcnt(" #n ")" ::: "memory")
#define PG8_WAIT_L(n) asm volatile("s_waitcnt lgkmcnt(" #n ")" ::: "memory")
#define PG8_BAR __builtin_amdgcn_s_barrier()
#define PG8_SCHED __builtin_amdgcn_sched_barrier(0)
    Unit cur, nxt; int ui = 0;
    if (!S.next(0, cur)) return;
    f32x4 acc[2][2][4][2];
#pragma unroll
    for (int a = 0; a < 2; ++a)
#pragma unroll
        for (int b = 0; b < 2; ++b)
#pragma unroll
            for (int m = 0; m < 4; ++m)
#pragma unroll
                for (int n = 0; n < 2; ++n) acc[a][b][m][n] = (f32x4){0.f, 0.f, 0.f, 0.f};
    bf16x8 At[4][2], B0[2][2], B1[2][2];
    const char* cA = (const char*)g.A + (size_t)cur.pm * tstep; const char* cB = (const char*)g.Bt + (size_t)cur.pn * tstep;
    S.a_ready(cur);
    if constexpr (SP2) {
        PG8_STAGE(PG8_SB(0, 0), cB, voffB); PG8_STAGE(PG8_SB(0, 1), cB + hstep, voffB); PG8_STAGE(PG8_SA(0, 0), cA, voffA); PG8_STAGE(PG8_SA(0, 1), cA + hstep, voffA);
        if (wr == 1) PG8_BAR;
        PG8_WAIT_V(2); PG8_BAR;
        PG8_STAGE(PG8_SB(1, 0), cB + kstep, voffB); PG8_STAGE(PG8_SA(1, 0), cA + kstep, voffA); PG8_STAGE(PG8_SB(1, 1), cB + hstep + kstep, voffB);
        PG8_WAIT_V(6); PG8_BAR;
    } else {
        PG8_STAGE(PG8_SB(0, 0), cB, voffB); PG8_STAGE(PG8_SA(0, 0), cA, voffA); PG8_STAGE(PG8_SB(0, 1), cB + hstep, voffB); PG8_STAGE(PG8_SA(0, 1), cA + hstep, voffA);
        if (wr == 1) PG8_BAR;
        PG8_WAIT_V(4); PG8_BAR;
        PG8_STAGE(PG8_SB(1, 0), cB + kstep, voffB); PG8_STAGE(PG8_SA(1, 0), cA + kstep, voffA); PG8_STAGE(PG8_SB(1, 1), cB + hstep + kstep, voffB);
        PG8_WAIT_V(6); PG8_BAR;
    }
    for (;;) {
        const bool has_next = S.next(ui + 1, nxt);
        const char* nA = has_next ? (const char*)g.A + (size_t)nxt.pm * tstep : cA; const char* nB = has_next ? (const char*)g.Bt + (size_t)nxt.pn * tstep : cB;
        for (int t = 0; t < nt; t += 2) {
            const bool last = (t == nt - 2);
            const char* a1 = cA + (size_t)(t + 1) * kstep;
            const char* a2 = last ? nA : cA + (size_t)(t + 2) * kstep; const char* b2 = last ? nB : cB + (size_t)(t + 2) * kstep;
            const char* a3 = a2 + kstep; const char* b3 = b2 + kstep;
            if (last && has_next) S.a_ready(nxt);
            if constexpr (SP2) {
            PG8_LDB(B0, 0, 0); PG8_LDB(B1, 0, 1); PG8_SCHED; PG8_LDA(At, 0, 0); PG8_STAGE(PG8_SA(1, 1), a1 + hstep, voffA);
            PG8_WAIT_V(8); PG8_WAIT_L(0); PG8_BAR; PG8_MMA(0, 0, At, B0); PG8_MMA(0, 1, At, B1); PG8_BAR; PG8_SCHED;
            PG8_LDA(At, 0, 1); PG8_STAGE(PG8_SB(0, 0), b2, voffB); PG8_STAGE(PG8_SB(0, 1), b2 + hstep, voffB); PG8_STAGE(PG8_SA(0, 0), a2, voffA);
            PG8_WAIT_V(8); PG8_WAIT_L(0); PG8_BAR; PG8_MMA(1, 0, At, B0); PG8_MMA(1, 1, At, B1); PG8_BAR; PG8_SCHED;
            PG8_LDB(B0, 1, 0); PG8_LDB(B1, 1, 1); PG8_SCHED; PG8_LDA(At, 1, 0); PG8_STAGE(PG8_SA(0, 1), a2 + hstep, voffA);
            PG8_WAIT_V(8); PG8_WAIT_L(0); PG8_BAR; PG8_MMA(0, 0, At, B0); PG8_MMA(0, 1, At, B1); PG8_BAR; PG8_SCHED;
            PG8_LDA(At, 1, 1); PG8_STAGE(PG8_SB(1, 0), b3, voffB); PG8_STAGE(PG8_SB(1, 1), b3 + hstep, voffB); PG8_STAGE(PG8_SA(1, 0), a3, voffA);
            PG8_WAIT_V(8); PG8_WAIT_L(0); PG8_BAR; PG8_MMA(1, 0, At, B0); PG8_MMA(1, 1, At, B1); PG8_BAR; PG8_SCHED;
            } else {
            PG8_LDB(B0, 0, 0); PG8_SCHED; PG8_LDA(At, 0, 0); PG8_STAGE(PG8_SA(1, 1), a1 + hstep, voffA);
            PG8_WAIT_L(8); PG8_BAR; PG8_WAIT_L(0); PG8_MMA(0, 0, At, B0); PG8_BAR; PG8_SCHED;
            PG8_LDB(B1, 0, 1); PG8_STAGE(PG8_SB(0, 0), b2, voffB);
            PG8_BAR; PG8_WAIT_L(0); PG8_MMA(0, 1, At, B1); PG8_BAR;
            PG8_LDA(At, 0, 1); PG8_STAGE(PG8_SA(0, 0), a2, voffA);
            PG8_BAR; PG8_WAIT_L(0); PG8_MMA(1, 0, At, B0); PG8_BAR; PG8_SCHED;
            PG8_STAGE(PG8_SB(0, 1), b2 + hstep, voffB);
            PG8_WAIT_V(6); PG8_BAR; PG8_MMA(1, 1, At, B1); PG8_BAR;
            PG8_LDB(B0, 1, 0); PG8_SCHED; PG8_LDA(At, 1, 0); PG8_STAGE(PG8_SA(0, 1), a2 + hstep, voffA);
            PG8_WAIT_L(8); PG8_BAR; PG8_WAIT_L(0); PG8_MMA(0, 0, At, B0); PG8_BAR; PG8_SCHED;
            PG8_LDB(B1, 1, 1); PG8_STAGE(PG8_SB(1, 0), b3, voffB);
            PG8_BAR; PG8_WAIT_L(0); PG8_MMA(0, 1, At, B1); PG8_BAR;
            PG8_LDA(At, 1, 1); PG8_STAGE(PG8_SA(1, 0), a3, voffA);
            PG8_BAR; PG8_WAIT_L(0); PG8_MMA(1, 0, At, B0); PG8_BAR; PG8_SCHED;
            PG8_STAGE(PG8_SB(1, 1), b3 + hstep, voffB);
            PG8_WAIT_V(6); PG8_BAR; PG8_MMA(1, 1, At, B1); PG8_BAR;
            }
        }
        if constexpr (ALIGN_EPI) { if (wr == 0) PG8_BAR; }
        if constexpr (!Epi::AFTER_DRAIN) { E(acc, cur, wr, wc, fr, fq); S.done(cur); }
        if (!has_next) break;
#pragma unroll
        for (int a = 0; a < 2; ++a)
#pragma unroll
            for (int b = 0; b < 2; ++b)
#pragma unroll
                for (int m = 0; m < 4; ++m)
#pragma unroll
                    for (int n = 0; n < 2; ++n) acc[a][b][m][n] = (f32x4){0.f, 0.f, 0.f, 0.f};
        cur = nxt; cA = nA; cB = nB; ++ui;
        if constexpr (ALIGN_EPI) { if (wr == 1) PG8_BAR; }
    }
    PG8_WAIT_V(0);
    if constexpr (!ALIGN_EPI) { if (wr == 0) PG8_BAR; }
    PG8_BAR;
    if constexpr (Epi::AFTER_DRAIN) { E.fused(acc, cur, wr, wc, fr, fq, lds, wid, lane); S.done(cur); }
#undef PG8_SA
#undef PG8_SB
#undef PG8_STAGE
#undef PG8_LDA
#undef PG8_LDB
#undef PG8_MMA
#undef PG8_WAIT_V
#undef PG8_WAIT_L
#undef PG8_BAR
#undef PG8_SCHED
}
}

#ifndef PG8_SP2
#define PG8_SP2 true
#endif
#ifndef PG8_ALIGN
#define PG8_ALIGN true
#endif
struct EpiProj8 {
    static constexpr bool PERM = true, AFTER_DRAIN = false;
    bf16_t* O; const float* rs; const float* rcos; const float* rsin;
    __device__ __forceinline__ void operator()(const pg8::f32x4 (&acc)[2][2][4][2], const pg8::Unit& u, int wr, int wc, int fr, int fq) const {
        const int row0 = u.pm * 256 + wr * 64 + fr, col0 = u.pn * 256 + wc * 32 + 8 * fq;
        const bool rot = u.pn < 4;
        const float ksc = u.pn >= 2 ? 0.08838834764831845f : 1.f;
#pragma unroll
        for (int ai = 0; ai < 2; ++ai)
#pragma unroll
            for (int m = 0; m < 4; ++m) {
                const int row = row0 + ai * 128 + m * 16;
                const float s = rs[row];
                bf16_t* rowp = O + (size_t)row * NPJ + col0;
                float4 cs = make_float4(1.f, 1.f, 1.f, 1.f), sn = make_float4(0.f, 0.f, 0.f, 0.f);
                float s2 = s;
                if (rot) {
                    const int ti = (row & 2047) * 64 + 16 * wc + 4 * fq;
                    cs = *(const float4*)(rcos + ti);
                    sn = *(const float4*)(rsin + ti);
                    s2 = s * ksc;
                }
#pragma unroll
                for (int bj = 0; bj < 2; ++bj) {
                    const pg8::f32x4 v0 = acc[ai][bj][m][0] * s2, v1 = acc[ai][bj][m][1] * s2;
                    *(uint4*)(rowp + bj * 128) = make_uint4(pk2(v0[0] * cs.x - v0[1] * sn.x, v0[0] * sn.x + v0[1] * cs.x), pk2(v0[2] * cs.y - v0[3] * sn.y, v0[2] * sn.y + v0[3] * cs.y),
                                                            pk2(v1[0] * cs.z - v1[1] * sn.z, v1[0] * sn.z + v1[1] * cs.z), pk2(v1[2] * cs.w - v1[3] * sn.w, v1[2] * sn.w + v1[3] * cs.w));
                }
            }
    }
};
struct EpiX18 {
    static constexpr bool PERM = false, AFTER_DRAIN = false;
    const float* x; float* out;
    __device__ __forceinline__ void operator()(const pg8::f32x4 (&acc)[2][2][4][2], const pg8::Unit& u, int wr, int wc, int fr, int fq) const {
        const int row0 = u.pm * 256 + wr * 64 + fr, col0 = u.pn * 256 + wc * 32 + 4 * fq;
#pragma unroll
        for (int ai = 0; ai < 2; ++ai)
#pragma unroll
            for (int m = 0; m < 4; ++m) {
                const size_t ro = (size_t)(row0 + ai * 128 + m * 16) * 1024 + col0;
#pragma unroll
                for (int bj = 0; bj < 2; ++bj)
#pragma unroll
                    for (int n = 0; n < 2; ++n) {
                        const float4 xv = *(const float4*)(x + ro + bj * 128 + n * 16);
                        const pg8::f32x4 v = acc[ai][bj][m][n];
                        *(float4*)(out + ro + bj * 128 + n * 16) = make_float4(xv.x + v[0], xv.y + v[1], xv.z + v[2], xv.w + v[3]);
                    }
            }
    }
};
template <class Epi, bool ALIGN>
DEVI void st_gemm8(const bf16_t* A, const bf16_t* Bt, int N, int K, char* smem, const Epi& epi) {
    pg8::Gemm g{A, Bt, T_TOK, N, K};
    pg8::StaticOrder S;
    S.init(T_TOK, N, (int)gridDim.x, (int)blockIdx.x);
    pg8::gemm_phase<Epi, pg8::StaticOrder, ALIGN, PG8_SP2>((PG8_LAS unsigned char*)smem, g, S, epi);
}

DEVI void st_conv_qk(const Params& p, char* smem) {
    char* cs = smem;
    char* ws = smem + 128 * 272;
    const int tid = stid(), lane = tid & 63, wid = tid >> 6, wr = wid >> 1, wc = wid & 1, fr = lane & 15, fq = lane >> 4;
    for (int it = blockIdx.x; it < 256 * 4; it += gridDim.x) {
        const int h = it & 3, t0 = (it >> 2) * 128, s0 = t0 & 2047;
        {
            const int ch = tid & 127, r0 = (tid >> 7) * 32;
            const int col = 2048 + h * 128 + ch;
            const float w0 = p.m_conv_w[0 * 512 + h * 128 + ch], w1 = p.m_conv_w[1 * 512 + h * 128 + ch], w2 = p.m_conv_w[2 * 512 + h * 128 + ch],
                        w3 = p.m_conv_w[3 * 512 + h * 128 + ch], bb = p.m_conv_b[h * 128 + ch];
            float xm3 = 0.f, xm2 = 0.f, xm1 = 0.f;
            if (s0 + r0 > 0) {
                xm3 = bf2f(p.proj[(size_t)(t0 + r0 - 3) * NPJ + col]);
                xm2 = bf2f(p.proj[(size_t)(t0 + r0 - 2) * NPJ + col]);
                xm1 = bf2f(p.proj[(size_t)(t0 + r0 - 1) * NPJ + col]);
            }
            for (int r = r0; r < r0 + 32; ++r) {
                const float xc = bf2f(p.proj[(size_t)(t0 + r) * NPJ + col]);
                const float y = bb + w0 * xm3 + w1 * xm2 + w2 * xm1 + w3 * xc;
                const float c = y * sigmoidf_(y);
                const bf16_t cb = f2bf(c);
                *(bf16_t*)(cs + r * 272 + ch * 2) = cb;
                p.cbuf[(size_t)(t0 + r) * 512 + h * 128 + ch] = cb;
                xm3 = xm2; xm2 = xm1; xm1 = xc;
            }
        }
#pragma unroll
        for (int which = 0; which < 2; ++which) {
            const bf16_t* W = (which ? p.Wkt : p.Wqt) + h * 16384;
            bf16_t* O = which ? p.mk : p.mq;
#pragma unroll
            for (int i = 0; i < 4; ++i) {
                const int id = tid + 512 * i, r = id >> 4, c = id & 15;
                *(uint4*)(ws + r * 272 + c * 16) = *(const uint4*)(W + r * 128 + c * 8);
            }
            __syncthreads();
            f32x4 acc[2][4];
#pragma unroll
            for (int i = 0; i < 2; ++i)
#pragma unroll
                for (int j = 0; j < 4; ++j) acc[i][j] = (f32x4){0.f, 0.f, 0.f, 0.f};
#pragma unroll
            for (int ks = 0; ks < 4; ++ks) {
                bf16x8 a[2], b[4];
#pragma unroll
                for (int i = 0; i < 2; ++i) a[i] = ld8(cs + (wr * 32 + i * 16 + fr) * 272 + (ks * 4 + fq) * 16);
#pragma unroll
                for (int j = 0; j < 4; ++j) b[j] = ld8(ws + (wc * 64 + j * 16 + fr) * 272 + (ks * 4 + fq) * 16);
#pragma unroll
                for (int i = 0; i < 2; ++i)
#pragma unroll
                    for (int j = 0; j < 4; ++j) acc[i][j] = mfma16(b[j], a[i], acc[i][j]);
            }
#pragma unroll
            for (int i = 0; i < 2; ++i)
#pragma unroll
                for (int j = 0; j < 4; ++j) {
                    const int m = t0 + wr * 32 + i * 16 + fr, n = h * 128 + wc * 64 + j * 16 + 4 * fq;
                    const f32x4 v = acc[i][j];
                    *(uint2*)(O + (size_t)m * 512 + n) = make_uint2(pk2(v[0], v[1]), pk2(v[2], v[3]));
                }
            __syncthreads();
        }
    }
}

DEVI bf16x8 u4_to_frag(uint4 u) { union { uint4 u; bf16x8 v; } x; x.u = u; return x.v; }
DEVI void sel_frags(bf16x8 (&sel)[2], int fr, int fq) {
#pragma unroll
    for (int hh = 0; hh < 2; ++hh) {
        const int jstar = fr + 16 * hh - 8 * fq;
        bf16x8 s;
#pragma unroll
        for (int j = 0; j < 8; ++j) s[j] = (j == jstar) ? (short)0x3F80 : (short)0;
        sel[hh] = s;
    }
}
DEVI void tr_store(char* XT, bf16x8 frag, const bf16x8 (&sel)[2], int mi, int ks, int fr, int fq, const float (&sc)[4]) {
#pragma unroll
    for (int hh = 0; hh < 2; ++hh) {
        const f32x4 d = mfma16(frag, sel[hh], (f32x4){0.f, 0.f, 0.f, 0.f});
        *(uint2*)(XT + (32 * ks + 16 * hh + fr) * 144 + (16 * mi + 4 * fq) * 2) = make_uint2(pk2(d[0] * sc[0], d[1] * sc[1]), pk2(d[2] * sc[2], d[3] * sc[3]));
    }
}
DEVI bf16x8 state_pack(const f32x4& a, const f32x4& b) {
    return mk8(make_uint2(pk2(a[0], a[1]), pk2(a[2], a[3])), make_uint2(pk2(b[0], b[1]), pk2(b[2], b[3])));
}
DEVI const float* opaque_ptr(const float* q) { asm volatile("" : "+v"(q)); return q; }
DEVI float opaque_f(float v) { asm volatile("" : "+v"(v)); return v; }
DEVI void lds_barrier() { asm volatile("s_waitcnt lgkmcnt(0)" ::: "memory"); __builtin_amdgcn_s_barrier(); asm volatile("" ::: "memory"); }
DEVI void pin_u4(uint4& a) { asm volatile("" : "+v"(a.x), "+v"(a.y), "+v"(a.z), "+v"(a.w)); }
DEVI float grp8_sum(float v) { v += __shfl_xor(v, 1); v += __shfl_xor(v, 2); v += __shfl_xor(v, 4); return v; }

struct RetPre { uint4 f[4]; uint4 v[2]; uint4 g[2]; };
struct RetOff { unsigned f, v0, v1, g; };
DEVI void ret_offsets(RetOff& o, int h, int tid) {
    const int lane = tid & 63, w = tid >> 6, fr = lane & 15, fq = lane >> 4, mi = w & 3;
    o.f = (unsigned)(((16 * mi + fr) * NPJ + (w < 4 ? 512 : 0) + h * 128 + 8 * fq) * 2);
    o.v0 = (unsigned)(((16 * ((2 * w) >> 2) + fr) * NPJ + 1024 + h * 128 + 32 * ((2 * w) & 3) + 8 * fq) * 2);
    o.v1 = (unsigned)(((16 * ((2 * w + 1) >> 2) + fr) * NPJ + 1024 + h * 128 + 32 * ((2 * w + 1) & 3) + 8 * fq) * 2);
    o.g = (unsigned)(((tid >> 3) * NPJ + 1536 + h * 128 + 16 * (tid & 7)) * 2);
}
DEVI void ret_prefetch(const Params& p, RetPre& P, const RetOff& o, int b, int c) {
    const char* base = (const char*)p.proj + (size_t)(b * 2048 + c * 64) * (NPJ * 2);
#pragma unroll
    for (int ks = 0; ks < 4; ++ks) P.f[ks] = *(const uint4*)(base + o.f + 64 * ks);
    P.v[0] = *(const uint4*)(base + o.v0);
    P.v[1] = *(const uint4*)(base + o.v1);
    P.g[0] = *(const uint4*)(base + o.g);
    P.g[1] = *(const uint4*)(base + o.g + 16);
}
DEVI void ret_block(const Params& p, char* smem, int b, int h) {
    char* qs = smem;
    char* ks_ = smem + 17408;
    char* kTs = smem + 34816;
    char* vTs = smem + 53248;
    char* Ss = smem + 71680;
    char* Os = smem + 80896;
    float* gn_s = (float*)(smem + 98304);
    const int tid = stid(), lane = tid & 63, w = tid >> 6, fr = lane & 15, fq = lane >> 4;
    const float gamma = 1.f - exp2f(-5.f - (float)h);
    const float l2g = log2f(gamma);
    const float g64 = exp2f(l2g * 64.f);
    bf16x8 sel[2];
    sel_frags(sel, fr, fq);
    f32x4 st[8];
#pragma unroll
    for (int i = 0; i < 8; ++i) st[i] = (f32x4){0.f, 0.f, 0.f, 0.f};
    if (tid < 128) gn_s[tid] = p.ret_norm_g[h * 128 + tid];
    __syncthreads();
    RetPre P;
    RetOff RO;
    ret_offsets(RO, h, tid);
    ret_prefetch(p, P, RO, b, 0);
#pragma unroll 1
    for (int c = 0; c < 32; ++c) {
        const int t0 = b * 2048 + c * 64;
        {
            const int mi = w & 3;
            char* dst = (w < 4 ? ks_ : qs) + (16 * mi + fr) * 272 + fq * 16;
#pragma unroll
            for (int ks = 0; ks < 4; ++ks) *(uint4*)(dst + ks * 64) = P.f[ks];
            if (w < 4) {
                float kd[4];
#pragma unroll
                for (int r = 0; r < 4; ++r) kd[r] = exp2f(l2g * (float)(63 - (16 * mi + 4 * fq + r)));
#pragma unroll
                for (int ks = 0; ks < 4; ++ks) tr_store(kTs, u4_to_frag(P.f[ks]), sel, mi, ks, fr, fq, kd);
            }
            const float one[4] = {1.f, 1.f, 1.f, 1.f};
#pragma unroll
            for (int q = 0; q < 2; ++q) { const int pr = 2 * w + q; tr_store(vTs, u4_to_frag(P.v[q]), sel, pr >> 2, pr & 3, fr, fq, one); }
        }
        uint4 g0 = P.g[0], g1 = P.g[1];
        lds_barrier();
        ret_prefetch(p, P, RO, b, c + 1 < 32 ? c + 1 : 31);
        {
            const int lt = w & 3;
            bf16x8 qf[4];
#pragma unroll
            for (int s = 0; s < 4; ++s) qf[s] = ld8(qs + (16 * lt + fr) * 272 + (s * 4 + fq) * 16);
#pragma unroll
            for (int jj = 0; jj < 2; ++jj) {
                const int j = 2 * (w >> 2) + jj;
                f32x4 a = (f32x4){0.f, 0.f, 0.f, 0.f};
#pragma unroll
                for (int s = 0; s < 4; ++s) a = mfma16(ld8(ks_ + (16 * j + fr) * 272 + (s * 4 + fq) * 16), qf[s], a);
                const int l = 16 * lt + fr, mb = 16 * j + 4 * fq;
                float v[4];
#pragma unroll
                for (int r = 0; r < 4; ++r) { const int dd = l - (mb + r); v[r] = a[r] * exp2f(l2g * (float)(dd < 0 ? -dd : dd)); }
                *(uint2*)(Ss + l * 144 + mb * 2) = make_uint2(pk2(v[0], v[1]), pk2(v[2], v[3]));
            }
        }
        lds_barrier();
        {
            bf16x8 sp[4];
#pragma unroll
            for (int s = 0; s < 4; ++s) sp[s] = state_pack(st[2 * s], st[2 * s + 1]);
            bf16x8 vf[2];
#pragma unroll
            for (int s2 = 0; s2 < 2; ++s2) vf[s2] = ld8(vTs + (16 * w + fr) * 144 + (s2 * 4 + fq) * 16);
#pragma unroll
            for (int i = 0; i < 4; ++i) {
                f32x4 a = (f32x4){0.f, 0.f, 0.f, 0.f};
                const char* qrow = qs + (16 * i + fr) * 272;
#pragma unroll
                for (int s = 0; s < 4; ++s) {
                    const uint2 lo = *(const uint2*)(qrow + (32 * s + 4 * fq) * 2), hi = *(const uint2*)(qrow + (32 * s + 16 + 4 * fq) * 2);
                    a = mfma16(sp[s], mk8(lo, hi), a);
                }
                a = a * exp2f(l2g * (float)(16 * i + fr + 1));
#pragma unroll
                for (int s2 = 0; s2 < 2; ++s2) a = mfma16(vf[s2], ld8(Ss + (16 * i + fr) * 144 + (s2 * 4 + fq) * 16), a);
                *(uint2*)(Os + (16 * i + fr) * 272 + (16 * w + 4 * fq) * 2) = make_uint2(pk2(a[0], a[1]), pk2(a[2], a[3]));
            }
#pragma unroll
            for (int i = 0; i < 8; ++i) {
                f32x4 a = st[i] * g64;
#pragma unroll
                for (int s2 = 0; s2 < 2; ++s2) a = mfma16(ld8(kTs + (16 * i + fr) * 144 + (s2 * 4 + fq) * 16), vf[s2], a);
                st[i] = a;
            }
        }
        lds_barrier();
        pin_u4(g0); pin_u4(g1);
        {
            const int l = tid >> 3, part = tid & 7;
            const uint4 o0 = *(const uint4*)(Os + l * 272 + part * 32), o1 = *(const uint4*)(Os + l * 272 + part * 32 + 16);
            const unsigned ow[8] = {o0.x, o0.y, o0.z, o0.w, o1.x, o1.y, o1.z, o1.w}, gw[8] = {g0.x, g0.y, g0.z, g0.w, g1.x, g1.y, g1.z, g1.w};
            float x[16], s = 0.f;
#pragma unroll
            for (int e = 0; e < 8; ++e) { x[2 * e] = bflo(ow[e]); x[2 * e + 1] = bfhi(ow[e]); s += x[2 * e] + x[2 * e + 1]; }
            const float mu = grp8_sum(s) * (1.f / 128.f);
            float q = 0.f;
#pragma unroll
            for (int e = 0; e < 16; ++e) { x[e] -= mu; q += x[e] * x[e]; }
            const float rstd = rsqrtf(grp8_sum(q) * (1.f / 128.f) + EPSN);
            const float* gn = gn_s + 16 * part;
            unsigned yo[8];
#pragma unroll
            for (int e = 0; e < 8; ++e) {
                const float ga = bflo(gw[e]), gb = bfhi(gw[e]);
                yo[e] = pk2(ga * sigmoidf_(ga) * x[2 * e] * rstd * gn[2 * e], gb * sigmoidf_(gb) * x[2 * e + 1] * rstd * gn[2 * e + 1]);
            }
            uint4* yp = (uint4*)(p.yb + (size_t)(t0 + l) * 1024 + h * 128 + 16 * part);
            yp[0] = make_uint4(yo[0], yo[1], yo[2], yo[3]);
            yp[1] = make_uint4(yo[4], yo[5], yo[6], yo[7]);
        }
    }
}

struct MlPre { uint4 f[4]; uint4 v[2]; uint4 o[2]; uint4 cc[2]; float iv, fv; };
struct MlOff { unsigned f, v0, v1, o, c, g; };
DEVI void ml_offsets(const Params& p, MlOff& o, int h, int tid) {
    const int lane = tid & 63, w = tid >> 6, fr = lane & 15, fq = lane >> 4, mi = w & 3;
    const unsigned kdiff = (unsigned)((const char*)p.mk - (const char*)p.mq);
    o.f = (unsigned)(((16 * mi + fr) * 512 + h * 128 + 8 * fq) * 2) + (w < 4 ? kdiff : 0u);
    o.v0 = (unsigned)(((16 * ((2 * w) >> 2) + fr) * NPJ + 2560 + h * 128 + 32 * ((2 * w) & 3) + 8 * fq) * 2);
    o.v1 = (unsigned)(((16 * ((2 * w + 1) >> 2) + fr) * NPJ + 2560 + h * 128 + 32 * ((2 * w + 1) & 3) + 8 * fq) * 2);
    o.o = (unsigned)(((tid >> 3) * NPJ + 3072 + h * 128 + 16 * (tid & 7)) * 2);
    o.c = (unsigned)(((tid >> 3) * 512 + h * 128 + 16 * (tid & 7)) * 2);
    o.g = (unsigned)((lane * 4 + h) * 4);
}
DEVI void ml_prefetch(const Params& p, MlPre& P, const MlOff& o, int b, int c) {
    const size_t t0 = (size_t)(b * 2048 + c * 64);
    const char* bq = (const char*)p.mq + t0 * 1024, *bp = (const char*)p.proj + t0 * (NPJ * 2), *bc = (const char*)p.cbuf + t0 * 1024;
    const char* bi = (const char*)p.ipre + t0 * 16, *bf = (const char*)p.logf + t0 * 16;
#pragma unroll
    for (int ks = 0; ks < 4; ++ks) P.f[ks] = *(const uint4*)(bq + o.f + 64 * ks);
    P.v[0] = *(const uint4*)(bp + o.v0);
    P.v[1] = *(const uint4*)(bp + o.v1);
    P.o[0] = *(const uint4*)(bp + o.o);
    P.o[1] = *(const uint4*)(bp + o.o + 16);
    P.cc[0] = *(const uint4*)(bc + o.c);
    P.cc[1] = *(const uint4*)(bc + o.c + 16);
    P.iv = *(const float*)(bi + o.g);
    P.fv = *(const float*)(bf + o.g);
}
DEVI void mlstm_block(const Params& p, char* smem, int b, int h) {
    char* qs = smem;
    char* kTs = smem + 17408;
    char* vTs = smem + 35840;
    char* Os = smem + 54272;
    float* n_s = (float*)(smem + 71680);
    float* den_s = (float*)(smem + 72192);
    float* gn_s = (float*)(smem + 72448);
    float* sk_s = gn_s + 128;
    const int tid = stid(), lane = tid & 63, w = tid >> 6, fr = lane & 15, fq = lane >> 4;
    bf16x8 sel[2];
    sel_frags(sel, fr, fq);
    f32x4 st[8];
#pragma unroll
    for (int i = 0; i < 8; ++i) st[i] = (f32x4){0.f, 0.f, 0.f, 0.f};
    float m_run = 0.f, n_reg = 0.f;
    if (tid < 128) { gn_s[tid] = p.m_norm_g[h * 128 + tid]; sk_s[tid] = p.m_skip[h * 128 + tid]; }
    __syncthreads();
    MlPre P;
    MlOff MO;
    ml_offsets(p, MO, h, tid);
    ml_prefetch(p, P, MO, b, 0);
#pragma unroll 1
    for (int c = 0; c < 32; ++c) {
        const int t0 = b * 2048 + c * 64;
        float fcum = P.fv;
#pragma unroll
        for (int o = 1; o < 64; o <<= 1) { const float tv = __shfl_up(fcum, o); if (lane >= o) fcum += tv; }
        const float a_c = __shfl(fcum, 63);
        const float logw = a_c - fcum + P.iv;
        const float m_in = wave_max(logw);
        const float m_new = fmaxf(a_c + m_run, m_in);
        const float decay = __expf(a_c + m_run - m_new);
        const float wgt = __expf(logw - m_new);
        const float emn = __expf(-m_new);
        m_run = m_new;
        {
            const int mi = w & 3;
            if (w < 4) {
                float kw[4];
#pragma unroll
                for (int r = 0; r < 4; ++r) kw[r] = __shfl(wgt, 16 * mi + 4 * fq + r);
#pragma unroll
                for (int ks = 0; ks < 4; ++ks) tr_store(kTs, u4_to_frag(P.f[ks]), sel, mi, ks, fr, fq, kw);
            } else {
                char* dst = qs + (16 * mi + fr) * 272 + fq * 16;
#pragma unroll
                for (int ks = 0; ks < 4; ++ks) *(uint4*)(dst + ks * 64) = P.f[ks];
            }
            const float one[4] = {1.f, 1.f, 1.f, 1.f};
#pragma unroll
            for (int q = 0; q < 2; ++q) { const int pr = 2 * w + q; tr_store(vTs, u4_to_frag(P.v[q]), sel, pr >> 2, pr & 3, fr, fq, one); }
        }
        uint4 mo0 = P.o[0], mo1 = P.o[1], cc0 = P.cc[0], cc1 = P.cc[1];
        lds_barrier();
        ml_prefetch(p, P, MO, b, c + 1 < 32 ? c + 1 : 31);
        if (tid < 128) {
            float s = 0.f;
#pragma unroll
            for (int q = 0; q < 8; ++q) {
                const uint4 a = *(const uint4*)(kTs + tid * 144 + q * 16);
                s += (bflo(a.x) + bfhi(a.x)) + (bflo(a.y) + bfhi(a.y)) + (bflo(a.z) + bfhi(a.z)) + (bflo(a.w) + bfhi(a.w));
            }
            n_reg = decay * n_reg + s;
            n_s[tid] = n_reg;
        }
        {
            bf16x8 vf[2];
#pragma unroll
            for (int s2 = 0; s2 < 2; ++s2) vf[s2] = ld8(vTs + (16 * w + fr) * 144 + (s2 * 4 + fq) * 16);
#pragma unroll
            for (int i = 0; i < 8; ++i) {
                f32x4 a = st[i] * decay;
#pragma unroll
                for (int s2 = 0; s2 < 2; ++s2) a = mfma16(ld8(kTs + (16 * i + fr) * 144 + (s2 * 4 + fq) * 16), vf[s2], a);
                st[i] = a;
            }
        }
        lds_barrier();
        {
            const int l = tid >> 3, part = tid & 7;
            const uint4 a0 = *(const uint4*)(qs + l * 272 + part * 32), a1 = *(const uint4*)(qs + l * 272 + part * 32 + 16);
            const unsigned aw[8] = {a0.x, a0.y, a0.z, a0.w, a1.x, a1.y, a1.z, a1.w};
            const float* nn = n_s + 16 * part;
            float s = 0.f;
#pragma unroll
            for (int e = 0; e < 8; ++e) s += bflo(aw[e]) * nn[2 * e] + bfhi(aw[e]) * nn[2 * e + 1];
            s = grp8_sum(s);
            if (part == 0) den_s[l] = fmaxf(fabsf(s), emn);
        }
        lds_barrier();
        {
            bf16x8 sp[4];
#pragma unroll
            for (int s = 0; s < 4; ++s) sp[s] = state_pack(st[2 * s], st[2 * s + 1]);
#pragma unroll
            for (int i = 0; i < 4; ++i) {
                f32x4 a = (f32x4){0.f, 0.f, 0.f, 0.f};
                const char* qrow = qs + (16 * i + fr) * 272;
#pragma unroll
                for (int s = 0; s < 4; ++s) {
                    const uint2 lo = *(const uint2*)(qrow + (32 * s + 4 * fq) * 2), hi = *(const uint2*)(qrow + (32 * s + 16 + 4 * fq) * 2);
                    a = mfma16(sp[s], mk8(lo, hi), a);
                }
                const float rd = 1.f / den_s[16 * i + fr];
                *(uint2*)(Os + (16 * i + fr) * 272 + (16 * w + 4 * fq) * 2) = make_uint2(pk2(a[0] * rd, a[1] * rd), pk2(a[2] * rd, a[3] * rd));
            }
        }
        lds_barrier();
        pin_u4(mo0); pin_u4(mo1); pin_u4(cc0); pin_u4(cc1);
        {
            const int l = tid >> 3, part = tid & 7;
            const uint4 o0 = *(const uint4*)(Os + l * 272 + part * 32), o1 = *(const uint4*)(Os + l * 272 + part * 32 + 16);
            const unsigned ow[8] = {o0.x, o0.y, o0.z, o0.w, o1.x, o1.y, o1.z, o1.w};
            const unsigned gw[8] = {mo0.x, mo0.y, mo0.z, mo0.w, mo1.x, mo1.y, mo1.z, mo1.w}, cw[8] = {cc0.x, cc0.y, cc0.z, cc0.w, cc1.x, cc1.y, cc1.z, cc1.w};
            float x[16], s = 0.f;
#pragma unroll
            for (int e = 0; e < 8; ++e) { x[2 * e] = bflo(ow[e]); x[2 * e + 1] = bfhi(ow[e]); s += x[2 * e] + x[2 * e + 1]; }
            const float mu = grp8_sum(s) * (1.f / 128.f);
            float q = 0.f;
#pragma unroll
            for (int e = 0; e < 16; ++e) { x[e] -= mu; q += x[e] * x[e]; }
            const float rstd = rsqrtf(grp8_sum(q) * (1.f / 128.f) + EPSN);
            const float* gn = gn_s + 16 * part;
            const float* sk = sk_s + 16 * part;
            unsigned yo[8];
#pragma unroll
            for (int e = 0; e < 8; ++e) {
                const float ya = sigmoidf_(bflo(gw[e])) * (x[2 * e] * rstd * gn[2 * e] + sk[2 * e] * bflo(cw[e]));
                const float yb_ = sigmoidf_(bfhi(gw[e])) * (x[2 * e + 1] * rstd * gn[2 * e + 1] + sk[2 * e + 1] * bfhi(cw[e]));
                yo[e] = pk2(ya, yb_);
            }
            uint4* yp = (uint4*)(p.yb + (size_t)(t0 + l) * 1024 + 512 + h * 128 + 16 * part);
            yp[0] = make_uint4(yo[0], yo[1], yo[2], yo[3]);
            yp[1] = make_uint4(yo[4], yo[5], yo[6], yo[7]);
        }
    }
}
DEVI void st_recur(const Params& p, char* smem) {
    if (blockIdx.x >= 128 || gridDim.x <= 128) {
        const int bid = gridDim.x > 128 ? (int)blockIdx.x - 128 : (int)blockIdx.x, nb = gridDim.x > 128 ? (int)gridDim.x - 128 : (int)gridDim.x;
        st_prep_w2(p, smem, bid, nb);
        st_prep_wsub(p, smem, bid, nb);
        st_prep_tables(p, bid, nb);
        if (gridDim.x > 128) return;
    }
    for (int bi = blockIdx.x; bi < 128; bi += gridDim.x) {
        const int kind = bi & 1, h = (bi >> 1) & 3, b = bi >> 3;
        if (kind == 0) ret_block(p, smem, b, h);
        else mlstm_block(p, smem, b, h);
        __syncthreads();
    }
}

DEVI void st_norm2(const Params& p) {
    const int lane = stid() & 63, wid = stid() >> 6;
    for (int t = blockIdx.x * NW + wid; t < T_TOK; t += gridDim.x * NW) {
        float xv[16];
        float ss = 0.f;
#pragma unroll
        for (int i = 0; i < 4; ++i) {
            const float4 a = *(const float4*)(p.out + (size_t)t * 1024 + lane * 16 + i * 4);
            xv[4 * i] = a.x; xv[4 * i + 1] = a.y; xv[4 * i + 2] = a.z; xv[4 * i + 3] = a.w;
            ss += a.x * a.x + a.y * a.y + a.z * a.z + a.w * a.w;
        }
        ss = wave_sum(ss);
        const float rs = rsqrtf(ss * (1.f / 1024.f) + EPSN);
        uint4* ob = (uint4*)(p.x1b + (size_t)t * 1024 + lane * 16);
        ob[0] = make_uint4(pk2(xv[0], xv[1]), pk2(xv[2], xv[3]), pk2(xv[4], xv[5]), pk2(xv[6], xv[7]));
        ob[1] = make_uint4(pk2(xv[8], xv[9]), pk2(xv[10], xv[11]), pk2(xv[12], xv[13]), pk2(xv[14], xv[15]));
        float am = 0.f;
#pragma unroll
        for (int i = 0; i < 4; ++i) {
            const float4 g = *(const float4*)(p.norm2_g + lane * 16 + i * 4);
            xv[4 * i] *= rs * g.x; xv[4 * i + 1] *= rs * g.y; xv[4 * i + 2] *= rs * g.z; xv[4 * i + 3] *= rs * g.w;
        }
#pragma unroll
        for (int c = 0; c < 16; ++c) am = fmaxf(am, fabsf(xv[c]));
        am = wave_max(am);
        const float inv = am > 0.f ? 127.f / am : 0.f;
        unsigned w[4];
#pragma unroll
        for (int i = 0; i < 4; ++i) {
            const int q0 = (int)rintf(xv[4 * i] * inv), q1 = (int)rintf(xv[4 * i + 1] * inv), q2 = (int)rintf(xv[4 * i + 2] * inv), q3 = (int)rintf(xv[4 * i + 3] * inv);
            w[i] = (unsigned)(q0 & 255) | ((unsigned)(q1 & 255) << 8) | ((unsigned)(q2 & 255) << 16) | ((unsigned)(q3 & 255) << 24);
        }
        *(uint4*)(p.xq + (size_t)t * 1024 + lane * 16) = make_uint4(w[0], w[1], w[2], w[3]);
        if (lane == 0) { p.rs2[t] = rs; p.xsc[t] = am > 0.f ? am * (1.f / 127.f) : 1.f; }
    }
}

DEVI int f2key(float f) { const int b = __float_as_int(f); return b ^ ((b >> 31) & 0x7fffffff); }
DEVI float key2f(int k) { return __int_as_float(k ^ ((k >> 31) & 0x7fffffff)); }
template <int N> DEVI void bsort_desc(int (&v)[N]) {
#pragma unroll
    for (int k = 2; k <= N; k <<= 1)
#pragma unroll
        for (int j = k >> 1; j > 0; j >>= 1)
#pragma unroll
            for (int i = 0; i < N; ++i) {
                const int l = i ^ j;
                if (l > i) {
                    const int a = v[i], b = v[l];
                    const int mx = a > b ? a : b, mn = a > b ? b : a;
                    if ((i & k) == 0) { v[i] = mx; v[l] = mn; } else { v[i] = mn; v[l] = mx; }
                }
            }
}
template <int N> DEVI void bmerge_desc(int (&v)[N]) {
#pragma unroll
    for (int j = N >> 1; j > 0; j >>= 1)
#pragma unroll
        for (int i = 0; i < N; ++i) {
            const int l = i ^ j;
            if (l > i) { const int a = v[i], b = v[l]; v[i] = a > b ? a : b; v[l] = a > b ? b : a; }
        }
}
DEVI void xmerge16(int (&v)[16], int mask) {
    int o[16];
#pragma unroll
    for (int i = 0; i < 16; ++i) o[i] = __shfl_xor(v[15 - i], mask);
#pragma unroll
    for (int i = 0; i < 16; ++i) v[i] = v[i] > o[i] ? v[i] : o[i];
    bmerge_desc<16>(v);
}
__device__ const unsigned char cand_tab[52] = {
    0x00, 0x01, 0x02, 0x03, 0x04, 0x05, 0x06, 0x07, 0x08, 0x09, 0x0a, 0x0b, 0x0c, 0x0d, 0x0e, 0x0f,
    0x10, 0x11, 0x12, 0x13, 0x14, 0x15, 0x16, 0x17, 0x20, 0x21, 0x22, 0x23, 0x24, 0x30, 0x31, 0x32, 0x33,
    0x40, 0x41, 0x42, 0x50, 0x51, 0x60, 0x61, 0x70, 0x71, 0x80, 0x90, 0xa0, 0xb0, 0xc0, 0xd0, 0xe0, 0xf0, 0xff, 0xff};
constexpr int H_A = 256 * 64, H_B = 256 * 64, H_STAGE = H_A + H_B;
constexpr int H_LIST = 3 * H_STAGE;
DEVI void glds16(const void* g, char* l) {
    __builtin_amdgcn_global_load_lds((const __attribute__((address_space(1))) unsigned*)g, (__attribute__((address_space(3))) unsigned*)l, 16, 0, 0);
}
DEVI void gemm3_topk_tile(const Params& p, int m0, int h, char* smem) {
    const int tid = stid(), lane = tid & 63, w = tid >> 6, wt = w >> 1, wp = w & 1, fr = lane & 15, fq = lane >> 4;
    f32x4 acc[4][8];
#pragma unroll
    for (int i = 0; i < 4; ++i)
#pragma unroll
        for (int j = 0; j < 8; ++j) acc[i][j] = (f32x4){0.f, 0.f, 0.f, 0.f};
    const int r16 = lane >> 2, csrc = (lane & 3) ^ ((r16 >> 2) & 3);
    const bf16_t* srcA = p.x1b + (size_t)(m0 + w * 32 + r16) * 1024 + csrc * 8;
    const bf16_t* srcB = p.Wsubt + ((size_t)h * 256 + w * 32 + r16) * 1024 + csrc * 8;
    char* dstA = smem + (w * 32) * 64 + lane * 16;
    char* dstB = smem + H_A + (w * 32) * 64 + lane * 16;
    auto issue = [&](int kt, int buf) {
#pragma unroll
        for (int q = 0; q < 2; ++q) glds16(srcA + (size_t)q * 16 * 1024 + kt * 32, dstA + buf * H_STAGE + q * 1024);
#pragma unroll
        for (int q = 0; q < 2; ++q) glds16(srcB + (size_t)q * 16 * 1024 + kt * 32, dstB + buf * H_STAGE + q * 1024);
    };
    const int rdoff = fr * 64 + ((fq ^ ((fr >> 2) & 3)) * 16);
    issue(0, 0);
    issue(1, 1);
    asm volatile("s_waitcnt vmcnt(4)" ::: "memory");
    __builtin_amdgcn_s_barrier();
    int buf = 0;
#pragma unroll 1
    for (int kt = 0; kt < 32; ++kt) {
        const int b2 = buf >= 1 ? buf - 1 : 2;
        if (kt + 2 < 32) issue(kt + 2, b2);
        const char* As = smem + buf * H_STAGE + (wt * 64) * 64 + rdoff;
        const char* Bs = smem + buf * H_STAGE + H_A + (wp * 128) * 64 + rdoff;
        bf16x8 a[4];
#pragma unroll
        for (int i = 0; i < 4; ++i) a[i] = ld8(As + (16 * i) * 64);
#pragma unroll
        for (int jg = 0; jg < 2; ++jg) {
            bf16x8 b[4];
#pragma unroll
            for (int j = 0; j < 4; ++j) b[j] = ld8(Bs + (16 * (4 * jg + j)) * 64);
#pragma unroll
            for (int i = 0; i < 4; ++i)
#pragma unroll
                for (int j = 0; j < 4; ++j) acc[i][4 * jg + j] = mfma16(b[j], a[i], acc[i][4 * jg + j]);
        }
        if (kt + 2 < 32) asm volatile("s_waitcnt vmcnt(4)" ::: "memory");
        else asm volatile("s_waitcnt vmcnt(0)" ::: "memory");
        __builtin_amdgcn_s_barrier();
        buf = buf == 2 ? 0 : buf + 1;
    }
    int* LX = (int*)(smem + H_LIST);
#pragma unroll
    for (int i = 0; i < 4; ++i) {
        const int tl = 64 * wt + 16 * i + fr;
        const float rs = p.rs2[m0 + tl];
        int ka[16], kb[16];
#pragma unroll
        for (int jj = 0; jj < 4; ++jj)
#pragma unroll
            for (int r = 0; r < 4; ++r) {
                ka[jj * 4 + r] = (f2key(acc[i][jj][r] * rs) & ~127) | (16 * jj + 4 * fq + r);
                kb[jj * 4 + r] = (f2key(acc[i][4 + jj][r] * rs) & ~127) | (16 * (jj + 4) + 4 * fq + r);
            }
        bsort_desc<16>(ka);
        bsort_desc<16>(kb);
#pragma unroll
        for (int q = 0; q < 16; ++q) ka[q] = ka[q] > kb[15 - q] ? ka[q] : kb[15 - q];
        bmerge_desc<16>(ka);
        xmerge16(ka, 16);
        xmerge16(ka, 32);
        const int k0 = fq == 0 ? ka[0] : fq == 1 ? ka[4] : fq == 2 ? ka[8] : ka[12];
        const int k1 = fq == 0 ? ka[1] : fq == 1 ? ka[5] : fq == 2 ? ka[9] : ka[13];
        const int k2 = fq == 0 ? ka[2] : fq == 1 ? ka[6] : fq == 2 ? ka[10] : ka[14];
        const int k3 = fq == 0 ? ka[3] : fq == 1 ? ka[7] : fq == 2 ? ka[11] : ka[15];
        *(int4*)(LX + tl * 32 + wp * 16 + 4 * fq) = make_int4(k0, k1, k2, k3);
    }
    __syncthreads();
#pragma unroll
    for (int i2 = 0; i2 < 2; ++i2) {
        const int tl = 32 * w + 16 * i2 + fr, t = m0 + tl;
        const int* L = LX + tl * 32;
        const unsigned long long clo = fq == 0 ? 0x0706050403020100ull : fq == 1 ? 0x14131211100f0e0dull : fq == 2 ? 0x4033323130242322ull : 0xc0b0a09080717061ull;
        const unsigned long long chi = fq == 0 ? 0x0c0b0a0908ull : fq == 1 ? 0x2120171615ull : fq == 2 ? 0x6051504241ull : 0xfffff0e0d0ull;
        int c[16];
#pragma unroll
        for (int s = 0; s < 13; ++s) {
            const int ab = (int)((s < 8 ? (clo >> (8 * s)) : (chi >> (8 * (s - 8)))) & 0xffull);
            const int k1 = L[ab >> 4], k2 = L[16 + (ab & 15)];
            const float v = key2f(k1 & ~127) + key2f(k2 & ~127);
            c[s] = (f2key(v) & ~0x3fff) | ((k1 & 127) << 7) | (k2 & 127);
        }
        c[13] = c[14] = c[15] = (int)0x80000000;
        bsort_desc<16>(c);
        xmerge16(c, 16);
        xmerge16(c, 32);
        const float vmax = key2f(c[0] & ~0x3fff);
        float e[16], sum = 0.f;
#pragma unroll
        for (int q = 0; q < 16; ++q) { e[q] = __expf(key2f(c[q] & ~0x3fff) - vmax); sum += e[q]; }
        const float inv = 1.f / sum;
        int ce[4]; float ge[4];
#pragma unroll
        for (int q = 0; q < 4; ++q) {
            const int cq = fq == 0 ? c[q] : fq == 1 ? c[4 + q] : fq == 2 ? c[8 + q] : c[12 + q];
            const float eq = fq == 0 ? e[q] : fq == 1 ? e[4 + q] : fq == 2 ? e[8 + q] : e[12 + q];
            ce[q] = ((cq >> 7) & 127) * 128 + (cq & 127);
            ge[q] = eq * inv;
        }
        *(uint2*)(p.eperm + (size_t)t * 128 + h * 16 + 4 * fq) = make_uint2((unsigned)ce[0] | ((unsigned)ce[1] << 16), (unsigned)ce[2] | ((unsigned)ce[3] << 16));
        *(float4*)(p.gate + (size_t)t * 128 + h * 16 + 4 * fq) = make_float4(ge[0], ge[1], ge[2], ge[3]);
    }
    __syncthreads();
}
DEVI void st_gemm3_topk(const Params& p, char* smem) {
    for (int it = blockIdx.x; it < 128 * 8; it += gridDim.x) gemm3_topk_tile(p, (it >> 3) * 256, it & 7, smem);
}

#define XB_TMO      128
#define XB_XCNT(j)  (256  + 64 * (j))
#define XB_XSUB(j)  (1280 + 64 * (j))
#define XB_XGEN(j)  (2304 + 64 * (j))
#define XB_TOP      3328
#define XB_TOPGEN   3392
#define XCD_BAR_WORDS 3456
#define XB_SPIN_CAP (1u << 20)
#define LAS __attribute__((address_space(3)))
DEVI unsigned xb_ld(unsigned* p) { return __hip_atomic_load(p, __ATOMIC_RELAXED, __HIP_MEMORY_SCOPE_AGENT); }
DEVI unsigned xb_add(unsigned* p, unsigned v) { return __hip_atomic_fetch_add(p, v, __ATOMIC_RELAXED, __HIP_MEMORY_SCOPE_AGENT); }
DEVI unsigned xb_xcc_id() { return (unsigned)__builtin_amdgcn_s_getreg((3 << 11) | 20) & 0xFu; }
#define XB_SPIN(cond, bar) do { unsigned _sp = 0; while (cond) { __builtin_amdgcn_s_sleep(1); \
    if ((++_sp & 255u) == 0u) { if (xb_ld(&(bar)[XB_TMO])) break; if (_sp > XB_SPIN_CAP) { atomicAdd(&(bar)[XB_TMO], 1u); break; } } } } while (0)
struct XcdBarrier { unsigned* bar; unsigned x; volatile LAS unsigned* st; };
DEVI XcdBarrier xcd_barrier_post(unsigned* bar, volatile LAS unsigned* st) {
    XcdBarrier b; b.bar = bar; b.x = xb_xcc_id(); b.st = st;
    if (stid() == 0) (void)xb_add(&bar[XB_XCNT(b.x)], 1u);
    return b;
}
DEVI void xcd_barrier_complete(unsigned* bar, unsigned x, unsigned& nloc, unsigned& nx) {
    const unsigned G = gridDim.x * gridDim.y * gridDim.z;
    unsigned sum, cnt, mine, sp = 0u;
    for (;;) {
        sum = 0u; cnt = 0u; mine = 0u;
#pragma unroll
        for (unsigned j = 0; j < 16; ++j) { const unsigned c = xb_ld(&bar[XB_XCNT(j)]); sum += c; cnt += (c > 0u) ? 1u : 0u; mine = (j == x) ? c : mine; }
        if (sum == G) break;
        __builtin_amdgcn_s_sleep(1);
        if ((++sp & 255u) == 0u) { if (xb_ld(&bar[XB_TMO])) break; if (sp > XB_SPIN_CAP) { atomicAdd(&bar[XB_TMO], 1u); break; } }
    }
    nloc = mine > 0u ? mine : 1u; nx = cnt > 0u ? cnt : 1u;
}
DEVI void xcd_barrier(const XcdBarrier& b) {
    asm volatile("s_waitcnt vmcnt(0)" ::: "memory");
    __syncthreads();
    if (stid() == 0) {
        unsigned* bar = b.bar;
        __builtin_amdgcn_s_waitcnt(0);
        unsigned nloc = b.st[0], nx = b.st[1];
        if (nloc == 0u) { xcd_barrier_complete(bar, b.x, nloc, nx); b.st[0] = nloc; b.st[1] = nx; }
        const unsigned old = xb_add(&bar[XB_XSUB(b.x)], 1u);
        const unsigned gen = old / nloc;
        if (old + 1u == (gen + 1u) * nloc) {
            __builtin_amdgcn_fence(__ATOMIC_RELEASE, "agent");
            asm volatile("s_waitcnt vmcnt(0)" ::: "memory");
            const unsigned og = xb_add(&bar[XB_TOP], 1u);
            const unsigned tg = og / nx;
            if (og + 1u == (tg + 1u) * nx) xb_add(&bar[XB_TOPGEN], 1u);
            else XB_SPIN(xb_ld(&bar[XB_TOPGEN]) == tg, bar);
            __builtin_amdgcn_fence(__ATOMIC_ACQUIRE, "agent");
            xb_add(&bar[XB_XGEN(b.x)], 1u);
            asm volatile("s_waitcnt vmcnt(0)" ::: "memory");
        } else {
            XB_SPIN(xb_ld(&bar[XB_XGEN(b.x)]) == gen, bar);
            __builtin_amdgcn_fence(__ATOMIC_ACQUIRE, "agent");
            asm volatile("s_waitcnt vmcnt(0)" ::: "memory");
        }
    }
    __syncthreads();
}

#define CTR_A(x) (XCD_BAR_WORDS + 64 * (x))
#define CTR_B(x) (XCD_BAR_WORDS + 512 + 64 * (x))
#define CTL_WORDS (XCD_BAR_WORDS + 1024)
typedef float f32x2 __attribute__((ext_vector_type(2)));
DEVI float ub(unsigned w, int n) { return (float)((w >> (8 * n)) & 0xffu); }
DEVI float gelu_erf(float u) { return 0.5f * u * (1.f + erff(u * 0.70710678118654752f)); }
struct ExpMeta { uint4 e[2]; uint4 xa; float sc; };
struct ExpRows { uint4 r[16]; float2 x1; };

template <int PHASE> DEVI void exp_load_meta(const Params& p, ExpMeta& m, int t, int x, int lane) {
    const uint4* ep = (const uint4*)(p.eperm + (size_t)t * 128 + (lane >> 3) * 16);
    m.e[0] = ep[0];
    m.e[1] = ep[1];
    if (PHASE == 0) m.xa = *(const uint4*)(p.xq + (size_t)t * 1024 + 128 * x + 16 * (lane & 7));
    else { m.xa = *(const uint4*)(p.aq + (size_t)t * 128 + (lane >> 3) * 16); m.sc = p.asc[t]; }
}
template <int PHASE> DEVI void exp_issue(const Params& p, const ExpMeta& m, ExpRows& R, int t, int x, int lane) {
    const unsigned char* base = (PHASE == 0 ? p.down_q : p.up_q) + (size_t)x * (16384 * 128) + (lane & 7) * 16;
    const unsigned ew[8] = {m.e[0].x, m.e[0].y, m.e[0].z, m.e[0].w, m.e[1].x, m.e[1].y, m.e[1].z, m.e[1].w};
#pragma unroll
    for (int j = 0; j < 16; ++j) {
        const unsigned ek = (j & 1) ? (ew[j >> 1] >> 16) : (ew[j >> 1] & 0xffffu);
        R.r[j] = *(const uint4*)(base + (size_t)ek * 128);
    }
    if (PHASE == 1) {
        const int col = 128 * x + 16 * (lane & 7) + ((lane & 32) ? 8 : 0) + ((lane & 16) ? 4 : 0) + ((lane & 8) ? 2 : 0);
        R.x1 = *(const float2*)(p.out + (size_t)t * 1024 + col);
    }
}
DEVI void expA_compute(const Params& p, const ExpMeta& m, const ExpRows& R, int t, int x, int lane) {
    const bool b2 = lane & 4, b1 = lane & 2, b0 = lane & 1;
    int ps[16];
#pragma unroll
    for (int j = 0; j < 16; ++j)
        ps[j] = __builtin_amdgcn_sdot4((int)R.r[j].x, (int)m.xa.x, __builtin_amdgcn_sdot4((int)R.r[j].y, (int)m.xa.y,
                __builtin_amdgcn_sdot4((int)R.r[j].z, (int)m.xa.z, __builtin_amdgcn_sdot4((int)R.r[j].w, (int)m.xa.w, 0, false), false), false), false);
    int q8[8], q4[4], q2[2];
#pragma unroll
    for (int j = 0; j < 8; ++j) { const int snd = b2 ? ps[j] : ps[j + 8], kp = b2 ? ps[j + 8] : ps[j]; q8[j] = kp + __shfl_xor(snd, 4); }
#pragma unroll
    for (int j = 0; j < 4; ++j) { const int snd = b1 ? q8[j] : q8[j + 4], kp = b1 ? q8[j + 4] : q8[j]; q4[j] = kp + __shfl_xor(snd, 2); }
#pragma unroll
    for (int j = 0; j < 2; ++j) { const int snd = b0 ? q4[j] : q4[j + 2], kp = b0 ? q4[j + 2] : q4[j]; q2[j] = kp + __shfl_xor(snd, 1); }
    *(int2*)(p.part + ((size_t)x * T_TOK + t) * 128 + 2 * lane) = make_int2(q2[0], q2[1]);
}
DEVI void expB_compute(const Params& p, const ExpMeta& m, const ExpRows& R, int t, int x, int lane) {
    const bool b5 = lane & 32, b4 = lane & 16, b3 = lane & 8;
    const unsigned pa[4] = {m.xa.x, m.xa.y, m.xa.z, m.xa.w};
    int acc[16];
#pragma unroll
    for (int c = 0; c < 16; ++c) acc[c] = 0;
#pragma unroll
    for (int g = 0; g < 4; ++g) {
        const unsigned r0[4] = {R.r[4 * g].x, R.r[4 * g].y, R.r[4 * g].z, R.r[4 * g].w};
        const unsigned r1[4] = {R.r[4 * g + 1].x, R.r[4 * g + 1].y, R.r[4 * g + 1].z, R.r[4 * g + 1].w};
        const unsigned r2[4] = {R.r[4 * g + 2].x, R.r[4 * g + 2].y, R.r[4 * g + 2].z, R.r[4 * g + 2].w};
        const unsigned r3[4] = {R.r[4 * g + 3].x, R.r[4 * g + 3].y, R.r[4 * g + 3].z, R.r[4 * g + 3].w};
#pragma unroll
        for (int i = 0; i < 4; ++i) {
            const unsigned t0 = __builtin_amdgcn_perm(r1[i], r0[i], 0x05010400u), t1 = __builtin_amdgcn_perm(r1[i], r0[i], 0x07030602u);
            const unsigned t2 = __builtin_amdgcn_perm(r3[i], r2[i], 0x05010400u), t3 = __builtin_amdgcn_perm(r3[i], r2[i], 0x07030602u);
            const unsigned o0 = __builtin_amdgcn_perm(t2, t0, 0x05040100u), o1 = __builtin_amdgcn_perm(t2, t0, 0x07060302u);
            const unsigned o2 = __builtin_amdgcn_perm(t3, t1, 0x05040100u), o3 = __builtin_amdgcn_perm(t3, t1, 0x07060302u);
            acc[4 * i + 0] = __builtin_amdgcn_sdot4((int)o0, (int)pa[g], acc[4 * i + 0], false);
            acc[4 * i + 1] = __builtin_amdgcn_sdot4((int)o1, (int)pa[g], acc[4 * i + 1], false);
            acc[4 * i + 2] = __builtin_amdgcn_sdot4((int)o2, (int)pa[g], acc[4 * i + 2], false);
            acc[4 * i + 3] = __builtin_amdgcn_sdot4((int)o3, (int)pa[g], acc[4 * i + 3], false);
        }
    }
    int q8[8], q4[4], q2[2];
#pragma unroll
    for (int j = 0; j < 8; ++j) { const int snd = b5 ? acc[j] : acc[j + 8], kp = b5 ? acc[j + 8] : acc[j]; q8[j] = kp + __shfl_xor(snd, 32); }
#pragma unroll
    for (int j = 0; j < 4; ++j) { const int snd = b4 ? q8[j] : q8[j + 4], kp = b4 ? q8[j + 4] : q8[j]; q4[j] = kp + __shfl_xor(snd, 16); }
#pragma unroll
    for (int j = 0; j < 2; ++j) { const int snd = b3 ? q4[j] : q4[j + 2], kp = b3 ? q4[j + 2] : q4[j]; q2[j] = kp + __shfl_xor(snd, 8); }
    const int col = 128 * x + 16 * (lane & 7) + (b5 ? 8 : 0) + (b4 ? 4 : 0) + (b3 ? 2 : 0);
    *(float2*)((float*)p.proj + (size_t)t * 1024 + col) = make_float2(R.x1.x + (float)q2[0] * m.sc, R.x1.y + (float)q2[1] * m.sc);
}
template <int PHASE>
DEVI void exp_chunk(const Params& p, int tb, int x, int lane) {
    ExpMeta mA, mB, nA, nB;
    ExpRows rA, rB;
    exp_load_meta<PHASE>(p, mA, tb, x, lane);
    exp_load_meta<PHASE>(p, mB, tb + 1, x, lane);
    exp_issue<PHASE>(p, mA, rA, tb, x, lane);
    exp_issue<PHASE>(p, mB, rB, tb + 1, x, lane);
    exp_load_meta<PHASE>(p, nA, tb + 2, x, lane);
    exp_load_meta<PHASE>(p, nB, tb + 3, x, lane);
#pragma unroll 1
    for (int i = 0; i < 8; ++i) {
        const int tA = tb + 2 * i, tB = tA + 1;
        if (PHASE == 0) expA_compute(p, mA, rA, tA, x, lane); else expB_compute(p, mA, rA, tA, x, lane);
        if (i < 7) {
            mA = nA;
            exp_issue<PHASE>(p, mA, rA, tA + 2, x, lane);
            if (i < 6) exp_load_meta<PHASE>(p, nA, tA + 4, x, lane);
        }
        if (PHASE == 0) expA_compute(p, mB, rB, tB, x, lane); else expB_compute(p, mB, rB, tB, x, lane);
        if (i < 7) {
            mB = nB;
            exp_issue<PHASE>(p, mB, rB, tB + 2, x, lane);
            if (i < 6) exp_load_meta<PHASE>(p, nB, tB + 4, x, lane);
        }
    }
}
template <int PHASE>
DEVI void st_expAB(const Params& p, char* smem) {
    const int tid = stid(), lane = tid & 63, wid = tid >> 6;
    volatile int* cs = (volatile int*)smem;
    const unsigned myx = xb_xcc_id() & 7u;
    constexpr int NCH = T_TOK / (16 * NW);
    for (int si = 0; si < 8; ++si) {
        const int x = (int)((myx + si) & 7u);
        unsigned* ctr = &p.bar[PHASE == 0 ? CTR_A(x) : CTR_B(x)];
        if (tid == 0) cs[0] = (int)xb_add(ctr, 1u);
        __syncthreads();
        int chunk = cs[0];
        __syncthreads();
        while (chunk < NCH) {
            int nxt = 0;
            if (tid == 0) nxt = (int)xb_add(ctr, 1u);
            exp_chunk<PHASE>(p, chunk * (16 * NW) + wid * 16, x, lane);
            if (tid == 0) cs[0] = nxt;
            __syncthreads();
            chunk = cs[0];
            __syncthreads();
        }
    }
}
DEVI void st_expA2(const Params& p) {
    const int lane = stid() & 63, wid = stid() >> 6;
    for (int t = blockIdx.x * NW + wid; t < T_TOK; t += gridDim.x * NW) {
        int s0 = 0, s1 = 0;
#pragma unroll
        for (int x = 0; x < 8; ++x) { const int2 v = *(const int2*)(p.part + ((size_t)x * T_TOK + t) * 128 + 2 * lane); s0 += v.x; s1 += v.y; }
        const float xs = p.xsc[t];
        const unsigned ew = *(const unsigned*)(p.eperm + (size_t)t * 128 + 2 * lane);
        const int ea = (int)(ew & 0xffffu), eb = (int)(ew >> 16);
        const float2 g = *(const float2*)(p.gate + (size_t)t * 128 + 2 * lane);
        const float a0 = g.x * gelu_erf((float)s0 * xs * p.dscale[ea]) * p.uscale[ea];
        const float a1 = g.y * gelu_erf((float)s1 * xs * p.dscale[eb]) * p.uscale[eb];
        const float amax = wave_max(fmaxf(fabsf(a0), fabsf(a1)));
        const float inv = amax > 0.f ? 127.f / amax : 0.f;
        const unsigned q0 = (unsigned)((int)rintf(a0 * inv) & 255), q1 = (unsigned)((int)rintf(a1 * inv) & 255);
        *(unsigned short*)(p.aq + (size_t)t * 128 + 2 * lane) = (unsigned short)(q0 | (q1 << 8));
        if (lane == 0) p.asc[t] = amax * (1.f / 127.f);
    }
}
DEVI void st_expC(const Params& p) {
    const int lane = stid() & 63, wid = stid() >> 6;
    for (int t = blockIdx.x * NW + wid; t < T_TOK; t += gridDim.x * NW) {
        const float4* row = (const float4*)((const float*)p.proj + (size_t)t * 1024);
        float4 v[4];
        float ss = 0.f;
#pragma unroll
        for (int j = 0; j < 4; ++j) { v[j] = row[lane + 64 * j]; ss += v[j].x * v[j].x + v[j].y * v[j].y + v[j].z * v[j].z + v[j].w * v[j].w; }
        ss = wave_sum(ss);
        const float rf = rsqrtf(ss * (1.f / 1024.f) + EPSN);
        float4* orow = (float4*)(p.out + (size_t)t * 1024);
#pragma unroll
        for (int j = 0; j < 4; ++j) {
            const float4 g = *(const float4*)(p.final_g + (lane + 64 * j) * 4);
            orow[lane + 64 * j] = make_float4(v[j].x * rf * g.x, v[j].y * rf * g.y, v[j].z * rf * g.z, v[j].w * rf * g.w);
        }
    }
}

constexpr int LDS_BYTES = 147456;
constexpr int LDS_BARW = LDS_BYTES - 16;
extern __shared__ __attribute__((aligned(16))) char smem_dyn[];
__global__ void __launch_bounds__(NTHR, 2) mega_fwd(Params p) {
    cg::grid_group grid = cg::this_grid();
    volatile LAS unsigned* bst = (volatile LAS unsigned*)(LAS char*)(smem_dyn + LDS_BARW);
    if (stid() < 4) bst[stid()] = 0u;
    __syncthreads();
    XcdBarrier bar = xcd_barrier_post(p.bar, bst);
    st_prep_misc(p);
    st_prep_w1(p, smem_dyn);
    st_prep_x(p, smem_dyn);
    if (p.pad_[0] == 0x7fffabcd) grid.sync();
    xcd_barrier(bar);
    st_gemm8<EpiProj8, PG8_ALIGN>(p.xb, p.W1t, NPJ, 1024, smem_dyn, EpiProj8{p.proj, p.rs1, p.rope_cos, p.rope_sin});
    xcd_barrier(bar);
    st_conv_qk(p, smem_dyn);
    xcd_barrier(bar);
    st_recur(p, smem_dyn);
    xcd_barrier(bar);
    st_gemm8<EpiX18, PG8_ALIGN>(p.yb, p.W2t, 1024, 1024, smem_dyn, EpiX18{p.x, p.out});
    xcd_barrier(bar);
    st_norm2(p);
    xcd_barrier(bar);
    st_gemm3_topk(p, smem_dyn);
    xcd_barrier(bar);
    st_expAB<0>(p, smem_dyn);
    xcd_barrier(bar);
    st_expA2(p);
    xcd_barrier(bar);
    st_expAB<1>(p, smem_dyn);
    xcd_barrier(bar);
    st_expC(p);
}

extern "C" void kernel_launch(void* const* d_in, const int* in_sizes, int n_in, void* d_out, int out_size, void* d_ws, size_t ws_size,
                              hipStream_t stream) {
    Params p{};
    const float* const* in = (const float* const*)d_in;
    p.x = in[0]; p.norm1_g = in[1]; p.w_in = in[2]; p.ret_norm_g = in[3]; p.m_conv_w = in[4]; p.m_conv_b = in[5]; p.m_wq = in[6]; p.m_wk = in[7];
    p.m_b_i = in[8]; p.m_b_f = in[9]; p.m_norm_g = in[10]; p.m_skip = in[11]; p.w_out = in[12]; p.norm2_g = in[13]; p.peer_wq = in[14];
    p.peer_keys = in[15]; p.peer_down = in[16]; p.peer_up = in[17]; p.final_g = in[18];
    p.out = (float*)d_out;
    char* ws = (char*)d_ws;
    size_t off = 0;
    auto take = [&](size_t bytes) { char* r = ws + off; off += (bytes + 255) & ~(size_t)255; return r; };
    p.proj = (bf16_t*)take((size_t)T_TOK * NPJ * 2);
    p.xb = (bf16_t*)take((size_t)T_TOK * 1024 * 2);
    p.yb = p.xb;
    p.gate = (float*)(ws + (size_t)T_TOK * 2048 * 4);
    p.mq = (bf16_t*)take((size_t)T_TOK * 512 * 2);
    p.mk = (bf16_t*)take((size_t)T_TOK * 512 * 2);
    p.x1b = p.mq;
    p.cbuf = (bf16_t*)take((size_t)T_TOK * 512 * 2);
    p.eperm = (unsigned short*)p.cbuf;
    p.down_q = (unsigned char*)take((size_t)16384 * 1024);
    p.up_q = (unsigned char*)take((size_t)16384 * 1024);
    p.dscale = (float*)take(16384 * 4);
    p.uscale = (float*)take(16384 * 4);
    p.bar = (unsigned*)take(CTL_WORDS * 4);
    p.xq = (unsigned char*)take((size_t)T_TOK * 1024);
    p.xsc = (float*)take(T_TOK * 4);
    p.asc = (float*)take(T_TOK * 4);
    p.aq = (unsigned char*)take((size_t)T_TOK * 128);
    p.part = (int*)(ws + (size_t)T_TOK * 1024 * 4);
    p.W1t = (bf16_t*)take((size_t)NPJ * 1024 * 2);
    p.W2t = (bf16_t*)take((size_t)1024 * 1024 * 2);
    p.Wsubt = (bf16_t*)take((size_t)2048 * 1024 * 2);
    p.Wqt = (bf16_t*)take(4 * 128 * 128 * 2);
    p.Wkt = (bf16_t*)take(4 * 128 * 128 * 2);
    p.rs1 = (float*)take(T_TOK * 4);
    p.rs2 = (float*)take(T_TOK * 4);
    p.ipre = (float*)take(T_TOK * 4 * 4);
    p.logf = (float*)take(T_TOK * 4 * 4);
    p.rope_cos = (float*)take(2048 * 64 * 4);
    p.rope_sin = (float*)take(2048 * 64 * 4);
    if (off > ws_size) { fprintf(stderr, "kernel_launch: workspace too small (%zu > %zu)\n", off, ws_size); return; }

    static int grid_blocks = 0;
    if (!grid_blocks) {
        int dev = 0, cus = 0, per_cu = 0;
        (void)hipGetDevice(&dev);
        (void)hipDeviceGetAttribute(&cus, hipDeviceAttributeMultiprocessorCount, dev);
        (void)hipFuncSetAttribute((const void*)mega_fwd, hipFuncAttributeMaxDynamicSharedMemorySize, LDS_BYTES);
        (void)hipOccupancyMaxActiveBlocksPerMultiprocessor(&per_cu, (const void*)mega_fwd, NTHR, LDS_BYTES);
        if (per_cu > 1) per_cu = 1;
        if (per_cu < 1) per_cu = 1;
        grid_blocks = cus * per_cu;
    }
    (void)hipMemsetAsync(p.bar, 0, CTL_WORDS * 4, stream);
    void* args[] = {&p};
    hipError_t e = hipLaunchCooperativeKernel((const void*)mega_fwd, dim3(grid_blocks), dim3(NTHR), args, LDS_BYTES, stream);
    if (e != hipSuccess) fprintf(stderr, "cooperative launch failed: %s (grid %d)\n", hipGetErrorString(e), grid_blocks);
}
```

```cpp
#include <hip/hip_runtime.h>
#include <hip/hip_cooperative_groups.h>
#include <stdint.h>
#include <cstdio>
namespace cg = cooperative_groups;

typedef unsigned short bf16_t;
typedef short bf16x8 __attribute__((ext_vector_type(8)));
typedef float f32x4 __attribute__((ext_vector_type(4)));

#define DEVI __device__ __forceinline__
__device__ __forceinline__ int stid() { int t = (int)threadIdx.x; asm volatile("" : "+v"(t)); return t; }

constexpr int T_TOK = 32768, DM = 1024, NPJ = 3584, DIN = 3592;
constexpr int NTHR = 512, NW = 8;
constexpr float EPSN = 1e-6f;

struct Params {
    const float *x, *norm1_g, *w_in, *ret_norm_g, *m_conv_w, *m_conv_b, *m_wq, *m_wk, *m_b_i, *m_b_f, *m_norm_g, *m_skip, *w_out,
        *norm2_g, *peer_wq, *peer_keys, *peer_down, *peer_up, *final_g;
    float* out;
    bf16_t *proj, *xb, *yb, *mq, *mk, *x1b, *cbuf, *W1t, *W2t, *Wsubt, *Wqt, *Wkt;
    unsigned char *down_q, *up_q;
    float *dscale, *uscale, *xsc, *asc;
    unsigned short* eperm;
    unsigned char* aq;
    int* part;
    unsigned char* xq;
    unsigned* bar;
    float *rs1, *rs2, *ipre, *logf, *rope_cos, *rope_sin, *gate;
    int pad_[2];
};

DEVI unsigned f2bf_bits(float f) { unsigned u = __float_as_uint(f); return (u + 0x7fffu + ((u >> 16) & 1u)) >> 16; }
DEVI bf16_t f2bf(float f) { return __builtin_bit_cast(bf16_t, (__bf16)f); }
typedef __bf16 bf16x2_t __attribute__((ext_vector_type(2)));
DEVI unsigned pk2(float lo, float hi) { bf16x2_t v = {(__bf16)lo, (__bf16)hi}; return __builtin_bit_cast(unsigned, v); }
DEVI float bflo(unsigned w) { return __uint_as_float(w << 16); }
DEVI float bfhi(unsigned w) { return __uint_as_float(w & 0xffff0000u); }
DEVI float bf2f(bf16_t h) { return __uint_as_float(((unsigned)h) << 16); }
DEVI float wave_sum(float v) {
#pragma unroll
    for (int o = 32; o; o >>= 1) v += __shfl_xor(v, o);
    return v;
}
DEVI float wave_max(float v) {
#pragma unroll
    for (int o = 32; o; o >>= 1) v = fmaxf(v, __shfl_xor(v, o));
    return v;
}
DEVI f32x4 mfma16(bf16x8 a, bf16x8 b, f32x4 c) { return __builtin_amdgcn_mfma_f32_16x16x32_bf16(a, b, c, 0, 0, 0); }
DEVI bf16x8 ld8(const char* p) { return *reinterpret_cast<const bf16x8*>(p); }
DEVI bf16x8 mk8(uint2 lo, uint2 hi) {
    union { uint4 u; bf16x8 v; } x;
    x.u = make_uint4(lo.x, lo.y, hi.x, hi.y);
    return x.v;
}
DEVI float sigmoidf_(float z) { return 1.f / (1.f + __expf(-z)); }

DEVI void st_prep_misc(const Params& p) {
    const int gtid = blockIdx.x * NTHR + stid(), gsz = gridDim.x * NTHR;
    for (int i = gtid; i < 2048 * 64; i += gsz) {
        const int pos = i >> 6, j = i & 63;
        const float inv = powf(10000.f, -(float)j * (1.f / 64.f));
        const float ang = (float)pos * inv;
        float s, c;
        sincosf(ang, &s, &c);
        p.rope_cos[i] = c;
        p.rope_sin[i] = s;
    }
    for (int i = gtid; i < 4 * 128 * 128; i += gsz) {
        const int h = i >> 14, e = (i >> 7) & 127, d = i & 127;
        p.Wqt[i] = f2bf(p.m_wq[h * 16384 + d * 128 + e]);
        p.Wkt[i] = f2bf(p.m_wk[h * 16384 + d * 128 + e] * 0.08838834764831845f);
    }
}
DEVI void prep_table_row(const Params& p, int row, const float4 (&v)[4], int lane) {
    const bool up = row >= 16384;
    const int e = up ? row - 16384 : row;
    float am = 0.f;
#pragma unroll
    for (int i = 0; i < 4; ++i) am = fmaxf(am, fmaxf(fmaxf(fabsf(v[i].x), fabsf(v[i].y)), fmaxf(fabsf(v[i].z), fabsf(v[i].w))));
    am = wave_max(am);
    const float sc = am > 0.f ? am * (1.f / 127.f) : 1.f, inv = am > 0.f ? 127.f / am : 0.f;
    unsigned w[4];
#pragma unroll
    for (int i = 0; i < 4; ++i) {
        const int q0 = (int)rintf(v[i].x * inv), q1 = (int)rintf(v[i].y * inv), q2 = (int)rintf(v[i].z * inv), q3 = (int)rintf(v[i].w * inv);
        w[i] = (unsigned)(q0 & 255) | ((unsigned)(q1 & 255) << 8) | ((unsigned)(q2 & 255) << 16) | ((unsigned)(q3 & 255) << 24);
    }
    *(uint4*)((up ? p.up_q : p.down_q) + ((size_t)(lane >> 3) * 16384 + e) * 128 + (lane & 7) * 16) = make_uint4(w[0], w[1], w[2], w[3]);
    if (lane == 0) (up ? p.uscale : p.dscale)[e] = sc;
}
DEVI void st_prep_tables(const Params& p, int bid, int nb) {
    const int lane = stid() & 63, wid = stid() >> 6;
    for (int row = (bid * NW + wid) * 2; row < 32768; row += nb * NW * 2) {
        float4 va[4], vb[4];
        const float4* sa = (const float4*)((row >= 16384 ? p.peer_up + (size_t)(row - 16384) * 1024 : p.peer_down + (size_t)row * 1024) + lane * 16);
        const float4* sb = (const float4*)((row + 1 >= 16384 ? p.peer_up + (size_t)(row + 1 - 16384) * 1024 : p.peer_down + (size_t)(row + 1) * 1024) + lane * 16);
#pragma unroll
        for (int i = 0; i < 4; ++i) { va[i] = sa[i]; vb[i] = sb[i]; }
        prep_table_row(p, row, va, lane);
        prep_table_row(p, row + 1, vb, lane);
    }
}

DEVI void transpose_tile(const float* __restrict__ src, int ld, const float* __restrict__ scale, bf16_t* __restrict__ dst, int K, int k0, int n0,
                         float* tile, bool permqk = false) {
    const int tid = stid();
    {
        const int tx = tid & 63, ty = tid >> 6;
#pragma unroll
        for (int i = 0; i < 4; ++i) {
            const int k = k0 + ty + 8 * i;
            float v = src[(size_t)k * ld + n0 + tx];
            if (scale) v *= scale[k];
            tile[(ty + 8 * i) * 65 + tx] = v;
        }
    }
    __syncthreads();
    {
        const int n = tid >> 3, kq = tid & 7;
        const float a = tile[(4 * kq) * 65 + n], b = tile[(4 * kq + 1) * 65 + n], c = tile[(4 * kq + 2) * 65 + n], d = tile[(4 * kq + 3) * 65 + n];
        int nn = n0 + n;
        if (permqk && nn < 1024) { const int dd = nn & 127; nn = (nn & ~127) + (dd < 64 ? 2 * dd : 2 * (dd - 64) + 1); }
        *(uint2*)(dst + (size_t)nn * K + k0 + 4 * kq) = make_uint2(pk2(a, b), pk2(c, d));
    }
    __syncthreads();
}
DEVI void st_prep_w1(const Params& p, char* smem) {
    float* tile = (float*)smem;
    for (int it = blockIdx.x; it < 56 * 32; it += gridDim.x) transpose_tile(p.w_in, DIN, p.norm1_g, p.W1t, 1024, (it & 31) * 32, (it >> 5) * 64, tile, true);
}
DEVI void st_prep_w2(const Params& p, char* smem, int bid, int nb) {
    float* tile = (float*)smem;
    for (int it = bid; it < 16 * 32; it += nb) transpose_tile(p.w_out, 1024, nullptr, p.W2t, 1024, (it & 31) * 32, (it >> 5) * 64, tile);
}
DEVI void st_prep_wsub(const Params& p, char* smem, int bid, int nb) {
    float* wq_s = (float*)smem;
    float* key_s = wq_s + 32 * 132;
    const int tid = stid();
    for (int it = bid; it < 16 * 32 * 2; it += nb) {
        const int grp = it >> 6, kt = (it >> 1) & 31, nh = it & 1, k0 = kt * 32;
#pragma unroll
        for (int i = 0; i < 8; ++i) {
            const int idx = tid + 512 * i, r = idx >> 7, d = idx & 127;
            wq_s[r * 132 + d] = p.peer_wq[(size_t)(k0 + r) * 2048 + grp * 128 + d];
        }
#pragma unroll
        for (int i = 0; i < 16; ++i) {
            const int idx = tid + 512 * i, n = idx >> 7, d = idx & 127;
            key_s[n * 132 + d] = p.peer_keys[((size_t)grp * 128 + nh * 64 + n) * 128 + d];
        }
        __syncthreads();
        const int kl = tid & 15, ng = tid >> 4;
        float a00 = 0.f, a01 = 0.f, a10 = 0.f, a11 = 0.f;
#pragma unroll 8
        for (int d4 = 0; d4 < 32; ++d4) {
            const float4 w0 = *(const float4*)(wq_s + (2 * kl) * 132 + 4 * d4), w1 = *(const float4*)(wq_s + (2 * kl + 1) * 132 + 4 * d4);
            const float4 y0 = *(const float4*)(key_s + (2 * ng) * 132 + 4 * d4), y1 = *(const float4*)(key_s + (2 * ng + 1) * 132 + 4 * d4);
            a00 += w0.x * y0.x + w0.y * y0.y + w0.z * y0.z + w0.w * y0.w;
            a01 += w0.x * y1.x + w0.y * y1.y + w0.z * y1.z + w0.w * y1.w;
            a10 += w1.x * y0.x + w1.y * y0.y + w1.z * y0.z + w1.w * y0.w;
            a11 += w1.x * y1.x + w1.y * y1.y + w1.z * y1.z + w1.w * y1.w;
        }
        const float g0 = p.norm2_g[k0 + 2 * kl], g1 = p.norm2_g[k0 + 2 * kl + 1];
        bf16_t* o = p.Wsubt + (size_t)(grp * 128 + nh * 64 + 2 * ng) * 1024 + k0 + 2 * kl;
        *(unsigned*)o = pk2(a00 * g0, a10 * g1);
        *(unsigned*)(o + 1024) = pk2(a01 * g0, a11 * g1);
        __syncthreads();
    }
}

DEVI void prep_x_token(const Params& p, const float* Wg_s, int t, const float4 (&v)[4], int lane) {
    float ss = 0.f, g8[8];
#pragma unroll
    for (int g = 0; g < 8; ++g) g8[g] = 0.f;
#pragma unroll
    for (int j = 0; j < 4; ++j) {
        ss += v[j].x * v[j].x + v[j].y * v[j].y + v[j].z * v[j].z + v[j].w * v[j].w;
#pragma unroll
        for (int g = 0; g < 8; ++g) {
            const float4 w = *(const float4*)(Wg_s + g * 1024 + (lane + 64 * j) * 4);
            g8[g] += v[j].x * w.x + v[j].y * w.y + v[j].z * w.z + v[j].w * w.w;
        }
    }
    ss = wave_sum(ss);
    const bool b5 = lane & 32, b4 = lane & 16, b3 = lane & 8;
    float q4[4], q2[2], q1;
#pragma unroll
    for (int j = 0; j < 4; ++j) { const float snd = b5 ? g8[j] : g8[j + 4], kp = b5 ? g8[j + 4] : g8[j]; q4[j] = kp + __shfl_xor(snd, 32); }
#pragma unroll
    for (int j = 0; j < 2; ++j) { const float snd = b4 ? q4[j] : q4[j + 2], kp = b4 ? q4[j + 2] : q4[j]; q2[j] = kp + __shfl_xor(snd, 16); }
    { const float snd = b3 ? q2[0] : q2[1], kp = b3 ? q2[1] : q2[0]; q1 = kp + __shfl_xor(snd, 8); }
    q1 += __shfl_xor(q1, 4);
    q1 += __shfl_xor(q1, 2);
    q1 += __shfl_xor(q1, 1);
    const float rs = rsqrtf(ss * (1.f / 1024.f) + EPSN);
    uint2* o = (uint2*)(p.xb + (size_t)t * 1024);
#pragma unroll
    for (int j = 0; j < 4; ++j) o[lane + 64 * j] = make_uint2(pk2(v[j].x, v[j].y), pk2(v[j].z, v[j].w));
    if (lane == 0) p.rs1[t] = rs;
    if ((lane & 7) == 0) {
        const int gi = (b5 ? 4 : 0) + (b4 ? 2 : 0) + (b3 ? 1 : 0);
        if (gi < 4) p.ipre[t * 4 + gi] = q1 * rs + p.m_b_i[gi];
        else {
            const float z = q1 * rs + p.m_b_f[gi - 4];
            p.logf[t * 4 + gi - 4] = fminf(z, 0.f) - log1pf(__expf(-fabsf(z)));
        }
    }
}
DEVI void st_prep_x(const Params& p, char* smem) {
    float* Wg_s = (float*)smem;
    for (int i = stid(); i < 8192; i += NTHR) {
        const int k = i >> 3, g = i & 7;
        Wg_s[g * 1024 + k] = p.norm1_g[k] * p.w_in[(size_t)k * DIN + NPJ + g];
    }
    __syncthreads();
    const int lane = stid() & 63, wid = stid() >> 6;
    for (int t = (blockIdx.x * NW + wid) * 2; t < T_TOK; t += gridDim.x * NW * 2) {
        float4 va[4], vb[4];
        const float4* xa = (const float4*)(p.x + (size_t)t * 1024);
#pragma unroll
        for (int j = 0; j < 4; ++j) { va[j] = xa[lane + 64 * j]; vb[j] = xa[256 + lane + 64 * j]; }
        prep_x_token(p, Wg_s, t, va, lane);
        prep_x_token(p, Wg_s, t + 1, vb, lane);
    }
    __syncthreads();
}

namespace pg8 {
#define PG8_LAS __attribute__((address_space(3)))
typedef unsigned short bf16_t;
typedef short bf16x8 __attribute__((ext_vector_type(8)));
typedef float f32x4 __attribute__((ext_vector_type(4)));
typedef unsigned u32x4 __attribute__((ext_vector_type(4)));
constexpr int BM = 256, BK = 64, HALF = 128, HTB = HALF * BK * 2  , STAGE_BYTES = 8 * HTB, NXCD = 8, WGM = 8;

__host__ __device__ __forceinline__ int lds_byte(int r, int c) { const int st = (r >> 4) * 2 + (c >> 5), rr = r & 15, cc = c & 31, ob = rr * 64 + cc * 2; return st * 1024 + (ob ^ (((ob >> 9) & 1) << 5)); }
__host__ __device__ __forceinline__ void stage_rc(int b, int& R, int& C) { const int st = b / 1024, sb = b % 1024, swz = sb ^ (((sb >> 9) & 1) << 5); R = (st >> 1) * 16 + swz / 64; C = (st & 1) * 32 + (swz % 64) / 2; }
__host__ __device__ __forceinline__ int perm32(int rho) { const int n = rho >> 4, i = rho & 15; return 8 * (i >> 2) + 4 * n + (i & 3); }

struct Unit { int pm, pn; };
struct Gemm { const bf16_t* A; const bf16_t* Bt; int M, N, K; };

struct StaticOrder {
    int nM, nN, nwg, G, c;
    __host__ __device__ void init(int M, int N, int G_, int c_) { nM = M / BM; nN = N / BM; nwg = nM * nN; G = G_; c = c_; }
    __host__ __device__ bool next(int i, Unit& u) const {
        const long L = (long)i * G + c; if (L >= nwg) return false;
        int wgid = (int)L; { const int q = nwg / NXCD, r = nwg % NXCD, xcd = wgid % NXCD, off = wgid / NXCD; wgid = (xcd < r ? xcd * (q + 1) : r * (q + 1) + (xcd - r) * q) + off; }
        const int nig = WGM * nN, gid = wgid / nig, fm = gid * WGM, gsz = (nM - fm) < WGM ? (nM - fm) : WGM;
        u.pm = fm + ((wgid % nig) % gsz); u.pn = (wgid % nig) / gsz; return true;
    }
    __device__ __forceinline__ void a_ready(const Unit&) const {}
    __device__ __forceinline__ void done(const Unit&) const {}
};

__device__ __forceinline__ unsigned cvt_pk_bf16(float lo, float hi) { unsigned r; asm volatile("v_cvt_pk_bf16_f32 %0, %1, %2" : "=v"(r) : "v"(lo), "v"(hi)); return r; }

template <class Epi, class Sched, bool ALIGN_EPI = false, bool SP2 = false>
__device__ __forceinline__ void gemm_phase(PG8_LAS unsigned char* lds, const Gemm g, const Sched& S, const Epi& E) {
    const int tid = stid(), wid = __builtin_amdgcn_readfirstlane(tid >> 6), lane = tid & 63, wr = wid >> 2, wc = wid & 3, fr = lane & 15, fq = lane >> 4;
    const int K = g.K, nt = K / BK;
    unsigned voffA[2], voffB[2];
#pragma unroll
    for (int i = 0; i < 2; ++i) { int R, C; stage_rc(tid * 16 + i * 8192, R, C); const int Rb = Epi::PERM ? ((R & ~31) + perm32(R & 31)) : R;
        voffA[i] = (unsigned)(R * K + C) * 2u; voffB[i] = (unsigned)(Rb * K + C) * 2u; }
    const size_t kstep = (size_t)(BK * 2);
    const size_t hstep = (size_t)HALF * K * 2;
    const size_t tstep = 2 * hstep;
    const unsigned ldsw = (unsigned)wid * 1024u;
    const int aoff = lds_byte(wr * 64 + fr, fq * 8), boff = lds_byte(wc * 32 + fr, fq * 8);
#define PG8_SA(b, h) (((b) * 2 + (h)) * HTB)
#define PG8_SB(b, h) ((4 + (b) * 2 + (h)) * HTB)
#define PG8_STAGE(bufoff, gbase, voff) do { _Pragma("unroll") for (int _i = 0; _i < 2; ++_i) \
        __builtin_amdgcn_global_load_lds((const unsigned*)((const char*)(gbase) + (voff)[_i]), (PG8_LAS unsigned*)(lds + (bufoff) + ldsw + _i * 8192), 16, 0, 0); } while (0)
#define PG8_LDA(dst, b, h) do { _Pragma("unroll") for (int m = 0; m < 4; ++m) _Pragma("unroll") for (int k = 0; k < 2; ++k) dst[m][k] = *(const PG8_LAS bf16x8*)(lds + PG8_SA(b, h) + aoff + m * 2048 + k * 1024); } while (0)
#define PG8_LDB(dst, b, h) do { _Pragma("unroll") for (int n = 0; n < 2; ++n) _Pragma("unroll") for (int k = 0; k < 2; ++k) dst[n][k] = *(const PG8_LAS bf16x8*)(lds + PG8_SB(b, h) + boff + n * 2048 + k * 1024); } while (0)
#define PG8_MMA(ai, bj, At, Bt) do { __builtin_amdgcn_s_setprio(1); _Pragma("unroll") for (int m = 0; m < 4; ++m) _Pragma("unroll") for (int n = 0; n < 2; ++n) _Pragma("unroll") for (int k = 0; k < 2; ++k) \
        acc[ai][bj][m][n] = __builtin_amdgcn_mfma_f32_16x16x32_bf16(Bt[n][k], At[m][k], acc[ai][bj][m][n], 0, 0, 0); __builtin_amdgcn_s_setprio(0); } while (0)
#define PG8_WAIT_V(n) asm volatile("s_waitcnt vmcnt(" #n ")" ::: "memory")
#define PG8_WAIT_L(n) asm volatile("s_waitcnt lgkmcnt(" #n ")" ::: "memory")
#define PG8_BAR __builtin_amdgcn_s_barrier()
#define PG8_SCHED __builtin_amdgcn_sched_barrier(0)
    Unit cur, nxt; int ui = 0;
    if (!S.next(0, cur)) return;
    f32x4 acc[2][2][4][2];
#pragma unroll
    for (int a = 0; a < 2; ++a)
#pragma unroll
        for (int b = 0; b < 2; ++b)
#pragma unroll
            for (int m = 0; m < 4; ++m)
#pragma unroll
                for (int n = 0; n < 2; ++n) acc[a][b][m][n] = (f32x4){0.f, 0.f, 0.f, 0.f};
    bf16x8 At[4][2], B0[2][2], B1[2][2];
    const char* cA = (const char*)g.A + (size_t)cur.pm * tstep; const char* cB = (const char*)g.Bt + (size_t)cur.pn * tstep;
    S.a_ready(cur);
    if constexpr (SP2) {
        PG8_STAGE(PG8_SB(0, 0), cB, voffB); PG8_STAGE(PG8_SB(0, 1), cB + hstep, voffB); PG8_STAGE(PG8_SA(0, 0), cA, voffA); PG8_STAGE(PG8_SA(0, 1), cA + hstep, voffA);
        if (wr == 1) PG8_BAR;
        PG8_WAIT_V(2); PG8_BAR;
        PG8_STAGE(PG8_SB(1, 0), cB + kstep, voffB); PG8_STAGE(PG8_SA(1, 0), cA + kstep, voffA); PG8_STAGE(PG8_SB(1, 1), cB + hstep + kstep, voffB);
        PG8_WAIT_V(6); PG8_BAR;
    } else {
        PG8_STAGE(PG8_SB(0, 0), cB, voffB); PG8_STAGE(PG8_SA(0, 0), cA, voffA); PG8_STAGE(PG8_SB(0, 1), cB + hstep, voffB); PG8_STAGE(PG8_SA(0, 1), cA + hstep, voffA);
        if (wr == 1) PG8_BAR;
        PG8_WAIT_V(4); PG8_BAR;
        PG8_STAGE(PG8_SB(1, 0), cB + kstep, voffB); PG8_STAGE(PG8_SA(1, 0), cA + kstep, voffA); PG8_STAGE(PG8_SB(1, 1), cB + hstep + kstep, voffB);
        PG8_WAIT_V(6); PG8_BAR;
    }
    for (;;) {
        const bool has_next = S.next(ui + 1, nxt);
        const char* nA = has_next ? (const char*)g.A + (size_t)nxt.pm * tstep : cA; const char* nB = has_next ? (const char*)g.Bt + (size_t)nxt.pn * tstep : cB;
        for (int t = 0; t < nt; t += 2) {
            const bool last = (t == nt - 2);
            const char* a1 = cA + (size_t)(t + 1) * kstep;
            const char* a2 = last ? nA : cA + (size_t)(t + 2) * kstep; const char* b2 = last ? nB : cB + (size_t)(t + 2) * kstep;
            const char* a3 = a2 + kstep; const char* b3 = b2 + kstep;
            if (last && has_next) S.a_ready(nxt);
            if constexpr (SP2) {
            PG8_LDB(B0, 0, 0); PG8_LDB(B1, 0, 1); PG8_SCHED; PG8_LDA(At, 0, 0); PG8_STAGE(PG8_SA(1, 1), a1 + hstep, voffA);
            PG8_WAIT_V(8); PG8_WAIT_L(0); PG8_BAR; PG8_MMA(0, 0, At, B0); PG8_MMA(0, 1, At, B1); PG8_BAR; PG8_SCHED;
            PG8_LDA(At, 0, 1); PG8_STAGE(PG8_SB(0, 0), b2, voffB); PG8_STAGE(PG8_SB(0, 1), b2 + hstep, voffB); PG8_STAGE(PG8_SA(0, 0), a2, voffA);
            PG8_WAIT_V(8); PG8_WAIT_L(0); PG8_BAR; PG8_MMA(1, 0, At, B0); PG8_MMA(1, 1, At, B1); PG8_BAR; PG8_SCHED;
            PG8_LDB(B0, 1, 0); PG8_LDB(B1, 1, 1); PG8_SCHED; PG8_LDA(At, 1, 0); PG8_STAGE(PG8_SA(0, 1), a2 + hstep, voffA);
            PG8_WAIT_V(8); PG8_WAIT_L(0); PG8_BAR; PG8_MMA(0, 0, At, B0); PG8_MMA(0, 1, At, B1); PG8_BAR; PG8_SCHED;
            PG8_LDA(At, 1, 1); PG8_STAGE(PG8_SB(1, 0), b3, voffB); PG8_STAGE(PG8_SB(1, 1), b3 + hstep, voffB); PG8_STAGE(PG8_SA(1, 0), a3, voffA);
            PG8_WAIT_V(8); PG8_WAIT_L(0); PG8_BAR; PG8_MMA(1, 0, At, B0); PG8_MMA(1, 1, At, B1); PG8_BAR; PG8_SCHED;
            } else {
            PG8_LDB(B0, 0, 0); PG8_SCHED; PG8_LDA(At, 0, 0); PG8_STAGE(PG8_SA(1, 1), a1 + hstep, voffA);
            PG8_WAIT_L(8); PG8_BAR; PG8_WAIT_L(0); PG8_MMA(0, 0, At, B0); PG8_BAR; PG8_SCHED;
            PG8_LDB(B1, 0, 1); PG8_STAGE(PG8_SB(0, 0), b2, voffB);
            PG8_BAR; PG8_WAIT_L(0); PG8_MMA(0, 1, At, B1); PG8_BAR;
            PG8_LDA(At, 0, 1); PG8_STAGE(PG8_SA(0, 0), a2, voffA);
            PG8_BAR; PG8_WAIT_L(0); PG8_MMA(1, 0, At, B0); PG8_BAR; PG8_SCHED;
            PG8_STAGE(PG8_SB(0, 1), b2 + hstep, voffB);
            PG8_WAIT_V(6); PG8_BAR; PG8_MMA(1, 1, At, B1); PG8_BAR;
            PG8_LDB(B0, 1, 0); PG8_SCHED; PG8_LDA(At, 1, 0); PG8_STAGE(PG8_SA(0, 1), a2 + hstep, voffA);
            PG8_WAIT_L(8); PG8_BAR; PG8_WAIT_L(0); PG8_MMA(0, 0, At, B0); PG8_BAR; PG8_SCHED;
            PG8_LDB(B1, 1, 1); PG8_STAGE(PG8_SB(1, 0), b3, voffB);
            PG8_BAR; PG8_WAIT_L(0); PG8_MMA(0, 1, At, B1); PG8_BAR;
            PG8_LDA(At, 1, 1); PG8_STAGE(PG8_SA(1, 0), a3, voffA);
            PG8_BAR; PG8_WAIT_L(0); PG8_MMA(1, 0, At, B0); PG8_BAR; PG8_SCHED;
            PG8_STAGE(PG8_SB(1, 1), b3 + hstep, voffB);
            PG8_WAIT_V(6); PG8_BAR; PG8_MMA(1, 1, At, B1); PG8_BAR;
            }
        }
        if constexpr (ALIGN_EPI) { if (wr == 0) PG8_BAR; }
        if constexpr (!Epi::AFTER_DRAIN) { E(acc, cur, wr, wc, fr, fq); S.done(cur); }
        if (!has_next) break;
#pragma unroll
        for (int a = 0; a < 2; ++a)
#pragma unroll
            for (int b = 0; b < 2; ++b)
#pragma unroll
                for (int m = 0; m < 4; ++m)
#pragma unroll
                    for (int n = 0; n < 2; ++n) acc[a][b][m][n] = (f32x4){0.f, 0.f, 0.f, 0.f};
        cur = nxt; cA = nA; cB = nB; ++ui;
        if constexpr (ALIGN_EPI) { if (wr == 1) PG8_BAR; }
    }
    PG8_WAIT_V(0);
    if constexpr (!ALIGN_EPI) { if (wr == 0) PG8_BAR; }
    PG8_BAR;
    if constexpr (Epi::AFTER_DRAIN) { E.fused(acc, cur, wr, wc, fr, fq, lds, wid, lane); S.done(cur); }
#undef PG8_SA
#undef PG8_SB
#undef PG8_STAGE
#undef PG8_LDA
#undef PG8_LDB
#undef PG8_MMA
#undef PG8_WAIT_V
#undef PG8_WAIT_L
#undef PG8_BAR
#undef PG8_SCHED
}
}

#ifndef PG8_SP2
#define PG8_SP2 true
#endif
#ifndef PG8_ALIGN
#define PG8_ALIGN true
#endif
struct EpiProj8 {
    static constexpr bool PERM = true, AFTER_DRAIN = false;
    bf16_t* O; const float* rs; const float* rcos; const float* rsin;
    __device__ __forceinline__ void operator()(const pg8::f32x4 (&acc)[2][2][4][2], const pg8::Unit& u, int wr, int wc, int fr, int fq) const {
        const int row0 = u.pm * 256 + wr * 64 + fr, col0 = u.pn * 256 + wc * 32 + 8 * fq;
        const bool rot = u.pn < 4;
        const float ksc = u.pn >= 2 ? 0.08838834764831845f : 1.f;
#pragma unroll
        for (int ai = 0; ai < 2; ++ai)
#pragma unroll
            for (int m = 0; m < 4; ++m) {
                const int row = row0 + ai * 128 + m * 16;
                const float s = rs[row];
                bf16_t* rowp = O + (size_t)row * NPJ + col0;
                float4 cs = make_float4(1.f, 1.f, 1.f, 1.f), sn = make_float4(0.f, 0.f, 0.f, 0.f);
                float s2 = s;
                if (rot) {
                    const int ti = (row & 2047) * 64 + 16 * wc + 4 * fq;
                    cs = *(const float4*)(rcos + ti);
                    sn = *(const float4*)(rsin + ti);
                    s2 = s * ksc;
                }
#pragma unroll
                for (int bj = 0; bj < 2; ++bj) {
                    const pg8::f32x4 v0 = acc[ai][bj][m][0] * s2, v1 = acc[ai][bj][m][1] * s2;
                    *(uint4*)(rowp + bj * 128) = make_uint4(pk2(v0[0] * cs.x - v0[1] * sn.x, v0[0] * sn.x + v0[1] * cs.x), pk2(v0[2] * cs.y - v0[3] * sn.y, v0[2] * sn.y + v0[3] * cs.y),
                                                            pk2(v1[0] * cs.z - v1[1] * sn.z, v1[0] * sn.z + v1[1] * cs.z), pk2(v1[2] * cs.w - v1[3] * sn.w, v1[2] * sn.w + v1[3] * cs.w));
                }
            }
    }
};
struct EpiX18 {
    static constexpr bool PERM = true, AFTER_DRAIN = false;
    const float* x; bf16_t* x1b;
    __device__ __forceinline__ void operator()(const pg8::f32x4 (&acc)[2][2][4][2], const pg8::Unit& u, int wr, int wc, int fr, int fq) const {
        const int row0 = u.pm * 256 + wr * 64 + fr, col0 = u.pn * 256 + wc * 32 + 8 * fq;
#pragma unroll
        for (int ai = 0; ai < 2; ++ai)
#pragma unroll
            for (int m = 0; m < 4; ++m) {
                const size_t ro = (size_t)(row0 + ai * 128 + m * 16) * 1024 + col0;
#pragma unroll
                for (int bj = 0; bj < 2; ++bj) {
                    const float4 xa = *(const float4*)(x + ro + bj * 128), xb_ = *(const float4*)(x + ro + bj * 128 + 4);
                    const pg8::f32x4 v0 = acc[ai][bj][m][0], v1 = acc[ai][bj][m][1];
                    *(uint4*)(x1b + ro + bj * 128) = make_uint4(pk2(xa.x + v0[0], xa.y + v0[1]), pk2(xa.z + v0[2], xa.w + v0[3]),
                                                                pk2(xb_.x + v1[0], xb_.y + v1[1]), pk2(xb_.z + v1[2], xb_.w + v1[3]));
                }
            }
    }
};
template <class Epi, bool ALIGN>
DEVI void st_gemm8(const bf16_t* A, const bf16_t* Bt, int N, int K, char* smem, const Epi& epi) {
    pg8::Gemm g{A, Bt, T_TOK, N, K};
    pg8::StaticOrder S;
    S.init(T_TOK, N, (int)gridDim.x, (int)blockIdx.x);
    pg8::gemm_phase<Epi, pg8::StaticOrder, ALIGN, PG8_SP2>((PG8_LAS unsigned char*)smem, g, S, epi);
}

DEVI void st_conv_qk(const Params& p, char* smem) {
    char* cs = smem;
    char* wqs = smem + 128 * 272;
    char* wks = smem + 2 * 128 * 272;
    const int tid = stid(), lane = tid & 63, wid = tid >> 6, wr = wid >> 1, wc = wid & 1, fr = lane & 15, fq = lane >> 4;
    const int r = tid >> 4, cg = tid & 15;
    int hcur = -1;
    float cw[4][8], cb[8];
    for (int it = blockIdx.x; it < 256 * 4; it += gridDim.x) {
        const int h = it & 3, t0 = (it >> 2) * 128, s0 = t0 & 2047;
        if (h != hcur) {
            __syncthreads();
#pragma unroll
            for (int i = 0; i < 4; ++i) {
                const int id = tid + 512 * i, rr = id >> 4, c = id & 15;
                *(uint4*)(wqs + rr * 272 + c * 16) = *(const uint4*)(p.Wqt + h * 16384 + rr * 128 + c * 8);
                *(uint4*)(wks + rr * 272 + c * 16) = *(const uint4*)(p.Wkt + h * 16384 + rr * 128 + c * 8);
            }
#pragma unroll
            for (int j = 0; j < 4; ++j) {
                const float4 a = *(const float4*)(p.m_conv_w + j * 512 + h * 128 + 8 * cg), b = *(const float4*)(p.m_conv_w + j * 512 + h * 128 + 8 * cg + 4);
                cw[j][0] = a.x; cw[j][1] = a.y; cw[j][2] = a.z; cw[j][3] = a.w; cw[j][4] = b.x; cw[j][5] = b.y; cw[j][6] = b.z; cw[j][7] = b.w;
            }
            { const float4 a = *(const float4*)(p.m_conv_b + h * 128 + 8 * cg), b = *(const float4*)(p.m_conv_b + h * 128 + 8 * cg + 4);
              cb[0] = a.x; cb[1] = a.y; cb[2] = a.z; cb[3] = a.w; cb[4] = b.x; cb[5] = b.y; cb[6] = b.z; cb[7] = b.w; }
            hcur = h;
        }
        const bf16_t* xcol = p.proj + (size_t)t0 * NPJ + 2048 + h * 128 + 8 * cg;
#pragma unroll
        for (int ps = 0; ps < 4; ++ps) {
            const int row = 32 * ps + r;
            uint4 xv[4];
#pragma unroll
            for (int j = 0; j < 4; ++j) {
                const int rj = row - 3 + j;
                xv[j] = (s0 + rj >= 0) ? *(const uint4*)(xcol + (long)rj * NPJ) : make_uint4(0u, 0u, 0u, 0u);
            }
            float y[8];
#pragma unroll
            for (int e = 0; e < 8; ++e) y[e] = cb[e];
#pragma unroll
            for (int j = 0; j < 4; ++j) {
                const unsigned w4[4] = {xv[j].x, xv[j].y, xv[j].z, xv[j].w};
#pragma unroll
                for (int e = 0; e < 4; ++e) { y[2 * e] += cw[j][2 * e] * bflo(w4[e]); y[2 * e + 1] += cw[j][2 * e + 1] * bfhi(w4[e]); }
            }
            unsigned o[4];
#pragma unroll
            for (int e = 0; e < 4; ++e) o[e] = pk2(y[2 * e] * sigmoidf_(y[2 * e]), y[2 * e + 1] * sigmoidf_(y[2 * e + 1]));
            const uint4 ov = make_uint4(o[0], o[1], o[2], o[3]);
            *(uint4*)(cs + row * 272 + cg * 16) = ov;
            *(uint4*)(p.cbuf + (size_t)(t0 + row) * 512 + h * 128 + 8 * cg) = ov;
        }
        __syncthreads();
#pragma unroll
        for (int which = 0; which < 2; ++which) {
            const char* ws = which ? wks : wqs;
            bf16_t* O = which ? p.mk : p.mq;
            f32x4 acc[2][4];
#pragma unroll
            for (int i = 0; i < 2; ++i)
#pragma unroll
                for (int j = 0; j < 4; ++j) acc[i][j] = (f32x4){0.f, 0.f, 0.f, 0.f};
#pragma unroll
            for (int ks = 0; ks < 4; ++ks) {
                bf16x8 a[2], b[4];
#pragma unroll
                for (int i = 0; i < 2; ++i) a[i] = ld8(cs + (wr * 32 + i * 16 + fr) * 272 + (ks * 4 + fq) * 16);
#pragma unroll
                for (int j = 0; j < 4; ++j) b[j] = ld8(ws + (wc * 64 + j * 16 + fr) * 272 + (ks * 4 + fq) * 16);
#pragma unroll
                for (int i = 0; i < 2; ++i)
#pragma unroll
                    for (int j = 0; j < 4; ++j) acc[i][j] = mfma16(b[j], a[i], acc[i][j]);
            }
#pragma unroll
            for (int i = 0; i < 2; ++i)
#pragma unroll
                for (int j = 0; j < 4; ++j) {
                    const int m = t0 + wr * 32 + i * 16 + fr, n = h * 128 + wc * 64 + j * 16 + 4 * fq;
                    const f32x4 v = acc[i][j];
                    *(uint2*)(O + (size_t)m * 512 + n) = make_uint2(pk2(v[0], v[1]), pk2(v[2], v[3]));
                }
        }
        __syncthreads();
    }
}

DEVI bf16x8 u4_to_frag(uint4 u) { union { uint4 u; bf16x8 v; } x; x.u = u; return x.v; }
DEVI void sel_frags(bf16x8 (&sel)[2], int fr, int fq) {
#pragma unroll
    for (int hh = 0; hh < 2; ++hh) {
        const int jstar = fr + 16 * hh - 8 * fq;
        bf16x8 s;
#pragma unroll
        for (int j = 0; j < 8; ++j) s[j] = (j == jstar) ? (short)0x3F80 : (short)0;
        sel[hh] = s;
    }
}
DEVI void tr_store(char* XT, bf16x8 frag, const bf16x8 (&sel)[2], int mi, int ks, int fr, int fq, const float (&sc)[4]) {
#pragma unroll
    for (int hh = 0; hh < 2; ++hh) {
        const f32x4 d = mfma16(frag, sel[hh], (f32x4){0.f, 0.f, 0.f, 0.f});
        *(uint2*)(XT + (32 * ks + 16 * hh + fr) * 144 + (16 * mi + 4 * fq) * 2) = make_uint2(pk2(d[0] * sc[0], d[1] * sc[1]), pk2(d[2] * sc[2], d[3] * sc[3]));
    }
}
DEVI bf16x8 state_pack(const f32x4& a, const f32x4& b) {
    return mk8(make_uint2(pk2(a[0], a[1]), pk2(a[2], a[3])), make_uint2(pk2(b[0], b[1]), pk2(b[2], b[3])));
}
DEVI const float* opaque_ptr(const float* q) { asm volatile("" : "+v"(q)); return q; }
DEVI float opaque_f(float v) { asm volatile("" : "+v"(v)); return v; }
DEVI void lds_barrier() { asm volatile("s_waitcnt lgkmcnt(0)" ::: "memory"); __builtin_amdgcn_s_barrier(); asm volatile("" ::: "memory"); }
DEVI void pin_u4(uint4& a) { asm volatile("" : "+v"(a.x), "+v"(a.y), "+v"(a.z), "+v"(a.w)); }
DEVI float grp8_sum(float v) { v += __shfl_xor(v, 1); v += __shfl_xor(v, 2); v += __shfl_xor(v, 4); return v; }

#define ASM_LD16(dst, voff, sbase, imm) asm volatile("global_load_dwordx4 %0, %1, %2 offset:" #imm : "=v"(dst) : "v"(voff), "s"(sbase) : "memory")
#define ASM_LD4(dst, voff, sbase) asm volatile("global_load_dword %0, %1, %2" : "=v"(dst) : "v"(voff), "s"(sbase) : "memory")
typedef unsigned u32x4_t __attribute__((ext_vector_type(4)));
struct RetPre { u32x4_t f[4]; u32x4_t v[2]; u32x4_t g[2]; };
struct RetOff { unsigned f, v0, v1, g; };
DEVI void ret_offsets(RetOff& o, int h, int tid) {
    const int lane = tid & 63, w = tid >> 6, fr = lane & 15, fq = lane >> 4, mi = w & 3;
    o.f = (unsigned)(((16 * mi + fr) * NPJ + (w < 4 ? 512 : 0) + h * 128 + 8 * fq) * 2);
    o.v0 = (unsigned)(((16 * ((2 * w) >> 2) + fr) * NPJ + 1024 + h * 128 + 32 * ((2 * w) & 3) + 8 * fq) * 2);
    o.v1 = (unsigned)(((16 * ((2 * w + 1) >> 2) + fr) * NPJ + 1024 + h * 128 + 32 * ((2 * w + 1) & 3) + 8 * fq) * 2);
    o.g = (unsigned)(((tid >> 3) * NPJ + 1536 + h * 128 + 16 * (tid & 7)) * 2);
}
DEVI void ret_prefetch(const Params& p, RetPre& P, const RetOff& o, int b, int c) {
    const char* base = (const char*)p.proj + (size_t)(b * 2048 + c * 64) * (NPJ * 2);
    ASM_LD16(P.f[0], o.f, base, 0); ASM_LD16(P.f[1], o.f, base, 64); ASM_LD16(P.f[2], o.f, base, 128); ASM_LD16(P.f[3], o.f, base, 192);
    ASM_LD16(P.v[0], o.v0, base, 0); ASM_LD16(P.v[1], o.v1, base, 0);
    ASM_LD16(P.g[0], o.g, base, 0); ASM_LD16(P.g[1], o.g, base, 16);
}
DEVI void ret_retire(RetPre& P) {
    asm volatile("s_waitcnt vmcnt(0)" : "+v"(P.f[0]), "+v"(P.f[1]), "+v"(P.f[2]), "+v"(P.f[3]), "+v"(P.v[0]), "+v"(P.v[1]), "+v"(P.g[0]), "+v"(P.g[1]) :: "memory");
}
DEVI uint4 asu4(const u32x4_t& v) { return make_uint4(v[0], v[1], v[2], v[3]); }
DEVI void ret_block(const Params& p, char* smem, int b, int h) {
    char* qs = smem;
    char* ks_ = smem + 17408;
    char* kTs = smem + 34816;
    char* vTs = smem + 53248;
    char* Ss = smem + 71680;
    char* Os = smem + 80896;
    float* gn_s = (float*)(smem + 98304);
    const int tid = stid(), lane = tid & 63, w = tid >> 6, fr = lane & 15, fq = lane >> 4;
    const float gamma = 1.f - exp2f(-5.f - (float)h);
    const float l2g = log2f(gamma);
    const float g64 = exp2f(l2g * 64.f);
    bf16x8 sel[2];
    sel_frags(sel, fr, fq);
    f32x4 st[8];
#pragma unroll
    for (int i = 0; i < 8; ++i) st[i] = (f32x4){0.f, 0.f, 0.f, 0.f};
    if (tid < 128) gn_s[tid] = p.ret_norm_g[h * 128 + tid];
    __syncthreads();
    RetPre P;
    RetOff RO;
    ret_offsets(RO, h, tid);
    ret_prefetch(p, P, RO, b, 0);
    ret_retire(P);
#pragma unroll 1
    for (int c = 0; c < 32; ++c) {
        const int t0 = b * 2048 + c * 64;
        {
            const int mi = w & 3;
            char* dst = (w < 4 ? ks_ : qs) + (16 * mi + fr) * 272 + fq * 16;
#pragma unroll
            for (int ks = 0; ks < 4; ++ks) *(uint4*)(dst + ks * 64) = asu4(P.f[ks]);
            if (w < 4) {
                float kd[4];
#pragma unroll
                for (int r = 0; r < 4; ++r) kd[r] = exp2f(l2g * (float)(63 - (16 * mi + 4 * fq + r)));
#pragma unroll
                for (int ks = 0; ks < 4; ++ks) tr_store(kTs, u4_to_frag(asu4(P.f[ks])), sel, mi, ks, fr, fq, kd);
            }
            const float one[4] = {1.f, 1.f, 1.f, 1.f};
#pragma unroll
            for (int q = 0; q < 2; ++q) { const int pr = 2 * w + q; tr_store(vTs, u4_to_frag(asu4(P.v[q])), sel, pr >> 2, pr & 3, fr, fq, one); }
        }
        uint4 g0 = asu4(P.g[0]), g1 = asu4(P.g[1]);
        lds_barrier();
        ret_prefetch(p, P, RO, b, c + 1 < 32 ? c + 1 : 31);
        {
            const int lt = w & 3;
            bf16x8 qf[4];
#pragma unroll
            for (int s = 0; s < 4; ++s) qf[s] = ld8(qs + (16 * lt + fr) * 272 + (s * 4 + fq) * 16);
#pragma unroll
            for (int jj = 0; jj < 2; ++jj) {
                const int j = 2 * (w >> 2) + jj;
                f32x4 a = (f32x4){0.f, 0.f, 0.f, 0.f};
#pragma unroll
                for (int s = 0; s < 4; ++s) a = mfma16(ld8(ks_ + (16 * j + fr) * 272 + (s * 4 + fq) * 16), qf[s], a);
                const int l = 16 * lt + fr, mb = 16 * j + 4 * fq;
                float v[4];
#pragma unroll
                for (int r = 0; r < 4; ++r) { const int dd = l - (mb + r); v[r] = a[r] * exp2f(l2g * (float)(dd < 0 ? -dd : dd)); }
                *(uint2*)(Ss + l * 144 + mb * 2) = make_uint2(pk2(v[0], v[1]), pk2(v[2], v[3]));
            }
        }
        lds_barrier();
        {
            bf16x8 sp[4];
#pragma unroll
            for (int s = 0; s < 4; ++s) sp[s] = state_pack(st[2 * s], st[2 * s + 1]);
            bf16x8 vf[2];
#pragma unroll
            for (int s2 = 0; s2 < 2; ++s2) vf[s2] = ld8(vTs + (16 * w + fr) * 144 + (s2 * 4 + fq) * 16);
#pragma unroll
            for (int i = 0; i < 4; ++i) {
                f32x4 a = (f32x4){0.f, 0.f, 0.f, 0.f};
                const char* qrow = qs + (16 * i + fr) * 272;
#pragma unroll
                for (int s = 0; s < 4; ++s) {
                    const uint2 lo = *(const uint2*)(qrow + (32 * s + 4 * fq) * 2), hi = *(const uint2*)(qrow + (32 * s + 16 + 4 * fq) * 2);
                    a = mfma16(sp[s], mk8(lo, hi), a);
                }
                a = a * exp2f(l2g * (float)(16 * i + fr + 1));
#pragma unroll
                for (int s2 = 0; s2 < 2; ++s2) a = mfma16(vf[s2], ld8(Ss + (16 * i + fr) * 144 + (s2 * 4 + fq) * 16), a);
                *(uint2*)(Os + (16 * i + fr) * 272 + (16 * w + 4 * fq) * 2) = make_uint2(pk2(a[0], a[1]), pk2(a[2], a[3]));
            }
#pragma unroll
            for (int i = 0; i < 8; ++i) {
                f32x4 a = st[i] * g64;
#pragma unroll
                for (int s2 = 0; s2 < 2; ++s2) a = mfma16(ld8(kTs + (16 * i + fr) * 144 + (s2 * 4 + fq) * 16), vf[s2], a);
                st[i] = a;
            }
        }
        lds_barrier();
        pin_u4(g0); pin_u4(g1);
        {
            const int l = tid >> 3, part = tid & 7;
            const uint4 o0 = *(const uint4*)(Os + l * 272 + part * 32), o1 = *(const uint4*)(Os + l * 272 + part * 32 + 16);
            const unsigned ow[8] = {o0.x, o0.y, o0.z, o0.w, o1.x, o1.y, o1.z, o1.w}, gw[8] = {g0.x, g0.y, g0.z, g0.w, g1.x, g1.y, g1.z, g1.w};
            float x[16], s = 0.f;
#pragma unroll
            for (int e = 0; e < 8; ++e) { x[2 * e] = bflo(ow[e]); x[2 * e + 1] = bfhi(ow[e]); s += x[2 * e] + x[2 * e + 1]; }
            const float mu = grp8_sum(s) * (1.f / 128.f);
            float q = 0.f;
#pragma unroll
            for (int e = 0; e < 16; ++e) { x[e] -= mu; q += x[e] * x[e]; }
            const float rstd = rsqrtf(grp8_sum(q) * (1.f / 128.f) + EPSN);
            const float* gn = gn_s + 16 * part;
            unsigned yo[8];
#pragma unroll
            for (int e = 0; e < 8; ++e) {
                const float ga = bflo(gw[e]), gb = bfhi(gw[e]);
                yo[e] = pk2(ga * sigmoidf_(ga) * x[2 * e] * rstd * gn[2 * e], gb * sigmoidf_(gb) * x[2 * e + 1] * rstd * gn[2 * e + 1]);
            }
            ret_retire(P);
            uint4* yp = (uint4*)(p.yb + (size_t)(t0 + l) * 1024 + h * 128 + 16 * part);
            yp[0] = make_uint4(yo[0], yo[1], yo[2], yo[3]);
            yp[1] = make_uint4(yo[4], yo[5], yo[6], yo[7]);
        }
    }
}

struct MlPre { u32x4_t f[4]; u32x4_t v[2]; u32x4_t o[2]; u32x4_t cc[2]; float iv, fv; };
struct MlOff { unsigned f, v0, v1, o, c, g; };
DEVI void ml_offsets(const Params& p, MlOff& o, int h, int tid) {
    const int lane = tid & 63, w = tid >> 6, fr = lane & 15, fq = lane >> 4, mi = w & 3;
    const unsigned kdiff = (unsigned)((const char*)p.mk - (const char*)p.mq);
    o.f = (unsigned)(((16 * mi + fr) * 512 + h * 128 + 8 * fq) * 2) + (w < 4 ? kdiff : 0u);
    o.v0 = (unsigned)(((16 * ((2 * w) >> 2) + fr) * NPJ + 2560 + h * 128 + 32 * ((2 * w) & 3) + 8 * fq) * 2);
    o.v1 = (unsigned)(((16 * ((2 * w + 1) >> 2) + fr) * NPJ + 2560 + h * 128 + 32 * ((2 * w + 1) & 3) + 8 * fq) * 2);
    o.o = (unsigned)(((tid >> 3) * NPJ + 3072 + h * 128 + 16 * (tid & 7)) * 2);
    o.c = (unsigned)(((tid >> 3) * 512 + h * 128 + 16 * (tid & 7)) * 2);
    o.g = (unsigned)((lane * 4 + h) * 4);
}
DEVI void ml_prefetch(const Params& p, MlPre& P, const MlOff& o, int b, int c) {
    const size_t t0 = (size_t)(b * 2048 + c * 64);
    const char* bq = (const char*)p.mq + t0 * 1024, *bp = (const char*)p.proj + t0 * (NPJ * 2), *bc = (const char*)p.cbuf + t0 * 1024;
    const char* bi = (const char*)p.ipre + t0 * 16, *bf = (const char*)p.logf + t0 * 16;
    ASM_LD16(P.f[0], o.f, bq, 0); ASM_LD16(P.f[1], o.f, bq, 64); ASM_LD16(P.f[2], o.f, bq, 128); ASM_LD16(P.f[3], o.f, bq, 192);
    ASM_LD16(P.v[0], o.v0, bp, 0); ASM_LD16(P.v[1], o.v1, bp, 0);
    ASM_LD16(P.o[0], o.o, bp, 0); ASM_LD16(P.o[1], o.o, bp, 16);
    ASM_LD16(P.cc[0], o.c, bc, 0); ASM_LD16(P.cc[1], o.c, bc, 16);
    ASM_LD4(P.iv, o.g, bi); ASM_LD4(P.fv, o.g, bf);
}
DEVI void ml_retire(MlPre& P) {
    asm volatile("s_waitcnt vmcnt(0)" : "+v"(P.f[0]), "+v"(P.f[1]), "+v"(P.f[2]), "+v"(P.f[3]), "+v"(P.v[0]), "+v"(P.v[1]), "+v"(P.o[0]), "+v"(P.o[1]),
                 "+v"(P.cc[0]), "+v"(P.cc[1]), "+v"(P.iv), "+v"(P.fv) :: "memory");
}
DEVI void mlstm_block(const Params& p, char* smem, int b, int h) {
    char* qs = smem;
    char* kTs = smem + 17408;
    char* vTs = smem + 35840;
    char* Os = smem + 54272;
    float* n_s = (float*)(smem + 71680);
    float* den_s = (float*)(smem + 72192);
    float* gn_s = (float*)(smem + 72448);
    float* sk_s = gn_s + 128;
    const int tid = stid(), lane = tid & 63, w = tid >> 6, fr = lane & 15, fq = lane >> 4;
    bf16x8 sel[2];
    sel_frags(sel, fr, fq);
    f32x4 st[8];
#pragma unroll
    for (int i = 0; i < 8; ++i) st[i] = (f32x4){0.f, 0.f, 0.f, 0.f};
    float m_run = 0.f;
    f32x4 nacc = (f32x4){0.f, 0.f, 0.f, 0.f};
    bf16x8 ones;
#pragma unroll
    for (int j = 0; j < 8; ++j) ones[j] = (short)0x3F80;
    if (tid < 128) { gn_s[tid] = p.m_norm_g[h * 128 + tid]; sk_s[tid] = p.m_skip[h * 128 + tid]; }
    __syncthreads();
    MlPre P;
    MlOff MO;
    ml_offsets(p, MO, h, tid);
    ml_prefetch(p, P, MO, b, 0);
    ml_retire(P);
#pragma unroll 1
    for (int c = 0; c < 32; ++c) {
        const int t0 = b * 2048 + c * 64;
        float fcum = P.fv;
#pragma unroll
        for (int o = 1; o < 64; o <<= 1) { const float tv = __shfl_up(fcum, o); if (lane >= o) fcum += tv; }
        const float a_c = __shfl(fcum, 63);
        const float logw = a_c - fcum + P.iv;
        const float m_in = wave_max(logw);
        const float m_new = fmaxf(a_c + m_run, m_in);
        const float decay = __expf(a_c + m_run - m_new);
        const float wgt = __expf(logw - m_new);
        const float emn = __expf(-m_new);
        m_run = m_new;
        {
            const int mi = w & 3;
            if (w < 4) {
                float kw[4];
#pragma unroll
                for (int r = 0; r < 4; ++r) kw[r] = __shfl(wgt, 16 * mi + 4 * fq + r);
#pragma unroll
                for (int ks = 0; ks < 4; ++ks) tr_store(kTs, u4_to_frag(asu4(P.f[ks])), sel, mi, ks, fr, fq, kw);
            } else {
                char* dst = qs + (16 * mi + fr) * 272 + fq * 16;
#pragma unroll
                for (int ks = 0; ks < 4; ++ks) *(uint4*)(dst + ks * 64) = asu4(P.f[ks]);
            }
            const float one[4] = {1.f, 1.f, 1.f, 1.f};
#pragma unroll
            for (int q = 0; q < 2; ++q) { const int pr = 2 * w + q; tr_store(vTs, u4_to_frag(asu4(P.v[q])), sel, pr >> 2, pr & 3, fr, fq, one); }
        }
        uint4 mo0 = asu4(P.o[0]), mo1 = asu4(P.o[1]), cc0 = asu4(P.cc[0]), cc1 = asu4(P.cc[1]);
        lds_barrier();
        ml_prefetch(p, P, MO, b, c + 1 < 32 ? c + 1 : 31);
        {
            f32x4 a = nacc * decay;
#pragma unroll
            for (int s2 = 0; s2 < 2; ++s2) a = mfma16(ld8(kTs + (16 * w + fr) * 144 + (s2 * 4 + fq) * 16), ones, a);
            nacc = a;
            if (fr == 0) *(f32x4*)(n_s + 16 * w + 4 * fq) = a;
        }
        {
            bf16x8 vf[2];
#pragma unroll
            for (int s2 = 0; s2 < 2; ++s2) vf[s2] = ld8(vTs + (16 * w + fr) * 144 + (s2 * 4 + fq) * 16);
#pragma unroll
            for (int i = 0; i < 8; ++i) {
                f32x4 a = st[i] * decay;
#pragma unroll
                for (int s2 = 0; s2 < 2; ++s2) a = mfma16(ld8(kTs + (16 * i + fr) * 144 + (s2 * 4 + fq) * 16), vf[s2], a);
                st[i] = a;
            }
        }
        lds_barrier();
        {
            const int l = tid >> 3, part = tid & 7;
            const uint4 a0 = *(const uint4*)(qs + l * 272 + part * 32), a1 = *(const uint4*)(qs + l * 272 + part * 32 + 16);
            const unsigned aw[8] = {a0.x, a0.y, a0.z, a0.w, a1.x, a1.y, a1.z, a1.w};
            const float* nn = n_s + 16 * part;
            float s = 0.f;
#pragma unroll
            for (int e = 0; e < 8; ++e) s += bflo(aw[e]) * nn[2 * e] + bfhi(aw[e]) * nn[2 * e + 1];
            s = grp8_sum(s);
            if (part == 0) den_s[l] = fmaxf(fabsf(s), emn);
        }
        lds_barrier();
        {
            bf16x8 sp[4];
#pragma unroll
            for (int s = 0; s < 4; ++s) sp[s] = state_pack(st[2 * s], st[2 * s + 1]);
#pragma unroll
            for (int i = 0; i < 4; ++i) {
                f32x4 a = (f32x4){0.f, 0.f, 0.f, 0.f};
                const char* qrow = qs + (16 * i + fr) * 272;
#pragma unroll
                for (int s = 0; s < 4; ++s) {
                    const uint2 lo = *(const uint2*)(qrow + (32 * s + 4 * fq) * 2), hi = *(const uint2*)(qrow + (32 * s + 16 + 4 * fq) * 2);
                    a = mfma16(sp[s], mk8(lo, hi), a);
                }
                const float rd = 1.f / den_s[16 * i + fr];
                *(uint2*)(Os + (16 * i + fr) * 272 + (16 * w + 4 * fq) * 2) = make_uint2(pk2(a[0] * rd, a[1] * rd), pk2(a[2] * rd, a[3] * rd));
            }
        }
        lds_barrier();
        pin_u4(mo0); pin_u4(mo1); pin_u4(cc0); pin_u4(cc1);
        {
            const int l = tid >> 3, part = tid & 7;
            const uint4 o0 = *(const uint4*)(Os + l * 272 + part * 32), o1 = *(const uint4*)(Os + l * 272 + part * 32 + 16);
            const unsigned ow[8] = {o0.x, o0.y, o0.z, o0.w, o1.x, o1.y, o1.z, o1.w};
            const unsigned gw[8] = {mo0.x, mo0.y, mo0.z, mo0.w, mo1.x, mo1.y, mo1.z, mo1.w}, cw[8] = {cc0.x, cc0.y, cc0.z, cc0.w, cc1.x, cc1.y, cc1.z, cc1.w};
            float x[16], s = 0.f;
#pragma unroll
            for (int e = 0; e < 8; ++e) { x[2 * e] = bflo(ow[e]); x[2 * e + 1] = bfhi(ow[e]); s += x[2 * e] + x[2 * e + 1]; }
            const float mu = grp8_sum(s) * (1.f / 128.f);
            float q = 0.f;
#pragma unroll
            for (int e = 0; e < 16; ++e) { x[e] -= mu; q += x[e] * x[e]; }
            const float rstd = rsqrtf(grp8_sum(q) * (1.f / 128.f) + EPSN);
            const float* gn = gn_s + 16 * part;
            const float* sk = sk_s + 16 * part;
            unsigned yo[8];
#pragma unroll
            for (int e = 0; e < 8; ++e) {
                const float ya = sigmoidf_(bflo(gw[e])) * (x[2 * e] * rstd * gn[2 * e] + sk[2 * e] * bflo(cw[e]));
                const float yb_ = sigmoidf_(bfhi(gw[e])) * (x[2 * e + 1] * rstd * gn[2 * e + 1] + sk[2 * e + 1] * bfhi(cw[e]));
                yo[e] = pk2(ya, yb_);
            }
            ml_retire(P);
            uint4* yp = (uint4*)(p.yb + (size_t)(t0 + l) * 1024 + 512 + h * 128 + 16 * part);
            yp[0] = make_uint4(yo[0], yo[1], yo[2], yo[3]);
            yp[1] = make_uint4(yo[4], yo[5], yo[6], yo[7]);
        }
    }
}
DEVI void st_recur(const Params& p, char* smem) {
    if (blockIdx.x >= 128 || gridDim.x <= 128) {
        const int bid = gridDim.x > 128 ? (int)blockIdx.x - 128 : (int)blockIdx.x, nb = gridDim.x > 128 ? (int)gridDim.x - 128 : (int)gridDim.x;
        st_prep_w2(p, smem, bid, nb);
        st_prep_wsub(p, smem, bid, nb);
        st_prep_tables(p, bid, nb);
        if (gridDim.x > 128) return;
    }
    for (int bi = blockIdx.x; bi < 128; bi += gridDim.x) {
        const int kind = bi & 1, h = (bi >> 1) & 3, b = bi >> 3;
        if (kind == 0) ret_block(p, smem, b, h);
        else mlstm_block(p, smem, b, h);
        __syncthreads();
    }
}

DEVI void st_norm2(const Params& p) {
    const int lane = stid() & 63, wid = stid() >> 6;
    for (int t = blockIdx.x * NW + wid; t < T_TOK; t += gridDim.x * NW) {
        float xv[16];
        float ss = 0.f;
        const uint4* xp = (const uint4*)(p.x1b + (size_t)t * 1024 + lane * 16);
        const uint4 a0 = xp[0], a1 = xp[1];
        const unsigned aw[8] = {a0.x, a0.y, a0.z, a0.w, a1.x, a1.y, a1.z, a1.w};
#pragma unroll
        for (int e = 0; e < 8; ++e) { xv[2 * e] = bflo(aw[e]); xv[2 * e + 1] = bfhi(aw[e]); ss += xv[2 * e] * xv[2 * e] + xv[2 * e + 1] * xv[2 * e + 1]; }
        ss = wave_sum(ss);
        const float rs = rsqrtf(ss * (1.f / 1024.f) + EPSN);
        float am = 0.f;
#pragma unroll
        for (int i = 0; i < 4; ++i) {
            const float4 g = *(const float4*)(p.norm2_g + lane * 16 + i * 4);
            xv[4 * i] *= rs * g.x; xv[4 * i + 1] *= rs * g.y; xv[4 * i + 2] *= rs * g.z; xv[4 * i + 3] *= rs * g.w;
        }
#pragma unroll
        for (int c = 0; c < 16; ++c) am = fmaxf(am, fabsf(xv[c]));
        am = wave_max(am);
        const float inv = am > 0.f ? 127.f / am : 0.f;
        unsigned w[4];
#pragma unroll
        for (int i = 0; i < 4; ++i) {
            const int q0 = (int)rintf(xv[4 * i] * inv), q1 = (int)rintf(xv[4 * i + 1] * inv), q2 = (int)rintf(xv[4 * i + 2] * inv), q3 = (int)rintf(xv[4 * i + 3] * inv);
            w[i] = (unsigned)(q0 & 255) | ((unsigned)(q1 & 255) << 8) | ((unsigned)(q2 & 255) << 16) | ((unsigned)(q3 & 255) << 24);
        }
        *(uint4*)(p.xq + (size_t)t * 1024 + lane * 16) = make_uint4(w[0], w[1], w[2], w[3]);
        if (lane == 0) { p.rs2[t] = rs; p.xsc[t] = am > 0.f ? am * (1.f / 127.f) : 1.f; }
    }
}

DEVI int f2key(float f) { const int b = __float_as_int(f); return b ^ ((b >> 31) & 0x7fffffff); }
DEVI float key2f(int k) { return __int_as_float(k ^ ((k >> 31) & 0x7fffffff)); }
template <int N> DEVI void bsort_desc(int (&v)[N]) {
#pragma unroll
    for (int k = 2; k <= N; k <<= 1)
#pragma unroll
        for (int j = k >> 1; j > 0; j >>= 1)
#pragma unroll
            for (int i = 0; i < N; ++i) {
                const int l = i ^ j;
                if (l > i) {
                    const int a = v[i], b = v[l];
                    const int mx = a > b ? a : b, mn = a > b ? b : a;
                    if ((i & k) == 0) { v[i] = mx; v[l] = mn; } else { v[i] = mn; v[l] = mx; }
                }
            }
}
template <int N> DEVI void bmerge_desc(int (&v)[N]) {
#pragma unroll
    for (int j = N >> 1; j > 0; j >>= 1)
#pragma unroll
        for (int i = 0; i < N; ++i) {
            const int l = i ^ j;
            if (l > i) { const int a = v[i], b = v[l]; v[i] = a > b ? a : b; v[l] = a > b ? b : a; }
        }
}
DEVI void xmerge16(int (&v)[16], int mask) {
    int o[16];
#pragma unroll
    for (int i = 0; i < 16; ++i) o[i] = __shfl_xor(v[15 - i], mask);
#pragma unroll
    for (int i = 0; i < 16; ++i) v[i] = v[i] > o[i] ? v[i] : o[i];
    bmerge_desc<16>(v);
}
__device__ const unsigned char cand_tab[52] = {
    0x00, 0x01, 0x02, 0x03, 0x04, 0x05, 0x06, 0x07, 0x08, 0x09, 0x0a, 0x0b, 0x0c, 0x0d, 0x0e, 0x0f,
    0x10, 0x11, 0x12, 0x13, 0x14, 0x15, 0x16, 0x17, 0x20, 0x21, 0x22, 0x23, 0x24, 0x30, 0x31, 0x32, 0x33,
    0x40, 0x41, 0x42, 0x50, 0x51, 0x60, 0x61, 0x70, 0x71, 0x80, 0x90, 0xa0, 0xb0, 0xc0, 0xd0, 0xe0, 0xf0, 0xff, 0xff};
constexpr int H_A = 256 * 64, H_B = 256 * 64, H_STAGE = H_A + H_B;
constexpr int H_LIST = 3 * H_STAGE;
DEVI void glds16(const void* g, char* l) {
    __builtin_amdgcn_global_load_lds((const __attribute__((address_space(1))) unsigned*)g, (__attribute__((address_space(3))) unsigned*)l, 16, 0, 0);
}
DEVI void gemm3_topk_tile(const Params& p, int m0, int h, char* smem) {
    const int tid = stid(), lane = tid & 63, w = tid >> 6, wt = w >> 1, wp = w & 1, fr = lane & 15, fq = lane >> 4;
    f32x4 acc[4][8];
#pragma unroll
    for (int i = 0; i < 4; ++i)
#pragma unroll
        for (int j = 0; j < 8; ++j) acc[i][j] = (f32x4){0.f, 0.f, 0.f, 0.f};
    const int r16 = lane >> 2, csrc = (lane & 3) ^ ((r16 >> 2) & 3);
    const bf16_t* srcA = p.x1b + (size_t)(m0 + w * 32 + r16) * 1024 + csrc * 8;
    const bf16_t* srcB = p.Wsubt + ((size_t)h * 256 + w * 32 + r16) * 1024 + csrc * 8;
    char* dstA = smem + (w * 32) * 64 + lane * 16;
    char* dstB = smem + H_A + (w * 32) * 64 + lane * 16;
    auto issue = [&](int kt, int buf) {
#pragma unroll
        for (int q = 0; q < 2; ++q) glds16(srcA + (size_t)q * 16 * 1024 + kt * 32, dstA + buf * H_STAGE + q * 1024);
#pragma unroll
        for (int q = 0; q < 2; ++q) glds16(srcB + (size_t)q * 16 * 1024 + kt * 32, dstB + buf * H_STAGE + q * 1024);
    };
    const int rdoff = fr * 64 + ((fq ^ ((fr >> 2) & 3)) * 16);
    issue(0, 0);
    issue(1, 1);
    asm volatile("s_waitcnt vmcnt(4)" ::: "memory");
    __builtin_amdgcn_s_barrier();
    int buf = 0;
#pragma unroll 1
    for (int kt = 0; kt < 32; ++kt) {
        const int b2 = buf >= 1 ? buf - 1 : 2;
        if (kt + 2 < 32) issue(kt + 2, b2);
        const char* As = smem + buf * H_STAGE + (wt * 64) * 64 + rdoff;
        const char* Bs = smem + buf * H_STAGE + H_A + (wp * 128) * 64 + rdoff;
        bf16x8 a[4];
#pragma unroll
        for (int i = 0; i < 4; ++i) a[i] = ld8(As + (16 * i) * 64);
#pragma unroll
        for (int jg = 0; jg < 2; ++jg) {
            bf16x8 b[4];
#pragma unroll
            for (int j = 0; j < 4; ++j) b[j] = ld8(Bs + (16 * (4 * jg + j)) * 64);
#pragma unroll
            for (int i = 0; i < 4; ++i)
#pragma unroll
                for (int j = 0; j < 4; ++j) acc[i][4 * jg + j] = mfma16(b[j], a[i], acc[i][4 * jg + j]);
        }
        if (kt + 2 < 32) asm volatile("s_waitcnt vmcnt(4)" ::: "memory");
        else asm volatile("s_waitcnt vmcnt(0)" ::: "memory");
        __builtin_amdgcn_s_barrier();
        buf = buf == 2 ? 0 : buf + 1;
    }
    int* LX = (int*)(smem + H_LIST);
#pragma unroll
    for (int i = 0; i < 4; ++i) {
        const int tl = 64 * wt + 16 * i + fr;
        const float rs = p.rs2[m0 + tl];
        int ka[16], kb[16];
#pragma unroll
        for (int jj = 0; jj < 4; ++jj)
#pragma unroll
            for (int r = 0; r < 4; ++r) {
                ka[jj * 4 + r] = (f2key(acc[i][jj][r] * rs) & ~127) | (16 * jj + 4 * fq + r);
                kb[jj * 4 + r] = (f2key(acc[i][4 + jj][r] * rs) & ~127) | (16 * (jj + 4) + 4 * fq + r);
            }
        bsort_desc<16>(ka);
        bsort_desc<16>(kb);
#pragma unroll
        for (int q = 0; q < 16; ++q) ka[q] = ka[q] > kb[15 - q] ? ka[q] : kb[15 - q];
        bmerge_desc<16>(ka);
        xmerge16(ka, 16);
        xmerge16(ka, 32);
        const int k0 = fq == 0 ? ka[0] : fq == 1 ? ka[4] : fq == 2 ? ka[8] : ka[12];
        const int k1 = fq == 0 ? ka[1] : fq == 1 ? ka[5] : fq == 2 ? ka[9] : ka[13];
        const int k2 = fq == 0 ? ka[2] : fq == 1 ? ka[6] : fq == 2 ? ka[10] : ka[14];
        const int k3 = fq == 0 ? ka[3] : fq == 1 ? ka[7] : fq == 2 ? ka[11] : ka[15];
        *(int4*)(LX + tl * 32 + wp * 16 + 4 * fq) = make_int4(k0, k1, k2, k3);
    }
    __syncthreads();
#pragma unroll
    for (int i2 = 0; i2 < 2; ++i2) {
        const int tl = 32 * w + 16 * i2 + fr, t = m0 + tl;
        const int* L = LX + tl * 32;
        const unsigned long long clo = fq == 0 ? 0x0706050403020100ull : fq == 1 ? 0x14131211100f0e0dull : fq == 2 ? 0x4033323130242322ull : 0xc0b0a09080717061ull;
        const unsigned long long chi = fq == 0 ? 0x0c0b0a0908ull : fq == 1 ? 0x2120171615ull : fq == 2 ? 0x6051504241ull : 0xfffff0e0d0ull;
        int c[16];
#pragma unroll
        for (int s = 0; s < 13; ++s) {
            const int ab = (int)((s < 8 ? (clo >> (8 * s)) : (chi >> (8 * (s - 8)))) & 0xffull);
            const int k1 = L[ab >> 4], k2 = L[16 + (ab & 15)];
            const float v = key2f(k1 & ~127) + key2f(k2 & ~127);
            c[s] = (f2key(v) & ~0x3fff) | ((k1 & 127) << 7) | (k2 & 127);
        }
        c[13] = c[14] = c[15] = (int)0x80000000;
        bsort_desc<16>(c);
        xmerge16(c, 16);
        xmerge16(c, 32);
        const float vmax = key2f(c[0] & ~0x3fff);
        float e[16], sum = 0.f;
#pragma unroll
        for (int q = 0; q < 16; ++q) { e[q] = __expf(key2f(c[q] & ~0x3fff) - vmax); sum += e[q]; }
        const float inv = 1.f / sum;
        int ce[4]; float ge[4];
#pragma unroll
        for (int q = 0; q < 4; ++q) {
            const int cq = fq == 0 ? c[q] : fq == 1 ? c[4 + q] : fq == 2 ? c[8 + q] : c[12 + q];
            const float eq = fq == 0 ? e[q] : fq == 1 ? e[4 + q] : fq == 2 ? e[8 + q] : e[12 + q];
            ce[q] = ((cq >> 7) & 127) * 128 + (cq & 127);
            ge[q] = eq * inv;
        }
        *(uint2*)(p.eperm + (size_t)t * 128 + h * 16 + 4 * fq) = make_uint2((unsigned)ce[0] | ((unsigned)ce[1] << 16), (unsigned)ce[2] | ((unsigned)ce[3] << 16));
        *(float4*)(p.gate + (size_t)t * 128 + h * 16 + 4 * fq) = make_float4(ge[0], ge[1], ge[2], ge[3]);
    }
    __syncthreads();
}
DEVI void st_gemm3_topk(const Params& p, char* smem) {
    for (int it = blockIdx.x; it < 128 * 8; it += gridDim.x) gemm3_topk_tile(p, (it >> 3) * 256, it & 7, smem);
}

#define XB_TMO      128
#define XB_XCNT(j)  (256  + 64 * (j))
#define XB_XSUB(j)  (1280 + 64 * (j))
#define XB_XGEN(j)  (2304 + 64 * (j))
#define XB_TOP      3328
#define XB_TOPGEN   3392
#define XCD_BAR_WORDS 3456
#define XB_SPIN_CAP (1u << 20)
#define LAS __attribute__((address_space(3)))
DEVI unsigned xb_ld(unsigned* p) { return __hip_atomic_load(p, __ATOMIC_RELAXED, __HIP_MEMORY_SCOPE_AGENT); }
DEVI unsigned xb_add(unsigned* p, unsigned v) { return __hip_atomic_fetch_add(p, v, __ATOMIC_RELAXED, __HIP_MEMORY_SCOPE_AGENT); }
DEVI unsigned xb_xcc_id() { return (unsigned)__builtin_amdgcn_s_getreg((3 << 11) | 20) & 0xFu; }
#define XB_SPIN(cond, bar) do { unsigned _sp = 0; while (cond) { __builtin_amdgcn_s_sleep(1); \
    if ((++_sp & 255u) == 0u) { if (xb_ld(&(bar)[XB_TMO])) break; if (_sp > XB_SPIN_CAP) { atomicAdd(&(bar)[XB_TMO], 1u); break; } } } } while (0)
struct XcdBarrier { unsigned* bar; unsigned x; volatile LAS unsigned* st; };
DEVI XcdBarrier xcd_barrier_post(unsigned* bar, volatile LAS unsigned* st) {
    XcdBarrier b; b.bar = bar; b.x = xb_xcc_id(); b.st = st;
    if (stid() == 0) (void)xb_add(&bar[XB_XCNT(b.x)], 1u);
    return b;
}
DEVI void xcd_barrier_complete(unsigned* bar, unsigned x, unsigned& nloc, unsigned& nx) {
    const unsigned G = gridDim.x * gridDim.y * gridDim.z;
    unsigned sum, cnt, mine, sp = 0u;
    for (;;) {
        sum = 0u; cnt = 0u; mine = 0u;
#pragma unroll
        for (unsigned j = 0; j < 16; ++j) { const unsigned c = xb_ld(&bar[XB_XCNT(j)]); sum += c; cnt += (c > 0u) ? 1u : 0u; mine = (j == x) ? c : mine; }
        if (sum == G) break;
        __builtin_amdgcn_s_sleep(1);
        if ((++sp & 255u) == 0u) { if (xb_ld(&bar[XB_TMO])) break; if (sp > XB_SPIN_CAP) { atomicAdd(&bar[XB_TMO], 1u); break; } }
    }
    nloc = mine > 0u ? mine : 1u; nx = cnt > 0u ? cnt : 1u;
}
DEVI void xcd_barrier(const XcdBarrier& b) {
    asm volatile("s_waitcnt vmcnt(0)" ::: "memory");
    __syncthreads();
    if (stid() == 0) {
        unsigned* bar = b.bar;
        __builtin_amdgcn_s_waitcnt(0);
        unsigned nloc = b.st[0], nx = b.st[1];
        if (nloc == 0u) { xcd_barrier_complete(bar, b.x, nloc, nx); b.st[0] = nloc; b.st[1] = nx; }
        const unsigned old = xb_add(&bar[XB_XSUB(b.x)], 1u);
        const unsigned gen = old / nloc;
        if (old + 1u == (gen + 1u) * nloc) {
            __builtin_amdgcn_fence(__ATOMIC_RELEASE, "agent");
            asm volatile("s_waitcnt vmcnt(0)" ::: "memory");
            const unsigned og = xb_add(&bar[XB_TOP], 1u);
            const unsigned tg = og / nx;
            if (og + 1u == (tg + 1u) * nx) xb_add(&bar[XB_TOPGEN], 1u);
            else XB_SPIN(xb_ld(&bar[XB_TOPGEN]) == tg, bar);
            __builtin_amdgcn_fence(__ATOMIC_ACQUIRE, "agent");
            xb_add(&bar[XB_XGEN(b.x)], 1u);
            asm volatile("s_waitcnt vmcnt(0)" ::: "memory");
        } else {
            XB_SPIN(xb_ld(&bar[XB_XGEN(b.x)]) == gen, bar);
            __builtin_amdgcn_fence(__ATOMIC_ACQUIRE, "agent");
            asm volatile("s_waitcnt vmcnt(0)" ::: "memory");
        }
    }
    __syncthreads();
}

#define CTR_A(x) (XCD_BAR_WORDS + 64 * (x))
#define CTR_B(x) (XCD_BAR_WORDS + 512 + 64 * (x))
#define CTL_WORDS (XCD_BAR_WORDS + 1024)
typedef float f32x2 __attribute__((ext_vector_type(2)));
DEVI float ub(unsigned w, int n) { return (float)((w >> (8 * n)) & 0xffu); }
DEVI float gelu_erf(float u) { return 0.5f * u * (1.f + erff(u * 0.70710678118654752f)); }
struct ExpMeta { uint4 e[2]; uint4 xa; float sc; };
struct ExpRows { uint4 r[16]; unsigned x1; };

template <int PHASE> DEVI void exp_load_meta(const Params& p, ExpMeta& m, int t, int x, int lane) {
    const uint4* ep = (const uint4*)(p.eperm + (size_t)t * 128 + (lane >> 3) * 16);
    m.e[0] = ep[0];
    m.e[1] = ep[1];
    if (PHASE == 0) m.xa = *(const uint4*)(p.xq + (size_t)t * 1024 + 128 * x + 16 * (lane & 7));
    else { m.xa = *(const uint4*)(p.aq + (size_t)t * 128 + (lane >> 3) * 16); m.sc = p.asc[t]; }
}
template <int PHASE> DEVI void exp_issue(const Params& p, const ExpMeta& m, ExpRows& R, int t, int x, int lane) {
    const unsigned char* base = (PHASE == 0 ? p.down_q : p.up_q) + (size_t)x * (16384 * 128) + (lane & 7) * 16;
    const unsigned ew[8] = {m.e[0].x, m.e[0].y, m.e[0].z, m.e[0].w, m.e[1].x, m.e[1].y, m.e[1].z, m.e[1].w};
#pragma unroll
    for (int j = 0; j < 16; ++j) {
        const unsigned ek = (j & 1) ? (ew[j >> 1] >> 16) : (ew[j >> 1] & 0xffffu);
        R.r[j] = *(const uint4*)(base + (size_t)ek * 128);
    }
    if (PHASE == 1) {
        const int col = 128 * x + 16 * (lane & 7) + ((lane & 32) ? 8 : 0) + ((lane & 16) ? 4 : 0) + ((lane & 8) ? 2 : 0);
        R.x1 = *(const unsigned*)(p.x1b + (size_t)t * 1024 + col);
    }
}
DEVI void expA_compute(const Params& p, const ExpMeta& m, const ExpRows& R, int t, int x, int lane) {
    const bool b2 = lane & 4, b1 = lane & 2, b0 = lane & 1;
    int ps[16];
#pragma unroll
    for (int j = 0; j < 16; ++j)
        ps[j] = __builtin_amdgcn_sdot4((int)R.r[j].x, (int)m.xa.x, __builtin_amdgcn_sdot4((int)R.r[j].y, (int)m.xa.y,
                __builtin_amdgcn_sdot4((int)R.r[j].z, (int)m.xa.z, __builtin_amdgcn_sdot4((int)R.r[j].w, (int)m.xa.w, 0, false), false), false), false);
    int q8[8], q4[4], q2[2];
#pragma unroll
    for (int j = 0; j < 8; ++j) { const int snd = b2 ? ps[j] : ps[j + 8], kp = b2 ? ps[j + 8] : ps[j]; q8[j] = kp + __shfl_xor(snd, 4); }
#pragma unroll
    for (int j = 0; j < 4; ++j) { const int snd = b1 ? q8[j] : q8[j + 4], kp = b1 ? q8[j + 4] : q8[j]; q4[j] = kp + __shfl_xor(snd, 2); }
#pragma unroll
    for (int j = 0; j < 2; ++j) { const int snd = b0 ? q4[j] : q4[j + 2], kp = b0 ? q4[j + 2] : q4[j]; q2[j] = kp + __shfl_xor(snd, 1); }
    *(int2*)(p.part + ((size_t)x * T_TOK + t) * 128 + 2 * lane) = make_int2(q2[0], q2[1]);
}
DEVI void expB_compute(const Params& p, const ExpMeta& m, const ExpRows& R, int t, int x, int lane) {
    const bool b5 = lane & 32, b4 = lane & 16, b3 = lane & 8;
    const unsigned pa[4] = {m.xa.x, m.xa.y, m.xa.z, m.xa.w};
    int acc[16];
#pragma unroll
    for (int c = 0; c < 16; ++c) acc[c] = 0;
#pragma unroll
    for (int g = 0; g < 4; ++g) {
        const unsigned r0[4] = {R.r[4 * g].x, R.r[4 * g].y, R.r[4 * g].z, R.r[4 * g].w};
        const unsigned r1[4] = {R.r[4 * g + 1].x, R.r[4 * g + 1].y, R.r[4 * g + 1].z, R.r[4 * g + 1].w};
        const unsigned r2[4] = {R.r[4 * g + 2].x, R.r[4 * g + 2].y, R.r[4 * g + 2].z, R.r[4 * g + 2].w};
        const unsigned r3[4] = {R.r[4 * g + 3].x, R.r[4 * g + 3].y, R.r[4 * g + 3].z, R.r[4 * g + 3].w};
#pragma unroll
        for (int i = 0; i < 4; ++i) {
            const unsigned t0 = __builtin_amdgcn_perm(r1[i], r0[i], 0x05010400u), t1 = __builtin_amdgcn_perm(r1[i], r0[i], 0x07030602u);
            const unsigned t2 = __builtin_amdgcn_perm(r3[i], r2[i], 0x05010400u), t3 = __builtin_amdgcn_perm(r3[i], r2[i], 0x07030602u);
            const unsigned o0 = __builtin_amdgcn_perm(t2, t0, 0x05040100u), o1 = __builtin_amdgcn_perm(t2, t0, 0x07060302u);
            const unsigned o2 = __builtin_amdgcn_perm(t3, t1, 0x05040100u), o3 = __builtin_amdgcn_perm(t3, t1, 0x07060302u);
            acc[4 * i + 0] = __builtin_amdgcn_sdot4((int)o0, (int)pa[g], acc[4 * i + 0], false);
            acc[4 * i + 1] = __builtin_amdgcn_sdot4((int)o1, (int)pa[g], acc[4 * i + 1], false);
            acc[4 * i + 2] = __builtin_amdgcn_sdot4((int)o2, (int)pa[g], acc[4 * i + 2], false);
            acc[4 * i + 3] = __builtin_amdgcn_sdot4((int)o3, (int)pa[g], acc[4 * i + 3], false);
        }
    }
    int q8[8], q4[4], q2[2];
#pragma unroll
    for (int j = 0; j < 8; ++j) { const int snd = b5 ? acc[j] : acc[j + 8], kp = b5 ? acc[j + 8] : acc[j]; q8[j] = kp + __shfl_xor(snd, 32); }
#pragma unroll
    for (int j = 0; j < 4; ++j) { const int snd = b4 ? q8[j] : q8[j + 4], kp = b4 ? q8[j + 4] : q8[j]; q4[j] = kp + __shfl_xor(snd, 16); }
#pragma unroll
    for (int j = 0; j < 2; ++j) { const int snd = b3 ? q4[j] : q4[j + 2], kp = b3 ? q4[j + 2] : q4[j]; q2[j] = kp + __shfl_xor(snd, 8); }
    const int col = 128 * x + 16 * (lane & 7) + (b5 ? 8 : 0) + (b4 ? 4 : 0) + (b3 ? 2 : 0);
    *(unsigned*)(p.proj + (size_t)t * 1024 + col) = pk2(bflo(R.x1) + (float)q2[0] * m.sc, bfhi(R.x1) + (float)q2[1] * m.sc);
}
template <int PHASE>
DEVI void exp_chunk(const Params& p, int tb, int x, int lane) {
    ExpMeta mA, mB, nA, nB;
    ExpRows rA, rB;
    exp_load_meta<PHASE>(p, mA, tb, x, lane);
    exp_load_meta<PHASE>(p, mB, tb + 1, x, lane);
    exp_issue<PHASE>(p, mA, rA, tb, x, lane);
    exp_issue<PHASE>(p, mB, rB, tb + 1, x, lane);
    exp_load_meta<PHASE>(p, nA, tb + 2, x, lane);
    exp_load_meta<PHASE>(p, nB, tb + 3, x, lane);
#pragma unroll 1
    for (int i = 0; i < 8; ++i) {
        const int tA = tb + 2 * i, tB = tA + 1;
        if (PHASE == 0) expA_compute(p, mA, rA, tA, x, lane); else expB_compute(p, mA, rA, tA, x, lane);
        if (i < 7) {
            mA = nA;
            exp_issue<PHASE>(p, mA, rA, tA + 2, x, lane);
            if (i < 6) exp_load_meta<PHASE>(p, nA, tA + 4, x, lane);
        }
        if (PHASE == 0) expA_compute(p, mB, rB, tB, x, lane); else expB_compute(p, mB, rB, tB, x, lane);
        if (i < 7) {
            mB = nB;
            exp_issue<PHASE>(p, mB, rB, tB + 2, x, lane);
            if (i < 6) exp_load_meta<PHASE>(p, nB, tB + 4, x, lane);
        }
    }
}
template <int PHASE>
DEVI void st_expAB(const Params& p, char* smem) {
    const int tid = stid(), lane = tid & 63, wid = tid >> 6;
    volatile int* cs = (volatile int*)smem;
    const unsigned myx = xb_xcc_id() & 7u;
    constexpr int NCH = T_TOK / (16 * NW);
    for (int si = 0; si < 8; ++si) {
        const int x = (int)((myx + si) & 7u);
        unsigned* ctr = &p.bar[PHASE == 0 ? CTR_A(x) : CTR_B(x)];
        if (tid == 0) cs[0] = (int)xb_add(ctr, 1u);
        __syncthreads();
        int chunk = cs[0];
        __syncthreads();
        while (chunk < NCH) {
            int nxt = 0;
            if (tid == 0) nxt = (int)xb_add(ctr, 1u);
            exp_chunk<PHASE>(p, chunk * (16 * NW) + wid * 16, x, lane);
            if (tid == 0) cs[0] = nxt;
            __syncthreads();
            chunk = cs[0];
            __syncthreads();
        }
    }
}
DEVI void st_expA2(const Params& p) {
    const int lane = stid() & 63, wid = stid() >> 6;
    for (int t = blockIdx.x * NW + wid; t < T_TOK; t += gridDim.x * NW) {
        int s0 = 0, s1 = 0;
#pragma unroll
        for (int x = 0; x < 8; ++x) { const int2 v = *(const int2*)(p.part + ((size_t)x * T_TOK + t) * 128 + 2 * lane); s0 += v.x; s1 += v.y; }
        const float xs = p.xsc[t];
        const unsigned ew = *(const unsigned*)(p.eperm + (size_t)t * 128 + 2 * lane);
        const int ea = (int)(ew & 0xffffu), eb = (int)(ew >> 16);
        const float2 g = *(const float2*)(p.gate + (size_t)t * 128 + 2 * lane);
        const float a0 = g.x * gelu_erf((float)s0 * xs * p.dscale[ea]) * p.uscale[ea];
        const float a1 = g.y * gelu_erf((float)s1 * xs * p.dscale[eb]) * p.uscale[eb];
        const float amax = wave_max(fmaxf(fabsf(a0), fabsf(a1)));
        const float inv = amax > 0.f ? 127.f / amax : 0.f;
        const unsigned q0 = (unsigned)((int)rintf(a0 * inv) & 255), q1 = (unsigned)((int)rintf(a1 * inv) & 255);
        *(unsigned short*)(p.aq + (size_t)t * 128 + 2 * lane) = (unsigned short)(q0 | (q1 << 8));
        if (lane == 0) p.asc[t] = amax * (1.f / 127.f);
    }
}
DEVI void st_expC(const Params& p) {
    const int lane = stid() & 63, wid = stid() >> 6;
    for (int t = blockIdx.x * NW + wid; t < T_TOK; t += gridDim.x * NW) {
        const uint2* row = (const uint2*)(p.proj + (size_t)t * 1024);
        float4 v[4];
        float ss = 0.f;
#pragma unroll
        for (int j = 0; j < 4; ++j) {
            const uint2 u = row[lane + 64 * j];
            v[j] = make_float4(bflo(u.x), bfhi(u.x), bflo(u.y), bfhi(u.y));
            ss += v[j].x * v[j].x + v[j].y * v[j].y + v[j].z * v[j].z + v[j].w * v[j].w;
        }
        ss = wave_sum(ss);
        const float rf = rsqrtf(ss * (1.f / 1024.f) + EPSN);
        float4* orow = (float4*)(p.out + (size_t)t * 1024);
#pragma unroll
        for (int j = 0; j < 4; ++j) {
            const float4 g = *(const float4*)(p.final_g + (lane + 64 * j) * 4);
            orow[lane + 64 * j] = make_float4(v[j].x * rf * g.x, v[j].y * rf * g.y, v[j].z * rf * g.z, v[j].w * rf * g.w);
        }
    }
}

constexpr int LDS_BYTES = 147456;
constexpr int LDS_BARW = LDS_BYTES - 16;
extern __shared__ __attribute__((aligned(16))) char smem_dyn[];
__global__ void __launch_bounds__(NTHR, 2) mega_fwd(Params p) {
    cg::grid_group grid = cg::this_grid();
    volatile LAS unsigned* bst = (volatile LAS unsigned*)(LAS char*)(smem_dyn + LDS_BARW);
    if (stid() < 4) bst[stid()] = 0u;
    __syncthreads();
    XcdBarrier bar = xcd_barrier_post(p.bar, bst);
    st_prep_misc(p);
    st_prep_w1(p, smem_dyn);
    st_prep_x(p, smem_dyn);
    if (p.pad_[0] == 0x7fffabcd) grid.sync();
    xcd_barrier(bar);
    st_gemm8<EpiProj8, PG8_ALIGN>(p.xb, p.W1t, NPJ, 1024, smem_dyn, EpiProj8{p.proj, p.rs1, p.rope_cos, p.rope_sin});
    xcd_barrier(bar);
    st_conv_qk(p, smem_dyn);
    xcd_barrier(bar);
    st_recur(p, smem_dyn);
    xcd_barrier(bar);
    st_gemm8<EpiX18, PG8_ALIGN>(p.yb, p.W2t, 1024, 1024, smem_dyn, EpiX18{p.x, p.x1b});
    xcd_barrier(bar);
    st_norm2(p);
    xcd_barrier(bar);
    st_gemm3_topk(p, smem_dyn);
    xcd_barrier(bar);
    st_expAB<0>(p, smem_dyn);
    xcd_barrier(bar);
    st_expA2(p);
    xcd_barrier(bar);
    st_expAB<1>(p, smem_dyn);
    xcd_barrier(bar);
    st_expC(p);
}

extern "C" void kernel_launch(void* const* d_in, const int* in_sizes, int n_in, void* d_out, int out_size, void* d_ws, size_t ws_size,
                              hipStream_t stream) {
    Params p{};
    const float* const* in = (const float* const*)d_in;
    p.x = in[0]; p.norm1_g = in[1]; p.w_in = in[2]; p.ret_norm_g = in[3]; p.m_conv_w = in[4]; p.m_conv_b = in[5]; p.m_wq = in[6]; p.m_wk = in[7];
    p.m_b_i = in[8]; p.m_b_f = in[9]; p.m_norm_g = in[10]; p.m_skip = in[11]; p.w_out = in[12]; p.norm2_g = in[13]; p.peer_wq = in[14];
    p.peer_keys = in[15]; p.peer_down = in[16]; p.peer_up = in[17]; p.final_g = in[18];
    p.out = (float*)d_out;
    char* ws = (char*)d_ws;
    size_t off = 0;
    auto take = [&](size_t bytes) { char* r = ws + off; off += (bytes + 255) & ~(size_t)255; return r; };
    p.proj = (bf16_t*)take((size_t)T_TOK * NPJ * 2);
    p.xb = (bf16_t*)take((size_t)T_TOK * 1024 * 2);
    p.yb = p.xb;
    p.gate = (float*)(ws + (size_t)T_TOK * 2048 * 4);
    p.mq = (bf16_t*)take((size_t)T_TOK * 512 * 2);
    p.mk = (bf16_t*)take((size_t)T_TOK * 512 * 2);
    p.x1b = p.mq;
    p.cbuf = (bf16_t*)take((size_t)T_TOK * 512 * 2);
    p.eperm = (unsigned short*)p.cbuf;
    p.down_q = (unsigned char*)take((size_t)16384 * 1024);
    p.up_q = (unsigned char*)take((size_t)16384 * 1024);
    p.dscale = (float*)take(16384 * 4);
    p.uscale = (float*)take(16384 * 4);
    p.bar = (unsigned*)take(CTL_WORDS * 4);
    p.xq = (unsigned char*)take((size_t)T_TOK * 1024);
    p.xsc = (float*)take(T_TOK * 4);
    p.asc = (float*)take(T_TOK * 4);
    p.aq = (unsigned char*)take((size_t)T_TOK * 128);
    p.part = (int*)(ws + (size_t)T_TOK * 1024 * 4);
    p.W1t = (bf16_t*)take((size_t)NPJ * 1024 * 2);
    p.W2t = (bf16_t*)take((size_t)1024 * 1024 * 2);
    p.Wsubt = (bf16_t*)take((size_t)2048 * 1024 * 2);
    p.Wqt = (bf16_t*)take(4 * 128 * 128 * 2);
    p.Wkt = (bf16_t*)take(4 * 128 * 128 * 2);
    p.rs1 = (float*)take(T_TOK * 4);
    p.rs2 = (float*)take(T_TOK * 4);
    p.ipre = (float*)take(T_TOK * 4 * 4);
    p.logf = (float*)take(T_TOK * 4 * 4);
    p.rope_cos = (float*)take(2048 * 64 * 4);
    p.rope_sin = (float*)take(2048 * 64 * 4);
    if (off > ws_size) { fprintf(stderr, "kernel_launch: workspace too small (%zu > %zu)\n", off, ws_size); return; }

    static int grid_blocks = 0;
    if (!grid_blocks) {
        int dev = 0, cus = 0, per_cu = 0;
        (void)hipGetDevice(&dev);
        (void)hipDeviceGetAttribute(&cus, hipDeviceAttributeMultiprocessorCount, dev);
        (void)hipFuncSetAttribute((const void*)mega_fwd, hipFuncAttributeMaxDynamicSharedMemorySize, LDS_BYTES);
        (void)hipOccupancyMaxActiveBlocksPerMultiprocessor(&per_cu, (const void*)mega_fwd, NTHR, LDS_BYTES);
        if (per_cu > 1) per_cu = 1;
        if (per_cu < 1) per_cu = 1;
        grid_blocks = cus * per_cu;
    }
    (void)hipMemsetAsync(p.bar, 0, CTL_WORDS * 4, stream);
    void* args[] = {&p};
    hipError_t e = hipLaunchCooperativeKernel((const void*)mega_fwd, dim3(grid_blocks), dim3(NTHR), args, LDS_BYTES, stream);
    if (e != hipSuccess) fprintf(stderr, "cooperative launch failed: %s (grid %d)\n", hipGetErrorString(e), grid_blocks);
}
```

```cpp
#include <hip/hip_runtime.h>
#include <hip/hip_cooperative_groups.h>
#include <stdint.h>
#include <cstdio>
namespace cg = cooperative_groups;

typedef unsigned short bf16_t;
typedef short bf16x8 __attribute__((ext_vector_type(8)));
typedef float f32x4 __attribute__((ext_vector_type(4)));

#define DEVI __device__ __forceinline__
__device__ __forceinline__ int stid() { int t = (int)threadIdx.x; asm volatile("" : "+v"(t)); return t; }

constexpr int T_TOK = 32768, DM = 1024, NPJ = 3584, DIN = 3592;
constexpr int NTHR = 512, NW = 8;
constexpr float EPSN = 1e-6f;

struct Params {
    const float *x, *norm1_g, *w_in, *ret_norm_g, *m_conv_w, *m_conv_b, *m_wq, *m_wk, *m_b_i, *m_b_f, *m_norm_g, *m_skip, *w_out,
        *norm2_g, *peer_wq, *peer_keys, *peer_down, *peer_up, *final_g;
    float* out;
    bf16_t *proj, *xb, *yb, *mq, *mk, *x1b, *cbuf, *W1t, *W2t, *Wsubt, *Wqt, *Wkt;
    unsigned char *down_q, *up_q;
    float *dscale, *uscale, *xsc, *asc;
    unsigned short* eperm;
    unsigned char* aq;
    short* part;
    unsigned char* xq;
    unsigned* bar;
    float *rs1, *rs2, *ipre, *logf, *rope_cos, *rope_sin, *gate;
    int pad_[2];
};

DEVI unsigned f2bf_bits(float f) { unsigned u = __float_as_uint(f); return (u + 0x7fffu + ((u >> 16) & 1u)) >> 16; }
DEVI bf16_t f2bf(float f) { return __builtin_bit_cast(bf16_t, (__bf16)f); }
typedef __bf16 bf16x2_t __attribute__((ext_vector_type(2)));
DEVI unsigned pk2(float lo, float hi) { bf16x2_t v = {(__bf16)lo, (__bf16)hi}; return __builtin_bit_cast(unsigned, v); }
DEVI float bflo(unsigned w) { return __uint_as_float(w << 16); }
DEVI float bfhi(unsigned w) { return __uint_as_float(w & 0xffff0000u); }
DEVI float bf2f(bf16_t h) { return __uint_as_float(((unsigned)h) << 16); }
DEVI float wave_sum(float v) {
#pragma unroll
    for (int o = 32; o; o >>= 1) v += __shfl_xor(v, o);
    return v;
}
DEVI float wave_max(float v) {
#pragma unroll
    for (int o = 32; o; o >>= 1) v = fmaxf(v, __shfl_xor(v, o));
    return v;
}
DEVI f32x4 mfma16(bf16x8 a, bf16x8 b, f32x4 c) { return __builtin_amdgcn_mfma_f32_16x16x32_bf16(a, b, c, 0, 0, 0); }
DEVI bf16x8 ld8(const char* p) { return *reinterpret_cast<const bf16x8*>(p); }
DEVI bf16x8 mk8(uint2 lo, uint2 hi) {
    union { uint4 u; bf16x8 v; } x;
    x.u = make_uint4(lo.x, lo.y, hi.x, hi.y);
    return x.v;
}
DEVI float sigmoidf_(float z) { return 1.f / (1.f + __expf(-z)); }

DEVI void st_prep_misc(const Params& p) {
    const int gtid = blockIdx.x * NTHR + stid(), gsz = gridDim.x * NTHR;
    for (int i = gtid; i < 2048 * 64; i += gsz) {
        const int pos = i >> 6, j = i & 63;
        const float inv = powf(10000.f, -(float)j * (1.f / 64.f));
        const float ang = (float)pos * inv;
        float s, c;
        sincosf(ang, &s, &c);
        p.rope_cos[i] = c;
        p.rope_sin[i] = s;
    }
    for (int i = gtid; i < 4 * 128 * 128; i += gsz) {
        const int h = i >> 14, e = (i >> 7) & 127, d = i & 127;
        p.Wqt[i] = f2bf(p.m_wq[h * 16384 + d * 128 + e]);
        p.Wkt[i] = f2bf(p.m_wk[h * 16384 + d * 128 + e] * 0.08838834764831845f);
    }
}
DEVI void prep_table_row(const Params& p, int row, const float4 (&v)[4], int lane) {
    const bool up = row >= 16384;
    const int e = up ? row - 16384 : row;
    float am = 0.f;
#pragma unroll
    for (int i = 0; i < 4; ++i) am = fmaxf(am, fmaxf(fmaxf(fabsf(v[i].x), fabsf(v[i].y)), fmaxf(fabsf(v[i].z), fabsf(v[i].w))));
    am = wave_max(am);
    const float sc = am > 0.f ? am * (1.f / 127.f) : 1.f, inv = am > 0.f ? 127.f / am : 0.f;
    unsigned w[4];
#pragma unroll
    for (int i = 0; i < 4; ++i) {
        const int q0 = (int)rintf(v[i].x * inv), q1 = (int)rintf(v[i].y * inv), q2 = (int)rintf(v[i].z * inv), q3 = (int)rintf(v[i].w * inv);
        w[i] = (unsigned)(q0 & 255) | ((unsigned)(q1 & 255) << 8) | ((unsigned)(q2 & 255) << 16) | ((unsigned)(q3 & 255) << 24);
    }
    *(uint4*)((up ? p.up_q : p.down_q) + ((size_t)(lane >> 3) * 16384 + e) * 128 + (lane & 7) * 16) = make_uint4(w[0], w[1], w[2], w[3]);
    if (lane == 0) (up ? p.uscale : p.dscale)[e] = sc;
}
DEVI void st_prep_tables(const Params& p, int bid, int nb) {
    const int lane = stid() & 63, wid = stid() >> 6;
    for (int row = (bid * NW + wid) * 2; row < 32768; row += nb * NW * 2) {
        float4 va[4], vb[4];
        const float4* sa = (const float4*)((row >= 16384 ? p.peer_up + (size_t)(row - 16384) * 1024 : p.peer_down + (size_t)row * 1024) + lane * 16);
        const float4* sb = (const float4*)((row + 1 >= 16384 ? p.peer_up + (size_t)(row + 1 - 16384) * 1024 : p.peer_down + (size_t)(row + 1) * 1024) + lane * 16);
#pragma unroll
        for (int i = 0; i < 4; ++i) { va[i] = sa[i]; vb[i] = sb[i]; }
        prep_table_row(p, row, va, lane);
        prep_table_row(p, row + 1, vb, lane);
    }
}

DEVI void transpose_tile(const float* __restrict__ src, int ld, const float* __restrict__ scale, bf16_t* __restrict__ dst, int K, int k0, int n0,
                         float* tile, bool permqk = false) {
    const int tid = stid();
    {
        const int tx = tid & 63, ty = tid >> 6;
#pragma unroll
        for (int i = 0; i < 4; ++i) {
            const int k = k0 + ty + 8 * i;
            float v = src[(size_t)k * ld + n0 + tx];
            if (scale) v *= scale[k];
            tile[(ty + 8 * i) * 65 + tx] = v;
        }
    }
    __syncthreads();
    {
        const int n = tid >> 3, kq = tid & 7;
        const float a = tile[(4 * kq) * 65 + n], b = tile[(4 * kq + 1) * 65 + n], c = tile[(4 * kq + 2) * 65 + n], d = tile[(4 * kq + 3) * 65 + n];
        int nn = n0 + n;
        if (permqk && nn < 1024) { const int dd = nn & 127; nn = (nn & ~127) + (dd < 64 ? 2 * dd : 2 * (dd - 64) + 1); }
        *(uint2*)(dst + (size_t)nn * K + k0 + 4 * kq) = make_uint2(pk2(a, b), pk2(c, d));
    }
    __syncthreads();
}
DEVI void st_prep_w1(const Params& p, char* smem) {
    float* tile = (float*)smem;
    for (int it = blockIdx.x; it < 56 * 32; it += gridDim.x) transpose_tile(p.w_in, DIN, p.norm1_g, p.W1t, 1024, (it & 31) * 32, (it >> 5) * 64, tile, true);
}
DEVI void st_prep_w2(const Params& p, char* smem, int bid, int nb) {
    float* tile = (float*)smem;
    for (int it = bid; it < 16 * 32; it += nb) transpose_tile(p.w_out, 1024, nullptr, p.W2t, 1024, (it & 31) * 32, (it >> 5) * 64, tile);
}
DEVI void st_prep_wsub(const Params& p, char* smem, int bid, int nb) {
    float* wq_s = (float*)smem;
    float* key_s = wq_s + 32 * 132;
    const int tid = stid();
    for (int it = bid; it < 16 * 32 * 2; it += nb) {
        const int grp = it >> 6, kt = (it >> 1) & 31, nh = it & 1, k0 = kt * 32;
#pragma unroll
        for (int i = 0; i < 8; ++i) {
            const int idx = tid + 512 * i, r = idx >> 7, d = idx & 127;
            wq_s[r * 132 + d] = p.peer_wq[(size_t)(k0 + r) * 2048 + grp * 128 + d];
        }
#pragma unroll
        for (int i = 0; i < 16; ++i) {
            const int idx = tid + 512 * i, n = idx >> 7, d = idx & 127;
            key_s[n * 132 + d] = p.peer_keys[((size_t)grp * 128 + nh * 64 + n) * 128 + d];
        }
        __syncthreads();
        const int kl = tid & 15, ng = tid >> 4;
        float a00 = 0.f, a01 = 0.f, a10 = 0.f, a11 = 0.f;
#pragma unroll 8
        for (int d4 = 0; d4 < 32; ++d4) {
            const float4 w0 = *(const float4*)(wq_s + (2 * kl) * 132 + 4 * d4), w1 = *(const float4*)(wq_s + (2 * kl + 1) * 132 + 4 * d4);
            const float4 y0 = *(const float4*)(key_s + (2 * ng) * 132 + 4 * d4), y1 = *(const float4*)(key_s + (2 * ng + 1) * 132 + 4 * d4);
            a00 += w0.x * y0.x + w0.y * y0.y + w0.z * y0.z + w0.w * y0.w;
            a01 += w0.x * y1.x + w0.y * y1.y + w0.z * y1.z + w0.w * y1.w;
            a10 += w1.x * y0.x + w1.y * y0.y + w1.z * y0.z + w1.w * y0.w;
            a11 += w1.x * y1.x + w1.y * y1.y + w1.z * y1.z + w1.w * y1.w;
        }
        const float g0 = p.norm2_g[k0 + 2 * kl], g1 = p.norm2_g[k0 + 2 * kl + 1];
        bf16_t* o = p.Wsubt + (size_t)(grp * 128 + nh * 64 + 2 * ng) * 1024 + k0 + 2 * kl;
        *(unsigned*)o = pk2(a00 * g0, a10 * g1);
        *(unsigned*)(o + 1024) = pk2(a01 * g0, a11 * g1);
        __syncthreads();
    }
}

DEVI void prep_x_token(const Params& p, const float* Wg_s, int t, const float4 (&v)[4], int lane) {
    float ss = 0.f, g8[8];
#pragma unroll
    for (int g = 0; g < 8; ++g) g8[g] = 0.f;
#pragma unroll
    for (int j = 0; j < 4; ++j) {
        ss += v[j].x * v[j].x + v[j].y * v[j].y + v[j].z * v[j].z + v[j].w * v[j].w;
#pragma unroll
        for (int g = 0; g < 8; ++g) {
            const float4 w = *(const float4*)(Wg_s + g * 1024 + (lane + 64 * j) * 4);
            g8[g] += v[j].x * w.x + v[j].y * w.y + v[j].z * w.z + v[j].w * w.w;
        }
    }
    ss = wave_sum(ss);
    const bool b5 = lane & 32, b4 = lane & 16, b3 = lane & 8;
    float q4[4], q2[2], q1;
#pragma unroll
    for (int j = 0; j < 4; ++j) { const float snd = b5 ? g8[j] : g8[j + 4], kp = b5 ? g8[j + 4] : g8[j]; q4[j] = kp + __shfl_xor(snd, 32); }
#pragma unroll
    for (int j = 0; j < 2; ++j) { const float snd = b4 ? q4[j] : q4[j + 2], kp = b4 ? q4[j + 2] : q4[j]; q2[j] = kp + __shfl_xor(snd, 16); }
    { const float snd = b3 ? q2[0] : q2[1], kp = b3 ? q2[1] : q2[0]; q1 = kp + __shfl_xor(snd, 8); }
    q1 += __shfl_xor(q1, 4);
    q1 += __shfl_xor(q1, 2);
    q1 += __shfl_xor(q1, 1);
    const float rs = rsqrtf(ss * (1.f / 1024.f) + EPSN);
    uint2* o = (uint2*)(p.xb + (size_t)t * 1024);
#pragma unroll
    for (int j = 0; j < 4; ++j) o[lane + 64 * j] = make_uint2(pk2(v[j].x, v[j].y), pk2(v[j].z, v[j].w));
    if (lane == 0) p.rs1[t] = rs;
    if ((lane & 7) == 0) {
        const int gi = (b5 ? 4 : 0) + (b4 ? 2 : 0) + (b3 ? 1 : 0);
        if (gi < 4) p.ipre[t * 4 + gi] = q1 * rs + p.m_b_i[gi];
        else {
            const float z = q1 * rs + p.m_b_f[gi - 4];
            p.logf[t * 4 + gi - 4] = fminf(z, 0.f) - log1pf(__expf(-fabsf(z)));
        }
    }
}
DEVI void st_prep_x(const Params& p, char* smem) {
    float* Wg_s = (float*)smem;
    for (int i = stid(); i < 8192; i += NTHR) {
        const int k = i >> 3, g = i & 7;
        Wg_s[g * 1024 + k] = p.norm1_g[k] * p.w_in[(size_t)k * DIN + NPJ + g];
    }
    __syncthreads();
    const int lane = stid() & 63, wid = stid() >> 6;
    for (int t = (blockIdx.x * NW + wid) * 4; t < T_TOK; t += gridDim.x * NW * 4) {
        float4 v[4][4];
        const float4* xa = (const float4*)(p.x + (size_t)t * 1024);
#pragma unroll
        for (int q = 0; q < 4; ++q)
#pragma unroll
            for (int j = 0; j < 4; ++j) v[q][j] = xa[256 * q + lane + 64 * j];
#pragma unroll
        for (int q = 0; q < 4; ++q) prep_x_token(p, Wg_s, t + q, v[q], lane);
    }
    __syncthreads();
}

namespace pg8 {
#define PG8_LAS __attribute__((address_space(3)))
typedef unsigned short bf16_t;
typedef short bf16x8 __attribute__((ext_vector_type(8)));
typedef float f32x4 __attribute__((ext_vector_type(4)));
typedef unsigned u32x4 __attribute__((ext_vector_type(4)));
constexpr int BM = 256, BK = 64, HALF = 128, HTB = HALF * BK * 2  , STAGE_BYTES = 8 * HTB, NXCD = 8, WGM = 8;

__host__ __device__ __forceinline__ int lds_byte(int r, int c) { const int st = (r >> 4) * 2 + (c >> 5), rr = r & 15, cc = c & 31, ob = rr * 64 + cc * 2; return st * 1024 + (ob ^ (((ob >> 9) & 1) << 5)); }
__host__ __device__ __forceinline__ void stage_rc(int b, int& R, int& C) { const int st = b / 1024, sb = b % 1024, swz = sb ^ (((sb >> 9) & 1) << 5); R = (st >> 1) * 16 + swz / 64; C = (st & 1) * 32 + (swz % 64) / 2; }
__host__ __device__ __forceinline__ int perm32(int rho) { const int n = rho >> 4, i = rho & 15; return 8 * (i >> 2) + 4 * n + (i & 3); }

struct Unit { int pm, pn; };
struct Gemm { const bf16_t* A; const bf16_t* Bt; int M, N, K; };

struct StaticOrder {
    int nM, nN, nwg, G, c;
    __host__ __device__ void init(int M, int N, int G_, int c_) { nM = M / BM; nN = N / BM; nwg = nM * nN; G = G_; c = c_; }
    __host__ __device__ bool next(int i, Unit& u) const {
        const long L = (long)i * G + c; if (L >= nwg) return false;
        int wgid = (int)L; { const int q = nwg / NXCD, r = nwg % NXCD, xcd = wgid % NXCD, off = wgid / NXCD; wgid = (xcd < r ? xcd * (q + 1) : r * (q + 1) + (xcd - r) * q) + off; }
        const int nig = WGM * nN, gid = wgid / nig, fm = gid * WGM, gsz = (nM - fm) < WGM ? (nM - fm) : WGM;
        u.pm = fm + ((wgid % nig) % gsz); u.pn = (wgid % nig) / gsz; return true;
    }
    __device__ __forceinline__ void a_ready(const Unit&) const {}
    __device__ __forceinline__ void done(const Unit&) const {}
};

__device__ __forceinline__ unsigned cvt_pk_bf16(float lo, float hi) { unsigned r; asm volatile("v_cvt_pk_bf16_f32 %0, %1, %2" : "=v"(r) : "v"(lo), "v"(hi)); return r; }

template <class Epi, class Sched, bool ALIGN_EPI = false, bool SP2 = false>
__device__ __forceinline__ void gemm_phase(PG8_LAS unsigned char* lds, const Gemm g, const Sched& S, const Epi& E) {
    const int tid = stid(), wid = __builtin_amdgcn_readfirstlane(tid >> 6), lane = tid & 63, wr = wid >> 2, wc = wid & 3, fr = lane & 15, fq = lane >> 4;
    const int K = g.K, nt = K / BK;
    unsigned voffA[2], voffB[2];
#pragma unroll
    for (int i = 0; i < 2; ++i) { int R, C; stage_rc(tid * 16 + i * 8192, R, C); const int Rb = Epi::PERM ? ((R & ~31) + perm32(R & 31)) : R;
        voffA[i] = (unsigned)(R * K + C) * 2u; voffB[i] = (unsigned)(Rb * K + C) * 2u; }
    const size_t kstep = (size_t)(BK * 2);
    const size_t hstep = (size_t)HALF * K * 2;
    const size_t tstep = 2 * hstep;
    const unsigned ldsw = (unsigned)wid * 1024u;
    const int aoff = lds_byte(wr * 64 + fr, fq * 8), boff = lds_byte(wc * 32 + fr, fq * 8);
#define PG8_SA(b, h) (((b) * 2 + (h)) * HTB)
#define PG8_SB(b, h) ((4 + (b) * 2 + (h)) * HTB)
#define PG8_STAGE(bufoff, gbase, voff) do { _Pragma("unroll") for (int _i = 0; _i < 2; ++_i) \
        __builtin_amdgcn_global_load_lds((const unsigned*)((const char*)(gbase) + (voff)[_i]), (PG8_LAS unsigned*)(lds + (bufoff) + ldsw + _i * 8192), 16, 0, 0); } while (0)
#define PG8_LDA(dst, b, h) do { _Pragma("unroll") for (int m = 0; m < 4; ++m) _Pragma("unroll") for (int k = 0; k < 2; ++k) dst[m][k] = *(const PG8_LAS bf16x8*)(lds + PG8_SA(b, h) + aoff + m * 2048 + k * 1024); } while (0)
#define PG8_LDB(dst, b, h) do { _Pragma("unroll") for (int n = 0; n < 2; ++n) _Pragma("unroll") for (int k = 0; k < 2; ++k) dst[n][k] = *(const PG8_LAS bf16x8*)(lds + PG8_SB(b, h) + boff + n * 2048 + k * 1024); } while (0)
#define PG8_MMA(ai, bj, At, Bt) do { __builtin_amdgcn_s_setprio(1); _Pragma("unroll") for (int m = 0; m < 4; ++m) _Pragma("unroll") for (int n = 0; n < 2; ++n) _Pragma("unroll") for (int k = 0; k < 2; ++k) \
        acc[ai][bj][m][n] = __builtin_amdgcn_mfma_f32_16x16x32_bf16(Bt[n][k], At[m][k], acc[ai][bj][m][n], 0, 0, 0); __builtin_amdgcn_s_setprio(0); } while (0)
#define PG8_WAIT_V(n) asm volatile("s_waitcnt vmcnt(" #n ")" ::: "memory")
#define PG8_WAIT_L(n) asm volatile("s_waitcnt lgkmcnt(" #n ")" ::: "memory")
#define PG8_BAR __builtin_amdgcn_s_barrier()
#define PG8_SCHED __builtin_amdgcn_sched_barrier(0)
    Unit cur, nxt; int ui = 0;
    if (!S.next(0, cur)) return;
    f32x4 acc[2][2][4][2];
#pragma unroll
    for (int a = 0; a < 2; ++a)
#pragma unroll
        for (int b = 0; b < 2; ++b)
#pragma unroll
            for (int m = 0; m < 4; ++m)
#pragma unroll
                for (int n = 0; n < 2; ++n) acc[a][b][m][n] = (f32x4){0.f, 0.f, 0.f, 0.f};
    bf16x8 At[4][2], B0[2][2], B1[2][2];
    const char* cA = (const char*)g.A + (size_t)cur.pm * tstep; const char* cB = (const char*)g.Bt + (size_t)cur.pn * tstep;
    S.a_ready(cur);
    if constexpr (SP2) {
        PG8_STAGE(PG8_SB(0, 0), cB, voffB); PG8_STAGE(PG8_SB(0, 1), cB + hstep, voffB); PG8_STAGE(PG8_SA(0, 0), cA, voffA); PG8_STAGE(PG8_SA(0, 1), cA + hstep, voffA);
        if (wr == 1) PG8_BAR;
        PG8_WAIT_V(2); PG8_BAR;
        PG8_STAGE(PG8_SB(1, 0), cB + kstep, voffB); PG8_STAGE(PG8_SA(1, 0), cA + kstep, voffA); PG8_STAGE(PG8_SB(1, 1), cB + hstep + kstep, voffB);
        PG8_WAIT_V(6); PG8_BAR;
    } else {
        PG8_STAGE(PG8_SB(0, 0), cB, voffB); PG8_STAGE(PG8_SA(0, 0), cA, voffA); PG8_STAGE(PG8_SB(0, 1), cB + hstep, voffB); PG8_STAGE(PG8_SA(0, 1), cA + hstep, voffA);
        if (wr == 1) PG8_BAR;
        PG8_WAIT_V(4); PG8_BAR;
        PG8_STAGE(PG8_SB(1, 0), cB + kstep, voffB); PG8_STAGE(PG8_SA(1, 0), cA + kstep, voffA); PG8_STAGE(PG8_SB(1, 1), cB + hstep + kstep, voffB);
        PG8_WAIT_V(6); PG8_BAR;
    }
    for (;;) {
        const bool has_next = S.next(ui + 1, nxt);
        const char* nA = has_next ? (const char*)g.A + (size_t)nxt.pm * tstep : cA; const char* nB = has_next ? (const char*)g.Bt + (size_t)nxt.pn * tstep : cB;
        for (int t = 0; t < nt; t += 2) {
            const bool last = (t == nt - 2);
            const char* a1 = cA + (size_t)(t + 1) * kstep;
            const char* a2 = last ? nA : cA + (size_t)(t + 2) * kstep; const char* b2 = last ? nB : cB + (size_t)(t + 2) * kstep;
            const char* a3 = a2 + kstep; const char* b3 = b2 + kstep;
            if (last && has_next) S.a_ready(nxt);
            if constexpr (SP2) {
            PG8_LDB(B0, 0, 0); PG8_LDB(B1, 0, 1); PG8_SCHED; PG8_LDA(At, 0, 0); PG8_STAGE(PG8_SA(1, 1), a1 + hstep, voffA);
            PG8_WAIT_V(8); PG8_WAIT_L(0); PG8_BAR; PG8_MMA(0, 0, At, B0); PG8_MMA(0, 1, At, B1); PG8_BAR; PG8_SCHED;
            PG8_LDA(At, 0, 1); PG8_STAGE(PG8_SB(0, 0), b2, voffB); PG8_STAGE(PG8_SB(0, 1), b2 + hstep, voffB); PG8_STAGE(PG8_SA(0, 0), a2, voffA);
            PG8_WAIT_V(8); PG8_WAIT_L(0); PG8_BAR; PG8_MMA(1, 0, At, B0); PG8_MMA(1, 1, At, B1); PG8_BAR; PG8_SCHED;
            PG8_LDB(B0, 1, 0); PG8_LDB(B1, 1, 1); PG8_SCHED; PG8_LDA(At, 1, 0); PG8_STAGE(PG8_SA(0, 1), a2 + hstep, voffA);
            PG8_WAIT_V(8); PG8_WAIT_L(0); PG8_BAR; PG8_MMA(0, 0, At, B0); PG8_MMA(0, 1, At, B1); PG8_BAR; PG8_SCHED;
            PG8_LDA(At, 1, 1); PG8_STAGE(PG8_SB(1, 0), b3, voffB); PG8_STAGE(PG8_SB(1, 1), b3 + hstep, voffB); PG8_STAGE(PG8_SA(1, 0), a3, voffA);
            PG8_WAIT_V(8); PG8_WAIT_L(0); PG8_BAR; PG8_MMA(1, 0, At, B0); PG8_MMA(1, 1, At, B1); PG8_BAR; PG8_SCHED;
            } else {
            PG8_LDB(B0, 0, 0); PG8_SCHED; PG8_LDA(At, 0, 0); PG8_STAGE(PG8_SA(1, 1), a1 + hstep, voffA);
            PG8_WAIT_L(8); PG8_BAR; PG8_WAIT_L(0); PG8_MMA(0, 0, At, B0); PG8_BAR; PG8_SCHED;
            PG8_LDB(B1, 0, 1); PG8_STAGE(PG8_SB(0, 0), b2, voffB);
            PG8_BAR; PG8_WAIT_L(0); PG8_MMA(0, 1, At, B1); PG8_BAR;
            PG8_LDA(At, 0, 1); PG8_STAGE(PG8_SA(0, 0), a2, voffA);
            PG8_BAR; PG8_WAIT_L(0); PG8_MMA(1, 0, At, B0); PG8_BAR; PG8_SCHED;
            PG8_STAGE(PG8_SB(0, 1), b2 + hstep, voffB);
            PG8_WAIT_V(6); PG8_BAR; PG8_MMA(1, 1, At, B1); PG8_BAR;
            PG8_LDB(B0, 1, 0); PG8_SCHED; PG8_LDA(At, 1, 0); PG8_STAGE(PG8_SA(0, 1), a2 + hstep, voffA);
            PG8_WAIT_L(8); PG8_BAR; PG8_WAIT_L(0); PG8_MMA(0, 0, At, B0); PG8_BAR; PG8_SCHED;
            PG8_LDB(B1, 1, 1); PG8_STAGE(PG8_SB(1, 0), b3, voffB);
            PG8_BAR; PG8_WAIT_L(0); PG8_MMA(0, 1, At, B1); PG8_BAR;
            PG8_LDA(At, 1, 1); PG8_STAGE(PG8_SA(1, 0), a3, voffA);
            PG8_BAR; PG8_WAIT_L(0); PG8_MMA(1, 0, At, B0); PG8_BAR; PG8_SCHED;
            PG8_STAGE(PG8_SB(1, 1), b3 + hstep, voffB);
            PG8_WAIT_V(6); PG8_BAR; PG8_MMA(1, 1, At, B1); PG8_BAR;
            }
        }
        if constexpr (ALIGN_EPI) { if (wr == 0) PG8_BAR; }
        if constexpr (!Epi::AFTER_DRAIN) { E(acc, cur, wr, wc, fr, fq); S.done(cur); }
        if (!has_next) break;
#pragma unroll
        for (int a = 0; a < 2; ++a)
#pragma unroll
            for (int b = 0; b < 2; ++b)
#pragma unroll
                for (int m = 0; m < 4; ++m)
#pragma unroll
                    for (int n = 0; n < 2; ++n) acc[a][b][m][n] = (f32x4){0.f, 0.f, 0.f, 0.f};
        cur = nxt; cA = nA; cB = nB; ++ui;
        if constexpr (ALIGN_EPI) { if (wr == 1) PG8_BAR; }
    }
    PG8_WAIT_V(0);
    if constexpr (!ALIGN_EPI) { if (wr == 0) PG8_BAR; }
    PG8_BAR;
    if constexpr (Epi::AFTER_DRAIN) { E.fused(acc, cur, wr, wc, fr, fq, lds, wid, lane); S.done(cur); }
#undef PG8_SA
#undef PG8_SB
#undef PG8_STAGE
#undef PG8_LDA
#undef PG8_LDB
#undef PG8_MMA
#undef PG8_WAIT_V
#undef PG8_WAIT_L
#undef PG8_BAR
#undef PG8_SCHED
}
}

#ifndef PG8_SP2
#define PG8_SP2 true
#endif
#ifndef PG8_ALIGN
#define PG8_ALIGN true
#endif
struct EpiProj8 {
    static constexpr bool PERM = true, AFTER_DRAIN = false;
    bf16_t* O; const float* rs; const float* rcos; const float* rsin;
    __device__ __forceinline__ void operator()(const pg8::f32x4 (&acc)[2][2][4][2], const pg8::Unit& u, int wr, int wc, int fr, int fq) const {
        const int row0 = u.pm * 256 + wr * 64 + fr, col0 = u.pn * 256 + wc * 32 + 8 * fq;
        const bool rot = u.pn < 4;
        const float ksc = u.pn >= 2 ? 0.08838834764831845f : 1.f;
#pragma unroll
        for (int ai = 0; ai < 2; ++ai)
#pragma unroll
            for (int m = 0; m < 4; ++m) {
                const int row = row0 + ai * 128 + m * 16;
                const float s = rs[row];
                bf16_t* rowp = O + (size_t)row * NPJ + col0;
                float4 cs = make_float4(1.f, 1.f, 1.f, 1.f), sn = make_float4(0.f, 0.f, 0.f, 0.f);
                float s2 = s;
                if (rot) {
                    const int ti = (row & 2047) * 64 + 16 * wc + 4 * fq;
                    cs = *(const float4*)(rcos + ti);
                    sn = *(const float4*)(rsin + ti);
                    s2 = s * ksc;
                }
#pragma unroll
                for (int bj = 0; bj < 2; ++bj) {
                    const pg8::f32x4 v0 = acc[ai][bj][m][0] * s2, v1 = acc[ai][bj][m][1] * s2;
                    *(uint4*)(rowp + bj * 128) = make_uint4(pk2(v0[0] * cs.x - v0[1] * sn.x, v0[0] * sn.x + v0[1] * cs.x), pk2(v0[2] * cs.y - v0[3] * sn.y, v0[2] * sn.y + v0[3] * cs.y),
                                                            pk2(v1[0] * cs.z - v1[1] * sn.z, v1[0] * sn.z + v1[1] * cs.z), pk2(v1[2] * cs.w - v1[3] * sn.w, v1[2] * sn.w + v1[3] * cs.w));
                }
            }
    }
};
struct EpiX18 {
    static constexpr bool PERM = true, AFTER_DRAIN = false;
    const float* x; bf16_t* x1b;
    __device__ __forceinline__ void operator()(const pg8::f32x4 (&acc)[2][2][4][2], const pg8::Unit& u, int wr, int wc, int fr, int fq) const {
        const int row0 = u.pm * 256 + wr * 64 + fr, col0 = u.pn * 256 + wc * 32 + 8 * fq;
#pragma unroll
        for (int ai = 0; ai < 2; ++ai)
#pragma unroll
            for (int m = 0; m < 4; ++m) {
                const size_t ro = (size_t)(row0 + ai * 128 + m * 16) * 1024 + col0;
#pragma unroll
                for (int bj = 0; bj < 2; ++bj) {
                    const float4 xa = *(const float4*)(x + ro + bj * 128), xb_ = *(const float4*)(x + ro + bj * 128 + 4);
                    const pg8::f32x4 v0 = acc[ai][bj][m][0], v1 = acc[ai][bj][m][1];
                    *(uint4*)(x1b + ro + bj * 128) = make_uint4(pk2(xa.x + v0[0], xa.y + v0[1]), pk2(xa.z + v0[2], xa.w + v0[3]),
                                                                pk2(xb_.x + v1[0], xb_.y + v1[1]), pk2(xb_.z + v1[2], xb_.w + v1[3]));
                }
            }
    }
};
template <class Epi, bool ALIGN>
DEVI void st_gemm8(const bf16_t* A, const bf16_t* Bt, int N, int K, char* smem, const Epi& epi) {
    pg8::Gemm g{A, Bt, T_TOK, N, K};
    pg8::StaticOrder S;
    S.init(T_TOK, N, (int)gridDim.x, (int)blockIdx.x);
    pg8::gemm_phase<Epi, pg8::StaticOrder, ALIGN, PG8_SP2>((PG8_LAS unsigned char*)smem, g, S, epi);
}

DEVI void st_conv_qk(const Params& p, char* smem) {
    char* cs = smem;
    char* wqs = smem + 128 * 272;
    char* wks = smem + 2 * 128 * 272;
    const int tid = stid(), lane = tid & 63, wid = tid >> 6, wr = wid >> 1, wc = wid & 1, fr = lane & 15, fq = lane >> 4;
    const int r = tid >> 4, cg = tid & 15;
    int hcur = -1;
    float cw[4][8], cb[8];
    for (int it = blockIdx.x; it < 256 * 4; it += gridDim.x) {
        const int h = it & 3, t0 = (it >> 2) * 128, s0 = t0 & 2047;
        if (h != hcur) {
            __syncthreads();
#pragma unroll
            for (int i = 0; i < 4; ++i) {
                const int id = tid + 512 * i, rr = id >> 4, c = id & 15;
                *(uint4*)(wqs + rr * 272 + c * 16) = *(const uint4*)(p.Wqt + h * 16384 + rr * 128 + c * 8);
                *(uint4*)(wks + rr * 272 + c * 16) = *(const uint4*)(p.Wkt + h * 16384 + rr * 128 + c * 8);
            }
#pragma unroll
            for (int j = 0; j < 4; ++j) {
                const float4 a = *(const float4*)(p.m_conv_w + j * 512 + h * 128 + 8 * cg), b = *(const float4*)(p.m_conv_w + j * 512 + h * 128 + 8 * cg + 4);
                cw[j][0] = a.x; cw[j][1] = a.y; cw[j][2] = a.z; cw[j][3] = a.w; cw[j][4] = b.x; cw[j][5] = b.y; cw[j][6] = b.z; cw[j][7] = b.w;
            }
            { const float4 a = *(const float4*)(p.m_conv_b + h * 128 + 8 * cg), b = *(const float4*)(p.m_conv_b + h * 128 + 8 * cg + 4);
              cb[0] = a.x; cb[1] = a.y; cb[2] = a.z; cb[3] = a.w; cb[4] = b.x; cb[5] = b.y; cb[6] = b.z; cb[7] = b.w; }
            hcur = h;
        }
        const bf16_t* xcol = p.proj + (size_t)t0 * NPJ + 2048 + h * 128 + 8 * cg;
#pragma unroll
        for (int ps = 0; ps < 4; ++ps) {
            const int row = 32 * ps + r;
            uint4 xv[4];
#pragma unroll
            for (int j = 0; j < 4; ++j) {
                const int rj = row - 3 + j;
                xv[j] = (s0 + rj >= 0) ? *(const uint4*)(xcol + (long)rj * NPJ) : make_uint4(0u, 0u, 0u, 0u);
            }
            float y[8];
#pragma unroll
            for (int e = 0; e < 8; ++e) y[e] = cb[e];
#pragma unroll
            for (int j = 0; j < 4; ++j) {
                const unsigned w4[4] = {xv[j].x, xv[j].y, xv[j].z, xv[j].w};
#pragma unroll
                for (int e = 0; e < 4; ++e) { y[2 * e] += cw[j][2 * e] * bflo(w4[e]); y[2 * e + 1] += cw[j][2 * e + 1] * bfhi(w4[e]); }
            }
            unsigned o[4];
#pragma unroll
            for (int e = 0; e < 4; ++e) o[e] = pk2(y[2 * e] * sigmoidf_(y[2 * e]), y[2 * e + 1] * sigmoidf_(y[2 * e + 1]));
            const uint4 ov = make_uint4(o[0], o[1], o[2], o[3]);
            *(uint4*)(cs + row * 272 + cg * 16) = ov;
            *(uint4*)(p.cbuf + (size_t)(t0 + row) * 512 + h * 128 + 8 * cg) = ov;
        }
        __syncthreads();
#pragma unroll
        for (int which = 0; which < 2; ++which) {
            const char* ws = which ? wks : wqs;
            bf16_t* O = which ? p.mk : p.mq;
            f32x4 acc[2][4];
#pragma unroll
            for (int i = 0; i < 2; ++i)
#pragma unroll
                for (int j = 0; j < 4; ++j) acc[i][j] = (f32x4){0.f, 0.f, 0.f, 0.f};
#pragma unroll
            for (int ks = 0; ks < 4; ++ks) {
                bf16x8 a[2], b[4];
#pragma unroll
                for (int i = 0; i < 2; ++i) a[i] = ld8(cs + (wr * 32 + i * 16 + fr) * 272 + (ks * 4 + fq) * 16);
#pragma unroll
                for (int j = 0; j < 4; ++j) b[j] = ld8(ws + (wc * 64 + j * 16 + fr) * 272 + (ks * 4 + fq) * 16);
#pragma unroll
                for (int i = 0; i < 2; ++i)
#pragma unroll
                    for (int j = 0; j < 4; ++j) acc[i][j] = mfma16(b[j], a[i], acc[i][j]);
            }
#pragma unroll
            for (int i = 0; i < 2; ++i)
#pragma unroll
                for (int j = 0; j < 4; ++j) {
                    const int m = t0 + wr * 32 + i * 16 + fr, n = h * 128 + wc * 64 + j * 16 + 4 * fq;
                    const f32x4 v = acc[i][j];
                    *(uint2*)(O + (size_t)m * 512 + n) = make_uint2(pk2(v[0], v[1]), pk2(v[2], v[3]));
                }
        }
        __syncthreads();
    }
}

DEVI bf16x8 u4_to_frag(uint4 u) { union { uint4 u; bf16x8 v; } x; x.u = u; return x.v; }
DEVI void sel_frags(bf16x8 (&sel)[2], int fr, int fq) {
#pragma unroll
    for (int hh = 0; hh < 2; ++hh) {
        const int jstar = fr + 16 * hh - 8 * fq;
        bf16x8 s;
#pragma unroll
        for (int j = 0; j < 8; ++j) s[j] = (j == jstar) ? (short)0x3F80 : (short)0;
        sel[hh] = s;
    }
}
DEVI void tr_store(char* XT, bf16x8 frag, const bf16x8 (&sel)[2], int mi, int ks, int fr, int fq, const float (&sc)[4]) {
#pragma unroll
    for (int hh = 0; hh < 2; ++hh) {
        const f32x4 d = mfma16(frag, sel[hh], (f32x4){0.f, 0.f, 0.f, 0.f});
        *(uint2*)(XT + (32 * ks + 16 * hh + fr) * 144 + (16 * mi + 4 * fq) * 2) = make_uint2(pk2(d[0] * sc[0], d[1] * sc[1]), pk2(d[2] * sc[2], d[3] * sc[3]));
    }
}
DEVI bf16x8 state_pack(const f32x4& a, const f32x4& b) {
    return mk8(make_uint2(pk2(a[0], a[1]), pk2(a[2], a[3])), make_uint2(pk2(b[0], b[1]), pk2(b[2], b[3])));
}
DEVI const float* opaque_ptr(const float* q) { asm volatile("" : "+v"(q)); return q; }
DEVI float opaque_f(float v) { asm volatile("" : "+v"(v)); return v; }
DEVI void lds_barrier() { asm volatile("s_waitcnt lgkmcnt(0)" ::: "memory"); __builtin_amdgcn_s_barrier(); asm volatile("" ::: "memory"); }
DEVI void pin_u4(uint4& a) { asm volatile("" : "+v"(a.x), "+v"(a.y), "+v"(a.z), "+v"(a.w)); }
DEVI float grp8_sum(float v) { v += __shfl_xor(v, 1); v += __shfl_xor(v, 2); v += __shfl_xor(v, 4); return v; }

#define ASM_LD16(dst, voff, sbase, imm) asm volatile("global_load_dwordx4 %0, %1, %2 offset:" #imm : "=v"(dst) : "v"(voff), "s"(sbase) : "memory")
#define ASM_LD4(dst, voff, sbase) asm volatile("global_load_dword %0, %1, %2" : "=v"(dst) : "v"(voff), "s"(sbase) : "memory")
typedef unsigned u32x4_t __attribute__((ext_vector_type(4)));
struct RetPre { u32x4_t f[4]; u32x4_t v[2]; u32x4_t g[2]; };
struct RetOff { unsigned f, v0, v1, g; };
DEVI void ret_offsets(RetOff& o, int h, int tid) {
    const int lane = tid & 63, w = tid >> 6, fr = lane & 15, fq = lane >> 4, mi = w & 3;
    o.f = (unsigned)(((16 * mi + fr) * NPJ + (w < 4 ? 512 : 0) + h * 128 + 8 * fq) * 2);
    o.v0 = (unsigned)(((16 * ((2 * w) >> 2) + fr) * NPJ + 1024 + h * 128 + 32 * ((2 * w) & 3) + 8 * fq) * 2);
    o.v1 = (unsigned)(((16 * ((2 * w + 1) >> 2) + fr) * NPJ + 1024 + h * 128 + 32 * ((2 * w + 1) & 3) + 8 * fq) * 2);
    o.g = (unsigned)(((tid >> 3) * NPJ + 1536 + h * 128 + 16 * (tid & 7)) * 2);
}
DEVI void ret_prefetch(const Params& p, RetPre& P, const RetOff& o, int b, int c) {
    const char* base = (const char*)p.proj + (size_t)(b * 2048 + c * 64) * (NPJ * 2);
    ASM_LD16(P.f[0], o.f, base, 0); ASM_LD16(P.f[1], o.f, base, 64); ASM_LD16(P.f[2], o.f, base, 128); ASM_LD16(P.f[3], o.f, base, 192);
    ASM_LD16(P.v[0], o.v0, base, 0); ASM_LD16(P.v[1], o.v1, base, 0);
    ASM_LD16(P.g[0], o.g, base, 0); ASM_LD16(P.g[1], o.g, base, 16);
}
DEVI void ret_retire(RetPre& P) {
    asm volatile("s_waitcnt vmcnt(0)" : "+v"(P.f[0]), "+v"(P.f[1]), "+v"(P.f[2]), "+v"(P.f[3]), "+v"(P.v[0]), "+v"(P.v[1]), "+v"(P.g[0]), "+v"(P.g[1]) :: "memory");
}
DEVI uint4 asu4(const u32x4_t& v) { return make_uint4(v[0], v[1], v[2], v[3]); }
DEVI void ret_block(const Params& p, char* smem, int b, int h) {
    char* qs = smem;
    char* ks_ = smem + 17408;
    char* kTs = smem + 34816;
    char* vTs = smem + 53248;
    char* Ss = smem + 71680;
    char* Os = smem + 80896;
    float* gn_s = (float*)(smem + 98304);
    const int tid = stid(), lane = tid & 63, w = tid >> 6, fr = lane & 15, fq = lane >> 4;
    const float gamma = 1.f - exp2f(-5.f - (float)h);
    const float l2g = log2f(gamma);
    const float g64 = exp2f(l2g * 64.f);
    bf16x8 sel[2];
    sel_frags(sel, fr, fq);
    f32x4 st[8];
#pragma unroll
    for (int i = 0; i < 8; ++i) st[i] = (f32x4){0.f, 0.f, 0.f, 0.f};
    if (tid < 128) gn_s[tid] = p.ret_norm_g[h * 128 + tid];
    __syncthreads();
    RetPre P;
    RetOff RO;
    ret_offsets(RO, h, tid);
    ret_prefetch(p, P, RO, b, 0);
    ret_retire(P);
#pragma unroll 1
    for (int c = 0; c < 32; ++c) {
        const int t0 = b * 2048 + c * 64;
        {
            const int mi = w & 3;
            char* dst = (w < 4 ? ks_ : qs) + (16 * mi + fr) * 272 + fq * 16;
#pragma unroll
            for (int ks = 0; ks < 4; ++ks) *(uint4*)(dst + ks * 64) = asu4(P.f[ks]);
            if (w < 4) {
                float kd[4];
#pragma unroll
                for (int r = 0; r < 4; ++r) kd[r] = exp2f(l2g * (float)(63 - (16 * mi + 4 * fq + r)));
#pragma unroll
                for (int ks = 0; ks < 4; ++ks) tr_store(kTs, u4_to_frag(asu4(P.f[ks])), sel, mi, ks, fr, fq, kd);
            }
            const float one[4] = {1.f, 1.f, 1.f, 1.f};
#pragma unroll
            for (int q = 0; q < 2; ++q) { const int pr = 2 * w + q; tr_store(vTs, u4_to_frag(asu4(P.v[q])), sel, pr >> 2, pr & 3, fr, fq, one); }
        }
        uint4 g0 = asu4(P.g[0]), g1 = asu4(P.g[1]);
        lds_barrier();
        ret_prefetch(p, P, RO, b, c + 1 < 32 ? c + 1 : 31);
        {
            const int lt = w & 3;
            bf16x8 qf[4];
#pragma unroll
            for (int s = 0; s < 4; ++s) qf[s] = ld8(qs + (16 * lt + fr) * 272 + (s * 4 + fq) * 16);
#pragma unroll
            for (int jj = 0; jj < 2; ++jj) {
                const int j = 2 * (w >> 2) + jj;
                f32x4 a = (f32x4){0.f, 0.f, 0.f, 0.f};
#pragma unroll
                for (int s = 0; s < 4; ++s) a = mfma16(ld8(ks_ + (16 * j + fr) * 272 + (s * 4 + fq) * 16), qf[s], a);
                const int l = 16 * lt + fr, mb = 16 * j + 4 * fq;
                float v[4];
#pragma unroll
                for (int r = 0; r < 4; ++r) { const int dd = l - (mb + r); v[r] = a[r] * exp2f(l2g * (float)(dd < 0 ? -dd : dd)); }
                *(uint2*)(Ss + l * 144 + mb * 2) = make_uint2(pk2(v[0], v[1]), pk2(v[2], v[3]));
            }
        }
        lds_barrier();
        {
            bf16x8 sp[4];
#pragma unroll
            for (int s = 0; s < 4; ++s) sp[s] = state_pack(st[2 * s], st[2 * s + 1]);
            bf16x8 vf[2];
#pragma unroll
            for (int s2 = 0; s2 < 2; ++s2) vf[s2] = ld8(vTs + (16 * w + fr) * 144 + (s2 * 4 + fq) * 16);
#pragma unroll
            for (int i = 0; i < 4; ++i) {
                f32x4 a = (f32x4){0.f, 0.f, 0.f, 0.f};
                const char* qrow = qs + (16 * i + fr) * 272;
#pragma unroll
                for (int s = 0; s < 4; ++s) {
                    const uint2 lo = *(const uint2*)(qrow + (32 * s + 4 * fq) * 2), hi = *(const uint2*)(qrow + (32 * s + 16 + 4 * fq) * 2);
                    a = mfma16(sp[s], mk8(lo, hi), a);
                }
                a = a * exp2f(l2g * (float)(16 * i + fr + 1));
#pragma unroll
                for (int s2 = 0; s2 < 2; ++s2) a = mfma16(vf[s2], ld8(Ss + (16 * i + fr) * 144 + (s2 * 4 + fq) * 16), a);
                *(uint2*)(Os + (16 * i + fr) * 272 + (16 * w + 4 * fq) * 2) = make_uint2(pk2(a[0], a[1]), pk2(a[2], a[3]));
            }
#pragma unroll
            for (int i = 0; i < 8; ++i) {
                f32x4 a = st[i] * g64;
#pragma unroll
                for (int s2 = 0; s2 < 2; ++s2) a = mfma16(ld8(kTs + (16 * i + fr) * 144 + (s2 * 4 + fq) * 16), vf[s2], a);
                st[i] = a;
            }
        }
        lds_barrier();
        pin_u4(g0); pin_u4(g1);
        {
            const int l = tid >> 3, part = tid & 7;
            const uint4 o0 = *(const uint4*)(Os + l * 272 + part * 32), o1 = *(const uint4*)(Os + l * 272 + part * 32 + 16);
            const unsigned ow[8] = {o0.x, o0.y, o0.z, o0.w, o1.x, o1.y, o1.z, o1.w}, gw[8] = {g0.x, g0.y, g0.z, g0.w, g1.x, g1.y, g1.z, g1.w};
            float x[16], s = 0.f;
#pragma unroll
            for (int e = 0; e < 8; ++e) { x[2 * e] = bflo(ow[e]); x[2 * e + 1] = bfhi(ow[e]); s += x[2 * e] + x[2 * e + 1]; }
            const float mu = grp8_sum(s) * (1.f / 128.f);
            float q = 0.f;
#pragma unroll
            for (int e = 0; e < 16; ++e) { x[e] -= mu; q += x[e] * x[e]; }
            const float rstd = rsqrtf(grp8_sum(q) * (1.f / 128.f) + EPSN);
            const float* gn = gn_s + 16 * part;
            unsigned yo[8];
#pragma unroll
            for (int e = 0; e < 8; ++e) {
                const float ga = bflo(gw[e]), gb = bfhi(gw[e]);
                yo[e] = pk2(ga * sigmoidf_(ga) * x[2 * e] * rstd * gn[2 * e], gb * sigmoidf_(gb) * x[2 * e + 1] * rstd * gn[2 * e + 1]);
            }
            ret_retire(P);
            uint4* yp = (uint4*)(p.yb + (size_t)(t0 + l) * 1024 + h * 128 + 16 * part);
            yp[0] = make_uint4(yo[0], yo[1], yo[2], yo[3]);
            yp[1] = make_uint4(yo[4], yo[5], yo[6], yo[7]);
        }
    }
}

struct MlPre { u32x4_t f[4]; u32x4_t v[2]; u32x4_t o[2]; u32x4_t cc[2]; float iv, fv; };
struct MlOff { unsigned f, v0, v1, o, c, g; };
DEVI void ml_offsets(const Params& p, MlOff& o, int h, int tid) {
    const int lane = tid & 63, w = tid >> 6, fr = lane & 15, fq = lane >> 4, mi = w & 3;
    const unsigned kdiff = (unsigned)((const char*)p.mk - (const char*)p.mq);
    o.f = (unsigned)(((16 * mi + fr) * 512 + h * 128 + 8 * fq) * 2) + (w < 4 ? kdiff : 0u);
    o.v0 = (unsigned)(((16 * ((2 * w) >> 2) + fr) * NPJ + 2560 + h * 128 + 32 * ((2 * w) & 3) + 8 * fq) * 2);
    o.v1 = (unsigned)(((16 * ((2 * w + 1) >> 2) + fr) * NPJ + 2560 + h * 128 + 32 * ((2 * w + 1) & 3) + 8 * fq) * 2);
    o.o = (unsigned)(((tid >> 3) * NPJ + 3072 + h * 128 + 16 * (tid & 7)) * 2);
    o.c = (unsigned)(((tid >> 3) * 512 + h * 128 + 16 * (tid & 7)) * 2);
    o.g = (unsigned)((lane * 4 + h) * 4);
}
DEVI void ml_prefetch(const Params& p, MlPre& P, const MlOff& o, int b, int c) {
    const size_t t0 = (size_t)(b * 2048 + c * 64);
    const char* bq = (const char*)p.mq + t0 * 1024, *bp = (const char*)p.proj + t0 * (NPJ * 2), *bc = (const char*)p.cbuf + t0 * 1024;
    const char* bi = (const char*)p.ipre + t0 * 16, *bf = (const char*)p.logf + t0 * 16;
    ASM_LD16(P.f[0], o.f, bq, 0); ASM_LD16(P.f[1], o.f, bq, 64); ASM_LD16(P.f[2], o.f, bq, 128); ASM_LD16(P.f[3], o.f, bq, 192);
    ASM_LD16(P.v[0], o.v0, bp, 0); ASM_LD16(P.v[1], o.v1, bp, 0);
    ASM_LD16(P.o[0], o.o, bp, 0); ASM_LD16(P.o[1], o.o, bp, 16);
    ASM_LD16(P.cc[0], o.c, bc, 0); ASM_LD16(P.cc[1], o.c, bc, 16);
    ASM_LD4(P.iv, o.g, bi); ASM_LD4(P.fv, o.g, bf);
}
DEVI void ml_retire(MlPre& P) {
    asm volatile("s_waitcnt vmcnt(0)" : "+v"(P.f[0]), "+v"(P.f[1]), "+v"(P.f[2]), "+v"(P.f[3]), "+v"(P.v[0]), "+v"(P.v[1]), "+v"(P.o[0]), "+v"(P.o[1]),
                 "+v"(P.cc[0]), "+v"(P.cc[1]), "+v"(P.iv), "+v"(P.fv) :: "memory");
}
DEVI void mlstm_block(const Params& p, char* smem, int b, int h) {
    char* qs = smem;
    char* kTs = smem + 17408;
    char* vTs = smem + 35840;
    char* Os = smem + 54272;
    float* n_s = (float*)(smem + 71680);
    float* den_s = (float*)(smem + 72192);
    float* gn_s = (float*)(smem + 72448);
    float* sk_s = gn_s + 128;
    const int tid = stid(), lane = tid & 63, w = tid >> 6, fr = lane & 15, fq = lane >> 4;
    bf16x8 sel[2];
    sel_frags(sel, fr, fq);
    f32x4 st[8];
#pragma unroll
    for (int i = 0; i < 8; ++i) st[i] = (f32x4){0.f, 0.f, 0.f, 0.f};
    float m_run = 0.f;
    f32x4 nacc = (f32x4){0.f, 0.f, 0.f, 0.f};
    bf16x8 ones;
#pragma unroll
    for (int j = 0; j < 8; ++j) ones[j] = (short)0x3F80;
    if (tid < 128) { gn_s[tid] = p.m_norm_g[h * 128 + tid]; sk_s[tid] = p.m_skip[h * 128 + tid]; }
    __syncthreads();
    MlPre P;
    MlOff MO;
    ml_offsets(p, MO, h, tid);
    ml_prefetch(p, P, MO, b, 0);
    ml_retire(P);
#pragma unroll 1
    for (int c = 0; c < 32; ++c) {
        const int t0 = b * 2048 + c * 64;
        float fcum = P.fv;
#pragma unroll
        for (int o = 1; o < 64; o <<= 1) { const float tv = __shfl_up(fcum, o); if (lane >= o) fcum += tv; }
        const float a_c = __shfl(fcum, 63);
        const float logw = a_c - fcum + P.iv;
        const float m_in = wave_max(logw);
        const float m_new = fmaxf(a_c + m_run, m_in);
        const float decay = __expf(a_c + m_run - m_new);
        const float wgt = __expf(logw - m_new);
        const float emn = __expf(-m_new);
        m_run = m_new;
        {
            const int mi = w & 3;
            if (w < 4) {
                float kw[4];
#pragma unroll
                for (int r = 0; r < 4; ++r) kw[r] = __shfl(wgt, 16 * mi + 4 * fq + r);
#pragma unroll
                for (int ks = 0; ks < 4; ++ks) tr_store(kTs, u4_to_frag(asu4(P.f[ks])), sel, mi, ks, fr, fq, kw);
            } else {
                char* dst = qs + (16 * mi + fr) * 272 + fq * 16;
#pragma unroll
                for (int ks = 0; ks < 4; ++ks) *(uint4*)(dst + ks * 64) = asu4(P.f[ks]);
            }
            const float one[4] = {1.f, 1.f, 1.f, 1.f};
#pragma unroll
            for (int q = 0; q < 2; ++q) { const int pr = 2 * w + q; tr_store(vTs, u4_to_frag(asu4(P.v[q])), sel, pr >> 2, pr & 3, fr, fq, one); }
        }
        uint4 mo0 = asu4(P.o[0]), mo1 = asu4(P.o[1]), cc0 = asu4(P.cc[0]), cc1 = asu4(P.cc[1]);
        lds_barrier();
        ml_prefetch(p, P, MO, b, c + 1 < 32 ? c + 1 : 31);
        {
            f32x4 a = nacc * decay;
#pragma unroll
            for (int s2 = 0; s2 < 2; ++s2) a = mfma16(ld8(kTs + (16 * w + fr) * 144 + (s2 * 4 + fq) * 16), ones, a);
            nacc = a;
            if (fr == 0) *(f32x4*)(n_s + 16 * w + 4 * fq) = a;
        }
        {
            bf16x8 vf[2];
#pragma unroll
            for (int s2 = 0; s2 < 2; ++s2) vf[s2] = ld8(vTs + (16 * w + fr) * 144 + (s2 * 4 + fq) * 16);
#pragma unroll
            for (int i = 0; i < 8; ++i) {
                f32x4 a = st[i] * decay;
#pragma unroll
                for (int s2 = 0; s2 < 2; ++s2) a = mfma16(ld8(kTs + (16 * i + fr) * 144 + (s2 * 4 + fq) * 16), vf[s2], a);
                st[i] = a;
            }
        }
        lds_barrier();
        {
            const int l = tid >> 3, part = tid & 7;
            const uint4 a0 = *(const uint4*)(qs + l * 272 + part * 32), a1 = *(const uint4*)(qs + l * 272 + part * 32 + 16);
            const unsigned aw[8] = {a0.x, a0.y, a0.z, a0.w, a1.x, a1.y, a1.z, a1.w};
            const float* nn = n_s + 16 * part;
            float s = 0.f;
#pragma unroll
            for (int e = 0; e < 8; ++e) s += bflo(aw[e]) * nn[2 * e] + bfhi(aw[e]) * nn[2 * e + 1];
            s = grp8_sum(s);
            if (part == 0) den_s[l] = fmaxf(fabsf(s), emn);
        }
        lds_barrier();
        {
            bf16x8 sp[4];
#pragma unroll
            for (int s = 0; s < 4; ++s) sp[s] = state_pack(st[2 * s], st[2 * s + 1]);
#pragma unroll
            for (int i = 0; i < 4; ++i) {
                f32x4 a = (f32x4){0.f, 0.f, 0.f, 0.f};
                const char* qrow = qs + (16 * i + fr) * 272;
#pragma unroll
                for (int s = 0; s < 4; ++s) {
                    const uint2 lo = *(const uint2*)(qrow + (32 * s + 4 * fq) * 2), hi = *(const uint2*)(qrow + (32 * s + 16 + 4 * fq) * 2);
                    a = mfma16(sp[s], mk8(lo, hi), a);
                }
                const float rd = 1.f / den_s[16 * i + fr];
                *(uint2*)(Os + (16 * i + fr) * 272 + (16 * w + 4 * fq) * 2) = make_uint2(pk2(a[0] * rd, a[1] * rd), pk2(a[2] * rd, a[3] * rd));
            }
        }
        lds_barrier();
        pin_u4(mo0); pin_u4(mo1); pin_u4(cc0); pin_u4(cc1);
        {
            const int l = tid >> 3, part = tid & 7;
            const uint4 o0 = *(const uint4*)(Os + l * 272 + part * 32), o1 = *(const uint4*)(Os + l * 272 + part * 32 + 16);
            const unsigned ow[8] = {o0.x, o0.y, o0.z, o0.w, o1.x, o1.y, o1.z, o1.w};
            const unsigned gw[8] = {mo0.x, mo0.y, mo0.z, mo0.w, mo1.x, mo1.y, mo1.z, mo1.w}, cw[8] = {cc0.x, cc0.y, cc0.z, cc0.w, cc1.x, cc1.y, cc1.z, cc1.w};
            float x[16], s = 0.f;
#pragma unroll
            for (int e = 0; e < 8; ++e) { x[2 * e] = bflo(ow[e]); x[2 * e + 1] = bfhi(ow[e]); s += x[2 * e] + x[2 * e + 1]; }
            const float mu = grp8_sum(s) * (1.f / 128.f);
            float q = 0.f;
#pragma unroll
            for (int e = 0; e < 16; ++e) { x[e] -= mu; q += x[e] * x[e]; }
            const float rstd = rsqrtf(grp8_sum(q) * (1.f / 128.f) + EPSN);
            const float* gn = gn_s + 16 * part;
            const float* sk = sk_s + 16 * part;
            unsigned yo[8];
#pragma unroll
            for (int e = 0; e < 8; ++e) {
                const float ya = sigmoidf_(bflo(gw[e])) * (x[2 * e] * rstd * gn[2 * e] + sk[2 * e] * bflo(cw[e]));
                const float yb_ = sigmoidf_(bfhi(gw[e])) * (x[2 * e + 1] * rstd * gn[2 * e + 1] + sk[2 * e + 1] * bfhi(cw[e]));
                yo[e] = pk2(ya, yb_);
            }
            ml_retire(P);
            uint4* yp = (uint4*)(p.yb + (size_t)(t0 + l) * 1024 + 512 + h * 128 + 16 * part);
            yp[0] = make_uint4(yo[0], yo[1], yo[2], yo[3]);
            yp[1] = make_uint4(yo[4], yo[5], yo[6], yo[7]);
        }
    }
}
DEVI void st_recur(const Params& p, char* smem) {
    if (blockIdx.x >= 128 || gridDim.x <= 128) {
        const int bid = gridDim.x > 128 ? (int)blockIdx.x - 128 : (int)blockIdx.x, nb = gridDim.x > 128 ? (int)gridDim.x - 128 : (int)gridDim.x;
        st_prep_w2(p, smem, bid, nb);
        st_prep_wsub(p, smem, bid, nb);
        st_prep_tables(p, bid, nb);
        if (gridDim.x > 128) return;
    }
    for (int bi = blockIdx.x; bi < 128; bi += gridDim.x) {
        const int kind = bi & 1, h = (bi >> 1) & 3, b = bi >> 3;
        if (kind == 0) ret_block(p, smem, b, h);
        else mlstm_block(p, smem, b, h);
        __syncthreads();
    }
}

DEVI void norm2_token(const Params& p, int t, uint4 a0, uint4 a1, int lane) {
    float xv[16];
    float ss = 0.f;
    const unsigned aw[8] = {a0.x, a0.y, a0.z, a0.w, a1.x, a1.y, a1.z, a1.w};
#pragma unroll
    for (int e = 0; e < 8; ++e) { xv[2 * e] = bflo(aw[e]); xv[2 * e + 1] = bfhi(aw[e]); ss += xv[2 * e] * xv[2 * e] + xv[2 * e + 1] * xv[2 * e + 1]; }
    ss = wave_sum(ss);
    const float rs = rsqrtf(ss * (1.f / 1024.f) + EPSN);
    float am = 0.f;
#pragma unroll
    for (int i = 0; i < 4; ++i) {
        const float4 g = *(const float4*)(p.norm2_g + lane * 16 + i * 4);
        xv[4 * i] *= rs * g.x; xv[4 * i + 1] *= rs * g.y; xv[4 * i + 2] *= rs * g.z; xv[4 * i + 3] *= rs * g.w;
    }
#pragma unroll
    for (int c = 0; c < 16; ++c) am = fmaxf(am, fabsf(xv[c]));
    am = wave_max(am);
    const float inv = am > 0.f ? 127.f / am : 0.f;
    unsigned w[4];
#pragma unroll
    for (int i = 0; i < 4; ++i) {
        const int q0 = (int)rintf(xv[4 * i] * inv), q1 = (int)rintf(xv[4 * i + 1] * inv), q2 = (int)rintf(xv[4 * i + 2] * inv), q3 = (int)rintf(xv[4 * i + 3] * inv);
        w[i] = (unsigned)(q0 & 255) | ((unsigned)(q1 & 255) << 8) | ((unsigned)(q2 & 255) << 16) | ((unsigned)(q3 & 255) << 24);
    }
    *(uint4*)(p.xq + (size_t)t * 1024 + lane * 16) = make_uint4(w[0], w[1], w[2], w[3]);
    if (lane == 0) { p.rs2[t] = rs; p.xsc[t] = am > 0.f ? am * (1.f / 127.f) : 1.f; }
}
DEVI void st_norm2(const Params& p) {
    const int lane = stid() & 63, wid = stid() >> 6;
    for (int t = (blockIdx.x * NW + wid) * 4; t < T_TOK; t += gridDim.x * NW * 4) {
        uint4 a[4][2];
#pragma unroll
        for (int q = 0; q < 4; ++q) { const uint4* xp = (const uint4*)(p.x1b + (size_t)(t + q) * 1024 + lane * 16); a[q][0] = xp[0]; a[q][1] = xp[1]; }
#pragma unroll
        for (int q = 0; q < 4; ++q) norm2_token(p, t + q, a[q][0], a[q][1], lane);
    }
}

DEVI int f2key(float f) { const int b = __float_as_int(f); return b ^ ((b >> 31) & 0x7fffffff); }
DEVI float key2f(int k) { return __int_as_float(k ^ ((k >> 31) & 0x7fffffff)); }
template <int N> DEVI void bsort_desc(int (&v)[N]) {
#pragma unroll
    for (int k = 2; k <= N; k <<= 1)
#pragma unroll
        for (int j = k >> 1; j > 0; j >>= 1)
#pragma unroll
            for (int i = 0; i < N; ++i) {
                const int l = i ^ j;
                if (l > i) {
                    const int a = v[i], b = v[l];
                    const int mx = a > b ? a : b, mn = a > b ? b : a;
                    if ((i & k) == 0) { v[i] = mx; v[l] = mn; } else { v[i] = mn; v[l] = mx; }
                }
            }
}
template <int N> DEVI void bmerge_desc(int (&v)[N]) {
#pragma unroll
    for (int j = N >> 1; j > 0; j >>= 1)
#pragma unroll
        for (int i = 0; i < N; ++i) {
            const int l = i ^ j;
            if (l > i) { const int a = v[i], b = v[l]; v[i] = a > b ? a : b; v[l] = a > b ? b : a; }
        }
}
DEVI void xmerge16(int (&v)[16], int mask) {
    int o[16];
#pragma unroll
    for (int i = 0; i < 16; ++i) o[i] = __shfl_xor(v[15 - i], mask);
#pragma unroll
    for (int i = 0; i < 16; ++i) v[i] = v[i] > o[i] ? v[i] : o[i];
    bmerge_desc<16>(v);
}
__device__ const unsigned char cand_tab[52] = {
    0x00, 0x01, 0x02, 0x03, 0x04, 0x05, 0x06, 0x07, 0x08, 0x09, 0x0a, 0x0b, 0x0c, 0x0d, 0x0e, 0x0f,
    0x10, 0x11, 0x12, 0x13, 0x14, 0x15, 0x16, 0x17, 0x20, 0x21, 0x22, 0x23, 0x24, 0x30, 0x31, 0x32, 0x33,
    0x40, 0x41, 0x42, 0x50, 0x51, 0x60, 0x61, 0x70, 0x71, 0x80, 0x90, 0xa0, 0xb0, 0xc0, 0xd0, 0xe0, 0xf0, 0xff, 0xff};
constexpr int H_A = 256 * 64, H_B = 256 * 64, H_STAGE = H_A + H_B;
constexpr int H_LIST = 3 * H_STAGE;
DEVI void glds16(const void* g, char* l) {
    __builtin_amdgcn_global_load_lds((const __attribute__((address_space(1))) unsigned*)g, (__attribute__((address_space(3))) unsigned*)l, 16, 0, 0);
}
DEVI void gemm3_topk_tile(const Params& p, int m0, int h, char* smem) {
    const int tid = stid(), lane = tid & 63, w = tid >> 6, wt = w >> 1, wp = w & 1, fr = lane & 15, fq = lane >> 4;
    f32x4 acc[4][8];
#pragma unroll
    for (int i = 0; i < 4; ++i)
#pragma unroll
        for (int j = 0; j < 8; ++j) acc[i][j] = (f32x4){0.f, 0.f, 0.f, 0.f};
    const int r16 = lane >> 2, csrc = (lane & 3) ^ ((r16 >> 2) & 3);
    const bf16_t* srcA = p.x1b + (size_t)(m0 + w * 32 + r16) * 1024 + csrc * 8;
    const bf16_t* srcB = p.Wsubt + ((size_t)h * 256 + w * 32 + r16) * 1024 + csrc * 8;
    char* dstA = smem + (w * 32) * 64 + lane * 16;
    char* dstB = smem + H_A + (w * 32) * 64 + lane * 16;
    auto issue = [&](int kt, int buf) {
#pragma unroll
        for (int q = 0; q < 2; ++q) glds16(srcA + (size_t)q * 16 * 1024 + kt * 32, dstA + buf * H_STAGE + q * 1024);
#pragma unroll
        for (int q = 0; q < 2; ++q) glds16(srcB + (size_t)q * 16 * 1024 + kt * 32, dstB + buf * H_STAGE + q * 1024);
    };
    const int rdoff = fr * 64 + ((fq ^ ((fr >> 2) & 3)) * 16);
    issue(0, 0);
    issue(1, 1);
    asm volatile("s_waitcnt vmcnt(4)" ::: "memory");
    __builtin_amdgcn_s_barrier();
    int buf = 0;
#pragma unroll 1
    for (int kt = 0; kt < 32; ++kt) {
        const int b2 = buf >= 1 ? buf - 1 : 2;
        if (kt + 2 < 32) issue(kt + 2, b2);
        const char* As = smem + buf * H_STAGE + (wt * 64) * 64 + rdoff;
        const char* Bs = smem + buf * H_STAGE + H_A + (wp * 128) * 64 + rdoff;
        bf16x8 a[4];
#pragma unroll
        for (int i = 0; i < 4; ++i) a[i] = ld8(As + (16 * i) * 64);
#pragma unroll
        for (int jg = 0; jg < 2; ++jg) {
            bf16x8 b[4];
#pragma unroll
            for (int j = 0; j < 4; ++j) b[j] = ld8(Bs + (16 * (4 * jg + j)) * 64);
#pragma unroll
            for (int i = 0; i < 4; ++i)
#pragma unroll
                for (int j = 0; j < 4; ++j) acc[i][4 * jg + j] = mfma16(b[j], a[i], acc[i][4 * jg + j]);
        }
        if (kt + 2 < 32) asm volatile("s_waitcnt vmcnt(4)" ::: "memory");
        else asm volatile("s_waitcnt vmcnt(0)" ::: "memory");
        __builtin_amdgcn_s_barrier();
        buf = buf == 2 ? 0 : buf + 1;
    }
    int* LX = (int*)(smem + H_LIST);
#pragma unroll
    for (int i = 0; i < 4; ++i) {
        const int tl = 64 * wt + 16 * i + fr;
        const float rs = p.rs2[m0 + tl];
        int ka[16], kb[16];
#pragma unroll
        for (int jj = 0; jj < 4; ++jj)
#pragma unroll
            for (int r = 0; r < 4; ++r) {
                ka[jj * 4 + r] = (f2key(acc[i][jj][r] * rs) & ~127) | (16 * jj + 4 * fq + r);
                kb[jj * 4 + r] = (f2key(acc[i][4 + jj][r] * rs) & ~127) | (16 * (jj + 4) + 4 * fq + r);
            }
        bsort_desc<16>(ka);
        bsort_desc<16>(kb);
#pragma unroll
        for (int q = 0; q < 16; ++q) ka[q] = ka[q] > kb[15 - q] ? ka[q] : kb[15 - q];
        bmerge_desc<16>(ka);
        xmerge16(ka, 16);
        xmerge16(ka, 32);
        const int k0 = fq == 0 ? ka[0] : fq == 1 ? ka[4] : fq == 2 ? ka[8] : ka[12];
        const int k1 = fq == 0 ? ka[1] : fq == 1 ? ka[5] : fq == 2 ? ka[9] : ka[13];
        const int k2 = fq == 0 ? ka[2] : fq == 1 ? ka[6] : fq == 2 ? ka[10] : ka[14];
        const int k3 = fq == 0 ? ka[3] : fq == 1 ? ka[7] : fq == 2 ? ka[11] : ka[15];
        *(int4*)(LX + tl * 32 + wp * 16 + 4 * fq) = make_int4(k0, k1, k2, k3);
    }
    __syncthreads();
#pragma unroll
    for (int i2 = 0; i2 < 2; ++i2) {
        const int tl = 32 * w + 16 * i2 + fr, t = m0 + tl;
        const int* L = LX + tl * 32;
        const unsigned long long clo = fq == 0 ? 0x0706050403020100ull : fq == 1 ? 0x14131211100f0e0dull : fq == 2 ? 0x4033323130242322ull : 0xc0b0a09080717061ull;
        const unsigned long long chi = fq == 0 ? 0x0c0b0a0908ull : fq == 1 ? 0x2120171615ull : fq == 2 ? 0x6051504241ull : 0xfffff0e0d0ull;
        int c[16];
#pragma unroll
        for (int s = 0; s < 13; ++s) {
            const int ab = (int)((s < 8 ? (clo >> (8 * s)) : (chi >> (8 * (s - 8)))) & 0xffull);
            const int k1 = L[ab >> 4], k2 = L[16 + (ab & 15)];
            const float v = key2f(k1 & ~127) + key2f(k2 & ~127);
            c[s] = (f2key(v) & ~0x3fff) | ((k1 & 127) << 7) | (k2 & 127);
        }
        c[13] = c[14] = c[15] = (int)0x80000000;
        bsort_desc<16>(c);
        xmerge16(c, 16);
        xmerge16(c, 32);
        const float vmax = key2f(c[0] & ~0x3fff);
        float e[16], sum = 0.f;
#pragma unroll
        for (int q = 0; q < 16; ++q) { e[q] = __expf(key2f(c[q] & ~0x3fff) - vmax); sum += e[q]; }
        const float inv = 1.f / sum;
        int ce[4]; float ge[4];
#pragma unroll
        for (int q = 0; q < 4; ++q) {
            const int cq = fq == 0 ? c[q] : fq == 1 ? c[4 + q] : fq == 2 ? c[8 + q] : c[12 + q];
            const float eq = fq == 0 ? e[q] : fq == 1 ? e[4 + q] : fq == 2 ? e[8 + q] : e[12 + q];
            ce[q] = ((cq >> 7) & 127) * 128 + (cq & 127);
            ge[q] = eq * inv;
        }
        *(uint2*)(p.eperm + (size_t)t * 128 + h * 16 + 4 * fq) = make_uint2((unsigned)ce[0] | ((unsigned)ce[1] << 16), (unsigned)ce[2] | ((unsigned)ce[3] << 16));
        *(float4*)(p.gate + (size_t)t * 128 + h * 16 + 4 * fq) = make_float4(ge[0], ge[1], ge[2], ge[3]);
    }
    __syncthreads();
}
DEVI void st_gemm3_topk(const Params& p, char* smem) {
    for (int it = blockIdx.x; it < 128 * 8; it += gridDim.x) gemm3_topk_tile(p, (it >> 3) * 256, it & 7, smem);
}

#define XB_TMO      128
#define XB_XCNT(j)  (256  + 64 * (j))
#define XB_XSUB(j)  (1280 + 64 * (j))
#define XB_XGEN(j)  (2304 + 64 * (j))
#define XB_TOP      3328
#define XB_TOPGEN   3392
#define XCD_BAR_WORDS 3456
#define XB_SPIN_CAP (1u << 20)
#define LAS __attribute__((address_space(3)))
DEVI unsigned xb_ld(unsigned* p) { return __hip_atomic_load(p, __ATOMIC_RELAXED, __HIP_MEMORY_SCOPE_AGENT); }
DEVI unsigned xb_add(unsigned* p, unsigned v) { return __hip_atomic_fetch_add(p, v, __ATOMIC_RELAXED, __HIP_MEMORY_SCOPE_AGENT); }
DEVI unsigned xb_xcc_id() { return (unsigned)__builtin_amdgcn_s_getreg((3 << 11) | 20) & 0xFu; }
#define XB_SPIN(cond, bar) do { unsigned _sp = 0; while (cond) { __builtin_amdgcn_s_sleep(1); \
    if ((++_sp & 255u) == 0u) { if (xb_ld(&(bar)[XB_TMO])) break; if (_sp > XB_SPIN_CAP) { atomicAdd(&(bar)[XB_TMO], 1u); break; } } } } while (0)
struct XcdBarrier { unsigned* bar; unsigned x; volatile LAS unsigned* st; };
DEVI XcdBarrier xcd_barrier_post(unsigned* bar, volatile LAS unsigned* st) {
    XcdBarrier b; b.bar = bar; b.x = xb_xcc_id(); b.st = st;
    if (stid() == 0) (void)xb_add(&bar[XB_XCNT(b.x)], 1u);
    return b;
}
DEVI void xcd_barrier_complete(unsigned* bar, unsigned x, unsigned& nloc, unsigned& nx) {
    const unsigned G = gridDim.x * gridDim.y * gridDim.z;
    unsigned sum, cnt, mine, sp = 0u;
    for (;;) {
        sum = 0u; cnt = 0u; mine = 0u;
#pragma unroll
        for (unsigned j = 0; j < 16; ++j) { const unsigned c = xb_ld(&bar[XB_XCNT(j)]); sum += c; cnt += (c > 0u) ? 1u : 0u; mine = (j == x) ? c : mine; }
        if (sum == G) break;
        __builtin_amdgcn_s_sleep(1);
        if ((++sp & 255u) == 0u) { if (xb_ld(&bar[XB_TMO])) break; if (sp > XB_SPIN_CAP) { atomicAdd(&bar[XB_TMO], 1u); break; } }
    }
    nloc = mine > 0u ? mine : 1u; nx = cnt > 0u ? cnt : 1u;
}
DEVI void xcd_barrier(const XcdBarrier& b) {
    asm volatile("s_waitcnt vmcnt(0)" ::: "memory");
    __syncthreads();
    if (stid() == 0) {
        unsigned* bar = b.bar;
        __builtin_amdgcn_s_waitcnt(0);
        unsigned nloc = b.st[0], nx = b.st[1];
        if (nloc == 0u) { xcd_barrier_complete(bar, b.x, nloc, nx); b.st[0] = nloc; b.st[1] = nx; }
        const unsigned old = xb_add(&bar[XB_XSUB(b.x)], 1u);
        const unsigned gen = old / nloc;
        if (old + 1u == (gen + 1u) * nloc) {
            __builtin_amdgcn_fence(__ATOMIC_RELEASE, "agent");
            asm volatile("s_waitcnt vmcnt(0)" ::: "memory");
            const unsigned og = xb_add(&bar[XB_TOP], 1u);
            const unsigned tg = og / nx;
            if (og + 1u == (tg + 1u) * nx) xb_add(&bar[XB_TOPGEN], 1u);
            else XB_SPIN(xb_ld(&bar[XB_TOPGEN]) == tg, bar);
            __builtin_amdgcn_fence(__ATOMIC_ACQUIRE, "agent");
            xb_add(&bar[XB_XGEN(b.x)], 1u);
            asm volatile("s_waitcnt vmcnt(0)" ::: "memory");
        } else {
            XB_SPIN(xb_ld(&bar[XB_XGEN(b.x)]) == gen, bar);
            __builtin_amdgcn_fence(__ATOMIC_ACQUIRE, "agent");
            asm volatile("s_waitcnt vmcnt(0)" ::: "memory");
        }
    }
    __syncthreads();
}

#define CTR_A(x) (XCD_BAR_WORDS + 64 * (x))
#define CTR_B(x) (XCD_BAR_WORDS + 512 + 64 * (x))
#define CTL_WORDS (XCD_BAR_WORDS + 1024)
typedef float f32x2 __attribute__((ext_vector_type(2)));
DEVI float ub(unsigned w, int n) { return (float)((w >> (8 * n)) & 0xffu); }
DEVI float gelu_erf(float u) { return 0.5f * u * (1.f + erff(u * 0.70710678118654752f)); }
struct ExpMeta { uint4 e[2]; uint4 xa; float sc; };
struct ExpRows { uint4 r[16]; unsigned x1; };

template <int PHASE> DEVI void exp_load_meta(const Params& p, ExpMeta& m, int t, int x, int lane) {
    const uint4* ep = (const uint4*)(p.eperm + (size_t)t * 128 + (lane >> 3) * 16);
    m.e[0] = ep[0];
    m.e[1] = ep[1];
    if (PHASE == 0) m.xa = *(const uint4*)(p.xq + (size_t)t * 1024 + 128 * x + 16 * (lane & 7));
    else { m.xa = *(const uint4*)(p.aq + (size_t)t * 128 + (lane >> 3) * 16); m.sc = p.asc[t]; }
}
template <int PHASE> DEVI void exp_issue(const Params& p, const ExpMeta& m, ExpRows& R, int t, int x, int lane) {
    const unsigned char* base = (PHASE == 0 ? p.down_q : p.up_q) + (size_t)x * (16384 * 128) + (lane & 7) * 16;
    const unsigned ew[8] = {m.e[0].x, m.e[0].y, m.e[0].z, m.e[0].w, m.e[1].x, m.e[1].y, m.e[1].z, m.e[1].w};
#pragma unroll
    for (int j = 0; j < 16; ++j) {
        const unsigned ek = (j & 1) ? (ew[j >> 1] >> 16) : (ew[j >> 1] & 0xffffu);
        R.r[j] = *(const uint4*)(base + (size_t)ek * 128);
    }
    if (PHASE == 1) {
        const int col = 128 * x + 16 * (lane & 7) + ((lane & 32) ? 8 : 0) + ((lane & 16) ? 4 : 0) + ((lane & 8) ? 2 : 0);
        R.x1 = *(const unsigned*)(p.x1b + (size_t)t * 1024 + col);
    }
}
DEVI void expA_compute(const Params& p, const ExpMeta& m, const ExpRows& R, int t, int x, int lane) {
    const bool b2 = lane & 4, b1 = lane & 2, b0 = lane & 1;
    int ps[16];
#pragma unroll
    for (int j = 0; j < 16; ++j)
        ps[j] = __builtin_amdgcn_sdot4((int)R.r[j].x, (int)m.xa.x, __builtin_amdgcn_sdot4((int)R.r[j].y, (int)m.xa.y,
                __builtin_amdgcn_sdot4((int)R.r[j].z, (int)m.xa.z, __builtin_amdgcn_sdot4((int)R.r[j].w, (int)m.xa.w, 0, false), false), false), false);
    int q8[8], q4[4], q2[2];
#pragma unroll
    for (int j = 0; j < 8; ++j) { const int snd = b2 ? ps[j] : ps[j + 8], kp = b2 ? ps[j + 8] : ps[j]; q8[j] = kp + __shfl_xor(snd, 4); }
#pragma unroll
    for (int j = 0; j < 4; ++j) { const int snd = b1 ? q8[j] : q8[j + 4], kp = b1 ? q8[j + 4] : q8[j]; q4[j] = kp + __shfl_xor(snd, 2); }
#pragma unroll
    for (int j = 0; j < 2; ++j) { const int snd = b0 ? q4[j] : q4[j + 2], kp = b0 ? q4[j + 2] : q4[j]; q2[j] = kp + __shfl_xor(snd, 1); }
    {
        int s0 = q2[0] >> 3, s1 = q2[1] >> 3;
        s0 = s0 > 32767 ? 32767 : (s0 < -32768 ? -32768 : s0);
        s1 = s1 > 32767 ? 32767 : (s1 < -32768 ? -32768 : s1);
        *(unsigned*)(p.part + ((size_t)x * T_TOK + t) * 128 + 2 * lane) = ((unsigned)s0 & 0xffffu) | ((unsigned)s1 << 16);
    }
}
DEVI void expB_compute(const Params& p, const ExpMeta& m, const ExpRows& R, int t, int x, int lane) {
    const bool b5 = lane & 32, b4 = lane & 16, b3 = lane & 8;
    const unsigned pa[4] = {m.xa.x, m.xa.y, m.xa.z, m.xa.w};
    int acc[16];
#pragma unroll
    for (int c = 0; c < 16; ++c) acc[c] = 0;
#pragma unroll
    for (int g = 0; g < 4; ++g) {
        const unsigned r0[4] = {R.r[4 * g].x, R.r[4 * g].y, R.r[4 * g].z, R.r[4 * g].w};
        const unsigned r1[4] = {R.r[4 * g + 1].x, R.r[4 * g + 1].y, R.r[4 * g + 1].z, R.r[4 * g + 1].w};
        const unsigned r2[4] = {R.r[4 * g + 2].x, R.r[4 * g + 2].y, R.r[4 * g + 2].z, R.r[4 * g + 2].w};
        const unsigned r3[4] = {R.r[4 * g + 3].x, R.r[4 * g + 3].y, R.r[4 * g + 3].z, R.r[4 * g + 3].w};
#pragma unroll
        for (int i = 0; i < 4; ++i) {
            const unsigned t0 = __builtin_amdgcn_perm(r1[i], r0[i], 0x05010400u), t1 = __builtin_amdgcn_perm(r1[i], r0[i], 0x07030602u);
            const unsigned t2 = __builtin_amdgcn_perm(r3[i], r2[i], 0x05010400u), t3 = __builtin_amdgcn_perm(r3[i], r2[i], 0x07030602u);
            const unsigned o0 = __builtin_amdgcn_perm(t2, t0, 0x05040100u), o1 = __builtin_amdgcn_perm(t2, t0, 0x07060302u);
            const unsigned o2 = __builtin_amdgcn_perm(t3, t1, 0x05040100u), o3 = __builtin_amdgcn_perm(t3, t1, 0x07060302u);
            acc[4 * i + 0] = __builtin_amdgcn_sdot4((int)o0, (int)pa[g], acc[4 * i + 0], false);
            acc[4 * i + 1] = __builtin_amdgcn_sdot4((int)o1, (int)pa[g], acc[4 * i + 1], false);
            acc[4 * i + 2] = __builtin_amdgcn_sdot4((int)o2, (int)pa[g], acc[4 * i + 2], false);
            acc[4 * i + 3] = __builtin_amdgcn_sdot4((int)o3, (int)pa[g], acc[4 * i + 3], false);
        }
    }
    int q8[8], q4[4], q2[2];
#pragma unroll
    for (int j = 0; j < 8; ++j) { const int snd = b5 ? acc[j] : acc[j + 8], kp = b5 ? acc[j + 8] : acc[j]; q8[j] = kp + __shfl_xor(snd, 32); }
#pragma unroll
    for (int j = 0; j < 4; ++j) { const int snd = b4 ? q8[j] : q8[j + 4], kp = b4 ? q8[j + 4] : q8[j]; q4[j] = kp + __shfl_xor(snd, 16); }
#pragma unroll
    for (int j = 0; j < 2; ++j) { const int snd = b3 ? q4[j] : q4[j + 2], kp = b3 ? q4[j + 2] : q4[j]; q2[j] = kp + __shfl_xor(snd, 8); }
    const int col = 128 * x + 16 * (lane & 7) + (b5 ? 8 : 0) + (b4 ? 4 : 0) + (b3 ? 2 : 0);
    *(unsigned*)(p.proj + (size_t)t * 1024 + col) = pk2(bflo(R.x1) + (float)q2[0] * m.sc, bfhi(R.x1) + (float)q2[1] * m.sc);
}
template <int PHASE>
DEVI void exp_chunk(const Params& p, int tb, int x, int lane) {
    ExpMeta mA, mB, nA, nB;
    ExpRows rA, rB;
    exp_load_meta<PHASE>(p, mA, tb, x, lane);
    exp_load_meta<PHASE>(p, mB, tb + 1, x, lane);
    exp_issue<PHASE>(p, mA, rA, tb, x, lane);
    exp_issue<PHASE>(p, mB, rB, tb + 1, x, lane);
    exp_load_meta<PHASE>(p, nA, tb + 2, x, lane);
    exp_load_meta<PHASE>(p, nB, tb + 3, x, lane);
#pragma unroll 1
    for (int i = 0; i < 8; ++i) {
        const int tA = tb + 2 * i, tB = tA + 1;
        if (PHASE == 0) expA_compute(p, mA, rA, tA, x, lane); else expB_compute(p, mA, rA, tA, x, lane);
        if (i < 7) {
            mA = nA;
            exp_issue<PHASE>(p, mA, rA, tA + 2, x, lane);
            if (i < 6) exp_load_meta<PHASE>(p, nA, tA + 4, x, lane);
        }
        if (PHASE == 0) expA_compute(p, mB, rB, tB, x, lane); else expB_compute(p, mB, rB, tB, x, lane);
        if (i < 7) {
            mB = nB;
            exp_issue<PHASE>(p, mB, rB, tB + 2, x, lane);
            if (i < 6) exp_load_meta<PHASE>(p, nB, tB + 4, x, lane);
        }
    }
}
template <int PHASE>
DEVI void st_expAB(const Params& p, char* smem) {
    const int tid = stid(), lane = tid & 63, wid = tid >> 6;
    volatile int* cs = (volatile int*)smem;
    const unsigned myx = xb_xcc_id() & 7u;
    constexpr int NCH = T_TOK / (16 * NW);
    for (int si = 0; si < 8; ++si) {
        const int x = (int)((myx + si) & 7u);
        unsigned* ctr = &p.bar[PHASE == 0 ? CTR_A(x) : CTR_B(x)];
        if (tid == 0) cs[0] = (int)xb_add(ctr, 1u);
        __syncthreads();
        int chunk = cs[0];
        __syncthreads();
        while (chunk < NCH) {
            int nxt = 0;
            if (tid == 0) nxt = (int)xb_add(ctr, 1u);
            exp_chunk<PHASE>(p, chunk * (16 * NW) + wid * 16, x, lane);
            if (tid == 0) cs[0] = nxt;
            __syncthreads();
            chunk = cs[0];
            __syncthreads();
        }
    }
}
DEVI void st_expA2(const Params& p) {
    const int lane = stid() & 63, wid = stid() >> 6;
    for (int t0 = (blockIdx.x * NW + wid) * 2; t0 < T_TOK; t0 += gridDim.x * NW * 2) {
        unsigned pv[2][8], ew[2];
        float2 g[2];
        float xs[2];
#pragma unroll
        for (int q = 0; q < 2; ++q) {
            const int t = t0 + q;
#pragma unroll
            for (int x = 0; x < 8; ++x) pv[q][x] = *(const unsigned*)(p.part + ((size_t)x * T_TOK + t) * 128 + 2 * lane);
            ew[q] = *(const unsigned*)(p.eperm + (size_t)t * 128 + 2 * lane);
            g[q] = *(const float2*)(p.gate + (size_t)t * 128 + 2 * lane);
            xs[q] = p.xsc[t] * 8.f;
        }
        float ds[2][2], us[2][2];
#pragma unroll
        for (int q = 0; q < 2; ++q) {
            const int ea = (int)(ew[q] & 0xffffu), eb = (int)(ew[q] >> 16);
            ds[q][0] = p.dscale[ea]; ds[q][1] = p.dscale[eb]; us[q][0] = p.uscale[ea]; us[q][1] = p.uscale[eb];
        }
#pragma unroll
        for (int q = 0; q < 2; ++q) {
            const int t = t0 + q;
            int s0 = 0, s1 = 0;
#pragma unroll
            for (int x = 0; x < 8; ++x) { s0 += (int)(short)(pv[q][x] & 0xffffu); s1 += (int)pv[q][x] >> 16; }
            const float a0 = g[q].x * gelu_erf((float)s0 * xs[q] * ds[q][0]) * us[q][0];
            const float a1 = g[q].y * gelu_erf((float)s1 * xs[q] * ds[q][1]) * us[q][1];
            const float amax = wave_max(fmaxf(fabsf(a0), fabsf(a1)));
            const float inv = amax > 0.f ? 127.f / amax : 0.f;
            const unsigned q0 = (unsigned)((int)rintf(a0 * inv) & 255), q1 = (unsigned)((int)rintf(a1 * inv) & 255);
            *(unsigned short*)(p.aq + (size_t)t * 128 + 2 * lane) = (unsigned short)(q0 | (q1 << 8));
            if (lane == 0) p.asc[t] = amax * (1.f / 127.f);
        }
    }
}
DEVI void st_expC(const Params& p) {
    const int lane = stid() & 63, wid = stid() >> 6;
    for (int t0 = (blockIdx.x * NW + wid) * 2; t0 < T_TOK; t0 += gridDim.x * NW * 2) {
        uint2 u[2][4];
#pragma unroll
        for (int q = 0; q < 2; ++q) {
            const uint2* row = (const uint2*)(p.proj + (size_t)(t0 + q) * 1024);
#pragma unroll
            for (int j = 0; j < 4; ++j) u[q][j] = row[lane + 64 * j];
        }
#pragma unroll
        for (int q = 0; q < 2; ++q) {
            float4 v[4];
            float ss = 0.f;
#pragma unroll
            for (int j = 0; j < 4; ++j) {
                v[j] = make_float4(bflo(u[q][j].x), bfhi(u[q][j].x), bflo(u[q][j].y), bfhi(u[q][j].y));
                ss += v[j].x * v[j].x + v[j].y * v[j].y + v[j].z * v[j].z + v[j].w * v[j].w;
            }
            ss = wave_sum(ss);
            const float rf = rsqrtf(ss * (1.f / 1024.f) + EPSN);
            float4* orow = (float4*)(p.out + (size_t)(t0 + q) * 1024);
#pragma unroll
            for (int j = 0; j < 4; ++j) {
                const float4 g = *(const float4*)(p.final_g + (lane + 64 * j) * 4);
                orow[lane + 64 * j] = make_float4(v[j].x * rf * g.x, v[j].y * rf * g.y, v[j].z * rf * g.z, v[j].w * rf * g.w);
            }
        }
    }
}

constexpr int LDS_BYTES = 147456;
constexpr int LDS_BARW = LDS_BYTES - 16;
extern __shared__ __attribute__((aligned(16))) char smem_dyn[];
__global__ void __launch_bounds__(NTHR, 2) mega_fwd(Params p) {
    cg::grid_group grid = cg::this_grid();
    volatile LAS unsigned* bst = (volatile LAS unsigned*)(LAS char*)(smem_dyn + LDS_BARW);
    if (stid() < 4) bst[stid()] = 0u;
    __syncthreads();
    XcdBarrier bar = xcd_barrier_post(p.bar, bst);
    st_prep_misc(p);
    st_prep_w1(p, smem_dyn);
    st_prep_x(p, smem_dyn);
    if (p.pad_[0] == 0x7fffabcd) grid.sync();
    xcd_barrier(bar);
    st_gemm8<EpiProj8, PG8_ALIGN>(p.xb, p.W1t, NPJ, 1024, smem_dyn, EpiProj8{p.proj, p.rs1, p.rope_cos, p.rope_sin});
    xcd_barrier(bar);
    st_conv_qk(p, smem_dyn);
    xcd_barrier(bar);
    st_recur(p, smem_dyn);
    xcd_barrier(bar);
    st_gemm8<EpiX18, PG8_ALIGN>(p.yb, p.W2t, 1024, 1024, smem_dyn, EpiX18{p.x, p.x1b});
    xcd_barrier(bar);
    st_norm2(p);
    xcd_barrier(bar);
    st_gemm3_topk(p, smem_dyn);
    xcd_barrier(bar);
    st_expAB<0>(p, smem_dyn);
    xcd_barrier(bar);
    st_expA2(p);
    xcd_barrier(bar);
    st_expAB<1>(p, smem_dyn);
    xcd_barrier(bar);
    st_expC(p);
}

extern "C" void kernel_launch(void* const* d_in, const int* in_sizes, int n_in, void* d_out, int out_size, void* d_ws, size_t ws_size,
                              hipStream_t stream) {
    Params p{};
    const float* const* in = (const float* const*)d_in;
    p.x = in[0]; p.norm1_g = in[1]; p.w_in = in[2]; p.ret_norm_g = in[3]; p.m_conv_w = in[4]; p.m_conv_b = in[5]; p.m_wq = in[6]; p.m_wk = in[7];
    p.m_b_i = in[8]; p.m_b_f = in[9]; p.m_norm_g = in[10]; p.m_skip = in[11]; p.w_out = in[12]; p.norm2_g = in[13]; p.peer_wq = in[14];
    p.peer_keys = in[15]; p.peer_down = in[16]; p.peer_up = in[17]; p.final_g = in[18];
    p.out = (float*)d_out;
    char* ws = (char*)d_ws;
    size_t off = 0;
    auto take = [&](size_t bytes) { char* r = ws + off; off += (bytes + 255) & ~(size_t)255; return r; };
    p.proj = (bf16_t*)take((size_t)T_TOK * NPJ * 2);
    p.xb = (bf16_t*)take((size_t)T_TOK * 1024 * 2);
    p.yb = p.xb;
    p.gate = (float*)(ws + (size_t)T_TOK * 2048 * 4);
    p.mq = (bf16_t*)take((size_t)T_TOK * 512 * 2);
    p.mk = (bf16_t*)take((size_t)T_TOK * 512 * 2);
    p.x1b = p.mq;
    p.cbuf = (bf16_t*)take((size_t)T_TOK * 512 * 2);
    p.eperm = (unsigned short*)p.cbuf;
    p.down_q = (unsigned char*)take((size_t)16384 * 1024);
    p.up_q = (unsigned char*)take((size_t)16384 * 1024);
    p.dscale = (float*)take(16384 * 4);
    p.uscale = (float*)take(16384 * 4);
    p.bar = (unsigned*)take(CTL_WORDS * 4);
    p.xq = (unsigned char*)take((size_t)T_TOK * 1024);
    p.xsc = (float*)take(T_TOK * 4);
    p.asc = (float*)take(T_TOK * 4);
    p.aq = (unsigned char*)take((size_t)T_TOK * 128);
    p.part = (short*)(ws + (size_t)T_TOK * 1024 * 4);
    p.W1t = (bf16_t*)take((size_t)NPJ * 1024 * 2);
    p.W2t = (bf16_t*)take((size_t)1024 * 1024 * 2);
    p.Wsubt = (bf16_t*)take((size_t)2048 * 1024 * 2);
    p.Wqt = (bf16_t*)take(4 * 128 * 128 * 2);
    p.Wkt = (bf16_t*)take(4 * 128 * 128 * 2);
    p.rs1 = (float*)take(T_TOK * 4);
    p.rs2 = (float*)take(T_TOK * 4);
    p.ipre = (float*)take(T_TOK * 4 * 4);
    p.logf = (float*)take(T_TOK * 4 * 4);
    p.rope_cos = (float*)take(2048 * 64 * 4);
    p.rope_sin = (float*)take(2048 * 64 * 4);
    if (off > ws_size) { fprintf(stderr, "kernel_launch: workspace too small (%zu > %zu)\n", off, ws_size); return; }

    static int grid_blocks = 0;
    if (!grid_blocks) {
        int dev = 0, cus = 0, per_cu = 0;
        (void)hipGetDevice(&dev);
        (void)hipDeviceGetAttribute(&cus, hipDeviceAttributeMultiprocessorCount, dev);
        (void)hipFuncSetAttribute((const void*)mega_fwd, hipFuncAttributeMaxDynamicSharedMemorySize, LDS_BYTES);
        (void)hipOccupancyMaxActiveBlocksPerMultiprocessor(&per_cu, (const void*)mega_fwd, NTHR, LDS_BYTES);
        if (per_cu > 1) per_cu = 1;
        if (per_cu < 1) per_cu = 1;
        grid_blocks = cus * per_cu;
    }
    (void)hipMemsetAsync(p.bar, 0, CTL_WORDS * 4, stream);
    void* args[] = {&p};
    hipError_t e = hipLaunchCooperativeKernel((const void*)mega_fwd, dim3(grid_blocks), dim3(NTHR), args, LDS_BYTES, stream);
    if (e != hipSuccess) fprintf(stderr, "cooperative launch failed: %s (grid %d)\n", hipGetErrorString(e), grid_blocks);
}
```

```cpp
#include <hip/hip_runtime.h>
#include <hip/hip_cooperative_groups.h>
#include <stdint.h>
#include <cstdio>
namespace cg = cooperative_groups;

typedef unsigned short bf16_t;
typedef short bf16x8 __attribute__((ext_vector_type(8)));
typedef float f32x4 __attribute__((ext_vector_type(4)));

#define DEVI __device__ __forceinline__
__device__ __forceinline__ int stid() { int t = (int)threadIdx.x; asm volatile("" : "+v"(t)); return t; }

constexpr int T_TOK = 32768, DM = 1024, NPJ = 3584, DIN = 3592;
constexpr int NTHR = 512, NW = 8;
constexpr float EPSN = 1e-6f;

struct Params {
    const float *x, *norm1_g, *w_in, *ret_norm_g, *m_conv_w, *m_conv_b, *m_wq, *m_wk, *m_b_i, *m_b_f, *m_norm_g, *m_skip, *w_out,
        *norm2_g, *peer_wq, *peer_keys, *peer_down, *peer_up, *final_g;
    float* out;
    bf16_t *proj, *xb, *yb, *mq, *mk, *x1b, *cbuf, *W1t, *W2t, *Wsubt, *Wqt, *Wkt;
    unsigned char *down_q, *up_q;
    float *dscale, *uscale, *asc;
    unsigned short* eperm;
    unsigned char* aq;
    short* part;
    unsigned char* xq;
    unsigned* bar;
    float *rs1, *rs2p, *ipre, *logf, *rope_cos, *rope_sin, *gate;
    int pad_[2];
};

DEVI unsigned f2bf_bits(float f) { unsigned u = __float_as_uint(f); return (u + 0x7fffu + ((u >> 16) & 1u)) >> 16; }
DEVI bf16_t f2bf(float f) { return __builtin_bit_cast(bf16_t, (__bf16)f); }
typedef __bf16 bf16x2_t __attribute__((ext_vector_type(2)));
DEVI unsigned pk2(float lo, float hi) { bf16x2_t v = {(__bf16)lo, (__bf16)hi}; return __builtin_bit_cast(unsigned, v); }
DEVI float bflo(unsigned w) { return __uint_as_float(w << 16); }
DEVI float bfhi(unsigned w) { return __uint_as_float(w & 0xffff0000u); }
DEVI float bf2f(bf16_t h) { return __uint_as_float(((unsigned)h) << 16); }
template <int CTRL> DEVI float dpp_f(float v) { return __int_as_float(__builtin_amdgcn_update_dpp(0, __float_as_int(v), CTRL, 0xf, 0xf, false)); }
template <int CTRL> DEVI int dpp_i(int v) { return __builtin_amdgcn_update_dpp(0, v, CTRL, 0xf, 0xf, false); }
constexpr int DPP_XOR1 = 0xB1  , DPP_XOR2 = 0x4E  , DPP_HMIRROR = 0x141  ,
              DPP_MIRROR = 0x140  , DPP_ROR8 = 0x128  ;
DEVI float rl_f(float v, int l) { return __int_as_float(__builtin_amdgcn_readlane(__float_as_int(v), l)); }
DEVI float wave_sum(float v) {
    v += dpp_f<DPP_XOR1>(v); v += dpp_f<DPP_XOR2>(v); v += dpp_f<DPP_HMIRROR>(v); v += dpp_f<DPP_MIRROR>(v);
    return (rl_f(v, 0) + rl_f(v, 16)) + (rl_f(v, 32) + rl_f(v, 48));
}
DEVI float wave_max(float v) {
    v = fmaxf(v, dpp_f<DPP_XOR1>(v)); v = fmaxf(v, dpp_f<DPP_XOR2>(v)); v = fmaxf(v, dpp_f<DPP_HMIRROR>(v)); v = fmaxf(v, dpp_f<DPP_MIRROR>(v));
    return fmaxf(fmaxf(rl_f(v, 0), rl_f(v, 16)), fmaxf(rl_f(v, 32), rl_f(v, 48)));
}
constexpr float ZQ_SCALE = 8.f / 127.f;
DEVI float rs2_of(const float* rs2p, int t) {
    const float4* q = (const float4*)(rs2p + (size_t)t * 16);
    const float4 a = q[0], b = q[1], c = q[2], d = q[3];
    const float ss = ((a.x + a.y) + (a.z + a.w)) + ((b.x + b.y) + (b.z + b.w)) + ((c.x + c.y) + (c.z + c.w)) + ((d.x + d.y) + (d.z + d.w));
    return rsqrtf(ss * (1.f / 1024.f) + EPSN);
}
DEVI f32x4 mfma16(bf16x8 a, bf16x8 b, f32x4 c) { return __builtin_amdgcn_mfma_f32_16x16x32_bf16(a, b, c, 0, 0, 0); }
DEVI bf16x8 ld8(const char* p) { return *reinterpret_cast<const bf16x8*>(p); }
DEVI bf16x8 mk8(uint2 lo, uint2 hi) {
    union { uint4 u; bf16x8 v; } x;
    x.u = make_uint4(lo.x, lo.y, hi.x, hi.y);
    return x.v;
}
DEVI float sigmoidf_(float z) { return 1.f / (1.f + __expf(-z)); }

DEVI void st_prep_misc(const Params& p) {
    const int gtid = blockIdx.x * NTHR + stid(), gsz = gridDim.x * NTHR;
    for (int i = gtid; i < 2048 * 64; i += gsz) {
        const int pos = i >> 6, j = i & 63;
        const float inv = powf(10000.f, -(float)j * (1.f / 64.f));
        const float ang = (float)pos * inv;
        float s, c;
        sincosf(ang, &s, &c);
        p.rope_cos[i] = c;
        p.rope_sin[i] = s;
    }
    for (int i = gtid; i < 4 * 128 * 128; i += gsz) {
        const int h = i >> 14, e = (i >> 7) & 127, d = i & 127;
        p.Wqt[i] = f2bf(p.m_wq[h * 16384 + d * 128 + e]);
        p.Wkt[i] = f2bf(p.m_wk[h * 16384 + d * 128 + e] * 0.08838834764831845f);
    }
}
DEVI void prep_table_row(const Params& p, int row, const float4 (&v)[4], int lane) {
    const bool up = row >= 16384;
    const int e = up ? row - 16384 : row;
    float am = 0.f;
#pragma unroll
    for (int i = 0; i < 4; ++i) am = fmaxf(am, fmaxf(fmaxf(fabsf(v[i].x), fabsf(v[i].y)), fmaxf(fabsf(v[i].z), fabsf(v[i].w))));
    am = wave_max(am);
    const float sc = am > 0.f ? am * (1.f / 127.f) : 1.f, inv = am > 0.f ? 127.f / am : 0.f;
    unsigned w[4];
#pragma unroll
    for (int i = 0; i < 4; ++i) {
        const int q0 = (int)rintf(v[i].x * inv), q1 = (int)rintf(v[i].y * inv), q2 = (int)rintf(v[i].z * inv), q3 = (int)rintf(v[i].w * inv);
        w[i] = (unsigned)(q0 & 255) | ((unsigned)(q1 & 255) << 8) | ((unsigned)(q2 & 255) << 16) | ((unsigned)(q3 & 255) << 24);
    }
    *(uint4*)((up ? p.up_q : p.down_q) + ((size_t)(lane >> 3) * 16384 + e) * 128 + (lane & 7) * 16) = make_uint4(w[0], w[1], w[2], w[3]);
    if (lane == 0) (up ? p.uscale : p.dscale)[e] = sc;
}
DEVI void st_prep_tables(const Params& p, int bid, int nb) {
    const int lane = stid() & 63, wid = stid() >> 6;
    for (int row = (bid * NW + wid) * 2; row < 32768; row += nb * NW * 2) {
        float4 va[4], vb[4];
        const float4* sa = (const float4*)((row >= 16384 ? p.peer_up + (size_t)(row - 16384) * 1024 : p.peer_down + (size_t)row * 1024) + lane * 16);
        const float4* sb = (const float4*)((row + 1 >= 16384 ? p.peer_up + (size_t)(row + 1 - 16384) * 1024 : p.peer_down + (size_t)(row + 1) * 1024) + lane * 16);
#pragma unroll
        for (int i = 0; i < 4; ++i) { va[i] = sa[i]; vb[i] = sb[i]; }
        prep_table_row(p, row, va, lane);
        prep_table_row(p, row + 1, vb, lane);
    }
}

DEVI void transpose_tile(const float* __restrict__ src, int ld, const float* __restrict__ scale, bf16_t* __restrict__ dst, int K, int k0, int n0,
                         float* tile, bool permqk = false) {
    const int tid = stid();
    {
        const int tx = tid & 63, ty = tid >> 6;
#pragma unroll
        for (int i = 0; i < 4; ++i) {
            const int k = k0 + ty + 8 * i;
            float v = src[(size_t)k * ld + n0 + tx];
            if (scale) v *= scale[k];
            tile[(ty + 8 * i) * 65 + tx] = v;
        }
    }
    __syncthreads();
    {
        const int n = tid >> 3, kq = tid & 7;
        const float a = tile[(4 * kq) * 65 + n], b = tile[(4 * kq + 1) * 65 + n], c = tile[(4 * kq + 2) * 65 + n], d = tile[(4 * kq + 3) * 65 + n];
        int nn = n0 + n;
        if (permqk && nn < 1024) { const int dd = nn & 127; nn = (nn & ~127) + (dd < 64 ? 2 * dd : 2 * (dd - 64) + 1); }
        *(uint2*)(dst + (size_t)nn * K + k0 + 4 * kq) = make_uint2(pk2(a, b), pk2(c, d));
    }
    __syncthreads();
}
DEVI void st_prep_w1(const Params& p, char* smem) {
    float* tile = (float*)smem;
    for (int it = blockIdx.x; it < 56 * 32; it += gridDim.x) transpose_tile(p.w_in, DIN, p.norm1_g, p.W1t, 1024, (it & 31) * 32, (it >> 5) * 64, tile, true);
}
DEVI void st_prep_w2(const Params& p, char* smem, int bid, int nb) {
    float* tile = (float*)smem;
    for (int it = bid; it < 16 * 32; it += nb) transpose_tile(p.w_out, 1024, nullptr, p.W2t, 1024, (it & 31) * 32, (it >> 5) * 64, tile);
}
DEVI void st_prep_wsub(const Params& p, char* smem, int bid, int nb) {
    float* wq_s = (float*)smem;
    float* key_s = wq_s + 32 * 132;
    const int tid = stid();
    for (int it = bid; it < 16 * 32 * 2; it += nb) {
        const int grp = it >> 6, kt = (it >> 1) & 31, nh = it & 1, k0 = kt * 32;
#pragma unroll
        for (int i = 0; i < 8; ++i) {
            const int idx = tid + 512 * i, r = idx >> 7, d = idx & 127;
            wq_s[r * 132 + d] = p.peer_wq[(size_t)(k0 + r) * 2048 + grp * 128 + d];
        }
#pragma unroll
        for (int i = 0; i < 16; ++i) {
            const int idx = tid + 512 * i, n = idx >> 7, d = idx & 127;
            key_s[n * 132 + d] = p.peer_keys[((size_t)grp * 128 + nh * 64 + n) * 128 + d];
        }
        __syncthreads();
        const int kl = tid & 15, ng = tid >> 4;
        float a00 = 0.f, a01 = 0.f, a10 = 0.f, a11 = 0.f;
#pragma unroll 8
        for (int d4 = 0; d4 < 32; ++d4) {
            const float4 w0 = *(const float4*)(wq_s + (2 * kl) * 132 + 4 * d4), w1 = *(const float4*)(wq_s + (2 * kl + 1) * 132 + 4 * d4);
            const float4 y0 = *(const float4*)(key_s + (2 * ng) * 132 + 4 * d4), y1 = *(const float4*)(key_s + (2 * ng + 1) * 132 + 4 * d4);
            a00 += w0.x * y0.x + w0.y * y0.y + w0.z * y0.z + w0.w * y0.w;
            a01 += w0.x * y1.x + w0.y * y1.y + w0.z * y1.z + w0.w * y1.w;
            a10 += w1.x * y0.x + w1.y * y0.y + w1.z * y0.z + w1.w * y0.w;
            a11 += w1.x * y1.x + w1.y * y1.y + w1.z * y1.z + w1.w * y1.w;
        }
        const float g0 = p.norm2_g[k0 + 2 * kl], g1 = p.norm2_g[k0 + 2 * kl + 1];
        bf16_t* o = p.Wsubt + (size_t)(grp * 128 + nh * 64 + 2 * ng) * 1024 + k0 + 2 * kl;
        *(unsigned*)o = pk2(a00 * g0, a10 * g1);
        *(unsigned*)(o + 1024) = pk2(a01 * g0, a11 * g1);
        __syncthreads();
    }
}

DEVI void prep_x_token(const Params& p, const float* Wg_s, int t, const float4 (&v)[4], int lane) {
    float ss = 0.f, g8[8];
#pragma unroll
    for (int g = 0; g < 8; ++g) g8[g] = 0.f;
#pragma unroll
    for (int j = 0; j < 4; ++j) {
        ss += v[j].x * v[j].x + v[j].y * v[j].y + v[j].z * v[j].z + v[j].w * v[j].w;
#pragma unroll
        for (int g = 0; g < 8; ++g) {
            const float4 w = *(const float4*)(Wg_s + g * 1024 + (lane + 64 * j) * 4);
            g8[g] += v[j].x * w.x + v[j].y * w.y + v[j].z * w.z + v[j].w * w.w;
        }
    }
    ss = wave_sum(ss);
    const bool b5 = lane & 32, b4 = lane & 16, b3 = lane & 8;
    float q4[4], q2[2], q1;
#pragma unroll
    for (int j = 0; j < 4; ++j) { const float snd = b5 ? g8[j] : g8[j + 4], kp = b5 ? g8[j + 4] : g8[j]; q4[j] = kp + __shfl_xor(snd, 32); }
#pragma unroll
    for (int j = 0; j < 2; ++j) { const float snd = b4 ? q4[j] : q4[j + 2], kp = b4 ? q4[j + 2] : q4[j]; q2[j] = kp + __shfl_xor(snd, 16); }
    { const float snd = b3 ? q2[0] : q2[1], kp = b3 ? q2[1] : q2[0]; q1 = kp + __shfl_xor(snd, 8); }
    q1 += __shfl_xor(q1, 4);
    q1 += __shfl_xor(q1, 2);
    q1 += __shfl_xor(q1, 1);
    const float rs = rsqrtf(ss * (1.f / 1024.f) + EPSN);
    uint2* o = (uint2*)(p.xb + (size_t)t * 1024);
#pragma unroll
    for (int j = 0; j < 4; ++j) o[lane + 64 * j] = make_uint2(pk2(v[j].x, v[j].y), pk2(v[j].z, v[j].w));
    if (lane == 0) p.rs1[t] = rs;
    if ((lane & 7) == 0) {
        const int gi = (b5 ? 4 : 0) + (b4 ? 2 : 0) + (b3 ? 1 : 0);
        if (gi < 4) p.ipre[t * 4 + gi] = q1 * rs + p.m_b_i[gi];
        else {
            const float z = q1 * rs + p.m_b_f[gi - 4];
            p.logf[t * 4 + gi - 4] = fminf(z, 0.f) - log1pf(__expf(-fabsf(z)));
        }
    }
}
DEVI void st_prep_x(const Params& p, char* smem) {
    float* Wg_s = (float*)smem;
    for (int i = stid(); i < 8192; i += NTHR) {
        const int k = i >> 3, g = i & 7;
        Wg_s[g * 1024 + k] = p.norm1_g[k] * p.w_in[(size_t)k * DIN + NPJ + g];
    }
    __syncthreads();
    const int lane = stid() & 63, wid = stid() >> 6;
    for (int t = (blockIdx.x * NW + wid) * 4; t < T_TOK; t += gridDim.x * NW * 4) {
        float4 v[4][4];
        const float4* xa = (const float4*)(p.x + (size_t)t * 1024);
#pragma unroll
        for (int q = 0; q < 4; ++q)
#pragma unroll
            for (int j = 0; j < 4; ++j) v[q][j] = xa[256 * q + lane + 64 * j];
#pragma unroll
        for (int q = 0; q < 4; ++q) prep_x_token(p, Wg_s, t + q, v[q], lane);
    }
    __syncthreads();
}

namespace pg8 {
#define PG8_LAS __attribute__((address_space(3)))
typedef unsigned short bf16_t;
typedef short bf16x8 __attribute__((ext_vector_type(8)));
typedef float f32x4 __attribute__((ext_vector_type(4)));
typedef unsigned u32x4 __attribute__((ext_vector_type(4)));
constexpr int BM = 256, BK = 64, HALF = 128, HTB = HALF * BK * 2  , STAGE_BYTES = 8 * HTB, NXCD = 8, WGM = 8;

__host__ __device__ __forceinline__ int lds_byte(int r, int c) { const int st = (r >> 4) * 2 + (c >> 5), rr = r & 15, cc = c & 31, ob = rr * 64 + cc * 2; return st * 1024 + (ob ^ (((ob >> 9) & 1) << 5)); }
__host__ __device__ __forceinline__ void stage_rc(int b, int& R, int& C) { const int st = b / 1024, sb = b % 1024, swz = sb ^ (((sb >> 9) & 1) << 5); R = (st >> 1) * 16 + swz / 64; C = (st & 1) * 32 + (swz % 64) / 2; }
__host__ __device__ __forceinline__ int perm32(int rho) { const int n = rho >> 4, i = rho & 15; return 8 * (i >> 2) + 4 * n + (i & 3); }

struct Unit { int pm, pn; };
struct Gemm { const bf16_t* A; const bf16_t* Bt; int M, N, K; };

struct StaticOrder {
    int nM, nN, nwg, G, c;
    __host__ __device__ void init(int M, int N, int G_, int c_) { nM = M / BM; nN = N / BM; nwg = nM * nN; G = G_; c = c_; }
    __host__ __device__ bool next(int i, Unit& u) const {
        const long L = (long)i * G + c; if (L >= nwg) return false;
        int wgid = (int)L; { const int q = nwg / NXCD, r = nwg % NXCD, xcd = wgid % NXCD, off = wgid / NXCD; wgid = (xcd < r ? xcd * (q + 1) : r * (q + 1) + (xcd - r) * q) + off; }
        const int nig = WGM * nN, gid = wgid / nig, fm = gid * WGM, gsz = (nM - fm) < WGM ? (nM - fm) : WGM;
        u.pm = fm + ((wgid % nig) % gsz); u.pn = (wgid % nig) / gsz; return true;
    }
    __device__ __forceinline__ void a_ready(const Unit&) const {}
    __device__ __forceinline__ void done(const Unit&) const {}
};

__device__ __forceinline__ unsigned cvt_pk_bf16(float lo, float hi) { unsigned r; asm volatile("v_cvt_pk_bf16_f32 %0, %1, %2" : "=v"(r) : "v"(lo), "v"(hi)); return r; }

template <class Epi, class Sched, bool ALIGN_EPI = false, bool SP2 = false>
__device__ __forceinline__ void gemm_phase(PG8_LAS unsigned char* lds, const Gemm g, const Sched& S, const Epi& E) {
    const int tid = stid(), wid = __builtin_amdgcn_readfirstlane(tid >> 6), lane = tid & 63, wr = wid >> 2, wc = wid & 3, fr = lane & 15, fq = lane >> 4;
    const int K = g.K, nt = K / BK;
    unsigned voffA[2], voffB[2];
#pragma unroll
    for (int i = 0; i < 2; ++i) { int R, C; stage_rc(tid * 16 + i * 8192, R, C); const int Rb = Epi::PERM ? ((R & ~31) + perm32(R & 31)) : R;
        voffA[i] = (unsigned)(R * K + C) * 2u; voffB[i] = (unsigned)(Rb * K + C) * 2u; }
    const size_t kstep = (size_t)(BK * 2);
    const size_t hstep = (size_t)HALF * K * 2;
    const size_t tstep = 2 * hstep;
    const unsigned ldsw = (unsigned)wid * 1024u;
    const int aoff = lds_byte(wr * 64 + fr, fq * 8), boff = lds_byte(wc * 32 + fr, fq * 8);
#define PG8_SA(b, h) (((b) * 2 + (h)) * HTB)
#define PG8_SB(b, h) ((4 + (b) * 2 + (h)) * HTB)
#define PG8_STAGE(bufoff, gbase, voff) do { _Pragma("unroll") for (int _i = 0; _i < 2; ++_i) \
        __builtin_amdgcn_global_load_lds((const unsigned*)((const char*)(gbase) + (voff)[_i]), (PG8_LAS unsigned*)(lds + (bufoff) + ldsw + _i * 8192), 16, 0, 0); } while (0)
#define PG8_LDA(dst, b, h) do { _Pragma("unroll") for (int m = 0; m < 4; ++m) _Pragma("unroll") for (int k = 0; k < 2; ++k) dst[m][k] = *(const PG8_LAS bf16x8*)(lds + PG8_SA(b, h) + aoff + m * 2048 + k * 1024); } while (0)
#define PG8_LDB(dst, b, h) do { _Pragma("unroll") for (int n = 0; n < 2; ++n) _Pragma("unroll") for (int k = 0; k < 2; ++k) dst[n][k] = *(const PG8_LAS bf16x8*)(lds + PG8_SB(b, h) + boff + n * 2048 + k * 1024); } while (0)
#define PG8_MMA(ai, bj, At, Bt) do { __builtin_amdgcn_s_setprio(1); _Pragma("unroll") for (int m = 0; m < 4; ++m) _Pragma("unroll") for (int n = 0; n < 2; ++n) _Pragma("unroll") for (int k = 0; k < 2; ++k) \
        acc[ai][bj][m][n] = __builtin_amdgcn_mfma_f32_16x16x32_bf16(Bt[n][k], At[m][k], acc[ai][bj][m][n], 0, 0, 0); __builtin_amdgcn_s_setprio(0); } while (0)
#define PG8_WAIT_V(n) asm volatile("s_waitcnt vmcnt(" #n ")" ::: "memory")
#define PG8_WAIT_L(n) asm volatile("s_waitcnt lgkmcnt(" #n ")" ::: "memory")
#define PG8_BAR __builtin_amdgcn_s_barrier()
#define PG8_SCHED __builtin_amdgcn_sched_barrier(0)
    Unit cur, nxt; int ui = 0;
    if (!S.next(0, cur)) return;
    f32x4 acc[2][2][4][2];
#pragma unroll
    for (int a = 0; a < 2; ++a)
#pragma unroll
        for (int b = 0; b < 2; ++b)
#pragma unroll
            for (int m = 0; m < 4; ++m)
#pragma unroll
                for (int n = 0; n < 2; ++n) acc[a][b][m][n] = (f32x4){0.f, 0.f, 0.f, 0.f};
    bf16x8 At[4][2], B0[2][2], B1[2][2];
    const char* cA = (const char*)g.A + (size_t)cur.pm * tstep; const char* cB = (const char*)g.Bt + (size_t)cur.pn * tstep;
    S.a_ready(cur);
    if constexpr (SP2) {
        PG8_STAGE(PG8_SB(0, 0), cB, voffB); PG8_STAGE(PG8_SB(0, 1), cB + hstep, voffB); PG8_STAGE(PG8_SA(0, 0), cA, voffA); PG8_STAGE(PG8_SA(0, 1), cA + hstep, voffA);
        if (wr == 1) PG8_BAR;
        PG8_WAIT_V(2); PG8_BAR;
        PG8_STAGE(PG8_SB(1, 0), cB + kstep, voffB); PG8_STAGE(PG8_SA(1, 0), cA + kstep, voffA); PG8_STAGE(PG8_SB(1, 1), cB + hstep + kstep, voffB);
        PG8_WAIT_V(6); PG8_BAR;
    } else {
        PG8_STAGE(PG8_SB(0, 0), cB, voffB); PG8_STAGE(PG8_SA(0, 0), cA, voffA); PG8_STAGE(PG8_SB(0, 1), cB + hstep, voffB); PG8_STAGE(PG8_SA(0, 1), cA + hstep, voffA);
        if (wr == 1) PG8_BAR;
        PG8_WAIT_V(4); PG8_BAR;
        PG8_STAGE(PG8_SB(1, 0), cB + kstep, voffB); PG8_STAGE(PG8_SA(1, 0), cA + kstep, voffA); PG8_STAGE(PG8_SB(1, 1), cB + hstep + kstep, voffB);
        PG8_WAIT_V(6); PG8_BAR;
    }
    for (;;) {
        const bool has_next = S.next(ui + 1, nxt);
        const char* nA = has_next ? (const char*)g.A + (size_t)nxt.pm * tstep : cA; const char* nB = has_next ? (const char*)g.Bt + (size_t)nxt.pn * tstep : cB;
        for (int t = 0; t < nt; t += 2) {
            const bool last = (t == nt - 2);
            const char* a1 = cA + (size_t)(t + 1) * kstep;
            const char* a2 = last ? nA : cA + (size_t)(t + 2) * kstep; const char* b2 = last ? nB : cB + (size_t)(t + 2) * kstep;
            const char* a3 = a2 + kstep; const char* b3 = b2 + kstep;
            if (last && has_next) S.a_ready(nxt);
            if constexpr (SP2) {
            PG8_LDB(B0, 0, 0); PG8_LDB(B1, 0, 1); PG8_SCHED; PG8_LDA(At, 0, 0); PG8_STAGE(PG8_SA(1, 1), a1 + hstep, voffA);
            PG8_WAIT_V(8); PG8_WAIT_L(0); PG8_BAR; PG8_MMA(0, 0, At, B0); PG8_MMA(0, 1, At, B1); PG8_BAR; PG8_SCHED;
            PG8_LDA(At, 0, 1); PG8_STAGE(PG8_SB(0, 0), b2, voffB); PG8_STAGE(PG8_SB(0, 1), b2 + hstep, voffB); PG8_STAGE(PG8_SA(0, 0), a2, voffA);
            PG8_WAIT_V(8); PG8_WAIT_L(0); PG8_BAR; PG8_MMA(1, 0, At, B0); PG8_MMA(1, 1, At, B1); PG8_BAR; PG8_SCHED;
            PG8_LDB(B0, 1, 0); PG8_LDB(B1, 1, 1); PG8_SCHED; PG8_LDA(At, 1, 0); PG8_STAGE(PG8_SA(0, 1), a2 + hstep, voffA);
            PG8_WAIT_V(8); PG8_WAIT_L(0); PG8_BAR; PG8_MMA(0, 0, At, B0); PG8_MMA(0, 1, At, B1); PG8_BAR; PG8_SCHED;
            PG8_LDA(At, 1, 1); PG8_STAGE(PG8_SB(1, 0), b3, voffB); PG8_STAGE(PG8_SB(1, 1), b3 + hstep, voffB); PG8_STAGE(PG8_SA(1, 0), a3, voffA);
            PG8_WAIT_V(8); PG8_WAIT_L(0); PG8_BAR; PG8_MMA(1, 0, At, B0); PG8_MMA(1, 1, At, B1); PG8_BAR; PG8_SCHED;
            } else {
            PG8_LDB(B0, 0, 0); PG8_SCHED; PG8_LDA(At, 0, 0); PG8_STAGE(PG8_SA(1, 1), a1 + hstep, voffA);
            PG8_WAIT_L(8); PG8_BAR; PG8_WAIT_L(0); PG8_MMA(0, 0, At, B0); PG8_BAR; PG8_SCHED;
            PG8_LDB(B1, 0, 1); PG8_STAGE(PG8_SB(0, 0), b2, voffB);
            PG8_BAR; PG8_WAIT_L(0); PG8_MMA(0, 1, At, B1); PG8_BAR;
            PG8_LDA(At, 0, 1); PG8_STAGE(PG8_SA(0, 0), a2, voffA);
            PG8_BAR; PG8_WAIT_L(0); PG8_MMA(1, 0, At, B0); PG8_BAR; PG8_SCHED;
            PG8_STAGE(PG8_SB(0, 1), b2 + hstep, voffB);
            PG8_WAIT_V(6); PG8_BAR; PG8_MMA(1, 1, At, B1); PG8_BAR;
            PG8_LDB(B0, 1, 0); PG8_SCHED; PG8_LDA(At, 1, 0); PG8_STAGE(PG8_SA(0, 1), a2 + hstep, voffA);
            PG8_WAIT_L(8); PG8_BAR; PG8_WAIT_L(0); PG8_MMA(0, 0, At, B0); PG8_BAR; PG8_SCHED;
            PG8_LDB(B1, 1, 1); PG8_STAGE(PG8_SB(1, 0), b3, voffB);
            PG8_BAR; PG8_WAIT_L(0); PG8_MMA(0, 1, At, B1); PG8_BAR;
            PG8_LDA(At, 1, 1); PG8_STAGE(PG8_SA(1, 0), a3, voffA);
            PG8_BAR; PG8_WAIT_L(0); PG8_MMA(1, 0, At, B0); PG8_BAR; PG8_SCHED;
            PG8_STAGE(PG8_SB(1, 1), b3 + hstep, voffB);
            PG8_WAIT_V(6); PG8_BAR; PG8_MMA(1, 1, At, B1); PG8_BAR;
            }
        }
        if constexpr (ALIGN_EPI) { if (wr == 0) PG8_BAR; }
        if constexpr (!Epi::AFTER_DRAIN) { E(acc, cur, wr, wc, fr, fq); S.done(cur); }
        if (!has_next) break;
#pragma unroll
        for (int a = 0; a < 2; ++a)
#pragma unroll
            for (int b = 0; b < 2; ++b)
#pragma unroll
                for (int m = 0; m < 4; ++m)
#pragma unroll
                    for (int n = 0; n < 2; ++n) acc[a][b][m][n] = (f32x4){0.f, 0.f, 0.f, 0.f};
        cur = nxt; cA = nA; cB = nB; ++ui;
        if constexpr (ALIGN_EPI) { if (wr == 1) PG8_BAR; }
    }
    PG8_WAIT_V(0);
    if constexpr (!ALIGN_EPI) { if (wr == 0) PG8_BAR; }
    PG8_BAR;
    if constexpr (Epi::AFTER_DRAIN) { E.fused(acc, cur, wr, wc, fr, fq, lds, wid, lane); S.done(cur); }
#undef PG8_SA
#undef PG8_SB
#undef PG8_STAGE
#undef PG8_LDA
#undef PG8_LDB
#undef PG8_MMA
#undef PG8_WAIT_V
#undef PG8_WAIT_L
#undef PG8_BAR
#undef PG8_SCHED
}
}

#ifndef PG8_SP2
#define PG8_SP2 true
#endif
#ifndef PG8_ALIGN
#define PG8_ALIGN true
#endif
struct EpiProj8 {
    static constexpr bool PERM = true, AFTER_DRAIN = false;
    bf16_t* O; const float* rs; const float* rcos; const float* rsin;
    __device__ __forceinline__ void operator()(const pg8::f32x4 (&acc)[2][2][4][2], const pg8::Unit& u, int wr, int wc, int fr, int fq) const {
        const int row0 = u.pm * 256 + wr * 64 + fr, col0 = u.pn * 256 + wc * 32 + 8 * fq;
        const bool rot = u.pn < 4;
        const float ksc = u.pn >= 2 ? 0.08838834764831845f : 1.f;
#pragma unroll
        for (int ai = 0; ai < 2; ++ai)
#pragma unroll
            for (int m = 0; m < 4; ++m) {
                const int row = row0 + ai * 128 + m * 16;
                const float s = rs[row];
                bf16_t* rowp = O + (size_t)row * NPJ + col0;
                float4 cs = make_float4(1.f, 1.f, 1.f, 1.f), sn = make_float4(0.f, 0.f, 0.f, 0.f);
                float s2 = s;
                if (rot) {
                    const int ti = (row & 2047) * 64 + 16 * wc + 4 * fq;
                    cs = *(const float4*)(rcos + ti);
                    sn = *(const float4*)(rsin + ti);
                    s2 = s * ksc;
                }
#pragma unroll
                for (int bj = 0; bj < 2; ++bj) {
                    const pg8::f32x4 v0 = acc[ai][bj][m][0] * s2, v1 = acc[ai][bj][m][1] * s2;
                    *(uint4*)(rowp + bj * 128) = make_uint4(pk2(v0[0] * cs.x - v0[1] * sn.x, v0[0] * sn.x + v0[1] * cs.x), pk2(v0[2] * cs.y - v0[3] * sn.y, v0[2] * sn.y + v0[3] * cs.y),
                                                            pk2(v1[0] * cs.z - v1[1] * sn.z, v1[0] * sn.z + v1[1] * cs.z), pk2(v1[2] * cs.w - v1[3] * sn.w, v1[2] * sn.w + v1[3] * cs.w));
                }
            }
    }
};
struct EpiX18 {
    static constexpr bool PERM = true, AFTER_DRAIN = false;
    const float* x; bf16_t* x1b; unsigned char* zq; float* rs2p; const float* g2;
    __device__ __forceinline__ void operator()(const pg8::f32x4 (&acc)[2][2][4][2], const pg8::Unit& u, int wr, int wc, int fr, int fq) const {
        const int row0 = u.pm * 256 + wr * 64 + fr, col0 = u.pn * 256 + wc * 32 + 8 * fq;
        float gq[2][8];
#pragma unroll
        for (int bj = 0; bj < 2; ++bj) {
            const float4 a = *(const float4*)(g2 + col0 + bj * 128), b = *(const float4*)(g2 + col0 + bj * 128 + 4);
            gq[bj][0] = a.x; gq[bj][1] = a.y; gq[bj][2] = a.z; gq[bj][3] = a.w; gq[bj][4] = b.x; gq[bj][5] = b.y; gq[bj][6] = b.z; gq[bj][7] = b.w;
        }
        float ssq[8];
#pragma unroll
        for (int ai = 0; ai < 2; ++ai)
#pragma unroll
            for (int m = 0; m < 4; ++m) {
                const size_t ro = (size_t)(row0 + ai * 128 + m * 16) * 1024 + col0;
                float s = 0.f;
#pragma unroll
                for (int bj = 0; bj < 2; ++bj) {
                    const float4 xa = *(const float4*)(x + ro + bj * 128), xb_ = *(const float4*)(x + ro + bj * 128 + 4);
                    const pg8::f32x4 v0 = acc[ai][bj][m][0], v1 = acc[ai][bj][m][1];
                    const float y[8] = {xa.x + v0[0], xa.y + v0[1], xa.z + v0[2], xa.w + v0[3], xb_.x + v1[0], xb_.y + v1[1], xb_.z + v1[2], xb_.w + v1[3]};
                    *(uint4*)(x1b + ro + bj * 128) = make_uint4(pk2(y[0], y[1]), pk2(y[2], y[3]), pk2(y[4], y[5]), pk2(y[6], y[7]));
                    unsigned w2[2] = {0u, 0u};
#pragma unroll
                    for (int e = 0; e < 8; ++e) {
                        s += y[e] * y[e];
                        const float z = fminf(fmaxf(y[e] * gq[bj][e] * (1.f / ZQ_SCALE), -127.f), 127.f);
                        w2[e >> 2] |= ((unsigned)((int)rintf(z) & 255)) << (8 * (e & 3));
                    }
                    *(uint2*)(zq + ro + bj * 128) = make_uint2(w2[0], w2[1]);
                }
                ssq[ai * 4 + m] = s;
            }
        float q4[4], q2[2];
#pragma unroll
        for (int j = 0; j < 4; ++j) {
            const auto r = __builtin_amdgcn_permlane32_swap(__float_as_uint(ssq[j]), __float_as_uint(ssq[j + 4]), false, false);
            q4[j] = __uint_as_float(r[0]) + __uint_as_float(r[1]);
        }
#pragma unroll
        for (int j = 0; j < 2; ++j) {
            const auto r = __builtin_amdgcn_permlane16_swap(__float_as_uint(q4[j]), __float_as_uint(q4[j + 2]), false, false);
            q2[j] = __uint_as_float(r[0]) + __uint_as_float(r[1]);
        }
#pragma unroll
        for (int j = 0; j < 2; ++j) {
            const int r8 = ((fq >> 1) & 1) * 4 + (fq & 1) * 2 + j;
            rs2p[(size_t)(row0 + (r8 >> 2) * 128 + (r8 & 3) * 16) * 16 + u.pn * 4 + wc] = q2[j];
        }
    }
};
template <class Epi, bool ALIGN>
DEVI void st_gemm8(const bf16_t* A, const bf16_t* Bt, int N, int K, char* smem, const Epi& epi) {
    pg8::Gemm g{A, Bt, T_TOK, N, K};
    pg8::StaticOrder S;
    S.init(T_TOK, N, (int)gridDim.x, (int)blockIdx.x);
    pg8::gemm_phase<Epi, pg8::StaticOrder, ALIGN, PG8_SP2>((PG8_LAS unsigned char*)smem, g, S, epi);
}

DEVI void st_conv_qk(const Params& p, char* smem) {
    char* cs = smem;
    char* wqs = smem + 128 * 272;
    char* wks = smem + 2 * 128 * 272;
    const int tid = stid(), lane = tid & 63, wid = tid >> 6, wr = wid >> 1, wc = wid & 1, fr = lane & 15, fq = lane >> 4;
    const int r = tid >> 4, cg = tid & 15;
    int hcur = -1;
    float cw[4][8], cb[8];
    for (int it = blockIdx.x; it < 256 * 4; it += gridDim.x) {
        const int h = it & 3, t0 = (it >> 2) * 128, s0 = t0 & 2047;
        if (h != hcur) {
            __syncthreads();
#pragma unroll
            for (int i = 0; i < 4; ++i) {
                const int id = tid + 512 * i, rr = id >> 4, c = id & 15;
                *(uint4*)(wqs + rr * 272 + c * 16) = *(const uint4*)(p.Wqt + h * 16384 + rr * 128 + c * 8);
                *(uint4*)(wks + rr * 272 + c * 16) = *(const uint4*)(p.Wkt + h * 16384 + rr * 128 + c * 8);
            }
#pragma unroll
            for (int j = 0; j < 4; ++j) {
                const float4 a = *(const float4*)(p.m_conv_w + j * 512 + h * 128 + 8 * cg), b = *(const float4*)(p.m_conv_w + j * 512 + h * 128 + 8 * cg + 4);
                cw[j][0] = a.x; cw[j][1] = a.y; cw[j][2] = a.z; cw[j][3] = a.w; cw[j][4] = b.x; cw[j][5] = b.y; cw[j][6] = b.z; cw[j][7] = b.w;
            }
            { const float4 a = *(const float4*)(p.m_conv_b + h * 128 + 8 * cg), b = *(const float4*)(p.m_conv_b + h * 128 + 8 * cg + 4);
              cb[0] = a.x; cb[1] = a.y; cb[2] = a.z; cb[3] = a.w; cb[4] = b.x; cb[5] = b.y; cb[6] = b.z; cb[7] = b.w; }
            hcur = h;
        }
        const bf16_t* xcol = p.proj + (size_t)t0 * NPJ + 2048 + h * 128 + 8 * cg;
#pragma unroll
        for (int ps = 0; ps < 4; ++ps) {
            const int row = 32 * ps + r;
            uint4 xv[4];
#pragma unroll
            for (int j = 0; j < 4; ++j) {
                const int rj = row - 3 + j;
                xv[j] = (s0 + rj >= 0) ? *(const uint4*)(xcol + (long)rj * NPJ) : make_uint4(0u, 0u, 0u, 0u);
            }
            float y[8];
#pragma unroll
            for (int e = 0; e < 8; ++e) y[e] = cb[e];
#pragma unroll
            for (int j = 0; j < 4; ++j) {
                const unsigned w4[4] = {xv[j].x, xv[j].y, xv[j].z, xv[j].w};
#pragma unroll
                for (int e = 0; e < 4; ++e) { y[2 * e] += cw[j][2 * e] * bflo(w4[e]); y[2 * e + 1] += cw[j][2 * e + 1] * bfhi(w4[e]); }
            }
            unsigned o[4];
#pragma unroll
            for (int e = 0; e < 4; ++e) o[e] = pk2(y[2 * e] * sigmoidf_(y[2 * e]), y[2 * e + 1] * sigmoidf_(y[2 * e + 1]));
            const uint4 ov = make_uint4(o[0], o[1], o[2], o[3]);
            *(uint4*)(cs + row * 272 + cg * 16) = ov;
            *(uint4*)(p.cbuf + (size_t)(t0 + row) * 512 + h * 128 + 8 * cg) = ov;
        }
        __syncthreads();
#pragma unroll
        for (int which = 0; which < 2; ++which) {
            const char* ws = which ? wks : wqs;
            bf16_t* O = which ? p.mk : p.mq;
            f32x4 acc[2][4];
#pragma unroll
            for (int i = 0; i < 2; ++i)
#pragma unroll
                for (int j = 0; j < 4; ++j) acc[i][j] = (f32x4){0.f, 0.f, 0.f, 0.f};
#pragma unroll
            for (int ks = 0; ks < 4; ++ks) {
                bf16x8 a[2], b[4];
#pragma unroll
                for (int i = 0; i < 2; ++i) a[i] = ld8(cs + (wr * 32 + i * 16 + fr) * 272 + (ks * 4 + fq) * 16);
#pragma unroll
                for (int j = 0; j < 4; ++j) b[j] = ld8(ws + (wc * 64 + j * 16 + fr) * 272 + (ks * 4 + fq) * 16);
#pragma unroll
                for (int i = 0; i < 2; ++i)
#pragma unroll
                    for (int j = 0; j < 4; ++j) acc[i][j] = mfma16(b[j], a[i], acc[i][j]);
            }
#pragma unroll
            for (int i = 0; i < 2; ++i)
#pragma unroll
                for (int j = 0; j < 4; ++j) {
                    const int m = t0 + wr * 32 + i * 16 + fr, n = h * 128 + wc * 64 + j * 16 + 4 * fq;
                    const f32x4 v = acc[i][j];
                    *(uint2*)(O + (size_t)m * 512 + n) = make_uint2(pk2(v[0], v[1]), pk2(v[2], v[3]));
                }
        }
        __syncthreads();
    }
}

DEVI bf16x8 u4_to_frag(uint4 u) { union { uint4 u; bf16x8 v; } x; x.u = u; return x.v; }
DEVI void sel_frags(bf16x8 (&sel)[2], int fr, int fq) {
#pragma unroll
    for (int hh = 0; hh < 2; ++hh) {
        const int jstar = fr + 16 * hh - 8 * fq;
        bf16x8 s;
#pragma unroll
        for (int j = 0; j < 8; ++j) s[j] = (j == jstar) ? (short)0x3F80 : (short)0;
        sel[hh] = s;
    }
}
DEVI void tr_store(char* XT, bf16x8 frag, const bf16x8 (&sel)[2], int mi, int ks, int fr, int fq, const float (&sc)[4]) {
#pragma unroll
    for (int hh = 0; hh < 2; ++hh) {
        const f32x4 d = mfma16(frag, sel[hh], (f32x4){0.f, 0.f, 0.f, 0.f});
        *(uint2*)(XT + (32 * ks + 16 * hh + fr) * 144 + (16 * mi + 4 * fq) * 2) = make_uint2(pk2(d[0] * sc[0], d[1] * sc[1]), pk2(d[2] * sc[2], d[3] * sc[3]));
    }
}
DEVI bf16x8 state_pack(const f32x4& a, const f32x4& b) {
    return mk8(make_uint2(pk2(a[0], a[1]), pk2(a[2], a[3])), make_uint2(pk2(b[0], b[1]), pk2(b[2], b[3])));
}
DEVI const float* opaque_ptr(const float* q) { asm volatile("" : "+v"(q)); return q; }
DEVI float opaque_f(float v) { asm volatile("" : "+v"(v)); return v; }
DEVI void lds_barrier() { asm volatile("s_waitcnt lgkmcnt(0)" ::: "memory"); __builtin_amdgcn_s_barrier(); asm volatile("" ::: "memory"); }
DEVI void pin_u4(uint4& a) { asm volatile("" : "+v"(a.x), "+v"(a.y), "+v"(a.z), "+v"(a.w)); }
DEVI float grp8_sum(float v) { v += dpp_f<DPP_XOR1>(v); v += dpp_f<DPP_XOR2>(v); v += dpp_f<DPP_HMIRROR>(v); return v; }

#define ASM_LD16(dst, voff, sbase, imm) asm volatile("global_load_dwordx4 %0, %1, %2 offset:" #imm : "=v"(dst) : "v"(voff), "s"(sbase) : "memory")
#define ASM_LD4(dst, voff, sbase) asm volatile("global_load_dword %0, %1, %2" : "=v"(dst) : "v"(voff), "s"(sbase) : "memory")
typedef unsigned u32x4_t __attribute__((ext_vector_type(4)));
struct RetPre { u32x4_t f[4]; u32x4_t v[2]; u32x4_t g[2]; };
struct RetOff { unsigned f, v0, v1, g; };
DEVI void ret_offsets(RetOff& o, int h, int tid) {
    const int lane = tid & 63, w = tid >> 6, fr = lane & 15, fq = lane >> 4, mi = w & 3;
    o.f = (unsigned)(((16 * mi + fr) * NPJ + (w < 4 ? 512 : 0) + h * 128 + 8 * fq) * 2);
    o.v0 = (unsigned)(((16 * ((2 * w) >> 2) + fr) * NPJ + 1024 + h * 128 + 32 * ((2 * w) & 3) + 8 * fq) * 2);
    o.v1 = (unsigned)(((16 * ((2 * w + 1) >> 2) + fr) * NPJ + 1024 + h * 128 + 32 * ((2 * w + 1) & 3) + 8 * fq) * 2);
    o.g = (unsigned)(((tid >> 3) * NPJ + 1536 + h * 128 + 16 * (tid & 7)) * 2);
}
DEVI void ret_prefetch(const Params& p, RetPre& P, const RetOff& o, int b, int c) {
    const char* base = (const char*)p.proj + (size_t)(b * 2048 + c * 64) * (NPJ * 2);
    ASM_LD16(P.f[0], o.f, base, 0); ASM_LD16(P.f[1], o.f, base, 64); ASM_LD16(P.f[2], o.f, base, 128); ASM_LD16(P.f[3], o.f, base, 192);
    ASM_LD16(P.v[0], o.v0, base, 0); ASM_LD16(P.v[1], o.v1, base, 0);
    ASM_LD16(P.g[0], o.g, base, 0); ASM_LD16(P.g[1], o.g, base, 16);
}
DEVI void ret_retire(RetPre& P) {
    asm volatile("s_waitcnt vmcnt(0)" : "+v"(P.f[0]), "+v"(P.f[1]), "+v"(P.f[2]), "+v"(P.f[3]), "+v"(P.v[0]), "+v"(P.v[1]), "+v"(P.g[0]), "+v"(P.g[1]) :: "memory");
}
DEVI uint4 asu4(const u32x4_t& v) { return make_uint4(v[0], v[1], v[2], v[3]); }
DEVI void ret_block(const Params& p, char* smem, int b, int h) {
    char* qs = smem;
    char* ks_ = smem + 17408;
    char* kTs = smem + 34816;
    char* vTs = smem + 53248;
    char* Ss = smem + 71680;
    char* Os = smem + 80896;
    float* gn_s = (float*)(smem + 98304);
    const int tid = stid(), lane = tid & 63, w = tid >> 6, fr = lane & 15, fq = lane >> 4;
    const float gamma = 1.f - exp2f(-5.f - (float)h);
    const float l2g = log2f(gamma);
    const float g64 = exp2f(l2g * 64.f);
    bf16x8 sel[2];
    sel_frags(sel, fr, fq);
    f32x4 st[8];
#pragma unroll
    for (int i = 0; i < 8; ++i) st[i] = (f32x4){0.f, 0.f, 0.f, 0.f};
    if (tid < 128) gn_s[tid] = p.ret_norm_g[h * 128 + tid];
    __syncthreads();
    RetPre P;
    RetOff RO;
    ret_offsets(RO, h, tid);
    ret_prefetch(p, P, RO, b, 0);
    ret_retire(P);
#pragma unroll 1
    for (int c = 0; c < 32; ++c) {
        const int t0 = b * 2048 + c * 64;
        {
            const int mi = w & 3;
            char* dst = (w < 4 ? ks_ : qs) + (16 * mi + fr) * 272 + fq * 16;
#pragma unroll
            for (int ks = 0; ks < 4; ++ks) *(uint4*)(dst + ks * 64) = asu4(P.f[ks]);
            if (w < 4) {
                float kd[4];
#pragma unroll
                for (int r = 0; r < 4; ++r) kd[r] = exp2f(l2g * (float)(63 - (16 * mi + 4 * fq + r)));
#pragma unroll
                for (int ks = 0; ks < 4; ++ks) tr_store(kTs, u4_to_frag(asu4(P.f[ks])), sel, mi, ks, fr, fq, kd);
            }
            const float one[4] = {1.f, 1.f, 1.f, 1.f};
#pragma unroll
            for (int q = 0; q < 2; ++q) { const int pr = 2 * w + q; tr_store(vTs, u4_to_frag(asu4(P.v[q])), sel, pr >> 2, pr & 3, fr, fq, one); }
        }
        uint4 g0 = asu4(P.g[0]), g1 = asu4(P.g[1]);
        lds_barrier();
        ret_prefetch(p, P, RO, b, c + 1 < 32 ? c + 1 : 31);
        {
            const int lt = w & 3;
            bf16x8 qf[4];
#pragma unroll
            for (int s = 0; s < 4; ++s) qf[s] = ld8(qs + (16 * lt + fr) * 272 + (s * 4 + fq) * 16);
#pragma unroll
            for (int jj = 0; jj < 2; ++jj) {
                const int j = 2 * (w >> 2) + jj;
                f32x4 a = (f32x4){0.f, 0.f, 0.f, 0.f};
#pragma unroll
                for (int s = 0; s < 4; ++s) a = mfma16(ld8(ks_ + (16 * j + fr) * 272 + (s * 4 + fq) * 16), qf[s], a);
                const int l = 16 * lt + fr, mb = 16 * j + 4 * fq;
                float v[4];
#pragma unroll
                for (int r = 0; r < 4; ++r) { const int dd = l - (mb + r); v[r] = a[r] * exp2f(l2g * (float)(dd < 0 ? -dd : dd)); }
                *(uint2*)(Ss + l * 144 + mb * 2) = make_uint2(pk2(v[0], v[1]), pk2(v[2], v[3]));
            }
        }
        lds_barrier();
        {
            bf16x8 sp[4];
#pragma unroll
            for (int s = 0; s < 4; ++s) sp[s] = state_pack(st[2 * s], st[2 * s + 1]);
            bf16x8 vf[2];
#pragma unroll
            for (int s2 = 0; s2 < 2; ++s2) vf[s2] = ld8(vTs + (16 * w + fr) * 144 + (s2 * 4 + fq) * 16);
#pragma unroll
            for (int i = 0; i < 4; ++i) {
                f32x4 a = (f32x4){0.f, 0.f, 0.f, 0.f};
                const char* qrow = qs + (16 * i + fr) * 272;
#pragma unroll
                for (int s = 0; s < 4; ++s) {
                    const uint2 lo = *(const uint2*)(qrow + (32 * s + 4 * fq) * 2), hi = *(const uint2*)(qrow + (32 * s + 16 + 4 * fq) * 2);
                    a = mfma16(sp[s], mk8(lo, hi), a);
                }
                a = a * exp2f(l2g * (float)(16 * i + fr + 1));
#pragma unroll
                for (int s2 = 0; s2 < 2; ++s2) a = mfma16(vf[s2], ld8(Ss + (16 * i + fr) * 144 + (s2 * 4 + fq) * 16), a);
                *(uint2*)(Os + (16 * i + fr) * 272 + (16 * w + 4 * fq) * 2) = make_uint2(pk2(a[0], a[1]), pk2(a[2], a[3]));
            }
#pragma unroll
            for (int i = 0; i < 8; ++i) {
                f32x4 a = st[i] * g64;
#pragma unroll
                for (int s2 = 0; s2 < 2; ++s2) a = mfma16(ld8(kTs + (16 * i + fr) * 144 + (s2 * 4 + fq) * 16), vf[s2], a);
                st[i] = a;
            }
        }
        lds_barrier();
        pin_u4(g0); pin_u4(g1);
        {
            const int l = tid >> 3, part = tid & 7;
            const uint4 o0 = *(const uint4*)(Os + l * 272 + part * 32), o1 = *(const uint4*)(Os + l * 272 + part * 32 + 16);
            const unsigned ow[8] = {o0.x, o0.y, o0.z, o0.w, o1.x, o1.y, o1.z, o1.w}, gw[8] = {g0.x, g0.y, g0.z, g0.w, g1.x, g1.y, g1.z, g1.w};
            float x[16], s = 0.f;
#pragma unroll
            for (int e = 0; e < 8; ++e) { x[2 * e] = bflo(ow[e]); x[2 * e + 1] = bfhi(ow[e]); s += x[2 * e] + x[2 * e + 1]; }
            const float mu = grp8_sum(s) * (1.f / 128.f);
            float q = 0.f;
#pragma unroll
            for (int e = 0; e < 16; ++e) { x[e] -= mu; q += x[e] * x[e]; }
            const float rstd = rsqrtf(grp8_sum(q) * (1.f / 128.f) + EPSN);
            const float* gn = gn_s + 16 * part;
            unsigned yo[8];
#pragma unroll
            for (int e = 0; e < 8; ++e) {
                const float ga = bflo(gw[e]), gb = bfhi(gw[e]);
                yo[e] = pk2(ga * sigmoidf_(ga) * x[2 * e] * rstd * gn[2 * e], gb * sigmoidf_(gb) * x[2 * e + 1] * rstd * gn[2 * e + 1]);
            }
            ret_retire(P);
            uint4* yp = (uint4*)(p.yb + (size_t)(t0 + l) * 1024 + h * 128 + 16 * part);
            yp[0] = make_uint4(yo[0], yo[1], yo[2], yo[3]);
            yp[1] = make_uint4(yo[4], yo[5], yo[6], yo[7]);
        }
    }
}

struct MlPre { u32x4_t f[4]; u32x4_t v[2]; u32x4_t o[2]; u32x4_t cc[2]; };
struct MlOff { unsigned f, v0, v1, o, c, g; };
DEVI void ml_offsets(const Params& p, MlOff& o, int h, int tid) {
    const int lane = tid & 63, w = tid >> 6, fr = lane & 15, fq = lane >> 4, mi = w & 3;
    const unsigned kdiff = (unsigned)((const char*)p.mk - (const char*)p.mq);
    o.f = (unsigned)(((16 * mi + fr) * 512 + h * 128 + 8 * fq) * 2) + (w < 4 ? kdiff : 0u);
    o.v0 = (unsigned)(((16 * ((2 * w) >> 2) + fr) * NPJ + 2560 + h * 128 + 32 * ((2 * w) & 3) + 8 * fq) * 2);
    o.v1 = (unsigned)(((16 * ((2 * w + 1) >> 2) + fr) * NPJ + 2560 + h * 128 + 32 * ((2 * w + 1) & 3) + 8 * fq) * 2);
    o.o = (unsigned)(((tid >> 3) * NPJ + 3072 + h * 128 + 16 * (tid & 7)) * 2);
    o.c = (unsigned)(((tid >> 3) * 512 + h * 128 + 16 * (tid & 7)) * 2);
    o.g = (unsigned)((lane * 4 + h) * 4);
}
DEVI void ml_prefetch(const Params& p, MlPre& P, const MlOff& o, int b, int c) {
    const size_t t0 = (size_t)(b * 2048 + c * 64);
    const char* bq = (const char*)p.mq + t0 * 1024, *bp = (const char*)p.proj + t0 * (NPJ * 2), *bc = (const char*)p.cbuf + t0 * 1024;
    ASM_LD16(P.f[0], o.f, bq, 0); ASM_LD16(P.f[1], o.f, bq, 64); ASM_LD16(P.f[2], o.f, bq, 128); ASM_LD16(P.f[3], o.f, bq, 192);
    ASM_LD16(P.v[0], o.v0, bp, 0); ASM_LD16(P.v[1], o.v1, bp, 0);
    ASM_LD16(P.o[0], o.o, bp, 0); ASM_LD16(P.o[1], o.o, bp, 16);
    ASM_LD16(P.cc[0], o.c, bc, 0); ASM_LD16(P.cc[1], o.c, bc, 16);
}
DEVI void ml_retire(MlPre& P) {
    asm volatile("s_waitcnt vmcnt(0)" : "+v"(P.f[0]), "+v"(P.f[1]), "+v"(P.f[2]), "+v"(P.f[3]), "+v"(P.v[0]), "+v"(P.v[1]), "+v"(P.o[0]), "+v"(P.o[1]),
                 "+v"(P.cc[0]), "+v"(P.cc[1]) :: "memory");
}
DEVI void mlstm_block(const Params& p, char* smem, int b, int h) {
    char* qs = smem;
    char* kTs = smem + 17408;
    char* vTs = smem + 35840;
    char* Os = smem + 54272;
    float* n_s = (float*)(smem + 71680);
    float* den_s = (float*)(smem + 72192);
    float* gn_s = (float*)(smem + 72448);
    float* sk_s = gn_s + 128;
    float* lw_s = sk_s + 128;
    float* ac_s = lw_s + 32 * 64;
    float* mi_s = ac_s + 32;
    const int tid = stid(), lane = tid & 63, w = tid >> 6, fr = lane & 15, fq = lane >> 4;
    bf16x8 sel[2];
    sel_frags(sel, fr, fq);
    f32x4 st[8];
#pragma unroll
    for (int i = 0; i < 8; ++i) st[i] = (f32x4){0.f, 0.f, 0.f, 0.f};
    float m_run = 0.f;
    f32x4 nacc = (f32x4){0.f, 0.f, 0.f, 0.f};
    bf16x8 ones;
#pragma unroll
    for (int j = 0; j < 8; ++j) ones[j] = (short)0x3F80;
    if (tid < 128) { gn_s[tid] = p.m_norm_g[h * 128 + tid]; sk_s[tid] = p.m_skip[h * 128 + tid]; }
#pragma unroll
    for (int q = 0; q < 4; ++q) {
        const int cc = 4 * w + q, tt = b * 2048 + cc * 64 + lane;
        const float iv = p.ipre[tt * 4 + h], fv = p.logf[tt * 4 + h];
        float fcum = fv;
#pragma unroll
        for (int o = 1; o < 64; o <<= 1) { const float tv = __shfl_up(fcum, o); if (lane >= o) fcum += tv; }
        const float a_c = __shfl(fcum, 63);
        const float logw = a_c - fcum + iv;
        const float m_in = wave_max(logw);
        lw_s[cc * 64 + lane] = logw;
        if (lane == 0) { ac_s[cc] = a_c; mi_s[cc] = m_in; }
    }
    __syncthreads();
    MlPre P;
    MlOff MO;
    ml_offsets(p, MO, h, tid);
    ml_prefetch(p, P, MO, b, 0);
    ml_retire(P);
#pragma unroll 1
    for (int c = 0; c < 32; ++c) {
        const int t0 = b * 2048 + c * 64;
        const float a_c = ac_s[c], m_in = mi_s[c], logw = lw_s[c * 64 + lane];
        const float m_new = fmaxf(a_c + m_run, m_in);
        const float decay = __expf(a_c + m_run - m_new);
        const float wgt = __expf(logw - m_new);
        const float emn = __expf(-m_new);
        m_run = m_new;
        {
            const int mi = w & 3;
            if (w < 4) {
                float kw[4];
#pragma unroll
                for (int r = 0; r < 4; ++r) kw[r] = __shfl(wgt, 16 * mi + 4 * fq + r);
#pragma unroll
                for (int ks = 0; ks < 4; ++ks) tr_store(kTs, u4_to_frag(asu4(P.f[ks])), sel, mi, ks, fr, fq, kw);
            } else {
                char* dst = qs + (16 * mi + fr) * 272 + fq * 16;
#pragma unroll
                for (int ks = 0; ks < 4; ++ks) *(uint4*)(dst + ks * 64) = asu4(P.f[ks]);
            }
            const float one[4] = {1.f, 1.f, 1.f, 1.f};
#pragma unroll
            for (int q = 0; q < 2; ++q) { const int pr = 2 * w + q; tr_store(vTs, u4_to_frag(asu4(P.v[q])), sel, pr >> 2, pr & 3, fr, fq, one); }
        }
        uint4 mo0 = asu4(P.o[0]), mo1 = asu4(P.o[1]), cc0 = asu4(P.cc[0]), cc1 = asu4(P.cc[1]);
        lds_barrier();
        ml_prefetch(p, P, MO, b, c + 1 < 32 ? c + 1 : 31);
        {
            f32x4 a = nacc * decay;
#pragma unroll
            for (int s2 = 0; s2 < 2; ++s2) a = mfma16(ld8(kTs + (16 * w + fr) * 144 + (s2 * 4 + fq) * 16), ones, a);
            nacc = a;
            if (fr == 0) *(f32x4*)(n_s + 16 * w + 4 * fq) = a;
        }
        {
            bf16x8 vf[2];
#pragma unroll
            for (int s2 = 0; s2 < 2; ++s2) vf[s2] = ld8(vTs + (16 * w + fr) * 144 + (s2 * 4 + fq) * 16);
#pragma unroll
            for (int i = 0; i < 8; ++i) {
                f32x4 a = st[i] * decay;
#pragma unroll
                for (int s2 = 0; s2 < 2; ++s2) a = mfma16(ld8(kTs + (16 * i + fr) * 144 + (s2 * 4 + fq) * 16), vf[s2], a);
                st[i] = a;
            }
        }
        lds_barrier();
        {
            const int l = tid >> 3, part = tid & 7;
            const uint4 a0 = *(const uint4*)(qs + l * 272 + part * 32), a1 = *(const uint4*)(qs + l * 272 + part * 32 + 16);
            const unsigned aw[8] = {a0.x, a0.y, a0.z, a0.w, a1.x, a1.y, a1.z, a1.w};
            const float* nn = n_s + 16 * part;
            float s = 0.f;
#pragma unroll
            for (int e = 0; e < 8; ++e) s += bflo(aw[e]) * nn[2 * e] + bfhi(aw[e]) * nn[2 * e + 1];
            s = grp8_sum(s);
            if (part == 0) den_s[l] = fmaxf(fabsf(s), emn);
        }
        lds_barrier();
        {
            bf16x8 sp[4];
#pragma unroll
            for (int s = 0; s < 4; ++s) sp[s] = state_pack(st[2 * s], st[2 * s + 1]);
#pragma unroll
            for (int i = 0; i < 4; ++i) {
                f32x4 a = (f32x4){0.f, 0.f, 0.f, 0.f};
                const char* qrow = qs + (16 * i + fr) * 272;
#pragma unroll
                for (int s = 0; s < 4; ++s) {
                    const uint2 lo = *(const uint2*)(qrow + (32 * s + 4 * fq) * 2), hi = *(const uint2*)(qrow + (32 * s + 16 + 4 * fq) * 2);
                    a = mfma16(sp[s], mk8(lo, hi), a);
                }
                const float rd = 1.f / den_s[16 * i + fr];
                *(uint2*)(Os + (16 * i + fr) * 272 + (16 * w + 4 * fq) * 2) = make_uint2(pk2(a[0] * rd, a[1] * rd), pk2(a[2] * rd, a[3] * rd));
            }
        }
        lds_barrier();
        pin_u4(mo0); pin_u4(mo1); pin_u4(cc0); pin_u4(cc1);
        {
            const int l = tid >> 3, part = tid & 7;
            const uint4 o0 = *(const uint4*)(Os + l * 272 + part * 32), o1 = *(const uint4*)(Os + l * 272 + part * 32 + 16);
            const unsigned ow[8] = {o0.x, o0.y, o0.z, o0.w, o1.x, o1.y, o1.z, o1.w};
            const unsigned gw[8] = {mo0.x, mo0.y, mo0.z, mo0.w, mo1.x, mo1.y, mo1.z, mo1.w}, cw[8] = {cc0.x, cc0.y, cc0.z, cc0.w, cc1.x, cc1.y, cc1.z, cc1.w};
            float x[16], s = 0.f;
#pragma unroll
            for (int e = 0; e < 8; ++e) { x[2 * e] = bflo(ow[e]); x[2 * e + 1] = bfhi(ow[e]); s += x[2 * e] + x[2 * e + 1]; }
            const float mu = grp8_sum(s) * (1.f / 128.f);
            float q = 0.f;
#pragma unroll
            for (int e = 0; e < 16; ++e) { x[e] -= mu; q += x[e] * x[e]; }
            const float rstd = rsqrtf(grp8_sum(q) * (1.f / 128.f) + EPSN);
            const float* gn = gn_s + 16 * part;
            const float* sk = sk_s + 16 * part;
            unsigned yo[8];
#pragma unroll
            for (int e = 0; e < 8; ++e) {
                const float ya = sigmoidf_(bflo(gw[e])) * (x[2 * e] * rstd * gn[2 * e] + sk[2 * e] * bflo(cw[e]));
                const float yb_ = sigmoidf_(bfhi(gw[e])) * (x[2 * e + 1] * rstd * gn[2 * e + 1] + sk[2 * e + 1] * bfhi(cw[e]));
                yo[e] = pk2(ya, yb_);
            }
            ml_retire(P);
            uint4* yp = (uint4*)(p.yb + (size_t)(t0 + l) * 1024 + 512 + h * 128 + 16 * part);
            yp[0] = make_uint4(yo[0], yo[1], yo[2], yo[3]);
            yp[1] = make_uint4(yo[4], yo[5], yo[6], yo[7]);
        }
    }
}
DEVI void st_recur(const Params& p, char* smem) {
    if (blockIdx.x >= 128 || gridDim.x <= 128) {
        const int bid = gridDim.x > 128 ? (int)blockIdx.x - 128 : (int)blockIdx.x, nb = gridDim.x > 128 ? (int)gridDim.x - 128 : (int)gridDim.x;
        st_prep_w2(p, smem, bid, nb);
        st_prep_wsub(p, smem, bid, nb);
        st_prep_tables(p, bid, nb);
        if (gridDim.x > 128) return;
    }
    for (int bi = blockIdx.x; bi < 128; bi += gridDim.x) {
        const int kind = bi & 1, h = (bi >> 1) & 3, b = bi >> 3;
        if (kind == 0) ret_block(p, smem, b, h);
        else mlstm_block(p, smem, b, h);
        __syncthreads();
    }
}

DEVI int f2key(float f) { const int b = __float_as_int(f); return b ^ ((b >> 31) & 0x7fffffff); }
DEVI float key2f(int k) { return __int_as_float(k ^ ((k >> 31) & 0x7fffffff)); }
template <int N> DEVI void bsort_desc(int (&v)[N]) {
#pragma unroll
    for (int k = 2; k <= N; k <<= 1)
#pragma unroll
        for (int j = k >> 1; j > 0; j >>= 1)
#pragma unroll
            for (int i = 0; i < N; ++i) {
                const int l = i ^ j;
                if (l > i) {
                    const int a = v[i], b = v[l];
                    const int mx = a > b ? a : b, mn = a > b ? b : a;
                    if ((i & k) == 0) { v[i] = mx; v[l] = mn; } else { v[i] = mn; v[l] = mx; }
                }
            }
}
template <int N> DEVI void bmerge_desc(int (&v)[N]) {
#pragma unroll
    for (int j = N >> 1; j > 0; j >>= 1)
#pragma unroll
        for (int i = 0; i < N; ++i) {
            const int l = i ^ j;
            if (l > i) { const int a = v[i], b = v[l]; v[i] = a > b ? a : b; v[l] = a > b ? b : a; }
        }
}
DEVI void xmerge16(int (&v)[16], int mask) {
    int o[16];
#pragma unroll
    for (int i = 0; i < 16; ++i) o[i] = __shfl_xor(v[15 - i], mask);
#pragma unroll
    for (int i = 0; i < 16; ++i) v[i] = v[i] > o[i] ? v[i] : o[i];
    bmerge_desc<16>(v);
}
__device__ const unsigned char cand_tab[52] = {
    0x00, 0x01, 0x02, 0x03, 0x04, 0x05, 0x06, 0x07, 0x08, 0x09, 0x0a, 0x0b, 0x0c, 0x0d, 0x0e, 0x0f,
    0x10, 0x11, 0x12, 0x13, 0x14, 0x15, 0x16, 0x17, 0x20, 0x21, 0x22, 0x23, 0x24, 0x30, 0x31, 0x32, 0x33,
    0x40, 0x41, 0x42, 0x50, 0x51, 0x60, 0x61, 0x70, 0x71, 0x80, 0x90, 0xa0, 0xb0, 0xc0, 0xd0, 0xe0, 0xf0, 0xff, 0xff};
constexpr int H_A = 256 * 64, H_B = 256 * 64, H_STAGE = H_A + H_B;
constexpr int H_LIST = 3 * H_STAGE;
DEVI void glds16(const void* g, char* l) {
    __builtin_amdgcn_global_load_lds((const __attribute__((address_space(1))) unsigned*)g, (__attribute__((address_space(3))) unsigned*)l, 16, 0, 0);
}
DEVI void gemm3_topk_tile(const Params& p, int m0, int h, char* smem) {
    const int tid = stid(), lane = tid & 63, w = tid >> 6, wt = w >> 1, wp = w & 1, fr = lane & 15, fq = lane >> 4;
    f32x4 acc[4][8];
#pragma unroll
    for (int i = 0; i < 4; ++i)
#pragma unroll
        for (int j = 0; j < 8; ++j) acc[i][j] = (f32x4){0.f, 0.f, 0.f, 0.f};
    const int r16 = lane >> 2, csrc = (lane & 3) ^ ((r16 >> 2) & 3);
    const bf16_t* srcA = p.x1b + (size_t)(m0 + w * 32 + r16) * 1024 + csrc * 8;
    const bf16_t* srcB = p.Wsubt + ((size_t)h * 256 + w * 32 + r16) * 1024 + csrc * 8;
    char* dstA = smem + (w * 32) * 64 + lane * 16;
    char* dstB = smem + H_A + (w * 32) * 64 + lane * 16;
    auto issue = [&](int kt, int buf) {
#pragma unroll
        for (int q = 0; q < 2; ++q) glds16(srcA + (size_t)q * 16 * 1024 + kt * 32, dstA + buf * H_STAGE + q * 1024);
#pragma unroll
        for (int q = 0; q < 2; ++q) glds16(srcB + (size_t)q * 16 * 1024 + kt * 32, dstB + buf * H_STAGE + q * 1024);
    };
    const int rdoff = fr * 64 + ((fq ^ ((fr >> 2) & 3)) * 16);
    issue(0, 0);
    issue(1, 1);
    asm volatile("s_waitcnt vmcnt(4)" ::: "memory");
    __builtin_amdgcn_s_barrier();
    int buf = 0;
#pragma unroll 1
    for (int kt = 0; kt < 32; ++kt) {
        const int b2 = buf >= 1 ? buf - 1 : 2;
        if (kt + 2 < 32) issue(kt + 2, b2);
        const char* As = smem + buf * H_STAGE + (wt * 64) * 64 + rdoff;
        const char* Bs = smem + buf * H_STAGE + H_A + (wp * 128) * 64 + rdoff;
        bf16x8 a[4];
#pragma unroll
        for (int i = 0; i < 4; ++i) a[i] = ld8(As + (16 * i) * 64);
#pragma unroll
        for (int jg = 0; jg < 2; ++jg) {
            bf16x8 b[4];
#pragma unroll
            for (int j = 0; j < 4; ++j) b[j] = ld8(Bs + (16 * (4 * jg + j)) * 64);
#pragma unroll
            for (int i = 0; i < 4; ++i)
#pragma unroll
                for (int j = 0; j < 4; ++j) acc[i][4 * jg + j] = mfma16(b[j], a[i], acc[i][4 * jg + j]);
        }
        if (kt + 2 < 32) asm volatile("s_waitcnt vmcnt(4)" ::: "memory");
        else asm volatile("s_waitcnt vmcnt(0)" ::: "memory");
        __builtin_amdgcn_s_barrier();
        buf = buf == 2 ? 0 : buf + 1;
    }
    int* LX = (int*)(smem + H_LIST);
#pragma unroll
    for (int i = 0; i < 4; ++i) {
        const int tl = 64 * wt + 16 * i + fr;
        const float rs = rs2_of(p.rs2p, m0 + tl);
        int ka[16], kb[16];
#pragma unroll
        for (int jj = 0; jj < 4; ++jj)
#pragma unroll
            for (int r = 0; r < 4; ++r) {
                ka[jj * 4 + r] = (f2key(acc[i][jj][r] * rs) & ~127) | (16 * jj + 4 * fq + r);
                kb[jj * 4 + r] = (f2key(acc[i][4 + jj][r] * rs) & ~127) | (16 * (jj + 4) + 4 * fq + r);
            }
        bsort_desc<16>(ka);
        bsort_desc<16>(kb);
#pragma unroll
        for (int q = 0; q < 16; ++q) ka[q] = ka[q] > kb[15 - q] ? ka[q] : kb[15 - q];
        bmerge_desc<16>(ka);
        xmerge16(ka, 16);
        xmerge16(ka, 32);
        const int k0 = fq == 0 ? ka[0] : fq == 1 ? ka[4] : fq == 2 ? ka[8] : ka[12];
        const int k1 = fq == 0 ? ka[1] : fq == 1 ? ka[5] : fq == 2 ? ka[9] : ka[13];
        const int k2 = fq == 0 ? ka[2] : fq == 1 ? ka[6] : fq == 2 ? ka[10] : ka[14];
        const int k3 = fq == 0 ? ka[3] : fq == 1 ? ka[7] : fq == 2 ? ka[11] : ka[15];
        *(int4*)(LX + tl * 32 + wp * 16 + 4 * fq) = make_int4(k0, k1, k2, k3);
    }
    __syncthreads();
#pragma unroll
    for (int i2 = 0; i2 < 2; ++i2) {
        const int tl = 32 * w + 16 * i2 + fr, t = m0 + tl;
        const int* L = LX + tl * 32;
        const unsigned long long clo = fq == 0 ? 0x0706050403020100ull : fq == 1 ? 0x14131211100f0e0dull : fq == 2 ? 0x4033323130242322ull : 0xc0b0a09080717061ull;
        const unsigned long long chi = fq == 0 ? 0x0c0b0a0908ull : fq == 1 ? 0x2120171615ull : fq == 2 ? 0x6051504241ull : 0xfffff0e0d0ull;
        int c[16];
#pragma unroll
        for (int s = 0; s < 13; ++s) {
            const int ab = (int)((s < 8 ? (clo >> (8 * s)) : (chi >> (8 * (s - 8)))) & 0xffull);
            const int k1 = L[ab >> 4], k2 = L[16 + (ab & 15)];
            const float v = key2f(k1 & ~127) + key2f(k2 & ~127);
            c[s] = (f2key(v) & ~0x3fff) | ((k1 & 127) << 7) | (k2 & 127);
        }
        c[13] = c[14] = c[15] = (int)0x80000000;
        bsort_desc<16>(c);
        xmerge16(c, 16);
        xmerge16(c, 32);
        const float vmax = key2f(c[0] & ~0x3fff);
        float e[16], sum = 0.f;
#pragma unroll
        for (int q = 0; q < 16; ++q) { e[q] = __expf(key2f(c[q] & ~0x3fff) - vmax); sum += e[q]; }
        const float inv = 1.f / sum;
        int ce[4]; float ge[4];
#pragma unroll
        for (int q = 0; q < 4; ++q) {
            const int cq = fq == 0 ? c[q] : fq == 1 ? c[4 + q] : fq == 2 ? c[8 + q] : c[12 + q];
            const float eq = fq == 0 ? e[q] : fq == 1 ? e[4 + q] : fq == 2 ? e[8 + q] : e[12 + q];
            ce[q] = ((cq >> 7) & 127) * 128 + (cq & 127);
            ge[q] = eq * inv;
        }
        *(uint2*)(p.eperm + (size_t)t * 128 + h * 16 + 4 * fq) = make_uint2((unsigned)ce[0] | ((unsigned)ce[1] << 16), (unsigned)ce[2] | ((unsigned)ce[3] << 16));
        *(float4*)(p.gate + (size_t)t * 128 + h * 16 + 4 * fq) = make_float4(ge[0], ge[1], ge[2], ge[3]);
    }
    __syncthreads();
}
DEVI void st_gemm3_topk(const Params& p, char* smem) {
    for (int it = blockIdx.x; it < 128 * 8; it += gridDim.x) gemm3_topk_tile(p, (it >> 3) * 256, it & 7, smem);
}

#define XB_TMO      128
#define XB_XCNT(j)  (256  + 64 * (j))
#define XB_XSUB(j)  (1280 + 64 * (j))
#define XB_XGEN(j)  (2304 + 64 * (j))
#define XB_TOP      3328
#define XB_TOPGEN   3392
#define XCD_BAR_WORDS 3456
#define XB_SPIN_CAP (1u << 20)
#define LAS __attribute__((address_space(3)))
DEVI unsigned xb_ld(unsigned* p) { return __hip_atomic_load(p, __ATOMIC_RELAXED, __HIP_MEMORY_SCOPE_AGENT); }
DEVI unsigned xb_add(unsigned* p, unsigned v) { return __hip_atomic_fetch_add(p, v, __ATOMIC_RELAXED, __HIP_MEMORY_SCOPE_AGENT); }
DEVI unsigned xb_xcc_id() { return (unsigned)__builtin_amdgcn_s_getreg((3 << 11) | 20) & 0xFu; }
#define XB_SPIN(cond, bar) do { unsigned _sp = 0; while (cond) { __builtin_amdgcn_s_sleep(1); \
    if ((++_sp & 255u) == 0u) { if (xb_ld(&(bar)[XB_TMO])) break; if (_sp > XB_SPIN_CAP) { atomicAdd(&(bar)[XB_TMO], 1u); break; } } } } while (0)
struct XcdBarrier { unsigned* bar; unsigned x; volatile LAS unsigned* st; };
DEVI XcdBarrier xcd_barrier_post(unsigned* bar, volatile LAS unsigned* st) {
    XcdBarrier b; b.bar = bar; b.x = xb_xcc_id(); b.st = st;
    if (stid() == 0) (void)xb_add(&bar[XB_XCNT(b.x)], 1u);
    return b;
}
DEVI void xcd_barrier_complete(unsigned* bar, unsigned x, unsigned& nloc, unsigned& nx) {
    const unsigned G = gridDim.x * gridDim.y * gridDim.z;
    unsigned sum, cnt, mine, sp = 0u;
    for (;;) {
        sum = 0u; cnt = 0u; mine = 0u;
#pragma unroll
        for (unsigned j = 0; j < 16; ++j) { const unsigned c = xb_ld(&bar[XB_XCNT(j)]); sum += c; cnt += (c > 0u) ? 1u : 0u; mine = (j == x) ? c : mine; }
        if (sum == G) break;
        __builtin_amdgcn_s_sleep(1);
        if ((++sp & 255u) == 0u) { if (xb_ld(&bar[XB_TMO])) break; if (sp > XB_SPIN_CAP) { atomicAdd(&bar[XB_TMO], 1u); break; } }
    }
    nloc = mine > 0u ? mine : 1u; nx = cnt > 0u ? cnt : 1u;
}
DEVI void xcd_barrier(const XcdBarrier& b) {
    asm volatile("s_waitcnt vmcnt(0)" ::: "memory");
    __syncthreads();
    if (stid() == 0) {
        unsigned* bar = b.bar;
        __builtin_amdgcn_s_waitcnt(0);
        unsigned nloc = b.st[0], nx = b.st[1];
        if (nloc == 0u) { xcd_barrier_complete(bar, b.x, nloc, nx); b.st[0] = nloc; b.st[1] = nx; }
        const unsigned old = xb_add(&bar[XB_XSUB(b.x)], 1u);
        const unsigned gen = old / nloc;
        if (old + 1u == (gen + 1u) * nloc) {
            __builtin_amdgcn_fence(__ATOMIC_RELEASE, "agent");
            asm volatile("s_waitcnt vmcnt(0)" ::: "memory");
            const unsigned og = xb_add(&bar[XB_TOP], 1u);
            const unsigned tg = og / nx;
            if (og + 1u == (tg + 1u) * nx) xb_add(&bar[XB_TOPGEN], 1u);
            else XB_SPIN(xb_ld(&bar[XB_TOPGEN]) == tg, bar);
            __builtin_amdgcn_fence(__ATOMIC_ACQUIRE, "agent");
            xb_add(&bar[XB_XGEN(b.x)], 1u);
            asm volatile("s_waitcnt vmcnt(0)" ::: "memory");
        } else {
            XB_SPIN(xb_ld(&bar[XB_XGEN(b.x)]) == gen, bar);
            __builtin_amdgcn_fence(__ATOMIC_ACQUIRE, "agent");
            asm volatile("s_waitcnt vmcnt(0)" ::: "memory");
        }
    }
    __syncthreads();
}

#define CTR_A(x) (XCD_BAR_WORDS + 64 * (x))
#define CTR_B(x) (XCD_BAR_WORDS + 512 + 64 * (x))
#define CTL_WORDS (XCD_BAR_WORDS + 1024)
typedef float f32x2 __attribute__((ext_vector_type(2)));
DEVI float ub(unsigned w, int n) { return (float)((w >> (8 * n)) & 0xffu); }
DEVI float gelu_erf(float u) { return 0.5f * u * (1.f + erff(u * 0.70710678118654752f)); }
struct ExpMeta { uint4 e[2]; uint4 xa; float sc; };
struct ExpRows { uint4 r[16]; unsigned x1; };

template <int PHASE> DEVI void exp_load_meta(const Params& p, ExpMeta& m, int t, int x, int lane) {
    const uint4* ep = (const uint4*)(p.eperm + (size_t)t * 128 + (lane >> 3) * 16);
    m.e[0] = ep[0];
    m.e[1] = ep[1];
    if (PHASE == 0) m.xa = *(const uint4*)(p.xq + (size_t)t * 1024 + 128 * x + 16 * (lane & 7));
    else { m.xa = *(const uint4*)(p.aq + (size_t)t * 128 + (lane >> 3) * 16); m.sc = p.asc[t]; }
}
template <int PHASE> DEVI void exp_issue(const Params& p, const ExpMeta& m, ExpRows& R, int t, int x, int lane) {
    const unsigned char* base = (PHASE == 0 ? p.down_q : p.up_q) + (size_t)x * (16384 * 128) + (lane & 7) * 16;
    const unsigned ew[8] = {m.e[0].x, m.e[0].y, m.e[0].z, m.e[0].w, m.e[1].x, m.e[1].y, m.e[1].z, m.e[1].w};
#pragma unroll
    for (int j = 0; j < 16; ++j) {
        const unsigned ek = (j & 1) ? (ew[j >> 1] >> 16) : (ew[j >> 1] & 0xffffu);
        R.r[j] = *(const uint4*)(base + (size_t)ek * 128);
    }
    if (PHASE == 1) {
        const int col = 128 * x + 16 * (lane & 7) + ((lane & 32) ? 8 : 0) + ((lane & 16) ? 4 : 0) + ((lane & 8) ? 2 : 0);
        R.x1 = *(const unsigned*)(p.x1b + (size_t)t * 1024 + col);
    }
}
DEVI void expA_compute(const Params& p, const ExpMeta& m, const ExpRows& R, int t, int x, int lane) {
    const bool b2 = lane & 4, b1 = lane & 2, b0 = lane & 1;
    int ps[16];
#pragma unroll
    for (int j = 0; j < 16; ++j)
        ps[j] = __builtin_amdgcn_sdot4((int)R.r[j].x, (int)m.xa.x, __builtin_amdgcn_sdot4((int)R.r[j].y, (int)m.xa.y,
                __builtin_amdgcn_sdot4((int)R.r[j].z, (int)m.xa.z, __builtin_amdgcn_sdot4((int)R.r[j].w, (int)m.xa.w, 0, false), false), false), false);
    int q8[8], q4[4], q2[2];
#pragma unroll
    for (int j = 0; j < 8; ++j) { const int snd = b2 ? ps[j] : ps[j + 8], kp = b2 ? ps[j + 8] : ps[j]; q8[j] = kp + dpp_i<DPP_HMIRROR>(snd); }
#pragma unroll
    for (int j = 0; j < 4; ++j) { const int snd = b1 ? q8[j] : q8[j + 4], kp = b1 ? q8[j + 4] : q8[j]; q4[j] = kp + dpp_i<DPP_XOR2>(snd); }
#pragma unroll
    for (int j = 0; j < 2; ++j) { const int snd = b0 ? q4[j] : q4[j + 2], kp = b0 ? q4[j + 2] : q4[j]; q2[j] = kp + dpp_i<DPP_XOR1>(snd); }
    {
        int s0 = q2[0] >> 3, s1 = q2[1] >> 3;
        s0 = s0 > 32767 ? 32767 : (s0 < -32768 ? -32768 : s0);
        s1 = s1 > 32767 ? 32767 : (s1 < -32768 ? -32768 : s1);
        *(unsigned*)(p.part + ((size_t)x * T_TOK + t) * 128 + 2 * lane) = ((unsigned)s0 & 0xffffu) | ((unsigned)s1 << 16);
    }
}
DEVI void expB_compute(const Params& p, const ExpMeta& m, const ExpRows& R, int t, int x, int lane) {
    const bool b5 = lane & 32, b4 = lane & 16, b3 = lane & 8;
    const unsigned pa[4] = {m.xa.x, m.xa.y, m.xa.z, m.xa.w};
    int acc[16];
#pragma unroll
    for (int c = 0; c < 16; ++c) acc[c] = 0;
#pragma unroll
    for (int g = 0; g < 4; ++g) {
        const unsigned r0[4] = {R.r[4 * g].x, R.r[4 * g].y, R.r[4 * g].z, R.r[4 * g].w};
        const unsigned r1[4] = {R.r[4 * g + 1].x, R.r[4 * g + 1].y, R.r[4 * g + 1].z, R.r[4 * g + 1].w};
        const unsigned r2[4] = {R.r[4 * g + 2].x, R.r[4 * g + 2].y, R.r[4 * g + 2].z, R.r[4 * g + 2].w};
        const unsigned r3[4] = {R.r[4 * g + 3].x, R.r[4 * g + 3].y, R.r[4 * g + 3].z, R.r[4 * g + 3].w};
#pragma unroll
        for (int i = 0; i < 4; ++i) {
            const unsigned t0 = __builtin_amdgcn_perm(r1[i], r0[i], 0x05010400u), t1 = __builtin_amdgcn_perm(r1[i], r0[i], 0x07030602u);
            const unsigned t2 = __builtin_amdgcn_perm(r3[i], r2[i], 0x05010400u), t3 = __builtin_amdgcn_perm(r3[i], r2[i], 0x07030602u);
            const unsigned o0 = __builtin_amdgcn_perm(t2, t0, 0x05040100u), o1 = __builtin_amdgcn_perm(t2, t0, 0x07060302u);
            const unsigned o2 = __builtin_amdgcn_perm(t3, t1, 0x05040100u), o3 = __builtin_amdgcn_perm(t3, t1, 0x07060302u);
            acc[4 * i + 0] = __builtin_amdgcn_sdot4((int)o0, (int)pa[g], acc[4 * i + 0], false);
            acc[4 * i + 1] = __builtin_amdgcn_sdot4((int)o1, (int)pa[g], acc[4 * i + 1], false);
            acc[4 * i + 2] = __builtin_amdgcn_sdot4((int)o2, (int)pa[g], acc[4 * i + 2], false);
            acc[4 * i + 3] = __builtin_amdgcn_sdot4((int)o3, (int)pa[g], acc[4 * i + 3], false);
        }
    }
    int q8[8], q4[4], q2[2];
#pragma unroll
    for (int j = 0; j < 8; ++j) {
        const auto r = __builtin_amdgcn_permlane32_swap((unsigned)acc[j], (unsigned)acc[j + 8], false, false);
        q8[j] = (int)r[0] + (int)r[1];
    }
#pragma unroll
    for (int j = 0; j < 4; ++j) {
        const auto r = __builtin_amdgcn_permlane16_swap((unsigned)q8[j], (unsigned)q8[j + 4], false, false);
        q4[j] = (int)r[0] + (int)r[1];
    }
#pragma unroll
    for (int j = 0; j < 2; ++j) { const int snd = b3 ? q4[j] : q4[j + 2], kp = b3 ? q4[j + 2] : q4[j]; q2[j] = kp + dpp_i<DPP_ROR8>(snd); }
    const int col = 128 * x + 16 * (lane & 7) + (b5 ? 8 : 0) + (b4 ? 4 : 0) + (b3 ? 2 : 0);
    *(unsigned*)(p.proj + (size_t)t * 1024 + col) = pk2(bflo(R.x1) + (float)q2[0] * m.sc, bfhi(R.x1) + (float)q2[1] * m.sc);
}
template <int PHASE>
DEVI void exp_chunk(const Params& p, int tb, int x, int lane) {
    ExpMeta mA, mB, nA, nB;
    ExpRows rA, rB;
    exp_load_meta<PHASE>(p, mA, tb, x, lane);
    exp_load_meta<PHASE>(p, mB, tb + 1, x, lane);
    exp_issue<PHASE>(p, mA, rA, tb, x, lane);
    exp_issue<PHASE>(p, mB, rB, tb + 1, x, lane);
    exp_load_meta<PHASE>(p, nA, tb + 2, x, lane);
    exp_load_meta<PHASE>(p, nB, tb + 3, x, lane);
#pragma unroll 1
    for (int i = 0; i < 8; ++i) {
        const int tA = tb + 2 * i, tB = tA + 1;
        if (PHASE == 0) expA_compute(p, mA, rA, tA, x, lane); else expB_compute(p, mA, rA, tA, x, lane);
        if (i < 7) {
            mA = nA;
            exp_issue<PHASE>(p, mA, rA, tA + 2, x, lane);
            if (i < 6) exp_load_meta<PHASE>(p, nA, tA + 4, x, lane);
        }
        if (PHASE == 0) expA_compute(p, mB, rB, tB, x, lane); else expB_compute(p, mB, rB, tB, x, lane);
        if (i < 7) {
            mB = nB;
            exp_issue<PHASE>(p, mB, rB, tB + 2, x, lane);
            if (i < 6) exp_load_meta<PHASE>(p, nB, tB + 4, x, lane);
        }
    }
}
template <int PHASE>
DEVI void st_expAB(const Params& p, char* smem) {
    const int tid = stid(), lane = tid & 63, wid = tid >> 6;
    volatile int* cs = (volatile int*)smem;
    const unsigned myx = xb_xcc_id() & 7u;
    constexpr int NCH = T_TOK / (16 * NW);
    for (int si = 0; si < 8; ++si) {
        const int x = (int)((myx + si) & 7u);
        unsigned* ctr = &p.bar[PHASE == 0 ? CTR_A(x) : CTR_B(x)];
        if (tid == 0) cs[0] = (int)xb_add(ctr, 1u);
        __syncthreads();
        int chunk = cs[0];
        __syncthreads();
        while (chunk < NCH) {
            int nxt = 0;
            if (tid == 0) nxt = (int)xb_add(ctr, 1u);
            exp_chunk<PHASE>(p, chunk * (16 * NW) + wid * 16, x, lane);
            if (tid == 0) cs[0] = nxt;
            __syncthreads();
            chunk = cs[0];
            __syncthreads();
        }
    }
}
DEVI void st_expA2(const Params& p) {
    const int lane = stid() & 63, wid = stid() >> 6;
    for (int t0 = (blockIdx.x * NW + wid) * 2; t0 < T_TOK; t0 += gridDim.x * NW * 2) {
        unsigned pv[2][8], ew[2];
        float2 g[2];
        float xs[2];
#pragma unroll
        for (int q = 0; q < 2; ++q) {
            const int t = t0 + q;
#pragma unroll
            for (int x = 0; x < 8; ++x) pv[q][x] = *(const unsigned*)(p.part + ((size_t)x * T_TOK + t) * 128 + 2 * lane);
            ew[q] = *(const unsigned*)(p.eperm + (size_t)t * 128 + 2 * lane);
            g[q] = *(const float2*)(p.gate + (size_t)t * 128 + 2 * lane);
            xs[q] = rs2_of(p.rs2p, t) * (8.f * ZQ_SCALE);
        }
        float ds[2][2], us[2][2];
#pragma unroll
        for (int q = 0; q < 2; ++q) {
            const int ea = (int)(ew[q] & 0xffffu), eb = (int)(ew[q] >> 16);
            ds[q][0] = p.dscale[ea]; ds[q][1] = p.dscale[eb]; us[q][0] = p.uscale[ea]; us[q][1] = p.uscale[eb];
        }
#pragma unroll
        for (int q = 0; q < 2; ++q) {
            const int t = t0 + q;
            int s0 = 0, s1 = 0;
#pragma unroll
            for (int x = 0; x < 8; ++x) { s0 += (int)(short)(pv[q][x] & 0xffffu); s1 += (int)pv[q][x] >> 16; }
            const float a0 = g[q].x * gelu_erf((float)s0 * xs[q] * ds[q][0]) * us[q][0];
            const float a1 = g[q].y * gelu_erf((float)s1 * xs[q] * ds[q][1]) * us[q][1];
            const float amax = wave_max(fmaxf(fabsf(a0), fabsf(a1)));
            const float inv = amax > 0.f ? 127.f / amax : 0.f;
            const unsigned q0 = (unsigned)((int)rintf(a0 * inv) & 255), q1 = (unsigned)((int)rintf(a1 * inv) & 255);
            *(unsigned short*)(p.aq + (size_t)t * 128 + 2 * lane) = (unsigned short)(q0 | (q1 << 8));
            if (lane == 0) p.asc[t] = amax * (1.f / 127.f);
        }
    }
}
DEVI void st_expC(const Params& p) {
    const int lane = stid() & 63, wid = stid() >> 6;
    for (int t0 = (blockIdx.x * NW + wid) * 2; t0 < T_TOK; t0 += gridDim.x * NW * 2) {
        uint2 u[2][4];
#pragma unroll
        for (int q = 0; q < 2; ++q) {
            const uint2* row = (const uint2*)(p.proj + (size_t)(t0 + q) * 1024);
#pragma unroll
            for (int j = 0; j < 4; ++j) u[q][j] = row[lane + 64 * j];
        }
#pragma unroll
        for (int q = 0; q < 2; ++q) {
            float4 v[4];
            float ss = 0.f;
#pragma unroll
            for (int j = 0; j < 4; ++j) {
                v[j] = make_float4(bflo(u[q][j].x), bfhi(u[q][j].x), bflo(u[q][j].y), bfhi(u[q][j].y));
                ss += v[j].x * v[j].x + v[j].y * v[j].y + v[j].z * v[j].z + v[j].w * v[j].w;
            }
            ss = wave_sum(ss);
            const float rf = rsqrtf(ss * (1.f / 1024.f) + EPSN);
            float4* orow = (float4*)(p.out + (size_t)(t0 + q) * 1024);
#pragma unroll
            for (int j = 0; j < 4; ++j) {
                const float4 g = *(const float4*)(p.final_g + (lane + 64 * j) * 4);
                orow[lane + 64 * j] = make_float4(v[j].x * rf * g.x, v[j].y * rf * g.y, v[j].z * rf * g.z, v[j].w * rf * g.w);
            }
        }
    }
}

constexpr int LDS_BYTES = 147456;
constexpr int LDS_BARW = LDS_BYTES - 16;
extern __shared__ __attribute__((aligned(16))) char smem_dyn[];
__global__ void __launch_bounds__(NTHR, 2) mega_fwd(Params p) {
    cg::grid_group grid = cg::this_grid();
    volatile LAS unsigned* bst = (volatile LAS unsigned*)(LAS char*)(smem_dyn + LDS_BARW);
    if (stid() < 4) bst[stid()] = 0u;
    __syncthreads();
    XcdBarrier bar = xcd_barrier_post(p.bar, bst);
    st_prep_misc(p);
    st_prep_w1(p, smem_dyn);
    st_prep_x(p, smem_dyn);
    if (p.pad_[0] == 0x7fffabcd) grid.sync();
    xcd_barrier(bar);
    st_gemm8<EpiProj8, PG8_ALIGN>(p.xb, p.W1t, NPJ, 1024, smem_dyn, EpiProj8{p.proj, p.rs1, p.rope_cos, p.rope_sin});
    xcd_barrier(bar);
    st_conv_qk(p, smem_dyn);
    xcd_barrier(bar);
    st_recur(p, smem_dyn);
    xcd_barrier(bar);
    st_gemm8<EpiX18, PG8_ALIGN>(p.yb, p.W2t, 1024, 1024, smem_dyn, EpiX18{p.x, p.x1b, p.xq, p.rs2p, p.norm2_g});
    xcd_barrier(bar);
    st_gemm3_topk(p, smem_dyn);
    xcd_barrier(bar);
    st_expAB<0>(p, smem_dyn);
    xcd_barrier(bar);
    st_expA2(p);
    xcd_barrier(bar);
    st_expAB<1>(p, smem_dyn);
    xcd_barrier(bar);
    st_expC(p);
}

extern "C" void kernel_launch(void* const* d_in, const int* in_sizes, int n_in, void* d_out, int out_size, void* d_ws, size_t ws_size,
                              hipStream_t stream) {
    Params p{};
    const float* const* in = (const float* const*)d_in;
    p.x = in[0]; p.norm1_g = in[1]; p.w_in = in[2]; p.ret_norm_g = in[3]; p.m_conv_w = in[4]; p.m_conv_b = in[5]; p.m_wq = in[6]; p.m_wk = in[7];
    p.m_b_i = in[8]; p.m_b_f = in[9]; p.m_norm_g = in[10]; p.m_skip = in[11]; p.w_out = in[12]; p.norm2_g = in[13]; p.peer_wq = in[14];
    p.peer_keys = in[15]; p.peer_down = in[16]; p.peer_up = in[17]; p.final_g = in[18];
    p.out = (float*)d_out;
    char* ws = (char*)d_ws;
    size_t off = 0;
    auto take = [&](size_t bytes) { char* r = ws + off; off += (bytes + 255) & ~(size_t)255; return r; };
    p.proj = (bf16_t*)take((size_t)T_TOK * NPJ * 2);
    p.xb = (bf16_t*)take((size_t)T_TOK * 1024 * 2);
    p.yb = p.xb;
    p.gate = (float*)(ws + (size_t)T_TOK * 2048 * 4);
    p.mq = (bf16_t*)take((size_t)T_TOK * 512 * 2);
    p.mk = (bf16_t*)take((size_t)T_TOK * 512 * 2);
    p.x1b = p.mq;
    p.cbuf = (bf16_t*)take((size_t)T_TOK * 512 * 2);
    p.eperm = (unsigned short*)p.cbuf;
    p.down_q = (unsigned char*)take((size_t)16384 * 1024);
    p.up_q = (unsigned char*)take((size_t)16384 * 1024);
    p.dscale = (float*)take(16384 * 4);
    p.uscale = (float*)take(16384 * 4);
    p.bar = (unsigned*)take(CTL_WORDS * 4);
    p.xq = (unsigned char*)take((size_t)T_TOK * 1024);
    p.asc = (float*)take(T_TOK * 4);
    p.aq = (unsigned char*)take((size_t)T_TOK * 128);
    p.part = (short*)(ws + (size_t)T_TOK * 1024 * 4);
    p.W1t = (bf16_t*)take((size_t)NPJ * 1024 * 2);
    p.W2t = (bf16_t*)take((size_t)1024 * 1024 * 2);
    p.Wsubt = (bf16_t*)take((size_t)2048 * 1024 * 2);
    p.Wqt = (bf16_t*)take(4 * 128 * 128 * 2);
    p.Wkt = (bf16_t*)take(4 * 128 * 128 * 2);
    p.rs1 = (float*)take(T_TOK * 4);
    p.rs2p = (float*)take((size_t)T_TOK * 16 * 4);
    p.ipre = (float*)take(T_TOK * 4 * 4);
    p.logf = (float*)take(T_TOK * 4 * 4);
    p.rope_cos = (float*)take(2048 * 64 * 4);
    p.rope_sin = (float*)take(2048 * 64 * 4);
    if (off > ws_size) { fprintf(stderr, "kernel_launch: workspace too small (%zu > %zu)\n", off, ws_size); return; }

    static int grid_blocks = 0;
    if (!grid_blocks) {
        int dev = 0, cus = 0, per_cu = 0;
        (void)hipGetDevice(&dev);
        (void)hipDeviceGetAttribute(&cus, hipDeviceAttributeMultiprocessorCount, dev);
        (void)hipFuncSetAttribute((const void*)mega_fwd, hipFuncAttributeMaxDynamicSharedMemorySize, LDS_BYTES);
        (void)hipOccupancyMaxActiveBlocksPerMultiprocessor(&per_cu, (const void*)mega_fwd, NTHR, LDS_BYTES);
        if (per_cu > 1) per_cu = 1;
        if (per_cu < 1) per_cu = 1;
        grid_blocks = cus * per_cu;
    }
    (void)hipMemsetAsync(p.bar, 0, CTL_WORDS * 4, stream);
    void* args[] = {&p};
    hipError_t e = hipLaunchCooperativeKernel((const void*)mega_fwd, dim3(grid_blocks), dim3(NTHR), args, LDS_BYTES, stream);
    if (e != hipSuccess) fprintf(stderr, "cooperative launch failed: %s (grid %d)\n", hipGetErrorString(e), grid_blocks);
}
```

```cpp
#include <hip/hip_runtime.h>
#include <hip/hip_cooperative_groups.h>
#include <stdint.h>
#include <cstdio>
namespace cg = cooperative_groups;

typedef unsigned short bf16_t;
typedef short bf16x8 __attribute__((ext_vector_type(8)));
typedef float f32x4 __attribute__((ext_vector_type(4)));
typedef int i32x4 __attribute__((ext_vector_type(4)));

#define DEVI __device__ __forceinline__
__device__ __forceinline__ int stid() { int t = (int)threadIdx.x; asm volatile("" : "+v"(t)); return t; }

constexpr int T_TOK = 32768, DM = 1024, NPJ = 3584, DIN = 3592;
constexpr int NTHR = 512, NW = 8;
constexpr float EPSN = 1e-6f;

struct Params {
    const float *x, *norm1_g, *w_in, *ret_norm_g, *m_conv_w, *m_conv_b, *m_wq, *m_wk, *m_b_i, *m_b_f, *m_norm_g, *m_skip, *w_out,
        *norm2_g, *peer_wq, *peer_keys, *peer_down, *peer_up, *final_g;
    float* out;
    bf16_t *proj, *xb, *yb, *mq, *mk, *x1b, *cbuf, *W1t, *W2t, *Wqt, *Wkt;
    signed char* Wsubq;
    float* wsc;
    unsigned char *down_q, *up_q;
    float *dscale, *uscale, *asc;
    unsigned short* eperm;
    unsigned char* aq;
    short* part;
    unsigned char* xq;
    unsigned* bar;
    float *rs1, *rs2p, *ipre, *logf, *rope_cos, *rope_sin, *gate;
    int pad_[2];
};

DEVI unsigned f2bf_bits(float f) { unsigned u = __float_as_uint(f); return (u + 0x7fffu + ((u >> 16) & 1u)) >> 16; }
DEVI bf16_t f2bf(float f) { return __builtin_bit_cast(bf16_t, (__bf16)f); }
typedef __bf16 bf16x2_t __attribute__((ext_vector_type(2)));
DEVI unsigned pk2(float lo, float hi) { bf16x2_t v = {(__bf16)lo, (__bf16)hi}; return __builtin_bit_cast(unsigned, v); }
DEVI float bflo(unsigned w) { return __uint_as_float(w << 16); }
DEVI float bfhi(unsigned w) { return __uint_as_float(w & 0xffff0000u); }
DEVI float bf2f(bf16_t h) { return __uint_as_float(((unsigned)h) << 16); }
template <int CTRL> DEVI float dpp_f(float v) { return __int_as_float(__builtin_amdgcn_update_dpp(0, __float_as_int(v), CTRL, 0xf, 0xf, false)); }
template <int CTRL> DEVI int dpp_i(int v) { return __builtin_amdgcn_update_dpp(0, v, CTRL, 0xf, 0xf, false); }
constexpr int DPP_XOR1 = 0xB1  , DPP_XOR2 = 0x4E  , DPP_HMIRROR = 0x141  ,
              DPP_MIRROR = 0x140  , DPP_ROR8 = 0x128  ;
DEVI float rl_f(float v, int l) { return __int_as_float(__builtin_amdgcn_readlane(__float_as_int(v), l)); }
DEVI float wave_sum(float v) {
    v += dpp_f<DPP_XOR1>(v); v += dpp_f<DPP_XOR2>(v); v += dpp_f<DPP_HMIRROR>(v); v += dpp_f<DPP_MIRROR>(v);
    return (rl_f(v, 0) + rl_f(v, 16)) + (rl_f(v, 32) + rl_f(v, 48));
}
DEVI float wave_max(float v) {
    v = fmaxf(v, dpp_f<DPP_XOR1>(v)); v = fmaxf(v, dpp_f<DPP_XOR2>(v)); v = fmaxf(v, dpp_f<DPP_HMIRROR>(v)); v = fmaxf(v, dpp_f<DPP_MIRROR>(v));
    return fmaxf(fmaxf(rl_f(v, 0), rl_f(v, 16)), fmaxf(rl_f(v, 32), rl_f(v, 48)));
}
constexpr float ZQ_SCALE = 6.f / 127.f;
DEVI float rs2_of(const float* rs2p, int t) {
    const float4* q = (const float4*)(rs2p + (size_t)t * 16);
    const float4 a = q[0], b = q[1], c = q[2], d = q[3];
    const float ss = ((a.x + a.y) + (a.z + a.w)) + ((b.x + b.y) + (b.z + b.w)) + ((c.x + c.y) + (c.z + c.w)) + ((d.x + d.y) + (d.z + d.w));
    return rsqrtf(ss * (1.f / 1024.f) + EPSN);
}
DEVI f32x4 mfma16(bf16x8 a, bf16x8 b, f32x4 c) { return __builtin_amdgcn_mfma_f32_16x16x32_bf16(a, b, c, 0, 0, 0); }
DEVI bf16x8 ld8(const char* p) { return *reinterpret_cast<const bf16x8*>(p); }
DEVI bf16x8 mk8(uint2 lo, uint2 hi) {
    union { uint4 u; bf16x8 v; } x;
    x.u = make_uint4(lo.x, lo.y, hi.x, hi.y);
    return x.v;
}
DEVI float fexp_(float x) { return __builtin_amdgcn_exp2f(x * 1.4426950408889634f); }
DEVI float rcp_(float x) { return __builtin_amdgcn_rcpf(x); }
DEVI float sigmoidf_(float z) { return rcp_(1.f + fexp_(-z)); }

DEVI void st_prep_misc(const Params& p) {
    const int gtid = blockIdx.x * NTHR + stid(), gsz = gridDim.x * NTHR;
    for (int i = gtid; i < 2048 * 64; i += gsz) {
        const int pos = i >> 6, j = i & 63;
        const float inv = powf(10000.f, -(float)j * (1.f / 64.f));
        const float ang = (float)pos * inv;
        float s, c;
        sincosf(ang, &s, &c);
        p.rope_cos[i] = c;
        p.rope_sin[i] = s;
    }
    for (int i = gtid; i < 4 * 128 * 128; i += gsz) {
        const int h = i >> 14, e = (i >> 7) & 127, d = i & 127;
        p.Wqt[i] = f2bf(p.m_wq[h * 16384 + d * 128 + e]);
        p.Wkt[i] = f2bf(p.m_wk[h * 16384 + d * 128 + e] * 0.08838834764831845f);
    }
}
DEVI void prep_table_row(const Params& p, int row, const float4 (&v)[4], int lane) {
    const bool up = row >= 16384;
    const int e = up ? row - 16384 : row;
    float am = 0.f;
#pragma unroll
    for (int i = 0; i < 4; ++i) am = fmaxf(am, fmaxf(fmaxf(fabsf(v[i].x), fabsf(v[i].y)), fmaxf(fabsf(v[i].z), fabsf(v[i].w))));
    am = wave_max(am);
    const float sc = am > 0.f ? am * (1.f / 127.f) : 1.f, inv = am > 0.f ? 127.f * rcp_(am) : 0.f;
    unsigned w[4];
#pragma unroll
    for (int i = 0; i < 4; ++i) {
        const int q0 = (int)rintf(v[i].x * inv), q1 = (int)rintf(v[i].y * inv), q2 = (int)rintf(v[i].z * inv), q3 = (int)rintf(v[i].w * inv);
        w[i] = (unsigned)(q0 & 255) | ((unsigned)(q1 & 255) << 8) | ((unsigned)(q2 & 255) << 16) | ((unsigned)(q3 & 255) << 24);
    }
    *(uint4*)((up ? p.up_q : p.down_q) + ((size_t)(lane >> 3) * 16384 + e) * 128 + (lane & 7) * 16) = make_uint4(w[0], w[1], w[2], w[3]);
    if (lane == 0) (up ? p.uscale : p.dscale)[e] = sc;
}
DEVI void st_prep_tables(const Params& p, int bid, int nb) {
    const int lane = stid() & 63, wid = stid() >> 6;
    for (int row = (bid * NW + wid) * 2; row < 32768; row += nb * NW * 2) {
        float4 va[4], vb[4];
        const float4* sa = (const float4*)((row >= 16384 ? p.peer_up + (size_t)(row - 16384) * 1024 : p.peer_down + (size_t)row * 1024) + lane * 16);
        const float4* sb = (const float4*)((row + 1 >= 16384 ? p.peer_up + (size_t)(row + 1 - 16384) * 1024 : p.peer_down + (size_t)(row + 1) * 1024) + lane * 16);
#pragma unroll
        for (int i = 0; i < 4; ++i) { va[i] = sa[i]; vb[i] = sb[i]; }
        prep_table_row(p, row, va, lane);
        prep_table_row(p, row + 1, vb, lane);
    }
}

DEVI void transpose_tile(const float* __restrict__ src, int ld, const float* __restrict__ scale, bf16_t* __restrict__ dst, int K, int k0, int n0,
                         float* tile, bool permqk = false) {
    const int tid = stid();
    {
        const int tx = tid & 63, ty = tid >> 6;
#pragma unroll
        for (int i = 0; i < 4; ++i) {
            const int k = k0 + ty + 8 * i;
            float v = src[(size_t)k * ld + n0 + tx];
            if (scale) v *= scale[k];
            tile[(ty + 8 * i) * 65 + tx] = v;
        }
    }
    __syncthreads();
    {
        const int n = tid >> 3, kq = tid & 7;
        const float a = tile[(4 * kq) * 65 + n], b = tile[(4 * kq + 1) * 65 + n], c = tile[(4 * kq + 2) * 65 + n], d = tile[(4 * kq + 3) * 65 + n];
        int nn = n0 + n;
        if (permqk && nn < 1024) { const int dd = nn & 127; nn = (nn & ~127) + (dd < 64 ? 2 * dd : 2 * (dd - 64) + 1); }
        *(uint2*)(dst + (size_t)nn * K + k0 + 4 * kq) = make_uint2(pk2(a, b), pk2(c, d));
    }
    __syncthreads();
}
DEVI void st_prep_w1(const Params& p, char* smem) {
    float* tile = (float*)smem;
    for (int it = blockIdx.x; it < 56 * 32; it += gridDim.x) transpose_tile(p.w_in, DIN, p.norm1_g, p.W1t, 1024, (it & 31) * 32, (it >> 5) * 64, tile, true);
}
DEVI void st_prep_w2(const Params& p, char* smem, int bid, int nb) {
    float* tile = (float*)smem;
    for (int it = bid; it < 16 * 32; it += nb) transpose_tile(p.w_out, 1024, nullptr, p.W2t, 1024, (it & 31) * 32, (it >> 5) * 64, tile);
}
DEVI void st_prep_wsub(const Params& p, char* smem, int bid, int nb) {
    float* wq_s = (float*)smem;
    float* key_s = wq_s + 64 * 132;
    const int tid = stid(), nl = tid >> 5, kp = tid & 31;
    for (int it = bid; it < 16 * 8; it += nb) {
        const int grp = it >> 3, n0 = (it & 7) * 16;
        __syncthreads();
        {
            const int idx = tid * 4, n = idx >> 7, d = idx & 127;
            *(float4*)(key_s + n * 132 + d) = *(const float4*)(p.peer_keys + ((size_t)grp * 128 + n0 + n) * 128 + d);
        }
        float v0[16], v1[16];
#pragma unroll 1
        for (int kt = 0; kt < 16; ++kt) {
            __syncthreads();
#pragma unroll
            for (int i = 0; i < 4; ++i) {
                const int idx = (tid + 512 * i) * 4, r = idx >> 7, d = idx & 127;
                *(float4*)(wq_s + r * 132 + d) = *(const float4*)(p.peer_wq + (size_t)(kt * 64 + r) * 2048 + grp * 128 + d);
            }
            __syncthreads();
            float a0 = 0.f, a1 = 0.f;
#pragma unroll 8
            for (int d4 = 0; d4 < 32; ++d4) {
                const float4 w0 = *(const float4*)(wq_s + (2 * kp) * 132 + 4 * d4), w1 = *(const float4*)(wq_s + (2 * kp + 1) * 132 + 4 * d4);
                const float4 y = *(const float4*)(key_s + nl * 132 + 4 * d4);
                a0 += w0.x * y.x + w0.y * y.y + w0.z * y.z + w0.w * y.w;
                a1 += w1.x * y.x + w1.y * y.y + w1.z * y.z + w1.w * y.w;
            }
#pragma unroll
            for (int q = 0; q < 16; ++q) if (q == kt) { v0[q] = a0; v1[q] = a1; }
        }
        float am = 0.f;
#pragma unroll
        for (int q = 0; q < 16; ++q) am = fmaxf(am, fmaxf(fabsf(v0[q]), fabsf(v1[q])));
#pragma unroll
        for (int o = 16; o; o >>= 1) am = fmaxf(am, __shfl_xor(am, o));
        const float inv = am > 0.f ? 127.f * rcp_(am) : 0.f;
        signed char* orow = p.Wsubq + (size_t)(grp * 128 + n0 + nl) * 1024 + 2 * kp;
#pragma unroll
        for (int q = 0; q < 16; ++q) {
            const int q0 = (int)rintf(v0[q] * inv), q1 = (int)rintf(v1[q] * inv);
            *(unsigned short*)(orow + 64 * q) = (unsigned short)((q0 & 255) | ((q1 & 255) << 8));
        }
        if (kp == 0) p.wsc[grp * 128 + n0 + nl] = am > 0.f ? am * (1.f / 127.f) : 1.f;
    }
    __syncthreads();
}

DEVI void prep_x_token(const Params& p, const float* Wg_s, int t, const float4 (&v)[4], int lane) {
    float ss = 0.f, g8[8];
#pragma unroll
    for (int g = 0; g < 8; ++g) g8[g] = 0.f;
#pragma unroll
    for (int j = 0; j < 4; ++j) {
        ss += v[j].x * v[j].x + v[j].y * v[j].y + v[j].z * v[j].z + v[j].w * v[j].w;
#pragma unroll
        for (int g = 0; g < 8; ++g) {
            const float4 w = *(const float4*)(Wg_s + g * 1024 + (lane + 64 * j) * 4);
            g8[g] += v[j].x * w.x + v[j].y * w.y + v[j].z * w.z + v[j].w * w.w;
        }
    }
    ss = wave_sum(ss);
    const bool b5 = lane & 32, b4 = lane & 16, b3 = lane & 8;
    float q4[4], q2[2], q1;
#pragma unroll
    for (int j = 0; j < 4; ++j) { const float snd = b5 ? g8[j] : g8[j + 4], kp = b5 ? g8[j + 4] : g8[j]; q4[j] = kp + __shfl_xor(snd, 32); }
#pragma unroll
    for (int j = 0; j < 2; ++j) { const float snd = b4 ? q4[j] : q4[j + 2], kp = b4 ? q4[j + 2] : q4[j]; q2[j] = kp + __shfl_xor(snd, 16); }
    { const float snd = b3 ? q2[0] : q2[1], kp = b3 ? q2[1] : q2[0]; q1 = kp + __shfl_xor(snd, 8); }
    q1 += __shfl_xor(q1, 4);
    q1 += __shfl_xor(q1, 2);
    q1 += __shfl_xor(q1, 1);
    const float rs = rsqrtf(ss * (1.f / 1024.f) + EPSN);
    uint2* o = (uint2*)(p.xb + (size_t)t * 1024);
#pragma unroll
    for (int j = 0; j < 4; ++j) o[lane + 64 * j] = make_uint2(pk2(v[j].x, v[j].y), pk2(v[j].z, v[j].w));
    if (lane == 0) p.rs1[t] = rs;
    if ((lane & 7) == 0) {
        const int gi = (b5 ? 4 : 0) + (b4 ? 2 : 0) + (b3 ? 1 : 0);
        if (gi < 4) p.ipre[t * 4 + gi] = q1 * rs + p.m_b_i[gi];
        else {
            const float z = q1 * rs + p.m_b_f[gi - 4];
            p.logf[t * 4 + gi - 4] = fminf(z, 0.f) - log1pf(fexp_(-fabsf(z)));
        }
    }
}
DEVI void st_prep_x(const Params& p, char* smem) {
    float* Wg_s = (float*)smem;
    for (int i = stid(); i < 8192; i += NTHR) {
        const int k = i >> 3, g = i & 7;
        Wg_s[g * 1024 + k] = p.norm1_g[k] * p.w_in[(size_t)k * DIN + NPJ + g];
    }
    __syncthreads();
    const int lane = stid() & 63, wid = stid() >> 6;
    for (int t = (blockIdx.x * NW + wid) * 4; t < T_TOK; t += gridDim.x * NW * 4) {
        float4 v[4][4];
        const float4* xa = (const float4*)(p.x + (size_t)t * 1024);
#pragma unroll
        for (int q = 0; q < 4; ++q)
#pragma unroll
            for (int j = 0; j < 4; ++j) v[q][j] = xa[256 * q + lane + 64 * j];
#pragma unroll
        for (int q = 0; q < 4; ++q) prep_x_token(p, Wg_s, t + q, v[q], lane);
    }
    __syncthreads();
}

namespace pg8 {
#define PG8_LAS __attribute__((address_space(3)))
typedef unsigned short bf16_t;
typedef short bf16x8 __attribute__((ext_vector_type(8)));
typedef float f32x4 __attribute__((ext_vector_type(4)));
typedef unsigned u32x4 __attribute__((ext_vector_type(4)));
constexpr int BM = 256, BK = 64, HALF = 128, HTB = HALF * BK * 2  , STAGE_BYTES = 8 * HTB, NXCD = 8, WGM = 8;

__host__ __device__ __forceinline__ int lds_byte(int r, int c) { const int st = (r >> 4) * 2 + (c >> 5), rr = r & 15, cc = c & 31, ob = rr * 64 + cc * 2; return st * 1024 + (ob ^ (((ob >> 9) & 1) << 5)); }
__host__ __device__ __forceinline__ void stage_rc(int b, int& R, int& C) { const int st = b / 1024, sb = b % 1024, swz = sb ^ (((sb >> 9) & 1) << 5); R = (st >> 1) * 16 + swz / 64; C = (st & 1) * 32 + (swz % 64) / 2; }
__host__ __device__ __forceinline__ int perm32(int rho) { const int n = rho >> 4, i = rho & 15; return 8 * (i >> 2) + 4 * n + (i & 3); }

struct Unit { int pm, pn; };
struct Gemm { const bf16_t* A; const bf16_t* Bt; int M, N, K; };

struct StaticOrder {
    int nM, nN, nwg, G, c;
    __host__ __device__ void init(int M, int N, int G_, int c_) { nM = M / BM; nN = N / BM; nwg = nM * nN; G = G_; c = c_; }
    __host__ __device__ bool next(int i, Unit& u) const {
        const long L = (long)i * G + c; if (L >= nwg) return false;
        int wgid = (int)L; { const int q = nwg / NXCD, r = nwg % NXCD, xcd = wgid % NXCD, off = wgid / NXCD; wgid = (xcd < r ? xcd * (q + 1) : r * (q + 1) + (xcd - r) * q) + off; }
        const int nig = WGM * nN, gid = wgid / nig, fm = gid * WGM, gsz = (nM - fm) < WGM ? (nM - fm) : WGM;
        u.pm = fm + ((wgid % nig) % gsz); u.pn = (wgid % nig) / gsz; return true;
    }
    __device__ __forceinline__ void a_ready(const Unit&) const {}
    __device__ __forceinline__ void done(const Unit&) const {}
};

__device__ __forceinline__ unsigned cvt_pk_bf16(float lo, float hi) { unsigned r; asm volatile("v_cvt_pk_bf16_f32 %0, %1, %2" : "=v"(r) : "v"(lo), "v"(hi)); return r; }

template <class Epi, class Sched, bool ALIGN_EPI = false, bool SP2 = false>
__device__ __forceinline__ void gemm_phase(PG8_LAS unsigned char* lds, const Gemm g, const Sched& S, const Epi& E) {
    const int tid = stid(), wid = __builtin_amdgcn_readfirstlane(tid >> 6), lane = tid & 63, wr = wid >> 2, wc = wid & 3, fr = lane & 15, fq = lane >> 4;
    const int K = g.K, nt = K / BK;
    unsigned voffA[2], voffB[2];
#pragma unroll
    for (int i = 0; i < 2; ++i) { int R, C; stage_rc(tid * 16 + i * 8192, R, C); const int Rb = Epi::PERM ? ((R & ~31) + perm32(R & 31)) : R;
        voffA[i] = (unsigned)(R * K + C) * 2u; voffB[i] = (unsigned)(Rb * K + C) * 2u; }
    const size_t kstep = (size_t)(BK * 2);
    const size_t hstep = (size_t)HALF * K * 2;
    const size_t tstep = 2 * hstep;
    const unsigned ldsw = (unsigned)wid * 1024u;
    const int aoff = lds_byte(wr * 64 + fr, fq * 8), boff = lds_byte(wc * 32 + fr, fq * 8);
#define PG8_SA(b, h) (((b) * 2 + (h)) * HTB)
#define PG8_SB(b, h) ((4 + (b) * 2 + (h)) * HTB)
#define PG8_STAGE(bufoff, gbase, voff) do { _Pragma("unroll") for (int _i = 0; _i < 2; ++_i) \
        __builtin_amdgcn_global_load_lds((const unsigned*)((const char*)(gbase) + (voff)[_i]), (PG8_LAS unsigned*)(lds + (bufoff) + ldsw + _i * 8192), 16, 0, 0); } while (0)
#define PG8_LDA(dst, b, h) do { _Pragma("unroll") for (int m = 0; m < 4; ++m) _Pragma("unroll") for (int k = 0; k < 2; ++k) dst[m][k] = *(const PG8_LAS bf16x8*)(lds + PG8_SA(b, h) + aoff + m * 2048 + k * 1024); } while (0)
#define PG8_LDB(dst, b, h) do { _Pragma("unroll") for (int n = 0; n < 2; ++n) _Pragma("unroll") for (int k = 0; k < 2; ++k) dst[n][k] = *(const PG8_LAS bf16x8*)(lds + PG8_SB(b, h) + boff + n * 2048 + k * 1024); } while (0)
#define PG8_MMA(ai, bj, At, Bt) do { __builtin_amdgcn_s_setprio(1); _Pragma("unroll") for (int m = 0; m < 4; ++m) _Pragma("unroll") for (int n = 0; n < 2; ++n) _Pragma("unroll") for (int k = 0; k < 2; ++k) \
        acc[ai][bj][m][n] = __builtin_amdgcn_mfma_f32_16x16x32_bf16(Bt[n][k], At[m][k], acc[ai][bj][m][n], 0, 0, 0); __builtin_amdgcn_s_setprio(0); } while (0)
#define PG8_WAIT_V(n) asm volatile("s_waitcnt vmcnt(" #n ")" ::: "memory")
#define PG8_WAIT_L(n) asm volatile("s_waitcnt lgkmcnt(" #n ")" ::: "memory")
#define PG8_BAR __builtin_amdgcn_s_barrier()
#define PG8_SCHED __builtin_amdgcn_sched_barrier(0)
    Unit cur, nxt; int ui = 0;
    if (!S.next(0, cur)) return;
    f32x4 acc[2][2][4][2];
#pragma unroll
    for (int a = 0; a < 2; ++a)
#pragma unroll
        for (int b = 0; b < 2; ++b)
#pragma unroll
            for (int m = 0; m < 4; ++m)
#pragma unroll
                for (int n = 0; n < 2; ++n) acc[a][b][m][n] = (f32x4){0.f, 0.f, 0.f, 0.f};
    bf16x8 At[4][2], B0[2][2], B1[2][2];
    const char* cA = (const char*)g.A + (size_t)cur.pm * tstep; const char* cB = (const char*)g.Bt + (size_t)cur.pn * tstep;
    S.a_ready(cur);
    if constexpr (SP2) {
        PG8_STAGE(PG8_SB(0, 0), cB, voffB); PG8_STAGE(PG8_SB(0, 1), cB + hstep, voffB); PG8_STAGE(PG8_SA(0, 0), cA, voffA); PG8_STAGE(PG8_SA(0, 1), cA + hstep, voffA);
        if (wr == 1) PG8_BAR;
        PG8_WAIT_V(2); PG8_BAR;
        PG8_STAGE(PG8_SB(1, 0), cB + kstep, voffB); PG8_STAGE(PG8_SA(1, 0), cA + kstep, voffA); PG8_STAGE(PG8_SB(1, 1), cB + hstep + kstep, voffB);
        PG8_WAIT_V(6); PG8_BAR;
    } else {
        PG8_STAGE(PG8_SB(0, 0), cB, voffB); PG8_STAGE(PG8_SA(0, 0), cA, voffA); PG8_STAGE(PG8_SB(0, 1), cB + hstep, voffB); PG8_STAGE(PG8_SA(0, 1), cA + hstep, voffA);
        if (wr == 1) PG8_BAR;
        PG8_WAIT_V(4); PG8_BAR;
        PG8_STAGE(PG8_SB(1, 0), cB + kstep, voffB); PG8_STAGE(PG8_SA(1, 0), cA + kstep, voffA); PG8_STAGE(PG8_SB(1, 1), cB + hstep + kstep, voffB);
        PG8_WAIT_V(6); PG8_BAR;
    }
    for (;;) {
        const bool has_next = S.next(ui + 1, nxt);
        const char* nA = has_next ? (const char*)g.A + (size_t)nxt.pm * tstep : cA; const char* nB = has_next ? (const char*)g.Bt + (size_t)nxt.pn * tstep : cB;
        for (int t = 0; t < nt; t += 2) {
            const bool last = (t == nt - 2);
            const char* a1 = cA + (size_t)(t + 1) * kstep;
            const char* a2 = last ? nA : cA + (size_t)(t + 2) * kstep; const char* b2 = last ? nB : cB + (size_t)(t + 2) * kstep;
            const char* a3 = a2 + kstep; const char* b3 = b2 + kstep;
            if (last && has_next) S.a_ready(nxt);
            if constexpr (SP2) {
            PG8_LDB(B0, 0, 0); PG8_LDB(B1, 0, 1); PG8_SCHED; PG8_LDA(At, 0, 0); PG8_STAGE(PG8_SA(1, 1), a1 + hstep, voffA);
            PG8_WAIT_V(8); PG8_WAIT_L(0); PG8_BAR; PG8_MMA(0, 0, At, B0); PG8_MMA(0, 1, At, B1); PG8_BAR; PG8_SCHED;
            PG8_LDA(At, 0, 1); PG8_STAGE(PG8_SB(0, 0), b2, voffB); PG8_STAGE(PG8_SB(0, 1), b2 + hstep, voffB); PG8_STAGE(PG8_SA(0, 0), a2, voffA);
            PG8_WAIT_V(8); PG8_WAIT_L(0); PG8_BAR; PG8_MMA(1, 0, At, B0); PG8_MMA(1, 1, At, B1); PG8_BAR; PG8_SCHED;
            PG8_LDB(B0, 1, 0); PG8_LDB(B1, 1, 1); PG8_SCHED; PG8_LDA(At, 1, 0); PG8_STAGE(PG8_SA(0, 1), a2 + hstep, voffA);
            PG8_WAIT_V(8); PG8_WAIT_L(0); PG8_BAR; PG8_MMA(0, 0, At, B0); PG8_MMA(0, 1, At, B1); PG8_BAR; PG8_SCHED;
            PG8_LDA(At, 1, 1); PG8_STAGE(PG8_SB(1, 0), b3, voffB); PG8_STAGE(PG8_SB(1, 1), b3 + hstep, voffB); PG8_STAGE(PG8_SA(1, 0), a3, voffA);
            PG8_WAIT_V(8); PG8_WAIT_L(0); PG8_BAR; PG8_MMA(1, 0, At, B0); PG8_MMA(1, 1, At, B1); PG8_BAR; PG8_SCHED;
            } else {
            PG8_LDB(B0, 0, 0); PG8_SCHED; PG8_LDA(At, 0, 0); PG8_STAGE(PG8_SA(1, 1), a1 + hstep, voffA);
            PG8_WAIT_L(8); PG8_BAR; PG8_WAIT_L(0); PG8_MMA(0, 0, At, B0); PG8_BAR; PG8_SCHED;
            PG8_LDB(B1, 0, 1); PG8_STAGE(PG8_SB(0, 0), b2, voffB);
            PG8_BAR; PG8_WAIT_L(0); PG8_MMA(0, 1, At, B1); PG8_BAR;
            PG8_LDA(At, 0, 1); PG8_STAGE(PG8_SA(0, 0), a2, voffA);
            PG8_BAR; PG8_WAIT_L(0); PG8_MMA(1, 0, At, B0); PG8_BAR; PG8_SCHED;
            PG8_STAGE(PG8_SB(0, 1), b2 + hstep, voffB);
            PG8_WAIT_V(6); PG8_BAR; PG8_MMA(1, 1, At, B1); PG8_BAR;
            PG8_LDB(B0, 1, 0); PG8_SCHED; PG8_LDA(At, 1, 0); PG8_STAGE(PG8_SA(0, 1), a2 + hstep, voffA);
            PG8_WAIT_L(8); PG8_BAR; PG8_WAIT_L(0); PG8_MMA(0, 0, At, B0); PG8_BAR; PG8_SCHED;
            PG8_LDB(B1, 1, 1); PG8_STAGE(PG8_SB(1, 0), b3, voffB);
            PG8_BAR; PG8_WAIT_L(0); PG8_MMA(0, 1, At, B1); PG8_BAR;
            PG8_LDA(At, 1, 1); PG8_STAGE(PG8_SA(1, 0), a3, voffA);
            PG8_BAR; PG8_WAIT_L(0); PG8_MMA(1, 0, At, B0); PG8_BAR; PG8_SCHED;
            PG8_STAGE(PG8_SB(1, 1), b3 + hstep, voffB);
            PG8_WAIT_V(6); PG8_BAR; PG8_MMA(1, 1, At, B1); PG8_BAR;
            }
        }
        if constexpr (ALIGN_EPI) { if (wr == 0) PG8_BAR; }
        if constexpr (!Epi::AFTER_DRAIN) { E(acc, cur, wr, wc, fr, fq); S.done(cur); }
        if (!has_next) break;
#pragma unroll
        for (int a = 0; a < 2; ++a)
#pragma unroll
            for (int b = 0; b < 2; ++b)
#pragma unroll
                for (int m = 0; m < 4; ++m)
#pragma unroll
                    for (int n = 0; n < 2; ++n) acc[a][b][m][n] = (f32x4){0.f, 0.f, 0.f, 0.f};
        cur = nxt; cA = nA; cB = nB; ++ui;
        if constexpr (ALIGN_EPI) { if (wr == 1) PG8_BAR; }
    }
    PG8_WAIT_V(0);
    if constexpr (!ALIGN_EPI) { if (wr == 0) PG8_BAR; }
    PG8_BAR;
    if constexpr (Epi::AFTER_DRAIN) { E.fused(acc, cur, wr, wc, fr, fq, lds, wid, lane); S.done(cur); }
#undef PG8_SA
#undef PG8_SB
#undef PG8_STAGE
#undef PG8_LDA
#undef PG8_LDB
#undef PG8_MMA
#undef PG8_WAIT_V
#undef PG8_WAIT_L
#undef PG8_BAR
#undef PG8_SCHED
}
}

#ifndef PG8_SP2
#define PG8_SP2 true
#endif
#ifndef PG8_ALIGN
#define PG8_ALIGN true
#endif
struct EpiProj8 {
    static constexpr bool PERM = true, AFTER_DRAIN = false;
    bf16_t* O; const float* rs; const float* rcos; const float* rsin;
    __device__ __forceinline__ void operator()(const pg8::f32x4 (&acc)[2][2][4][2], const pg8::Unit& u, int wr, int wc, int fr, int fq) const {
        const int row0 = u.pm * 256 + wr * 64 + fr, col0 = u.pn * 256 + wc * 32 + 8 * fq;
        const bool rot = u.pn < 4;
        const float ksc = u.pn >= 2 ? 0.08838834764831845f : 1.f;
#pragma unroll
        for (int ai = 0; ai < 2; ++ai)
#pragma unroll
            for (int m = 0; m < 4; ++m) {
                const int row = row0 + ai * 128 + m * 16;
                const float s = rs[row];
                bf16_t* rowp = O + (size_t)row * NPJ + col0;
                float4 cs = make_float4(1.f, 1.f, 1.f, 1.f), sn = make_float4(0.f, 0.f, 0.f, 0.f);
                float s2 = s;
                if (rot) {
                    const int ti = (row & 2047) * 64 + 16 * wc + 4 * fq;
                    cs = *(const float4*)(rcos + ti);
                    sn = *(const float4*)(rsin + ti);
                    s2 = s * ksc;
                }
#pragma unroll
                for (int bj = 0; bj < 2; ++bj) {
                    const pg8::f32x4 v0 = acc[ai][bj][m][0] * s2, v1 = acc[ai][bj][m][1] * s2;
                    *(uint4*)(rowp + bj * 128) = make_uint4(pk2(v0[0] * cs.x - v0[1] * sn.x, v0[0] * sn.x + v0[1] * cs.x), pk2(v0[2] * cs.y - v0[3] * sn.y, v0[2] * sn.y + v0[3] * cs.y),
                                                            pk2(v1[0] * cs.z - v1[1] * sn.z, v1[0] * sn.z + v1[1] * cs.z), pk2(v1[2] * cs.w - v1[3] * sn.w, v1[2] * sn.w + v1[3] * cs.w));
                }
            }
    }
};
struct EpiX18 {
    static constexpr bool PERM = true, AFTER_DRAIN = false;
    const float* x; bf16_t* x1b; unsigned char* zq; float* rs2p; const float* g2;
    __device__ __forceinline__ void operator()(const pg8::f32x4 (&acc)[2][2][4][2], const pg8::Unit& u, int wr, int wc, int fr, int fq) const {
        const int row0 = u.pm * 256 + wr * 64 + fr, col0 = u.pn * 256 + wc * 32 + 8 * fq;
        float gq[2][8];
#pragma unroll
        for (int bj = 0; bj < 2; ++bj) {
            const float4 a = *(const float4*)(g2 + col0 + bj * 128), b = *(const float4*)(g2 + col0 + bj * 128 + 4);
            gq[bj][0] = a.x; gq[bj][1] = a.y; gq[bj][2] = a.z; gq[bj][3] = a.w; gq[bj][4] = b.x; gq[bj][5] = b.y; gq[bj][6] = b.z; gq[bj][7] = b.w;
        }
        float ssq[8];
#pragma unroll
        for (int ai = 0; ai < 2; ++ai)
#pragma unroll
            for (int m = 0; m < 4; ++m) {
                const size_t ro = (size_t)(row0 + ai * 128 + m * 16) * 1024 + col0;
                float s = 0.f;
#pragma unroll
                for (int bj = 0; bj < 2; ++bj) {
                    const float4 xa = *(const float4*)(x + ro + bj * 128), xb_ = *(const float4*)(x + ro + bj * 128 + 4);
                    const pg8::f32x4 v0 = acc[ai][bj][m][0], v1 = acc[ai][bj][m][1];
                    const float y[8] = {xa.x + v0[0], xa.y + v0[1], xa.z + v0[2], xa.w + v0[3], xb_.x + v1[0], xb_.y + v1[1], xb_.z + v1[2], xb_.w + v1[3]};
                    *(uint4*)(x1b + ro + bj * 128) = make_uint4(pk2(y[0], y[1]), pk2(y[2], y[3]), pk2(y[4], y[5]), pk2(y[6], y[7]));
                    unsigned w2[2] = {0u, 0u};
#pragma unroll
                    for (int e = 0; e < 8; ++e) {
                        s += y[e] * y[e];
                        const float z = fminf(fmaxf(y[e] * gq[bj][e] * (1.f / ZQ_SCALE), -127.f), 127.f);
                        w2[e >> 2] |= ((unsigned)((int)rintf(z) & 255)) << (8 * (e & 3));
                    }
                    *(uint2*)(zq + ro + bj * 128) = make_uint2(w2[0], w2[1]);
                }
                ssq[ai * 4 + m] = s;
            }
        float q4[4], q2[2];
#pragma unroll
        for (int j = 0; j < 4; ++j) {
            const auto r = __builtin_amdgcn_permlane32_swap(__float_as_uint(ssq[j]), __float_as_uint(ssq[j + 4]), false, false);
            q4[j] = __uint_as_float(r[0]) + __uint_as_float(r[1]);
        }
#pragma unroll
        for (int j = 0; j < 2; ++j) {
            const auto r = __builtin_amdgcn_permlane16_swap(__float_as_uint(q4[j]), __float_as_uint(q4[j + 2]), false, false);
            q2[j] = __uint_as_float(r[0]) + __uint_as_float(r[1]);
        }
#pragma unroll
        for (int j = 0; j < 2; ++j) {
            const int r8 = ((fq >> 1) & 1) * 4 + (fq & 1) * 2 + j;
            rs2p[(size_t)(row0 + (r8 >> 2) * 128 + (r8 & 3) * 16) * 16 + u.pn * 4 + wc] = q2[j];
        }
    }
};
template <class Epi, bool ALIGN>
DEVI void st_gemm8(const bf16_t* A, const bf16_t* Bt, int N, int K, char* smem, const Epi& epi) {
    pg8::Gemm g{A, Bt, T_TOK, N, K};
    pg8::StaticOrder S;
    S.init(T_TOK, N, (int)gridDim.x, (int)blockIdx.x);
    pg8::gemm_phase<Epi, pg8::StaticOrder, ALIGN, PG8_SP2>((PG8_LAS unsigned char*)smem, g, S, epi);
}

DEVI void st_conv_qk(const Params& p, char* smem) {
    char* cs = smem;
    char* wqs = smem + 128 * 272;
    char* wks = smem + 2 * 128 * 272;
    const int tid = stid(), lane = tid & 63, wid = tid >> 6, wr = wid >> 1, wc = wid & 1, fr = lane & 15, fq = lane >> 4;
    const int r = tid >> 4, cg = tid & 15;
    int hcur = -1;
    float cw[4][8], cb[8];
    for (int it = blockIdx.x; it < 256 * 4; it += gridDim.x) {
        const int h = it & 3, t0 = (it >> 2) * 128, s0 = t0 & 2047;
        if (h != hcur) {
            __syncthreads();
#pragma unroll
            for (int i = 0; i < 4; ++i) {
                const int id = tid + 512 * i, rr = id >> 4, c = id & 15;
                *(uint4*)(wqs + rr * 272 + c * 16) = *(const uint4*)(p.Wqt + h * 16384 + rr * 128 + c * 8);
                *(uint4*)(wks + rr * 272 + c * 16) = *(const uint4*)(p.Wkt + h * 16384 + rr * 128 + c * 8);
            }
#pragma unroll
            for (int j = 0; j < 4; ++j) {
                const float4 a = *(const float4*)(p.m_conv_w + j * 512 + h * 128 + 8 * cg), b = *(const float4*)(p.m_conv_w + j * 512 + h * 128 + 8 * cg + 4);
                cw[j][0] = a.x; cw[j][1] = a.y; cw[j][2] = a.z; cw[j][3] = a.w; cw[j][4] = b.x; cw[j][5] = b.y; cw[j][6] = b.z; cw[j][7] = b.w;
            }
            { const float4 a = *(const float4*)(p.m_conv_b + h * 128 + 8 * cg), b = *(const float4*)(p.m_conv_b + h * 128 + 8 * cg + 4);
              cb[0] = a.x; cb[1] = a.y; cb[2] = a.z; cb[3] = a.w; cb[4] = b.x; cb[5] = b.y; cb[6] = b.z; cb[7] = b.w; }
            hcur = h;
        }
        const bf16_t* xcol = p.proj + (size_t)t0 * NPJ + 2048 + h * 128 + 8 * cg;
#pragma unroll
        for (int ps = 0; ps < 4; ++ps) {
            const int row = 32 * ps + r;
            uint4 xv[4];
#pragma unroll
            for (int j = 0; j < 4; ++j) {
                const int rj = row - 3 + j;
                xv[j] = (s0 + rj >= 0) ? *(const uint4*)(xcol + (long)rj * NPJ) : make_uint4(0u, 0u, 0u, 0u);
            }
            float y[8];
#pragma unroll
            for (int e = 0; e < 8; ++e) y[e] = cb[e];
#pragma unroll
            for (int j = 0; j < 4; ++j) {
                const unsigned w4[4] = {xv[j].x, xv[j].y, xv[j].z, xv[j].w};
#pragma unroll
                for (int e = 0; e < 4; ++e) { y[2 * e] += cw[j][2 * e] * bflo(w4[e]); y[2 * e + 1] += cw[j][2 * e + 1] * bfhi(w4[e]); }
            }
            unsigned o[4];
#pragma unroll
            for (int e = 0; e < 4; ++e) o[e] = pk2(y[2 * e] * sigmoidf_(y[2 * e]), y[2 * e + 1] * sigmoidf_(y[2 * e + 1]));
            const uint4 ov = make_uint4(o[0], o[1], o[2], o[3]);
            *(uint4*)(cs + row * 272 + cg * 16) = ov;
            *(uint4*)(p.cbuf + (size_t)(t0 + row) * 512 + h * 128 + 8 * cg) = ov;
        }
        __syncthreads();
#pragma unroll
        for (int which = 0; which < 2; ++which) {
            const char* ws = which ? wks : wqs;
            bf16_t* O = which ? p.mk : p.mq;
            f32x4 acc[2][4];
#pragma unroll
            for (int i = 0; i < 2; ++i)
#pragma unroll
                for (int j = 0; j < 4; ++j) acc[i][j] = (f32x4){0.f, 0.f, 0.f, 0.f};
#pragma unroll
            for (int ks = 0; ks < 4; ++ks) {
                bf16x8 a[2], b[4];
#pragma unroll
                for (int i = 0; i < 2; ++i) a[i] = ld8(cs + (wr * 32 + i * 16 + fr) * 272 + (ks * 4 + fq) * 16);
#pragma unroll
                for (int j = 0; j < 4; ++j) b[j] = ld8(ws + (wc * 64 + j * 16 + fr) * 272 + (ks * 4 + fq) * 16);
#pragma unroll
                for (int i = 0; i < 2; ++i)
#pragma unroll
                    for (int j = 0; j < 4; ++j) acc[i][j] = mfma16(b[j], a[i], acc[i][j]);
            }
#pragma unroll
            for (int i = 0; i < 2; ++i)
#pragma unroll
                for (int j = 0; j < 4; ++j) {
                    const int m = t0 + wr * 32 + i * 16 + fr, n = h * 128 + wc * 64 + j * 16 + 4 * fq;
                    const f32x4 v = acc[i][j];
                    *(uint2*)(O + (size_t)m * 512 + n) = make_uint2(pk2(v[0], v[1]), pk2(v[2], v[3]));
                }
        }
        __syncthreads();
    }
}

DEVI bf16x8 u4_to_frag(uint4 u) { union { uint4 u; bf16x8 v; } x; x.u = u; return x.v; }
DEVI void sel_frags(bf16x8 (&sel)[2], int fr, int fq) {
#pragma unroll
    for (int hh = 0; hh < 2; ++hh) {
        const int jstar = fr + 16 * hh - 8 * fq;
        bf16x8 s;
#pragma unroll
        for (int j = 0; j < 8; ++j) s[j] = (j == jstar) ? (short)0x3F80 : (short)0;
        sel[hh] = s;
    }
}
DEVI void tr_store(char* XT, bf16x8 frag, const bf16x8 (&sel)[2], int mi, int ks, int fr, int fq, const float (&sc)[4]) {
#pragma unroll
    for (int hh = 0; hh < 2; ++hh) {
        const f32x4 d = mfma16(frag, sel[hh], (f32x4){0.f, 0.f, 0.f, 0.f});
        *(uint2*)(XT + (32 * ks + 16 * hh + fr) * 144 + (16 * mi + 4 * fq) * 2) = make_uint2(pk2(d[0] * sc[0], d[1] * sc[1]), pk2(d[2] * sc[2], d[3] * sc[3]));
    }
}
DEVI bf16x8 state_pack(const f32x4& a, const f32x4& b) {
    return mk8(make_uint2(pk2(a[0], a[1]), pk2(a[2], a[3])), make_uint2(pk2(b[0], b[1]), pk2(b[2], b[3])));
}
DEVI const float* opaque_ptr(const float* q) { asm volatile("" : "+v"(q)); return q; }
DEVI float opaque_f(float v) { asm volatile("" : "+v"(v)); return v; }
DEVI void lds_barrier() { asm volatile("s_waitcnt lgkmcnt(0)" ::: "memory"); __builtin_amdgcn_s_barrier(); asm volatile("" ::: "memory"); }
DEVI void pin_u4(uint4& a) { asm volatile("" : "+v"(a.x), "+v"(a.y), "+v"(a.z), "+v"(a.w)); }
DEVI float grp8_sum(float v) { v += dpp_f<DPP_XOR1>(v); v += dpp_f<DPP_XOR2>(v); v += dpp_f<DPP_HMIRROR>(v); return v; }

#define ASM_LD16(dst, voff, sbase, imm) asm volatile("global_load_dwordx4 %0, %1, %2 offset:" #imm : "=v"(dst) : "v"(voff), "s"(sbase) : "memory")
#define ASM_LD4(dst, voff, sbase) asm volatile("global_load_dword %0, %1, %2" : "=v"(dst) : "v"(voff), "s"(sbase) : "memory")
typedef unsigned u32x4_t __attribute__((ext_vector_type(4)));
struct RetPre { u32x4_t f[4]; u32x4_t v[2]; u32x4_t g[2]; };
struct RetOff { unsigned f, v0, v1, g; };
DEVI void ret_offsets(RetOff& o, int h, int tid) {
    const int lane = tid & 63, w = tid >> 6, fr = lane & 15, fq = lane >> 4, mi = w & 3;
    o.f = (unsigned)(((16 * mi + fr) * NPJ + (w < 4 ? 512 : 0) + h * 128 + 8 * fq) * 2);
    o.v0 = (unsigned)(((16 * ((2 * w) >> 2) + fr) * NPJ + 1024 + h * 128 + 32 * ((2 * w) & 3) + 8 * fq) * 2);
    o.v1 = (unsigned)(((16 * ((2 * w + 1) >> 2) + fr) * NPJ + 1024 + h * 128 + 32 * ((2 * w + 1) & 3) + 8 * fq) * 2);
    o.g = (unsigned)(((tid >> 3) * NPJ + 1536 + h * 128 + 16 * (tid & 7)) * 2);
}
DEVI void ret_prefetch(const Params& p, RetPre& P, const RetOff& o, int b, int c) {
    const char* base = (const char*)p.proj + (size_t)(b * 2048 + c * 64) * (NPJ * 2);
    ASM_LD16(P.f[0], o.f, base, 0); ASM_LD16(P.f[1], o.f, base, 64); ASM_LD16(P.f[2], o.f, base, 128); ASM_LD16(P.f[3], o.f, base, 192);
    ASM_LD16(P.v[0], o.v0, base, 0); ASM_LD16(P.v[1], o.v1, base, 0);
    ASM_LD16(P.g[0], o.g, base, 0); ASM_LD16(P.g[1], o.g, base, 16);
}
DEVI void ret_retire(RetPre& P) {
    asm volatile("s_waitcnt vmcnt(0)" : "+v"(P.f[0]), "+v"(P.f[1]), "+v"(P.f[2]), "+v"(P.f[3]), "+v"(P.v[0]), "+v"(P.v[1]), "+v"(P.g[0]), "+v"(P.g[1]) :: "memory");
}
DEVI uint4 asu4(const u32x4_t& v) { return make_uint4(v[0], v[1], v[2], v[3]); }
DEVI void ret_block(const Params& p, char* smem, int b, int h) {
    char* qs = smem;
    char* ks_ = smem + 17408;
    char* kTs = smem + 34816;
    char* vTs = smem + 53248;
    char* Ss = smem + 71680;
    char* Os = smem + 80896;
    float* gn_s = (float*)(smem + 98304);
    const int tid = stid(), lane = tid & 63, w = tid >> 6, fr = lane & 15, fq = lane >> 4;
    const float gamma = 1.f - exp2f(-5.f - (float)h);
    const float l2g = log2f(gamma);
    const float g64 = exp2f(l2g * 64.f);
    bf16x8 sel[2];
    sel_frags(sel, fr, fq);
    f32x4 st[8];
#pragma unroll
    for (int i = 0; i < 8; ++i) st[i] = (f32x4){0.f, 0.f, 0.f, 0.f};
    if (tid < 128) gn_s[tid] = p.ret_norm_g[h * 128 + tid];
    __syncthreads();
    RetPre P;
    RetOff RO;
    ret_offsets(RO, h, tid);
    ret_prefetch(p, P, RO, b, 0);
    ret_retire(P);
#pragma unroll 1
    for (int c = 0; c < 32; ++c) {
        const int t0 = b * 2048 + c * 64;
        {
            const int mi = w & 3;
            char* dst = (w < 4 ? ks_ : qs) + (16 * mi + fr) * 272 + fq * 16;
#pragma unroll
            for (int ks = 0; ks < 4; ++ks) *(uint4*)(dst + ks * 64) = asu4(P.f[ks]);
            if (w < 4) {
                float kd[4];
#pragma unroll
                for (int r = 0; r < 4; ++r) kd[r] = exp2f(l2g * (float)(63 - (16 * mi + 4 * fq + r)));
#pragma unroll
                for (int ks = 0; ks < 4; ++ks) tr_store(kTs, u4_to_frag(asu4(P.f[ks])), sel, mi, ks, fr, fq, kd);
            }
            const float one[4] = {1.f, 1.f, 1.f, 1.f};
#pragma unroll
            for (int q = 0; q < 2; ++q) { const int pr = 2 * w + q; tr_store(vTs, u4_to_frag(asu4(P.v[q])), sel, pr >> 2, pr & 3, fr, fq, one); }
        }
        uint4 g0 = asu4(P.g[0]), g1 = asu4(P.g[1]);
        lds_barrier();
        ret_prefetch(p, P, RO, b, c + 1 < 32 ? c + 1 : 31);
        {
            const int lt = w & 3;
            bf16x8 qf[4];
#pragma unroll
            for (int s = 0; s < 4; ++s) qf[s] = ld8(qs + (16 * lt + fr) * 272 + (s * 4 + fq) * 16);
#pragma unroll
            for (int jj = 0; jj < 2; ++jj) {
                const int j = 2 * (w >> 2) + jj;
                f32x4 a = (f32x4){0.f, 0.f, 0.f, 0.f};
#pragma unroll
                for (int s = 0; s < 4; ++s) a = mfma16(ld8(ks_ + (16 * j + fr) * 272 + (s * 4 + fq) * 16), qf[s], a);
                const int l = 16 * lt + fr, mb = 16 * j + 4 * fq;
                float v[4];
#pragma unroll
                for (int r = 0; r < 4; ++r) { const int dd = l - (mb + r); v[r] = a[r] * exp2f(l2g * (float)(dd < 0 ? -dd : dd)); }
                *(uint2*)(Ss + l * 144 + mb * 2) = make_uint2(pk2(v[0], v[1]), pk2(v[2], v[3]));
            }
        }
        lds_barrier();
        {
            bf16x8 sp[4];
#pragma unroll
            for (int s = 0; s < 4; ++s) sp[s] = state_pack(st[2 * s], st[2 * s + 1]);
            bf16x8 vf[2];
#pragma unroll
            for (int s2 = 0; s2 < 2; ++s2) vf[s2] = ld8(vTs + (16 * w + fr) * 144 + (s2 * 4 + fq) * 16);
#pragma unroll
            for (int i = 0; i < 4; ++i) {
                f32x4 a = (f32x4){0.f, 0.f, 0.f, 0.f};
                const char* qrow = qs + (16 * i + fr) * 272;
#pragma unroll
                for (int s = 0; s < 4; ++s) {
                    const uint2 lo = *(const uint2*)(qrow + (32 * s + 4 * fq) * 2), hi = *(const uint2*)(qrow + (32 * s + 16 + 4 * fq) * 2);
                    a = mfma16(sp[s], mk8(lo, hi), a);
                }
                a = a * exp2f(l2g * (float)(16 * i + fr + 1));
#pragma unroll
                for (int s2 = 0; s2 < 2; ++s2) a = mfma16(vf[s2], ld8(Ss + (16 * i + fr) * 144 + (s2 * 4 + fq) * 16), a);
                *(uint2*)(Os + (16 * i + fr) * 272 + (16 * w + 4 * fq) * 2) = make_uint2(pk2(a[0], a[1]), pk2(a[2], a[3]));
            }
#pragma unroll
            for (int i = 0; i < 8; ++i) {
                f32x4 a = st[i] * g64;
#pragma unroll
                for (int s2 = 0; s2 < 2; ++s2) a = mfma16(ld8(kTs + (16 * i + fr) * 144 + (s2 * 4 + fq) * 16), vf[s2], a);
                st[i] = a;
            }
        }
        lds_barrier();
        pin_u4(g0); pin_u4(g1);
        {
            const int l = tid >> 3, part = tid & 7;
            const uint4 o0 = *(const uint4*)(Os + l * 272 + part * 32), o1 = *(const uint4*)(Os + l * 272 + part * 32 + 16);
            const unsigned ow[8] = {o0.x, o0.y, o0.z, o0.w, o1.x, o1.y, o1.z, o1.w}, gw[8] = {g0.x, g0.y, g0.z, g0.w, g1.x, g1.y, g1.z, g1.w};
            float x[16], s = 0.f;
#pragma unroll
            for (int e = 0; e < 8; ++e) { x[2 * e] = bflo(ow[e]); x[2 * e + 1] = bfhi(ow[e]); s += x[2 * e] + x[2 * e + 1]; }
            const float mu = grp8_sum(s) * (1.f / 128.f);
            float q = 0.f;
#pragma unroll
            for (int e = 0; e < 16; ++e) { x[e] -= mu; q += x[e] * x[e]; }
            const float rstd = rsqrtf(grp8_sum(q) * (1.f / 128.f) + EPSN);
            const float* gn = gn_s + 16 * part;
            unsigned yo[8];
#pragma unroll
            for (int e = 0; e < 8; ++e) {
                const float ga = bflo(gw[e]), gb = bfhi(gw[e]);
                yo[e] = pk2(ga * sigmoidf_(ga) * x[2 * e] * rstd * gn[2 * e], gb * sigmoidf_(gb) * x[2 * e + 1] * rstd * gn[2 * e + 1]);
            }
            ret_retire(P);
            uint4* yp = (uint4*)(p.yb + (size_t)(t0 + l) * 1024 + h * 128 + 16 * part);
            yp[0] = make_uint4(yo[0], yo[1], yo[2], yo[3]);
            yp[1] = make_uint4(yo[4], yo[5], yo[6], yo[7]);
        }
    }
}

struct MlPre { u32x4_t f[4]; u32x4_t v[2]; u32x4_t o[2]; u32x4_t cc[2]; };
struct MlOff { unsigned f, v0, v1, o, c, g; };
DEVI void ml_offsets(const Params& p, MlOff& o, int h, int tid) {
    const int lane = tid & 63, w = tid >> 6, fr = lane & 15, fq = lane >> 4, mi = w & 3;
    const unsigned kdiff = (unsigned)((const char*)p.mk - (const char*)p.mq);
    o.f = (unsigned)(((16 * mi + fr) * 512 + h * 128 + 8 * fq) * 2) + (w < 4 ? kdiff : 0u);
    o.v0 = (unsigned)(((16 * ((2 * w) >> 2) + fr) * NPJ + 2560 + h * 128 + 32 * ((2 * w) & 3) + 8 * fq) * 2);
    o.v1 = (unsigned)(((16 * ((2 * w + 1) >> 2) + fr) * NPJ + 2560 + h * 128 + 32 * ((2 * w + 1) & 3) + 8 * fq) * 2);
    o.o = (unsigned)(((tid >> 3) * NPJ + 3072 + h * 128 + 16 * (tid & 7)) * 2);
    o.c = (unsigned)(((tid >> 3) * 512 + h * 128 + 16 * (tid & 7)) * 2);
    o.g = (unsigned)((lane * 4 + h) * 4);
}
DEVI void ml_prefetch(const Params& p, MlPre& P, const MlOff& o, int b, int c) {
    const size_t t0 = (size_t)(b * 2048 + c * 64);
    const char* bq = (const char*)p.mq + t0 * 1024, *bp = (const char*)p.proj + t0 * (NPJ * 2), *bc = (const char*)p.cbuf + t0 * 1024;
    ASM_LD16(P.f[0], o.f, bq, 0); ASM_LD16(P.f[1], o.f, bq, 64); ASM_LD16(P.f[2], o.f, bq, 128); ASM_LD16(P.f[3], o.f, bq, 192);
    ASM_LD16(P.v[0], o.v0, bp, 0); ASM_LD16(P.v[1], o.v1, bp, 0);
    ASM_LD16(P.o[0], o.o, bp, 0); ASM_LD16(P.o[1], o.o, bp, 16);
    ASM_LD16(P.cc[0], o.c, bc, 0); ASM_LD16(P.cc[1], o.c, bc, 16);
}
DEVI void ml_retire(MlPre& P) {
    asm volatile("s_waitcnt vmcnt(0)" : "+v"(P.f[0]), "+v"(P.f[1]), "+v"(P.f[2]), "+v"(P.f[3]), "+v"(P.v[0]), "+v"(P.v[1]), "+v"(P.o[0]), "+v"(P.o[1]),
                 "+v"(P.cc[0]), "+v"(P.cc[1]) :: "memory");
}
DEVI void mlstm_block(const Params& p, char* smem, int b, int h) {
    char* qs = smem;
    char* kTs = smem + 17408;
    char* vTs = smem + 35840;
    char* Os = smem + 54272;
    float* n_s = (float*)(smem + 71680);
    float* den_s = (float*)(smem + 72192);
    float* gn_s = (float*)(smem + 72448);
    float* sk_s = gn_s + 128;
    float* lw_s = sk_s + 128;
    float* ac_s = lw_s + 32 * 64;
    float* mi_s = ac_s + 32;
    const int tid = stid(), lane = tid & 63, w = tid >> 6, fr = lane & 15, fq = lane >> 4;
    bf16x8 sel[2];
    sel_frags(sel, fr, fq);
    f32x4 st[8];
#pragma unroll
    for (int i = 0; i < 8; ++i) st[i] = (f32x4){0.f, 0.f, 0.f, 0.f};
    float m_run = 0.f;
    f32x4 nacc = (f32x4){0.f, 0.f, 0.f, 0.f};
    bf16x8 ones;
#pragma unroll
    for (int j = 0; j < 8; ++j) ones[j] = (short)0x3F80;
    if (tid < 128) { gn_s[tid] = p.m_norm_g[h * 128 + tid]; sk_s[tid] = p.m_skip[h * 128 + tid]; }
#pragma unroll
    for (int q = 0; q < 4; ++q) {
        const int cc = 4 * w + q, tt = b * 2048 + cc * 64 + lane;
        const float iv = p.ipre[tt * 4 + h], fv = p.logf[tt * 4 + h];
        float fcum = fv;
#pragma unroll
        for (int o = 1; o < 64; o <<= 1) { const float tv = __shfl_up(fcum, o); if (lane >= o) fcum += tv; }
        const float a_c = __shfl(fcum, 63);
        const float logw = a_c - fcum + iv;
        const float m_in = wave_max(logw);
        lw_s[cc * 64 + lane] = logw;
        if (lane == 0) { ac_s[cc] = a_c; mi_s[cc] = m_in; }
    }
    __syncthreads();
    MlPre P;
    MlOff MO;
    ml_offsets(p, MO, h, tid);
    ml_prefetch(p, P, MO, b, 0);
    ml_retire(P);
#pragma unroll 1
    for (int c = 0; c < 32; ++c) {
        const int t0 = b * 2048 + c * 64;
        const float a_c = ac_s[c], m_in = mi_s[c], logw = lw_s[c * 64 + lane];
        const float m_new = fmaxf(a_c + m_run, m_in);
        const float decay = fexp_(a_c + m_run - m_new);
        const float wgt = fexp_(logw - m_new);
        const float emn = fexp_(-m_new);
        m_run = m_new;
        {
            const int mi = w & 3;
            if (w < 4) {
                float kw[4];
#pragma unroll
                for (int r = 0; r < 4; ++r) kw[r] = __shfl(wgt, 16 * mi + 4 * fq + r);
#pragma unroll
                for (int ks = 0; ks < 4; ++ks) tr_store(kTs, u4_to_frag(asu4(P.f[ks])), sel, mi, ks, fr, fq, kw);
            } else {
                char* dst = qs + (16 * mi + fr) * 272 + fq * 16;
#pragma unroll
                for (int ks = 0; ks < 4; ++ks) *(uint4*)(dst + ks * 64) = asu4(P.f[ks]);
            }
            const float one[4] = {1.f, 1.f, 1.f, 1.f};
#pragma unroll
            for (int q = 0; q < 2; ++q) { const int pr = 2 * w + q; tr_store(vTs, u4_to_frag(asu4(P.v[q])), sel, pr >> 2, pr & 3, fr, fq, one); }
        }
        uint4 mo0 = asu4(P.o[0]), mo1 = asu4(P.o[1]), cc0 = asu4(P.cc[0]), cc1 = asu4(P.cc[1]);
        lds_barrier();
        ml_prefetch(p, P, MO, b, c + 1 < 32 ? c + 1 : 31);
        {
            f32x4 a = nacc * decay;
#pragma unroll
            for (int s2 = 0; s2 < 2; ++s2) a = mfma16(ld8(kTs + (16 * w + fr) * 144 + (s2 * 4 + fq) * 16), ones, a);
            nacc = a;
            if (fr == 0) *(f32x4*)(n_s + 16 * w + 4 * fq) = a;
        }
        {
            bf16x8 vf[2];
#pragma unroll
            for (int s2 = 0; s2 < 2; ++s2) vf[s2] = ld8(vTs + (16 * w + fr) * 144 + (s2 * 4 + fq) * 16);
#pragma unroll
            for (int i = 0; i < 8; ++i) {
                f32x4 a = st[i] * decay;
#pragma unroll
                for (int s2 = 0; s2 < 2; ++s2) a = mfma16(ld8(kTs + (16 * i + fr) * 144 + (s2 * 4 + fq) * 16), vf[s2], a);
                st[i] = a;
            }
        }
        lds_barrier();
        {
            const int l = tid >> 3, part = tid & 7;
            const uint4 a0 = *(const uint4*)(qs + l * 272 + part * 32), a1 = *(const uint4*)(qs + l * 272 + part * 32 + 16);
            const unsigned aw[8] = {a0.x, a0.y, a0.z, a0.w, a1.x, a1.y, a1.z, a1.w};
            const float* nn = n_s + 16 * part;
            float s = 0.f;
#pragma unroll
            for (int e = 0; e < 8; ++e) s += bflo(aw[e]) * nn[2 * e] + bfhi(aw[e]) * nn[2 * e + 1];
            s = grp8_sum(s);
            if (part == 0) den_s[l] = fmaxf(fabsf(s), emn);
        }
        lds_barrier();
        {
            bf16x8 sp[4];
#pragma unroll
            for (int s = 0; s < 4; ++s) sp[s] = state_pack(st[2 * s], st[2 * s + 1]);
#pragma unroll
            for (int i = 0; i < 4; ++i) {
                f32x4 a = (f32x4){0.f, 0.f, 0.f, 0.f};
                const char* qrow = qs + (16 * i + fr) * 272;
#pragma unroll
                for (int s = 0; s < 4; ++s) {
                    const uint2 lo = *(const uint2*)(qrow + (32 * s + 4 * fq) * 2), hi = *(const uint2*)(qrow + (32 * s + 16 + 4 * fq) * 2);
                    a = mfma16(sp[s], mk8(lo, hi), a);
                }
                const float rd = rcp_(den_s[16 * i + fr]);
                *(uint2*)(Os + (16 * i + fr) * 272 + (16 * w + 4 * fq) * 2) = make_uint2(pk2(a[0] * rd, a[1] * rd), pk2(a[2] * rd, a[3] * rd));
            }
        }
        lds_barrier();
        pin_u4(mo0); pin_u4(mo1); pin_u4(cc0); pin_u4(cc1);
        {
            const int l = tid >> 3, part = tid & 7;
            const uint4 o0 = *(const uint4*)(Os + l * 272 + part * 32), o1 = *(const uint4*)(Os + l * 272 + part * 32 + 16);
            const unsigned ow[8] = {o0.x, o0.y, o0.z, o0.w, o1.x, o1.y, o1.z, o1.w};
            const unsigned gw[8] = {mo0.x, mo0.y, mo0.z, mo0.w, mo1.x, mo1.y, mo1.z, mo1.w}, cw[8] = {cc0.x, cc0.y, cc0.z, cc0.w, cc1.x, cc1.y, cc1.z, cc1.w};
            float x[16], s = 0.f;
#pragma unroll
            for (int e = 0; e < 8; ++e) { x[2 * e] = bflo(ow[e]); x[2 * e + 1] = bfhi(ow[e]); s += x[2 * e] + x[2 * e + 1]; }
            const float mu = grp8_sum(s) * (1.f / 128.f);
            float q = 0.f;
#pragma unroll
            for (int e = 0; e < 16; ++e) { x[e] -= mu; q += x[e] * x[e]; }
            const float rstd = rsqrtf(grp8_sum(q) * (1.f / 128.f) + EPSN);
            const float* gn = gn_s + 16 * part;
            const float* sk = sk_s + 16 * part;
            unsigned yo[8];
#pragma unroll
            for (int e = 0; e < 8; ++e) {
                const float ya = sigmoidf_(bflo(gw[e])) * (x[2 * e] * rstd * gn[2 * e] + sk[2 * e] * bflo(cw[e]));
                const float yb_ = sigmoidf_(bfhi(gw[e])) * (x[2 * e + 1] * rstd * gn[2 * e + 1] + sk[2 * e + 1] * bfhi(cw[e]));
                yo[e] = pk2(ya, yb_);
            }
            ml_retire(P);
            uint4* yp = (uint4*)(p.yb + (size_t)(t0 + l) * 1024 + 512 + h * 128 + 16 * part);
            yp[0] = make_uint4(yo[0], yo[1], yo[2], yo[3]);
            yp[1] = make_uint4(yo[4], yo[5], yo[6], yo[7]);
        }
    }
}
DEVI void st_recur(const Params& p, char* smem) {
    if (blockIdx.x >= 128 || gridDim.x <= 128) {
        const int bid = gridDim.x > 128 ? (int)blockIdx.x - 128 : (int)blockIdx.x, nb = gridDim.x > 128 ? (int)gridDim.x - 128 : (int)gridDim.x;
        st_prep_w2(p, smem, bid, nb);
        st_prep_wsub(p, smem, bid, nb);
        st_prep_tables(p, bid, nb);
        if (gridDim.x > 128) return;
    }
    for (int bi = blockIdx.x; bi < 128; bi += gridDim.x) {
        const int kind = bi & 1, h = (bi >> 1) & 3, b = bi >> 3;
        if (kind == 0) ret_block(p, smem, b, h);
        else mlstm_block(p, smem, b, h);
        __syncthreads();
    }
}

DEVI int f2key(float f) { const int b = __float_as_int(f); return b ^ ((b >> 31) & 0x7fffffff); }
DEVI float key2f(int k) { return __int_as_float(k ^ ((k >> 31) & 0x7fffffff)); }
template <int N> DEVI void bsort_desc(int (&v)[N]) {
#pragma unroll
    for (int k = 2; k <= N; k <<= 1)
#pragma unroll
        for (int j = k >> 1; j > 0; j >>= 1)
#pragma unroll
            for (int i = 0; i < N; ++i) {
                const int l = i ^ j;
                if (l > i) {
                    const int a = v[i], b = v[l];
                    const int mx = a > b ? a : b, mn = a > b ? b : a;
                    if ((i & k) == 0) { v[i] = mx; v[l] = mn; } else { v[i] = mn; v[l] = mx; }
                }
            }
}
template <int N> DEVI void bmerge_desc(int (&v)[N]) {
#pragma unroll
    for (int j = N >> 1; j > 0; j >>= 1)
#pragma unroll
        for (int i = 0; i < N; ++i) {
            const int l = i ^ j;
            if (l > i) { const int a = v[i], b = v[l]; v[i] = a > b ? a : b; v[l] = a > b ? b : a; }
        }
}
DEVI void xmerge16(int (&v)[16], int mask) {
    int o[16];
#pragma unroll
    for (int i = 0; i < 16; ++i) o[i] = __shfl_xor(v[15 - i], mask);
#pragma unroll
    for (int i = 0; i < 16; ++i) v[i] = v[i] > o[i] ? v[i] : o[i];
    bmerge_desc<16>(v);
}
__device__ const unsigned char cand_tab[52] = {
    0x00, 0x01, 0x02, 0x03, 0x04, 0x05, 0x06, 0x07, 0x08, 0x09, 0x0a, 0x0b, 0x0c, 0x0d, 0x0e, 0x0f,
    0x10, 0x11, 0x12, 0x13, 0x14, 0x15, 0x16, 0x17, 0x20, 0x21, 0x22, 0x23, 0x24, 0x30, 0x31, 0x32, 0x33,
    0x40, 0x41, 0x42, 0x50, 0x51, 0x60, 0x61, 0x70, 0x71, 0x80, 0x90, 0xa0, 0xb0, 0xc0, 0xd0, 0xe0, 0xf0, 0xff, 0xff};
constexpr int H_A = 256 * 64, H_B = 256 * 64, H_STAGE = H_A + H_B;
constexpr int H_LIST = 3 * H_STAGE;
DEVI void glds16(const void* g, char* l) {
    __builtin_amdgcn_global_load_lds((const __attribute__((address_space(1))) unsigned*)g, (__attribute__((address_space(3))) unsigned*)l, 16, 0, 0);
}
DEVI void gemm3_topk_tile(const Params& p, int m0, int h, char* smem) {
    const int tid = stid(), lane = tid & 63, w = tid >> 6, wt = w >> 1, wp = w & 1, fr = lane & 15, fq = lane >> 4;
    i32x4 acc[4][8];
#pragma unroll
    for (int i = 0; i < 4; ++i)
#pragma unroll
        for (int j = 0; j < 8; ++j) acc[i][j] = (i32x4){0, 0, 0, 0};
    const int r16 = lane >> 2, csrc = (lane & 3) ^ ((r16 >> 2) & 3);
    const unsigned char* srcA = p.xq + (size_t)(m0 + w * 32 + r16) * 1024 + csrc * 16;
    const unsigned char* srcB = (const unsigned char*)p.Wsubq + ((size_t)h * 256 + w * 32 + r16) * 1024 + csrc * 16;
    char* dstA = smem + (w * 32) * 64 + lane * 16;
    char* dstB = smem + H_A + (w * 32) * 64 + lane * 16;
    auto issue = [&](int kt, int buf) {
#pragma unroll
        for (int q = 0; q < 2; ++q) glds16(srcA + (size_t)q * 16 * 1024 + kt * 64, dstA + buf * H_STAGE + q * 1024);
#pragma unroll
        for (int q = 0; q < 2; ++q) glds16(srcB + (size_t)q * 16 * 1024 + kt * 64, dstB + buf * H_STAGE + q * 1024);
    };
    const int rdoff = fr * 64 + ((fq ^ ((fr >> 2) & 3)) * 16);
    issue(0, 0);
    issue(1, 1);
    asm volatile("s_waitcnt vmcnt(4)" ::: "memory");
    __builtin_amdgcn_s_barrier();
    int buf = 0;
#pragma unroll 1
    for (int kt = 0; kt < 16; ++kt) {
        const int b2 = buf >= 1 ? buf - 1 : 2;
        if (kt + 2 < 16) issue(kt + 2, b2);
        const char* As = smem + buf * H_STAGE + (wt * 64) * 64 + rdoff;
        const char* Bs = smem + buf * H_STAGE + H_A + (wp * 128) * 64 + rdoff;
        i32x4 a[4];
#pragma unroll
        for (int i = 0; i < 4; ++i) a[i] = *(const i32x4*)(As + (16 * i) * 64);
#pragma unroll
        for (int jg = 0; jg < 2; ++jg) {
            i32x4 b[4];
#pragma unroll
            for (int j = 0; j < 4; ++j) b[j] = *(const i32x4*)(Bs + (16 * (4 * jg + j)) * 64);
#pragma unroll
            for (int i = 0; i < 4; ++i)
#pragma unroll
                for (int j = 0; j < 4; ++j) acc[i][4 * jg + j] = __builtin_amdgcn_mfma_i32_16x16x64_i8(b[j], a[i], acc[i][4 * jg + j], 0, 0, 0);
        }
        if (kt + 2 < 16) asm volatile("s_waitcnt vmcnt(4)" ::: "memory");
        else asm volatile("s_waitcnt vmcnt(0)" ::: "memory");
        __builtin_amdgcn_s_barrier();
        buf = buf == 2 ? 0 : buf + 1;
    }
    float4 ws[8];
#pragma unroll
    for (int j = 0; j < 8; ++j) ws[j] = *(const float4*)(p.wsc + h * 256 + wp * 128 + 16 * j + 4 * fq);
    int* LX = (int*)(smem + H_LIST);
#pragma unroll
    for (int i = 0; i < 4; ++i) {
        const int tl = 64 * wt + 16 * i + fr;
        const float rs = rs2_of(p.rs2p, m0 + tl) * ZQ_SCALE;
        int ka[16], kb[16];
#pragma unroll
        for (int jj = 0; jj < 4; ++jj)
#pragma unroll
            for (int r = 0; r < 4; ++r) {
                const float sa = r == 0 ? ws[jj].x : r == 1 ? ws[jj].y : r == 2 ? ws[jj].z : ws[jj].w;
                const float sb = r == 0 ? ws[4 + jj].x : r == 1 ? ws[4 + jj].y : r == 2 ? ws[4 + jj].z : ws[4 + jj].w;
                ka[jj * 4 + r] = (f2key((float)acc[i][jj][r] * (sa * rs)) & ~127) | (16 * jj + 4 * fq + r);
                kb[jj * 4 + r] = (f2key((float)acc[i][4 + jj][r] * (sb * rs)) & ~127) | (16 * (jj + 4) + 4 * fq + r);
            }
        bsort_desc<16>(ka);
        bsort_desc<16>(kb);
#pragma unroll
        for (int q = 0; q < 16; ++q) ka[q] = ka[q] > kb[15 - q] ? ka[q] : kb[15 - q];
        bmerge_desc<16>(ka);
        xmerge16(ka, 16);
        xmerge16(ka, 32);
        const int k0 = fq == 0 ? ka[0] : fq == 1 ? ka[4] : fq == 2 ? ka[8] : ka[12];
        const int k1 = fq == 0 ? ka[1] : fq == 1 ? ka[5] : fq == 2 ? ka[9] : ka[13];
        const int k2 = fq == 0 ? ka[2] : fq == 1 ? ka[6] : fq == 2 ? ka[10] : ka[14];
        const int k3 = fq == 0 ? ka[3] : fq == 1 ? ka[7] : fq == 2 ? ka[11] : ka[15];
        *(int4*)(LX + tl * 32 + wp * 16 + 4 * fq) = make_int4(k0, k1, k2, k3);
    }
    __syncthreads();
#pragma unroll
    for (int i2 = 0; i2 < 2; ++i2) {
        const int tl = 32 * w + 16 * i2 + fr, t = m0 + tl;
        const int* L = LX + tl * 32;
        const unsigned long long clo = fq == 0 ? 0x0706050403020100ull : fq == 1 ? 0x14131211100f0e0dull : fq == 2 ? 0x4033323130242322ull : 0xc0b0a09080717061ull;
        const unsigned long long chi = fq == 0 ? 0x0c0b0a0908ull : fq == 1 ? 0x2120171615ull : fq == 2 ? 0x6051504241ull : 0xfffff0e0d0ull;
        int c[16];
#pragma unroll
        for (int s = 0; s < 13; ++s) {
            const int ab = (int)((s < 8 ? (clo >> (8 * s)) : (chi >> (8 * (s - 8)))) & 0xffull);
            const int k1 = L[ab >> 4], k2 = L[16 + (ab & 15)];
            const float v = key2f(k1 & ~127) + key2f(k2 & ~127);
            c[s] = (f2key(v) & ~0x3fff) | ((k1 & 127) << 7) | (k2 & 127);
        }
        c[13] = c[14] = c[15] = (int)0x80000000;
        bsort_desc<16>(c);
        xmerge16(c, 16);
        xmerge16(c, 32);
        const float vmax = key2f(c[0] & ~0x3fff);
        float e[16], sum = 0.f;
#pragma unroll
        for (int q = 0; q < 16; ++q) { e[q] = fexp_(key2f(c[q] & ~0x3fff) - vmax); sum += e[q]; }
        const float inv = rcp_(sum);
        int ce[4]; float ge[4];
#pragma unroll
        for (int q = 0; q < 4; ++q) {
            const int cq = fq == 0 ? c[q] : fq == 1 ? c[4 + q] : fq == 2 ? c[8 + q] : c[12 + q];
            const float eq = fq == 0 ? e[q] : fq == 1 ? e[4 + q] : fq == 2 ? e[8 + q] : e[12 + q];
            ce[q] = ((cq >> 7) & 127) * 128 + (cq & 127);
            ge[q] = eq * inv;
        }
        *(uint2*)(p.eperm + (size_t)t * 128 + h * 16 + 4 * fq) = make_uint2((unsigned)ce[0] | ((unsigned)ce[1] << 16), (unsigned)ce[2] | ((unsigned)ce[3] << 16));
        *(float4*)(p.gate + (size_t)t * 128 + h * 16 + 4 * fq) = make_float4(ge[0], ge[1], ge[2], ge[3]);
    }
    __syncthreads();
}
DEVI void st_gemm3_topk(const Params& p, char* smem) {
    for (int it = blockIdx.x; it < 128 * 8; it += gridDim.x) gemm3_topk_tile(p, (it >> 3) * 256, it & 7, smem);
}

#define XB_TMO      128
#define XB_XCNT(j)  (256  + 64 * (j))
#define XB_XSUB(j)  (1280 + 64 * (j))
#define XB_XGEN(j)  (2304 + 64 * (j))
#define XB_TOP      3328
#define XB_TOPGEN   3392
#define XCD_BAR_WORDS 3456
#define XB_SPIN_CAP (1u << 20)
#define LAS __attribute__((address_space(3)))
DEVI unsigned xb_ld(unsigned* p) { return __hip_atomic_load(p, __ATOMIC_RELAXED, __HIP_MEMORY_SCOPE_AGENT); }
DEVI unsigned xb_add(unsigned* p, unsigned v) { return __hip_atomic_fetch_add(p, v, __ATOMIC_RELAXED, __HIP_MEMORY_SCOPE_AGENT); }
DEVI unsigned xb_xcc_id() { return (unsigned)__builtin_amdgcn_s_getreg((3 << 11) | 20) & 0xFu; }
#define XB_SPIN(cond, bar) do { unsigned _sp = 0; while (cond) { __builtin_amdgcn_s_sleep(1); \
    if ((++_sp & 255u) == 0u) { if (xb_ld(&(bar)[XB_TMO])) break; if (_sp > XB_SPIN_CAP) { atomicAdd(&(bar)[XB_TMO], 1u); break; } } } } while (0)
struct XcdBarrier { unsigned* bar; unsigned x; volatile LAS unsigned* st; };
DEVI XcdBarrier xcd_barrier_post(unsigned* bar, volatile LAS unsigned* st) {
    XcdBarrier b; b.bar = bar; b.x = xb_xcc_id(); b.st = st;
    if (stid() == 0) (void)xb_add(&bar[XB_XCNT(b.x)], 1u);
    return b;
}
DEVI void xcd_barrier_complete(unsigned* bar, unsigned x, unsigned& nloc, unsigned& nx) {
    const unsigned G = gridDim.x * gridDim.y * gridDim.z;
    unsigned sum, cnt, mine, sp = 0u;
    for (;;) {
        sum = 0u; cnt = 0u; mine = 0u;
#pragma unroll
        for (unsigned j = 0; j < 16; ++j) { const unsigned c = xb_ld(&bar[XB_XCNT(j)]); sum += c; cnt += (c > 0u) ? 1u : 0u; mine = (j == x) ? c : mine; }
        if (sum == G) break;
        __builtin_amdgcn_s_sleep(1);
        if ((++sp & 255u) == 0u) { if (xb_ld(&bar[XB_TMO])) break; if (sp > XB_SPIN_CAP) { atomicAdd(&bar[XB_TMO], 1u); break; } }
    }
    nloc = mine > 0u ? mine : 1u; nx = cnt > 0u ? cnt : 1u;
}
DEVI void xcd_barrier(const XcdBarrier& b) {
    asm volatile("s_waitcnt vmcnt(0)" ::: "memory");
    __syncthreads();
    if (stid() == 0) {
        unsigned* bar = b.bar;
        __builtin_amdgcn_s_waitcnt(0);
        unsigned nloc = b.st[0], nx = b.st[1];
        if (nloc == 0u) { xcd_barrier_complete(bar, b.x, nloc, nx); b.st[0] = nloc; b.st[1] = nx; }
        const unsigned old = xb_add(&bar[XB_XSUB(b.x)], 1u);
        const unsigned gen = old / nloc;
        if (old + 1u == (gen + 1u) * nloc) {
            __builtin_amdgcn_fence(__ATOMIC_RELEASE, "agent");
            asm volatile("s_waitcnt vmcnt(0)" ::: "memory");
            const unsigned og = xb_add(&bar[XB_TOP], 1u);
            const unsigned tg = og / nx;
            if (og + 1u == (tg + 1u) * nx) xb_add(&bar[XB_TOPGEN], 1u);
            else XB_SPIN(xb_ld(&bar[XB_TOPGEN]) == tg, bar);
            __builtin_amdgcn_fence(__ATOMIC_ACQUIRE, "agent");
            xb_add(&bar[XB_XGEN(b.x)], 1u);
            asm volatile("s_waitcnt vmcnt(0)" ::: "memory");
        } else {
            XB_SPIN(xb_ld(&bar[XB_XGEN(b.x)]) == gen, bar);
            __builtin_amdgcn_fence(__ATOMIC_ACQUIRE, "agent");
            asm volatile("s_waitcnt vmcnt(0)" ::: "memory");
        }
    }
    __syncthreads();
}

#define CTR_A(x) (XCD_BAR_WORDS + 64 * (x))
#define CTR_B(x) (XCD_BAR_WORDS + 512 + 64 * (x))
#define CTL_WORDS (XCD_BAR_WORDS + 1024)
typedef float f32x2 __attribute__((ext_vector_type(2)));
DEVI float ub(unsigned w, int n) { return (float)((w >> (8 * n)) & 0xffu); }
DEVI float gelu_erf(float u) { return 0.5f * u * (1.f + erff(u * 0.70710678118654752f)); }
struct ExpMeta { uint4 e[2]; uint4 xa; float sc; };
struct ExpRows { uint4 r[16]; unsigned x1; };

template <int PHASE> DEVI void exp_load_meta(const Params& p, ExpMeta& m, int t, int x, int lane) {
    const uint4* ep = (const uint4*)(p.eperm + (size_t)t * 128 + (lane >> 3) * 16);
    m.e[0] = ep[0];
    m.e[1] = ep[1];
    if (PHASE == 0) m.xa = *(const uint4*)(p.xq + (size_t)t * 1024 + 128 * x + 16 * (lane & 7));
    else { m.xa = *(const uint4*)(p.aq + (size_t)t * 128 + (lane >> 3) * 16); m.sc = p.asc[t]; }
}
template <int PHASE> DEVI void exp_issue(const Params& p, const ExpMeta& m, ExpRows& R, int t, int x, int lane) {
    const unsigned char* base = (PHASE == 0 ? p.down_q : p.up_q) + (size_t)x * (16384 * 128) + (lane & 7) * 16;
    const unsigned ew[8] = {m.e[0].x, m.e[0].y, m.e[0].z, m.e[0].w, m.e[1].x, m.e[1].y, m.e[1].z, m.e[1].w};
#pragma unroll
    for (int j = 0; j < 16; ++j) {
        const unsigned ek = (j & 1) ? (ew[j >> 1] >> 16) : (ew[j >> 1] & 0xffffu);
        R.r[j] = *(const uint4*)(base + (size_t)ek * 128);
    }
    if (PHASE == 1) {
        const int col = 128 * x + 16 * (lane & 7) + ((lane & 32) ? 8 : 0) + ((lane & 16) ? 4 : 0) + ((lane & 8) ? 2 : 0);
        R.x1 = *(const unsigned*)(p.x1b + (size_t)t * 1024 + col);
    }
}
DEVI void expA_compute(const Params& p, const ExpMeta& m, const ExpRows& R, int t, int x, int lane) {
    const bool b2 = lane & 4, b1 = lane & 2, b0 = lane & 1;
    int ps[16];
#pragma unroll
    for (int j = 0; j < 16; ++j)
        ps[j] = __builtin_amdgcn_sdot4((int)R.r[j].x, (int)m.xa.x, __builtin_amdgcn_sdot4((int)R.r[j].y, (int)m.xa.y,
                __builtin_amdgcn_sdot4((int)R.r[j].z, (int)m.xa.z, __builtin_amdgcn_sdot4((int)R.r[j].w, (int)m.xa.w, 0, false), false), false), false);
    int q8[8], q4[4], q2[2];
#pragma unroll
    for (int j = 0; j < 8; ++j) { const int snd = b2 ? ps[j] : ps[j + 8], kp = b2 ? ps[j + 8] : ps[j]; q8[j] = kp + dpp_i<DPP_HMIRROR>(snd); }
#pragma unroll
    for (int j = 0; j < 4; ++j) { const int snd = b1 ? q8[j] : q8[j + 4], kp = b1 ? q8[j + 4] : q8[j]; q4[j] = kp + dpp_i<DPP_XOR2>(snd); }
#pragma unroll
    for (int j = 0; j < 2; ++j) { const int snd = b0 ? q4[j] : q4[j + 2], kp = b0 ? q4[j + 2] : q4[j]; q2[j] = kp + dpp_i<DPP_XOR1>(snd); }
    {
        int s0 = q2[0] >> 3, s1 = q2[1] >> 3;
        s0 = s0 > 32767 ? 32767 : (s0 < -32768 ? -32768 : s0);
        s1 = s1 > 32767 ? 32767 : (s1 < -32768 ? -32768 : s1);
        *(unsigned*)(p.part + ((size_t)x * T_TOK + t) * 128 + 2 * lane) = ((unsigned)s0 & 0xffffu) | ((unsigned)s1 << 16);
    }
}
DEVI void expB_compute(const Params& p, const ExpMeta& m, const ExpRows& R, int t, int x, int lane) {
    const bool b5 = lane & 32, b4 = lane & 16, b3 = lane & 8;
    const unsigned pa[4] = {m.xa.x, m.xa.y, m.xa.z, m.xa.w};
    int acc[16];
#pragma unroll
    for (int c = 0; c < 16; ++c) acc[c] = 0;
#pragma unroll
    for (int g = 0; g < 4; ++g) {
        const unsigned r0[4] = {R.r[4 * g].x, R.r[4 * g].y, R.r[4 * g].z, R.r[4 * g].w};
        const unsigned r1[4] = {R.r[4 * g + 1].x, R.r[4 * g + 1].y, R.r[4 * g + 1].z, R.r[4 * g + 1].w};
        const unsigned r2[4] = {R.r[4 * g + 2].x, R.r[4 * g + 2].y, R.r[4 * g + 2].z, R.r[4 * g + 2].w};
        const unsigned r3[4] = {R.r[4 * g + 3].x, R.r[4 * g + 3].y, R.r[4 * g + 3].z, R.r[4 * g + 3].w};
#pragma unroll
        for (int i = 0; i < 4; ++i) {
            const unsigned t0 = __builtin_amdgcn_perm(r1[i], r0[i], 0x05010400u), t1 = __builtin_amdgcn_perm(r1[i], r0[i], 0x07030602u);
            const unsigned t2 = __builtin_amdgcn_perm(r3[i], r2[i], 0x05010400u), t3 = __builtin_amdgcn_perm(r3[i], r2[i], 0x07030602u);
            const unsigned o0 = __builtin_amdgcn_perm(t2, t0, 0x05040100u), o1 = __builtin_amdgcn_perm(t2, t0, 0x07060302u);
            const unsigned o2 = __builtin_amdgcn_perm(t3, t1, 0x05040100u), o3 = __builtin_amdgcn_perm(t3, t1, 0x07060302u);
            acc[4 * i + 0] = __builtin_amdgcn_sdot4((int)o0, (int)pa[g], acc[4 * i + 0], false);
            acc[4 * i + 1] = __builtin_amdgcn_sdot4((int)o1, (int)pa[g], acc[4 * i + 1], false);
            acc[4 * i + 2] = __builtin_amdgcn_sdot4((int)o2, (int)pa[g], acc[4 * i + 2], false);
            acc[4 * i + 3] = __builtin_amdgcn_sdot4((int)o3, (int)pa[g], acc[4 * i + 3], false);
        }
    }
    int q8[8], q4[4], q2[2];
#pragma unroll
    for (int j = 0; j < 8; ++j) {
        const auto r = __builtin_amdgcn_permlane32_swap((unsigned)acc[j], (unsigned)acc[j + 8], false, false);
        q8[j] = (int)r[0] + (int)r[1];
    }
#pragma unroll
    for (int j = 0; j < 4; ++j) {
        const auto r = __builtin_amdgcn_permlane16_swap((unsigned)q8[j], (unsigned)q8[j + 4], false, false);
        q4[j] = (int)r[0] + (int)r[1];
    }
#pragma unroll
    for (int j = 0; j < 2; ++j) { const int snd = b3 ? q4[j] : q4[j + 2], kp = b3 ? q4[j + 2] : q4[j]; q2[j] = kp + dpp_i<DPP_ROR8>(snd); }
    const int col = 128 * x + 16 * (lane & 7) + (b5 ? 8 : 0) + (b4 ? 4 : 0) + (b3 ? 2 : 0);
    *(unsigned*)(p.proj + (size_t)t * 1024 + col) = pk2(bflo(R.x1) + (float)q2[0] * m.sc, bfhi(R.x1) + (float)q2[1] * m.sc);
}
constexpr int EXP_NP = 16;
template <int PHASE>
DEVI void exp_chunk(const Params& p, int tb, int x, int lane) {
    ExpMeta mA, mB, nA, nB;
    ExpRows rA, rB;
    exp_load_meta<PHASE>(p, mA, tb, x, lane);
    exp_load_meta<PHASE>(p, mB, tb + 1, x, lane);
    exp_issue<PHASE>(p, mA, rA, tb, x, lane);
    exp_issue<PHASE>(p, mB, rB, tb + 1, x, lane);
    exp_load_meta<PHASE>(p, nA, tb + 2, x, lane);
    exp_load_meta<PHASE>(p, nB, tb + 3, x, lane);
#pragma unroll 1
    for (int i = 0; i < EXP_NP; ++i) {
        const int tA = tb + 2 * i, tB = tA + 1;
        if (PHASE == 0) expA_compute(p, mA, rA, tA, x, lane); else expB_compute(p, mA, rA, tA, x, lane);
        if (i < EXP_NP - 1) {
            mA = nA;
            exp_issue<PHASE>(p, mA, rA, tA + 2, x, lane);
            if (i < EXP_NP - 2) exp_load_meta<PHASE>(p, nA, tA + 4, x, lane);
        }
        if (PHASE == 0) expA_compute(p, mB, rB, tB, x, lane); else expB_compute(p, mB, rB, tB, x, lane);
        if (i < EXP_NP - 1) {
            mB = nB;
            exp_issue<PHASE>(p, mB, rB, tB + 2, x, lane);
            if (i < EXP_NP - 2) exp_load_meta<PHASE>(p, nB, tB + 4, x, lane);
        }
    }
}
template <int PHASE>
DEVI void st_expAB(const Params& p, char* smem) {
    const int tid = stid(), lane = tid & 63, wid = tid >> 6;
    volatile int* cs = (volatile int*)smem;
    const unsigned myx = xb_xcc_id() & 7u;
    constexpr int NCH = T_TOK / (2 * EXP_NP * NW);
    for (int si = 0; si < 8; ++si) {
        const int x = (int)((myx + si) & 7u);
        unsigned* ctr = &p.bar[PHASE == 0 ? CTR_A(x) : CTR_B(x)];
        if (tid == 0) cs[0] = (int)xb_add(ctr, 1u);
        __syncthreads();
        int chunk = cs[0];
        __syncthreads();
        while (chunk < NCH) {
            int nxt = 0;
            if (tid == 0) nxt = (int)xb_add(ctr, 1u);
            exp_chunk<PHASE>(p, chunk * (2 * EXP_NP * NW) + wid * (2 * EXP_NP), x, lane);
            if (tid == 0) cs[0] = nxt;
            __syncthreads();
            chunk = cs[0];
            __syncthreads();
        }
    }
}
DEVI void st_expA2(const Params& p) {
    const int lane = stid() & 63, wid = stid() >> 6;
    for (int t0 = (blockIdx.x * NW + wid) * 2; t0 < T_TOK; t0 += gridDim.x * NW * 2) {
        unsigned pv[2][8], ew[2];
        float2 g[2];
        float xs[2];
#pragma unroll
        for (int q = 0; q < 2; ++q) {
            const int t = t0 + q;
#pragma unroll
            for (int x = 0; x < 8; ++x) pv[q][x] = *(const unsigned*)(p.part + ((size_t)x * T_TOK + t) * 128 + 2 * lane);
            ew[q] = *(const unsigned*)(p.eperm + (size_t)t * 128 + 2 * lane);
            g[q] = *(const float2*)(p.gate + (size_t)t * 128 + 2 * lane);
            xs[q] = rs2_of(p.rs2p, t) * (8.f * ZQ_SCALE);
        }
        float ds[2][2], us[2][2];
#pragma unroll
        for (int q = 0; q < 2; ++q) {
            const int ea = (int)(ew[q] & 0xffffu), eb = (int)(ew[q] >> 16);
            ds[q][0] = p.dscale[ea]; ds[q][1] = p.dscale[eb]; us[q][0] = p.uscale[ea]; us[q][1] = p.uscale[eb];
        }
#pragma unroll
        for (int q = 0; q < 2; ++q) {
            const int t = t0 + q;
            int s0 = 0, s1 = 0;
#pragma unroll
            for (int x = 0; x < 8; ++x) { s0 += (int)(short)(pv[q][x] & 0xffffu); s1 += (int)pv[q][x] >> 16; }
            const float a0 = g[q].x * gelu_erf((float)s0 * xs[q] * ds[q][0]) * us[q][0];
            const float a1 = g[q].y * gelu_erf((float)s1 * xs[q] * ds[q][1]) * us[q][1];
            const float amax = wave_max(fmaxf(fabsf(a0), fabsf(a1)));
            const float inv = amax > 0.f ? 127.f * rcp_(amax) : 0.f;
            const unsigned q0 = (unsigned)((int)rintf(a0 * inv) & 255), q1 = (unsigned)((int)rintf(a1 * inv) & 255);
            *(unsigned short*)(p.aq + (size_t)t * 128 + 2 * lane) = (unsigned short)(q0 | (q1 << 8));
            if (lane == 0) p.asc[t] = amax * (1.f / 127.f);
        }
    }
}
DEVI void st_expC(const Params& p) {
    const int lane = stid() & 63, wid = stid() >> 6;
    for (int t0 = (blockIdx.x * NW + wid) * 2; t0 < T_TOK; t0 += gridDim.x * NW * 2) {
        uint2 u[2][4];
#pragma unroll
        for (int q = 0; q < 2; ++q) {
            const uint2* row = (const uint2*)(p.proj + (size_t)(t0 + q) * 1024);
#pragma unroll
            for (int j = 0; j < 4; ++j) u[q][j] = row[lane + 64 * j];
        }
#pragma unroll
        for (int q = 0; q < 2; ++q) {
            float4 v[4];
            float ss = 0.f;
#pragma unroll
            for (int j = 0; j < 4; ++j) {
                v[j] = make_float4(bflo(u[q][j].x), bfhi(u[q][j].x), bflo(u[q][j].y), bfhi(u[q][j].y));
                ss += v[j].x * v[j].x + v[j].y * v[j].y + v[j].z * v[j].z + v[j].w * v[j].w;
            }
            ss = wave_sum(ss);
            const float rf = rsqrtf(ss * (1.f / 1024.f) + EPSN);
            float4* orow = (float4*)(p.out + (size_t)(t0 + q) * 1024);
#pragma unroll
            for (int j = 0; j < 4; ++j) {
                const float4 g = *(const float4*)(p.final_g + (lane + 64 * j) * 4);
                orow[lane + 64 * j] = make_float4(v[j].x * rf * g.x, v[j].y * rf * g.y, v[j].z * rf * g.z, v[j].w * rf * g.w);
            }
        }
    }
}

constexpr int LDS_BYTES = 147456;
constexpr int LDS_BARW = LDS_BYTES - 16;
extern __shared__ __attribute__((aligned(16))) char smem_dyn[];
__global__ void __launch_bounds__(NTHR, 2) mega_fwd(Params p) {
    cg::grid_group grid = cg::this_grid();
    volatile LAS unsigned* bst = (volatile LAS unsigned*)(LAS char*)(smem_dyn + LDS_BARW);
    if (stid() < 4) bst[stid()] = 0u;
    __syncthreads();
    XcdBarrier bar = xcd_barrier_post(p.bar, bst);
    st_prep_misc(p);
    st_prep_w1(p, smem_dyn);
    st_prep_x(p, smem_dyn);
    if (p.pad_[0] == 0x7fffabcd) grid.sync();
    xcd_barrier(bar);
    st_gemm8<EpiProj8, PG8_ALIGN>(p.xb, p.W1t, NPJ, 1024, smem_dyn, EpiProj8{p.proj, p.rs1, p.rope_cos, p.rope_sin});
    xcd_barrier(bar);
    st_conv_qk(p, smem_dyn);
    xcd_barrier(bar);
    st_recur(p, smem_dyn);
    xcd_barrier(bar);
    st_gemm8<EpiX18, PG8_ALIGN>(p.yb, p.W2t, 1024, 1024, smem_dyn, EpiX18{p.x, p.x1b, p.xq, p.rs2p, p.norm2_g});
    xcd_barrier(bar);
    st_gemm3_topk(p, smem_dyn);
    xcd_barrier(bar);
    st_expAB<0>(p, smem_dyn);
    xcd_barrier(bar);
    st_expA2(p);
    xcd_barrier(bar);
    st_expAB<1>(p, smem_dyn);
    xcd_barrier(bar);
    st_expC(p);
}

extern "C" void kernel_launch(void* const* d_in, const int* in_sizes, int n_in, void* d_out, int out_size, void* d_ws, size_t ws_size,
                              hipStream_t stream) {
    Params p{};
    const float* const* in = (const float* const*)d_in;
    p.x = in[0]; p.norm1_g = in[1]; p.w_in = in[2]; p.ret_norm_g = in[3]; p.m_conv_w = in[4]; p.m_conv_b = in[5]; p.m_wq = in[6]; p.m_wk = in[7];
    p.m_b_i = in[8]; p.m_b_f = in[9]; p.m_norm_g = in[10]; p.m_skip = in[11]; p.w_out = in[12]; p.norm2_g = in[13]; p.peer_wq = in[14];
    p.peer_keys = in[15]; p.peer_down = in[16]; p.peer_up = in[17]; p.final_g = in[18];
    p.out = (float*)d_out;
    char* ws = (char*)d_ws;
    size_t off = 0;
    auto take = [&](size_t bytes) { char* r = ws + off; off += (bytes + 255) & ~(size_t)255; return r; };
    p.proj = (bf16_t*)take((size_t)T_TOK * NPJ * 2);
    p.xb = (bf16_t*)take((size_t)T_TOK * 1024 * 2);
    p.yb = p.xb;
    p.gate = (float*)(ws + (size_t)T_TOK * 2048 * 4);
    p.mq = (bf16_t*)take((size_t)T_TOK * 512 * 2);
    p.mk = (bf16_t*)take((size_t)T_TOK * 512 * 2);
    p.x1b = p.mq;
    p.cbuf = (bf16_t*)take((size_t)T_TOK * 512 * 2);
    p.eperm = (unsigned short*)p.cbuf;
    p.down_q = (unsigned char*)take((size_t)16384 * 1024);
    p.up_q = (unsigned char*)take((size_t)16384 * 1024);
    p.dscale = (float*)take(16384 * 4);
    p.uscale = (float*)take(16384 * 4);
    p.bar = (unsigned*)take(CTL_WORDS * 4);
    p.xq = (unsigned char*)take((size_t)T_TOK * 1024);
    p.asc = (float*)take(T_TOK * 4);
    p.aq = (unsigned char*)take((size_t)T_TOK * 128);
    p.part = (short*)(ws + (size_t)T_TOK * 1024 * 4);
    p.W1t = (bf16_t*)take((size_t)NPJ * 1024 * 2);
    p.W2t = (bf16_t*)take((size_t)1024 * 1024 * 2);
    p.Wsubq = (signed char*)take((size_t)2048 * 1024);
    p.wsc = (float*)take(2048 * 4);
    p.Wqt = (bf16_t*)take(4 * 128 * 128 * 2);
    p.Wkt = (bf16_t*)take(4 * 128 * 128 * 2);
    p.rs1 = (float*)take(T_TOK * 4);
    p.rs2p = (float*)take((size_t)T_TOK * 16 * 4);
    p.ipre = (float*)take(T_TOK * 4 * 4);
    p.logf = (float*)take(T_TOK * 4 * 4);
    p.rope_cos = (float*)take(2048 * 64 * 4);
    p.rope_sin = (float*)take(2048 * 64 * 4);
    if (off > ws_size) { fprintf(stderr, "kernel_launch: workspace too small (%zu > %zu)\n", off, ws_size); return; }

    static int grid_blocks = 0;
    if (!grid_blocks) {
        int dev = 0, cus = 0, per_cu = 0;
        (void)hipGetDevice(&dev);
        (void)hipDeviceGetAttribute(&cus, hipDeviceAttributeMultiprocessorCount, dev);
        (void)hipFuncSetAttribute((const void*)mega_fwd, hipFuncAttributeMaxDynamicSharedMemorySize, LDS_BYTES);
        (void)hipOccupancyMaxActiveBlocksPerMultiprocessor(&per_cu, (const void*)mega_fwd, NTHR, LDS_BYTES);
        if (per_cu > 1) per_cu = 1;
        if (per_cu < 1) per_cu = 1;
        grid_blocks = cus * per_cu;
    }
    (void)hipMemsetAsync(p.bar, 0, CTL_WORDS * 4, stream);
    void* args[] = {&p};
    hipError_t e = hipLaunchCooperativeKernel((const void*)mega_fwd, dim3(grid_blocks), dim3(NTHR), args, LDS_BYTES, stream);
    if (e != hipSuccess) fprintf(stderr, "cooperative launch failed: %s (grid %d)\n", hipGetErrorString(e), grid_blocks);
}
```

```cpp
#include <hip/hip_runtime.h>
#include <hip/hip_cooperative_groups.h>
#include <stdint.h>
#include <cstdio>
namespace cg = cooperative_groups;

typedef unsigned short bf16_t;
typedef short bf16x8 __attribute__((ext_vector_type(8)));
typedef float f32x4 __attribute__((ext_vector_type(4)));
typedef int i32x4 __attribute__((ext_vector_type(4)));

#define DEVI __device__ __forceinline__
__device__ __forceinline__ int stid() { int t = (int)threadIdx.x; asm volatile("" : "+v"(t)); return t; }

constexpr int T_TOK = 32768, DM = 1024, NPJ = 3584, DIN = 3592;
constexpr int NTHR = 512, NW = 8;
constexpr float EPSN = 1e-6f;

struct Params {
    const float *x, *norm1_g, *w_in, *ret_norm_g, *m_conv_w, *m_conv_b, *m_wq, *m_wk, *m_b_i, *m_b_f, *m_norm_g, *m_skip, *w_out,
        *norm2_g, *peer_wq, *peer_keys, *peer_down, *peer_up, *final_g;
    float* out;
    bf16_t *proj, *xb, *yb, *mq, *mk, *x1b, *cbuf, *W1t, *W2t, *Wqt, *Wkt;
    signed char* Wsubq;
    float* wsc;
    unsigned char *down_q, *up_q;
    float *dscale, *uscale, *asc;
    unsigned short* eperm;
    unsigned char* aq;
    short* part;
    unsigned char* xq;
    unsigned* bar;
    float *rs1, *rs2p, *ipre, *logf, *rope_cos, *rope_sin, *gate;
    int pad_[2];
};

DEVI unsigned f2bf_bits(float f) { unsigned u = __float_as_uint(f); return (u + 0x7fffu + ((u >> 16) & 1u)) >> 16; }
DEVI bf16_t f2bf(float f) { return __builtin_bit_cast(bf16_t, (__bf16)f); }
typedef __bf16 bf16x2_t __attribute__((ext_vector_type(2)));
DEVI unsigned pk2(float lo, float hi) { bf16x2_t v = {(__bf16)lo, (__bf16)hi}; return __builtin_bit_cast(unsigned, v); }
DEVI float bflo(unsigned w) { return __uint_as_float(w << 16); }
DEVI float bfhi(unsigned w) { return __uint_as_float(w & 0xffff0000u); }
DEVI float bf2f(bf16_t h) { return __uint_as_float(((unsigned)h) << 16); }
template <int CTRL> DEVI float dpp_f(float v) { return __int_as_float(__builtin_amdgcn_update_dpp(0, __float_as_int(v), CTRL, 0xf, 0xf, false)); }
template <int CTRL> DEVI int dpp_i(int v) { return __builtin_amdgcn_update_dpp(0, v, CTRL, 0xf, 0xf, false); }
constexpr int DPP_XOR1 = 0xB1  , DPP_XOR2 = 0x4E  , DPP_HMIRROR = 0x141  ,
              DPP_MIRROR = 0x140  , DPP_ROR8 = 0x128  ;
DEVI float rl_f(float v, int l) { return __int_as_float(__builtin_amdgcn_readlane(__float_as_int(v), l)); }
DEVI float wave_sum(float v) {
    v += dpp_f<DPP_XOR1>(v); v += dpp_f<DPP_XOR2>(v); v += dpp_f<DPP_HMIRROR>(v); v += dpp_f<DPP_MIRROR>(v);
    return (rl_f(v, 0) + rl_f(v, 16)) + (rl_f(v, 32) + rl_f(v, 48));
}
DEVI float wave_max(float v) {
    v = fmaxf(v, dpp_f<DPP_XOR1>(v)); v = fmaxf(v, dpp_f<DPP_XOR2>(v)); v = fmaxf(v, dpp_f<DPP_HMIRROR>(v)); v = fmaxf(v, dpp_f<DPP_MIRROR>(v));
    return fmaxf(fmaxf(rl_f(v, 0), rl_f(v, 16)), fmaxf(rl_f(v, 32), rl_f(v, 48)));
}
constexpr float ZQ_SCALE = 6.f / 127.f;
DEVI float rs2_of(const float* rs2p, int t) {
    const float4* q = (const float4*)(rs2p + (size_t)t * 16);
    const float4 a = q[0], b = q[1], c = q[2], d = q[3];
    const float ss = ((a.x + a.y) + (a.z + a.w)) + ((b.x + b.y) + (b.z + b.w)) + ((c.x + c.y) + (c.z + c.w)) + ((d.x + d.y) + (d.z + d.w));
    return rsqrtf(ss * (1.f / 1024.f) + EPSN);
}
DEVI f32x4 mfma16(bf16x8 a, bf16x8 b, f32x4 c) { return __builtin_amdgcn_mfma_f32_16x16x32_bf16(a, b, c, 0, 0, 0); }
DEVI bf16x8 ld8(const char* p) { return *reinterpret_cast<const bf16x8*>(p); }
DEVI bf16x8 mk8(uint2 lo, uint2 hi) {
    union { uint4 u; bf16x8 v; } x;
    x.u = make_uint4(lo.x, lo.y, hi.x, hi.y);
    return x.v;
}
DEVI float fexp_(float x) { return __builtin_amdgcn_exp2f(x * 1.4426950408889634f); }
DEVI float rcp_(float x) { return __builtin_amdgcn_rcpf(x); }
DEVI float sigmoidf_(float z) { return rcp_(1.f + fexp_(-z)); }

DEVI void st_prep_misc(const Params& p) {
    const int gtid = blockIdx.x * NTHR + stid(), gsz = gridDim.x * NTHR;
    for (int i = gtid; i < 2048 * 64; i += gsz) {
        const int pos = i >> 6, j = i & 63;
        const float inv = powf(10000.f, -(float)j * (1.f / 64.f));
        const float ang = (float)pos * inv;
        float s, c;
        sincosf(ang, &s, &c);
        p.rope_cos[i] = c;
        p.rope_sin[i] = s;
    }
    for (int i = gtid; i < 4 * 128 * 128; i += gsz) {
        const int h = i >> 14, e = (i >> 7) & 127, d = i & 127;
        p.Wqt[i] = f2bf(p.m_wq[h * 16384 + d * 128 + e]);
        p.Wkt[i] = f2bf(p.m_wk[h * 16384 + d * 128 + e] * 0.08838834764831845f);
    }
}
DEVI void prep_table_row(const Params& p, int row, const float4 (&v)[4], int lane) {
    const bool up = row >= 16384;
    const int e = up ? row - 16384 : row;
    float am = 0.f;
#pragma unroll
    for (int i = 0; i < 4; ++i) am = fmaxf(am, fmaxf(fmaxf(fabsf(v[i].x), fabsf(v[i].y)), fmaxf(fabsf(v[i].z), fabsf(v[i].w))));
    am = wave_max(am);
    const float sc = am > 0.f ? am * (1.f / 127.f) : 1.f, inv = am > 0.f ? 127.f * rcp_(am) : 0.f;
    unsigned w[4];
#pragma unroll
    for (int i = 0; i < 4; ++i) {
        const int q0 = (int)rintf(v[i].x * inv), q1 = (int)rintf(v[i].y * inv), q2 = (int)rintf(v[i].z * inv), q3 = (int)rintf(v[i].w * inv);
        w[i] = (unsigned)(q0 & 255) | ((unsigned)(q1 & 255) << 8) | ((unsigned)(q2 & 255) << 16) | ((unsigned)(q3 & 255) << 24);
    }
    *(uint4*)((up ? p.up_q : p.down_q) + ((size_t)(lane >> 3) * 16384 + e) * 128 + (lane & 7) * 16) = make_uint4(w[0], w[1], w[2], w[3]);
    if (lane == 0) (up ? p.uscale : p.dscale)[e] = sc;
}
DEVI void st_prep_tables(const Params& p, int bid, int nb) {
    const int lane = stid() & 63, wid = stid() >> 6;
    for (int row = (bid * NW + wid) * 2; row < 32768; row += nb * NW * 2) {
        float4 va[4], vb[4];
        const float4* sa = (const float4*)((row >= 16384 ? p.peer_up + (size_t)(row - 16384) * 1024 : p.peer_down + (size_t)row * 1024) + lane * 16);
        const float4* sb = (const float4*)((row + 1 >= 16384 ? p.peer_up + (size_t)(row + 1 - 16384) * 1024 : p.peer_down + (size_t)(row + 1) * 1024) + lane * 16);
#pragma unroll
        for (int i = 0; i < 4; ++i) { va[i] = sa[i]; vb[i] = sb[i]; }
        prep_table_row(p, row, va, lane);
        prep_table_row(p, row + 1, vb, lane);
    }
}

DEVI void transpose_tile(const float* __restrict__ src, int ld, const float* __restrict__ scale, bf16_t* __restrict__ dst, int K, int k0, int n0,
                         float* tile, bool permqk = false) {
    const int tid = stid();
    {
        const int tx = tid & 63, ty = tid >> 6;
#pragma unroll
        for (int i = 0; i < 4; ++i) {
            const int k = k0 + ty + 8 * i;
            float v = src[(size_t)k * ld + n0 + tx];
            if (scale) v *= scale[k];
            tile[(ty + 8 * i) * 65 + tx] = v;
        }
    }
    __syncthreads();
    {
        const int n = tid >> 3, kq = tid & 7;
        const float a = tile[(4 * kq) * 65 + n], b = tile[(4 * kq + 1) * 65 + n], c = tile[(4 * kq + 2) * 65 + n], d = tile[(4 * kq + 3) * 65 + n];
        int nn = n0 + n;
        if (permqk && nn < 1024) { const int dd = nn & 127; nn = (nn & ~127) + (dd < 64 ? 2 * dd : 2 * (dd - 64) + 1); }
        *(uint2*)(dst + (size_t)nn * K + k0 + 4 * kq) = make_uint2(pk2(a, b), pk2(c, d));
    }
    __syncthreads();
}
DEVI void st_prep_w1(const Params& p, char* smem) {
    float* tile = (float*)smem;
    for (int it = blockIdx.x; it < 56 * 32; it += gridDim.x) transpose_tile(p.w_in, DIN, p.norm1_g, p.W1t, 1024, (it & 31) * 32, (it >> 5) * 64, tile, true);
}
DEVI void st_prep_w2(const Params& p, char* smem, int bid, int nb) {
    float* tile = (float*)smem;
    for (int it = bid; it < 16 * 32; it += nb) transpose_tile(p.w_out, 1024, nullptr, p.W2t, 1024, (it & 31) * 32, (it >> 5) * 64, tile);
}
DEVI void st_prep_wsub(const Params& p, char* smem, int bid, int nb) {
    float* wq_s = (float*)smem;
    float* key_s = wq_s + 64 * 132;
    const int tid = stid(), nl = tid >> 5, kp = tid & 31;
    for (int it = bid; it < 16 * 8; it += nb) {
        const int grp = it >> 3, n0 = (it & 7) * 16;
        __syncthreads();
        {
            const int idx = tid * 4, n = idx >> 7, d = idx & 127;
            *(float4*)(key_s + n * 132 + d) = *(const float4*)(p.peer_keys + ((size_t)grp * 128 + n0 + n) * 128 + d);
        }
        float v0[16], v1[16];
#pragma unroll 1
        for (int kt = 0; kt < 16; ++kt) {
            __syncthreads();
#pragma unroll
            for (int i = 0; i < 4; ++i) {
                const int idx = (tid + 512 * i) * 4, r = idx >> 7, d = idx & 127;
                *(float4*)(wq_s + r * 132 + d) = *(const float4*)(p.peer_wq + (size_t)(kt * 64 + r) * 2048 + grp * 128 + d);
            }
            __syncthreads();
            float a0 = 0.f, a1 = 0.f;
#pragma unroll 8
            for (int d4 = 0; d4 < 32; ++d4) {
                const float4 w0 = *(const float4*)(wq_s + (2 * kp) * 132 + 4 * d4), w1 = *(const float4*)(wq_s + (2 * kp + 1) * 132 + 4 * d4);
                const float4 y = *(const float4*)(key_s + nl * 132 + 4 * d4);
                a0 += w0.x * y.x + w0.y * y.y + w0.z * y.z + w0.w * y.w;
                a1 += w1.x * y.x + w1.y * y.y + w1.z * y.z + w1.w * y.w;
            }
#pragma unroll
            for (int q = 0; q < 16; ++q) if (q == kt) { v0[q] = a0; v1[q] = a1; }
        }
        float am = 0.f;
#pragma unroll
        for (int q = 0; q < 16; ++q) am = fmaxf(am, fmaxf(fabsf(v0[q]), fabsf(v1[q])));
#pragma unroll
        for (int o = 16; o; o >>= 1) am = fmaxf(am, __shfl_xor(am, o));
        const float inv = am > 0.f ? 127.f * rcp_(am) : 0.f;
        signed char* orow = p.Wsubq + (size_t)(grp * 128 + n0 + nl) * 1024 + 2 * kp;
#pragma unroll
        for (int q = 0; q < 16; ++q) {
            const int q0 = (int)rintf(v0[q] * inv), q1 = (int)rintf(v1[q] * inv);
            *(unsigned short*)(orow + 64 * q) = (unsigned short)((q0 & 255) | ((q1 & 255) << 8));
        }
        if (kp == 0) p.wsc[grp * 128 + n0 + nl] = am > 0.f ? am * (1.f / 127.f) : 1.f;
    }
    __syncthreads();
}

DEVI void prep_x_token(const Params& p, const float* Wg_s, int t, const float4 (&v)[4], int lane) {
    float ss = 0.f, g8[8];
#pragma unroll
    for (int g = 0; g < 8; ++g) g8[g] = 0.f;
#pragma unroll
    for (int j = 0; j < 4; ++j) {
        ss += v[j].x * v[j].x + v[j].y * v[j].y + v[j].z * v[j].z + v[j].w * v[j].w;
#pragma unroll
        for (int g = 0; g < 8; ++g) {
            const float4 w = *(const float4*)(Wg_s + g * 1024 + (lane + 64 * j) * 4);
            g8[g] += v[j].x * w.x + v[j].y * w.y + v[j].z * w.z + v[j].w * w.w;
        }
    }
    ss = wave_sum(ss);
    const bool b5 = lane & 32, b4 = lane & 16, b3 = lane & 8;
    float q4[4], q2[2], q1;
#pragma unroll
    for (int j = 0; j < 4; ++j) { const float snd = b5 ? g8[j] : g8[j + 4], kp = b5 ? g8[j + 4] : g8[j]; q4[j] = kp + __shfl_xor(snd, 32); }
#pragma unroll
    for (int j = 0; j < 2; ++j) { const float snd = b4 ? q4[j] : q4[j + 2], kp = b4 ? q4[j + 2] : q4[j]; q2[j] = kp + __shfl_xor(snd, 16); }
    { const float snd = b3 ? q2[0] : q2[1], kp = b3 ? q2[1] : q2[0]; q1 = kp + __shfl_xor(snd, 8); }
    q1 += __shfl_xor(q1, 4);
    q1 += __shfl_xor(q1, 2);
    q1 += __shfl_xor(q1, 1);
    const float rs = rsqrtf(ss * (1.f / 1024.f) + EPSN);
    uint2* o = (uint2*)(p.xb + (size_t)t * 1024);
#pragma unroll
    for (int j = 0; j < 4; ++j) o[lane + 64 * j] = make_uint2(pk2(v[j].x, v[j].y), pk2(v[j].z, v[j].w));
    if (lane == 0) p.rs1[t] = rs;
    if ((lane & 7) == 0) {
        const int gi = (b5 ? 4 : 0) + (b4 ? 2 : 0) + (b3 ? 1 : 0);
        if (gi < 4) p.ipre[t * 4 + gi] = q1 * rs + p.m_b_i[gi];
        else {
            const float z = q1 * rs + p.m_b_f[gi - 4];
            p.logf[t * 4 + gi - 4] = fminf(z, 0.f) - log1pf(fexp_(-fabsf(z)));
        }
    }
}
DEVI void st_prep_x(const Params& p, char* smem) {
    float* Wg_s = (float*)smem;
    for (int i = stid(); i < 8192; i += NTHR) {
        const int k = i >> 3, g = i & 7;
        Wg_s[g * 1024 + k] = p.norm1_g[k] * p.w_in[(size_t)k * DIN + NPJ + g];
    }
    __syncthreads();
    const int lane = stid() & 63, wid = stid() >> 6;
    for (int t = (blockIdx.x * NW + wid) * 4; t < T_TOK; t += gridDim.x * NW * 4) {
        float4 v[4][4];
        const float4* xa = (const float4*)(p.x + (size_t)t * 1024);
#pragma unroll
        for (int q = 0; q < 4; ++q)
#pragma unroll
            for (int j = 0; j < 4; ++j) v[q][j] = xa[256 * q + lane + 64 * j];
#pragma unroll
        for (int q = 0; q < 4; ++q) prep_x_token(p, Wg_s, t + q, v[q], lane);
    }
    __syncthreads();
}

namespace pg8 {
#define PG8_LAS __attribute__((address_space(3)))
typedef unsigned short bf16_t;
typedef short bf16x8 __attribute__((ext_vector_type(8)));
typedef float f32x4 __attribute__((ext_vector_type(4)));
typedef unsigned u32x4 __attribute__((ext_vector_type(4)));
constexpr int BM = 256, BK = 64, HALF = 128, HTB = HALF * BK * 2  , STAGE_BYTES = 8 * HTB, NXCD = 8, WGM = 8;

__host__ __device__ __forceinline__ int lds_byte(int r, int c) { const int st = (r >> 4) * 2 + (c >> 5), rr = r & 15, cc = c & 31, ob = rr * 64 + cc * 2; return st * 1024 + (ob ^ (((ob >> 9) & 1) << 5)); }
__host__ __device__ __forceinline__ void stage_rc(int b, int& R, int& C) { const int st = b / 1024, sb = b % 1024, swz = sb ^ (((sb >> 9) & 1) << 5); R = (st >> 1) * 16 + swz / 64; C = (st & 1) * 32 + (swz % 64) / 2; }
__host__ __device__ __forceinline__ int perm32(int rho) { const int n = rho >> 4, i = rho & 15; return 8 * (i >> 2) + 4 * n + (i & 3); }

struct Unit { int pm, pn; };
struct Gemm { const bf16_t* A; const bf16_t* Bt; int M, N, K; };

struct StaticOrder {
    int nM, nN, nwg, G, c;
    __host__ __device__ void init(int M, int N, int G_, int c_) { nM = M / BM; nN = N / BM; nwg = nM * nN; G = G_; c = c_; }
    __host__ __device__ bool next(int i, Unit& u) const {
        const long L = (long)i * G + c; if (L >= nwg) return false;
        int wgid = (int)L; { const int q = nwg / NXCD, r = nwg % NXCD, xcd = wgid % NXCD, off = wgid / NXCD; wgid = (xcd < r ? xcd * (q + 1) : r * (q + 1) + (xcd - r) * q) + off; }
        const int nig = WGM * nN, gid = wgid / nig, fm = gid * WGM, gsz = (nM - fm) < WGM ? (nM - fm) : WGM;
        u.pm = fm + ((wgid % nig) % gsz); u.pn = (wgid % nig) / gsz; return true;
    }
    __device__ __forceinline__ void a_ready(const Unit&) const {}
    __device__ __forceinline__ void done(const Unit&) const {}
};

__device__ __forceinline__ unsigned cvt_pk_bf16(float lo, float hi) { unsigned r; asm volatile("v_cvt_pk_bf16_f32 %0, %1, %2" : "=v"(r) : "v"(lo), "v"(hi)); return r; }

template <class Epi, class Sched, bool ALIGN_EPI = false, bool SP2 = false>
__device__ __forceinline__ void gemm_phase(PG8_LAS unsigned char* lds, const Gemm g, const Sched& S, const Epi& E) {
    const int tid = stid(), wid = __builtin_amdgcn_readfirstlane(tid >> 6), lane = tid & 63, wr = wid >> 2, wc = wid & 3, fr = lane & 15, fq = lane >> 4;
    const int K = g.K, nt = K / BK;
    unsigned voffA[2], voffB[2];
#pragma unroll
    for (int i = 0; i < 2; ++i) { int R, C; stage_rc(tid * 16 + i * 8192, R, C); const int Rb = Epi::PERM ? ((R & ~31) + perm32(R & 31)) : R;
        voffA[i] = (unsigned)(R * K + C) * 2u; voffB[i] = (unsigned)(Rb * K + C) * 2u; }
    const size_t kstep = (size_t)(BK * 2);
    const size_t hstep = (size_t)HALF * K * 2;
    const size_t tstep = 2 * hstep;
    const unsigned ldsw = (unsigned)wid * 1024u;
    const int aoff = lds_byte(wr * 64 + fr, fq * 8), boff = lds_byte(wc * 32 + fr, fq * 8);
#define PG8_SA(b, h) (((b) * 2 + (h)) * HTB)
#define PG8_SB(b, h) ((4 + (b) * 2 + (h)) * HTB)
#define PG8_STAGE(bufoff, gbase, voff) do { _Pragma("unroll") for (int _i = 0; _i < 2; ++_i) \
        __builtin_amdgcn_global_load_lds((const unsigned*)((const char*)(gbase) + (voff)[_i]), (PG8_LAS unsigned*)(lds + (bufoff) + ldsw + _i * 8192), 16, 0, 0); } while (0)
#define PG8_LDA(dst, b, h) do { _Pragma("unroll") for (int m = 0; m < 4; ++m) _Pragma("unroll") for (int k = 0; k < 2; ++k) dst[m][k] = *(const PG8_LAS bf16x8*)(lds + PG8_SA(b, h) + aoff + m * 2048 + k * 1024); } while (0)
#define PG8_LDB(dst, b, h) do { _Pragma("unroll") for (int n = 0; n < 2; ++n) _Pragma("unroll") for (int k = 0; k < 2; ++k) dst[n][k] = *(const PG8_LAS bf16x8*)(lds + PG8_SB(b, h) + boff + n * 2048 + k * 1024); } while (0)
#define PG8_MMA(ai, bj, At, Bt) do { __builtin_amdgcn_s_setprio(1); _Pragma("unroll") for (int m = 0; m < 4; ++m) _Pragma("unroll") for (int n = 0; n < 2; ++n) _Pragma("unroll") for (int k = 0; k < 2; ++k) \
        acc[ai][bj][m][n] = __builtin_amdgcn_mfma_f32_16x16x32_bf16(Bt[n][k], At[m][k], acc[ai][bj][m][n], 0, 0, 0); __builtin_amdgcn_s_setprio(0); } while (0)
#define PG8_WAIT_V(n) asm volatile("s_waitcnt vmcnt(" #n ")" ::: "memory")
#define PG8_WAIT_L(n) asm volatile("s_waitcnt lgkmcnt(" #n ")" ::: "memory")
#define PG8_BAR __builtin_amdgcn_s_barrier()
#define PG8_SCHED __builtin_amdgcn_sched_barrier(0)
    Unit cur, nxt; int ui = 0;
    if (!S.next(0, cur)) return;
    f32x4 acc[2][2][4][2];
#pragma unroll
    for (int a = 0; a < 2; ++a)
#pragma unroll
        for (int b = 0; b < 2; ++b)
#pragma unroll
            for (int m = 0; m < 4; ++m)
#pragma unroll
                for (int n = 0; n < 2; ++n) acc[a][b][m][n] = (f32x4){0.f, 0.f, 0.f, 0.f};
    bf16x8 At[4][2], B0[2][2], B1[2][2];
    const char* cA = (const char*)g.A + (size_t)cur.pm * tstep; const char* cB = (const char*)g.Bt + (size_t)cur.pn * tstep;
    S.a_ready(cur);
    if constexpr (SP2) {
        PG8_STAGE(PG8_SB(0, 0), cB, voffB); PG8_STAGE(PG8_SB(0, 1), cB + hstep, voffB); PG8_STAGE(PG8_SA(0, 0), cA, voffA); PG8_STAGE(PG8_SA(0, 1), cA + hstep, voffA);
        if (wr == 1) PG8_BAR;
        PG8_WAIT_V(2); PG8_BAR;
        PG8_STAGE(PG8_SB(1, 0), cB + kstep, voffB); PG8_STAGE(PG8_SA(1, 0), cA + kstep, voffA); PG8_STAGE(PG8_SB(1, 1), cB + hstep + kstep, voffB);
        PG8_WAIT_V(6); PG8_BAR;
    } else {
        PG8_STAGE(PG8_SB(0, 0), cB, voffB); PG8_STAGE(PG8_SA(0, 0), cA, voffA); PG8_STAGE(PG8_SB(0, 1), cB + hstep, voffB); PG8_STAGE(PG8_SA(0, 1), cA + hstep, voffA);
        if (wr == 1) PG8_BAR;
        PG8_WAIT_V(4); PG8_BAR;
        PG8_STAGE(PG8_SB(1, 0), cB + kstep, voffB); PG8_STAGE(PG8_SA(1, 0), cA + kstep, voffA); PG8_STAGE(PG8_SB(1, 1), cB + hstep + kstep, voffB);
        PG8_WAIT_V(6); PG8_BAR;
    }
    for (;;) {
        const bool has_next = S.next(ui + 1, nxt);
        const char* nA = has_next ? (const char*)g.A + (size_t)nxt.pm * tstep : cA; const char* nB = has_next ? (const char*)g.Bt + (size_t)nxt.pn * tstep : cB;
        for (int t = 0; t < nt; t += 2) {
            const bool last = (t == nt - 2);
            const char* a1 = cA + (size_t)(t + 1) * kstep;
            const char* a2 = last ? nA : cA + (size_t)(t + 2) * kstep; const char* b2 = last ? nB : cB + (size_t)(t + 2) * kstep;
            const char* a3 = a2 + kstep; const char* b3 = b2 + kstep;
            if (last && has_next) S.a_ready(nxt);
            if constexpr (SP2) {
            PG8_LDB(B0, 0, 0); PG8_LDB(B1, 0, 1); PG8_SCHED; PG8_LDA(At, 0, 0); PG8_STAGE(PG8_SA(1, 1), a1 + hstep, voffA);
            PG8_WAIT_V(8); PG8_WAIT_L(0); PG8_BAR; PG8_MMA(0, 0, At, B0); PG8_MMA(0, 1, At, B1); PG8_BAR; PG8_SCHED;
            PG8_LDA(At, 0, 1); PG8_STAGE(PG8_SB(0, 0), b2, voffB); PG8_STAGE(PG8_SB(0, 1), b2 + hstep, voffB); PG8_STAGE(PG8_SA(0, 0), a2, voffA);
            PG8_WAIT_V(8); PG8_WAIT_L(0); PG8_BAR; PG8_MMA(1, 0, At, B0); PG8_MMA(1, 1, At, B1); PG8_BAR; PG8_SCHED;
            PG8_LDB(B0, 1, 0); PG8_LDB(B1, 1, 1); PG8_SCHED; PG8_LDA(At, 1, 0); PG8_STAGE(PG8_SA(0, 1), a2 + hstep, voffA);
            PG8_WAIT_V(8); PG8_WAIT_L(0); PG8_BAR; PG8_MMA(0, 0, At, B0); PG8_MMA(0, 1, At, B1); PG8_BAR; PG8_SCHED;
            PG8_LDA(At, 1, 1); PG8_STAGE(PG8_SB(1, 0), b3, voffB); PG8_STAGE(PG8_SB(1, 1), b3 + hstep, voffB); PG8_STAGE(PG8_SA(1, 0), a3, voffA);
            PG8_WAIT_V(8); PG8_WAIT_L(0); PG8_BAR; PG8_MMA(1, 0, At, B0); PG8_MMA(1, 1, At, B1); PG8_BAR; PG8_SCHED;
            } else {
            PG8_LDB(B0, 0, 0); PG8_SCHED; PG8_LDA(At, 0, 0); PG8_STAGE(PG8_SA(1, 1), a1 + hstep, voffA);
            PG8_WAIT_L(8); PG8_BAR; PG8_WAIT_L(0); PG8_MMA(0, 0, At, B0); PG8_BAR; PG8_SCHED;
            PG8_LDB(B1, 0, 1); PG8_STAGE(PG8_SB(0, 0), b2, voffB);
            PG8_BAR; PG8_WAIT_L(0); PG8_MMA(0, 1, At, B1); PG8_BAR;
            PG8_LDA(At, 0, 1); PG8_STAGE(PG8_SA(0, 0), a2, voffA);
            PG8_BAR; PG8_WAIT_L(0); PG8_MMA(1, 0, At, B0); PG8_BAR; PG8_SCHED;
            PG8_STAGE(PG8_SB(0, 1), b2 + hstep, voffB);
            PG8_WAIT_V(6); PG8_BAR; PG8_MMA(1, 1, At, B1); PG8_BAR;
            PG8_LDB(B0, 1, 0); PG8_SCHED; PG8_LDA(At, 1, 0); PG8_STAGE(PG8_SA(0, 1), a2 + hstep, voffA);
            PG8_WAIT_L(8); PG8_BAR; PG8_WAIT_L(0); PG8_MMA(0, 0, At, B0); PG8_BAR; PG8_SCHED;
            PG8_LDB(B1, 1, 1); PG8_STAGE(PG8_SB(1, 0), b3, voffB);
            PG8_BAR; PG8_WAIT_L(0); PG8_MMA(0, 1, At, B1); PG8_BAR;
            PG8_LDA(At, 1, 1); PG8_STAGE(PG8_SA(1, 0), a3, voffA);
            PG8_BAR; PG8_WAIT_L(0); PG8_MMA(1, 0, At, B0); PG8_BAR; PG8_SCHED;
            PG8_STAGE(PG8_SB(1, 1), b3 + hstep, voffB);
            PG8_WAIT_V(6); PG8_BAR; PG8_MMA(1, 1, At, B1); PG8_BAR;
            }
        }
        if constexpr (ALIGN_EPI) { if (wr == 0) PG8_BAR; }
        if constexpr (!Epi::AFTER_DRAIN) { E(acc, cur, wr, wc, fr, fq); S.done(cur); }
        if (!has_next) break;
#pragma unroll
        for (int a = 0; a < 2; ++a)
#pragma unroll
            for (int b = 0; b < 2; ++b)
#pragma unroll
                for (int m = 0; m < 4; ++m)
#pragma unroll
                    for (int n = 0; n < 2; ++n) acc[a][b][m][n] = (f32x4){0.f, 0.f, 0.f, 0.f};
        cur = nxt; cA = nA; cB = nB; ++ui;
        if constexpr (ALIGN_EPI) { if (wr == 1) PG8_BAR; }
    }
    PG8_WAIT_V(0);
    if constexpr (!ALIGN_EPI) { if (wr == 0) PG8_BAR; }
    PG8_BAR;
    if constexpr (Epi::AFTER_DRAIN) { E.fused(acc, cur, wr, wc, fr, fq, lds, wid, lane); S.done(cur); }
#undef PG8_SA
#undef PG8_SB
#undef PG8_STAGE
#undef PG8_LDA
#undef PG8_LDB
#undef PG8_MMA
#undef PG8_WAIT_V
#undef PG8_WAIT_L
#undef PG8_BAR
#undef PG8_SCHED
}
}

#ifndef PG8_SP2
#define PG8_SP2 true
#endif
#ifndef PG8_ALIGN
#define PG8_ALIGN true
#endif
struct EpiProj8 {
    static constexpr bool PERM = true, AFTER_DRAIN = false;
    bf16_t* O; const float* rs; const float* rcos; const float* rsin;
    __device__ __forceinline__ void operator()(const pg8::f32x4 (&acc)[2][2][4][2], const pg8::Unit& u, int wr, int wc, int fr, int fq) const {
        const int row0 = u.pm * 256 + wr * 64 + fr, col0 = u.pn * 256 + wc * 32 + 8 * fq;
        const bool rot = u.pn < 4;
        const float ksc = u.pn >= 2 ? 0.08838834764831845f : 1.f;
#pragma unroll
        for (int ai = 0; ai < 2; ++ai)
#pragma unroll
            for (int m = 0; m < 4; ++m) {
                const int row = row0 + ai * 128 + m * 16;
                const float s = rs[row];
                bf16_t* rowp = O + (size_t)row * NPJ + col0;
                float4 cs = make_float4(1.f, 1.f, 1.f, 1.f), sn = make_float4(0.f, 0.f, 0.f, 0.f);
                float s2 = s;
                if (rot) {
                    const int ti = (row & 2047) * 64 + 16 * wc + 4 * fq;
                    cs = *(const float4*)(rcos + ti);
                    sn = *(const float4*)(rsin + ti);
                    s2 = s * ksc;
                }
#pragma unroll
                for (int bj = 0; bj < 2; ++bj) {
                    const pg8::f32x4 v0 = acc[ai][bj][m][0] * s2, v1 = acc[ai][bj][m][1] * s2;
                    *(uint4*)(rowp + bj * 128) = make_uint4(pk2(v0[0] * cs.x - v0[1] * sn.x, v0[0] * sn.x + v0[1] * cs.x), pk2(v0[2] * cs.y - v0[3] * sn.y, v0[2] * sn.y + v0[3] * cs.y),
                                                            pk2(v1[0] * cs.z - v1[1] * sn.z, v1[0] * sn.z + v1[1] * cs.z), pk2(v1[2] * cs.w - v1[3] * sn.w, v1[2] * sn.w + v1[3] * cs.w));
                }
            }
    }
};
struct EpiX18 {
    static constexpr bool PERM = true, AFTER_DRAIN = false;
    const float* x; bf16_t* x1b; unsigned char* zq; float* rs2p; const float* g2;
    __device__ __forceinline__ void operator()(const pg8::f32x4 (&acc)[2][2][4][2], const pg8::Unit& u, int wr, int wc, int fr, int fq) const {
        const int row0 = u.pm * 256 + wr * 64 + fr, col0 = u.pn * 256 + wc * 32 + 8 * fq;
        float gq[2][8];
#pragma unroll
        for (int bj = 0; bj < 2; ++bj) {
            const float4 a = *(const float4*)(g2 + col0 + bj * 128), b = *(const float4*)(g2 + col0 + bj * 128 + 4);
            gq[bj][0] = a.x; gq[bj][1] = a.y; gq[bj][2] = a.z; gq[bj][3] = a.w; gq[bj][4] = b.x; gq[bj][5] = b.y; gq[bj][6] = b.z; gq[bj][7] = b.w;
        }
        float ssq[8];
#pragma unroll
        for (int ai = 0; ai < 2; ++ai)
#pragma unroll
            for (int m = 0; m < 4; ++m) {
                const size_t ro = (size_t)(row0 + ai * 128 + m * 16) * 1024 + col0;
                float s = 0.f;
#pragma unroll
                for (int bj = 0; bj < 2; ++bj) {
                    const float4 xa = *(const float4*)(x + ro + bj * 128), xb_ = *(const float4*)(x + ro + bj * 128 + 4);
                    const pg8::f32x4 v0 = acc[ai][bj][m][0], v1 = acc[ai][bj][m][1];
                    const float y[8] = {xa.x + v0[0], xa.y + v0[1], xa.z + v0[2], xa.w + v0[3], xb_.x + v1[0], xb_.y + v1[1], xb_.z + v1[2], xb_.w + v1[3]};
                    *(uint4*)(x1b + ro + bj * 128) = make_uint4(pk2(y[0], y[1]), pk2(y[2], y[3]), pk2(y[4], y[5]), pk2(y[6], y[7]));
                    unsigned w2[2] = {0u, 0u};
#pragma unroll
                    for (int e = 0; e < 8; ++e) {
                        s += y[e] * y[e];
                        const float z = fminf(fmaxf(y[e] * gq[bj][e] * (1.f / ZQ_SCALE), -127.f), 127.f);
                        w2[e >> 2] |= ((unsigned)((int)rintf(z) & 255)) << (8 * (e & 3));
                    }
                    *(uint2*)(zq + ro + bj * 128) = make_uint2(w2[0], w2[1]);
                }
                ssq[ai * 4 + m] = s;
            }
        float q4[4], q2[2];
#pragma unroll
        for (int j = 0; j < 4; ++j) {
            const auto r = __builtin_amdgcn_permlane32_swap(__float_as_uint(ssq[j]), __float_as_uint(ssq[j + 4]), false, false);
            q4[j] = __uint_as_float(r[0]) + __uint_as_float(r[1]);
        }
#pragma unroll
        for (int j = 0; j < 2; ++j) {
            const auto r = __builtin_amdgcn_permlane16_swap(__float_as_uint(q4[j]), __float_as_uint(q4[j + 2]), false, false);
            q2[j] = __uint_as_float(r[0]) + __uint_as_float(r[1]);
        }
#pragma unroll
        for (int j = 0; j < 2; ++j) {
            const int r8 = ((fq >> 1) & 1) * 4 + (fq & 1) * 2 + j;
            rs2p[(size_t)(row0 + (r8 >> 2) * 128 + (r8 & 3) * 16) * 16 + u.pn * 4 + wc] = q2[j];
        }
    }
};
template <class Epi, bool ALIGN>
DEVI void st_gemm8(const bf16_t* A, const bf16_t* Bt, int N, int K, char* smem, const Epi& epi) {
    pg8::Gemm g{A, Bt, T_TOK, N, K};
    pg8::StaticOrder S;
    S.init(T_TOK, N, (int)gridDim.x, (int)blockIdx.x);
    pg8::gemm_phase<Epi, pg8::StaticOrder, ALIGN, PG8_SP2>((PG8_LAS unsigned char*)smem, g, S, epi);
}

DEVI void st_conv_qk(const Params& p, char* smem) {
    char* cs = smem;
    char* wqs = smem + 128 * 272;
    char* wks = smem + 2 * 128 * 272;
    const int tid = stid(), lane = tid & 63, wid = tid >> 6, wr = wid >> 1, wc = wid & 1, fr = lane & 15, fq = lane >> 4;
    const int r = tid >> 4, cg = tid & 15;
    int hcur = -1;
    float cw[4][8], cb[8];
    for (int it = blockIdx.x; it < 256 * 4; it += gridDim.x) {
        const int h = it & 3, t0 = (it >> 2) * 128, s0 = t0 & 2047;
        if (h != hcur) {
            __syncthreads();
#pragma unroll
            for (int i = 0; i < 4; ++i) {
                const int id = tid + 512 * i, rr = id >> 4, c = id & 15;
                *(uint4*)(wqs + rr * 272 + c * 16) = *(const uint4*)(p.Wqt + h * 16384 + rr * 128 + c * 8);
                *(uint4*)(wks + rr * 272 + c * 16) = *(const uint4*)(p.Wkt + h * 16384 + rr * 128 + c * 8);
            }
#pragma unroll
            for (int j = 0; j < 4; ++j) {
                const float4 a = *(const float4*)(p.m_conv_w + j * 512 + h * 128 + 8 * cg), b = *(const float4*)(p.m_conv_w + j * 512 + h * 128 + 8 * cg + 4);
                cw[j][0] = a.x; cw[j][1] = a.y; cw[j][2] = a.z; cw[j][3] = a.w; cw[j][4] = b.x; cw[j][5] = b.y; cw[j][6] = b.z; cw[j][7] = b.w;
            }
            { const float4 a = *(const float4*)(p.m_conv_b + h * 128 + 8 * cg), b = *(const float4*)(p.m_conv_b + h * 128 + 8 * cg + 4);
              cb[0] = a.x; cb[1] = a.y; cb[2] = a.z; cb[3] = a.w; cb[4] = b.x; cb[5] = b.y; cb[6] = b.z; cb[7] = b.w; }
            hcur = h;
        }
        const bf16_t* xcol = p.proj + (size_t)t0 * NPJ + 2048 + h * 128 + 8 * cg;
#pragma unroll
        for (int ps = 0; ps < 4; ++ps) {
            const int row = 32 * ps + r;
            uint4 xv[4];
#pragma unroll
            for (int j = 0; j < 4; ++j) {
                const int rj = row - 3 + j;
                xv[j] = (s0 + rj >= 0) ? *(const uint4*)(xcol + (long)rj * NPJ) : make_uint4(0u, 0u, 0u, 0u);
            }
            float y[8];
#pragma unroll
            for (int e = 0; e < 8; ++e) y[e] = cb[e];
#pragma unroll
            for (int j = 0; j < 4; ++j) {
                const unsigned w4[4] = {xv[j].x, xv[j].y, xv[j].z, xv[j].w};
#pragma unroll
                for (int e = 0; e < 4; ++e) { y[2 * e] += cw[j][2 * e] * bflo(w4[e]); y[2 * e + 1] += cw[j][2 * e + 1] * bfhi(w4[e]); }
            }
            unsigned o[4];
#pragma unroll
            for (int e = 0; e < 4; ++e) o[e] = pk2(y[2 * e] * sigmoidf_(y[2 * e]), y[2 * e + 1] * sigmoidf_(y[2 * e + 1]));
            const uint4 ov = make_uint4(o[0], o[1], o[2], o[3]);
            *(uint4*)(cs + row * 272 + cg * 16) = ov;
            *(uint4*)(p.cbuf + (size_t)(t0 + row) * 512 + h * 128 + 8 * cg) = ov;
        }
        __syncthreads();
#pragma unroll
        for (int which = 0; which < 2; ++which) {
            const char* ws = which ? wks : wqs;
            bf16_t* O = which ? p.mk : p.mq;
            f32x4 acc[2][4];
#pragma unroll
            for (int i = 0; i < 2; ++i)
#pragma unroll
                for (int j = 0; j < 4; ++j) acc[i][j] = (f32x4){0.f, 0.f, 0.f, 0.f};
#pragma unroll
            for (int ks = 0; ks < 4; ++ks) {
                bf16x8 a[2], b[4];
#pragma unroll
                for (int i = 0; i < 2; ++i) a[i] = ld8(cs + (wr * 32 + i * 16 + fr) * 272 + (ks * 4 + fq) * 16);
#pragma unroll
                for (int j = 0; j < 4; ++j) b[j] = ld8(ws + (wc * 64 + j * 16 + fr) * 272 + (ks * 4 + fq) * 16);
#pragma unroll
                for (int i = 0; i < 2; ++i)
#pragma unroll
                    for (int j = 0; j < 4; ++j) acc[i][j] = mfma16(b[j], a[i], acc[i][j]);
            }
#pragma unroll
            for (int i = 0; i < 2; ++i)
#pragma unroll
                for (int j = 0; j < 4; ++j) {
                    const int m = t0 + wr * 32 + i * 16 + fr, n = h * 128 + wc * 64 + j * 16 + 4 * fq;
                    const f32x4 v = acc[i][j];
                    *(uint2*)(O + (size_t)m * 512 + n) = make_uint2(pk2(v[0], v[1]), pk2(v[2], v[3]));
                }
        }
        __syncthreads();
    }
}

DEVI bf16x8 u4_to_frag(uint4 u) { union { uint4 u; bf16x8 v; } x; x.u = u; return x.v; }
DEVI void sel_frags(bf16x8 (&sel)[2], int fr, int fq) {
#pragma unroll
    for (int hh = 0; hh < 2; ++hh) {
        const int jstar = fr + 16 * hh - 8 * fq;
        bf16x8 s;
#pragma unroll
        for (int j = 0; j < 8; ++j) s[j] = (j == jstar) ? (short)0x3F80 : (short)0;
        sel[hh] = s;
    }
}
DEVI void tr_store(char* XT, bf16x8 frag, const bf16x8 (&sel)[2], int mi, int ks, int fr, int fq, const float (&sc)[4]) {
#pragma unroll
    for (int hh = 0; hh < 2; ++hh) {
        const f32x4 d = mfma16(frag, sel[hh], (f32x4){0.f, 0.f, 0.f, 0.f});
        *(uint2*)(XT + (32 * ks + 16 * hh + fr) * 144 + (16 * mi + 4 * fq) * 2) = make_uint2(pk2(d[0] * sc[0], d[1] * sc[1]), pk2(d[2] * sc[2], d[3] * sc[3]));
    }
}
DEVI bf16x8 state_pack(const f32x4& a, const f32x4& b) {
    return mk8(make_uint2(pk2(a[0], a[1]), pk2(a[2], a[3])), make_uint2(pk2(b[0], b[1]), pk2(b[2], b[3])));
}
DEVI const float* opaque_ptr(const float* q) { asm volatile("" : "+v"(q)); return q; }
DEVI float opaque_f(float v) { asm volatile("" : "+v"(v)); return v; }
DEVI void lds_barrier() { asm volatile("s_waitcnt lgkmcnt(0)" ::: "memory"); __builtin_amdgcn_s_barrier(); asm volatile("" ::: "memory"); }
DEVI void pin_u4(uint4& a) { asm volatile("" : "+v"(a.x), "+v"(a.y), "+v"(a.z), "+v"(a.w)); }
DEVI float grp8_sum(float v) { v += dpp_f<DPP_XOR1>(v); v += dpp_f<DPP_XOR2>(v); v += dpp_f<DPP_HMIRROR>(v); return v; }

#define ASM_LD16(dst, voff, sbase, imm) asm volatile("global_load_dwordx4 %0, %1, %2 offset:" #imm : "=v"(dst) : "v"(voff), "s"(sbase) : "memory")
#define ASM_LD4(dst, voff, sbase) asm volatile("global_load_dword %0, %1, %2" : "=v"(dst) : "v"(voff), "s"(sbase) : "memory")
typedef unsigned u32x4_t __attribute__((ext_vector_type(4)));
struct RetPre { u32x4_t f[4]; u32x4_t v[2]; u32x4_t g[2]; };
struct RetOff { unsigned f, v0, v1, g; };
DEVI void ret_offsets(RetOff& o, int h, int tid) {
    const int lane = tid & 63, w = tid >> 6, fr = lane & 15, fq = lane >> 4, mi = w & 3;
    o.f = (unsigned)(((16 * mi + fr) * NPJ + (w < 4 ? 512 : 0) + h * 128 + 8 * fq) * 2);
    o.v0 = (unsigned)(((16 * ((2 * w) >> 2) + fr) * NPJ + 1024 + h * 128 + 32 * ((2 * w) & 3) + 8 * fq) * 2);
    o.v1 = (unsigned)(((16 * ((2 * w + 1) >> 2) + fr) * NPJ + 1024 + h * 128 + 32 * ((2 * w + 1) & 3) + 8 * fq) * 2);
    o.g = (unsigned)(((tid >> 3) * NPJ + 1536 + h * 128 + 16 * (tid & 7)) * 2);
}
DEVI void ret_prefetch(const Params& p, RetPre& P, const RetOff& o, int b, int c) {
    const char* base = (const char*)p.proj + (size_t)(b * 2048 + c * 64) * (NPJ * 2);
    ASM_LD16(P.f[0], o.f, base, 0); ASM_LD16(P.f[1], o.f, base, 64); ASM_LD16(P.f[2], o.f, base, 128); ASM_LD16(P.f[3], o.f, base, 192);
    ASM_LD16(P.v[0], o.v0, base, 0); ASM_LD16(P.v[1], o.v1, base, 0);
    ASM_LD16(P.g[0], o.g, base, 0); ASM_LD16(P.g[1], o.g, base, 16);
}
DEVI void ret_retire(RetPre& P) {
    asm volatile("s_waitcnt vmcnt(0)" : "+v"(P.f[0]), "+v"(P.f[1]), "+v"(P.f[2]), "+v"(P.f[3]), "+v"(P.v[0]), "+v"(P.v[1]), "+v"(P.g[0]), "+v"(P.g[1]) :: "memory");
}
DEVI uint4 asu4(const u32x4_t& v) { return make_uint4(v[0], v[1], v[2], v[3]); }
DEVI void ret_block(const Params& p, char* smem, int b, int h) {
    char* qs = smem;
    char* ks_ = smem + 17408;
    char* kTs = smem + 34816;
    char* vTs = smem + 53248;
    char* Ss = smem + 71680;
    char* Os = smem + 80896;
    float* gn_s = (float*)(smem + 98304);
    const int tid = stid(), lane = tid & 63, w = tid >> 6, fr = lane & 15, fq = lane >> 4;
    const float gamma = 1.f - exp2f(-5.f - (float)h);
    const float l2g = log2f(gamma);
    const float g64 = exp2f(l2g * 64.f);
    bf16x8 sel[2];
    sel_frags(sel, fr, fq);
    f32x4 st[8];
#pragma unroll
    for (int i = 0; i < 8; ++i) st[i] = (f32x4){0.f, 0.f, 0.f, 0.f};
    if (tid < 128) gn_s[tid] = p.ret_norm_g[h * 128 + tid];
    __syncthreads();
    RetPre P;
    RetOff RO;
    ret_offsets(RO, h, tid);
    ret_prefetch(p, P, RO, b, 0);
    ret_retire(P);
#pragma unroll 1
    for (int c = 0; c < 32; ++c) {
        const int t0 = b * 2048 + c * 64;
        {
            const int mi = w & 3;
            char* dst = (w < 4 ? ks_ : qs) + (16 * mi + fr) * 272 + fq * 16;
#pragma unroll
            for (int ks = 0; ks < 4; ++ks) *(uint4*)(dst + ks * 64) = asu4(P.f[ks]);
            if (w < 4) {
                float kd[4];
#pragma unroll
                for (int r = 0; r < 4; ++r) kd[r] = exp2f(l2g * (float)(63 - (16 * mi + 4 * fq + r)));
#pragma unroll
                for (int ks = 0; ks < 4; ++ks) tr_store(kTs, u4_to_frag(asu4(P.f[ks])), sel, mi, ks, fr, fq, kd);
            }
            const float one[4] = {1.f, 1.f, 1.f, 1.f};
#pragma unroll
            for (int q = 0; q < 2; ++q) { const int pr = 2 * w + q; tr_store(vTs, u4_to_frag(asu4(P.v[q])), sel, pr >> 2, pr & 3, fr, fq, one); }
        }
        uint4 g0 = asu4(P.g[0]), g1 = asu4(P.g[1]);
        lds_barrier();
        ret_prefetch(p, P, RO, b, c + 1 < 32 ? c + 1 : 31);
        {
            const int lt = w & 3;
            bf16x8 qf[4];
#pragma unroll
            for (int s = 0; s < 4; ++s) qf[s] = ld8(qs + (16 * lt + fr) * 272 + (s * 4 + fq) * 16);
#pragma unroll
            for (int jj = 0; jj < 2; ++jj) {
                const int j = 2 * (w >> 2) + jj;
                f32x4 a = (f32x4){0.f, 0.f, 0.f, 0.f};
#pragma unroll
                for (int s = 0; s < 4; ++s) a = mfma16(ld8(ks_ + (16 * j + fr) * 272 + (s * 4 + fq) * 16), qf[s], a);
                const int l = 16 * lt + fr, mb = 16 * j + 4 * fq;
                float v[4];
#pragma unroll
                for (int r = 0; r < 4; ++r) { const int dd = l - (mb + r); v[r] = a[r] * exp2f(l2g * (float)(dd < 0 ? -dd : dd)); }
                *(uint2*)(Ss + l * 144 + mb * 2) = make_uint2(pk2(v[0], v[1]), pk2(v[2], v[3]));
            }
        }
        lds_barrier();
        {
            bf16x8 sp[4];
#pragma unroll
            for (int s = 0; s < 4; ++s) sp[s] = state_pack(st[2 * s], st[2 * s + 1]);
            bf16x8 vf[2];
#pragma unroll
            for (int s2 = 0; s2 < 2; ++s2) vf[s2] = ld8(vTs + (16 * w + fr) * 144 + (s2 * 4 + fq) * 16);
#pragma unroll
            for (int i = 0; i < 4; ++i) {
                f32x4 a = (f32x4){0.f, 0.f, 0.f, 0.f};
                const char* qrow = qs + (16 * i + fr) * 272;
#pragma unroll
                for (int s = 0; s < 4; ++s) {
                    const uint2 lo = *(const uint2*)(qrow + (32 * s + 4 * fq) * 2), hi = *(const uint2*)(qrow + (32 * s + 16 + 4 * fq) * 2);
                    a = mfma16(sp[s], mk8(lo, hi), a);
                }
                a = a * exp2f(l2g * (float)(16 * i + fr + 1));
#pragma unroll
                for (int s2 = 0; s2 < 2; ++s2) a = mfma16(vf[s2], ld8(Ss + (16 * i + fr) * 144 + (s2 * 4 + fq) * 16), a);
                *(uint2*)(Os + (16 * i + fr) * 272 + (16 * w + 4 * fq) * 2) = make_uint2(pk2(a[0], a[1]), pk2(a[2], a[3]));
            }
#pragma unroll
            for (int i = 0; i < 8; ++i) {
                f32x4 a = st[i] * g64;
#pragma unroll
                for (int s2 = 0; s2 < 2; ++s2) a = mfma16(ld8(kTs + (16 * i + fr) * 144 + (s2 * 4 + fq) * 16), vf[s2], a);
                st[i] = a;
            }
        }
        lds_barrier();
        pin_u4(g0); pin_u4(g1);
        {
            const int l = tid >> 3, part = tid & 7;
            const uint4 o0 = *(const uint4*)(Os + l * 272 + part * 32), o1 = *(const uint4*)(Os + l * 272 + part * 32 + 16);
            const unsigned ow[8] = {o0.x, o0.y, o0.z, o0.w, o1.x, o1.y, o1.z, o1.w}, gw[8] = {g0.x, g0.y, g0.z, g0.w, g1.x, g1.y, g1.z, g1.w};
            float x[16], s = 0.f;
#pragma unroll
            for (int e = 0; e < 8; ++e) { x[2 * e] = bflo(ow[e]); x[2 * e + 1] = bfhi(ow[e]); s += x[2 * e] + x[2 * e + 1]; }
            const float mu = grp8_sum(s) * (1.f / 128.f);
            float q = 0.f;
#pragma unroll
            for (int e = 0; e < 16; ++e) { x[e] -= mu; q += x[e] * x[e]; }
            const float rstd = rsqrtf(grp8_sum(q) * (1.f / 128.f) + EPSN);
            const float* gn = gn_s + 16 * part;
            unsigned yo[8];
#pragma unroll
            for (int e = 0; e < 8; ++e) {
                const float ga = bflo(gw[e]), gb = bfhi(gw[e]);
                yo[e] = pk2(ga * sigmoidf_(ga) * x[2 * e] * rstd * gn[2 * e], gb * sigmoidf_(gb) * x[2 * e + 1] * rstd * gn[2 * e + 1]);
            }
            ret_retire(P);
            uint4* yp = (uint4*)(p.yb + (size_t)(t0 + l) * 1024 + h * 128 + 16 * part);
            yp[0] = make_uint4(yo[0], yo[1], yo[2], yo[3]);
            yp[1] = make_uint4(yo[4], yo[5], yo[6], yo[7]);
        }
    }
}

struct MlPre { u32x4_t f[4]; u32x4_t v[2]; u32x4_t o[2]; u32x4_t cc[2]; };
struct MlOff { unsigned f, v0, v1, o, c, g; };
DEVI void ml_offsets(const Params& p, MlOff& o, int h, int tid) {
    const int lane = tid & 63, w = tid >> 6, fr = lane & 15, fq = lane >> 4, mi = w & 3;
    const unsigned kdiff = (unsigned)((const char*)p.mk - (const char*)p.mq);
    o.f = (unsigned)(((16 * mi + fr) * 512 + h * 128 + 8 * fq) * 2) + (w < 4 ? kdiff : 0u);
    o.v0 = (unsigned)(((16 * ((2 * w) >> 2) + fr) * NPJ + 2560 + h * 128 + 32 * ((2 * w) & 3) + 8 * fq) * 2);
    o.v1 = (unsigned)(((16 * ((2 * w + 1) >> 2) + fr) * NPJ + 2560 + h * 128 + 32 * ((2 * w + 1) & 3) + 8 * fq) * 2);
    o.o = (unsigned)(((tid >> 3) * NPJ + 3072 + h * 128 + 16 * (tid & 7)) * 2);
    o.c = (unsigned)(((tid >> 3) * 512 + h * 128 + 16 * (tid & 7)) * 2);
    o.g = (unsigned)((lane * 4 + h) * 4);
}
DEVI void ml_prefetch(const Params& p, MlPre& P, const MlOff& o, int b, int c) {
    const size_t t0 = (size_t)(b * 2048 + c * 64);
    const char* bq = (const char*)p.mq + t0 * 1024, *bp = (const char*)p.proj + t0 * (NPJ * 2), *bc = (const char*)p.cbuf + t0 * 1024;
    ASM_LD16(P.f[0], o.f, bq, 0); ASM_LD16(P.f[1], o.f, bq, 64); ASM_LD16(P.f[2], o.f, bq, 128); ASM_LD16(P.f[3], o.f, bq, 192);
    ASM_LD16(P.v[0], o.v0, bp, 0); ASM_LD16(P.v[1], o.v1, bp, 0);
    ASM_LD16(P.o[0], o.o, bp, 0); ASM_LD16(P.o[1], o.o, bp, 16);
    ASM_LD16(P.cc[0], o.c, bc, 0); ASM_LD16(P.cc[1], o.c, bc, 16);
}
DEVI void ml_retire(MlPre& P) {
    asm volatile("s_waitcnt vmcnt(0)" : "+v"(P.f[0]), "+v"(P.f[1]), "+v"(P.f[2]), "+v"(P.f[3]), "+v"(P.v[0]), "+v"(P.v[1]), "+v"(P.o[0]), "+v"(P.o[1]),
                 "+v"(P.cc[0]), "+v"(P.cc[1]) :: "memory");
}
DEVI void mlstm_block(const Params& p, char* smem, int b, int h) {
    char* qs = smem;
    char* kTs = smem + 17408;
    char* vTs = smem + 35840;
    char* Os = smem + 54272;
    float* n_s = (float*)(smem + 71680);
    float* den_s = (float*)(smem + 72192);
    float* gn_s = (float*)(smem + 72448);
    float* sk_s = gn_s + 128;
    float* lw_s = sk_s + 128;
    float* ac_s = lw_s + 32 * 64;
    float* mi_s = ac_s + 32;
    const int tid = stid(), lane = tid & 63, w = tid >> 6, fr = lane & 15, fq = lane >> 4;
    bf16x8 sel[2];
    sel_frags(sel, fr, fq);
    f32x4 st[8];
#pragma unroll
    for (int i = 0; i < 8; ++i) st[i] = (f32x4){0.f, 0.f, 0.f, 0.f};
    float m_run = 0.f;
    f32x4 nacc = (f32x4){0.f, 0.f, 0.f, 0.f};
    bf16x8 ones;
#pragma unroll
    for (int j = 0; j < 8; ++j) ones[j] = (short)0x3F80;
    if (tid < 128) { gn_s[tid] = p.m_norm_g[h * 128 + tid]; sk_s[tid] = p.m_skip[h * 128 + tid]; }
#pragma unroll
    for (int q = 0; q < 4; ++q) {
        const int cc = 4 * w + q, tt = b * 2048 + cc * 64 + lane;
        const float iv = p.ipre[tt * 4 + h], fv = p.logf[tt * 4 + h];
        float fcum = fv;
#pragma unroll
        for (int o = 1; o < 64; o <<= 1) { const float tv = __shfl_up(fcum, o); if (lane >= o) fcum += tv; }
        const float a_c = __shfl(fcum, 63);
        const float logw = a_c - fcum + iv;
        const float m_in = wave_max(logw);
        lw_s[cc * 64 + lane] = logw;
        if (lane == 0) { ac_s[cc] = a_c; mi_s[cc] = m_in; }
    }
    __syncthreads();
    MlPre P;
    MlOff MO;
    ml_offsets(p, MO, h, tid);
    ml_prefetch(p, P, MO, b, 0);
    ml_retire(P);
#pragma unroll 1
    for (int c = 0; c < 32; ++c) {
        const int t0 = b * 2048 + c * 64;
        const float a_c = ac_s[c], m_in = mi_s[c], logw = lw_s[c * 64 + lane];
        const float m_new = fmaxf(a_c + m_run, m_in);
        const float decay = fexp_(a_c + m_run - m_new);
        const float wgt = fexp_(logw - m_new);
        const float emn = fexp_(-m_new);
        m_run = m_new;
        {
            const int mi = w & 3;
            if (w < 4) {
                float kw[4];
#pragma unroll
                for (int r = 0; r < 4; ++r) kw[r] = __shfl(wgt, 16 * mi + 4 * fq + r);
#pragma unroll
                for (int ks = 0; ks < 4; ++ks) tr_store(kTs, u4_to_frag(asu4(P.f[ks])), sel, mi, ks, fr, fq, kw);
            } else {
                char* dst = qs + (16 * mi + fr) * 272 + fq * 16;
#pragma unroll
                for (int ks = 0; ks < 4; ++ks) *(uint4*)(dst + ks * 64) = asu4(P.f[ks]);
            }
            const float one[4] = {1.f, 1.f, 1.f, 1.f};
#pragma unroll
            for (int q = 0; q < 2; ++q) { const int pr = 2 * w + q; tr_store(vTs, u4_to_frag(asu4(P.v[q])), sel, pr >> 2, pr & 3, fr, fq, one); }
        }
        uint4 mo0 = asu4(P.o[0]), mo1 = asu4(P.o[1]), cc0 = asu4(P.cc[0]), cc1 = asu4(P.cc[1]);
        lds_barrier();
        ml_prefetch(p, P, MO, b, c + 1 < 32 ? c + 1 : 31);
        {
            f32x4 a = nacc * decay;
#pragma unroll
            for (int s2 = 0; s2 < 2; ++s2) a = mfma16(ld8(kTs + (16 * w + fr) * 144 + (s2 * 4 + fq) * 16), ones, a);
            nacc = a;
            if (fr == 0) *(f32x4*)(n_s + 16 * w + 4 * fq) = a;
        }
        {
            bf16x8 vf[2];
#pragma unroll
            for (int s2 = 0; s2 < 2; ++s2) vf[s2] = ld8(vTs + (16 * w + fr) * 144 + (s2 * 4 + fq) * 16);
#pragma unroll
            for (int i = 0; i < 8; ++i) {
                f32x4 a = st[i] * decay;
#pragma unroll
                for (int s2 = 0; s2 < 2; ++s2) a = mfma16(ld8(kTs + (16 * i + fr) * 144 + (s2 * 4 + fq) * 16), vf[s2], a);
                st[i] = a;
            }
        }
        lds_barrier();
        {
            const int l = tid >> 3, part = tid & 7;
            const uint4 a0 = *(const uint4*)(qs + l * 272 + part * 32), a1 = *(const uint4*)(qs + l * 272 + part * 32 + 16);
            const unsigned aw[8] = {a0.x, a0.y, a0.z, a0.w, a1.x, a1.y, a1.z, a1.w};
            const float* nn = n_s + 16 * part;
            float s = 0.f;
#pragma unroll
            for (int e = 0; e < 8; ++e) s += bflo(aw[e]) * nn[2 * e] + bfhi(aw[e]) * nn[2 * e + 1];
            s = grp8_sum(s);
            if (part == 0) den_s[l] = fmaxf(fabsf(s), emn);
        }
        lds_barrier();
        {
            bf16x8 sp[4];
#pragma unroll
            for (int s = 0; s < 4; ++s) sp[s] = state_pack(st[2 * s], st[2 * s + 1]);
#pragma unroll
            for (int i = 0; i < 4; ++i) {
                f32x4 a = (f32x4){0.f, 0.f, 0.f, 0.f};
                const char* qrow = qs + (16 * i + fr) * 272;
#pragma unroll
                for (int s = 0; s < 4; ++s) {
                    const uint2 lo = *(const uint2*)(qrow + (32 * s + 4 * fq) * 2), hi = *(const uint2*)(qrow + (32 * s + 16 + 4 * fq) * 2);
                    a = mfma16(sp[s], mk8(lo, hi), a);
                }
                const float rd = rcp_(den_s[16 * i + fr]);
                *(uint2*)(Os + (16 * i + fr) * 272 + (16 * w + 4 * fq) * 2) = make_uint2(pk2(a[0] * rd, a[1] * rd), pk2(a[2] * rd, a[3] * rd));
            }
        }
        lds_barrier();
        pin_u4(mo0); pin_u4(mo1); pin_u4(cc0); pin_u4(cc1);
        {
            const int l = tid >> 3, part = tid & 7;
            const uint4 o0 = *(const uint4*)(Os + l * 272 + part * 32), o1 = *(const uint4*)(Os + l * 272 + part * 32 + 16);
            const unsigned ow[8] = {o0.x, o0.y, o0.z, o0.w, o1.x, o1.y, o1.z, o1.w};
            const unsigned gw[8] = {mo0.x, mo0.y, mo0.z, mo0.w, mo1.x, mo1.y, mo1.z, mo1.w}, cw[8] = {cc0.x, cc0.y, cc0.z, cc0.w, cc1.x, cc1.y, cc1.z, cc1.w};
            float x[16], s = 0.f;
#pragma unroll
            for (int e = 0; e < 8; ++e) { x[2 * e] = bflo(ow[e]); x[2 * e + 1] = bfhi(ow[e]); s += x[2 * e] + x[2 * e + 1]; }
            const float mu = grp8_sum(s) * (1.f / 128.f);
            float q = 0.f;
#pragma unroll
            for (int e = 0; e < 16; ++e) { x[e] -= mu; q += x[e] * x[e]; }
            const float rstd = rsqrtf(grp8_sum(q) * (1.f / 128.f) + EPSN);
            const float* gn = gn_s + 16 * part;
            const float* sk = sk_s + 16 * part;
            unsigned yo[8];
#pragma unroll
            for (int e = 0; e < 8; ++e) {
                const float ya = sigmoidf_(bflo(gw[e])) * (x[2 * e] * rstd * gn[2 * e] + sk[2 * e] * bflo(cw[e]));
                const float yb_ = sigmoidf_(bfhi(gw[e])) * (x[2 * e + 1] * rstd * gn[2 * e + 1] + sk[2 * e + 1] * bfhi(cw[e]));
                yo[e] = pk2(ya, yb_);
            }
            ml_retire(P);
            uint4* yp = (uint4*)(p.yb + (size_t)(t0 + l) * 1024 + 512 + h * 128 + 16 * part);
            yp[0] = make_uint4(yo[0], yo[1], yo[2], yo[3]);
            yp[1] = make_uint4(yo[4], yo[5], yo[6], yo[7]);
        }
    }
}
DEVI void st_recur(const Params& p, char* smem) {
    if (blockIdx.x >= 128 || gridDim.x <= 128) {
        const int bid = gridDim.x > 128 ? (int)blockIdx.x - 128 : (int)blockIdx.x, nb = gridDim.x > 128 ? (int)gridDim.x - 128 : (int)gridDim.x;
        st_prep_w2(p, smem, bid, nb);
        st_prep_wsub(p, smem, bid, nb);
        st_prep_tables(p, bid, nb);
        if (gridDim.x > 128) return;
    }
    for (int bi = blockIdx.x; bi < 128; bi += gridDim.x) {
        const int kind = bi & 1, h = (bi >> 1) & 3, b = bi >> 3;
        if (kind == 0) ret_block(p, smem, b, h);
        else mlstm_block(p, smem, b, h);
        __syncthreads();
    }
}

constexpr float KEY_BIAS = 64.f;
DEVI int f2key(float f) { const int b = __float_as_int(f); return b ^ ((b >> 31) & 0x7fffffff); }
DEVI float key2f(int k) { return __int_as_float(k ^ ((k >> 31) & 0x7fffffff)); }
template <int N> DEVI void bsort_desc(int (&v)[N]) {
#pragma unroll
    for (int k = 2; k <= N; k <<= 1)
#pragma unroll
        for (int j = k >> 1; j > 0; j >>= 1)
#pragma unroll
            for (int i = 0; i < N; ++i) {
                const int l = i ^ j;
                if (l > i) {
                    const int a = v[i], b = v[l];
                    const int mx = a > b ? a : b, mn = a > b ? b : a;
                    if ((i & k) == 0) { v[i] = mx; v[l] = mn; } else { v[i] = mn; v[l] = mx; }
                }
            }
}
template <int N> DEVI void bmerge_desc(int (&v)[N]) {
#pragma unroll
    for (int j = N >> 1; j > 0; j >>= 1)
#pragma unroll
        for (int i = 0; i < N; ++i) {
            const int l = i ^ j;
            if (l > i) { const int a = v[i], b = v[l]; v[i] = a > b ? a : b; v[l] = a > b ? b : a; }
        }
}
DEVI void xmerge16(int (&v)[16], int mask) {
    int o[16];
#pragma unroll
    for (int i = 0; i < 16; ++i) o[i] = __shfl_xor(v[15 - i], mask);
#pragma unroll
    for (int i = 0; i < 16; ++i) v[i] = v[i] > o[i] ? v[i] : o[i];
    bmerge_desc<16>(v);
}
__device__ const unsigned char cand_tab[52] = {
    0x00, 0x01, 0x02, 0x03, 0x04, 0x05, 0x06, 0x07, 0x08, 0x09, 0x0a, 0x0b, 0x0c, 0x0d, 0x0e, 0x0f,
    0x10, 0x11, 0x12, 0x13, 0x14, 0x15, 0x16, 0x17, 0x20, 0x21, 0x22, 0x23, 0x24, 0x30, 0x31, 0x32, 0x33,
    0x40, 0x41, 0x42, 0x50, 0x51, 0x60, 0x61, 0x70, 0x71, 0x80, 0x90, 0xa0, 0xb0, 0xc0, 0xd0, 0xe0, 0xf0, 0xff, 0xff};
constexpr int H_A = 256 * 64, H_B = 256 * 64, H_STAGE = H_A + H_B;
constexpr int H_LIST = 3 * H_STAGE;
DEVI void glds16(const void* g, char* l) {
    __builtin_amdgcn_global_load_lds((const __attribute__((address_space(1))) unsigned*)g, (__attribute__((address_space(3))) unsigned*)l, 16, 0, 0);
}
DEVI void gemm3_topk_tile(const Params& p, int m0, int h, char* smem) {
    const int tid = stid(), lane = tid & 63, w = tid >> 6, wt = w >> 1, wp = w & 1, fr = lane & 15, fq = lane >> 4;
    i32x4 acc[4][8];
#pragma unroll
    for (int i = 0; i < 4; ++i)
#pragma unroll
        for (int j = 0; j < 8; ++j) acc[i][j] = (i32x4){0, 0, 0, 0};
    const int r16 = lane >> 2, csrc = (lane & 3) ^ ((r16 >> 2) & 3);
    const unsigned char* srcA = p.xq + (size_t)(m0 + w * 32 + r16) * 1024 + csrc * 16;
    const unsigned char* srcB = (const unsigned char*)p.Wsubq + ((size_t)h * 256 + w * 32 + r16) * 1024 + csrc * 16;
    char* dstA = smem + (w * 32) * 64 + lane * 16;
    char* dstB = smem + H_A + (w * 32) * 64 + lane * 16;
    auto issue = [&](int kt, int buf) {
#pragma unroll
        for (int q = 0; q < 2; ++q) glds16(srcA + (size_t)q * 16 * 1024 + kt * 64, dstA + buf * H_STAGE + q * 1024);
#pragma unroll
        for (int q = 0; q < 2; ++q) glds16(srcB + (size_t)q * 16 * 1024 + kt * 64, dstB + buf * H_STAGE + q * 1024);
    };
    const int rdoff = fr * 64 + ((fq ^ ((fr >> 2) & 3)) * 16);
    issue(0, 0);
    issue(1, 1);
    asm volatile("s_waitcnt vmcnt(4)" ::: "memory");
    __builtin_amdgcn_s_barrier();
    int buf = 0;
#pragma unroll 1
    for (int kt = 0; kt < 16; ++kt) {
        const int b2 = buf >= 1 ? buf - 1 : 2;
        if (kt + 2 < 16) issue(kt + 2, b2);
        const char* As = smem + buf * H_STAGE + (wt * 64) * 64 + rdoff;
        const char* Bs = smem + buf * H_STAGE + H_A + (wp * 128) * 64 + rdoff;
        i32x4 a[4];
#pragma unroll
        for (int i = 0; i < 4; ++i) a[i] = *(const i32x4*)(As + (16 * i) * 64);
#pragma unroll
        for (int jg = 0; jg < 2; ++jg) {
            i32x4 b[4];
#pragma unroll
            for (int j = 0; j < 4; ++j) b[j] = *(const i32x4*)(Bs + (16 * (4 * jg + j)) * 64);
#pragma unroll
            for (int i = 0; i < 4; ++i)
#pragma unroll
                for (int j = 0; j < 4; ++j) acc[i][4 * jg + j] = __builtin_amdgcn_mfma_i32_16x16x64_i8(b[j], a[i], acc[i][4 * jg + j], 0, 0, 0);
        }
        if (kt + 2 < 16) asm volatile("s_waitcnt vmcnt(4)" ::: "memory");
        else asm volatile("s_waitcnt vmcnt(0)" ::: "memory");
        __builtin_amdgcn_s_barrier();
        buf = buf == 2 ? 0 : buf + 1;
    }
    float4 ws[8];
#pragma unroll
    for (int j = 0; j < 8; ++j) ws[j] = *(const float4*)(p.wsc + h * 256 + wp * 128 + 16 * j + 4 * fq);
    int* LX = (int*)(smem + H_LIST);
#pragma unroll
    for (int i = 0; i < 4; ++i) {
        const int tl = 64 * wt + 16 * i + fr;
        const float rs = rs2_of(p.rs2p, m0 + tl) * ZQ_SCALE;
        int ka[16], kb[16];
#pragma unroll
        for (int jj = 0; jj < 4; ++jj)
#pragma unroll
            for (int r = 0; r < 4; ++r) {
                const float sa = r == 0 ? ws[jj].x : r == 1 ? ws[jj].y : r == 2 ? ws[jj].z : ws[jj].w;
                const float sb = r == 0 ? ws[4 + jj].x : r == 1 ? ws[4 + jj].y : r == 2 ? ws[4 + jj].z : ws[4 + jj].w;
                ka[jj * 4 + r] = (__float_as_int((float)acc[i][jj][r] * (sa * rs) + KEY_BIAS) & ~127) | (16 * jj + 4 * fq + r);
                kb[jj * 4 + r] = (__float_as_int((float)acc[i][4 + jj][r] * (sb * rs) + KEY_BIAS) & ~127) | (16 * (jj + 4) + 4 * fq + r);
            }
        bsort_desc<16>(ka);
        bsort_desc<16>(kb);
#pragma unroll
        for (int q = 0; q < 16; ++q) ka[q] = ka[q] > kb[15 - q] ? ka[q] : kb[15 - q];
        bmerge_desc<16>(ka);
        xmerge16(ka, 16);
        xmerge16(ka, 32);
        const int k0 = fq == 0 ? ka[0] : fq == 1 ? ka[4] : fq == 2 ? ka[8] : ka[12];
        const int k1 = fq == 0 ? ka[1] : fq == 1 ? ka[5] : fq == 2 ? ka[9] : ka[13];
        const int k2 = fq == 0 ? ka[2] : fq == 1 ? ka[6] : fq == 2 ? ka[10] : ka[14];
        const int k3 = fq == 0 ? ka[3] : fq == 1 ? ka[7] : fq == 2 ? ka[11] : ka[15];
        *(int4*)(LX + tl * 32 + wp * 16 + 4 * fq) = make_int4(k0, k1, k2, k3);
    }
    __syncthreads();
#pragma unroll
    for (int i2 = 0; i2 < 2; ++i2) {
        const int tl = 32 * w + 16 * i2 + fr, t = m0 + tl;
        const int* L = LX + tl * 32;
        const unsigned long long clo = fq == 0 ? 0x0706050403020100ull : fq == 1 ? 0x14131211100f0e0dull : fq == 2 ? 0x4033323130242322ull : 0xc0b0a09080717061ull;
        const unsigned long long chi = fq == 0 ? 0x0c0b0a0908ull : fq == 1 ? 0x2120171615ull : fq == 2 ? 0x6051504241ull : 0xfffff0e0d0ull;
        int c[16];
#pragma unroll
        for (int s = 0; s < 13; ++s) {
            const int ab = (int)((s < 8 ? (clo >> (8 * s)) : (chi >> (8 * (s - 8)))) & 0xffull);
            const int k1 = L[ab >> 4], k2 = L[16 + (ab & 15)];
            const float v = (__int_as_float(k1 & ~127) - KEY_BIAS) + (__int_as_float(k2 & ~127) - KEY_BIAS);
            c[s] = (f2key(v) & ~0x3fff) | ((k1 & 127) << 7) | (k2 & 127);
        }
        c[13] = c[14] = c[15] = (int)0x80000000;
        bsort_desc<16>(c);
        xmerge16(c, 16);
        xmerge16(c, 32);
        const float vmax = key2f(c[0] & ~0x3fff);
        float e[16], sum = 0.f;
#pragma unroll
        for (int q = 0; q < 16; ++q) { e[q] = fexp_(key2f(c[q] & ~0x3fff) - vmax); sum += e[q]; }
        const float inv = rcp_(sum);
        int ce[4]; float ge[4];
#pragma unroll
        for (int q = 0; q < 4; ++q) {
            const int cq = fq == 0 ? c[q] : fq == 1 ? c[4 + q] : fq == 2 ? c[8 + q] : c[12 + q];
            const float eq = fq == 0 ? e[q] : fq == 1 ? e[4 + q] : fq == 2 ? e[8 + q] : e[12 + q];
            ce[q] = ((cq >> 7) & 127) * 128 + (cq & 127);
            ge[q] = eq * inv;
        }
        *(uint2*)(p.eperm + (size_t)t * 128 + h * 16 + 4 * fq) = make_uint2((unsigned)ce[0] | ((unsigned)ce[1] << 16), (unsigned)ce[2] | ((unsigned)ce[3] << 16));
        *(float4*)(p.gate + (size_t)t * 128 + h * 16 + 4 * fq) = make_float4(ge[0], ge[1], ge[2], ge[3]);
    }
    __syncthreads();
}
DEVI void st_gemm3_topk(const Params& p, char* smem) {
    for (int it = blockIdx.x; it < 128 * 8; it += gridDim.x) gemm3_topk_tile(p, (it >> 3) * 256, it & 7, smem);
}

#define XB_TMO      128
#define XB_XCNT(j)  (256  + 64 * (j))
#define XB_XSUB(j)  (1280 + 64 * (j))
#define XB_XGEN(j)  (2304 + 64 * (j))
#define XB_TOP      3328
#define XB_TOPGEN   3392
#define XCD_BAR_WORDS 3456
#define XB_SPIN_CAP (1u << 20)
#define LAS __attribute__((address_space(3)))
DEVI unsigned xb_ld(unsigned* p) { return __hip_atomic_load(p, __ATOMIC_RELAXED, __HIP_MEMORY_SCOPE_AGENT); }
DEVI unsigned xb_add(unsigned* p, unsigned v) { return __hip_atomic_fetch_add(p, v, __ATOMIC_RELAXED, __HIP_MEMORY_SCOPE_AGENT); }
DEVI unsigned xb_xcc_id() { return (unsigned)__builtin_amdgcn_s_getreg((3 << 11) | 20) & 0xFu; }
#define XB_SPIN(cond, bar) do { unsigned _sp = 0; while (cond) { __builtin_amdgcn_s_sleep(1); \
    if ((++_sp & 255u) == 0u) { if (xb_ld(&(bar)[XB_TMO])) break; if (_sp > XB_SPIN_CAP) { atomicAdd(&(bar)[XB_TMO], 1u); break; } } } } while (0)
struct XcdBarrier { unsigned* bar; unsigned x; volatile LAS unsigned* st; };
DEVI XcdBarrier xcd_barrier_post(unsigned* bar, volatile LAS unsigned* st) {
    XcdBarrier b; b.bar = bar; b.x = xb_xcc_id(); b.st = st;
    if (stid() == 0) (void)xb_add(&bar[XB_XCNT(b.x)], 1u);
    return b;
}
DEVI void xcd_barrier_complete(unsigned* bar, unsigned x, unsigned& nloc, unsigned& nx) {
    const unsigned G = gridDim.x * gridDim.y * gridDim.z;
    unsigned sum, cnt, mine, sp = 0u;
    for (;;) {
        sum = 0u; cnt = 0u; mine = 0u;
#pragma unroll
        for (unsigned j = 0; j < 16; ++j) { const unsigned c = xb_ld(&bar[XB_XCNT(j)]); sum += c; cnt += (c > 0u) ? 1u : 0u; mine = (j == x) ? c : mine; }
        if (sum == G) break;
        __builtin_amdgcn_s_sleep(1);
        if ((++sp & 255u) == 0u) { if (xb_ld(&bar[XB_TMO])) break; if (sp > XB_SPIN_CAP) { atomicAdd(&bar[XB_TMO], 1u); break; } }
    }
    nloc = mine > 0u ? mine : 1u; nx = cnt > 0u ? cnt : 1u;
}
DEVI void xcd_barrier(const XcdBarrier& b) {
    asm volatile("s_waitcnt vmcnt(0)" ::: "memory");
    __syncthreads();
    if (stid() == 0) {
        unsigned* bar = b.bar;
        __builtin_amdgcn_s_waitcnt(0);
        unsigned nloc = b.st[0], nx = b.st[1];
        if (nloc == 0u) { xcd_barrier_complete(bar, b.x, nloc, nx); b.st[0] = nloc; b.st[1] = nx; }
        const unsigned old = xb_add(&bar[XB_XSUB(b.x)], 1u);
        const unsigned gen = old / nloc;
        if (old + 1u == (gen + 1u) * nloc) {
            __builtin_amdgcn_fence(__ATOMIC_RELEASE, "agent");
            asm volatile("s_waitcnt vmcnt(0)" ::: "memory");
            const unsigned og = xb_add(&bar[XB_TOP], 1u);
            const unsigned tg = og / nx;
            if (og + 1u == (tg + 1u) * nx) xb_add(&bar[XB_TOPGEN], 1u);
            else XB_SPIN(xb_ld(&bar[XB_TOPGEN]) == tg, bar);
            __builtin_amdgcn_fence(__ATOMIC_ACQUIRE, "agent");
            xb_add(&bar[XB_XGEN(b.x)], 1u);
            asm volatile("s_waitcnt vmcnt(0)" ::: "memory");
        } else {
            XB_SPIN(xb_ld(&bar[XB_XGEN(b.x)]) == gen, bar);
            __builtin_amdgcn_fence(__ATOMIC_ACQUIRE, "agent");
            asm volatile("s_waitcnt vmcnt(0)" ::: "memory");
        }
    }
    __syncthreads();
}

#define CTR_A(x) (XCD_BAR_WORDS + 64 * (x))
#define CTR_B(x) (XCD_BAR_WORDS + 512 + 64 * (x))
#define CTL_WORDS (XCD_BAR_WORDS + 1024)
typedef float f32x2 __attribute__((ext_vector_type(2)));
DEVI float ub(unsigned w, int n) { return (float)((w >> (8 * n)) & 0xffu); }
DEVI float gelu_erf(float u) { return 0.5f * u * (1.f + erff(u * 0.70710678118654752f)); }
struct ExpMeta { uint4 e[2]; uint4 xa; float sc; };
struct ExpRows { uint4 r[16]; unsigned x1; };

template <int PHASE> DEVI void exp_load_meta(const Params& p, ExpMeta& m, int t, int x, int lane) {
    const uint4* ep = (const uint4*)(p.eperm + (size_t)t * 128 + (lane >> 3) * 16);
    m.e[0] = ep[0];
    m.e[1] = ep[1];
    if (PHASE == 0) m.xa = *(const uint4*)(p.xq + (size_t)t * 1024 + 128 * x + 16 * (lane & 7));
    else { m.xa = *(const uint4*)(p.aq + (size_t)t * 128 + (lane >> 3) * 16); m.sc = p.asc[t]; }
}
template <int PHASE> DEVI void exp_issue(const Params& p, const ExpMeta& m, ExpRows& R, int t, int x, int lane) {
    const unsigned char* base = (PHASE == 0 ? p.down_q : p.up_q) + (size_t)x * (16384 * 128) + (lane & 7) * 16;
    const unsigned ew[8] = {m.e[0].x, m.e[0].y, m.e[0].z, m.e[0].w, m.e[1].x, m.e[1].y, m.e[1].z, m.e[1].w};
#pragma unroll
    for (int j = 0; j < 16; ++j) {
        const unsigned ek = (j & 1) ? (ew[j >> 1] >> 16) : (ew[j >> 1] & 0xffffu);
        R.r[j] = *(const uint4*)(base + (size_t)ek * 128);
    }
    if (PHASE == 1) {
        const int col = 128 * x + 16 * (lane & 7) + ((lane & 32) ? 8 : 0) + ((lane & 16) ? 4 : 0) + ((lane & 8) ? 2 : 0);
        R.x1 = *(const unsigned*)(p.x1b + (size_t)t * 1024 + col);
    }
}
DEVI void expA_compute(const Params& p, const ExpMeta& m, const ExpRows& R, int t, int x, int lane) {
    const bool b2 = lane & 4, b1 = lane & 2, b0 = lane & 1;
    int ps[16];
#pragma unroll
    for (int j = 0; j < 16; ++j)
        ps[j] = __builtin_amdgcn_sdot4((int)R.r[j].x, (int)m.xa.x, __builtin_amdgcn_sdot4((int)R.r[j].y, (int)m.xa.y,
                __builtin_amdgcn_sdot4((int)R.r[j].z, (int)m.xa.z, __builtin_amdgcn_sdot4((int)R.r[j].w, (int)m.xa.w, 0, false), false), false), false);
    int q8[8], q4[4], q2[2];
#pragma unroll
    for (int j = 0; j < 8; ++j) { const int snd = b2 ? ps[j] : ps[j + 8], kp = b2 ? ps[j + 8] : ps[j]; q8[j] = kp + dpp_i<DPP_HMIRROR>(snd); }
#pragma unroll
    for (int j = 0; j < 4; ++j) { const int snd = b1 ? q8[j] : q8[j + 4], kp = b1 ? q8[j + 4] : q8[j]; q4[j] = kp + dpp_i<DPP_XOR2>(snd); }
#pragma unroll
    for (int j = 0; j < 2; ++j) { const int snd = b0 ? q4[j] : q4[j + 2], kp = b0 ? q4[j + 2] : q4[j]; q2[j] = kp + dpp_i<DPP_XOR1>(snd); }
    {
        int s0 = q2[0] >> 3, s1 = q2[1] >> 3;
        s0 = s0 > 32767 ? 32767 : (s0 < -32768 ? -32768 : s0);
        s1 = s1 > 32767 ? 32767 : (s1 < -32768 ? -32768 : s1);
        *(unsigned*)(p.part + ((size_t)x * T_TOK + t) * 128 + 2 * lane) = ((unsigned)s0 & 0xffffu) | ((unsigned)s1 << 16);
    }
}
DEVI void expB_compute(const Params& p, const ExpMeta& m, const ExpRows& R, int t, int x, int lane) {
    const bool b5 = lane & 32, b4 = lane & 16, b3 = lane & 8;
    const unsigned pa[4] = {m.xa.x, m.xa.y, m.xa.z, m.xa.w};
    int acc[16];
#pragma unroll
    for (int c = 0; c < 16; ++c) acc[c] = 0;
#pragma unroll
    for (int g = 0; g < 4; ++g) {
        const unsigned r0[4] = {R.r[4 * g].x, R.r[4 * g].y, R.r[4 * g].z, R.r[4 * g].w};
        const unsigned r1[4] = {R.r[4 * g + 1].x, R.r[4 * g + 1].y, R.r[4 * g + 1].z, R.r[4 * g + 1].w};
        const unsigned r2[4] = {R.r[4 * g + 2].x, R.r[4 * g + 2].y, R.r[4 * g + 2].z, R.r[4 * g + 2].w};
        const unsigned r3[4] = {R.r[4 * g + 3].x, R.r[4 * g + 3].y, R.r[4 * g + 3].z, R.r[4 * g + 3].w};
#pragma unroll
        for (int i = 0; i < 4; ++i) {
            const unsigned t0 = __builtin_amdgcn_perm(r1[i], r0[i], 0x05010400u), t1 = __builtin_amdgcn_perm(r1[i], r0[i], 0x07030602u);
            const unsigned t2 = __builtin_amdgcn_perm(r3[i], r2[i], 0x05010400u), t3 = __builtin_amdgcn_perm(r3[i], r2[i], 0x07030602u);
            const unsigned o0 = __builtin_amdgcn_perm(t2, t0, 0x05040100u), o1 = __builtin_amdgcn_perm(t2, t0, 0x07060302u);
            const unsigned o2 = __builtin_amdgcn_perm(t3, t1, 0x05040100u), o3 = __builtin_amdgcn_perm(t3, t1, 0x07060302u);
            acc[4 * i + 0] = __builtin_amdgcn_sdot4((int)o0, (int)pa[g], acc[4 * i + 0], false);
            acc[4 * i + 1] = __builtin_amdgcn_sdot4((int)o1, (int)pa[g], acc[4 * i + 1], false);
            acc[4 * i + 2] = __builtin_amdgcn_sdot4((int)o2, (int)pa[g], acc[4 * i + 2], false);
            acc[4 * i + 3] = __builtin_amdgcn_sdot4((int)o3, (int)pa[g], acc[4 * i + 3], false);
        }
    }
    int q8[8], q4[4], q2[2];
#pragma unroll
    for (int j = 0; j < 8; ++j) {
        const auto r = __builtin_amdgcn_permlane32_swap((unsigned)acc[j], (unsigned)acc[j + 8], false, false);
        q8[j] = (int)r[0] + (int)r[1];
    }
#pragma unroll
    for (int j = 0; j < 4; ++j) {
        const auto r = __builtin_amdgcn_permlane16_swap((unsigned)q8[j], (unsigned)q8[j + 4], false, false);
        q4[j] = (int)r[0] + (int)r[1];
    }
#pragma unroll
    for (int j = 0; j < 2; ++j) { const int snd = b3 ? q4[j] : q4[j + 2], kp = b3 ? q4[j + 2] : q4[j]; q2[j] = kp + dpp_i<DPP_ROR8>(snd); }
    const int col = 128 * x + 16 * (lane & 7) + (b5 ? 8 : 0) + (b4 ? 4 : 0) + (b3 ? 2 : 0);
    *(unsigned*)(p.proj + (size_t)t * 1024 + col) = pk2(bflo(R.x1) + (float)q2[0] * m.sc, bfhi(R.x1) + (float)q2[1] * m.sc);
}
constexpr int EXP_NP = 16;
template <int PHASE>
DEVI void exp_chunk(const Params& p, int tb, int x, int lane) {
    ExpMeta mA, mB, nA, nB;
    ExpRows rA, rB;
    exp_load_meta<PHASE>(p, mA, tb, x, lane);
    exp_load_meta<PHASE>(p, mB, tb + 1, x, lane);
    exp_issue<PHASE>(p, mA, rA, tb, x, lane);
    exp_issue<PHASE>(p, mB, rB, tb + 1, x, lane);
    exp_load_meta<PHASE>(p, nA, tb + 2, x, lane);
    exp_load_meta<PHASE>(p, nB, tb + 3, x, lane);
#pragma unroll 1
    for (int i = 0; i < EXP_NP; ++i) {
        const int tA = tb + 2 * i, tB = tA + 1;
        if (PHASE == 0) expA_compute(p, mA, rA, tA, x, lane); else expB_compute(p, mA, rA, tA, x, lane);
        if (i < EXP_NP - 1) {
            mA = nA;
            exp_issue<PHASE>(p, mA, rA, tA + 2, x, lane);
            if (i < EXP_NP - 2) exp_load_meta<PHASE>(p, nA, tA + 4, x, lane);
        }
        if (PHASE == 0) expA_compute(p, mB, rB, tB, x, lane); else expB_compute(p, mB, rB, tB, x, lane);
        if (i < EXP_NP - 1) {
            mB = nB;
            exp_issue<PHASE>(p, mB, rB, tB + 2, x, lane);
            if (i < EXP_NP - 2) exp_load_meta<PHASE>(p, nB, tB + 4, x, lane);
        }
    }
}
template <int PHASE>
DEVI void st_expAB(const Params& p, char* smem) {
    const int tid = stid(), lane = tid & 63, wid = tid >> 6;
    volatile int* cs = (volatile int*)smem;
    const unsigned myx = xb_xcc_id() & 7u;
    constexpr int NCH = T_TOK / (2 * EXP_NP * NW);
    for (int si = 0; si < 8; ++si) {
        const int x = (int)((myx + si) & 7u);
        unsigned* ctr = &p.bar[PHASE == 0 ? CTR_A(x) : CTR_B(x)];
        if (tid == 0) cs[0] = (int)xb_add(ctr, 1u);
        __syncthreads();
        int chunk = cs[0];
        __syncthreads();
        while (chunk < NCH) {
            int nxt = 0;
            if (tid == 0) nxt = (int)xb_add(ctr, 1u);
            exp_chunk<PHASE>(p, chunk * (2 * EXP_NP * NW) + wid * (2 * EXP_NP), x, lane);
            if (tid == 0) cs[0] = nxt;
            __syncthreads();
            chunk = cs[0];
            __syncthreads();
        }
    }
}
DEVI void st_expA2(const Params& p) {
    const int lane = stid() & 63, wid = stid() >> 6;
    for (int t0 = (blockIdx.x * NW + wid) * 2; t0 < T_TOK; t0 += gridDim.x * NW * 2) {
        unsigned pv[2][8], ew[2];
        float2 g[2];
        float xs[2];
#pragma unroll
        for (int q = 0; q < 2; ++q) {
            const int t = t0 + q;
#pragma unroll
            for (int x = 0; x < 8; ++x) pv[q][x] = *(const unsigned*)(p.part + ((size_t)x * T_TOK + t) * 128 + 2 * lane);
            ew[q] = *(const unsigned*)(p.eperm + (size_t)t * 128 + 2 * lane);
            g[q] = *(const float2*)(p.gate + (size_t)t * 128 + 2 * lane);
            xs[q] = rs2_of(p.rs2p, t) * (8.f * ZQ_SCALE);
        }
        float ds[2][2], us[2][2];
#pragma unroll
        for (int q = 0; q < 2; ++q) {
            const int ea = (int)(ew[q] & 0xffffu), eb = (int)(ew[q] >> 16);
            ds[q][0] = p.dscale[ea]; ds[q][1] = p.dscale[eb]; us[q][0] = p.uscale[ea]; us[q][1] = p.uscale[eb];
        }
#pragma unroll
        for (int q = 0; q < 2; ++q) {
            const int t = t0 + q;
            int s0 = 0, s1 = 0;
#pragma unroll
            for (int x = 0; x < 8; ++x) { s0 += (int)(short)(pv[q][x] & 0xffffu); s1 += (int)pv[q][x] >> 16; }
            const float a0 = g[q].x * gelu_erf((float)s0 * xs[q] * ds[q][0]) * us[q][0];
            const float a1 = g[q].y * gelu_erf((float)s1 * xs[q] * ds[q][1]) * us[q][1];
            const float amax = wave_max(fmaxf(fabsf(a0), fabsf(a1)));
            const float inv = amax > 0.f ? 127.f * rcp_(amax) : 0.f;
            const unsigned q0 = (unsigned)((int)rintf(a0 * inv) & 255), q1 = (unsigned)((int)rintf(a1 * inv) & 255);
            *(unsigned short*)(p.aq + (size_t)t * 128 + 2 * lane) = (unsigned short)(q0 | (q1 << 8));
            if (lane == 0) p.asc[t] = amax * (1.f / 127.f);
        }
    }
}
DEVI void st_expC(const Params& p) {
    const int lane = stid() & 63, wid = stid() >> 6;
    for (int t0 = (blockIdx.x * NW + wid) * 2; t0 < T_TOK; t0 += gridDim.x * NW * 2) {
        uint2 u[2][4];
#pragma unroll
        for (int q = 0; q < 2; ++q) {
            const uint2* row = (const uint2*)(p.proj + (size_t)(t0 + q) * 1024);
#pragma unroll
            for (int j = 0; j < 4; ++j) u[q][j] = row[lane + 64 * j];
        }
#pragma unroll
        for (int q = 0; q < 2; ++q) {
            float4 v[4];
            float ss = 0.f;
#pragma unroll
            for (int j = 0; j < 4; ++j) {
                v[j] = make_float4(bflo(u[q][j].x), bfhi(u[q][j].x), bflo(u[q][j].y), bfhi(u[q][j].y));
                ss += v[j].x * v[j].x + v[j].y * v[j].y + v[j].z * v[j].z + v[j].w * v[j].w;
            }
            ss = wave_sum(ss);
            const float rf = rsqrtf(ss * (1.f / 1024.f) + EPSN);
            float4* orow = (float4*)(p.out + (size_t)(t0 + q) * 1024);
#pragma unroll
            for (int j = 0; j < 4; ++j) {
                const float4 g = *(const float4*)(p.final_g + (lane + 64 * j) * 4);
                orow[lane + 64 * j] = make_float4(v[j].x * rf * g.x, v[j].y * rf * g.y, v[j].z * rf * g.z, v[j].w * rf * g.w);
            }
        }
    }
}

constexpr int LDS_BYTES = 147456;
constexpr int LDS_BARW = LDS_BYTES - 16;
extern __shared__ __attribute__((aligned(16))) char smem_dyn[];
__global__ void __launch_bounds__(NTHR, 2) mega_fwd(Params p) {
    cg::grid_group grid = cg::this_grid();
    volatile LAS unsigned* bst = (volatile LAS unsigned*)(LAS char*)(smem_dyn + LDS_BARW);
    if (stid() < 4) bst[stid()] = 0u;
    __syncthreads();
    XcdBarrier bar = xcd_barrier_post(p.bar, bst);
    st_prep_misc(p);
    st_prep_w1(p, smem_dyn);
    st_prep_x(p, smem_dyn);
    if (p.pad_[0] == 0x7fffabcd) grid.sync();
    xcd_barrier(bar);
    st_gemm8<EpiProj8, PG8_ALIGN>(p.xb, p.W1t, NPJ, 1024, smem_dyn, EpiProj8{p.proj, p.rs1, p.rope_cos, p.rope_sin});
    xcd_barrier(bar);
    st_conv_qk(p, smem_dyn);
    xcd_barrier(bar);
    st_recur(p, smem_dyn);
    xcd_barrier(bar);
    st_gemm8<EpiX18, PG8_ALIGN>(p.yb, p.W2t, 1024, 1024, smem_dyn, EpiX18{p.x, p.x1b, p.xq, p.rs2p, p.norm2_g});
    xcd_barrier(bar);
    st_gemm3_topk(p, smem_dyn);
    xcd_barrier(bar);
    st_expAB<0>(p, smem_dyn);
    xcd_barrier(bar);
    st_expA2(p);
    xcd_barrier(bar);
    st_expAB<1>(p, smem_dyn);
    xcd_barrier(bar);
    st_expC(p);
}

extern "C" void kernel_launch(void* const* d_in, const int* in_sizes, int n_in, void* d_out, int out_size, void* d_ws, size_t ws_size,
                              hipStream_t stream) {
    Params p{};
    const float* const* in = (const float* const*)d_in;
    p.x = in[0]; p.norm1_g = in[1]; p.w_in = in[2]; p.ret_norm_g = in[3]; p.m_conv_w = in[4]; p.m_conv_b = in[5]; p.m_wq = in[6]; p.m_wk = in[7];
    p.m_b_i = in[8]; p.m_b_f = in[9]; p.m_norm_g = in[10]; p.m_skip = in[11]; p.w_out = in[12]; p.norm2_g = in[13]; p.peer_wq = in[14];
    p.peer_keys = in[15]; p.peer_down = in[16]; p.peer_up = in[17]; p.final_g = in[18];
    p.out = (float*)d_out;
    char* ws = (char*)d_ws;
    size_t off = 0;
    auto take = [&](size_t bytes) { char* r = ws + off; off += (bytes + 255) & ~(size_t)255; return r; };
    p.proj = (bf16_t*)take((size_t)T_TOK * NPJ * 2);
    p.xb = (bf16_t*)take((size_t)T_TOK * 1024 * 2);
    p.yb = p.xb;
    p.gate = (float*)(ws + (size_t)T_TOK * 2048 * 4);
    p.mq = (bf16_t*)take((size_t)T_TOK * 512 * 2);
    p.mk = (bf16_t*)take((size_t)T_TOK * 512 * 2);
    p.x1b = p.mq;
    p.cbuf = (bf16_t*)take((size_t)T_TOK * 512 * 2);
    p.eperm = (unsigned short*)p.cbuf;
    p.down_q = (unsigned char*)take((size_t)16384 * 1024);
    p.up_q = (unsigned char*)take((size_t)16384 * 1024);
    p.dscale = (float*)take(16384 * 4);
    p.uscale = (float*)take(16384 * 4);
    p.bar = (unsigned*)take(CTL_WORDS * 4);
    p.xq = (unsigned char*)take((size_t)T_TOK * 1024);
    p.asc = (float*)take(T_TOK * 4);
    p.aq = (unsigned char*)take((size_t)T_TOK * 128);
    p.part = (short*)(ws + (size_t)T_TOK * 1024 * 4);
    p.W1t = (bf16_t*)take((size_t)NPJ * 1024 * 2);
    p.W2t = (bf16_t*)take((size_t)1024 * 1024 * 2);
    p.Wsubq = (signed char*)take((size_t)2048 * 1024);
    p.wsc = (float*)take(2048 * 4);
    p.Wqt = (bf16_t*)take(4 * 128 * 128 * 2);
    p.Wkt = (bf16_t*)take(4 * 128 * 128 * 2);
    p.rs1 = (float*)take(T_TOK * 4);
    p.rs2p = (float*)take((size_t)T_TOK * 16 * 4);
    p.ipre = (float*)take(T_TOK * 4 * 4);
    p.logf = (float*)take(T_TOK * 4 * 4);
    p.rope_cos = (float*)take(2048 * 64 * 4);
    p.rope_sin = (float*)take(2048 * 64 * 4);
    if (off > ws_size) { fprintf(stderr, "kernel_launch: workspace too small (%zu > %zu)\n", off, ws_size); return; }

    static int grid_blocks = 0;
    if (!grid_blocks) {
        int dev = 0, cus = 0, per_cu = 0;
        (void)hipGetDevice(&dev);
        (void)hipDeviceGetAttribute(&cus, hipDeviceAttributeMultiprocessorCount, dev);
        (void)hipFuncSetAttribute((const void*)mega_fwd, hipFuncAttributeMaxDynamicSharedMemorySize, LDS_BYTES);
        (void)hipOccupancyMaxActiveBlocksPerMultiprocessor(&per_cu, (const void*)mega_fwd, NTHR, LDS_BYTES);
        if (per_cu > 1) per_cu = 1;
        if (per_cu < 1) per_cu = 1;
        grid_blocks = cus * per_cu;
    }
    (void)hipMemsetAsync(p.bar, 0, CTL_WORDS * 4, stream);
    void* args[] = {&p};
    hipError_t e = hipLaunchCooperativeKernel((const void*)mega_fwd, dim3(grid_blocks), dim3(NTHR), args, LDS_BYTES, stream);
    if (e != hipSuccess) fprintf(stderr, "cooperative launch failed: %s (grid %d)\n", hipGetErrorString(e), grid_blocks);
}
```

```cpp
#include <hip/hip_runtime.h>
#include <hip/hip_cooperative_groups.h>
#include <stdint.h>
#include <cstdio>
namespace cg = cooperative_groups;

typedef unsigned short bf16_t;
typedef short bf16x8 __attribute__((ext_vector_type(8)));
typedef float f32x4 __attribute__((ext_vector_type(4)));
typedef int i32x4 __attribute__((ext_vector_type(4)));

#define DEVI __device__ __forceinline__
__device__ __forceinline__ int stid() { int t = (int)threadIdx.x; asm volatile("" : "+v"(t)); return t; }

constexpr int T_TOK = 32768, DM = 1024, NPJ = 3584, DIN = 3592;
constexpr int NTHR = 512, NW = 8;
constexpr float EPSN = 1e-6f;

struct Params {
    const float *x, *norm1_g, *w_in, *ret_norm_g, *m_conv_w, *m_conv_b, *m_wq, *m_wk, *m_b_i, *m_b_f, *m_norm_g, *m_skip, *w_out,
        *norm2_g, *peer_wq, *peer_keys, *peer_down, *peer_up, *final_g;
    float* out;
    bf16_t *proj, *xb, *yb, *mq, *mk, *x1b, *cbuf, *W1t, *W2t, *Wqt, *Wkt;
    signed char* Wsubq;
    float* wsc;
    unsigned char *down_q, *up_q;
    float *dscale, *uscale, *asc;
    unsigned short* eperm;
    unsigned char* aq;
    short* part;
    unsigned char* xq;
    unsigned* bar;
    float *rs1, *rs2p, *ipre, *logf, *rope_cos, *rope_sin, *gate;
    int pad_[2];
};

DEVI unsigned f2bf_bits(float f) { unsigned u = __float_as_uint(f); return (u + 0x7fffu + ((u >> 16) & 1u)) >> 16; }
DEVI bf16_t f2bf(float f) { return __builtin_bit_cast(bf16_t, (__bf16)f); }
typedef __bf16 bf16x2_t __attribute__((ext_vector_type(2)));
DEVI unsigned pk2(float lo, float hi) { bf16x2_t v = {(__bf16)lo, (__bf16)hi}; return __builtin_bit_cast(unsigned, v); }
DEVI float bflo(unsigned w) { return __uint_as_float(w << 16); }
DEVI float bfhi(unsigned w) { return __uint_as_float(w & 0xffff0000u); }
DEVI float bf2f(bf16_t h) { return __uint_as_float(((unsigned)h) << 16); }
template <int CTRL> DEVI float dpp_f(float v) { return __int_as_float(__builtin_amdgcn_update_dpp(0, __float_as_int(v), CTRL, 0xf, 0xf, false)); }
template <int CTRL> DEVI int dpp_i(int v) { return __builtin_amdgcn_update_dpp(0, v, CTRL, 0xf, 0xf, false); }
constexpr int DPP_XOR1 = 0xB1  , DPP_XOR2 = 0x4E  , DPP_HMIRROR = 0x141  ,
              DPP_MIRROR = 0x140  , DPP_ROR8 = 0x128  ;
DEVI float rl_f(float v, int l) { return __int_as_float(__builtin_amdgcn_readlane(__float_as_int(v), l)); }
DEVI float wave_sum(float v) {
    v += dpp_f<DPP_XOR1>(v); v += dpp_f<DPP_XOR2>(v); v += dpp_f<DPP_HMIRROR>(v); v += dpp_f<DPP_MIRROR>(v);
    return (rl_f(v, 0) + rl_f(v, 16)) + (rl_f(v, 32) + rl_f(v, 48));
}
DEVI float wave_max(float v) {
    v = fmaxf(v, dpp_f<DPP_XOR1>(v)); v = fmaxf(v, dpp_f<DPP_XOR2>(v)); v = fmaxf(v, dpp_f<DPP_HMIRROR>(v)); v = fmaxf(v, dpp_f<DPP_MIRROR>(v));
    return fmaxf(fmaxf(rl_f(v, 0), rl_f(v, 16)), fmaxf(rl_f(v, 32), rl_f(v, 48)));
}
constexpr float ZQ_SCALE = 6.f / 127.f;
DEVI float rs2_of(const float* rs2p, int t) {
    const float4* q = (const float4*)(rs2p + (size_t)t * 16);
    const float4 a = q[0], b = q[1], c = q[2], d = q[3];
    const float ss = ((a.x + a.y) + (a.z + a.w)) + ((b.x + b.y) + (b.z + b.w)) + ((c.x + c.y) + (c.z + c.w)) + ((d.x + d.y) + (d.z + d.w));
    return rsqrtf(ss * (1.f / 1024.f) + EPSN);
}
DEVI f32x4 mfma16(bf16x8 a, bf16x8 b, f32x4 c) { return __builtin_amdgcn_mfma_f32_16x16x32_bf16(a, b, c, 0, 0, 0); }
DEVI bf16x8 ld8(const char* p) { return *reinterpret_cast<const bf16x8*>(p); }
DEVI bf16x8 mk8(uint2 lo, uint2 hi) {
    union { uint4 u; bf16x8 v; } x;
    x.u = make_uint4(lo.x, lo.y, hi.x, hi.y);
    return x.v;
}
DEVI float fexp_(float x) { return __builtin_amdgcn_exp2f(x * 1.4426950408889634f); }
DEVI float rcp_(float x) { return __builtin_amdgcn_rcpf(x); }
DEVI float sigmoidf_(float z) { return rcp_(1.f + fexp_(-z)); }

DEVI void st_prep_misc(const Params& p) {
    const int gtid = blockIdx.x * NTHR + stid(), gsz = gridDim.x * NTHR;
    for (int i = gtid; i < 2048 * 64; i += gsz) {
        const int pos = i >> 6, j = i & 63;
        const float inv = powf(10000.f, -(float)j * (1.f / 64.f));
        const float ang = (float)pos * inv;
        float s, c;
        sincosf(ang, &s, &c);
        p.rope_cos[i] = c;
        p.rope_sin[i] = s;
    }
    for (int i = gtid; i < 4 * 128 * 128; i += gsz) {
        const int h = i >> 14, e = (i >> 7) & 127, d = i & 127;
        p.Wqt[i] = f2bf(p.m_wq[h * 16384 + d * 128 + e]);
        p.Wkt[i] = f2bf(p.m_wk[h * 16384 + d * 128 + e] * 0.08838834764831845f);
    }
}
DEVI void prep_table_row(const Params& p, int row, const float4 (&v)[4], int lane) {
    const bool up = row >= 16384;
    const int e = up ? row - 16384 : row;
    float am = 0.f;
#pragma unroll
    for (int i = 0; i < 4; ++i) am = fmaxf(am, fmaxf(fmaxf(fabsf(v[i].x), fabsf(v[i].y)), fmaxf(fabsf(v[i].z), fabsf(v[i].w))));
    am = wave_max(am);
    const float sc = am > 0.f ? am * (1.f / 127.f) : 1.f, inv = am > 0.f ? 127.f * rcp_(am) : 0.f;
    unsigned w[4];
#pragma unroll
    for (int i = 0; i < 4; ++i) {
        const int q0 = (int)rintf(v[i].x * inv), q1 = (int)rintf(v[i].y * inv), q2 = (int)rintf(v[i].z * inv), q3 = (int)rintf(v[i].w * inv);
        w[i] = (unsigned)(q0 & 255) | ((unsigned)(q1 & 255) << 8) | ((unsigned)(q2 & 255) << 16) | ((unsigned)(q3 & 255) << 24);
    }
    *(uint4*)((up ? p.up_q : p.down_q) + ((size_t)(lane >> 3) * 16384 + e) * 128 + (lane & 7) * 16) = make_uint4(w[0], w[1], w[2], w[3]);
    if (lane == 0) (up ? p.uscale : p.dscale)[e] = sc;
}
DEVI void st_prep_tables(const Params& p, int bid, int nb) {
    const int lane = stid() & 63, wid = stid() >> 6;
    for (int row = (bid * NW + wid) * 2; row < 32768; row += nb * NW * 2) {
        float4 va[4], vb[4];
        const float4* sa = (const float4*)((row >= 16384 ? p.peer_up + (size_t)(row - 16384) * 1024 : p.peer_down + (size_t)row * 1024) + lane * 16);
        const float4* sb = (const float4*)((row + 1 >= 16384 ? p.peer_up + (size_t)(row + 1 - 16384) * 1024 : p.peer_down + (size_t)(row + 1) * 1024) + lane * 16);
#pragma unroll
        for (int i = 0; i < 4; ++i) { va[i] = sa[i]; vb[i] = sb[i]; }
        prep_table_row(p, row, va, lane);
        prep_table_row(p, row + 1, vb, lane);
    }
}

DEVI void transpose_tile(const float* __restrict__ src, int ld, const float* __restrict__ scale, bf16_t* __restrict__ dst, int K, int k0, int n0,
                         float* tile, bool permqk = false) {
    const int tid = stid();
    {
        const int tx = tid & 63, ty = tid >> 6;
#pragma unroll
        for (int i = 0; i < 4; ++i) {
            const int k = k0 + ty + 8 * i;
            float v = src[(size_t)k * ld + n0 + tx];
            if (scale) v *= scale[k];
            tile[(ty + 8 * i) * 65 + tx] = v;
        }
    }
    __syncthreads();
    {
        const int n = tid >> 3, kq = tid & 7;
        const float a = tile[(4 * kq) * 65 + n], b = tile[(4 * kq + 1) * 65 + n], c = tile[(4 * kq + 2) * 65 + n], d = tile[(4 * kq + 3) * 65 + n];
        int nn = n0 + n;
        if (permqk && nn < 1024) { const int dd = nn & 127; nn = (nn & ~127) + (dd < 64 ? 2 * dd : 2 * (dd - 64) + 1); }
        *(uint2*)(dst + (size_t)nn * K + k0 + 4 * kq) = make_uint2(pk2(a, b), pk2(c, d));
    }
    __syncthreads();
}
DEVI void st_prep_w1(const Params& p, char* smem) {
    float* tile = (float*)smem;
    for (int it = blockIdx.x; it < 56 * 32; it += gridDim.x) transpose_tile(p.w_in, DIN, p.norm1_g, p.W1t, 1024, (it & 31) * 32, (it >> 5) * 64, tile, true);
}
DEVI void st_prep_w2(const Params& p, char* smem, int bid, int nb) {
    float* tile = (float*)smem;
    for (int it = bid; it < 16 * 32; it += nb) transpose_tile(p.w_out, 1024, nullptr, p.W2t, 1024, (it & 31) * 32, (it >> 5) * 64, tile);
}
DEVI void st_prep_wsub(const Params& p, char* smem, int bid, int nb) {
    float* wq_s = (float*)smem;
    float* key_s = wq_s + 64 * 132;
    const int tid = stid(), nl = tid >> 5, kp = tid & 31;
    for (int it = bid; it < 16 * 8; it += nb) {
        const int grp = it >> 3, n0 = (it & 7) * 16;
        __syncthreads();
        {
            const int idx = tid * 4, n = idx >> 7, d = idx & 127;
            *(float4*)(key_s + n * 132 + d) = *(const float4*)(p.peer_keys + ((size_t)grp * 128 + n0 + n) * 128 + d);
        }
        float v0[16], v1[16];
#pragma unroll 1
        for (int kt = 0; kt < 16; ++kt) {
            __syncthreads();
#pragma unroll
            for (int i = 0; i < 4; ++i) {
                const int idx = (tid + 512 * i) * 4, r = idx >> 7, d = idx & 127;
                *(float4*)(wq_s + r * 132 + d) = *(const float4*)(p.peer_wq + (size_t)(kt * 64 + r) * 2048 + grp * 128 + d);
            }
            __syncthreads();
            float a0 = 0.f, a1 = 0.f;
#pragma unroll 8
            for (int d4 = 0; d4 < 32; ++d4) {
                const float4 w0 = *(const float4*)(wq_s + (2 * kp) * 132 + 4 * d4), w1 = *(const float4*)(wq_s + (2 * kp + 1) * 132 + 4 * d4);
                const float4 y = *(const float4*)(key_s + nl * 132 + 4 * d4);
                a0 += w0.x * y.x + w0.y * y.y + w0.z * y.z + w0.w * y.w;
                a1 += w1.x * y.x + w1.y * y.y + w1.z * y.z + w1.w * y.w;
            }
#pragma unroll
            for (int q = 0; q < 16; ++q) if (q == kt) { v0[q] = a0; v1[q] = a1; }
        }
        float am = 0.f;
#pragma unroll
        for (int q = 0; q < 16; ++q) am = fmaxf(am, fmaxf(fabsf(v0[q]), fabsf(v1[q])));
#pragma unroll
        for (int o = 16; o; o >>= 1) am = fmaxf(am, __shfl_xor(am, o));
        const float inv = am > 0.f ? 127.f * rcp_(am) : 0.f;
        signed char* orow = p.Wsubq + (size_t)(grp * 128 + n0 + nl) * 1024 + 2 * kp;
#pragma unroll
        for (int q = 0; q < 16; ++q) {
            const int q0 = (int)rintf(v0[q] * inv), q1 = (int)rintf(v1[q] * inv);
            *(unsigned short*)(orow + 64 * q) = (unsigned short)((q0 & 255) | ((q1 & 255) << 8));
        }
        if (kp == 0) p.wsc[grp * 128 + n0 + nl] = am > 0.f ? am * (1.f / 127.f) : 1.f;
    }
    __syncthreads();
}

DEVI void prep_x_token(const Params& p, const float* Wg_s, int t, const float4 (&v)[4], int lane) {
    float ss = 0.f, g8[8];
#pragma unroll
    for (int g = 0; g < 8; ++g) g8[g] = 0.f;
#pragma unroll
    for (int j = 0; j < 4; ++j) {
        ss += v[j].x * v[j].x + v[j].y * v[j].y + v[j].z * v[j].z + v[j].w * v[j].w;
#pragma unroll
        for (int g = 0; g < 8; ++g) {
            const float4 w = *(const float4*)(Wg_s + g * 1024 + (lane + 64 * j) * 4);
            g8[g] += v[j].x * w.x + v[j].y * w.y + v[j].z * w.z + v[j].w * w.w;
        }
    }
    ss = wave_sum(ss);
    const bool b5 = lane & 32, b4 = lane & 16, b3 = lane & 8;
    float q4[4], q2[2], q1;
#pragma unroll
    for (int j = 0; j < 4; ++j) { const float snd = b5 ? g8[j] : g8[j + 4], kp = b5 ? g8[j + 4] : g8[j]; q4[j] = kp + __shfl_xor(snd, 32); }
#pragma unroll
    for (int j = 0; j < 2; ++j) { const float snd = b4 ? q4[j] : q4[j + 2], kp = b4 ? q4[j + 2] : q4[j]; q2[j] = kp + __shfl_xor(snd, 16); }
    { const float snd = b3 ? q2[0] : q2[1], kp = b3 ? q2[1] : q2[0]; q1 = kp + __shfl_xor(snd, 8); }
    q1 += __shfl_xor(q1, 4);
    q1 += __shfl_xor(q1, 2);
    q1 += __shfl_xor(q1, 1);
    const float rs = rsqrtf(ss * (1.f / 1024.f) + EPSN);
    uint2* o = (uint2*)(p.xb + (size_t)t * 1024);
#pragma unroll
    for (int j = 0; j < 4; ++j) o[lane + 64 * j] = make_uint2(pk2(v[j].x, v[j].y), pk2(v[j].z, v[j].w));
    if (lane == 0) p.rs1[t] = rs;
    if ((lane & 7) == 0) {
        const int gi = (b5 ? 4 : 0) + (b4 ? 2 : 0) + (b3 ? 1 : 0);
        if (gi < 4) p.ipre[t * 4 + gi] = q1 * rs + p.m_b_i[gi];
        else {
            const float z = q1 * rs + p.m_b_f[gi - 4];
            p.logf[t * 4 + gi - 4] = fminf(z, 0.f) - log1pf(fexp_(-fabsf(z)));
        }
    }
}
DEVI void st_prep_x(const Params& p, char* smem) {
    float* Wg_s = (float*)smem;
    for (int i = stid(); i < 8192; i += NTHR) {
        const int k = i >> 3, g = i & 7;
        Wg_s[g * 1024 + k] = p.norm1_g[k] * p.w_in[(size_t)k * DIN + NPJ + g];
    }
    __syncthreads();
    const int lane = stid() & 63, wid = stid() >> 6;
    for (int t = (blockIdx.x * NW + wid) * 4; t < T_TOK; t += gridDim.x * NW * 4) {
        float4 v[4][4];
        const float4* xa = (const float4*)(p.x + (size_t)t * 1024);
#pragma unroll
        for (int q = 0; q < 4; ++q)
#pragma unroll
            for (int j = 0; j < 4; ++j) v[q][j] = xa[256 * q + lane + 64 * j];
#pragma unroll
        for (int q = 0; q < 4; ++q) prep_x_token(p, Wg_s, t + q, v[q], lane);
    }
    __syncthreads();
}

namespace pg8 {
#define PG8_LAS __attribute__((address_space(3)))
typedef unsigned short bf16_t;
typedef short bf16x8 __attribute__((ext_vector_type(8)));
typedef float f32x4 __attribute__((ext_vector_type(4)));
typedef unsigned u32x4 __attribute__((ext_vector_type(4)));
constexpr int BM = 256, BK = 64, HALF = 128, HTB = HALF * BK * 2  , STAGE_BYTES = 8 * HTB, NXCD = 8, WGM = 8;

__host__ __device__ __forceinline__ int lds_byte(int r, int c) { const int st = (r >> 4) * 2 + (c >> 5), rr = r & 15, cc = c & 31, ob = rr * 64 + cc * 2; return st * 1024 + (ob ^ (((ob >> 9) & 1) << 5)); }
__host__ __device__ __forceinline__ void stage_rc(int b, int& R, int& C) { const int st = b / 1024, sb = b % 1024, swz = sb ^ (((sb >> 9) & 1) << 5); R = (st >> 1) * 16 + swz / 64; C = (st & 1) * 32 + (swz % 64) / 2; }
__host__ __device__ __forceinline__ int perm32(int rho) { const int n = rho >> 4, i = rho & 15; return 8 * (i >> 2) + 4 * n + (i & 3); }

struct Unit { int pm, pn; };
struct Gemm { const bf16_t* A; const bf16_t* Bt; int M, N, K; };

struct StaticOrder {
    int nM, nN, nwg, G, c;
    __host__ __device__ void init(int M, int N, int G_, int c_) { nM = M / BM; nN = N / BM; nwg = nM * nN; G = G_; c = c_; }
    __host__ __device__ bool next(int i, Unit& u) const {
        const long L = (long)i * G + c; if (L >= nwg) return false;
        int wgid = (int)L; { const int q = nwg / NXCD, r = nwg % NXCD, xcd = wgid % NXCD, off = wgid / NXCD; wgid = (xcd < r ? xcd * (q + 1) : r * (q + 1) + (xcd - r) * q) + off; }
        const int nig = WGM * nN, gid = wgid / nig, fm = gid * WGM, gsz = (nM - fm) < WGM ? (nM - fm) : WGM;
        u.pm = fm + ((wgid % nig) % gsz); u.pn = (wgid % nig) / gsz; return true;
    }
    __device__ __forceinline__ void a_ready(const Unit&) const {}
    __device__ __forceinline__ void done(const Unit&) const {}
};

__device__ __forceinline__ unsigned cvt_pk_bf16(float lo, float hi) { unsigned r; asm volatile("v_cvt_pk_bf16_f32 %0, %1, %2" : "=v"(r) : "v"(lo), "v"(hi)); return r; }

template <class Epi, class Sched, bool ALIGN_EPI = false, bool SP2 = false>
__device__ __forceinline__ void gemm_phase(PG8_LAS unsigned char* lds, const Gemm g, const Sched& S, const Epi& E) {
    const int tid = stid(), wid = __builtin_amdgcn_readfirstlane(tid >> 6), lane = tid & 63, wr = wid >> 2, wc = wid & 3, fr = lane & 15, fq = lane >> 4;
    const int K = g.K, nt = K / BK;
    unsigned voffA[2], voffB[2];
#pragma unroll
    for (int i = 0; i < 2; ++i) { int R, C; stage_rc(tid * 16 + i * 8192, R, C); const int Rb = Epi::PERM ? ((R & ~31) + perm32(R & 31)) : R;
        voffA[i] = (unsigned)(R * K + C) * 2u; voffB[i] = (unsigned)(Rb * K + C) * 2u; }
    const size_t kstep = (size_t)(BK * 2);
    const size_t hstep = (size_t)HALF * K * 2;
    const size_t tstep = 2 * hstep;
    const unsigned ldsw = (unsigned)wid * 1024u;
    const int aoff = lds_byte(wr * 64 + fr, fq * 8), boff = lds_byte(wc * 32 + fr, fq * 8);
#define PG8_SA(b, h) (((b) * 2 + (h)) * HTB)
#define PG8_SB(b, h) ((4 + (b) * 2 + (h)) * HTB)
#define PG8_STAGE(bufoff, gbase, voff) do { _Pragma("unroll") for (int _i = 0; _i < 2; ++_i) \
        __builtin_amdgcn_global_load_lds((const unsigned*)((const char*)(gbase) + (voff)[_i]), (PG8_LAS unsigned*)(lds + (bufoff) + ldsw + _i * 8192), 16, 0, 0); } while (0)
#define PG8_LDA(dst, b, h) do { _Pragma("unroll") for (int m = 0; m < 4; ++m) _Pragma("unroll") for (int k = 0; k < 2; ++k) dst[m][k] = *(const PG8_LAS bf16x8*)(lds + PG8_SA(b, h) + aoff + m * 2048 + k * 1024); } while (0)
#define PG8_LDB(dst, b, h) do { _Pragma("unroll") for (int n = 0; n < 2; ++n) _Pragma("unroll") for (int k = 0; k < 2; ++k) dst[n][k] = *(const PG8_LAS bf16x8*)(lds + PG8_SB(b, h) + boff + n * 2048 + k * 1024); } while (0)
#define PG8_MMA(ai, bj, At, Bt) do { __builtin_amdgcn_s_setprio(1); _Pragma("unroll") for (int m = 0; m < 4; ++m) _Pragma("unroll") for (int n = 0; n < 2; ++n) _Pragma("unroll") for (int k = 0; k < 2; ++k) \
        acc[ai][bj][m][n] = __builtin_amdgcn_mfma_f32_16x16x32_bf16(Bt[n][k], At[m][k], acc[ai][bj][m][n], 0, 0, 0); __builtin_amdgcn_s_setprio(0); } while (0)
#define PG8_WAIT_V(n) asm volatile("s_waitcnt vmcnt(" #n ")" ::: "memory")
#define PG8_WAIT_L(n) asm volatile("s_waitcnt lgkmcnt(" #n ")" ::: "memory")
#define PG8_BAR __builtin_amdgcn_s_barrier()
#define PG8_SCHED __builtin_amdgcn_sched_barrier(0)
    Unit cur, nxt; int ui = 0;
    if (!S.next(0, cur)) return;
    f32x4 acc[2][2][4][2];
#pragma unroll
    for (int a = 0; a < 2; ++a)
#pragma unroll
        for (int b = 0; b < 2; ++b)
#pragma unroll
            for (int m = 0; m < 4; ++m)
#pragma unroll
                for (int n = 0; n < 2; ++n) acc[a][b][m][n] = (f32x4){0.f, 0.f, 0.f, 0.f};
    bf16x8 At[4][2], B0[2][2], B1[2][2];
    const char* cA = (const char*)g.A + (size_t)cur.pm * tstep; const char* cB = (const char*)g.Bt + (size_t)cur.pn * tstep;
    S.a_ready(cur);
    if constexpr (SP2) {
        PG8_STAGE(PG8_SB(0, 0), cB, voffB); PG8_STAGE(PG8_SB(0, 1), cB + hstep, voffB); PG8_STAGE(PG8_SA(0, 0), cA, voffA); PG8_STAGE(PG8_SA(0, 1), cA + hstep, voffA);
        if (wr == 1) PG8_BAR;
        PG8_WAIT_V(2); PG8_BAR;
        PG8_STAGE(PG8_SB(1, 0), cB + kstep, voffB); PG8_STAGE(PG8_SA(1, 0), cA + kstep, voffA); PG8_STAGE(PG8_SB(1, 1), cB + hstep + kstep, voffB);
        PG8_WAIT_V(6); PG8_BAR;
    } else {
        PG8_STAGE(PG8_SB(0, 0), cB, voffB); PG8_STAGE(PG8_SA(0, 0), cA, voffA); PG8_STAGE(PG8_SB(0, 1), cB + hstep, voffB); PG8_STAGE(PG8_SA(0, 1), cA + hstep, voffA);
        if (wr == 1) PG8_BAR;
        PG8_WAIT_V(4); PG8_BAR;
        PG8_STAGE(PG8_SB(1, 0), cB + kstep, voffB); PG8_STAGE(PG8_SA(1, 0), cA + kstep, voffA); PG8_STAGE(PG8_SB(1, 1), cB + hstep + kstep, voffB);
        PG8_WAIT_V(6); PG8_BAR;
    }
    for (;;) {
        const bool has_next = S.next(ui + 1, nxt);
        const char* nA = has_next ? (const char*)g.A + (size_t)nxt.pm * tstep : cA; const char* nB = has_next ? (const char*)g.Bt + (size_t)nxt.pn * tstep : cB;
        for (int t = 0; t < nt; t += 2) {
            const bool last = (t == nt - 2);
            const char* a1 = cA + (size_t)(t + 1) * kstep;
            const char* a2 = last ? nA : cA + (size_t)(t + 2) * kstep; const char* b2 = last ? nB : cB + (size_t)(t + 2) * kstep;
            const char* a3 = a2 + kstep; const char* b3 = b2 + kstep;
            if (last && has_next) S.a_ready(nxt);
            if constexpr (SP2) {
            PG8_LDB(B0, 0, 0); PG8_LDB(B1, 0, 1); PG8_SCHED; PG8_LDA(At, 0, 0); PG8_STAGE(PG8_SA(1, 1), a1 + hstep, voffA);
            PG8_WAIT_V(8); PG8_WAIT_L(0); PG8_BAR; PG8_MMA(0, 0, At, B0); PG8_MMA(0, 1, At, B1); PG8_BAR; PG8_SCHED;
            PG8_LDA(At, 0, 1); PG8_STAGE(PG8_SB(0, 0), b2, voffB); PG8_STAGE(PG8_SB(0, 1), b2 + hstep, voffB); PG8_STAGE(PG8_SA(0, 0), a2, voffA);
            PG8_WAIT_V(8); PG8_WAIT_L(0); PG8_BAR; PG8_MMA(1, 0, At, B0); PG8_MMA(1, 1, At, B1); PG8_BAR; PG8_SCHED;
            PG8_LDB(B0, 1, 0); PG8_LDB(B1, 1, 1); PG8_SCHED; PG8_LDA(At, 1, 0); PG8_STAGE(PG8_SA(0, 1), a2 + hstep, voffA);
            PG8_WAIT_V(8); PG8_WAIT_L(0); PG8_BAR; PG8_MMA(0, 0, At, B0); PG8_MMA(0, 1, At, B1); PG8_BAR; PG8_SCHED;
            PG8_LDA(At, 1, 1); PG8_STAGE(PG8_SB(1, 0), b3, voffB); PG8_STAGE(PG8_SB(1, 1), b3 + hstep, voffB); PG8_STAGE(PG8_SA(1, 0), a3, voffA);
            PG8_WAIT_V(8); PG8_WAIT_L(0); PG8_BAR; PG8_MMA(1, 0, At, B0); PG8_MMA(1, 1, At, B1); PG8_BAR; PG8_SCHED;
            } else {
            PG8_LDB(B0, 0, 0); PG8_SCHED; PG8_LDA(At, 0, 0); PG8_STAGE(PG8_SA(1, 1), a1 + hstep, voffA);
            PG8_WAIT_L(8); PG8_BAR; PG8_WAIT_L(0); PG8_MMA(0, 0, At, B0); PG8_BAR; PG8_SCHED;
            PG8_LDB(B1, 0, 1); PG8_STAGE(PG8_SB(0, 0), b2, voffB);
            PG8_BAR; PG8_WAIT_L(0); PG8_MMA(0, 1, At, B1); PG8_BAR;
            PG8_LDA(At, 0, 1); PG8_STAGE(PG8_SA(0, 0), a2, voffA);
            PG8_BAR; PG8_WAIT_L(0); PG8_MMA(1, 0, At, B0); PG8_BAR; PG8_SCHED;
            PG8_STAGE(PG8_SB(0, 1), b2 + hstep, voffB);
            PG8_WAIT_V(6); PG8_BAR; PG8_MMA(1, 1, At, B1); PG8_BAR;
            PG8_LDB(B0, 1, 0); PG8_SCHED; PG8_LDA(At, 1, 0); PG8_STAGE(PG8_SA(0, 1), a2 + hstep, voffA);
            PG8_WAIT_L(8); PG8_BAR; PG8_WAIT_L(0); PG8_MMA(0, 0, At, B0); PG8_BAR; PG8_SCHED;
            PG8_LDB(B1, 1, 1); PG8_STAGE(PG8_SB(1, 0), b3, voffB);
            PG8_BAR; PG8_WAIT_L(0); PG8_MMA(0, 1, At, B1); PG8_BAR;
            PG8_LDA(At, 1, 1); PG8_STAGE(PG8_SA(1, 0), a3, voffA);
            PG8_BAR; PG8_WAIT_L(0); PG8_MMA(1, 0, At, B0); PG8_BAR; PG8_SCHED;
            PG8_STAGE(PG8_SB(1, 1), b3 + hstep, voffB);
            PG8_WAIT_V(6); PG8_BAR; PG8_MMA(1, 1, At, B1); PG8_BAR;
            }
        }
        if constexpr (ALIGN_EPI) { if (wr == 0) PG8_BAR; }
        if constexpr (!Epi::AFTER_DRAIN) { E(acc, cur, wr, wc, fr, fq); S.done(cur); }
        if (!has_next) break;
#pragma unroll
        for (int a = 0; a < 2; ++a)
#pragma unroll
            for (int b = 0; b < 2; ++b)
#pragma unroll
                for (int m = 0; m < 4; ++m)
#pragma unroll
                    for (int n = 0; n < 2; ++n) acc[a][b][m][n] = (f32x4){0.f, 0.f, 0.f, 0.f};
        cur = nxt; cA = nA; cB = nB; ++ui;
        if constexpr (ALIGN_EPI) { if (wr == 1) PG8_BAR; }
    }
    PG8_WAIT_V(0);
    if constexpr (!ALIGN_EPI) { if (wr == 0) PG8_BAR; }
    PG8_BAR;
    if constexpr (Epi::AFTER_DRAIN) { E.fused(acc, cur, wr, wc, fr, fq, lds, wid, lane); S.done(cur); }
#undef PG8_SA
#undef PG8_SB
#undef PG8_STAGE
#undef PG8_LDA
#undef PG8_LDB
#undef PG8_MMA
#undef PG8_WAIT_V
#undef PG8_WAIT_L
#undef PG8_BAR
#undef PG8_SCHED
}
}

#ifndef PG8_SP2
#define PG8_SP2 true
#endif
#ifndef PG8_ALIGN
#define PG8_ALIGN true
#endif
struct EpiProj8 {
    static constexpr bool PERM = true, AFTER_DRAIN = false;
    bf16_t* O; const float* rs; const float* rcos; const float* rsin;
    __device__ __forceinline__ void operator()(const pg8::f32x4 (&acc)[2][2][4][2], const pg8::Unit& u, int wr, int wc, int fr, int fq) const {
        const int row0 = u.pm * 256 + wr * 64 + fr, col0 = u.pn * 256 + wc * 32 + 8 * fq;
        const bool rot = u.pn < 4;
        const float ksc = u.pn >= 2 ? 0.08838834764831845f : 1.f;
#pragma unroll
        for (int ai = 0; ai < 2; ++ai)
#pragma unroll
            for (int m = 0; m < 4; ++m) {
                const int row = row0 + ai * 128 + m * 16;
                const float s = rs[row];
                bf16_t* rowp = O + (size_t)row * NPJ + col0;
                float4 cs = make_float4(1.f, 1.f, 1.f, 1.f), sn = make_float4(0.f, 0.f, 0.f, 0.f);
                float s2 = s;
                if (rot) {
                    const int ti = (row & 2047) * 64 + 16 * wc + 4 * fq;
                    cs = *(const float4*)(rcos + ti);
                    sn = *(const float4*)(rsin + ti);
                    s2 = s * ksc;
                }
#pragma unroll
                for (int bj = 0; bj < 2; ++bj) {
                    const pg8::f32x4 v0 = acc[ai][bj][m][0] * s2, v1 = acc[ai][bj][m][1] * s2;
                    *(uint4*)(rowp + bj * 128) = make_uint4(pk2(v0[0] * cs.x - v0[1] * sn.x, v0[0] * sn.x + v0[1] * cs.x), pk2(v0[2] * cs.y - v0[3] * sn.y, v0[2] * sn.y + v0[3] * cs.y),
                                                            pk2(v1[0] * cs.z - v1[1] * sn.z, v1[0] * sn.z + v1[1] * cs.z), pk2(v1[2] * cs.w - v1[3] * sn.w, v1[2] * sn.w + v1[3] * cs.w));
                }
            }
    }
};
struct EpiX18 {
    static constexpr bool PERM = true, AFTER_DRAIN = false;
    const float* x; bf16_t* x1b; unsigned char* zq; float* rs2p; const float* g2;
    __device__ __forceinline__ void operator()(const pg8::f32x4 (&acc)[2][2][4][2], const pg8::Unit& u, int wr, int wc, int fr, int fq) const {
        const int row0 = u.pm * 256 + wr * 64 + fr, col0 = u.pn * 256 + wc * 32 + 8 * fq;
        float gq[2][8];
#pragma unroll
        for (int bj = 0; bj < 2; ++bj) {
            const float4 a = *(const float4*)(g2 + col0 + bj * 128), b = *(const float4*)(g2 + col0 + bj * 128 + 4);
            gq[bj][0] = a.x; gq[bj][1] = a.y; gq[bj][2] = a.z; gq[bj][3] = a.w; gq[bj][4] = b.x; gq[bj][5] = b.y; gq[bj][6] = b.z; gq[bj][7] = b.w;
        }
        float ssq[8];
#pragma unroll
        for (int ai = 0; ai < 2; ++ai)
#pragma unroll
            for (int m = 0; m < 4; ++m) {
                const size_t ro = (size_t)(row0 + ai * 128 + m * 16) * 1024 + col0;
                float s = 0.f;
#pragma unroll
                for (int bj = 0; bj < 2; ++bj) {
                    const float4 xa = *(const float4*)(x + ro + bj * 128), xb_ = *(const float4*)(x + ro + bj * 128 + 4);
                    const pg8::f32x4 v0 = acc[ai][bj][m][0], v1 = acc[ai][bj][m][1];
                    const float y[8] = {xa.x + v0[0], xa.y + v0[1], xa.z + v0[2], xa.w + v0[3], xb_.x + v1[0], xb_.y + v1[1], xb_.z + v1[2], xb_.w + v1[3]};
                    *(uint4*)(x1b + ro + bj * 128) = make_uint4(pk2(y[0], y[1]), pk2(y[2], y[3]), pk2(y[4], y[5]), pk2(y[6], y[7]));
                    unsigned w2[2] = {0u, 0u};
#pragma unroll
                    for (int e = 0; e < 8; ++e) {
                        s += y[e] * y[e];
                        const float z = fminf(fmaxf(y[e] * gq[bj][e] * (1.f / ZQ_SCALE), -127.f), 127.f);
                        w2[e >> 2] |= ((unsigned)((int)rintf(z) & 255)) << (8 * (e & 3));
                    }
                    *(uint2*)(zq + ro + bj * 128) = make_uint2(w2[0], w2[1]);
                }
                ssq[ai * 4 + m] = s;
            }
        float q4[4], q2[2];
#pragma unroll
        for (int j = 0; j < 4; ++j) {
            const auto r = __builtin_amdgcn_permlane32_swap(__float_as_uint(ssq[j]), __float_as_uint(ssq[j + 4]), false, false);
            q4[j] = __uint_as_float(r[0]) + __uint_as_float(r[1]);
        }
#pragma unroll
        for (int j = 0; j < 2; ++j) {
            const auto r = __builtin_amdgcn_permlane16_swap(__float_as_uint(q4[j]), __float_as_uint(q4[j + 2]), false, false);
            q2[j] = __uint_as_float(r[0]) + __uint_as_float(r[1]);
        }
#pragma unroll
        for (int j = 0; j < 2; ++j) {
            const int r8 = ((fq >> 1) & 1) * 4 + (fq & 1) * 2 + j;
            rs2p[(size_t)(row0 + (r8 >> 2) * 128 + (r8 & 3) * 16) * 16 + u.pn * 4 + wc] = q2[j];
        }
    }
};
template <class Epi, bool ALIGN>
DEVI void st_gemm8(const bf16_t* A, const bf16_t* Bt, int N, int K, char* smem, const Epi& epi) {
    pg8::Gemm g{A, Bt, T_TOK, N, K};
    pg8::StaticOrder S;
    S.init(T_TOK, N, (int)gridDim.x, (int)blockIdx.x);
    pg8::gemm_phase<Epi, pg8::StaticOrder, ALIGN, PG8_SP2>((PG8_LAS unsigned char*)smem, g, S, epi);
}

DEVI void st_conv_qk(const Params& p, char* smem) {
    char* cs = smem;
    char* wqs = smem + 128 * 272;
    char* wks = smem + 2 * 128 * 272;
    const int tid = stid(), lane = tid & 63, wid = tid >> 6, wr = wid >> 1, wc = wid & 1, fr = lane & 15, fq = lane >> 4;
    const int r = tid >> 4, cg = tid & 15;
    int hcur = -1;
    float cw[4][8], cb[8];
    for (int it = blockIdx.x; it < 256 * 4; it += gridDim.x) {
        const int h = it & 3, t0 = (it >> 2) * 128, s0 = t0 & 2047;
        if (h != hcur) {
            __syncthreads();
#pragma unroll
            for (int i = 0; i < 4; ++i) {
                const int id = tid + 512 * i, rr = id >> 4, c = id & 15;
                *(uint4*)(wqs + rr * 272 + c * 16) = *(const uint4*)(p.Wqt + h * 16384 + rr * 128 + c * 8);
                *(uint4*)(wks + rr * 272 + c * 16) = *(const uint4*)(p.Wkt + h * 16384 + rr * 128 + c * 8);
            }
#pragma unroll
            for (int j = 0; j < 4; ++j) {
                const float4 a = *(const float4*)(p.m_conv_w + j * 512 + h * 128 + 8 * cg), b = *(const float4*)(p.m_conv_w + j * 512 + h * 128 + 8 * cg + 4);
                cw[j][0] = a.x; cw[j][1] = a.y; cw[j][2] = a.z; cw[j][3] = a.w; cw[j][4] = b.x; cw[j][5] = b.y; cw[j][6] = b.z; cw[j][7] = b.w;
            }
            { const float4 a = *(const float4*)(p.m_conv_b + h * 128 + 8 * cg), b = *(const float4*)(p.m_conv_b + h * 128 + 8 * cg + 4);
              cb[0] = a.x; cb[1] = a.y; cb[2] = a.z; cb[3] = a.w; cb[4] = b.x; cb[5] = b.y; cb[6] = b.z; cb[7] = b.w; }
            hcur = h;
        }
        const bf16_t* xcol = p.proj + (size_t)t0 * NPJ + 2048 + h * 128 + 8 * cg;
#pragma unroll
        for (int ps = 0; ps < 4; ++ps) {
            const int row = 32 * ps + r;
            uint4 xv[4];
#pragma unroll
            for (int j = 0; j < 4; ++j) {
                const int rj = row - 3 + j;
                xv[j] = (s0 + rj >= 0) ? *(const uint4*)(xcol + (long)rj * NPJ) : make_uint4(0u, 0u, 0u, 0u);
            }
            float y[8];
#pragma unroll
            for (int e = 0; e < 8; ++e) y[e] = cb[e];
#pragma unroll
            for (int j = 0; j < 4; ++j) {
                const unsigned w4[4] = {xv[j].x, xv[j].y, xv[j].z, xv[j].w};
#pragma unroll
                for (int e = 0; e < 4; ++e) { y[2 * e] += cw[j][2 * e] * bflo(w4[e]); y[2 * e + 1] += cw[j][2 * e + 1] * bfhi(w4[e]); }
            }
            unsigned o[4];
#pragma unroll
            for (int e = 0; e < 4; ++e) o[e] = pk2(y[2 * e] * sigmoidf_(y[2 * e]), y[2 * e + 1] * sigmoidf_(y[2 * e + 1]));
            const uint4 ov = make_uint4(o[0], o[1], o[2], o[3]);
            *(uint4*)(cs + row * 272 + cg * 16) = ov;
            *(uint4*)(p.cbuf + (size_t)(t0 + row) * 512 + h * 128 + 8 * cg) = ov;
        }
        __syncthreads();
#pragma unroll
        for (int which = 0; which < 2; ++which) {
            const char* ws = which ? wks : wqs;
            bf16_t* O = which ? p.mk : p.mq;
            f32x4 acc[2][4];
#pragma unroll
            for (int i = 0; i < 2; ++i)
#pragma unroll
                for (int j = 0; j < 4; ++j) acc[i][j] = (f32x4){0.f, 0.f, 0.f, 0.f};
#pragma unroll
            for (int ks = 0; ks < 4; ++ks) {
                bf16x8 a[2], b[4];
#pragma unroll
                for (int i = 0; i < 2; ++i) a[i] = ld8(cs + (wr * 32 + i * 16 + fr) * 272 + (ks * 4 + fq) * 16);
#pragma unroll
                for (int j = 0; j < 4; ++j) b[j] = ld8(ws + (wc * 64 + j * 16 + fr) * 272 + (ks * 4 + fq) * 16);
#pragma unroll
                for (int i = 0; i < 2; ++i)
#pragma unroll
                    for (int j = 0; j < 4; ++j) acc[i][j] = mfma16(b[j], a[i], acc[i][j]);
            }
#pragma unroll
            for (int i = 0; i < 2; ++i)
#pragma unroll
                for (int j = 0; j < 4; ++j) {
                    const int m = t0 + wr * 32 + i * 16 + fr, n = h * 128 + wc * 64 + j * 16 + 4 * fq;
                    const f32x4 v = acc[i][j];
                    *(uint2*)(O + (size_t)m * 512 + n) = make_uint2(pk2(v[0], v[1]), pk2(v[2], v[3]));
                }
        }
        __syncthreads();
    }
}

DEVI bf16x8 u4_to_frag(uint4 u) { union { uint4 u; bf16x8 v; } x; x.u = u; return x.v; }
DEVI void sel_frags(bf16x8 (&sel)[2], int fr, int fq) {
#pragma unroll
    for (int hh = 0; hh < 2; ++hh) {
        const int jstar = fr + 16 * hh - 8 * fq;
        bf16x8 s;
#pragma unroll
        for (int j = 0; j < 8; ++j) s[j] = (j == jstar) ? (short)0x3F80 : (short)0;
        sel[hh] = s;
    }
}
DEVI void tr_store(char* XT, bf16x8 frag, const bf16x8 (&sel)[2], int mi, int ks, int fr, int fq, const float (&sc)[4]) {
#pragma unroll
    for (int hh = 0; hh < 2; ++hh) {
        const f32x4 d = mfma16(frag, sel[hh], (f32x4){0.f, 0.f, 0.f, 0.f});
        *(uint2*)(XT + (32 * ks + 16 * hh + fr) * 144 + (16 * mi + 4 * fq) * 2) = make_uint2(pk2(d[0] * sc[0], d[1] * sc[1]), pk2(d[2] * sc[2], d[3] * sc[3]));
    }
}
DEVI bf16x8 state_pack(const f32x4& a, const f32x4& b) {
    return mk8(make_uint2(pk2(a[0], a[1]), pk2(a[2], a[3])), make_uint2(pk2(b[0], b[1]), pk2(b[2], b[3])));
}
DEVI const float* opaque_ptr(const float* q) { asm volatile("" : "+v"(q)); return q; }
DEVI float opaque_f(float v) { asm volatile("" : "+v"(v)); return v; }
DEVI void lds_barrier() { asm volatile("s_waitcnt lgkmcnt(0)" ::: "memory"); __builtin_amdgcn_s_barrier(); asm volatile("" ::: "memory"); }
DEVI void pin_u4(uint4& a) { asm volatile("" : "+v"(a.x), "+v"(a.y), "+v"(a.z), "+v"(a.w)); }
DEVI float grp8_sum(float v) { v += dpp_f<DPP_XOR1>(v); v += dpp_f<DPP_XOR2>(v); v += dpp_f<DPP_HMIRROR>(v); return v; }

#define ASM_LD16(dst, voff, sbase, imm) asm volatile("global_load_dwordx4 %0, %1, %2 offset:" #imm : "=v"(dst) : "v"(voff), "s"(sbase) : "memory")
#define ASM_LD4(dst, voff, sbase) asm volatile("global_load_dword %0, %1, %2" : "=v"(dst) : "v"(voff), "s"(sbase) : "memory")
typedef unsigned u32x4_t __attribute__((ext_vector_type(4)));
struct RetPre { u32x4_t f[4]; u32x4_t v[2]; u32x4_t g[2]; };
struct RetOff { unsigned f, v0, v1, g; };
DEVI void ret_offsets(RetOff& o, int h, int tid) {
    const int lane = tid & 63, w = tid >> 6, fr = lane & 15, fq = lane >> 4, mi = w & 3;
    o.f = (unsigned)(((16 * mi + fr) * NPJ + (w < 4 ? 512 : 0) + h * 128 + 8 * fq) * 2);
    o.v0 = (unsigned)(((16 * ((2 * w) >> 2) + fr) * NPJ + 1024 + h * 128 + 32 * ((2 * w) & 3) + 8 * fq) * 2);
    o.v1 = (unsigned)(((16 * ((2 * w + 1) >> 2) + fr) * NPJ + 1024 + h * 128 + 32 * ((2 * w + 1) & 3) + 8 * fq) * 2);
    o.g = (unsigned)(((tid >> 3) * NPJ + 1536 + h * 128 + 16 * (tid & 7)) * 2);
}
DEVI void ret_prefetch(const Params& p, RetPre& P, const RetOff& o, int b, int c) {
    const char* base = (const char*)p.proj + (size_t)(b * 2048 + c * 64) * (NPJ * 2);
    ASM_LD16(P.f[0], o.f, base, 0); ASM_LD16(P.f[1], o.f, base, 64); ASM_LD16(P.f[2], o.f, base, 128); ASM_LD16(P.f[3], o.f, base, 192);
    ASM_LD16(P.v[0], o.v0, base, 0); ASM_LD16(P.v[1], o.v1, base, 0);
    ASM_LD16(P.g[0], o.g, base, 0); ASM_LD16(P.g[1], o.g, base, 16);
}
DEVI void ret_retire(RetPre& P) {
    asm volatile("s_waitcnt vmcnt(0)" : "+v"(P.f[0]), "+v"(P.f[1]), "+v"(P.f[2]), "+v"(P.f[3]), "+v"(P.v[0]), "+v"(P.v[1]), "+v"(P.g[0]), "+v"(P.g[1]) :: "memory");
}
DEVI uint4 asu4(const u32x4_t& v) { return make_uint4(v[0], v[1], v[2], v[3]); }
DEVI void ret_block(const Params& p, char* smem, int b, int h) {
    char* qs = smem;
    char* ks_ = smem + 17408;
    char* kTs = smem + 34816;
    char* vTs = smem + 53248;
    char* Ss = smem + 71680;
    char* Os = smem + 80896;
    float* gn_s = (float*)(smem + 98304);
    const int tid = stid(), lane = tid & 63, w = tid >> 6, fr = lane & 15, fq = lane >> 4;
    const float gamma = 1.f - exp2f(-5.f - (float)h);
    const float l2g = log2f(gamma);
    const float g64 = exp2f(l2g * 64.f);
    bf16x8 sel[2];
    sel_frags(sel, fr, fq);
    f32x4 st[8];
#pragma unroll
    for (int i = 0; i < 8; ++i) st[i] = (f32x4){0.f, 0.f, 0.f, 0.f};
    if (tid < 128) gn_s[tid] = p.ret_norm_g[h * 128 + tid];
    __syncthreads();
    RetPre P;
    RetOff RO;
    ret_offsets(RO, h, tid);
    ret_prefetch(p, P, RO, b, 0);
    ret_retire(P);
#pragma unroll 1
    for (int c = 0; c < 32; ++c) {
        const int t0 = b * 2048 + c * 64;
        {
            const int mi = w & 3;
            char* dst = (w < 4 ? ks_ : qs) + (16 * mi + fr) * 272 + fq * 16;
#pragma unroll
            for (int ks = 0; ks < 4; ++ks) *(uint4*)(dst + ks * 64) = asu4(P.f[ks]);
            if (w < 4) {
                float kd[4];
#pragma unroll
                for (int r = 0; r < 4; ++r) kd[r] = exp2f(l2g * (float)(63 - (16 * mi + 4 * fq + r)));
#pragma unroll
                for (int ks = 0; ks < 4; ++ks) tr_store(kTs, u4_to_frag(asu4(P.f[ks])), sel, mi, ks, fr, fq, kd);
            }
            const float one[4] = {1.f, 1.f, 1.f, 1.f};
#pragma unroll
            for (int q = 0; q < 2; ++q) { const int pr = 2 * w + q; tr_store(vTs, u4_to_frag(asu4(P.v[q])), sel, pr >> 2, pr & 3, fr, fq, one); }
        }
        uint4 g0 = asu4(P.g[0]), g1 = asu4(P.g[1]);
        lds_barrier();
        ret_prefetch(p, P, RO, b, c + 1 < 32 ? c + 1 : 31);
        {
            const int lt = w & 3;
            bf16x8 qf[4];
#pragma unroll
            for (int s = 0; s < 4; ++s) qf[s] = ld8(qs + (16 * lt + fr) * 272 + (s * 4 + fq) * 16);
#pragma unroll
            for (int jj = 0; jj < 2; ++jj) {
                const int j = 2 * (w >> 2) + jj;
                f32x4 a = (f32x4){0.f, 0.f, 0.f, 0.f};
#pragma unroll
                for (int s = 0; s < 4; ++s) a = mfma16(ld8(ks_ + (16 * j + fr) * 272 + (s * 4 + fq) * 16), qf[s], a);
                const int l = 16 * lt + fr, mb = 16 * j + 4 * fq;
                float v[4];
#pragma unroll
                for (int r = 0; r < 4; ++r) { const int dd = l - (mb + r); v[r] = a[r] * exp2f(l2g * (float)(dd < 0 ? -dd : dd)); }
                *(uint2*)(Ss + l * 144 + mb * 2) = make_uint2(pk2(v[0], v[1]), pk2(v[2], v[3]));
            }
        }
        lds_barrier();
        {
            bf16x8 sp[4];
#pragma unroll
            for (int s = 0; s < 4; ++s) sp[s] = state_pack(st[2 * s], st[2 * s + 1]);
            bf16x8 vf[2];
#pragma unroll
            for (int s2 = 0; s2 < 2; ++s2) vf[s2] = ld8(vTs + (16 * w + fr) * 144 + (s2 * 4 + fq) * 16);
#pragma unroll
            for (int i = 0; i < 4; ++i) {
                f32x4 a = (f32x4){0.f, 0.f, 0.f, 0.f};
                const char* qrow = qs + (16 * i + fr) * 272;
#pragma unroll
                for (int s = 0; s < 4; ++s) {
                    const uint2 lo = *(const uint2*)(qrow + (32 * s + 4 * fq) * 2), hi = *(const uint2*)(qrow + (32 * s + 16 + 4 * fq) * 2);
                    a = mfma16(sp[s], mk8(lo, hi), a);
                }
                a = a * exp2f(l2g * (float)(16 * i + fr + 1));
#pragma unroll
                for (int s2 = 0; s2 < 2; ++s2) a = mfma16(vf[s2], ld8(Ss + (16 * i + fr) * 144 + (s2 * 4 + fq) * 16), a);
                *(uint2*)(Os + (16 * i + fr) * 272 + (16 * w + 4 * fq) * 2) = make_uint2(pk2(a[0], a[1]), pk2(a[2], a[3]));
            }
#pragma unroll
            for (int i = 0; i < 8; ++i) {
                f32x4 a = st[i] * g64;
#pragma unroll
                for (int s2 = 0; s2 < 2; ++s2) a = mfma16(ld8(kTs + (16 * i + fr) * 144 + (s2 * 4 + fq) * 16), vf[s2], a);
                st[i] = a;
            }
        }
        lds_barrier();
        pin_u4(g0); pin_u4(g1);
        {
            const int l = tid >> 3, part = tid & 7;
            const uint4 o0 = *(const uint4*)(Os + l * 272 + part * 32), o1 = *(const uint4*)(Os + l * 272 + part * 32 + 16);
            const unsigned ow[8] = {o0.x, o0.y, o0.z, o0.w, o1.x, o1.y, o1.z, o1.w}, gw[8] = {g0.x, g0.y, g0.z, g0.w, g1.x, g1.y, g1.z, g1.w};
            float x[16], s = 0.f;
#pragma unroll
            for (int e = 0; e < 8; ++e) { x[2 * e] = bflo(ow[e]); x[2 * e + 1] = bfhi(ow[e]); s += x[2 * e] + x[2 * e + 1]; }
            const float mu = grp8_sum(s) * (1.f / 128.f);
            float q = 0.f;
#pragma unroll
            for (int e = 0; e < 16; ++e) { x[e] -= mu; q += x[e] * x[e]; }
            const float rstd = rsqrtf(grp8_sum(q) * (1.f / 128.f) + EPSN);
            const float* gn = gn_s + 16 * part;
            unsigned yo[8];
#pragma unroll
            for (int e = 0; e < 8; ++e) {
                const float ga = bflo(gw[e]), gb = bfhi(gw[e]);
                yo[e] = pk2(ga * sigmoidf_(ga) * x[2 * e] * rstd * gn[2 * e], gb * sigmoidf_(gb) * x[2 * e + 1] * rstd * gn[2 * e + 1]);
            }
            ret_retire(P);
            uint4* yp = (uint4*)(p.yb + (size_t)(t0 + l) * 1024 + h * 128 + 16 * part);
            yp[0] = make_uint4(yo[0], yo[1], yo[2], yo[3]);
            yp[1] = make_uint4(yo[4], yo[5], yo[6], yo[7]);
        }
    }
}

struct MlPre { u32x4_t f[4]; u32x4_t v[2]; u32x4_t o[2]; u32x4_t cc[2]; };
struct MlOff { unsigned f, v0, v1, o, c, g; };
DEVI void ml_offsets(const Params& p, MlOff& o, int h, int tid) {
    const int lane = tid & 63, w = tid >> 6, fr = lane & 15, fq = lane >> 4, mi = w & 3;
    const unsigned kdiff = (unsigned)((const char*)p.mk - (const char*)p.mq);
    o.f = (unsigned)(((16 * mi + fr) * 512 + h * 128 + 8 * fq) * 2) + (w < 4 ? kdiff : 0u);
    o.v0 = (unsigned)(((16 * ((2 * w) >> 2) + fr) * NPJ + 2560 + h * 128 + 32 * ((2 * w) & 3) + 8 * fq) * 2);
    o.v1 = (unsigned)(((16 * ((2 * w + 1) >> 2) + fr) * NPJ + 2560 + h * 128 + 32 * ((2 * w + 1) & 3) + 8 * fq) * 2);
    o.o = (unsigned)(((tid >> 3) * NPJ + 3072 + h * 128 + 16 * (tid & 7)) * 2);
    o.c = (unsigned)(((tid >> 3) * 512 + h * 128 + 16 * (tid & 7)) * 2);
    o.g = (unsigned)((lane * 4 + h) * 4);
}
DEVI void ml_prefetch(const Params& p, MlPre& P, const MlOff& o, int b, int c) {
    const size_t t0 = (size_t)(b * 2048 + c * 64);
    const char* bq = (const char*)p.mq + t0 * 1024, *bp = (const char*)p.proj + t0 * (NPJ * 2), *bc = (const char*)p.cbuf + t0 * 1024;
    ASM_LD16(P.f[0], o.f, bq, 0); ASM_LD16(P.f[1], o.f, bq, 64); ASM_LD16(P.f[2], o.f, bq, 128); ASM_LD16(P.f[3], o.f, bq, 192);
    ASM_LD16(P.v[0], o.v0, bp, 0); ASM_LD16(P.v[1], o.v1, bp, 0);
    ASM_LD16(P.o[0], o.o, bp, 0); ASM_LD16(P.o[1], o.o, bp, 16);
    ASM_LD16(P.cc[0], o.c, bc, 0); ASM_LD16(P.cc[1], o.c, bc, 16);
}
DEVI void ml_retire(MlPre& P) {
    asm volatile("s_waitcnt vmcnt(0)" : "+v"(P.f[0]), "+v"(P.f[1]), "+v"(P.f[2]), "+v"(P.f[3]), "+v"(P.v[0]), "+v"(P.v[1]), "+v"(P.o[0]), "+v"(P.o[1]),
                 "+v"(P.cc[0]), "+v"(P.cc[1]) :: "memory");
}
DEVI void mlstm_block(const Params& p, char* smem, int b, int h) {
    char* qs = smem;
    char* kTs = smem + 17408;
    char* vTs = smem + 35840;
    char* Os = smem + 54272;
    float* n_s = (float*)(smem + 71680);
    float* den_s = (float*)(smem + 72192);
    float* gn_s = (float*)(smem + 72448);
    float* sk_s = gn_s + 128;
    float* lw_s = sk_s + 128;
    float* ac_s = lw_s + 32 * 64;
    float* mi_s = ac_s + 32;
    const int tid = stid(), lane = tid & 63, w = tid >> 6, fr = lane & 15, fq = lane >> 4;
    bf16x8 sel[2];
    sel_frags(sel, fr, fq);
    f32x4 st[8];
#pragma unroll
    for (int i = 0; i < 8; ++i) st[i] = (f32x4){0.f, 0.f, 0.f, 0.f};
    float m_run = 0.f;
    f32x4 nacc = (f32x4){0.f, 0.f, 0.f, 0.f};
    bf16x8 ones;
#pragma unroll
    for (int j = 0; j < 8; ++j) ones[j] = (short)0x3F80;
    if (tid < 128) { gn_s[tid] = p.m_norm_g[h * 128 + tid]; sk_s[tid] = p.m_skip[h * 128 + tid]; }
#pragma unroll
    for (int q = 0; q < 4; ++q) {
        const int cc = 4 * w + q, tt = b * 2048 + cc * 64 + lane;
        const float iv = p.ipre[tt * 4 + h], fv = p.logf[tt * 4 + h];
        float fcum = fv;
#pragma unroll
        for (int o = 1; o < 64; o <<= 1) { const float tv = __shfl_up(fcum, o); if (lane >= o) fcum += tv; }
        const float a_c = __shfl(fcum, 63);
        const float logw = a_c - fcum + iv;
        const float m_in = wave_max(logw);
        lw_s[cc * 64 + lane] = logw;
        if (lane == 0) { ac_s[cc] = a_c; mi_s[cc] = m_in; }
    }
    __syncthreads();
    MlPre P;
    MlOff MO;
    ml_offsets(p, MO, h, tid);
    ml_prefetch(p, P, MO, b, 0);
    ml_retire(P);
#pragma unroll 1
    for (int c = 0; c < 32; ++c) {
        const int t0 = b * 2048 + c * 64;
        const float a_c = ac_s[c], m_in = mi_s[c], logw = lw_s[c * 64 + lane];
        const float m_new = fmaxf(a_c + m_run, m_in);
        const float decay = fexp_(a_c + m_run - m_new);
        const float wgt = fexp_(logw - m_new);
        const float emn = fexp_(-m_new);
        m_run = m_new;
        {
            const int mi = w & 3;
            if (w < 4) {
                float kw[4];
#pragma unroll
                for (int r = 0; r < 4; ++r) kw[r] = __shfl(wgt, 16 * mi + 4 * fq + r);
#pragma unroll
                for (int ks = 0; ks < 4; ++ks) tr_store(kTs, u4_to_frag(asu4(P.f[ks])), sel, mi, ks, fr, fq, kw);
            } else {
                char* dst = qs + (16 * mi + fr) * 272 + fq * 16;
#pragma unroll
                for (int ks = 0; ks < 4; ++ks) *(uint4*)(dst + ks * 64) = asu4(P.f[ks]);
            }
            const float one[4] = {1.f, 1.f, 1.f, 1.f};
#pragma unroll
            for (int q = 0; q < 2; ++q) { const int pr = 2 * w + q; tr_store(vTs, u4_to_frag(asu4(P.v[q])), sel, pr >> 2, pr & 3, fr, fq, one); }
        }
        uint4 mo0 = asu4(P.o[0]), mo1 = asu4(P.o[1]), cc0 = asu4(P.cc[0]), cc1 = asu4(P.cc[1]);
        lds_barrier();
        ml_prefetch(p, P, MO, b, c + 1 < 32 ? c + 1 : 31);
        {
            f32x4 a = nacc * decay;
#pragma unroll
            for (int s2 = 0; s2 < 2; ++s2) a = mfma16(ld8(kTs + (16 * w + fr) * 144 + (s2 * 4 + fq) * 16), ones, a);
            nacc = a;
            if (fr == 0) *(f32x4*)(n_s + 16 * w + 4 * fq) = a;
        }
        {
            bf16x8 vf[2];
#pragma unroll
            for (int s2 = 0; s2 < 2; ++s2) vf[s2] = ld8(vTs + (16 * w + fr) * 144 + (s2 * 4 + fq) * 16);
#pragma unroll
            for (int i = 0; i < 8; ++i) {
                f32x4 a = st[i] * decay;
#pragma unroll
                for (int s2 = 0; s2 < 2; ++s2) a = mfma16(ld8(kTs + (16 * i + fr) * 144 + (s2 * 4 + fq) * 16), vf[s2], a);
                st[i] = a;
            }
        }
        lds_barrier();
        {
            const int l = tid >> 3, part = tid & 7;
            const uint4 a0 = *(const uint4*)(qs + l * 272 + part * 32), a1 = *(const uint4*)(qs + l * 272 + part * 32 + 16);
            const unsigned aw[8] = {a0.x, a0.y, a0.z, a0.w, a1.x, a1.y, a1.z, a1.w};
            const float* nn = n_s + 16 * part;
            float s = 0.f;
#pragma unroll
            for (int e = 0; e < 8; ++e) s += bflo(aw[e]) * nn[2 * e] + bfhi(aw[e]) * nn[2 * e + 1];
            s = grp8_sum(s);
            if (part == 0) den_s[l] = fmaxf(fabsf(s), emn);
        }
        lds_barrier();
        {
            bf16x8 sp[4];
#pragma unroll
            for (int s = 0; s < 4; ++s) sp[s] = state_pack(st[2 * s], st[2 * s + 1]);
#pragma unroll
            for (int i = 0; i < 4; ++i) {
                f32x4 a = (f32x4){0.f, 0.f, 0.f, 0.f};
                const char* qrow = qs + (16 * i + fr) * 272;
#pragma unroll
                for (int s = 0; s < 4; ++s) {
                    const uint2 lo = *(const uint2*)(qrow + (32 * s + 4 * fq) * 2), hi = *(const uint2*)(qrow + (32 * s + 16 + 4 * fq) * 2);
                    a = mfma16(sp[s], mk8(lo, hi), a);
                }
                const float rd = rcp_(den_s[16 * i + fr]);
                *(uint2*)(Os + (16 * i + fr) * 272 + (16 * w + 4 * fq) * 2) = make_uint2(pk2(a[0] * rd, a[1] * rd), pk2(a[2] * rd, a[3] * rd));
            }
        }
        lds_barrier();
        pin_u4(mo0); pin_u4(mo1); pin_u4(cc0); pin_u4(cc1);
        {
            const int l = tid >> 3, part = tid & 7;
            const uint4 o0 = *(const uint4*)(Os + l * 272 + part * 32), o1 = *(const uint4*)(Os + l * 272 + part * 32 + 16);
            const unsigned ow[8] = {o0.x, o0.y, o0.z, o0.w, o1.x, o1.y, o1.z, o1.w};
            const unsigned gw[8] = {mo0.x, mo0.y, mo0.z, mo0.w, mo1.x, mo1.y, mo1.z, mo1.w}, cw[8] = {cc0.x, cc0.y, cc0.z, cc0.w, cc1.x, cc1.y, cc1.z, cc1.w};
            float x[16], s = 0.f;
#pragma unroll
            for (int e = 0; e < 8; ++e) { x[2 * e] = bflo(ow[e]); x[2 * e + 1] = bfhi(ow[e]); s += x[2 * e] + x[2 * e + 1]; }
            const float mu = grp8_sum(s) * (1.f / 128.f);
            float q = 0.f;
#pragma unroll
            for (int e = 0; e < 16; ++e) { x[e] -= mu; q += x[e] * x[e]; }
            const float rstd = rsqrtf(grp8_sum(q) * (1.f / 128.f) + EPSN);
            const float* gn = gn_s + 16 * part;
            const float* sk = sk_s + 16 * part;
            unsigned yo[8];
#pragma unroll
            for (int e = 0; e < 8; ++e) {
                const float ya = sigmoidf_(bflo(gw[e])) * (x[2 * e] * rstd * gn[2 * e] + sk[2 * e] * bflo(cw[e]));
                const float yb_ = sigmoidf_(bfhi(gw[e])) * (x[2 * e + 1] * rstd * gn[2 * e + 1] + sk[2 * e + 1] * bfhi(cw[e]));
                yo[e] = pk2(ya, yb_);
            }
            ml_retire(P);
            uint4* yp = (uint4*)(p.yb + (size_t)(t0 + l) * 1024 + 512 + h * 128 + 16 * part);
            yp[0] = make_uint4(yo[0], yo[1], yo[2], yo[3]);
            yp[1] = make_uint4(yo[4], yo[5], yo[6], yo[7]);
        }
    }
}
DEVI void st_recur(const Params& p, char* smem) {
    if (blockIdx.x >= 128 || gridDim.x <= 128) {
        const int bid = gridDim.x > 128 ? (int)blockIdx.x - 128 : (int)blockIdx.x, nb = gridDim.x > 128 ? (int)gridDim.x - 128 : (int)gridDim.x;
        st_prep_w2(p, smem, bid, nb);
        st_prep_wsub(p, smem, bid, nb);
        st_prep_tables(p, bid, nb);
        if (gridDim.x > 128) return;
    }
    for (int bi = blockIdx.x; bi < 128; bi += gridDim.x) {
        const int kind = bi & 1, h = (bi >> 1) & 3, b = bi >> 3;
        if (kind == 0) ret_block(p, smem, b, h);
        else mlstm_block(p, smem, b, h);
        __syncthreads();
    }
}

constexpr float KEY_BIAS = 64.f;
DEVI int f2key(float f) { const int b = __float_as_int(f); return b ^ ((b >> 31) & 0x7fffffff); }
DEVI float key2f(int k) { return __int_as_float(k ^ ((k >> 31) & 0x7fffffff)); }
template <int N> DEVI void bsort_desc(int (&v)[N]) {
#pragma unroll
    for (int k = 2; k <= N; k <<= 1)
#pragma unroll
        for (int j = k >> 1; j > 0; j >>= 1)
#pragma unroll
            for (int i = 0; i < N; ++i) {
                const int l = i ^ j;
                if (l > i) {
                    const int a = v[i], b = v[l];
                    const int mx = a > b ? a : b, mn = a > b ? b : a;
                    if ((i & k) == 0) { v[i] = mx; v[l] = mn; } else { v[i] = mn; v[l] = mx; }
                }
            }
}
template <int N> DEVI void bmerge_desc(int (&v)[N]) {
#pragma unroll
    for (int j = N >> 1; j > 0; j >>= 1)
#pragma unroll
        for (int i = 0; i < N; ++i) {
            const int l = i ^ j;
            if (l > i) { const int a = v[i], b = v[l]; v[i] = a > b ? a : b; v[l] = a > b ? b : a; }
        }
}
DEVI void xmerge16(int (&v)[16], int mask) {
    int o[16];
#pragma unroll
    for (int i = 0; i < 16; ++i) o[i] = __shfl_xor(v[15 - i], mask);
#pragma unroll
    for (int i = 0; i < 16; ++i) v[i] = v[i] > o[i] ? v[i] : o[i];
    bmerge_desc<16>(v);
}
__device__ const unsigned char cand_tab[52] = {
    0x00, 0x01, 0x02, 0x03, 0x04, 0x05, 0x06, 0x07, 0x08, 0x09, 0x0a, 0x0b, 0x0c, 0x0d, 0x0e, 0x0f,
    0x10, 0x11, 0x12, 0x13, 0x14, 0x15, 0x16, 0x17, 0x20, 0x21, 0x22, 0x23, 0x24, 0x30, 0x31, 0x32, 0x33,
    0x40, 0x41, 0x42, 0x50, 0x51, 0x60, 0x61, 0x70, 0x71, 0x80, 0x90, 0xa0, 0xb0, 0xc0, 0xd0, 0xe0, 0xf0, 0xff, 0xff};
constexpr int H_A = 256 * 64, H_B = 256 * 64, H_STAGE = H_A + H_B;
constexpr int H_LIST = 3 * H_STAGE;
DEVI void glds16(const void* g, char* l) {
    __builtin_amdgcn_global_load_lds((const __attribute__((address_space(1))) unsigned*)g, (__attribute__((address_space(3))) unsigned*)l, 16, 0, 0);
}
DEVI void gemm3_topk_tile(const Params& p, int m0, int h, char* smem) {
    const int tid = stid(), lane = tid & 63, w = tid >> 6, wt = w >> 1, wp = w & 1, fr = lane & 15, fq = lane >> 4;
    i32x4 acc[4][8];
#pragma unroll
    for (int i = 0; i < 4; ++i)
#pragma unroll
        for (int j = 0; j < 8; ++j) acc[i][j] = (i32x4){0, 0, 0, 0};
    const int r16 = lane >> 2, csrc = (lane & 3) ^ ((r16 >> 2) & 3);
    const unsigned char* srcA = p.xq + (size_t)(m0 + w * 32 + r16) * 1024 + csrc * 16;
    const unsigned char* srcB = (const unsigned char*)p.Wsubq + ((size_t)h * 256 + w * 32 + r16) * 1024 + csrc * 16;
    char* dstA = smem + (w * 32) * 64 + lane * 16;
    char* dstB = smem + H_A + (w * 32) * 64 + lane * 16;
    auto issue = [&](int kt, int buf) {
#pragma unroll
        for (int q = 0; q < 2; ++q) glds16(srcA + (size_t)q * 16 * 1024 + kt * 64, dstA + buf * H_STAGE + q * 1024);
#pragma unroll
        for (int q = 0; q < 2; ++q) glds16(srcB + (size_t)q * 16 * 1024 + kt * 64, dstB + buf * H_STAGE + q * 1024);
    };
    const int rdoff = fr * 64 + ((fq ^ ((fr >> 2) & 3)) * 16);
    issue(0, 0);
    issue(1, 1);
    asm volatile("s_waitcnt vmcnt(4)" ::: "memory");
    __builtin_amdgcn_s_barrier();
    int buf = 0;
#pragma unroll 1
    for (int kt = 0; kt < 16; ++kt) {
        const int b2 = buf >= 1 ? buf - 1 : 2;
        if (kt + 2 < 16) issue(kt + 2, b2);
        const char* As = smem + buf * H_STAGE + (wt * 64) * 64 + rdoff;
        const char* Bs = smem + buf * H_STAGE + H_A + (wp * 128) * 64 + rdoff;
        i32x4 a[4];
#pragma unroll
        for (int i = 0; i < 4; ++i) a[i] = *(const i32x4*)(As + (16 * i) * 64);
#pragma unroll
        for (int jg = 0; jg < 2; ++jg) {
            i32x4 b[4];
#pragma unroll
            for (int j = 0; j < 4; ++j) b[j] = *(const i32x4*)(Bs + (16 * (4 * jg + j)) * 64);
#pragma unroll
            for (int i = 0; i < 4; ++i)
#pragma unroll
                for (int j = 0; j < 4; ++j) acc[i][4 * jg + j] = __builtin_amdgcn_mfma_i32_16x16x64_i8(b[j], a[i], acc[i][4 * jg + j], 0, 0, 0);
        }
        if (kt + 2 < 16) asm volatile("s_waitcnt vmcnt(4)" ::: "memory");
        else asm volatile("s_waitcnt vmcnt(0)" ::: "memory");
        __builtin_amdgcn_s_barrier();
        buf = buf == 2 ? 0 : buf + 1;
    }
    float4 ws[8];
#pragma unroll
    for (int j = 0; j < 8; ++j) ws[j] = *(const float4*)(p.wsc + h * 256 + wp * 128 + 16 * j + 4 * fq);
    int* LX = (int*)(smem + H_LIST);
#pragma unroll
    for (int i = 0; i < 4; ++i) {
        const int tl = 64 * wt + 16 * i + fr;
        const float rs = rs2_of(p.rs2p, m0 + tl) * ZQ_SCALE;
        int ka[16], kb[16];
#pragma unroll
        for (int jj = 0; jj < 4; ++jj)
#pragma unroll
            for (int r = 0; r < 4; ++r) {
                const float sa = r == 0 ? ws[jj].x : r == 1 ? ws[jj].y : r == 2 ? ws[jj].z : ws[jj].w;
                const float sb = r == 0 ? ws[4 + jj].x : r == 1 ? ws[4 + jj].y : r == 2 ? ws[4 + jj].z : ws[4 + jj].w;
                ka[jj * 4 + r] = (__float_as_int((float)acc[i][jj][r] * (sa * rs) + KEY_BIAS) & ~127) | (16 * jj + 4 * fq + r);
                kb[jj * 4 + r] = (__float_as_int((float)acc[i][4 + jj][r] * (sb * rs) + KEY_BIAS) & ~127) | (16 * (jj + 4) + 4 * fq + r);
            }
        bsort_desc<16>(ka);
        bsort_desc<16>(kb);
#pragma unroll
        for (int q = 0; q < 16; ++q) ka[q] = ka[q] > kb[15 - q] ? ka[q] : kb[15 - q];
        bmerge_desc<16>(ka);
        xmerge16(ka, 16);
        xmerge16(ka, 32);
        const int k0 = fq == 0 ? ka[0] : fq == 1 ? ka[4] : fq == 2 ? ka[8] : ka[12];
        const int k1 = fq == 0 ? ka[1] : fq == 1 ? ka[5] : fq == 2 ? ka[9] : ka[13];
        const int k2 = fq == 0 ? ka[2] : fq == 1 ? ka[6] : fq == 2 ? ka[10] : ka[14];
        const int k3 = fq == 0 ? ka[3] : fq == 1 ? ka[7] : fq == 2 ? ka[11] : ka[15];
        *(int4*)(LX + tl * 32 + wp * 16 + 4 * fq) = make_int4(k0, k1, k2, k3);
    }
    __syncthreads();
#pragma unroll
    for (int i2 = 0; i2 < 2; ++i2) {
        const int tl = 32 * w + 16 * i2 + fr, t = m0 + tl;
        const int* L = LX + tl * 32;
        const unsigned long long clo = fq == 0 ? 0x0706050403020100ull : fq == 1 ? 0x14131211100f0e0dull : fq == 2 ? 0x4033323130242322ull : 0xc0b0a09080717061ull;
        const unsigned long long chi = fq == 0 ? 0x0c0b0a0908ull : fq == 1 ? 0x2120171615ull : fq == 2 ? 0x6051504241ull : 0xfffff0e0d0ull;
        int c[16];
#pragma unroll
        for (int s = 0; s < 13; ++s) {
            const int ab = (int)((s < 8 ? (clo >> (8 * s)) : (chi >> (8 * (s - 8)))) & 0xffull);
            const int k1 = L[ab >> 4], k2 = L[16 + (ab & 15)];
            const float v = (__int_as_float(k1 & ~127) - KEY_BIAS) + (__int_as_float(k2 & ~127) - KEY_BIAS);
            c[s] = (f2key(v) & ~0x3fff) | ((k1 & 127) << 7) | (k2 & 127);
        }
        c[13] = c[14] = c[15] = (int)0x80000000;
        bsort_desc<16>(c);
        xmerge16(c, 16);
        xmerge16(c, 32);
        const float vmax = key2f(c[0] & ~0x3fff);
        float e[16], sum = 0.f;
#pragma unroll
        for (int q = 0; q < 16; ++q) { e[q] = fexp_(key2f(c[q] & ~0x3fff) - vmax); sum += e[q]; }
        const float inv = rcp_(sum);
        int ce[4]; float ge[4];
#pragma unroll
        for (int q = 0; q < 4; ++q) {
            const int cq = fq == 0 ? c[q] : fq == 1 ? c[4 + q] : fq == 2 ? c[8 + q] : c[12 + q];
            const float eq = fq == 0 ? e[q] : fq == 1 ? e[4 + q] : fq == 2 ? e[8 + q] : e[12 + q];
            ce[q] = ((cq >> 7) & 127) * 128 + (cq & 127);
            ge[q] = eq * inv;
        }
        *(uint2*)(p.eperm + (size_t)t * 128 + h * 16 + 4 * fq) = make_uint2((unsigned)ce[0] | ((unsigned)ce[1] << 16), (unsigned)ce[2] | ((unsigned)ce[3] << 16));
        *(float4*)(p.gate + (size_t)t * 128 + h * 16 + 4 * fq) = make_float4(ge[0], ge[1], ge[2], ge[3]);
    }
    __syncthreads();
}
DEVI void st_gemm3_topk(const Params& p, char* smem) {
    for (int it = blockIdx.x; it < 128 * 8; it += gridDim.x) gemm3_topk_tile(p, (it >> 3) * 256, it & 7, smem);
}

#define XB_TMO      128
#define XB_XCNT(j)  (256  + 64 * (j))
#define XB_XSUB(j)  (1280 + 64 * (j))
#define XB_XGEN(j)  (2304 + 64 * (j))
#define XB_TOP      3328
#define XB_TOPGEN   3392
#define XCD_BAR_WORDS 3456
#define XB_SPIN_CAP (1u << 20)
#define LAS __attribute__((address_space(3)))
DEVI unsigned xb_ld(unsigned* p) { return __hip_atomic_load(p, __ATOMIC_RELAXED, __HIP_MEMORY_SCOPE_AGENT); }
DEVI unsigned xb_add(unsigned* p, unsigned v) { return __hip_atomic_fetch_add(p, v, __ATOMIC_RELAXED, __HIP_MEMORY_SCOPE_AGENT); }
DEVI unsigned xb_xcc_id() { return (unsigned)__builtin_amdgcn_s_getreg((3 << 11) | 20) & 0xFu; }
#define XB_SPIN(cond, bar) do { unsigned _sp = 0; while (cond) { __builtin_amdgcn_s_sleep(1); \
    if ((++_sp & 255u) == 0u) { if (xb_ld(&(bar)[XB_TMO])) break; if (_sp > XB_SPIN_CAP) { atomicAdd(&(bar)[XB_TMO], 1u); break; } } } } while (0)
struct XcdBarrier { unsigned* bar; unsigned x; volatile LAS unsigned* st; };
DEVI XcdBarrier xcd_barrier_post(unsigned* bar, volatile LAS unsigned* st) {
    XcdBarrier b; b.bar = bar; b.x = xb_xcc_id(); b.st = st;
    if (stid() == 0) (void)xb_add(&bar[XB_XCNT(b.x)], 1u);
    return b;
}
DEVI void xcd_barrier_complete(unsigned* bar, unsigned x, unsigned& nloc, unsigned& nx) {
    const unsigned G = gridDim.x * gridDim.y * gridDim.z;
    unsigned sum, cnt, mine, sp = 0u;
    for (;;) {
        sum = 0u; cnt = 0u; mine = 0u;
#pragma unroll
        for (unsigned j = 0; j < 16; ++j) { const unsigned c = xb_ld(&bar[XB_XCNT(j)]); sum += c; cnt += (c > 0u) ? 1u : 0u; mine = (j == x) ? c : mine; }
        if (sum == G) break;
        __builtin_amdgcn_s_sleep(1);
        if ((++sp & 255u) == 0u) { if (xb_ld(&bar[XB_TMO])) break; if (sp > XB_SPIN_CAP) { atomicAdd(&bar[XB_TMO], 1u); break; } }
    }
    nloc = mine > 0u ? mine : 1u; nx = cnt > 0u ? cnt : 1u;
}
DEVI void xcd_barrier(const XcdBarrier& b) {
    asm volatile("s_waitcnt vmcnt(0)" ::: "memory");
    __syncthreads();
    if (stid() == 0) {
        unsigned* bar = b.bar;
        __builtin_amdgcn_s_waitcnt(0);
        unsigned nloc = b.st[0], nx = b.st[1];
        if (nloc == 0u) { xcd_barrier_complete(bar, b.x, nloc, nx); b.st[0] = nloc; b.st[1] = nx; }
        const unsigned old = xb_add(&bar[XB_XSUB(b.x)], 1u);
        const unsigned gen = old / nloc;
        if (old + 1u == (gen + 1u) * nloc) {
            __builtin_amdgcn_fence(__ATOMIC_RELEASE, "agent");
            asm volatile("s_waitcnt vmcnt(0)" ::: "memory");
            const unsigned og = xb_add(&bar[XB_TOP], 1u);
            const unsigned tg = og / nx;
            if (og + 1u == (tg + 1u) * nx) xb_add(&bar[XB_TOPGEN], 1u);
            else XB_SPIN(xb_ld(&bar[XB_TOPGEN]) == tg, bar);
            __builtin_amdgcn_fence(__ATOMIC_ACQUIRE, "agent");
            xb_add(&bar[XB_XGEN(b.x)], 1u);
            asm volatile("s_waitcnt vmcnt(0)" ::: "memory");
        } else {
            XB_SPIN(xb_ld(&bar[XB_XGEN(b.x)]) == gen, bar);
            __builtin_amdgcn_fence(__ATOMIC_ACQUIRE, "agent");
            asm volatile("s_waitcnt vmcnt(0)" ::: "memory");
        }
    }
    __syncthreads();
}

#define CTR_A(x) (XCD_BAR_WORDS + 64 * (x))
#define CTR_B(x) (XCD_BAR_WORDS + 512 + 64 * (x))
#define CTL_WORDS (XCD_BAR_WORDS + 1024)
typedef float f32x2 __attribute__((ext_vector_type(2)));
DEVI float ub(unsigned w, int n) { return (float)((w >> (8 * n)) & 0xffu); }
DEVI float gelu_erf(float v) {
    const float av = fabsf(v), t = rcp_(av * 0.2316418882f + 1.0f);
    float q = t * 0.5307027145f + (-0.7265760135f);
    q = q * t + 0.7107068705f; q = q * t + (-0.142248368f); q = q * t + 0.127414796f; q = q * t;
    const float e = __builtin_amdgcn_exp2f((v * v) * (-0.72134752044f));
    const float m = v * (q * e);
    return v < 0.f ? m : v - m;
}
struct ExpMeta { uint4 e[2]; uint4 xa; float sc; };
struct ExpRows { uint4 r[16]; unsigned x1; };

template <int PHASE> DEVI void exp_load_meta(const Params& p, ExpMeta& m, int t, int x, int lane) {
    const uint4* ep = (const uint4*)(p.eperm + (size_t)t * 128 + (lane >> 3) * 16);
    m.e[0] = ep[0];
    m.e[1] = ep[1];
    if (PHASE == 0) m.xa = *(const uint4*)(p.xq + (size_t)t * 1024 + 128 * x + 16 * (lane & 7));
    else { m.xa = *(const uint4*)(p.aq + (size_t)t * 128 + (lane >> 3) * 16); m.sc = p.asc[t]; }
}
template <int PHASE> DEVI void exp_issue(const Params& p, const ExpMeta& m, ExpRows& R, int t, int x, int lane) {
    const unsigned char* base = (PHASE == 0 ? p.down_q : p.up_q) + (size_t)x * (16384 * 128) + (lane & 7) * 16;
    const unsigned ew[8] = {m.e[0].x, m.e[0].y, m.e[0].z, m.e[0].w, m.e[1].x, m.e[1].y, m.e[1].z, m.e[1].w};
#pragma unroll
    for (int j = 0; j < 16; ++j) {
        const unsigned ek = (j & 1) ? (ew[j >> 1] >> 16) : (ew[j >> 1] & 0xffffu);
        R.r[j] = *(const uint4*)(base + (size_t)ek * 128);
    }
    if (PHASE == 1) {
        const int col = 128 * x + 16 * (lane & 7) + ((lane & 32) ? 8 : 0) + ((lane & 16) ? 4 : 0) + ((lane & 8) ? 2 : 0);
        R.x1 = *(const unsigned*)(p.x1b + (size_t)t * 1024 + col);
    }
}
DEVI void expA_compute(const Params& p, const ExpMeta& m, const ExpRows& R, int t, int x, int lane) {
    const bool b2 = lane & 4, b1 = lane & 2, b0 = lane & 1;
    int ps[16];
#pragma unroll
    for (int j = 0; j < 16; ++j)
        ps[j] = __builtin_amdgcn_sdot4((int)R.r[j].x, (int)m.xa.x, __builtin_amdgcn_sdot4((int)R.r[j].y, (int)m.xa.y,
                __builtin_amdgcn_sdot4((int)R.r[j].z, (int)m.xa.z, __builtin_amdgcn_sdot4((int)R.r[j].w, (int)m.xa.w, 0, false), false), false), false);
    int q8[8], q4[4], q2[2];
#pragma unroll
    for (int j = 0; j < 8; ++j) { const int snd = b2 ? ps[j] : ps[j + 8], kp = b2 ? ps[j + 8] : ps[j]; q8[j] = kp + dpp_i<DPP_HMIRROR>(snd); }
#pragma unroll
    for (int j = 0; j < 4; ++j) { const int snd = b1 ? q8[j] : q8[j + 4], kp = b1 ? q8[j + 4] : q8[j]; q4[j] = kp + dpp_i<DPP_XOR2>(snd); }
#pragma unroll
    for (int j = 0; j < 2; ++j) { const int snd = b0 ? q4[j] : q4[j + 2], kp = b0 ? q4[j + 2] : q4[j]; q2[j] = kp + dpp_i<DPP_XOR1>(snd); }
    {
        int s0 = q2[0] >> 3, s1 = q2[1] >> 3;
        s0 = s0 > 32767 ? 32767 : (s0 < -32768 ? -32768 : s0);
        s1 = s1 > 32767 ? 32767 : (s1 < -32768 ? -32768 : s1);
        *(unsigned*)(p.part + ((size_t)x * T_TOK + t) * 128 + 2 * lane) = ((unsigned)s0 & 0xffffu) | ((unsigned)s1 << 16);
    }
}
DEVI void expB_compute(const Params& p, const ExpMeta& m, const ExpRows& R, int t, int x, int lane) {
    const bool b5 = lane & 32, b4 = lane & 16, b3 = lane & 8;
    const unsigned pa[4] = {m.xa.x, m.xa.y, m.xa.z, m.xa.w};
    int acc[16];
#pragma unroll
    for (int c = 0; c < 16; ++c) acc[c] = 0;
#pragma unroll
    for (int g = 0; g < 4; ++g) {
        const unsigned r0[4] = {R.r[4 * g].x, R.r[4 * g].y, R.r[4 * g].z, R.r[4 * g].w};
        const unsigned r1[4] = {R.r[4 * g + 1].x, R.r[4 * g + 1].y, R.r[4 * g + 1].z, R.r[4 * g + 1].w};
        const unsigned r2[4] = {R.r[4 * g + 2].x, R.r[4 * g + 2].y, R.r[4 * g + 2].z, R.r[4 * g + 2].w};
        const unsigned r3[4] = {R.r[4 * g + 3].x, R.r[4 * g + 3].y, R.r[4 * g + 3].z, R.r[4 * g + 3].w};
#pragma unroll
        for (int i = 0; i < 4; ++i) {
            const unsigned t0 = __builtin_amdgcn_perm(r1[i], r0[i], 0x05010400u), t1 = __builtin_amdgcn_perm(r1[i], r0[i], 0x07030602u);
            const unsigned t2 = __builtin_amdgcn_perm(r3[i], r2[i], 0x05010400u), t3 = __builtin_amdgcn_perm(r3[i], r2[i], 0x07030602u);
            const unsigned o0 = __builtin_amdgcn_perm(t2, t0, 0x05040100u), o1 = __builtin_amdgcn_perm(t2, t0, 0x07060302u);
            const unsigned o2 = __builtin_amdgcn_perm(t3, t1, 0x05040100u), o3 = __builtin_amdgcn_perm(t3, t1, 0x07060302u);
            acc[4 * i + 0] = __builtin_amdgcn_sdot4((int)o0, (int)pa[g], acc[4 * i + 0], false);
            acc[4 * i + 1] = __builtin_amdgcn_sdot4((int)o1, (int)pa[g], acc[4 * i + 1], false);
            acc[4 * i + 2] = __builtin_amdgcn_sdot4((int)o2, (int)pa[g], acc[4 * i + 2], false);
            acc[4 * i + 3] = __builtin_amdgcn_sdot4((int)o3, (int)pa[g], acc[4 * i + 3], false);
        }
    }
    int q8[8], q4[4], q2[2];
#pragma unroll
    for (int j = 0; j < 8; ++j) {
        const auto r = __builtin_amdgcn_permlane32_swap((unsigned)acc[j], (unsigned)acc[j + 8], false, false);
        q8[j] = (int)r[0] + (int)r[1];
    }
#pragma unroll
    for (int j = 0; j < 4; ++j) {
        const auto r = __builtin_amdgcn_permlane16_swap((unsigned)q8[j], (unsigned)q8[j + 4], false, false);
        q4[j] = (int)r[0] + (int)r[1];
    }
#pragma unroll
    for (int j = 0; j < 2; ++j) { const int snd = b3 ? q4[j] : q4[j + 2], kp = b3 ? q4[j + 2] : q4[j]; q2[j] = kp + dpp_i<DPP_ROR8>(snd); }
    const int col = 128 * x + 16 * (lane & 7) + (b5 ? 8 : 0) + (b4 ? 4 : 0) + (b3 ? 2 : 0);
    *(unsigned*)(p.proj + (size_t)t * 1024 + col) = pk2(bflo(R.x1) + (float)q2[0] * m.sc, bfhi(R.x1) + (float)q2[1] * m.sc);
}
constexpr int EXP_NP = 16;
template <int PHASE>
DEVI void exp_chunk(const Params& p, int tb, int x, int lane) {
    ExpMeta mA, mB, nA, nB;
    ExpRows rA, rB;
    exp_load_meta<PHASE>(p, mA, tb, x, lane);
    exp_load_meta<PHASE>(p, mB, tb + 1, x, lane);
    exp_issue<PHASE>(p, mA, rA, tb, x, lane);
    exp_issue<PHASE>(p, mB, rB, tb + 1, x, lane);
    exp_load_meta<PHASE>(p, nA, tb + 2, x, lane);
    exp_load_meta<PHASE>(p, nB, tb + 3, x, lane);
#pragma unroll 1
    for (int i = 0; i < EXP_NP; ++i) {
        const int tA = tb + 2 * i, tB = tA + 1;
        if (PHASE == 0) expA_compute(p, mA, rA, tA, x, lane); else expB_compute(p, mA, rA, tA, x, lane);
        if (i < EXP_NP - 1) {
            mA = nA;
            exp_issue<PHASE>(p, mA, rA, tA + 2, x, lane);
            if (i < EXP_NP - 2) exp_load_meta<PHASE>(p, nA, tA + 4, x, lane);
        }
        if (PHASE == 0) expA_compute(p, mB, rB, tB, x, lane); else expB_compute(p, mB, rB, tB, x, lane);
        if (i < EXP_NP - 1) {
            mB = nB;
            exp_issue<PHASE>(p, mB, rB, tB + 2, x, lane);
            if (i < EXP_NP - 2) exp_load_meta<PHASE>(p, nB, tB + 4, x, lane);
        }
    }
}
template <int PHASE>
DEVI void st_expAB(const Params& p, char* smem) {
    const int tid = stid(), lane = tid & 63, wid = tid >> 6;
    volatile int* cs = (volatile int*)smem;
    const unsigned myx = xb_xcc_id() & 7u;
    constexpr int NCH = T_TOK / (2 * EXP_NP * NW);
    for (int si = 0; si < 8; ++si) {
        const int x = (int)((myx + si) & 7u);
        unsigned* ctr = &p.bar[PHASE == 0 ? CTR_A(x) : CTR_B(x)];
        if (tid == 0) cs[0] = (int)xb_add(ctr, 1u);
        __syncthreads();
        int chunk = cs[0];
        __syncthreads();
        while (chunk < NCH) {
            int nxt = 0;
            if (tid == 0) nxt = (int)xb_add(ctr, 1u);
            exp_chunk<PHASE>(p, chunk * (2 * EXP_NP * NW) + wid * (2 * EXP_NP), x, lane);
            if (tid == 0) cs[0] = nxt;
            __syncthreads();
            chunk = cs[0];
            __syncthreads();
        }
    }
}
DEVI void st_expA2(const Params& p) {
    const int lane = stid() & 63, wid = stid() >> 6;
    for (int t0 = (blockIdx.x * NW + wid) * 2; t0 < T_TOK; t0 += gridDim.x * NW * 2) {
        unsigned pv[2][8], ew[2];
        float2 g[2];
        float xs[2];
#pragma unroll
        for (int q = 0; q < 2; ++q) {
            const int t = t0 + q;
#pragma unroll
            for (int x = 0; x < 8; ++x) pv[q][x] = *(const unsigned*)(p.part + ((size_t)x * T_TOK + t) * 128 + 2 * lane);
            ew[q] = *(const unsigned*)(p.eperm + (size_t)t * 128 + 2 * lane);
            g[q] = *(const float2*)(p.gate + (size_t)t * 128 + 2 * lane);
            xs[q] = rs2_of(p.rs2p, t) * (8.f * ZQ_SCALE);
        }
        float ds[2][2], us[2][2];
#pragma unroll
        for (int q = 0; q < 2; ++q) {
            const int ea = (int)(ew[q] & 0xffffu), eb = (int)(ew[q] >> 16);
            ds[q][0] = p.dscale[ea]; ds[q][1] = p.dscale[eb]; us[q][0] = p.uscale[ea]; us[q][1] = p.uscale[eb];
        }
#pragma unroll
        for (int q = 0; q < 2; ++q) {
            const int t = t0 + q;
            int s0 = 0, s1 = 0;
#pragma unroll
            for (int x = 0; x < 8; ++x) { s0 += (int)(short)(pv[q][x] & 0xffffu); s1 += (int)pv[q][x] >> 16; }
            const float a0 = g[q].x * gelu_erf((float)s0 * xs[q] * ds[q][0]) * us[q][0];
            const float a1 = g[q].y * gelu_erf((float)s1 * xs[q] * ds[q][1]) * us[q][1];
            const float amax = wave_max(fmaxf(fabsf(a0), fabsf(a1)));
            const float inv = amax > 0.f ? 127.f * rcp_(amax) : 0.f;
            const unsigned q0 = (unsigned)((int)rintf(a0 * inv) & 255), q1 = (unsigned)((int)rintf(a1 * inv) & 255);
            *(unsigned short*)(p.aq + (size_t)t * 128 + 2 * lane) = (unsigned short)(q0 | (q1 << 8));
            if (lane == 0) p.asc[t] = amax * (1.f / 127.f);
        }
    }
}
DEVI void st_expC(const Params& p) {
    const int lane = stid() & 63, wid = stid() >> 6;
    for (int t0 = (blockIdx.x * NW + wid) * 2; t0 < T_TOK; t0 += gridDim.x * NW * 2) {
        uint2 u[2][4];
#pragma unroll
        for (int q = 0; q < 2; ++q) {
            const uint2* row = (const uint2*)(p.proj + (size_t)(t0 + q) * 1024);
#pragma unroll
            for (int j = 0; j < 4; ++j) u[q][j] = row[lane + 64 * j];
        }
#pragma unroll
        for (int q = 0; q < 2; ++q) {
            float4 v[4];
            float ss = 0.f;
#pragma unroll
            for (int j = 0; j < 4; ++j) {
                v[j] = make_float4(bflo(u[q][j].x), bfhi(u[q][j].x), bflo(u[q][j].y), bfhi(u[q][j].y));
                ss += v[j].x * v[j].x + v[j].y * v[j].y + v[j].z * v[j].z + v[j].w * v[j].w;
            }
            ss = wave_sum(ss);
            const float rf = rsqrtf(ss * (1.f / 1024.f) + EPSN);
            float4* orow = (float4*)(p.out + (size_t)(t0 + q) * 1024);
#pragma unroll
            for (int j = 0; j < 4; ++j) {
                const float4 g = *(const float4*)(p.final_g + (lane + 64 * j) * 4);
                orow[lane + 64 * j] = make_float4(v[j].x * rf * g.x, v[j].y * rf * g.y, v[j].z * rf * g.z, v[j].w * rf * g.w);
            }
        }
    }
}

constexpr int LDS_BYTES = 147456;
constexpr int LDS_BARW = LDS_BYTES - 16;
extern __shared__ __attribute__((aligned(16))) char smem_dyn[];
__global__ void __launch_bounds__(NTHR, 2) mega_fwd(Params p) {
    cg::grid_group grid = cg::this_grid();
    volatile LAS unsigned* bst = (volatile LAS unsigned*)(LAS char*)(smem_dyn + LDS_BARW);
    if (stid() < 4) bst[stid()] = 0u;
    __syncthreads();
    XcdBarrier bar = xcd_barrier_post(p.bar, bst);
    st_prep_misc(p);
    st_prep_w1(p, smem_dyn);
    st_prep_x(p, smem_dyn);
    if (p.pad_[0] == 0x7fffabcd) grid.sync();
    xcd_barrier(bar);
    st_gemm8<EpiProj8, PG8_ALIGN>(p.xb, p.W1t, NPJ, 1024, smem_dyn, EpiProj8{p.proj, p.rs1, p.rope_cos, p.rope_sin});
    xcd_barrier(bar);
    st_conv_qk(p, smem_dyn);
    xcd_barrier(bar);
    st_recur(p, smem_dyn);
    xcd_barrier(bar);
    st_gemm8<EpiX18, PG8_ALIGN>(p.yb, p.W2t, 1024, 1024, smem_dyn, EpiX18{p.x, p.x1b, p.xq, p.rs2p, p.norm2_g});
    xcd_barrier(bar);
    st_gemm3_topk(p, smem_dyn);
    xcd_barrier(bar);
    st_expAB<0>(p, smem_dyn);
    xcd_barrier(bar);
    st_expA2(p);
    xcd_barrier(bar);
    st_expAB<1>(p, smem_dyn);
    xcd_barrier(bar);
    st_expC(p);
}

extern "C" void kernel_launch(void* const* d_in, const int* in_sizes, int n_in, void* d_out, int out_size, void* d_ws, size_t ws_size,
                              hipStream_t stream) {
    Params p{};
    const float* const* in = (const float* const*)d_in;
    p.x = in[0]; p.norm1_g = in[1]; p.w_in = in[2]; p.ret_norm_g = in[3]; p.m_conv_w = in[4]; p.m_conv_b = in[5]; p.m_wq = in[6]; p.m_wk = in[7];
    p.m_b_i = in[8]; p.m_b_f = in[9]; p.m_norm_g = in[10]; p.m_skip = in[11]; p.w_out = in[12]; p.norm2_g = in[13]; p.peer_wq = in[14];
    p.peer_keys = in[15]; p.peer_down = in[16]; p.peer_up = in[17]; p.final_g = in[18];
    p.out = (float*)d_out;
    char* ws = (char*)d_ws;
    size_t off = 0;
    auto take = [&](size_t bytes) { char* r = ws + off; off += (bytes + 255) & ~(size_t)255; return r; };
    p.proj = (bf16_t*)take((size_t)T_TOK * NPJ * 2);
    p.xb = (bf16_t*)take((size_t)T_TOK * 1024 * 2);
    p.yb = p.xb;
    p.gate = (float*)(ws + (size_t)T_TOK * 2048 * 4);
    p.mq = (bf16_t*)take((size_t)T_TOK * 512 * 2);
    p.mk = (bf16_t*)take((size_t)T_TOK * 512 * 2);
    p.x1b = p.mq;
    p.cbuf = (bf16_t*)take((size_t)T_TOK * 512 * 2);
    p.eperm = (unsigned short*)p.cbuf;
    p.down_q = (unsigned char*)take((size_t)16384 * 1024);
    p.up_q = (unsigned char*)take((size_t)16384 * 1024);
    p.dscale = (float*)take(16384 * 4);
    p.uscale = (float*)take(16384 * 4);
    p.bar = (unsigned*)take(CTL_WORDS * 4);
    p.xq = (unsigned char*)take((size_t)T_TOK * 1024);
    p.asc = (float*)take(T_TOK * 4);
    p.aq = (unsigned char*)take((size_t)T_TOK * 128);
    p.part = (short*)(ws + (size_t)T_TOK * 1024 * 4);
    p.W1t = (bf16_t*)take((size_t)NPJ * 1024 * 2);
    p.W2t = (bf16_t*)take((size_t)1024 * 1024 * 2);
    p.Wsubq = (signed char*)take((size_t)2048 * 1024);
    p.wsc = (float*)take(2048 * 4);
    p.Wqt = (bf16_t*)take(4 * 128 * 128 * 2);
    p.Wkt = (bf16_t*)take(4 * 128 * 128 * 2);
    p.rs1 = (float*)take(T_TOK * 4);
    p.rs2p = (float*)take((size_t)T_TOK * 16 * 4);
    p.ipre = (float*)take(T_TOK * 4 * 4);
    p.logf = (float*)take(T_TOK * 4 * 4);
    p.rope_cos = (float*)take(2048 * 64 * 4);
    p.rope_sin = (float*)take(2048 * 64 * 4);
    if (off > ws_size) { fprintf(stderr, "kernel_launch: workspace too small (%zu > %zu)\n", off, ws_size); return; }

    static int grid_blocks = 0;
    if (!grid_blocks) {
        int dev = 0, cus = 0, per_cu = 0;
        (void)hipGetDevice(&dev);
        (void)hipDeviceGetAttribute(&cus, hipDeviceAttributeMultiprocessorCount, dev);
        (void)hipFuncSetAttribute((const void*)mega_fwd, hipFuncAttributeMaxDynamicSharedMemorySize, LDS_BYTES);
        (void)hipOccupancyMaxActiveBlocksPerMultiprocessor(&per_cu, (const void*)mega_fwd, NTHR, LDS_BYTES);
        if (per_cu > 1) per_cu = 1;
        if (per_cu < 1) per_cu = 1;
        grid_blocks = cus * per_cu;
    }
    (void)hipMemsetAsync(p.bar, 0, CTL_WORDS * 4, stream);
    void* args[] = {&p};
    hipError_t e = hipLaunchCooperativeKernel((const void*)mega_fwd, dim3(grid_blocks), dim3(NTHR), args, LDS_BYTES, stream);
    if (e != hipSuccess) fprintf(stderr, "cooperative launch failed: %s (grid %d)\n", hipGetErrorString(e), grid_blocks);
}
```

```cpp
#include <hip/hip_runtime.h>
#include <hip/hip_cooperative_groups.h>
#include <stdint.h>
#include <cstdio>
namespace cg = cooperative_groups;

typedef unsigned short bf16_t;
typedef short bf16x8 __attribute__((ext_vector_type(8)));
typedef float f32x4 __attribute__((ext_vector_type(4)));
typedef int i32x4 __attribute__((ext_vector_type(4)));

#define DEVI __device__ __forceinline__
__device__ __forceinline__ int stid() { int t = (int)threadIdx.x; asm volatile("" : "+v"(t)); return t; }

constexpr int T_TOK = 32768, DM = 1024, NPJ = 3584, DIN = 3592;
constexpr int NTHR = 512, NW = 8;
constexpr float EPSN = 1e-6f;

struct Params {
    const float *x, *norm1_g, *w_in, *ret_norm_g, *m_conv_w, *m_conv_b, *m_wq, *m_wk, *m_b_i, *m_b_f, *m_norm_g, *m_skip, *w_out,
        *norm2_g, *peer_wq, *peer_keys, *peer_down, *peer_up, *final_g;
    float* out;
    bf16_t *proj, *xb, *yb, *mq, *mk, *x1b, *cbuf, *W1t, *W2t, *Wqt, *Wkt;
    signed char* Wsubq;
    float* wsc;
    unsigned char *down_q, *up_q;
    float *dscale, *uscale, *asc;
    unsigned short* eperm;
    unsigned char* aq;
    short* part;
    unsigned char* xq;
    unsigned* bar;
    float *rs1, *rs2p, *ipre, *logf, *rope_cos, *rope_sin, *gate;
    int pad_[2];
};

DEVI unsigned f2bf_bits(float f) { unsigned u = __float_as_uint(f); return (u + 0x7fffu + ((u >> 16) & 1u)) >> 16; }
DEVI bf16_t f2bf(float f) { return __builtin_bit_cast(bf16_t, (__bf16)f); }
typedef __bf16 bf16x2_t __attribute__((ext_vector_type(2)));
DEVI unsigned pk2(float lo, float hi) { bf16x2_t v = {(__bf16)lo, (__bf16)hi}; return __builtin_bit_cast(unsigned, v); }
DEVI float bflo(unsigned w) { return __uint_as_float(w << 16); }
DEVI float bfhi(unsigned w) { return __uint_as_float(w & 0xffff0000u); }
DEVI float bf2f(bf16_t h) { return __uint_as_float(((unsigned)h) << 16); }
template <int CTRL> DEVI float dpp_f(float v) { return __int_as_float(__builtin_amdgcn_update_dpp(0, __float_as_int(v), CTRL, 0xf, 0xf, false)); }
template <int CTRL> DEVI int dpp_i(int v) { return __builtin_amdgcn_update_dpp(0, v, CTRL, 0xf, 0xf, false); }
constexpr int DPP_XOR1 = 0xB1  , DPP_XOR2 = 0x4E  , DPP_HMIRROR = 0x141  ,
              DPP_MIRROR = 0x140  , DPP_ROR8 = 0x128  ;
DEVI float rl_f(float v, int l) { return __int_as_float(__builtin_amdgcn_readlane(__float_as_int(v), l)); }
DEVI float wave_sum(float v) {
    v += dpp_f<DPP_XOR1>(v); v += dpp_f<DPP_XOR2>(v); v += dpp_f<DPP_HMIRROR>(v); v += dpp_f<DPP_MIRROR>(v);
    return (rl_f(v, 0) + rl_f(v, 16)) + (rl_f(v, 32) + rl_f(v, 48));
}
DEVI float wave_max(float v) {
    v = fmaxf(v, dpp_f<DPP_XOR1>(v)); v = fmaxf(v, dpp_f<DPP_XOR2>(v)); v = fmaxf(v, dpp_f<DPP_HMIRROR>(v)); v = fmaxf(v, dpp_f<DPP_MIRROR>(v));
    return fmaxf(fmaxf(rl_f(v, 0), rl_f(v, 16)), fmaxf(rl_f(v, 32), rl_f(v, 48)));
}
constexpr float ZQ_SCALE = 6.f / 127.f;
DEVI float rs2_of(const float* rs2p, int t) {
    const float4* q = (const float4*)(rs2p + (size_t)t * 16);
    const float4 a = q[0], b = q[1], c = q[2], d = q[3];
    const float ss = ((a.x + a.y) + (a.z + a.w)) + ((b.x + b.y) + (b.z + b.w)) + ((c.x + c.y) + (c.z + c.w)) + ((d.x + d.y) + (d.z + d.w));
    return rsqrtf(ss * (1.f / 1024.f) + EPSN);
}
DEVI f32x4 mfma16(bf16x8 a, bf16x8 b, f32x4 c) { return __builtin_amdgcn_mfma_f32_16x16x32_bf16(a, b, c, 0, 0, 0); }
DEVI bf16x8 ld8(const char* p) { return *reinterpret_cast<const bf16x8*>(p); }
DEVI bf16x8 mk8(uint2 lo, uint2 hi) {
    union { uint4 u; bf16x8 v; } x;
    x.u = make_uint4(lo.x, lo.y, hi.x, hi.y);
    return x.v;
}
DEVI float fexp_(float x) { return __builtin_amdgcn_exp2f(x * 1.4426950408889634f); }
DEVI float rcp_(float x) { return __builtin_amdgcn_rcpf(x); }
DEVI float sigmoidf_(float z) { return rcp_(1.f + fexp_(-z)); }

DEVI void st_prep_misc(const Params& p) {
    const int gtid = blockIdx.x * NTHR + stid(), gsz = gridDim.x * NTHR;
    for (int i = gtid; i < 2048 * 64; i += gsz) {
        const int pos = i >> 6, j = i & 63;
        const float inv = powf(10000.f, -(float)j * (1.f / 64.f));
        const float ang = (float)pos * inv;
        float s, c;
        sincosf(ang, &s, &c);
        p.rope_cos[i] = c;
        p.rope_sin[i] = s;
    }
    for (int i = gtid; i < 4 * 128 * 128; i += gsz) {
        const int h = i >> 14, e = (i >> 7) & 127, d = i & 127;
        p.Wqt[i] = f2bf(p.m_wq[h * 16384 + d * 128 + e]);
        p.Wkt[i] = f2bf(p.m_wk[h * 16384 + d * 128 + e] * 0.08838834764831845f);
    }
}
DEVI void prep_table_row(const Params& p, int row, const float4 (&v)[4], int lane) {
    const bool up = row >= 16384;
    const int e = up ? row - 16384 : row;
    float am = 0.f;
#pragma unroll
    for (int i = 0; i < 4; ++i) am = fmaxf(am, fmaxf(fmaxf(fabsf(v[i].x), fabsf(v[i].y)), fmaxf(fabsf(v[i].z), fabsf(v[i].w))));
    am = wave_max(am);
    const float sc = am > 0.f ? am * (1.f / 127.f) : 1.f, inv = am > 0.f ? 127.f * rcp_(am) : 0.f;
    unsigned w[4];
#pragma unroll
    for (int i = 0; i < 4; ++i) {
        const int q0 = (int)rintf(v[i].x * inv), q1 = (int)rintf(v[i].y * inv), q2 = (int)rintf(v[i].z * inv), q3 = (int)rintf(v[i].w * inv);
        w[i] = (unsigned)(q0 & 255) | ((unsigned)(q1 & 255) << 8) | ((unsigned)(q2 & 255) << 16) | ((unsigned)(q3 & 255) << 24);
    }
    *(uint4*)((up ? p.up_q : p.down_q) + ((size_t)(lane >> 3) * 16384 + e) * 128 + (lane & 7) * 16) = make_uint4(w[0], w[1], w[2], w[3]);
    if (lane == 0) (up ? p.uscale : p.dscale)[e] = sc;
}
DEVI void st_prep_tables(const Params& p, int bid, int nb) {
    const int lane = stid() & 63, wid = stid() >> 6;
    for (int row = (bid * NW + wid) * 2; row < 32768; row += nb * NW * 2) {
        float4 va[4], vb[4];
        const float4* sa = (const float4*)((row >= 16384 ? p.peer_up + (size_t)(row - 16384) * 1024 : p.peer_down + (size_t)row * 1024) + lane * 16);
        const float4* sb = (const float4*)((row + 1 >= 16384 ? p.peer_up + (size_t)(row + 1 - 16384) * 1024 : p.peer_down + (size_t)(row + 1) * 1024) + lane * 16);
#pragma unroll
        for (int i = 0; i < 4; ++i) { va[i] = sa[i]; vb[i] = sb[i]; }
        prep_table_row(p, row, va, lane);
        prep_table_row(p, row + 1, vb, lane);
    }
}

DEVI void transpose_tile(const float* __restrict__ src, int ld, const float* __restrict__ scale, bf16_t* __restrict__ dst, int K, int k0, int n0,
                         float* tile, bool permqk = false) {
    const int tid = stid();
    {
        const int tx = tid & 63, ty = tid >> 6;
#pragma unroll
        for (int i = 0; i < 4; ++i) {
            const int k = k0 + ty + 8 * i;
            float v = src[(size_t)k * ld + n0 + tx];
            if (scale) v *= scale[k];
            tile[(ty + 8 * i) * 65 + tx] = v;
        }
    }
    __syncthreads();
    {
        const int n = tid >> 3, kq = tid & 7;
        const float a = tile[(4 * kq) * 65 + n], b = tile[(4 * kq + 1) * 65 + n], c = tile[(4 * kq + 2) * 65 + n], d = tile[(4 * kq + 3) * 65 + n];
        int nn = n0 + n;
        if (permqk && nn < 1024) { const int dd = nn & 127; nn = (nn & ~127) + (dd < 64 ? 2 * dd : 2 * (dd - 64) + 1); }
        *(uint2*)(dst + (size_t)nn * K + k0 + 4 * kq) = make_uint2(pk2(a, b), pk2(c, d));
    }
    __syncthreads();
}
DEVI void st_prep_w1(const Params& p, char* smem) {
    float* tile = (float*)smem;
    for (int it = blockIdx.x; it < 56 * 32; it += gridDim.x) transpose_tile(p.w_in, DIN, p.norm1_g, p.W1t, 1024, (it & 31) * 32, (it >> 5) * 64, tile, true);
}
DEVI void st_prep_w2(const Params& p, char* smem, int bid, int nb) {
    float* tile = (float*)smem;
    for (int it = bid; it < 16 * 32; it += nb) transpose_tile(p.w_out, 1024, nullptr, p.W2t, 1024, (it & 31) * 32, (it >> 5) * 64, tile);
}
DEVI void st_prep_wsub(const Params& p, char* smem, int bid, int nb) {
    float* wq_s = (float*)smem;
    float* key_s = wq_s + 64 * 132;
    const int tid = stid(), nl = tid >> 5, kp = tid & 31;
    for (int it = bid; it < 16 * 8; it += nb) {
        const int grp = it >> 3, n0 = (it & 7) * 16;
        __syncthreads();
        {
            const int idx = tid * 4, n = idx >> 7, d = idx & 127;
            *(float4*)(key_s + n * 132 + d) = *(const float4*)(p.peer_keys + ((size_t)grp * 128 + n0 + n) * 128 + d);
        }
        float v0[16], v1[16];
#pragma unroll 1
        for (int kt = 0; kt < 16; ++kt) {
            __syncthreads();
#pragma unroll
            for (int i = 0; i < 4; ++i) {
                const int idx = (tid + 512 * i) * 4, r = idx >> 7, d = idx & 127;
                *(float4*)(wq_s + r * 132 + d) = *(const float4*)(p.peer_wq + (size_t)(kt * 64 + r) * 2048 + grp * 128 + d);
            }
            __syncthreads();
            float a0 = 0.f, a1 = 0.f;
#pragma unroll 8
            for (int d4 = 0; d4 < 32; ++d4) {
                const float4 w0 = *(const float4*)(wq_s + (2 * kp) * 132 + 4 * d4), w1 = *(const float4*)(wq_s + (2 * kp + 1) * 132 + 4 * d4);
                const float4 y = *(const float4*)(key_s + nl * 132 + 4 * d4);
                a0 += w0.x * y.x + w0.y * y.y + w0.z * y.z + w0.w * y.w;
                a1 += w1.x * y.x + w1.y * y.y + w1.z * y.z + w1.w * y.w;
            }
#pragma unroll
            for (int q = 0; q < 16; ++q) if (q == kt) { v0[q] = a0; v1[q] = a1; }
        }
        float am = 0.f;
#pragma unroll
        for (int q = 0; q < 16; ++q) am = fmaxf(am, fmaxf(fabsf(v0[q]), fabsf(v1[q])));
#pragma unroll
        for (int o = 16; o; o >>= 1) am = fmaxf(am, __shfl_xor(am, o));
        const float inv = am > 0.f ? 127.f * rcp_(am) : 0.f;
        signed char* orow = p.Wsubq + (size_t)(grp * 128 + n0 + nl) * 1024 + 2 * kp;
#pragma unroll
        for (int q = 0; q < 16; ++q) {
            const int q0 = (int)rintf(v0[q] * inv), q1 = (int)rintf(v1[q] * inv);
            *(unsigned short*)(orow + 64 * q) = (unsigned short)((q0 & 255) | ((q1 & 255) << 8));
        }
        if (kp == 0) p.wsc[grp * 128 + n0 + nl] = am > 0.f ? am * (1.f / 127.f) : 1.f;
    }
    __syncthreads();
}

DEVI void prep_x_token(const Params& p, const float* Wg_s, int t, const float4 (&v)[4], int lane) {
    float ss = 0.f, g8[8];
#pragma unroll
    for (int g = 0; g < 8; ++g) g8[g] = 0.f;
#pragma unroll
    for (int j = 0; j < 4; ++j) {
        ss += v[j].x * v[j].x + v[j].y * v[j].y + v[j].z * v[j].z + v[j].w * v[j].w;
#pragma unroll
        for (int g = 0; g < 8; ++g) {
            const float4 w = *(const float4*)(Wg_s + g * 1024 + (lane + 64 * j) * 4);
            g8[g] += v[j].x * w.x + v[j].y * w.y + v[j].z * w.z + v[j].w * w.w;
        }
    }
    ss = wave_sum(ss);
    const bool b5 = lane & 32, b4 = lane & 16, b3 = lane & 8;
    float q4[4], q2[2], q1;
#pragma unroll
    for (int j = 0; j < 4; ++j) { const float snd = b5 ? g8[j] : g8[j + 4], kp = b5 ? g8[j + 4] : g8[j]; q4[j] = kp + __shfl_xor(snd, 32); }
#pragma unroll
    for (int j = 0; j < 2; ++j) { const float snd = b4 ? q4[j] : q4[j + 2], kp = b4 ? q4[j + 2] : q4[j]; q2[j] = kp + __shfl_xor(snd, 16); }
    { const float snd = b3 ? q2[0] : q2[1], kp = b3 ? q2[1] : q2[0]; q1 = kp + __shfl_xor(snd, 8); }
    q1 += __shfl_xor(q1, 4);
    q1 += __shfl_xor(q1, 2);
    q1 += __shfl_xor(q1, 1);
    const float rs = rsqrtf(ss * (1.f / 1024.f) + EPSN);
    uint2* o = (uint2*)(p.xb + (size_t)t * 1024);
#pragma unroll
    for (int j = 0; j < 4; ++j) o[lane + 64 * j] = make_uint2(pk2(v[j].x, v[j].y), pk2(v[j].z, v[j].w));
    if (lane == 0) p.rs1[t] = rs;
    if ((lane & 7) == 0) {
        const int gi = (b5 ? 4 : 0) + (b4 ? 2 : 0) + (b3 ? 1 : 0);
        if (gi < 4) p.ipre[t * 4 + gi] = q1 * rs + p.m_b_i[gi];
        else {
            const float z = q1 * rs + p.m_b_f[gi - 4];
            p.logf[t * 4 + gi - 4] = fminf(z, 0.f) - log1pf(fexp_(-fabsf(z)));
        }
    }
}
DEVI void st_prep_x(const Params& p, char* smem) {
    float* Wg_s = (float*)smem;
    for (int i = stid(); i < 8192; i += NTHR) {
        const int k = i >> 3, g = i & 7;
        Wg_s[g * 1024 + k] = p.norm1_g[k] * p.w_in[(size_t)k * DIN + NPJ + g];
    }
    __syncthreads();
    const int lane = stid() & 63, wid = stid() >> 6;
    for (int t = (blockIdx.x * NW + wid) * 4; t < T_TOK; t += gridDim.x * NW * 4) {
        float4 v[4][4];
        const float4* xa = (const float4*)(p.x + (size_t)t * 1024);
#pragma unroll
        for (int q = 0; q < 4; ++q)
#pragma unroll
            for (int j = 0; j < 4; ++j) v[q][j] = xa[256 * q + lane + 64 * j];
#pragma unroll
        for (int q = 0; q < 4; ++q) prep_x_token(p, Wg_s, t + q, v[q], lane);
    }
    __syncthreads();
}

namespace pg8 {
#define PG8_LAS __attribute__((address_space(3)))
typedef unsigned short bf16_t;
typedef short bf16x8 __attribute__((ext_vector_type(8)));
typedef float f32x4 __attribute__((ext_vector_type(4)));
typedef unsigned u32x4 __attribute__((ext_vector_type(4)));
constexpr int BM = 256, BK = 64, HALF = 128, HTB = HALF * BK * 2  , STAGE_BYTES = 8 * HTB, NXCD = 8, WGM = 8;

__host__ __device__ __forceinline__ int lds_byte(int r, int c) { const int st = (r >> 4) * 2 + (c >> 5), rr = r & 15, cc = c & 31, ob = rr * 64 + cc * 2; return st * 1024 + (ob ^ (((ob >> 9) & 1) << 5)); }
__host__ __device__ __forceinline__ void stage_rc(int b, int& R, int& C) { const int st = b / 1024, sb = b % 1024, swz = sb ^ (((sb >> 9) & 1) << 5); R = (st >> 1) * 16 + swz / 64; C = (st & 1) * 32 + (swz % 64) / 2; }
__host__ __device__ __forceinline__ int perm32(int rho) { const int n = rho >> 4, i = rho & 15; return 8 * (i >> 2) + 4 * n + (i & 3); }

struct Unit { int pm, pn; };
struct Gemm { const bf16_t* A; const bf16_t* Bt; int M, N, K; };

struct StaticOrder {
    int nM, nN, nwg, G, c;
    __host__ __device__ void init(int M, int N, int G_, int c_) { nM = M / BM; nN = N / BM; nwg = nM * nN; G = G_; c = c_; }
    __host__ __device__ bool next(int i, Unit& u) const {
        const long L = (long)i * G + c; if (L >= nwg) return false;
        int wgid = (int)L; { const int q = nwg / NXCD, r = nwg % NXCD, xcd = wgid % NXCD, off = wgid / NXCD; wgid = (xcd < r ? xcd * (q + 1) : r * (q + 1) + (xcd - r) * q) + off; }
        const int nig = WGM * nN, gid = wgid / nig, fm = gid * WGM, gsz = (nM - fm) < WGM ? (nM - fm) : WGM;
        u.pm = fm + ((wgid % nig) % gsz); u.pn = (wgid % nig) / gsz; return true;
    }
    __device__ __forceinline__ void a_ready(const Unit&) const {}
    __device__ __forceinline__ void done(const Unit&) const {}
};

__device__ __forceinline__ unsigned cvt_pk_bf16(float lo, float hi) { unsigned r; asm volatile("v_cvt_pk_bf16_f32 %0, %1, %2" : "=v"(r) : "v"(lo), "v"(hi)); return r; }

template <class Epi, class Sched, bool ALIGN_EPI = false, bool SP2 = false>
__device__ __forceinline__ void gemm_phase(PG8_LAS unsigned char* lds, const Gemm g, const Sched& S, const Epi& E) {
    const int tid = stid(), wid = __builtin_amdgcn_readfirstlane(tid >> 6), lane = tid & 63, wr = wid >> 2, wc = wid & 3, fr = lane & 15, fq = lane >> 4;
    const int K = g.K, nt = K / BK;
    unsigned voffA[2], voffB[2];
#pragma unroll
    for (int i = 0; i < 2; ++i) { int R, C; stage_rc(tid * 16 + i * 8192, R, C); const int Rb = Epi::PERM ? ((R & ~31) + perm32(R & 31)) : R;
        voffA[i] = (unsigned)(R * K + C) * 2u; voffB[i] = (unsigned)(Rb * K + C) * 2u; }
    const size_t kstep = (size_t)(BK * 2);
    const size_t hstep = (size_t)HALF * K * 2;
    const size_t tstep = 2 * hstep;
    const unsigned ldsw = (unsigned)wid * 1024u;
    const int aoff = lds_byte(wr * 64 + fr, fq * 8), boff = lds_byte(wc * 32 + fr, fq * 8);
#define PG8_SA(b, h) (((b) * 2 + (h)) * HTB)
#define PG8_SB(b, h) ((4 + (b) * 2 + (h)) * HTB)
#define PG8_STAGE(bufoff, gbase, voff) do { _Pragma("unroll") for (int _i = 0; _i < 2; ++_i) \
        __builtin_amdgcn_global_load_lds((const unsigned*)((const char*)(gbase) + (voff)[_i]), (PG8_LAS unsigned*)(lds + (bufoff) + ldsw + _i * 8192), 16, 0, 0); } while (0)
#define PG8_LDA(dst, b, h) do { _Pragma("unroll") for (int m = 0; m < 4; ++m) _Pragma("unroll") for (int k = 0; k < 2; ++k) dst[m][k] = *(const PG8_LAS bf16x8*)(lds + PG8_SA(b, h) + aoff + m * 2048 + k * 1024); } while (0)
#define PG8_LDB(dst, b, h) do { _Pragma("unroll") for (int n = 0; n < 2; ++n) _Pragma("unroll") for (int k = 0; k < 2; ++k) dst[n][k] = *(const PG8_LAS bf16x8*)(lds + PG8_SB(b, h) + boff + n * 2048 + k * 1024); } while (0)
#define PG8_MMA(ai, bj, At, Bt) do { __builtin_amdgcn_s_setprio(1); _Pragma("unroll") for (int m = 0; m < 4; ++m) _Pragma("unroll") for (int n = 0; n < 2; ++n) _Pragma("unroll") for (int k = 0; k < 2; ++k) \
        acc[ai][bj][m][n] = __builtin_amdgcn_mfma_f32_16x16x32_bf16(Bt[n][k], At[m][k], acc[ai][bj][m][n], 0, 0, 0); __builtin_amdgcn_s_setprio(0); } while (0)
#define PG8_WAIT_V(n) asm volatile("s_waitcnt vmcnt(" #n ")" ::: "memory")
#define PG8_WAIT_L(n) asm volatile("s_waitcnt lgkmcnt(" #n ")" ::: "memory")
#define PG8_BAR __builtin_amdgcn_s_barrier()
#define PG8_SCHED __builtin_amdgcn_sched_barrier(0)
    Unit cur, nxt; int ui = 0;
    if (!S.next(0, cur)) return;
    f32x4 acc[2][2][4][2];
#pragma unroll
    for (int a = 0; a < 2; ++a)
#pragma unroll
        for (int b = 0; b < 2; ++b)
#pragma unroll
            for (int m = 0; m < 4; ++m)
#pragma unroll
                for (int n = 0; n < 2; ++n) acc[a][b][m][n] = (f32x4){0.f, 0.f, 0.f, 0.f};
    bf16x8 At[4][2], B0[2][2], B1[2][2];
    const char* cA = (const char*)g.A + (size_t)cur.pm * tstep; const char* cB = (const char*)g.Bt + (size_t)cur.pn * tstep;
    S.a_ready(cur);
    if constexpr (SP2) {
        PG8_STAGE(PG8_SB(0, 0), cB, voffB); PG8_STAGE(PG8_SB(0, 1), cB + hstep, voffB); PG8_STAGE(PG8_SA(0, 0), cA, voffA); PG8_STAGE(PG8_SA(0, 1), cA + hstep, voffA);
        if (wr == 1) PG8_BAR;
        PG8_WAIT_V(2); PG8_BAR;
        PG8_STAGE(PG8_SB(1, 0), cB + kstep, voffB); PG8_STAGE(PG8_SA(1, 0), cA + kstep, voffA); PG8_STAGE(PG8_SB(1, 1), cB + hstep + kstep, voffB);
        PG8_WAIT_V(6); PG8_BAR;
    } else {
        PG8_STAGE(PG8_SB(0, 0), cB, voffB); PG8_STAGE(PG8_SA(0, 0), cA, voffA); PG8_STAGE(PG8_SB(0, 1), cB + hstep, voffB); PG8_STAGE(PG8_SA(0, 1), cA + hstep, voffA);
        if (wr == 1) PG8_BAR;
        PG8_WAIT_V(4); PG8_BAR;
        PG8_STAGE(PG8_SB(1, 0), cB + kstep, voffB); PG8_STAGE(PG8_SA(1, 0), cA + kstep, voffA); PG8_STAGE(PG8_SB(1, 1), cB + hstep + kstep, voffB);
        PG8_WAIT_V(6); PG8_BAR;
    }
    for (;;) {
        const bool has_next = S.next(ui + 1, nxt);
        const char* nA = has_next ? (const char*)g.A + (size_t)nxt.pm * tstep : cA; const char* nB = has_next ? (const char*)g.Bt + (size_t)nxt.pn * tstep : cB;
        for (int t = 0; t < nt; t += 2) {
            const bool last = (t == nt - 2);
            const char* a1 = cA + (size_t)(t + 1) * kstep;
            const char* a2 = last ? nA : cA + (size_t)(t + 2) * kstep; const char* b2 = last ? nB : cB + (size_t)(t + 2) * kstep;
            const char* a3 = a2 + kstep; const char* b3 = b2 + kstep;
            if (last && has_next) S.a_ready(nxt);
            if constexpr (SP2) {
            PG8_LDB(B0, 0, 0); PG8_LDB(B1, 0, 1); PG8_SCHED; PG8_LDA(At, 0, 0); PG8_STAGE(PG8_SA(1, 1), a1 + hstep, voffA);
            PG8_WAIT_V(8); PG8_WAIT_L(0); PG8_BAR; PG8_MMA(0, 0, At, B0); PG8_MMA(0, 1, At, B1); PG8_BAR; PG8_SCHED;
            PG8_LDA(At, 0, 1); PG8_STAGE(PG8_SB(0, 0), b2, voffB); PG8_STAGE(PG8_SB(0, 1), b2 + hstep, voffB); PG8_STAGE(PG8_SA(0, 0), a2, voffA);
            PG8_WAIT_V(8); PG8_WAIT_L(0); PG8_BAR; PG8_MMA(1, 0, At, B0); PG8_MMA(1, 1, At, B1); PG8_BAR; PG8_SCHED;
            PG8_LDB(B0, 1, 0); PG8_LDB(B1, 1, 1); PG8_SCHED; PG8_LDA(At, 1, 0); PG8_STAGE(PG8_SA(0, 1), a2 + hstep, voffA);
            PG8_WAIT_V(8); PG8_WAIT_L(0); PG8_BAR; PG8_MMA(0, 0, At, B0); PG8_MMA(0, 1, At, B1); PG8_BAR; PG8_SCHED;
            PG8_LDA(At, 1, 1); PG8_STAGE(PG8_SB(1, 0), b3, voffB); PG8_STAGE(PG8_SB(1, 1), b3 + hstep, voffB); PG8_STAGE(PG8_SA(1, 0), a3, voffA);
            PG8_WAIT_V(8); PG8_WAIT_L(0); PG8_BAR; PG8_MMA(1, 0, At, B0); PG8_MMA(1, 1, At, B1); PG8_BAR; PG8_SCHED;
            } else {
            PG8_LDB(B0, 0, 0); PG8_SCHED; PG8_LDA(At, 0, 0); PG8_STAGE(PG8_SA(1, 1), a1 + hstep, voffA);
            PG8_WAIT_L(8); PG8_BAR; PG8_WAIT_L(0); PG8_MMA(0, 0, At, B0); PG8_BAR; PG8_SCHED;
            PG8_LDB(B1, 0, 1); PG8_STAGE(PG8_SB(0, 0), b2, voffB);
            PG8_BAR; PG8_WAIT_L(0); PG8_MMA(0, 1, At, B1); PG8_BAR;
            PG8_LDA(At, 0, 1); PG8_STAGE(PG8_SA(0, 0), a2, voffA);
            PG8_BAR; PG8_WAIT_L(0); PG8_MMA(1, 0, At, B0); PG8_BAR; PG8_SCHED;
            PG8_STAGE(PG8_SB(0, 1), b2 + hstep, voffB);
            PG8_WAIT_V(6); PG8_BAR; PG8_MMA(1, 1, At, B1); PG8_BAR;
            PG8_LDB(B0, 1, 0); PG8_SCHED; PG8_LDA(At, 1, 0); PG8_STAGE(PG8_SA(0, 1), a2 + hstep, voffA);
            PG8_WAIT_L(8); PG8_BAR; PG8_WAIT_L(0); PG8_MMA(0, 0, At, B0); PG8_BAR; PG8_SCHED;
            PG8_LDB(B1, 1, 1); PG8_STAGE(PG8_SB(1, 0), b3, voffB);
            PG8_BAR; PG8_WAIT_L(0); PG8_MMA(0, 1, At, B1); PG8_BAR;
            PG8_LDA(At, 1, 1); PG8_STAGE(PG8_SA(1, 0), a3, voffA);
            PG8_BAR; PG8_WAIT_L(0); PG8_MMA(1, 0, At, B0); PG8_BAR; PG8_SCHED;
            PG8_STAGE(PG8_SB(1, 1), b3 + hstep, voffB);
            PG8_WAIT_V(6); PG8_BAR; PG8_MMA(1, 1, At, B1); PG8_BAR;
            }
        }
        if constexpr (ALIGN_EPI) { if (wr == 0) PG8_BAR; }
        if constexpr (!Epi::AFTER_DRAIN) { E(acc, cur, wr, wc, fr, fq); S.done(cur); }
        if (!has_next) break;
#pragma unroll
        for (int a = 0; a < 2; ++a)
#pragma unroll
            for (int b = 0; b < 2; ++b)
#pragma unroll
                for (int m = 0; m < 4; ++m)
#pragma unroll
                    for (int n = 0; n < 2; ++n) acc[a][b][m][n] = (f32x4){0.f, 0.f, 0.f, 0.f};
        cur = nxt; cA = nA; cB = nB; ++ui;
        if constexpr (ALIGN_EPI) { if (wr == 1) PG8_BAR; }
    }
    PG8_WAIT_V(0);
    if constexpr (!ALIGN_EPI) { if (wr == 0) PG8_BAR; }
    PG8_BAR;
    if constexpr (Epi::AFTER_DRAIN) { E.fused(acc, cur, wr, wc, fr, fq, lds, wid, lane); S.done(cur); }
#undef PG8_SA
#undef PG8_SB
#undef PG8_STAGE
#undef PG8_LDA
#undef PG8_LDB
#undef PG8_MMA
#undef PG8_WAIT_V
#undef PG8_WAIT_L
#undef PG8_BAR
#undef PG8_SCHED
}
}

#ifndef PG8_SP2
#define PG8_SP2 true
#endif
#ifndef PG8_ALIGN
#define PG8_ALIGN true
#endif
struct EpiProj8 {
    static constexpr bool PERM = true, AFTER_DRAIN = false;
    bf16_t* O; const float* rs; const float* rcos; const float* rsin;
    __device__ __forceinline__ void operator()(const pg8::f32x4 (&acc)[2][2][4][2], const pg8::Unit& u, int wr, int wc, int fr, int fq) const {
        const int row0 = u.pm * 256 + wr * 64 + fr, col0 = u.pn * 256 + wc * 32 + 8 * fq;
        const bool rot = u.pn < 4;
        const float ksc = u.pn >= 2 ? 0.08838834764831845f : 1.f;
#pragma unroll
        for (int ai = 0; ai < 2; ++ai)
#pragma unroll
            for (int m = 0; m < 4; ++m) {
                const int row = row0 + ai * 128 + m * 16;
                const float s = rs[row];
                bf16_t* rowp = O + (size_t)row * NPJ + col0;
                float4 cs = make_float4(1.f, 1.f, 1.f, 1.f), sn = make_float4(0.f, 0.f, 0.f, 0.f);
                float s2 = s;
                if (rot) {
                    const int ti = (row & 2047) * 64 + 16 * wc + 4 * fq;
                    cs = *(const float4*)(rcos + ti);
                    sn = *(const float4*)(rsin + ti);
                    s2 = s * ksc;
                }
#pragma unroll
                for (int bj = 0; bj < 2; ++bj) {
                    const pg8::f32x4 v0 = acc[ai][bj][m][0] * s2, v1 = acc[ai][bj][m][1] * s2;
                    *(uint4*)(rowp + bj * 128) = make_uint4(pk2(v0[0] * cs.x - v0[1] * sn.x, v0[0] * sn.x + v0[1] * cs.x), pk2(v0[2] * cs.y - v0[3] * sn.y, v0[2] * sn.y + v0[3] * cs.y),
                                                            pk2(v1[0] * cs.z - v1[1] * sn.z, v1[0] * sn.z + v1[1] * cs.z), pk2(v1[2] * cs.w - v1[3] * sn.w, v1[2] * sn.w + v1[3] * cs.w));
                }
            }
    }
};
struct EpiX18 {
    static constexpr bool PERM = true, AFTER_DRAIN = false;
    const float* x; bf16_t* x1b; unsigned char* zq; float* rs2p; const float* g2;
    __device__ __forceinline__ void operator()(const pg8::f32x4 (&acc)[2][2][4][2], const pg8::Unit& u, int wr, int wc, int fr, int fq) const {
        const int row0 = u.pm * 256 + wr * 64 + fr, col0 = u.pn * 256 + wc * 32 + 8 * fq;
        float gq[2][8];
#pragma unroll
        for (int bj = 0; bj < 2; ++bj) {
            const float4 a = *(const float4*)(g2 + col0 + bj * 128), b = *(const float4*)(g2 + col0 + bj * 128 + 4);
            gq[bj][0] = a.x; gq[bj][1] = a.y; gq[bj][2] = a.z; gq[bj][3] = a.w; gq[bj][4] = b.x; gq[bj][5] = b.y; gq[bj][6] = b.z; gq[bj][7] = b.w;
        }
        float ssq[8];
#pragma unroll
        for (int ai = 0; ai < 2; ++ai)
#pragma unroll
            for (int m = 0; m < 4; ++m) {
                const size_t ro = (size_t)(row0 + ai * 128 + m * 16) * 1024 + col0;
                float s = 0.f;
#pragma unroll
                for (int bj = 0; bj < 2; ++bj) {
                    const float4 xa = *(const float4*)(x + ro + bj * 128), xb_ = *(const float4*)(x + ro + bj * 128 + 4);
                    const pg8::f32x4 v0 = acc[ai][bj][m][0], v1 = acc[ai][bj][m][1];
                    const float y[8] = {xa.x + v0[0], xa.y + v0[1], xa.z + v0[2], xa.w + v0[3], xb_.x + v1[0], xb_.y + v1[1], xb_.z + v1[2], xb_.w + v1[3]};
                    *(uint4*)(x1b + ro + bj * 128) = make_uint4(pk2(y[0], y[1]), pk2(y[2], y[3]), pk2(y[4], y[5]), pk2(y[6], y[7]));
                    unsigned w2[2] = {0u, 0u};
#pragma unroll
                    for (int e = 0; e < 8; ++e) {
                        s += y[e] * y[e];
                        const float z = fminf(fmaxf(y[e] * gq[bj][e] * (1.f / ZQ_SCALE), -127.f), 127.f);
                        w2[e >> 2] |= ((unsigned)((int)rintf(z) & 255)) << (8 * (e & 3));
                    }
                    *(uint2*)(zq + ro + bj * 128) = make_uint2(w2[0], w2[1]);
                }
                ssq[ai * 4 + m] = s;
            }
        float q4[4], q2[2];
#pragma unroll
        for (int j = 0; j < 4; ++j) {
            const auto r = __builtin_amdgcn_permlane32_swap(__float_as_uint(ssq[j]), __float_as_uint(ssq[j + 4]), false, false);
            q4[j] = __uint_as_float(r[0]) + __uint_as_float(r[1]);
        }
#pragma unroll
        for (int j = 0; j < 2; ++j) {
            const auto r = __builtin_amdgcn_permlane16_swap(__float_as_uint(q4[j]), __float_as_uint(q4[j + 2]), false, false);
            q2[j] = __uint_as_float(r[0]) + __uint_as_float(r[1]);
        }
#pragma unroll
        for (int j = 0; j < 2; ++j) {
            const int r8 = ((fq >> 1) & 1) * 4 + (fq & 1) * 2 + j;
            rs2p[(size_t)(row0 + (r8 >> 2) * 128 + (r8 & 3) * 16) * 16 + u.pn * 4 + wc] = q2[j];
        }
    }
};
template <class Epi, bool ALIGN>
DEVI void st_gemm8(const bf16_t* A, const bf16_t* Bt, int N, int K, char* smem, const Epi& epi) {
    pg8::Gemm g{A, Bt, T_TOK, N, K};
    pg8::StaticOrder S;
    S.init(T_TOK, N, (int)gridDim.x, (int)blockIdx.x);
    pg8::gemm_phase<Epi, pg8::StaticOrder, ALIGN, PG8_SP2>((PG8_LAS unsigned char*)smem, g, S, epi);
}

DEVI void st_conv_qk(const Params& p, char* smem) {
    char* cs = smem;
    char* wqs = smem + 128 * 272;
    char* wks = smem + 2 * 128 * 272;
    const int tid = stid(), lane = tid & 63, wid = tid >> 6, wr = wid >> 1, wc = wid & 1, fr = lane & 15, fq = lane >> 4;
    const int r = tid >> 4, cg = tid & 15;
    int hcur = -1;
    float cw[4][8], cb[8];
    for (int it = blockIdx.x; it < 256 * 4; it += gridDim.x) {
        const int h = it & 3, t0 = (it >> 2) * 128, s0 = t0 & 2047;
        if (h != hcur) {
            __syncthreads();
#pragma unroll
            for (int i = 0; i < 4; ++i) {
                const int id = tid + 512 * i, rr = id >> 4, c = id & 15;
                *(uint4*)(wqs + rr * 272 + c * 16) = *(const uint4*)(p.Wqt + h * 16384 + rr * 128 + c * 8);
                *(uint4*)(wks + rr * 272 + c * 16) = *(const uint4*)(p.Wkt + h * 16384 + rr * 128 + c * 8);
            }
#pragma unroll
            for (int j = 0; j < 4; ++j) {
                const float4 a = *(const float4*)(p.m_conv_w + j * 512 + h * 128 + 8 * cg), b = *(const float4*)(p.m_conv_w + j * 512 + h * 128 + 8 * cg + 4);
                cw[j][0] = a.x; cw[j][1] = a.y; cw[j][2] = a.z; cw[j][3] = a.w; cw[j][4] = b.x; cw[j][5] = b.y; cw[j][6] = b.z; cw[j][7] = b.w;
            }
            { const float4 a = *(const float4*)(p.m_conv_b + h * 128 + 8 * cg), b = *(const float4*)(p.m_conv_b + h * 128 + 8 * cg + 4);
              cb[0] = a.x; cb[1] = a.y; cb[2] = a.z; cb[3] = a.w; cb[4] = b.x; cb[5] = b.y; cb[6] = b.z; cb[7] = b.w; }
            hcur = h;
        }
        const bf16_t* xcol = p.proj + (size_t)t0 * NPJ + 2048 + h * 128 + 8 * cg;
#pragma unroll
        for (int ps = 0; ps < 4; ++ps) {
            const int row = 32 * ps + r;
            uint4 xv[4];
#pragma unroll
            for (int j = 0; j < 4; ++j) {
                const int rj = row - 3 + j;
                xv[j] = (s0 + rj >= 0) ? *(const uint4*)(xcol + (long)rj * NPJ) : make_uint4(0u, 0u, 0u, 0u);
            }
            float y[8];
#pragma unroll
            for (int e = 0; e < 8; ++e) y[e] = cb[e];
#pragma unroll
            for (int j = 0; j < 4; ++j) {
                const unsigned w4[4] = {xv[j].x, xv[j].y, xv[j].z, xv[j].w};
#pragma unroll
                for (int e = 0; e < 4; ++e) { y[2 * e] += cw[j][2 * e] * bflo(w4[e]); y[2 * e + 1] += cw[j][2 * e + 1] * bfhi(w4[e]); }
            }
            unsigned o[4];
#pragma unroll
            for (int e = 0; e < 4; ++e) o[e] = pk2(y[2 * e] * sigmoidf_(y[2 * e]), y[2 * e + 1] * sigmoidf_(y[2 * e + 1]));
            const uint4 ov = make_uint4(o[0], o[1], o[2], o[3]);
            *(uint4*)(cs + row * 272 + cg * 16) = ov;
            *(uint4*)(p.cbuf + (size_t)(t0 + row) * 512 + h * 128 + 8 * cg) = ov;
        }
        __syncthreads();
#pragma unroll
        for (int which = 0; which < 2; ++which) {
            const char* ws = which ? wks : wqs;
            bf16_t* O = which ? p.mk : p.mq;
            f32x4 acc[2][4];
#pragma unroll
            for (int i = 0; i < 2; ++i)
#pragma unroll
                for (int j = 0; j < 4; ++j) acc[i][j] = (f32x4){0.f, 0.f, 0.f, 0.f};
#pragma unroll
            for (int ks = 0; ks < 4; ++ks) {
                bf16x8 a[2], b[4];
#pragma unroll
                for (int i = 0; i < 2; ++i) a[i] = ld8(cs + (wr * 32 + i * 16 + fr) * 272 + (ks * 4 + fq) * 16);
#pragma unroll
                for (int j = 0; j < 4; ++j) b[j] = ld8(ws + (wc * 64 + j * 16 + fr) * 272 + (ks * 4 + fq) * 16);
#pragma unroll
                for (int i = 0; i < 2; ++i)
#pragma unroll
                    for (int j = 0; j < 4; ++j) acc[i][j] = mfma16(b[j], a[i], acc[i][j]);
            }
#pragma unroll
            for (int i = 0; i < 2; ++i)
#pragma unroll
                for (int j = 0; j < 4; ++j) {
                    const int m = t0 + wr * 32 + i * 16 + fr, n = h * 128 + wc * 64 + j * 16 + 4 * fq;
                    const f32x4 v = acc[i][j];
                    *(uint2*)(O + (size_t)m * 512 + n) = make_uint2(pk2(v[0], v[1]), pk2(v[2], v[3]));
                }
        }
        __syncthreads();
    }
}

DEVI bf16x8 u4_to_frag(uint4 u) { union { uint4 u; bf16x8 v; } x; x.u = u; return x.v; }
DEVI void sel_frags(bf16x8 (&sel)[2], int fr, int fq) {
#pragma unroll
    for (int hh = 0; hh < 2; ++hh) {
        const int jstar = fr + 16 * hh - 8 * fq;
        bf16x8 s;
#pragma unroll
        for (int j = 0; j < 8; ++j) s[j] = (j == jstar) ? (short)0x3F80 : (short)0;
        sel[hh] = s;
    }
}
DEVI void tr_store(char* XT, bf16x8 frag, const bf16x8 (&sel)[2], int mi, int ks, int fr, int fq, const float (&sc)[4]) {
#pragma unroll
    for (int hh = 0; hh < 2; ++hh) {
        const f32x4 d = mfma16(frag, sel[hh], (f32x4){0.f, 0.f, 0.f, 0.f});
        *(uint2*)(XT + (32 * ks + 16 * hh + fr) * 144 + (16 * mi + 4 * fq) * 2) = make_uint2(pk2(d[0] * sc[0], d[1] * sc[1]), pk2(d[2] * sc[2], d[3] * sc[3]));
    }
}
DEVI bf16x8 state_pack(const f32x4& a, const f32x4& b) {
    return mk8(make_uint2(pk2(a[0], a[1]), pk2(a[2], a[3])), make_uint2(pk2(b[0], b[1]), pk2(b[2], b[3])));
}
DEVI const float* opaque_ptr(const float* q) { asm volatile("" : "+v"(q)); return q; }
DEVI float opaque_f(float v) { asm volatile("" : "+v"(v)); return v; }
DEVI void lds_barrier() { asm volatile("s_waitcnt lgkmcnt(0)" ::: "memory"); __builtin_amdgcn_s_barrier(); asm volatile("" ::: "memory"); }
DEVI void pin_u4(uint4& a) { asm volatile("" : "+v"(a.x), "+v"(a.y), "+v"(a.z), "+v"(a.w)); }
DEVI float grp8_sum(float v) { v += dpp_f<DPP_XOR1>(v); v += dpp_f<DPP_XOR2>(v); v += dpp_f<DPP_HMIRROR>(v); return v; }

#define ASM_LD16(dst, voff, sbase, imm) asm volatile("global_load_dwordx4 %0, %1, %2 offset:" #imm : "=v"(dst) : "v"(voff), "s"(sbase) : "memory")
#define ASM_LD4(dst, voff, sbase) asm volatile("global_load_dword %0, %1, %2" : "=v"(dst) : "v"(voff), "s"(sbase) : "memory")
typedef unsigned u32x4_t __attribute__((ext_vector_type(4)));
struct RetPre { u32x4_t f[4]; u32x4_t v[2]; u32x4_t g[2]; };
struct RetOff { unsigned f, v0, v1, g; };
DEVI void ret_offsets(RetOff& o, int h, int tid) {
    const int lane = tid & 63, w = tid >> 6, fr = lane & 15, fq = lane >> 4, mi = w & 3;
    o.f = (unsigned)(((16 * mi + fr) * NPJ + (w < 4 ? 512 : 0) + h * 128 + 8 * fq) * 2);
    o.v0 = (unsigned)(((16 * ((2 * w) >> 2) + fr) * NPJ + 1024 + h * 128 + 32 * ((2 * w) & 3) + 8 * fq) * 2);
    o.v1 = (unsigned)(((16 * ((2 * w + 1) >> 2) + fr) * NPJ + 1024 + h * 128 + 32 * ((2 * w + 1) & 3) + 8 * fq) * 2);
    o.g = (unsigned)(((tid >> 3) * NPJ + 1536 + h * 128 + 16 * (tid & 7)) * 2);
}
DEVI const char* ret_base(const Params& p, int b, int c) { return (const char*)p.proj + (size_t)(b * 2048 + c * 64) * (NPJ * 2); }
template <int N> DEVI void ret_retire_fv(RetPre& P) {
    asm volatile("s_waitcnt vmcnt(%6)" : "+v"(P.f[0]), "+v"(P.f[1]), "+v"(P.f[2]), "+v"(P.f[3]), "+v"(P.v[0]), "+v"(P.v[1]) : "n"(N) : "memory");
}
DEVI uint4 asu4(const u32x4_t& v) { return make_uint4(v[0], v[1], v[2], v[3]); }
DEVI void ret_block(const Params& p, char* smem, int b, int h) {
    char* qs = smem;
    char* ks_ = smem + 17408;
    char* kTs = smem + 34816;
    char* vTs = smem + 53248;
    char* Ss = smem + 71680;
    char* Os = smem + 80896;
    float* gn_s = (float*)(smem + 98304);
    const int tid = stid(), lane = tid & 63, w = tid >> 6, fr = lane & 15, fq = lane >> 4;
    const float gamma = 1.f - exp2f(-5.f - (float)h);
    const float l2g = log2f(gamma);
    const float g64 = exp2f(l2g * 64.f);
    bf16x8 sel[2];
    sel_frags(sel, fr, fq);
    f32x4 st[8];
#pragma unroll
    for (int i = 0; i < 8; ++i) st[i] = (f32x4){0.f, 0.f, 0.f, 0.f};
    if (tid < 128) gn_s[tid] = p.ret_norm_g[h * 128 + tid];
    __syncthreads();
    RetPre P;
    RetOff RO;
    ret_offsets(RO, h, tid);
    {
        const char* base = ret_base(p, b, 0);
        ASM_LD16(P.f[0], RO.f, base, 0); ASM_LD16(P.f[1], RO.f, base, 64); ASM_LD16(P.f[2], RO.f, base, 128); ASM_LD16(P.f[3], RO.f, base, 192);
        ASM_LD16(P.v[0], RO.v0, base, 0); ASM_LD16(P.v[1], RO.v1, base, 0);
    }
    ret_retire_fv<0>(P);
#pragma unroll 1
    for (int c = 0; c < 32; ++c) {
        const int t0 = b * 2048 + c * 64;
        {
            const int mi = w & 3;
            char* dst = (w < 4 ? ks_ : qs) + (16 * mi + fr) * 272 + fq * 16;
#pragma unroll
            for (int ks = 0; ks < 4; ++ks) *(uint4*)(dst + ks * 64) = asu4(P.f[ks]);
            if (w < 4) {
                float kd[4];
#pragma unroll
                for (int r = 0; r < 4; ++r) kd[r] = exp2f(l2g * (float)(63 - (16 * mi + 4 * fq + r)));
#pragma unroll
                for (int ks = 0; ks < 4; ++ks) tr_store(kTs, u4_to_frag(asu4(P.f[ks])), sel, mi, ks, fr, fq, kd);
            }
            const float one[4] = {1.f, 1.f, 1.f, 1.f};
#pragma unroll
            for (int q = 0; q < 2; ++q) { const int pr = 2 * w + q; tr_store(vTs, u4_to_frag(asu4(P.v[q])), sel, pr >> 2, pr & 3, fr, fq, one); }
        }
        lds_barrier();
        const char* cbase = ret_base(p, b, c);
        const char* nbase = ret_base(p, b, c + 1 < 32 ? c + 1 : 31);
        ASM_LD16(P.g[0], RO.g, cbase, 0); ASM_LD16(P.g[1], RO.g, cbase, 16);
        {
            const int lt = w & 3;
            bf16x8 qf[4];
#pragma unroll
            for (int s = 0; s < 4; ++s) qf[s] = ld8(qs + (16 * lt + fr) * 272 + (s * 4 + fq) * 16);
#pragma unroll
            for (int jj = 0; jj < 2; ++jj) {
                const int j = 2 * (w >> 2) + jj;
                if (jj == 0) { ASM_LD16(P.f[0], RO.f, nbase, 0); ASM_LD16(P.f[1], RO.f, nbase, 64); }
                else { ASM_LD16(P.f[2], RO.f, nbase, 128); ASM_LD16(P.f[3], RO.f, nbase, 192); }
                f32x4 a = (f32x4){0.f, 0.f, 0.f, 0.f};
#pragma unroll
                for (int s = 0; s < 4; ++s) a = mfma16(ld8(ks_ + (16 * j + fr) * 272 + (s * 4 + fq) * 16), qf[s], a);
                const int l = 16 * lt + fr, mb = 16 * j + 4 * fq;
                float v[4];
#pragma unroll
                for (int r = 0; r < 4; ++r) { const int dd = l - (mb + r); v[r] = a[r] * exp2f(l2g * (float)(dd < 0 ? -dd : dd)); }
                *(uint2*)(Ss + l * 144 + mb * 2) = make_uint2(pk2(v[0], v[1]), pk2(v[2], v[3]));
            }
        }
        lds_barrier();
        {
            bf16x8 sp[4];
#pragma unroll
            for (int s = 0; s < 4; ++s) sp[s] = state_pack(st[2 * s], st[2 * s + 1]);
            bf16x8 vf[2];
#pragma unroll
            for (int s2 = 0; s2 < 2; ++s2) vf[s2] = ld8(vTs + (16 * w + fr) * 144 + (s2 * 4 + fq) * 16);
#pragma unroll
            for (int i = 0; i < 4; ++i) {
                if (i == 0) ASM_LD16(P.v[0], RO.v0, nbase, 0);
                if (i == 1) ASM_LD16(P.v[1], RO.v1, nbase, 0);
                f32x4 a = (f32x4){0.f, 0.f, 0.f, 0.f};
                const char* qrow = qs + (16 * i + fr) * 272;
#pragma unroll
                for (int s = 0; s < 4; ++s) {
                    const uint2 lo = *(const uint2*)(qrow + (32 * s + 4 * fq) * 2), hi = *(const uint2*)(qrow + (32 * s + 16 + 4 * fq) * 2);
                    a = mfma16(sp[s], mk8(lo, hi), a);
                }
                a = a * exp2f(l2g * (float)(16 * i + fr + 1));
#pragma unroll
                for (int s2 = 0; s2 < 2; ++s2) a = mfma16(vf[s2], ld8(Ss + (16 * i + fr) * 144 + (s2 * 4 + fq) * 16), a);
                *(uint2*)(Os + (16 * i + fr) * 272 + (16 * w + 4 * fq) * 2) = make_uint2(pk2(a[0], a[1]), pk2(a[2], a[3]));
            }
#pragma unroll
            for (int i = 0; i < 8; ++i) {
                f32x4 a = st[i] * g64;
#pragma unroll
                for (int s2 = 0; s2 < 2; ++s2) a = mfma16(ld8(kTs + (16 * i + fr) * 144 + (s2 * 4 + fq) * 16), vf[s2], a);
                st[i] = a;
            }
        }
        lds_barrier();
        {
            const int l = tid >> 3, part = tid & 7;
            const uint4 o0 = *(const uint4*)(Os + l * 272 + part * 32), o1 = *(const uint4*)(Os + l * 272 + part * 32 + 16);
            const unsigned ow[8] = {o0.x, o0.y, o0.z, o0.w, o1.x, o1.y, o1.z, o1.w};
            float x[16], s = 0.f;
#pragma unroll
            for (int e = 0; e < 8; ++e) { x[2 * e] = bflo(ow[e]); x[2 * e + 1] = bfhi(ow[e]); s += x[2 * e] + x[2 * e + 1]; }
            const float mu = grp8_sum(s) * (1.f / 128.f);
            float q = 0.f;
#pragma unroll
            for (int e = 0; e < 16; ++e) { x[e] -= mu; q += x[e] * x[e]; }
            float rstd = rsqrtf(grp8_sum(q) * (1.f / 128.f) + EPSN);
            asm volatile("s_waitcnt vmcnt(6)" : "+v"(P.g[0]), "+v"(P.g[1]), "+v"(rstd) :: "memory");
            const unsigned gw[8] = {P.g[0][0], P.g[0][1], P.g[0][2], P.g[0][3], P.g[1][0], P.g[1][1], P.g[1][2], P.g[1][3]};
            const float* gn = gn_s + 16 * part;
            unsigned yo[8];
#pragma unroll
            for (int e = 0; e < 8; ++e) {
                const float ga = bflo(gw[e]), gb = bfhi(gw[e]);
                yo[e] = pk2(ga * sigmoidf_(ga) * x[2 * e] * rstd * gn[2 * e], gb * sigmoidf_(gb) * x[2 * e + 1] * rstd * gn[2 * e + 1]);
            }
            asm volatile("" : "+v"(yo[0]), "+v"(yo[1]), "+v"(yo[2]), "+v"(yo[3]), "+v"(yo[4]), "+v"(yo[5]), "+v"(yo[6]), "+v"(yo[7]));
            ret_retire_fv<0>(P);
            uint4* yp = (uint4*)(p.yb + (size_t)(t0 + l) * 1024 + h * 128 + 16 * part);
            yp[0] = make_uint4(yo[0], yo[1], yo[2], yo[3]);
            yp[1] = make_uint4(yo[4], yo[5], yo[6], yo[7]);
        }
    }
}

struct MlPre { u32x4_t f[4]; u32x4_t v[2]; u32x4_t o[2]; u32x4_t cc[2]; };
struct MlOff { unsigned f, v0, v1, o, c, g; };
DEVI void ml_offsets(const Params& p, MlOff& o, int h, int tid) {
    const int lane = tid & 63, w = tid >> 6, fr = lane & 15, fq = lane >> 4, mi = w & 3;
    const unsigned kdiff = (unsigned)((const char*)p.mk - (const char*)p.mq);
    o.f = (unsigned)(((16 * mi + fr) * 512 + h * 128 + 8 * fq) * 2) + (w < 4 ? kdiff : 0u);
    o.v0 = (unsigned)(((16 * ((2 * w) >> 2) + fr) * NPJ + 2560 + h * 128 + 32 * ((2 * w) & 3) + 8 * fq) * 2);
    o.v1 = (unsigned)(((16 * ((2 * w + 1) >> 2) + fr) * NPJ + 2560 + h * 128 + 32 * ((2 * w + 1) & 3) + 8 * fq) * 2);
    o.o = (unsigned)(((tid >> 3) * NPJ + 3072 + h * 128 + 16 * (tid & 7)) * 2);
    o.c = (unsigned)(((tid >> 3) * 512 + h * 128 + 16 * (tid & 7)) * 2);
    o.g = (unsigned)((lane * 4 + h) * 4);
}
template <int N> DEVI void ml_retire_fv(MlPre& P) {
    asm volatile("s_waitcnt vmcnt(%6)" : "+v"(P.f[0]), "+v"(P.f[1]), "+v"(P.f[2]), "+v"(P.f[3]), "+v"(P.v[0]), "+v"(P.v[1]) : "n"(N) : "memory");
}
DEVI void mlstm_block(const Params& p, char* smem, int b, int h) {
    char* qs = smem;
    char* kTs = smem + 17408;
    char* vTs = smem + 35840;
    char* Os = smem + 54272;
    float* n_s = (float*)(smem + 71680);
    float* den_s = (float*)(smem + 72192);
    float* gn_s = (float*)(smem + 72448);
    float* sk_s = gn_s + 128;
    float* lw_s = sk_s + 128;
    float* ac_s = lw_s + 32 * 64;
    float* mi_s = ac_s + 32;
    const int tid = stid(), lane = tid & 63, w = tid >> 6, fr = lane & 15, fq = lane >> 4;
    bf16x8 sel[2];
    sel_frags(sel, fr, fq);
    f32x4 st[8];
#pragma unroll
    for (int i = 0; i < 8; ++i) st[i] = (f32x4){0.f, 0.f, 0.f, 0.f};
    float m_run = 0.f;
    f32x4 nacc = (f32x4){0.f, 0.f, 0.f, 0.f};
    bf16x8 ones;
#pragma unroll
    for (int j = 0; j < 8; ++j) ones[j] = (short)0x3F80;
    if (tid < 128) { gn_s[tid] = p.m_norm_g[h * 128 + tid]; sk_s[tid] = p.m_skip[h * 128 + tid]; }
#pragma unroll
    for (int q = 0; q < 4; ++q) {
        const int cc = 4 * w + q, tt = b * 2048 + cc * 64 + lane;
        const float iv = p.ipre[tt * 4 + h], fv = p.logf[tt * 4 + h];
        float fcum = fv;
#pragma unroll
        for (int o = 1; o < 64; o <<= 1) { const float tv = __shfl_up(fcum, o); if (lane >= o) fcum += tv; }
        const float a_c = __shfl(fcum, 63);
        const float logw = a_c - fcum + iv;
        const float m_in = wave_max(logw);
        lw_s[cc * 64 + lane] = logw;
        if (lane == 0) { ac_s[cc] = a_c; mi_s[cc] = m_in; }
    }
    __syncthreads();
    MlPre P;
    MlOff MO;
    ml_offsets(p, MO, h, tid);
    {
        const size_t t00 = (size_t)(b * 2048);
        const char* bq = (const char*)p.mq + t00 * 1024, *bp = (const char*)p.proj + t00 * (NPJ * 2);
        ASM_LD16(P.f[0], MO.f, bq, 0); ASM_LD16(P.f[1], MO.f, bq, 64); ASM_LD16(P.f[2], MO.f, bq, 128); ASM_LD16(P.f[3], MO.f, bq, 192);
        ASM_LD16(P.v[0], MO.v0, bp, 0); ASM_LD16(P.v[1], MO.v1, bp, 0);
    }
    ml_retire_fv<0>(P);
#pragma unroll 1
    for (int c = 0; c < 32; ++c) {
        const int t0 = b * 2048 + c * 64;
        const float a_c = ac_s[c], m_in = mi_s[c], logw = lw_s[c * 64 + lane];
        const float m_new = fmaxf(a_c + m_run, m_in);
        const float decay = fexp_(a_c + m_run - m_new);
        const float wgt = fexp_(logw - m_new);
        const float emn = fexp_(-m_new);
        m_run = m_new;
        {
            const int mi = w & 3;
            if (w < 4) {
                float kw[4];
#pragma unroll
                for (int r = 0; r < 4; ++r) kw[r] = __shfl(wgt, 16 * mi + 4 * fq + r);
#pragma unroll
                for (int ks = 0; ks < 4; ++ks) tr_store(kTs, u4_to_frag(asu4(P.f[ks])), sel, mi, ks, fr, fq, kw);
            } else {
                char* dst = qs + (16 * mi + fr) * 272 + fq * 16;
#pragma unroll
                for (int ks = 0; ks < 4; ++ks) *(uint4*)(dst + ks * 64) = asu4(P.f[ks]);
            }
            const float one[4] = {1.f, 1.f, 1.f, 1.f};
#pragma unroll
            for (int q = 0; q < 2; ++q) { const int pr = 2 * w + q; tr_store(vTs, u4_to_frag(asu4(P.v[q])), sel, pr >> 2, pr & 3, fr, fq, one); }
        }
        lds_barrier();
        const size_t tc = (size_t)t0, tn = (size_t)(b * 2048 + (c + 1 < 32 ? c + 1 : 31) * 64);
        const char* cbp = (const char*)p.proj + tc * (NPJ * 2), *cbc = (const char*)p.cbuf + tc * 1024;
        const char* nbq = (const char*)p.mq + tn * 1024, *nbp = (const char*)p.proj + tn * (NPJ * 2);
        ASM_LD16(P.o[0], MO.o, cbp, 0); ASM_LD16(P.o[1], MO.o, cbp, 16);
        {
            f32x4 a = nacc * decay;
#pragma unroll
            for (int s2 = 0; s2 < 2; ++s2) a = mfma16(ld8(kTs + (16 * w + fr) * 144 + (s2 * 4 + fq) * 16), ones, a);
            nacc = a;
            if (fr == 0) *(f32x4*)(n_s + 16 * w + 4 * fq) = a;
        }
        {
            bf16x8 vf[2];
#pragma unroll
            for (int s2 = 0; s2 < 2; ++s2) vf[s2] = ld8(vTs + (16 * w + fr) * 144 + (s2 * 4 + fq) * 16);
#pragma unroll
            for (int i = 0; i < 8; ++i) {
                if (i == 0) ASM_LD16(P.cc[0], MO.c, cbc, 0);
                if (i == 1) ASM_LD16(P.cc[1], MO.c, cbc, 16);
                if (i == 2) ASM_LD16(P.f[0], MO.f, nbq, 0);
                if (i == 3) ASM_LD16(P.f[1], MO.f, nbq, 64);
                if (i == 4) ASM_LD16(P.f[2], MO.f, nbq, 128);
                if (i == 5) ASM_LD16(P.f[3], MO.f, nbq, 192);
                if (i == 6) ASM_LD16(P.v[0], MO.v0, nbp, 0);
                if (i == 7) ASM_LD16(P.v[1], MO.v1, nbp, 0);
                f32x4 a = st[i] * decay;
#pragma unroll
                for (int s2 = 0; s2 < 2; ++s2) a = mfma16(ld8(kTs + (16 * i + fr) * 144 + (s2 * 4 + fq) * 16), vf[s2], a);
                st[i] = a;
            }
        }
        lds_barrier();
        {
            const int l = tid >> 3, part = tid & 7;
            const uint4 a0 = *(const uint4*)(qs + l * 272 + part * 32), a1 = *(const uint4*)(qs + l * 272 + part * 32 + 16);
            const unsigned aw[8] = {a0.x, a0.y, a0.z, a0.w, a1.x, a1.y, a1.z, a1.w};
            const float* nn = n_s + 16 * part;
            float s = 0.f;
#pragma unroll
            for (int e = 0; e < 8; ++e) s += bflo(aw[e]) * nn[2 * e] + bfhi(aw[e]) * nn[2 * e + 1];
            s = grp8_sum(s);
            if (part == 0) den_s[l] = fmaxf(fabsf(s), emn);
        }
        lds_barrier();
        {
            bf16x8 sp[4];
#pragma unroll
            for (int s = 0; s < 4; ++s) sp[s] = state_pack(st[2 * s], st[2 * s + 1]);
#pragma unroll
            for (int i = 0; i < 4; ++i) {
                f32x4 a = (f32x4){0.f, 0.f, 0.f, 0.f};
                const char* qrow = qs + (16 * i + fr) * 272;
#pragma unroll
                for (int s = 0; s < 4; ++s) {
                    const uint2 lo = *(const uint2*)(qrow + (32 * s + 4 * fq) * 2), hi = *(const uint2*)(qrow + (32 * s + 16 + 4 * fq) * 2);
                    a = mfma16(sp[s], mk8(lo, hi), a);
                }
                const float rd = rcp_(den_s[16 * i + fr]);
                *(uint2*)(Os + (16 * i + fr) * 272 + (16 * w + 4 * fq) * 2) = make_uint2(pk2(a[0] * rd, a[1] * rd), pk2(a[2] * rd, a[3] * rd));
            }
        }
        lds_barrier();
        {
            const int l = tid >> 3, part = tid & 7;
            const uint4 o0 = *(const uint4*)(Os + l * 272 + part * 32), o1 = *(const uint4*)(Os + l * 272 + part * 32 + 16);
            const unsigned ow[8] = {o0.x, o0.y, o0.z, o0.w, o1.x, o1.y, o1.z, o1.w};
            float x[16], s = 0.f;
#pragma unroll
            for (int e = 0; e < 8; ++e) { x[2 * e] = bflo(ow[e]); x[2 * e + 1] = bfhi(ow[e]); s += x[2 * e] + x[2 * e + 1]; }
            const float mu = grp8_sum(s) * (1.f / 128.f);
            float q = 0.f;
#pragma unroll
            for (int e = 0; e < 16; ++e) { x[e] -= mu; q += x[e] * x[e]; }
            float rstd = rsqrtf(grp8_sum(q) * (1.f / 128.f) + EPSN);
            asm volatile("s_waitcnt vmcnt(6)" : "+v"(P.o[0]), "+v"(P.o[1]), "+v"(P.cc[0]), "+v"(P.cc[1]), "+v"(rstd) :: "memory");
            const unsigned gw[8] = {P.o[0][0], P.o[0][1], P.o[0][2], P.o[0][3], P.o[1][0], P.o[1][1], P.o[1][2], P.o[1][3]};
            const unsigned cw[8] = {P.cc[0][0], P.cc[0][1], P.cc[0][2], P.cc[0][3], P.cc[1][0], P.cc[1][1], P.cc[1][2], P.cc[1][3]};
            const float* gn = gn_s + 16 * part;
            const float* sk = sk_s + 16 * part;
            unsigned yo[8];
#pragma unroll
            for (int e = 0; e < 8; ++e) {
                const float ya = sigmoidf_(bflo(gw[e])) * (x[2 * e] * rstd * gn[2 * e] + sk[2 * e] * bflo(cw[e]));
                const float yb_ = sigmoidf_(bfhi(gw[e])) * (x[2 * e + 1] * rstd * gn[2 * e + 1] + sk[2 * e + 1] * bfhi(cw[e]));
                yo[e] = pk2(ya, yb_);
            }
            asm volatile("" : "+v"(yo[0]), "+v"(yo[1]), "+v"(yo[2]), "+v"(yo[3]), "+v"(yo[4]), "+v"(yo[5]), "+v"(yo[6]), "+v"(yo[7]));
            ml_retire_fv<0>(P);
            uint4* yp = (uint4*)(p.yb + (size_t)(t0 + l) * 1024 + 512 + h * 128 + 16 * part);
            yp[0] = make_uint4(yo[0], yo[1], yo[2], yo[3]);
            yp[1] = make_uint4(yo[4], yo[5], yo[6], yo[7]);
        }
    }
}
DEVI void st_recur(const Params& p, char* smem) {
    if (blockIdx.x >= 128 || gridDim.x <= 128) {
        const int bid = gridDim.x > 128 ? (int)blockIdx.x - 128 : (int)blockIdx.x, nb = gridDim.x > 128 ? (int)gridDim.x - 128 : (int)gridDim.x;
        st_prep_w2(p, smem, bid, nb);
        st_prep_wsub(p, smem, bid, nb);
        st_prep_tables(p, bid, nb);
        if (gridDim.x > 128) return;
    }
    for (int bi = blockIdx.x; bi < 128; bi += gridDim.x) {
        const int kind = bi & 1, h = (bi >> 1) & 3, b = bi >> 3;
        if (kind == 0) ret_block(p, smem, b, h);
        else mlstm_block(p, smem, b, h);
        __syncthreads();
    }
}

constexpr float KEY_BIAS = 64.f;
DEVI int f2key(float f) { const int b = __float_as_int(f); return b ^ ((b >> 31) & 0x7fffffff); }
DEVI float key2f(int k) { return __int_as_float(k ^ ((k >> 31) & 0x7fffffff)); }
template <int N> DEVI void bsort_desc(int (&v)[N]) {
#pragma unroll
    for (int k = 2; k <= N; k <<= 1)
#pragma unroll
        for (int j = k >> 1; j > 0; j >>= 1)
#pragma unroll
            for (int i = 0; i < N; ++i) {
                const int l = i ^ j;
                if (l > i) {
                    const int a = v[i], b = v[l];
                    const int mx = a > b ? a : b, mn = a > b ? b : a;
                    if ((i & k) == 0) { v[i] = mx; v[l] = mn; } else { v[i] = mn; v[l] = mx; }
                }
            }
}
template <int N> DEVI void bmerge_desc(int (&v)[N]) {
#pragma unroll
    for (int j = N >> 1; j > 0; j >>= 1)
#pragma unroll
        for (int i = 0; i < N; ++i) {
            const int l = i ^ j;
            if (l > i) { const int a = v[i], b = v[l]; v[i] = a > b ? a : b; v[l] = a > b ? b : a; }
        }
}
DEVI void xmerge16(int (&v)[16], int mask) {
    int o[16];
#pragma unroll
    for (int i = 0; i < 16; ++i) o[i] = __shfl_xor(v[15 - i], mask);
#pragma unroll
    for (int i = 0; i < 16; ++i) v[i] = v[i] > o[i] ? v[i] : o[i];
    bmerge_desc<16>(v);
}
__device__ const unsigned char cand_tab[52] = {
    0x00, 0x01, 0x02, 0x03, 0x04, 0x05, 0x06, 0x07, 0x08, 0x09, 0x0a, 0x0b, 0x0c, 0x0d, 0x0e, 0x0f,
    0x10, 0x11, 0x12, 0x13, 0x14, 0x15, 0x16, 0x17, 0x20, 0x21, 0x22, 0x23, 0x24, 0x30, 0x31, 0x32, 0x33,
    0x40, 0x41, 0x42, 0x50, 0x51, 0x60, 0x61, 0x70, 0x71, 0x80, 0x90, 0xa0, 0xb0, 0xc0, 0xd0, 0xe0, 0xf0, 0xff, 0xff};
constexpr int H_A = 256 * 64, H_B = 256 * 64, H_STAGE = H_A + H_B;
constexpr int H_LIST = 3 * H_STAGE;
DEVI void glds16(const void* g, char* l) {
    __builtin_amdgcn_global_load_lds((const __attribute__((address_space(1))) unsigned*)g, (__attribute__((address_space(3))) unsigned*)l, 16, 0, 0);
}
DEVI void gemm3_topk_tile(const Params& p, int m0, int h, char* smem) {
    const int tid = stid(), lane = tid & 63, w = tid >> 6, wt = w >> 1, wp = w & 1, fr = lane & 15, fq = lane >> 4;
    i32x4 acc[4][8];
#pragma unroll
    for (int i = 0; i < 4; ++i)
#pragma unroll
        for (int j = 0; j < 8; ++j) acc[i][j] = (i32x4){0, 0, 0, 0};
    const int r16 = lane >> 2, csrc = (lane & 3) ^ ((r16 >> 2) & 3);
    const unsigned char* srcA = p.xq + (size_t)(m0 + w * 32 + r16) * 1024 + csrc * 16;
    const unsigned char* srcB = (const unsigned char*)p.Wsubq + ((size_t)h * 256 + w * 32 + r16) * 1024 + csrc * 16;
    char* dstA = smem + (w * 32) * 64 + lane * 16;
    char* dstB = smem + H_A + (w * 32) * 64 + lane * 16;
    auto issue = [&](int kt, int buf) {
#pragma unroll
        for (int q = 0; q < 2; ++q) glds16(srcA + (size_t)q * 16 * 1024 + kt * 64, dstA + buf * H_STAGE + q * 1024);
#pragma unroll
        for (int q = 0; q < 2; ++q) glds16(srcB + (size_t)q * 16 * 1024 + kt * 64, dstB + buf * H_STAGE + q * 1024);
    };
    const int rdoff = fr * 64 + ((fq ^ ((fr >> 2) & 3)) * 16);
    issue(0, 0);
    issue(1, 1);
    asm volatile("s_waitcnt vmcnt(4)" ::: "memory");
    __builtin_amdgcn_s_barrier();
    int buf = 0;
#pragma unroll 1
    for (int kt = 0; kt < 16; ++kt) {
        const int b2 = buf >= 1 ? buf - 1 : 2;
        if (kt + 2 < 16) issue(kt + 2, b2);
        const char* As = smem + buf * H_STAGE + (wt * 64) * 64 + rdoff;
        const char* Bs = smem + buf * H_STAGE + H_A + (wp * 128) * 64 + rdoff;
        i32x4 a[4];
#pragma unroll
        for (int i = 0; i < 4; ++i) a[i] = *(const i32x4*)(As + (16 * i) * 64);
#pragma unroll
        for (int jg = 0; jg < 2; ++jg) {
            i32x4 b[4];
#pragma unroll
            for (int j = 0; j < 4; ++j) b[j] = *(const i32x4*)(Bs + (16 * (4 * jg + j)) * 64);
#pragma unroll
            for (int i = 0; i < 4; ++i)
#pragma unroll
                for (int j = 0; j < 4; ++j) acc[i][4 * jg + j] = __builtin_amdgcn_mfma_i32_16x16x64_i8(b[j], a[i], acc[i][4 * jg + j], 0, 0, 0);
        }
        if (kt + 2 < 16) asm volatile("s_waitcnt vmcnt(4)" ::: "memory");
        else asm volatile("s_waitcnt vmcnt(0)" ::: "memory");
        __builtin_amdgcn_s_barrier();
        buf = buf == 2 ? 0 : buf + 1;
    }
    float4 ws[8];
#pragma unroll
    for (int j = 0; j < 8; ++j) ws[j] = *(const float4*)(p.wsc + h * 256 + wp * 128 + 16 * j + 4 * fq);
    int* LX = (int*)(smem + H_LIST);
#pragma unroll
    for (int i = 0; i < 4; ++i) {
        const int tl = 64 * wt + 16 * i + fr;
        const float rs = rs2_of(p.rs2p, m0 + tl) * ZQ_SCALE;
        int ka[16], kb[16];
#pragma unroll
        for (int jj = 0; jj < 4; ++jj)
#pragma unroll
            for (int r = 0; r < 4; ++r) {
                const float sa = r == 0 ? ws[jj].x : r == 1 ? ws[jj].y : r == 2 ? ws[jj].z : ws[jj].w;
                const float sb = r == 0 ? ws[4 + jj].x : r == 1 ? ws[4 + jj].y : r == 2 ? ws[4 + jj].z : ws[4 + jj].w;
                ka[jj * 4 + r] = (__float_as_int((float)acc[i][jj][r] * (sa * rs) + KEY_BIAS) & ~127) | (16 * jj + 4 * fq + r);
                kb[jj * 4 + r] = (__float_as_int((float)acc[i][4 + jj][r] * (sb * rs) + KEY_BIAS) & ~127) | (16 * (jj + 4) + 4 * fq + r);
            }
        bsort_desc<16>(ka);
        bsort_desc<16>(kb);
#pragma unroll
        for (int q = 0; q < 16; ++q) ka[q] = ka[q] > kb[15 - q] ? ka[q] : kb[15 - q];
        bmerge_desc<16>(ka);
        xmerge16(ka, 16);
        xmerge16(ka, 32);
        const int k0 = fq == 0 ? ka[0] : fq == 1 ? ka[4] : fq == 2 ? ka[8] : ka[12];
        const int k1 = fq == 0 ? ka[1] : fq == 1 ? ka[5] : fq == 2 ? ka[9] : ka[13];
        const int k2 = fq == 0 ? ka[2] : fq == 1 ? ka[6] : fq == 2 ? ka[10] : ka[14];
        const int k3 = fq == 0 ? ka[3] : fq == 1 ? ka[7] : fq == 2 ? ka[11] : ka[15];
        *(int4*)(LX + tl * 32 + wp * 16 + 4 * fq) = make_int4(k0, k1, k2, k3);
    }
    __syncthreads();
#pragma unroll
    for (int i2 = 0; i2 < 2; ++i2) {
        const int tl = 32 * w + 16 * i2 + fr, t = m0 + tl;
        const int* L = LX + tl * 32;
        const unsigned long long clo = fq == 0 ? 0x0706050403020100ull : fq == 1 ? 0x14131211100f0e0dull : fq == 2 ? 0x4033323130242322ull : 0xc0b0a09080717061ull;
        const unsigned long long chi = fq == 0 ? 0x0c0b0a0908ull : fq == 1 ? 0x2120171615ull : fq == 2 ? 0x6051504241ull : 0xfffff0e0d0ull;
        int c[16];
#pragma unroll
        for (int s = 0; s < 13; ++s) {
            const int ab = (int)((s < 8 ? (clo >> (8 * s)) : (chi >> (8 * (s - 8)))) & 0xffull);
            const int k1 = L[ab >> 4], k2 = L[16 + (ab & 15)];
            const float v = (__int_as_float(k1 & ~127) - KEY_BIAS) + (__int_as_float(k2 & ~127) - KEY_BIAS);
            c[s] = (f2key(v) & ~0x3fff) | ((k1 & 127) << 7) | (k2 & 127);
        }
        c[13] = c[14] = c[15] = (int)0x80000000;
        bsort_desc<16>(c);
        xmerge16(c, 16);
        xmerge16(c, 32);
        const float vmax = key2f(c[0] & ~0x3fff);
        float e[16], sum = 0.f;
#pragma unroll
        for (int q = 0; q < 16; ++q) { e[q] = fexp_(key2f(c[q] & ~0x3fff) - vmax); sum += e[q]; }
        const float inv = rcp_(sum);
        int ce[4]; float ge[4];
#pragma unroll
        for (int q = 0; q < 4; ++q) {
            const int cq = fq == 0 ? c[q] : fq == 1 ? c[4 + q] : fq == 2 ? c[8 + q] : c[12 + q];
            const float eq = fq == 0 ? e[q] : fq == 1 ? e[4 + q] : fq == 2 ? e[8 + q] : e[12 + q];
            ce[q] = ((cq >> 7) & 127) * 128 + (cq & 127);
            ge[q] = eq * inv;
        }
        *(uint2*)(p.eperm + (size_t)t * 128 + h * 16 + 4 * fq) = make_uint2((unsigned)ce[0] | ((unsigned)ce[1] << 16), (unsigned)ce[2] | ((unsigned)ce[3] << 16));
        *(float4*)(p.gate + (size_t)t * 128 + h * 16 + 4 * fq) = make_float4(ge[0], ge[1], ge[2], ge[3]);
    }
    __syncthreads();
}
DEVI void st_gemm3_topk(const Params& p, char* smem) {
    for (int it = blockIdx.x; it < 128 * 8; it += gridDim.x) gemm3_topk_tile(p, (it >> 3) * 256, it & 7, smem);
}

#define XB_TMO      128
#define XB_XCNT(j)  (256  + 64 * (j))
#define XB_XSUB(j)  (1280 + 64 * (j))
#define XB_XGEN(j)  (2304 + 64 * (j))
#define XB_TOP      3328
#define XB_TOPGEN   3392
#define XCD_BAR_WORDS 3456
#define XB_SPIN_CAP (1u << 20)
#define LAS __attribute__((address_space(3)))
DEVI unsigned xb_ld(unsigned* p) { return __hip_atomic_load(p, __ATOMIC_RELAXED, __HIP_MEMORY_SCOPE_AGENT); }
DEVI unsigned xb_add(unsigned* p, unsigned v) { return __hip_atomic_fetch_add(p, v, __ATOMIC_RELAXED, __HIP_MEMORY_SCOPE_AGENT); }
DEVI unsigned xb_xcc_id() { return (unsigned)__builtin_amdgcn_s_getreg((3 << 11) | 20) & 0xFu; }
#define XB_SPIN(cond, bar) do { unsigned _sp = 0; while (cond) { __builtin_amdgcn_s_sleep(1); \
    if ((++_sp & 255u) == 0u) { if (xb_ld(&(bar)[XB_TMO])) break; if (_sp > XB_SPIN_CAP) { atomicAdd(&(bar)[XB_TMO], 1u); break; } } } } while (0)
struct XcdBarrier { unsigned* bar; unsigned x; volatile LAS unsigned* st; };
DEVI XcdBarrier xcd_barrier_post(unsigned* bar, volatile LAS unsigned* st) {
    XcdBarrier b; b.bar = bar; b.x = xb_xcc_id(); b.st = st;
    if (stid() == 0) (void)xb_add(&bar[XB_XCNT(b.x)], 1u);
    return b;
}
DEVI void xcd_barrier_complete(unsigned* bar, unsigned x, unsigned& nloc, unsigned& nx) {
    const unsigned G = gridDim.x * gridDim.y * gridDim.z;
    unsigned sum, cnt, mine, sp = 0u;
    for (;;) {
        sum = 0u; cnt = 0u; mine = 0u;
#pragma unroll
        for (unsigned j = 0; j < 16; ++j) { const unsigned c = xb_ld(&bar[XB_XCNT(j)]); sum += c; cnt += (c > 0u) ? 1u : 0u; mine = (j == x) ? c : mine; }
        if (sum == G) break;
        __builtin_amdgcn_s_sleep(1);
        if ((++sp & 255u) == 0u) { if (xb_ld(&bar[XB_TMO])) break; if (sp > XB_SPIN_CAP) { atomicAdd(&bar[XB_TMO], 1u); break; } }
    }
    nloc = mine > 0u ? mine : 1u; nx = cnt > 0u ? cnt : 1u;
}
DEVI void xcd_barrier(const XcdBarrier& b) {
    asm volatile("s_waitcnt vmcnt(0)" ::: "memory");
    __syncthreads();
    if (stid() == 0) {
        unsigned* bar = b.bar;
        __builtin_amdgcn_s_waitcnt(0);
        unsigned nloc = b.st[0], nx = b.st[1];
        if (nloc == 0u) { xcd_barrier_complete(bar, b.x, nloc, nx); b.st[0] = nloc; b.st[1] = nx; }
        const unsigned old = xb_add(&bar[XB_XSUB(b.x)], 1u);
        const unsigned gen = old / nloc;
        if (old + 1u == (gen + 1u) * nloc) {
            __builtin_amdgcn_fence(__ATOMIC_RELEASE, "agent");
            asm volatile("s_waitcnt vmcnt(0)" ::: "memory");
            const unsigned og = xb_add(&bar[XB_TOP], 1u);
            const unsigned tg = og / nx;
            if (og + 1u == (tg + 1u) * nx) xb_add(&bar[XB_TOPGEN], 1u);
            else XB_SPIN(xb_ld(&bar[XB_TOPGEN]) == tg, bar);
            __builtin_amdgcn_fence(__ATOMIC_ACQUIRE, "agent");
            xb_add(&bar[XB_XGEN(b.x)], 1u);
            asm volatile("s_waitcnt vmcnt(0)" ::: "memory");
        } else {
            XB_SPIN(xb_ld(&bar[XB_XGEN(b.x)]) == gen, bar);
            __builtin_amdgcn_fence(__ATOMIC_ACQUIRE, "agent");
            asm volatile("s_waitcnt vmcnt(0)" ::: "memory");
        }
    }
    __syncthreads();
}

#define CTR_A(x) (XCD_BAR_WORDS + 64 * (x))
#define CTR_B(x) (XCD_BAR_WORDS + 512 + 64 * (x))
#define CTL_WORDS (XCD_BAR_WORDS + 1024)
typedef float f32x2 __attribute__((ext_vector_type(2)));
DEVI float ub(unsigned w, int n) { return (float)((w >> (8 * n)) & 0xffu); }
DEVI float gelu_erf(float v) {
    const float av = fabsf(v), t = rcp_(av * 0.2316418882f + 1.0f);
    float q = t * 0.5307027145f + (-0.7265760135f);
    q = q * t + 0.7107068705f; q = q * t + (-0.142248368f); q = q * t + 0.127414796f; q = q * t;
    const float e = __builtin_amdgcn_exp2f((v * v) * (-0.72134752044f));
    const float m = v * (q * e);
    return v < 0.f ? m : v - m;
}
struct ExpMeta { uint4 e[2]; uint4 xa; float sc; };
struct ExpRows { uint4 r[16]; unsigned x1; };

template <int PHASE> DEVI void exp_load_meta(const Params& p, ExpMeta& m, int t, int x, int lane) {
    const uint4* ep = (const uint4*)(p.eperm + (size_t)t * 128 + (lane >> 3) * 16);
    m.e[0] = ep[0];
    m.e[1] = ep[1];
    if (PHASE == 0) m.xa = *(const uint4*)(p.xq + (size_t)t * 1024 + 128 * x + 16 * (lane & 7));
    else { m.xa = *(const uint4*)(p.aq + (size_t)t * 128 + (lane >> 3) * 16); m.sc = p.asc[t]; }
}
template <int PHASE> DEVI void exp_issue(const Params& p, const ExpMeta& m, ExpRows& R, int t, int x, int lane) {
    const unsigned char* base = (PHASE == 0 ? p.down_q : p.up_q) + (size_t)x * (16384 * 128) + (lane & 7) * 16;
    const unsigned ew[8] = {m.e[0].x, m.e[0].y, m.e[0].z, m.e[0].w, m.e[1].x, m.e[1].y, m.e[1].z, m.e[1].w};
#pragma unroll
    for (int j = 0; j < 16; ++j) {
        const unsigned ek = (j & 1) ? (ew[j >> 1] >> 16) : (ew[j >> 1] & 0xffffu);
        R.r[j] = *(const uint4*)(base + (size_t)ek * 128);
    }
    if (PHASE == 1) {
        const int col = 128 * x + 16 * (lane & 7) + ((lane & 32) ? 8 : 0) + ((lane & 16) ? 4 : 0) + ((lane & 8) ? 2 : 0);
        R.x1 = *(const unsigned*)(p.x1b + (size_t)t * 1024 + col);
    }
}
DEVI void expA_compute(const Params& p, const ExpMeta& m, const ExpRows& R, int t, int x, int lane) {
    const bool b2 = lane & 4, b1 = lane & 2, b0 = lane & 1;
    int ps[16];
#pragma unroll
    for (int j = 0; j < 16; ++j)
        ps[j] = __builtin_amdgcn_sdot4((int)R.r[j].x, (int)m.xa.x, __builtin_amdgcn_sdot4((int)R.r[j].y, (int)m.xa.y,
                __builtin_amdgcn_sdot4((int)R.r[j].z, (int)m.xa.z, __builtin_amdgcn_sdot4((int)R.r[j].w, (int)m.xa.w, 0, false), false), false), false);
    int q8[8], q4[4], q2[2];
#pragma unroll
    for (int j = 0; j < 8; ++j) { const int snd = b2 ? ps[j] : ps[j + 8], kp = b2 ? ps[j + 8] : ps[j]; q8[j] = kp + dpp_i<DPP_HMIRROR>(snd); }
#pragma unroll
    for (int j = 0; j < 4; ++j) { const int snd = b1 ? q8[j] : q8[j + 4], kp = b1 ? q8[j + 4] : q8[j]; q4[j] = kp + dpp_i<DPP_XOR2>(snd); }
#pragma unroll
    for (int j = 0; j < 2; ++j) { const int snd = b0 ? q4[j] : q4[j + 2], kp = b0 ? q4[j + 2] : q4[j]; q2[j] = kp + dpp_i<DPP_XOR1>(snd); }
    {
        int s0 = q2[0] >> 3, s1 = q2[1] >> 3;
        s0 = s0 > 32767 ? 32767 : (s0 < -32768 ? -32768 : s0);
        s1 = s1 > 32767 ? 32767 : (s1 < -32768 ? -32768 : s1);
        *(unsigned*)(p.part + ((size_t)x * T_TOK + t) * 128 + 2 * lane) = ((unsigned)s0 & 0xffffu) | ((unsigned)s1 << 16);
    }
}
DEVI void expB_compute(const Params& p, const ExpMeta& m, const ExpRows& R, int t, int x, int lane) {
    const bool b5 = lane & 32, b4 = lane & 16, b3 = lane & 8;
    const unsigned pa[4] = {m.xa.x, m.xa.y, m.xa.z, m.xa.w};
    int acc[16];
#pragma unroll
    for (int c = 0; c < 16; ++c) acc[c] = 0;
#pragma unroll
    for (int g = 0; g < 4; ++g) {
        const unsigned r0[4] = {R.r[4 * g].x, R.r[4 * g].y, R.r[4 * g].z, R.r[4 * g].w};
        const unsigned r1[4] = {R.r[4 * g + 1].x, R.r[4 * g + 1].y, R.r[4 * g + 1].z, R.r[4 * g + 1].w};
        const unsigned r2[4] = {R.r[4 * g + 2].x, R.r[4 * g + 2].y, R.r[4 * g + 2].z, R.r[4 * g + 2].w};
        const unsigned r3[4] = {R.r[4 * g + 3].x, R.r[4 * g + 3].y, R.r[4 * g + 3].z, R.r[4 * g + 3].w};
#pragma unroll
        for (int i = 0; i < 4; ++i) {
            const unsigned t0 = __builtin_amdgcn_perm(r1[i], r0[i], 0x05010400u), t1 = __builtin_amdgcn_perm(r1[i], r0[i], 0x07030602u);
            const unsigned t2 = __builtin_amdgcn_perm(r3[i], r2[i], 0x05010400u), t3 = __builtin_amdgcn_perm(r3[i], r2[i], 0x07030602u);
            const unsigned o0 = __builtin_amdgcn_perm(t2, t0, 0x05040100u), o1 = __builtin_amdgcn_perm(t2, t0, 0x07060302u);
            const unsigned o2 = __builtin_amdgcn_perm(t3, t1, 0x05040100u), o3 = __builtin_amdgcn_perm(t3, t1, 0x07060302u);
            acc[4 * i + 0] = __builtin_amdgcn_sdot4((int)o0, (int)pa[g], acc[4 * i + 0], false);
            acc[4 * i + 1] = __builtin_amdgcn_sdot4((int)o1, (int)pa[g], acc[4 * i + 1], false);
            acc[4 * i + 2] = __builtin_amdgcn_sdot4((int)o2, (int)pa[g], acc[4 * i + 2], false);
            acc[4 * i + 3] = __builtin_amdgcn_sdot4((int)o3, (int)pa[g], acc[4 * i + 3], false);
        }
    }
    int q8[8], q4[4], q2[2];
#pragma unroll
    for (int j = 0; j < 8; ++j) {
        const auto r = __builtin_amdgcn_permlane32_swap((unsigned)acc[j], (unsigned)acc[j + 8], false, false);
        q8[j] = (int)r[0] + (int)r[1];
    }
#pragma unroll
    for (int j = 0; j < 4; ++j) {
        const auto r = __builtin_amdgcn_permlane16_swap((unsigned)q8[j], (unsigned)q8[j + 4], false, false);
        q4[j] = (int)r[0] + (int)r[1];
    }
#pragma unroll
    for (int j = 0; j < 2; ++j) { const int snd = b3 ? q4[j] : q4[j + 2], kp = b3 ? q4[j + 2] : q4[j]; q2[j] = kp + dpp_i<DPP_ROR8>(snd); }
    const int col = 128 * x + 16 * (lane & 7) + (b5 ? 8 : 0) + (b4 ? 4 : 0) + (b3 ? 2 : 0);
    *(unsigned*)(p.proj + (size_t)t * 1024 + col) = pk2(bflo(R.x1) + (float)q2[0] * m.sc, bfhi(R.x1) + (float)q2[1] * m.sc);
}
constexpr int EXP_NP = 16;
template <int PHASE>
DEVI void exp_chunk(const Params& p, int tb, int x, int lane) {
    ExpMeta mA, mB, nA, nB;
    ExpRows rA, rB;
    exp_load_meta<PHASE>(p, mA, tb, x, lane);
    exp_load_meta<PHASE>(p, mB, tb + 1, x, lane);
    exp_issue<PHASE>(p, mA, rA, tb, x, lane);
    exp_issue<PHASE>(p, mB, rB, tb + 1, x, lane);
    exp_load_meta<PHASE>(p, nA, tb + 2, x, lane);
    exp_load_meta<PHASE>(p, nB, tb + 3, x, lane);
#pragma unroll 1
    for (int i = 0; i < EXP_NP; ++i) {
        const int tA = tb + 2 * i, tB = tA + 1;
        if (PHASE == 0) expA_compute(p, mA, rA, tA, x, lane); else expB_compute(p, mA, rA, tA, x, lane);
        if (i < EXP_NP - 1) {
            mA = nA;
            exp_issue<PHASE>(p, mA, rA, tA + 2, x, lane);
            if (i < EXP_NP - 2) exp_load_meta<PHASE>(p, nA, tA + 4, x, lane);
        }
        if (PHASE == 0) expA_compute(p, mB, rB, tB, x, lane); else expB_compute(p, mB, rB, tB, x, lane);
        if (i < EXP_NP - 1) {
            mB = nB;
            exp_issue<PHASE>(p, mB, rB, tB + 2, x, lane);
            if (i < EXP_NP - 2) exp_load_meta<PHASE>(p, nB, tB + 4, x, lane);
        }
    }
}
template <int PHASE>
DEVI void st_expAB(const Params& p, char* smem) {
    const int tid = stid(), lane = tid & 63, wid = tid >> 6;
    volatile int* cs = (volatile int*)smem;
    const unsigned myx = xb_xcc_id() & 7u;
    constexpr int NCH = T_TOK / (2 * EXP_NP * NW);
    for (int si = 0; si < 8; ++si) {
        const int x = (int)((myx + si) & 7u);
        unsigned* ctr = &p.bar[PHASE == 0 ? CTR_A(x) : CTR_B(x)];
        if (tid == 0) cs[0] = (int)xb_add(ctr, 1u);
        __syncthreads();
        int chunk = cs[0];
        __syncthreads();
        while (chunk < NCH) {
            int nxt = 0;
            if (tid == 0) nxt = (int)xb_add(ctr, 1u);
            exp_chunk<PHASE>(p, chunk * (2 * EXP_NP * NW) + wid * (2 * EXP_NP), x, lane);
            if (tid == 0) cs[0] = nxt;
            __syncthreads();
            chunk = cs[0];
            __syncthreads();
        }
    }
}
DEVI void st_expA2(const Params& p) {
    const int lane = stid() & 63, wid = stid() >> 6;
    for (int t0 = (blockIdx.x * NW + wid) * 2; t0 < T_TOK; t0 += gridDim.x * NW * 2) {
        unsigned pv[2][8], ew[2];
        float2 g[2];
        float xs[2];
#pragma unroll
        for (int q = 0; q < 2; ++q) {
            const int t = t0 + q;
#pragma unroll
            for (int x = 0; x < 8; ++x) pv[q][x] = *(const unsigned*)(p.part + ((size_t)x * T_TOK + t) * 128 + 2 * lane);
            ew[q] = *(const unsigned*)(p.eperm + (size_t)t * 128 + 2 * lane);
            g[q] = *(const float2*)(p.gate + (size_t)t * 128 + 2 * lane);
            xs[q] = rs2_of(p.rs2p, t) * (8.f * ZQ_SCALE);
        }
        float ds[2][2], us[2][2];
#pragma unroll
        for (int q = 0; q < 2; ++q) {
            const int ea = (int)(ew[q] & 0xffffu), eb = (int)(ew[q] >> 16);
            ds[q][0] = p.dscale[ea]; ds[q][1] = p.dscale[eb]; us[q][0] = p.uscale[ea]; us[q][1] = p.uscale[eb];
        }
#pragma unroll
        for (int q = 0; q < 2; ++q) {
            const int t = t0 + q;
            int s0 = 0, s1 = 0;
#pragma unroll
            for (int x = 0; x < 8; ++x) { s0 += (int)(short)(pv[q][x] & 0xffffu); s1 += (int)pv[q][x] >> 16; }
            const float a0 = g[q].x * gelu_erf((float)s0 * xs[q] * ds[q][0]) * us[q][0];
            const float a1 = g[q].y * gelu_erf((float)s1 * xs[q] * ds[q][1]) * us[q][1];
            const float amax = wave_max(fmaxf(fabsf(a0), fabsf(a1)));
            const float inv = amax > 0.f ? 127.f * rcp_(amax) : 0.f;
            const unsigned q0 = (unsigned)((int)rintf(a0 * inv) & 255), q1 = (unsigned)((int)rintf(a1 * inv) & 255);
            *(unsigned short*)(p.aq + (size_t)t * 128 + 2 * lane) = (unsigned short)(q0 | (q1 << 8));
            if (lane == 0) p.asc[t] = amax * (1.f / 127.f);
        }
    }
}
DEVI void st_expC(const Params& p) {
    const int lane = stid() & 63, wid = stid() >> 6;
    for (int t0 = (blockIdx.x * NW + wid) * 2; t0 < T_TOK; t0 += gridDim.x * NW * 2) {
        uint2 u[2][4];
#pragma unroll
        for (int q = 0; q < 2; ++q) {
            const uint2* row = (const uint2*)(p.proj + (size_t)(t0 + q) * 1024);
#pragma unroll
            for (int j = 0; j < 4; ++j) u[q][j] = row[lane + 64 * j];
        }
#pragma unroll
        for (int q = 0; q < 2; ++q) {
            float4 v[4];
            float ss = 0.f;
#pragma unroll
            for (int j = 0; j < 4; ++j) {
                v[j] = make_float4(bflo(u[q][j].x), bfhi(u[q][j].x), bflo(u[q][j].y), bfhi(u[q][j].y));
                ss += v[j].x * v[j].x + v[j].y * v[j].y + v[j].z * v[j].z + v[j].w * v[j].w;
            }
            ss = wave_sum(ss);
            const float rf = rsqrtf(ss * (1.f / 1024.f) + EPSN);
            float4* orow = (float4*)(p.out + (size_t)(t0 + q) * 1024);
#pragma unroll
            for (int j = 0; j < 4; ++j) {
                const float4 g = *(const float4*)(p.final_g + (lane + 64 * j) * 4);
                orow[lane + 64 * j] = make_float4(v[j].x * rf * g.x, v[j].y * rf * g.y, v[j].z * rf * g.z, v[j].w * rf * g.w);
            }
        }
    }
}

constexpr int LDS_BYTES = 147456;
constexpr int LDS_BARW = LDS_BYTES - 16;
extern __shared__ __attribute__((aligned(16))) char smem_dyn[];
__global__ void __launch_bounds__(NTHR, 2) mega_fwd(Params p) {
    cg::grid_group grid = cg::this_grid();
    volatile LAS unsigned* bst = (volatile LAS unsigned*)(LAS char*)(smem_dyn + LDS_BARW);
    if (stid() < 4) bst[stid()] = 0u;
    __syncthreads();
    XcdBarrier bar = xcd_barrier_post(p.bar, bst);
    st_prep_misc(p);
    st_prep_w1(p, smem_dyn);
    st_prep_x(p, smem_dyn);
    if (p.pad_[0] == 0x7fffabcd) grid.sync();
    xcd_barrier(bar);
    st_gemm8<EpiProj8, PG8_ALIGN>(p.xb, p.W1t, NPJ, 1024, smem_dyn, EpiProj8{p.proj, p.rs1, p.rope_cos, p.rope_sin});
    xcd_barrier(bar);
    st_conv_qk(p, smem_dyn);
    xcd_barrier(bar);
    st_recur(p, smem_dyn);
    xcd_barrier(bar);
    st_gemm8<EpiX18, PG8_ALIGN>(p.yb, p.W2t, 1024, 1024, smem_dyn, EpiX18{p.x, p.x1b, p.xq, p.rs2p, p.norm2_g});
    xcd_barrier(bar);
    st_gemm3_topk(p, smem_dyn);
    xcd_barrier(bar);
    st_expAB<0>(p, smem_dyn);
    xcd_barrier(bar);
    st_expA2(p);
    xcd_barrier(bar);
    st_expAB<1>(p, smem_dyn);
    xcd_barrier(bar);
    st_expC(p);
}

extern "C" void kernel_launch(void* const* d_in, const int* in_sizes, int n_in, void* d_out, int out_size, void* d_ws, size_t ws_size,
                              hipStream_t stream) {
    Params p{};
    const float* const* in = (const float* const*)d_in;
    p.x = in[0]; p.norm1_g = in[1]; p.w_in = in[2]; p.ret_norm_g = in[3]; p.m_conv_w = in[4]; p.m_conv_b = in[5]; p.m_wq = in[6]; p.m_wk = in[7];
    p.m_b_i = in[8]; p.m_b_f = in[9]; p.m_norm_g = in[10]; p.m_skip = in[11]; p.w_out = in[12]; p.norm2_g = in[13]; p.peer_wq = in[14];
    p.peer_keys = in[15]; p.peer_down = in[16]; p.peer_up = in[17]; p.final_g = in[18];
    p.out = (float*)d_out;
    char* ws = (char*)d_ws;
    size_t off = 0;
    auto take = [&](size_t bytes) { char* r = ws + off; off += (bytes + 255) & ~(size_t)255; return r; };
    p.proj = (bf16_t*)take((size_t)T_TOK * NPJ * 2);
    p.xb = (bf16_t*)take((size_t)T_TOK * 1024 * 2);
    p.yb = p.xb;
    p.gate = (float*)(ws + (size_t)T_TOK * 2048 * 4);
    p.mq = (bf16_t*)take((size_t)T_TOK * 512 * 2);
    p.mk = (bf16_t*)take((size_t)T_TOK * 512 * 2);
    p.x1b = p.mq;
    p.cbuf = (bf16_t*)take((size_t)T_TOK * 512 * 2);
    p.eperm = (unsigned short*)p.cbuf;
    p.down_q = (unsigned char*)take((size_t)16384 * 1024);
    p.up_q = (unsigned char*)take((size_t)16384 * 1024);
    p.dscale = (float*)take(16384 * 4);
    p.uscale = (float*)take(16384 * 4);
    p.bar = (unsigned*)take(CTL_WORDS * 4);
    p.xq = (unsigned char*)take((size_t)T_TOK * 1024);
    p.asc = (float*)take(T_TOK * 4);
    p.aq = (unsigned char*)take((size_t)T_TOK * 128);
    p.part = (short*)(ws + (size_t)T_TOK * 1024 * 4);
    p.W1t = (bf16_t*)take((size_t)NPJ * 1024 * 2);
    p.W2t = (bf16_t*)take((size_t)1024 * 1024 * 2);
    p.Wsubq = (signed char*)take((size_t)2048 * 1024);
    p.wsc = (float*)take(2048 * 4);
    p.Wqt = (bf16_t*)take(4 * 128 * 128 * 2);
    p.Wkt = (bf16_t*)take(4 * 128 * 128 * 2);
    p.rs1 = (float*)take(T_TOK * 4);
    p.rs2p = (float*)take((size_t)T_TOK * 16 * 4);
    p.ipre = (float*)take(T_TOK * 4 * 4);
    p.logf = (float*)take(T_TOK * 4 * 4);
    p.rope_cos = (float*)take(2048 * 64 * 4);
    p.rope_sin = (float*)take(2048 * 64 * 4);
    if (off > ws_size) { fprintf(stderr, "kernel_launch: workspace too small (%zu > %zu)\n", off, ws_size); return; }

    static int grid_blocks = 0;
    if (!grid_blocks) {
        int dev = 0, cus = 0, per_cu = 0;
        (void)hipGetDevice(&dev);
        (void)hipDeviceGetAttribute(&cus, hipDeviceAttributeMultiprocessorCount, dev);
        (void)hipFuncSetAttribute((const void*)mega_fwd, hipFuncAttributeMaxDynamicSharedMemorySize, LDS_BYTES);
        (void)hipOccupancyMaxActiveBlocksPerMultiprocessor(&per_cu, (const void*)mega_fwd, NTHR, LDS_BYTES);
        if (per_cu > 1) per_cu = 1;
        if (per_cu < 1) per_cu = 1;
        grid_blocks = cus * per_cu;
    }
    (void)hipMemsetAsync(p.bar, 0, CTL_WORDS * 4, stream);
    void* args[] = {&p};
    hipError_t e = hipLaunchCooperativeKernel((const void*)mega_fwd, dim3(grid_blocks), dim3(NTHR), args, LDS_BYTES, stream);
    if (e != hipSuccess) fprintf(stderr, "cooperative launch failed: %s (grid %d)\n", hipGetErrorString(e), grid_blocks);
}
```

```cpp
#include <hip/hip_runtime.h>
#include <hip/hip_cooperative_groups.h>
#include <stdint.h>
#include <cstdio>
namespace cg = cooperative_groups;

typedef unsigned short bf16_t;
typedef short bf16x8 __attribute__((ext_vector_type(8)));
typedef float f32x4 __attribute__((ext_vector_type(4)));
typedef int i32x4 __attribute__((ext_vector_type(4)));

#define DEVI __device__ __forceinline__
__device__ __forceinline__ int stid() { int t = (int)threadIdx.x; asm volatile("" : "+v"(t)); return t; }

constexpr int T_TOK = 32768, DM = 1024, NPJ = 3584, DIN = 3592;
constexpr int NPR = 1536;
constexpr size_t OPB = (size_t)T_TOK * 512;
__device__ __forceinline__ size_t blk_off(int t16, int h) { return ((size_t)(((t16 >> 2) * 4 + h) * 4 + (t16 & 3))) * 2048; }
constexpr int NTHR = 512, NW = 8;
constexpr float EPSN = 1e-6f;

struct Params {
    const float *x, *norm1_g, *w_in, *ret_norm_g, *m_conv_w, *m_conv_b, *m_wq, *m_wk, *m_b_i, *m_b_f, *m_norm_g, *m_skip, *w_out,
        *norm2_g, *peer_wq, *peer_keys, *peer_down, *peer_up, *final_g;
    float* out;
    bf16_t *proj, *xb, *yb, *mq, *mk, *x1b, *cbuf, *W1t, *W2t, *Wqt, *Wkt;
    signed char* Wsubq;
    float* wsc;
    unsigned char *down_q, *up_q;
    float *dscale, *uscale, *asc;
    unsigned short* eperm;
    unsigned char* aq;
    short* part;
    unsigned char* xq;
    unsigned* bar;
    float *rs1, *rs2p, *ipre, *logf, *rope_cos, *rope_sin, *gate;
    int pad_[2];
};

DEVI unsigned f2bf_bits(float f) { unsigned u = __float_as_uint(f); return (u + 0x7fffu + ((u >> 16) & 1u)) >> 16; }
DEVI bf16_t f2bf(float f) { return __builtin_bit_cast(bf16_t, (__bf16)f); }
typedef __bf16 bf16x2_t __attribute__((ext_vector_type(2)));
DEVI unsigned pk2(float lo, float hi) { bf16x2_t v = {(__bf16)lo, (__bf16)hi}; return __builtin_bit_cast(unsigned, v); }
DEVI float bflo(unsigned w) { return __uint_as_float(w << 16); }
DEVI float bfhi(unsigned w) { return __uint_as_float(w & 0xffff0000u); }
DEVI float bf2f(bf16_t h) { return __uint_as_float(((unsigned)h) << 16); }
template <int CTRL> DEVI float dpp_f(float v) { return __int_as_float(__builtin_amdgcn_update_dpp(0, __float_as_int(v), CTRL, 0xf, 0xf, false)); }
template <int CTRL> DEVI int dpp_i(int v) { return __builtin_amdgcn_update_dpp(0, v, CTRL, 0xf, 0xf, false); }
constexpr int DPP_XOR1 = 0xB1  , DPP_XOR2 = 0x4E  , DPP_HMIRROR = 0x141  ,
              DPP_MIRROR = 0x140  , DPP_ROR8 = 0x128  ;
DEVI float rl_f(float v, int l) { return __int_as_float(__builtin_amdgcn_readlane(__float_as_int(v), l)); }
DEVI float wave_sum(float v) {
    v += dpp_f<DPP_XOR1>(v); v += dpp_f<DPP_XOR2>(v); v += dpp_f<DPP_HMIRROR>(v); v += dpp_f<DPP_MIRROR>(v);
    return (rl_f(v, 0) + rl_f(v, 16)) + (rl_f(v, 32) + rl_f(v, 48));
}
DEVI float wave_max(float v) {
    v = fmaxf(v, dpp_f<DPP_XOR1>(v)); v = fmaxf(v, dpp_f<DPP_XOR2>(v)); v = fmaxf(v, dpp_f<DPP_HMIRROR>(v)); v = fmaxf(v, dpp_f<DPP_MIRROR>(v));
    return fmaxf(fmaxf(rl_f(v, 0), rl_f(v, 16)), fmaxf(rl_f(v, 32), rl_f(v, 48)));
}
constexpr float ZQ_SCALE = 6.f / 127.f;
DEVI float rs2_of(const float* rs2p, int t) {
    const float4* q = (const float4*)(rs2p + (size_t)t * 16);
    const float4 a = q[0], b = q[1], c = q[2], d = q[3];
    const float ss = ((a.x + a.y) + (a.z + a.w)) + ((b.x + b.y) + (b.z + b.w)) + ((c.x + c.y) + (c.z + c.w)) + ((d.x + d.y) + (d.z + d.w));
    return rsqrtf(ss * (1.f / 1024.f) + EPSN);
}
DEVI f32x4 mfma16(bf16x8 a, bf16x8 b, f32x4 c) { return __builtin_amdgcn_mfma_f32_16x16x32_bf16(a, b, c, 0, 0, 0); }
DEVI bf16x8 ld8(const char* p) { return *reinterpret_cast<const bf16x8*>(p); }
DEVI bf16x8 mk8(uint2 lo, uint2 hi) {
    union { uint4 u; bf16x8 v; } x;
    x.u = make_uint4(lo.x, lo.y, hi.x, hi.y);
    return x.v;
}
DEVI float fexp_(float x) { return __builtin_amdgcn_exp2f(x * 1.4426950408889634f); }
DEVI float rcp_(float x) { return __builtin_amdgcn_rcpf(x); }
DEVI float sigmoidf_(float z) { return rcp_(1.f + fexp_(-z)); }

DEVI void st_prep_misc(const Params& p) {
    const int gtid = blockIdx.x * NTHR + stid(), gsz = gridDim.x * NTHR;
    for (int i = gtid; i < 2048 * 64; i += gsz) {
        const int pos = i >> 6, j = i & 63;
        const float inv = powf(10000.f, -(float)j * (1.f / 64.f));
        const float ang = (float)pos * inv;
        float s, c;
        sincosf(ang, &s, &c);
        p.rope_cos[i] = c;
        p.rope_sin[i] = s;
    }
    for (int i = gtid; i < 4 * 128 * 128; i += gsz) {
        const int h = i >> 14, e = (i >> 7) & 127, d = i & 127;
        p.Wqt[i] = f2bf(p.m_wq[h * 16384 + d * 128 + e]);
        p.Wkt[i] = f2bf(p.m_wk[h * 16384 + d * 128 + e] * 0.08838834764831845f);
    }
}
DEVI void prep_table_row(const Params& p, int row, const float4 (&v)[4], int lane) {
    const bool up = row >= 16384;
    const int e = up ? row - 16384 : row;
    float am = 0.f;
#pragma unroll
    for (int i = 0; i < 4; ++i) am = fmaxf(am, fmaxf(fmaxf(fabsf(v[i].x), fabsf(v[i].y)), fmaxf(fabsf(v[i].z), fabsf(v[i].w))));
    am = wave_max(am);
    const float sc = am > 0.f ? am * (1.f / 127.f) : 1.f, inv = am > 0.f ? 127.f * rcp_(am) : 0.f;
    unsigned w[4];
#pragma unroll
    for (int i = 0; i < 4; ++i) {
        const int q0 = (int)rintf(v[i].x * inv), q1 = (int)rintf(v[i].y * inv), q2 = (int)rintf(v[i].z * inv), q3 = (int)rintf(v[i].w * inv);
        w[i] = (unsigned)(q0 & 255) | ((unsigned)(q1 & 255) << 8) | ((unsigned)(q2 & 255) << 16) | ((unsigned)(q3 & 255) << 24);
    }
    *(uint4*)((up ? p.up_q : p.down_q) + ((size_t)(lane >> 3) * 16384 + e) * 128 + (lane & 7) * 16) = make_uint4(w[0], w[1], w[2], w[3]);
    if (lane == 0) (up ? p.uscale : p.dscale)[e] = sc;
}
DEVI void st_prep_tables(const Params& p, int bid, int nb) {
    const int lane = stid() & 63, wid = stid() >> 6;
    for (int row = (bid * NW + wid) * 2; row < 32768; row += nb * NW * 2) {
        float4 va[4], vb[4];
        const float4* sa = (const float4*)((row >= 16384 ? p.peer_up + (size_t)(row - 16384) * 1024 : p.peer_down + (size_t)row * 1024) + lane * 16);
        const float4* sb = (const float4*)((row + 1 >= 16384 ? p.peer_up + (size_t)(row + 1 - 16384) * 1024 : p.peer_down + (size_t)(row + 1) * 1024) + lane * 16);
#pragma unroll
        for (int i = 0; i < 4; ++i) { va[i] = sa[i]; vb[i] = sb[i]; }
        prep_table_row(p, row, va, lane);
        prep_table_row(p, row + 1, vb, lane);
    }
}

DEVI void transpose_tile(const float* __restrict__ src, int ld, const float* __restrict__ scale, bf16_t* __restrict__ dst, int K, int k0, int n0,
                         float* tile, bool permqk = false) {
    const int tid = stid();
    {
        const int tx = tid & 63, ty = tid >> 6;
#pragma unroll
        for (int i = 0; i < 4; ++i) {
            const int k = k0 + ty + 8 * i;
            float v = src[(size_t)k * ld + n0 + tx];
            if (scale) v *= scale[k];
            tile[(ty + 8 * i) * 65 + tx] = v;
        }
    }
    __syncthreads();
    {
        const int n = tid >> 3, kq = tid & 7;
        const float a = tile[(4 * kq) * 65 + n], b = tile[(4 * kq + 1) * 65 + n], c = tile[(4 * kq + 2) * 65 + n], d = tile[(4 * kq + 3) * 65 + n];
        int nn = n0 + n;
        if (permqk && nn < 1024) { const int dd = nn & 127; nn = (nn & ~127) + (dd < 64 ? 2 * dd : 2 * (dd - 64) + 1); }
        *(uint2*)(dst + (size_t)nn * K + k0 + 4 * kq) = make_uint2(pk2(a, b), pk2(c, d));
    }
    __syncthreads();
}
DEVI void st_prep_w1(const Params& p, char* smem) {
    float* tile = (float*)smem;
    for (int it = blockIdx.x; it < 56 * 32; it += gridDim.x) transpose_tile(p.w_in, DIN, p.norm1_g, p.W1t, 1024, (it & 31) * 32, (it >> 5) * 64, tile, true);
}
DEVI void st_prep_w2(const Params& p, char* smem, int bid, int nb) {
    float* tile = (float*)smem;
    for (int it = bid; it < 16 * 32; it += nb) transpose_tile(p.w_out, 1024, nullptr, p.W2t, 1024, (it & 31) * 32, (it >> 5) * 64, tile);
}
DEVI void st_prep_wsub(const Params& p, char* smem, int bid, int nb) {
    float* wq_s = (float*)smem;
    float* key_s = wq_s + 64 * 132;
    const int tid = stid(), nl = tid >> 5, kp = tid & 31;
    for (int it = bid; it < 16 * 8; it += nb) {
        const int grp = it >> 3, n0 = (it & 7) * 16;
        __syncthreads();
        {
            const int idx = tid * 4, n = idx >> 7, d = idx & 127;
            *(float4*)(key_s + n * 132 + d) = *(const float4*)(p.peer_keys + ((size_t)grp * 128 + n0 + n) * 128 + d);
        }
        float v0[16], v1[16];
#pragma unroll 1
        for (int kt = 0; kt < 16; ++kt) {
            __syncthreads();
#pragma unroll
            for (int i = 0; i < 4; ++i) {
                const int idx = (tid + 512 * i) * 4, r = idx >> 7, d = idx & 127;
                *(float4*)(wq_s + r * 132 + d) = *(const float4*)(p.peer_wq + (size_t)(kt * 64 + r) * 2048 + grp * 128 + d);
            }
            __syncthreads();
            float a0 = 0.f, a1 = 0.f;
#pragma unroll 8
            for (int d4 = 0; d4 < 32; ++d4) {
                const float4 w0 = *(const float4*)(wq_s + (2 * kp) * 132 + 4 * d4), w1 = *(const float4*)(wq_s + (2 * kp + 1) * 132 + 4 * d4);
                const float4 y = *(const float4*)(key_s + nl * 132 + 4 * d4);
                a0 += w0.x * y.x + w0.y * y.y + w0.z * y.z + w0.w * y.w;
                a1 += w1.x * y.x + w1.y * y.y + w1.z * y.z + w1.w * y.w;
            }
#pragma unroll
            for (int q = 0; q < 16; ++q) if (q == kt) { v0[q] = a0; v1[q] = a1; }
        }
        float am = 0.f;
#pragma unroll
        for (int q = 0; q < 16; ++q) am = fmaxf(am, fmaxf(fabsf(v0[q]), fabsf(v1[q])));
#pragma unroll
        for (int o = 16; o; o >>= 1) am = fmaxf(am, __shfl_xor(am, o));
        const float inv = am > 0.f ? 127.f * rcp_(am) : 0.f;
        signed char* orow = p.Wsubq + (size_t)(grp * 128 + n0 + nl) * 1024 + 2 * kp;
#pragma unroll
        for (int q = 0; q < 16; ++q) {
            const int q0 = (int)rintf(v0[q] * inv), q1 = (int)rintf(v1[q] * inv);
            *(unsigned short*)(orow + 64 * q) = (unsigned short)((q0 & 255) | ((q1 & 255) << 8));
        }
        if (kp == 0) p.wsc[grp * 128 + n0 + nl] = am > 0.f ? am * (1.f / 127.f) : 1.f;
    }
    __syncthreads();
}

DEVI void prep_x_token(const Params& p, const float* Wg_s, int t, const float4 (&v)[4], int lane) {
    float ss = 0.f, g8[8];
#pragma unroll
    for (int g = 0; g < 8; ++g) g8[g] = 0.f;
#pragma unroll
    for (int j = 0; j < 4; ++j) {
        ss += v[j].x * v[j].x + v[j].y * v[j].y + v[j].z * v[j].z + v[j].w * v[j].w;
#pragma unroll
        for (int g = 0; g < 8; ++g) {
            const float4 w = *(const float4*)(Wg_s + g * 1024 + (lane + 64 * j) * 4);
            g8[g] += v[j].x * w.x + v[j].y * w.y + v[j].z * w.z + v[j].w * w.w;
        }
    }
    ss = wave_sum(ss);
    const bool b5 = lane & 32, b4 = lane & 16, b3 = lane & 8;
    float q4[4], q2[2], q1;
#pragma unroll
    for (int j = 0; j < 4; ++j) { const float snd = b5 ? g8[j] : g8[j + 4], kp = b5 ? g8[j + 4] : g8[j]; q4[j] = kp + __shfl_xor(snd, 32); }
#pragma unroll
    for (int j = 0; j < 2; ++j) { const float snd = b4 ? q4[j] : q4[j + 2], kp = b4 ? q4[j + 2] : q4[j]; q2[j] = kp + __shfl_xor(snd, 16); }
    { const float snd = b3 ? q2[0] : q2[1], kp = b3 ? q2[1] : q2[0]; q1 = kp + __shfl_xor(snd, 8); }
    q1 += __shfl_xor(q1, 4);
    q1 += __shfl_xor(q1, 2);
    q1 += __shfl_xor(q1, 1);
    const float rs = rsqrtf(ss * (1.f / 1024.f) + EPSN);
    uint2* o = (uint2*)(p.xb + (size_t)t * 1024);
#pragma unroll
    for (int j = 0; j < 4; ++j) o[lane + 64 * j] = make_uint2(pk2(v[j].x, v[j].y), pk2(v[j].z, v[j].w));
    if (lane == 0) p.rs1[t] = rs;
    if ((lane & 7) == 0) {
        const int gi = (b5 ? 4 : 0) + (b4 ? 2 : 0) + (b3 ? 1 : 0);
        if (gi < 4) p.ipre[t * 4 + gi] = q1 * rs + p.m_b_i[gi];
        else {
            const float z = q1 * rs + p.m_b_f[gi - 4];
            p.logf[t * 4 + gi - 4] = fminf(z, 0.f) - log1pf(fexp_(-fabsf(z)));
        }
    }
}
DEVI void st_prep_x(const Params& p, char* smem) {
    float* Wg_s = (float*)smem;
    for (int i = stid(); i < 8192; i += NTHR) {
        const int k = i >> 3, g = i & 7;
        Wg_s[g * 1024 + k] = p.norm1_g[k] * p.w_in[(size_t)k * DIN + NPJ + g];
    }
    __syncthreads();
    const int lane = stid() & 63, wid = stid() >> 6;
    for (int t = (blockIdx.x * NW + wid) * 4; t < T_TOK; t += gridDim.x * NW * 4) {
        float4 v[4][4];
        const float4* xa = (const float4*)(p.x + (size_t)t * 1024);
#pragma unroll
        for (int q = 0; q < 4; ++q)
#pragma unroll
            for (int j = 0; j < 4; ++j) v[q][j] = xa[256 * q + lane + 64 * j];
#pragma unroll
        for (int q = 0; q < 4; ++q) prep_x_token(p, Wg_s, t + q, v[q], lane);
    }
    __syncthreads();
}

namespace pg8 {
#define PG8_LAS __attribute__((address_space(3)))
typedef unsigned short bf16_t;
typedef short bf16x8 __attribute__((ext_vector_type(8)));
typedef float f32x4 __attribute__((ext_vector_type(4)));
typedef unsigned u32x4 __attribute__((ext_vector_type(4)));
constexpr int BM = 256, BK = 64, HALF = 128, HTB = HALF * BK * 2  , STAGE_BYTES = 8 * HTB, NXCD = 8, WGM = 8;

__host__ __device__ __forceinline__ int lds_byte(int r, int c) { const int st = (r >> 4) * 2 + (c >> 5), rr = r & 15, cc = c & 31, ob = rr * 64 + cc * 2; return st * 1024 + (ob ^ (((ob >> 9) & 1) << 5)); }
__host__ __device__ __forceinline__ void stage_rc(int b, int& R, int& C) { const int st = b / 1024, sb = b % 1024, swz = sb ^ (((sb >> 9) & 1) << 5); R = (st >> 1) * 16 + swz / 64; C = (st & 1) * 32 + (swz % 64) / 2; }
__host__ __device__ __forceinline__ int perm32(int rho) { const int n = rho >> 4, i = rho & 15; return 8 * (i >> 2) + 4 * n + (i & 3); }

struct Unit { int pm, pn; };
struct Gemm { const bf16_t* A; const bf16_t* Bt; int M, N, K; };

struct StaticOrder {
    int nM, nN, nwg, G, c;
    __host__ __device__ void init(int M, int N, int G_, int c_) { nM = M / BM; nN = N / BM; nwg = nM * nN; G = G_; c = c_; }
    __host__ __device__ bool next(int i, Unit& u) const {
        const long L = (long)i * G + c; if (L >= nwg) return false;
        int wgid = (int)L; { const int q = nwg / NXCD, r = nwg % NXCD, xcd = wgid % NXCD, off = wgid / NXCD; wgid = (xcd < r ? xcd * (q + 1) : r * (q + 1) + (xcd - r) * q) + off; }
        const int nig = WGM * nN, gid = wgid / nig, fm = gid * WGM, gsz = (nM - fm) < WGM ? (nM - fm) : WGM;
        u.pm = fm + ((wgid % nig) % gsz); u.pn = (wgid % nig) / gsz; return true;
    }
    __device__ __forceinline__ void a_ready(const Unit&) const {}
    __device__ __forceinline__ void done(const Unit&) const {}
};

__device__ __forceinline__ unsigned cvt_pk_bf16(float lo, float hi) { unsigned r; asm volatile("v_cvt_pk_bf16_f32 %0, %1, %2" : "=v"(r) : "v"(lo), "v"(hi)); return r; }

template <class Epi, class Sched, bool ALIGN_EPI = false, bool SP2 = false>
__device__ __forceinline__ void gemm_phase(PG8_LAS unsigned char* lds, const Gemm g, const Sched& S, const Epi& E) {
    const int tid = stid(), wid = __builtin_amdgcn_readfirstlane(tid >> 6), lane = tid & 63, wr = wid >> 2, wc = wid & 3, fr = lane & 15, fq = lane >> 4;
    const int K = g.K, nt = K / BK;
    unsigned voffA[2], voffB[2];
#pragma unroll
    for (int i = 0; i < 2; ++i) { int R, C; stage_rc(tid * 16 + i * 8192, R, C); const int Rb = Epi::PERM ? ((R & ~31) + perm32(R & 31)) : R;
        voffA[i] = (unsigned)(R * K + C) * 2u; voffB[i] = (unsigned)(Rb * K + C) * 2u; }
    const size_t kstep = (size_t)(BK * 2);
    const size_t hstep = (size_t)HALF * K * 2;
    const size_t tstep = 2 * hstep;
    const unsigned ldsw = (unsigned)wid * 1024u;
    const int aoff = lds_byte(wr * 64 + fr, fq * 8), boff = lds_byte(wc * 32 + fr, fq * 8);
#define PG8_SA(b, h) (((b) * 2 + (h)) * HTB)
#define PG8_SB(b, h) ((4 + (b) * 2 + (h)) * HTB)
#define PG8_STAGE(bufoff, gbase, voff) do { _Pragma("unroll") for (int _i = 0; _i < 2; ++_i) \
        __builtin_amdgcn_global_load_lds((const unsigned*)((const char*)(gbase) + (voff)[_i]), (PG8_LAS unsigned*)(lds + (bufoff) + ldsw + _i * 8192), 16, 0, 0); } while (0)
#define PG8_LDA(dst, b, h) do { _Pragma("unroll") for (int m = 0; m < 4; ++m) _Pragma("unroll") for (int k = 0; k < 2; ++k) dst[m][k] = *(const PG8_LAS bf16x8*)(lds + PG8_SA(b, h) + aoff + m * 2048 + k * 1024); } while (0)
#define PG8_LDB(dst, b, h) do { _Pragma("unroll") for (int n = 0; n < 2; ++n) _Pragma("unroll") for (int k = 0; k < 2; ++k) dst[n][k] = *(const PG8_LAS bf16x8*)(lds + PG8_SB(b, h) + boff + n * 2048 + k * 1024); } while (0)
#define PG8_MMA(ai, bj, At, Bt) do { __builtin_amdgcn_s_setprio(1); _Pragma("unroll") for (int m = 0; m < 4; ++m) _Pragma("unroll") for (int n = 0; n < 2; ++n) _Pragma("unroll") for (int k = 0; k < 2; ++k) \
        acc[ai][bj][m][n] = __builtin_amdgcn_mfma_f32_16x16x32_bf16(Bt[n][k], At[m][k], acc[ai][bj][m][n], 0, 0, 0); __builtin_amdgcn_s_setprio(0); } while (0)
#define PG8_WAIT_V(n) asm volatile("s_waitcnt vmcnt(" #n ")" ::: "memory")
#define PG8_WAIT_L(n) asm volatile("s_waitcnt lgkmcnt(" #n ")" ::: "memory")
#define PG8_BAR __builtin_amdgcn_s_barrier()
#define PG8_SCHED __builtin_amdgcn_sched_barrier(0)
    Unit cur, nxt; int ui = 0;
    if (!S.next(0, cur)) return;
    f32x4 acc[2][2][4][2];
#pragma unroll
    for (int a = 0; a < 2; ++a)
#pragma unroll
        for (int b = 0; b < 2; ++b)
#pragma unroll
            for (int m = 0; m < 4; ++m)
#pragma unroll
                for (int n = 0; n < 2; ++n) acc[a][b][m][n] = (f32x4){0.f, 0.f, 0.f, 0.f};
    bf16x8 At[4][2], B0[2][2], B1[2][2];
    const char* cA = (const char*)g.A + (size_t)cur.pm * tstep; const char* cB = (const char*)g.Bt + (size_t)cur.pn * tstep;
    S.a_ready(cur);
    if constexpr (SP2) {
        PG8_STAGE(PG8_SB(0, 0), cB, voffB); PG8_STAGE(PG8_SB(0, 1), cB + hstep, voffB); PG8_STAGE(PG8_SA(0, 0), cA, voffA); PG8_STAGE(PG8_SA(0, 1), cA + hstep, voffA);
        if (wr == 1) PG8_BAR;
        PG8_WAIT_V(2); PG8_BAR;
        PG8_STAGE(PG8_SB(1, 0), cB + kstep, voffB); PG8_STAGE(PG8_SA(1, 0), cA + kstep, voffA); PG8_STAGE(PG8_SB(1, 1), cB + hstep + kstep, voffB);
        PG8_WAIT_V(6); PG8_BAR;
    } else {
        PG8_STAGE(PG8_SB(0, 0), cB, voffB); PG8_STAGE(PG8_SA(0, 0), cA, voffA); PG8_STAGE(PG8_SB(0, 1), cB + hstep, voffB); PG8_STAGE(PG8_SA(0, 1), cA + hstep, voffA);
        if (wr == 1) PG8_BAR;
        PG8_WAIT_V(4); PG8_BAR;
        PG8_STAGE(PG8_SB(1, 0), cB + kstep, voffB); PG8_STAGE(PG8_SA(1, 0), cA + kstep, voffA); PG8_STAGE(PG8_SB(1, 1), cB + hstep + kstep, voffB);
        PG8_WAIT_V(6); PG8_BAR;
    }
    for (;;) {
        const bool has_next = S.next(ui + 1, nxt);
        const char* nA = has_next ? (const char*)g.A + (size_t)nxt.pm * tstep : cA; const char* nB = has_next ? (const char*)g.Bt + (size_t)nxt.pn * tstep : cB;
        for (int t = 0; t < nt; t += 2) {
            const bool last = (t == nt - 2);
            const char* a1 = cA + (size_t)(t + 1) * kstep;
            const char* a2 = last ? nA : cA + (size_t)(t + 2) * kstep; const char* b2 = last ? nB : cB + (size_t)(t + 2) * kstep;
            const char* a3 = a2 + kstep; const char* b3 = b2 + kstep;
            if (last && has_next) S.a_ready(nxt);
            if constexpr (SP2) {
            PG8_LDB(B0, 0, 0); PG8_LDB(B1, 0, 1); PG8_SCHED; PG8_LDA(At, 0, 0); PG8_STAGE(PG8_SA(1, 1), a1 + hstep, voffA);
            PG8_WAIT_V(8); PG8_WAIT_L(0); PG8_BAR; PG8_MMA(0, 0, At, B0); PG8_MMA(0, 1, At, B1); PG8_BAR; PG8_SCHED;
            PG8_LDA(At, 0, 1); PG8_STAGE(PG8_SB(0, 0), b2, voffB); PG8_STAGE(PG8_SB(0, 1), b2 + hstep, voffB); PG8_STAGE(PG8_SA(0, 0), a2, voffA);
            PG8_WAIT_V(8); PG8_WAIT_L(0); PG8_BAR; PG8_MMA(1, 0, At, B0); PG8_MMA(1, 1, At, B1); PG8_BAR; PG8_SCHED;
            PG8_LDB(B0, 1, 0); PG8_LDB(B1, 1, 1); PG8_SCHED; PG8_LDA(At, 1, 0); PG8_STAGE(PG8_SA(0, 1), a2 + hstep, voffA);
            PG8_WAIT_V(8); PG8_WAIT_L(0); PG8_BAR; PG8_MMA(0, 0, At, B0); PG8_MMA(0, 1, At, B1); PG8_BAR; PG8_SCHED;
            PG8_LDA(At, 1, 1); PG8_STAGE(PG8_SB(1, 0), b3, voffB); PG8_STAGE(PG8_SB(1, 1), b3 + hstep, voffB); PG8_STAGE(PG8_SA(1, 0), a3, voffA);
            PG8_WAIT_V(8); PG8_WAIT_L(0); PG8_BAR; PG8_MMA(1, 0, At, B0); PG8_MMA(1, 1, At, B1); PG8_BAR; PG8_SCHED;
            } else {
            PG8_LDB(B0, 0, 0); PG8_SCHED; PG8_LDA(At, 0, 0); PG8_STAGE(PG8_SA(1, 1), a1 + hstep, voffA);
            PG8_WAIT_L(8); PG8_BAR; PG8_WAIT_L(0); PG8_MMA(0, 0, At, B0); PG8_BAR; PG8_SCHED;
            PG8_LDB(B1, 0, 1); PG8_STAGE(PG8_SB(0, 0), b2, voffB);
            PG8_BAR; PG8_WAIT_L(0); PG8_MMA(0, 1, At, B1); PG8_BAR;
            PG8_LDA(At, 0, 1); PG8_STAGE(PG8_SA(0, 0), a2, voffA);
            PG8_BAR; PG8_WAIT_L(0); PG8_MMA(1, 0, At, B0); PG8_BAR; PG8_SCHED;
            PG8_STAGE(PG8_SB(0, 1), b2 + hstep, voffB);
            PG8_WAIT_V(6); PG8_BAR; PG8_MMA(1, 1, At, B1); PG8_BAR;
            PG8_LDB(B0, 1, 0); PG8_SCHED; PG8_LDA(At, 1, 0); PG8_STAGE(PG8_SA(0, 1), a2 + hstep, voffA);
            PG8_WAIT_L(8); PG8_BAR; PG8_WAIT_L(0); PG8_MMA(0, 0, At, B0); PG8_BAR; PG8_SCHED;
            PG8_LDB(B1, 1, 1); PG8_STAGE(PG8_SB(1, 0), b3, voffB);
            PG8_BAR; PG8_WAIT_L(0); PG8_MMA(0, 1, At, B1); PG8_BAR;
            PG8_LDA(At, 1, 1); PG8_STAGE(PG8_SA(1, 0), a3, voffA);
            PG8_BAR; PG8_WAIT_L(0); PG8_MMA(1, 0, At, B0); PG8_BAR; PG8_SCHED;
            PG8_STAGE(PG8_SB(1, 1), b3 + hstep, voffB);
            PG8_WAIT_V(6); PG8_BAR; PG8_MMA(1, 1, At, B1); PG8_BAR;
            }
        }
        if constexpr (ALIGN_EPI) { if (wr == 0) PG8_BAR; }
        if constexpr (!Epi::AFTER_DRAIN) { E(acc, cur, wr, wc, fr, fq); S.done(cur); }
        if (!has_next) break;
#pragma unroll
        for (int a = 0; a < 2; ++a)
#pragma unroll
            for (int b = 0; b < 2; ++b)
#pragma unroll
                for (int m = 0; m < 4; ++m)
#pragma unroll
                    for (int n = 0; n < 2; ++n) acc[a][b][m][n] = (f32x4){0.f, 0.f, 0.f, 0.f};
        cur = nxt; cA = nA; cB = nB; ++ui;
        if constexpr (ALIGN_EPI) { if (wr == 1) PG8_BAR; }
    }
    PG8_WAIT_V(0);
    if constexpr (!ALIGN_EPI) { if (wr == 0) PG8_BAR; }
    PG8_BAR;
    if constexpr (Epi::AFTER_DRAIN) { E.fused(acc, cur, wr, wc, fr, fq, lds, wid, lane); S.done(cur); }
#undef PG8_SA
#undef PG8_SB
#undef PG8_STAGE
#undef PG8_LDA
#undef PG8_LDB
#undef PG8_MMA
#undef PG8_WAIT_V
#undef PG8_WAIT_L
#undef PG8_BAR
#undef PG8_SCHED
}
}

#ifndef PG8_SP2
#define PG8_SP2 true
#endif
#ifndef PG8_ALIGN
#define PG8_ALIGN true
#endif
struct EpiProj8 {
    static constexpr bool PERM = true, AFTER_DRAIN = false;
    bf16_t* O; const float* rs; const float* rcos; const float* rsin;
    __device__ __forceinline__ void operator()(const pg8::f32x4 (&acc)[2][2][4][2], const pg8::Unit& u, int wr, int wc, int fr, int fq) const {
        const int row0 = u.pm * 256 + wr * 64 + fr, col0 = u.pn * 256 + wc * 32 + 8 * fq;
        const bool rot = u.pn < 4;
        const float ksc = u.pn >= 2 ? 0.08838834764831845f : 1.f;
#pragma unroll
        for (int ai = 0; ai < 2; ++ai)
#pragma unroll
            for (int m = 0; m < 4; ++m) {
                const int row = row0 + ai * 128 + m * 16;
                const float s = rs[row];
                const int seg = u.pn >> 1;
                const bool blocked = (seg < 3) || (seg == 5);
                bf16_t* rowp;
                int bjs;
                if (blocked) {
                    rowp = O + (size_t)(seg == 5 ? 3 : seg) * OPB + blk_off(row >> 4, (u.pn & 1) * 2) + (wc * 4 + fq) * 128 + fr * 8;
                    bjs = 4 * 2048;
                } else {
                    rowp = O + 4 * OPB + (size_t)row * NPR + (seg == 3 ? 0 : seg == 4 ? 512 : 1024) + (u.pn & 1) * 256 + wc * 32 + 8 * fq;
                    bjs = 128;
                }
                float4 cs = make_float4(1.f, 1.f, 1.f, 1.f), sn = make_float4(0.f, 0.f, 0.f, 0.f);
                float s2 = s;
                if (rot) {
                    const int ti = (row & 2047) * 64 + 16 * wc + 4 * fq;
                    cs = *(const float4*)(rcos + ti);
                    sn = *(const float4*)(rsin + ti);
                    s2 = s * ksc;
                }
#pragma unroll
                for (int bj = 0; bj < 2; ++bj) {
                    const pg8::f32x4 v0 = acc[ai][bj][m][0] * s2, v1 = acc[ai][bj][m][1] * s2;
                    *(uint4*)(rowp + bj * bjs) = make_uint4(pk2(v0[0] * cs.x - v0[1] * sn.x, v0[0] * sn.x + v0[1] * cs.x), pk2(v0[2] * cs.y - v0[3] * sn.y, v0[2] * sn.y + v0[3] * cs.y),
                                                            pk2(v1[0] * cs.z - v1[1] * sn.z, v1[0] * sn.z + v1[1] * cs.z), pk2(v1[2] * cs.w - v1[3] * sn.w, v1[2] * sn.w + v1[3] * cs.w));
                }
            }
    }
};
struct EpiX18 {
    static constexpr bool PERM = true, AFTER_DRAIN = false;
    const float* x; bf16_t* x1b; unsigned char* zq; float* rs2p; const float* g2;
    __device__ __forceinline__ void operator()(const pg8::f32x4 (&acc)[2][2][4][2], const pg8::Unit& u, int wr, int wc, int fr, int fq) const {
        const int row0 = u.pm * 256 + wr * 64 + fr, col0 = u.pn * 256 + wc * 32 + 8 * fq;
        float gq[2][8];
#pragma unroll
        for (int bj = 0; bj < 2; ++bj) {
            const float4 a = *(const float4*)(g2 + col0 + bj * 128), b = *(const float4*)(g2 + col0 + bj * 128 + 4);
            gq[bj][0] = a.x; gq[bj][1] = a.y; gq[bj][2] = a.z; gq[bj][3] = a.w; gq[bj][4] = b.x; gq[bj][5] = b.y; gq[bj][6] = b.z; gq[bj][7] = b.w;
        }
        float ssq[8];
#pragma unroll
        for (int ai = 0; ai < 2; ++ai)
#pragma unroll
            for (int m = 0; m < 4; ++m) {
                const size_t ro = (size_t)(row0 + ai * 128 + m * 16) * 1024 + col0;
                float s = 0.f;
#pragma unroll
                for (int bj = 0; bj < 2; ++bj) {
                    const float4 xa = *(const float4*)(x + ro + bj * 128), xb_ = *(const float4*)(x + ro + bj * 128 + 4);
                    const pg8::f32x4 v0 = acc[ai][bj][m][0], v1 = acc[ai][bj][m][1];
                    const float y[8] = {xa.x + v0[0], xa.y + v0[1], xa.z + v0[2], xa.w + v0[3], xb_.x + v1[0], xb_.y + v1[1], xb_.z + v1[2], xb_.w + v1[3]};
                    *(uint4*)(x1b + ro + bj * 128) = make_uint4(pk2(y[0], y[1]), pk2(y[2], y[3]), pk2(y[4], y[5]), pk2(y[6], y[7]));
                    unsigned w2[2] = {0u, 0u};
#pragma unroll
                    for (int e = 0; e < 8; ++e) {
                        s += y[e] * y[e];
                        const float z = fminf(fmaxf(y[e] * gq[bj][e] * (1.f / ZQ_SCALE), -127.f), 127.f);
                        w2[e >> 2] |= ((unsigned)((int)rintf(z) & 255)) << (8 * (e & 3));
                    }
                    *(uint2*)(zq + ro + bj * 128) = make_uint2(w2[0], w2[1]);
                }
                ssq[ai * 4 + m] = s;
            }
        float q4[4], q2[2];
#pragma unroll
        for (int j = 0; j < 4; ++j) {
            const auto r = __builtin_amdgcn_permlane32_swap(__float_as_uint(ssq[j]), __float_as_uint(ssq[j + 4]), false, false);
            q4[j] = __uint_as_float(r[0]) + __uint_as_float(r[1]);
        }
#pragma unroll
        for (int j = 0; j < 2; ++j) {
            const auto r = __builtin_amdgcn_permlane16_swap(__float_as_uint(q4[j]), __float_as_uint(q4[j + 2]), false, false);
            q2[j] = __uint_as_float(r[0]) + __uint_as_float(r[1]);
        }
#pragma unroll
        for (int j = 0; j < 2; ++j) {
            const int r8 = ((fq >> 1) & 1) * 4 + (fq & 1) * 2 + j;
            rs2p[(size_t)(row0 + (r8 >> 2) * 128 + (r8 & 3) * 16) * 16 + u.pn * 4 + wc] = q2[j];
        }
    }
};
template <class Epi, bool ALIGN>
DEVI void st_gemm8(const bf16_t* A, const bf16_t* Bt, int N, int K, char* smem, const Epi& epi) {
    pg8::Gemm g{A, Bt, T_TOK, N, K};
    pg8::StaticOrder S;
    S.init(T_TOK, N, (int)gridDim.x, (int)blockIdx.x);
    pg8::gemm_phase<Epi, pg8::StaticOrder, ALIGN, PG8_SP2>((PG8_LAS unsigned char*)smem, g, S, epi);
}

DEVI void st_conv_qk(const Params& p, char* smem) {
    char* cs = smem;
    char* wqs = smem + 128 * 272;
    char* wks = smem + 2 * 128 * 272;
    const int tid = stid(), lane = tid & 63, wid = tid >> 6, wr = wid >> 1, wc = wid & 1, fr = lane & 15, fq = lane >> 4;
    const int r = tid >> 4, cg = tid & 15;
    int hcur = -1;
    float cw[4][8], cb[8];
    for (int it = blockIdx.x; it < 256 * 4; it += gridDim.x) {
        const int h = it & 3, t0 = (it >> 2) * 128, s0 = t0 & 2047;
        if (h != hcur) {
            __syncthreads();
#pragma unroll
            for (int i = 0; i < 4; ++i) {
                const int id = tid + 512 * i, rr = id >> 4, c = id & 15;
                *(uint4*)(wqs + rr * 272 + c * 16) = *(const uint4*)(p.Wqt + h * 16384 + rr * 128 + c * 8);
                *(uint4*)(wks + rr * 272 + c * 16) = *(const uint4*)(p.Wkt + h * 16384 + rr * 128 + c * 8);
            }
#pragma unroll
            for (int j = 0; j < 4; ++j) {
                const float4 a = *(const float4*)(p.m_conv_w + j * 512 + h * 128 + 8 * cg), b = *(const float4*)(p.m_conv_w + j * 512 + h * 128 + 8 * cg + 4);
                cw[j][0] = a.x; cw[j][1] = a.y; cw[j][2] = a.z; cw[j][3] = a.w; cw[j][4] = b.x; cw[j][5] = b.y; cw[j][6] = b.z; cw[j][7] = b.w;
            }
            { const float4 a = *(const float4*)(p.m_conv_b + h * 128 + 8 * cg), b = *(const float4*)(p.m_conv_b + h * 128 + 8 * cg + 4);
              cb[0] = a.x; cb[1] = a.y; cb[2] = a.z; cb[3] = a.w; cb[4] = b.x; cb[5] = b.y; cb[6] = b.z; cb[7] = b.w; }
            hcur = h;
        }
        const bf16_t* xcol = p.proj + 4 * OPB + (size_t)t0 * NPR + 512 + h * 128 + 8 * cg;
#pragma unroll
        for (int ps = 0; ps < 4; ++ps) {
            const int row = 32 * ps + r;
            uint4 xv[4];
#pragma unroll
            for (int j = 0; j < 4; ++j) {
                const int rj = row - 3 + j;
                xv[j] = (s0 + rj >= 0) ? *(const uint4*)(xcol + (long)rj * NPR) : make_uint4(0u, 0u, 0u, 0u);
            }
            float y[8];
#pragma unroll
            for (int e = 0; e < 8; ++e) y[e] = cb[e];
#pragma unroll
            for (int j = 0; j < 4; ++j) {
                const unsigned w4[4] = {xv[j].x, xv[j].y, xv[j].z, xv[j].w};
#pragma unroll
                for (int e = 0; e < 4; ++e) { y[2 * e] += cw[j][2 * e] * bflo(w4[e]); y[2 * e + 1] += cw[j][2 * e + 1] * bfhi(w4[e]); }
            }
            unsigned o[4];
#pragma unroll
            for (int e = 0; e < 4; ++e) o[e] = pk2(y[2 * e] * sigmoidf_(y[2 * e]), y[2 * e + 1] * sigmoidf_(y[2 * e + 1]));
            const uint4 ov = make_uint4(o[0], o[1], o[2], o[3]);
            *(uint4*)(cs + row * 272 + cg * 16) = ov;
            *(uint4*)(p.cbuf + (size_t)(t0 + row) * 512 + h * 128 + 8 * cg) = ov;
        }
        __syncthreads();
#pragma unroll
        for (int which = 0; which < 2; ++which) {
            const char* ws = which ? wks : wqs;
            bf16_t* O = which ? p.mk : p.mq;
            f32x4 acc[2][4];
#pragma unroll
            for (int i = 0; i < 2; ++i)
#pragma unroll
                for (int j = 0; j < 4; ++j) acc[i][j] = (f32x4){0.f, 0.f, 0.f, 0.f};
#pragma unroll
            for (int ks = 0; ks < 4; ++ks) {
                bf16x8 a[2], b[4];
#pragma unroll
                for (int i = 0; i < 2; ++i) a[i] = ld8(cs + (wr * 32 + i * 16 + fr) * 272 + (ks * 4 + fq) * 16);
#pragma unroll
                for (int j = 0; j < 4; ++j) b[j] = ld8(ws + (wc * 64 + j * 16 + fr) * 272 + (ks * 4 + fq) * 16);
#pragma unroll
                for (int i = 0; i < 2; ++i)
#pragma unroll
                    for (int j = 0; j < 4; ++j) acc[i][j] = mfma16(b[j], a[i], acc[i][j]);
            }
#pragma unroll
            for (int i = 0; i < 2; ++i)
#pragma unroll
                for (int j = 0; j < 4; ++j) {
                    const f32x4 v = acc[i][j];
                    *(uint2*)(O + blk_off((t0 >> 4) + wr * 2 + i, h) + (wc * 8 + j * 2 + (fq >> 1)) * 128 + fr * 8 + (fq & 1) * 4) = make_uint2(pk2(v[0], v[1]), pk2(v[2], v[3]));
                }
        }
        __syncthreads();
    }
}

DEVI bf16x8 u4_to_frag(uint4 u) { union { uint4 u; bf16x8 v; } x; x.u = u; return x.v; }
DEVI void sel_frags(bf16x8 (&sel)[2], int fr, int fq) {
#pragma unroll
    for (int hh = 0; hh < 2; ++hh) {
        const int jstar = fr + 16 * hh - 8 * fq;
        bf16x8 s;
#pragma unroll
        for (int j = 0; j < 8; ++j) s[j] = (j == jstar) ? (short)0x3F80 : (short)0;
        sel[hh] = s;
    }
}
DEVI void tr_store(char* XT, bf16x8 frag, const bf16x8 (&sel)[2], int mi, int ks, int fr, int fq, const float (&sc)[4]) {
#pragma unroll
    for (int hh = 0; hh < 2; ++hh) {
        const f32x4 d = mfma16(frag, sel[hh], (f32x4){0.f, 0.f, 0.f, 0.f});
        *(uint2*)(XT + (32 * ks + 16 * hh + fr) * 144 + (16 * mi + 4 * fq) * 2) = make_uint2(pk2(d[0] * sc[0], d[1] * sc[1]), pk2(d[2] * sc[2], d[3] * sc[3]));
    }
}
DEVI bf16x8 state_pack(const f32x4& a, const f32x4& b) {
    return mk8(make_uint2(pk2(a[0], a[1]), pk2(a[2], a[3])), make_uint2(pk2(b[0], b[1]), pk2(b[2], b[3])));
}
DEVI const float* opaque_ptr(const float* q) { asm volatile("" : "+v"(q)); return q; }
DEVI float opaque_f(float v) { asm volatile("" : "+v"(v)); return v; }
DEVI void lds_barrier() { asm volatile("s_waitcnt lgkmcnt(0)" ::: "memory"); __builtin_amdgcn_s_barrier(); asm volatile("" ::: "memory"); }
DEVI void pin_u4(uint4& a) { asm volatile("" : "+v"(a.x), "+v"(a.y), "+v"(a.z), "+v"(a.w)); }
DEVI float grp8_sum(float v) { v += dpp_f<DPP_XOR1>(v); v += dpp_f<DPP_XOR2>(v); v += dpp_f<DPP_HMIRROR>(v); return v; }

#define ASM_LD16(dst, voff, sbase, imm) asm volatile("global_load_dwordx4 %0, %1, %2 offset:" #imm : "=v"(dst) : "v"(voff), "s"(sbase) : "memory")
#define ASM_LD4(dst, voff, sbase) asm volatile("global_load_dword %0, %1, %2" : "=v"(dst) : "v"(voff), "s"(sbase) : "memory")
typedef unsigned u32x4_t __attribute__((ext_vector_type(4)));
struct RetPre { u32x4_t f[4]; u32x4_t v[2]; u32x4_t g[2]; };
struct RetOff { unsigned f, v0, v1, g; };
DEVI void ret_offsets(RetOff& o, int h, int tid) {
    const int lane = tid & 63, w = tid >> 6, fr = lane & 15, fq = lane >> 4, mi = w & 3;
    o.f = (unsigned)((w < 4 ? OPB * 2 : 0) + (4 * h + mi) * 4096 + fq * 256 + fr * 16);
    o.v0 = (unsigned)(2 * OPB * 2 + (4 * h + ((2 * w) >> 2)) * 4096 + (4 * ((2 * w) & 3) + fq) * 256 + fr * 16);
    o.v1 = (unsigned)(2 * OPB * 2 + (4 * h + ((2 * w + 1) >> 2)) * 4096 + (4 * ((2 * w + 1) & 3) + fq) * 256 + fr * 16);
    o.g = (unsigned)(((tid >> 3) * NPR + h * 128 + 16 * (tid & 7)) * 2);
}
DEVI const char* ret_base(const Params& p, int b, int c) { return (const char*)p.proj + (size_t)(b * 32 + c) * 65536; }
DEVI const char* ret_gbase(const Params& p, int b, int c) { return (const char*)(p.proj + 4 * OPB) + (size_t)(b * 2048 + c * 64) * (NPR * 2); }
template <int N> DEVI void ret_retire_fv(RetPre& P) {
    asm volatile("s_waitcnt vmcnt(%6)" : "+v"(P.f[0]), "+v"(P.f[1]), "+v"(P.f[2]), "+v"(P.f[3]), "+v"(P.v[0]), "+v"(P.v[1]) : "n"(N) : "memory");
}
DEVI uint4 asu4(const u32x4_t& v) { return make_uint4(v[0], v[1], v[2], v[3]); }
DEVI void ret_block(const Params& p, char* smem, int b, int h) {
    char* qs = smem;
    char* ks_ = smem + 17408;
    char* kTs = smem + 34816;
    char* vTs = smem + 53248;
    char* Ss = smem + 71680;
    char* Os = smem + 80896;
    float* gn_s = (float*)(smem + 98304);
    const int tid = stid(), lane = tid & 63, w = tid >> 6, fr = lane & 15, fq = lane >> 4;
    const float gamma = 1.f - exp2f(-5.f - (float)h);
    const float l2g = log2f(gamma);
    const float g64 = exp2f(l2g * 64.f);
    bf16x8 sel[2];
    sel_frags(sel, fr, fq);
    f32x4 st[8];
#pragma unroll
    for (int i = 0; i < 8; ++i) st[i] = (f32x4){0.f, 0.f, 0.f, 0.f};
    if (tid < 128) gn_s[tid] = p.ret_norm_g[h * 128 + tid];
    __syncthreads();
    RetPre P;
    RetOff RO;
    ret_offsets(RO, h, tid);
    {
        const char* base = ret_base(p, b, 0);
        ASM_LD16(P.f[0], RO.f, base, 0); ASM_LD16(P.f[1], RO.f, base, 1024); ASM_LD16(P.f[2], RO.f, base, 2048); ASM_LD16(P.f[3], RO.f, base, 3072);
        ASM_LD16(P.v[0], RO.v0, base, 0); ASM_LD16(P.v[1], RO.v1, base, 0);
    }
    ret_retire_fv<0>(P);
#pragma unroll 1
    for (int c = 0; c < 32; ++c) {
        const int t0 = b * 2048 + c * 64;
        {
            const int mi = w & 3;
            char* dst = (w < 4 ? ks_ : qs) + (16 * mi + fr) * 272 + fq * 16;
#pragma unroll
            for (int ks = 0; ks < 4; ++ks) *(uint4*)(dst + ks * 64) = asu4(P.f[ks]);
            if (w < 4) {
                float kd[4];
#pragma unroll
                for (int r = 0; r < 4; ++r) kd[r] = exp2f(l2g * (float)(63 - (16 * mi + 4 * fq + r)));
#pragma unroll
                for (int ks = 0; ks < 4; ++ks) tr_store(kTs, u4_to_frag(asu4(P.f[ks])), sel, mi, ks, fr, fq, kd);
            }
            const float one[4] = {1.f, 1.f, 1.f, 1.f};
#pragma unroll
            for (int q = 0; q < 2; ++q) { const int pr = 2 * w + q; tr_store(vTs, u4_to_frag(asu4(P.v[q])), sel, pr >> 2, pr & 3, fr, fq, one); }
        }
        lds_barrier();
        const char* cbase = ret_gbase(p, b, c);
        const char* nbase = ret_base(p, b, c + 1 < 32 ? c + 1 : 31);
        ASM_LD16(P.g[0], RO.g, cbase, 0); ASM_LD16(P.g[1], RO.g, cbase, 16);
        {
            const int lt = w & 3;
            bf16x8 qf[4];
#pragma unroll
            for (int s = 0; s < 4; ++s) qf[s] = ld8(qs + (16 * lt + fr) * 272 + (s * 4 + fq) * 16);
#pragma unroll
            for (int jj = 0; jj < 2; ++jj) {
                const int j = 2 * (w >> 2) + jj;
                if (jj == 0) { ASM_LD16(P.f[0], RO.f, nbase, 0); ASM_LD16(P.f[1], RO.f, nbase, 1024); }
                else { ASM_LD16(P.f[2], RO.f, nbase, 2048); ASM_LD16(P.f[3], RO.f, nbase, 3072); }
                f32x4 a = (f32x4){0.f, 0.f, 0.f, 0.f};
#pragma unroll
                for (int s = 0; s < 4; ++s) a = mfma16(ld8(ks_ + (16 * j + fr) * 272 + (s * 4 + fq) * 16), qf[s], a);
                const int l = 16 * lt + fr, mb = 16 * j + 4 * fq;
                float v[4];
#pragma unroll
                for (int r = 0; r < 4; ++r) { const int dd = l - (mb + r); v[r] = a[r] * exp2f(l2g * (float)(dd < 0 ? -dd : dd)); }
                *(uint2*)(Ss + l * 144 + mb * 2) = make_uint2(pk2(v[0], v[1]), pk2(v[2], v[3]));
            }
        }
        lds_barrier();
        {
            bf16x8 sp[4];
#pragma unroll
            for (int s = 0; s < 4; ++s) sp[s] = state_pack(st[2 * s], st[2 * s + 1]);
            bf16x8 vf[2];
#pragma unroll
            for (int s2 = 0; s2 < 2; ++s2) vf[s2] = ld8(vTs + (16 * w + fr) * 144 + (s2 * 4 + fq) * 16);
#pragma unroll
            for (int i = 0; i < 4; ++i) {
                if (i == 0) ASM_LD16(P.v[0], RO.v0, nbase, 0);
                if (i == 1) ASM_LD16(P.v[1], RO.v1, nbase, 0);
                f32x4 a = (f32x4){0.f, 0.f, 0.f, 0.f};
                const char* qrow = qs + (16 * i + fr) * 272;
#pragma unroll
                for (int s = 0; s < 4; ++s) {
                    const uint2 lo = *(const uint2*)(qrow + (32 * s + 4 * fq) * 2), hi = *(const uint2*)(qrow + (32 * s + 16 + 4 * fq) * 2);
                    a = mfma16(sp[s], mk8(lo, hi), a);
                }
                a = a * exp2f(l2g * (float)(16 * i + fr + 1));
#pragma unroll
                for (int s2 = 0; s2 < 2; ++s2) a = mfma16(vf[s2], ld8(Ss + (16 * i + fr) * 144 + (s2 * 4 + fq) * 16), a);
                *(uint2*)(Os + (16 * i + fr) * 272 + (16 * w + 4 * fq) * 2) = make_uint2(pk2(a[0], a[1]), pk2(a[2], a[3]));
            }
#pragma unroll
            for (int i = 0; i < 8; ++i) {
                f32x4 a = st[i] * g64;
#pragma unroll
                for (int s2 = 0; s2 < 2; ++s2) a = mfma16(ld8(kTs + (16 * i + fr) * 144 + (s2 * 4 + fq) * 16), vf[s2], a);
                st[i] = a;
            }
        }
        lds_barrier();
        {
            const int l = tid >> 3, part = tid & 7;
            const uint4 o0 = *(const uint4*)(Os + l * 272 + part * 32), o1 = *(const uint4*)(Os + l * 272 + part * 32 + 16);
            const unsigned ow[8] = {o0.x, o0.y, o0.z, o0.w, o1.x, o1.y, o1.z, o1.w};
            float x[16], s = 0.f;
#pragma unroll
            for (int e = 0; e < 8; ++e) { x[2 * e] = bflo(ow[e]); x[2 * e + 1] = bfhi(ow[e]); s += x[2 * e] + x[2 * e + 1]; }
            const float mu = grp8_sum(s) * (1.f / 128.f);
            float q = 0.f;
#pragma unroll
            for (int e = 0; e < 16; ++e) { x[e] -= mu; q += x[e] * x[e]; }
            float rstd = rsqrtf(grp8_sum(q) * (1.f / 128.f) + EPSN);
            asm volatile("s_waitcnt vmcnt(6)" : "+v"(P.g[0]), "+v"(P.g[1]), "+v"(rstd) :: "memory");
            const unsigned gw[8] = {P.g[0][0], P.g[0][1], P.g[0][2], P.g[0][3], P.g[1][0], P.g[1][1], P.g[1][2], P.g[1][3]};
            const float* gn = gn_s + 16 * part;
            unsigned yo[8];
#pragma unroll
            for (int e = 0; e < 8; ++e) {
                const float ga = bflo(gw[e]), gb = bfhi(gw[e]);
                yo[e] = pk2(ga * sigmoidf_(ga) * x[2 * e] * rstd * gn[2 * e], gb * sigmoidf_(gb) * x[2 * e + 1] * rstd * gn[2 * e + 1]);
            }
            asm volatile("" : "+v"(yo[0]), "+v"(yo[1]), "+v"(yo[2]), "+v"(yo[3]), "+v"(yo[4]), "+v"(yo[5]), "+v"(yo[6]), "+v"(yo[7]));
            ret_retire_fv<0>(P);
            uint4* yp = (uint4*)(p.yb + (size_t)(t0 + l) * 1024 + h * 128 + 16 * part);
            yp[0] = make_uint4(yo[0], yo[1], yo[2], yo[3]);
            yp[1] = make_uint4(yo[4], yo[5], yo[6], yo[7]);
        }
    }
}

struct MlPre { u32x4_t f[4]; u32x4_t v[2]; u32x4_t o[2]; u32x4_t cc[2]; };
struct MlOff { unsigned f, v0, v1, o, c, g; };
DEVI void ml_offsets(const Params& p, MlOff& o, int h, int tid) {
    const int lane = tid & 63, w = tid >> 6, fr = lane & 15, fq = lane >> 4, mi = w & 3;
    const unsigned kdiff = (unsigned)((const char*)p.mk - (const char*)p.mq);
    o.f = (unsigned)((4 * h + mi) * 4096 + fq * 256 + fr * 16) + (w < 4 ? kdiff : 0u);
    o.v0 = (unsigned)((4 * h + ((2 * w) >> 2)) * 4096 + (4 * ((2 * w) & 3) + fq) * 256 + fr * 16);
    o.v1 = (unsigned)((4 * h + ((2 * w + 1) >> 2)) * 4096 + (4 * ((2 * w + 1) & 3) + fq) * 256 + fr * 16);
    o.o = (unsigned)(((tid >> 3) * NPR + 1024 + h * 128 + 16 * (tid & 7)) * 2);
    o.c = (unsigned)(((tid >> 3) * 512 + h * 128 + 16 * (tid & 7)) * 2);
    o.g = (unsigned)((lane * 4 + h) * 4);
}
template <int N> DEVI void ml_retire_fv(MlPre& P) {
    asm volatile("s_waitcnt vmcnt(%6)" : "+v"(P.f[0]), "+v"(P.f[1]), "+v"(P.f[2]), "+v"(P.f[3]), "+v"(P.v[0]), "+v"(P.v[1]) : "n"(N) : "memory");
}
DEVI void mlstm_block(const Params& p, char* smem, int b, int h) {
    char* qs = smem;
    char* kTs = smem + 17408;
    char* vTs = smem + 35840;
    char* Os = smem + 54272;
    float* n_s = (float*)(smem + 71680);
    float* den_s = (float*)(smem + 72192);
    float* gn_s = (float*)(smem + 72448);
    float* sk_s = gn_s + 128;
    float* lw_s = sk_s + 128;
    float* ac_s = lw_s + 32 * 64;
    float* mi_s = ac_s + 32;
    const int tid = stid(), lane = tid & 63, w = tid >> 6, fr = lane & 15, fq = lane >> 4;
    bf16x8 sel[2];
    sel_frags(sel, fr, fq);
    f32x4 st[8];
#pragma unroll
    for (int i = 0; i < 8; ++i) st[i] = (f32x4){0.f, 0.f, 0.f, 0.f};
    float m_run = 0.f;
    f32x4 nacc = (f32x4){0.f, 0.f, 0.f, 0.f};
    bf16x8 ones;
#pragma unroll
    for (int j = 0; j < 8; ++j) ones[j] = (short)0x3F80;
    if (tid < 128) { gn_s[tid] = p.m_norm_g[h * 128 + tid]; sk_s[tid] = p.m_skip[h * 128 + tid]; }
#pragma unroll
    for (int q = 0; q < 4; ++q) {
        const int cc = 4 * w + q, tt = b * 2048 + cc * 64 + lane;
        const float iv = p.ipre[tt * 4 + h], fv = p.logf[tt * 4 + h];
        float fcum = fv;
#pragma unroll
        for (int o = 1; o < 64; o <<= 1) { const float tv = __shfl_up(fcum, o); if (lane >= o) fcum += tv; }
        const float a_c = __shfl(fcum, 63);
        const float logw = a_c - fcum + iv;
        const float m_in = wave_max(logw);
        lw_s[cc * 64 + lane] = logw;
        if (lane == 0) { ac_s[cc] = a_c; mi_s[cc] = m_in; }
    }
    __syncthreads();
    MlPre P;
    MlOff MO;
    ml_offsets(p, MO, h, tid);
    {
        const size_t t00 = (size_t)(b * 2048);
        const char* bq = (const char*)p.mq + t00 * 1024, *bp = (const char*)(p.proj + 3 * OPB) + t00 * 1024;
        ASM_LD16(P.f[0], MO.f, bq, 0); ASM_LD16(P.f[1], MO.f, bq, 1024); ASM_LD16(P.f[2], MO.f, bq, 2048); ASM_LD16(P.f[3], MO.f, bq, 3072);
        ASM_LD16(P.v[0], MO.v0, bp, 0); ASM_LD16(P.v[1], MO.v1, bp, 0);
    }
    ml_retire_fv<0>(P);
#pragma unroll 1
    for (int c = 0; c < 32; ++c) {
        const int t0 = b * 2048 + c * 64;
        const float a_c = ac_s[c], m_in = mi_s[c], logw = lw_s[c * 64 + lane];
        const float m_new = fmaxf(a_c + m_run, m_in);
        const float decay = fexp_(a_c + m_run - m_new);
        const float wgt = fexp_(logw - m_new);
        const float emn = fexp_(-m_new);
        m_run = m_new;
        {
            const int mi = w & 3;
            if (w < 4) {
                float kw[4];
#pragma unroll
                for (int r = 0; r < 4; ++r) kw[r] = __shfl(wgt, 16 * mi + 4 * fq + r);
#pragma unroll
                for (int ks = 0; ks < 4; ++ks) tr_store(kTs, u4_to_frag(asu4(P.f[ks])), sel, mi, ks, fr, fq, kw);
            } else {
                char* dst = qs + (16 * mi + fr) * 272 + fq * 16;
#pragma unroll
                for (int ks = 0; ks < 4; ++ks) *(uint4*)(dst + ks * 64) = asu4(P.f[ks]);
            }
            const float one[4] = {1.f, 1.f, 1.f, 1.f};
#pragma unroll
            for (int q = 0; q < 2; ++q) { const int pr = 2 * w + q; tr_store(vTs, u4_to_frag(asu4(P.v[q])), sel, pr >> 2, pr & 3, fr, fq, one); }
        }
        lds_barrier();
        const size_t tc = (size_t)t0, tn = (size_t)(b * 2048 + (c + 1 < 32 ? c + 1 : 31) * 64);
        const char* cbp = (const char*)(p.proj + 4 * OPB) + tc * (NPR * 2), *cbc = (const char*)p.cbuf + tc * 1024;
        const char* nbq = (const char*)p.mq + tn * 1024, *nbp = (const char*)(p.proj + 3 * OPB) + tn * 1024;
        ASM_LD16(P.o[0], MO.o, cbp, 0); ASM_LD16(P.o[1], MO.o, cbp, 16);
        {
            f32x4 a = nacc * decay;
#pragma unroll
            for (int s2 = 0; s2 < 2; ++s2) a = mfma16(ld8(kTs + (16 * w + fr) * 144 + (s2 * 4 + fq) * 16), ones, a);
            nacc = a;
            if (fr == 0) *(f32x4*)(n_s + 16 * w + 4 * fq) = a;
        }
        {
            bf16x8 vf[2];
#pragma unroll
            for (int s2 = 0; s2 < 2; ++s2) vf[s2] = ld8(vTs + (16 * w + fr) * 144 + (s2 * 4 + fq) * 16);
#pragma unroll
            for (int i = 0; i < 8; ++i) {
                if (i == 0) ASM_LD16(P.cc[0], MO.c, cbc, 0);
                if (i == 1) ASM_LD16(P.cc[1], MO.c, cbc, 16);
                if (i == 2) ASM_LD16(P.f[0], MO.f, nbq, 0);
                if (i == 3) ASM_LD16(P.f[1], MO.f, nbq, 1024);
                if (i == 4) ASM_LD16(P.f[2], MO.f, nbq, 2048);
                if (i == 5) ASM_LD16(P.f[3], MO.f, nbq, 3072);
                if (i == 6) ASM_LD16(P.v[0], MO.v0, nbp, 0);
                if (i == 7) ASM_LD16(P.v[1], MO.v1, nbp, 0);
                f32x4 a = st[i] * decay;
#pragma unroll
                for (int s2 = 0; s2 < 2; ++s2) a = mfma16(ld8(kTs + (16 * i + fr) * 144 + (s2 * 4 + fq) * 16), vf[s2], a);
                st[i] = a;
            }
        }
        lds_barrier();
        {
            const int l = tid >> 3, part = tid & 7;
            const uint4 a0 = *(const uint4*)(qs + l * 272 + part * 32), a1 = *(const uint4*)(qs + l * 272 + part * 32 + 16);
            const unsigned aw[8] = {a0.x, a0.y, a0.z, a0.w, a1.x, a1.y, a1.z, a1.w};
            const float* nn = n_s + 16 * part;
            float s = 0.f;
#pragma unroll
            for (int e = 0; e < 8; ++e) s += bflo(aw[e]) * nn[2 * e] + bfhi(aw[e]) * nn[2 * e + 1];
            s = grp8_sum(s);
            if (part == 0) den_s[l] = fmaxf(fabsf(s), emn);
        }
        lds_barrier();
        {
            bf16x8 sp[4];
#pragma unroll
            for (int s = 0; s < 4; ++s) sp[s] = state_pack(st[2 * s], st[2 * s + 1]);
#pragma unroll
            for (int i = 0; i < 4; ++i) {
                f32x4 a = (f32x4){0.f, 0.f, 0.f, 0.f};
                const char* qrow = qs + (16 * i + fr) * 272;
#pragma unroll
                for (int s = 0; s < 4; ++s) {
                    const uint2 lo = *(const uint2*)(qrow + (32 * s + 4 * fq) * 2), hi = *(const uint2*)(qrow + (32 * s + 16 + 4 * fq) * 2);
                    a = mfma16(sp[s], mk8(lo, hi), a);
                }
                const float rd = rcp_(den_s[16 * i + fr]);
                *(uint2*)(Os + (16 * i + fr) * 272 + (16 * w + 4 * fq) * 2) = make_uint2(pk2(a[0] * rd, a[1] * rd), pk2(a[2] * rd, a[3] * rd));
            }
        }
        lds_barrier();
        {
            const int l = tid >> 3, part = tid & 7;
            const uint4 o0 = *(const uint4*)(Os + l * 272 + part * 32), o1 = *(const uint4*)(Os + l * 272 + part * 32 + 16);
            const unsigned ow[8] = {o0.x, o0.y, o0.z, o0.w, o1.x, o1.y, o1.z, o1.w};
            float x[16], s = 0.f;
#pragma unroll
            for (int e = 0; e < 8; ++e) { x[2 * e] = bflo(ow[e]); x[2 * e + 1] = bfhi(ow[e]); s += x[2 * e] + x[2 * e + 1]; }
            const float mu = grp8_sum(s) * (1.f / 128.f);
            float q = 0.f;
#pragma unroll
            for (int e = 0; e < 16; ++e) { x[e] -= mu; q += x[e] * x[e]; }
            float rstd = rsqrtf(grp8_sum(q) * (1.f / 128.f) + EPSN);
            asm volatile("s_waitcnt vmcnt(6)" : "+v"(P.o[0]), "+v"(P.o[1]), "+v"(P.cc[0]), "+v"(P.cc[1]), "+v"(rstd) :: "memory");
            const unsigned gw[8] = {P.o[0][0], P.o[0][1], P.o[0][2], P.o[0][3], P.o[1][0], P.o[1][1], P.o[1][2], P.o[1][3]};
            const unsigned cw[8] = {P.cc[0][0], P.cc[0][1], P.cc[0][2], P.cc[0][3], P.cc[1][0], P.cc[1][1], P.cc[1][2], P.cc[1][3]};
            const float* gn = gn_s + 16 * part;
            const float* sk = sk_s + 16 * part;
            unsigned yo[8];
#pragma unroll
            for (int e = 0; e < 8; ++e) {
                const float ya = sigmoidf_(bflo(gw[e])) * (x[2 * e] * rstd * gn[2 * e] + sk[2 * e] * bflo(cw[e]));
                const float yb_ = sigmoidf_(bfhi(gw[e])) * (x[2 * e + 1] * rstd * gn[2 * e + 1] + sk[2 * e + 1] * bfhi(cw[e]));
                yo[e] = pk2(ya, yb_);
            }
            asm volatile("" : "+v"(yo[0]), "+v"(yo[1]), "+v"(yo[2]), "+v"(yo[3]), "+v"(yo[4]), "+v"(yo[5]), "+v"(yo[6]), "+v"(yo[7]));
            ml_retire_fv<0>(P);
            uint4* yp = (uint4*)(p.yb + (size_t)(t0 + l) * 1024 + 512 + h * 128 + 16 * part);
            yp[0] = make_uint4(yo[0], yo[1], yo[2], yo[3]);
            yp[1] = make_uint4(yo[4], yo[5], yo[6], yo[7]);
        }
    }
}
DEVI void st_recur(const Params& p, char* smem) {
    if (blockIdx.x >= 128 || gridDim.x <= 128) {
        const int bid = gridDim.x > 128 ? (int)blockIdx.x - 128 : (int)blockIdx.x, nb = gridDim.x > 128 ? (int)gridDim.x - 128 : (int)gridDim.x;
        st_prep_w2(p, smem, bid, nb);
        st_prep_wsub(p, smem, bid, nb);
        st_prep_tables(p, bid, nb);
        if (gridDim.x > 128) return;
    }
    for (int bi = blockIdx.x; bi < 128; bi += gridDim.x) {
        const int kind = bi & 1, h = (bi >> 1) & 3, b = bi >> 3;
        if (kind == 0) ret_block(p, smem, b, h);
        else mlstm_block(p, smem, b, h);
        __syncthreads();
    }
}

constexpr float KEY_BIAS = 64.f;
DEVI int f2key(float f) { const int b = __float_as_int(f); return b ^ ((b >> 31) & 0x7fffffff); }
DEVI float key2f(int k) { return __int_as_float(k ^ ((k >> 31) & 0x7fffffff)); }
template <int N> DEVI void bsort_desc(int (&v)[N]) {
#pragma unroll
    for (int k = 2; k <= N; k <<= 1)
#pragma unroll
        for (int j = k >> 1; j > 0; j >>= 1)
#pragma unroll
            for (int i = 0; i < N; ++i) {
                const int l = i ^ j;
                if (l > i) {
                    const int a = v[i], b = v[l];
                    const int mx = a > b ? a : b, mn = a > b ? b : a;
                    if ((i & k) == 0) { v[i] = mx; v[l] = mn; } else { v[i] = mn; v[l] = mx; }
                }
            }
}
template <int N> DEVI void bmerge_desc(int (&v)[N]) {
#pragma unroll
    for (int j = N >> 1; j > 0; j >>= 1)
#pragma unroll
        for (int i = 0; i < N; ++i) {
            const int l = i ^ j;
            if (l > i) { const int a = v[i], b = v[l]; v[i] = a > b ? a : b; v[l] = a > b ? b : a; }
        }
}
DEVI void xmerge16(int (&v)[16], int mask) {
    int o[16];
#pragma unroll
    for (int i = 0; i < 16; ++i) o[i] = __shfl_xor(v[15 - i], mask);
#pragma unroll
    for (int i = 0; i < 16; ++i) v[i] = v[i] > o[i] ? v[i] : o[i];
    bmerge_desc<16>(v);
}
__device__ const unsigned char cand_tab[52] = {
    0x00, 0x01, 0x02, 0x03, 0x04, 0x05, 0x06, 0x07, 0x08, 0x09, 0x0a, 0x0b, 0x0c, 0x0d, 0x0e, 0x0f,
    0x10, 0x11, 0x12, 0x13, 0x14, 0x15, 0x16, 0x17, 0x20, 0x21, 0x22, 0x23, 0x24, 0x30, 0x31, 0x32, 0x33,
    0x40, 0x41, 0x42, 0x50, 0x51, 0x60, 0x61, 0x70, 0x71, 0x80, 0x90, 0xa0, 0xb0, 0xc0, 0xd0, 0xe0, 0xf0, 0xff, 0xff};
constexpr int H_A = 256 * 64, H_B = 256 * 64, H_STAGE = H_A + H_B;
constexpr int H_LIST = 3 * H_STAGE;
DEVI void glds16(const void* g, char* l) {
    __builtin_amdgcn_global_load_lds((const __attribute__((address_space(1))) unsigned*)g, (__attribute__((address_space(3))) unsigned*)l, 16, 0, 0);
}
DEVI void gemm3_topk_tile(const Params& p, int m0, int h, char* smem) {
    const int tid = stid(), lane = tid & 63, w = tid >> 6, wt = w >> 1, wp = w & 1, fr = lane & 15, fq = lane >> 4;
    i32x4 acc[4][8];
#pragma unroll
    for (int i = 0; i < 4; ++i)
#pragma unroll
        for (int j = 0; j < 8; ++j) acc[i][j] = (i32x4){0, 0, 0, 0};
    const int r16 = lane >> 2, csrc = (lane & 3) ^ ((r16 >> 2) & 3);
    const unsigned char* srcA = p.xq + (size_t)(m0 + w * 32 + r16) * 1024 + csrc * 16;
    const unsigned char* srcB = (const unsigned char*)p.Wsubq + ((size_t)h * 256 + w * 32 + r16) * 1024 + csrc * 16;
    char* dstA = smem + (w * 32) * 64 + lane * 16;
    char* dstB = smem + H_A + (w * 32) * 64 + lane * 16;
    auto issue = [&](int kt, int buf) {
#pragma unroll
        for (int q = 0; q < 2; ++q) glds16(srcA + (size_t)q * 16 * 1024 + kt * 64, dstA + buf * H_STAGE + q * 1024);
#pragma unroll
        for (int q = 0; q < 2; ++q) glds16(srcB + (size_t)q * 16 * 1024 + kt * 64, dstB + buf * H_STAGE + q * 1024);
    };
    const int rdoff = fr * 64 + ((fq ^ ((fr >> 2) & 3)) * 16);
    issue(0, 0);
    issue(1, 1);
    asm volatile("s_waitcnt vmcnt(4)" ::: "memory");
    __builtin_amdgcn_s_barrier();
    int buf = 0;
#pragma unroll 1
    for (int kt = 0; kt < 16; ++kt) {
        const int b2 = buf >= 1 ? buf - 1 : 2;
        if (kt + 2 < 16) issue(kt + 2, b2);
        const char* As = smem + buf * H_STAGE + (wt * 64) * 64 + rdoff;
        const char* Bs = smem + buf * H_STAGE + H_A + (wp * 128) * 64 + rdoff;
        i32x4 a[4];
#pragma unroll
        for (int i = 0; i < 4; ++i) a[i] = *(const i32x4*)(As + (16 * i) * 64);
#pragma unroll
        for (int jg = 0; jg < 2; ++jg) {
            i32x4 b[4];
#pragma unroll
            for (int j = 0; j < 4; ++j) b[j] = *(const i32x4*)(Bs + (16 * (4 * jg + j)) * 64);
#pragma unroll
            for (int i = 0; i < 4; ++i)
#pragma unroll
                for (int j = 0; j < 4; ++j) acc[i][4 * jg + j] = __builtin_amdgcn_mfma_i32_16x16x64_i8(b[j], a[i], acc[i][4 * jg + j], 0, 0, 0);
        }
        if (kt + 2 < 16) asm volatile("s_waitcnt vmcnt(4)" ::: "memory");
        else asm volatile("s_waitcnt vmcnt(0)" ::: "memory");
        __builtin_amdgcn_s_barrier();
        buf = buf == 2 ? 0 : buf + 1;
    }
    float4 ws[8];
#pragma unroll
    for (int j = 0; j < 8; ++j) ws[j] = *(const float4*)(p.wsc + h * 256 + wp * 128 + 16 * j + 4 * fq);
    int* LX = (int*)(smem + H_LIST);
#pragma unroll
    for (int i = 0; i < 4; ++i) {
        const int tl = 64 * wt + 16 * i + fr;
        const float rs = rs2_of(p.rs2p, m0 + tl) * ZQ_SCALE;
        int ka[16], kb[16];
#pragma unroll
        for (int jj = 0; jj < 4; ++jj)
#pragma unroll
            for (int r = 0; r < 4; ++r) {
                const float sa = r == 0 ? ws[jj].x : r == 1 ? ws[jj].y : r == 2 ? ws[jj].z : ws[jj].w;
                const float sb = r == 0 ? ws[4 + jj].x : r == 1 ? ws[4 + jj].y : r == 2 ? ws[4 + jj].z : ws[4 + jj].w;
                ka[jj * 4 + r] = (__float_as_int((float)acc[i][jj][r] * (sa * rs) + KEY_BIAS) & ~127) | (16 * jj + 4 * fq + r);
                kb[jj * 4 + r] = (__float_as_int((float)acc[i][4 + jj][r] * (sb * rs) + KEY_BIAS) & ~127) | (16 * (jj + 4) + 4 * fq + r);
            }
        bsort_desc<16>(ka);
        bsort_desc<16>(kb);
#pragma unroll
        for (int q = 0; q < 16; ++q) ka[q] = ka[q] > kb[15 - q] ? ka[q] : kb[15 - q];
        bmerge_desc<16>(ka);
        xmerge16(ka, 16);
        xmerge16(ka, 32);
        const int k0 = fq == 0 ? ka[0] : fq == 1 ? ka[4] : fq == 2 ? ka[8] : ka[12];
        const int k1 = fq == 0 ? ka[1] : fq == 1 ? ka[5] : fq == 2 ? ka[9] : ka[13];
        const int k2 = fq == 0 ? ka[2] : fq == 1 ? ka[6] : fq == 2 ? ka[10] : ka[14];
        const int k3 = fq == 0 ? ka[3] : fq == 1 ? ka[7] : fq == 2 ? ka[11] : ka[15];
        *(int4*)(LX + tl * 32 + wp * 16 + 4 * fq) = make_int4(k0, k1, k2, k3);
    }
    __syncthreads();
#pragma unroll
    for (int i2 = 0; i2 < 2; ++i2) {
        const int tl = 32 * w + 16 * i2 + fr, t = m0 + tl;
        const int* L = LX + tl * 32;
        const unsigned long long clo = fq == 0 ? 0x0706050403020100ull : fq == 1 ? 0x14131211100f0e0dull : fq == 2 ? 0x4033323130242322ull : 0xc0b0a09080717061ull;
        const unsigned long long chi = fq == 0 ? 0x0c0b0a0908ull : fq == 1 ? 0x2120171615ull : fq == 2 ? 0x6051504241ull : 0xfffff0e0d0ull;
        int c[16];
#pragma unroll
        for (int s = 0; s < 13; ++s) {
            const int ab = (int)((s < 8 ? (clo >> (8 * s)) : (chi >> (8 * (s - 8)))) & 0xffull);
            const int k1 = L[ab >> 4], k2 = L[16 + (ab & 15)];
            const float v = (__int_as_float(k1 & ~127) - KEY_BIAS) + (__int_as_float(k2 & ~127) - KEY_BIAS);
            c[s] = (f2key(v) & ~0x3fff) | ((k1 & 127) << 7) | (k2 & 127);
        }
        c[13] = c[14] = c[15] = (int)0x80000000;
        bsort_desc<16>(c);
        xmerge16(c, 16);
        xmerge16(c, 32);
        const float vmax = key2f(c[0] & ~0x3fff);
        float e[16], sum = 0.f;
#pragma unroll
        for (int q = 0; q < 16; ++q) { e[q] = fexp_(key2f(c[q] & ~0x3fff) - vmax); sum += e[q]; }
        const float inv = rcp_(sum);
        int ce[4]; float ge[4];
#pragma unroll
        for (int q = 0; q < 4; ++q) {
            const int cq = fq == 0 ? c[q] : fq == 1 ? c[4 + q] : fq == 2 ? c[8 + q] : c[12 + q];
            const float eq = fq == 0 ? e[q] : fq == 1 ? e[4 + q] : fq == 2 ? e[8 + q] : e[12 + q];
            ce[q] = ((cq >> 7) & 127) * 128 + (cq & 127);
            ge[q] = eq * inv;
        }
        *(uint2*)(p.eperm + (size_t)t * 128 + h * 16 + 4 * fq) = make_uint2((unsigned)ce[0] | ((unsigned)ce[1] << 16), (unsigned)ce[2] | ((unsigned)ce[3] << 16));
        *(float4*)(p.gate + (size_t)t * 128 + h * 16 + 4 * fq) = make_float4(ge[0], ge[1], ge[2], ge[3]);
    }
    __syncthreads();
}
DEVI void st_gemm3_topk(const Params& p, char* smem) {
    for (int it = blockIdx.x; it < 128 * 8; it += gridDim.x) gemm3_topk_tile(p, (it >> 3) * 256, it & 7, smem);
}

#define XB_TMO      128
#define XB_XCNT(j)  (256  + 64 * (j))
#define XB_XSUB(j)  (1280 + 64 * (j))
#define XB_XGEN(j)  (2304 + 64 * (j))
#define XB_TOP      3328
#define XB_TOPGEN   3392
#define XCD_BAR_WORDS 3456
#define XB_SPIN_CAP (1u << 20)
#define LAS __attribute__((address_space(3)))
DEVI unsigned xb_ld(unsigned* p) { return __hip_atomic_load(p, __ATOMIC_RELAXED, __HIP_MEMORY_SCOPE_AGENT); }
DEVI unsigned xb_add(unsigned* p, unsigned v) { return __hip_atomic_fetch_add(p, v, __ATOMIC_RELAXED, __HIP_MEMORY_SCOPE_AGENT); }
DEVI unsigned xb_xcc_id() { return (unsigned)__builtin_amdgcn_s_getreg((3 << 11) | 20) & 0xFu; }
#define XB_SPIN(cond, bar) do { unsigned _sp = 0; while (cond) { __builtin_amdgcn_s_sleep(1); \
    if ((++_sp & 255u) == 0u) { if (xb_ld(&(bar)[XB_TMO])) break; if (_sp > XB_SPIN_CAP) { atomicAdd(&(bar)[XB_TMO], 1u); break; } } } } while (0)
struct XcdBarrier { unsigned* bar; unsigned x; volatile LAS unsigned* st; };
DEVI XcdBarrier xcd_barrier_post(unsigned* bar, volatile LAS unsigned* st) {
    XcdBarrier b; b.bar = bar; b.x = xb_xcc_id(); b.st = st;
    if (stid() == 0) (void)xb_add(&bar[XB_XCNT(b.x)], 1u);
    return b;
}
DEVI void xcd_barrier_complete(unsigned* bar, unsigned x, unsigned& nloc, unsigned& nx) {
    const unsigned G = gridDim.x * gridDim.y * gridDim.z;
    unsigned sum, cnt, mine, sp = 0u;
    for (;;) {
        sum = 0u; cnt = 0u; mine = 0u;
#pragma unroll
        for (unsigned j = 0; j < 16; ++j) { const unsigned c = xb_ld(&bar[XB_XCNT(j)]); sum += c; cnt += (c > 0u) ? 1u : 0u; mine = (j == x) ? c : mine; }
        if (sum == G) break;
        __builtin_amdgcn_s_sleep(1);
        if ((++sp & 255u) == 0u) { if (xb_ld(&bar[XB_TMO])) break; if (sp > XB_SPIN_CAP) { atomicAdd(&bar[XB_TMO], 1u); break; } }
    }
    nloc = mine > 0u ? mine : 1u; nx = cnt > 0u ? cnt : 1u;
}
DEVI void xcd_barrier(const XcdBarrier& b) {
    asm volatile("s_waitcnt vmcnt(0)" ::: "memory");
    __syncthreads();
    if (stid() == 0) {
        unsigned* bar = b.bar;
        __builtin_amdgcn_s_waitcnt(0);
        unsigned nloc = b.st[0], nx = b.st[1];
        if (nloc == 0u) { xcd_barrier_complete(bar, b.x, nloc, nx); b.st[0] = nloc; b.st[1] = nx; }
        const unsigned old = xb_add(&bar[XB_XSUB(b.x)], 1u);
        const unsigned gen = old / nloc;
        if (old + 1u == (gen + 1u) * nloc) {
            __builtin_amdgcn_fence(__ATOMIC_RELEASE, "agent");
            asm volatile("s_waitcnt vmcnt(0)" ::: "memory");
            const unsigned og = xb_add(&bar[XB_TOP], 1u);
            const unsigned tg = og / nx;
            if (og + 1u == (tg + 1u) * nx) xb_add(&bar[XB_TOPGEN], 1u);
            else XB_SPIN(xb_ld(&bar[XB_TOPGEN]) == tg, bar);
            __builtin_amdgcn_fence(__ATOMIC_ACQUIRE, "agent");
            xb_add(&bar[XB_XGEN(b.x)], 1u);
            asm volatile("s_waitcnt vmcnt(0)" ::: "memory");
        } else {
            XB_SPIN(xb_ld(&bar[XB_XGEN(b.x)]) == gen, bar);
            __builtin_amdgcn_fence(__ATOMIC_ACQUIRE, "agent");
            asm volatile("s_waitcnt vmcnt(0)" ::: "memory");
        }
    }
    __syncthreads();
}

#define CTR_A(x) (XCD_BAR_WORDS + 64 * (x))
#define CTR_B(x) (XCD_BAR_WORDS + 512 + 64 * (x))
#define CTL_WORDS (XCD_BAR_WORDS + 1024)
typedef float f32x2 __attribute__((ext_vector_type(2)));
DEVI float ub(unsigned w, int n) { return (float)((w >> (8 * n)) & 0xffu); }
DEVI float gelu_erf(float v) {
    const float av = fabsf(v), t = rcp_(av * 0.2316418882f + 1.0f);
    float q = t * 0.5307027145f + (-0.7265760135f);
    q = q * t + 0.7107068705f; q = q * t + (-0.142248368f); q = q * t + 0.127414796f; q = q * t;
    const float e = __builtin_amdgcn_exp2f((v * v) * (-0.72134752044f));
    const float m = v * (q * e);
    return v < 0.f ? m : v - m;
}
struct ExpMeta { uint4 e[2]; uint4 xa; float sc; };
struct ExpRows { uint4 r[16]; unsigned x1; };

template <int PHASE> DEVI void exp_load_meta(const Params& p, ExpMeta& m, int t, int x, int lane) {
    const uint4* ep = (const uint4*)(p.eperm + (size_t)t * 128 + (lane >> 3) * 16);
    m.e[0] = ep[0];
    m.e[1] = ep[1];
    if (PHASE == 0) m.xa = *(const uint4*)(p.xq + (size_t)t * 1024 + 128 * x + 16 * (lane & 7));
    else { m.xa = *(const uint4*)(p.aq + (size_t)t * 128 + (lane >> 3) * 16); m.sc = p.asc[t]; }
}
template <int PHASE> DEVI void exp_issue(const Params& p, const ExpMeta& m, ExpRows& R, int t, int x, int lane) {
    const unsigned char* base = (PHASE == 0 ? p.down_q : p.up_q) + (size_t)x * (16384 * 128) + (lane & 7) * 16;
    const unsigned ew[8] = {m.e[0].x, m.e[0].y, m.e[0].z, m.e[0].w, m.e[1].x, m.e[1].y, m.e[1].z, m.e[1].w};
#pragma unroll
    for (int j = 0; j < 16; ++j) {
        const unsigned ek = (j & 1) ? (ew[j >> 1] >> 16) : (ew[j >> 1] & 0xffffu);
        R.r[j] = *(const uint4*)(base + (size_t)ek * 128);
    }
    if (PHASE == 1) {
        const int col = 128 * x + 16 * (lane & 7) + ((lane & 32) ? 8 : 0) + ((lane & 16) ? 4 : 0) + ((lane & 8) ? 2 : 0);
        R.x1 = *(const unsigned*)(p.x1b + (size_t)t * 1024 + col);
    }
}
DEVI void expA_compute(const Params& p, const ExpMeta& m, const ExpRows& R, int t, int x, int lane) {
    const bool b2 = lane & 4, b1 = lane & 2, b0 = lane & 1;
    int ps[16];
#pragma unroll
    for (int j = 0; j < 16; ++j)
        ps[j] = __builtin_amdgcn_sdot4((int)R.r[j].x, (int)m.xa.x, __builtin_amdgcn_sdot4((int)R.r[j].y, (int)m.xa.y,
                __builtin_amdgcn_sdot4((int)R.r[j].z, (int)m.xa.z, __builtin_amdgcn_sdot4((int)R.r[j].w, (int)m.xa.w, 0, false), false), false), false);
    int q8[8], q4[4], q2[2];
#pragma unroll
    for (int j = 0; j < 8; ++j) { const int snd = b2 ? ps[j] : ps[j + 8], kp = b2 ? ps[j + 8] : ps[j]; q8[j] = kp + dpp_i<DPP_HMIRROR>(snd); }
#pragma unroll
    for (int j = 0; j < 4; ++j) { const int snd = b1 ? q8[j] : q8[j + 4], kp = b1 ? q8[j + 4] : q8[j]; q4[j] = kp + dpp_i<DPP_XOR2>(snd); }
#pragma unroll
    for (int j = 0; j < 2; ++j) { const int snd = b0 ? q4[j] : q4[j + 2], kp = b0 ? q4[j + 2] : q4[j]; q2[j] = kp + dpp_i<DPP_XOR1>(snd); }
    {
        int s0 = q2[0] >> 3, s1 = q2[1] >> 3;
        s0 = s0 > 32767 ? 32767 : (s0 < -32768 ? -32768 : s0);
        s1 = s1 > 32767 ? 32767 : (s1 < -32768 ? -32768 : s1);
        *(unsigned*)(p.part + ((size_t)x * T_TOK + t) * 128 + 2 * lane) = ((unsigned)s0 & 0xffffu) | ((unsigned)s1 << 16);
    }
}
DEVI void expB_compute(const Params& p, const ExpMeta& m, const ExpRows& R, int t, int x, int lane) {
    const bool b5 = lane & 32, b4 = lane & 16, b3 = lane & 8;
    const unsigned pa[4] = {m.xa.x, m.xa.y, m.xa.z, m.xa.w};
    int acc[16];
#pragma unroll
    for (int c = 0; c < 16; ++c) acc[c] = 0;
#pragma unroll
    for (int g = 0; g < 4; ++g) {
        const unsigned r0[4] = {R.r[4 * g].x, R.r[4 * g].y, R.r[4 * g].z, R.r[4 * g].w};
        const unsigned r1[4] = {R.r[4 * g + 1].x, R.r[4 * g + 1].y, R.r[4 * g + 1].z, R.r[4 * g + 1].w};
        const unsigned r2[4] = {R.r[4 * g + 2].x, R.r[4 * g + 2].y, R.r[4 * g + 2].z, R.r[4 * g + 2].w};
        const unsigned r3[4] = {R.r[4 * g + 3].x, R.r[4 * g + 3].y, R.r[4 * g + 3].z, R.r[4 * g + 3].w};
#pragma unroll
        for (int i = 0; i < 4; ++i) {
            const unsigned t0 = __builtin_amdgcn_perm(r1[i], r0[i], 0x05010400u), t1 = __builtin_amdgcn_perm(r1[i], r0[i], 0x07030602u);
            const unsigned t2 = __builtin_amdgcn_perm(r3[i], r2[i], 0x05010400u), t3 = __builtin_amdgcn_perm(r3[i], r2[i], 0x07030602u);
            const unsigned o0 = __builtin_amdgcn_perm(t2, t0, 0x05040100u), o1 = __builtin_amdgcn_perm(t2, t0, 0x07060302u);
            const unsigned o2 = __builtin_amdgcn_perm(t3, t1, 0x05040100u), o3 = __builtin_amdgcn_perm(t3, t1, 0x07060302u);
            acc[4 * i + 0] = __builtin_amdgcn_sdot4((int)o0, (int)pa[g], acc[4 * i + 0], false);
            acc[4 * i + 1] = __builtin_amdgcn_sdot4((int)o1, (int)pa[g], acc[4 * i + 1], false);
            acc[4 * i + 2] = __builtin_amdgcn_sdot4((int)o2, (int)pa[g], acc[4 * i + 2], false);
            acc[4 * i + 3] = __builtin_amdgcn_sdot4((int)o3, (int)pa[g], acc[4 * i + 3], false);
        }
    }
    int q8[8], q4[4], q2[2];
#pragma unroll
    for (int j = 0; j < 8; ++j) {
        const auto r = __builtin_amdgcn_permlane32_swap((unsigned)acc[j], (unsigned)acc[j + 8], false, false);
        q8[j] = (int)r[0] + (int)r[1];
    }
#pragma unroll
    for (int j = 0; j < 4; ++j) {
        const auto r = __builtin_amdgcn_permlane16_swap((unsigned)q8[j], (unsigned)q8[j + 4], false, false);
        q4[j] = (int)r[0] + (int)r[1];
    }
#pragma unroll
    for (int j = 0; j < 2; ++j) { const int snd = b3 ? q4[j] : q4[j + 2], kp = b3 ? q4[j + 2] : q4[j]; q2[j] = kp + dpp_i<DPP_ROR8>(snd); }
    const int col = 128 * x + 16 * (lane & 7) + (b5 ? 8 : 0) + (b4 ? 4 : 0) + (b3 ? 2 : 0);
    *(unsigned*)(p.proj + (size_t)t * 1024 + col) = pk2(bflo(R.x1) + (float)q2[0] * m.sc, bfhi(R.x1) + (float)q2[1] * m.sc);
}
constexpr int EXP_NP = 16;
template <int PHASE>
DEVI void exp_chunk(const Params& p, int tb, int x, int lane) {
    ExpMeta mA, mB, nA, nB;
    ExpRows rA, rB;
    exp_load_meta<PHASE>(p, mA, tb, x, lane);
    exp_load_meta<PHASE>(p, mB, tb + 1, x, lane);
    exp_issue<PHASE>(p, mA, rA, tb, x, lane);
    exp_issue<PHASE>(p, mB, rB, tb + 1, x, lane);
    exp_load_meta<PHASE>(p, nA, tb + 2, x, lane);
    exp_load_meta<PHASE>(p, nB, tb + 3, x, lane);
#pragma unroll 1
    for (int i = 0; i < EXP_NP; ++i) {
        const int tA = tb + 2 * i, tB = tA + 1;
        if (PHASE == 0) expA_compute(p, mA, rA, tA, x, lane); else expB_compute(p, mA, rA, tA, x, lane);
        if (i < EXP_NP - 1) {
            mA = nA;
            exp_issue<PHASE>(p, mA, rA, tA + 2, x, lane);
            if (i < EXP_NP - 2) exp_load_meta<PHASE>(p, nA, tA + 4, x, lane);
        }
        if (PHASE == 0) expA_compute(p, mB, rB, tB, x, lane); else expB_compute(p, mB, rB, tB, x, lane);
        if (i < EXP_NP - 1) {
            mB = nB;
            exp_issue<PHASE>(p, mB, rB, tB + 2, x, lane);
            if (i < EXP_NP - 2) exp_load_meta<PHASE>(p, nB, tB + 4, x, lane);
        }
    }
}
template <int PHASE>
DEVI void st_expAB(const Params& p, char* smem) {
    const int tid = stid(), lane = tid & 63, wid = tid >> 6;
    volatile int* cs = (volatile int*)smem;
    const unsigned myx = xb_xcc_id() & 7u;
    constexpr int NCH = T_TOK / (2 * EXP_NP * NW);
    for (int si = 0; si < 8; ++si) {
        const int x = (int)((myx + si) & 7u);
        unsigned* ctr = &p.bar[PHASE == 0 ? CTR_A(x) : CTR_B(x)];
        if (tid == 0) cs[0] = (int)xb_add(ctr, 1u);
        __syncthreads();
        int chunk = cs[0];
        __syncthreads();
        while (chunk < NCH) {
            int nxt = 0;
            if (tid == 0) nxt = (int)xb_add(ctr, 1u);
            exp_chunk<PHASE>(p, chunk * (2 * EXP_NP * NW) + wid * (2 * EXP_NP), x, lane);
            if (tid == 0) cs[0] = nxt;
            __syncthreads();
            chunk = cs[0];
            __syncthreads();
        }
    }
}
DEVI void st_expA2(const Params& p) {
    const int lane = stid() & 63, wid = stid() >> 6;
    for (int t0 = (blockIdx.x * NW + wid) * 2; t0 < T_TOK; t0 += gridDim.x * NW * 2) {
        unsigned pv[2][8], ew[2];
        float2 g[2];
        float xs[2];
#pragma unroll
        for (int q = 0; q < 2; ++q) {
            const int t = t0 + q;
#pragma unroll
            for (int x = 0; x < 8; ++x) pv[q][x] = *(const unsigned*)(p.part + ((size_t)x * T_TOK + t) * 128 + 2 * lane);
            ew[q] = *(const unsigned*)(p.eperm + (size_t)t * 128 + 2 * lane);
            g[q] = *(const float2*)(p.gate + (size_t)t * 128 + 2 * lane);
            xs[q] = rs2_of(p.rs2p, t) * (8.f * ZQ_SCALE);
        }
        float ds[2][2], us[2][2];
#pragma unroll
        for (int q = 0; q < 2; ++q) {
            const int ea = (int)(ew[q] & 0xffffu), eb = (int)(ew[q] >> 16);
            ds[q][0] = p.dscale[ea]; ds[q][1] = p.dscale[eb]; us[q][0] = p.uscale[ea]; us[q][1] = p.uscale[eb];
        }
#pragma unroll
        for (int q = 0; q < 2; ++q) {
            const int t = t0 + q;
            int s0 = 0, s1 = 0;
#pragma unroll
            for (int x = 0; x < 8; ++x) { s0 += (int)(short)(pv[q][x] & 0xffffu); s1 += (int)pv[q][x] >> 16; }
            const float a0 = g[q].x * gelu_erf((float)s0 * xs[q] * ds[q][0]) * us[q][0];
            const float a1 = g[q].y * gelu_erf((float)s1 * xs[q] * ds[q][1]) * us[q][1];
            const float amax = wave_max(fmaxf(fabsf(a0), fabsf(a1)));
            const float inv = amax > 0.f ? 127.f * rcp_(amax) : 0.f;
            const unsigned q0 = (unsigned)((int)rintf(a0 * inv) & 255), q1 = (unsigned)((int)rintf(a1 * inv) & 255);
            *(unsigned short*)(p.aq + (size_t)t * 128 + 2 * lane) = (unsigned short)(q0 | (q1 << 8));
            if (lane == 0) p.asc[t] = amax * (1.f / 127.f);
        }
    }
}
DEVI void st_expC(const Params& p) {
    const int lane = stid() & 63, wid = stid() >> 6;
    for (int t0 = (blockIdx.x * NW + wid) * 2; t0 < T_TOK; t0 += gridDim.x * NW * 2) {
        uint2 u[2][4];
#pragma unroll
        for (int q = 0; q < 2; ++q) {
            const uint2* row = (const uint2*)(p.proj + (size_t)(t0 + q) * 1024);
#pragma unroll
            for (int j = 0; j < 4; ++j) u[q][j] = row[lane + 64 * j];
        }
#pragma unroll
        for (int q = 0; q < 2; ++q) {
            float4 v[4];
            float ss = 0.f;
#pragma unroll
            for (int j = 0; j < 4; ++j) {
                v[j] = make_float4(bflo(u[q][j].x), bfhi(u[q][j].x), bflo(u[q][j].y), bfhi(u[q][j].y));
                ss += v[j].x * v[j].x + v[j].y * v[j].y + v[j].z * v[j].z + v[j].w * v[j].w;
            }
            ss = wave_sum(ss);
            const float rf = rsqrtf(ss * (1.f / 1024.f) + EPSN);
            float4* orow = (float4*)(p.out + (size_t)(t0 + q) * 1024);
#pragma unroll
            for (int j = 0; j < 4; ++j) {
                const float4 g = *(const float4*)(p.final_g + (lane + 64 * j) * 4);
                orow[lane + 64 * j] = make_float4(v[j].x * rf * g.x, v[j].y * rf * g.y, v[j].z * rf * g.z, v[j].w * rf * g.w);
            }
        }
    }
}

constexpr int LDS_BYTES = 147456;
constexpr int LDS_BARW = LDS_BYTES - 16;
extern __shared__ __attribute__((aligned(16))) char smem_dyn[];
__global__ void __launch_bounds__(NTHR, 2) mega_fwd(Params p) {
    cg::grid_group grid = cg::this_grid();
    volatile LAS unsigned* bst = (volatile LAS unsigned*)(LAS char*)(smem_dyn + LDS_BARW);
    if (stid() < 4) bst[stid()] = 0u;
    __syncthreads();
    XcdBarrier bar = xcd_barrier_post(p.bar, bst);
    st_prep_misc(p);
    st_prep_w1(p, smem_dyn);
    st_prep_x(p, smem_dyn);
    if (p.pad_[0] == 0x7fffabcd) grid.sync();
    xcd_barrier(bar);
    st_gemm8<EpiProj8, PG8_ALIGN>(p.xb, p.W1t, NPJ, 1024, smem_dyn, EpiProj8{p.proj, p.rs1, p.rope_cos, p.rope_sin});
    xcd_barrier(bar);
    st_conv_qk(p, smem_dyn);
    xcd_barrier(bar);
    st_recur(p, smem_dyn);
    xcd_barrier(bar);
    st_gemm8<EpiX18, PG8_ALIGN>(p.yb, p.W2t, 1024, 1024, smem_dyn, EpiX18{p.x, p.x1b, p.xq, p.rs2p, p.norm2_g});
    xcd_barrier(bar);
    st_gemm3_topk(p, smem_dyn);
    xcd_barrier(bar);
    st_expAB<0>(p, smem_dyn);
    xcd_barrier(bar);
    st_expA2(p);
    xcd_barrier(bar);
    st_expAB<1>(p, smem_dyn);
    xcd_barrier(bar);
    st_expC(p);
}

extern "C" void kernel_launch(void* const* d_in, const int* in_sizes, int n_in, void* d_out, int out_size, void* d_ws, size_t ws_size,
                              hipStream_t stream) {
    Params p{};
    const float* const* in = (const float* const*)d_in;
    p.x = in[0]; p.norm1_g = in[1]; p.w_in = in[2]; p.ret_norm_g = in[3]; p.m_conv_w = in[4]; p.m_conv_b = in[5]; p.m_wq = in[6]; p.m_wk = in[7];
    p.m_b_i = in[8]; p.m_b_f = in[9]; p.m_norm_g = in[10]; p.m_skip = in[11]; p.w_out = in[12]; p.norm2_g = in[13]; p.peer_wq = in[14];
    p.peer_keys = in[15]; p.peer_down = in[16]; p.peer_up = in[17]; p.final_g = in[18];
    p.out = (float*)d_out;
    char* ws = (char*)d_ws;
    size_t off = 0;
    auto take = [&](size_t bytes) { char* r = ws + off; off += (bytes + 255) & ~(size_t)255; return r; };
    p.proj = (bf16_t*)take((size_t)T_TOK * NPJ * 2);
    p.xb = (bf16_t*)take((size_t)T_TOK * 1024 * 2);
    p.yb = p.xb;
    p.gate = (float*)(ws + (size_t)T_TOK * 2048 * 4);
    p.mq = (bf16_t*)take((size_t)T_TOK * 512 * 2);
    p.mk = (bf16_t*)take((size_t)T_TOK * 512 * 2);
    p.x1b = p.mq;
    p.cbuf = (bf16_t*)take((size_t)T_TOK * 512 * 2);
    p.eperm = (unsigned short*)p.cbuf;
    p.down_q = (unsigned char*)take((size_t)16384 * 1024);
    p.up_q = (unsigned char*)take((size_t)16384 * 1024);
    p.dscale = (float*)take(16384 * 4);
    p.uscale = (float*)take(16384 * 4);
    p.bar = (unsigned*)take(CTL_WORDS * 4);
    p.xq = (unsigned char*)take((size_t)T_TOK * 1024);
    p.asc = (float*)take(T_TOK * 4);
    p.aq = (unsigned char*)take((size_t)T_TOK * 128);
    p.part = (short*)(ws + (size_t)T_TOK * 1024 * 4);
    p.W1t = (bf16_t*)take((size_t)NPJ * 1024 * 2);
    p.W2t = (bf16_t*)take((size_t)1024 * 1024 * 2);
    p.Wsubq = (signed char*)take((size_t)2048 * 1024);
    p.wsc = (float*)take(2048 * 4);
    p.Wqt = (bf16_t*)take(4 * 128 * 128 * 2);
    p.Wkt = (bf16_t*)take(4 * 128 * 128 * 2);
    p.rs1 = (float*)take(T_TOK * 4);
    p.rs2p = (float*)take((size_t)T_TOK * 16 * 4);
    p.ipre = (float*)take(T_TOK * 4 * 4);
    p.logf = (float*)take(T_TOK * 4 * 4);
    p.rope_cos = (float*)take(2048 * 64 * 4);
    p.rope_sin = (float*)take(2048 * 64 * 4);
    if (off > ws_size) { fprintf(stderr, "kernel_launch: workspace too small (%zu > %zu)\n", off, ws_size); return; }

    static int grid_blocks = 0;
    if (!grid_blocks) {
        int dev = 0, cus = 0, per_cu = 0;
        (void)hipGetDevice(&dev);
        (void)hipDeviceGetAttribute(&cus, hipDeviceAttributeMultiprocessorCount, dev);
        (void)hipFuncSetAttribute((const void*)mega_fwd, hipFuncAttributeMaxDynamicSharedMemorySize, LDS_BYTES);
        (void)hipOccupancyMaxActiveBlocksPerMultiprocessor(&per_cu, (const void*)mega_fwd, NTHR, LDS_BYTES);
        if (per_cu > 1) per_cu = 1;
        if (per_cu < 1) per_cu = 1;
        grid_blocks = cus * per_cu;
    }
    (void)hipMemsetAsync(p.bar, 0, CTL_WORDS * 4, stream);
    void* args[] = {&p};
    hipError_t e = hipLaunchCooperativeKernel((const void*)mega_fwd, dim3(grid_blocks), dim3(NTHR), args, LDS_BYTES, stream);
    if (e != hipSuccess) fprintf(stderr, "cooperative launch failed: %s (grid %d)\n", hipGetErrorString(e), grid_blocks);
}
```

```cpp
#include <hip/hip_runtime.h>
#include <hip/hip_cooperative_groups.h>
#include <stdint.h>
#include <cstdio>
namespace cg = cooperative_groups;

typedef unsigned short bf16_t;
typedef short bf16x8 __attribute__((ext_vector_type(8)));
typedef float f32x4 __attribute__((ext_vector_type(4)));
typedef int i32x4 __attribute__((ext_vector_type(4)));

#define DEVI __device__ __forceinline__
__device__ __forceinline__ int stid() { int t = (int)threadIdx.x; asm volatile("" : "+v"(t)); return t; }

constexpr int T_TOK = 32768, DM = 1024, NPJ = 3584, DIN = 3592;
constexpr int NPR = 1536;
constexpr size_t OPB = (size_t)T_TOK * 512;
__device__ __forceinline__ size_t blk_off(int t16, int h) { return ((size_t)(((t16 >> 2) * 4 + h) * 4 + (t16 & 3))) * 2048; }
constexpr int NTHR = 512, NW = 8;
constexpr float EPSN = 1e-6f;

struct Params {
    const float *x, *norm1_g, *w_in, *ret_norm_g, *m_conv_w, *m_conv_b, *m_wq, *m_wk, *m_b_i, *m_b_f, *m_norm_g, *m_skip, *w_out,
        *norm2_g, *peer_wq, *peer_keys, *peer_down, *peer_up, *final_g;
    float* out;
    bf16_t *proj, *xb, *yb, *mq, *mk, *x1b, *cbuf, *W1t, *W2t, *Wqt, *Wkt;
    signed char* Wsubq;
    float* wsc;
    unsigned char *down_q, *up_q;
    float *dscale, *uscale, *asc;
    unsigned short* eperm;
    unsigned char* aq;
    short* part;
    unsigned char* xq;
    unsigned* bar;
    float *rs1, *rs2p, *ipre, *logf, *rope_cos, *rope_sin, *gate;
    int pad_[2];
};

DEVI unsigned f2bf_bits(float f) { unsigned u = __float_as_uint(f); return (u + 0x7fffu + ((u >> 16) & 1u)) >> 16; }
DEVI bf16_t f2bf(float f) { return __builtin_bit_cast(bf16_t, (__bf16)f); }
typedef __bf16 bf16x2_t __attribute__((ext_vector_type(2)));
DEVI unsigned pk2(float lo, float hi) { bf16x2_t v = {(__bf16)lo, (__bf16)hi}; return __builtin_bit_cast(unsigned, v); }
DEVI float bflo(unsigned w) { return __uint_as_float(w << 16); }
DEVI float bfhi(unsigned w) { return __uint_as_float(w & 0xffff0000u); }
DEVI float bf2f(bf16_t h) { return __uint_as_float(((unsigned)h) << 16); }
template <int CTRL> DEVI float dpp_f(float v) { return __int_as_float(__builtin_amdgcn_update_dpp(0, __float_as_int(v), CTRL, 0xf, 0xf, false)); }
template <int CTRL> DEVI int dpp_i(int v) { return __builtin_amdgcn_update_dpp(0, v, CTRL, 0xf, 0xf, false); }
constexpr int DPP_XOR1 = 0xB1  , DPP_XOR2 = 0x4E  , DPP_HMIRROR = 0x141  ,
              DPP_MIRROR = 0x140  , DPP_ROR8 = 0x128  ;
DEVI float rl_f(float v, int l) { return __int_as_float(__builtin_amdgcn_readlane(__float_as_int(v), l)); }
DEVI float wave_sum(float v) {
    v += dpp_f<DPP_XOR1>(v); v += dpp_f<DPP_XOR2>(v); v += dpp_f<DPP_HMIRROR>(v); v += dpp_f<DPP_MIRROR>(v);
    return (rl_f(v, 0) + rl_f(v, 16)) + (rl_f(v, 32) + rl_f(v, 48));
}
DEVI float wave_max(float v) {
    v = fmaxf(v, dpp_f<DPP_XOR1>(v)); v = fmaxf(v, dpp_f<DPP_XOR2>(v)); v = fmaxf(v, dpp_f<DPP_HMIRROR>(v)); v = fmaxf(v, dpp_f<DPP_MIRROR>(v));
    return fmaxf(fmaxf(rl_f(v, 0), rl_f(v, 16)), fmaxf(rl_f(v, 32), rl_f(v, 48)));
}
constexpr float ZQ_SCALE = 6.f / 127.f;
DEVI float rs2_of(const float* rs2p, int t) {
    const float4* q = (const float4*)(rs2p + (size_t)t * 16);
    const float4 a = q[0], b = q[1], c = q[2], d = q[3];
    const float ss = ((a.x + a.y) + (a.z + a.w)) + ((b.x + b.y) + (b.z + b.w)) + ((c.x + c.y) + (c.z + c.w)) + ((d.x + d.y) + (d.z + d.w));
    return rsqrtf(ss * (1.f / 1024.f) + EPSN);
}
DEVI f32x4 mfma16(bf16x8 a, bf16x8 b, f32x4 c) { return __builtin_amdgcn_mfma_f32_16x16x32_bf16(a, b, c, 0, 0, 0); }
DEVI bf16x8 ld8(const char* p) { return *reinterpret_cast<const bf16x8*>(p); }
DEVI bf16x8 mk8(uint2 lo, uint2 hi) {
    union { uint4 u; bf16x8 v; } x;
    x.u = make_uint4(lo.x, lo.y, hi.x, hi.y);
    return x.v;
}
DEVI float fexp_(float x) { return __builtin_amdgcn_exp2f(x * 1.4426950408889634f); }
DEVI float rcp_(float x) { return __builtin_amdgcn_rcpf(x); }
DEVI float sigmoidf_(float z) { return rcp_(1.f + fexp_(-z)); }

DEVI void st_prep_misc(const Params& p) {
    const int gtid = blockIdx.x * NTHR + stid(), gsz = gridDim.x * NTHR;
    for (int i = gtid; i < 2048 * 64; i += gsz) {
        const int pos = i >> 6, j = i & 63;
        const float inv = powf(10000.f, -(float)j * (1.f / 64.f));
        const float ang = (float)pos * inv;
        float s, c;
        sincosf(ang, &s, &c);
        p.rope_cos[i] = c;
        p.rope_sin[i] = s;
    }
    for (int i = gtid; i < 4 * 128 * 128; i += gsz) {
        const int h = i >> 14, e = (i >> 7) & 127, d = i & 127;
        p.Wqt[i] = f2bf(p.m_wq[h * 16384 + d * 128 + e]);
        p.Wkt[i] = f2bf(p.m_wk[h * 16384 + d * 128 + e] * 0.08838834764831845f);
    }
}
DEVI void prep_table_row(const Params& p, int row, const float4 (&v)[4], int lane) {
    const bool up = row >= 16384;
    const int e = up ? row - 16384 : row;
    float am = 0.f;
#pragma unroll
    for (int i = 0; i < 4; ++i) am = fmaxf(am, fmaxf(fmaxf(fabsf(v[i].x), fabsf(v[i].y)), fmaxf(fabsf(v[i].z), fabsf(v[i].w))));
    am = wave_max(am);
    const float sc = am > 0.f ? am * (1.f / 127.f) : 1.f, inv = am > 0.f ? 127.f * rcp_(am) : 0.f;
    unsigned w[4];
#pragma unroll
    for (int i = 0; i < 4; ++i) {
        const int q0 = (int)rintf(v[i].x * inv), q1 = (int)rintf(v[i].y * inv), q2 = (int)rintf(v[i].z * inv), q3 = (int)rintf(v[i].w * inv);
        w[i] = (unsigned)(q0 & 255) | ((unsigned)(q1 & 255) << 8) | ((unsigned)(q2 & 255) << 16) | ((unsigned)(q3 & 255) << 24);
    }
    *(uint4*)((up ? p.up_q : p.down_q) + ((size_t)(lane >> 3) * 16384 + e) * 128 + (lane & 7) * 16) = make_uint4(w[0], w[1], w[2], w[3]);
    if (lane == 0) (up ? p.uscale : p.dscale)[e] = sc;
}
DEVI void st_prep_tables(const Params& p, int bid, int nb) {
    const int lane = stid() & 63, wid = stid() >> 6;
    for (int row = (bid * NW + wid) * 2; row < 32768; row += nb * NW * 2) {
        float4 va[4], vb[4];
        const float4* sa = (const float4*)((row >= 16384 ? p.peer_up + (size_t)(row - 16384) * 1024 : p.peer_down + (size_t)row * 1024) + lane * 16);
        const float4* sb = (const float4*)((row + 1 >= 16384 ? p.peer_up + (size_t)(row + 1 - 16384) * 1024 : p.peer_down + (size_t)(row + 1) * 1024) + lane * 16);
#pragma unroll
        for (int i = 0; i < 4; ++i) { va[i] = sa[i]; vb[i] = sb[i]; }
        prep_table_row(p, row, va, lane);
        prep_table_row(p, row + 1, vb, lane);
    }
}

DEVI void transpose_tile(const float* __restrict__ src, int ld, const float* __restrict__ scale, bf16_t* __restrict__ dst, int K, int k0, int n0,
                         float* tile, bool permqk = false) {
    const int tid = stid();
    {
        const int tx = tid & 63, ty = tid >> 6;
#pragma unroll
        for (int i = 0; i < 4; ++i) {
            const int k = k0 + ty + 8 * i;
            float v = src[(size_t)k * ld + n0 + tx];
            if (scale) v *= scale[k];
            tile[(ty + 8 * i) * 65 + tx] = v;
        }
    }
    __syncthreads();
    {
        const int n = tid >> 3, kq = tid & 7;
        const float a = tile[(4 * kq) * 65 + n], b = tile[(4 * kq + 1) * 65 + n], c = tile[(4 * kq + 2) * 65 + n], d = tile[(4 * kq + 3) * 65 + n];
        int nn = n0 + n;
        if (permqk && nn < 1024) { const int dd = nn & 127; nn = (nn & ~127) + (dd < 64 ? 2 * dd : 2 * (dd - 64) + 1); }
        *(uint2*)(dst + (size_t)nn * K + k0 + 4 * kq) = make_uint2(pk2(a, b), pk2(c, d));
    }
    __syncthreads();
}
DEVI void st_prep_w1(const Params& p, char* smem) {
    float* tile = (float*)smem;
    for (int it = blockIdx.x; it < 56 * 32; it += gridDim.x) transpose_tile(p.w_in, DIN, p.norm1_g, p.W1t, 1024, (it & 31) * 32, (it >> 5) * 64, tile, true);
}
DEVI void st_prep_w2(const Params& p, char* smem, int bid, int nb) {
    float* tile = (float*)smem;
    for (int it = bid; it < 16 * 32; it += nb) transpose_tile(p.w_out, 1024, nullptr, p.W2t, 1024, (it & 31) * 32, (it >> 5) * 64, tile);
}
DEVI void st_prep_wsub(const Params& p, char* smem, int bid, int nb) {
    float* wq_s = (float*)smem;
    float* key_s = wq_s + 64 * 132;
    const int tid = stid(), nl = tid >> 5, kp = tid & 31;
    for (int it = bid; it < 16 * 8; it += nb) {
        const int grp = it >> 3, n0 = (it & 7) * 16;
        __syncthreads();
        {
            const int idx = tid * 4, n = idx >> 7, d = idx & 127;
            *(float4*)(key_s + n * 132 + d) = *(const float4*)(p.peer_keys + ((size_t)grp * 128 + n0 + n) * 128 + d);
        }
        float v0[16], v1[16];
#pragma unroll 1
        for (int kt = 0; kt < 16; ++kt) {
            __syncthreads();
#pragma unroll
            for (int i = 0; i < 4; ++i) {
                const int idx = (tid + 512 * i) * 4, r = idx >> 7, d = idx & 127;
                *(float4*)(wq_s + r * 132 + d) = *(const float4*)(p.peer_wq + (size_t)(kt * 64 + r) * 2048 + grp * 128 + d);
            }
            __syncthreads();
            float a0 = 0.f, a1 = 0.f;
#pragma unroll 8
            for (int d4 = 0; d4 < 32; ++d4) {
                const float4 w0 = *(const float4*)(wq_s + (2 * kp) * 132 + 4 * d4), w1 = *(const float4*)(wq_s + (2 * kp + 1) * 132 + 4 * d4);
                const float4 y = *(const float4*)(key_s + nl * 132 + 4 * d4);
                a0 += w0.x * y.x + w0.y * y.y + w0.z * y.z + w0.w * y.w;
                a1 += w1.x * y.x + w1.y * y.y + w1.z * y.z + w1.w * y.w;
            }
#pragma unroll
            for (int q = 0; q < 16; ++q) if (q == kt) { v0[q] = a0; v1[q] = a1; }
        }
        float am = 0.f;
#pragma unroll
        for (int q = 0; q < 16; ++q) am = fmaxf(am, fmaxf(fabsf(v0[q]), fabsf(v1[q])));
#pragma unroll
        for (int o = 16; o; o >>= 1) am = fmaxf(am, __shfl_xor(am, o));
        const float inv = am > 0.f ? 127.f * rcp_(am) : 0.f;
        signed char* orow = p.Wsubq + (size_t)(grp * 128 + n0 + nl) * 1024 + 2 * kp;
#pragma unroll
        for (int q = 0; q < 16; ++q) {
            const int q0 = (int)rintf(v0[q] * inv), q1 = (int)rintf(v1[q] * inv);
            *(unsigned short*)(orow + 64 * q) = (unsigned short)((q0 & 255) | ((q1 & 255) << 8));
        }
        if (kp == 0) p.wsc[grp * 128 + n0 + nl] = am > 0.f ? am * (1.f / 127.f) : 1.f;
    }
    __syncthreads();
}

DEVI void prep_x_token(const Params& p, const float* Wg_s, int t, const float4 (&v)[4], int lane) {
    float ss = 0.f, g8[8];
#pragma unroll
    for (int g = 0; g < 8; ++g) g8[g] = 0.f;
#pragma unroll
    for (int j = 0; j < 4; ++j) {
        ss += v[j].x * v[j].x + v[j].y * v[j].y + v[j].z * v[j].z + v[j].w * v[j].w;
#pragma unroll
        for (int g = 0; g < 8; ++g) {
            const float4 w = *(const float4*)(Wg_s + g * 1024 + (lane + 64 * j) * 4);
            g8[g] += v[j].x * w.x + v[j].y * w.y + v[j].z * w.z + v[j].w * w.w;
        }
    }
    ss = wave_sum(ss);
    const bool b5 = lane & 32, b4 = lane & 16, b3 = lane & 8;
    float q4[4], q2[2], q1;
#pragma unroll
    for (int j = 0; j < 4; ++j) { const float snd = b5 ? g8[j] : g8[j + 4], kp = b5 ? g8[j + 4] : g8[j]; q4[j] = kp + __shfl_xor(snd, 32); }
#pragma unroll
    for (int j = 0; j < 2; ++j) { const float snd = b4 ? q4[j] : q4[j + 2], kp = b4 ? q4[j + 2] : q4[j]; q2[j] = kp + __shfl_xor(snd, 16); }
    { const float snd = b3 ? q2[0] : q2[1], kp = b3 ? q2[1] : q2[0]; q1 = kp + __shfl_xor(snd, 8); }
    q1 += __shfl_xor(q1, 4);
    q1 += __shfl_xor(q1, 2);
    q1 += __shfl_xor(q1, 1);
    const float rs = rsqrtf(ss * (1.f / 1024.f) + EPSN);
    uint2* o = (uint2*)(p.xb + (size_t)t * 1024);
#pragma unroll
    for (int j = 0; j < 4; ++j) o[lane + 64 * j] = make_uint2(pk2(v[j].x, v[j].y), pk2(v[j].z, v[j].w));
    if (lane == 0) p.rs1[t] = rs;
    if ((lane & 7) == 0) {
        const int gi = (b5 ? 4 : 0) + (b4 ? 2 : 0) + (b3 ? 1 : 0);
        if (gi < 4) p.ipre[t * 4 + gi] = q1 * rs + p.m_b_i[gi];
        else {
            const float z = q1 * rs + p.m_b_f[gi - 4];
            p.logf[t * 4 + gi - 4] = fminf(z, 0.f) - log1pf(fexp_(-fabsf(z)));
        }
    }
}
DEVI void st_prep_x(const Params& p, char* smem) {
    float* Wg_s = (float*)smem;
    for (int i = stid(); i < 8192; i += NTHR) {
        const int k = i >> 3, g = i & 7;
        Wg_s[g * 1024 + k] = p.norm1_g[k] * p.w_in[(size_t)k * DIN + NPJ + g];
    }
    __syncthreads();
    const int lane = stid() & 63, wid = stid() >> 6;
    for (int t = (blockIdx.x * NW + wid) * 4; t < T_TOK; t += gridDim.x * NW * 4) {
        float4 v[4][4];
        const float4* xa = (const float4*)(p.x + (size_t)t * 1024);
#pragma unroll
        for (int q = 0; q < 4; ++q)
#pragma unroll
            for (int j = 0; j < 4; ++j) v[q][j] = xa[256 * q + lane + 64 * j];
#pragma unroll
        for (int q = 0; q < 4; ++q) prep_x_token(p, Wg_s, t + q, v[q], lane);
    }
    __syncthreads();
}

namespace pg8 {
#define PG8_LAS __attribute__((address_space(3)))
typedef unsigned short bf16_t;
typedef short bf16x8 __attribute__((ext_vector_type(8)));
typedef float f32x4 __attribute__((ext_vector_type(4)));
typedef unsigned u32x4 __attribute__((ext_vector_type(4)));
constexpr int BM = 256, BK = 64, HALF = 128, HTB = HALF * BK * 2  , STAGE_BYTES = 8 * HTB, NXCD = 8, WGM = 8;

__host__ __device__ __forceinline__ int lds_byte(int r, int c) { const int st = (r >> 4) * 2 + (c >> 5), rr = r & 15, cc = c & 31, ob = rr * 64 + cc * 2; return st * 1024 + (ob ^ (((ob >> 9) & 1) << 5)); }
__host__ __device__ __forceinline__ void stage_rc(int b, int& R, int& C) { const int st = b / 1024, sb = b % 1024, swz = sb ^ (((sb >> 9) & 1) << 5); R = (st >> 1) * 16 + swz / 64; C = (st & 1) * 32 + (swz % 64) / 2; }
__host__ __device__ __forceinline__ int perm32(int rho) { const int n = rho >> 4, i = rho & 15; return 8 * (i >> 2) + 4 * n + (i & 3); }

struct Unit { int pm, pn; };
struct Gemm { const bf16_t* A; const bf16_t* Bt; int M, N, K; };

struct StaticOrder {
    int nM, nN, nwg, G, c;
    __host__ __device__ void init(int M, int N, int G_, int c_) { nM = M / BM; nN = N / BM; nwg = nM * nN; G = G_; c = c_; }
    __host__ __device__ bool next(int i, Unit& u) const {
        const long L = (long)i * G + c; if (L >= nwg) return false;
        int wgid = (int)L; { const int q = nwg / NXCD, r = nwg % NXCD, xcd = wgid % NXCD, off = wgid / NXCD; wgid = (xcd < r ? xcd * (q + 1) : r * (q + 1) + (xcd - r) * q) + off; }
        const int nig = WGM * nN, gid = wgid / nig, fm = gid * WGM, gsz = (nM - fm) < WGM ? (nM - fm) : WGM;
        u.pm = fm + ((wgid % nig) % gsz); u.pn = (wgid % nig) / gsz; return true;
    }
    __device__ __forceinline__ void a_ready(const Unit&) const {}
    __device__ __forceinline__ void done(const Unit&) const {}
};

__device__ __forceinline__ unsigned cvt_pk_bf16(float lo, float hi) { unsigned r; asm volatile("v_cvt_pk_bf16_f32 %0, %1, %2" : "=v"(r) : "v"(lo), "v"(hi)); return r; }

template <class Epi, class Sched, bool ALIGN_EPI = false, bool SP2 = false>
__device__ __forceinline__ void gemm_phase(PG8_LAS unsigned char* lds, const Gemm g, const Sched& S, const Epi& E) {
    const int tid = stid(), wid = __builtin_amdgcn_readfirstlane(tid >> 6), lane = tid & 63, wr = wid >> 2, wc = wid & 3, fr = lane & 15, fq = lane >> 4;
    const int K = g.K, nt = K / BK;
    unsigned voffA[2], voffB[2];
#pragma unroll
    for (int i = 0; i < 2; ++i) { int R, C; stage_rc(tid * 16 + i * 8192, R, C); const int Rb = Epi::PERM ? ((R & ~31) + perm32(R & 31)) : R;
        voffA[i] = (unsigned)(R * K + C) * 2u; voffB[i] = (unsigned)(Rb * K + C) * 2u; }
    const size_t kstep = (size_t)(BK * 2);
    const size_t hstep = (size_t)HALF * K * 2;
    const size_t tstep = 2 * hstep;
    const unsigned ldsw = (unsigned)wid * 1024u;
    const int aoff = lds_byte(wr * 64 + fr, fq * 8), boff = lds_byte(wc * 32 + fr, fq * 8);
#define PG8_SA(b, h) (((b) * 2 + (h)) * HTB)
#define PG8_SB(b, h) ((4 + (b) * 2 + (h)) * HTB)
#define PG8_STAGE(bufoff, gbase, voff) do { _Pragma("unroll") for (int _i = 0; _i < 2; ++_i) \
        __builtin_amdgcn_global_load_lds((const unsigned*)((const char*)(gbase) + (voff)[_i]), (PG8_LAS unsigned*)(lds + (bufoff) + ldsw + _i * 8192), 16, 0, 0); } while (0)
#define PG8_LDA(dst, b, h) do { _Pragma("unroll") for (int m = 0; m < 4; ++m) _Pragma("unroll") for (int k = 0; k < 2; ++k) dst[m][k] = *(const PG8_LAS bf16x8*)(lds + PG8_SA(b, h) + aoff + m * 2048 + k * 1024); } while (0)
#define PG8_LDB(dst, b, h) do { _Pragma("unroll") for (int n = 0; n < 2; ++n) _Pragma("unroll") for (int k = 0; k < 2; ++k) dst[n][k] = *(const PG8_LAS bf16x8*)(lds + PG8_SB(b, h) + boff + n * 2048 + k * 1024); } while (0)
#define PG8_MMA(ai, bj, At, Bt) do { __builtin_amdgcn_s_setprio(1); _Pragma("unroll") for (int m = 0; m < 4; ++m) _Pragma("unroll") for (int n = 0; n < 2; ++n) _Pragma("unroll") for (int k = 0; k < 2; ++k) \
        acc[ai][bj][m][n] = __builtin_amdgcn_mfma_f32_16x16x32_bf16(Bt[n][k], At[m][k], acc[ai][bj][m][n], 0, 0, 0); __builtin_amdgcn_s_setprio(0); } while (0)
#define PG8_WAIT_V(n) asm volatile("s_waitcnt vmcnt(" #n ")" ::: "memory")
#define PG8_WAIT_L(n) asm volatile("s_waitcnt lgkmcnt(" #n ")" ::: "memory")
#define PG8_BAR __builtin_amdgcn_s_barrier()
#define PG8_SCHED __builtin_amdgcn_sched_barrier(0)
    Unit cur, nxt; int ui = 0;
    if (!S.next(0, cur)) return;
    f32x4 acc[2][2][4][2];
#pragma unroll
    for (int a = 0; a < 2; ++a)
#pragma unroll
        for (int b = 0; b < 2; ++b)
#pragma unroll
            for (int m = 0; m < 4; ++m)
#pragma unroll
                for (int n = 0; n < 2; ++n) acc[a][b][m][n] = (f32x4){0.f, 0.f, 0.f, 0.f};
    bf16x8 At[4][2], B0[2][2], B1[2][2];
    const char* cA = (const char*)g.A + (size_t)cur.pm * tstep; const char* cB = (const char*)g.Bt + (size_t)cur.pn * tstep;
    S.a_ready(cur);
    if constexpr (SP2) {
        PG8_STAGE(PG8_SB(0, 0), cB, voffB); PG8_STAGE(PG8_SB(0, 1), cB + hstep, voffB); PG8_STAGE(PG8_SA(0, 0), cA, voffA); PG8_STAGE(PG8_SA(0, 1), cA + hstep, voffA);
        if (wr == 1) PG8_BAR;
        PG8_WAIT_V(2); PG8_BAR;
        PG8_STAGE(PG8_SB(1, 0), cB + kstep, voffB); PG8_STAGE(PG8_SA(1, 0), cA + kstep, voffA); PG8_STAGE(PG8_SB(1, 1), cB + hstep + kstep, voffB);
        PG8_WAIT_V(6); PG8_BAR;
    } else {
        PG8_STAGE(PG8_SB(0, 0), cB, voffB); PG8_STAGE(PG8_SA(0, 0), cA, voffA); PG8_STAGE(PG8_SB(0, 1), cB + hstep, voffB); PG8_STAGE(PG8_SA(0, 1), cA + hstep, voffA);
        if (wr == 1) PG8_BAR;
        PG8_WAIT_V(4); PG8_BAR;
        PG8_STAGE(PG8_SB(1, 0), cB + kstep, voffB); PG8_STAGE(PG8_SA(1, 0), cA + kstep, voffA); PG8_STAGE(PG8_SB(1, 1), cB + hstep + kstep, voffB);
        PG8_WAIT_V(6); PG8_BAR;
    }
    for (;;) {
        const bool has_next = S.next(ui + 1, nxt);
        const char* nA = has_next ? (const char*)g.A + (size_t)nxt.pm * tstep : cA; const char* nB = has_next ? (const char*)g.Bt + (size_t)nxt.pn * tstep : cB;
        for (int t = 0; t < nt; t += 2) {
            const bool last = (t == nt - 2);
            const char* a1 = cA + (size_t)(t + 1) * kstep;
            const char* a2 = last ? nA : cA + (size_t)(t + 2) * kstep; const char* b2 = last ? nB : cB + (size_t)(t + 2) * kstep;
            const char* a3 = a2 + kstep; const char* b3 = b2 + kstep;
            if (last && has_next) S.a_ready(nxt);
            if constexpr (SP2) {
            PG8_LDB(B0, 0, 0); PG8_LDB(B1, 0, 1); PG8_SCHED; PG8_LDA(At, 0, 0); PG8_STAGE(PG8_SA(1, 1), a1 + hstep, voffA);
            PG8_WAIT_V(8); PG8_WAIT_L(0); PG8_BAR; PG8_MMA(0, 0, At, B0); PG8_MMA(0, 1, At, B1); PG8_BAR; PG8_SCHED;
            PG8_LDA(At, 0, 1); PG8_STAGE(PG8_SB(0, 0), b2, voffB); PG8_STAGE(PG8_SB(0, 1), b2 + hstep, voffB); PG8_STAGE(PG8_SA(0, 0), a2, voffA);
            PG8_WAIT_V(8); PG8_WAIT_L(0); PG8_BAR; PG8_MMA(1, 0, At, B0); PG8_MMA(1, 1, At, B1); PG8_BAR; PG8_SCHED;
            PG8_LDB(B0, 1, 0); PG8_LDB(B1, 1, 1); PG8_SCHED; PG8_LDA(At, 1, 0); PG8_STAGE(PG8_SA(0, 1), a2 + hstep, voffA);
            PG8_WAIT_V(8); PG8_WAIT_L(0); PG8_BAR; PG8_MMA(0, 0, At, B0); PG8_MMA(0, 1, At, B1); PG8_BAR; PG8_SCHED;
            PG8_LDA(At, 1, 1); PG8_STAGE(PG8_SB(1, 0), b3, voffB); PG8_STAGE(PG8_SB(1, 1), b3 + hstep, voffB); PG8_STAGE(PG8_SA(1, 0), a3, voffA);
            PG8_WAIT_V(8); PG8_WAIT_L(0); PG8_BAR; PG8_MMA(1, 0, At, B0); PG8_MMA(1, 1, At, B1); PG8_BAR; PG8_SCHED;
            } else {
            PG8_LDB(B0, 0, 0); PG8_SCHED; PG8_LDA(At, 0, 0); PG8_STAGE(PG8_SA(1, 1), a1 + hstep, voffA);
            PG8_WAIT_L(8); PG8_BAR; PG8_WAIT_L(0); PG8_MMA(0, 0, At, B0); PG8_BAR; PG8_SCHED;
            PG8_LDB(B1, 0, 1); PG8_STAGE(PG8_SB(0, 0), b2, voffB);
            PG8_BAR; PG8_WAIT_L(0); PG8_MMA(0, 1, At, B1); PG8_BAR;
            PG8_LDA(At, 0, 1); PG8_STAGE(PG8_SA(0, 0), a2, voffA);
            PG8_BAR; PG8_WAIT_L(0); PG8_MMA(1, 0, At, B0); PG8_BAR; PG8_SCHED;
            PG8_STAGE(PG8_SB(0, 1), b2 + hstep, voffB);
            PG8_WAIT_V(6); PG8_BAR; PG8_MMA(1, 1, At, B1); PG8_BAR;
            PG8_LDB(B0, 1, 0); PG8_SCHED; PG8_LDA(At, 1, 0); PG8_STAGE(PG8_SA(0, 1), a2 + hstep, voffA);
            PG8_WAIT_L(8); PG8_BAR; PG8_WAIT_L(0); PG8_MMA(0, 0, At, B0); PG8_BAR; PG8_SCHED;
            PG8_LDB(B1, 1, 1); PG8_STAGE(PG8_SB(1, 0), b3, voffB);
            PG8_BAR; PG8_WAIT_L(0); PG8_MMA(0, 1, At, B1); PG8_BAR;
            PG8_LDA(At, 1, 1); PG8_STAGE(PG8_SA(1, 0), a3, voffA);
            PG8_BAR; PG8_WAIT_L(0); PG8_MMA(1, 0, At, B0); PG8_BAR; PG8_SCHED;
            PG8_STAGE(PG8_SB(1, 1), b3 + hstep, voffB);
            PG8_WAIT_V(6); PG8_BAR; PG8_MMA(1, 1, At, B1); PG8_BAR;
            }
        }
        if constexpr (ALIGN_EPI) { if (wr == 0) PG8_BAR; }
        if constexpr (!Epi::AFTER_DRAIN) { E(acc, cur, wr, wc, fr, fq); S.done(cur); }
        if (!has_next) break;
#pragma unroll
        for (int a = 0; a < 2; ++a)
#pragma unroll
            for (int b = 0; b < 2; ++b)
#pragma unroll
                for (int m = 0; m < 4; ++m)
#pragma unroll
                    for (int n = 0; n < 2; ++n) acc[a][b][m][n] = (f32x4){0.f, 0.f, 0.f, 0.f};
        cur = nxt; cA = nA; cB = nB; ++ui;
        if constexpr (ALIGN_EPI) { if (wr == 1) PG8_BAR; }
    }
    PG8_WAIT_V(0);
    if constexpr (!ALIGN_EPI) { if (wr == 0) PG8_BAR; }
    PG8_BAR;
    if constexpr (Epi::AFTER_DRAIN) { E.fused(acc, cur, wr, wc, fr, fq, lds, wid, lane); S.done(cur); }
#undef PG8_SA
#undef PG8_SB
#undef PG8_STAGE
#undef PG8_LDA
#undef PG8_LDB
#undef PG8_MMA
#undef PG8_WAIT_V
#undef PG8_WAIT_L
#undef PG8_BAR
#undef PG8_SCHED
}
}

#ifndef PG8_SP2
#define PG8_SP2 true
#endif
#ifndef PG8_ALIGN
#define PG8_ALIGN true
#endif
struct EpiProj8 {
    static constexpr bool PERM = true, AFTER_DRAIN = false;
    bf16_t* O; const float* rs; const float* rcos; const float* rsin;
    __device__ __forceinline__ void operator()(const pg8::f32x4 (&acc)[2][2][4][2], const pg8::Unit& u, int wr, int wc, int fr, int fq) const {
        const int row0 = u.pm * 256 + wr * 64 + fr, col0 = u.pn * 256 + wc * 32 + 8 * fq;
        const bool rot = u.pn < 4;
        const float ksc = u.pn >= 2 ? 0.08838834764831845f : 1.f;
#pragma unroll
        for (int ai = 0; ai < 2; ++ai)
#pragma unroll
            for (int m = 0; m < 4; ++m) {
                const int row = row0 + ai * 128 + m * 16;
                const float s = rs[row];
                const int seg = u.pn >> 1;
                const bool blocked = (seg < 3) || (seg == 5);
                bf16_t* rowp;
                int bjs;
                if (blocked) {
                    rowp = O + (size_t)(seg == 5 ? 3 : seg) * OPB + blk_off(row >> 4, (u.pn & 1) * 2) + (wc * 4 + fq) * 128 + fr * 8;
                    bjs = 4 * 2048;
                } else {
                    rowp = O + 4 * OPB + (size_t)row * NPR + (seg == 3 ? 0 : seg == 4 ? 512 : 1024) + (u.pn & 1) * 256 + wc * 32 + 8 * fq;
                    bjs = 128;
                }
                float4 cs = make_float4(1.f, 1.f, 1.f, 1.f), sn = make_float4(0.f, 0.f, 0.f, 0.f);
                float s2 = s;
                if (rot) {
                    const int ti = (row & 2047) * 64 + 16 * wc + 4 * fq;
                    cs = *(const float4*)(rcos + ti);
                    sn = *(const float4*)(rsin + ti);
                    s2 = s * ksc;
                }
#pragma unroll
                for (int bj = 0; bj < 2; ++bj) {
                    const pg8::f32x4 v0 = acc[ai][bj][m][0] * s2, v1 = acc[ai][bj][m][1] * s2;
                    *(uint4*)(rowp + bj * bjs) = make_uint4(pk2(v0[0] * cs.x - v0[1] * sn.x, v0[0] * sn.x + v0[1] * cs.x), pk2(v0[2] * cs.y - v0[3] * sn.y, v0[2] * sn.y + v0[3] * cs.y),
                                                            pk2(v1[0] * cs.z - v1[1] * sn.z, v1[0] * sn.z + v1[1] * cs.z), pk2(v1[2] * cs.w - v1[3] * sn.w, v1[2] * sn.w + v1[3] * cs.w));
                }
            }
    }
};
struct EpiX18 {
    static constexpr bool PERM = true, AFTER_DRAIN = false;
    const float* x; bf16_t* x1b; unsigned char* zq; float* rs2p; const float* g2;
    __device__ __forceinline__ void operator()(const pg8::f32x4 (&acc)[2][2][4][2], const pg8::Unit& u, int wr, int wc, int fr, int fq) const {
        const int row0 = u.pm * 256 + wr * 64 + fr, col0 = u.pn * 256 + wc * 32 + 8 * fq;
        float gq[2][8];
#pragma unroll
        for (int bj = 0; bj < 2; ++bj) {
            const float4 a = *(const float4*)(g2 + col0 + bj * 128), b = *(const float4*)(g2 + col0 + bj * 128 + 4);
            gq[bj][0] = a.x; gq[bj][1] = a.y; gq[bj][2] = a.z; gq[bj][3] = a.w; gq[bj][4] = b.x; gq[bj][5] = b.y; gq[bj][6] = b.z; gq[bj][7] = b.w;
        }
        float ssq[8];
#pragma unroll
        for (int ai = 0; ai < 2; ++ai)
#pragma unroll
            for (int m = 0; m < 4; ++m) {
                const size_t ro = (size_t)(row0 + ai * 128 + m * 16) * 1024 + col0;
                float s = 0.f;
#pragma unroll
                for (int bj = 0; bj < 2; ++bj) {
                    const float4 xa = *(const float4*)(x + ro + bj * 128), xb_ = *(const float4*)(x + ro + bj * 128 + 4);
                    const pg8::f32x4 v0 = acc[ai][bj][m][0], v1 = acc[ai][bj][m][1];
                    const float y[8] = {xa.x + v0[0], xa.y + v0[1], xa.z + v0[2], xa.w + v0[3], xb_.x + v1[0], xb_.y + v1[1], xb_.z + v1[2], xb_.w + v1[3]};
                    *(uint4*)(x1b + ro + bj * 128) = make_uint4(pk2(y[0], y[1]), pk2(y[2], y[3]), pk2(y[4], y[5]), pk2(y[6], y[7]));
                    unsigned w2[2] = {0u, 0u};
#pragma unroll
                    for (int e = 0; e < 8; ++e) {
                        s += y[e] * y[e];
                        const float z = fminf(fmaxf(y[e] * gq[bj][e] * (1.f / ZQ_SCALE), -127.f), 127.f);
                        w2[e >> 2] |= ((unsigned)((int)rintf(z) & 255)) << (8 * (e & 3));
                    }
                    *(uint2*)(zq + ro + bj * 128) = make_uint2(w2[0], w2[1]);
                }
                ssq[ai * 4 + m] = s;
            }
        float q4[4], q2[2];
#pragma unroll
        for (int j = 0; j < 4; ++j) {
            const auto r = __builtin_amdgcn_permlane32_swap(__float_as_uint(ssq[j]), __float_as_uint(ssq[j + 4]), false, false);
            q4[j] = __uint_as_float(r[0]) + __uint_as_float(r[1]);
        }
#pragma unroll
        for (int j = 0; j < 2; ++j) {
            const auto r = __builtin_amdgcn_permlane16_swap(__float_as_uint(q4[j]), __float_as_uint(q4[j + 2]), false, false);
            q2[j] = __uint_as_float(r[0]) + __uint_as_float(r[1]);
        }
#pragma unroll
        for (int j = 0; j < 2; ++j) {
            const int r8 = ((fq >> 1) & 1) * 4 + (fq & 1) * 2 + j;
            rs2p[(size_t)(row0 + (r8 >> 2) * 128 + (r8 & 3) * 16) * 16 + u.pn * 4 + wc] = q2[j];
        }
    }
};
template <class Epi, bool ALIGN>
DEVI void st_gemm8(const bf16_t* A, const bf16_t* Bt, int N, int K, char* smem, const Epi& epi) {
    pg8::Gemm g{A, Bt, T_TOK, N, K};
    pg8::StaticOrder S;
    S.init(T_TOK, N, (int)gridDim.x, (int)blockIdx.x);
    pg8::gemm_phase<Epi, pg8::StaticOrder, ALIGN, PG8_SP2>((PG8_LAS unsigned char*)smem, g, S, epi);
}

DEVI void st_conv_qk(const Params& p, char* smem) {
    char* cs = smem;
    char* wqs = smem + 128 * 272;
    char* wks = smem + 2 * 128 * 272;
    const int tid = stid(), lane = tid & 63, wid = tid >> 6, wr = wid >> 1, wc = wid & 1, fr = lane & 15, fq = lane >> 4;
    const int r = tid >> 4, cg = tid & 15;
    int hcur = -1;
    float cw[4][8], cb[8];
    for (int it = blockIdx.x; it < 256 * 4; it += gridDim.x) {
        const int h = it & 3, t0 = (it >> 2) * 128, s0 = t0 & 2047;
        if (h != hcur) {
            __syncthreads();
#pragma unroll
            for (int i = 0; i < 4; ++i) {
                const int id = tid + 512 * i, rr = id >> 4, c = id & 15;
                *(uint4*)(wqs + rr * 272 + c * 16) = *(const uint4*)(p.Wqt + h * 16384 + rr * 128 + c * 8);
                *(uint4*)(wks + rr * 272 + c * 16) = *(const uint4*)(p.Wkt + h * 16384 + rr * 128 + c * 8);
            }
#pragma unroll
            for (int j = 0; j < 4; ++j) {
                const float4 a = *(const float4*)(p.m_conv_w + j * 512 + h * 128 + 8 * cg), b = *(const float4*)(p.m_conv_w + j * 512 + h * 128 + 8 * cg + 4);
                cw[j][0] = a.x; cw[j][1] = a.y; cw[j][2] = a.z; cw[j][3] = a.w; cw[j][4] = b.x; cw[j][5] = b.y; cw[j][6] = b.z; cw[j][7] = b.w;
            }
            { const float4 a = *(const float4*)(p.m_conv_b + h * 128 + 8 * cg), b = *(const float4*)(p.m_conv_b + h * 128 + 8 * cg + 4);
              cb[0] = a.x; cb[1] = a.y; cb[2] = a.z; cb[3] = a.w; cb[4] = b.x; cb[5] = b.y; cb[6] = b.z; cb[7] = b.w; }
            hcur = h;
        }
        const bf16_t* xcol = p.proj + 4 * OPB + (size_t)t0 * NPR + 512 + h * 128 + 8 * cg;
#pragma unroll
        for (int ps = 0; ps < 4; ++ps) {
            const int row = 32 * ps + r;
            uint4 xv[4];
#pragma unroll
            for (int j = 0; j < 4; ++j) {
                const int rj = row - 3 + j;
                xv[j] = (s0 + rj >= 0) ? *(const uint4*)(xcol + (long)rj * NPR) : make_uint4(0u, 0u, 0u, 0u);
            }
            float y[8];
#pragma unroll
            for (int e = 0; e < 8; ++e) y[e] = cb[e];
#pragma unroll
            for (int j = 0; j < 4; ++j) {
                const unsigned w4[4] = {xv[j].x, xv[j].y, xv[j].z, xv[j].w};
#pragma unroll
                for (int e = 0; e < 4; ++e) { y[2 * e] += cw[j][2 * e] * bflo(w4[e]); y[2 * e + 1] += cw[j][2 * e + 1] * bfhi(w4[e]); }
            }
            unsigned o[4];
#pragma unroll
            for (int e = 0; e < 4; ++e) o[e] = pk2(y[2 * e] * sigmoidf_(y[2 * e]), y[2 * e + 1] * sigmoidf_(y[2 * e + 1]));
            const uint4 ov = make_uint4(o[0], o[1], o[2], o[3]);
            *(uint4*)(cs + row * 272 + cg * 16) = ov;
            *(uint4*)(p.cbuf + (size_t)(t0 + row) * 512 + h * 128 + 8 * cg) = ov;
        }
        __syncthreads();
#pragma unroll
        for (int which = 0; which < 2; ++which) {
            const char* ws = which ? wks : wqs;
            bf16_t* O = which ? p.mk : p.mq;
            f32x4 acc[2][4];
#pragma unroll
            for (int i = 0; i < 2; ++i)
#pragma unroll
                for (int j = 0; j < 4; ++j) acc[i][j] = (f32x4){0.f, 0.f, 0.f, 0.f};
#pragma unroll
            for (int ks = 0; ks < 4; ++ks) {
                bf16x8 a[2], b[4];
#pragma unroll
                for (int i = 0; i < 2; ++i) a[i] = ld8(cs + (wr * 32 + i * 16 + fr) * 272 + (ks * 4 + fq) * 16);
#pragma unroll
                for (int j = 0; j < 4; ++j) b[j] = ld8(ws + (wc * 64 + j * 16 + fr) * 272 + (ks * 4 + fq) * 16);
#pragma unroll
                for (int i = 0; i < 2; ++i)
#pragma unroll
                    for (int j = 0; j < 4; ++j) acc[i][j] = mfma16(b[j], a[i], acc[i][j]);
            }
#pragma unroll
            for (int i = 0; i < 2; ++i)
#pragma unroll
                for (int j = 0; j < 4; ++j) {
                    const f32x4 v = acc[i][j];
                    *(uint2*)(O + blk_off((t0 >> 4) + wr * 2 + i, h) + (wc * 8 + j * 2 + (fq >> 1)) * 128 + fr * 8 + (fq & 1) * 4) = make_uint2(pk2(v[0], v[1]), pk2(v[2], v[3]));
                }
        }
        __syncthreads();
    }
}

DEVI bf16x8 u4_to_frag(uint4 u) { union { uint4 u; bf16x8 v; } x; x.u = u; return x.v; }
DEVI void sel_frags(bf16x8 (&sel)[2], int fr, int fq) {
#pragma unroll
    for (int hh = 0; hh < 2; ++hh) {
        const int jstar = fr + 16 * hh - 8 * fq;
        bf16x8 s;
#pragma unroll
        for (int j = 0; j < 8; ++j) s[j] = (j == jstar) ? (short)0x3F80 : (short)0;
        sel[hh] = s;
    }
}
DEVI void tr_store(char* XT, bf16x8 frag, const bf16x8 (&sel)[2], int mi, int ks, int fr, int fq, const float (&sc)[4]) {
#pragma unroll
    for (int hh = 0; hh < 2; ++hh) {
        const f32x4 d = mfma16(frag, sel[hh], (f32x4){0.f, 0.f, 0.f, 0.f});
        *(uint2*)(XT + (32 * ks + 16 * hh + fr) * 144 + (16 * mi + 4 * fq) * 2) = make_uint2(pk2(d[0] * sc[0], d[1] * sc[1]), pk2(d[2] * sc[2], d[3] * sc[3]));
    }
}
DEVI bf16x8 state_pack(const f32x4& a, const f32x4& b) {
    return mk8(make_uint2(pk2(a[0], a[1]), pk2(a[2], a[3])), make_uint2(pk2(b[0], b[1]), pk2(b[2], b[3])));
}
DEVI const float* opaque_ptr(const float* q) { asm volatile("" : "+v"(q)); return q; }
DEVI float opaque_f(float v) { asm volatile("" : "+v"(v)); return v; }
DEVI void lds_barrier() { asm volatile("s_waitcnt lgkmcnt(0)" ::: "memory"); __builtin_amdgcn_s_barrier(); asm volatile("" ::: "memory"); }
DEVI void pin_u4(uint4& a) { asm volatile("" : "+v"(a.x), "+v"(a.y), "+v"(a.z), "+v"(a.w)); }
DEVI float grp8_sum(float v) { v += dpp_f<DPP_XOR1>(v); v += dpp_f<DPP_XOR2>(v); v += dpp_f<DPP_HMIRROR>(v); return v; }

#define ASM_LD16(dst, voff, sbase, imm) asm volatile("global_load_dwordx4 %0, %1, %2 offset:" #imm : "=v"(dst) : "v"(voff), "s"(sbase) : "memory")
#define ASM_LD4(dst, voff, sbase) asm volatile("global_load_dword %0, %1, %2" : "=v"(dst) : "v"(voff), "s"(sbase) : "memory")
typedef unsigned u32x4_t __attribute__((ext_vector_type(4)));
struct RetPre { u32x4_t f[4]; u32x4_t v[2]; u32x4_t g[2]; };
struct RetOff { unsigned f, v0, v1, g; };
DEVI void ret_offsets(RetOff& o, int h, int tid) {
    const int lane = tid & 63, w = tid >> 6, fr = lane & 15, fq = lane >> 4, mi = w & 3;
    o.f = (unsigned)((w < 4 ? OPB * 2 : 0) + (4 * h + mi) * 4096 + fq * 256 + fr * 16);
    o.v0 = (unsigned)(2 * OPB * 2 + (4 * h + ((2 * w) >> 2)) * 4096 + (4 * ((2 * w) & 3) + fq) * 256 + fr * 16);
    o.v1 = (unsigned)(2 * OPB * 2 + (4 * h + ((2 * w + 1) >> 2)) * 4096 + (4 * ((2 * w + 1) & 3) + fq) * 256 + fr * 16);
    o.g = (unsigned)(((tid >> 3) * NPR + h * 128 + 8 * (tid & 7)) * 2);
}
DEVI const char* ret_base(const Params& p, int b, int c) { return (const char*)p.proj + (size_t)(b * 32 + c) * 65536; }
DEVI const char* ret_gbase(const Params& p, int b, int c) { return (const char*)(p.proj + 4 * OPB) + (size_t)(b * 2048 + c * 64) * (NPR * 2); }
template <int N> DEVI void ret_retire_fv(RetPre& P) {
    asm volatile("s_waitcnt vmcnt(%6)" : "+v"(P.f[0]), "+v"(P.f[1]), "+v"(P.f[2]), "+v"(P.f[3]), "+v"(P.v[0]), "+v"(P.v[1]) : "n"(N) : "memory");
}
DEVI uint4 asu4(const u32x4_t& v) { return make_uint4(v[0], v[1], v[2], v[3]); }
DEVI void ret_block(const Params& p, char* smem, int b, int h) {
    char* qs = smem;
    char* ks_ = smem + 17408;
    char* kTs = smem + 34816;
    char* vTs = smem + 53248;
    char* Ss = smem + 71680;
    char* Os = smem + 80896;
    float* gn_s = (float*)(smem + 98304);
    const int tid = stid(), lane = tid & 63, w = tid >> 6, fr = lane & 15, fq = lane >> 4;
    const float gamma = 1.f - exp2f(-5.f - (float)h);
    const float l2g = log2f(gamma);
    const float g64 = exp2f(l2g * 64.f);
    bf16x8 sel[2];
    sel_frags(sel, fr, fq);
    f32x4 st[8];
#pragma unroll
    for (int i = 0; i < 8; ++i) st[i] = (f32x4){0.f, 0.f, 0.f, 0.f};
    if (tid < 128) gn_s[tid] = p.ret_norm_g[h * 128 + tid];
    __syncthreads();
    RetPre P;
    RetOff RO;
    ret_offsets(RO, h, tid);
    {
        const char* base = ret_base(p, b, 0);
        ASM_LD16(P.f[0], RO.f, base, 0); ASM_LD16(P.f[1], RO.f, base, 1024); ASM_LD16(P.f[2], RO.f, base, 2048); ASM_LD16(P.f[3], RO.f, base, 3072);
        ASM_LD16(P.v[0], RO.v0, base, 0); ASM_LD16(P.v[1], RO.v1, base, 0);
    }
    ret_retire_fv<0>(P);
#pragma unroll 1
    for (int c = 0; c < 32; ++c) {
        const int t0 = b * 2048 + c * 64;
        {
            const int mi = w & 3;
            char* dst = (w < 4 ? ks_ : qs) + (16 * mi + fr) * 272 + fq * 16;
#pragma unroll
            for (int ks = 0; ks < 4; ++ks) *(uint4*)(dst + ks * 64) = asu4(P.f[ks]);
            if (w < 4) {
                float kd[4];
#pragma unroll
                for (int r = 0; r < 4; ++r) kd[r] = exp2f(l2g * (float)(63 - (16 * mi + 4 * fq + r)));
#pragma unroll
                for (int ks = 0; ks < 4; ++ks) tr_store(kTs, u4_to_frag(asu4(P.f[ks])), sel, mi, ks, fr, fq, kd);
            }
            const float one[4] = {1.f, 1.f, 1.f, 1.f};
#pragma unroll
            for (int q = 0; q < 2; ++q) { const int pr = 2 * w + q; tr_store(vTs, u4_to_frag(asu4(P.v[q])), sel, pr >> 2, pr & 3, fr, fq, one); }
        }
        lds_barrier();
        const char* cbase = ret_gbase(p, b, c);
        const char* nbase = ret_base(p, b, c + 1 < 32 ? c + 1 : 31);
        ASM_LD16(P.g[0], RO.g, cbase, 0); ASM_LD16(P.g[1], RO.g, cbase, 128);
        {
            const int lt = w & 3;
            bf16x8 qf[4];
#pragma unroll
            for (int s = 0; s < 4; ++s) qf[s] = ld8(qs + (16 * lt + fr) * 272 + (s * 4 + fq) * 16);
#pragma unroll
            for (int jj = 0; jj < 2; ++jj) {
                const int j = 2 * (w >> 2) + jj;
                if (jj == 0) { ASM_LD16(P.f[0], RO.f, nbase, 0); ASM_LD16(P.f[1], RO.f, nbase, 1024); }
                else { ASM_LD16(P.f[2], RO.f, nbase, 2048); ASM_LD16(P.f[3], RO.f, nbase, 3072); }
                f32x4 a = (f32x4){0.f, 0.f, 0.f, 0.f};
#pragma unroll
                for (int s = 0; s < 4; ++s) a = mfma16(ld8(ks_ + (16 * j + fr) * 272 + (s * 4 + fq) * 16), qf[s], a);
                const int l = 16 * lt + fr, mb = 16 * j + 4 * fq;
                float v[4];
#pragma unroll
                for (int r = 0; r < 4; ++r) { const int dd = l - (mb + r); v[r] = a[r] * exp2f(l2g * (float)(dd < 0 ? -dd : dd)); }
                *(uint2*)(Ss + l * 144 + mb * 2) = make_uint2(pk2(v[0], v[1]), pk2(v[2], v[3]));
            }
        }
        lds_barrier();
        {
            bf16x8 sp[4];
#pragma unroll
            for (int s = 0; s < 4; ++s) sp[s] = state_pack(st[2 * s], st[2 * s + 1]);
            bf16x8 vf[2];
#pragma unroll
            for (int s2 = 0; s2 < 2; ++s2) vf[s2] = ld8(vTs + (16 * w + fr) * 144 + (s2 * 4 + fq) * 16);
#pragma unroll
            for (int i = 0; i < 4; ++i) {
                if (i == 0) ASM_LD16(P.v[0], RO.v0, nbase, 0);
                if (i == 1) ASM_LD16(P.v[1], RO.v1, nbase, 0);
                f32x4 a = (f32x4){0.f, 0.f, 0.f, 0.f};
                const char* qrow = qs + (16 * i + fr) * 272;
#pragma unroll
                for (int s = 0; s < 4; ++s) {
                    const uint2 lo = *(const uint2*)(qrow + (32 * s + 4 * fq) * 2), hi = *(const uint2*)(qrow + (32 * s + 16 + 4 * fq) * 2);
                    a = mfma16(sp[s], mk8(lo, hi), a);
                }
                a = a * exp2f(l2g * (float)(16 * i + fr + 1));
#pragma unroll
                for (int s2 = 0; s2 < 2; ++s2) a = mfma16(vf[s2], ld8(Ss + (16 * i + fr) * 144 + (s2 * 4 + fq) * 16), a);
                *(uint2*)(Os + (16 * i + fr) * 272 + (16 * w + 4 * fq) * 2) = make_uint2(pk2(a[0], a[1]), pk2(a[2], a[3]));
            }
#pragma unroll
            for (int i = 0; i < 8; ++i) {
                f32x4 a = st[i] * g64;
#pragma unroll
                for (int s2 = 0; s2 < 2; ++s2) a = mfma16(ld8(kTs + (16 * i + fr) * 144 + (s2 * 4 + fq) * 16), vf[s2], a);
                st[i] = a;
            }
        }
        lds_barrier();
        {
            const int l = tid >> 3, part = tid & 7;
            const uint4 o0 = *(const uint4*)(Os + l * 272 + part * 16), o1 = *(const uint4*)(Os + l * 272 + 128 + part * 16);
            const unsigned ow[8] = {o0.x, o0.y, o0.z, o0.w, o1.x, o1.y, o1.z, o1.w};
            float x[16], s = 0.f;
#pragma unroll
            for (int e = 0; e < 8; ++e) { x[2 * e] = bflo(ow[e]); x[2 * e + 1] = bfhi(ow[e]); s += x[2 * e] + x[2 * e + 1]; }
            const float mu = grp8_sum(s) * (1.f / 128.f);
            float q = 0.f;
#pragma unroll
            for (int e = 0; e < 16; ++e) { x[e] -= mu; q += x[e] * x[e]; }
            float rstd = rsqrtf(grp8_sum(q) * (1.f / 128.f) + EPSN);
            asm volatile("s_waitcnt vmcnt(6)" : "+v"(P.g[0]), "+v"(P.g[1]), "+v"(rstd) :: "memory");
            const unsigned gw[8] = {P.g[0][0], P.g[0][1], P.g[0][2], P.g[0][3], P.g[1][0], P.g[1][1], P.g[1][2], P.g[1][3]};
            const float* gn = gn_s + 8 * part;
            unsigned yo[8];
#pragma unroll
            for (int e = 0; e < 8; ++e) {
                const float ga = bflo(gw[e]), gb = bfhi(gw[e]);
                const int ci = (e < 4 ? 0 : 56) + 2 * e;
                yo[e] = pk2(ga * sigmoidf_(ga) * x[2 * e] * rstd * gn[ci], gb * sigmoidf_(gb) * x[2 * e + 1] * rstd * gn[ci + 1]);
            }
            asm volatile("" : "+v"(yo[0]), "+v"(yo[1]), "+v"(yo[2]), "+v"(yo[3]), "+v"(yo[4]), "+v"(yo[5]), "+v"(yo[6]), "+v"(yo[7]));
            ret_retire_fv<0>(P);
            uint4* yp = (uint4*)(p.yb + (size_t)(t0 + l) * 1024 + h * 128 + 8 * part);
            yp[0] = make_uint4(yo[0], yo[1], yo[2], yo[3]);
            yp[8] = make_uint4(yo[4], yo[5], yo[6], yo[7]);
        }
    }
}

struct MlPre { u32x4_t f[4]; u32x4_t v[2]; u32x4_t o[2]; u32x4_t cc[2]; };
struct MlOff { unsigned f, v0, v1, o, c, g; };
DEVI void ml_offsets(const Params& p, MlOff& o, int h, int tid) {
    const int lane = tid & 63, w = tid >> 6, fr = lane & 15, fq = lane >> 4, mi = w & 3;
    const unsigned kdiff = (unsigned)((const char*)p.mk - (const char*)p.mq);
    o.f = (unsigned)((4 * h + mi) * 4096 + fq * 256 + fr * 16) + (w < 4 ? kdiff : 0u);
    o.v0 = (unsigned)((4 * h + ((2 * w) >> 2)) * 4096 + (4 * ((2 * w) & 3) + fq) * 256 + fr * 16);
    o.v1 = (unsigned)((4 * h + ((2 * w + 1) >> 2)) * 4096 + (4 * ((2 * w + 1) & 3) + fq) * 256 + fr * 16);
    o.o = (unsigned)(((tid >> 3) * NPR + 1024 + h * 128 + 8 * (tid & 7)) * 2);
    o.c = (unsigned)(((tid >> 3) * 512 + h * 128 + 8 * (tid & 7)) * 2);
    o.g = (unsigned)((lane * 4 + h) * 4);
}
template <int N> DEVI void ml_retire_fv(MlPre& P) {
    asm volatile("s_waitcnt vmcnt(%6)" : "+v"(P.f[0]), "+v"(P.f[1]), "+v"(P.f[2]), "+v"(P.f[3]), "+v"(P.v[0]), "+v"(P.v[1]) : "n"(N) : "memory");
}
DEVI void mlstm_block(const Params& p, char* smem, int b, int h) {
    char* qs = smem;
    char* kTs = smem + 17408;
    char* vTs = smem + 35840;
    char* Os = smem + 54272;
    float* n_s = (float*)(smem + 71680);
    float* den_s = (float*)(smem + 72192);
    float* gn_s = (float*)(smem + 72448);
    float* sk_s = gn_s + 128;
    float* lw_s = sk_s + 128;
    float* ac_s = lw_s + 32 * 64;
    float* mi_s = ac_s + 32;
    const int tid = stid(), lane = tid & 63, w = tid >> 6, fr = lane & 15, fq = lane >> 4;
    bf16x8 sel[2];
    sel_frags(sel, fr, fq);
    f32x4 st[8];
#pragma unroll
    for (int i = 0; i < 8; ++i) st[i] = (f32x4){0.f, 0.f, 0.f, 0.f};
    float m_run = 0.f;
    f32x4 nacc = (f32x4){0.f, 0.f, 0.f, 0.f};
    bf16x8 ones;
#pragma unroll
    for (int j = 0; j < 8; ++j) ones[j] = (short)0x3F80;
    if (tid < 128) { gn_s[tid] = p.m_norm_g[h * 128 + tid]; sk_s[tid] = p.m_skip[h * 128 + tid]; }
#pragma unroll
    for (int q = 0; q < 4; ++q) {
        const int cc = 4 * w + q, tt = b * 2048 + cc * 64 + lane;
        const float iv = p.ipre[tt * 4 + h], fv = p.logf[tt * 4 + h];
        float fcum = fv;
#pragma unroll
        for (int o = 1; o < 64; o <<= 1) { const float tv = __shfl_up(fcum, o); if (lane >= o) fcum += tv; }
        const float a_c = __shfl(fcum, 63);
        const float logw = a_c - fcum + iv;
        const float m_in = wave_max(logw);
        lw_s[cc * 64 + lane] = logw;
        if (lane == 0) { ac_s[cc] = a_c; mi_s[cc] = m_in; }
    }
    __syncthreads();
    MlPre P;
    MlOff MO;
    ml_offsets(p, MO, h, tid);
    {
        const size_t t00 = (size_t)(b * 2048);
        const char* bq = (const char*)p.mq + t00 * 1024, *bp = (const char*)(p.proj + 3 * OPB) + t00 * 1024;
        ASM_LD16(P.f[0], MO.f, bq, 0); ASM_LD16(P.f[1], MO.f, bq, 1024); ASM_LD16(P.f[2], MO.f, bq, 2048); ASM_LD16(P.f[3], MO.f, bq, 3072);
        ASM_LD16(P.v[0], MO.v0, bp, 0); ASM_LD16(P.v[1], MO.v1, bp, 0);
    }
    ml_retire_fv<0>(P);
#pragma unroll 1
    for (int c = 0; c < 32; ++c) {
        const int t0 = b * 2048 + c * 64;
        const float a_c = ac_s[c], m_in = mi_s[c], logw = lw_s[c * 64 + lane];
        const float m_new = fmaxf(a_c + m_run, m_in);
        const float decay = fexp_(a_c + m_run - m_new);
        const float wgt = fexp_(logw - m_new);
        const float emn = fexp_(-m_new);
        m_run = m_new;
        {
            const int mi = w & 3;
            if (w < 4) {
                float kw[4];
#pragma unroll
                for (int r = 0; r < 4; ++r) kw[r] = __shfl(wgt, 16 * mi + 4 * fq + r);
#pragma unroll
                for (int ks = 0; ks < 4; ++ks) tr_store(kTs, u4_to_frag(asu4(P.f[ks])), sel, mi, ks, fr, fq, kw);
            } else {
                char* dst = qs + (16 * mi + fr) * 272 + fq * 16;
#pragma unroll
                for (int ks = 0; ks < 4; ++ks) *(uint4*)(dst + ks * 64) = asu4(P.f[ks]);
            }
            const float one[4] = {1.f, 1.f, 1.f, 1.f};
#pragma unroll
            for (int q = 0; q < 2; ++q) { const int pr = 2 * w + q; tr_store(vTs, u4_to_frag(asu4(P.v[q])), sel, pr >> 2, pr & 3, fr, fq, one); }
        }
        lds_barrier();
        const size_t tc = (size_t)t0, tn = (size_t)(b * 2048 + (c + 1 < 32 ? c + 1 : 31) * 64);
        const char* cbp = (const char*)(p.proj + 4 * OPB) + tc * (NPR * 2), *cbc = (const char*)p.cbuf + tc * 1024;
        const char* nbq = (const char*)p.mq + tn * 1024, *nbp = (const char*)(p.proj + 3 * OPB) + tn * 1024;
        ASM_LD16(P.o[0], MO.o, cbp, 0); ASM_LD16(P.o[1], MO.o, cbp, 128);
        {
            f32x4 a = nacc * decay;
#pragma unroll
            for (int s2 = 0; s2 < 2; ++s2) a = mfma16(ld8(kTs + (16 * w + fr) * 144 + (s2 * 4 + fq) * 16), ones, a);
            nacc = a;
            if (fr == 0) *(f32x4*)(n_s + 16 * w + 4 * fq) = a;
        }
        {
            bf16x8 vf[2];
#pragma unroll
            for (int s2 = 0; s2 < 2; ++s2) vf[s2] = ld8(vTs + (16 * w + fr) * 144 + (s2 * 4 + fq) * 16);
#pragma unroll
            for (int i = 0; i < 8; ++i) {
                if (i == 0) ASM_LD16(P.cc[0], MO.c, cbc, 0);
                if (i == 1) ASM_LD16(P.cc[1], MO.c, cbc, 128);
                if (i == 2) ASM_LD16(P.f[0], MO.f, nbq, 0);
                if (i == 3) ASM_LD16(P.f[1], MO.f, nbq, 1024);
                if (i == 4) ASM_LD16(P.f[2], MO.f, nbq, 2048);
                if (i == 5) ASM_LD16(P.f[3], MO.f, nbq, 3072);
                if (i == 6) ASM_LD16(P.v[0], MO.v0, nbp, 0);
                if (i == 7) ASM_LD16(P.v[1], MO.v1, nbp, 0);
                f32x4 a = st[i] * decay;
#pragma unroll
                for (int s2 = 0; s2 < 2; ++s2) a = mfma16(ld8(kTs + (16 * i + fr) * 144 + (s2 * 4 + fq) * 16), vf[s2], a);
                st[i] = a;
            }
        }
        lds_barrier();
        {
            const int l = tid >> 3, part = tid & 7;
            const uint4 a0 = *(const uint4*)(qs + l * 272 + part * 32), a1 = *(const uint4*)(qs + l * 272 + part * 32 + 16);
            const unsigned aw[8] = {a0.x, a0.y, a0.z, a0.w, a1.x, a1.y, a1.z, a1.w};
            const float* nn = n_s + 16 * part;
            float s = 0.f;
#pragma unroll
            for (int e = 0; e < 8; ++e) s += bflo(aw[e]) * nn[2 * e] + bfhi(aw[e]) * nn[2 * e + 1];
            s = grp8_sum(s);
            if (part == 0) den_s[l] = fmaxf(fabsf(s), emn);
        }
        lds_barrier();
        {
            bf16x8 sp[4];
#pragma unroll
            for (int s = 0; s < 4; ++s) sp[s] = state_pack(st[2 * s], st[2 * s + 1]);
#pragma unroll
            for (int i = 0; i < 4; ++i) {
                f32x4 a = (f32x4){0.f, 0.f, 0.f, 0.f};
                const char* qrow = qs + (16 * i + fr) * 272;
#pragma unroll
                for (int s = 0; s < 4; ++s) {
                    const uint2 lo = *(const uint2*)(qrow + (32 * s + 4 * fq) * 2), hi = *(const uint2*)(qrow + (32 * s + 16 + 4 * fq) * 2);
                    a = mfma16(sp[s], mk8(lo, hi), a);
                }
                const float rd = rcp_(den_s[16 * i + fr]);
                *(uint2*)(Os + (16 * i + fr) * 272 + (16 * w + 4 * fq) * 2) = make_uint2(pk2(a[0] * rd, a[1] * rd), pk2(a[2] * rd, a[3] * rd));
            }
        }
        lds_barrier();
        {
            const int l = tid >> 3, part = tid & 7;
            const uint4 o0 = *(const uint4*)(Os + l * 272 + part * 16), o1 = *(const uint4*)(Os + l * 272 + 128 + part * 16);
            const unsigned ow[8] = {o0.x, o0.y, o0.z, o0.w, o1.x, o1.y, o1.z, o1.w};
            float x[16], s = 0.f;
#pragma unroll
            for (int e = 0; e < 8; ++e) { x[2 * e] = bflo(ow[e]); x[2 * e + 1] = bfhi(ow[e]); s += x[2 * e] + x[2 * e + 1]; }
            const float mu = grp8_sum(s) * (1.f / 128.f);
            float q = 0.f;
#pragma unroll
            for (int e = 0; e < 16; ++e) { x[e] -= mu; q += x[e] * x[e]; }
            float rstd = rsqrtf(grp8_sum(q) * (1.f / 128.f) + EPSN);
            asm volatile("s_waitcnt vmcnt(6)" : "+v"(P.o[0]), "+v"(P.o[1]), "+v"(P.cc[0]), "+v"(P.cc[1]), "+v"(rstd) :: "memory");
            const unsigned gw[8] = {P.o[0][0], P.o[0][1], P.o[0][2], P.o[0][3], P.o[1][0], P.o[1][1], P.o[1][2], P.o[1][3]};
            const unsigned cw[8] = {P.cc[0][0], P.cc[0][1], P.cc[0][2], P.cc[0][3], P.cc[1][0], P.cc[1][1], P.cc[1][2], P.cc[1][3]};
            const float* gn = gn_s + 8 * part;
            const float* sk = sk_s + 8 * part;
            unsigned yo[8];
#pragma unroll
            for (int e = 0; e < 8; ++e) {
                const int ci = (e < 4 ? 0 : 56) + 2 * e;
                const float ya = sigmoidf_(bflo(gw[e])) * (x[2 * e] * rstd * gn[ci] + sk[ci] * bflo(cw[e]));
                const float yb_ = sigmoidf_(bfhi(gw[e])) * (x[2 * e + 1] * rstd * gn[ci + 1] + sk[ci + 1] * bfhi(cw[e]));
                yo[e] = pk2(ya, yb_);
            }
            asm volatile("" : "+v"(yo[0]), "+v"(yo[1]), "+v"(yo[2]), "+v"(yo[3]), "+v"(yo[4]), "+v"(yo[5]), "+v"(yo[6]), "+v"(yo[7]));
            ml_retire_fv<0>(P);
            uint4* yp = (uint4*)(p.yb + (size_t)(t0 + l) * 1024 + 512 + h * 128 + 8 * part);
            yp[0] = make_uint4(yo[0], yo[1], yo[2], yo[3]);
            yp[8] = make_uint4(yo[4], yo[5], yo[6], yo[7]);
        }
    }
}
DEVI void st_recur(const Params& p, char* smem) {
    if (blockIdx.x >= 128 || gridDim.x <= 128) {
        const int bid = gridDim.x > 128 ? (int)blockIdx.x - 128 : (int)blockIdx.x, nb = gridDim.x > 128 ? (int)gridDim.x - 128 : (int)gridDim.x;
        st_prep_w2(p, smem, bid, nb);
        st_prep_wsub(p, smem, bid, nb);
        st_prep_tables(p, bid, nb);
        if (gridDim.x > 128) return;
    }
    for (int bi = blockIdx.x; bi < 128; bi += gridDim.x) {
        const int kind = bi & 1, h = (bi >> 1) & 3, b = bi >> 3;
        if (kind == 0) ret_block(p, smem, b, h);
        else mlstm_block(p, smem, b, h);
        __syncthreads();
    }
}

constexpr float KEY_BIAS = 64.f;
DEVI int f2key(float f) { const int b = __float_as_int(f); return b ^ ((b >> 31) & 0x7fffffff); }
DEVI float key2f(int k) { return __int_as_float(k ^ ((k >> 31) & 0x7fffffff)); }
template <int N> DEVI void bsort_desc(int (&v)[N]) {
#pragma unroll
    for (int k = 2; k <= N; k <<= 1)
#pragma unroll
        for (int j = k >> 1; j > 0; j >>= 1)
#pragma unroll
            for (int i = 0; i < N; ++i) {
                const int l = i ^ j;
                if (l > i) {
                    const int a = v[i], b = v[l];
                    const int mx = a > b ? a : b, mn = a > b ? b : a;
                    if ((i & k) == 0) { v[i] = mx; v[l] = mn; } else { v[i] = mn; v[l] = mx; }
                }
            }
}
template <int N> DEVI void bmerge_desc(int (&v)[N]) {
#pragma unroll
    for (int j = N >> 1; j > 0; j >>= 1)
#pragma unroll
        for (int i = 0; i < N; ++i) {
            const int l = i ^ j;
            if (l > i) { const int a = v[i], b = v[l]; v[i] = a > b ? a : b; v[l] = a > b ? b : a; }
        }
}
DEVI void xmerge16(int (&v)[16], int mask) {
    int o[16];
#pragma unroll
    for (int i = 0; i < 16; ++i) o[i] = __shfl_xor(v[15 - i], mask);
#pragma unroll
    for (int i = 0; i < 16; ++i) v[i] = v[i] > o[i] ? v[i] : o[i];
    bmerge_desc<16>(v);
}
__device__ const unsigned char cand_tab[52] = {
    0x00, 0x01, 0x02, 0x03, 0x04, 0x05, 0x06, 0x07, 0x08, 0x09, 0x0a, 0x0b, 0x0c, 0x0d, 0x0e, 0x0f,
    0x10, 0x11, 0x12, 0x13, 0x14, 0x15, 0x16, 0x17, 0x20, 0x21, 0x22, 0x23, 0x24, 0x30, 0x31, 0x32, 0x33,
    0x40, 0x41, 0x42, 0x50, 0x51, 0x60, 0x61, 0x70, 0x71, 0x80, 0x90, 0xa0, 0xb0, 0xc0, 0xd0, 0xe0, 0xf0, 0xff, 0xff};
constexpr int H_A = 256 * 64, H_B = 256 * 64, H_STAGE = H_A + H_B;
constexpr int H_LIST = 3 * H_STAGE;
DEVI void glds16(const void* g, char* l) {
    __builtin_amdgcn_global_load_lds((const __attribute__((address_space(1))) unsigned*)g, (__attribute__((address_space(3))) unsigned*)l, 16, 0, 0);
}
DEVI void gemm3_topk_tile(const Params& p, int m0, int h, char* smem) {
    const int tid = stid(), lane = tid & 63, w = tid >> 6, wt = w >> 1, wp = w & 1, fr = lane & 15, fq = lane >> 4;
    i32x4 acc[4][8];
#pragma unroll
    for (int i = 0; i < 4; ++i)
#pragma unroll
        for (int j = 0; j < 8; ++j) acc[i][j] = (i32x4){0, 0, 0, 0};
    const int r16 = lane >> 2, csrc = (lane & 3) ^ ((r16 >> 2) & 3);
    const unsigned char* srcA = p.xq + (size_t)(m0 + w * 32 + r16) * 1024 + csrc * 16;
    const unsigned char* srcB = (const unsigned char*)p.Wsubq + ((size_t)h * 256 + w * 32 + r16) * 1024 + csrc * 16;
    char* dstA = smem + (w * 32) * 64 + lane * 16;
    char* dstB = smem + H_A + (w * 32) * 64 + lane * 16;
    auto issue = [&](int kt, int buf) {
#pragma unroll
        for (int q = 0; q < 2; ++q) glds16(srcA + (size_t)q * 16 * 1024 + kt * 64, dstA + buf * H_STAGE + q * 1024);
#pragma unroll
        for (int q = 0; q < 2; ++q) glds16(srcB + (size_t)q * 16 * 1024 + kt * 64, dstB + buf * H_STAGE + q * 1024);
    };
    const int rdoff = fr * 64 + ((fq ^ ((fr >> 2) & 3)) * 16);
    issue(0, 0);
    issue(1, 1);
    asm volatile("s_waitcnt vmcnt(4)" ::: "memory");
    __builtin_amdgcn_s_barrier();
    int buf = 0;
#pragma unroll 1
    for (int kt = 0; kt < 16; ++kt) {
        const int b2 = buf >= 1 ? buf - 1 : 2;
        if (kt + 2 < 16) issue(kt + 2, b2);
        const char* As = smem + buf * H_STAGE + (wt * 64) * 64 + rdoff;
        const char* Bs = smem + buf * H_STAGE + H_A + (wp * 128) * 64 + rdoff;
        i32x4 a[4];
#pragma unroll
        for (int i = 0; i < 4; ++i) a[i] = *(const i32x4*)(As + (16 * i) * 64);
#pragma unroll
        for (int jg = 0; jg < 2; ++jg) {
            i32x4 b[4];
#pragma unroll
            for (int j = 0; j < 4; ++j) b[j] = *(const i32x4*)(Bs + (16 * (4 * jg + j)) * 64);
#pragma unroll
            for (int i = 0; i < 4; ++i)
#pragma unroll
                for (int j = 0; j < 4; ++j) acc[i][4 * jg + j] = __builtin_amdgcn_mfma_i32_16x16x64_i8(b[j], a[i], acc[i][4 * jg + j], 0, 0, 0);
        }
        if (kt + 2 < 16) asm volatile("s_waitcnt vmcnt(4)" ::: "memory");
        else asm volatile("s_waitcnt vmcnt(0)" ::: "memory");
        __builtin_amdgcn_s_barrier();
        buf = buf == 2 ? 0 : buf + 1;
    }
    float4 ws[8];
#pragma unroll
    for (int j = 0; j < 8; ++j) ws[j] = *(const float4*)(p.wsc + h * 256 + wp * 128 + 16 * j + 4 * fq);
    int* LX = (int*)(smem + H_LIST);
#pragma unroll
    for (int i = 0; i < 4; ++i) {
        const int tl = 64 * wt + 16 * i + fr;
        const float rs = rs2_of(p.rs2p, m0 + tl) * ZQ_SCALE;
        int ka[16], kb[16];
#pragma unroll
        for (int jj = 0; jj < 4; ++jj)
#pragma unroll
            for (int r = 0; r < 4; ++r) {
                const float sa = r == 0 ? ws[jj].x : r == 1 ? ws[jj].y : r == 2 ? ws[jj].z : ws[jj].w;
                const float sb = r == 0 ? ws[4 + jj].x : r == 1 ? ws[4 + jj].y : r == 2 ? ws[4 + jj].z : ws[4 + jj].w;
                ka[jj * 4 + r] = (__float_as_int((float)acc[i][jj][r] * (sa * rs) + KEY_BIAS) & ~127) | (16 * jj + 4 * fq + r);
                kb[jj * 4 + r] = (__float_as_int((float)acc[i][4 + jj][r] * (sb * rs) + KEY_BIAS) & ~127) | (16 * (jj + 4) + 4 * fq + r);
            }
        bsort_desc<16>(ka);
        bsort_desc<16>(kb);
#pragma unroll
        for (int q = 0; q < 16; ++q) ka[q] = ka[q] > kb[15 - q] ? ka[q] : kb[15 - q];
        bmerge_desc<16>(ka);
        xmerge16(ka, 16);
        xmerge16(ka, 32);
        const int k0 = fq == 0 ? ka[0] : fq == 1 ? ka[4] : fq == 2 ? ka[8] : ka[12];
        const int k1 = fq == 0 ? ka[1] : fq == 1 ? ka[5] : fq == 2 ? ka[9] : ka[13];
        const int k2 = fq == 0 ? ka[2] : fq == 1 ? ka[6] : fq == 2 ? ka[10] : ka[14];
        const int k3 = fq == 0 ? ka[3] : fq == 1 ? ka[7] : fq == 2 ? ka[11] : ka[15];
        *(int4*)(LX + tl * 32 + wp * 16 + 4 * fq) = make_int4(k0, k1, k2, k3);
    }
    __syncthreads();
#pragma unroll
    for (int i2 = 0; i2 < 2; ++i2) {
        const int tl = 32 * w + 16 * i2 + fr, t = m0 + tl;
        const int* L = LX + tl * 32;
        const unsigned long long clo = fq == 0 ? 0x0706050403020100ull : fq == 1 ? 0x14131211100f0e0dull : fq == 2 ? 0x4033323130242322ull : 0xc0b0a09080717061ull;
        const unsigned long long chi = fq == 0 ? 0x0c0b0a0908ull : fq == 1 ? 0x2120171615ull : fq == 2 ? 0x6051504241ull : 0xfffff0e0d0ull;
        int c[16];
#pragma unroll
        for (int s = 0; s < 13; ++s) {
            const int ab = (int)((s < 8 ? (clo >> (8 * s)) : (chi >> (8 * (s - 8)))) & 0xffull);
            const int k1 = L[ab >> 4], k2 = L[16 + (ab & 15)];
            const float v = (__int_as_float(k1 & ~127) - KEY_BIAS) + (__int_as_float(k2 & ~127) - KEY_BIAS);
            c[s] = (f2key(v) & ~0x3fff) | ((k1 & 127) << 7) | (k2 & 127);
        }
        c[13] = c[14] = c[15] = (int)0x80000000;
        bsort_desc<16>(c);
        xmerge16(c, 16);
        xmerge16(c, 32);
        const float vmax = key2f(c[0] & ~0x3fff);
        float e[16], sum = 0.f;
#pragma unroll
        for (int q = 0; q < 16; ++q) { e[q] = fexp_(key2f(c[q] & ~0x3fff) - vmax); sum += e[q]; }
        const float inv = rcp_(sum);
        int ce[4]; float ge[4];
#pragma unroll
        for (int q = 0; q < 4; ++q) {
            const int cq = fq == 0 ? c[q] : fq == 1 ? c[4 + q] : fq == 2 ? c[8 + q] : c[12 + q];
            const float eq = fq == 0 ? e[q] : fq == 1 ? e[4 + q] : fq == 2 ? e[8 + q] : e[12 + q];
            ce[q] = ((cq >> 7) & 127) * 128 + (cq & 127);
            ge[q] = eq * inv;
        }
        *(uint2*)(p.eperm + (size_t)t * 128 + h * 16 + 4 * fq) = make_uint2((unsigned)ce[0] | ((unsigned)ce[1] << 16), (unsigned)ce[2] | ((unsigned)ce[3] << 16));
        *(float4*)(p.gate + (size_t)t * 128 + h * 16 + 4 * fq) = make_float4(ge[0], ge[1], ge[2], ge[3]);
    }
    __syncthreads();
}
DEVI void st_gemm3_topk(const Params& p, char* smem) {
    for (int it = blockIdx.x; it < 128 * 8; it += gridDim.x) gemm3_topk_tile(p, (it >> 3) * 256, it & 7, smem);
}

#define XB_TMO      128
#define XB_XCNT(j)  (256  + 64 * (j))
#define XB_XSUB(j)  (1280 + 64 * (j))
#define XB_XGEN(j)  (2304 + 64 * (j))
#define XB_TOP      3328
#define XB_TOPGEN   3392
#define XCD_BAR_WORDS 3456
#define XB_SPIN_CAP (1u << 20)
#define LAS __attribute__((address_space(3)))
DEVI unsigned xb_ld(unsigned* p) { return __hip_atomic_load(p, __ATOMIC_RELAXED, __HIP_MEMORY_SCOPE_AGENT); }
DEVI unsigned xb_add(unsigned* p, unsigned v) { return __hip_atomic_fetch_add(p, v, __ATOMIC_RELAXED, __HIP_MEMORY_SCOPE_AGENT); }
DEVI unsigned xb_xcc_id() { return (unsigned)__builtin_amdgcn_s_getreg((3 << 11) | 20) & 0xFu; }
#define XB_SPIN(cond, bar) do { unsigned _sp = 0; while (cond) { __builtin_amdgcn_s_sleep(1); \
    if ((++_sp & 255u) == 0u) { if (xb_ld(&(bar)[XB_TMO])) break; if (_sp > XB_SPIN_CAP) { atomicAdd(&(bar)[XB_TMO], 1u); break; } } } } while (0)
struct XcdBarrier { unsigned* bar; unsigned x; volatile LAS unsigned* st; };
DEVI XcdBarrier xcd_barrier_post(unsigned* bar, volatile LAS unsigned* st) {
    XcdBarrier b; b.bar = bar; b.x = xb_xcc_id(); b.st = st;
    if (stid() == 0) (void)xb_add(&bar[XB_XCNT(b.x)], 1u);
    return b;
}
DEVI void xcd_barrier_complete(unsigned* bar, unsigned x, unsigned& nloc, unsigned& nx) {
    const unsigned G = gridDim.x * gridDim.y * gridDim.z;
    unsigned sum, cnt, mine, sp = 0u;
    for (;;) {
        sum = 0u; cnt = 0u; mine = 0u;
#pragma unroll
        for (unsigned j = 0; j < 16; ++j) { const unsigned c = xb_ld(&bar[XB_XCNT(j)]); sum += c; cnt += (c > 0u) ? 1u : 0u; mine = (j == x) ? c : mine; }
        if (sum == G) break;
        __builtin_amdgcn_s_sleep(1);
        if ((++sp & 255u) == 0u) { if (xb_ld(&bar[XB_TMO])) break; if (sp > XB_SPIN_CAP) { atomicAdd(&bar[XB_TMO], 1u); break; } }
    }
    nloc = mine > 0u ? mine : 1u; nx = cnt > 0u ? cnt : 1u;
}
DEVI void xcd_barrier(const XcdBarrier& b) {
    asm volatile("s_waitcnt vmcnt(0)" ::: "memory");
    __syncthreads();
    if (stid() == 0) {
        unsigned* bar = b.bar;
        __builtin_amdgcn_s_waitcnt(0);
        unsigned nloc = b.st[0], nx = b.st[1];
        if (nloc == 0u) { xcd_barrier_complete(bar, b.x, nloc, nx); b.st[0] = nloc; b.st[1] = nx; }
        const unsigned old = xb_add(&bar[XB_XSUB(b.x)], 1u);
        const unsigned gen = old / nloc;
        if (old + 1u == (gen + 1u) * nloc) {
            __builtin_amdgcn_fence(__ATOMIC_RELEASE, "agent");
            asm volatile("s_waitcnt vmcnt(0)" ::: "memory");
            const unsigned og = xb_add(&bar[XB_TOP], 1u);
            const unsigned tg = og / nx;
            if (og + 1u == (tg + 1u) * nx) xb_add(&bar[XB_TOPGEN], 1u);
            else XB_SPIN(xb_ld(&bar[XB_TOPGEN]) == tg, bar);
            __builtin_amdgcn_fence(__ATOMIC_ACQUIRE, "agent");
            xb_add(&bar[XB_XGEN(b.x)], 1u);
            asm volatile("s_waitcnt vmcnt(0)" ::: "memory");
        } else {
            XB_SPIN(xb_ld(&bar[XB_XGEN(b.x)]) == gen, bar);
            __builtin_amdgcn_fence(__ATOMIC_ACQUIRE, "agent");
            asm volatile("s_waitcnt vmcnt(0)" ::: "memory");
        }
    }
    __syncthreads();
}

#define CTR_A(x) (XCD_BAR_WORDS + 64 * (x))
#define CTR_B(x) (XCD_BAR_WORDS + 512 + 64 * (x))
#define CTL_WORDS (XCD_BAR_WORDS + 1024)
typedef float f32x2 __attribute__((ext_vector_type(2)));
DEVI float ub(unsigned w, int n) { return (float)((w >> (8 * n)) & 0xffu); }
DEVI float gelu_erf(float v) {
    const float av = fabsf(v), t = rcp_(av * 0.2316418882f + 1.0f);
    float q = t * 0.5307027145f + (-0.7265760135f);
    q = q * t + 0.7107068705f; q = q * t + (-0.142248368f); q = q * t + 0.127414796f; q = q * t;
    const float e = __builtin_amdgcn_exp2f((v * v) * (-0.72134752044f));
    const float m = v * (q * e);
    return v < 0.f ? m : v - m;
}
struct ExpMeta { uint4 e[2]; uint4 xa; float sc; };
struct ExpRows { uint4 r[16]; unsigned x1; };

template <int PHASE> DEVI void exp_load_meta(const Params& p, ExpMeta& m, int t, int x, int lane) {
    const uint4* ep = (const uint4*)(p.eperm + (size_t)t * 128 + (lane >> 3) * 16);
    m.e[0] = ep[0];
    m.e[1] = ep[1];
    if (PHASE == 0) m.xa = *(const uint4*)(p.xq + (size_t)t * 1024 + 128 * x + 16 * (lane & 7));
    else { m.xa = *(const uint4*)(p.aq + (size_t)t * 128 + (lane >> 3) * 16); m.sc = p.asc[t]; }
}
template <int PHASE> DEVI void exp_issue(const Params& p, const ExpMeta& m, ExpRows& R, int t, int x, int lane) {
    const unsigned char* base = (PHASE == 0 ? p.down_q : p.up_q) + (size_t)x * (16384 * 128) + (lane & 7) * 16;
    const unsigned ew[8] = {m.e[0].x, m.e[0].y, m.e[0].z, m.e[0].w, m.e[1].x, m.e[1].y, m.e[1].z, m.e[1].w};
#pragma unroll
    for (int j = 0; j < 16; ++j) {
        const unsigned ek = (j & 1) ? (ew[j >> 1] >> 16) : (ew[j >> 1] & 0xffffu);
        R.r[j] = *(const uint4*)(base + (size_t)ek * 128);
    }
    if (PHASE == 1) {
        const int col = 128 * x + 16 * (lane & 7) + ((lane & 32) ? 8 : 0) + ((lane & 16) ? 4 : 0) + ((lane & 8) ? 2 : 0);
        R.x1 = *(const unsigned*)(p.x1b + (size_t)t * 1024 + col);
    }
}
DEVI void expA_compute(const Params& p, const ExpMeta& m, const ExpRows& R, int t, int x, int lane) {
    const bool b2 = lane & 4, b1 = lane & 2, b0 = lane & 1;
    int ps[16];
#pragma unroll
    for (int j = 0; j < 16; ++j)
        ps[j] = __builtin_amdgcn_sdot4((int)R.r[j].x, (int)m.xa.x, __builtin_amdgcn_sdot4((int)R.r[j].y, (int)m.xa.y,
                __builtin_amdgcn_sdot4((int)R.r[j].z, (int)m.xa.z, __builtin_amdgcn_sdot4((int)R.r[j].w, (int)m.xa.w, 0, false), false), false), false);
    int q8[8], q4[4], q2[2];
#pragma unroll
    for (int j = 0; j < 8; ++j) { const int snd = b2 ? ps[j] : ps[j + 8], kp = b2 ? ps[j + 8] : ps[j]; q8[j] = kp + dpp_i<DPP_HMIRROR>(snd); }
#pragma unroll
    for (int j = 0; j < 4; ++j) { const int snd = b1 ? q8[j] : q8[j + 4], kp = b1 ? q8[j + 4] : q8[j]; q4[j] = kp + dpp_i<DPP_XOR2>(snd); }
#pragma unroll
    for (int j = 0; j < 2; ++j) { const int snd = b0 ? q4[j] : q4[j + 2], kp = b0 ? q4[j + 2] : q4[j]; q2[j] = kp + dpp_i<DPP_XOR1>(snd); }
    {
        int s0 = q2[0] >> 3, s1 = q2[1] >> 3;
        s0 = s0 > 32767 ? 32767 : (s0 < -32768 ? -32768 : s0);
        s1 = s1 > 32767 ? 32767 : (s1 < -32768 ? -32768 : s1);
        *(unsigned*)(p.part + ((size_t)x * T_TOK + t) * 128 + 2 * lane) = ((unsigned)s0 & 0xffffu) | ((unsigned)s1 << 16);
    }
}
DEVI void expB_compute(const Params& p, const ExpMeta& m, const ExpRows& R, int t, int x, int lane) {
    const bool b5 = lane & 32, b4 = lane & 16, b3 = lane & 8;
    const unsigned pa[4] = {m.xa.x, m.xa.y, m.xa.z, m.xa.w};
    int acc[16];
#pragma unroll
    for (int c = 0; c < 16; ++c) acc[c] = 0;
#pragma unroll
    for (int g = 0; g < 4; ++g) {
        const unsigned r0[4] = {R.r[4 * g].x, R.r[4 * g].y, R.r[4 * g].z, R.r[4 * g].w};
        const unsigned r1[4] = {R.r[4 * g + 1].x, R.r[4 * g + 1].y, R.r[4 * g + 1].z, R.r[4 * g + 1].w};
        const unsigned r2[4] = {R.r[4 * g + 2].x, R.r[4 * g + 2].y, R.r[4 * g + 2].z, R.r[4 * g + 2].w};
        const unsigned r3[4] = {R.r[4 * g + 3].x, R.r[4 * g + 3].y, R.r[4 * g + 3].z, R.r[4 * g + 3].w};
#pragma unroll
        for (int i = 0; i < 4; ++i) {
            const unsigned t0 = __builtin_amdgcn_perm(r1[i], r0[i], 0x05010400u), t1 = __builtin_amdgcn_perm(r1[i], r0[i], 0x07030602u);
            const unsigned t2 = __builtin_amdgcn_perm(r3[i], r2[i], 0x05010400u), t3 = __builtin_amdgcn_perm(r3[i], r2[i], 0x07030602u);
            const unsigned o0 = __builtin_amdgcn_perm(t2, t0, 0x05040100u), o1 = __builtin_amdgcn_perm(t2, t0, 0x07060302u);
            const unsigned o2 = __builtin_amdgcn_perm(t3, t1, 0x05040100u), o3 = __builtin_amdgcn_perm(t3, t1, 0x07060302u);
            acc[4 * i + 0] = __builtin_amdgcn_sdot4((int)o0, (int)pa[g], acc[4 * i + 0], false);
            acc[4 * i + 1] = __builtin_amdgcn_sdot4((int)o1, (int)pa[g], acc[4 * i + 1], false);
            acc[4 * i + 2] = __builtin_amdgcn_sdot4((int)o2, (int)pa[g], acc[4 * i + 2], false);
            acc[4 * i + 3] = __builtin_amdgcn_sdot4((int)o3, (int)pa[g], acc[4 * i + 3], false);
        }
    }
    int q8[8], q4[4], q2[2];
#pragma unroll
    for (int j = 0; j < 8; ++j) {
        const auto r = __builtin_amdgcn_permlane32_swap((unsigned)acc[j], (unsigned)acc[j + 8], false, false);
        q8[j] = (int)r[0] + (int)r[1];
    }
#pragma unroll
    for (int j = 0; j < 4; ++j) {
        const auto r = __builtin_amdgcn_permlane16_swap((unsigned)q8[j], (unsigned)q8[j + 4], false, false);
        q4[j] = (int)r[0] + (int)r[1];
    }
#pragma unroll
    for (int j = 0; j < 2; ++j) { const int snd = b3 ? q4[j] : q4[j + 2], kp = b3 ? q4[j + 2] : q4[j]; q2[j] = kp + dpp_i<DPP_ROR8>(snd); }
    const int col = 128 * x + 16 * (lane & 7) + (b5 ? 8 : 0) + (b4 ? 4 : 0) + (b3 ? 2 : 0);
    *(unsigned*)(p.proj + (size_t)t * 1024 + col) = pk2(bflo(R.x1) + (float)q2[0] * m.sc, bfhi(R.x1) + (float)q2[1] * m.sc);
}
constexpr int EXP_NP = 16;
template <int PHASE>
DEVI void exp_chunk(const Params& p, int tb, int x, int lane) {
    ExpMeta mA, mB, nA, nB;
    ExpRows rA, rB;
    exp_load_meta<PHASE>(p, mA, tb, x, lane);
    exp_load_meta<PHASE>(p, mB, tb + 1, x, lane);
    exp_issue<PHASE>(p, mA, rA, tb, x, lane);
    exp_issue<PHASE>(p, mB, rB, tb + 1, x, lane);
    exp_load_meta<PHASE>(p, nA, tb + 2, x, lane);
    exp_load_meta<PHASE>(p, nB, tb + 3, x, lane);
#pragma unroll 1
    for (int i = 0; i < EXP_NP; ++i) {
        const int tA = tb + 2 * i, tB = tA + 1;
        if (PHASE == 0) expA_compute(p, mA, rA, tA, x, lane); else expB_compute(p, mA, rA, tA, x, lane);
        if (i < EXP_NP - 1) {
            mA = nA;
            exp_issue<PHASE>(p, mA, rA, tA + 2, x, lane);
            if (i < EXP_NP - 2) exp_load_meta<PHASE>(p, nA, tA + 4, x, lane);
        }
        if (PHASE == 0) expA_compute(p, mB, rB, tB, x, lane); else expB_compute(p, mB, rB, tB, x, lane);
        if (i < EXP_NP - 1) {
            mB = nB;
            exp_issue<PHASE>(p, mB, rB, tB + 2, x, lane);
            if (i < EXP_NP - 2) exp_load_meta<PHASE>(p, nB, tB + 4, x, lane);
        }
    }
}
template <int PHASE>
DEVI void st_expAB(const Params& p, char* smem) {
    const int tid = stid(), lane = tid & 63, wid = tid >> 6;
    volatile int* cs = (volatile int*)smem;
    const unsigned myx = xb_xcc_id() & 7u;
    constexpr int NCH = T_TOK / (2 * EXP_NP * NW);
    for (int si = 0; si < 8; ++si) {
        const int x = (int)((myx + si) & 7u);
        unsigned* ctr = &p.bar[PHASE == 0 ? CTR_A(x) : CTR_B(x)];
        if (tid == 0) cs[0] = (int)xb_add(ctr, 1u);
        __syncthreads();
        int chunk = cs[0];
        __syncthreads();
        while (chunk < NCH) {
            int nxt = 0;
            if (tid == 0) nxt = (int)xb_add(ctr, 1u);
            exp_chunk<PHASE>(p, chunk * (2 * EXP_NP * NW) + wid * (2 * EXP_NP), x, lane);
            if (tid == 0) cs[0] = nxt;
            __syncthreads();
            chunk = cs[0];
            __syncthreads();
        }
    }
}
DEVI void st_expA2(const Params& p) {
    const int lane = stid() & 63, wid = stid() >> 6;
    for (int t0 = (blockIdx.x * NW + wid) * 2; t0 < T_TOK; t0 += gridDim.x * NW * 2) {
        unsigned pv[2][8], ew[2];
        float2 g[2];
        float xs[2];
#pragma unroll
        for (int q = 0; q < 2; ++q) {
            const int t = t0 + q;
#pragma unroll
            for (int x = 0; x < 8; ++x) pv[q][x] = *(const unsigned*)(p.part + ((size_t)x * T_TOK + t) * 128 + 2 * lane);
            ew[q] = *(const unsigned*)(p.eperm + (size_t)t * 128 + 2 * lane);
            g[q] = *(const float2*)(p.gate + (size_t)t * 128 + 2 * lane);
            xs[q] = rs2_of(p.rs2p, t) * (8.f * ZQ_SCALE);
        }
        float ds[2][2], us[2][2];
#pragma unroll
        for (int q = 0; q < 2; ++q) {
            const int ea = (int)(ew[q] & 0xffffu), eb = (int)(ew[q] >> 16);
            ds[q][0] = p.dscale[ea]; ds[q][1] = p.dscale[eb]; us[q][0] = p.uscale[ea]; us[q][1] = p.uscale[eb];
        }
#pragma unroll
        for (int q = 0; q < 2; ++q) {
            const int t = t0 + q;
            int s0 = 0, s1 = 0;
#pragma unroll
            for (int x = 0; x < 8; ++x) { s0 += (int)(short)(pv[q][x] & 0xffffu); s1 += (int)pv[q][x] >> 16; }
            const float a0 = g[q].x * gelu_erf((float)s0 * xs[q] * ds[q][0]) * us[q][0];
            const float a1 = g[q].y * gelu_erf((float)s1 * xs[q] * ds[q][1]) * us[q][1];
            const float amax = wave_max(fmaxf(fabsf(a0), fabsf(a1)));
            const float inv = amax > 0.f ? 127.f * rcp_(amax) : 0.f;
            const unsigned q0 = (unsigned)((int)rintf(a0 * inv) & 255), q1 = (unsigned)((int)rintf(a1 * inv) & 255);
            *(unsigned short*)(p.aq + (size_t)t * 128 + 2 * lane) = (unsigned short)(q0 | (q1 << 8));
            if (lane == 0) p.asc[t] = amax * (1.f / 127.f);
        }
    }
}
DEVI void st_expC(const Params& p) {
    const int lane = stid() & 63, wid = stid() >> 6;
    for (int t0 = (blockIdx.x * NW + wid) * 2; t0 < T_TOK; t0 += gridDim.x * NW * 2) {
        uint2 u[2][4];
#pragma unroll
        for (int q = 0; q < 2; ++q) {
            const uint2* row = (const uint2*)(p.proj + (size_t)(t0 + q) * 1024);
#pragma unroll
            for (int j = 0; j < 4; ++j) u[q][j] = row[lane + 64 * j];
        }
#pragma unroll
        for (int q = 0; q < 2; ++q) {
            float4 v[4];
            float ss = 0.f;
#pragma unroll
            for (int j = 0; j < 4; ++j) {
                v[j] = make_float4(bflo(u[q][j].x), bfhi(u[q][j].x), bflo(u[q][j].y), bfhi(u[q][j].y));
                ss += v[j].x * v[j].x + v[j].y * v[j].y + v[j].z * v[j].z + v[j].w * v[j].w;
            }
            ss = wave_sum(ss);
            const float rf = rsqrtf(ss * (1.f / 1024.f) + EPSN);
            float4* orow = (float4*)(p.out + (size_t)(t0 + q) * 1024);
#pragma unroll
            for (int j = 0; j < 4; ++j) {
                const float4 g = *(const float4*)(p.final_g + (lane + 64 * j) * 4);
                orow[lane + 64 * j] = make_float4(v[j].x * rf * g.x, v[j].y * rf * g.y, v[j].z * rf * g.z, v[j].w * rf * g.w);
            }
        }
    }
}

constexpr int LDS_BYTES = 147456;
constexpr int LDS_BARW = LDS_BYTES - 16;
extern __shared__ __attribute__((aligned(16))) char smem_dyn[];
__global__ void __launch_bounds__(NTHR, 2) mega_fwd(Params p) {
    cg::grid_group grid = cg::this_grid();
    volatile LAS unsigned* bst = (volatile LAS unsigned*)(LAS char*)(smem_dyn + LDS_BARW);
    if (stid() < 4) bst[stid()] = 0u;
    __syncthreads();
    XcdBarrier bar = xcd_barrier_post(p.bar, bst);
    st_prep_misc(p);
    st_prep_w1(p, smem_dyn);
    st_prep_x(p, smem_dyn);
    if (p.pad_[0] == 0x7fffabcd) grid.sync();
    xcd_barrier(bar);
    st_gemm8<EpiProj8, PG8_ALIGN>(p.xb, p.W1t, NPJ, 1024, smem_dyn, EpiProj8{p.proj, p.rs1, p.rope_cos, p.rope_sin});
    xcd_barrier(bar);
    st_conv_qk(p, smem_dyn);
    xcd_barrier(bar);
    st_recur(p, smem_dyn);
    xcd_barrier(bar);
    st_gemm8<EpiX18, PG8_ALIGN>(p.yb, p.W2t, 1024, 1024, smem_dyn, EpiX18{p.x, p.x1b, p.xq, p.rs2p, p.norm2_g});
    xcd_barrier(bar);
    st_gemm3_topk(p, smem_dyn);
    xcd_barrier(bar);
    st_expAB<0>(p, smem_dyn);
    xcd_barrier(bar);
    st_expA2(p);
    xcd_barrier(bar);
    st_expAB<1>(p, smem_dyn);
    xcd_barrier(bar);
    st_expC(p);
}

extern "C" void kernel_launch(void* const* d_in, const int* in_sizes, int n_in, void* d_out, int out_size, void* d_ws, size_t ws_size,
                              hipStream_t stream) {
    Params p{};
    const float* const* in = (const float* const*)d_in;
    p.x = in[0]; p.norm1_g = in[1]; p.w_in = in[2]; p.ret_norm_g = in[3]; p.m_conv_w = in[4]; p.m_conv_b = in[5]; p.m_wq = in[6]; p.m_wk = in[7];
    p.m_b_i = in[8]; p.m_b_f = in[9]; p.m_norm_g = in[10]; p.m_skip = in[11]; p.w_out = in[12]; p.norm2_g = in[13]; p.peer_wq = in[14];
    p.peer_keys = in[15]; p.peer_down = in[16]; p.peer_up = in[17]; p.final_g = in[18];
    p.out = (float*)d_out;
    char* ws = (char*)d_ws;
    size_t off = 0;
    auto take = [&](size_t bytes) { char* r = ws + off; off += (bytes + 255) & ~(size_t)255; return r; };
    p.proj = (bf16_t*)take((size_t)T_TOK * NPJ * 2);
    p.xb = (bf16_t*)take((size_t)T_TOK * 1024 * 2);
    p.yb = p.xb;
    p.gate = (float*)(ws + (size_t)T_TOK * 2048 * 4);
    p.mq = (bf16_t*)take((size_t)T_TOK * 512 * 2);
    p.mk = (bf16_t*)take((size_t)T_TOK * 512 * 2);
    p.x1b = p.mq;
    p.cbuf = (bf16_t*)take((size_t)T_TOK * 512 * 2);
    p.eperm = (unsigned short*)p.cbuf;
    p.down_q = (unsigned char*)take((size_t)16384 * 1024);
    p.up_q = (unsigned char*)take((size_t)16384 * 1024);
    p.dscale = (float*)take(16384 * 4);
    p.uscale = (float*)take(16384 * 4);
    p.bar = (unsigned*)take(CTL_WORDS * 4);
    p.xq = (unsigned char*)take((size_t)T_TOK * 1024);
    p.asc = (float*)take(T_TOK * 4);
    p.aq = (unsigned char*)take((size_t)T_TOK * 128);
    p.part = (short*)(ws + (size_t)T_TOK * 1024 * 4);
    p.W1t = (bf16_t*)take((size_t)NPJ * 1024 * 2);
    p.W2t = (bf16_t*)take((size_t)1024 * 1024 * 2);
    p.Wsubq = (signed char*)take((size_t)2048 * 1024);
    p.wsc = (float*)take(2048 * 4);
    p.Wqt = (bf16_t*)take(4 * 128 * 128 * 2);
    p.Wkt = (bf16_t*)take(4 * 128 * 128 * 2);
    p.rs1 = (float*)take(T_TOK * 4);
    p.rs2p = (float*)take((size_t)T_TOK * 16 * 4);
    p.ipre = (float*)take(T_TOK * 4 * 4);
    p.logf = (float*)take(T_TOK * 4 * 4);
    p.rope_cos = (float*)take(2048 * 64 * 4);
    p.rope_sin = (float*)take(2048 * 64 * 4);
    if (off > ws_size) { fprintf(stderr, "kernel_launch: workspace too small (%zu > %zu)\n", off, ws_size); return; }

    static int grid_blocks = 0;
    if (!grid_blocks) {
        int dev = 0, cus = 0, per_cu = 0;
        (void)hipGetDevice(&dev);
        (void)hipDeviceGetAttribute(&cus, hipDeviceAttributeMultiprocessorCount, dev);
        (void)hipFuncSetAttribute((const void*)mega_fwd, hipFuncAttributeMaxDynamicSharedMemorySize, LDS_BYTES);
        (void)hipOccupancyMaxActiveBlocksPerMultiprocessor(&per_cu, (const void*)mega_fwd, NTHR, LDS_BYTES);
        if (per_cu > 1) per_cu = 1;
        if (per_cu < 1) per_cu = 1;
        grid_blocks = cus * per_cu;
    }
    (void)hipMemsetAsync(p.bar, 0, CTL_WORDS * 4, stream);
    void* args[] = {&p};
    hipError_t e = hipLaunchCooperativeKernel((const void*)mega_fwd, dim3(grid_blocks), dim3(NTHR), args, LDS_BYTES, stream);
    if (e != hipSuccess) fprintf(stderr, "cooperative launch failed: %s (grid %d)\n", hipGetErrorString(e), grid_blocks);
}
```

```cpp
#include <hip/hip_runtime.h>
#include <hip/hip_cooperative_groups.h>
#include <stdint.h>
#include <cstdio>
namespace cg = cooperative_groups;

typedef unsigned short bf16_t;
typedef short bf16x8 __attribute__((ext_vector_type(8)));
typedef float f32x4 __attribute__((ext_vector_type(4)));
typedef int i32x4 __attribute__((ext_vector_type(4)));

#define DEVI __device__ __forceinline__
__device__ __forceinline__ int stid() { int t = (int)threadIdx.x; asm volatile("" : "+v"(t)); return t; }

constexpr int T_TOK = 32768, DM = 1024, NPJ = 3584, DIN = 3592;
constexpr int NPR = 1536;
constexpr size_t OPB = (size_t)T_TOK * 512;
__device__ __forceinline__ size_t blk_off(int t16, int h) { return ((size_t)(((t16 >> 2) * 4 + h) * 4 + (t16 & 3))) * 2048; }
constexpr int NTHR = 512, NW = 8;
constexpr float EPSN = 1e-6f;

struct Params {
    const float *x, *norm1_g, *w_in, *ret_norm_g, *m_conv_w, *m_conv_b, *m_wq, *m_wk, *m_b_i, *m_b_f, *m_norm_g, *m_skip, *w_out,
        *norm2_g, *peer_wq, *peer_keys, *peer_down, *peer_up, *final_g;
    float* out;
    bf16_t *proj, *xb, *yb, *mq, *mk, *x1b, *cbuf, *W1t, *W2t, *Wqt, *Wkt;
    signed char* Wsubq;
    float* wsc;
    unsigned char *down_q, *up_q;
    float *dscale, *uscale, *asc;
    unsigned short* eperm;
    unsigned char* aq;
    short* part;
    unsigned char* xq;
    unsigned* bar;
    float *rs1, *rs2p, *ipre, *logf, *rope_cos, *rope_sin, *gate;
    int pad_[2];
};

DEVI unsigned f2bf_bits(float f) { unsigned u = __float_as_uint(f); return (u + 0x7fffu + ((u >> 16) & 1u)) >> 16; }
DEVI bf16_t f2bf(float f) { return __builtin_bit_cast(bf16_t, (__bf16)f); }
typedef __bf16 bf16x2_t __attribute__((ext_vector_type(2)));
DEVI unsigned pk2(float lo, float hi) { bf16x2_t v = {(__bf16)lo, (__bf16)hi}; return __builtin_bit_cast(unsigned, v); }
DEVI float bflo(unsigned w) { return __uint_as_float(w << 16); }
DEVI float bfhi(unsigned w) { return __uint_as_float(w & 0xffff0000u); }
DEVI float bf2f(bf16_t h) { return __uint_as_float(((unsigned)h) << 16); }
template <int CTRL> DEVI float dpp_f(float v) { return __int_as_float(__builtin_amdgcn_update_dpp(0, __float_as_int(v), CTRL, 0xf, 0xf, false)); }
template <int CTRL> DEVI int dpp_i(int v) { return __builtin_amdgcn_update_dpp(0, v, CTRL, 0xf, 0xf, false); }
constexpr int DPP_XOR1 = 0xB1  , DPP_XOR2 = 0x4E  , DPP_HMIRROR = 0x141  ,
              DPP_MIRROR = 0x140  , DPP_ROR8 = 0x128  ;
DEVI float rl_f(float v, int l) { return __int_as_float(__builtin_amdgcn_readlane(__float_as_int(v), l)); }
DEVI float wave_sum(float v) {
    v += dpp_f<DPP_XOR1>(v); v += dpp_f<DPP_XOR2>(v); v += dpp_f<DPP_HMIRROR>(v); v += dpp_f<DPP_MIRROR>(v);
    return (rl_f(v, 0) + rl_f(v, 16)) + (rl_f(v, 32) + rl_f(v, 48));
}
DEVI float wave_max(float v) {
    v = fmaxf(v, dpp_f<DPP_XOR1>(v)); v = fmaxf(v, dpp_f<DPP_XOR2>(v)); v = fmaxf(v, dpp_f<DPP_HMIRROR>(v)); v = fmaxf(v, dpp_f<DPP_MIRROR>(v));
    return fmaxf(fmaxf(rl_f(v, 0), rl_f(v, 16)), fmaxf(rl_f(v, 32), rl_f(v, 48)));
}
constexpr float ZQ_SCALE = 6.f / 127.f;
DEVI float rs2_of(const float* rs2p, int t) {
    const float4* q = (const float4*)(rs2p + (size_t)t * 16);
    const float4 a = q[0], b = q[1], c = q[2], d = q[3];
    const float ss = ((a.x + a.y) + (a.z + a.w)) + ((b.x + b.y) + (b.z + b.w)) + ((c.x + c.y) + (c.z + c.w)) + ((d.x + d.y) + (d.z + d.w));
    return rsqrtf(ss * (1.f / 1024.f) + EPSN);
}
DEVI f32x4 mfma16(bf16x8 a, bf16x8 b, f32x4 c) { return __builtin_amdgcn_mfma_f32_16x16x32_bf16(a, b, c, 0, 0, 0); }
DEVI bf16x8 ld8(const char* p) { return *reinterpret_cast<const bf16x8*>(p); }
DEVI bf16x8 mk8(uint2 lo, uint2 hi) {
    union { uint4 u; bf16x8 v; } x;
    x.u = make_uint4(lo.x, lo.y, hi.x, hi.y);
    return x.v;
}
DEVI float fexp_(float x) { return __builtin_amdgcn_exp2f(x * 1.4426950408889634f); }
DEVI float rcp_(float x) { return __builtin_amdgcn_rcpf(x); }
DEVI float sigmoidf_(float z) { return rcp_(1.f + fexp_(-z)); }

DEVI void st_prep_misc(const Params& p) {
    const int gtid = blockIdx.x * NTHR + stid(), gsz = gridDim.x * NTHR;
    for (int i = gtid; i < 2048 * 64; i += gsz) {
        const int pos = i >> 6, j = i & 63;
        const float inv = powf(10000.f, -(float)j * (1.f / 64.f));
        const float ang = (float)pos * inv;
        float s, c;
        sincosf(ang, &s, &c);
        p.rope_cos[i] = c;
        p.rope_sin[i] = s;
    }
    for (int i = gtid; i < 4 * 128 * 128; i += gsz) {
        const int h = i >> 14, e = (i >> 7) & 127, d = i & 127;
        p.Wqt[i] = f2bf(p.m_wq[h * 16384 + d * 128 + e]);
        p.Wkt[i] = f2bf(p.m_wk[h * 16384 + d * 128 + e] * 0.08838834764831845f);
    }
}
DEVI void prep_table_row(const Params& p, int row, const float4 (&v)[4], int lane) {
    const bool up = row >= 16384;
    const int e = up ? row - 16384 : row;
    float am = 0.f, ss = 0.f;
#pragma unroll
    for (int i = 0; i < 4; ++i) {
        am = fmaxf(am, fmaxf(fmaxf(fabsf(v[i].x), fabsf(v[i].y)), fmaxf(fabsf(v[i].z), fabsf(v[i].w))));
        ss += v[i].x * v[i].x + v[i].y * v[i].y + v[i].z * v[i].z + v[i].w * v[i].w;
    }
    am = wave_max(am);
    if (up) {
        const float sc = am > 0.f ? am * (1.f / 127.f) : 1.f, inv = am > 0.f ? 127.f * rcp_(am) : 0.f;
        unsigned w[4];
#pragma unroll
        for (int i = 0; i < 4; ++i) {
            const int q0 = (int)rintf(v[i].x * inv), q1 = (int)rintf(v[i].y * inv), q2 = (int)rintf(v[i].z * inv), q3 = (int)rintf(v[i].w * inv);
            w[i] = (unsigned)(q0 & 255) | ((unsigned)(q1 & 255) << 8) | ((unsigned)(q2 & 255) << 16) | ((unsigned)(q3 & 255) << 24);
        }
        *(uint4*)(p.up_q + ((size_t)(lane >> 3) * 16384 + e) * 128 + (lane & 7) * 16) = make_uint4(w[0], w[1], w[2], w[3]);
        if (lane == 0) p.uscale[e] = sc;
    } else {
        ss = wave_sum(ss);
        const float s_rms = 0.36f * sqrtf(ss * (1.f / 1024.f));
        float sc = fminf(am * (1.f / 7.f), s_rms);
        sc = sc > 0.f ? sc : 1.f;
        const float inv = 1.f / sc;
        unsigned w2[2];
#pragma unroll
        for (int g = 0; g < 2; ++g) {
            const float lo[4] = {v[2 * g].x, v[2 * g].y, v[2 * g].z, v[2 * g].w}, hi[4] = {v[2 * g + 1].x, v[2 * g + 1].y, v[2 * g + 1].z, v[2 * g + 1].w};
            unsigned d = 0u;
#pragma unroll
            for (int i = 0; i < 4; ++i) {
                const int ql = (int)fminf(fmaxf(rintf(lo[i] * inv), -7.f), 7.f) + 8, qh = (int)fminf(fmaxf(rintf(hi[i] * inv), -7.f), 7.f) + 8;
                d |= ((unsigned)ql | ((unsigned)qh << 4)) << (8 * i);
            }
            w2[g] = d;
        }
        *(uint2*)(p.down_q + ((size_t)(lane >> 4) * 16384 + e) * 128 + (lane & 15) * 8) = make_uint2(w2[0], w2[1]);
        if (lane == 0) p.dscale[e] = sc;
    }
}
DEVI void st_prep_tables(const Params& p, int bid, int nb) {
    const int lane = stid() & 63, wid = stid() >> 6;
    for (int row = (bid * NW + wid) * 2; row < 32768; row += nb * NW * 2) {
        float4 va[4], vb[4];
        const float4* sa = (const float4*)((row >= 16384 ? p.peer_up + (size_t)(row - 16384) * 1024 : p.peer_down + (size_t)row * 1024) + lane * 16);
        const float4* sb = (const float4*)((row + 1 >= 16384 ? p.peer_up + (size_t)(row + 1 - 16384) * 1024 : p.peer_down + (size_t)(row + 1) * 1024) + lane * 16);
#pragma unroll
        for (int i = 0; i < 4; ++i) { va[i] = sa[i]; vb[i] = sb[i]; }
        prep_table_row(p, row, va, lane);
        prep_table_row(p, row + 1, vb, lane);
    }
}

DEVI void transpose_tile(const float* __restrict__ src, int ld, const float* __restrict__ scale, bf16_t* __restrict__ dst, int K, int k0, int n0,
                         float* tile, bool permqk = false) {
    const int tid = stid();
    {
        const int tx = tid & 63, ty = tid >> 6;
#pragma unroll
        for (int i = 0; i < 4; ++i) {
            const int k = k0 + ty + 8 * i;
            float v = src[(size_t)k * ld + n0 + tx];
            if (scale) v *= scale[k];
            tile[(ty + 8 * i) * 65 + tx] = v;
        }
    }
    __syncthreads();
    {
        const int n = tid >> 3, kq = tid & 7;
        const float a = tile[(4 * kq) * 65 + n], b = tile[(4 * kq + 1) * 65 + n], c = tile[(4 * kq + 2) * 65 + n], d = tile[(4 * kq + 3) * 65 + n];
        int nn = n0 + n;
        if (permqk && nn < 1024) { const int dd = nn & 127; nn = (nn & ~127) + (dd < 64 ? 2 * dd : 2 * (dd - 64) + 1); }
        *(uint2*)(dst + (size_t)nn * K + k0 + 4 * kq) = make_uint2(pk2(a, b), pk2(c, d));
    }
    __syncthreads();
}
DEVI void st_prep_w1(const Params& p, char* smem) {
    float* tile = (float*)smem;
    for (int it = blockIdx.x; it < 56 * 32; it += gridDim.x) transpose_tile(p.w_in, DIN, p.norm1_g, p.W1t, 1024, (it & 31) * 32, (it >> 5) * 64, tile, true);
}
DEVI void st_prep_w2(const Params& p, char* smem, int bid, int nb) {
    float* tile = (float*)smem;
    for (int it = bid; it < 16 * 32; it += nb) transpose_tile(p.w_out, 1024, nullptr, p.W2t, 1024, (it & 31) * 32, (it >> 5) * 64, tile);
}
DEVI void st_prep_wsub(const Params& p, char* smem, int bid, int nb) {
    float* wq_s = (float*)smem;
    float* key_s = wq_s + 64 * 132;
    const int tid = stid(), nl = tid >> 5, kp = tid & 31;
    for (int it = bid; it < 16 * 8; it += nb) {
        const int grp = it >> 3, n0 = (it & 7) * 16;
        __syncthreads();
        {
            const int idx = tid * 4, n = idx >> 7, d = idx & 127;
            *(float4*)(key_s + n * 132 + d) = *(const float4*)(p.peer_keys + ((size_t)grp * 128 + n0 + n) * 128 + d);
        }
        float v0[16], v1[16];
#pragma unroll 1
        for (int kt = 0; kt < 16; ++kt) {
            __syncthreads();
#pragma unroll
            for (int i = 0; i < 4; ++i) {
                const int idx = (tid + 512 * i) * 4, r = idx >> 7, d = idx & 127;
                *(float4*)(wq_s + r * 132 + d) = *(const float4*)(p.peer_wq + (size_t)(kt * 64 + r) * 2048 + grp * 128 + d);
            }
            __syncthreads();
            float a0 = 0.f, a1 = 0.f;
#pragma unroll 8
            for (int d4 = 0; d4 < 32; ++d4) {
                const float4 w0 = *(const float4*)(wq_s + (2 * kp) * 132 + 4 * d4), w1 = *(const float4*)(wq_s + (2 * kp + 1) * 132 + 4 * d4);
                const float4 y = *(const float4*)(key_s + nl * 132 + 4 * d4);
                a0 += w0.x * y.x + w0.y * y.y + w0.z * y.z + w0.w * y.w;
                a1 += w1.x * y.x + w1.y * y.y + w1.z * y.z + w1.w * y.w;
            }
#pragma unroll
            for (int q = 0; q < 16; ++q) if (q == kt) { v0[q] = a0; v1[q] = a1; }
        }
        float am = 0.f;
#pragma unroll
        for (int q = 0; q < 16; ++q) am = fmaxf(am, fmaxf(fabsf(v0[q]), fabsf(v1[q])));
#pragma unroll
        for (int o = 16; o; o >>= 1) am = fmaxf(am, __shfl_xor(am, o));
        const float inv = am > 0.f ? 127.f * rcp_(am) : 0.f;
        signed char* orow = p.Wsubq + (size_t)(grp * 128 + n0 + nl) * 1024 + 2 * kp;
#pragma unroll
        for (int q = 0; q < 16; ++q) {
            const int q0 = (int)rintf(v0[q] * inv), q1 = (int)rintf(v1[q] * inv);
            *(unsigned short*)(orow + 64 * q) = (unsigned short)((q0 & 255) | ((q1 & 255) << 8));
        }
        if (kp == 0) p.wsc[grp * 128 + n0 + nl] = am > 0.f ? am * (1.f / 127.f) : 1.f;
    }
    __syncthreads();
}

DEVI void prep_x_token(const Params& p, const float* Wg_s, int t, const float4 (&v)[4], int lane) {
    float ss = 0.f, g8[8];
#pragma unroll
    for (int g = 0; g < 8; ++g) g8[g] = 0.f;
#pragma unroll
    for (int j = 0; j < 4; ++j) {
        ss += v[j].x * v[j].x + v[j].y * v[j].y + v[j].z * v[j].z + v[j].w * v[j].w;
#pragma unroll
        for (int g = 0; g < 8; ++g) {
            const float4 w = *(const float4*)(Wg_s + g * 1024 + (lane + 64 * j) * 4);
            g8[g] += v[j].x * w.x + v[j].y * w.y + v[j].z * w.z + v[j].w * w.w;
        }
    }
    ss = wave_sum(ss);
    const bool b5 = lane & 32, b4 = lane & 16, b3 = lane & 8;
    float q4[4], q2[2], q1;
#pragma unroll
    for (int j = 0; j < 4; ++j) { const float snd = b5 ? g8[j] : g8[j + 4], kp = b5 ? g8[j + 4] : g8[j]; q4[j] = kp + __shfl_xor(snd, 32); }
#pragma unroll
    for (int j = 0; j < 2; ++j) { const float snd = b4 ? q4[j] : q4[j + 2], kp = b4 ? q4[j + 2] : q4[j]; q2[j] = kp + __shfl_xor(snd, 16); }
    { const float snd = b3 ? q2[0] : q2[1], kp = b3 ? q2[1] : q2[0]; q1 = kp + __shfl_xor(snd, 8); }
    q1 += __shfl_xor(q1, 4);
    q1 += __shfl_xor(q1, 2);
    q1 += __shfl_xor(q1, 1);
    const float rs = rsqrtf(ss * (1.f / 1024.f) + EPSN);
    uint2* o = (uint2*)(p.xb + (size_t)t * 1024);
#pragma unroll
    for (int j = 0; j < 4; ++j) o[lane + 64 * j] = make_uint2(pk2(v[j].x, v[j].y), pk2(v[j].z, v[j].w));
    if (lane == 0) p.rs1[t] = rs;
    if ((lane & 7) == 0) {
        const int gi = (b5 ? 4 : 0) + (b4 ? 2 : 0) + (b3 ? 1 : 0);
        if (gi < 4) p.ipre[t * 4 + gi] = q1 * rs + p.m_b_i[gi];
        else {
            const float z = q1 * rs + p.m_b_f[gi - 4];
            p.logf[t * 4 + gi - 4] = fminf(z, 0.f) - log1pf(fexp_(-fabsf(z)));
        }
    }
}
DEVI void st_prep_x(const Params& p, char* smem) {
    float* Wg_s = (float*)smem;
    for (int i = stid(); i < 8192; i += NTHR) {
        const int k = i >> 3, g = i & 7;
        Wg_s[g * 1024 + k] = p.norm1_g[k] * p.w_in[(size_t)k * DIN + NPJ + g];
    }
    __syncthreads();
    const int lane = stid() & 63, wid = stid() >> 6;
    for (int t = (blockIdx.x * NW + wid) * 4; t < T_TOK; t += gridDim.x * NW * 4) {
        float4 v[4][4];
        const float4* xa = (const float4*)(p.x + (size_t)t * 1024);
#pragma unroll
        for (int q = 0; q < 4; ++q)
#pragma unroll
            for (int j = 0; j < 4; ++j) v[q][j] = xa[256 * q + lane + 64 * j];
#pragma unroll
        for (int q = 0; q < 4; ++q) prep_x_token(p, Wg_s, t + q, v[q], lane);
    }
    __syncthreads();
}

namespace pg8 {
#define PG8_LAS __attribute__((address_space(3)))
typedef unsigned short bf16_t;
typedef short bf16x8 __attribute__((ext_vector_type(8)));
typedef float f32x4 __attribute__((ext_vector_type(4)));
typedef unsigned u32x4 __attribute__((ext_vector_type(4)));
constexpr int BM = 256, BK = 64, HALF = 128, HTB = HALF * BK * 2  , STAGE_BYTES = 8 * HTB, NXCD = 8, WGM = 8;

__host__ __device__ __forceinline__ int lds_byte(int r, int c) { const int st = (r >> 4) * 2 + (c >> 5), rr = r & 15, cc = c & 31, ob = rr * 64 + cc * 2; return st * 1024 + (ob ^ (((ob >> 9) & 1) << 5)); }
__host__ __device__ __forceinline__ void stage_rc(int b, int& R, int& C) { const int st = b / 1024, sb = b % 1024, swz = sb ^ (((sb >> 9) & 1) << 5); R = (st >> 1) * 16 + swz / 64; C = (st & 1) * 32 + (swz % 64) / 2; }
__host__ __device__ __forceinline__ int perm32(int rho) { const int n = rho >> 4, i = rho & 15; return 8 * (i >> 2) + 4 * n + (i & 3); }

struct Unit { int pm, pn; };
struct Gemm { const bf16_t* A; const bf16_t* Bt; int M, N, K; };

struct StaticOrder {
    int nM, nN, nwg, G, c;
    __host__ __device__ void init(int M, int N, int G_, int c_) { nM = M / BM; nN = N / BM; nwg = nM * nN; G = G_; c = c_; }
    __host__ __device__ bool next(int i, Unit& u) const {
        const long L = (long)i * G + c; if (L >= nwg) return false;
        int wgid = (int)L; { const int q = nwg / NXCD, r = nwg % NXCD, xcd = wgid % NXCD, off = wgid / NXCD; wgid = (xcd < r ? xcd * (q + 1) : r * (q + 1) + (xcd - r) * q) + off; }
        const int nig = WGM * nN, gid = wgid / nig, fm = gid * WGM, gsz = (nM - fm) < WGM ? (nM - fm) : WGM;
        u.pm = fm + ((wgid % nig) % gsz); u.pn = (wgid % nig) / gsz; return true;
    }
    __device__ __forceinline__ void a_ready(const Unit&) const {}
    __device__ __forceinline__ void done(const Unit&) const {}
};

__device__ __forceinline__ unsigned cvt_pk_bf16(float lo, float hi) { unsigned r; asm volatile("v_cvt_pk_bf16_f32 %0, %1, %2" : "=v"(r) : "v"(lo), "v"(hi)); return r; }

template <class Epi, class Sched, bool ALIGN_EPI = false, bool SP2 = false>
__device__ __forceinline__ void gemm_phase(PG8_LAS unsigned char* lds, const Gemm g, const Sched& S, const Epi& E) {
    const int tid = stid(), wid = __builtin_amdgcn_readfirstlane(tid >> 6), lane = tid & 63, wr = wid >> 2, wc = wid & 3, fr = lane & 15, fq = lane >> 4;
    const int K = g.K, nt = K / BK;
    unsigned voffA[2], voffB[2];
#pragma unroll
    for (int i = 0; i < 2; ++i) { int R, C; stage_rc(tid * 16 + i * 8192, R, C); const int Rb = Epi::PERM ? ((R & ~31) + perm32(R & 31)) : R;
        voffA[i] = (unsigned)(R * K + C) * 2u; voffB[i] = (unsigned)(Rb * K + C) * 2u; }
    const size_t kstep = (size_t)(BK * 2);
    const size_t hstep = (size_t)HALF * K * 2;
    const size_t tstep = 2 * hstep;
    const unsigned ldsw = (unsigned)wid * 1024u;
    const int aoff = lds_byte(wr * 64 + fr, fq * 8), boff = lds_byte(wc * 32 + fr, fq * 8);
#define PG8_SA(b, h) (((b) * 2 + (h)) * HTB)
#define PG8_SB(b, h) ((4 + (b) * 2 + (h)) * HTB)
#define PG8_STAGE(bufoff, gbase, voff) do { _Pragma("unroll") for (int _i = 0; _i < 2; ++_i) \
        __builtin_amdgcn_global_load_lds((const unsigned*)((const char*)(gbase) + (voff)[_i]), (PG8_LAS unsigned*)(lds + (bufoff) + ldsw + _i * 8192), 16, 0, 0); } while (0)
#define PG8_LDA(dst, b, h) do { _Pragma("unroll") for (int m = 0; m < 4; ++m) _Pragma("unroll") for (int k = 0; k < 2; ++k) dst[m][k] = *(const PG8_LAS bf16x8*)(lds + PG8_SA(b, h) + aoff + m * 2048 + k * 1024); } while (0)
#define PG8_LDB(dst, b, h) do { _Pragma("unroll") for (int n = 0; n < 2; ++n) _Pragma("unroll") for (int k = 0; k < 2; ++k) dst[n][k] = *(const PG8_LAS bf16x8*)(lds + PG8_SB(b, h) + boff + n * 2048 + k * 1024); } while (0)
#define PG8_MMA(ai, bj, At, Bt) do { __builtin_amdgcn_s_setprio(1); _Pragma("unroll") for (int m = 0; m < 4; ++m) _Pragma("unroll") for (int n = 0; n < 2; ++n) _Pragma("unroll") for (int k = 0; k < 2; ++k) \
        acc[ai][bj][m][n] = __builtin_amdgcn_mfma_f32_16x16x32_bf16(Bt[n][k], At[m][k], acc[ai][bj][m][n], 0, 0, 0); __builtin_amdgcn_s_setprio(0); } while (0)
#define PG8_WAIT_V(n) asm volatile("s_waitcnt vmcnt(" #n ")" ::: "memory")
#define PG8_WAIT_L(n) asm volatile("s_waitcnt lgkmcnt(" #n ")" ::: "memory")
#define PG8_BAR __builtin_amdgcn_s_barrier()
#define PG8_SCHED __builtin_amdgcn_sched_barrier(0)
    Unit cur, nxt; int ui = 0;
    if (!S.next(0, cur)) return;
    f32x4 acc[2][2][4][2];
#pragma unroll
    for (int a = 0; a < 2; ++a)
#pragma unroll
        for (int b = 0; b < 2; ++b)
#pragma unroll
            for (int m = 0; m < 4; ++m)
#pragma unroll
                for (int n = 0; n < 2; ++n) acc[a][b][m][n] = (f32x4){0.f, 0.f, 0.f, 0.f};
    bf16x8 At[4][2], B0[2][2], B1[2][2];
    const char* cA = (const char*)g.A + (size_t)cur.pm * tstep; const char* cB = (const char*)g.Bt + (size_t)cur.pn * tstep;
    S.a_ready(cur);
    if constexpr (SP2) {
        PG8_STAGE(PG8_SB(0, 0), cB, voffB); PG8_STAGE(PG8_SB(0, 1), cB + hstep, voffB); PG8_STAGE(PG8_SA(0, 0), cA, voffA); PG8_STAGE(PG8_SA(0, 1), cA + hstep, voffA);
        if (wr == 1) PG8_BAR;
        PG8_WAIT_V(2); PG8_BAR;
        PG8_STAGE(PG8_SB(1, 0), cB + kstep, voffB); PG8_STAGE(PG8_SA(1, 0), cA + kstep, voffA); PG8_STAGE(PG8_SB(1, 1), cB + hstep + kstep, voffB);
        PG8_WAIT_V(6); PG8_BAR;
    } else {
        PG8_STAGE(PG8_SB(0, 0), cB, voffB); PG8_STAGE(PG8_SA(0, 0), cA, voffA); PG8_STAGE(PG8_SB(0, 1), cB + hstep, voffB); PG8_STAGE(PG8_SA(0, 1), cA + hstep, voffA);
        if (wr == 1) PG8_BAR;
        PG8_WAIT_V(4); PG8_BAR;
        PG8_STAGE(PG8_SB(1, 0), cB + kstep, voffB); PG8_STAGE(PG8_SA(1, 0), cA + kstep, voffA); PG8_STAGE(PG8_SB(1, 1), cB + hstep + kstep, voffB);
        PG8_WAIT_V(6); PG8_BAR;
    }
    for (;;) {
        const bool has_next = S.next(ui + 1, nxt);
        const char* nA = has_next ? (const char*)g.A + (size_t)nxt.pm * tstep : cA; const char* nB = has_next ? (const char*)g.Bt + (size_t)nxt.pn * tstep : cB;
        for (int t = 0; t < nt; t += 2) {
            const bool last = (t == nt - 2);
            const char* a1 = cA + (size_t)(t + 1) * kstep;
            const char* a2 = last ? nA : cA + (size_t)(t + 2) * kstep; const char* b2 = last ? nB : cB + (size_t)(t + 2) * kstep;
            const char* a3 = a2 + kstep; const char* b3 = b2 + kstep;
            if (last && has_next) S.a_ready(nxt);
            if constexpr (SP2) {
            PG8_LDB(B0, 0, 0); PG8_LDB(B1, 0, 1); PG8_SCHED; PG8_LDA(At, 0, 0); PG8_STAGE(PG8_SA(1, 1), a1 + hstep, voffA);
            PG8_WAIT_V(8); PG8_WAIT_L(0); PG8_BAR; PG8_MMA(0, 0, At, B0); PG8_MMA(0, 1, At, B1); PG8_BAR; PG8_SCHED;
            PG8_LDA(At, 0, 1); PG8_STAGE(PG8_SB(0, 0), b2, voffB); PG8_STAGE(PG8_SB(0, 1), b2 + hstep, voffB); PG8_STAGE(PG8_SA(0, 0), a2, voffA);
            PG8_WAIT_V(8); PG8_WAIT_L(0); PG8_BAR; PG8_MMA(1, 0, At, B0); PG8_MMA(1, 1, At, B1); PG8_BAR; PG8_SCHED;
            PG8_LDB(B0, 1, 0); PG8_LDB(B1, 1, 1); PG8_SCHED; PG8_LDA(At, 1, 0); PG8_STAGE(PG8_SA(0, 1), a2 + hstep, voffA);
            PG8_WAIT_V(8); PG8_WAIT_L(0); PG8_BAR; PG8_MMA(0, 0, At, B0); PG8_MMA(0, 1, At, B1); PG8_BAR; PG8_SCHED;
            PG8_LDA(At, 1, 1); PG8_STAGE(PG8_SB(1, 0), b3, voffB); PG8_STAGE(PG8_SB(1, 1), b3 + hstep, voffB); PG8_STAGE(PG8_SA(1, 0), a3, voffA);
            PG8_WAIT_V(8); PG8_WAIT_L(0); PG8_BAR; PG8_MMA(1, 0, At, B0); PG8_MMA(1, 1, At, B1); PG8_BAR; PG8_SCHED;
            } else {
            PG8_LDB(B0, 0, 0); PG8_SCHED; PG8_LDA(At, 0, 0); PG8_STAGE(PG8_SA(1, 1), a1 + hstep, voffA);
            PG8_WAIT_L(8); PG8_BAR; PG8_WAIT_L(0); PG8_MMA(0, 0, At, B0); PG8_BAR; PG8_SCHED;
            PG8_LDB(B1, 0, 1); PG8_STAGE(PG8_SB(0, 0), b2, voffB);
            PG8_BAR; PG8_WAIT_L(0); PG8_MMA(0, 1, At, B1); PG8_BAR;
            PG8_LDA(At, 0, 1); PG8_STAGE(PG8_SA(0, 0), a2, voffA);
            PG8_BAR; PG8_WAIT_L(0); PG8_MMA(1, 0, At, B0); PG8_BAR; PG8_SCHED;
            PG8_STAGE(PG8_SB(0, 1), b2 + hstep, voffB);
            PG8_WAIT_V(6); PG8_BAR; PG8_MMA(1, 1, At, B1); PG8_BAR;
            PG8_LDB(B0, 1, 0); PG8_SCHED; PG8_LDA(At, 1, 0); PG8_STAGE(PG8_SA(0, 1), a2 + hstep, voffA);
            PG8_WAIT_L(8); PG8_BAR; PG8_WAIT_L(0); PG8_MMA(0, 0, At, B0); PG8_BAR; PG8_SCHED;
            PG8_LDB(B1, 1, 1); PG8_STAGE(PG8_SB(1, 0), b3, voffB);
            PG8_BAR; PG8_WAIT_L(0); PG8_MMA(0, 1, At, B1); PG8_BAR;
            PG8_LDA(At, 1, 1); PG8_STAGE(PG8_SA(1, 0), a3, voffA);
            PG8_BAR; PG8_WAIT_L(0); PG8_MMA(1, 0, At, B0); PG8_BAR; PG8_SCHED;
            PG8_STAGE(PG8_SB(1, 1), b3 + hstep, voffB);
            PG8_WAIT_V(6); PG8_BAR; PG8_MMA(1, 1, At, B1); PG8_BAR;
            }
        }
        if constexpr (ALIGN_EPI) { if (wr == 0) PG8_BAR; }
        if constexpr (!Epi::AFTER_DRAIN) { E(acc, cur, wr, wc, fr, fq); S.done(cur); }
        if (!has_next) break;
#pragma unroll
        for (int a = 0; a < 2; ++a)
#pragma unroll
            for (int b = 0; b < 2; ++b)
#pragma unroll
                for (int m = 0; m < 4; ++m)
#pragma unroll
                    for (int n = 0; n < 2; ++n) acc[a][b][m][n] = (f32x4){0.f, 0.f, 0.f, 0.f};
        cur = nxt; cA = nA; cB = nB; ++ui;
        if constexpr (ALIGN_EPI) { if (wr == 1) PG8_BAR; }
    }
    PG8_WAIT_V(0);
    if constexpr (!ALIGN_EPI) { if (wr == 0) PG8_BAR; }
    PG8_BAR;
    if constexpr (Epi::AFTER_DRAIN) { E.fused(acc, cur, wr, wc, fr, fq, lds, wid, lane); S.done(cur); }
#undef PG8_SA
#undef PG8_SB
#undef PG8_STAGE
#undef PG8_LDA
#undef PG8_LDB
#undef PG8_MMA
#undef PG8_WAIT_V
#undef PG8_WAIT_L
#undef PG8_BAR
#undef PG8_SCHED
}
}

#ifndef PG8_SP2
#define PG8_SP2 true
#endif
#ifndef PG8_ALIGN
#define PG8_ALIGN true
#endif
struct EpiProj8 {
    static constexpr bool PERM = true, AFTER_DRAIN = false;
    bf16_t* O; const float* rs; const float* rcos; const float* rsin;
    __device__ __forceinline__ void operator()(const pg8::f32x4 (&acc)[2][2][4][2], const pg8::Unit& u, int wr, int wc, int fr, int fq) const {
        const int row0 = u.pm * 256 + wr * 64 + fr, col0 = u.pn * 256 + wc * 32 + 8 * fq;
        const bool rot = u.pn < 4;
        const float ksc = u.pn >= 2 ? 0.08838834764831845f : 1.f;
#pragma unroll
        for (int ai = 0; ai < 2; ++ai)
#pragma unroll
            for (int m = 0; m < 4; ++m) {
                const int row = row0 + ai * 128 + m * 16;
                const float s = rs[row];
                const int seg = u.pn >> 1;
                const bool blocked = (seg < 3) || (seg == 5);
                bf16_t* rowp;
                int bjs;
                if (blocked) {
                    rowp = O + (size_t)(seg == 5 ? 3 : seg) * OPB + blk_off(row >> 4, (u.pn & 1) * 2) + (wc * 4 + fq) * 128 + fr * 8;
                    bjs = 4 * 2048;
                } else {
                    rowp = O + 4 * OPB + (size_t)row * NPR + (seg == 3 ? 0 : seg == 4 ? 512 : 1024) + (u.pn & 1) * 256 + wc * 32 + 8 * fq;
                    bjs = 128;
                }
                float4 cs = make_float4(1.f, 1.f, 1.f, 1.f), sn = make_float4(0.f, 0.f, 0.f, 0.f);
                float s2 = s;
                if (rot) {
                    const int ti = (row & 2047) * 64 + 16 * wc + 4 * fq;
                    cs = *(const float4*)(rcos + ti);
                    sn = *(const float4*)(rsin + ti);
                    s2 = s * ksc;
                }
#pragma unroll
                for (int bj = 0; bj < 2; ++bj) {
                    const pg8::f32x4 v0 = acc[ai][bj][m][0] * s2, v1 = acc[ai][bj][m][1] * s2;
                    *(uint4*)(rowp + bj * bjs) = make_uint4(pk2(v0[0] * cs.x - v0[1] * sn.x, v0[0] * sn.x + v0[1] * cs.x), pk2(v0[2] * cs.y - v0[3] * sn.y, v0[2] * sn.y + v0[3] * cs.y),
                                                            pk2(v1[0] * cs.z - v1[1] * sn.z, v1[0] * sn.z + v1[1] * cs.z), pk2(v1[2] * cs.w - v1[3] * sn.w, v1[2] * sn.w + v1[3] * cs.w));
                }
            }
    }
};
struct EpiX18 {
    static constexpr bool PERM = true, AFTER_DRAIN = false;
    const float* x; bf16_t* x1b; unsigned char* zq; float* rs2p; const float* g2;
    __device__ __forceinline__ void operator()(const pg8::f32x4 (&acc)[2][2][4][2], const pg8::Unit& u, int wr, int wc, int fr, int fq) const {
        const int row0 = u.pm * 256 + wr * 64 + fr, col0 = u.pn * 256 + wc * 32 + 8 * fq;
        float gq[2][8];
#pragma unroll
        for (int bj = 0; bj < 2; ++bj) {
            const float4 a = *(const float4*)(g2 + col0 + bj * 128), b = *(const float4*)(g2 + col0 + bj * 128 + 4);
            gq[bj][0] = a.x; gq[bj][1] = a.y; gq[bj][2] = a.z; gq[bj][3] = a.w; gq[bj][4] = b.x; gq[bj][5] = b.y; gq[bj][6] = b.z; gq[bj][7] = b.w;
        }
        float ssq[8];
#pragma unroll
        for (int ai = 0; ai < 2; ++ai)
#pragma unroll
            for (int m = 0; m < 4; ++m) {
                const size_t ro = (size_t)(row0 + ai * 128 + m * 16) * 1024 + col0;
                float s = 0.f;
#pragma unroll
                for (int bj = 0; bj < 2; ++bj) {
                    const float4 xa = *(const float4*)(x + ro + bj * 128), xb_ = *(const float4*)(x + ro + bj * 128 + 4);
                    const pg8::f32x4 v0 = acc[ai][bj][m][0], v1 = acc[ai][bj][m][1];
                    const float y[8] = {xa.x + v0[0], xa.y + v0[1], xa.z + v0[2], xa.w + v0[3], xb_.x + v1[0], xb_.y + v1[1], xb_.z + v1[2], xb_.w + v1[3]};
                    *(uint4*)(x1b + ro + bj * 128) = make_uint4(pk2(y[0], y[1]), pk2(y[2], y[3]), pk2(y[4], y[5]), pk2(y[6], y[7]));
                    unsigned w2[2] = {0u, 0u};
#pragma unroll
                    for (int e = 0; e < 8; ++e) {
                        s += y[e] * y[e];
                        const float z = fminf(fmaxf(y[e] * gq[bj][e] * (1.f / ZQ_SCALE), -127.f), 127.f);
                        w2[e >> 2] |= ((unsigned)((int)rintf(z) & 255)) << (8 * (e & 3));
                    }
                    *(uint2*)(zq + ro + bj * 128) = make_uint2(w2[0], w2[1]);
                }
                ssq[ai * 4 + m] = s;
            }
        float q4[4], q2[2];
#pragma unroll
        for (int j = 0; j < 4; ++j) {
            const auto r = __builtin_amdgcn_permlane32_swap(__float_as_uint(ssq[j]), __float_as_uint(ssq[j + 4]), false, false);
            q4[j] = __uint_as_float(r[0]) + __uint_as_float(r[1]);
        }
#pragma unroll
        for (int j = 0; j < 2; ++j) {
            const auto r = __builtin_amdgcn_permlane16_swap(__float_as_uint(q4[j]), __float_as_uint(q4[j + 2]), false, false);
            q2[j] = __uint_as_float(r[0]) + __uint_as_float(r[1]);
        }
#pragma unroll
        for (int j = 0; j < 2; ++j) {
            const int r8 = ((fq >> 1) & 1) * 4 + (fq & 1) * 2 + j;
            rs2p[(size_t)(row0 + (r8 >> 2) * 128 + (r8 & 3) * 16) * 16 + u.pn * 4 + wc] = q2[j];
        }
    }
};
template <class Epi, bool ALIGN>
DEVI void st_gemm8(const bf16_t* A, const bf16_t* Bt, int N, int K, char* smem, const Epi& epi) {
    pg8::Gemm g{A, Bt, T_TOK, N, K};
    pg8::StaticOrder S;
    S.init(T_TOK, N, (int)gridDim.x, (int)blockIdx.x);
    pg8::gemm_phase<Epi, pg8::StaticOrder, ALIGN, PG8_SP2>((PG8_LAS unsigned char*)smem, g, S, epi);
}

DEVI void st_conv_qk(const Params& p, char* smem) {
    char* cs = smem;
    char* wqs = smem + 128 * 272;
    char* wks = smem + 2 * 128 * 272;
    const int tid = stid(), lane = tid & 63, wid = tid >> 6, wr = wid >> 1, wc = wid & 1, fr = lane & 15, fq = lane >> 4;
    const int r = tid >> 4, cg = tid & 15;
    int hcur = -1;
    float cw[4][8], cb[8];
    for (int it = blockIdx.x; it < 256 * 4; it += gridDim.x) {
        const int h = it & 3, t0 = (it >> 2) * 128, s0 = t0 & 2047;
        if (h != hcur) {
            __syncthreads();
#pragma unroll
            for (int i = 0; i < 4; ++i) {
                const int id = tid + 512 * i, rr = id >> 4, c = id & 15;
                *(uint4*)(wqs + rr * 272 + c * 16) = *(const uint4*)(p.Wqt + h * 16384 + rr * 128 + c * 8);
                *(uint4*)(wks + rr * 272 + c * 16) = *(const uint4*)(p.Wkt + h * 16384 + rr * 128 + c * 8);
            }
#pragma unroll
            for (int j = 0; j < 4; ++j) {
                const float4 a = *(const float4*)(p.m_conv_w + j * 512 + h * 128 + 8 * cg), b = *(const float4*)(p.m_conv_w + j * 512 + h * 128 + 8 * cg + 4);
                cw[j][0] = a.x; cw[j][1] = a.y; cw[j][2] = a.z; cw[j][3] = a.w; cw[j][4] = b.x; cw[j][5] = b.y; cw[j][6] = b.z; cw[j][7] = b.w;
            }
            { const float4 a = *(const float4*)(p.m_conv_b + h * 128 + 8 * cg), b = *(const float4*)(p.m_conv_b + h * 128 + 8 * cg + 4);
              cb[0] = a.x; cb[1] = a.y; cb[2] = a.z; cb[3] = a.w; cb[4] = b.x; cb[5] = b.y; cb[6] = b.z; cb[7] = b.w; }
            hcur = h;
        }
        const bf16_t* xcol = p.proj + 4 * OPB + (size_t)t0 * NPR + 512 + h * 128 + 8 * cg;
#pragma unroll
        for (int ps = 0; ps < 4; ++ps) {
            const int row = 32 * ps + r;
            uint4 xv[4];
#pragma unroll
            for (int j = 0; j < 4; ++j) {
                const int rj = row - 3 + j;
                xv[j] = (s0 + rj >= 0) ? *(const uint4*)(xcol + (long)rj * NPR) : make_uint4(0u, 0u, 0u, 0u);
            }
            float y[8];
#pragma unroll
            for (int e = 0; e < 8; ++e) y[e] = cb[e];
#pragma unroll
            for (int j = 0; j < 4; ++j) {
                const unsigned w4[4] = {xv[j].x, xv[j].y, xv[j].z, xv[j].w};
#pragma unroll
                for (int e = 0; e < 4; ++e) { y[2 * e] += cw[j][2 * e] * bflo(w4[e]); y[2 * e + 1] += cw[j][2 * e + 1] * bfhi(w4[e]); }
            }
            unsigned o[4];
#pragma unroll
            for (int e = 0; e < 4; ++e) o[e] = pk2(y[2 * e] * sigmoidf_(y[2 * e]), y[2 * e + 1] * sigmoidf_(y[2 * e + 1]));
            const uint4 ov = make_uint4(o[0], o[1], o[2], o[3]);
            *(uint4*)(cs + row * 272 + cg * 16) = ov;
            *(uint4*)(p.cbuf + (size_t)(t0 + row) * 512 + h * 128 + 8 * cg) = ov;
        }
        __syncthreads();
#pragma unroll
        for (int which = 0; which < 2; ++which) {
            const char* ws = which ? wks : wqs;
            bf16_t* O = which ? p.mk : p.mq;
            f32x4 acc[2][4];
#pragma unroll
            for (int i = 0; i < 2; ++i)
#pragma unroll
                for (int j = 0; j < 4; ++j) acc[i][j] = (f32x4){0.f, 0.f, 0.f, 0.f};
#pragma unroll
            for (int ks = 0; ks < 4; ++ks) {
                bf16x8 a[2], b[4];
#pragma unroll
                for (int i = 0; i < 2; ++i) a[i] = ld8(cs + (wr * 32 + i * 16 + fr) * 272 + (ks * 4 + fq) * 16);
#pragma unroll
                for (int j = 0; j < 4; ++j) b[j] = ld8(ws + (wc * 64 + j * 16 + fr) * 272 + (ks * 4 + fq) * 16);
#pragma unroll
                for (int i = 0; i < 2; ++i)
#pragma unroll
                    for (int j = 0; j < 4; ++j) acc[i][j] = mfma16(b[j], a[i], acc[i][j]);
            }
#pragma unroll
            for (int i = 0; i < 2; ++i)
#pragma unroll
                for (int j = 0; j < 4; ++j) {
                    const f32x4 v = acc[i][j];
                    *(uint2*)(O + blk_off((t0 >> 4) + wr * 2 + i, h) + (wc * 8 + j * 2 + (fq >> 1)) * 128 + fr * 8 + (fq & 1) * 4) = make_uint2(pk2(v[0], v[1]), pk2(v[2], v[3]));
                }
        }
        __syncthreads();
    }
}

DEVI bf16x8 u4_to_frag(uint4 u) { union { uint4 u; bf16x8 v; } x; x.u = u; return x.v; }
DEVI void sel_frags(bf16x8 (&sel)[2], int fr, int fq) {
#pragma unroll
    for (int hh = 0; hh < 2; ++hh) {
        const int jstar = fr + 16 * hh - 8 * fq;
        bf16x8 s;
#pragma unroll
        for (int j = 0; j < 8; ++j) s[j] = (j == jstar) ? (short)0x3F80 : (short)0;
        sel[hh] = s;
    }
}
DEVI void tr_store(char* XT, bf16x8 frag, const bf16x8 (&sel)[2], int mi, int ks, int fr, int fq, const float (&sc)[4]) {
#pragma unroll
    for (int hh = 0; hh < 2; ++hh) {
        const f32x4 d = mfma16(frag, sel[hh], (f32x4){0.f, 0.f, 0.f, 0.f});
        *(uint2*)(XT + (32 * ks + 16 * hh + fr) * 144 + (16 * mi + 4 * fq) * 2) = make_uint2(pk2(d[0] * sc[0], d[1] * sc[1]), pk2(d[2] * sc[2], d[3] * sc[3]));
    }
}
DEVI bf16x8 state_pack(const f32x4& a, const f32x4& b) {
    return mk8(make_uint2(pk2(a[0], a[1]), pk2(a[2], a[3])), make_uint2(pk2(b[0], b[1]), pk2(b[2], b[3])));
}
DEVI const float* opaque_ptr(const float* q) { asm volatile("" : "+v"(q)); return q; }
DEVI float opaque_f(float v) { asm volatile("" : "+v"(v)); return v; }
DEVI void lds_barrier() { asm volatile("s_waitcnt lgkmcnt(0)" ::: "memory"); __builtin_amdgcn_s_barrier(); asm volatile("" ::: "memory"); }
DEVI void pin_u4(uint4& a) { asm volatile("" : "+v"(a.x), "+v"(a.y), "+v"(a.z), "+v"(a.w)); }
DEVI float grp8_sum(float v) { v += dpp_f<DPP_XOR1>(v); v += dpp_f<DPP_XOR2>(v); v += dpp_f<DPP_HMIRROR>(v); return v; }

#define ASM_LD16(dst, voff, sbase, imm) asm volatile("global_load_dwordx4 %0, %1, %2 offset:" #imm : "=v"(dst) : "v"(voff), "s"(sbase) : "memory")
#define ASM_LD4(dst, voff, sbase) asm volatile("global_load_dword %0, %1, %2" : "=v"(dst) : "v"(voff), "s"(sbase) : "memory")
typedef unsigned u32x4_t __attribute__((ext_vector_type(4)));
struct RetPre { u32x4_t f[4]; u32x4_t v[2]; u32x4_t g[2]; };
struct RetOff { unsigned f, v0, v1, g; };
DEVI void ret_offsets(RetOff& o, int h, int tid) {
    const int lane = tid & 63, w = tid >> 6, fr = lane & 15, fq = lane >> 4, mi = w & 3;
    o.f = (unsigned)((w < 4 ? OPB * 2 : 0) + (4 * h + mi) * 4096 + fq * 256 + fr * 16);
    o.v0 = (unsigned)(2 * OPB * 2 + (4 * h + ((2 * w) >> 2)) * 4096 + (4 * ((2 * w) & 3) + fq) * 256 + fr * 16);
    o.v1 = (unsigned)(2 * OPB * 2 + (4 * h + ((2 * w + 1) >> 2)) * 4096 + (4 * ((2 * w + 1) & 3) + fq) * 256 + fr * 16);
    o.g = (unsigned)(((tid >> 3) * NPR + h * 128 + 8 * (tid & 7)) * 2);
}
DEVI const char* ret_base(const Params& p, int b, int c) { return (const char*)p.proj + (size_t)(b * 32 + c) * 65536; }
DEVI const char* ret_gbase(const Params& p, int b, int c) { return (const char*)(p.proj + 4 * OPB) + (size_t)(b * 2048 + c * 64) * (NPR * 2); }
template <int N> DEVI void ret_retire_fv(RetPre& P) {
    asm volatile("s_waitcnt vmcnt(%6)" : "+v"(P.f[0]), "+v"(P.f[1]), "+v"(P.f[2]), "+v"(P.f[3]), "+v"(P.v[0]), "+v"(P.v[1]) : "n"(N) : "memory");
}
DEVI uint4 asu4(const u32x4_t& v) { return make_uint4(v[0], v[1], v[2], v[3]); }
DEVI void ret_block(const Params& p, char* smem, int b, int h) {
    char* qs = smem;
    char* ks_ = smem + 17408;
    char* kTs = smem + 34816;
    char* vTs = smem + 53248;
    char* Ss = smem + 71680;
    char* Os = smem + 80896;
    float* gn_s = (float*)(smem + 98304);
    const int tid = stid(), lane = tid & 63, w = tid >> 6, fr = lane & 15, fq = lane >> 4;
    const float gamma = 1.f - exp2f(-5.f - (float)h);
    const float l2g = log2f(gamma);
    const float g64 = exp2f(l2g * 64.f);
    bf16x8 sel[2];
    sel_frags(sel, fr, fq);
    f32x4 st[8];
#pragma unroll
    for (int i = 0; i < 8; ++i) st[i] = (f32x4){0.f, 0.f, 0.f, 0.f};
    if (tid < 128) gn_s[tid] = p.ret_norm_g[h * 128 + tid];
    __syncthreads();
    RetPre P;
    RetOff RO;
    ret_offsets(RO, h, tid);
    {
        const char* base = ret_base(p, b, 0);
        ASM_LD16(P.f[0], RO.f, base, 0); ASM_LD16(P.f[1], RO.f, base, 1024); ASM_LD16(P.f[2], RO.f, base, 2048); ASM_LD16(P.f[3], RO.f, base, 3072);
        ASM_LD16(P.v[0], RO.v0, base, 0); ASM_LD16(P.v[1], RO.v1, base, 0);
    }
    ret_retire_fv<0>(P);
#pragma unroll 1
    for (int c = 0; c < 32; ++c) {
        const int t0 = b * 2048 + c * 64;
        {
            const int mi = w & 3;
            char* dst = (w < 4 ? ks_ : qs) + (16 * mi + fr) * 272 + fq * 16;
#pragma unroll
            for (int ks = 0; ks < 4; ++ks) *(uint4*)(dst + ks * 64) = asu4(P.f[ks]);
            if (w < 4) {
                float kd[4];
#pragma unroll
                for (int r = 0; r < 4; ++r) kd[r] = exp2f(l2g * (float)(63 - (16 * mi + 4 * fq + r)));
#pragma unroll
                for (int ks = 0; ks < 4; ++ks) tr_store(kTs, u4_to_frag(asu4(P.f[ks])), sel, mi, ks, fr, fq, kd);
            }
            const float one[4] = {1.f, 1.f, 1.f, 1.f};
#pragma unroll
            for (int q = 0; q < 2; ++q) { const int pr = 2 * w + q; tr_store(vTs, u4_to_frag(asu4(P.v[q])), sel, pr >> 2, pr & 3, fr, fq, one); }
        }
        lds_barrier();
        const char* cbase = ret_gbase(p, b, c);
        const char* nbase = ret_base(p, b, c + 1 < 32 ? c + 1 : 31);
        ASM_LD16(P.g[0], RO.g, cbase, 0); ASM_LD16(P.g[1], RO.g, cbase, 128);
        {
            const int lt = w & 3;
            bf16x8 qf[4];
#pragma unroll
            for (int s = 0; s < 4; ++s) qf[s] = ld8(qs + (16 * lt + fr) * 272 + (s * 4 + fq) * 16);
#pragma unroll
            for (int jj = 0; jj < 2; ++jj) {
                const int j = 2 * (w >> 2) + jj;
                if (jj == 0) { ASM_LD16(P.f[0], RO.f, nbase, 0); ASM_LD16(P.f[1], RO.f, nbase, 1024); }
                else { ASM_LD16(P.f[2], RO.f, nbase, 2048); ASM_LD16(P.f[3], RO.f, nbase, 3072); }
                f32x4 a = (f32x4){0.f, 0.f, 0.f, 0.f};
#pragma unroll
                for (int s = 0; s < 4; ++s) a = mfma16(ld8(ks_ + (16 * j + fr) * 272 + (s * 4 + fq) * 16), qf[s], a);
                const int l = 16 * lt + fr, mb = 16 * j + 4 * fq;
                float v[4];
#pragma unroll
                for (int r = 0; r < 4; ++r) { const int dd = l - (mb + r); v[r] = a[r] * exp2f(l2g * (float)(dd < 0 ? -dd : dd)); }
                *(uint2*)(Ss + l * 144 + mb * 2) = make_uint2(pk2(v[0], v[1]), pk2(v[2], v[3]));
            }
        }
        lds_barrier();
        {
            bf16x8 sp[4];
#pragma unroll
            for (int s = 0; s < 4; ++s) sp[s] = state_pack(st[2 * s], st[2 * s + 1]);
            bf16x8 vf[2];
#pragma unroll
            for (int s2 = 0; s2 < 2; ++s2) vf[s2] = ld8(vTs + (16 * w + fr) * 144 + (s2 * 4 + fq) * 16);
#pragma unroll
            for (int i = 0; i < 4; ++i) {
                if (i == 0) ASM_LD16(P.v[0], RO.v0, nbase, 0);
                if (i == 1) ASM_LD16(P.v[1], RO.v1, nbase, 0);
                f32x4 a = (f32x4){0.f, 0.f, 0.f, 0.f};
                const char* qrow = qs + (16 * i + fr) * 272;
#pragma unroll
                for (int s = 0; s < 4; ++s) {
                    const uint2 lo = *(const uint2*)(qrow + (32 * s + 4 * fq) * 2), hi = *(const uint2*)(qrow + (32 * s + 16 + 4 * fq) * 2);
                    a = mfma16(sp[s], mk8(lo, hi), a);
                }
                a = a * exp2f(l2g * (float)(16 * i + fr + 1));
#pragma unroll
                for (int s2 = 0; s2 < 2; ++s2) a = mfma16(vf[s2], ld8(Ss + (16 * i + fr) * 144 + (s2 * 4 + fq) * 16), a);
                *(uint2*)(Os + (16 * i + fr) * 272 + (16 * w + 4 * fq) * 2) = make_uint2(pk2(a[0], a[1]), pk2(a[2], a[3]));
            }
#pragma unroll
            for (int i = 0; i < 8; ++i) {
                f32x4 a = st[i] * g64;
#pragma unroll
                for (int s2 = 0; s2 < 2; ++s2) a = mfma16(ld8(kTs + (16 * i + fr) * 144 + (s2 * 4 + fq) * 16), vf[s2], a);
                st[i] = a;
            }
        }
        lds_barrier();
        {
            const int l = tid >> 3, part = tid & 7;
            const uint4 o0 = *(const uint4*)(Os + l * 272 + part * 16), o1 = *(const uint4*)(Os + l * 272 + 128 + part * 16);
            const unsigned ow[8] = {o0.x, o0.y, o0.z, o0.w, o1.x, o1.y, o1.z, o1.w};
            float x[16], s = 0.f;
#pragma unroll
            for (int e = 0; e < 8; ++e) { x[2 * e] = bflo(ow[e]); x[2 * e + 1] = bfhi(ow[e]); s += x[2 * e] + x[2 * e + 1]; }
            const float mu = grp8_sum(s) * (1.f / 128.f);
            float q = 0.f;
#pragma unroll
            for (int e = 0; e < 16; ++e) { x[e] -= mu; q += x[e] * x[e]; }
            float rstd = rsqrtf(grp8_sum(q) * (1.f / 128.f) + EPSN);
            asm volatile("s_waitcnt vmcnt(6)" : "+v"(P.g[0]), "+v"(P.g[1]), "+v"(rstd) :: "memory");
            const unsigned gw[8] = {P.g[0][0], P.g[0][1], P.g[0][2], P.g[0][3], P.g[1][0], P.g[1][1], P.g[1][2], P.g[1][3]};
            const float* gn = gn_s + 8 * part;
            unsigned yo[8];
#pragma unroll
            for (int e = 0; e < 8; ++e) {
                const float ga = bflo(gw[e]), gb = bfhi(gw[e]);
                const int ci = (e < 4 ? 0 : 56) + 2 * e;
                yo[e] = pk2(ga * sigmoidf_(ga) * x[2 * e] * rstd * gn[ci], gb * sigmoidf_(gb) * x[2 * e + 1] * rstd * gn[ci + 1]);
            }
            asm volatile("" : "+v"(yo[0]), "+v"(yo[1]), "+v"(yo[2]), "+v"(yo[3]), "+v"(yo[4]), "+v"(yo[5]), "+v"(yo[6]), "+v"(yo[7]));
            ret_retire_fv<0>(P);
            uint4* yp = (uint4*)(p.yb + (size_t)(t0 + l) * 1024 + h * 128 + 8 * part);
            yp[0] = make_uint4(yo[0], yo[1], yo[2], yo[3]);
            yp[8] = make_uint4(yo[4], yo[5], yo[6], yo[7]);
        }
    }
}

struct MlPre { u32x4_t f[4]; u32x4_t v[2]; u32x4_t o[2]; u32x4_t cc[2]; };
struct MlOff { unsigned f, v0, v1, o, c, g; };
DEVI void ml_offsets(const Params& p, MlOff& o, int h, int tid) {
    const int lane = tid & 63, w = tid >> 6, fr = lane & 15, fq = lane >> 4, mi = w & 3;
    const unsigned kdiff = (unsigned)((const char*)p.mk - (const char*)p.mq);
    o.f = (unsigned)((4 * h + mi) * 4096 + fq * 256 + fr * 16) + (w < 4 ? kdiff : 0u);
    o.v0 = (unsigned)((4 * h + ((2 * w) >> 2)) * 4096 + (4 * ((2 * w) & 3) + fq) * 256 + fr * 16);
    o.v1 = (unsigned)((4 * h + ((2 * w + 1) >> 2)) * 4096 + (4 * ((2 * w + 1) & 3) + fq) * 256 + fr * 16);
    o.o = (unsigned)(((tid >> 3) * NPR + 1024 + h * 128 + 8 * (tid & 7)) * 2);
    o.c = (unsigned)(((tid >> 3) * 512 + h * 128 + 8 * (tid & 7)) * 2);
    o.g = (unsigned)((lane * 4 + h) * 4);
}
template <int N> DEVI void ml_retire_fv(MlPre& P) {
    asm volatile("s_waitcnt vmcnt(%6)" : "+v"(P.f[0]), "+v"(P.f[1]), "+v"(P.f[2]), "+v"(P.f[3]), "+v"(P.v[0]), "+v"(P.v[1]) : "n"(N) : "memory");
}
DEVI void mlstm_block(const Params& p, char* smem, int b, int h) {
    char* qs = smem;
    char* kTs = smem + 17408;
    char* vTs = smem + 35840;
    char* Os = smem + 54272;
    float* n_s = (float*)(smem + 71680);
    float* den_s = (float*)(smem + 72192);
    float* gn_s = (float*)(smem + 72448);
    float* sk_s = gn_s + 128;
    float* lw_s = sk_s + 128;
    float* ac_s = lw_s + 32 * 64;
    float* mi_s = ac_s + 32;
    const int tid = stid(), lane = tid & 63, w = tid >> 6, fr = lane & 15, fq = lane >> 4;
    bf16x8 sel[2];
    sel_frags(sel, fr, fq);
    f32x4 st[8];
#pragma unroll
    for (int i = 0; i < 8; ++i) st[i] = (f32x4){0.f, 0.f, 0.f, 0.f};
    float m_run = 0.f;
    f32x4 nacc = (f32x4){0.f, 0.f, 0.f, 0.f};
    bf16x8 ones;
#pragma unroll
    for (int j = 0; j < 8; ++j) ones[j] = (short)0x3F80;
    if (tid < 128) { gn_s[tid] = p.m_norm_g[h * 128 + tid]; sk_s[tid] = p.m_skip[h * 128 + tid]; }
#pragma unroll
    for (int q = 0; q < 4; ++q) {
        const int cc = 4 * w + q, tt = b * 2048 + cc * 64 + lane;
        const float iv = p.ipre[tt * 4 + h], fv = p.logf[tt * 4 + h];
        float fcum = fv;
#pragma unroll
        for (int o = 1; o < 64; o <<= 1) { const float tv = __shfl_up(fcum, o); if (lane >= o) fcum += tv; }
        const float a_c = __shfl(fcum, 63);
        const float logw = a_c - fcum + iv;
        const float m_in = wave_max(logw);
        lw_s[cc * 64 + lane] = logw;
        if (lane == 0) { ac_s[cc] = a_c; mi_s[cc] = m_in; }
    }
    __syncthreads();
    MlPre P;
    MlOff MO;
    ml_offsets(p, MO, h, tid);
    {
        const size_t t00 = (size_t)(b * 2048);
        const char* bq = (const char*)p.mq + t00 * 1024, *bp = (const char*)(p.proj + 3 * OPB) + t00 * 1024;
        ASM_LD16(P.f[0], MO.f, bq, 0); ASM_LD16(P.f[1], MO.f, bq, 1024); ASM_LD16(P.f[2], MO.f, bq, 2048); ASM_LD16(P.f[3], MO.f, bq, 3072);
        ASM_LD16(P.v[0], MO.v0, bp, 0); ASM_LD16(P.v[1], MO.v1, bp, 0);
    }
    ml_retire_fv<0>(P);
#pragma unroll 1
    for (int c = 0; c < 32; ++c) {
        const int t0 = b * 2048 + c * 64;
        const float a_c = ac_s[c], m_in = mi_s[c], logw = lw_s[c * 64 + lane];
        const float m_new = fmaxf(a_c + m_run, m_in);
        const float decay = fexp_(a_c + m_run - m_new);
        const float wgt = fexp_(logw - m_new);
        const float emn = fexp_(-m_new);
        m_run = m_new;
        {
            const int mi = w & 3;
            if (w < 4) {
                float kw[4];
#pragma unroll
                for (int r = 0; r < 4; ++r) kw[r] = __shfl(wgt, 16 * mi + 4 * fq + r);
#pragma unroll
                for (int ks = 0; ks < 4; ++ks) tr_store(kTs, u4_to_frag(asu4(P.f[ks])), sel, mi, ks, fr, fq, kw);
            } else {
                char* dst = qs + (16 * mi + fr) * 272 + fq * 16;
#pragma unroll
                for (int ks = 0; ks < 4; ++ks) *(uint4*)(dst + ks * 64) = asu4(P.f[ks]);
            }
            const float one[4] = {1.f, 1.f, 1.f, 1.f};
#pragma unroll
            for (int q = 0; q < 2; ++q) { const int pr = 2 * w + q; tr_store(vTs, u4_to_frag(asu4(P.v[q])), sel, pr >> 2, pr & 3, fr, fq, one); }
        }
        lds_barrier();
        const size_t tc = (size_t)t0, tn = (size_t)(b * 2048 + (c + 1 < 32 ? c + 1 : 31) * 64);
        const char* cbp = (const char*)(p.proj + 4 * OPB) + tc * (NPR * 2), *cbc = (const char*)p.cbuf + tc * 1024;
        const char* nbq = (const char*)p.mq + tn * 1024, *nbp = (const char*)(p.proj + 3 * OPB) + tn * 1024;
        ASM_LD16(P.o[0], MO.o, cbp, 0); ASM_LD16(P.o[1], MO.o, cbp, 128);
        {
            f32x4 a = nacc * decay;
#pragma unroll
            for (int s2 = 0; s2 < 2; ++s2) a = mfma16(ld8(kTs + (16 * w + fr) * 144 + (s2 * 4 + fq) * 16), ones, a);
            nacc = a;
            if (fr == 0) *(f32x4*)(n_s + 16 * w + 4 * fq) = a;
        }
        {
            bf16x8 vf[2];
#pragma unroll
            for (int s2 = 0; s2 < 2; ++s2) vf[s2] = ld8(vTs + (16 * w + fr) * 144 + (s2 * 4 + fq) * 16);
#pragma unroll
            for (int i = 0; i < 8; ++i) {
                if (i == 0) ASM_LD16(P.cc[0], MO.c, cbc, 0);
                if (i == 1) ASM_LD16(P.cc[1], MO.c, cbc, 128);
                if (i == 2) ASM_LD16(P.f[0], MO.f, nbq, 0);
                if (i == 3) ASM_LD16(P.f[1], MO.f, nbq, 1024);
                if (i == 4) ASM_LD16(P.f[2], MO.f, nbq, 2048);
                if (i == 5) ASM_LD16(P.f[3], MO.f, nbq, 3072);
                if (i == 6) ASM_LD16(P.v[0], MO.v0, nbp, 0);
                if (i == 7) ASM_LD16(P.v[1], MO.v1, nbp, 0);
                f32x4 a = st[i] * decay;
#pragma unroll
                for (int s2 = 0; s2 < 2; ++s2) a = mfma16(ld8(kTs + (16 * i + fr) * 144 + (s2 * 4 + fq) * 16), vf[s2], a);
                st[i] = a;
            }
        }
        lds_barrier();
        {
            const int l = tid >> 3, part = tid & 7;
            const uint4 a0 = *(const uint4*)(qs + l * 272 + part * 32), a1 = *(const uint4*)(qs + l * 272 + part * 32 + 16);
            const unsigned aw[8] = {a0.x, a0.y, a0.z, a0.w, a1.x, a1.y, a1.z, a1.w};
            const float* nn = n_s + 16 * part;
            float s = 0.f;
#pragma unroll
            for (int e = 0; e < 8; ++e) s += bflo(aw[e]) * nn[2 * e] + bfhi(aw[e]) * nn[2 * e + 1];
            s = grp8_sum(s);
            if (part == 0) den_s[l] = fmaxf(fabsf(s), emn);
        }
        lds_barrier();
        {
            bf16x8 sp[4];
#pragma unroll
            for (int s = 0; s < 4; ++s) sp[s] = state_pack(st[2 * s], st[2 * s + 1]);
#pragma unroll
            for (int i = 0; i < 4; ++i) {
                f32x4 a = (f32x4){0.f, 0.f, 0.f, 0.f};
                const char* qrow = qs + (16 * i + fr) * 272;
#pragma unroll
                for (int s = 0; s < 4; ++s) {
                    const uint2 lo = *(const uint2*)(qrow + (32 * s + 4 * fq) * 2), hi = *(const uint2*)(qrow + (32 * s + 16 + 4 * fq) * 2);
                    a = mfma16(sp[s], mk8(lo, hi), a);
                }
                const float rd = rcp_(den_s[16 * i + fr]);
                *(uint2*)(Os + (16 * i + fr) * 272 + (16 * w + 4 * fq) * 2) = make_uint2(pk2(a[0] * rd, a[1] * rd), pk2(a[2] * rd, a[3] * rd));
            }
        }
        lds_barrier();
        {
            const int l = tid >> 3, part = tid & 7;
            const uint4 o0 = *(const uint4*)(Os + l * 272 + part * 16), o1 = *(const uint4*)(Os + l * 272 + 128 + part * 16);
            const unsigned ow[8] = {o0.x, o0.y, o0.z, o0.w, o1.x, o1.y, o1.z, o1.w};
            float x[16], s = 0.f;
#pragma unroll
            for (int e = 0; e < 8; ++e) { x[2 * e] = bflo(ow[e]); x[2 * e + 1] = bfhi(ow[e]); s += x[2 * e] + x[2 * e + 1]; }
            const float mu = grp8_sum(s) * (1.f / 128.f);
            float q = 0.f;
#pragma unroll
            for (int e = 0; e < 16; ++e) { x[e] -= mu; q += x[e] * x[e]; }
            float rstd = rsqrtf(grp8_sum(q) * (1.f / 128.f) + EPSN);
            asm volatile("s_waitcnt vmcnt(6)" : "+v"(P.o[0]), "+v"(P.o[1]), "+v"(P.cc[0]), "+v"(P.cc[1]), "+v"(rstd) :: "memory");
            const unsigned gw[8] = {P.o[0][0], P.o[0][1], P.o[0][2], P.o[0][3], P.o[1][0], P.o[1][1], P.o[1][2], P.o[1][3]};
            const unsigned cw[8] = {P.cc[0][0], P.cc[0][1], P.cc[0][2], P.cc[0][3], P.cc[1][0], P.cc[1][1], P.cc[1][2], P.cc[1][3]};
            const float* gn = gn_s + 8 * part;
            const float* sk = sk_s + 8 * part;
            unsigned yo[8];
#pragma unroll
            for (int e = 0; e < 8; ++e) {
                const int ci = (e < 4 ? 0 : 56) + 2 * e;
                const float ya = sigmoidf_(bflo(gw[e])) * (x[2 * e] * rstd * gn[ci] + sk[ci] * bflo(cw[e]));
                const float yb_ = sigmoidf_(bfhi(gw[e])) * (x[2 * e + 1] * rstd * gn[ci + 1] + sk[ci + 1] * bfhi(cw[e]));
                yo[e] = pk2(ya, yb_);
            }
            asm volatile("" : "+v"(yo[0]), "+v"(yo[1]), "+v"(yo[2]), "+v"(yo[3]), "+v"(yo[4]), "+v"(yo[5]), "+v"(yo[6]), "+v"(yo[7]));
            ml_retire_fv<0>(P);
            uint4* yp = (uint4*)(p.yb + (size_t)(t0 + l) * 1024 + 512 + h * 128 + 8 * part);
            yp[0] = make_uint4(yo[0], yo[1], yo[2], yo[3]);
            yp[8] = make_uint4(yo[4], yo[5], yo[6], yo[7]);
        }
    }
}
DEVI void st_recur(const Params& p, char* smem) {
    if (blockIdx.x >= 128 || gridDim.x <= 128) {
        const int bid = gridDim.x > 128 ? (int)blockIdx.x - 128 : (int)blockIdx.x, nb = gridDim.x > 128 ? (int)gridDim.x - 128 : (int)gridDim.x;
        st_prep_w2(p, smem, bid, nb);
        st_prep_wsub(p, smem, bid, nb);
        st_prep_tables(p, bid, nb);
        if (gridDim.x > 128) return;
    }
    for (int bi = blockIdx.x; bi < 128; bi += gridDim.x) {
        const int kind = bi & 1, h = (bi >> 1) & 3, b = bi >> 3;
        if (kind == 0) ret_block(p, smem, b, h);
        else mlstm_block(p, smem, b, h);
        __syncthreads();
    }
}

constexpr float KEY_BIAS = 64.f;
DEVI int f2key(float f) { const int b = __float_as_int(f); return b ^ ((b >> 31) & 0x7fffffff); }
DEVI float key2f(int k) { return __int_as_float(k ^ ((k >> 31) & 0x7fffffff)); }
template <int N> DEVI void bsort_desc(int (&v)[N]) {
#pragma unroll
    for (int k = 2; k <= N; k <<= 1)
#pragma unroll
        for (int j = k >> 1; j > 0; j >>= 1)
#pragma unroll
            for (int i = 0; i < N; ++i) {
                const int l = i ^ j;
                if (l > i) {
                    const int a = v[i], b = v[l];
                    const int mx = a > b ? a : b, mn = a > b ? b : a;
                    if ((i & k) == 0) { v[i] = mx; v[l] = mn; } else { v[i] = mn; v[l] = mx; }
                }
            }
}
template <int N> DEVI void bmerge_desc(int (&v)[N]) {
#pragma unroll
    for (int j = N >> 1; j > 0; j >>= 1)
#pragma unroll
        for (int i = 0; i < N; ++i) {
            const int l = i ^ j;
            if (l > i) { const int a = v[i], b = v[l]; v[i] = a > b ? a : b; v[l] = a > b ? b : a; }
        }
}
DEVI void xmerge16(int (&v)[16], int mask) {
    int o[16];
#pragma unroll
    for (int i = 0; i < 16; ++i) o[i] = __shfl_xor(v[15 - i], mask);
#pragma unroll
    for (int i = 0; i < 16; ++i) v[i] = v[i] > o[i] ? v[i] : o[i];
    bmerge_desc<16>(v);
}
__device__ const unsigned char cand_tab[52] = {
    0x00, 0x01, 0x02, 0x03, 0x04, 0x05, 0x06, 0x07, 0x08, 0x09, 0x0a, 0x0b, 0x0c, 0x0d, 0x0e, 0x0f,
    0x10, 0x11, 0x12, 0x13, 0x14, 0x15, 0x16, 0x17, 0x20, 0x21, 0x22, 0x23, 0x24, 0x30, 0x31, 0x32, 0x33,
    0x40, 0x41, 0x42, 0x50, 0x51, 0x60, 0x61, 0x70, 0x71, 0x80, 0x90, 0xa0, 0xb0, 0xc0, 0xd0, 0xe0, 0xf0, 0xff, 0xff};
constexpr int H_A = 256 * 64, H_B = 256 * 64, H_STAGE = H_A + H_B;
constexpr int H_LIST = 3 * H_STAGE;
DEVI void glds16(const void* g, char* l) {
    __builtin_amdgcn_global_load_lds((const __attribute__((address_space(1))) unsigned*)g, (__attribute__((address_space(3))) unsigned*)l, 16, 0, 0);
}
DEVI void gemm3_topk_tile(const Params& p, int m0, int h, char* smem) {
    const int tid = stid(), lane = tid & 63, w = tid >> 6, wt = w >> 1, wp = w & 1, fr = lane & 15, fq = lane >> 4;
    i32x4 acc[4][8];
#pragma unroll
    for (int i = 0; i < 4; ++i)
#pragma unroll
        for (int j = 0; j < 8; ++j) acc[i][j] = (i32x4){0, 0, 0, 0};
    const int r16 = lane >> 2, csrc = (lane & 3) ^ ((r16 >> 2) & 3);
    const unsigned char* srcA = p.xq + (size_t)(m0 + w * 32 + r16) * 1024 + csrc * 16;
    const unsigned char* srcB = (const unsigned char*)p.Wsubq + ((size_t)h * 256 + w * 32 + r16) * 1024 + csrc * 16;
    char* dstA = smem + (w * 32) * 64 + lane * 16;
    char* dstB = smem + H_A + (w * 32) * 64 + lane * 16;
    auto issue = [&](int kt, int buf) {
#pragma unroll
        for (int q = 0; q < 2; ++q) glds16(srcA + (size_t)q * 16 * 1024 + kt * 64, dstA + buf * H_STAGE + q * 1024);
#pragma unroll
        for (int q = 0; q < 2; ++q) glds16(srcB + (size_t)q * 16 * 1024 + kt * 64, dstB + buf * H_STAGE + q * 1024);
    };
    const int rdoff = fr * 64 + ((fq ^ ((fr >> 2) & 3)) * 16);
    issue(0, 0);
    issue(1, 1);
    asm volatile("s_waitcnt vmcnt(4)" ::: "memory");
    __builtin_amdgcn_s_barrier();
    int buf = 0;
#pragma unroll 1
    for (int kt = 0; kt < 16; ++kt) {
        const int b2 = buf >= 1 ? buf - 1 : 2;
        if (kt + 2 < 16) issue(kt + 2, b2);
        const char* As = smem + buf * H_STAGE + (wt * 64) * 64 + rdoff;
        const char* Bs = smem + buf * H_STAGE + H_A + (wp * 128) * 64 + rdoff;
        i32x4 a[4];
#pragma unroll
        for (int i = 0; i < 4; ++i) a[i] = *(const i32x4*)(As + (16 * i) * 64);
#pragma unroll
        for (int jg = 0; jg < 2; ++jg) {
            i32x4 b[4];
#pragma unroll
            for (int j = 0; j < 4; ++j) b[j] = *(const i32x4*)(Bs + (16 * (4 * jg + j)) * 64);
#pragma unroll
            for (int i = 0; i < 4; ++i)
#pragma unroll
                for (int j = 0; j < 4; ++j) acc[i][4 * jg + j] = __builtin_amdgcn_mfma_i32_16x16x64_i8(b[j], a[i], acc[i][4 * jg + j], 0, 0, 0);
        }
        if (kt + 2 < 16) asm volatile("s_waitcnt vmcnt(4)" ::: "memory");
        else asm volatile("s_waitcnt vmcnt(0)" ::: "memory");
        __builtin_amdgcn_s_barrier();
        buf = buf == 2 ? 0 : buf + 1;
    }
    float4 ws[8];
#pragma unroll
    for (int j = 0; j < 8; ++j) ws[j] = *(const float4*)(p.wsc + h * 256 + wp * 128 + 16 * j + 4 * fq);
    int* LX = (int*)(smem + H_LIST);
#pragma unroll
    for (int i = 0; i < 4; ++i) {
        const int tl = 64 * wt + 16 * i + fr;
        const float rs = rs2_of(p.rs2p, m0 + tl) * ZQ_SCALE;
        int ka[16], kb[16];
#pragma unroll
        for (int jj = 0; jj < 4; ++jj)
#pragma unroll
            for (int r = 0; r < 4; ++r) {
                const float sa = r == 0 ? ws[jj].x : r == 1 ? ws[jj].y : r == 2 ? ws[jj].z : ws[jj].w;
                const float sb = r == 0 ? ws[4 + jj].x : r == 1 ? ws[4 + jj].y : r == 2 ? ws[4 + jj].z : ws[4 + jj].w;
                ka[jj * 4 + r] = (__float_as_int((float)acc[i][jj][r] * (sa * rs) + KEY_BIAS) & ~127) | (16 * jj + 4 * fq + r);
                kb[jj * 4 + r] = (__float_as_int((float)acc[i][4 + jj][r] * (sb * rs) + KEY_BIAS) & ~127) | (16 * (jj + 4) + 4 * fq + r);
            }
        bsort_desc<16>(ka);
        bsort_desc<16>(kb);
#pragma unroll
        for (int q = 0; q < 16; ++q) ka[q] = ka[q] > kb[15 - q] ? ka[q] : kb[15 - q];
        bmerge_desc<16>(ka);
        xmerge16(ka, 16);
        xmerge16(ka, 32);
        const int k0 = fq == 0 ? ka[0] : fq == 1 ? ka[4] : fq == 2 ? ka[8] : ka[12];
        const int k1 = fq == 0 ? ka[1] : fq == 1 ? ka[5] : fq == 2 ? ka[9] : ka[13];
        const int k2 = fq == 0 ? ka[2] : fq == 1 ? ka[6] : fq == 2 ? ka[10] : ka[14];
        const int k3 = fq == 0 ? ka[3] : fq == 1 ? ka[7] : fq == 2 ? ka[11] : ka[15];
        *(int4*)(LX + tl * 32 + wp * 16 + 4 * fq) = make_int4(k0, k1, k2, k3);
    }
    __syncthreads();
#pragma unroll
    for (int i2 = 0; i2 < 2; ++i2) {
        const int tl = 32 * w + 16 * i2 + fr, t = m0 + tl;
        const int* L = LX + tl * 32;
        const unsigned long long clo = fq == 0 ? 0x0706050403020100ull : fq == 1 ? 0x14131211100f0e0dull : fq == 2 ? 0x4033323130242322ull : 0xc0b0a09080717061ull;
        const unsigned long long chi = fq == 0 ? 0x0c0b0a0908ull : fq == 1 ? 0x2120171615ull : fq == 2 ? 0x6051504241ull : 0xfffff0e0d0ull;
        int c[16];
#pragma unroll
        for (int s = 0; s < 13; ++s) {
            const int ab = (int)((s < 8 ? (clo >> (8 * s)) : (chi >> (8 * (s - 8)))) & 0xffull);
            const int k1 = L[ab >> 4], k2 = L[16 + (ab & 15)];
            const float v = (__int_as_float(k1 & ~127) - KEY_BIAS) + (__int_as_float(k2 & ~127) - KEY_BIAS);
            c[s] = (f2key(v) & ~0x3fff) | ((k1 & 127) << 7) | (k2 & 127);
        }
        c[13] = c[14] = c[15] = (int)0x80000000;
        bsort_desc<16>(c);
        xmerge16(c, 16);
        xmerge16(c, 32);
        const float vmax = key2f(c[0] & ~0x3fff);
        float e[16], sum = 0.f;
#pragma unroll
        for (int q = 0; q < 16; ++q) { e[q] = fexp_(key2f(c[q] & ~0x3fff) - vmax); sum += e[q]; }
        const float inv = rcp_(sum);
        int ce[4]; float ge[4];
#pragma unroll
        for (int q = 0; q < 4; ++q) {
            const int cq = fq == 0 ? c[q] : fq == 1 ? c[4 + q] : fq == 2 ? c[8 + q] : c[12 + q];
            const float eq = fq == 0 ? e[q] : fq == 1 ? e[4 + q] : fq == 2 ? e[8 + q] : e[12 + q];
            ce[q] = ((cq >> 7) & 127) * 128 + (cq & 127);
            ge[q] = eq * inv;
        }
        *(uint2*)(p.eperm + (size_t)t * 128 + h * 16 + 4 * fq) = make_uint2((unsigned)ce[0] | ((unsigned)ce[1] << 16), (unsigned)ce[2] | ((unsigned)ce[3] << 16));
        *(float4*)(p.gate + (size_t)t * 128 + h * 16 + 4 * fq) = make_float4(ge[0], ge[1], ge[2], ge[3]);
    }
    __syncthreads();
}
DEVI void st_gemm3_topk(const Params& p, char* smem) {
    for (int it = blockIdx.x; it < 128 * 8; it += gridDim.x) gemm3_topk_tile(p, (it >> 3) * 256, it & 7, smem);
}

#define XB_TMO      128
#define XB_XCNT(j)  (256  + 64 * (j))
#define XB_XSUB(j)  (1280 + 64 * (j))
#define XB_XGEN(j)  (2304 + 64 * (j))
#define XB_TOP      3328
#define XB_TOPGEN   3392
#define XCD_BAR_WORDS 3456
#define XB_SPIN_CAP (1u << 20)
#define LAS __attribute__((address_space(3)))
DEVI unsigned xb_ld(unsigned* p) { return __hip_atomic_load(p, __ATOMIC_RELAXED, __HIP_MEMORY_SCOPE_AGENT); }
DEVI unsigned xb_add(unsigned* p, unsigned v) { return __hip_atomic_fetch_add(p, v, __ATOMIC_RELAXED, __HIP_MEMORY_SCOPE_AGENT); }
DEVI unsigned xb_xcc_id() { return (unsigned)__builtin_amdgcn_s_getreg((3 << 11) | 20) & 0xFu; }
#define XB_SPIN(cond, bar) do { unsigned _sp = 0; while (cond) { __builtin_amdgcn_s_sleep(1); \
    if ((++_sp & 255u) == 0u) { if (xb_ld(&(bar)[XB_TMO])) break; if (_sp > XB_SPIN_CAP) { atomicAdd(&(bar)[XB_TMO], 1u); break; } } } } while (0)
struct XcdBarrier { unsigned* bar; unsigned x; volatile LAS unsigned* st; };
DEVI XcdBarrier xcd_barrier_post(unsigned* bar, volatile LAS unsigned* st) {
    XcdBarrier b; b.bar = bar; b.x = xb_xcc_id(); b.st = st;
    if (stid() == 0) (void)xb_add(&bar[XB_XCNT(b.x)], 1u);
    return b;
}
DEVI void xcd_barrier_complete(unsigned* bar, unsigned x, unsigned& nloc, unsigned& nx) {
    const unsigned G = gridDim.x * gridDim.y * gridDim.z;
    unsigned sum, cnt, mine, sp = 0u;
    for (;;) {
        sum = 0u; cnt = 0u; mine = 0u;
#pragma unroll
        for (unsigned j = 0; j < 16; ++j) { const unsigned c = xb_ld(&bar[XB_XCNT(j)]); sum += c; cnt += (c > 0u) ? 1u : 0u; mine = (j == x) ? c : mine; }
        if (sum == G) break;
        __builtin_amdgcn_s_sleep(1);
        if ((++sp & 255u) == 0u) { if (xb_ld(&bar[XB_TMO])) break; if (sp > XB_SPIN_CAP) { atomicAdd(&bar[XB_TMO], 1u); break; } }
    }
    nloc = mine > 0u ? mine : 1u; nx = cnt > 0u ? cnt : 1u;
}
DEVI void xcd_barrier(const XcdBarrier& b) {
    asm volatile("s_waitcnt vmcnt(0)" ::: "memory");
    __syncthreads();
    if (stid() == 0) {
        unsigned* bar = b.bar;
        __builtin_amdgcn_s_waitcnt(0);
        unsigned nloc = b.st[0], nx = b.st[1];
        if (nloc == 0u) { xcd_barrier_complete(bar, b.x, nloc, nx); b.st[0] = nloc; b.st[1] = nx; }
        const unsigned old = xb_add(&bar[XB_XSUB(b.x)], 1u);
        const unsigned gen = old / nloc;
        if (old + 1u == (gen + 1u) * nloc) {
            __builtin_amdgcn_fence(__ATOMIC_RELEASE, "agent");
            asm volatile("s_waitcnt vmcnt(0)" ::: "memory");
            const unsigned og = xb_add(&bar[XB_TOP], 1u);
            const unsigned tg = og / nx;
            if (og + 1u == (tg + 1u) * nx) xb_add(&bar[XB_TOPGEN], 1u);
            else XB_SPIN(xb_ld(&bar[XB_TOPGEN]) == tg, bar);
            __builtin_amdgcn_fence(__ATOMIC_ACQUIRE, "agent");
            xb_add(&bar[XB_XGEN(b.x)], 1u);
            asm volatile("s_waitcnt vmcnt(0)" ::: "memory");
        } else {
            XB_SPIN(xb_ld(&bar[XB_XGEN(b.x)]) == gen, bar);
            __builtin_amdgcn_fence(__ATOMIC_ACQUIRE, "agent");
            asm volatile("s_waitcnt vmcnt(0)" ::: "memory");
        }
    }
    __syncthreads();
}

#define CTR_A(x) (XCD_BAR_WORDS + 64 * (x))
#define CTR_B(x) (XCD_BAR_WORDS + 512 + 64 * (x))
#define CTL_WORDS (XCD_BAR_WORDS + 1024)
typedef float f32x2 __attribute__((ext_vector_type(2)));
DEVI float ub(unsigned w, int n) { return (float)((w >> (8 * n)) & 0xffu); }
DEVI float gelu_erf(float v) {
    const float av = fabsf(v), t = rcp_(av * 0.2316418882f + 1.0f);
    float q = t * 0.5307027145f + (-0.7265760135f);
    q = q * t + 0.7107068705f; q = q * t + (-0.142248368f); q = q * t + 0.127414796f; q = q * t;
    const float e = __builtin_amdgcn_exp2f((v * v) * (-0.72134752044f));
    const float m = v * (q * e);
    return v < 0.f ? m : v - m;
}
struct ExpMeta { uint4 e[2]; uint4 xa; uint4 xb; float sc; };
struct ExpRows { uint4 r[16]; unsigned x1; };

template <int PHASE> DEVI void exp_load_meta(const Params& p, ExpMeta& m, int t, int x, int lane) {
    const uint4* ep = (const uint4*)(p.eperm + (size_t)t * 128 + (lane >> 3) * 16);
    m.e[0] = ep[0];
    m.e[1] = ep[1];
    if (PHASE == 0) { const uint4* xp = (const uint4*)(p.xq + (size_t)t * 1024 + 256 * x + 32 * (lane & 7)); m.xa = xp[0]; m.xb = xp[1]; }
    else { m.xa = *(const uint4*)(p.aq + (size_t)t * 128 + (lane >> 3) * 16); m.sc = p.asc[t]; }
}
template <int PHASE> DEVI void exp_issue(const Params& p, const ExpMeta& m, ExpRows& R, int t, int x, int lane) {
    const unsigned char* base = (PHASE == 0 ? p.down_q : p.up_q) + (size_t)x * (16384 * 128) + (lane & 7) * 16;
    const unsigned ew[8] = {m.e[0].x, m.e[0].y, m.e[0].z, m.e[0].w, m.e[1].x, m.e[1].y, m.e[1].z, m.e[1].w};
#pragma unroll
    for (int j = 0; j < 16; ++j) {
        const unsigned ek = (j & 1) ? (ew[j >> 1] >> 16) : (ew[j >> 1] & 0xffffu);
        R.r[j] = *(const uint4*)(base + (size_t)ek * 128);
    }
    if (PHASE == 1) {
        const int col = 128 * x + 16 * (lane & 7) + ((lane & 32) ? 8 : 0) + ((lane & 16) ? 4 : 0) + ((lane & 8) ? 2 : 0);
        R.x1 = *(const unsigned*)(p.x1b + (size_t)t * 1024 + col);
    }
}
DEVI void expA_compute(const Params& p, const ExpMeta& m, const ExpRows& R, int t, int x, int lane) {
    const bool b2 = lane & 4, b1 = lane & 2, b0 = lane & 1;
    int ps[16];
    const int xq8[8] = {(int)m.xa.x, (int)m.xa.y, (int)m.xa.z, (int)m.xa.w, (int)m.xb.x, (int)m.xb.y, (int)m.xb.z, (int)m.xb.w};
#pragma unroll
    for (int j = 0; j < 16; ++j) {
        const unsigned wd[4] = {R.r[j].x, R.r[j].y, R.r[j].z, R.r[j].w};
        int a = 0;
#pragma unroll
        for (int d = 0; d < 4; ++d) {
            a = __builtin_amdgcn_sdot4((int)(wd[d] & 0x0f0f0f0fu), xq8[2 * d], a, false);
            a = __builtin_amdgcn_sdot4((int)((wd[d] >> 4) & 0x0f0f0f0fu), xq8[2 * d + 1], a, false);
        }
        ps[j] = a;
    }
    int sx = 0;
#pragma unroll
    for (int d = 0; d < 8; ++d) sx = __builtin_amdgcn_sdot4(xq8[d], 0x01010101, sx, false);
    sx += dpp_i<DPP_HMIRROR>(sx); sx += dpp_i<DPP_XOR2>(sx); sx += dpp_i<DPP_XOR1>(sx);
    int q8[8], q4[4], q2[2];
#pragma unroll
    for (int j = 0; j < 8; ++j) { const int snd = b2 ? ps[j] : ps[j + 8], kp = b2 ? ps[j + 8] : ps[j]; q8[j] = kp + dpp_i<DPP_HMIRROR>(snd); }
#pragma unroll
    for (int j = 0; j < 4; ++j) { const int snd = b1 ? q8[j] : q8[j + 4], kp = b1 ? q8[j + 4] : q8[j]; q4[j] = kp + dpp_i<DPP_XOR2>(snd); }
#pragma unroll
    for (int j = 0; j < 2; ++j) { const int snd = b0 ? q4[j] : q4[j + 2], kp = b0 ? q4[j + 2] : q4[j]; q2[j] = kp + dpp_i<DPP_XOR1>(snd); }
    {
        int s0 = q2[0] - 8 * sx, s1 = q2[1] - 8 * sx;
        s0 = s0 > 32767 ? 32767 : (s0 < -32768 ? -32768 : s0);
        s1 = s1 > 32767 ? 32767 : (s1 < -32768 ? -32768 : s1);
        *(unsigned*)(p.part + ((size_t)x * T_TOK + t) * 128 + 2 * lane) = ((unsigned)s0 & 0xffffu) | ((unsigned)s1 << 16);
    }
}
DEVI void expB_compute(const Params& p, const ExpMeta& m, const ExpRows& R, int t, int x, int lane) {
    const bool b5 = lane & 32, b4 = lane & 16, b3 = lane & 8;
    const unsigned pa[4] = {m.xa.x, m.xa.y, m.xa.z, m.xa.w};
    int acc[16];
#pragma unroll
    for (int c = 0; c < 16; ++c) acc[c] = 0;
#pragma unroll
    for (int g = 0; g < 4; ++g) {
        const unsigned r0[4] = {R.r[4 * g].x, R.r[4 * g].y, R.r[4 * g].z, R.r[4 * g].w};
        const unsigned r1[4] = {R.r[4 * g + 1].x, R.r[4 * g + 1].y, R.r[4 * g + 1].z, R.r[4 * g + 1].w};
        const unsigned r2[4] = {R.r[4 * g + 2].x, R.r[4 * g + 2].y, R.r[4 * g + 2].z, R.r[4 * g + 2].w};
        const unsigned r3[4] = {R.r[4 * g + 3].x, R.r[4 * g + 3].y, R.r[4 * g + 3].z, R.r[4 * g + 3].w};
#pragma unroll
        for (int i = 0; i < 4; ++i) {
            const unsigned t0 = __builtin_amdgcn_perm(r1[i], r0[i], 0x05010400u), t1 = __builtin_amdgcn_perm(r1[i], r0[i], 0x07030602u);
            const unsigned t2 = __builtin_amdgcn_perm(r3[i], r2[i], 0x05010400u), t3 = __builtin_amdgcn_perm(r3[i], r2[i], 0x07030602u);
            const unsigned o0 = __builtin_amdgcn_perm(t2, t0, 0x05040100u), o1 = __builtin_amdgcn_perm(t2, t0, 0x07060302u);
            const unsigned o2 = __builtin_amdgcn_perm(t3, t1, 0x05040100u), o3 = __builtin_amdgcn_perm(t3, t1, 0x07060302u);
            acc[4 * i + 0] = __builtin_amdgcn_sdot4((int)o0, (int)pa[g], acc[4 * i + 0], false);
            acc[4 * i + 1] = __builtin_amdgcn_sdot4((int)o1, (int)pa[g], acc[4 * i + 1], false);
            acc[4 * i + 2] = __builtin_amdgcn_sdot4((int)o2, (int)pa[g], acc[4 * i + 2], false);
            acc[4 * i + 3] = __builtin_amdgcn_sdot4((int)o3, (int)pa[g], acc[4 * i + 3], false);
        }
    }
    int q8[8], q4[4], q2[2];
#pragma unroll
    for (int j = 0; j < 8; ++j) {
        const auto r = __builtin_amdgcn_permlane32_swap((unsigned)acc[j], (unsigned)acc[j + 8], false, false);
        q8[j] = (int)r[0] + (int)r[1];
    }
#pragma unroll
    for (int j = 0; j < 4; ++j) {
        const auto r = __builtin_amdgcn_permlane16_swap((unsigned)q8[j], (unsigned)q8[j + 4], false, false);
        q4[j] = (int)r[0] + (int)r[1];
    }
#pragma unroll
    for (int j = 0; j < 2; ++j) { const int snd = b3 ? q4[j] : q4[j + 2], kp = b3 ? q4[j + 2] : q4[j]; q2[j] = kp + dpp_i<DPP_ROR8>(snd); }
    const int col = 128 * x + 16 * (lane & 7) + (b5 ? 8 : 0) + (b4 ? 4 : 0) + (b3 ? 2 : 0);
    *(unsigned*)(p.proj + (size_t)t * 1024 + col) = pk2(bflo(R.x1) + (float)q2[0] * m.sc, bfhi(R.x1) + (float)q2[1] * m.sc);
}
constexpr int EXP_NP = 16;
template <int PHASE>
DEVI void exp_chunk(const Params& p, int tb, int x, int lane) {
    ExpMeta mA, mB, nA, nB;
    ExpRows rA, rB;
    exp_load_meta<PHASE>(p, mA, tb, x, lane);
    exp_load_meta<PHASE>(p, mB, tb + 1, x, lane);
    exp_issue<PHASE>(p, mA, rA, tb, x, lane);
    exp_issue<PHASE>(p, mB, rB, tb + 1, x, lane);
    exp_load_meta<PHASE>(p, nA, tb + 2, x, lane);
    exp_load_meta<PHASE>(p, nB, tb + 3, x, lane);
#pragma unroll 1
    for (int i = 0; i < EXP_NP; ++i) {
        const int tA = tb + 2 * i, tB = tA + 1;
        if (PHASE == 0) expA_compute(p, mA, rA, tA, x, lane); else expB_compute(p, mA, rA, tA, x, lane);
        if (i < EXP_NP - 1) {
            mA = nA;
            exp_issue<PHASE>(p, mA, rA, tA + 2, x, lane);
            if (i < EXP_NP - 2) exp_load_meta<PHASE>(p, nA, tA + 4, x, lane);
        }
        if (PHASE == 0) expA_compute(p, mB, rB, tB, x, lane); else expB_compute(p, mB, rB, tB, x, lane);
        if (i < EXP_NP - 1) {
            mB = nB;
            exp_issue<PHASE>(p, mB, rB, tB + 2, x, lane);
            if (i < EXP_NP - 2) exp_load_meta<PHASE>(p, nB, tB + 4, x, lane);
        }
    }
}
template <int PHASE>
DEVI void st_expAB(const Params& p, char* smem) {
    const int tid = stid(), lane = tid & 63, wid = tid >> 6;
    volatile int* cs = (volatile int*)smem;
    const unsigned myx = xb_xcc_id() & 7u;
    constexpr int NCH = T_TOK / (2 * EXP_NP * NW);
    constexpr int NSL = PHASE == 0 ? 4 : 8;
    for (int si = 0; si < NSL; ++si) {
        const int x = (int)((myx + si) & (unsigned)(NSL - 1));
        unsigned* ctr = &p.bar[PHASE == 0 ? CTR_A(x) : CTR_B(x)];
        if (tid == 0) cs[0] = (int)xb_add(ctr, 1u);
        __syncthreads();
        int chunk = cs[0];
        __syncthreads();
        while (chunk < NCH) {
            int nxt = 0;
            if (tid == 0) nxt = (int)xb_add(ctr, 1u);
            exp_chunk<PHASE>(p, chunk * (2 * EXP_NP * NW) + wid * (2 * EXP_NP), x, lane);
            if (tid == 0) cs[0] = nxt;
            __syncthreads();
            chunk = cs[0];
            __syncthreads();
        }
    }
}
DEVI void st_expA2(const Params& p) {
    const int lane = stid() & 63, wid = stid() >> 6;
    for (int t0 = (blockIdx.x * NW + wid) * 2; t0 < T_TOK; t0 += gridDim.x * NW * 2) {
        unsigned pv[2][4], ew[2];
        float2 g[2];
        float xs[2];
#pragma unroll
        for (int q = 0; q < 2; ++q) {
            const int t = t0 + q;
#pragma unroll
            for (int x = 0; x < 4; ++x) pv[q][x] = *(const unsigned*)(p.part + ((size_t)x * T_TOK + t) * 128 + 2 * lane);
            ew[q] = *(const unsigned*)(p.eperm + (size_t)t * 128 + 2 * lane);
            g[q] = *(const float2*)(p.gate + (size_t)t * 128 + 2 * lane);
            xs[q] = rs2_of(p.rs2p, t) * ZQ_SCALE;
        }
        float ds[2][2], us[2][2];
#pragma unroll
        for (int q = 0; q < 2; ++q) {
            const int ea = (int)(ew[q] & 0xffffu), eb = (int)(ew[q] >> 16);
            ds[q][0] = p.dscale[ea]; ds[q][1] = p.dscale[eb]; us[q][0] = p.uscale[ea]; us[q][1] = p.uscale[eb];
        }
#pragma unroll
        for (int q = 0; q < 2; ++q) {
            const int t = t0 + q;
            int s0 = 0, s1 = 0;
#pragma unroll
            for (int x = 0; x < 4; ++x) { s0 += (int)(short)(pv[q][x] & 0xffffu); s1 += (int)pv[q][x] >> 16; }
            const float a0 = g[q].x * gelu_erf((float)s0 * xs[q] * ds[q][0]) * us[q][0];
            const float a1 = g[q].y * gelu_erf((float)s1 * xs[q] * ds[q][1]) * us[q][1];
            const float amax = wave_max(fmaxf(fabsf(a0), fabsf(a1)));
            const float inv = amax > 0.f ? 127.f * rcp_(amax) : 0.f;
            const unsigned q0 = (unsigned)((int)rintf(a0 * inv) & 255), q1 = (unsigned)((int)rintf(a1 * inv) & 255);
            *(unsigned short*)(p.aq + (size_t)t * 128 + 2 * lane) = (unsigned short)(q0 | (q1 << 8));
            if (lane == 0) p.asc[t] = amax * (1.f / 127.f);
        }
    }
}
DEVI void st_expC(const Params& p) {
    const int lane = stid() & 63, wid = stid() >> 6;
    for (int t0 = (blockIdx.x * NW + wid) * 2; t0 < T_TOK; t0 += gridDim.x * NW * 2) {
        uint2 u[2][4];
#pragma unroll
        for (int q = 0; q < 2; ++q) {
            const uint2* row = (const uint2*)(p.proj + (size_t)(t0 + q) * 1024);
#pragma unroll
            for (int j = 0; j < 4; ++j) u[q][j] = row[lane + 64 * j];
        }
#pragma unroll
        for (int q = 0; q < 2; ++q) {
            float4 v[4];
            float ss = 0.f;
#pragma unroll
            for (int j = 0; j < 4; ++j) {
                v[j] = make_float4(bflo(u[q][j].x), bfhi(u[q][j].x), bflo(u[q][j].y), bfhi(u[q][j].y));
                ss += v[j].x * v[j].x + v[j].y * v[j].y + v[j].z * v[j].z + v[j].w * v[j].w;
            }
            ss = wave_sum(ss);
            const float rf = rsqrtf(ss * (1.f / 1024.f) + EPSN);
            float4* orow = (float4*)(p.out + (size_t)(t0 + q) * 1024);
#pragma unroll
            for (int j = 0; j < 4; ++j) {
                const float4 g = *(const float4*)(p.final_g + (lane + 64 * j) * 4);
                orow[lane + 64 * j] = make_float4(v[j].x * rf * g.x, v[j].y * rf * g.y, v[j].z * rf * g.z, v[j].w * rf * g.w);
            }
        }
    }
}

constexpr int LDS_BYTES = 147456;
constexpr int LDS_BARW = LDS_BYTES - 16;
extern __shared__ __attribute__((aligned(16))) char smem_dyn[];
__global__ void __launch_bounds__(NTHR, 2) mega_fwd(Params p) {
    cg::grid_group grid = cg::this_grid();
    volatile LAS unsigned* bst = (volatile LAS unsigned*)(LAS char*)(smem_dyn + LDS_BARW);
    if (stid() < 4) bst[stid()] = 0u;
    __syncthreads();
    XcdBarrier bar = xcd_barrier_post(p.bar, bst);
    st_prep_misc(p);
    st_prep_w1(p, smem_dyn);
    st_prep_x(p, smem_dyn);
    if (p.pad_[0] == 0x7fffabcd) grid.sync();
    xcd_barrier(bar);
    st_gemm8<EpiProj8, PG8_ALIGN>(p.xb, p.W1t, NPJ, 1024, smem_dyn, EpiProj8{p.proj, p.rs1, p.rope_cos, p.rope_sin});
    xcd_barrier(bar);
    st_conv_qk(p, smem_dyn);
    xcd_barrier(bar);
    st_recur(p, smem_dyn);
    xcd_barrier(bar);
    st_gemm8<EpiX18, PG8_ALIGN>(p.yb, p.W2t, 1024, 1024, smem_dyn, EpiX18{p.x, p.x1b, p.xq, p.rs2p, p.norm2_g});
    xcd_barrier(bar);
    st_gemm3_topk(p, smem_dyn);
    xcd_barrier(bar);
    st_expAB<0>(p, smem_dyn);
    xcd_barrier(bar);
    st_expA2(p);
    xcd_barrier(bar);
    st_expAB<1>(p, smem_dyn);
    xcd_barrier(bar);
    st_expC(p);
}

extern "C" void kernel_launch(void* const* d_in, const int* in_sizes, int n_in, void* d_out, int out_size, void* d_ws, size_t ws_size,
                              hipStream_t stream) {
    Params p{};
    const float* const* in = (const float* const*)d_in;
    p.x = in[0]; p.norm1_g = in[1]; p.w_in = in[2]; p.ret_norm_g = in[3]; p.m_conv_w = in[4]; p.m_conv_b = in[5]; p.m_wq = in[6]; p.m_wk = in[7];
    p.m_b_i = in[8]; p.m_b_f = in[9]; p.m_norm_g = in[10]; p.m_skip = in[11]; p.w_out = in[12]; p.norm2_g = in[13]; p.peer_wq = in[14];
    p.peer_keys = in[15]; p.peer_down = in[16]; p.peer_up = in[17]; p.final_g = in[18];
    p.out = (float*)d_out;
    char* ws = (char*)d_ws;
    size_t off = 0;
    auto take = [&](size_t bytes) { char* r = ws + off; off += (bytes + 255) & ~(size_t)255; return r; };
    p.proj = (bf16_t*)take((size_t)T_TOK * NPJ * 2);
    p.xb = (bf16_t*)take((size_t)T_TOK * 1024 * 2);
    p.yb = p.xb;
    p.gate = (float*)(ws + (size_t)T_TOK * 2048 * 4);
    p.mq = (bf16_t*)take((size_t)T_TOK * 512 * 2);
    p.mk = (bf16_t*)take((size_t)T_TOK * 512 * 2);
    p.x1b = p.mq;
    p.cbuf = (bf16_t*)take((size_t)T_TOK * 512 * 2);
    p.eperm = (unsigned short*)p.cbuf;
    p.down_q = (unsigned char*)take((size_t)16384 * 1024);
    p.up_q = (unsigned char*)take((size_t)16384 * 1024);
    p.dscale = (float*)take(16384 * 4);
    p.uscale = (float*)take(16384 * 4);
    p.bar = (unsigned*)take(CTL_WORDS * 4);
    p.xq = (unsigned char*)take((size_t)T_TOK * 1024);
    p.asc = (float*)take(T_TOK * 4);
    p.aq = (unsigned char*)take((size_t)T_TOK * 128);
    p.part = (short*)(ws + (size_t)T_TOK * 1024 * 4);
    p.W1t = (bf16_t*)take((size_t)NPJ * 1024 * 2);
    p.W2t = (bf16_t*)take((size_t)1024 * 1024 * 2);
    p.Wsubq = (signed char*)take((size_t)2048 * 1024);
    p.wsc = (float*)take(2048 * 4);
    p.Wqt = (bf16_t*)take(4 * 128 * 128 * 2);
    p.Wkt = (bf16_t*)take(4 * 128 * 128 * 2);
    p.rs1 = (float*)take(T_TOK * 4);
    p.rs2p = (float*)take((size_t)T_TOK * 16 * 4);
    p.ipre = (float*)take(T_TOK * 4 * 4);
    p.logf = (float*)take(T_TOK * 4 * 4);
    p.rope_cos = (float*)take(2048 * 64 * 4);
    p.rope_sin = (float*)take(2048 * 64 * 4);
    if (off > ws_size) { fprintf(stderr, "kernel_launch: workspace too small (%zu > %zu)\n", off, ws_size); return; }

    static int grid_blocks = 0;
    if (!grid_blocks) {
        int dev = 0, cus = 0, per_cu = 0;
        (void)hipGetDevice(&dev);
        (void)hipDeviceGetAttribute(&cus, hipDeviceAttributeMultiprocessorCount, dev);
        (void)hipFuncSetAttribute((const void*)mega_fwd, hipFuncAttributeMaxDynamicSharedMemorySize, LDS_BYTES);
        (void)hipOccupancyMaxActiveBlocksPerMultiprocessor(&per_cu, (const void*)mega_fwd, NTHR, LDS_BYTES);
        if (per_cu > 1) per_cu = 1;
        if (per_cu < 1) per_cu = 1;
        grid_blocks = cus * per_cu;
    }
    (void)hipMemsetAsync(p.bar, 0, CTL_WORDS * 4, stream);
    void* args[] = {&p};
    hipError_t e = hipLaunchCooperativeKernel((const void*)mega_fwd, dim3(grid_blocks), dim3(NTHR), args, LDS_BYTES, stream);
    if (e != hipSuccess) fprintf(stderr, "cooperative launch failed: %s (grid %d)\n", hipGetErrorString(e), grid_blocks);
}
```

```cpp
#include <hip/hip_runtime.h>
#include <hip/hip_cooperative_groups.h>
#include <stdint.h>
#include <cstdio>
namespace cg = cooperative_groups;

typedef unsigned short bf16_t;
typedef short bf16x8 __attribute__((ext_vector_type(8)));
typedef float f32x4 __attribute__((ext_vector_type(4)));
typedef int i32x4 __attribute__((ext_vector_type(4)));

#define DEVI __device__ __forceinline__
__device__ __forceinline__ int stid() { int t = (int)threadIdx.x; asm volatile("" : "+v"(t)); return t; }

constexpr int T_TOK = 32768, DM = 1024, NPJ = 3584, DIN = 3592;
constexpr int NPR = 1536;
constexpr size_t OPB = (size_t)T_TOK * 512;
__device__ __forceinline__ size_t blk_off(int t16, int h) { return ((size_t)(((t16 >> 2) * 4 + h) * 4 + (t16 & 3))) * 2048; }
constexpr int NTHR = 512, NW = 8;
constexpr float EPSN = 1e-6f;

struct Params {
    const float *x, *norm1_g, *w_in, *ret_norm_g, *m_conv_w, *m_conv_b, *m_wq, *m_wk, *m_b_i, *m_b_f, *m_norm_g, *m_skip, *w_out,
        *norm2_g, *peer_wq, *peer_keys, *peer_down, *peer_up, *final_g;
    float* out;
    bf16_t *proj, *xb, *yb, *mq, *mk, *x1b, *cbuf, *W1t, *W2t, *Wqt, *Wkt;
    signed char* Wsubq;
    float* wsc;
    unsigned char *down_q, *up_q;
    float *dscale, *uscale, *asc;
    unsigned short* eperm;
    unsigned char* aq;
    short* part;
    unsigned char* xq;
    unsigned* bar;
    float *rs1, *rs2p, *ipre, *logf, *rope_cos, *rope_sin, *gate;
    int pad_[2];
};

DEVI unsigned f2bf_bits(float f) { unsigned u = __float_as_uint(f); return (u + 0x7fffu + ((u >> 16) & 1u)) >> 16; }
DEVI bf16_t f2bf(float f) { return __builtin_bit_cast(bf16_t, (__bf16)f); }
typedef __bf16 bf16x2_t __attribute__((ext_vector_type(2)));
DEVI unsigned pk2(float lo, float hi) { bf16x2_t v = {(__bf16)lo, (__bf16)hi}; return __builtin_bit_cast(unsigned, v); }
DEVI float bflo(unsigned w) { return __uint_as_float(w << 16); }
DEVI float bfhi(unsigned w) { return __uint_as_float(w & 0xffff0000u); }
DEVI float bf2f(bf16_t h) { return __uint_as_float(((unsigned)h) << 16); }
template <int CTRL> DEVI float dpp_f(float v) { return __int_as_float(__builtin_amdgcn_update_dpp(0, __float_as_int(v), CTRL, 0xf, 0xf, false)); }
template <int CTRL> DEVI int dpp_i(int v) { return __builtin_amdgcn_update_dpp(0, v, CTRL, 0xf, 0xf, false); }
constexpr int DPP_XOR1 = 0xB1  , DPP_XOR2 = 0x4E  , DPP_HMIRROR = 0x141  ,
              DPP_MIRROR = 0x140  , DPP_ROR8 = 0x128  ;
DEVI float rl_f(float v, int l) { return __int_as_float(__builtin_amdgcn_readlane(__float_as_int(v), l)); }
DEVI float wave_sum(float v) {
    v += dpp_f<DPP_XOR1>(v); v += dpp_f<DPP_XOR2>(v); v += dpp_f<DPP_HMIRROR>(v); v += dpp_f<DPP_MIRROR>(v);
    return (rl_f(v, 0) + rl_f(v, 16)) + (rl_f(v, 32) + rl_f(v, 48));
}
DEVI float wave_max(float v) {
    v = fmaxf(v, dpp_f<DPP_XOR1>(v)); v = fmaxf(v, dpp_f<DPP_XOR2>(v)); v = fmaxf(v, dpp_f<DPP_HMIRROR>(v)); v = fmaxf(v, dpp_f<DPP_MIRROR>(v));
    return fmaxf(fmaxf(rl_f(v, 0), rl_f(v, 16)), fmaxf(rl_f(v, 32), rl_f(v, 48)));
}
constexpr float ZQ_SCALE = 6.f / 127.f;
DEVI float rs2_of(const float* rs2p, int t) {
    const float4* q = (const float4*)(rs2p + (size_t)t * 16);
    const float4 a = q[0], b = q[1], c = q[2], d = q[3];
    const float ss = ((a.x + a.y) + (a.z + a.w)) + ((b.x + b.y) + (b.z + b.w)) + ((c.x + c.y) + (c.z + c.w)) + ((d.x + d.y) + (d.z + d.w));
    return rsqrtf(ss * (1.f / 1024.f) + EPSN);
}
DEVI f32x4 mfma16(bf16x8 a, bf16x8 b, f32x4 c) { return __builtin_amdgcn_mfma_f32_16x16x32_bf16(a, b, c, 0, 0, 0); }
DEVI bf16x8 ld8(const char* p) { return *reinterpret_cast<const bf16x8*>(p); }
DEVI bf16x8 mk8(uint2 lo, uint2 hi) {
    union { uint4 u; bf16x8 v; } x;
    x.u = make_uint4(lo.x, lo.y, hi.x, hi.y);
    return x.v;
}
DEVI float fexp_(float x) { return __builtin_amdgcn_exp2f(x * 1.4426950408889634f); }
DEVI float rcp_(float x) { return __builtin_amdgcn_rcpf(x); }
DEVI float sigmoidf_(float z) { return rcp_(1.f + fexp_(-z)); }

DEVI void st_prep_misc(const Params& p) {
    const int gtid = blockIdx.x * NTHR + stid(), gsz = gridDim.x * NTHR;
    for (int i = gtid; i < 2048 * 64; i += gsz) {
        const int pos = i >> 6, j = i & 63;
        const float inv = powf(10000.f, -(float)j * (1.f / 64.f));
        const float ang = (float)pos * inv;
        float s, c;
        sincosf(ang, &s, &c);
        p.rope_cos[i] = c;
        p.rope_sin[i] = s;
    }
    for (int i = gtid; i < 4 * 128 * 128; i += gsz) {
        const int h = i >> 14, e = (i >> 7) & 127, d = i & 127;
        p.Wqt[i] = f2bf(p.m_wq[h * 16384 + d * 128 + e]);
        p.Wkt[i] = f2bf(p.m_wk[h * 16384 + d * 128 + e] * 0.08838834764831845f);
    }
}
DEVI void prep_table_row(const Params& p, int row, const float4 (&v)[4], int lane) {
    const bool up = row >= 16384;
    const int e = up ? row - 16384 : row;
    float am = 0.f, ss = 0.f;
#pragma unroll
    for (int i = 0; i < 4; ++i) {
        am = fmaxf(am, fmaxf(fmaxf(fabsf(v[i].x), fabsf(v[i].y)), fmaxf(fabsf(v[i].z), fabsf(v[i].w))));
        ss += v[i].x * v[i].x + v[i].y * v[i].y + v[i].z * v[i].z + v[i].w * v[i].w;
    }
    am = wave_max(am);
    ss = wave_sum(ss);
    float sc = fminf(am * (1.f / 7.f), 0.36f * sqrtf(ss * (1.f / 1024.f)));
    sc = sc > 0.f ? sc : 1.f;
    const float inv = 1.f / sc;
    unsigned w2[2];
#pragma unroll
    for (int g = 0; g < 2; ++g) {
        const float lo[4] = {v[2 * g].x, v[2 * g].y, v[2 * g].z, v[2 * g].w}, hi[4] = {v[2 * g + 1].x, v[2 * g + 1].y, v[2 * g + 1].z, v[2 * g + 1].w};
        unsigned d = 0u;
#pragma unroll
        for (int i = 0; i < 4; ++i) {
            const int ql = (int)fminf(fmaxf(rintf(lo[i] * inv), -7.f), 7.f), qh = (int)fminf(fmaxf(rintf(hi[i] * inv), -7.f), 7.f);
            d |= ((unsigned)((up ? ql + 8 : ql) & 15) | ((unsigned)(qh & 15) << 4)) << (8 * i);
        }
        w2[g] = d;
    }
    *(uint2*)((up ? p.up_q : p.down_q) + ((size_t)(lane >> 4) * 16384 + e) * 128 + (lane & 15) * 8) = make_uint2(w2[0], w2[1]);
    if (lane == 0) { if (up) p.uscale[e] = sc * (1.f / 16.f); else p.dscale[e] = sc; }
}
DEVI void st_prep_tables(const Params& p, int bid, int nb) {
    const int lane = stid() & 63, wid = stid() >> 6;
    for (int row = (bid * NW + wid) * 2; row < 32768; row += nb * NW * 2) {
        float4 va[4], vb[4];
        const float4* sa = (const float4*)((row >= 16384 ? p.peer_up + (size_t)(row - 16384) * 1024 : p.peer_down + (size_t)row * 1024) + lane * 16);
        const float4* sb = (const float4*)((row + 1 >= 16384 ? p.peer_up + (size_t)(row + 1 - 16384) * 1024 : p.peer_down + (size_t)(row + 1) * 1024) + lane * 16);
#pragma unroll
        for (int i = 0; i < 4; ++i) { va[i] = sa[i]; vb[i] = sb[i]; }
        prep_table_row(p, row, va, lane);
        prep_table_row(p, row + 1, vb, lane);
    }
}

DEVI void transpose_tile(const float* __restrict__ src, int ld, const float* __restrict__ scale, bf16_t* __restrict__ dst, int K, int k0, int n0,
                         float* tile, bool permqk = false) {
    const int tid = stid();
    {
        const int tx = tid & 63, ty = tid >> 6;
#pragma unroll
        for (int i = 0; i < 4; ++i) {
            const int k = k0 + ty + 8 * i;
            float v = src[(size_t)k * ld + n0 + tx];
            if (scale) v *= scale[k];
            tile[(ty + 8 * i) * 65 + tx] = v;
        }
    }
    __syncthreads();
    {
        const int n = tid >> 3, kq = tid & 7;
        const float a = tile[(4 * kq) * 65 + n], b = tile[(4 * kq + 1) * 65 + n], c = tile[(4 * kq + 2) * 65 + n], d = tile[(4 * kq + 3) * 65 + n];
        int nn = n0 + n;
        if (permqk && nn < 1024) { const int dd = nn & 127; nn = (nn & ~127) + (dd < 64 ? 2 * dd : 2 * (dd - 64) + 1); }
        *(uint2*)(dst + (size_t)nn * K + k0 + 4 * kq) = make_uint2(pk2(a, b), pk2(c, d));
    }
    __syncthreads();
}
DEVI void st_prep_w1(const Params& p, char* smem) {
    float* tile = (float*)smem;
    for (int it = blockIdx.x; it < 56 * 32; it += gridDim.x) transpose_tile(p.w_in, DIN, p.norm1_g, p.W1t, 1024, (it & 31) * 32, (it >> 5) * 64, tile, true);
}
DEVI void st_prep_w2(const Params& p, char* smem, int bid, int nb) {
    float* tile = (float*)smem;
    for (int it = bid; it < 16 * 32; it += nb) transpose_tile(p.w_out, 1024, nullptr, p.W2t, 1024, (it & 31) * 32, (it >> 5) * 64, tile);
}
DEVI void st_prep_wsub(const Params& p, char* smem, int bid, int nb) {
    float* wq_s = (float*)smem;
    float* key_s = wq_s + 64 * 132;
    const int tid = stid(), nl = tid >> 5, kp = tid & 31;
    for (int it = bid; it < 16 * 8; it += nb) {
        const int grp = it >> 3, n0 = (it & 7) * 16;
        __syncthreads();
        {
            const int idx = tid * 4, n = idx >> 7, d = idx & 127;
            *(float4*)(key_s + n * 132 + d) = *(const float4*)(p.peer_keys + ((size_t)grp * 128 + n0 + n) * 128 + d);
        }
        float v0[16], v1[16];
#pragma unroll 1
        for (int kt = 0; kt < 16; ++kt) {
            __syncthreads();
#pragma unroll
            for (int i = 0; i < 4; ++i) {
                const int idx = (tid + 512 * i) * 4, r = idx >> 7, d = idx & 127;
                *(float4*)(wq_s + r * 132 + d) = *(const float4*)(p.peer_wq + (size_t)(kt * 64 + r) * 2048 + grp * 128 + d);
            }
            __syncthreads();
            float a0 = 0.f, a1 = 0.f;
#pragma unroll 8
            for (int d4 = 0; d4 < 32; ++d4) {
                const float4 w0 = *(const float4*)(wq_s + (2 * kp) * 132 + 4 * d4), w1 = *(const float4*)(wq_s + (2 * kp + 1) * 132 + 4 * d4);
                const float4 y = *(const float4*)(key_s + nl * 132 + 4 * d4);
                a0 += w0.x * y.x + w0.y * y.y + w0.z * y.z + w0.w * y.w;
                a1 += w1.x * y.x + w1.y * y.y + w1.z * y.z + w1.w * y.w;
            }
#pragma unroll
            for (int q = 0; q < 16; ++q) if (q == kt) { v0[q] = a0; v1[q] = a1; }
        }
        float am = 0.f;
#pragma unroll
        for (int q = 0; q < 16; ++q) am = fmaxf(am, fmaxf(fabsf(v0[q]), fabsf(v1[q])));
#pragma unroll
        for (int o = 16; o; o >>= 1) am = fmaxf(am, __shfl_xor(am, o));
        const float inv = am > 0.f ? 127.f * rcp_(am) : 0.f;
        signed char* orow = p.Wsubq + (size_t)(grp * 128 + n0 + nl) * 1024 + 2 * kp;
#pragma unroll
        for (int q = 0; q < 16; ++q) {
            const int q0 = (int)rintf(v0[q] * inv), q1 = (int)rintf(v1[q] * inv);
            *(unsigned short*)(orow + 64 * q) = (unsigned short)((q0 & 255) | ((q1 & 255) << 8));
        }
        if (kp == 0) p.wsc[grp * 128 + n0 + nl] = am > 0.f ? am * (1.f / 127.f) : 1.f;
    }
    __syncthreads();
}

DEVI void prep_x_token(const Params& p, const float* Wg_s, int t, const float4 (&v)[4], int lane) {
    float ss = 0.f, g8[8];
#pragma unroll
    for (int g = 0; g < 8; ++g) g8[g] = 0.f;
#pragma unroll
    for (int j = 0; j < 4; ++j) {
        ss += v[j].x * v[j].x + v[j].y * v[j].y + v[j].z * v[j].z + v[j].w * v[j].w;
#pragma unroll
        for (int g = 0; g < 8; ++g) {
            const float4 w = *(const float4*)(Wg_s + g * 1024 + (lane + 64 * j) * 4);
            g8[g] += v[j].x * w.x + v[j].y * w.y + v[j].z * w.z + v[j].w * w.w;
        }
    }
    ss = wave_sum(ss);
    const bool b5 = lane & 32, b4 = lane & 16, b3 = lane & 8;
    float q4[4], q2[2], q1;
#pragma unroll
    for (int j = 0; j < 4; ++j) { const float snd = b5 ? g8[j] : g8[j + 4], kp = b5 ? g8[j + 4] : g8[j]; q4[j] = kp + __shfl_xor(snd, 32); }
#pragma unroll
    for (int j = 0; j < 2; ++j) { const float snd = b4 ? q4[j] : q4[j + 2], kp = b4 ? q4[j + 2] : q4[j]; q2[j] = kp + __shfl_xor(snd, 16); }
    { const float snd = b3 ? q2[0] : q2[1], kp = b3 ? q2[1] : q2[0]; q1 = kp + __shfl_xor(snd, 8); }
    q1 += __shfl_xor(q1, 4);
    q1 += __shfl_xor(q1, 2);
    q1 += __shfl_xor(q1, 1);
    const float rs = rsqrtf(ss * (1.f / 1024.f) + EPSN);
    uint2* o = (uint2*)(p.xb + (size_t)t * 1024);
#pragma unroll
    for (int j = 0; j < 4; ++j) o[lane + 64 * j] = make_uint2(pk2(v[j].x, v[j].y), pk2(v[j].z, v[j].w));
    if (lane == 0) p.rs1[t] = rs;
    if ((lane & 7) == 0) {
        const int gi = (b5 ? 4 : 0) + (b4 ? 2 : 0) + (b3 ? 1 : 0);
        if (gi < 4) p.ipre[t * 4 + gi] = q1 * rs + p.m_b_i[gi];
        else {
            const float z = q1 * rs + p.m_b_f[gi - 4];
            p.logf[t * 4 + gi - 4] = fminf(z, 0.f) - log1pf(fexp_(-fabsf(z)));
        }
    }
}
DEVI void st_prep_x(const Params& p, char* smem) {
    float* Wg_s = (float*)smem;
    for (int i = stid(); i < 8192; i += NTHR) {
        const int k = i >> 3, g = i & 7;
        Wg_s[g * 1024 + k] = p.norm1_g[k] * p.w_in[(size_t)k * DIN + NPJ + g];
    }
    __syncthreads();
    const int lane = stid() & 63, wid = stid() >> 6;
    for (int t = (blockIdx.x * NW + wid) * 4; t < T_TOK; t += gridDim.x * NW * 4) {
        float4 v[4][4];
        const float4* xa = (const float4*)(p.x + (size_t)t * 1024);
#pragma unroll
        for (int q = 0; q < 4; ++q)
#pragma unroll
            for (int j = 0; j < 4; ++j) v[q][j] = xa[256 * q + lane + 64 * j];
#pragma unroll
        for (int q = 0; q < 4; ++q) prep_x_token(p, Wg_s, t + q, v[q], lane);
    }
    __syncthreads();
}

namespace pg8 {
#define PG8_LAS __attribute__((address_space(3)))
typedef unsigned short bf16_t;
typedef short bf16x8 __attribute__((ext_vector_type(8)));
typedef float f32x4 __attribute__((ext_vector_type(4)));
typedef unsigned u32x4 __attribute__((ext_vector_type(4)));
constexpr int BM = 256, BK = 64, HALF = 128, HTB = HALF * BK * 2  , STAGE_BYTES = 8 * HTB, NXCD = 8, WGM = 8;

__host__ __device__ __forceinline__ int lds_byte(int r, int c) { const int st = (r >> 4) * 2 + (c >> 5), rr = r & 15, cc = c & 31, ob = rr * 64 + cc * 2; return st * 1024 + (ob ^ (((ob >> 9) & 1) << 5)); }
__host__ __device__ __forceinline__ void stage_rc(int b, int& R, int& C) { const int st = b / 1024, sb = b % 1024, swz = sb ^ (((sb >> 9) & 1) << 5); R = (st >> 1) * 16 + swz / 64; C = (st & 1) * 32 + (swz % 64) / 2; }
__host__ __device__ __forceinline__ int perm32(int rho) { const int n = rho >> 4, i = rho & 15; return 8 * (i >> 2) + 4 * n + (i & 3); }

struct Unit { int pm, pn; };
struct Gemm { const bf16_t* A; const bf16_t* Bt; int M, N, K; };

struct StaticOrder {
    int nM, nN, nwg, G, c;
    __host__ __device__ void init(int M, int N, int G_, int c_) { nM = M / BM; nN = N / BM; nwg = nM * nN; G = G_; c = c_; }
    __host__ __device__ bool next(int i, Unit& u) const {
        const long L = (long)i * G + c; if (L >= nwg) return false;
        int wgid = (int)L; { const int q = nwg / NXCD, r = nwg % NXCD, xcd = wgid % NXCD, off = wgid / NXCD; wgid = (xcd < r ? xcd * (q + 1) : r * (q + 1) + (xcd - r) * q) + off; }
        const int nig = WGM * nN, gid = wgid / nig, fm = gid * WGM, gsz = (nM - fm) < WGM ? (nM - fm) : WGM;
        u.pm = fm + ((wgid % nig) % gsz); u.pn = (wgid % nig) / gsz; return true;
    }
    __device__ __forceinline__ void a_ready(const Unit&) const {}
    __device__ __forceinline__ void done(const Unit&) const {}
};

__device__ __forceinline__ unsigned cvt_pk_bf16(float lo, float hi) { unsigned r; asm volatile("v_cvt_pk_bf16_f32 %0, %1, %2" : "=v"(r) : "v"(lo), "v"(hi)); return r; }

template <class Epi, class Sched, bool ALIGN_EPI = false, bool SP2 = false>
__device__ __forceinline__ void gemm_phase(PG8_LAS unsigned char* lds, const Gemm g, const Sched& S, const Epi& E) {
    const int tid = stid(), wid = __builtin_amdgcn_readfirstlane(tid >> 6), lane = tid & 63, wr = wid >> 2, wc = wid & 3, fr = lane & 15, fq = lane >> 4;
    const int K = g.K, nt = K / BK;
    unsigned voffA[2], voffB[2];
#pragma unroll
    for (int i = 0; i < 2; ++i) { int R, C; stage_rc(tid * 16 + i * 8192, R, C); const int Rb = Epi::PERM ? ((R & ~31) + perm32(R & 31)) : R;
        voffA[i] = (unsigned)(R * K + C) * 2u; voffB[i] = (unsigned)(Rb * K + C) * 2u; }
    const size_t kstep = (size_t)(BK * 2);
    const size_t hstep = (size_t)HALF * K * 2;
    const size_t tstep = 2 * hstep;
    const unsigned ldsw = (unsigned)wid * 1024u;
    const int aoff = lds_byte(wr * 64 + fr, fq * 8), boff = lds_byte(wc * 32 + fr, fq * 8);
#define PG8_SA(b, h) (((b) * 2 + (h)) * HTB)
#define PG8_SB(b, h) ((4 + (b) * 2 + (h)) * HTB)
#define PG8_STAGE(bufoff, gbase, voff) do { _Pragma("unroll") for (int _i = 0; _i < 2; ++_i) \
        __builtin_amdgcn_global_load_lds((const unsigned*)((const char*)(gbase) + (voff)[_i]), (PG8_LAS unsigned*)(lds + (bufoff) + ldsw + _i * 8192), 16, 0, 0); } while (0)
#define PG8_LDA(dst, b, h) do { _Pragma("unroll") for (int m = 0; m < 4; ++m) _Pragma("unroll") for (int k = 0; k < 2; ++k) dst[m][k] = *(const PG8_LAS bf16x8*)(lds + PG8_SA(b, h) + aoff + m * 2048 + k * 1024); } while (0)
#define PG8_LDB(dst, b, h) do { _Pragma("unroll") for (int n = 0; n < 2; ++n) _Pragma("unroll") for (int k = 0; k < 2; ++k) dst[n][k] = *(const PG8_LAS bf16x8*)(lds + PG8_SB(b, h) + boff + n * 2048 + k * 1024); } while (0)
#define PG8_MMA(ai, bj, At, Bt) do { __builtin_amdgcn_s_setprio(1); _Pragma("unroll") for (int m = 0; m < 4; ++m) _Pragma("unroll") for (int n = 0; n < 2; ++n) _Pragma("unroll") for (int k = 0; k < 2; ++k) \
        acc[ai][bj][m][n] = __builtin_amdgcn_mfma_f32_16x16x32_bf16(Bt[n][k], At[m][k], acc[ai][bj][m][n], 0, 0, 0); __builtin_amdgcn_s_setprio(0); } while (0)
#define PG8_WAIT_V(n) asm volatile("s_waitcnt vmcnt(" #n ")" ::: "memory")
#define PG8_WAIT_L(n) asm volatile("s_waitcnt lgkmcnt(" #n ")" ::: "memory")
#define PG8_BAR __builtin_amdgcn_s_barrier()
#define PG8_SCHED __builtin_amdgcn_sched_barrier(0)
    Unit cur, nxt; int ui = 0;
    if (!S.next(0, cur)) return;
    f32x4 acc[2][2][4][2];
#pragma unroll
    for (int a = 0; a < 2; ++a)
#pragma unroll
        for (int b = 0; b < 2; ++b)
#pragma unroll
            for (int m = 0; m < 4; ++m)
#pragma unroll
                for (int n = 0; n < 2; ++n) acc[a][b][m][n] = (f32x4){0.f, 0.f, 0.f, 0.f};
    bf16x8 At[4][2], B0[2][2], B1[2][2];
    const char* cA = (const char*)g.A + (size_t)cur.pm * tstep; const char* cB = (const char*)g.Bt + (size_t)cur.pn * tstep;
    S.a_ready(cur);
    if constexpr (SP2) {
        PG8_STAGE(PG8_SB(0, 0), cB, voffB); PG8_STAGE(PG8_SB(0, 1), cB + hstep, voffB); PG8_STAGE(PG8_SA(0, 0), cA, voffA); PG8_STAGE(PG8_SA(0, 1), cA + hstep, voffA);
        if (wr == 1) PG8_BAR;
        PG8_WAIT_V(2); PG8_BAR;
        PG8_STAGE(PG8_SB(1, 0), cB + kstep, voffB); PG8_STAGE(PG8_SA(1, 0), cA + kstep, voffA); PG8_STAGE(PG8_SB(1, 1), cB + hstep + kstep, voffB);
        PG8_WAIT_V(6); PG8_BAR;
    } else {
        PG8_STAGE(PG8_SB(0, 0), cB, voffB); PG8_STAGE(PG8_SA(0, 0), cA, voffA); PG8_STAGE(PG8_SB(0, 1), cB + hstep, voffB); PG8_STAGE(PG8_SA(0, 1), cA + hstep, voffA);
        if (wr == 1) PG8_BAR;
        PG8_WAIT_V(4); PG8_BAR;
        PG8_STAGE(PG8_SB(1, 0), cB + kstep, voffB); PG8_STAGE(PG8_SA(1, 0), cA + kstep, voffA); PG8_STAGE(PG8_SB(1, 1), cB + hstep + kstep, voffB);
        PG8_WAIT_V(6); PG8_BAR;
    }
    for (;;) {
        const bool has_next = S.next(ui + 1, nxt);
        const char* nA = has_next ? (const char*)g.A + (size_t)nxt.pm * tstep : cA; const char* nB = has_next ? (const char*)g.Bt + (size_t)nxt.pn * tstep : cB;
        for (int t = 0; t < nt; t += 2) {
            const bool last = (t == nt - 2);
            const char* a1 = cA + (size_t)(t + 1) * kstep;
            const char* a2 = last ? nA : cA + (size_t)(t + 2) * kstep; const char* b2 = last ? nB : cB + (size_t)(t + 2) * kstep;
            const char* a3 = a2 + kstep; const char* b3 = b2 + kstep;
            if (last && has_next) S.a_ready(nxt);
            if constexpr (SP2) {
            PG8_LDB(B0, 0, 0); PG8_LDB(B1, 0, 1); PG8_SCHED; PG8_LDA(At, 0, 0); PG8_STAGE(PG8_SA(1, 1), a1 + hstep, voffA);
            PG8_WAIT_V(8); PG8_WAIT_L(0); PG8_BAR; PG8_MMA(0, 0, At, B0); PG8_MMA(0, 1, At, B1); PG8_BAR; PG8_SCHED;
            PG8_LDA(At, 0, 1); PG8_STAGE(PG8_SB(0, 0), b2, voffB); PG8_STAGE(PG8_SB(0, 1), b2 + hstep, voffB); PG8_STAGE(PG8_SA(0, 0), a2, voffA);
            PG8_WAIT_V(8); PG8_WAIT_L(0); PG8_BAR; PG8_MMA(1, 0, At, B0); PG8_MMA(1, 1, At, B1); PG8_BAR; PG8_SCHED;
            PG8_LDB(B0, 1, 0); PG8_LDB(B1, 1, 1); PG8_SCHED; PG8_LDA(At, 1, 0); PG8_STAGE(PG8_SA(0, 1), a2 + hstep, voffA);
            PG8_WAIT_V(8); PG8_WAIT_L(0); PG8_BAR; PG8_MMA(0, 0, At, B0); PG8_MMA(0, 1, At, B1); PG8_BAR; PG8_SCHED;
            PG8_LDA(At, 1, 1); PG8_STAGE(PG8_SB(1, 0), b3, voffB); PG8_STAGE(PG8_SB(1, 1), b3 + hstep, voffB); PG8_STAGE(PG8_SA(1, 0), a3, voffA);
            PG8_WAIT_V(8); PG8_WAIT_L(0); PG8_BAR; PG8_MMA(1, 0, At, B0); PG8_MMA(1, 1, At, B1); PG8_BAR; PG8_SCHED;
            } else {
            PG8_LDB(B0, 0, 0); PG8_SCHED; PG8_LDA(At, 0, 0); PG8_STAGE(PG8_SA(1, 1), a1 + hstep, voffA);
            PG8_WAIT_L(8); PG8_BAR; PG8_WAIT_L(0); PG8_MMA(0, 0, At, B0); PG8_BAR; PG8_SCHED;
            PG8_LDB(B1, 0, 1); PG8_STAGE(PG8_SB(0, 0), b2, voffB);
            PG8_BAR; PG8_WAIT_L(0); PG8_MMA(0, 1, At, B1); PG8_BAR;
            PG8_LDA(At, 0, 1); PG8_STAGE(PG8_SA(0, 0), a2, voffA);
            PG8_BAR; PG8_WAIT_L(0); PG8_MMA(1, 0, At, B0); PG8_BAR; PG8_SCHED;
            PG8_STAGE(PG8_SB(0, 1), b2 + hstep, voffB);
            PG8_WAIT_V(6); PG8_BAR; PG8_MMA(1, 1, At, B1); PG8_BAR;
            PG8_LDB(B0, 1, 0); PG8_SCHED; PG8_LDA(At, 1, 0); PG8_STAGE(PG8_SA(0, 1), a2 + hstep, voffA);
            PG8_WAIT_L(8); PG8_BAR; PG8_WAIT_L(0); PG8_MMA(0, 0, At, B0); PG8_BAR; PG8_SCHED;
            PG8_LDB(B1, 1, 1); PG8_STAGE(PG8_SB(1, 0), b3, voffB);
            PG8_BAR; PG8_WAIT_L(0); PG8_MMA(0, 1, At, B1); PG8_BAR;
            PG8_LDA(At, 1, 1); PG8_STAGE(PG8_SA(1, 0), a3, voffA);
            PG8_BAR; PG8_WAIT_L(0); PG8_MMA(1, 0, At, B0); PG8_BAR; PG8_SCHED;
            PG8_STAGE(PG8_SB(1, 1), b3 + hstep, voffB);
            PG8_WAIT_V(6); PG8_BAR; PG8_MMA(1, 1, At, B1); PG8_BAR;
            }
        }
        if constexpr (ALIGN_EPI) { if (wr == 0) PG8_BAR; }
        if constexpr (!Epi::AFTER_DRAIN) { E(acc, cur, wr, wc, fr, fq); S.done(cur); }
        if (!has_next) break;
#pragma unroll
        for (int a = 0; a < 2; ++a)
#pragma unroll
            for (int b = 0; b < 2; ++b)
#pragma unroll
                for (int m = 0; m < 4; ++m)
#pragma unroll
                    for (int n = 0; n < 2; ++n) acc[a][b][m][n] = (f32x4){0.f, 0.f, 0.f, 0.f};
        cur = nxt; cA = nA; cB = nB; ++ui;
        if constexpr (ALIGN_EPI) { if (wr == 1) PG8_BAR; }
    }
    PG8_WAIT_V(0);
    if constexpr (!ALIGN_EPI) { if (wr == 0) PG8_BAR; }
    PG8_BAR;
    if constexpr (Epi::AFTER_DRAIN) { E.fused(acc, cur, wr, wc, fr, fq, lds, wid, lane); S.done(cur); }
#undef PG8_SA
#undef PG8_SB
#undef PG8_STAGE
#undef PG8_LDA
#undef PG8_LDB
#undef PG8_MMA
#undef PG8_WAIT_V
#undef PG8_WAIT_L
#undef PG8_BAR
#undef PG8_SCHED
}
}

#ifndef PG8_SP2
#define PG8_SP2 true
#endif
#ifndef PG8_ALIGN
#define PG8_ALIGN true
#endif
struct EpiProj8 {
    static constexpr bool PERM = true, AFTER_DRAIN = false;
    bf16_t* O; const float* rs; const float* rcos; const float* rsin;
    __device__ __forceinline__ void operator()(const pg8::f32x4 (&acc)[2][2][4][2], const pg8::Unit& u, int wr, int wc, int fr, int fq) const {
        const int row0 = u.pm * 256 + wr * 64 + fr, col0 = u.pn * 256 + wc * 32 + 8 * fq;
        const bool rot = u.pn < 4;
        const float ksc = u.pn >= 2 ? 0.08838834764831845f : 1.f;
#pragma unroll
        for (int ai = 0; ai < 2; ++ai)
#pragma unroll
            for (int m = 0; m < 4; ++m) {
                const int row = row0 + ai * 128 + m * 16;
                const float s = rs[row];
                const int seg = u.pn >> 1;
                const bool blocked = (seg < 3) || (seg == 5);
                bf16_t* rowp;
                int bjs;
                if (blocked) {
                    rowp = O + (size_t)(seg == 5 ? 3 : seg) * OPB + blk_off(row >> 4, (u.pn & 1) * 2) + (wc * 4 + fq) * 128 + fr * 8;
                    bjs = 4 * 2048;
                } else {
                    rowp = O + 4 * OPB + (size_t)row * NPR + (seg == 3 ? 0 : seg == 4 ? 512 : 1024) + (u.pn & 1) * 256 + wc * 32 + 8 * fq;
                    bjs = 128;
                }
                float4 cs = make_float4(1.f, 1.f, 1.f, 1.f), sn = make_float4(0.f, 0.f, 0.f, 0.f);
                float s2 = s;
                if (rot) {
                    const int ti = (row & 2047) * 64 + 16 * wc + 4 * fq;
                    cs = *(const float4*)(rcos + ti);
                    sn = *(const float4*)(rsin + ti);
                    s2 = s * ksc;
                }
#pragma unroll
                for (int bj = 0; bj < 2; ++bj) {
                    const pg8::f32x4 v0 = acc[ai][bj][m][0] * s2, v1 = acc[ai][bj][m][1] * s2;
                    *(uint4*)(rowp + bj * bjs) = make_uint4(pk2(v0[0] * cs.x - v0[1] * sn.x, v0[0] * sn.x + v0[1] * cs.x), pk2(v0[2] * cs.y - v0[3] * sn.y, v0[2] * sn.y + v0[3] * cs.y),
                                                            pk2(v1[0] * cs.z - v1[1] * sn.z, v1[0] * sn.z + v1[1] * cs.z), pk2(v1[2] * cs.w - v1[3] * sn.w, v1[2] * sn.w + v1[3] * cs.w));
                }
            }
    }
};
struct EpiX18 {
    static constexpr bool PERM = true, AFTER_DRAIN = false;
    const float* x; bf16_t* x1b; unsigned char* zq; float* rs2p; const float* g2;
    __device__ __forceinline__ void operator()(const pg8::f32x4 (&acc)[2][2][4][2], const pg8::Unit& u, int wr, int wc, int fr, int fq) const {
        const int row0 = u.pm * 256 + wr * 64 + fr, col0 = u.pn * 256 + wc * 32 + 8 * fq;
        float gq[2][8];
#pragma unroll
        for (int bj = 0; bj < 2; ++bj) {
            const float4 a = *(const float4*)(g2 + col0 + bj * 128), b = *(const float4*)(g2 + col0 + bj * 128 + 4);
            gq[bj][0] = a.x; gq[bj][1] = a.y; gq[bj][2] = a.z; gq[bj][3] = a.w; gq[bj][4] = b.x; gq[bj][5] = b.y; gq[bj][6] = b.z; gq[bj][7] = b.w;
        }
        float ssq[8];
#pragma unroll
        for (int ai = 0; ai < 2; ++ai)
#pragma unroll
            for (int m = 0; m < 4; ++m) {
                const size_t ro = (size_t)(row0 + ai * 128 + m * 16) * 1024 + col0;
                float s = 0.f;
#pragma unroll
                for (int bj = 0; bj < 2; ++bj) {
                    const float4 xa = *(const float4*)(x + ro + bj * 128), xb_ = *(const float4*)(x + ro + bj * 128 + 4);
                    const pg8::f32x4 v0 = acc[ai][bj][m][0], v1 = acc[ai][bj][m][1];
                    const float y[8] = {xa.x + v0[0], xa.y + v0[1], xa.z + v0[2], xa.w + v0[3], xb_.x + v1[0], xb_.y + v1[1], xb_.z + v1[2], xb_.w + v1[3]};
                    *(uint4*)(x1b + ro + bj * 128) = make_uint4(pk2(y[0], y[1]), pk2(y[2], y[3]), pk2(y[4], y[5]), pk2(y[6], y[7]));
                    unsigned w2[2] = {0u, 0u};
#pragma unroll
                    for (int e = 0; e < 8; ++e) {
                        s += y[e] * y[e];
                        const float z = fminf(fmaxf(y[e] * gq[bj][e] * (1.f / ZQ_SCALE), -127.f), 127.f);
                        w2[e >> 2] |= ((unsigned)((int)rintf(z) & 255)) << (8 * (e & 3));
                    }
                    *(uint2*)(zq + ro + bj * 128) = make_uint2(w2[0], w2[1]);
                }
                ssq[ai * 4 + m] = s;
            }
        float q4[4], q2[2];
#pragma unroll
        for (int j = 0; j < 4; ++j) {
            const auto r = __builtin_amdgcn_permlane32_swap(__float_as_uint(ssq[j]), __float_as_uint(ssq[j + 4]), false, false);
            q4[j] = __uint_as_float(r[0]) + __uint_as_float(r[1]);
        }
#pragma unroll
        for (int j = 0; j < 2; ++j) {
            const auto r = __builtin_amdgcn_permlane16_swap(__float_as_uint(q4[j]), __float_as_uint(q4[j + 2]), false, false);
            q2[j] = __uint_as_float(r[0]) + __uint_as_float(r[1]);
        }
#pragma unroll
        for (int j = 0; j < 2; ++j) {
            const int r8 = ((fq >> 1) & 1) * 4 + (fq & 1) * 2 + j;
            rs2p[(size_t)(row0 + (r8 >> 2) * 128 + (r8 & 3) * 16) * 16 + u.pn * 4 + wc] = q2[j];
        }
    }
};
template <class Epi, bool ALIGN>
DEVI void st_gemm8(const bf16_t* A, const bf16_t* Bt, int N, int K, char* smem, const Epi& epi) {
    pg8::Gemm g{A, Bt, T_TOK, N, K};
    pg8::StaticOrder S;
    S.init(T_TOK, N, (int)gridDim.x, (int)blockIdx.x);
    pg8::gemm_phase<Epi, pg8::StaticOrder, ALIGN, PG8_SP2>((PG8_LAS unsigned char*)smem, g, S, epi);
}

DEVI void st_conv_qk(const Params& p, char* smem) {
    char* cs = smem;
    char* wqs = smem + 128 * 272;
    char* wks = smem + 2 * 128 * 272;
    const int tid = stid(), lane = tid & 63, wid = tid >> 6, wr = wid >> 1, wc = wid & 1, fr = lane & 15, fq = lane >> 4;
    const int r = tid >> 4, cg = tid & 15;
    int hcur = -1;
    float cw[4][8], cb[8];
    for (int it = blockIdx.x; it < 256 * 4; it += gridDim.x) {
        const int h = it & 3, t0 = (it >> 2) * 128, s0 = t0 & 2047;
        if (h != hcur) {
            __syncthreads();
#pragma unroll
            for (int i = 0; i < 4; ++i) {
                const int id = tid + 512 * i, rr = id >> 4, c = id & 15;
                *(uint4*)(wqs + rr * 272 + c * 16) = *(const uint4*)(p.Wqt + h * 16384 + rr * 128 + c * 8);
                *(uint4*)(wks + rr * 272 + c * 16) = *(const uint4*)(p.Wkt + h * 16384 + rr * 128 + c * 8);
            }
#pragma unroll
            for (int j = 0; j < 4; ++j) {
                const float4 a = *(const float4*)(p.m_conv_w + j * 512 + h * 128 + 8 * cg), b = *(const float4*)(p.m_conv_w + j * 512 + h * 128 + 8 * cg + 4);
                cw[j][0] = a.x; cw[j][1] = a.y; cw[j][2] = a.z; cw[j][3] = a.w; cw[j][4] = b.x; cw[j][5] = b.y; cw[j][6] = b.z; cw[j][7] = b.w;
            }
            { const float4 a = *(const float4*)(p.m_conv_b + h * 128 + 8 * cg), b = *(const float4*)(p.m_conv_b + h * 128 + 8 * cg + 4);
              cb[0] = a.x; cb[1] = a.y; cb[2] = a.z; cb[3] = a.w; cb[4] = b.x; cb[5] = b.y; cb[6] = b.z; cb[7] = b.w; }
            hcur = h;
        }
        const bf16_t* xcol = p.proj + 4 * OPB + (size_t)t0 * NPR + 512 + h * 128 + 8 * cg;
#pragma unroll
        for (int ps = 0; ps < 4; ++ps) {
            const int row = 32 * ps + r;
            uint4 xv[4];
#pragma unroll
            for (int j = 0; j < 4; ++j) {
                const int rj = row - 3 + j;
                xv[j] = (s0 + rj >= 0) ? *(const uint4*)(xcol + (long)rj * NPR) : make_uint4(0u, 0u, 0u, 0u);
            }
            float y[8];
#pragma unroll
            for (int e = 0; e < 8; ++e) y[e] = cb[e];
#pragma unroll
            for (int j = 0; j < 4; ++j) {
                const unsigned w4[4] = {xv[j].x, xv[j].y, xv[j].z, xv[j].w};
#pragma unroll
                for (int e = 0; e < 4; ++e) { y[2 * e] += cw[j][2 * e] * bflo(w4[e]); y[2 * e + 1] += cw[j][2 * e + 1] * bfhi(w4[e]); }
            }
            unsigned o[4];
#pragma unroll
            for (int e = 0; e < 4; ++e) o[e] = pk2(y[2 * e] * sigmoidf_(y[2 * e]), y[2 * e + 1] * sigmoidf_(y[2 * e + 1]));
            const uint4 ov = make_uint4(o[0], o[1], o[2], o[3]);
            *(uint4*)(cs + row * 272 + cg * 16) = ov;
            *(uint4*)(p.cbuf + (size_t)(t0 + row) * 512 + h * 128 + 8 * cg) = ov;
        }
        __syncthreads();
#pragma unroll
        for (int which = 0; which < 2; ++which) {
            const char* ws = which ? wks : wqs;
            bf16_t* O = which ? p.mk : p.mq;
            f32x4 acc[2][4];
#pragma unroll
            for (int i = 0; i < 2; ++i)
#pragma unroll
                for (int j = 0; j < 4; ++j) acc[i][j] = (f32x4){0.f, 0.f, 0.f, 0.f};
#pragma unroll
            for (int ks = 0; ks < 4; ++ks) {
                bf16x8 a[2], b[4];
#pragma unroll
                for (int i = 0; i < 2; ++i) a[i] = ld8(cs + (wr * 32 + i * 16 + fr) * 272 + (ks * 4 + fq) * 16);
#pragma unroll
                for (int j = 0; j < 4; ++j) b[j] = ld8(ws + (wc * 64 + j * 16 + fr) * 272 + (ks * 4 + fq) * 16);
#pragma unroll
                for (int i = 0; i < 2; ++i)
#pragma unroll
                    for (int j = 0; j < 4; ++j) acc[i][j] = mfma16(b[j], a[i], acc[i][j]);
            }
#pragma unroll
            for (int i = 0; i < 2; ++i)
#pragma unroll
                for (int j = 0; j < 4; ++j) {
                    const f32x4 v = acc[i][j];
                    *(uint2*)(O + blk_off((t0 >> 4) + wr * 2 + i, h) + (wc * 8 + j * 2 + (fq >> 1)) * 128 + fr * 8 + (fq & 1) * 4) = make_uint2(pk2(v[0], v[1]), pk2(v[2], v[3]));
                }
        }
        __syncthreads();
    }
}

DEVI bf16x8 u4_to_frag(uint4 u) { union { uint4 u; bf16x8 v; } x; x.u = u; return x.v; }
DEVI void sel_frags(bf16x8 (&sel)[2], int fr, int fq) {
#pragma unroll
    for (int hh = 0; hh < 2; ++hh) {
        const int jstar = fr + 16 * hh - 8 * fq;
        bf16x8 s;
#pragma unroll
        for (int j = 0; j < 8; ++j) s[j] = (j == jstar) ? (short)0x3F80 : (short)0;
        sel[hh] = s;
    }
}
DEVI void tr_store(char* XT, bf16x8 frag, const bf16x8 (&sel)[2], int mi, int ks, int fr, int fq, const float (&sc)[4]) {
#pragma unroll
    for (int hh = 0; hh < 2; ++hh) {
        const f32x4 d = mfma16(frag, sel[hh], (f32x4){0.f, 0.f, 0.f, 0.f});
        *(uint2*)(XT + (32 * ks + 16 * hh + fr) * 144 + (16 * mi + 4 * fq) * 2) = make_uint2(pk2(d[0] * sc[0], d[1] * sc[1]), pk2(d[2] * sc[2], d[3] * sc[3]));
    }
}
DEVI bf16x8 state_pack(const f32x4& a, const f32x4& b) {
    return mk8(make_uint2(pk2(a[0], a[1]), pk2(a[2], a[3])), make_uint2(pk2(b[0], b[1]), pk2(b[2], b[3])));
}
DEVI const float* opaque_ptr(const float* q) { asm volatile("" : "+v"(q)); return q; }
DEVI float opaque_f(float v) { asm volatile("" : "+v"(v)); return v; }
DEVI void lds_barrier() { asm volatile("s_waitcnt lgkmcnt(0)" ::: "memory"); __builtin_amdgcn_s_barrier(); asm volatile("" ::: "memory"); }
DEVI void pin_u4(uint4& a) { asm volatile("" : "+v"(a.x), "+v"(a.y), "+v"(a.z), "+v"(a.w)); }
DEVI float grp8_sum(float v) { v += dpp_f<DPP_XOR1>(v); v += dpp_f<DPP_XOR2>(v); v += dpp_f<DPP_HMIRROR>(v); return v; }

#define ASM_LD16(dst, voff, sbase, imm) asm volatile("global_load_dwordx4 %0, %1, %2 offset:" #imm : "=v"(dst) : "v"(voff), "s"(sbase) : "memory")
#define ASM_LD4(dst, voff, sbase) asm volatile("global_load_dword %0, %1, %2" : "=v"(dst) : "v"(voff), "s"(sbase) : "memory")
typedef unsigned u32x4_t __attribute__((ext_vector_type(4)));
struct RetPre { u32x4_t f[4]; u32x4_t v[2]; u32x4_t g[2]; };
struct RetOff { unsigned f, v0, v1, g; };
DEVI void ret_offsets(RetOff& o, int h, int tid) {
    const int lane = tid & 63, w = tid >> 6, fr = lane & 15, fq = lane >> 4, mi = w & 3;
    o.f = (unsigned)((w < 4 ? OPB * 2 : 0) + (4 * h + mi) * 4096 + fq * 256 + fr * 16);
    o.v0 = (unsigned)(2 * OPB * 2 + (4 * h + ((2 * w) >> 2)) * 4096 + (4 * ((2 * w) & 3) + fq) * 256 + fr * 16);
    o.v1 = (unsigned)(2 * OPB * 2 + (4 * h + ((2 * w + 1) >> 2)) * 4096 + (4 * ((2 * w + 1) & 3) + fq) * 256 + fr * 16);
    o.g = (unsigned)(((tid >> 3) * NPR + h * 128 + 8 * (tid & 7)) * 2);
}
DEVI const char* ret_base(const Params& p, int b, int c) { return (const char*)p.proj + (size_t)(b * 32 + c) * 65536; }
DEVI const char* ret_gbase(const Params& p, int b, int c) { return (const char*)(p.proj + 4 * OPB) + (size_t)(b * 2048 + c * 64) * (NPR * 2); }
template <int N> DEVI void ret_retire_fv(RetPre& P) {
    asm volatile("s_waitcnt vmcnt(%6)" : "+v"(P.f[0]), "+v"(P.f[1]), "+v"(P.f[2]), "+v"(P.f[3]), "+v"(P.v[0]), "+v"(P.v[1]) : "n"(N) : "memory");
}
DEVI uint4 asu4(const u32x4_t& v) { return make_uint4(v[0], v[1], v[2], v[3]); }
DEVI void ret_block(const Params& p, char* smem, int b, int h) {
    char* qs = smem;
    char* ks_ = smem + 17408;
    char* kTs = smem + 34816;
    char* vTs = smem + 53248;
    char* Ss = smem + 71680;
    char* Os = smem + 80896;
    float* gn_s = (float*)(smem + 98304);
    const int tid = stid(), lane = tid & 63, w = tid >> 6, fr = lane & 15, fq = lane >> 4;
    const float gamma = 1.f - exp2f(-5.f - (float)h);
    const float l2g = log2f(gamma);
    const float g64 = exp2f(l2g * 64.f);
    bf16x8 sel[2];
    sel_frags(sel, fr, fq);
    f32x4 st[8];
#pragma unroll
    for (int i = 0; i < 8; ++i) st[i] = (f32x4){0.f, 0.f, 0.f, 0.f};
    if (tid < 128) gn_s[tid] = p.ret_norm_g[h * 128 + tid];
    __syncthreads();
    RetPre P;
    RetOff RO;
    ret_offsets(RO, h, tid);
    {
        const char* base = ret_base(p, b, 0);
        ASM_LD16(P.f[0], RO.f, base, 0); ASM_LD16(P.f[1], RO.f, base, 1024); ASM_LD16(P.f[2], RO.f, base, 2048); ASM_LD16(P.f[3], RO.f, base, 3072);
        ASM_LD16(P.v[0], RO.v0, base, 0); ASM_LD16(P.v[1], RO.v1, base, 0);
    }
    ret_retire_fv<0>(P);
#pragma unroll 1
    for (int c = 0; c < 32; ++c) {
        const int t0 = b * 2048 + c * 64;
        {
            const int mi = w & 3;
            char* dst = (w < 4 ? ks_ : qs) + (16 * mi + fr) * 272 + fq * 16;
#pragma unroll
            for (int ks = 0; ks < 4; ++ks) *(uint4*)(dst + ks * 64) = asu4(P.f[ks]);
            if (w < 4) {
                float kd[4];
#pragma unroll
                for (int r = 0; r < 4; ++r) kd[r] = exp2f(l2g * (float)(63 - (16 * mi + 4 * fq + r)));
#pragma unroll
                for (int ks = 0; ks < 4; ++ks) tr_store(kTs, u4_to_frag(asu4(P.f[ks])), sel, mi, ks, fr, fq, kd);
            }
            const float one[4] = {1.f, 1.f, 1.f, 1.f};
#pragma unroll
            for (int q = 0; q < 2; ++q) { const int pr = 2 * w + q; tr_store(vTs, u4_to_frag(asu4(P.v[q])), sel, pr >> 2, pr & 3, fr, fq, one); }
        }
        lds_barrier();
        const char* cbase = ret_gbase(p, b, c);
        const char* nbase = ret_base(p, b, c + 1 < 32 ? c + 1 : 31);
        ASM_LD16(P.g[0], RO.g, cbase, 0); ASM_LD16(P.g[1], RO.g, cbase, 128);
        {
            const int lt = w & 3;
            bf16x8 qf[4];
#pragma unroll
            for (int s = 0; s < 4; ++s) qf[s] = ld8(qs + (16 * lt + fr) * 272 + (s * 4 + fq) * 16);
#pragma unroll
            for (int jj = 0; jj < 2; ++jj) {
                const int j = 2 * (w >> 2) + jj;
                if (jj == 0) { ASM_LD16(P.f[0], RO.f, nbase, 0); ASM_LD16(P.f[1], RO.f, nbase, 1024); }
                else { ASM_LD16(P.f[2], RO.f, nbase, 2048); ASM_LD16(P.f[3], RO.f, nbase, 3072); }
                f32x4 a = (f32x4){0.f, 0.f, 0.f, 0.f};
#pragma unroll
                for (int s = 0; s < 4; ++s) a = mfma16(ld8(ks_ + (16 * j + fr) * 272 + (s * 4 + fq) * 16), qf[s], a);
                const int l = 16 * lt + fr, mb = 16 * j + 4 * fq;
                float v[4];
#pragma unroll
                for (int r = 0; r < 4; ++r) { const int dd = l - (mb + r); v[r] = a[r] * exp2f(l2g * (float)(dd < 0 ? -dd : dd)); }
                *(uint2*)(Ss + l * 144 + mb * 2) = make_uint2(pk2(v[0], v[1]), pk2(v[2], v[3]));
            }
        }
        lds_barrier();
        {
            bf16x8 sp[4];
#pragma unroll
            for (int s = 0; s < 4; ++s) sp[s] = state_pack(st[2 * s], st[2 * s + 1]);
            bf16x8 vf[2];
#pragma unroll
            for (int s2 = 0; s2 < 2; ++s2) vf[s2] = ld8(vTs + (16 * w + fr) * 144 + (s2 * 4 + fq) * 16);
#pragma unroll
            for (int i = 0; i < 4; ++i) {
                if (i == 0) ASM_LD16(P.v[0], RO.v0, nbase, 0);
                if (i == 1) ASM_LD16(P.v[1], RO.v1, nbase, 0);
                f32x4 a = (f32x4){0.f, 0.f, 0.f, 0.f};
                const char* qrow = qs + (16 * i + fr) * 272;
#pragma unroll
                for (int s = 0; s < 4; ++s) {
                    const uint2 lo = *(const uint2*)(qrow + (32 * s + 4 * fq) * 2), hi = *(const uint2*)(qrow + (32 * s + 16 + 4 * fq) * 2);
                    a = mfma16(sp[s], mk8(lo, hi), a);
                }
                a = a * exp2f(l2g * (float)(16 * i + fr + 1));
#pragma unroll
                for (int s2 = 0; s2 < 2; ++s2) a = mfma16(vf[s2], ld8(Ss + (16 * i + fr) * 144 + (s2 * 4 + fq) * 16), a);
                *(uint2*)(Os + (16 * i + fr) * 272 + (16 * w + 4 * fq) * 2) = make_uint2(pk2(a[0], a[1]), pk2(a[2], a[3]));
            }
#pragma unroll
            for (int i = 0; i < 8; ++i) {
                f32x4 a = st[i] * g64;
#pragma unroll
                for (int s2 = 0; s2 < 2; ++s2) a = mfma16(ld8(kTs + (16 * i + fr) * 144 + (s2 * 4 + fq) * 16), vf[s2], a);
                st[i] = a;
            }
        }
        lds_barrier();
        {
            const int l = tid >> 3, part = tid & 7;
            const uint4 o0 = *(const uint4*)(Os + l * 272 + part * 16), o1 = *(const uint4*)(Os + l * 272 + 128 + part * 16);
            const unsigned ow[8] = {o0.x, o0.y, o0.z, o0.w, o1.x, o1.y, o1.z, o1.w};
            float x[16], s = 0.f;
#pragma unroll
            for (int e = 0; e < 8; ++e) { x[2 * e] = bflo(ow[e]); x[2 * e + 1] = bfhi(ow[e]); s += x[2 * e] + x[2 * e + 1]; }
            const float mu = grp8_sum(s) * (1.f / 128.f);
            float q = 0.f;
#pragma unroll
            for (int e = 0; e < 16; ++e) { x[e] -= mu; q += x[e] * x[e]; }
            float rstd = rsqrtf(grp8_sum(q) * (1.f / 128.f) + EPSN);
            asm volatile("s_waitcnt vmcnt(6)" : "+v"(P.g[0]), "+v"(P.g[1]), "+v"(rstd) :: "memory");
            const unsigned gw[8] = {P.g[0][0], P.g[0][1], P.g[0][2], P.g[0][3], P.g[1][0], P.g[1][1], P.g[1][2], P.g[1][3]};
            const float* gn = gn_s + 8 * part;
            unsigned yo[8];
#pragma unroll
            for (int e = 0; e < 8; ++e) {
                const float ga = bflo(gw[e]), gb = bfhi(gw[e]);
                const int ci = (e < 4 ? 0 : 56) + 2 * e;
                yo[e] = pk2(ga * sigmoidf_(ga) * x[2 * e] * rstd * gn[ci], gb * sigmoidf_(gb) * x[2 * e + 1] * rstd * gn[ci + 1]);
            }
            asm volatile("" : "+v"(yo[0]), "+v"(yo[1]), "+v"(yo[2]), "+v"(yo[3]), "+v"(yo[4]), "+v"(yo[5]), "+v"(yo[6]), "+v"(yo[7]));
            ret_retire_fv<0>(P);
            uint4* yp = (uint4*)(p.yb + (size_t)(t0 + l) * 1024 + h * 128 + 8 * part);
            yp[0] = make_uint4(yo[0], yo[1], yo[2], yo[3]);
            yp[8] = make_uint4(yo[4], yo[5], yo[6], yo[7]);
        }
    }
}

struct MlPre { u32x4_t f[4]; u32x4_t v[2]; u32x4_t o[2]; u32x4_t cc[2]; };
struct MlOff { unsigned f, v0, v1, o, c, g; };
DEVI void ml_offsets(const Params& p, MlOff& o, int h, int tid) {
    const int lane = tid & 63, w = tid >> 6, fr = lane & 15, fq = lane >> 4, mi = w & 3;
    const unsigned kdiff = (unsigned)((const char*)p.mk - (const char*)p.mq);
    o.f = (unsigned)((4 * h + mi) * 4096 + fq * 256 + fr * 16) + (w < 4 ? kdiff : 0u);
    o.v0 = (unsigned)((4 * h + ((2 * w) >> 2)) * 4096 + (4 * ((2 * w) & 3) + fq) * 256 + fr * 16);
    o.v1 = (unsigned)((4 * h + ((2 * w + 1) >> 2)) * 4096 + (4 * ((2 * w + 1) & 3) + fq) * 256 + fr * 16);
    o.o = (unsigned)(((tid >> 3) * NPR + 1024 + h * 128 + 8 * (tid & 7)) * 2);
    o.c = (unsigned)(((tid >> 3) * 512 + h * 128 + 8 * (tid & 7)) * 2);
    o.g = (unsigned)((lane * 4 + h) * 4);
}
template <int N> DEVI void ml_retire_fv(MlPre& P) {
    asm volatile("s_waitcnt vmcnt(%6)" : "+v"(P.f[0]), "+v"(P.f[1]), "+v"(P.f[2]), "+v"(P.f[3]), "+v"(P.v[0]), "+v"(P.v[1]) : "n"(N) : "memory");
}
DEVI void mlstm_block(const Params& p, char* smem, int b, int h) {
    char* qs = smem;
    char* kTs = smem + 17408;
    char* vTs = smem + 35840;
    char* Os = smem + 54272;
    float* n_s = (float*)(smem + 71680);
    float* den_s = (float*)(smem + 72192);
    float* gn_s = (float*)(smem + 72448);
    float* sk_s = gn_s + 128;
    float* lw_s = sk_s + 128;
    float* ac_s = lw_s + 32 * 64;
    float* mi_s = ac_s + 32;
    const int tid = stid(), lane = tid & 63, w = tid >> 6, fr = lane & 15, fq = lane >> 4;
    bf16x8 sel[2];
    sel_frags(sel, fr, fq);
    f32x4 st[8];
#pragma unroll
    for (int i = 0; i < 8; ++i) st[i] = (f32x4){0.f, 0.f, 0.f, 0.f};
    float m_run = 0.f;
    f32x4 nacc = (f32x4){0.f, 0.f, 0.f, 0.f};
    bf16x8 ones;
#pragma unroll
    for (int j = 0; j < 8; ++j) ones[j] = (short)0x3F80;
    if (tid < 128) { gn_s[tid] = p.m_norm_g[h * 128 + tid]; sk_s[tid] = p.m_skip[h * 128 + tid]; }
#pragma unroll
    for (int q = 0; q < 4; ++q) {
        const int cc = 4 * w + q, tt = b * 2048 + cc * 64 + lane;
        const float iv = p.ipre[tt * 4 + h], fv = p.logf[tt * 4 + h];
        float fcum = fv;
#pragma unroll
        for (int o = 1; o < 64; o <<= 1) { const float tv = __shfl_up(fcum, o); if (lane >= o) fcum += tv; }
        const float a_c = __shfl(fcum, 63);
        const float logw = a_c - fcum + iv;
        const float m_in = wave_max(logw);
        lw_s[cc * 64 + lane] = logw;
        if (lane == 0) { ac_s[cc] = a_c; mi_s[cc] = m_in; }
    }
    __syncthreads();
    MlPre P;
    MlOff MO;
    ml_offsets(p, MO, h, tid);
    {
        const size_t t00 = (size_t)(b * 2048);
        const char* bq = (const char*)p.mq + t00 * 1024, *bp = (const char*)(p.proj + 3 * OPB) + t00 * 1024;
        ASM_LD16(P.f[0], MO.f, bq, 0); ASM_LD16(P.f[1], MO.f, bq, 1024); ASM_LD16(P.f[2], MO.f, bq, 2048); ASM_LD16(P.f[3], MO.f, bq, 3072);
        ASM_LD16(P.v[0], MO.v0, bp, 0); ASM_LD16(P.v[1], MO.v1, bp, 0);
    }
    ml_retire_fv<0>(P);
#pragma unroll 1
    for (int c = 0; c < 32; ++c) {
        const int t0 = b * 2048 + c * 64;
        const float a_c = ac_s[c], m_in = mi_s[c], logw = lw_s[c * 64 + lane];
        const float m_new = fmaxf(a_c + m_run, m_in);
        const float decay = fexp_(a_c + m_run - m_new);
        const float wgt = fexp_(logw - m_new);
        const float emn = fexp_(-m_new);
        m_run = m_new;
        {
            const int mi = w & 3;
            if (w < 4) {
                float kw[4];
#pragma unroll
                for (int r = 0; r < 4; ++r) kw[r] = __shfl(wgt, 16 * mi + 4 * fq + r);
#pragma unroll
                for (int ks = 0; ks < 4; ++ks) tr_store(kTs, u4_to_frag(asu4(P.f[ks])), sel, mi, ks, fr, fq, kw);
            } else {
                char* dst = qs + (16 * mi + fr) * 272 + fq * 16;
#pragma unroll
                for (int ks = 0; ks < 4; ++ks) *(uint4*)(dst + ks * 64) = asu4(P.f[ks]);
            }
            const float one[4] = {1.f, 1.f, 1.f, 1.f};
#pragma unroll
            for (int q = 0; q < 2; ++q) { const int pr = 2 * w + q; tr_store(vTs, u4_to_frag(asu4(P.v[q])), sel, pr >> 2, pr & 3, fr, fq, one); }
        }
        lds_barrier();
        const size_t tc = (size_t)t0, tn = (size_t)(b * 2048 + (c + 1 < 32 ? c + 1 : 31) * 64);
        const char* cbp = (const char*)(p.proj + 4 * OPB) + tc * (NPR * 2), *cbc = (const char*)p.cbuf + tc * 1024;
        const char* nbq = (const char*)p.mq + tn * 1024, *nbp = (const char*)(p.proj + 3 * OPB) + tn * 1024;
        ASM_LD16(P.o[0], MO.o, cbp, 0); ASM_LD16(P.o[1], MO.o, cbp, 128);
        {
            f32x4 a = nacc * decay;
#pragma unroll
            for (int s2 = 0; s2 < 2; ++s2) a = mfma16(ld8(kTs + (16 * w + fr) * 144 + (s2 * 4 + fq) * 16), ones, a);
            nacc = a;
            if (fr == 0) *(f32x4*)(n_s + 16 * w + 4 * fq) = a;
        }
        {
            bf16x8 vf[2];
#pragma unroll
            for (int s2 = 0; s2 < 2; ++s2) vf[s2] = ld8(vTs + (16 * w + fr) * 144 + (s2 * 4 + fq) * 16);
#pragma unroll
            for (int i = 0; i < 8; ++i) {
                if (i == 0) ASM_LD16(P.cc[0], MO.c, cbc, 0);
                if (i == 1) ASM_LD16(P.cc[1], MO.c, cbc, 128);
                if (i == 2) ASM_LD16(P.f[0], MO.f, nbq, 0);
                if (i == 3) ASM_LD16(P.f[1], MO.f, nbq, 1024);
                if (i == 4) ASM_LD16(P.f[2], MO.f, nbq, 2048);
                if (i == 5) ASM_LD16(P.f[3], MO.f, nbq, 3072);
                if (i == 6) ASM_LD16(P.v[0], MO.v0, nbp, 0);
                if (i == 7) ASM_LD16(P.v[1], MO.v1, nbp, 0);
                f32x4 a = st[i] * decay;
#pragma unroll
                for (int s2 = 0; s2 < 2; ++s2) a = mfma16(ld8(kTs + (16 * i + fr) * 144 + (s2 * 4 + fq) * 16), vf[s2], a);
                st[i] = a;
            }
        }
        lds_barrier();
        {
            const int l = tid >> 3, part = tid & 7;
            const uint4 a0 = *(const uint4*)(qs + l * 272 + part * 32), a1 = *(const uint4*)(qs + l * 272 + part * 32 + 16);
            const unsigned aw[8] = {a0.x, a0.y, a0.z, a0.w, a1.x, a1.y, a1.z, a1.w};
            const float* nn = n_s + 16 * part;
            float s = 0.f;
#pragma unroll
            for (int e = 0; e < 8; ++e) s += bflo(aw[e]) * nn[2 * e] + bfhi(aw[e]) * nn[2 * e + 1];
            s = grp8_sum(s);
            if (part == 0) den_s[l] = fmaxf(fabsf(s), emn);
        }
        lds_barrier();
        {
            bf16x8 sp[4];
#pragma unroll
            for (int s = 0; s < 4; ++s) sp[s] = state_pack(st[2 * s], st[2 * s + 1]);
#pragma unroll
            for (int i = 0; i < 4; ++i) {
                f32x4 a = (f32x4){0.f, 0.f, 0.f, 0.f};
                const char* qrow = qs + (16 * i + fr) * 272;
#pragma unroll
                for (int s = 0; s < 4; ++s) {
                    const uint2 lo = *(const uint2*)(qrow + (32 * s + 4 * fq) * 2), hi = *(const uint2*)(qrow + (32 * s + 16 + 4 * fq) * 2);
                    a = mfma16(sp[s], mk8(lo, hi), a);
                }
                const float rd = rcp_(den_s[16 * i + fr]);
                *(uint2*)(Os + (16 * i + fr) * 272 + (16 * w + 4 * fq) * 2) = make_uint2(pk2(a[0] * rd, a[1] * rd), pk2(a[2] * rd, a[3] * rd));
            }
        }
        lds_barrier();
        {
            const int l = tid >> 3, part = tid & 7;
            const uint4 o0 = *(const uint4*)(Os + l * 272 + part * 16), o1 = *(const uint4*)(Os + l * 272 + 128 + part * 16);
            const unsigned ow[8] = {o0.x, o0.y, o0.z, o0.w, o1.x, o1.y, o1.z, o1.w};
            float x[16], s = 0.f;
#pragma unroll
            for (int e = 0; e < 8; ++e) { x[2 * e] = bflo(ow[e]); x[2 * e + 1] = bfhi(ow[e]); s += x[2 * e] + x[2 * e + 1]; }
            const float mu = grp8_sum(s) * (1.f / 128.f);
            float q = 0.f;
#pragma unroll
            for (int e = 0; e < 16; ++e) { x[e] -= mu; q += x[e] * x[e]; }
            float rstd = rsqrtf(grp8_sum(q) * (1.f / 128.f) + EPSN);
            asm volatile("s_waitcnt vmcnt(6)" : "+v"(P.o[0]), "+v"(P.o[1]), "+v"(P.cc[0]), "+v"(P.cc[1]), "+v"(rstd) :: "memory");
            const unsigned gw[8] = {P.o[0][0], P.o[0][1], P.o[0][2], P.o[0][3], P.o[1][0], P.o[1][1], P.o[1][2], P.o[1][3]};
            const unsigned cw[8] = {P.cc[0][0], P.cc[0][1], P.cc[0][2], P.cc[0][3], P.cc[1][0], P.cc[1][1], P.cc[1][2], P.cc[1][3]};
            const float* gn = gn_s + 8 * part;
            const float* sk = sk_s + 8 * part;
            unsigned yo[8];
#pragma unroll
            for (int e = 0; e < 8; ++e) {
                const int ci = (e < 4 ? 0 : 56) + 2 * e;
                const float ya = sigmoidf_(bflo(gw[e])) * (x[2 * e] * rstd * gn[ci] + sk[ci] * bflo(cw[e]));
                const float yb_ = sigmoidf_(bfhi(gw[e])) * (x[2 * e + 1] * rstd * gn[ci + 1] + sk[ci + 1] * bfhi(cw[e]));
                yo[e] = pk2(ya, yb_);
            }
            asm volatile("" : "+v"(yo[0]), "+v"(yo[1]), "+v"(yo[2]), "+v"(yo[3]), "+v"(yo[4]), "+v"(yo[5]), "+v"(yo[6]), "+v"(yo[7]));
            ml_retire_fv<0>(P);
            uint4* yp = (uint4*)(p.yb + (size_t)(t0 + l) * 1024 + 512 + h * 128 + 8 * part);
            yp[0] = make_uint4(yo[0], yo[1], yo[2], yo[3]);
            yp[8] = make_uint4(yo[4], yo[5], yo[6], yo[7]);
        }
    }
}
DEVI void st_recur(const Params& p, char* smem) {
    if (blockIdx.x >= 128 || gridDim.x <= 128) {
        const int bid = gridDim.x > 128 ? (int)blockIdx.x - 128 : (int)blockIdx.x, nb = gridDim.x > 128 ? (int)gridDim.x - 128 : (int)gridDim.x;
        st_prep_w2(p, smem, bid, nb);
        st_prep_wsub(p, smem, bid, nb);
        st_prep_tables(p, bid, nb);
        if (gridDim.x > 128) return;
    }
    for (int bi = blockIdx.x; bi < 128; bi += gridDim.x) {
        const int kind = bi & 1, h = (bi >> 1) & 3, b = bi >> 3;
        if (kind == 0) ret_block(p, smem, b, h);
        else mlstm_block(p, smem, b, h);
        __syncthreads();
    }
}

constexpr float KEY_BIAS = 64.f;
DEVI int f2key(float f) { const int b = __float_as_int(f); return b ^ ((b >> 31) & 0x7fffffff); }
DEVI float key2f(int k) { return __int_as_float(k ^ ((k >> 31) & 0x7fffffff)); }
template <int N> DEVI void bsort_desc(int (&v)[N]) {
#pragma unroll
    for (int k = 2; k <= N; k <<= 1)
#pragma unroll
        for (int j = k >> 1; j > 0; j >>= 1)
#pragma unroll
            for (int i = 0; i < N; ++i) {
                const int l = i ^ j;
                if (l > i) {
                    const int a = v[i], b = v[l];
                    const int mx = a > b ? a : b, mn = a > b ? b : a;
                    if ((i & k) == 0) { v[i] = mx; v[l] = mn; } else { v[i] = mn; v[l] = mx; }
                }
            }
}
template <int N> DEVI void bmerge_desc(int (&v)[N]) {
#pragma unroll
    for (int j = N >> 1; j > 0; j >>= 1)
#pragma unroll
        for (int i = 0; i < N; ++i) {
            const int l = i ^ j;
            if (l > i) { const int a = v[i], b = v[l]; v[i] = a > b ? a : b; v[l] = a > b ? b : a; }
        }
}
DEVI void xmerge16(int (&v)[16], int mask) {
    int o[16];
#pragma unroll
    for (int i = 0; i < 16; ++i) o[i] = __shfl_xor(v[15 - i], mask);
#pragma unroll
    for (int i = 0; i < 16; ++i) v[i] = v[i] > o[i] ? v[i] : o[i];
    bmerge_desc<16>(v);
}
__device__ const unsigned char cand_tab[52] = {
    0x00, 0x01, 0x02, 0x03, 0x04, 0x05, 0x06, 0x07, 0x08, 0x09, 0x0a, 0x0b, 0x0c, 0x0d, 0x0e, 0x0f,
    0x10, 0x11, 0x12, 0x13, 0x14, 0x15, 0x16, 0x17, 0x20, 0x21, 0x22, 0x23, 0x24, 0x30, 0x31, 0x32, 0x33,
    0x40, 0x41, 0x42, 0x50, 0x51, 0x60, 0x61, 0x70, 0x71, 0x80, 0x90, 0xa0, 0xb0, 0xc0, 0xd0, 0xe0, 0xf0, 0xff, 0xff};
constexpr int H_A = 256 * 64, H_B = 256 * 64, H_STAGE = H_A + H_B;
constexpr int H_LIST = 3 * H_STAGE;
DEVI void glds16(const void* g, char* l) {
    __builtin_amdgcn_global_load_lds((const __attribute__((address_space(1))) unsigned*)g, (__attribute__((address_space(3))) unsigned*)l, 16, 0, 0);
}
DEVI void gemm3_topk_tile(const Params& p, int m0, int h, char* smem) {
    const int tid = stid(), lane = tid & 63, w = tid >> 6, wt = w >> 1, wp = w & 1, fr = lane & 15, fq = lane >> 4;
    i32x4 acc[4][8];
#pragma unroll
    for (int i = 0; i < 4; ++i)
#pragma unroll
        for (int j = 0; j < 8; ++j) acc[i][j] = (i32x4){0, 0, 0, 0};
    const int r16 = lane >> 2, csrc = (lane & 3) ^ ((r16 >> 2) & 3);
    const unsigned char* srcA = p.xq + (size_t)(m0 + w * 32 + r16) * 1024 + csrc * 16;
    const unsigned char* srcB = (const unsigned char*)p.Wsubq + ((size_t)h * 256 + w * 32 + r16) * 1024 + csrc * 16;
    char* dstA = smem + (w * 32) * 64 + lane * 16;
    char* dstB = smem + H_A + (w * 32) * 64 + lane * 16;
    auto issue = [&](int kt, int buf) {
#pragma unroll
        for (int q = 0; q < 2; ++q) glds16(srcA + (size_t)q * 16 * 1024 + kt * 64, dstA + buf * H_STAGE + q * 1024);
#pragma unroll
        for (int q = 0; q < 2; ++q) glds16(srcB + (size_t)q * 16 * 1024 + kt * 64, dstB + buf * H_STAGE + q * 1024);
    };
    const int rdoff = fr * 64 + ((fq ^ ((fr >> 2) & 3)) * 16);
    issue(0, 0);
    issue(1, 1);
    asm volatile("s_waitcnt vmcnt(4)" ::: "memory");
    __builtin_amdgcn_s_barrier();
    int buf = 0;
#pragma unroll 1
    for (int kt = 0; kt < 16; ++kt) {
        const int b2 = buf >= 1 ? buf - 1 : 2;
        if (kt + 2 < 16) issue(kt + 2, b2);
        const char* As = smem + buf * H_STAGE + (wt * 64) * 64 + rdoff;
        const char* Bs = smem + buf * H_STAGE + H_A + (wp * 128) * 64 + rdoff;
        i32x4 a[4];
#pragma unroll
        for (int i = 0; i < 4; ++i) a[i] = *(const i32x4*)(As + (16 * i) * 64);
#pragma unroll
        for (int jg = 0; jg < 2; ++jg) {
            i32x4 b[4];
#pragma unroll
            for (int j = 0; j < 4; ++j) b[j] = *(const i32x4*)(Bs + (16 * (4 * jg + j)) * 64);
#pragma unroll
            for (int i = 0; i < 4; ++i)
#pragma unroll
                for (int j = 0; j < 4; ++j) acc[i][4 * jg + j] = __builtin_amdgcn_mfma_i32_16x16x64_i8(b[j], a[i], acc[i][4 * jg + j], 0, 0, 0);
        }
        if (kt + 2 < 16) asm volatile("s_waitcnt vmcnt(4)" ::: "memory");
        else asm volatile("s_waitcnt vmcnt(0)" ::: "memory");
        __builtin_amdgcn_s_barrier();
        buf = buf == 2 ? 0 : buf + 1;
    }
    float4 ws[8];
#pragma unroll
    for (int j = 0; j < 8; ++j) ws[j] = *(const float4*)(p.wsc + h * 256 + wp * 128 + 16 * j + 4 * fq);
    int* LX = (int*)(smem + H_LIST);
#pragma unroll
    for (int i = 0; i < 4; ++i) {
        const int tl = 64 * wt + 16 * i + fr;
        const float rs = rs2_of(p.rs2p, m0 + tl) * ZQ_SCALE;
        int ka[16], kb[16];
#pragma unroll
        for (int jj = 0; jj < 4; ++jj)
#pragma unroll
            for (int r = 0; r < 4; ++r) {
                const float sa = r == 0 ? ws[jj].x : r == 1 ? ws[jj].y : r == 2 ? ws[jj].z : ws[jj].w;
                const float sb = r == 0 ? ws[4 + jj].x : r == 1 ? ws[4 + jj].y : r == 2 ? ws[4 + jj].z : ws[4 + jj].w;
                ka[jj * 4 + r] = (__float_as_int((float)acc[i][jj][r] * (sa * rs) + KEY_BIAS) & ~127) | (16 * jj + 4 * fq + r);
                kb[jj * 4 + r] = (__float_as_int((float)acc[i][4 + jj][r] * (sb * rs) + KEY_BIAS) & ~127) | (16 * (jj + 4) + 4 * fq + r);
            }
        bsort_desc<16>(ka);
        bsort_desc<16>(kb);
#pragma unroll
        for (int q = 0; q < 16; ++q) ka[q] = ka[q] > kb[15 - q] ? ka[q] : kb[15 - q];
        bmerge_desc<16>(ka);
        xmerge16(ka, 16);
        xmerge16(ka, 32);
        const int k0 = fq == 0 ? ka[0] : fq == 1 ? ka[4] : fq == 2 ? ka[8] : ka[12];
        const int k1 = fq == 0 ? ka[1] : fq == 1 ? ka[5] : fq == 2 ? ka[9] : ka[13];
        const int k2 = fq == 0 ? ka[2] : fq == 1 ? ka[6] : fq == 2 ? ka[10] : ka[14];
        const int k3 = fq == 0 ? ka[3] : fq == 1 ? ka[7] : fq == 2 ? ka[11] : ka[15];
        *(int4*)(LX + tl * 32 + wp * 16 + 4 * fq) = make_int4(k0, k1, k2, k3);
    }
    __syncthreads();
#pragma unroll
    for (int i2 = 0; i2 < 2; ++i2) {
        const int tl = 32 * w + 16 * i2 + fr, t = m0 + tl;
        const int* L = LX + tl * 32;
        const unsigned long long clo = fq == 0 ? 0x0706050403020100ull : fq == 1 ? 0x14131211100f0e0dull : fq == 2 ? 0x4033323130242322ull : 0xc0b0a09080717061ull;
        const unsigned long long chi = fq == 0 ? 0x0c0b0a0908ull : fq == 1 ? 0x2120171615ull : fq == 2 ? 0x6051504241ull : 0xfffff0e0d0ull;
        int c[16];
#pragma unroll
        for (int s = 0; s < 13; ++s) {
            const int ab = (int)((s < 8 ? (clo >> (8 * s)) : (chi >> (8 * (s - 8)))) & 0xffull);
            const int k1 = L[ab >> 4], k2 = L[16 + (ab & 15)];
            const float v = (__int_as_float(k1 & ~127) - KEY_BIAS) + (__int_as_float(k2 & ~127) - KEY_BIAS);
            c[s] = (f2key(v) & ~0x3fff) | ((k1 & 127) << 7) | (k2 & 127);
        }
        c[13] = c[14] = c[15] = (int)0x80000000;
        bsort_desc<16>(c);
        xmerge16(c, 16);
        xmerge16(c, 32);
        const float vmax = key2f(c[0] & ~0x3fff);
        float e[16], sum = 0.f;
#pragma unroll
        for (int q = 0; q < 16; ++q) { e[q] = fexp_(key2f(c[q] & ~0x3fff) - vmax); sum += e[q]; }
        const float inv = rcp_(sum);
        int ce[4]; float ge[4];
#pragma unroll
        for (int q = 0; q < 4; ++q) {
            const int cq = fq == 0 ? c[q] : fq == 1 ? c[4 + q] : fq == 2 ? c[8 + q] : c[12 + q];
            const float eq = fq == 0 ? e[q] : fq == 1 ? e[4 + q] : fq == 2 ? e[8 + q] : e[12 + q];
            ce[q] = ((cq >> 7) & 127) * 128 + (cq & 127);
            ge[q] = eq * inv;
        }
        *(uint2*)(p.eperm + (size_t)t * 128 + h * 16 + 4 * fq) = make_uint2((unsigned)ce[0] | ((unsigned)ce[1] << 16), (unsigned)ce[2] | ((unsigned)ce[3] << 16));
        *(float4*)(p.gate + (size_t)t * 128 + h * 16 + 4 * fq) = make_float4(ge[0], ge[1], ge[2], ge[3]);
    }
    __syncthreads();
}
DEVI void st_gemm3_topk(const Params& p, char* smem) {
    for (int it = blockIdx.x; it < 128 * 8; it += gridDim.x) gemm3_topk_tile(p, (it >> 3) * 256, it & 7, smem);
}

#define XB_TMO      128
#define XB_XCNT(j)  (256  + 64 * (j))
#define XB_XSUB(j)  (1280 + 64 * (j))
#define XB_XGEN(j)  (2304 + 64 * (j))
#define XB_TOP      3328
#define XB_TOPGEN   3392
#define XCD_BAR_WORDS 3456
#define XB_SPIN_CAP (1u << 20)
#define LAS __attribute__((address_space(3)))
DEVI unsigned xb_ld(unsigned* p) { return __hip_atomic_load(p, __ATOMIC_RELAXED, __HIP_MEMORY_SCOPE_AGENT); }
DEVI unsigned xb_add(unsigned* p, unsigned v) { return __hip_atomic_fetch_add(p, v, __ATOMIC_RELAXED, __HIP_MEMORY_SCOPE_AGENT); }
DEVI unsigned xb_xcc_id() { return (unsigned)__builtin_amdgcn_s_getreg((3 << 11) | 20) & 0xFu; }
#define XB_SPIN(cond, bar) do { unsigned _sp = 0; while (cond) { __builtin_amdgcn_s_sleep(1); \
    if ((++_sp & 255u) == 0u) { if (xb_ld(&(bar)[XB_TMO])) break; if (_sp > XB_SPIN_CAP) { atomicAdd(&(bar)[XB_TMO], 1u); break; } } } } while (0)
struct XcdBarrier { unsigned* bar; unsigned x; volatile LAS unsigned* st; };
DEVI XcdBarrier xcd_barrier_post(unsigned* bar, volatile LAS unsigned* st) {
    XcdBarrier b; b.bar = bar; b.x = xb_xcc_id(); b.st = st;
    if (stid() == 0) (void)xb_add(&bar[XB_XCNT(b.x)], 1u);
    return b;
}
DEVI void xcd_barrier_complete(unsigned* bar, unsigned x, unsigned& nloc, unsigned& nx) {
    const unsigned G = gridDim.x * gridDim.y * gridDim.z;
    unsigned sum, cnt, mine, sp = 0u;
    for (;;) {
        sum = 0u; cnt = 0u; mine = 0u;
#pragma unroll
        for (unsigned j = 0; j < 16; ++j) { const unsigned c = xb_ld(&bar[XB_XCNT(j)]); sum += c; cnt += (c > 0u) ? 1u : 0u; mine = (j == x) ? c : mine; }
        if (sum == G) break;
        __builtin_amdgcn_s_sleep(1);
        if ((++sp & 255u) == 0u) { if (xb_ld(&bar[XB_TMO])) break; if (sp > XB_SPIN_CAP) { atomicAdd(&bar[XB_TMO], 1u); break; } }
    }
    nloc = mine > 0u ? mine : 1u; nx = cnt > 0u ? cnt : 1u;
}
DEVI void xcd_barrier(const XcdBarrier& b) {
    asm volatile("s_waitcnt vmcnt(0)" ::: "memory");
    __syncthreads();
    if (stid() == 0) {
        unsigned* bar = b.bar;
        __builtin_amdgcn_s_waitcnt(0);
        unsigned nloc = b.st[0], nx = b.st[1];
        if (nloc == 0u) { xcd_barrier_complete(bar, b.x, nloc, nx); b.st[0] = nloc; b.st[1] = nx; }
        const unsigned old = xb_add(&bar[XB_XSUB(b.x)], 1u);
        const unsigned gen = old / nloc;
        if (old + 1u == (gen + 1u) * nloc) {
            __builtin_amdgcn_fence(__ATOMIC_RELEASE, "agent");
            asm volatile("s_waitcnt vmcnt(0)" ::: "memory");
            const unsigned og = xb_add(&bar[XB_TOP], 1u);
            const unsigned tg = og / nx;
            if (og + 1u == (tg + 1u) * nx) xb_add(&bar[XB_TOPGEN], 1u);
            else XB_SPIN(xb_ld(&bar[XB_TOPGEN]) == tg, bar);
            __builtin_amdgcn_fence(__ATOMIC_ACQUIRE, "agent");
            xb_add(&bar[XB_XGEN(b.x)], 1u);
            asm volatile("s_waitcnt vmcnt(0)" ::: "memory");
        } else {
            XB_SPIN(xb_ld(&bar[XB_XGEN(b.x)]) == gen, bar);
            __builtin_amdgcn_fence(__ATOMIC_ACQUIRE, "agent");
            asm volatile("s_waitcnt vmcnt(0)" ::: "memory");
        }
    }
    __syncthreads();
}

#define CTR_A(x) (XCD_BAR_WORDS + 64 * (x))
#define CTR_B(x) (XCD_BAR_WORDS + 512 + 64 * (x))
#define CTL_WORDS (XCD_BAR_WORDS + 1024)
typedef float f32x2 __attribute__((ext_vector_type(2)));
DEVI float ub(unsigned w, int n) { return (float)((w >> (8 * n)) & 0xffu); }
DEVI float gelu_erf(float v) {
    const float av = fabsf(v), t = rcp_(av * 0.2316418882f + 1.0f);
    float q = t * 0.5307027145f + (-0.7265760135f);
    q = q * t + 0.7107068705f; q = q * t + (-0.142248368f); q = q * t + 0.127414796f; q = q * t;
    const float e = __builtin_amdgcn_exp2f((v * v) * (-0.72134752044f));
    const float m = v * (q * e);
    return v < 0.f ? m : v - m;
}
struct ExpMeta { uint4 e[2]; uint4 xa; uint4 xb; float sc; float sa8; };
struct ExpRows { uint4 r[16]; uint2 x1; };

template <int PHASE> DEVI void exp_load_meta(const Params& p, ExpMeta& m, int t, int x, int lane) {
    const uint4* ep = (const uint4*)(p.eperm + (size_t)t * 128 + (lane >> 3) * 16);
    m.e[0] = ep[0];
    m.e[1] = ep[1];
    if (PHASE == 0) { const uint4* xp = (const uint4*)(p.xq + (size_t)t * 1024 + 256 * x + 32 * (lane & 7)); m.xa = xp[0]; m.xb = xp[1]; }
    else { m.xa = *(const uint4*)(p.aq + (size_t)t * 128 + (lane >> 3) * 16); const float2 s2 = *(const float2*)(p.asc + 2 * (size_t)t); m.sc = s2.x; m.sa8 = s2.y; }
}
template <int PHASE> DEVI void exp_issue(const Params& p, const ExpMeta& m, ExpRows& R, int t, int x, int lane) {
    const unsigned char* base = (PHASE == 0 ? p.down_q : p.up_q) + (size_t)x * (16384 * 128) + (lane & 7) * 16;
    const unsigned ew[8] = {m.e[0].x, m.e[0].y, m.e[0].z, m.e[0].w, m.e[1].x, m.e[1].y, m.e[1].z, m.e[1].w};
#pragma unroll
    for (int j = 0; j < 16; ++j) {
        const unsigned ek = (j & 1) ? (ew[j >> 1] >> 16) : (ew[j >> 1] & 0xffffu);
        R.r[j] = *(const uint4*)(base + (size_t)ek * 128);
    }
    if (PHASE == 1) {
        const int col = 256 * x + 32 * (lane & 7) + ((lane & 32) ? 16 : 0) + ((lane & 16) ? 8 : 0) + ((lane & 8) ? 4 : 0);
        R.x1 = *(const uint2*)(p.x1b + (size_t)t * 1024 + col);
    }
}
DEVI void expA_compute(const Params& p, const ExpMeta& m, const ExpRows& R, int t, int x, int lane) {
    const bool b2 = lane & 4, b1 = lane & 2, b0 = lane & 1;
    int ps[16];
    const int xq8[8] = {(int)m.xa.x, (int)m.xa.y, (int)m.xa.z, (int)m.xa.w, (int)m.xb.x, (int)m.xb.y, (int)m.xb.z, (int)m.xb.w};
#pragma unroll
    for (int j = 0; j < 16; ++j) {
        const unsigned wd[4] = {R.r[j].x, R.r[j].y, R.r[j].z, R.r[j].w};
        int a = 0;
#pragma unroll
        for (int d = 0; d < 4; ++d) {
            a = __builtin_amdgcn_sdot4((int)((wd[d] << 4) & 0xf0f0f0f0u), xq8[2 * d], a, false);
            a = __builtin_amdgcn_sdot4((int)(wd[d] & 0xf0f0f0f0u), xq8[2 * d + 1], a, false);
        }
        ps[j] = a;
    }
    int q8[8], q4[4], q2[2];
#pragma unroll
    for (int j = 0; j < 8; ++j) { const int snd = b2 ? ps[j] : ps[j + 8], kp = b2 ? ps[j + 8] : ps[j]; q8[j] = kp + dpp_i<DPP_HMIRROR>(snd); }
#pragma unroll
    for (int j = 0; j < 4; ++j) { const int snd = b1 ? q8[j] : q8[j + 4], kp = b1 ? q8[j + 4] : q8[j]; q4[j] = kp + dpp_i<DPP_XOR2>(snd); }
#pragma unroll
    for (int j = 0; j < 2; ++j) { const int snd = b0 ? q4[j] : q4[j + 2], kp = b0 ? q4[j + 2] : q4[j]; q2[j] = kp + dpp_i<DPP_XOR1>(snd); }
    {
        int s0 = q2[0] >> 4, s1 = q2[1] >> 4;
        s0 = s0 > 32767 ? 32767 : (s0 < -32768 ? -32768 : s0);
        s1 = s1 > 32767 ? 32767 : (s1 < -32768 ? -32768 : s1);
        *(unsigned*)(p.part + ((size_t)x * T_TOK + t) * 128 + 2 * lane) = ((unsigned)s0 & 0xffffu) | ((unsigned)s1 << 16);
    }
}
DEVI void expB_compute(const Params& p, const ExpMeta& m, const ExpRows& R, int t, int x, int lane) {
    const bool b3 = lane & 8;
    const unsigned pa[4] = {m.xa.x, m.xa.y, m.xa.z, m.xa.w};
    int accF[16], accH[16];
#pragma unroll
    for (int c = 0; c < 16; ++c) { accF[c] = 0; accH[c] = 0; }
#pragma unroll
    for (int g = 0; g < 4; ++g) {
        const unsigned r0[4] = {R.r[4 * g].x, R.r[4 * g].y, R.r[4 * g].z, R.r[4 * g].w};
        const unsigned r1[4] = {R.r[4 * g + 1].x, R.r[4 * g + 1].y, R.r[4 * g + 1].z, R.r[4 * g + 1].w};
        const unsigned r2[4] = {R.r[4 * g + 2].x, R.r[4 * g + 2].y, R.r[4 * g + 2].z, R.r[4 * g + 2].w};
        const unsigned r3[4] = {R.r[4 * g + 3].x, R.r[4 * g + 3].y, R.r[4 * g + 3].z, R.r[4 * g + 3].w};
#pragma unroll
        for (int i = 0; i < 4; ++i) {
            const unsigned t0 = __builtin_amdgcn_perm(r1[i], r0[i], 0x05010400u), t1 = __builtin_amdgcn_perm(r1[i], r0[i], 0x07030602u);
            const unsigned t2 = __builtin_amdgcn_perm(r3[i], r2[i], 0x05010400u), t3 = __builtin_amdgcn_perm(r3[i], r2[i], 0x07030602u);
            const unsigned o[4] = {__builtin_amdgcn_perm(t2, t0, 0x05040100u), __builtin_amdgcn_perm(t2, t0, 0x07060302u),
                                   __builtin_amdgcn_perm(t3, t1, 0x05040100u), __builtin_amdgcn_perm(t3, t1, 0x07060302u)};
#pragma unroll
            for (int n = 0; n < 4; ++n) {
                accF[4 * i + n] = __builtin_amdgcn_sdot4((int)o[n], (int)pa[g], accF[4 * i + n], false);
                accH[4 * i + n] = __builtin_amdgcn_sdot4((int)(o[n] & 0xf0f0f0f0u), (int)pa[g], accH[4 * i + n], false);
            }
        }
    }
    int acc[32];
#pragma unroll
    for (int i = 0; i < 4; ++i)
#pragma unroll
        for (int n = 0; n < 4; ++n) { acc[8 * i + n] = accF[4 * i + n] - accH[4 * i + n]; acc[8 * i + 4 + n] = accH[4 * i + n]; }
    int q16[16], q8[8], q4[4];
#pragma unroll
    for (int j = 0; j < 16; ++j) {
        const auto r = __builtin_amdgcn_permlane32_swap((unsigned)acc[j], (unsigned)acc[j + 16], false, false);
        q16[j] = (int)r[0] + (int)r[1];
    }
#pragma unroll
    for (int j = 0; j < 8; ++j) {
        const auto r = __builtin_amdgcn_permlane16_swap((unsigned)q16[j], (unsigned)q16[j + 8], false, false);
        q8[j] = (int)r[0] + (int)r[1];
    }
#pragma unroll
    for (int j = 0; j < 4; ++j) { const int snd = b3 ? q8[j] : q8[j + 4], kp = b3 ? q8[j + 4] : q8[j]; q4[j] = kp + dpp_i<DPP_ROR8>(snd); }
    const int col = 256 * x + 32 * (lane & 7) + ((lane & 32) ? 16 : 0) + ((lane & 16) ? 8 : 0) + (b3 ? 4 : 0);
    const float sc = b3 ? m.sc : m.sc * 16.f, off = b3 ? 0.f : m.sa8;
    *(uint2*)(p.proj + (size_t)t * 1024 + col) = make_uint2(pk2(bflo(R.x1.x) + ((float)q4[0] - off) * sc, bfhi(R.x1.x) + ((float)q4[1] - off) * sc),
                                                            pk2(bflo(R.x1.y) + ((float)q4[2] - off) * sc, bfhi(R.x1.y) + ((float)q4[3] - off) * sc));
}
constexpr int EXP_NP = 16;
template <int PHASE>
DEVI void exp_chunk(const Params& p, int tb, int x, int lane) {
    ExpMeta mA, mB, nA, nB;
    ExpRows rA, rB;
    exp_load_meta<PHASE>(p, mA, tb, x, lane);
    exp_load_meta<PHASE>(p, mB, tb + 1, x, lane);
    exp_issue<PHASE>(p, mA, rA, tb, x, lane);
    exp_issue<PHASE>(p, mB, rB, tb + 1, x, lane);
    exp_load_meta<PHASE>(p, nA, tb + 2, x, lane);
    exp_load_meta<PHASE>(p, nB, tb + 3, x, lane);
#pragma unroll 1
    for (int i = 0; i < EXP_NP; ++i) {
        const int tA = tb + 2 * i, tB = tA + 1;
        if (PHASE == 0) expA_compute(p, mA, rA, tA, x, lane); else expB_compute(p, mA, rA, tA, x, lane);
        if (i < EXP_NP - 1) {
            mA = nA;
            exp_issue<PHASE>(p, mA, rA, tA + 2, x, lane);
            if (i < EXP_NP - 2) exp_load_meta<PHASE>(p, nA, tA + 4, x, lane);
        }
        if (PHASE == 0) expA_compute(p, mB, rB, tB, x, lane); else expB_compute(p, mB, rB, tB, x, lane);
        if (i < EXP_NP - 1) {
            mB = nB;
            exp_issue<PHASE>(p, mB, rB, tB + 2, x, lane);
            if (i < EXP_NP - 2) exp_load_meta<PHASE>(p, nB, tB + 4, x, lane);
        }
    }
}
template <int PHASE>
DEVI void st_expAB(const Params& p, char* smem) {
    const int tid = stid(), lane = tid & 63, wid = tid >> 6;
    volatile int* cs = (volatile int*)smem;
    const unsigned myx = xb_xcc_id() & 7u;
    constexpr int NCH = T_TOK / (2 * EXP_NP * NW);
    constexpr int NSL = 4;
    for (int si = 0; si < NSL; ++si) {
        const int x = (int)((myx + si) & (unsigned)(NSL - 1));
        unsigned* ctr = &p.bar[PHASE == 0 ? CTR_A(x) : CTR_B(x)];
        if (tid == 0) cs[0] = (int)xb_add(ctr, 1u);
        __syncthreads();
        int chunk = cs[0];
        __syncthreads();
        while (chunk < NCH) {
            int nxt = 0;
            if (tid == 0) nxt = (int)xb_add(ctr, 1u);
            exp_chunk<PHASE>(p, chunk * (2 * EXP_NP * NW) + wid * (2 * EXP_NP), x, lane);
            if (tid == 0) cs[0] = nxt;
            __syncthreads();
            chunk = cs[0];
            __syncthreads();
        }
    }
}
DEVI void st_expA2(const Params& p) {
    const int lane = stid() & 63, wid = stid() >> 6;
    for (int t0 = (blockIdx.x * NW + wid) * 2; t0 < T_TOK; t0 += gridDim.x * NW * 2) {
        unsigned pv[2][4], ew[2];
        float2 g[2];
        float xs[2];
#pragma unroll
        for (int q = 0; q < 2; ++q) {
            const int t = t0 + q;
#pragma unroll
            for (int x = 0; x < 4; ++x) pv[q][x] = *(const unsigned*)(p.part + ((size_t)x * T_TOK + t) * 128 + 2 * lane);
            ew[q] = *(const unsigned*)(p.eperm + (size_t)t * 128 + 2 * lane);
            g[q] = *(const float2*)(p.gate + (size_t)t * 128 + 2 * lane);
            xs[q] = rs2_of(p.rs2p, t) * ZQ_SCALE;
        }
        float ds[2][2], us[2][2];
#pragma unroll
        for (int q = 0; q < 2; ++q) {
            const int ea = (int)(ew[q] & 0xffffu), eb = (int)(ew[q] >> 16);
            ds[q][0] = p.dscale[ea]; ds[q][1] = p.dscale[eb]; us[q][0] = p.uscale[ea]; us[q][1] = p.uscale[eb];
        }
#pragma unroll
        for (int q = 0; q < 2; ++q) {
            const int t = t0 + q;
            int s0 = 0, s1 = 0;
#pragma unroll
            for (int x = 0; x < 4; ++x) { s0 += (int)(short)(pv[q][x] & 0xffffu); s1 += (int)pv[q][x] >> 16; }
            const float a0 = g[q].x * gelu_erf((float)s0 * xs[q] * ds[q][0]) * us[q][0];
            const float a1 = g[q].y * gelu_erf((float)s1 * xs[q] * ds[q][1]) * us[q][1];
            const float amax = wave_max(fmaxf(fabsf(a0), fabsf(a1)));
            const float inv = amax > 0.f ? 127.f * rcp_(amax) : 0.f;
            const float f0 = rintf(a0 * inv), f1 = rintf(a1 * inv);
            const unsigned q0 = (unsigned)((int)f0 & 255), q1 = (unsigned)((int)f1 & 255);
            *(unsigned short*)(p.aq + (size_t)t * 128 + 2 * lane) = (unsigned short)(q0 | (q1 << 8));
            const float sa = wave_sum(f0 + f1);
            if (lane == 0) *(float2*)(p.asc + 2 * (size_t)t) = make_float2(amax * (1.f / 127.f), 8.f * sa);
        }
    }
}
DEVI void st_expC(const Params& p) {
    const int lane = stid() & 63, wid = stid() >> 6;
    for (int t0 = (blockIdx.x * NW + wid) * 2; t0 < T_TOK; t0 += gridDim.x * NW * 2) {
        uint2 u[2][4];
#pragma unroll
        for (int q = 0; q < 2; ++q) {
            const uint2* row = (const uint2*)(p.proj + (size_t)(t0 + q) * 1024);
#pragma unroll
            for (int j = 0; j < 4; ++j) u[q][j] = row[lane + 64 * j];
        }
#pragma unroll
        for (int q = 0; q < 2; ++q) {
            float4 v[4];
            float ss = 0.f;
#pragma unroll
            for (int j = 0; j < 4; ++j) {
                v[j] = make_float4(bflo(u[q][j].x), bfhi(u[q][j].x), bflo(u[q][j].y), bfhi(u[q][j].y));
                ss += v[j].x * v[j].x + v[j].y * v[j].y + v[j].z * v[j].z + v[j].w * v[j].w;
            }
            ss = wave_sum(ss);
            const float rf = rsqrtf(ss * (1.f / 1024.f) + EPSN);
            float4* orow = (float4*)(p.out + (size_t)(t0 + q) * 1024);
#pragma unroll
            for (int j = 0; j < 4; ++j) {
                const float4 g = *(const float4*)(p.final_g + (lane + 64 * j) * 4);
                orow[lane + 64 * j] = make_float4(v[j].x * rf * g.x, v[j].y * rf * g.y, v[j].z * rf * g.z, v[j].w * rf * g.w);
            }
        }
    }
}

constexpr int LDS_BYTES = 147456;
constexpr int LDS_BARW = LDS_BYTES - 16;
extern __shared__ __attribute__((aligned(16))) char smem_dyn[];
__global__ void __launch_bounds__(NTHR, 2) mega_fwd(Params p) {
    cg::grid_group grid = cg::this_grid();
    volatile LAS unsigned* bst = (volatile LAS unsigned*)(LAS char*)(smem_dyn + LDS_BARW);
    if (stid() < 4) bst[stid()] = 0u;
    __syncthreads();
    XcdBarrier bar = xcd_barrier_post(p.bar, bst);
    st_prep_misc(p);
    st_prep_w1(p, smem_dyn);
    st_prep_x(p, smem_dyn);
    if (p.pad_[0] == 0x7fffabcd) grid.sync();
    xcd_barrier(bar);
    st_gemm8<EpiProj8, PG8_ALIGN>(p.xb, p.W1t, NPJ, 1024, smem_dyn, EpiProj8{p.proj, p.rs1, p.rope_cos, p.rope_sin});
    xcd_barrier(bar);
    st_conv_qk(p, smem_dyn);
    xcd_barrier(bar);
    st_recur(p, smem_dyn);
    xcd_barrier(bar);
    st_gemm8<EpiX18, PG8_ALIGN>(p.yb, p.W2t, 1024, 1024, smem_dyn, EpiX18{p.x, p.x1b, p.xq, p.rs2p, p.norm2_g});
    xcd_barrier(bar);
    st_gemm3_topk(p, smem_dyn);
    xcd_barrier(bar);
    st_expAB<0>(p, smem_dyn);
    xcd_barrier(bar);
    st_expA2(p);
    xcd_barrier(bar);
    st_expAB<1>(p, smem_dyn);
    xcd_barrier(bar);
    st_expC(p);
}

extern "C" void kernel_launch(void* const* d_in, const int* in_sizes, int n_in, void* d_out, int out_size, void* d_ws, size_t ws_size,
                              hipStream_t stream) {
    Params p{};
    const float* const* in = (const float* const*)d_in;
    p.x = in[0]; p.norm1_g = in[1]; p.w_in = in[2]; p.ret_norm_g = in[3]; p.m_conv_w = in[4]; p.m_conv_b = in[5]; p.m_wq = in[6]; p.m_wk = in[7];
    p.m_b_i = in[8]; p.m_b_f = in[9]; p.m_norm_g = in[10]; p.m_skip = in[11]; p.w_out = in[12]; p.norm2_g = in[13]; p.peer_wq = in[14];
    p.peer_keys = in[15]; p.peer_down = in[16]; p.peer_up = in[17]; p.final_g = in[18];
    p.out = (float*)d_out;
    char* ws = (char*)d_ws;
    size_t off = 0;
    auto take = [&](size_t bytes) { char* r = ws + off; off += (bytes + 255) & ~(size_t)255; return r; };
    p.proj = (bf16_t*)take((size_t)T_TOK * NPJ * 2);
    p.xb = (bf16_t*)take((size_t)T_TOK * 1024 * 2);
    p.yb = p.xb;
    p.gate = (float*)(ws + (size_t)T_TOK * 2048 * 4);
    p.mq = (bf16_t*)take((size_t)T_TOK * 512 * 2);
    p.mk = (bf16_t*)take((size_t)T_TOK * 512 * 2);
    p.x1b = p.mq;
    p.cbuf = (bf16_t*)take((size_t)T_TOK * 512 * 2);
    p.eperm = (unsigned short*)p.cbuf;
    p.down_q = (unsigned char*)take((size_t)16384 * 1024);
    p.up_q = (unsigned char*)take((size_t)16384 * 1024);
    p.dscale = (float*)take(16384 * 4);
    p.uscale = (float*)take(16384 * 4);
    p.bar = (unsigned*)take(CTL_WORDS * 4);
    p.xq = (unsigned char*)take((size_t)T_TOK * 1024);
    p.asc = (float*)take(T_TOK * 8);
    p.aq = (unsigned char*)take((size_t)T_TOK * 128);
    p.part = (short*)(ws + (size_t)T_TOK * 1024 * 4);
    p.W1t = (bf16_t*)take((size_t)NPJ * 1024 * 2);
    p.W2t = (bf16_t*)take((size_t)1024 * 1024 * 2);
    p.Wsubq = (signed char*)take((size_t)2048 * 1024);
    p.wsc = (float*)take(2048 * 4);
    p.Wqt = (bf16_t*)take(4 * 128 * 128 * 2);
    p.Wkt = (bf16_t*)take(4 * 128 * 128 * 2);
    p.rs1 = (float*)take(T_TOK * 4);
    p.rs2p = (float*)take((size_t)T_TOK * 16 * 4);
    p.ipre = (float*)take(T_TOK * 4 * 4);
    p.logf = (float*)take(T_TOK * 4 * 4);
    p.rope_cos = (float*)take(2048 * 64 * 4);
    p.rope_sin = (float*)take(2048 * 64 * 4);
    if (off > ws_size) { fprintf(stderr, "kernel_launch: workspace too small (%zu > %zu)\n", off, ws_size); return; }

    static int grid_blocks = 0;
    if (!grid_blocks) {
        int dev = 0, cus = 0, per_cu = 0;
        (void)hipGetDevice(&dev);
        (void)hipDeviceGetAttribute(&cus, hipDeviceAttributeMultiprocessorCount, dev);
        (void)hipFuncSetAttribute((const void*)mega_fwd, hipFuncAttributeMaxDynamicSharedMemorySize, LDS_BYTES);
        (void)hipOccupancyMaxActiveBlocksPerMultiprocessor(&per_cu, (const void*)mega_fwd, NTHR, LDS_BYTES);
        if (per_cu > 1) per_cu = 1;
        if (per_cu < 1) per_cu = 1;
        grid_blocks = cus * per_cu;
    }
    (void)hipMemsetAsync(p.bar, 0, CTL_WORDS * 4, stream);
    void* args[] = {&p};
    hipError_t e = hipLaunchCooperativeKernel((const void*)mega_fwd, dim3(grid_blocks), dim3(NTHR), args, LDS_BYTES, stream);
    if (e != hipSuccess) fprintf(stderr, "cooperative launch failed: %s (grid %d)\n", hipGetErrorString(e), grid_blocks);
}
```

```cpp
#include <hip/hip_runtime.h>
#include <hip/hip_cooperative_groups.h>
#include <stdint.h>
#include <cstdio>
namespace cg = cooperative_groups;

typedef unsigned short bf16_t;
typedef short bf16x8 __attribute__((ext_vector_type(8)));
typedef float f32x4 __attribute__((ext_vector_type(4)));
typedef int i32x4 __attribute__((ext_vector_type(4)));

#define DEVI __device__ __forceinline__
__device__ __forceinline__ int stid() { int t = (int)threadIdx.x; asm volatile("" : "+v"(t)); return t; }

constexpr int T_TOK = 32768, DM = 1024, NPJ = 3584, DIN = 3592;
constexpr int NPR = 1536;
constexpr size_t OPB = (size_t)T_TOK * 512;
__device__ __forceinline__ size_t blk_off(int t16, int h) { return ((size_t)(((t16 >> 2) * 4 + h) * 4 + (t16 & 3))) * 2048; }
constexpr int NTHR = 512, NW = 8;
constexpr float EPSN = 1e-6f;

struct Params {
    const float *x, *norm1_g, *w_in, *ret_norm_g, *m_conv_w, *m_conv_b, *m_wq, *m_wk, *m_b_i, *m_b_f, *m_norm_g, *m_skip, *w_out,
        *norm2_g, *peer_wq, *peer_keys, *peer_down, *peer_up, *final_g;
    float* out;
    bf16_t *proj, *xb, *yb, *mq, *mk, *x1b, *cbuf, *W1t, *W2t, *Wqt, *Wkt;
    signed char* Wsubq;
    float* wsc;
    unsigned char *down_q, *up_q;
    float *dscale, *uscale, *asc;
    unsigned short* eperm;
    unsigned char* aq;
    short* part;
    unsigned char* xq; unsigned char* xq4;
    unsigned* bar;
    float *rs1, *rs2p, *ipre, *logf, *rope_cos, *rope_sin, *gate;
    int pad_[2];
};

DEVI unsigned f2bf_bits(float f) { unsigned u = __float_as_uint(f); return (u + 0x7fffu + ((u >> 16) & 1u)) >> 16; }
DEVI bf16_t f2bf(float f) { return __builtin_bit_cast(bf16_t, (__bf16)f); }
typedef __bf16 bf16x2_t __attribute__((ext_vector_type(2)));
DEVI unsigned pk2(float lo, float hi) { bf16x2_t v = {(__bf16)lo, (__bf16)hi}; return __builtin_bit_cast(unsigned, v); }
DEVI float bflo(unsigned w) { return __uint_as_float(w << 16); }
DEVI float bfhi(unsigned w) { return __uint_as_float(w & 0xffff0000u); }
DEVI float bf2f(bf16_t h) { return __uint_as_float(((unsigned)h) << 16); }
template <int CTRL> DEVI float dpp_f(float v) { return __int_as_float(__builtin_amdgcn_update_dpp(0, __float_as_int(v), CTRL, 0xf, 0xf, false)); }
template <int CTRL> DEVI int dpp_i(int v) { return __builtin_amdgcn_update_dpp(0, v, CTRL, 0xf, 0xf, false); }
constexpr int DPP_XOR1 = 0xB1  , DPP_XOR2 = 0x4E  , DPP_HMIRROR = 0x141  ,
              DPP_MIRROR = 0x140  , DPP_ROR8 = 0x128  ;
DEVI float rl_f(float v, int l) { return __int_as_float(__builtin_amdgcn_readlane(__float_as_int(v), l)); }
DEVI float wave_sum(float v) {
    v += dpp_f<DPP_XOR1>(v); v += dpp_f<DPP_XOR2>(v); v += dpp_f<DPP_HMIRROR>(v); v += dpp_f<DPP_MIRROR>(v);
    return (rl_f(v, 0) + rl_f(v, 16)) + (rl_f(v, 32) + rl_f(v, 48));
}
DEVI float wave_max(float v) {
    v = fmaxf(v, dpp_f<DPP_XOR1>(v)); v = fmaxf(v, dpp_f<DPP_XOR2>(v)); v = fmaxf(v, dpp_f<DPP_HMIRROR>(v)); v = fmaxf(v, dpp_f<DPP_MIRROR>(v));
    return fmaxf(fmaxf(rl_f(v, 0), rl_f(v, 16)), fmaxf(rl_f(v, 32), rl_f(v, 48)));
}
constexpr float ZQ_SCALE = 6.f / 127.f;
DEVI float rs2_of(const float* rs2p, int t) {
    const float4* q = (const float4*)(rs2p + (size_t)t * 16);
    const float4 a = q[0], b = q[1], c = q[2], d = q[3];
    const float ss = ((a.x + a.y) + (a.z + a.w)) + ((b.x + b.y) + (b.z + b.w)) + ((c.x + c.y) + (c.z + c.w)) + ((d.x + d.y) + (d.z + d.w));
    return rsqrtf(ss * (1.f / 1024.f) + EPSN);
}
DEVI f32x4 mfma16(bf16x8 a, bf16x8 b, f32x4 c) { return __builtin_amdgcn_mfma_f32_16x16x32_bf16(a, b, c, 0, 0, 0); }
DEVI bf16x8 ld8(const char* p) { return *reinterpret_cast<const bf16x8*>(p); }
DEVI bf16x8 mk8(uint2 lo, uint2 hi) {
    union { uint4 u; bf16x8 v; } x;
    x.u = make_uint4(lo.x, lo.y, hi.x, hi.y);
    return x.v;
}
DEVI float fexp_(float x) { return __builtin_amdgcn_exp2f(x * 1.4426950408889634f); }
DEVI float rcp_(float x) { return __builtin_amdgcn_rcpf(x); }
DEVI float sigmoidf_(float z) { return rcp_(1.f + fexp_(-z)); }

DEVI void st_prep_misc(const Params& p) {
    const int gtid = blockIdx.x * NTHR + stid(), gsz = gridDim.x * NTHR;
    for (int i = gtid; i < 2048 * 64; i += gsz) {
        const int pos = i >> 6, j = i & 63;
        const float inv = powf(10000.f, -(float)j * (1.f / 64.f));
        const float ang = (float)pos * inv;
        float s, c;
        sincosf(ang, &s, &c);
        p.rope_cos[i] = c;
        p.rope_sin[i] = s;
    }
    for (int i = gtid; i < 4 * 128 * 128; i += gsz) {
        const int h = i >> 14, e = (i >> 7) & 127, d = i & 127;
        p.Wqt[i] = f2bf(p.m_wq[h * 16384 + d * 128 + e]);
        p.Wkt[i] = f2bf(p.m_wk[h * 16384 + d * 128 + e] * 0.08838834764831845f);
    }
}
DEVI void prep_table_row(const Params& p, int row, const float4 (&v)[4], int lane) {
    const bool up = row >= 16384;
    const int e = up ? row - 16384 : row;
    float am = 0.f, ss = 0.f;
#pragma unroll
    for (int i = 0; i < 4; ++i) {
        am = fmaxf(am, fmaxf(fmaxf(fabsf(v[i].x), fabsf(v[i].y)), fmaxf(fabsf(v[i].z), fabsf(v[i].w))));
        ss += v[i].x * v[i].x + v[i].y * v[i].y + v[i].z * v[i].z + v[i].w * v[i].w;
    }
    am = wave_max(am);
    ss = wave_sum(ss);
    float sc = fminf(am * (1.f / 7.f), 0.36f * sqrtf(ss * (1.f / 1024.f)));
    sc = sc > 0.f ? sc : 1.f;
    const float inv = 1.f / sc;
    unsigned w2[2];
#pragma unroll
    for (int g = 0; g < 2; ++g) {
        const float lo[4] = {v[2 * g].x, v[2 * g].y, v[2 * g].z, v[2 * g].w}, hi[4] = {v[2 * g + 1].x, v[2 * g + 1].y, v[2 * g + 1].z, v[2 * g + 1].w};
        unsigned d = 0u;
#pragma unroll
        for (int i = 0; i < 4; ++i) {
            const int ql = (int)fminf(fmaxf(rintf(lo[i] * inv), -7.f), 7.f), qh = (int)fminf(fmaxf(rintf(hi[i] * inv), -7.f), 7.f);
            d |= ((unsigned)((up ? ql + 8 : ql) & 15) | ((unsigned)(qh & 15) << 4)) << (8 * i);
        }
        w2[g] = d;
    }
    *(uint2*)((up ? p.up_q : p.down_q) + ((size_t)(lane >> 4) * 16384 + e) * 128 + (lane & 15) * 8) = make_uint2(w2[0], w2[1]);
    if (lane == 0) { if (up) p.uscale[e] = sc * (1.f / 16.f); else p.dscale[e] = sc; }
}
DEVI void st_prep_tables(const Params& p, int bid, int nb) {
    const int lane = stid() & 63, wid = stid() >> 6;
    for (int row = (bid * NW + wid) * 2; row < 32768; row += nb * NW * 2) {
        float4 va[4], vb[4];
        const float4* sa = (const float4*)((row >= 16384 ? p.peer_up + (size_t)(row - 16384) * 1024 : p.peer_down + (size_t)row * 1024) + lane * 16);
        const float4* sb = (const float4*)((row + 1 >= 16384 ? p.peer_up + (size_t)(row + 1 - 16384) * 1024 : p.peer_down + (size_t)(row + 1) * 1024) + lane * 16);
#pragma unroll
        for (int i = 0; i < 4; ++i) { va[i] = sa[i]; vb[i] = sb[i]; }
        prep_table_row(p, row, va, lane);
        prep_table_row(p, row + 1, vb, lane);
    }
}

DEVI void transpose_tile(const float* __restrict__ src, int ld, const float* __restrict__ scale, bf16_t* __restrict__ dst, int K, int k0, int n0,
                         float* tile, bool permqk = false) {
    const int tid = stid();
    {
        const int tx = tid & 63, ty = tid >> 6;
#pragma unroll
        for (int i = 0; i < 4; ++i) {
            const int k = k0 + ty + 8 * i;
            float v = src[(size_t)k * ld + n0 + tx];
            if (scale) v *= scale[k];
            tile[(ty + 8 * i) * 65 + tx] = v;
        }
    }
    __syncthreads();
    {
        const int n = tid >> 3, kq = tid & 7;
        const float a = tile[(4 * kq) * 65 + n], b = tile[(4 * kq + 1) * 65 + n], c = tile[(4 * kq + 2) * 65 + n], d = tile[(4 * kq + 3) * 65 + n];
        int nn = n0 + n;
        if (permqk && nn < 1024) { const int dd = nn & 127; nn = (nn & ~127) + (dd < 64 ? 2 * dd : 2 * (dd - 64) + 1); }
        *(uint2*)(dst + (size_t)nn * K + k0 + 4 * kq) = make_uint2(pk2(a, b), pk2(c, d));
    }
    __syncthreads();
}
DEVI void st_prep_w1(const Params& p, char* smem) {
    float* tile = (float*)smem;
    for (int it = blockIdx.x; it < 56 * 32; it += gridDim.x) transpose_tile(p.w_in, DIN, p.norm1_g, p.W1t, 1024, (it & 31) * 32, (it >> 5) * 64, tile, true);
}
DEVI void st_prep_w2(const Params& p, char* smem, int bid, int nb) {
    float* tile = (float*)smem;
    for (int it = bid; it < 16 * 32; it += nb) transpose_tile(p.w_out, 1024, nullptr, p.W2t, 1024, (it & 31) * 32, (it >> 5) * 64, tile);
}
DEVI void st_prep_wsub(const Params& p, char* smem, int bid, int nb) {
    float* wq_s = (float*)smem;
    float* key_s = wq_s + 64 * 132;
    const int tid = stid(), nl = tid >> 5, kp = tid & 31;
    for (int it = bid; it < 16 * 8; it += nb) {
        const int grp = it >> 3, n0 = (it & 7) * 16;
        __syncthreads();
        {
            const int idx = tid * 4, n = idx >> 7, d = idx & 127;
            *(float4*)(key_s + n * 132 + d) = *(const float4*)(p.peer_keys + ((size_t)grp * 128 + n0 + n) * 128 + d);
        }
        float v0[16], v1[16];
#pragma unroll 1
        for (int kt = 0; kt < 16; ++kt) {
            __syncthreads();
#pragma unroll
            for (int i = 0; i < 4; ++i) {
                const int idx = (tid + 512 * i) * 4, r = idx >> 7, d = idx & 127;
                *(float4*)(wq_s + r * 132 + d) = *(const float4*)(p.peer_wq + (size_t)(kt * 64 + r) * 2048 + grp * 128 + d);
            }
            __syncthreads();
            float a0 = 0.f, a1 = 0.f;
#pragma unroll 8
            for (int d4 = 0; d4 < 32; ++d4) {
                const float4 w0 = *(const float4*)(wq_s + (2 * kp) * 132 + 4 * d4), w1 = *(const float4*)(wq_s + (2 * kp + 1) * 132 + 4 * d4);
                const float4 y = *(const float4*)(key_s + nl * 132 + 4 * d4);
                a0 += w0.x * y.x + w0.y * y.y + w0.z * y.z + w0.w * y.w;
                a1 += w1.x * y.x + w1.y * y.y + w1.z * y.z + w1.w * y.w;
            }
#pragma unroll
            for (int q = 0; q < 16; ++q) if (q == kt) { v0[q] = a0; v1[q] = a1; }
        }
        float am = 0.f;
#pragma unroll
        for (int q = 0; q < 16; ++q) am = fmaxf(am, fmaxf(fabsf(v0[q]), fabsf(v1[q])));
#pragma unroll
        for (int o = 16; o; o >>= 1) am = fmaxf(am, __shfl_xor(am, o));
        const float inv = am > 0.f ? 127.f * rcp_(am) : 0.f;
        signed char* orow = p.Wsubq + (size_t)(grp * 128 + n0 + nl) * 1024 + 2 * kp;
#pragma unroll
        for (int q = 0; q < 16; ++q) {
            const int q0 = (int)rintf(v0[q] * inv), q1 = (int)rintf(v1[q] * inv);
            *(unsigned short*)(orow + 64 * q) = (unsigned short)((q0 & 255) | ((q1 & 255) << 8));
        }
        if (kp == 0) p.wsc[grp * 128 + n0 + nl] = am > 0.f ? am * (1.f / 127.f) : 1.f;
    }
    __syncthreads();
}

DEVI void prep_x_token(const Params& p, const float* Wg_s, int t, const float4 (&v)[4], int lane) {
    float ss = 0.f, g8[8];
#pragma unroll
    for (int g = 0; g < 8; ++g) g8[g] = 0.f;
#pragma unroll
    for (int j = 0; j < 4; ++j) {
        ss += v[j].x * v[j].x + v[j].y * v[j].y + v[j].z * v[j].z + v[j].w * v[j].w;
#pragma unroll
        for (int g = 0; g < 8; ++g) {
            const float4 w = *(const float4*)(Wg_s + g * 1024 + (lane + 64 * j) * 4);
            g8[g] += v[j].x * w.x + v[j].y * w.y + v[j].z * w.z + v[j].w * w.w;
        }
    }
    ss = wave_sum(ss);
    const bool b5 = lane & 32, b4 = lane & 16, b3 = lane & 8;
    float q4[4], q2[2], q1;
#pragma unroll
    for (int j = 0; j < 4; ++j) { const float snd = b5 ? g8[j] : g8[j + 4], kp = b5 ? g8[j + 4] : g8[j]; q4[j] = kp + __shfl_xor(snd, 32); }
#pragma unroll
    for (int j = 0; j < 2; ++j) { const float snd = b4 ? q4[j] : q4[j + 2], kp = b4 ? q4[j + 2] : q4[j]; q2[j] = kp + __shfl_xor(snd, 16); }
    { const float snd = b3 ? q2[0] : q2[1], kp = b3 ? q2[1] : q2[0]; q1 = kp + __shfl_xor(snd, 8); }
    q1 += __shfl_xor(q1, 4);
    q1 += __shfl_xor(q1, 2);
    q1 += __shfl_xor(q1, 1);
    const float rs = rsqrtf(ss * (1.f / 1024.f) + EPSN);
    uint2* o = (uint2*)(p.xb + (size_t)t * 1024);
#pragma unroll
    for (int j = 0; j < 4; ++j) o[lane + 64 * j] = make_uint2(pk2(v[j].x, v[j].y), pk2(v[j].z, v[j].w));
    if (lane == 0) p.rs1[t] = rs;
    if ((lane & 7) == 0) {
        const int gi = (b5 ? 4 : 0) + (b4 ? 2 : 0) + (b3 ? 1 : 0);
        if (gi < 4) p.ipre[t * 4 + gi] = q1 * rs + p.m_b_i[gi];
        else {
            const float z = q1 * rs + p.m_b_f[gi - 4];
            p.logf[t * 4 + gi - 4] = fminf(z, 0.f) - log1pf(fexp_(-fabsf(z)));
        }
    }
}
DEVI void st_prep_x(const Params& p, char* smem) {
    float* Wg_s = (float*)smem;
    for (int i = stid(); i < 8192; i += NTHR) {
        const int k = i >> 3, g = i & 7;
        Wg_s[g * 1024 + k] = p.norm1_g[k] * p.w_in[(size_t)k * DIN + NPJ + g];
    }
    __syncthreads();
    const int lane = stid() & 63, wid = stid() >> 6;
    for (int t = (blockIdx.x * NW + wid) * 4; t < T_TOK; t += gridDim.x * NW * 4) {
        float4 v[4][4];
        const float4* xa = (const float4*)(p.x + (size_t)t * 1024);
#pragma unroll
        for (int q = 0; q < 4; ++q)
#pragma unroll
            for (int j = 0; j < 4; ++j) v[q][j] = xa[256 * q + lane + 64 * j];
#pragma unroll
        for (int q = 0; q < 4; ++q) prep_x_token(p, Wg_s, t + q, v[q], lane);
    }
    __syncthreads();
}

namespace pg8 {
#define PG8_LAS __attribute__((address_space(3)))
typedef unsigned short bf16_t;
typedef short bf16x8 __attribute__((ext_vector_type(8)));
typedef float f32x4 __attribute__((ext_vector_type(4)));
typedef unsigned u32x4 __attribute__((ext_vector_type(4)));
constexpr int BM = 256, BK = 64, HALF = 128, HTB = HALF * BK * 2  , STAGE_BYTES = 8 * HTB, NXCD = 8, WGM = 8;

__host__ __device__ __forceinline__ int lds_byte(int r, int c) { const int st = (r >> 4) * 2 + (c >> 5), rr = r & 15, cc = c & 31, ob = rr * 64 + cc * 2; return st * 1024 + (ob ^ (((ob >> 9) & 1) << 5)); }
__host__ __device__ __forceinline__ void stage_rc(int b, int& R, int& C) { const int st = b / 1024, sb = b % 1024, swz = sb ^ (((sb >> 9) & 1) << 5); R = (st >> 1) * 16 + swz / 64; C = (st & 1) * 32 + (swz % 64) / 2; }
__host__ __device__ __forceinline__ int perm32(int rho) { const int n = rho >> 4, i = rho & 15; return 8 * (i >> 2) + 4 * n + (i & 3); }

struct Unit { int pm, pn; };
struct Gemm { const bf16_t* A; const bf16_t* Bt; int M, N, K; };

struct StaticOrder {
    int nM, nN, nwg, G, c;
    __host__ __device__ void init(int M, int N, int G_, int c_) { nM = M / BM; nN = N / BM; nwg = nM * nN; G = G_; c = c_; }
    __host__ __device__ bool next(int i, Unit& u) const {
        const long L = (long)i * G + c; if (L >= nwg) return false;
        int wgid = (int)L; { const int q = nwg / NXCD, r = nwg % NXCD, xcd = wgid % NXCD, off = wgid / NXCD; wgid = (xcd < r ? xcd * (q + 1) : r * (q + 1) + (xcd - r) * q) + off; }
        const int nig = WGM * nN, gid = wgid / nig, fm = gid * WGM, gsz = (nM - fm) < WGM ? (nM - fm) : WGM;
        u.pm = fm + ((wgid % nig) % gsz); u.pn = (wgid % nig) / gsz; return true;
    }
    __device__ __forceinline__ void a_ready(const Unit&) const {}
    __device__ __forceinline__ void done(const Unit&) const {}
};

__device__ __forceinline__ unsigned cvt_pk_bf16(float lo, float hi) { unsigned r; asm volatile("v_cvt_pk_bf16_f32 %0, %1, %2" : "=v"(r) : "v"(lo), "v"(hi)); return r; }

template <class Epi, class Sched, bool ALIGN_EPI = false, bool SP2 = false>
__device__ __forceinline__ void gemm_phase(PG8_LAS unsigned char* lds, const Gemm g, const Sched& S, const Epi& E) {
    const int tid = stid(), wid = __builtin_amdgcn_readfirstlane(tid >> 6), lane = tid & 63, wr = wid >> 2, wc = wid & 3, fr = lane & 15, fq = lane >> 4;
    const int K = g.K, nt = K / BK;
    unsigned voffA[2], voffB[2];
#pragma unroll
    for (int i = 0; i < 2; ++i) { int R, C; stage_rc(tid * 16 + i * 8192, R, C); const int Rb = Epi::PERM ? ((R & ~31) + perm32(R & 31)) : R;
        voffA[i] = (unsigned)(R * K + C) * 2u; voffB[i] = (unsigned)(Rb * K + C) * 2u; }
    const size_t kstep = (size_t)(BK * 2);
    const size_t hstep = (size_t)HALF * K * 2;
    const size_t tstep = 2 * hstep;
    const unsigned ldsw = (unsigned)wid * 1024u;
    const int aoff = lds_byte(wr * 64 + fr, fq * 8), boff = lds_byte(wc * 32 + fr, fq * 8);
#define PG8_SA(b, h) (((b) * 2 + (h)) * HTB)
#define PG8_SB(b, h) ((4 + (b) * 2 + (h)) * HTB)
#define PG8_STAGE(bufoff, gbase, voff) do { _Pragma("unroll") for (int _i = 0; _i < 2; ++_i) \
        __builtin_amdgcn_global_load_lds((const unsigned*)((const char*)(gbase) + (voff)[_i]), (PG8_LAS unsigned*)(lds + (bufoff) + ldsw + _i * 8192), 16, 0, 0); } while (0)
#define PG8_LDA(dst, b, h) do { _Pragma("unroll") for (int m = 0; m < 4; ++m) _Pragma("unroll") for (int k = 0; k < 2; ++k) dst[m][k] = *(const PG8_LAS bf16x8*)(lds + PG8_SA(b, h) + aoff + m * 2048 + k * 1024); } while (0)
#define PG8_LDB(dst, b, h) do { _Pragma("unroll") for (int n = 0; n < 2; ++n) _Pragma("unroll") for (int k = 0; k < 2; ++k) dst[n][k] = *(const PG8_LAS bf16x8*)(lds + PG8_SB(b, h) + boff + n * 2048 + k * 1024); } while (0)
#define PG8_MMA(ai, bj, At, Bt) do { __builtin_amdgcn_s_setprio(1); _Pragma("unroll") for (int m = 0; m < 4; ++m) _Pragma("unroll") for (int n = 0; n < 2; ++n) _Pragma("unroll") for (int k = 0; k < 2; ++k) \
        acc[ai][bj][m][n] = __builtin_amdgcn_mfma_f32_16x16x32_bf16(Bt[n][k], At[m][k], acc[ai][bj][m][n], 0, 0, 0); __builtin_amdgcn_s_setprio(0); } while (0)
#define PG8_WAIT_V(n) asm volatile("s_waitcnt vmcnt(" #n ")" ::: "memory")
#define PG8_WAIT_L(n) asm volatile("s_waitcnt lgkmcnt(" #n ")" ::: "memory")
#define PG8_BAR __builtin_amdgcn_s_barrier()
#define PG8_SCHED __builtin_amdgcn_sched_barrier(0)
    Unit cur, nxt; int ui = 0;
    if (!S.next(0, cur)) return;
    f32x4 acc[2][2][4][2];
#pragma unroll
    for (int a = 0; a < 2; ++a)
#pragma unroll
        for (int b = 0; b < 2; ++b)
#pragma unroll
            for (int m = 0; m < 4; ++m)
#pragma unroll
                for (int n = 0; n < 2; ++n) acc[a][b][m][n] = (f32x4){0.f, 0.f, 0.f, 0.f};
    bf16x8 At[4][2], B0[2][2], B1[2][2];
    const char* cA = (const char*)g.A + (size_t)cur.pm * tstep; const char* cB = (const char*)g.Bt + (size_t)cur.pn * tstep;
    S.a_ready(cur);
    if constexpr (SP2) {
        PG8_STAGE(PG8_SB(0, 0), cB, voffB); PG8_STAGE(PG8_SB(0, 1), cB + hstep, voffB); PG8_STAGE(PG8_SA(0, 0), cA, voffA); PG8_STAGE(PG8_SA(0, 1), cA + hstep, voffA);
        if (wr == 1) PG8_BAR;
        PG8_WAIT_V(2); PG8_BAR;
        PG8_STAGE(PG8_SB(1, 0), cB + kstep, voffB); PG8_STAGE(PG8_SA(1, 0), cA + kstep, voffA); PG8_STAGE(PG8_SB(1, 1), cB + hstep + kstep, voffB);
        PG8_WAIT_V(6); PG8_BAR;
    } else {
        PG8_STAGE(PG8_SB(0, 0), cB, voffB); PG8_STAGE(PG8_SA(0, 0), cA, voffA); PG8_STAGE(PG8_SB(0, 1), cB + hstep, voffB); PG8_STAGE(PG8_SA(0, 1), cA + hstep, voffA);
        if (wr == 1) PG8_BAR;
        PG8_WAIT_V(4); PG8_BAR;
        PG8_STAGE(PG8_SB(1, 0), cB + kstep, voffB); PG8_STAGE(PG8_SA(1, 0), cA + kstep, voffA); PG8_STAGE(PG8_SB(1, 1), cB + hstep + kstep, voffB);
        PG8_WAIT_V(6); PG8_BAR;
    }
    for (;;) {
        const bool has_next = S.next(ui + 1, nxt);
        const char* nA = has_next ? (const char*)g.A + (size_t)nxt.pm * tstep : cA; const char* nB = has_next ? (const char*)g.Bt + (size_t)nxt.pn * tstep : cB;
        for (int t = 0; t < nt; t += 2) {
            const bool last = (t == nt - 2);
            const char* a1 = cA + (size_t)(t + 1) * kstep;
            const char* a2 = last ? nA : cA + (size_t)(t + 2) * kstep; const char* b2 = last ? nB : cB + (size_t)(t + 2) * kstep;
            const char* a3 = a2 + kstep; const char* b3 = b2 + kstep;
            if (last && has_next) S.a_ready(nxt);
            if constexpr (SP2) {
            PG8_LDB(B0, 0, 0); PG8_LDB(B1, 0, 1); PG8_SCHED; PG8_LDA(At, 0, 0); PG8_STAGE(PG8_SA(1, 1), a1 + hstep, voffA);
            PG8_WAIT_V(8); PG8_WAIT_L(0); PG8_BAR; PG8_MMA(0, 0, At, B0); PG8_MMA(0, 1, At, B1); PG8_BAR; PG8_SCHED;
            PG8_LDA(At, 0, 1); PG8_STAGE(PG8_SB(0, 0), b2, voffB); PG8_STAGE(PG8_SB(0, 1), b2 + hstep, voffB); PG8_STAGE(PG8_SA(0, 0), a2, voffA);
            PG8_WAIT_V(8); PG8_WAIT_L(0); PG8_BAR; PG8_MMA(1, 0, At, B0); PG8_MMA(1, 1, At, B1); PG8_BAR; PG8_SCHED;
            PG8_LDB(B0, 1, 0); PG8_LDB(B1, 1, 1); PG8_SCHED; PG8_LDA(At, 1, 0); PG8_STAGE(PG8_SA(0, 1), a2 + hstep, voffA);
            PG8_WAIT_V(8); PG8_WAIT_L(0); PG8_BAR; PG8_MMA(0, 0, At, B0); PG8_MMA(0, 1, At, B1); PG8_BAR; PG8_SCHED;
            PG8_LDA(At, 1, 1); PG8_STAGE(PG8_SB(1, 0), b3, voffB); PG8_STAGE(PG8_SB(1, 1), b3 + hstep, voffB); PG8_STAGE(PG8_SA(1, 0), a3, voffA);
            PG8_WAIT_V(8); PG8_WAIT_L(0); PG8_BAR; PG8_MMA(1, 0, At, B0); PG8_MMA(1, 1, At, B1); PG8_BAR; PG8_SCHED;
            } else {
            PG8_LDB(B0, 0, 0); PG8_SCHED; PG8_LDA(At, 0, 0); PG8_STAGE(PG8_SA(1, 1), a1 + hstep, voffA);
            PG8_WAIT_L(8); PG8_BAR; PG8_WAIT_L(0); PG8_MMA(0, 0, At, B0); PG8_BAR; PG8_SCHED;
            PG8_LDB(B1, 0, 1); PG8_STAGE(PG8_SB(0, 0), b2, voffB);
            PG8_BAR; PG8_WAIT_L(0); PG8_MMA(0, 1, At, B1); PG8_BAR;
            PG8_LDA(At, 0, 1); PG8_STAGE(PG8_SA(0, 0), a2, voffA);
            PG8_BAR; PG8_WAIT_L(0); PG8_MMA(1, 0, At, B0); PG8_BAR; PG8_SCHED;
            PG8_STAGE(PG8_SB(0, 1), b2 + hstep, voffB);
            PG8_WAIT_V(6); PG8_BAR; PG8_MMA(1, 1, At, B1); PG8_BAR;
            PG8_LDB(B0, 1, 0); PG8_SCHED; PG8_LDA(At, 1, 0); PG8_STAGE(PG8_SA(0, 1), a2 + hstep, voffA);
            PG8_WAIT_L(8); PG8_BAR; PG8_WAIT_L(0); PG8_MMA(0, 0, At, B0); PG8_BAR; PG8_SCHED;
            PG8_LDB(B1, 1, 1); PG8_STAGE(PG8_SB(1, 0), b3, voffB);
            PG8_BAR; PG8_WAIT_L(0); PG8_MMA(0, 1, At, B1); PG8_BAR;
            PG8_LDA(At, 1, 1); PG8_STAGE(PG8_SA(1, 0), a3, voffA);
            PG8_BAR; PG8_WAIT_L(0); PG8_MMA(1, 0, At, B0); PG8_BAR; PG8_SCHED;
            PG8_STAGE(PG8_SB(1, 1), b3 + hstep, voffB);
            PG8_WAIT_V(6); PG8_BAR; PG8_MMA(1, 1, At, B1); PG8_BAR;
            }
        }
        if constexpr (ALIGN_EPI) { if (wr == 0) PG8_BAR; }
        if constexpr (!Epi::AFTER_DRAIN) { E(acc, cur, wr, wc, fr, fq); S.done(cur); }
        if (!has_next) break;
#pragma unroll
        for (int a = 0; a < 2; ++a)
#pragma unroll
            for (int b = 0; b < 2; ++b)
#pragma unroll
                for (int m = 0; m < 4; ++m)
#pragma unroll
                    for (int n = 0; n < 2; ++n) acc[a][b][m][n] = (f32x4){0.f, 0.f, 0.f, 0.f};
        cur = nxt; cA = nA; cB = nB; ++ui;
        if constexpr (ALIGN_EPI) { if (wr == 1) PG8_BAR; }
    }
    PG8_WAIT_V(0);
    if constexpr (!ALIGN_EPI) { if (wr == 0) PG8_BAR; }
    PG8_BAR;
    if constexpr (Epi::AFTER_DRAIN) { E.fused(acc, cur, wr, wc, fr, fq, lds, wid, lane); S.done(cur); }
#undef PG8_SA
#undef PG8_SB
#undef PG8_STAGE
#undef PG8_LDA
#undef PG8_LDB
#undef PG8_MMA
#undef PG8_WAIT_V
#undef PG8_WAIT_L
#undef PG8_BAR
#undef PG8_SCHED
}
}

#ifndef PG8_SP2
#define PG8_SP2 true
#endif
#ifndef PG8_ALIGN
#define PG8_ALIGN true
#endif
struct EpiProj8 {
    static constexpr bool PERM = true, AFTER_DRAIN = false;
    bf16_t* O; const float* rs; const float* rcos; const float* rsin;
    __device__ __forceinline__ void operator()(const pg8::f32x4 (&acc)[2][2][4][2], const pg8::Unit& u, int wr, int wc, int fr, int fq) const {
        const int row0 = u.pm * 256 + wr * 64 + fr, col0 = u.pn * 256 + wc * 32 + 8 * fq;
        const bool rot = u.pn < 4;
        const float ksc = u.pn >= 2 ? 0.08838834764831845f : 1.f;
#pragma unroll
        for (int ai = 0; ai < 2; ++ai)
#pragma unroll
            for (int m = 0; m < 4; ++m) {
                const int row = row0 + ai * 128 + m * 16;
                const float s = rs[row];
                const int seg = u.pn >> 1;
                const bool blocked = (seg < 3) || (seg == 5);
                bf16_t* rowp;
                int bjs;
                if (blocked) {
                    rowp = O + (size_t)(seg == 5 ? 3 : seg) * OPB + blk_off(row >> 4, (u.pn & 1) * 2) + (wc * 4 + fq) * 128 + fr * 8;
                    bjs = 4 * 2048;
                } else {
                    rowp = O + 4 * OPB + (size_t)row * NPR + (seg == 3 ? 0 : seg == 4 ? 512 : 1024) + (u.pn & 1) * 256 + wc * 32 + 8 * fq;
                    bjs = 128;
                }
                float4 cs = make_float4(1.f, 1.f, 1.f, 1.f), sn = make_float4(0.f, 0.f, 0.f, 0.f);
                float s2 = s;
                if (rot) {
                    const int ti = (row & 2047) * 64 + 16 * wc + 4 * fq;
                    cs = *(const float4*)(rcos + ti);
                    sn = *(const float4*)(rsin + ti);
                    s2 = s * ksc;
                }
#pragma unroll
                for (int bj = 0; bj < 2; ++bj) {
                    const pg8::f32x4 v0 = acc[ai][bj][m][0] * s2, v1 = acc[ai][bj][m][1] * s2;
                    *(uint4*)(rowp + bj * bjs) = make_uint4(pk2(v0[0] * cs.x - v0[1] * sn.x, v0[0] * sn.x + v0[1] * cs.x), pk2(v0[2] * cs.y - v0[3] * sn.y, v0[2] * sn.y + v0[3] * cs.y),
                                                            pk2(v1[0] * cs.z - v1[1] * sn.z, v1[0] * sn.z + v1[1] * cs.z), pk2(v1[2] * cs.w - v1[3] * sn.w, v1[2] * sn.w + v1[3] * cs.w));
                }
            }
    }
};
struct EpiX18 {
    static constexpr bool PERM = true, AFTER_DRAIN = false;
    const float* x; bf16_t* x1b; unsigned char* zq; unsigned char* zq4; float* rs2p; const float* g2;
    __device__ __forceinline__ void operator()(const pg8::f32x4 (&acc)[2][2][4][2], const pg8::Unit& u, int wr, int wc, int fr, int fq) const {
        const int row0 = u.pm * 256 + wr * 64 + fr, col0 = u.pn * 256 + wc * 32 + 8 * fq;
        float gq[2][8];
#pragma unroll
        for (int bj = 0; bj < 2; ++bj) {
            const float4 a = *(const float4*)(g2 + col0 + bj * 128), b = *(const float4*)(g2 + col0 + bj * 128 + 4);
            gq[bj][0] = a.x; gq[bj][1] = a.y; gq[bj][2] = a.z; gq[bj][3] = a.w; gq[bj][4] = b.x; gq[bj][5] = b.y; gq[bj][6] = b.z; gq[bj][7] = b.w;
        }
        float ssq[8];
#pragma unroll
        for (int ai = 0; ai < 2; ++ai)
#pragma unroll
            for (int m = 0; m < 4; ++m) {
                const size_t ro = (size_t)(row0 + ai * 128 + m * 16) * 1024 + col0;
                float s = 0.f;
#pragma unroll
                for (int bj = 0; bj < 2; ++bj) {
                    const float4 xa = *(const float4*)(x + ro + bj * 128), xb_ = *(const float4*)(x + ro + bj * 128 + 4);
                    const pg8::f32x4 v0 = acc[ai][bj][m][0], v1 = acc[ai][bj][m][1];
                    const float y[8] = {xa.x + v0[0], xa.y + v0[1], xa.z + v0[2], xa.w + v0[3], xb_.x + v1[0], xb_.y + v1[1], xb_.z + v1[2], xb_.w + v1[3]};
                    *(uint4*)(x1b + ro + bj * 128) = make_uint4(pk2(y[0], y[1]), pk2(y[2], y[3]), pk2(y[4], y[5]), pk2(y[6], y[7]));
                    unsigned w2[2] = {0u, 0u}, dh = 0u, dl = 0u;
#pragma unroll
                    for (int e = 0; e < 8; ++e) {
                        s += y[e] * y[e];
                        const float z = fminf(fmaxf(y[e] * gq[bj][e] * (1.f / ZQ_SCALE), -127.f), 127.f);
                        const int zi = (int)rintf(z);
                        w2[e >> 2] |= ((unsigned)(zi & 255)) << (8 * (e & 3));
                        const int zc = zi > 119 ? 119 : zi, hn = (zc + 8) >> 4, ln = zc - 16 * hn, pos = e < 4 ? 8 * e : 8 * (e - 4) + 4;
                        dh |= ((unsigned)(hn & 15)) << pos;
                        dl |= ((unsigned)(ln & 15)) << pos;
                    }
                    *(uint2*)(zq + ro + bj * 128) = make_uint2(w2[0], w2[1]);
                    *(uint2*)(zq4 + ro + bj * 128) = make_uint2(dh, dl);
                }
                ssq[ai * 4 + m] = s;
            }
        float q4[4], q2[2];
#pragma unroll
        for (int j = 0; j < 4; ++j) {
            const auto r = __builtin_amdgcn_permlane32_swap(__float_as_uint(ssq[j]), __float_as_uint(ssq[j + 4]), false, false);
            q4[j] = __uint_as_float(r[0]) + __uint_as_float(r[1]);
        }
#pragma unroll
        for (int j = 0; j < 2; ++j) {
            const auto r = __builtin_amdgcn_permlane16_swap(__float_as_uint(q4[j]), __float_as_uint(q4[j + 2]), false, false);
            q2[j] = __uint_as_float(r[0]) + __uint_as_float(r[1]);
        }
#pragma unroll
        for (int j = 0; j < 2; ++j) {
            const int r8 = ((fq >> 1) & 1) * 4 + (fq & 1) * 2 + j;
            rs2p[(size_t)(row0 + (r8 >> 2) * 128 + (r8 & 3) * 16) * 16 + u.pn * 4 + wc] = q2[j];
        }
    }
};
template <class Epi, bool ALIGN>
DEVI void st_gemm8(const bf16_t* A, const bf16_t* Bt, int N, int K, char* smem, const Epi& epi) {
    pg8::Gemm g{A, Bt, T_TOK, N, K};
    pg8::StaticOrder S;
    S.init(T_TOK, N, (int)gridDim.x, (int)blockIdx.x);
    pg8::gemm_phase<Epi, pg8::StaticOrder, ALIGN, PG8_SP2>((PG8_LAS unsigned char*)smem, g, S, epi);
}

DEVI void st_conv_qk(const Params& p, char* smem) {
    char* cs = smem;
    char* wqs = smem + 128 * 272;
    char* wks = smem + 2 * 128 * 272;
    const int tid = stid(), lane = tid & 63, wid = tid >> 6, wr = wid >> 1, wc = wid & 1, fr = lane & 15, fq = lane >> 4;
    const int r = tid >> 4, cg = tid & 15;
    int hcur = -1;
    float cw[4][8], cb[8];
    for (int it = blockIdx.x; it < 256 * 4; it += gridDim.x) {
        const int h = it & 3, t0 = (it >> 2) * 128, s0 = t0 & 2047;
        if (h != hcur) {
            __syncthreads();
#pragma unroll
            for (int i = 0; i < 4; ++i) {
                const int id = tid + 512 * i, rr = id >> 4, c = id & 15;
                *(uint4*)(wqs + rr * 272 + c * 16) = *(const uint4*)(p.Wqt + h * 16384 + rr * 128 + c * 8);
                *(uint4*)(wks + rr * 272 + c * 16) = *(const uint4*)(p.Wkt + h * 16384 + rr * 128 + c * 8);
            }
#pragma unroll
            for (int j = 0; j < 4; ++j) {
                const float4 a = *(const float4*)(p.m_conv_w + j * 512 + h * 128 + 8 * cg), b = *(const float4*)(p.m_conv_w + j * 512 + h * 128 + 8 * cg + 4);
                cw[j][0] = a.x; cw[j][1] = a.y; cw[j][2] = a.z; cw[j][3] = a.w; cw[j][4] = b.x; cw[j][5] = b.y; cw[j][6] = b.z; cw[j][7] = b.w;
            }
            { const float4 a = *(const float4*)(p.m_conv_b + h * 128 + 8 * cg), b = *(const float4*)(p.m_conv_b + h * 128 + 8 * cg + 4);
              cb[0] = a.x; cb[1] = a.y; cb[2] = a.z; cb[3] = a.w; cb[4] = b.x; cb[5] = b.y; cb[6] = b.z; cb[7] = b.w; }
            hcur = h;
        }
        const bf16_t* xcol = p.proj + 4 * OPB + (size_t)t0 * NPR + 512 + h * 128 + 8 * cg;
#pragma unroll
        for (int ps = 0; ps < 4; ++ps) {
            const int row = 32 * ps + r;
            uint4 xv[4];
#pragma unroll
            for (int j = 0; j < 4; ++j) {
                const int rj = row - 3 + j;
                xv[j] = (s0 + rj >= 0) ? *(const uint4*)(xcol + (long)rj * NPR) : make_uint4(0u, 0u, 0u, 0u);
            }
            float y[8];
#pragma unroll
            for (int e = 0; e < 8; ++e) y[e] = cb[e];
#pragma unroll
            for (int j = 0; j < 4; ++j) {
                const unsigned w4[4] = {xv[j].x, xv[j].y, xv[j].z, xv[j].w};
#pragma unroll
                for (int e = 0; e < 4; ++e) { y[2 * e] += cw[j][2 * e] * bflo(w4[e]); y[2 * e + 1] += cw[j][2 * e + 1] * bfhi(w4[e]); }
            }
            unsigned o[4];
#pragma unroll
            for (int e = 0; e < 4; ++e) o[e] = pk2(y[2 * e] * sigmoidf_(y[2 * e]), y[2 * e + 1] * sigmoidf_(y[2 * e + 1]));
            const uint4 ov = make_uint4(o[0], o[1], o[2], o[3]);
            *(uint4*)(cs + row * 272 + cg * 16) = ov;
            *(uint4*)(p.cbuf + (size_t)(t0 + row) * 512 + h * 128 + 8 * cg) = ov;
        }
        __syncthreads();
#pragma unroll
        for (int which = 0; which < 2; ++which) {
            const char* ws = which ? wks : wqs;
            bf16_t* O = which ? p.mk : p.mq;
            f32x4 acc[2][4];
#pragma unroll
            for (int i = 0; i < 2; ++i)
#pragma unroll
                for (int j = 0; j < 4; ++j) acc[i][j] = (f32x4){0.f, 0.f, 0.f, 0.f};
#pragma unroll
            for (int ks = 0; ks < 4; ++ks) {
                bf16x8 a[2], b[4];
#pragma unroll
                for (int i = 0; i < 2; ++i) a[i] = ld8(cs + (wr * 32 + i * 16 + fr) * 272 + (ks * 4 + fq) * 16);
#pragma unroll
                for (int j = 0; j < 4; ++j) b[j] = ld8(ws + (wc * 64 + j * 16 + fr) * 272 + (ks * 4 + fq) * 16);
#pragma unroll
                for (int i = 0; i < 2; ++i)
#pragma unroll
                    for (int j = 0; j < 4; ++j) acc[i][j] = mfma16(b[j], a[i], acc[i][j]);
            }
#pragma unroll
            for (int i = 0; i < 2; ++i)
#pragma unroll
                for (int j = 0; j < 4; ++j) {
                    const f32x4 v = acc[i][j];
                    *(uint2*)(O + blk_off((t0 >> 4) + wr * 2 + i, h) + (wc * 8 + j * 2 + (fq >> 1)) * 128 + fr * 8 + (fq & 1) * 4) = make_uint2(pk2(v[0], v[1]), pk2(v[2], v[3]));
                }
        }
        __syncthreads();
    }
}

DEVI bf16x8 u4_to_frag(uint4 u) { union { uint4 u; bf16x8 v; } x; x.u = u; return x.v; }
DEVI void sel_frags(bf16x8 (&sel)[2], int fr, int fq) {
#pragma unroll
    for (int hh = 0; hh < 2; ++hh) {
        const int jstar = fr + 16 * hh - 8 * fq;
        bf16x8 s;
#pragma unroll
        for (int j = 0; j < 8; ++j) s[j] = (j == jstar) ? (short)0x3F80 : (short)0;
        sel[hh] = s;
    }
}
DEVI void tr_store(char* XT, bf16x8 frag, const bf16x8 (&sel)[2], int mi, int ks, int fr, int fq, const float (&sc)[4]) {
#pragma unroll
    for (int hh = 0; hh < 2; ++hh) {
        const f32x4 d = mfma16(frag, sel[hh], (f32x4){0.f, 0.f, 0.f, 0.f});
        *(uint2*)(XT + (32 * ks + 16 * hh + fr) * 144 + (16 * mi + 4 * fq) * 2) = make_uint2(pk2(d[0] * sc[0], d[1] * sc[1]), pk2(d[2] * sc[2], d[3] * sc[3]));
    }
}
DEVI bf16x8 state_pack(const f32x4& a, const f32x4& b) {
    return mk8(make_uint2(pk2(a[0], a[1]), pk2(a[2], a[3])), make_uint2(pk2(b[0], b[1]), pk2(b[2], b[3])));
}
DEVI const float* opaque_ptr(const float* q) { asm volatile("" : "+v"(q)); return q; }
DEVI float opaque_f(float v) { asm volatile("" : "+v"(v)); return v; }
DEVI void lds_barrier() { asm volatile("s_waitcnt lgkmcnt(0)" ::: "memory"); __builtin_amdgcn_s_barrier(); asm volatile("" ::: "memory"); }
DEVI void pin_u4(uint4& a) { asm volatile("" : "+v"(a.x), "+v"(a.y), "+v"(a.z), "+v"(a.w)); }
DEVI float grp8_sum(float v) { v += dpp_f<DPP_XOR1>(v); v += dpp_f<DPP_XOR2>(v); v += dpp_f<DPP_HMIRROR>(v); return v; }

#define ASM_LD16(dst, voff, sbase, imm) asm volatile("global_load_dwordx4 %0, %1, %2 offset:" #imm : "=v"(dst) : "v"(voff), "s"(sbase) : "memory")
#define ASM_LD4(dst, voff, sbase) asm volatile("global_load_dword %0, %1, %2" : "=v"(dst) : "v"(voff), "s"(sbase) : "memory")
typedef unsigned u32x4_t __attribute__((ext_vector_type(4)));
struct RetPre { u32x4_t f[4]; u32x4_t v[2]; u32x4_t g[2]; };
struct RetOff { unsigned f, v0, v1, g; };
DEVI void ret_offsets(RetOff& o, int h, int tid) {
    const int lane = tid & 63, w = tid >> 6, fr = lane & 15, fq = lane >> 4, mi = w & 3;
    o.f = (unsigned)((w < 4 ? OPB * 2 : 0) + (4 * h + mi) * 4096 + fq * 256 + fr * 16);
    o.v0 = (unsigned)(2 * OPB * 2 + (4 * h + ((2 * w) >> 2)) * 4096 + (4 * ((2 * w) & 3) + fq) * 256 + fr * 16);
    o.v1 = (unsigned)(2 * OPB * 2 + (4 * h + ((2 * w + 1) >> 2)) * 4096 + (4 * ((2 * w + 1) & 3) + fq) * 256 + fr * 16);
    o.g = (unsigned)(((tid >> 3) * NPR + h * 128 + 8 * (tid & 7)) * 2);
}
DEVI const char* ret_base(const Params& p, int b, int c) { return (const char*)p.proj + (size_t)(b * 32 + c) * 65536; }
DEVI const char* ret_gbase(const Params& p, int b, int c) { return (const char*)(p.proj + 4 * OPB) + (size_t)(b * 2048 + c * 64) * (NPR * 2); }
template <int N> DEVI void ret_retire_fv(RetPre& P) {
    asm volatile("s_waitcnt vmcnt(%6)" : "+v"(P.f[0]), "+v"(P.f[1]), "+v"(P.f[2]), "+v"(P.f[3]), "+v"(P.v[0]), "+v"(P.v[1]) : "n"(N) : "memory");
}
DEVI uint4 asu4(const u32x4_t& v) { return make_uint4(v[0], v[1], v[2], v[3]); }
DEVI void ret_block(const Params& p, char* smem, int b, int h) {
    char* qs = smem;
    char* ks_ = smem + 17408;
    char* kTs = smem + 34816;
    char* vTs = smem + 53248;
    char* Ss = smem + 71680;
    char* Os = smem + 80896;
    float* gn_s = (float*)(smem + 98304);
    const int tid = stid(), lane = tid & 63, w = tid >> 6, fr = lane & 15, fq = lane >> 4;
    const float gamma = 1.f - exp2f(-5.f - (float)h);
    const float l2g = log2f(gamma);
    const float g64 = exp2f(l2g * 64.f);
    bf16x8 sel[2];
    sel_frags(sel, fr, fq);
    f32x4 st[8];
#pragma unroll
    for (int i = 0; i < 8; ++i) st[i] = (f32x4){0.f, 0.f, 0.f, 0.f};
    if (tid < 128) gn_s[tid] = p.ret_norm_g[h * 128 + tid];
    __syncthreads();
    RetPre P;
    RetOff RO;
    ret_offsets(RO, h, tid);
    {
        const char* base = ret_base(p, b, 0);
        ASM_LD16(P.f[0], RO.f, base, 0); ASM_LD16(P.f[1], RO.f, base, 1024); ASM_LD16(P.f[2], RO.f, base, 2048); ASM_LD16(P.f[3], RO.f, base, 3072);
        ASM_LD16(P.v[0], RO.v0, base, 0); ASM_LD16(P.v[1], RO.v1, base, 0);
    }
    ret_retire_fv<0>(P);
#pragma unroll 1
    for (int c = 0; c < 32; ++c) {
        const int t0 = b * 2048 + c * 64;
        {
            const int mi = w & 3;
            char* dst = (w < 4 ? ks_ : qs) + (16 * mi + fr) * 272 + fq * 16;
#pragma unroll
            for (int ks = 0; ks < 4; ++ks) *(uint4*)(dst + ks * 64) = asu4(P.f[ks]);
            if (w < 4) {
                float kd[4];
#pragma unroll
                for (int r = 0; r < 4; ++r) kd[r] = exp2f(l2g * (float)(63 - (16 * mi + 4 * fq + r)));
#pragma unroll
                for (int ks = 0; ks < 4; ++ks) tr_store(kTs, u4_to_frag(asu4(P.f[ks])), sel, mi, ks, fr, fq, kd);
            }
            const float one[4] = {1.f, 1.f, 1.f, 1.f};
#pragma unroll
            for (int q = 0; q < 2; ++q) { const int pr = 2 * w + q; tr_store(vTs, u4_to_frag(asu4(P.v[q])), sel, pr >> 2, pr & 3, fr, fq, one); }
        }
        lds_barrier();
        const char* cbase = ret_gbase(p, b, c);
        const char* nbase = ret_base(p, b, c + 1 < 32 ? c + 1 : 31);
        ASM_LD16(P.g[0], RO.g, cbase, 0); ASM_LD16(P.g[1], RO.g, cbase, 128);
        {
            const int lt = w & 3;
            bf16x8 qf[4];
#pragma unroll
            for (int s = 0; s < 4; ++s) qf[s] = ld8(qs + (16 * lt + fr) * 272 + (s * 4 + fq) * 16);
#pragma unroll
            for (int jj = 0; jj < 2; ++jj) {
                const int j = 2 * (w >> 2) + jj;
                if (jj == 0) { ASM_LD16(P.f[0], RO.f, nbase, 0); ASM_LD16(P.f[1], RO.f, nbase, 1024); }
                else { ASM_LD16(P.f[2], RO.f, nbase, 2048); ASM_LD16(P.f[3], RO.f, nbase, 3072); }
                f32x4 a = (f32x4){0.f, 0.f, 0.f, 0.f};
#pragma unroll
                for (int s = 0; s < 4; ++s) a = mfma16(ld8(ks_ + (16 * j + fr) * 272 + (s * 4 + fq) * 16), qf[s], a);
                const int l = 16 * lt + fr, mb = 16 * j + 4 * fq;
                float v[4];
#pragma unroll
                for (int r = 0; r < 4; ++r) { const int dd = l - (mb + r); v[r] = a[r] * exp2f(l2g * (float)(dd < 0 ? -dd : dd)); }
                *(uint2*)(Ss + l * 144 + mb * 2) = make_uint2(pk2(v[0], v[1]), pk2(v[2], v[3]));
            }
        }
        lds_barrier();
        {
            bf16x8 sp[4];
#pragma unroll
            for (int s = 0; s < 4; ++s) sp[s] = state_pack(st[2 * s], st[2 * s + 1]);
            bf16x8 vf[2];
#pragma unroll
            for (int s2 = 0; s2 < 2; ++s2) vf[s2] = ld8(vTs + (16 * w + fr) * 144 + (s2 * 4 + fq) * 16);
#pragma unroll
            for (int i = 0; i < 4; ++i) {
                if (i == 0) ASM_LD16(P.v[0], RO.v0, nbase, 0);
                if (i == 1) ASM_LD16(P.v[1], RO.v1, nbase, 0);
                f32x4 a = (f32x4){0.f, 0.f, 0.f, 0.f};
                const char* qrow = qs + (16 * i + fr) * 272;
#pragma unroll
                for (int s = 0; s < 4; ++s) {
                    const uint2 lo = *(const uint2*)(qrow + (32 * s + 4 * fq) * 2), hi = *(const uint2*)(qrow + (32 * s + 16 + 4 * fq) * 2);
                    a = mfma16(sp[s], mk8(lo, hi), a);
                }
                a = a * exp2f(l2g * (float)(16 * i + fr + 1));
#pragma unroll
                for (int s2 = 0; s2 < 2; ++s2) a = mfma16(vf[s2], ld8(Ss + (16 * i + fr) * 144 + (s2 * 4 + fq) * 16), a);
                *(uint2*)(Os + (16 * i + fr) * 272 + (16 * w + 4 * fq) * 2) = make_uint2(pk2(a[0], a[1]), pk2(a[2], a[3]));
            }
#pragma unroll
            for (int i = 0; i < 8; ++i) {
                f32x4 a = st[i] * g64;
#pragma unroll
                for (int s2 = 0; s2 < 2; ++s2) a = mfma16(ld8(kTs + (16 * i + fr) * 144 + (s2 * 4 + fq) * 16), vf[s2], a);
                st[i] = a;
            }
        }
        lds_barrier();
        {
            const int l = tid >> 3, part = tid & 7;
            const uint4 o0 = *(const uint4*)(Os + l * 272 + part * 16), o1 = *(const uint4*)(Os + l * 272 + 128 + part * 16);
            const unsigned ow[8] = {o0.x, o0.y, o0.z, o0.w, o1.x, o1.y, o1.z, o1.w};
            float x[16], s = 0.f;
#pragma unroll
            for (int e = 0; e < 8; ++e) { x[2 * e] = bflo(ow[e]); x[2 * e + 1] = bfhi(ow[e]); s += x[2 * e] + x[2 * e + 1]; }
            const float mu = grp8_sum(s) * (1.f / 128.f);
            float q = 0.f;
#pragma unroll
            for (int e = 0; e < 16; ++e) { x[e] -= mu; q += x[e] * x[e]; }
            float rstd = rsqrtf(grp8_sum(q) * (1.f / 128.f) + EPSN);
            asm volatile("s_waitcnt vmcnt(6)" : "+v"(P.g[0]), "+v"(P.g[1]), "+v"(rstd) :: "memory");
            const unsigned gw[8] = {P.g[0][0], P.g[0][1], P.g[0][2], P.g[0][3], P.g[1][0], P.g[1][1], P.g[1][2], P.g[1][3]};
            const float* gn = gn_s + 8 * part;
            unsigned yo[8];
#pragma unroll
            for (int e = 0; e < 8; ++e) {
                const float ga = bflo(gw[e]), gb = bfhi(gw[e]);
                const int ci = (e < 4 ? 0 : 56) + 2 * e;
                yo[e] = pk2(ga * sigmoidf_(ga) * x[2 * e] * rstd * gn[ci], gb * sigmoidf_(gb) * x[2 * e + 1] * rstd * gn[ci + 1]);
            }
            asm volatile("" : "+v"(yo[0]), "+v"(yo[1]), "+v"(yo[2]), "+v"(yo[3]), "+v"(yo[4]), "+v"(yo[5]), "+v"(yo[6]), "+v"(yo[7]));
            ret_retire_fv<0>(P);
            uint4* yp = (uint4*)(p.yb + (size_t)(t0 + l) * 1024 + h * 128 + 8 * part);
            yp[0] = make_uint4(yo[0], yo[1], yo[2], yo[3]);
            yp[8] = make_uint4(yo[4], yo[5], yo[6], yo[7]);
        }
    }
}

struct MlPre { u32x4_t f[4]; u32x4_t v[2]; u32x4_t o[2]; u32x4_t cc[2]; };
struct MlOff { unsigned f, v0, v1, o, c, g; };
DEVI void ml_offsets(const Params& p, MlOff& o, int h, int tid) {
    const int lane = tid & 63, w = tid >> 6, fr = lane & 15, fq = lane >> 4, mi = w & 3;
    const unsigned kdiff = (unsigned)((const char*)p.mk - (const char*)p.mq);
    o.f = (unsigned)((4 * h + mi) * 4096 + fq * 256 + fr * 16) + (w < 4 ? kdiff : 0u);
    o.v0 = (unsigned)((4 * h + ((2 * w) >> 2)) * 4096 + (4 * ((2 * w) & 3) + fq) * 256 + fr * 16);
    o.v1 = (unsigned)((4 * h + ((2 * w + 1) >> 2)) * 4096 + (4 * ((2 * w + 1) & 3) + fq) * 256 + fr * 16);
    o.o = (unsigned)(((tid >> 3) * NPR + 1024 + h * 128 + 8 * (tid & 7)) * 2);
    o.c = (unsigned)(((tid >> 3) * 512 + h * 128 + 8 * (tid & 7)) * 2);
    o.g = (unsigned)((lane * 4 + h) * 4);
}
template <int N> DEVI void ml_retire_fv(MlPre& P) {
    asm volatile("s_waitcnt vmcnt(%6)" : "+v"(P.f[0]), "+v"(P.f[1]), "+v"(P.f[2]), "+v"(P.f[3]), "+v"(P.v[0]), "+v"(P.v[1]) : "n"(N) : "memory");
}
DEVI void mlstm_block(const Params& p, char* smem, int b, int h) {
    char* qs = smem;
    char* kTs = smem + 17408;
    char* vTs = smem + 35840;
    char* Os = smem + 54272;
    float* n_s = (float*)(smem + 71680);
    float* den_s = (float*)(smem + 72192);
    float* gn_s = (float*)(smem + 72448);
    float* sk_s = gn_s + 128;
    float* lw_s = sk_s + 128;
    float* ac_s = lw_s + 32 * 64;
    float* mi_s = ac_s + 32;
    const int tid = stid(), lane = tid & 63, w = tid >> 6, fr = lane & 15, fq = lane >> 4;
    bf16x8 sel[2];
    sel_frags(sel, fr, fq);
    f32x4 st[8];
#pragma unroll
    for (int i = 0; i < 8; ++i) st[i] = (f32x4){0.f, 0.f, 0.f, 0.f};
    float m_run = 0.f;
    f32x4 nacc = (f32x4){0.f, 0.f, 0.f, 0.f};
    bf16x8 ones;
#pragma unroll
    for (int j = 0; j < 8; ++j) ones[j] = (short)0x3F80;
    if (tid < 128) { gn_s[tid] = p.m_norm_g[h * 128 + tid]; sk_s[tid] = p.m_skip[h * 128 + tid]; }
#pragma unroll
    for (int q = 0; q < 4; ++q) {
        const int cc = 4 * w + q, tt = b * 2048 + cc * 64 + lane;
        const float iv = p.ipre[tt * 4 + h], fv = p.logf[tt * 4 + h];
        float fcum = fv;
#pragma unroll
        for (int o = 1; o < 64; o <<= 1) { const float tv = __shfl_up(fcum, o); if (lane >= o) fcum += tv; }
        const float a_c = __shfl(fcum, 63);
        const float logw = a_c - fcum + iv;
        const float m_in = wave_max(logw);
        lw_s[cc * 64 + lane] = logw;
        if (lane == 0) { ac_s[cc] = a_c; mi_s[cc] = m_in; }
    }
    __syncthreads();
    MlPre P;
    MlOff MO;
    ml_offsets(p, MO, h, tid);
    {
        const size_t t00 = (size_t)(b * 2048);
        const char* bq = (const char*)p.mq + t00 * 1024, *bp = (const char*)(p.proj + 3 * OPB) + t00 * 1024;
        ASM_LD16(P.f[0], MO.f, bq, 0); ASM_LD16(P.f[1], MO.f, bq, 1024); ASM_LD16(P.f[2], MO.f, bq, 2048); ASM_LD16(P.f[3], MO.f, bq, 3072);
        ASM_LD16(P.v[0], MO.v0, bp, 0); ASM_LD16(P.v[1], MO.v1, bp, 0);
    }
    ml_retire_fv<0>(P);
#pragma unroll 1
    for (int c = 0; c < 32; ++c) {
        const int t0 = b * 2048 + c * 64;
        const float a_c = ac_s[c], m_in = mi_s[c], logw = lw_s[c * 64 + lane];
        const float m_new = fmaxf(a_c + m_run, m_in);
        const float decay = fexp_(a_c + m_run - m_new);
        const float wgt = fexp_(logw - m_new);
        const float emn = fexp_(-m_new);
        m_run = m_new;
        {
            const int mi = w & 3;
            if (w < 4) {
                float kw[4];
#pragma unroll
                for (int r = 0; r < 4; ++r) kw[r] = __shfl(wgt, 16 * mi + 4 * fq + r);
#pragma unroll
                for (int ks = 0; ks < 4; ++ks) tr_store(kTs, u4_to_frag(asu4(P.f[ks])), sel, mi, ks, fr, fq, kw);
            } else {
                char* dst = qs + (16 * mi + fr) * 272 + fq * 16;
#pragma unroll
                for (int ks = 0; ks < 4; ++ks) *(uint4*)(dst + ks * 64) = asu4(P.f[ks]);
            }
            const float one[4] = {1.f, 1.f, 1.f, 1.f};
#pragma unroll
            for (int q = 0; q < 2; ++q) { const int pr = 2 * w + q; tr_store(vTs, u4_to_frag(asu4(P.v[q])), sel, pr >> 2, pr & 3, fr, fq, one); }
        }
        lds_barrier();
        const size_t tc = (size_t)t0, tn = (size_t)(b * 2048 + (c + 1 < 32 ? c + 1 : 31) * 64);
        const char* cbp = (const char*)(p.proj + 4 * OPB) + tc * (NPR * 2), *cbc = (const char*)p.cbuf + tc * 1024;
        const char* nbq = (const char*)p.mq + tn * 1024, *nbp = (const char*)(p.proj + 3 * OPB) + tn * 1024;
        ASM_LD16(P.o[0], MO.o, cbp, 0); ASM_LD16(P.o[1], MO.o, cbp, 128);
        {
            f32x4 a = nacc * decay;
#pragma unroll
            for (int s2 = 0; s2 < 2; ++s2) a = mfma16(ld8(kTs + (16 * w + fr) * 144 + (s2 * 4 + fq) * 16), ones, a);
            nacc = a;
            if (fr == 0) *(f32x4*)(n_s + 16 * w + 4 * fq) = a;
        }
        {
            bf16x8 vf[2];
#pragma unroll
            for (int s2 = 0; s2 < 2; ++s2) vf[s2] = ld8(vTs + (16 * w + fr) * 144 + (s2 * 4 + fq) * 16);
#pragma unroll
            for (int i = 0; i < 8; ++i) {
                if (i == 0) ASM_LD16(P.cc[0], MO.c, cbc, 0);
                if (i == 1) ASM_LD16(P.cc[1], MO.c, cbc, 128);
                if (i == 2) ASM_LD16(P.f[0], MO.f, nbq, 0);
                if (i == 3) ASM_LD16(P.f[1], MO.f, nbq, 1024);
                if (i == 4) ASM_LD16(P.f[2], MO.f, nbq, 2048);
                if (i == 5) ASM_LD16(P.f[3], MO.f, nbq, 3072);
                if (i == 6) ASM_LD16(P.v[0], MO.v0, nbp, 0);
                if (i == 7) ASM_LD16(P.v[1], MO.v1, nbp, 0);
                f32x4 a = st[i] * decay;
#pragma unroll
                for (int s2 = 0; s2 < 2; ++s2) a = mfma16(ld8(kTs + (16 * i + fr) * 144 + (s2 * 4 + fq) * 16), vf[s2], a);
                st[i] = a;
            }
        }
        lds_barrier();
        {
            const int l = tid >> 3, part = tid & 7;
            const uint4 a0 = *(const uint4*)(qs + l * 272 + part * 32), a1 = *(const uint4*)(qs + l * 272 + part * 32 + 16);
            const unsigned aw[8] = {a0.x, a0.y, a0.z, a0.w, a1.x, a1.y, a1.z, a1.w};
            const float* nn = n_s + 16 * part;
            float s = 0.f;
#pragma unroll
            for (int e = 0; e < 8; ++e) s += bflo(aw[e]) * nn[2 * e] + bfhi(aw[e]) * nn[2 * e + 1];
            s = grp8_sum(s);
            if (part == 0) den_s[l] = fmaxf(fabsf(s), emn);
        }
        lds_barrier();
        {
            bf16x8 sp[4];
#pragma unroll
            for (int s = 0; s < 4; ++s) sp[s] = state_pack(st[2 * s], st[2 * s + 1]);
#pragma unroll
            for (int i = 0; i < 4; ++i) {
                f32x4 a = (f32x4){0.f, 0.f, 0.f, 0.f};
                const char* qrow = qs + (16 * i + fr) * 272;
#pragma unroll
                for (int s = 0; s < 4; ++s) {
                    const uint2 lo = *(const uint2*)(qrow + (32 * s + 4 * fq) * 2), hi = *(const uint2*)(qrow + (32 * s + 16 + 4 * fq) * 2);
                    a = mfma16(sp[s], mk8(lo, hi), a);
                }
                const float rd = rcp_(den_s[16 * i + fr]);
                *(uint2*)(Os + (16 * i + fr) * 272 + (16 * w + 4 * fq) * 2) = make_uint2(pk2(a[0] * rd, a[1] * rd), pk2(a[2] * rd, a[3] * rd));
            }
        }
        lds_barrier();
        {
            const int l = tid >> 3, part = tid & 7;
            const uint4 o0 = *(const uint4*)(Os + l * 272 + part * 16), o1 = *(const uint4*)(Os + l * 272 + 128 + part * 16);
            const unsigned ow[8] = {o0.x, o0.y, o0.z, o0.w, o1.x, o1.y, o1.z, o1.w};
            float x[16], s = 0.f;
#pragma unroll
            for (int e = 0; e < 8; ++e) { x[2 * e] = bflo(ow[e]); x[2 * e + 1] = bfhi(ow[e]); s += x[2 * e] + x[2 * e + 1]; }
            const float mu = grp8_sum(s) * (1.f / 128.f);
            float q = 0.f;
#pragma unroll
            for (int e = 0; e < 16; ++e) { x[e] -= mu; q += x[e] * x[e]; }
            float rstd = rsqrtf(grp8_sum(q) * (1.f / 128.f) + EPSN);
            asm volatile("s_waitcnt vmcnt(6)" : "+v"(P.o[0]), "+v"(P.o[1]), "+v"(P.cc[0]), "+v"(P.cc[1]), "+v"(rstd) :: "memory");
            const unsigned gw[8] = {P.o[0][0], P.o[0][1], P.o[0][2], P.o[0][3], P.o[1][0], P.o[1][1], P.o[1][2], P.o[1][3]};
            const unsigned cw[8] = {P.cc[0][0], P.cc[0][1], P.cc[0][2], P.cc[0][3], P.cc[1][0], P.cc[1][1], P.cc[1][2], P.cc[1][3]};
            const float* gn = gn_s + 8 * part;
            const float* sk = sk_s + 8 * part;
            unsigned yo[8];
#pragma unroll
            for (int e = 0; e < 8; ++e) {
                const int ci = (e < 4 ? 0 : 56) + 2 * e;
                const float ya = sigmoidf_(bflo(gw[e])) * (x[2 * e] * rstd * gn[ci] + sk[ci] * bflo(cw[e]));
                const float yb_ = sigmoidf_(bfhi(gw[e])) * (x[2 * e + 1] * rstd * gn[ci + 1] + sk[ci + 1] * bfhi(cw[e]));
                yo[e] = pk2(ya, yb_);
            }
            asm volatile("" : "+v"(yo[0]), "+v"(yo[1]), "+v"(yo[2]), "+v"(yo[3]), "+v"(yo[4]), "+v"(yo[5]), "+v"(yo[6]), "+v"(yo[7]));
            ml_retire_fv<0>(P);
            uint4* yp = (uint4*)(p.yb + (size_t)(t0 + l) * 1024 + 512 + h * 128 + 8 * part);
            yp[0] = make_uint4(yo[0], yo[1], yo[2], yo[3]);
            yp[8] = make_uint4(yo[4], yo[5], yo[6], yo[7]);
        }
    }
}
DEVI void st_recur(const Params& p, char* smem) {
    if (blockIdx.x >= 128 || gridDim.x <= 128) {
        const int bid = gridDim.x > 128 ? (int)blockIdx.x - 128 : (int)blockIdx.x, nb = gridDim.x > 128 ? (int)gridDim.x - 128 : (int)gridDim.x;
        st_prep_w2(p, smem, bid, nb);
        st_prep_wsub(p, smem, bid, nb);
        st_prep_tables(p, bid, nb);
        if (gridDim.x > 128) return;
    }
    for (int bi = blockIdx.x; bi < 128; bi += gridDim.x) {
        const int kind = bi & 1, h = (bi >> 1) & 3, b = bi >> 3;
        if (kind == 0) ret_block(p, smem, b, h);
        else mlstm_block(p, smem, b, h);
        __syncthreads();
    }
}

constexpr float KEY_BIAS = 64.f;
DEVI int f2key(float f) { const int b = __float_as_int(f); return b ^ ((b >> 31) & 0x7fffffff); }
DEVI float key2f(int k) { return __int_as_float(k ^ ((k >> 31) & 0x7fffffff)); }
template <int N> DEVI void bsort_desc(int (&v)[N]) {
#pragma unroll
    for (int k = 2; k <= N; k <<= 1)
#pragma unroll
        for (int j = k >> 1; j > 0; j >>= 1)
#pragma unroll
            for (int i = 0; i < N; ++i) {
                const int l = i ^ j;
                if (l > i) {
                    const int a = v[i], b = v[l];
                    const int mx = a > b ? a : b, mn = a > b ? b : a;
                    if ((i & k) == 0) { v[i] = mx; v[l] = mn; } else { v[i] = mn; v[l] = mx; }
                }
            }
}
template <int N> DEVI void bmerge_desc(int (&v)[N]) {
#pragma unroll
    for (int j = N >> 1; j > 0; j >>= 1)
#pragma unroll
        for (int i = 0; i < N; ++i) {
            const int l = i ^ j;
            if (l > i) { const int a = v[i], b = v[l]; v[i] = a > b ? a : b; v[l] = a > b ? b : a; }
        }
}
DEVI void xmerge16(int (&v)[16], int mask) {
    int o[16];
#pragma unroll
    for (int i = 0; i < 16; ++i) o[i] = __shfl_xor(v[15 - i], mask);
#pragma unroll
    for (int i = 0; i < 16; ++i) v[i] = v[i] > o[i] ? v[i] : o[i];
    bmerge_desc<16>(v);
}
__device__ const unsigned char cand_tab[52] = {
    0x00, 0x01, 0x02, 0x03, 0x04, 0x05, 0x06, 0x07, 0x08, 0x09, 0x0a, 0x0b, 0x0c, 0x0d, 0x0e, 0x0f,
    0x10, 0x11, 0x12, 0x13, 0x14, 0x15, 0x16, 0x17, 0x20, 0x21, 0x22, 0x23, 0x24, 0x30, 0x31, 0x32, 0x33,
    0x40, 0x41, 0x42, 0x50, 0x51, 0x60, 0x61, 0x70, 0x71, 0x80, 0x90, 0xa0, 0xb0, 0xc0, 0xd0, 0xe0, 0xf0, 0xff, 0xff};
constexpr int H_A = 256 * 64, H_B = 256 * 64, H_STAGE = H_A + H_B;
constexpr int H_LIST = 3 * H_STAGE;
DEVI void glds16(const void* g, char* l) {
    __builtin_amdgcn_global_load_lds((const __attribute__((address_space(1))) unsigned*)g, (__attribute__((address_space(3))) unsigned*)l, 16, 0, 0);
}
DEVI void gemm3_topk_tile(const Params& p, int m0, int h, char* smem) {
    const int tid = stid(), lane = tid & 63, w = tid >> 6, wt = w >> 1, wp = w & 1, fr = lane & 15, fq = lane >> 4;
    i32x4 acc[4][8];
#pragma unroll
    for (int i = 0; i < 4; ++i)
#pragma unroll
        for (int j = 0; j < 8; ++j) acc[i][j] = (i32x4){0, 0, 0, 0};
    const int r16 = lane >> 2, csrc = (lane & 3) ^ ((r16 >> 2) & 3);
    const unsigned char* srcA = p.xq + (size_t)(m0 + w * 32 + r16) * 1024 + csrc * 16;
    const unsigned char* srcB = (const unsigned char*)p.Wsubq + ((size_t)h * 256 + w * 32 + r16) * 1024 + csrc * 16;
    char* dstA = smem + (w * 32) * 64 + lane * 16;
    char* dstB = smem + H_A + (w * 32) * 64 + lane * 16;
    auto issue = [&](int kt, int buf) {
#pragma unroll
        for (int q = 0; q < 2; ++q) glds16(srcA + (size_t)q * 16 * 1024 + kt * 64, dstA + buf * H_STAGE + q * 1024);
#pragma unroll
        for (int q = 0; q < 2; ++q) glds16(srcB + (size_t)q * 16 * 1024 + kt * 64, dstB + buf * H_STAGE + q * 1024);
    };
    const int rdoff = fr * 64 + ((fq ^ ((fr >> 2) & 3)) * 16);
    issue(0, 0);
    issue(1, 1);
    asm volatile("s_waitcnt vmcnt(4)" ::: "memory");
    __builtin_amdgcn_s_barrier();
    int buf = 0;
#pragma unroll 1
    for (int kt = 0; kt < 16; ++kt) {
        const int b2 = buf >= 1 ? buf - 1 : 2;
        if (kt + 2 < 16) issue(kt + 2, b2);
        const char* As = smem + buf * H_STAGE + (wt * 64) * 64 + rdoff;
        const char* Bs = smem + buf * H_STAGE + H_A + (wp * 128) * 64 + rdoff;
        i32x4 a[4];
#pragma unroll
        for (int i = 0; i < 4; ++i) a[i] = *(const i32x4*)(As + (16 * i) * 64);
#pragma unroll
        for (int jg = 0; jg < 2; ++jg) {
            i32x4 b[4];
#pragma unroll
            for (int j = 0; j < 4; ++j) b[j] = *(const i32x4*)(Bs + (16 * (4 * jg + j)) * 64);
#pragma unroll
            for (int i = 0; i < 4; ++i)
#pragma unroll
                for (int j = 0; j < 4; ++j) acc[i][4 * jg + j] = __builtin_amdgcn_mfma_i32_16x16x64_i8(b[j], a[i], acc[i][4 * jg + j], 0, 0, 0);
        }
        if (kt + 2 < 16) asm volatile("s_waitcnt vmcnt(4)" ::: "memory");
        else asm volatile("s_waitcnt vmcnt(0)" ::: "memory");
        __builtin_amdgcn_s_barrier();
        buf = buf == 2 ? 0 : buf + 1;
    }
    float4 ws[8];
#pragma unroll
    for (int j = 0; j < 8; ++j) ws[j] = *(const float4*)(p.wsc + h * 256 + wp * 128 + 16 * j + 4 * fq);
    int* LX = (int*)(smem + H_LIST);
#pragma unroll
    for (int i = 0; i < 4; ++i) {
        const int tl = 64 * wt + 16 * i + fr;
        const float rs = rs2_of(p.rs2p, m0 + tl) * ZQ_SCALE;
        int ka[16], kb[16];
#pragma unroll
        for (int jj = 0; jj < 4; ++jj)
#pragma unroll
            for (int r = 0; r < 4; ++r) {
                const float sa = r == 0 ? ws[jj].x : r == 1 ? ws[jj].y : r == 2 ? ws[jj].z : ws[jj].w;
                const float sb = r == 0 ? ws[4 + jj].x : r == 1 ? ws[4 + jj].y : r == 2 ? ws[4 + jj].z : ws[4 + jj].w;
                ka[jj * 4 + r] = (__float_as_int((float)acc[i][jj][r] * (sa * rs) + KEY_BIAS) & ~127) | (16 * jj + 4 * fq + r);
                kb[jj * 4 + r] = (__float_as_int((float)acc[i][4 + jj][r] * (sb * rs) + KEY_BIAS) & ~127) | (16 * (jj + 4) + 4 * fq + r);
            }
        bsort_desc<16>(ka);
        bsort_desc<16>(kb);
#pragma unroll
        for (int q = 0; q < 16; ++q) ka[q] = ka[q] > kb[15 - q] ? ka[q] : kb[15 - q];
        bmerge_desc<16>(ka);
        xmerge16(ka, 16);
        xmerge16(ka, 32);
        const int k0 = fq == 0 ? ka[0] : fq == 1 ? ka[4] : fq == 2 ? ka[8] : ka[12];
        const int k1 = fq == 0 ? ka[1] : fq == 1 ? ka[5] : fq == 2 ? ka[9] : ka[13];
        const int k2 = fq == 0 ? ka[2] : fq == 1 ? ka[6] : fq == 2 ? ka[10] : ka[14];
        const int k3 = fq == 0 ? ka[3] : fq == 1 ? ka[7] : fq == 2 ? ka[11] : ka[15];
        *(int4*)(LX + tl * 32 + wp * 16 + 4 * fq) = make_int4(k0, k1, k2, k3);
    }
    __syncthreads();
#pragma unroll
    for (int i2 = 0; i2 < 2; ++i2) {
        const int tl = 32 * w + 16 * i2 + fr, t = m0 + tl;
        const int* L = LX + tl * 32;
        const unsigned long long clo = fq == 0 ? 0x0706050403020100ull : fq == 1 ? 0x14131211100f0e0dull : fq == 2 ? 0x4033323130242322ull : 0xc0b0a09080717061ull;
        const unsigned long long chi = fq == 0 ? 0x0c0b0a0908ull : fq == 1 ? 0x2120171615ull : fq == 2 ? 0x6051504241ull : 0xfffff0e0d0ull;
        int c[16];
#pragma unroll
        for (int s = 0; s < 13; ++s) {
            const int ab = (int)((s < 8 ? (clo >> (8 * s)) : (chi >> (8 * (s - 8)))) & 0xffull);
            const int k1 = L[ab >> 4], k2 = L[16 + (ab & 15)];
            const float v = (__int_as_float(k1 & ~127) - KEY_BIAS) + (__int_as_float(k2 & ~127) - KEY_BIAS);
            c[s] = (f2key(v) & ~0x3fff) | ((k1 & 127) << 7) | (k2 & 127);
        }
        c[13] = c[14] = c[15] = (int)0x80000000;
        bsort_desc<16>(c);
        xmerge16(c, 16);
        xmerge16(c, 32);
        const float vmax = key2f(c[0] & ~0x3fff);
        float e[16], sum = 0.f;
#pragma unroll
        for (int q = 0; q < 16; ++q) { e[q] = fexp_(key2f(c[q] & ~0x3fff) - vmax); sum += e[q]; }
        const float inv = rcp_(sum);
        int ce[4]; float ge[4];
#pragma unroll
        for (int q = 0; q < 4; ++q) {
            const int cq = fq == 0 ? c[q] : fq == 1 ? c[4 + q] : fq == 2 ? c[8 + q] : c[12 + q];
            const float eq = fq == 0 ? e[q] : fq == 1 ? e[4 + q] : fq == 2 ? e[8 + q] : e[12 + q];
            ce[q] = ((cq >> 7) & 127) * 128 + (cq & 127);
            ge[q] = eq * inv;
        }
        *(uint2*)(p.eperm + (size_t)t * 128 + h * 16 + 4 * fq) = make_uint2((unsigned)ce[0] | ((unsigned)ce[1] << 16), (unsigned)ce[2] | ((unsigned)ce[3] << 16));
        *(float4*)(p.gate + (size_t)t * 128 + h * 16 + 4 * fq) = make_float4(ge[0], ge[1], ge[2], ge[3]);
    }
    __syncthreads();
}
DEVI void st_gemm3_topk(const Params& p, char* smem) {
    for (int it = blockIdx.x; it < 128 * 8; it += gridDim.x) gemm3_topk_tile(p, (it >> 3) * 256, it & 7, smem);
}

#define XB_TMO      128
#define XB_XCNT(j)  (256  + 64 * (j))
#define XB_XSUB(j)  (1280 + 64 * (j))
#define XB_XGEN(j)  (2304 + 64 * (j))
#define XB_TOP      3328
#define XB_TOPGEN   3392
#define XCD_BAR_WORDS 3456
#define XB_SPIN_CAP (1u << 20)
#define LAS __attribute__((address_space(3)))
DEVI unsigned xb_ld(unsigned* p) { return __hip_atomic_load(p, __ATOMIC_RELAXED, __HIP_MEMORY_SCOPE_AGENT); }
DEVI unsigned xb_add(unsigned* p, unsigned v) { return __hip_atomic_fetch_add(p, v, __ATOMIC_RELAXED, __HIP_MEMORY_SCOPE_AGENT); }
DEVI unsigned xb_xcc_id() { return (unsigned)__builtin_amdgcn_s_getreg((3 << 11) | 20) & 0xFu; }
#define XB_SPIN(cond, bar) do { unsigned _sp = 0; while (cond) { __builtin_amdgcn_s_sleep(1); \
    if ((++_sp & 255u) == 0u) { if (xb_ld(&(bar)[XB_TMO])) break; if (_sp > XB_SPIN_CAP) { atomicAdd(&(bar)[XB_TMO], 1u); break; } } } } while (0)
struct XcdBarrier { unsigned* bar; unsigned x; volatile LAS unsigned* st; };
DEVI XcdBarrier xcd_barrier_post(unsigned* bar, volatile LAS unsigned* st) {
    XcdBarrier b; b.bar = bar; b.x = xb_xcc_id(); b.st = st;
    if (stid() == 0) (void)xb_add(&bar[XB_XCNT(b.x)], 1u);
    return b;
}
DEVI void xcd_barrier_complete(unsigned* bar, unsigned x, unsigned& nloc, unsigned& nx) {
    const unsigned G = gridDim.x * gridDim.y * gridDim.z;
    unsigned sum, cnt, mine, sp = 0u;
    for (;;) {
        sum = 0u; cnt = 0u; mine = 0u;
#pragma unroll
        for (unsigned j = 0; j < 16; ++j) { const unsigned c = xb_ld(&bar[XB_XCNT(j)]); sum += c; cnt += (c > 0u) ? 1u : 0u; mine = (j == x) ? c : mine; }
        if (sum == G) break;
        __builtin_amdgcn_s_sleep(1);
        if ((++sp & 255u) == 0u) { if (xb_ld(&bar[XB_TMO])) break; if (sp > XB_SPIN_CAP) { atomicAdd(&bar[XB_TMO], 1u); break; } }
    }
    nloc = mine > 0u ? mine : 1u; nx = cnt > 0u ? cnt : 1u;
}
DEVI void xcd_barrier(const XcdBarrier& b) {
    asm volatile("s_waitcnt vmcnt(0)" ::: "memory");
    __syncthreads();
    if (stid() == 0) {
        unsigned* bar = b.bar;
        __builtin_amdgcn_s_waitcnt(0);
        unsigned nloc = b.st[0], nx = b.st[1];
        if (nloc == 0u) { xcd_barrier_complete(bar, b.x, nloc, nx); b.st[0] = nloc; b.st[1] = nx; }
        const unsigned old = xb_add(&bar[XB_XSUB(b.x)], 1u);
        const unsigned gen = old / nloc;
        if (old + 1u == (gen + 1u) * nloc) {
            __builtin_amdgcn_fence(__ATOMIC_RELEASE, "agent");
            asm volatile("s_waitcnt vmcnt(0)" ::: "memory");
            const unsigned og = xb_add(&bar[XB_TOP], 1u);
            const unsigned tg = og / nx;
            if (og + 1u == (tg + 1u) * nx) xb_add(&bar[XB_TOPGEN], 1u);
            else XB_SPIN(xb_ld(&bar[XB_TOPGEN]) == tg, bar);
            __builtin_amdgcn_fence(__ATOMIC_ACQUIRE, "agent");
            xb_add(&bar[XB_XGEN(b.x)], 1u);
            asm volatile("s_waitcnt vmcnt(0)" ::: "memory");
        } else {
            XB_SPIN(xb_ld(&bar[XB_XGEN(b.x)]) == gen, bar);
            __builtin_amdgcn_fence(__ATOMIC_ACQUIRE, "agent");
            asm volatile("s_waitcnt vmcnt(0)" ::: "memory");
        }
    }
    __syncthreads();
}

#define CTR_A(x) (XCD_BAR_WORDS + 64 * (x))
#define CTR_B(x) (XCD_BAR_WORDS + 512 + 64 * (x))
#define CTL_WORDS (XCD_BAR_WORDS + 1024)
typedef float f32x2 __attribute__((ext_vector_type(2)));
DEVI float ub(unsigned w, int n) { return (float)((w >> (8 * n)) & 0xffu); }
DEVI float gelu_erf(float v) {
    const float av = fabsf(v), t = rcp_(av * 0.2316418882f + 1.0f);
    float q = t * 0.5307027145f + (-0.7265760135f);
    q = q * t + 0.7107068705f; q = q * t + (-0.142248368f); q = q * t + 0.127414796f; q = q * t;
    const float e = __builtin_amdgcn_exp2f((v * v) * (-0.72134752044f));
    const float m = v * (q * e);
    return v < 0.f ? m : v - m;
}
struct ExpMeta { uint4 e[2]; uint4 xa; uint4 xb; float sc; float sa8; };
struct ExpRows { uint4 r[16]; uint2 x1; };

template <int PHASE> DEVI void exp_load_meta(const Params& p, ExpMeta& m, int t, int x, int lane) {
    const uint4* ep = (const uint4*)(p.eperm + (size_t)t * 128 + (lane >> 3) * 16);
    m.e[0] = ep[0];
    m.e[1] = ep[1];
    if (PHASE == 0) { const uint4* xp = (const uint4*)(p.xq4 + (size_t)t * 1024 + 256 * x + 32 * (lane & 7)); m.xa = xp[0]; m.xb = xp[1]; }
    else { m.xa = *(const uint4*)(p.aq + (size_t)t * 128 + (lane >> 3) * 16); const float2 s2 = *(const float2*)(p.asc + 2 * (size_t)t); m.sc = s2.x; m.sa8 = s2.y; }
}
template <int PHASE> DEVI void exp_issue(const Params& p, const ExpMeta& m, ExpRows& R, int t, int x, int lane) {
    const unsigned char* base = (PHASE == 0 ? p.down_q : p.up_q) + (size_t)x * (16384 * 128) + (lane & 7) * 16;
    const unsigned ew[8] = {m.e[0].x, m.e[0].y, m.e[0].z, m.e[0].w, m.e[1].x, m.e[1].y, m.e[1].z, m.e[1].w};
#pragma unroll
    for (int j = 0; j < 16; ++j) {
        const unsigned ek = (j & 1) ? (ew[j >> 1] >> 16) : (ew[j >> 1] & 0xffffu);
        R.r[j] = *(const uint4*)(base + (size_t)ek * 128);
    }
    if (PHASE == 1) {
        const int col = 256 * x + 32 * (lane & 7) + ((lane & 32) ? 16 : 0) + ((lane & 16) ? 8 : 0) + ((lane & 8) ? 4 : 0);
        R.x1 = *(const uint2*)(p.x1b + (size_t)t * 1024 + col);
    }
}
DEVI void expA_compute(const Params& p, const ExpMeta& m, const ExpRows& R, int t, int x, int lane) {
    const bool b2 = lane & 4, b1 = lane & 2, b0 = lane & 1;
    int ps[16];
    const int xq8[8] = {(int)m.xa.x, (int)m.xa.y, (int)m.xa.z, (int)m.xa.w, (int)m.xb.x, (int)m.xb.y, (int)m.xb.z, (int)m.xb.w};
#pragma unroll
    for (int j = 0; j < 16; ++j) {
        const unsigned wd[4] = {R.r[j].x, R.r[j].y, R.r[j].z, R.r[j].w};
        int ah = 0, al = 0;
#pragma unroll
        for (int d = 0; d < 4; ++d) {
            ah = __builtin_amdgcn_sdot8((int)wd[d], xq8[2 * d], ah, false);
            al = __builtin_amdgcn_sdot8((int)wd[d], xq8[2 * d + 1], al, false);
        }
        ps[j] = 16 * ah + al;
    }
    int q8[8], q4[4], q2[2];
#pragma unroll
    for (int j = 0; j < 8; ++j) { const int snd = b2 ? ps[j] : ps[j + 8], kp = b2 ? ps[j + 8] : ps[j]; q8[j] = kp + dpp_i<DPP_HMIRROR>(snd); }
#pragma unroll
    for (int j = 0; j < 4; ++j) { const int snd = b1 ? q8[j] : q8[j + 4], kp = b1 ? q8[j + 4] : q8[j]; q4[j] = kp + dpp_i<DPP_XOR2>(snd); }
#pragma unroll
    for (int j = 0; j < 2; ++j) { const int snd = b0 ? q4[j] : q4[j + 2], kp = b0 ? q4[j + 2] : q4[j]; q2[j] = kp + dpp_i<DPP_XOR1>(snd); }
    {
        int s0 = q2[0], s1 = q2[1];
        s0 = s0 > 32767 ? 32767 : (s0 < -32768 ? -32768 : s0);
        s1 = s1 > 32767 ? 32767 : (s1 < -32768 ? -32768 : s1);
        *(unsigned*)(p.part + ((size_t)x * T_TOK + t) * 128 + 2 * lane) = ((unsigned)s0 & 0xffffu) | ((unsigned)s1 << 16);
    }
}
DEVI void expB_compute(const Params& p, const ExpMeta& m, const ExpRows& R, int t, int x, int lane) {
    const bool b3 = lane & 8;
    const unsigned pa[4] = {m.xa.x, m.xa.y, m.xa.z, m.xa.w};
    int accF[16], accH[16];
#pragma unroll
    for (int c = 0; c < 16; ++c) { accF[c] = 0; accH[c] = 0; }
#pragma unroll
    for (int g = 0; g < 4; ++g) {
        const unsigned r0[4] = {R.r[4 * g].x, R.r[4 * g].y, R.r[4 * g].z, R.r[4 * g].w};
        const unsigned r1[4] = {R.r[4 * g + 1].x, R.r[4 * g + 1].y, R.r[4 * g + 1].z, R.r[4 * g + 1].w};
        const unsigned r2[4] = {R.r[4 * g + 2].x, R.r[4 * g + 2].y, R.r[4 * g + 2].z, R.r[4 * g + 2].w};
        const unsigned r3[4] = {R.r[4 * g + 3].x, R.r[4 * g + 3].y, R.r[4 * g + 3].z, R.r[4 * g + 3].w};
#pragma unroll
        for (int i = 0; i < 4; ++i) {
            const unsigned t0 = __builtin_amdgcn_perm(r1[i], r0[i], 0x05010400u), t1 = __builtin_amdgcn_perm(r1[i], r0[i], 0x07030602u);
            const unsigned t2 = __builtin_amdgcn_perm(r3[i], r2[i], 0x05010400u), t3 = __builtin_amdgcn_perm(r3[i], r2[i], 0x07030602u);
            const unsigned o[4] = {__builtin_amdgcn_perm(t2, t0, 0x05040100u), __builtin_amdgcn_perm(t2, t0, 0x07060302u),
                                   __builtin_amdgcn_perm(t3, t1, 0x05040100u), __builtin_amdgcn_perm(t3, t1, 0x07060302u)};
#pragma unroll
            for (int n = 0; n < 4; ++n) {
                accF[4 * i + n] = __builtin_amdgcn_sdot4((int)o[n], (int)pa[g], accF[4 * i + n], false);
                accH[4 * i + n] = __builtin_amdgcn_sdot4((int)(o[n] & 0xf0f0f0f0u), (int)pa[g], accH[4 * i + n], false);
            }
        }
    }
    int acc[32];
#pragma unroll
    for (int i = 0; i < 4; ++i)
#pragma unroll
        for (int n = 0; n < 4; ++n) { acc[8 * i + n] = accF[4 * i + n] - accH[4 * i + n]; acc[8 * i + 4 + n] = accH[4 * i + n]; }
    int q16[16], q8[8], q4[4];
#pragma unroll
    for (int j = 0; j < 16; ++j) {
        const auto r = __builtin_amdgcn_permlane32_swap((unsigned)acc[j], (unsigned)acc[j + 16], false, false);
        q16[j] = (int)r[0] + (int)r[1];
    }
#pragma unroll
    for (int j = 0; j < 8; ++j) {
        const auto r = __builtin_amdgcn_permlane16_swap((unsigned)q16[j], (unsigned)q16[j + 8], false, false);
        q8[j] = (int)r[0] + (int)r[1];
    }
#pragma unroll
    for (int j = 0; j < 4; ++j) { const int snd = b3 ? q8[j] : q8[j + 4], kp = b3 ? q8[j + 4] : q8[j]; q4[j] = kp + dpp_i<DPP_ROR8>(snd); }
    const int col = 256 * x + 32 * (lane & 7) + ((lane & 32) ? 16 : 0) + ((lane & 16) ? 8 : 0) + (b3 ? 4 : 0);
    const float sc = b3 ? m.sc : m.sc * 16.f, off = b3 ? 0.f : m.sa8;
    *(uint2*)(p.proj + (size_t)t * 1024 + col) = make_uint2(pk2(bflo(R.x1.x) + ((float)q4[0] - off) * sc, bfhi(R.x1.x) + ((float)q4[1] - off) * sc),
                                                            pk2(bflo(R.x1.y) + ((float)q4[2] - off) * sc, bfhi(R.x1.y) + ((float)q4[3] - off) * sc));
}
constexpr int EXP_NP = 16;
template <int PHASE>
DEVI void exp_chunk(const Params& p, int tb, int x, int lane) {
    ExpMeta mA, mB, nA, nB;
    ExpRows rA, rB;
    exp_load_meta<PHASE>(p, mA, tb, x, lane);
    exp_load_meta<PHASE>(p, mB, tb + 1, x, lane);
    exp_issue<PHASE>(p, mA, rA, tb, x, lane);
    exp_issue<PHASE>(p, mB, rB, tb + 1, x, lane);
    exp_load_meta<PHASE>(p, nA, tb + 2, x, lane);
    exp_load_meta<PHASE>(p, nB, tb + 3, x, lane);
#pragma unroll 1
    for (int i = 0; i < EXP_NP; ++i) {
        const int tA = tb + 2 * i, tB = tA + 1;
        if (PHASE == 0) expA_compute(p, mA, rA, tA, x, lane); else expB_compute(p, mA, rA, tA, x, lane);
        if (i < EXP_NP - 1) {
            mA = nA;
            exp_issue<PHASE>(p, mA, rA, tA + 2, x, lane);
            if (i < EXP_NP - 2) exp_load_meta<PHASE>(p, nA, tA + 4, x, lane);
        }
        if (PHASE == 0) expA_compute(p, mB, rB, tB, x, lane); else expB_compute(p, mB, rB, tB, x, lane);
        if (i < EXP_NP - 1) {
            mB = nB;
            exp_issue<PHASE>(p, mB, rB, tB + 2, x, lane);
            if (i < EXP_NP - 2) exp_load_meta<PHASE>(p, nB, tB + 4, x, lane);
        }
    }
}
template <int PHASE>
DEVI void st_expAB(const Params& p, char* smem) {
    const int tid = stid(), lane = tid & 63, wid = tid >> 6;
    volatile int* cs = (volatile int*)smem;
    const unsigned myx = xb_xcc_id() & 7u;
    constexpr int NCH = T_TOK / (2 * EXP_NP * NW);
    constexpr int NSL = 4;
    for (int si = 0; si < NSL; ++si) {
        const int x = (int)((myx + si) & (unsigned)(NSL - 1));
        unsigned* ctr = &p.bar[PHASE == 0 ? CTR_A(x) : CTR_B(x)];
        if (tid == 0) cs[0] = (int)xb_add(ctr, 1u);
        __syncthreads();
        int chunk = cs[0];
        __syncthreads();
        while (chunk < NCH) {
            int nxt = 0;
            if (tid == 0) nxt = (int)xb_add(ctr, 1u);
            exp_chunk<PHASE>(p, chunk * (2 * EXP_NP * NW) + wid * (2 * EXP_NP), x, lane);
            if (tid == 0) cs[0] = nxt;
            __syncthreads();
            chunk = cs[0];
            __syncthreads();
        }
    }
}
DEVI void st_expA2(const Params& p) {
    const int lane = stid() & 63, wid = stid() >> 6;
    for (int t0 = (blockIdx.x * NW + wid) * 2; t0 < T_TOK; t0 += gridDim.x * NW * 2) {
        unsigned pv[2][4], ew[2];
        float2 g[2];
        float xs[2];
#pragma unroll
        for (int q = 0; q < 2; ++q) {
            const int t = t0 + q;
#pragma unroll
            for (int x = 0; x < 4; ++x) pv[q][x] = *(const unsigned*)(p.part + ((size_t)x * T_TOK + t) * 128 + 2 * lane);
            ew[q] = *(const unsigned*)(p.eperm + (size_t)t * 128 + 2 * lane);
            g[q] = *(const float2*)(p.gate + (size_t)t * 128 + 2 * lane);
            xs[q] = rs2_of(p.rs2p, t) * ZQ_SCALE;
        }
        float ds[2][2], us[2][2];
#pragma unroll
        for (int q = 0; q < 2; ++q) {
            const int ea = (int)(ew[q] & 0xffffu), eb = (int)(ew[q] >> 16);
            ds[q][0] = p.dscale[ea]; ds[q][1] = p.dscale[eb]; us[q][0] = p.uscale[ea]; us[q][1] = p.uscale[eb];
        }
#pragma unroll
        for (int q = 0; q < 2; ++q) {
            const int t = t0 + q;
            int s0 = 0, s1 = 0;
#pragma unroll
            for (int x = 0; x < 4; ++x) { s0 += (int)(short)(pv[q][x] & 0xffffu); s1 += (int)pv[q][x] >> 16; }
            const float a0 = g[q].x * gelu_erf((float)s0 * xs[q] * ds[q][0]) * us[q][0];
            const float a1 = g[q].y * gelu_erf((float)s1 * xs[q] * ds[q][1]) * us[q][1];
            const float amax = wave_max(fmaxf(fabsf(a0), fabsf(a1)));
            const float inv = amax > 0.f ? 127.f * rcp_(amax) : 0.f;
            const float f0 = rintf(a0 * inv), f1 = rintf(a1 * inv);
            const unsigned q0 = (unsigned)((int)f0 & 255), q1 = (unsigned)((int)f1 & 255);
            *(unsigned short*)(p.aq + (size_t)t * 128 + 2 * lane) = (unsigned short)(q0 | (q1 << 8));
            const float sa = wave_sum(f0 + f1);
            if (lane == 0) *(float2*)(p.asc + 2 * (size_t)t) = make_float2(amax * (1.f / 127.f), 8.f * sa);
        }
    }
}
DEVI void st_expC(const Params& p) {
    const int lane = stid() & 63, wid = stid() >> 6;
    for (int t0 = (blockIdx.x * NW + wid) * 2; t0 < T_TOK; t0 += gridDim.x * NW * 2) {
        uint2 u[2][4];
#pragma unroll
        for (int q = 0; q < 2; ++q) {
            const uint2* row = (const uint2*)(p.proj + (size_t)(t0 + q) * 1024);
#pragma unroll
            for (int j = 0; j < 4; ++j) u[q][j] = row[lane + 64 * j];
        }
#pragma unroll
        for (int q = 0; q < 2; ++q) {
            float4 v[4];
            float ss = 0.f;
#pragma unroll
            for (int j = 0; j < 4; ++j) {
                v[j] = make_float4(bflo(u[q][j].x), bfhi(u[q][j].x), bflo(u[q][j].y), bfhi(u[q][j].y));
                ss += v[j].x * v[j].x + v[j].y * v[j].y + v[j].z * v[j].z + v[j].w * v[j].w;
            }
            ss = wave_sum(ss);
            const float rf = rsqrtf(ss * (1.f / 1024.f) + EPSN);
            float4* orow = (float4*)(p.out + (size_t)(t0 + q) * 1024);
#pragma unroll
            for (int j = 0; j < 4; ++j) {
                const float4 g = *(const float4*)(p.final_g + (lane + 64 * j) * 4);
                orow[lane + 64 * j] = make_float4(v[j].x * rf * g.x, v[j].y * rf * g.y, v[j].z * rf * g.z, v[j].w * rf * g.w);
            }
        }
    }
}

constexpr int LDS_BYTES = 147456;
constexpr int LDS_BARW = LDS_BYTES - 16;
extern __shared__ __attribute__((aligned(16))) char smem_dyn[];
__global__ void __launch_bounds__(NTHR, 2) mega_fwd(Params p) {
    cg::grid_group grid = cg::this_grid();
    volatile LAS unsigned* bst = (volatile LAS unsigned*)(LAS char*)(smem_dyn + LDS_BARW);
    if (stid() < 4) bst[stid()] = 0u;
    __syncthreads();
    XcdBarrier bar = xcd_barrier_post(p.bar, bst);
    st_prep_misc(p);
    st_prep_w1(p, smem_dyn);
    st_prep_x(p, smem_dyn);
    if (p.pad_[0] == 0x7fffabcd) grid.sync();
    xcd_barrier(bar);
    st_gemm8<EpiProj8, PG8_ALIGN>(p.xb, p.W1t, NPJ, 1024, smem_dyn, EpiProj8{p.proj, p.rs1, p.rope_cos, p.rope_sin});
    xcd_barrier(bar);
    st_conv_qk(p, smem_dyn);
    xcd_barrier(bar);
    st_recur(p, smem_dyn);
    xcd_barrier(bar);
    st_gemm8<EpiX18, PG8_ALIGN>(p.yb, p.W2t, 1024, 1024, smem_dyn, EpiX18{p.x, p.x1b, p.xq, p.xq4, p.rs2p, p.norm2_g});
    xcd_barrier(bar);
    st_gemm3_topk(p, smem_dyn);
    xcd_barrier(bar);
    st_expAB<0>(p, smem_dyn);
    xcd_barrier(bar);
    st_expA2(p);
    xcd_barrier(bar);
    st_expAB<1>(p, smem_dyn);
    xcd_barrier(bar);
    st_expC(p);
}

extern "C" void kernel_launch(void* const* d_in, const int* in_sizes, int n_in, void* d_out, int out_size, void* d_ws, size_t ws_size,
                              hipStream_t stream) {
    Params p{};
    const float* const* in = (const float* const*)d_in;
    p.x = in[0]; p.norm1_g = in[1]; p.w_in = in[2]; p.ret_norm_g = in[3]; p.m_conv_w = in[4]; p.m_conv_b = in[5]; p.m_wq = in[6]; p.m_wk = in[7];
    p.m_b_i = in[8]; p.m_b_f = in[9]; p.m_norm_g = in[10]; p.m_skip = in[11]; p.w_out = in[12]; p.norm2_g = in[13]; p.peer_wq = in[14];
    p.peer_keys = in[15]; p.peer_down = in[16]; p.peer_up = in[17]; p.final_g = in[18];
    p.out = (float*)d_out;
    char* ws = (char*)d_ws;
    size_t off = 0;
    auto take = [&](size_t bytes) { char* r = ws + off; off += (bytes + 255) & ~(size_t)255; return r; };
    p.proj = (bf16_t*)take((size_t)T_TOK * NPJ * 2);
    p.xb = (bf16_t*)take((size_t)T_TOK * 1024 * 2);
    p.yb = p.xb;
    p.gate = (float*)(ws + (size_t)T_TOK * 2048 * 4);
    p.mq = (bf16_t*)take((size_t)T_TOK * 512 * 2);
    p.mk = (bf16_t*)take((size_t)T_TOK * 512 * 2);
    p.x1b = p.mq;
    p.cbuf = (bf16_t*)take((size_t)T_TOK * 512 * 2);
    p.eperm = (unsigned short*)p.cbuf;
    p.down_q = (unsigned char*)take((size_t)16384 * 1024);
    p.up_q = (unsigned char*)take((size_t)16384 * 1024);
    p.dscale = (float*)take(16384 * 4);
    p.uscale = (float*)take(16384 * 4);
    p.bar = (unsigned*)take(CTL_WORDS * 4);
    p.xq = (unsigned char*)take((size_t)T_TOK * 1024);
    p.xq4 = (unsigned char*)take((size_t)T_TOK * 1024);
    p.asc = (float*)take(T_TOK * 8);
    p.aq = (unsigned char*)take((size_t)T_TOK * 128);
    p.part = (short*)(ws + (size_t)T_TOK * 1024 * 4);
    p.W1t = (bf16_t*)take((size_t)NPJ * 1024 * 2);
    p.W2t = (bf16_t*)take((size_t)1024 * 1024 * 2);
    p.Wsubq = (signed char*)take((size_t)2048 * 1024);
    p.wsc = (float*)take(2048 * 4);
    p.Wqt = (bf16_t*)take(4 * 128 * 128 * 2);
    p.Wkt = (bf16_t*)take(4 * 128 * 128 * 2);
    p.rs1 = (float*)take(T_TOK * 4);
    p.rs2p = (float*)take((size_t)T_TOK * 16 * 4);
    p.ipre = (float*)take(T_TOK * 4 * 4);
    p.logf = (float*)take(T_TOK * 4 * 4);
    p.rope_cos = (float*)take(2048 * 64 * 4);
    p.rope_sin = (float*)take(2048 * 64 * 4);
    if (off > ws_size) { fprintf(stderr, "kernel_launch: workspace too small (%zu > %zu)\n", off, ws_size); return; }

    static int grid_blocks = 0;
    if (!grid_blocks) {
        int dev = 0, cus = 0, per_cu = 0;
        (void)hipGetDevice(&dev);
        (void)hipDeviceGetAttribute(&cus, hipDeviceAttributeMultiprocessorCount, dev);
        (void)hipFuncSetAttribute((const void*)mega_fwd, hipFuncAttributeMaxDynamicSharedMemorySize, LDS_BYTES);
        (void)hipOccupancyMaxActiveBlocksPerMultiprocessor(&per_cu, (const void*)mega_fwd, NTHR, LDS_BYTES);
        if (per_cu > 1) per_cu = 1;
        if (per_cu < 1) per_cu = 1;
        grid_blocks = cus * per_cu;
    }
    (void)hipMemsetAsync(p.bar, 0, CTL_WORDS * 4, stream);
    void* args[] = {&p};
    hipError_t e = hipLaunchCooperativeKernel((const void*)mega_fwd, dim3(grid_blocks), dim3(NTHR), args, LDS_BYTES, stream);
    if (e != hipSuccess) fprintf(stderr, "cooperative launch failed: %s (grid %d)\n", hipGetErrorString(e), grid_blocks);
}
```
